# Optimizing an MI355X kernel written in HIP

```python
import jax
import jax.numpy as jnp
from jax import lax
import numpy as np

D_MODEL = 1024
BATCH = 1
SEQ = 16384
DEPTH = 2

GRID_W = 64
CTX_LEN = 256
HEAD_DIM = 64
EPS = 1e-6
ROPE_THETA = 10000.0

D_LRU = 256
LRU_BLOCKS = 4
LRU_BLOCK = D_LRU // LRU_BLOCKS
CONV_W = 4
CONV_PAD = (2, 1)
LRU_C = 8.0
WIN_Q_HEADS = 6
WIN_KV_HEADS = 2
WINDOW = 128
WIN_BLOCK = 128
NA_HEADS = 6
NA_KH = 8
NA_KW = 16
NA_QW = 16
NA_KCOLS = NA_QW + NA_KW
PEER_HEADS = 8
PEER_NKEYS = 128
PEER_N = PEER_NKEYS * PEER_NKEYS
PEER_DKEY = 256
PEER_TOPK = 16
PEER_CHUNK = 128

D_WIN_Q = WIN_Q_HEADS * HEAD_DIM
D_WIN_KV = WIN_KV_HEADS * HEAD_DIM
D_NA = NA_HEADS * HEAD_DIM
D_MIX = D_LRU + D_WIN_Q + D_NA
IN_WIDTHS = (D_LRU, D_LRU, D_WIN_Q, D_WIN_KV, D_WIN_KV, D_NA, D_NA, D_NA)
D_IN = sum(IN_WIDTHS)

kernel_name = 'hybrid_lru_window_natten_peer_prefix'


def rms_norm(x, g):
    xf = x.astype(jnp.float32)
    y = xf * lax.rsqrt(jnp.mean(xf * xf, axis=-1, keepdims=True) + EPS)
    return (y * g.astype(jnp.float32)).astype(x.dtype)


def heads(t, n):
    return t.reshape(*t.shape[:-1], n, HEAD_DIM)


def split_in(p):
    bounds = np.cumsum(IN_WIDTHS)[:-1].tolist()
    return jnp.split(p, bounds, axis=-1)


def rope_angles(L):
    t = jnp.arange(L)
    row = (t // GRID_W).astype(jnp.float32)
    col = (t % GRID_W).astype(jnp.float32)
    n = HEAD_DIM // 4
    inv = ROPE_THETA ** (-jnp.arange(n, dtype=jnp.float32) / n)
    ang = jnp.concatenate([row[:, None] * inv, col[:, None] * inv], axis=-1)
    return jnp.cos(ang), jnp.sin(ang)


def apply_rope_2d(x, cos, sin):
    n = HEAD_DIM // 4
    xf = x.astype(jnp.float32)
    parts = []
    for axis in range(2):
        seg = xf[..., axis * 2 * n:(axis + 1) * 2 * n]
        x1, x2 = seg[..., :n], seg[..., n:]
        cs = cos[None, :, None, axis * n:(axis + 1) * n]
        sn = sin[None, :, None, axis * n:(axis + 1) * n]
        parts += [x1 * cs - x2 * sn, x1 * sn + x2 * cs]
    return jnp.concatenate(parts, axis=-1).astype(x.dtype)


def dwconv(x, w, b):
    y = lax.conv_general_dilated(x, w[:, None, :].astype(x.dtype), window_strides=(1,),
                                 padding=[CONV_PAD], dimension_numbers=('NWC', 'WIO', 'NWC'),
                                 feature_group_count=x.shape[-1])
    return y + b


def block_linear(x, w, b):
    B, L, C = x.shape
    y = jnp.einsum('blnd,nde->blne', x.reshape(B, L, LRU_BLOCKS, LRU_BLOCK), w)
    return y.reshape(B, L, C) + b


def rglru_coeffs(u, wa, ba, wx, bx, lam):
    r = jax.nn.sigmoid(block_linear(u, wa, ba).astype(jnp.float32))
    i = jax.nn.sigmoid(block_linear(u, wx, bx).astype(jnp.float32))
    log_a = -LRU_C * r * jax.nn.softplus(-lam.astype(jnp.float32))
    a = jnp.exp(log_a)
    b = jnp.sqrt(-jnp.expm1(2.0 * log_a)) * i * u.astype(jnp.float32)
    return a, b


def _combine(left, right):
    a_l, b_l = left
    a_r, b_r = right
    return a_l * a_r, a_r * b_l + b_r


def linear_scan(a, b, h0, reverse):
    if h0 is not None:
        edge = -1 if reverse else 0
        b = b.at[:, edge].add(a[:, edge] * h0)
    _, h = lax.associative_scan(_combine, (a, b), reverse=reverse, axis=1)
    return h


def lru_mixer(xb_c, gb_c, xb_l, gb_l, conv_w, conv_b, wa, ba, wx, bx, lam, ctx_out):
    u_c = dwconv(xb_c, conv_w, conv_b)
    u_l = dwconv(xb_l, conv_w, conv_b)
    hs_c, hs_l = [], []
    for d in range(2):
        rev = d == 1
        a_c, b_c = rglru_coeffs(u_c, wa[d], ba[d], wx[d], bx[d], lam[d])
        h_c = linear_scan(a_c, b_c, None, rev)
        h0 = h_c[:, 0] if rev else h_c[:, -1]
        a_l, b_l = rglru_coeffs(u_l, wa[d], ba[d], wx[d], bx[d], lam[d])
        hs_l.append(linear_scan(a_l, b_l, h0, rev))
        hs_c.append(h_c)
    y_l = (hs_l[0] + hs_l[1]).astype(xb_l.dtype) * jax.nn.gelu(gb_l)
    y_c = (hs_c[0] + hs_c[1]).astype(xb_c.dtype) * jax.nn.gelu(gb_c) if ctx_out else None
    return y_c, y_l


def ctx_attention(q, k, v, sink):
    B, Lc, H, hd = q.shape
    G = k.shape[2]
    R = H // G
    qg = q.reshape(B, Lc, G, R, hd)
    s = jnp.einsum('bqgrd,bkgd->bgrqk', qg, k).astype(jnp.float32) * hd ** -0.5
    if sink is not None:
        s_sink = jnp.broadcast_to(sink.astype(jnp.float32).reshape(1, G, R, 1, 1), (B, G, R, Lc, 1))
        s = jnp.concatenate([s, s_sink], axis=-1)
    p = jax.nn.softmax(s, axis=-1)[..., :Lc].astype(v.dtype)
    o = jnp.einsum('bgrqk,bkgd->bqgrd', p, v)
    return o.reshape(B, Lc, H * hd)


def window_attention(q, k, v, kc, vc, sink):
    B, L, H, hd = q.shape
    G = k.shape[2]
    R = H // G
    W = WIN_BLOCK
    nb = L // W
    Lc = kc.shape[1]
    scale = hd ** -0.5
    qb = q.reshape(B, nb, W, G, R, hd)

    def bands(t):
        tp = jnp.pad(t, ((0, 0), (W, W), (0, 0), (0, 0))).reshape(B, nb + 2, W, G, hd)
        return jnp.concatenate([tp[:, :-2], tp[:, 1:-1], tp[:, 2:]], axis=2)

    kb, vb = bands(k), bands(v)
    s_loc = jnp.einsum('bnqgrd,bnkgd->bngrqk', qb, kb).astype(jnp.float32) * scale
    s_ctx = jnp.einsum('bnqgrd,bcgd->bngrqc', qb, kc).astype(jnp.float32) * scale
    qi = jnp.arange(W)[:, None]
    ki = jnp.arange(3 * W)[None, :]
    kpos = jnp.arange(nb)[:, None, None] * W + ki[None] - W
    valid = (jnp.abs(ki - W - qi) <= WINDOW)[None] & (kpos >= 0) & (kpos < L)
    s_loc = jnp.where(valid[None, :, None, None], s_loc, -jnp.inf)
    s_sink = jnp.broadcast_to(sink.astype(jnp.float32).reshape(1, 1, G, R, 1, 1), (B, nb, G, R, W, 1))
    p = jax.nn.softmax(jnp.concatenate([s_loc, s_ctx, s_sink], axis=-1), axis=-1).astype(v.dtype)
    o = (jnp.einsum('bngrqk,bnkgd->bnqgrd', p[..., :3 * W], vb)
         + jnp.einsum('bngrqc,bcgd->bnqgrd', p[..., 3 * W:3 * W + Lc], vc))
    return o.reshape(B, L, H * hd)


def neighborhood_attention(q, k, v, kc, vc, rpb):
    B, L, H, hd = q.shape
    rows = L // GRID_W
    kh = min(NA_KH, rows)
    ncb = GRID_W // NA_QW
    K = kh * NA_KCOLS
    scale = hd ** -0.5
    r = jnp.arange(rows)
    kr = jnp.clip(r - NA_KH // 2, 0, rows - kh)[:, None] + jnp.arange(kh)[None]
    kcol = (jnp.clip(jnp.arange(ncb) * NA_QW - NA_KW // 2, 0, GRID_W - NA_KCOLS)[:, None]
            + jnp.arange(NA_KCOLS)[None])
    qcol = jnp.arange(ncb)[:, None] * NA_QW + jnp.arange(NA_QW)[None]
    qstart = jnp.clip(qcol - NA_KW // 2, 0, GRID_W - NA_KW)
    rel = kcol[:, None, :] - qstart[:, :, None]
    colmask = (rel >= 0) & (rel < NA_KW)
    mask = jnp.broadcast_to(colmask[:, :, None, :], (ncb, NA_QW, kh, NA_KCOLS)).reshape(ncb, NA_QW, K)
    dc = jnp.clip(kcol[:, None, :] - qcol[:, :, None] + NA_KW - 1, 0, 2 * NA_KW - 2)
    dr = kr - r[:, None] + NA_KH - 1
    idx = (kr[:, None, :, None] * GRID_W + kcol[None, :, None, :]).reshape(rows, ncb, K)
    qrows = jnp.moveaxis(q.reshape(B, rows, ncb, NA_QW, H, hd), 1, 0)

    def row_block(args):
        q_r, idx_r, dr_r = args
        k_r = k[:, idx_r]
        v_r = v[:, idx_r]
        bias = rpb[:, dr_r[None, None, :, None], dc[:, :, None, :]]
        bias = jnp.moveaxis(bias, 0, 1).reshape(ncb, H, NA_QW, K).astype(jnp.float32)
        s = jnp.einsum('bjqhd,bjkhd->bjhqk', q_r, k_r).astype(jnp.float32) * scale + bias[None]
        s = jnp.where(mask[None, :, None], s, -jnp.inf)
        s_c = jnp.einsum('bjqhd,bchd->bjhqc', q_r, kc).astype(jnp.float32) * scale
        p = jax.nn.softmax(jnp.concatenate([s, s_c], axis=-1), axis=-1).astype(v.dtype)
        return (jnp.einsum('bjhqk,bjkhd->bjqhd', p[..., :K], v_r)
                + jnp.einsum('bjhqc,bchd->bjqhd', p[..., K:], vc))

    o = lax.map(row_block, (qrows, idx, dr))
    return jnp.moveaxis(o, 0, 1).reshape(B, L, H * hd)


def peer_ffn(h, w_q, k1, k2, u, v):
    B, L, D = h.shape
    half = PEER_DKEY // 2
    q = (h @ w_q).reshape(B, L, PEER_HEADS, 2, half)
    s1 = jnp.einsum('blhd,nd->blhn', q[..., 0, :], k1).astype(jnp.float32)
    s2 = jnp.einsum('blhd,nd->blhn', q[..., 1, :], k2).astype(jnp.float32)
    v1, i1 = lax.top_k(s1, PEER_TOPK)
    v2, i2 = lax.top_k(s2, PEER_TOPK)
    cand = (v1[..., :, None] + v2[..., None, :]).reshape(B, L, PEER_HEADS, PEER_TOPK * PEER_TOPK)
    cidx = (i1[..., :, None] * PEER_NKEYS + i2[..., None, :]).reshape(B, L, PEER_HEADS, PEER_TOPK * PEER_TOPK)
    best, pos = lax.top_k(cand, PEER_TOPK)
    eidx = jnp.take_along_axis(cidx, pos, axis=-1)
    gate = jax.nn.softmax(best, axis=-1).astype(h.dtype)
    n = B * L
    E = PEER_HEADS * PEER_TOPK
    nch = n // PEER_CHUNK
    xs = (h.reshape(nch, PEER_CHUNK, D), eidx.reshape(nch, PEER_CHUNK, E), gate.reshape(nch, PEER_CHUNK, E))

    def chunk(args):
        h_c, e_c, g_c = args
        act = jax.nn.gelu(jnp.einsum('ted,td->te', u[e_c], h_c))
        return jnp.einsum('te,ted->td', g_c * act, v[e_c])

    return lax.map(chunk, xs).reshape(B, L, D)


def setup_inputs(seed: int = 0) -> dict:
    key = jax.random.key(seed)
    ks = iter(jax.random.split(key, 40))
    f32 = jnp.float32
    D = D_MODEL

    def nrm(shape, s):
        return jax.random.normal(next(ks), shape, f32) * s

    def gain(shape):
        return 1.0 + nrm(shape, 0.02)

    x = nrm((BATCH, SEQ, D), 1.0)
    c = nrm((BATCH, D), 1.0)
    ctx = nrm((BATCH, CTX_LEN, D), 1.0)
    c_ctx = nrm((D,), 1.0)
    w_mod = nrm((DEPTH, D, 6 * D), 0.5 * D ** -0.5)
    b_mod = nrm((DEPTH, 6 * D), 0.01)
    norm1_g = gain((DEPTH, D))
    norm2_g = gain((DEPTH, D))
    w_in = nrm((DEPTH, D, D_IN), D ** -0.5)
    w_out = nrm((DEPTH, D_MIX, D), D_MIX ** -0.5)
    lru_conv_w = nrm((DEPTH, CONV_W, D_LRU), CONV_W ** -0.5)
    lru_conv_b = nrm((DEPTH, D_LRU), 0.01)
    lru_wa = nrm((DEPTH, 2, LRU_BLOCKS, LRU_BLOCK, LRU_BLOCK), LRU_BLOCK ** -0.5)
    lru_ba = nrm((DEPTH, 2, D_LRU), 0.01)
    lru_wx = nrm((DEPTH, 2, LRU_BLOCKS, LRU_BLOCK, LRU_BLOCK), LRU_BLOCK ** -0.5)
    lru_bx = nrm((DEPTH, 2, D_LRU), 0.01)
    a8 = jax.random.uniform(next(ks), (DEPTH, 2, D_LRU), f32, 0.9, 0.999)
    a_base = a8 ** (1.0 / LRU_C)
    lru_lam = jnp.log(a_base) - jnp.log1p(-a_base)
    win_qn_g = gain((DEPTH, HEAD_DIM))
    win_kn_g = gain((DEPTH, HEAD_DIM))
    win_sink = nrm((DEPTH, WIN_Q_HEADS), 0.5)
    na_qn_g = gain((DEPTH, HEAD_DIM))
    na_kn_g = gain((DEPTH, HEAD_DIM))
    na_rpb = nrm((DEPTH, NA_HEADS, 2 * NA_KH - 1, 2 * NA_KW - 1), 0.1)
    peer_wq = nrm((DEPTH, D, PEER_HEADS * PEER_DKEY), D ** -0.5)
    peer_k1 = nrm((DEPTH, PEER_NKEYS, PEER_DKEY // 2), (PEER_DKEY // 2) ** -0.5)
    peer_k2 = nrm((DEPTH, PEER_NKEYS, PEER_DKEY // 2), (PEER_DKEY // 2) ** -0.5)
    peer_u = nrm((DEPTH, PEER_N, D), D ** -0.5)
    peer_v = nrm((DEPTH, PEER_N, D), 1.0)
    return {'x': x, 'c': c, 'ctx': ctx, 'c_ctx': c_ctx, 'w_mod': w_mod, 'b_mod': b_mod,
            'norm1_g': norm1_g, 'norm2_g': norm2_g, 'w_in': w_in, 'w_out': w_out,
            'lru_conv_w': lru_conv_w, 'lru_conv_b': lru_conv_b, 'lru_wa': lru_wa, 'lru_ba': lru_ba,
            'lru_wx': lru_wx, 'lru_bx': lru_bx, 'lru_lam': lru_lam,
            'win_qn_g': win_qn_g, 'win_kn_g': win_kn_g, 'win_sink': win_sink,
            'na_qn_g': na_qn_g, 'na_kn_g': na_kn_g, 'na_rpb': na_rpb,
            'peer_wq': peer_wq, 'peer_k1': peer_k1, 'peer_k2': peer_k2, 'peer_u': peer_u, 'peer_v': peer_v}


def reference(x, c, ctx, c_ctx, w_mod, b_mod, norm1_g, norm2_g, w_in, w_out,
              lru_conv_w, lru_conv_b, lru_wa, lru_ba, lru_wx, lru_bx, lru_lam,
              win_qn_g, win_kn_g, win_sink, na_qn_g, na_kn_g, na_rpb,
              peer_wq, peer_k1, peer_k2, peer_u, peer_v):
    B, L, D = x.shape
    Lc = ctx.shape[1]
    cos, sin = rope_angles(L)
    xc = ctx
    c_act = jax.nn.silu(c)
    cc_act = jax.nn.silu(c_ctx)
    for l in range(DEPTH):
        ctx_out = l < DEPTH - 1
        mod = (c_act @ w_mod[l] + b_mod[l])[:, None, :]
        mod_c = (cc_act @ w_mod[l] + b_mod[l])[None, None, :]
        sh1, sc1, g1, sh2, sc2, g2 = jnp.split(mod, 6, axis=-1)
        csh1, csc1, cg1, csh2, csc2, cg2 = jnp.split(mod_c, 6, axis=-1)

        h_l = rms_norm(x, norm1_g[l]) * (1 + sc1) + sh1
        h_c = rms_norm(xc, norm1_g[l]) * (1 + csc1) + csh1
        xa_l, ga_l, qw_l, kw_l, vw_l, qn_l, kn_l, vn_l = split_in(h_l @ w_in[l])
        xa_c, ga_c, qw_c, kw_c, vw_c, qn_c, kn_c, vn_c = split_in(h_c @ w_in[l])

        ya_c, ya_l = lru_mixer(xa_c, ga_c, xa_l, ga_l, lru_conv_w[l], lru_conv_b[l], lru_wa[l], lru_ba[l],
                               lru_wx[l], lru_bx[l], lru_lam[l], ctx_out)

        kwc = rms_norm(heads(kw_c, WIN_KV_HEADS), win_kn_g[l])
        vwc = heads(vw_c, WIN_KV_HEADS)
        qwl = apply_rope_2d(rms_norm(heads(qw_l, WIN_Q_HEADS), win_qn_g[l]), cos, sin)
        kwl = apply_rope_2d(rms_norm(heads(kw_l, WIN_KV_HEADS), win_kn_g[l]), cos, sin)
        yb_l = window_attention(qwl, kwl, heads(vw_l, WIN_KV_HEADS), kwc, vwc, win_sink[l])

        knc = rms_norm(heads(kn_c, NA_HEADS), na_kn_g[l])
        vnc = heads(vn_c, NA_HEADS)
        qnl = rms_norm(heads(qn_l, NA_HEADS), na_qn_g[l])
        knl = rms_norm(heads(kn_l, NA_HEADS), na_kn_g[l])
        yc_l = neighborhood_attention(qnl, knl, heads(vn_l, NA_HEADS), knc, vnc, na_rpb[l])

        x = x + g1 * (jnp.concatenate([ya_l, yb_l, yc_l], axis=-1) @ w_out[l])
        if ctx_out:
            yb_c = ctx_attention(rms_norm(heads(qw_c, WIN_Q_HEADS), win_qn_g[l]), kwc, vwc, win_sink[l])
            yc_c = ctx_attention(rms_norm(heads(qn_c, NA_HEADS), na_qn_g[l]), knc, vnc, None)
            xc = xc + cg1 * (jnp.concatenate([ya_c, yb_c, yc_c], axis=-1) @ w_out[l])

        h2_l = rms_norm(x, norm2_g[l]) * (1 + sc2) + sh2
        if ctx_out:
            h2_c = rms_norm(xc, norm2_g[l]) * (1 + csc2) + csh2
            f = peer_ffn(jnp.concatenate([h2_c, h2_l], axis=1), peer_wq[l], peer_k1[l], peer_k2[l],
                         peer_u[l], peer_v[l])
            xc = xc + cg2 * f[:, :Lc]
            x = x + g2 * f[:, Lc:]
        else:
            x = x + g2 * peer_ffn(h2_l, peer_wq[l], peer_k1[l], peer_k2[l], peer_u[l], peer_v[l])
    return x
```

```cpp
#include <hip/hip_runtime.h>
#include <hip/hip_cooperative_groups.h>
#include <stdint.h>
#include <stdio.h>
namespace cg = cooperative_groups;

#ifndef SINGLE_LAUNCH
#define SINGLE_LAUNCH 0
#endif

constexpr int DM = 1024, SEQ = 16384, LC = 256, TT = SEQ + LC, DIN = 2304, NPQ = 2048;
constexpr int OFF_XA = 0, OFF_GA = 256, OFF_QW = 512, OFF_KW = 896, OFF_VW = 1024, OFF_QN = 1152, OFF_KN = 1536, OFF_VN = 1920;
constexpr float EPS = 1e-6f;

struct P {
  const float *x, *c, *ctx, *c_ctx, *w_mod, *b_mod, *norm1_g, *norm2_g, *w_in, *w_out,
      *conv_w, *conv_b, *wa, *ba, *wx, *bx, *lam, *win_qn, *win_kn, *win_sink, *na_qn, *na_kn, *rpb,
      *wq, *k1, *k2, *pu, *pv;
  float* out;
  float *mod, *xall, *h, *proj, *mix, *ub, *la, *lb, *hs, *gate;
  int* eidx;
};

__device__ __forceinline__ float silu_f(float x) { return x / (1.f + __expf(-x)); }
__device__ __forceinline__ float sigmoid_f(float x) { return 1.f / (1.f + __expf(-x)); }
__device__ __forceinline__ float gelu_f(float x) {
  float u = 0.7978845608028654f * (x + 0.044715f * x * x * x);
  float e = __expf(2.f * u);
  float th = 1.f - 2.f / (e + 1.f);
  return 0.5f * x * (1.f + th);
}
__device__ __forceinline__ float wave_sum(float v) {
#pragma unroll
  for (int o = 32; o > 0; o >>= 1) v += __shfl_xor(v, o);
  return v;
}

#define GTID (blockIdx.x * blockDim.x + threadIdx.x)
#define GSZ (gridDim.x * blockDim.x)

__device__ void ph_mod(const P& p) {
  for (int idx = GTID; idx < 4 * 6144; idx += GSZ) {
    int n = idx % 6144, lw = idx / 6144, l = lw >> 1, which = lw & 1;
    const float* vec = which ? p.c_ctx : p.c;
    const float* w = p.w_mod + (size_t)l * 1024 * 6144 + n;
    float acc = 0.f;
    for (int k = 0; k < 1024; ++k) acc += silu_f(vec[k]) * w[(size_t)k * 6144];
    p.mod[idx] = acc + p.b_mod[l * 6144 + n];
  }
}

__device__ void ph_copy_in(const P& p) {
  const float4* xs = (const float4*)p.x;
  const float4* cs = (const float4*)p.ctx;
  float4* d = (float4*)p.xall;
  for (int i = GTID; i < TT * 256; i += GSZ) d[i] = (i < LC * 256) ? cs[i] : xs[i - LC * 256];
}

__device__ void ph_copy_out(const P& p) {
  const float4* s = (const float4*)(p.xall + (size_t)LC * 1024);
  float4* d = (float4*)p.out;
  for (int i = GTID; i < SEQ * 256; i += GSZ) d[i] = s[i];
}

__device__ void ph_norm_mod(const P& p, int l, int which_norm, int t0, float* smem) {
  const float* g = (which_norm ? p.norm2_g : p.norm1_g) + l * 1024;
  const int sh_off = which_norm ? 3072 : 0, sc_off = which_norm ? 4096 : 1024;
  const int tid = threadIdx.x;
  for (int t = t0 + blockIdx.x; t < TT; t += gridDim.x) {
    const float* mod = p.mod + (l * 2 + (t < LC ? 1 : 0)) * 6144;
    float4 v = ((const float4*)(p.xall + (size_t)t * 1024))[tid];
    float ss = wave_sum(v.x * v.x + v.y * v.y + v.z * v.z + v.w * v.w);
    __syncthreads();
    if ((tid & 63) == 0) smem[tid >> 6] = ss;
    __syncthreads();
    float tot = smem[0] + smem[1] + smem[2] + smem[3];
    float rinv = rsqrtf(tot * (1.f / 1024.f) + EPS);
    float4 gg = ((const float4*)g)[tid];
    float4 sc = ((const float4*)(mod + sc_off))[tid];
    float4 sh = ((const float4*)(mod + sh_off))[tid];
    float4 o;
    o.x = v.x * rinv * gg.x * (1.f + sc.x) + sh.x;
    o.y = v.y * rinv * gg.y * (1.f + sc.y) + sh.y;
    o.z = v.z * rinv * gg.z * (1.f + sc.z) + sh.z;
    o.w = v.w * rinv * gg.w * (1.f + sc.w) + sh.w;
    ((float4*)(p.h + (size_t)t * 1024))[tid] = o;
  }
}

template <int EPI>
__device__ void ph_gemm(const P& p, const float* A, int lda, const float* B, float* C, int m_begin, int M, int N, int K,
                        int l, int gofs, float* smem) {
  float(*As)[68] = (float(*)[68])smem;
  float(*Bs)[64] = (float(*)[64])(smem + 16 * 68);
  const int tid = threadIdx.x, ty = tid >> 4, tx = tid & 15;
  const int tiles_n = N / 64, tiles_m = (M - m_begin) / 64;
  for (int tile = blockIdx.x; tile < tiles_m * tiles_n; tile += gridDim.x) {
    const int m0 = m_begin + (tile / tiles_n) * 64, n0 = (tile % tiles_n) * 64;
    float acc[4][4];
#pragma unroll
    for (int i = 0; i < 4; ++i)
#pragma unroll
      for (int j = 0; j < 4; ++j) acc[i][j] = 0.f;
    for (int k0 = 0; k0 < K; k0 += 16) {
      {
        int row = tid >> 2, kq = (tid & 3) * 4;
        float4 a = *(const float4*)(A + (size_t)(m0 + row) * lda + k0 + kq);
        As[kq + 0][row] = a.x; As[kq + 1][row] = a.y; As[kq + 2][row] = a.z; As[kq + 3][row] = a.w;
        int kr = tid >> 4, n4 = (tid & 15) * 4;
        float4 b = *(const float4*)(B + (size_t)(k0 + kr) * N + n0 + n4);
        *(float4*)&Bs[kr][n4] = b;
      }
      __syncthreads();
#pragma unroll
      for (int kk = 0; kk < 16; ++kk) {
        float4 a = *(const float4*)&As[kk][ty * 4];
        float4 b = *(const float4*)&Bs[kk][tx * 4];
        float av[4] = {a.x, a.y, a.z, a.w}, bv[4] = {b.x, b.y, b.z, b.w};
#pragma unroll
        for (int i = 0; i < 4; ++i)
#pragma unroll
          for (int j = 0; j < 4; ++j) acc[i][j] += av[i] * bv[j];
      }
      __syncthreads();
    }
#pragma unroll
    for (int i = 0; i < 4; ++i) {
      int m = m0 + ty * 4 + i, n = n0 + tx * 4;
      if (EPI == 0) {
        *(float4*)(C + (size_t)m * N + n) = make_float4(acc[i][0], acc[i][1], acc[i][2], acc[i][3]);
      } else {
        const float* gt = p.mod + (l * 2 + (m < LC ? 1 : 0)) * 6144 + gofs + n;
        float4* xp = (float4*)(p.xall + (size_t)m * 1024 + n);
        float4 xv = *xp;
        xv.x += gt[0] * acc[i][0]; xv.y += gt[1] * acc[i][1]; xv.z += gt[2] * acc[i][2]; xv.w += gt[3] * acc[i][3];
        *xp = xv;
      }
    }
  }
}

__device__ void ph_qknorm_rope(const P& p, int l) {
  const int lane = threadIdx.x & 63;
  const int wpb = blockDim.x >> 6;
  for (int pair = blockIdx.x * wpb + (threadIdx.x >> 6); pair < TT * 20; pair += gridDim.x * wpb) {
    int t = pair / 20, slot = pair % 20;
    int off; const float* g; bool rope;
    if (slot < 6) { off = OFF_QW + slot * 64; g = p.win_qn + l * 64; rope = true; }
    else if (slot < 8) { off = OFF_KW + (slot - 6) * 64; g = p.win_kn + l * 64; rope = true; }
    else if (slot < 14) { off = OFF_QN + (slot - 8) * 64; g = p.na_qn + l * 64; rope = false; }
    else { off = OFF_KN + (slot - 14) * 64; g = p.na_kn + l * 64; rope = false; }
    rope = rope && (t >= LC);
    float* ptr = p.proj + (size_t)t * DIN + off + lane;
    float v = *ptr;
    float ss = wave_sum(v * v);
    float y = v * rsqrtf(ss * (1.f / 64.f) + EPS) * g[lane];
    float partner = __shfl_xor(y, 16);
    if (rope) {
      int pos = t - LC, row = pos >> 6, col = pos & 63;
      int j = lane & 15, axis = lane >> 5;
      float inv = __expf(-(float)j * (1.f / 16.f) * 9.210340371976184f);
      float ang = (float)(axis ? col : row) * inv;
      float k = rintf(ang * 0.15915494309189535f);
      float r = fmaf(-k, 6.2831854820251465f, ang);
      r = fmaf(-k, -1.7484555e-07f, r);
      float cs = __cosf(r), sn = __sinf(r);
      bool first = ((lane >> 4) & 1) == 0;
      y = first ? (y * cs - partner * sn) : (partner * sn + y * cs);
    }
    *ptr = y;
  }
}

__device__ void ph_lru_conv(const P& p, int l) {
  for (int idx = GTID; idx < TT * 256; idx += GSZ) {
    int t = idx >> 8, c = idx & 255;
    int lo = t < LC ? 0 : LC, hi = t < LC ? LC : TT;
    float acc = p.conv_b[l * 256 + c];
#pragma unroll
    for (int k = 0; k < 4; ++k) {
      int tt = t + k - 2;
      if (tt >= lo && tt < hi) acc += p.conv_w[(l * 4 + k) * 256 + c] * p.proj[(size_t)tt * DIN + OFF_XA + c];
    }
    p.ub[idx] = acc;
  }
}

__device__ void ph_lru_gates(const P& p, int l) {
  for (int idx = GTID; idx < 2 * TT * 256; idx += GSZ) {
    int c = idx & 255, t = (idx >> 8) % TT, dir = idx / (TT * 256);
    int blk = c >> 6, e = c & 63;
    int pd = l * 2 + dir;
    float ra = p.ba[pd * 256 + c], rx = p.bx[pd * 256 + c];
    const float* wa = p.wa + ((size_t)(pd * 4 + blk) * 64) * 64 + e;
    const float* wx = p.wx + ((size_t)(pd * 4 + blk) * 64) * 64 + e;
    const float* u = p.ub + (size_t)t * 256 + blk * 64;
    for (int d = 0; d < 64; ++d) {
      float uu = u[d];
      ra += uu * wa[d * 64];
      rx += uu * wx[d * 64];
    }
    float r = sigmoid_f(ra), ig = sigmoid_f(rx);
    float sp = log1pf(expf(-p.lam[pd * 256 + c]));
    float log_a = -8.f * r * sp;
    float a = expf(log_a);
    float b = sqrtf(-expm1f(2.f * log_a)) * ig * p.ub[(size_t)t * 256 + c];
    p.la[idx] = a;
    p.lb[idx] = b;
  }
}

__device__ void ph_lru_scan(const P& p) {
  for (int idx = GTID; idx < 512; idx += GSZ) {
    int c = idx & 255, dir = idx >> 8;
    const float* a = p.la + (size_t)dir * TT * 256 + c;
    const float* b = p.lb + (size_t)dir * TT * 256 + c;
    float* hs = p.hs + (size_t)dir * TT * 256 + c;
    float h = 0.f;
    if (dir == 0) {
      for (int t = 0; t < TT; ++t) { h = a[(size_t)t * 256] * h + b[(size_t)t * 256]; hs[(size_t)t * 256] = h; }
    } else {
      for (int t = LC - 1; t >= 0; --t) { h = a[(size_t)t * 256] * h + b[(size_t)t * 256]; hs[(size_t)t * 256] = h; }
      for (int t = TT - 1; t >= LC; --t) { h = a[(size_t)t * 256] * h + b[(size_t)t * 256]; hs[(size_t)t * 256] = h; }
    }
  }
}

__device__ void ph_lru_out(const P& p) {
  for (int idx = GTID; idx < TT * 256; idx += GSZ) {
    int t = idx >> 8, c = idx & 255;
    float hsum = p.hs[idx] + p.hs[(size_t)TT * 256 + idx];
    p.mix[(size_t)t * 1024 + c] = hsum * gelu_f(p.proj[(size_t)t * DIN + OFF_GA + c]);
  }
}

#define ATTN_STEP(KP, VP, BIAS)                                          \
  {                                                                      \
    float s = 0.f;                                                       \
    _Pragma("unroll") for (int d4 = 0; d4 < 16; ++d4) {                  \
      float4 kk = ((const float4*)(KP))[d4];                             \
      s += q[d4 * 4] * kk.x + q[d4 * 4 + 1] * kk.y + q[d4 * 4 + 2] * kk.z + q[d4 * 4 + 3] * kk.w; \
    }                                                                    \
    s = s * 0.125f + (BIAS);                                             \
    float mn = fmaxf(m, s);                                              \
    float sc = __expf(m - mn), pp = __expf(s - mn);                      \
    m = mn;                                                              \
    lsum = lsum * sc + pp;                                               \
    _Pragma("unroll") for (int d4 = 0; d4 < 16; ++d4) {                  \
      float4 vv = ((const float4*)(VP))[d4];                             \
      acc[d4 * 4] = acc[d4 * 4] * sc + pp * vv.x;                        \
      acc[d4 * 4 + 1] = acc[d4 * 4 + 1] * sc + pp * vv.y;                \
      acc[d4 * 4 + 2] = acc[d4 * 4 + 2] * sc + pp * vv.z;                \
      acc[d4 * 4 + 3] = acc[d4 * 4 + 3] * sc + pp * vv.w;                \
    }                                                                    \
  }

__device__ void ph_win_attn(const P& p, int l) {
  for (int idx = GTID; idx < SEQ * 6; idx += GSZ) {
    int h = idx % 6, i = idx / 6, g = h / 3;
    float q[64], acc[64];
    const float* qp = p.proj + (size_t)(LC + i) * DIN + OFF_QW + h * 64;
#pragma unroll
    for (int d4 = 0; d4 < 16; ++d4) {
      float4 v = ((const float4*)qp)[d4];
      q[d4 * 4] = v.x; q[d4 * 4 + 1] = v.y; q[d4 * 4 + 2] = v.z; q[d4 * 4 + 3] = v.w;
    }
#pragma unroll
    for (int d = 0; d < 64; ++d) acc[d] = 0.f;
    float m = p.win_sink[l * 6 + h], lsum = 1.f;
    int lo = max(0, i - 128), hi = min(SEQ - 1, i + 128);
    for (int j = lo; j <= hi; ++j) {
      const float* kp = p.proj + (size_t)(LC + j) * DIN + OFF_KW + g * 64;
      const float* vp = p.proj + (size_t)(LC + j) * DIN + OFF_VW + g * 64;
      ATTN_STEP(kp, vp, 0.f)
    }
    for (int j = 0; j < LC; ++j) {
      const float* kp = p.proj + (size_t)j * DIN + OFF_KW + g * 64;
      const float* vp = p.proj + (size_t)j * DIN + OFF_VW + g * 64;
      ATTN_STEP(kp, vp, 0.f)
    }
    float inv = 1.f / lsum;
    float* op = p.mix + (size_t)(LC + i) * 1024 + 256 + h * 64;
#pragma unroll
    for (int d4 = 0; d4 < 16; ++d4)
      ((float4*)op)[d4] = make_float4(acc[d4 * 4] * inv, acc[d4 * 4 + 1] * inv, acc[d4 * 4 + 2] * inv, acc[d4 * 4 + 3] * inv);
  }
}

__device__ void ph_na_attn(const P& p, int l) {
  for (int idx = GTID; idx < SEQ * 6; idx += GSZ) {
    int h = idx % 6, i = idx / 6;
    int r = i >> 6, c = i & 63;
    int kr0 = min(max(r - 4, 0), 248), qs = min(max(c - 8, 0), 48);
    float q[64], acc[64];
    const float* qp = p.proj + (size_t)(LC + i) * DIN + OFF_QN + h * 64;
#pragma unroll
    for (int d4 = 0; d4 < 16; ++d4) {
      float4 v = ((const float4*)qp)[d4];
      q[d4 * 4] = v.x; q[d4 * 4 + 1] = v.y; q[d4 * 4 + 2] = v.z; q[d4 * 4 + 3] = v.w;
    }
#pragma unroll
    for (int d = 0; d < 64; ++d) acc[d] = 0.f;
    float m = -1e30f, lsum = 0.f;
    const float* rpb = p.rpb + (size_t)(l * 6 + h) * 15 * 31;
    for (int a = 0; a < 8; ++a) {
      int krow = kr0 + a;
      for (int b = 0; b < 16; ++b) {
        int kcol = qs + b;
        int j = krow * 64 + kcol;
        float bias = rpb[(krow - r + 7) * 31 + (kcol - c + 15)];
        const float* kp = p.proj + (size_t)(LC + j) * DIN + OFF_KN + h * 64;
        const float* vp = p.proj + (size_t)(LC + j) * DIN + OFF_VN + h * 64;
        ATTN_STEP(kp, vp, bias)
      }
    }
    for (int j = 0; j < LC; ++j) {
      const float* kp = p.proj + (size_t)j * DIN + OFF_KN + h * 64;
      const float* vp = p.proj + (size_t)j * DIN + OFF_VN + h * 64;
      ATTN_STEP(kp, vp, 0.f)
    }
    float inv = 1.f / lsum;
    float* op = p.mix + (size_t)(LC + i) * 1024 + 640 + h * 64;
#pragma unroll
    for (int d4 = 0; d4 < 16; ++d4)
      ((float4*)op)[d4] = make_float4(acc[d4 * 4] * inv, acc[d4 * 4 + 1] * inv, acc[d4 * 4 + 2] * inv, acc[d4 * 4 + 3] * inv);
  }
}

__device__ void ph_ctx_attn(const P& p, int l) {
  for (int idx = GTID; idx < LC * 12; idx += GSZ) {
    int slot = idx % 12, i = idx / 12;
    int qoff, koff, voff, ooff;
    float m, lsum;
    if (slot < 6) {
      int h = slot, g = h / 3;
      qoff = OFF_QW + h * 64; koff = OFF_KW + g * 64; voff = OFF_VW + g * 64; ooff = 256 + h * 64;
      m = p.win_sink[l * 6 + h]; lsum = 1.f;
    } else {
      int h = slot - 6;
      qoff = OFF_QN + h * 64; koff = OFF_KN + h * 64; voff = OFF_VN + h * 64; ooff = 640 + h * 64;
      m = -1e30f; lsum = 0.f;
    }
    float q[64], acc[64];
    const float* qp = p.proj + (size_t)i * DIN + qoff;
#pragma unroll
    for (int d4 = 0; d4 < 16; ++d4) {
      float4 v = ((const float4*)qp)[d4];
      q[d4 * 4] = v.x; q[d4 * 4 + 1] = v.y; q[d4 * 4 + 2] = v.z; q[d4 * 4 + 3] = v.w;
    }
#pragma unroll
    for (int d = 0; d < 64; ++d) acc[d] = 0.f;
    for (int j = 0; j < LC; ++j) {
      const float* kp = p.proj + (size_t)j * DIN + koff;
      const float* vp = p.proj + (size_t)j * DIN + voff;
      ATTN_STEP(kp, vp, 0.f)
    }
    float inv = 1.f / lsum;
    float* op = p.mix + (size_t)i * 1024 + ooff;
#pragma unroll
    for (int d4 = 0; d4 < 16; ++d4)
      ((float4*)op)[d4] = make_float4(acc[d4 * 4] * inv, acc[d4 * 4 + 1] * inv, acc[d4 * 4 + 2] * inv, acc[d4 * 4 + 3] * inv);
  }
}

__device__ void ph_peer_topk(const P& p, int l, int t0, float* smem) {
  float* sq = smem;
  float* ss = smem + 256;
  float* tv = smem + 512;
  int* ti = (int*)(smem + 544);
  float* cv = smem + 576;
  int* ci = (int*)(smem + 832);
  float* bv = smem + 1088;
  int* bi = (int*)(smem + 1104);
  const int tid = threadIdx.x;
  const int nitems = (TT - t0) * 8;
  for (int item = blockIdx.x; item < nitems; item += gridDim.x) {
    int t = t0 + item / 8, hd = item % 8;
    __syncthreads();
    sq[tid] = p.proj[(size_t)t * NPQ + hd * 256 + tid];
    __syncthreads();
    {
      int half = tid >> 7, n = tid & 127;
      const float* kk = (half ? p.k2 : p.k1) + (size_t)l * 128 * 128 + n * 128;
      const float* qq = sq + half * 128;
      float s = 0.f;
      for (int d = 0; d < 128; ++d) s += qq[d] * kk[d];
      ss[tid] = s;
    }
    __syncthreads();
    {
      int half = tid >> 7, n = tid & 127;
      float mine = ss[tid];
      const float* base = ss + half * 128;
      int rank = 0;
      for (int mI = 0; mI < 128; ++mI) {
        float o = base[mI];
        rank += (o > mine) || (o == mine && mI < n);
      }
      if (rank < 16) { tv[half * 16 + rank] = mine; ti[half * 16 + rank] = n; }
    }
    __syncthreads();
    {
      int a = tid >> 4, b = tid & 15;
      cv[tid] = tv[a] + tv[16 + b];
      ci[tid] = ti[a] * 128 + ti[16 + b];
    }
    __syncthreads();
    {
      float mine = cv[tid];
      int rank = 0;
      for (int mI = 0; mI < 256; ++mI) {
        float o = cv[mI];
        rank += (o > mine) || (o == mine && mI < tid);
      }
      if (rank < 16) { bv[rank] = mine; bi[rank] = ci[tid]; }
    }
    __syncthreads();
    if (tid < 16) {
      float mx = bv[0], sum = 0.f;
      for (int r = 0; r < 16; ++r) sum += __expf(bv[r] - mx);
      p.gate[(size_t)t * 128 + hd * 16 + tid] = __expf(bv[tid] - mx) / sum;
      p.eidx[(size_t)t * 128 + hd * 16 + tid] = bi[tid];
    }
  }
}

__device__ void ph_peer_apply(const P& p, int l, int t0, float* smem) {
  const int tid = threadIdx.x, lane = tid & 63, w = tid >> 6;
  const float* U = p.pu + (size_t)l * 16384 * 1024;
  const float* V = p.pv + (size_t)l * 16384 * 1024;
  for (int t = t0 + blockIdx.x; t < TT; t += gridDim.x) {
    float4 hv[4], acc[4];
#pragma unroll
    for (int i = 0; i < 4; ++i) {
      hv[i] = ((const float4*)(p.h + (size_t)t * 1024))[i * 64 + lane];
      acc[i] = make_float4(0.f, 0.f, 0.f, 0.f);
    }
    for (int e = w; e < 128; e += 4) {
      int ex = p.eidx[(size_t)t * 128 + e];
      float gt = p.gate[(size_t)t * 128 + e];
      const float4* ur = (const float4*)(U + (size_t)ex * 1024);
      const float4* vr = (const float4*)(V + (size_t)ex * 1024);
      float dot = 0.f;
#pragma unroll
      for (int i = 0; i < 4; ++i) {
        float4 uu = ur[i * 64 + lane];
        dot += uu.x * hv[i].x + uu.y * hv[i].y + uu.z * hv[i].z + uu.w * hv[i].w;
      }
      dot = wave_sum(dot);
      float a = gt * gelu_f(dot);
#pragma unroll
      for (int i = 0; i < 4; ++i) {
        float4 vv = vr[i * 64 + lane];
        acc[i].x += a * vv.x; acc[i].y += a * vv.y; acc[i].z += a * vv.z; acc[i].w += a * vv.w;
      }
    }
    __syncthreads();
#pragma unroll
    for (int i = 0; i < 4; ++i) ((float4*)(smem + w * 1024))[i * 64 + lane] = acc[i];
    __syncthreads();
    {
      float4 s0 = ((float4*)smem)[tid], s1 = ((float4*)(smem + 1024))[tid], s2 = ((float4*)(smem + 2048))[tid], s3 = ((float4*)(smem + 3072))[tid];
      const float* g2 = p.mod + (l * 2 + (t < LC ? 1 : 0)) * 6144 + 5120;
      float4 gg = ((const float4*)g2)[tid];
      float4* xp = (float4*)(p.xall + (size_t)t * 1024) + tid;
      float4 xv = *xp;
      xv.x += gg.x * (s0.x + s1.x + s2.x + s3.x);
      xv.y += gg.y * (s0.y + s1.y + s2.y + s3.y);
      xv.z += gg.z * (s0.z + s1.z + s2.z + s3.z);
      xv.w += gg.w * (s0.w + s1.w + s2.w + s3.w);
      *xp = xv;
    }
  }
}

constexpr int N_PH_PRE = 2;
constexpr int N_PH_LAYER = 15;
constexpr int N_PHASES = N_PH_PRE + 2 * N_PH_LAYER + 1;

__device__ __forceinline__ void run_phase(const P& p, int ph, float* smem) {
  if (ph == 0) { ph_mod(p); return; }
  if (ph == 1) { ph_copy_in(p); return; }
  if (ph == N_PHASES - 1) { ph_copy_out(p); return; }
  int l = (ph - N_PH_PRE) / N_PH_LAYER, s = (ph - N_PH_PRE) % N_PH_LAYER;
  int t0 = (l == 0) ? 0 : LC;
  switch (s) {
    case 0: ph_norm_mod(p, l, 0, 0, smem); break;
    case 1: ph_gemm<0>(p, p.h, 1024, p.w_in + (size_t)l * 1024 * DIN, p.proj, 0, TT, DIN, 1024, l, 0, smem); break;
    case 2: ph_qknorm_rope(p, l); break;
    case 3: ph_lru_conv(p, l); break;
    case 4: ph_lru_gates(p, l); break;
    case 5: ph_lru_scan(p); break;
    case 6: ph_lru_out(p); break;
    case 7: ph_win_attn(p, l); break;
    case 8: ph_na_attn(p, l); break;
    case 9: if (l == 0) ph_ctx_attn(p, l); break;
    case 10: ph_gemm<1>(p, p.mix, 1024, p.w_out + (size_t)l * 1024 * 1024, nullptr, t0, TT, 1024, 1024, l, 2048, smem); break;
    case 11: ph_norm_mod(p, l, 1, t0, smem); break;
    case 12: ph_gemm<0>(p, p.h, 1024, p.wq + (size_t)l * 1024 * NPQ, p.proj, t0, TT, NPQ, 1024, l, 0, smem); break;
    case 13: ph_peer_topk(p, l, t0, smem); break;
    case 14: ph_peer_apply(p, l, t0, smem); break;
  }
}

__global__ void __launch_bounds__(256) k_phase(P p, int ph) {
  __shared__ __attribute__((aligned(16))) float smem[4096];
  run_phase(p, ph, smem);
}

__global__ void __launch_bounds__(256) k_mega(P p) {
  __shared__ __attribute__((aligned(16))) float smem[4096];
  cg::grid_group grid = cg::this_grid();
  for (int ph = 0; ph < N_PHASES; ++ph) {
    run_phase(p, ph, smem);
    if (ph + 1 < N_PHASES) grid.sync();
  }
}

extern "C" void kernel_launch(void* const* d_in, const int* in_sizes, int n_in, void* d_out, int out_size, void* d_ws,
                              size_t ws_size, hipStream_t stream) {
  P p{};
  const float** fp = (const float**)&p;
  for (int i = 0; i < 28; ++i) fp[i] = (const float*)d_in[i];
  p.out = (float*)d_out;
  float* w = (float*)d_ws;
  size_t o = 0;
  auto carve = [&](size_t n) { float* r = w + o; o += (n + 63) & ~(size_t)63; return r; };
  p.mod = carve(4 * 6144);
  p.xall = carve((size_t)TT * 1024);
  p.h = carve((size_t)TT * 1024);
  p.proj = carve((size_t)TT * DIN);
  p.mix = carve((size_t)TT * 1024);
  p.ub = carve((size_t)TT * 256);
  p.la = carve((size_t)2 * TT * 256);
  p.lb = carve((size_t)2 * TT * 256);
  p.hs = carve((size_t)2 * TT * 256);
  p.gate = carve((size_t)TT * 128);
  p.eidx = (int*)carve((size_t)TT * 128);
  if (o * 4 > ws_size) { fprintf(stderr, "workspace too small: need %zu have %zu\n", o * 4, ws_size); return; }
#if SINGLE_LAUNCH
  static int grid_blocks = 0;
  if (!grid_blocks) {
    int dev = 0, cus = 0, per_cu = 0;
    hipGetDevice(&dev);
    hipDeviceGetAttribute(&cus, hipDeviceAttributeMultiprocessorCount, dev);
    hipOccupancyMaxActiveBlocksPerMultiprocessor(&per_cu, k_mega, 256, 0);
    if (per_cu > 2) per_cu = 2;
    grid_blocks = cus * per_cu;
  }
  void* args[] = {&p};
  hipError_t e = hipLaunchCooperativeKernel((void*)k_mega, dim3(grid_blocks), dim3(256), args, 0, stream);
  if (e != hipSuccess) fprintf(stderr, "cooperative launch failed: %s (grid %d)\n", hipGetErrorString(e), grid_blocks);
#else
  for (int ph = 0; ph < N_PHASES; ++ph) {
    if ((ph - N_PH_PRE) % N_PH_LAYER == 9 && ph >= N_PH_PRE + N_PH_LAYER && ph != N_PHASES - 1) continue;
    k_phase<<<2048, 256, 0, stream>>>(p, ph);
  }
#endif
}
```

```cpp
#include <hip/hip_runtime.h>
#include <hip/hip_cooperative_groups.h>
#include <stdint.h>
#include <stdio.h>
namespace cg = cooperative_groups;

#ifndef SINGLE_LAUNCH
#define SINGLE_LAUNCH 1
#endif

constexpr int DM = 1024, SEQ = 16384, LC = 256, TT = SEQ + LC, DIN = 2304, NPQ = 2048;
constexpr int OFF_XA = 0, OFF_GA = 256, OFF_QW = 512, OFF_KW = 896, OFF_VW = 1024, OFF_QN = 1152, OFF_KN = 1536, OFF_VN = 1920;
constexpr float EPS = 1e-6f;

struct P {
  const float *x, *c, *ctx, *c_ctx, *w_mod, *b_mod, *norm1_g, *norm2_g, *w_in, *w_out,
      *conv_w, *conv_b, *wa, *ba, *wx, *bx, *lam, *win_qn, *win_kn, *win_sink, *na_qn, *na_kn, *rpb,
      *wq, *k1, *k2, *pu, *pv;
  float* out;
  float *mod, *xall, *h, *proj, *mix, *ub, *la, *lb, *hs, *gate;
  int* eidx;
};

__device__ __forceinline__ float silu_f(float x) { return x / (1.f + __expf(-x)); }
__device__ __forceinline__ float sigmoid_f(float x) { return 1.f / (1.f + __expf(-x)); }
__device__ __forceinline__ float gelu_f(float x) {
  float u = 0.7978845608028654f * (x + 0.044715f * x * x * x);
  float e = __expf(2.f * u);
  float th = 1.f - 2.f / (e + 1.f);
  return 0.5f * x * (1.f + th);
}
__device__ __forceinline__ float wave_sum(float v) {
#pragma unroll
  for (int o = 32; o > 0; o >>= 1) v += __shfl_xor(v, o);
  return v;
}

#define GTID (blockIdx.x * blockDim.x + threadIdx.x)
#define GSZ (gridDim.x * blockDim.x)

__device__ void ph_mod(const P& p) {
  for (int idx = GTID; idx < 4 * 6144; idx += GSZ) {
    int n = idx % 6144, lw = idx / 6144, l = lw >> 1, which = lw & 1;
    const float* vec = which ? p.c_ctx : p.c;
    const float* w = p.w_mod + (size_t)l * 1024 * 6144 + n;
    float acc = 0.f;
    for (int k = 0; k < 1024; ++k) acc += silu_f(vec[k]) * w[(size_t)k * 6144];
    p.mod[idx] = acc + p.b_mod[l * 6144 + n];
  }
}

__device__ void ph_copy_in(const P& p) {
  const float4* xs = (const float4*)p.x;
  const float4* cs = (const float4*)p.ctx;
  float4* d = (float4*)p.xall;
  for (int i = GTID; i < TT * 256; i += GSZ) d[i] = (i < LC * 256) ? cs[i] : xs[i - LC * 256];
}

__device__ void ph_copy_out(const P& p) {
  const float4* s = (const float4*)(p.xall + (size_t)LC * 1024);
  float4* d = (float4*)p.out;
  for (int i = GTID; i < SEQ * 256; i += GSZ) d[i] = s[i];
}

__device__ void ph_norm_mod(const P& p, int l, int which_norm, int t0, float* smem) {
  const float* g = (which_norm ? p.norm2_g : p.norm1_g) + l * 1024;
  const int sh_off = which_norm ? 3072 : 0, sc_off = which_norm ? 4096 : 1024;
  const int tid = threadIdx.x;
  for (int t = t0 + blockIdx.x; t < TT; t += gridDim.x) {
    const float* mod = p.mod + (l * 2 + (t < LC ? 1 : 0)) * 6144;
    float4 v = ((const float4*)(p.xall + (size_t)t * 1024))[tid];
    float ss = wave_sum(v.x * v.x + v.y * v.y + v.z * v.z + v.w * v.w);
    __syncthreads();
    if ((tid & 63) == 0) smem[tid >> 6] = ss;
    __syncthreads();
    float tot = smem[0] + smem[1] + smem[2] + smem[3];
    float rinv = rsqrtf(tot * (1.f / 1024.f) + EPS);
    float4 gg = ((const float4*)g)[tid];
    float4 sc = ((const float4*)(mod + sc_off))[tid];
    float4 sh = ((const float4*)(mod + sh_off))[tid];
    float4 o;
    o.x = v.x * rinv * gg.x * (1.f + sc.x) + sh.x;
    o.y = v.y * rinv * gg.y * (1.f + sc.y) + sh.y;
    o.z = v.z * rinv * gg.z * (1.f + sc.z) + sh.z;
    o.w = v.w * rinv * gg.w * (1.f + sc.w) + sh.w;
    ((float4*)(p.h + (size_t)t * 1024))[tid] = o;
  }
}

template <int EPI>
__device__ void ph_gemm(const P& p, const float* A, int lda, const float* B, float* C, int m_begin, int M, int N, int K,
                        int l, int gofs, float* smem) {
  float(*As)[68] = (float(*)[68])smem;
  float(*Bs)[64] = (float(*)[64])(smem + 16 * 68);
  const int tid = threadIdx.x, ty = tid >> 4, tx = tid & 15;
  const int tiles_n = N / 64, tiles_m = (M - m_begin) / 64;
  for (int tile = blockIdx.x; tile < tiles_m * tiles_n; tile += gridDim.x) {
    const int m0 = m_begin + (tile / tiles_n) * 64, n0 = (tile % tiles_n) * 64;
    float acc[4][4];
#pragma unroll
    for (int i = 0; i < 4; ++i)
#pragma unroll
      for (int j = 0; j < 4; ++j) acc[i][j] = 0.f;
    for (int k0 = 0; k0 < K; k0 += 16) {
      {
        int row = tid >> 2, kq = (tid & 3) * 4;
        float4 a = *(const float4*)(A + (size_t)(m0 + row) * lda + k0 + kq);
        As[kq + 0][row] = a.x; As[kq + 1][row] = a.y; As[kq + 2][row] = a.z; As[kq + 3][row] = a.w;
        int kr = tid >> 4, n4 = (tid & 15) * 4;
        float4 b = *(const float4*)(B + (size_t)(k0 + kr) * N + n0 + n4);
        *(float4*)&Bs[kr][n4] = b;
      }
      __syncthreads();
#pragma unroll
      for (int kk = 0; kk < 16; ++kk) {
        float4 a = *(const float4*)&As[kk][ty * 4];
        float4 b = *(const float4*)&Bs[kk][tx * 4];
        float av[4] = {a.x, a.y, a.z, a.w}, bv[4] = {b.x, b.y, b.z, b.w};
#pragma unroll
        for (int i = 0; i < 4; ++i)
#pragma unroll
          for (int j = 0; j < 4; ++j) acc[i][j] += av[i] * bv[j];
      }
      __syncthreads();
    }
#pragma unroll
    for (int i = 0; i < 4; ++i) {
      int m = m0 + ty * 4 + i, n = n0 + tx * 4;
      if (EPI == 0) {
        *(float4*)(C + (size_t)m * N + n) = make_float4(acc[i][0], acc[i][1], acc[i][2], acc[i][3]);
      } else {
        const float* gt = p.mod + (l * 2 + (m < LC ? 1 : 0)) * 6144 + gofs + n;
        float4* xp = (float4*)(p.xall + (size_t)m * 1024 + n);
        float4 xv = *xp;
        xv.x += gt[0] * acc[i][0]; xv.y += gt[1] * acc[i][1]; xv.z += gt[2] * acc[i][2]; xv.w += gt[3] * acc[i][3];
        *xp = xv;
      }
    }
  }
}

__device__ void ph_qknorm_rope(const P& p, int l) {
  const int lane = threadIdx.x & 63;
  const int wpb = blockDim.x >> 6;
  for (int pair = blockIdx.x * wpb + (threadIdx.x >> 6); pair < TT * 20; pair += gridDim.x * wpb) {
    int t = pair / 20, slot = pair % 20;
    int off; const float* g; bool rope;
    if (slot < 6) { off = OFF_QW + slot * 64; g = p.win_qn + l * 64; rope = true; }
    else if (slot < 8) { off = OFF_KW + (slot - 6) * 64; g = p.win_kn + l * 64; rope = true; }
    else if (slot < 14) { off = OFF_QN + (slot - 8) * 64; g = p.na_qn + l * 64; rope = false; }
    else { off = OFF_KN + (slot - 14) * 64; g = p.na_kn + l * 64; rope = false; }
    rope = rope && (t >= LC);
    float* ptr = p.proj + (size_t)t * DIN + off + lane;
    float v = *ptr;
    float ss = wave_sum(v * v);
    float y = v * rsqrtf(ss * (1.f / 64.f) + EPS) * g[lane];
    float partner = __shfl_xor(y, 16);
    if (rope) {
      int pos = t - LC, row = pos >> 6, col = pos & 63;
      int j = lane & 15, axis = lane >> 5;
      float inv = __expf(-(float)j * (1.f / 16.f) * 9.210340371976184f);
      float ang = (float)(axis ? col : row) * inv;
      float k = rintf(ang * 0.15915494309189535f);
      float r = fmaf(-k, 6.2831854820251465f, ang);
      r = fmaf(-k, -1.7484555e-07f, r);
      float cs = __cosf(r), sn = __sinf(r);
      bool first = ((lane >> 4) & 1) == 0;
      y = first ? (y * cs - partner * sn) : (partner * sn + y * cs);
    }
    *ptr = y;
  }
}

__device__ void ph_lru_conv(const P& p, int l) {
  for (int idx = GTID; idx < TT * 256; idx += GSZ) {
    int t = idx >> 8, c = idx & 255;
    int lo = t < LC ? 0 : LC, hi = t < LC ? LC : TT;
    float acc = p.conv_b[l * 256 + c];
#pragma unroll
    for (int k = 0; k < 4; ++k) {
      int tt = t + k - 2;
      if (tt >= lo && tt < hi) acc += p.conv_w[(l * 4 + k) * 256 + c] * p.proj[(size_t)tt * DIN + OFF_XA + c];
    }
    p.ub[idx] = acc;
  }
}

__device__ void ph_lru_gates(const P& p, int l) {
  for (int idx = GTID; idx < 2 * TT * 256; idx += GSZ) {
    int c = idx & 255, t = (idx >> 8) % TT, dir = idx / (TT * 256);
    int blk = c >> 6, e = c & 63;
    int pd = l * 2 + dir;
    float ra = p.ba[pd * 256 + c], rx = p.bx[pd * 256 + c];
    const float* wa = p.wa + ((size_t)(pd * 4 + blk) * 64) * 64 + e;
    const float* wx = p.wx + ((size_t)(pd * 4 + blk) * 64) * 64 + e;
    const float* u = p.ub + (size_t)t * 256 + blk * 64;
    for (int d = 0; d < 64; ++d) {
      float uu = u[d];
      ra += uu * wa[d * 64];
      rx += uu * wx[d * 64];
    }
    float r = sigmoid_f(ra), ig = sigmoid_f(rx);
    float sp = log1pf(expf(-p.lam[pd * 256 + c]));
    float log_a = -8.f * r * sp;
    float a = expf(log_a);
    float b = sqrtf(-expm1f(2.f * log_a)) * ig * p.ub[(size_t)t * 256 + c];
    p.la[idx] = a;
    p.lb[idx] = b;
  }
}

__device__ void ph_lru_scan(const P& p) {
  for (int idx = GTID; idx < 512; idx += GSZ) {
    int c = idx & 255, dir = idx >> 8;
    const float* a = p.la + (size_t)dir * TT * 256 + c;
    const float* b = p.lb + (size_t)dir * TT * 256 + c;
    float* hs = p.hs + (size_t)dir * TT * 256 + c;
    float h = 0.f;
    if (dir == 0) {
      for (int t = 0; t < TT; ++t) { h = a[(size_t)t * 256] * h + b[(size_t)t * 256]; hs[(size_t)t * 256] = h; }
    } else {
      for (int t = LC - 1; t >= 0; --t) { h = a[(size_t)t * 256] * h + b[(size_t)t * 256]; hs[(size_t)t * 256] = h; }
      for (int t = TT - 1; t >= LC; --t) { h = a[(size_t)t * 256] * h + b[(size_t)t * 256]; hs[(size_t)t * 256] = h; }
    }
  }
}

__device__ void ph_lru_out(const P& p) {
  for (int idx = GTID; idx < TT * 256; idx += GSZ) {
    int t = idx >> 8, c = idx & 255;
    float hsum = p.hs[idx] + p.hs[(size_t)TT * 256 + idx];
    p.mix[(size_t)t * 1024 + c] = hsum * gelu_f(p.proj[(size_t)t * DIN + OFF_GA + c]);
  }
}

#define ATTN_STEP(KP, VP, BIAS)                                          \
  {                                                                      \
    float s = 0.f;                                                       \
    _Pragma("unroll") for (int d4 = 0; d4 < 16; ++d4) {                  \
      float4 kk = ((const float4*)(KP))[d4];                             \
      s += q[d4 * 4] * kk.x + q[d4 * 4 + 1] * kk.y + q[d4 * 4 + 2] * kk.z + q[d4 * 4 + 3] * kk.w; \
    }                                                                    \
    s = s * 0.125f + (BIAS);                                             \
    float mn = fmaxf(m, s);                                              \
    float sc = __expf(m - mn), pp = __expf(s - mn);                      \
    m = mn;                                                              \
    lsum = lsum * sc + pp;                                               \
    _Pragma("unroll") for (int d4 = 0; d4 < 16; ++d4) {                  \
      float4 vv = ((const float4*)(VP))[d4];                             \
      acc[d4 * 4] = acc[d4 * 4] * sc + pp * vv.x;                        \
      acc[d4 * 4 + 1] = acc[d4 * 4 + 1] * sc + pp * vv.y;                \
      acc[d4 * 4 + 2] = acc[d4 * 4 + 2] * sc + pp * vv.z;                \
      acc[d4 * 4 + 3] = acc[d4 * 4 + 3] * sc + pp * vv.w;                \
    }                                                                    \
  }

__device__ void ph_win_attn(const P& p, int l) {
  for (int idx = GTID; idx < SEQ * 6; idx += GSZ) {
    int h = idx % 6, i = idx / 6, g = h / 3;
    float q[64], acc[64];
    const float* qp = p.proj + (size_t)(LC + i) * DIN + OFF_QW + h * 64;
#pragma unroll
    for (int d4 = 0; d4 < 16; ++d4) {
      float4 v = ((const float4*)qp)[d4];
      q[d4 * 4] = v.x; q[d4 * 4 + 1] = v.y; q[d4 * 4 + 2] = v.z; q[d4 * 4 + 3] = v.w;
    }
#pragma unroll
    for (int d = 0; d < 64; ++d) acc[d] = 0.f;
    float m = p.win_sink[l * 6 + h], lsum = 1.f;
    int lo = max(0, i - 128), hi = min(SEQ - 1, i + 128);
    for (int j = lo; j <= hi; ++j) {
      const float* kp = p.proj + (size_t)(LC + j) * DIN + OFF_KW + g * 64;
      const float* vp = p.proj + (size_t)(LC + j) * DIN + OFF_VW + g * 64;
      ATTN_STEP(kp, vp, 0.f)
    }
    for (int j = 0; j < LC; ++j) {
      const float* kp = p.proj + (size_t)j * DIN + OFF_KW + g * 64;
      const float* vp = p.proj + (size_t)j * DIN + OFF_VW + g * 64;
      ATTN_STEP(kp, vp, 0.f)
    }
    float inv = 1.f / lsum;
    float* op = p.mix + (size_t)(LC + i) * 1024 + 256 + h * 64;
#pragma unroll
    for (int d4 = 0; d4 < 16; ++d4)
      ((float4*)op)[d4] = make_float4(acc[d4 * 4] * inv, acc[d4 * 4 + 1] * inv, acc[d4 * 4 + 2] * inv, acc[d4 * 4 + 3] * inv);
  }
}

__device__ void ph_na_attn(const P& p, int l) {
  for (int idx = GTID; idx < SEQ * 6; idx += GSZ) {
    int h = idx % 6, i = idx / 6;
    int r = i >> 6, c = i & 63;
    int kr0 = min(max(r - 4, 0), 248), qs = min(max(c - 8, 0), 48);
    float q[64], acc[64];
    const float* qp = p.proj + (size_t)(LC + i) * DIN + OFF_QN + h * 64;
#pragma unroll
    for (int d4 = 0; d4 < 16; ++d4) {
      float4 v = ((const float4*)qp)[d4];
      q[d4 * 4] = v.x; q[d4 * 4 + 1] = v.y; q[d4 * 4 + 2] = v.z; q[d4 * 4 + 3] = v.w;
    }
#pragma unroll
    for (int d = 0; d < 64; ++d) acc[d] = 0.f;
    float m = -1e30f, lsum = 0.f;
    const float* rpb = p.rpb + (size_t)(l * 6 + h) * 15 * 31;
    for (int a = 0; a < 8; ++a) {
      int krow = kr0 + a;
      for (int b = 0; b < 16; ++b) {
        int kcol = qs + b;
        int j = krow * 64 + kcol;
        float bias = rpb[(krow - r + 7) * 31 + (kcol - c + 15)];
        const float* kp = p.proj + (size_t)(LC + j) * DIN + OFF_KN + h * 64;
        const float* vp = p.proj + (size_t)(LC + j) * DIN + OFF_VN + h * 64;
        ATTN_STEP(kp, vp, bias)
      }
    }
    for (int j = 0; j < LC; ++j) {
      const float* kp = p.proj + (size_t)j * DIN + OFF_KN + h * 64;
      const float* vp = p.proj + (size_t)j * DIN + OFF_VN + h * 64;
      ATTN_STEP(kp, vp, 0.f)
    }
    float inv = 1.f / lsum;
    float* op = p.mix + (size_t)(LC + i) * 1024 + 640 + h * 64;
#pragma unroll
    for (int d4 = 0; d4 < 16; ++d4)
      ((float4*)op)[d4] = make_float4(acc[d4 * 4] * inv, acc[d4 * 4 + 1] * inv, acc[d4 * 4 + 2] * inv, acc[d4 * 4 + 3] * inv);
  }
}

__device__ void ph_ctx_attn(const P& p, int l) {
  for (int idx = GTID; idx < LC * 12; idx += GSZ) {
    int slot = idx % 12, i = idx / 12;
    int qoff, koff, voff, ooff;
    float m, lsum;
    if (slot < 6) {
      int h = slot, g = h / 3;
      qoff = OFF_QW + h * 64; koff = OFF_KW + g * 64; voff = OFF_VW + g * 64; ooff = 256 + h * 64;
      m = p.win_sink[l * 6 + h]; lsum = 1.f;
    } else {
      int h = slot - 6;
      qoff = OFF_QN + h * 64; koff = OFF_KN + h * 64; voff = OFF_VN + h * 64; ooff = 640 + h * 64;
      m = -1e30f; lsum = 0.f;
    }
    float q[64], acc[64];
    const float* qp = p.proj + (size_t)i * DIN + qoff;
#pragma unroll
    for (int d4 = 0; d4 < 16; ++d4) {
      float4 v = ((const float4*)qp)[d4];
      q[d4 * 4] = v.x; q[d4 * 4 + 1] = v.y; q[d4 * 4 + 2] = v.z; q[d4 * 4 + 3] = v.w;
    }
#pragma unroll
    for (int d = 0; d < 64; ++d) acc[d] = 0.f;
    for (int j = 0; j < LC; ++j) {
      const float* kp = p.proj + (size_t)j * DIN + koff;
      const float* vp = p.proj + (size_t)j * DIN + voff;
      ATTN_STEP(kp, vp, 0.f)
    }
    float inv = 1.f / lsum;
    float* op = p.mix + (size_t)i * 1024 + ooff;
#pragma unroll
    for (int d4 = 0; d4 < 16; ++d4)
      ((float4*)op)[d4] = make_float4(acc[d4 * 4] * inv, acc[d4 * 4 + 1] * inv, acc[d4 * 4 + 2] * inv, acc[d4 * 4 + 3] * inv);
  }
}

__device__ void ph_peer_topk(const P& p, int l, int t0, float* smem) {
  float* sq = smem;
  float* ss = smem + 256;
  float* tv = smem + 512;
  int* ti = (int*)(smem + 544);
  float* cv = smem + 576;
  int* ci = (int*)(smem + 832);
  float* bv = smem + 1088;
  int* bi = (int*)(smem + 1104);
  const int tid = threadIdx.x;
  const int nitems = (TT - t0) * 8;
  for (int item = blockIdx.x; item < nitems; item += gridDim.x) {
    int t = t0 + item / 8, hd = item % 8;
    __syncthreads();
    sq[tid] = p.proj[(size_t)t * NPQ + hd * 256 + tid];
    __syncthreads();
    {
      int half = tid >> 7, n = tid & 127;
      const float* kk = (half ? p.k2 : p.k1) + (size_t)l * 128 * 128 + n * 128;
      const float* qq = sq + half * 128;
      float s = 0.f;
      for (int d = 0; d < 128; ++d) s += qq[d] * kk[d];
      ss[tid] = s;
    }
    __syncthreads();
    {
      int half = tid >> 7, n = tid & 127;
      float mine = ss[tid];
      const float* base = ss + half * 128;
      int rank = 0;
      for (int mI = 0; mI < 128; ++mI) {
        float o = base[mI];
        rank += (o > mine) || (o == mine && mI < n);
      }
      if (rank < 16) { tv[half * 16 + rank] = mine; ti[half * 16 + rank] = n; }
    }
    __syncthreads();
    {
      int a = tid >> 4, b = tid & 15;
      cv[tid] = tv[a] + tv[16 + b];
      ci[tid] = ti[a] * 128 + ti[16 + b];
    }
    __syncthreads();
    {
      float mine = cv[tid];
      int rank = 0;
      for (int mI = 0; mI < 256; ++mI) {
        float o = cv[mI];
        rank += (o > mine) || (o == mine && mI < tid);
      }
      if (rank < 16) { bv[rank] = mine; bi[rank] = ci[tid]; }
    }
    __syncthreads();
    if (tid < 16) {
      float mx = bv[0], sum = 0.f;
      for (int r = 0; r < 16; ++r) sum += __expf(bv[r] - mx);
      p.gate[(size_t)t * 128 + hd * 16 + tid] = __expf(bv[tid] - mx) / sum;
      p.eidx[(size_t)t * 128 + hd * 16 + tid] = bi[tid];
    }
  }
}

__device__ void ph_peer_apply(const P& p, int l, int t0, float* smem) {
  const int tid = threadIdx.x, lane = tid & 63, w = tid >> 6;
  const float* U = p.pu + (size_t)l * 16384 * 1024;
  const float* V = p.pv + (size_t)l * 16384 * 1024;
  for (int t = t0 + blockIdx.x; t < TT; t += gridDim.x) {
    float4 hv[4], acc[4];
#pragma unroll
    for (int i = 0; i < 4; ++i) {
      hv[i] = ((const float4*)(p.h + (size_t)t * 1024))[i * 64 + lane];
      acc[i] = make_float4(0.f, 0.f, 0.f, 0.f);
    }
    for (int e = w; e < 128; e += 4) {
      int ex = p.eidx[(size_t)t * 128 + e];
      float gt = p.gate[(size_t)t * 128 + e];
      const float4* ur = (const float4*)(U + (size_t)ex * 1024);
      const float4* vr = (const float4*)(V + (size_t)ex * 1024);
      float dot = 0.f;
#pragma unroll
      for (int i = 0; i < 4; ++i) {
        float4 uu = ur[i * 64 + lane];
        dot += uu.x * hv[i].x + uu.y * hv[i].y + uu.z * hv[i].z + uu.w * hv[i].w;
      }
      dot = wave_sum(dot);
      float a = gt * gelu_f(dot);
#pragma unroll
      for (int i = 0; i < 4; ++i) {
        float4 vv = vr[i * 64 + lane];
        acc[i].x += a * vv.x; acc[i].y += a * vv.y; acc[i].z += a * vv.z; acc[i].w += a * vv.w;
      }
    }
    __syncthreads();
#pragma unroll
    for (int i = 0; i < 4; ++i) ((float4*)(smem + w * 1024))[i * 64 + lane] = acc[i];
    __syncthreads();
    {
      float4 s0 = ((float4*)smem)[tid], s1 = ((float4*)(smem + 1024))[tid], s2 = ((float4*)(smem + 2048))[tid], s3 = ((float4*)(smem + 3072))[tid];
      const float* g2 = p.mod + (l * 2 + (t < LC ? 1 : 0)) * 6144 + 5120;
      float4 gg = ((const float4*)g2)[tid];
      float4* xp = (float4*)(p.xall + (size_t)t * 1024) + tid;
      float4 xv = *xp;
      xv.x += gg.x * (s0.x + s1.x + s2.x + s3.x);
      xv.y += gg.y * (s0.y + s1.y + s2.y + s3.y);
      xv.z += gg.z * (s0.z + s1.z + s2.z + s3.z);
      xv.w += gg.w * (s0.w + s1.w + s2.w + s3.w);
      *xp = xv;
    }
  }
}

constexpr int N_PH_PRE = 2;
constexpr int N_PH_LAYER = 15;
constexpr int N_PHASES = N_PH_PRE + 2 * N_PH_LAYER + 1;

__device__ __forceinline__ void run_phase(const P& p, int ph, float* smem) {
  if (ph == 0) { ph_mod(p); return; }
  if (ph == 1) { ph_copy_in(p); return; }
  if (ph == N_PHASES - 1) { ph_copy_out(p); return; }
  int l = (ph - N_PH_PRE) / N_PH_LAYER, s = (ph - N_PH_PRE) % N_PH_LAYER;
  int t0 = (l == 0) ? 0 : LC;
  switch (s) {
    case 0: ph_norm_mod(p, l, 0, 0, smem); break;
    case 1: ph_gemm<0>(p, p.h, 1024, p.w_in + (size_t)l * 1024 * DIN, p.proj, 0, TT, DIN, 1024, l, 0, smem); break;
    case 2: ph_qknorm_rope(p, l); break;
    case 3: ph_lru_conv(p, l); break;
    case 4: ph_lru_gates(p, l); break;
    case 5: ph_lru_scan(p); break;
    case 6: ph_lru_out(p); break;
    case 7: ph_win_attn(p, l); break;
    case 8: ph_na_attn(p, l); break;
    case 9: if (l == 0) ph_ctx_attn(p, l); break;
    case 10: ph_gemm<1>(p, p.mix, 1024, p.w_out + (size_t)l * 1024 * 1024, nullptr, t0, TT, 1024, 1024, l, 2048, smem); break;
    case 11: ph_norm_mod(p, l, 1, t0, smem); break;
    case 12: ph_gemm<0>(p, p.h, 1024, p.wq + (size_t)l * 1024 * NPQ, p.proj, t0, TT, NPQ, 1024, l, 0, smem); break;
    case 13: ph_peer_topk(p, l, t0, smem); break;
    case 14: ph_peer_apply(p, l, t0, smem); break;
  }
}

__global__ void __launch_bounds__(256) k_phase(P p, int ph) {
  __shared__ __attribute__((aligned(16))) float smem[4096];
  run_phase(p, ph, smem);
}

__global__ void __launch_bounds__(256) k_mega(P p) {
  __shared__ __attribute__((aligned(16))) float smem[4096];
  cg::grid_group grid = cg::this_grid();
  for (int ph = 0; ph < N_PHASES; ++ph) {
    run_phase(p, ph, smem);
    if (ph + 1 < N_PHASES) grid.sync();
  }
}

extern "C" void kernel_launch(void* const* d_in, const int* in_sizes, int n_in, void* d_out, int out_size, void* d_ws,
                              size_t ws_size, hipStream_t stream) {
  P p{};
  const float** fp = (const float**)&p;
  for (int i = 0; i < 28; ++i) fp[i] = (const float*)d_in[i];
  p.out = (float*)d_out;
  float* w = (float*)d_ws;
  size_t o = 0;
  auto carve = [&](size_t n) { float* r = w + o; o += (n + 63) & ~(size_t)63; return r; };
  p.mod = carve(4 * 6144);
  p.xall = carve((size_t)TT * 1024);
  p.h = carve((size_t)TT * 1024);
  p.proj = carve((size_t)TT * DIN);
  p.mix = carve((size_t)TT * 1024);
  p.ub = carve((size_t)TT * 256);
  p.la = carve((size_t)2 * TT * 256);
  p.lb = carve((size_t)2 * TT * 256);
  p.hs = carve((size_t)2 * TT * 256);
  p.gate = carve((size_t)TT * 128);
  p.eidx = (int*)carve((size_t)TT * 128);
  if (o * 4 > ws_size) { fprintf(stderr, "workspace too small: need %zu have %zu\n", o * 4, ws_size); return; }
#if SINGLE_LAUNCH
  static int grid_blocks = 0;
  if (!grid_blocks) {
    int dev = 0, cus = 0, per_cu = 0;
    hipGetDevice(&dev);
    hipDeviceGetAttribute(&cus, hipDeviceAttributeMultiprocessorCount, dev);
    hipOccupancyMaxActiveBlocksPerMultiprocessor(&per_cu, k_mega, 256, 0);
    if (per_cu > 2) per_cu = 2;
    grid_blocks = cus * per_cu;
  }
  void* args[] = {&p};
  hipError_t e = hipLaunchCooperativeKernel((void*)k_mega, dim3(grid_blocks), dim3(256), args, 0, stream);
  if (e != hipSuccess) fprintf(stderr, "cooperative launch failed: %s (grid %d)\n", hipGetErrorString(e), grid_blocks);
#else
  for (int ph = 0; ph < N_PHASES; ++ph) {
    if ((ph - N_PH_PRE) % N_PH_LAYER == 9 && ph >= N_PH_PRE + N_PH_LAYER && ph != N_PHASES - 1) continue;
    k_phase<<<2048, 256, 0, stream>>>(p, ph);
  }
#endif
}
```

```cpp
#include <hip/hip_runtime.h>
#include <hip/hip_cooperative_groups.h>
#include <stdint.h>
#include <stdio.h>
namespace cg = cooperative_groups;

#ifndef SINGLE_LAUNCH
#define SINGLE_LAUNCH 1
#endif

constexpr int DM = 1024, SEQ = 16384, LC = 256, TT = SEQ + LC, DIN = 2304, NPQ = 2048;
constexpr int OFF_XA = 0, OFF_GA = 256, OFF_QW = 512, OFF_KW = 896, OFF_VW = 1024, OFF_QN = 1152, OFF_KN = 1536, OFF_VN = 1920;
constexpr float EPS = 1e-6f;

struct P {
  const float *x, *c, *ctx, *c_ctx, *w_mod, *b_mod, *norm1_g, *norm2_g, *w_in, *w_out,
      *conv_w, *conv_b, *wa, *ba, *wx, *bx, *lam, *win_qn, *win_kn, *win_sink, *na_qn, *na_kn, *rpb,
      *wq, *k1, *k2, *pu, *pv;
  float* out;
  float *mod, *xall, *h, *proj;
  unsigned* pk;
  unsigned short *ub16, *vb16, *k1b, *k2b;
  unsigned short *hb, *mixb, *w_in_t, *w_out_t, *wq_t, *lruw_t;
  float* lagg;
};

typedef unsigned short bf16_t;
typedef __attribute__((ext_vector_type(8))) short bf16x8;
typedef __attribute__((ext_vector_type(4))) float f32x4;
__device__ __forceinline__ unsigned short f2bf(float f) {
  unsigned u = __float_as_uint(f);
  u += 0x7fffu + ((u >> 16) & 1u);
  return (unsigned short)(u >> 16);
}
__device__ __forceinline__ unsigned pack2bf(float a, float b) { return (unsigned)f2bf(a) | ((unsigned)f2bf(b) << 16); }
__device__ __forceinline__ float bf2f(unsigned short h) { return __uint_as_float(((unsigned)h) << 16); }


__device__ __forceinline__ float silu_f(float x) { return x / (1.f + __expf(-x)); }
__device__ __forceinline__ float sigmoid_f(float x) { return 1.f / (1.f + __expf(-x)); }
__device__ __forceinline__ float gelu_f(float x) {
  float u = 0.7978845608028654f * (x + 0.044715f * x * x * x);
  float e = __expf(2.f * u);
  float th = 1.f - 2.f / (e + 1.f);
  return 0.5f * x * (1.f + th);
}
__device__ __forceinline__ float wave_sum(float v) {
#pragma unroll
  for (int o = 32; o > 0; o >>= 1) v += __shfl_xor(v, o);
  return v;
}

#define GTID (blockIdx.x * blockDim.x + threadIdx.x)
#define GSZ (gridDim.x * blockDim.x)

__device__ void ph_mod(const P& p) {
  for (int idx = GTID; idx < 4 * 6144; idx += GSZ) {
    int n = idx % 6144, lw = idx / 6144, l = lw >> 1, which = lw & 1;
    const float* vec = which ? p.c_ctx : p.c;
    const float* w = p.w_mod + (size_t)l * 1024 * 6144 + n;
    float acc = 0.f;
    for (int k = 0; k < 1024; ++k) acc += silu_f(vec[k]) * w[(size_t)k * 6144];
    p.mod[idx] = acc + p.b_mod[l * 6144 + n];
  }
}

__device__ void ph_copy_in(const P& p) {
  const float4* xs = (const float4*)p.x;
  const float4* cs = (const float4*)p.ctx;
  float4* d = (float4*)p.xall;
  for (int i = GTID; i < TT * 256; i += GSZ) d[i] = (i < LC * 256) ? cs[i] : xs[i - LC * 256];
}

__device__ void ph_copy_out(const P& p) {
  const float4* s = (const float4*)(p.xall + (size_t)LC * 1024);
  float4* d = (float4*)p.out;
  for (int i = GTID; i < SEQ * 256; i += GSZ) d[i] = s[i];
}

__device__ void ph_norm_mod(const P& p, int l, int which_norm, int t0, float* smem) {
  const float* g = (which_norm ? p.norm2_g : p.norm1_g) + l * 1024;
  const int sh_off = which_norm ? 3072 : 0, sc_off = which_norm ? 4096 : 1024;
  const int tid = threadIdx.x;
  for (int t = t0 + blockIdx.x; t < TT; t += gridDim.x) {
    const float* mod = p.mod + (l * 2 + (t < LC ? 1 : 0)) * 6144;
    float4 v = ((const float4*)(p.xall + (size_t)t * 1024))[tid];
    float ss = wave_sum(v.x * v.x + v.y * v.y + v.z * v.z + v.w * v.w);
    __syncthreads();
    if ((tid & 63) == 0) smem[tid >> 6] = ss;
    __syncthreads();
    float tot = smem[0] + smem[1] + smem[2] + smem[3];
    float rinv = rsqrtf(tot * (1.f / 1024.f) + EPS);
    float4 gg = ((const float4*)g)[tid];
    float4 sc = ((const float4*)(mod + sc_off))[tid];
    float4 sh = ((const float4*)(mod + sh_off))[tid];
    float4 o;
    o.x = v.x * rinv * gg.x * (1.f + sc.x) + sh.x;
    o.y = v.y * rinv * gg.y * (1.f + sc.y) + sh.y;
    o.z = v.z * rinv * gg.z * (1.f + sc.z) + sh.z;
    o.w = v.w * rinv * gg.w * (1.f + sc.w) + sh.w;
    ((float4*)(p.h + (size_t)t * 1024))[tid] = o;
    ((uint2*)(p.hb + (size_t)t * 1024))[tid] = make_uint2(pack2bf(o.x, o.y), pack2bf(o.z, o.w));
  }
}

template <int EPI>
__device__ void ph_gemm(const P& p, const float* A, int lda, const float* B, float* C, int m_begin, int M, int N, int K,
                        int l, int gofs, float* smem) {
  float(*As)[68] = (float(*)[68])smem;
  float(*Bs)[64] = (float(*)[64])(smem + 16 * 68);
  const int tid = threadIdx.x, ty = tid >> 4, tx = tid & 15;
  const int tiles_n = N / 64, tiles_m = (M - m_begin) / 64;
  for (int tile = blockIdx.x; tile < tiles_m * tiles_n; tile += gridDim.x) {
    const int m0 = m_begin + (tile / tiles_n) * 64, n0 = (tile % tiles_n) * 64;
    float acc[4][4];
#pragma unroll
    for (int i = 0; i < 4; ++i)
#pragma unroll
      for (int j = 0; j < 4; ++j) acc[i][j] = 0.f;
    for (int k0 = 0; k0 < K; k0 += 16) {
      {
        int row = tid >> 2, kq = (tid & 3) * 4;
        float4 a = *(const float4*)(A + (size_t)(m0 + row) * lda + k0 + kq);
        As[kq + 0][row] = a.x; As[kq + 1][row] = a.y; As[kq + 2][row] = a.z; As[kq + 3][row] = a.w;
        int kr = tid >> 4, n4 = (tid & 15) * 4;
        float4 b = *(const float4*)(B + (size_t)(k0 + kr) * N + n0 + n4);
        *(float4*)&Bs[kr][n4] = b;
      }
      __syncthreads();
#pragma unroll
      for (int kk = 0; kk < 16; ++kk) {
        float4 a = *(const float4*)&As[kk][ty * 4];
        float4 b = *(const float4*)&Bs[kk][tx * 4];
        float av[4] = {a.x, a.y, a.z, a.w}, bv[4] = {b.x, b.y, b.z, b.w};
#pragma unroll
        for (int i = 0; i < 4; ++i)
#pragma unroll
          for (int j = 0; j < 4; ++j) acc[i][j] += av[i] * bv[j];
      }
      __syncthreads();
    }
#pragma unroll
    for (int i = 0; i < 4; ++i) {
      int m = m0 + ty * 4 + i, n = n0 + tx * 4;
      if (EPI == 0) {
        *(float4*)(C + (size_t)m * N + n) = make_float4(acc[i][0], acc[i][1], acc[i][2], acc[i][3]);
      } else {
        const float* gt = p.mod + (l * 2 + (m < LC ? 1 : 0)) * 6144 + gofs + n;
        float4* xp = (float4*)(p.xall + (size_t)m * 1024 + n);
        float4 xv = *xp;
        xv.x += gt[0] * acc[i][0]; xv.y += gt[1] * acc[i][1]; xv.z += gt[2] * acc[i][2]; xv.w += gt[3] * acc[i][3];
        *xp = xv;
      }
    }
  }
}

__device__ void prep_transpose(const float* W, bf16_t* Wt, int K, int N, int item0, int nitems_total, float* smem) {
  (void)nitems_total;
  float(*ts)[65] = (float(*)[65])smem;
  const int tid = threadIdx.x;
  const int tn = N / 64, nt = (K / 64) * tn;
  for (int it = blockIdx.x; it < nt; it += gridDim.x) {
    int k0 = (it / tn) * 64, n0 = (it % tn) * 64;
    __syncthreads();
#pragma unroll
    for (int i = 0; i < 16; ++i) {
      int r = (tid >> 6) + i * 4, c = tid & 63;
      ts[r][c] = W[(size_t)(k0 + r) * N + n0 + c];
    }
    __syncthreads();
#pragma unroll
    for (int i = 0; i < 16; ++i) {
      int r = (tid >> 6) + i * 4, c = tid & 63;
      Wt[(size_t)(n0 + r) * K + k0 + c] = f2bf(ts[c][r]);
    }
  }
  (void)item0;
}

__device__ void ph_prep(const P& p, float* smem) {
  for (int l = 0; l < 2; ++l) {
    prep_transpose(p.w_in + (size_t)l * 1024 * DIN, p.w_in_t + (size_t)l * 1024 * DIN, 1024, DIN, 0, 0, smem);
    prep_transpose(p.w_out + (size_t)l * 1024 * 1024, p.w_out_t + (size_t)l * 1024 * 1024, 1024, 1024, 0, 0, smem);
    prep_transpose(p.wq + (size_t)l * 1024 * NPQ, p.wq_t + (size_t)l * 1024 * NPQ, 1024, NPQ, 0, 0, smem);
  }
}

struct EpiStoreF32 {
  float* C; int ldc;
  __device__ __forceinline__ void operator()(const P& p, f32x4 (&acc)[4][4], int m0, int n0, int wm, int wn, int lane, char* smem) const {
    const int mw0 = m0 + wm * 64, nw0 = n0 + wn * 64;
#pragma unroll
    for (int i = 0; i < 4; ++i)
#pragma unroll
      for (int r = 0; r < 4; ++r) {
        int row = mw0 + 16 * i + (lane >> 4) * 4 + r;
#pragma unroll
        for (int j = 0; j < 4; ++j) C[(size_t)row * ldc + nw0 + 16 * j + (lane & 15)] = acc[i][j][r];
      }
  }
};
struct EpiResid {
  int l, gofs;
  __device__ __forceinline__ void operator()(const P& p, f32x4 (&acc)[4][4], int m0, int n0, int wm, int wn, int lane, char* smem) const {
    const int mw0 = m0 + wm * 64, nw0 = n0 + wn * 64;
#pragma unroll
    for (int i = 0; i < 4; ++i)
#pragma unroll
      for (int r = 0; r < 4; ++r) {
        int row = mw0 + 16 * i + (lane >> 4) * 4 + r;
        const float* gt = p.mod + (l * 2 + (row < LC ? 1 : 0)) * 6144 + gofs;
#pragma unroll
        for (int j = 0; j < 4; ++j) {
          int col = nw0 + 16 * j + (lane & 15);
          p.xall[(size_t)row * 1024 + col] += gt[col] * acc[i][j][r];
        }
      }
  }
};

template <class Epi>
__device__ void gemm_bf16_128(const P& p, const bf16_t* __restrict__ A, const bf16_t* __restrict__ Bt, int K, int m_begin, int m_end,
                              int N, char* smem, const Epi& epi) {
  const int tid = threadIdx.x, lane = tid & 63, wv = tid >> 6, wm = wv >> 1, wn = wv & 1;
  const int tiles_n = N / 128, tiles_m = (m_end - m_begin) / 128;
  const int nk = K / 64;
  const int lrow = lane & 15, lq = lane >> 4;
  for (int tile = blockIdx.x; tile < tiles_m * tiles_n; tile += gridDim.x) {
    const int m0 = m_begin + (tile / tiles_n) * 128, n0 = (tile % tiles_n) * 128;
    f32x4 acc[4][4];
#pragma unroll
    for (int i = 0; i < 4; ++i)
#pragma unroll
      for (int j = 0; j < 4; ++j) acc[i][j] = (f32x4){0.f, 0.f, 0.f, 0.f};
    uint4 ra[4], rb[4];
    const bf16_t* Ag = A + (size_t)m0 * K;
    const bf16_t* Bg = Bt + (size_t)n0 * K;
#pragma unroll
    for (int i = 0; i < 4; ++i) {
      int id = tid + 256 * i, row = id >> 3, c = id & 7;
      ra[i] = *(const uint4*)(Ag + (size_t)row * K + c * 8);
      rb[i] = *(const uint4*)(Bg + (size_t)row * K + c * 8);
    }
#pragma unroll
    for (int i = 0; i < 4; ++i) {
      int id = tid + 256 * i, row = id >> 3, c = id & 7;
      int off = row * 128 + ((c ^ (row & 7)) << 4);
      *(uint4*)(smem + off) = ra[i];
      *(uint4*)(smem + 16384 + off) = rb[i];
    }
    __syncthreads();
    for (int kt = 0; kt < nk; ++kt) {
      const int cur = (kt & 1) * 32768, nxt = ((kt + 1) & 1) * 32768;
      if (kt + 1 < nk) {
#pragma unroll
        for (int i = 0; i < 4; ++i) {
          int id = tid + 256 * i, row = id >> 3, c = id & 7;
          ra[i] = *(const uint4*)(Ag + (size_t)row * K + (kt + 1) * 64 + c * 8);
          rb[i] = *(const uint4*)(Bg + (size_t)row * K + (kt + 1) * 64 + c * 8);
        }
      }
#pragma unroll
      for (int s = 0; s < 2; ++s) {
        bf16x8 af[4], bfr[4];
#pragma unroll
        for (int i = 0; i < 4; ++i) {
          int row = wm * 64 + 16 * i + lrow;
          af[i] = *(const bf16x8*)(smem + cur + row * 128 + (((4 * s + lq) ^ (row & 7)) << 4));
        }
#pragma unroll
        for (int j = 0; j < 4; ++j) {
          int row = wn * 64 + 16 * j + lrow;
          bfr[j] = *(const bf16x8*)(smem + cur + 16384 + row * 128 + (((4 * s + lq) ^ (row & 7)) << 4));
        }
#pragma unroll
        for (int i = 0; i < 4; ++i)
#pragma unroll
          for (int j = 0; j < 4; ++j) acc[i][j] = __builtin_amdgcn_mfma_f32_16x16x32_bf16(af[i], bfr[j], acc[i][j], 0, 0, 0);
      }
      if (kt + 1 < nk) {
#pragma unroll
        for (int i = 0; i < 4; ++i) {
          int id = tid + 256 * i, row = id >> 3, c = id & 7;
          int off = row * 128 + ((c ^ (row & 7)) << 4);
          *(uint4*)(smem + nxt + off) = ra[i];
          *(uint4*)(smem + nxt + 16384 + off) = rb[i];
        }
      }
      __syncthreads();
    }
    epi(p, acc, m0, n0, wm, wn, lane, smem);
    __syncthreads();
  }
}

__device__ void ph_qknorm_rope(const P& p, int l) {
  const int lane = threadIdx.x & 63;
  const int wpb = blockDim.x >> 6;
  for (int pair = blockIdx.x * wpb + (threadIdx.x >> 6); pair < TT * 20; pair += gridDim.x * wpb) {
    int t = pair / 20, slot = pair % 20;
    int off; const float* g; bool rope;
    if (slot < 6) { off = OFF_QW + slot * 64; g = p.win_qn + l * 64; rope = true; }
    else if (slot < 8) { off = OFF_KW + (slot - 6) * 64; g = p.win_kn + l * 64; rope = true; }
    else if (slot < 14) { off = OFF_QN + (slot - 8) * 64; g = p.na_qn + l * 64; rope = false; }
    else { off = OFF_KN + (slot - 14) * 64; g = p.na_kn + l * 64; rope = false; }
    rope = rope && (t >= LC);
    float* ptr = p.proj + (size_t)t * DIN + off + lane;
    float v = *ptr;
    float ss = wave_sum(v * v);
    float y = v * rsqrtf(ss * (1.f / 64.f) + EPS) * g[lane];
    float partner = __shfl_xor(y, 16);
    if (rope) {
      int pos = t - LC, row = pos >> 6, col = pos & 63;
      int j = lane & 15, axis = lane >> 5;
      float inv = __expf(-(float)j * (1.f / 16.f) * 9.210340371976184f);
      float ang = (float)(axis ? col : row) * inv;
      float k = rintf(ang * 0.15915494309189535f);
      float r = fmaf(-k, 6.2831854820251465f, ang);
      r = fmaf(-k, -1.7484555e-07f, r);
      float cs = __cosf(r), sn = __sinf(r);
      bool first = ((lane >> 4) & 1) == 0;
      y = first ? (y * cs - partner * sn) : (partner * sn + y * cs);
    }
    *ptr = y;
  }
}

constexpr int NCHUNK = TT / 64;
__device__ __forceinline__ int lru_pos(int dir, int c) { return dir == 0 ? c : (c < 4 ? 3 - c : 4 + (NCHUNK - 1 - c)); }

__device__ void ph_lru_prepw(const P& p) {
  for (int idx = GTID; idx < 2 * 2 * 4 * 2 * 4096; idx += GSZ) {
    int d = idx & 63, e = (idx >> 6) & 63, mtx = (idx >> 12) & 1, rest = idx >> 13;
    const float* w = (mtx ? p.wx : p.wa) + (size_t)rest * 4096;
    p.lruw_t[idx] = f2bf(w[d * 64 + e]);
  }
}

template <int PASS>
__device__ void lru_item(const P& p, int l, int cidx, int kb, char* smem) {
  bf16_t* u_img = (bf16_t*)smem;
  float* ab_a = (float*)(smem + 8192);
  float* ab_b = (float*)(smem + 8192 + 16384);
  float* hsum = (float*)(smem + 8192 + 32768);
  float* segagg = (float*)(smem + 8192 + 49152);
  float* ccarry = (float*)(smem + 8192 + 49152 + 2048);
  const int tid = threadIdx.x, lane = tid & 63, wv = tid >> 6, g = lane >> 4, lr = lane & 15;
  const int t0 = cidx * 64;
  const int lo = t0 < LC ? 0 : LC, hi = t0 < LC ? LC : TT;
  __syncthreads();
  {
    const int ch = tid & 63, c = kb * 64 + ch;
    const float cb = p.conv_b[l * 256 + c];
    float cw[4];
#pragma unroll
    for (int k = 0; k < 4; ++k) cw[k] = p.conv_w[(l * 4 + k) * 256 + c];
#pragma unroll
    for (int i = 0; i < 16; ++i) {
      int row = (tid >> 6) + 4 * i, t = t0 + row;
      float acc = cb;
#pragma unroll
      for (int k = 0; k < 4; ++k) {
        int tt = t + k - 2;
        if (tt >= lo && tt < hi) acc += cw[k] * p.proj[(size_t)tt * DIN + OFF_XA + c];
      }
      u_img[row * 64 + ((((ch >> 3) ^ (row & 7)) << 3) | (ch & 7))] = f2bf(acc);
    }
  }
  if (PASS == 2) {
    if (tid < 128) {
      const int ch = tid & 63, dir = tid >> 6;
      const int pos = lru_pos(dir, cidx);
      const float2* ag = (const float2*)p.lagg + (size_t)dir * NCHUNK * 256 + kb * 64 + ch;
      float h = 0.f;
      for (int q = 0; q < pos; ++q) {
        float2 v = ag[(size_t)q * 256];
        h = v.x * h + v.y;
      }
      ccarry[dir * 64 + ch] = h;
    }
  }
  __syncthreads();
  for (int dir = 0; dir < 2; ++dir) {
    const int pd = l * 2 + dir;
    {
      f32x4 ga[4], gx[4];
#pragma unroll
      for (int i = 0; i < 4; ++i) { ga[i] = (f32x4){0.f, 0.f, 0.f, 0.f}; gx[i] = (f32x4){0.f, 0.f, 0.f, 0.f}; }
      const bf16_t* wbase = p.lruw_t + (size_t)((pd * 4 + kb) * 2) * 4096 + (16 * wv + lr) * 64 + 8 * g;
#pragma unroll
      for (int s = 0; s < 2; ++s) {
        bf16x8 ba_ = *(const bf16x8*)(wbase + 32 * s);
        bf16x8 bx_ = *(const bf16x8*)(wbase + 4096 + 32 * s);
#pragma unroll
        for (int i = 0; i < 4; ++i) {
          int row = 16 * i + lr;
          bf16x8 af = *(const bf16x8*)((const char*)u_img + row * 128 + (((4 * s + g) ^ (row & 7)) << 4));
          ga[i] = __builtin_amdgcn_mfma_f32_16x16x32_bf16(af, ba_, ga[i], 0, 0, 0);
          gx[i] = __builtin_amdgcn_mfma_f32_16x16x32_bf16(af, bx_, gx[i], 0, 0, 0);
        }
      }
      const int ch = 16 * wv + lr, c = kb * 64 + ch;
      const float bav = p.ba[pd * 256 + c], bxv = p.bx[pd * 256 + c];
      const float sp = log1pf(expf(-p.lam[pd * 256 + c]));
#pragma unroll
      for (int i = 0; i < 4; ++i)
#pragma unroll
        for (int r = 0; r < 4; ++r) {
          int row = 16 * i + 4 * g + r;
          float rr = sigmoid_f(ga[i][r] + bav), ig = sigmoid_f(gx[i][r] + bxv);
          float log_a = -8.f * rr * sp;
          float a = __expf(log_a);
          float uu = bf2f(u_img[row * 64 + ((((ch >> 3) ^ (row & 7)) << 3) | (ch & 7))]);
          float b = sqrtf(-expm1f(2.f * log_a)) * ig * uu;
          ab_a[row * 64 + ch] = a;
          ab_b[row * 64 + ch] = b;
        }
    }
    __syncthreads();
    {
      const int ch = tid & 63, seg = tid >> 6;
      float Pr = 1.f, H = 0.f;
#pragma unroll
      for (int i = 0; i < 16; ++i) {
        int row = dir == 0 ? seg * 16 + i : seg * 16 + 15 - i;
        float a = ab_a[row * 64 + ch], b = ab_b[row * 64 + ch];
        H = a * H + b;
        Pr *= a;
      }
      segagg[(seg * 64 + ch) * 2] = Pr;
      segagg[(seg * 64 + ch) * 2 + 1] = H;
      __syncthreads();
      if (PASS == 1) {
        if (seg == 0) {
          float A = 1.f, B = 0.f;
#pragma unroll
          for (int s2 = 0; s2 < 4; ++s2) {
            int sg = dir == 0 ? s2 : 3 - s2;
            float pa = segagg[(sg * 64 + ch) * 2], pb = segagg[(sg * 64 + ch) * 2 + 1];
            B = pa * B + pb;
            A *= pa;
          }
          float2* ag = (float2*)p.lagg + ((size_t)dir * NCHUNK + lru_pos(dir, cidx)) * 256 + kb * 64 + ch;
          *ag = make_float2(A, B);
        }
      } else {
        float h = ccarry[dir * 64 + ch];
#pragma unroll
        for (int s2 = 0; s2 < 3; ++s2) {
          int sg = dir == 0 ? s2 : 3 - s2;
          bool before = dir == 0 ? (sg < seg) : (sg > seg);
          if (before) h = segagg[(sg * 64 + ch) * 2] * h + segagg[(sg * 64 + ch) * 2 + 1];
        }
#pragma unroll
        for (int i = 0; i < 16; ++i) {
          int row = dir == 0 ? seg * 16 + i : seg * 16 + 15 - i;
          float a = ab_a[row * 64 + ch], b = ab_b[row * 64 + ch];
          h = a * h + b;
          if (dir == 0) hsum[row * 64 + ch] = h;
          else {
            int t = t0 + row, c = kb * 64 + ch;
            float gv = p.proj[(size_t)t * DIN + OFF_GA + c];
            p.mixb[(size_t)t * 1024 + c] = f2bf((hsum[row * 64 + ch] + h) * gelu_f(gv));
          }
        }
      }
    }
    __syncthreads();
  }
}

template <int PASS>
__device__ void ph_lru(const P& p, int l, char* smem) {
  const int c_begin = (PASS == 2 && l == 1) ? 4 : 0;
  const int nitems = (NCHUNK - c_begin) * 4;
  for (int it = blockIdx.x; it < nitems; it += gridDim.x) lru_item<PASS>(p, l, c_begin + (it >> 2), it & 3, smem);
}

#define ATTN_STEP(KP, VP, BIAS)                                          \
  {                                                                      \
    float s = 0.f;                                                       \
    _Pragma("unroll") for (int d4 = 0; d4 < 16; ++d4) {                  \
      float4 kk = ((const float4*)(KP))[d4];                             \
      s += q[d4 * 4] * kk.x + q[d4 * 4 + 1] * kk.y + q[d4 * 4 + 2] * kk.z + q[d4 * 4 + 3] * kk.w; \
    }                                                                    \
    s = s * 0.125f + (BIAS);                                             \
    float mn = fmaxf(m, s);                                              \
    float sc = __expf(m - mn), pp = __expf(s - mn);                      \
    m = mn;                                                              \
    lsum = lsum * sc + pp;                                               \
    _Pragma("unroll") for (int d4 = 0; d4 < 16; ++d4) {                  \
      float4 vv = ((const float4*)(VP))[d4];                             \
      acc[d4 * 4] = acc[d4 * 4] * sc + pp * vv.x;                        \
      acc[d4 * 4 + 1] = acc[d4 * 4 + 1] * sc + pp * vv.y;                \
      acc[d4 * 4 + 2] = acc[d4 * 4 + 2] * sc + pp * vv.z;                \
      acc[d4 * 4 + 3] = acc[d4 * 4 + 3] * sc + pp * vv.w;                \
    }                                                                    \
  }

__device__ void ph_win_attn(const P& p, int l) {
  for (int idx = GTID; idx < SEQ * 6; idx += GSZ) {
    int h = idx % 6, i = idx / 6, g = h / 3;
    float q[64], acc[64];
    const float* qp = p.proj + (size_t)(LC + i) * DIN + OFF_QW + h * 64;
#pragma unroll
    for (int d4 = 0; d4 < 16; ++d4) {
      float4 v = ((const float4*)qp)[d4];
      q[d4 * 4] = v.x; q[d4 * 4 + 1] = v.y; q[d4 * 4 + 2] = v.z; q[d4 * 4 + 3] = v.w;
    }
#pragma unroll
    for (int d = 0; d < 64; ++d) acc[d] = 0.f;
    float m = p.win_sink[l * 6 + h], lsum = 1.f;
    int lo = max(0, i - 128), hi = min(SEQ - 1, i + 128);
    for (int j = lo; j <= hi; ++j) {
      const float* kp = p.proj + (size_t)(LC + j) * DIN + OFF_KW + g * 64;
      const float* vp = p.proj + (size_t)(LC + j) * DIN + OFF_VW + g * 64;
      ATTN_STEP(kp, vp, 0.f)
    }
    for (int j = 0; j < LC; ++j) {
      const float* kp = p.proj + (size_t)j * DIN + OFF_KW + g * 64;
      const float* vp = p.proj + (size_t)j * DIN + OFF_VW + g * 64;
      ATTN_STEP(kp, vp, 0.f)
    }
    float inv = 1.f / lsum;
    bf16_t* op = p.mixb + (size_t)(LC + i) * 1024 + 256 + h * 64;
#pragma unroll
    for (int d4 = 0; d4 < 16; ++d4)
      ((uint2*)op)[d4] = make_uint2(pack2bf(acc[d4 * 4] * inv, acc[d4 * 4 + 1] * inv), pack2bf(acc[d4 * 4 + 2] * inv, acc[d4 * 4 + 3] * inv));
  }
}

__device__ void ph_na_attn(const P& p, int l) {
  for (int idx = GTID; idx < SEQ * 6; idx += GSZ) {
    int h = idx % 6, i = idx / 6;
    int r = i >> 6, c = i & 63;
    int kr0 = min(max(r - 4, 0), 248), qs = min(max(c - 8, 0), 48);
    float q[64], acc[64];
    const float* qp = p.proj + (size_t)(LC + i) * DIN + OFF_QN + h * 64;
#pragma unroll
    for (int d4 = 0; d4 < 16; ++d4) {
      float4 v = ((const float4*)qp)[d4];
      q[d4 * 4] = v.x; q[d4 * 4 + 1] = v.y; q[d4 * 4 + 2] = v.z; q[d4 * 4 + 3] = v.w;
    }
#pragma unroll
    for (int d = 0; d < 64; ++d) acc[d] = 0.f;
    float m = -1e30f, lsum = 0.f;
    const float* rpb = p.rpb + (size_t)(l * 6 + h) * 15 * 31;
    for (int a = 0; a < 8; ++a) {
      int krow = kr0 + a;
      for (int b = 0; b < 16; ++b) {
        int kcol = qs + b;
        int j = krow * 64 + kcol;
        float bias = rpb[(krow - r + 7) * 31 + (kcol - c + 15)];
        const float* kp = p.proj + (size_t)(LC + j) * DIN + OFF_KN + h * 64;
        const float* vp = p.proj + (size_t)(LC + j) * DIN + OFF_VN + h * 64;
        ATTN_STEP(kp, vp, bias)
      }
    }
    for (int j = 0; j < LC; ++j) {
      const float* kp = p.proj + (size_t)j * DIN + OFF_KN + h * 64;
      const float* vp = p.proj + (size_t)j * DIN + OFF_VN + h * 64;
      ATTN_STEP(kp, vp, 0.f)
    }
    float inv = 1.f / lsum;
    bf16_t* op = p.mixb + (size_t)(LC + i) * 1024 + 640 + h * 64;
#pragma unroll
    for (int d4 = 0; d4 < 16; ++d4)
      ((uint2*)op)[d4] = make_uint2(pack2bf(acc[d4 * 4] * inv, acc[d4 * 4 + 1] * inv), pack2bf(acc[d4 * 4 + 2] * inv, acc[d4 * 4 + 3] * inv));
  }
}

__device__ void ph_ctx_attn(const P& p, int l) {
  for (int idx = GTID; idx < LC * 12; idx += GSZ) {
    int slot = idx % 12, i = idx / 12;
    int qoff, koff, voff, ooff;
    float m, lsum;
    if (slot < 6) {
      int h = slot, g = h / 3;
      qoff = OFF_QW + h * 64; koff = OFF_KW + g * 64; voff = OFF_VW + g * 64; ooff = 256 + h * 64;
      m = p.win_sink[l * 6 + h]; lsum = 1.f;
    } else {
      int h = slot - 6;
      qoff = OFF_QN + h * 64; koff = OFF_KN + h * 64; voff = OFF_VN + h * 64; ooff = 640 + h * 64;
      m = -1e30f; lsum = 0.f;
    }
    float q[64], acc[64];
    const float* qp = p.proj + (size_t)i * DIN + qoff;
#pragma unroll
    for (int d4 = 0; d4 < 16; ++d4) {
      float4 v = ((const float4*)qp)[d4];
      q[d4 * 4] = v.x; q[d4 * 4 + 1] = v.y; q[d4 * 4 + 2] = v.z; q[d4 * 4 + 3] = v.w;
    }
#pragma unroll
    for (int d = 0; d < 64; ++d) acc[d] = 0.f;
    for (int j = 0; j < LC; ++j) {
      const float* kp = p.proj + (size_t)j * DIN + koff;
      const float* vp = p.proj + (size_t)j * DIN + voff;
      ATTN_STEP(kp, vp, 0.f)
    }
    float inv = 1.f / lsum;
    bf16_t* op = p.mixb + (size_t)i * 1024 + ooff;
#pragma unroll
    for (int d4 = 0; d4 < 16; ++d4)
      ((uint2*)op)[d4] = make_uint2(pack2bf(acc[d4 * 4] * inv, acc[d4 * 4 + 1] * inv), pack2bf(acc[d4 * 4 + 2] * inv, acc[d4 * 4 + 3] * inv));
  }
}

__device__ __forceinline__ unsigned ord_key(float s) {
  unsigned u = __float_as_uint(s);
  return (u & 0x80000000u) ? ~u : (u | 0x80000000u);
}
__device__ __forceinline__ float ord_val(unsigned pk) {
  unsigned u = pk & ~127u;
  unsigned b = (u & 0x80000000u) ? (u & 0x7fffffffu) : ~u;
  return __uint_as_float(b);
}
__device__ __forceinline__ void ce_desc(unsigned& a, unsigned& b) {
  unsigned mx = a > b ? a : b, mn = a > b ? b : a;
  a = mx; b = mn;
}
__device__ __forceinline__ void sort16_desc(unsigned (&v)[16]) {
#pragma unroll
  for (int k = 2; k <= 16; k <<= 1) {
#pragma unroll
    for (int j = k >> 1; j > 0; j >>= 1) {
#pragma unroll
      for (int i = 0; i < 16; ++i) {
        int m = i ^ j;
        if (m > i) {
          if ((i & k) == 0) ce_desc(v[i], v[m]); else ce_desc(v[m], v[i]);
        }
      }
    }
  }
}
__device__ __forceinline__ void merge16_desc(unsigned (&a)[16], const unsigned (&b)[16]) {
#pragma unroll
  for (int i = 0; i < 16; ++i) { unsigned o = b[15 - i]; a[i] = a[i] > o ? a[i] : o; }
#pragma unroll
  for (int j = 8; j > 0; j >>= 1) {
#pragma unroll
    for (int i = 0; i < 16; ++i) {
      int m = i ^ j;
      if (m > i) ce_desc(a[i], a[m]);
    }
  }
}

__device__ void ph_prep_peer(const P& p) {
  const size_t n4 = (size_t)2 * 16384 * 1024 / 4;
  for (size_t i = GTID; i < n4; i += GSZ) {
    float4 a = ((const float4*)p.pu)[i], b = ((const float4*)p.pv)[i];
    ((uint2*)p.ub16)[i] = make_uint2(pack2bf(a.x, a.y), pack2bf(a.z, a.w));
    ((uint2*)p.vb16)[i] = make_uint2(pack2bf(b.x, b.y), pack2bf(b.z, b.w));
  }
  for (int i = GTID; i < 2 * 128 * 128; i += GSZ) { p.k1b[i] = f2bf(p.k1[i]); p.k2b[i] = f2bf(p.k2[i]); }
}

struct EpiPeerTopk {
  int l;
  __device__ __forceinline__ void operator()(const P& p, f32x4 (&acc)[4][4], int m0, int n0, int wm, int wn, int lane, char* smem) const {
    const int tid = threadIdx.x, g = lane >> 4, lr = lane & 15;
    const int nt = n0 >> 7, head = nt >> 1, hf = nt & 1;
    char* qimg = smem;
    char* kimg = smem + 34816;
    {
      char* qw = qimg + (wm * 64 + 4 * g) * 272 + (wn * 64 + lr) * 2;
#pragma unroll
      for (int i = 0; i < 4; ++i)
#pragma unroll
        for (int r = 0; r < 4; ++r)
#pragma unroll
          for (int j = 0; j < 4; ++j) *(bf16_t*)(qw + (16 * i + r) * 272 + 32 * j) = f2bf(acc[i][j][r]);
      const bf16_t* kk = (hf ? p.k2b : p.k1b) + (size_t)l * 16384 + (tid >> 4) * 128 + (tid & 15) * 8;
      char* kw = kimg + (tid >> 4) * 272 + (tid & 15) * 16;
#pragma unroll
      for (int i = 0; i < 8; ++i) *(uint4*)(kw + i * 16 * 272) = *(const uint4*)(kk + i * 16 * 128);
    }
    __syncthreads();
#pragma unroll
    for (int i = 0; i < 4; ++i)
#pragma unroll
      for (int j = 0; j < 4; ++j) acc[i][j] = (f32x4){0.f, 0.f, 0.f, 0.f};
    {
      const char* qa = qimg + (wm * 64 + lr) * 272 + g * 16;
      const char* kb = kimg + (wn * 64 + lr) * 272 + g * 16;
#pragma unroll
      for (int s = 0; s < 4; ++s) {
        bf16x8 af[4], bfr[4];
#pragma unroll
        for (int i = 0; i < 4; ++i) af[i] = *(const bf16x8*)(qa + i * 16 * 272 + s * 64);
#pragma unroll
        for (int j = 0; j < 4; ++j) bfr[j] = *(const bf16x8*)(kb + j * 16 * 272 + s * 64);
#pragma unroll
        for (int i = 0; i < 4; ++i)
#pragma unroll
          for (int j = 0; j < 4; ++j) acc[i][j] = __builtin_amdgcn_mfma_f32_16x16x32_bf16(af[i], bfr[j], acc[i][j], 0, 0, 0);
      }
    }
    __syncthreads();
    unsigned* simg = (unsigned*)smem;
    {
      unsigned* sw = simg + (wm * 64 + 4 * g) * 129 + wn * 64 + lr;
#pragma unroll
      for (int i = 0; i < 4; ++i)
#pragma unroll
        for (int r = 0; r < 4; ++r)
#pragma unroll
          for (int j = 0; j < 4; ++j)
            sw[(16 * i + r) * 129 + 16 * j] = (ord_key(acc[i][j][r]) & ~127u) | (unsigned)(wn * 64 + 16 * j + lr);
    }
    __syncthreads();
    const int row = tid & 127, half = tid >> 7;
    unsigned top[16];
    {
      const unsigned* sr = simg + row * 129 + half * 64;
#pragma unroll
      for (int k = 0; k < 16; ++k) top[k] = sr[k];
      sort16_desc(top);
#pragma unroll 1
      for (int gi = 1; gi < 4; ++gi) {
        unsigned v1[16];
#pragma unroll
        for (int k = 0; k < 16; ++k) v1[k] = sr[gi * 16 + k];
        sort16_desc(v1);
        merge16_desc(top, v1);
      }
    }
    __syncthreads();
    if (half == 1) {
#pragma unroll
      for (int k = 0; k < 16; ++k) simg[k * 128 + row] = top[k];
    }
    __syncthreads();
    if (half == 0) {
      unsigned o[16];
#pragma unroll
      for (int k = 0; k < 16; ++k) o[k] = simg[k * 128 + row];
      merge16_desc(top, o);
      uint4* dst = (uint4*)(p.pk + (((size_t)(m0 + row) * 8 + head) * 2 + hf) * 16);
#pragma unroll
      for (int k = 0; k < 4; ++k) dst[k] = make_uint4(top[4 * k], top[4 * k + 1], top[4 * k + 2], top[4 * k + 3]);
    }
  }
};

__device__ const unsigned char CAND_A[64] = {0,0,0,0,0,0,0,0,0,0,0,0,0,0,0,0, 1,1,1,1,1,1,1,1, 2,2,2,2,2, 3,3,3,3, 4,4,4, 5,5, 6,6, 7,7,
                                             8,9,10,11,12,13,14,15, 0,0,0,0,0,0,0,0,0,0,0,0,0,0};
__device__ const unsigned char CAND_B[64] = {0,1,2,3,4,5,6,7,8,9,10,11,12,13,14,15, 0,1,2,3,4,5,6,7, 0,1,2,3,4, 0,1,2,3, 0,1,2, 0,1, 0,1, 0,1,
                                             0,0,0,0,0,0,0,0, 0,0,0,0,0,0,0,0,0,0,0,0,0,0};

__device__ void ph_peer_apply2(const P& p, int l, int t0, char* smem) {
  const int tid = threadIdx.x, lane = tid & 63, wv = tid >> 6;
  int* lds_e = (int*)(smem + wv * 1024);
  float* lds_g = (float*)(smem + wv * 1024 + 512);
  const bf16_t* U = p.ub16 + (size_t)l * 16384 * 1024;
  const bf16_t* V = p.vb16 + (size_t)l * 16384 * 1024;
  const float* n2g = p.norm2_g + l * 1024;
  const int ca = CAND_A[lane], cb = CAND_B[lane];
  for (int tk = t0 + blockIdx.x * 4 + wv; tk < TT; tk += gridDim.x * 4) {
    const float* mod = p.mod + (l * 2 + (tk < LC ? 1 : 0)) * 6144;
    float xv[16], hv[16];
    {
      const float4* xp = (const float4*)(p.xall + (size_t)tk * 1024);
      float ss = 0.f;
#pragma unroll
      for (int i = 0; i < 2; ++i)
#pragma unroll
        for (int q = 0; q < 2; ++q) {
          float4 v = xp[(i * 64 + lane) * 2 + q];
          xv[i * 8 + q * 4 + 0] = v.x; xv[i * 8 + q * 4 + 1] = v.y; xv[i * 8 + q * 4 + 2] = v.z; xv[i * 8 + q * 4 + 3] = v.w;
          ss += v.x * v.x + v.y * v.y + v.z * v.z + v.w * v.w;
        }
      ss = wave_sum(ss);
      float rinv = rsqrtf(ss * (1.f / 1024.f) + EPS);
#pragma unroll
      for (int i = 0; i < 2; ++i)
#pragma unroll
        for (int k = 0; k < 8; ++k) {
          int d = (i * 64 + lane) * 8 + k;
          hv[i * 8 + k] = xv[i * 8 + k] * rinv * n2g[d] * (1.f + mod[4096 + d]) + mod[3072 + d];
        }
    }
    for (int head = 0; head < 8; ++head) {
      const unsigned* pk = p.pk + ((size_t)tk * 8 + head) * 32;
      unsigned p1 = pk[ca], p2 = pk[16 + cb];
      float sum = lane < 50 ? ord_val(p1) + ord_val(p2) : -3.0e38f;
      int eid = (int)(p1 & 127u) * 128 + (int)(p2 & 127u);
      int rank = 0;
      for (int m = 0; m < 50; ++m) {
        float sm = __shfl(sum, m);
        rank += (sm > sum || (sm == sum && m < lane)) ? 1 : 0;
      }
      float mx = sum;
#pragma unroll
      for (int o = 32; o > 0; o >>= 1) mx = fmaxf(mx, __shfl_xor(mx, o));
      bool sel = (lane < 50) && (rank < 16);
      float e = sel ? __expf(sum - mx) : 0.f;
      float tot = wave_sum(e);
      if (sel) { lds_e[head * 16 + rank] = eid; lds_g[head * 16 + rank] = e / tot; }
    }
    float acc[16];
#pragma unroll
    for (int k = 0; k < 16; ++k) acc[k] = 0.f;
    for (int e0 = 0; e0 < 128; e0 += 4) {
      uint4 ur[4][2], vr[4][2];
      float gt[4];
#pragma unroll
      for (int k = 0; k < 4; ++k) {
        int ex = __builtin_amdgcn_readfirstlane(lds_e[e0 + k]);
        gt[k] = lds_g[e0 + k];
        const uint4* up = (const uint4*)(U + (size_t)ex * 1024);
        const uint4* vp = (const uint4*)(V + (size_t)ex * 1024);
        ur[k][0] = up[lane]; ur[k][1] = up[64 + lane];
        vr[k][0] = vp[lane]; vr[k][1] = vp[64 + lane];
      }
#pragma unroll
      for (int k = 0; k < 4; ++k) {
        float dot = 0.f;
#pragma unroll
        for (int i = 0; i < 2; ++i) {
          unsigned w[4] = {ur[k][i].x, ur[k][i].y, ur[k][i].z, ur[k][i].w};
#pragma unroll
          for (int q = 0; q < 4; ++q) {
            dot += __uint_as_float(w[q] << 16) * hv[i * 8 + 2 * q];
            dot += __uint_as_float(w[q] & 0xffff0000u) * hv[i * 8 + 2 * q + 1];
          }
        }
        dot = wave_sum(dot);
        float a = gt[k] * gelu_f(dot);
#pragma unroll
        for (int i = 0; i < 2; ++i) {
          unsigned w[4] = {vr[k][i].x, vr[k][i].y, vr[k][i].z, vr[k][i].w};
#pragma unroll
          for (int q = 0; q < 4; ++q) {
            acc[i * 8 + 2 * q] += a * __uint_as_float(w[q] << 16);
            acc[i * 8 + 2 * q + 1] += a * __uint_as_float(w[q] & 0xffff0000u);
          }
        }
      }
    }
    {
      float4* xp = (float4*)(p.xall + (size_t)tk * 1024);
#pragma unroll
      for (int i = 0; i < 2; ++i)
#pragma unroll
        for (int q = 0; q < 2; ++q) {
          int d = (i * 64 + lane) * 8 + q * 4;
          float4 gg = *(const float4*)(mod + 5120 + d);
          float4 o;
          o.x = xv[i * 8 + q * 4 + 0] + gg.x * acc[i * 8 + q * 4 + 0];
          o.y = xv[i * 8 + q * 4 + 1] + gg.y * acc[i * 8 + q * 4 + 1];
          o.z = xv[i * 8 + q * 4 + 2] + gg.z * acc[i * 8 + q * 4 + 2];
          o.w = xv[i * 8 + q * 4 + 3] + gg.w * acc[i * 8 + q * 4 + 3];
          xp[(i * 64 + lane) * 2 + q] = o;
        }
    }
  }
}

constexpr int N_PH_PRE = 2;
constexpr int N_PH_LAYER = 15;
constexpr int N_PHASES = N_PH_PRE + 2 * N_PH_LAYER + 1;

__device__ __forceinline__ void run_phase(const P& p, int ph, float* smem) {
  if (ph == 0) { ph_mod(p); return; }
  if (ph == 1) { ph_copy_in(p); ph_prep(p, smem); ph_lru_prepw(p); ph_prep_peer(p); return; }
  if (ph == N_PHASES - 1) { ph_copy_out(p); return; }
  int l = (ph - N_PH_PRE) / N_PH_LAYER, s = (ph - N_PH_PRE) % N_PH_LAYER;
  int t0 = (l == 0) ? 0 : LC;
  switch (s) {
    case 0: ph_norm_mod(p, l, 0, 0, smem); break;
    case 1: gemm_bf16_128(p, p.hb, p.w_in_t + (size_t)l * 1024 * DIN, 1024, 0, TT, DIN, (char*)smem, EpiStoreF32{p.proj, DIN}); break;
    case 2: ph_qknorm_rope(p, l); break;
    case 3: ph_lru<1>(p, l, (char*)smem); break;
    case 4: ph_lru<2>(p, l, (char*)smem); break;
    case 5: break;
    case 6: break;
#ifndef NO_NAIVE_ATTN
    case 7: ph_win_attn(p, l); break;
    case 8: ph_na_attn(p, l); break;
    case 9: if (l == 0) ph_ctx_attn(p, l); break;
#endif
    case 10: gemm_bf16_128(p, p.mixb, p.w_out_t + (size_t)l * 1024 * 1024, 1024, t0, TT, 1024, (char*)smem, EpiResid{l, 2048}); break;
    case 11: ph_norm_mod(p, l, 1, t0, smem); break;
    case 12: gemm_bf16_128(p, p.hb, p.wq_t + (size_t)l * 1024 * NPQ, 1024, t0, TT, NPQ, (char*)smem, EpiPeerTopk{l}); break;
    case 13: break;
    case 14: ph_peer_apply2(p, l, t0, (char*)smem); break;
  }
}

#if !SINGLE_LAUNCH
__global__ void __launch_bounds__(256) k_phase(P p, int ph) {
  __shared__ __attribute__((aligned(16))) float smem[18432];
  run_phase(p, ph, smem);
}
#endif

__global__ void __launch_bounds__(256) k_mega(P p) {
  __shared__ __attribute__((aligned(16))) float smem[18432];
  cg::grid_group grid = cg::this_grid();
  for (int ph = 0; ph < N_PHASES; ++ph) {
    run_phase(p, ph, smem);
    if (ph + 1 < N_PHASES) grid.sync();
  }
}

extern "C" void kernel_launch(void* const* d_in, const int* in_sizes, int n_in, void* d_out, int out_size, void* d_ws,
                              size_t ws_size, hipStream_t stream) {
  P p{};
  const float** fp = (const float**)&p;
  for (int i = 0; i < 28; ++i) fp[i] = (const float*)d_in[i];
  p.out = (float*)d_out;
  float* w = (float*)d_ws;
  size_t o = 0;
  auto carve = [&](size_t n) { float* r = w + o; o += (n + 63) & ~(size_t)63; return r; };
  p.mod = carve(4 * 6144);
  p.xall = carve((size_t)TT * 1024);
  p.h = carve((size_t)TT * 1024);
  p.proj = carve((size_t)TT * DIN);
  p.mixb = (bf16_t*)carve((size_t)TT * 512);
  p.hb = (bf16_t*)carve((size_t)TT * 512);
  p.w_in_t = (bf16_t*)carve((size_t)1024 * DIN);
  p.w_out_t = (bf16_t*)carve((size_t)1024 * 1024);
  p.wq_t = (bf16_t*)carve((size_t)1024 * NPQ);
  p.lruw_t = (bf16_t*)carve((size_t)2 * 2 * 4 * 2 * 4096 / 2);
  p.lagg = carve((size_t)2 * NCHUNK * 256 * 2);
  p.pk = (unsigned*)carve((size_t)TT * 256);
  p.ub16 = (bf16_t*)carve((size_t)16384 * 1024);
  p.vb16 = (bf16_t*)carve((size_t)16384 * 1024);
  p.k1b = (bf16_t*)carve(16384);
  p.k2b = (bf16_t*)carve(16384);
  if (o * 4 > ws_size) { fprintf(stderr, "workspace too small: need %zu have %zu\n", o * 4, ws_size); return; }
#if SINGLE_LAUNCH
  static int grid_blocks = 0;
  if (!grid_blocks) {
    int dev = 0, cus = 0, per_cu = 0;
    hipGetDevice(&dev);
    hipDeviceGetAttribute(&cus, hipDeviceAttributeMultiprocessorCount, dev);
    hipOccupancyMaxActiveBlocksPerMultiprocessor(&per_cu, k_mega, 256, 0);
    if (per_cu > 2) per_cu = 2;
    grid_blocks = cus * per_cu;
  }
  void* args[] = {&p};
  hipError_t e = hipLaunchCooperativeKernel((void*)k_mega, dim3(grid_blocks), dim3(256), args, 0, stream);
  if (e != hipSuccess) fprintf(stderr, "cooperative launch failed: %s (grid %d)\n", hipGetErrorString(e), grid_blocks);
#else
  for (int ph = 0; ph < N_PHASES; ++ph) {
    if ((ph - N_PH_PRE) % N_PH_LAYER == 9 && ph >= N_PH_PRE + N_PH_LAYER && ph != N_PHASES - 1) continue;
    k_phase<<<2048, 256, 0, stream>>>(p, ph);
  }
#endif
}
```

```cpp
#include <hip/hip_runtime.h>
#include <hip/hip_cooperative_groups.h>
#include <stdint.h>
#include <stdio.h>
namespace cg = cooperative_groups;

#ifndef SINGLE_LAUNCH
#define SINGLE_LAUNCH 1
#endif

constexpr int DM = 1024, SEQ = 16384, LC = 256, TT = SEQ + LC, DIN = 2304, NPQ = 2048;
constexpr int OFF_XA = 0, OFF_GA = 256, OFF_QW = 512, OFF_KW = 896, OFF_VW = 1024, OFF_QN = 1152, OFF_KN = 1536, OFF_VN = 1920;
constexpr float EPS = 1e-6f;

struct P {
  const float *x, *c, *ctx, *c_ctx, *w_mod, *b_mod, *norm1_g, *norm2_g, *w_in, *w_out,
      *conv_w, *conv_b, *wa, *ba, *wx, *bx, *lam, *win_qn, *win_kn, *win_sink, *na_qn, *na_kn, *rpb,
      *wq, *k1, *k2, *pu, *pv;
  float* out;
  float *mod, *xall, *proj;
  unsigned short* projb;
  unsigned* pk;
  unsigned short *ub16, *vb16, *k1b, *k2b;
  unsigned short *hb, *mixb, *w_in_t, *w_out_t, *wq_t, *lruw_t;
  float* lagg;
};

typedef unsigned short bf16_t;
typedef __attribute__((ext_vector_type(8))) short bf16x8;
typedef __attribute__((ext_vector_type(4))) float f32x4;
__device__ __forceinline__ unsigned short f2bf(float f) {
  unsigned u = __float_as_uint(f);
  u += 0x7fffu + ((u >> 16) & 1u);
  return (unsigned short)(u >> 16);
}
__device__ __forceinline__ unsigned pack2bf(float a, float b) { return (unsigned)f2bf(a) | ((unsigned)f2bf(b) << 16); }
__device__ __forceinline__ float bf2f(unsigned short h) { return __uint_as_float(((unsigned)h) << 16); }


__device__ __forceinline__ float silu_f(float x) { return x / (1.f + __expf(-x)); }
__device__ __forceinline__ float sigmoid_f(float x) { return 1.f / (1.f + __expf(-x)); }
__device__ __forceinline__ float gelu_f(float x) {
  float u = 0.7978845608028654f * (x + 0.044715f * x * x * x);
  float e = __expf(2.f * u);
  float th = 1.f - 2.f / (e + 1.f);
  return 0.5f * x * (1.f + th);
}
__device__ __forceinline__ float wave_sum(float v) {
#pragma unroll
  for (int o = 32; o > 0; o >>= 1) v += __shfl_xor(v, o);
  return v;
}

#define GTID (blockIdx.x * blockDim.x + threadIdx.x)
#define GSZ (gridDim.x * blockDim.x)

__device__ void ph_mod(const P& p) {
  for (int idx = GTID; idx < 4 * 6144; idx += GSZ) {
    int n = idx % 6144, lw = idx / 6144, l = lw >> 1, which = lw & 1;
    const float* vec = which ? p.c_ctx : p.c;
    const float* w = p.w_mod + (size_t)l * 1024 * 6144 + n;
    float acc = 0.f;
    for (int k = 0; k < 1024; ++k) acc += silu_f(vec[k]) * w[(size_t)k * 6144];
    p.mod[idx] = acc + p.b_mod[l * 6144 + n];
  }
}

__device__ void ph_copy_in(const P& p) {
  const float4* xs = (const float4*)p.x;
  const float4* cs = (const float4*)p.ctx;
  float4* d = (float4*)p.xall;
  for (int i = GTID; i < TT * 256; i += GSZ) d[i] = (i < LC * 256) ? cs[i] : xs[i - LC * 256];
}

__device__ void ph_copy_out(const P& p) {
  const float4* s = (const float4*)(p.xall + (size_t)LC * 1024);
  float4* d = (float4*)p.out;
  for (int i = GTID; i < SEQ * 256; i += GSZ) d[i] = s[i];
}

__device__ void ph_norm_mod(const P& p, int l, int which_norm, int t0, float* smem) {
  const float* g = (which_norm ? p.norm2_g : p.norm1_g) + l * 1024;
  const int sh_off = which_norm ? 3072 : 0, sc_off = which_norm ? 4096 : 1024;
  const int tid = threadIdx.x;
  for (int t = t0 + blockIdx.x; t < TT; t += gridDim.x) {
    const float* mod = p.mod + (l * 2 + (t < LC ? 1 : 0)) * 6144;
    float4 v = ((const float4*)(p.xall + (size_t)t * 1024))[tid];
    float ss = wave_sum(v.x * v.x + v.y * v.y + v.z * v.z + v.w * v.w);
    __syncthreads();
    if ((tid & 63) == 0) smem[tid >> 6] = ss;
    __syncthreads();
    float tot = smem[0] + smem[1] + smem[2] + smem[3];
    float rinv = rsqrtf(tot * (1.f / 1024.f) + EPS);
    float4 gg = ((const float4*)g)[tid];
    float4 sc = ((const float4*)(mod + sc_off))[tid];
    float4 sh = ((const float4*)(mod + sh_off))[tid];
    float4 o;
    o.x = v.x * rinv * gg.x * (1.f + sc.x) + sh.x;
    o.y = v.y * rinv * gg.y * (1.f + sc.y) + sh.y;
    o.z = v.z * rinv * gg.z * (1.f + sc.z) + sh.z;
    o.w = v.w * rinv * gg.w * (1.f + sc.w) + sh.w;
    ((uint2*)(p.hb + (size_t)t * 1024))[tid] = make_uint2(pack2bf(o.x, o.y), pack2bf(o.z, o.w));
  }
}

__device__ void prep_transpose(const float* W, bf16_t* Wt, int K, int N, int item0, int nitems_total, float* smem) {
  (void)nitems_total;
  float(*ts)[65] = (float(*)[65])smem;
  const int tid = threadIdx.x;
  const int tn = N / 64, nt = (K / 64) * tn;
  for (int it = blockIdx.x; it < nt; it += gridDim.x) {
    int k0 = (it / tn) * 64, n0 = (it % tn) * 64;
    __syncthreads();
#pragma unroll
    for (int i = 0; i < 16; ++i) {
      int r = (tid >> 6) + i * 4, c = tid & 63;
      ts[r][c] = W[(size_t)(k0 + r) * N + n0 + c];
    }
    __syncthreads();
#pragma unroll
    for (int i = 0; i < 16; ++i) {
      int r = (tid >> 6) + i * 4, c = tid & 63;
      Wt[(size_t)(n0 + r) * K + k0 + c] = f2bf(ts[c][r]);
    }
  }
  (void)item0;
}

__device__ void ph_prep(const P& p, float* smem) {
  for (int l = 0; l < 2; ++l) {
    prep_transpose(p.w_in + (size_t)l * 1024 * DIN, p.w_in_t + (size_t)l * 1024 * DIN, 1024, DIN, 0, 0, smem);
    prep_transpose(p.w_out + (size_t)l * 1024 * 1024, p.w_out_t + (size_t)l * 1024 * 1024, 1024, 1024, 0, 0, smem);
    prep_transpose(p.wq + (size_t)l * 1024 * NPQ, p.wq_t + (size_t)l * 1024 * NPQ, 1024, NPQ, 0, 0, smem);
  }
}

struct EpiStoreF32 {
  float* C; int ldc;
  __device__ __forceinline__ void operator()(const P& p, f32x4 (&acc)[4][4], int m0, int n0, int wm, int wn, int lane, char* smem) const {
    const int mw0 = m0 + wm * 64, nw0 = n0 + wn * 64;
#pragma unroll
    for (int i = 0; i < 4; ++i)
#pragma unroll
      for (int r = 0; r < 4; ++r) {
        int row = mw0 + 16 * i + (lane >> 4) * 4 + r;
#pragma unroll
        for (int j = 0; j < 4; ++j) C[(size_t)row * ldc + nw0 + 16 * j + (lane & 15)] = acc[i][j][r];
      }
  }
};
struct EpiProjSplit {
  __device__ __forceinline__ void operator()(const P& p, f32x4 (&acc)[4][4], int m0, int n0, int wm, int wn, int lane, char* smem) const {
    const int mw0 = m0 + wm * 64, nw0 = n0 + wn * 64;
#pragma unroll
    for (int i = 0; i < 4; ++i)
#pragma unroll
      for (int r = 0; r < 4; ++r) {
        int row = mw0 + 16 * i + (lane >> 4) * 4 + r;
#pragma unroll
        for (int j = 0; j < 4; ++j) {
          int col = nw0 + 16 * j + (lane & 15);
          if (n0 < 512) p.proj[(size_t)row * 512 + col] = acc[i][j][r];
          else p.projb[(size_t)row * DIN + col] = f2bf(acc[i][j][r]);
        }
      }
  }
};
struct EpiResid {
  int l, gofs;
  __device__ __forceinline__ void operator()(const P& p, f32x4 (&acc)[4][4], int m0, int n0, int wm, int wn, int lane, char* smem) const {
    const int mw0 = m0 + wm * 64, nw0 = n0 + wn * 64;
#pragma unroll
    for (int i = 0; i < 4; ++i)
#pragma unroll
      for (int r = 0; r < 4; ++r) {
        int row = mw0 + 16 * i + (lane >> 4) * 4 + r;
        const float* gt = p.mod + (l * 2 + (row < LC ? 1 : 0)) * 6144 + gofs;
#pragma unroll
        for (int j = 0; j < 4; ++j) {
          int col = nw0 + 16 * j + (lane & 15);
          p.xall[(size_t)row * 1024 + col] += gt[col] * acc[i][j][r];
        }
      }
  }
};

template <class Epi>
__device__ void gemm_bf16_128(const P& p, const bf16_t* __restrict__ A, const bf16_t* __restrict__ Bt, int K, int m_begin, int m_end,
                              int N, char* smem, const Epi& epi) {
  const int tid = threadIdx.x, lane = tid & 63, wv = tid >> 6, wm = wv >> 1, wn = wv & 1;
  const int tiles_n = N / 128, tiles_m = (m_end - m_begin) / 128;
  const int nk = K / 64;
  const int lrow = lane & 15, lq = lane >> 4;
  for (int tile = blockIdx.x; tile < tiles_m * tiles_n; tile += gridDim.x) {
    const int m0 = m_begin + (tile / tiles_n) * 128, n0 = (tile % tiles_n) * 128;
    f32x4 acc[4][4];
#pragma unroll
    for (int i = 0; i < 4; ++i)
#pragma unroll
      for (int j = 0; j < 4; ++j) acc[i][j] = (f32x4){0.f, 0.f, 0.f, 0.f};
    uint4 ra[4], rb[4];
    const bf16_t* Ag = A + (size_t)m0 * K;
    const bf16_t* Bg = Bt + (size_t)n0 * K;
#pragma unroll
    for (int i = 0; i < 4; ++i) {
      int id = tid + 256 * i, row = id >> 3, c = id & 7;
      ra[i] = *(const uint4*)(Ag + (size_t)row * K + c * 8);
      rb[i] = *(const uint4*)(Bg + (size_t)row * K + c * 8);
    }
#pragma unroll
    for (int i = 0; i < 4; ++i) {
      int id = tid + 256 * i, row = id >> 3, c = id & 7;
      int off = row * 128 + ((c ^ (row & 7)) << 4);
      *(uint4*)(smem + off) = ra[i];
      *(uint4*)(smem + 16384 + off) = rb[i];
    }
    __syncthreads();
    for (int kt = 0; kt < nk; ++kt) {
      const int cur = (kt & 1) * 32768, nxt = ((kt + 1) & 1) * 32768;
      if (kt + 1 < nk) {
#pragma unroll
        for (int i = 0; i < 4; ++i) {
          int id = tid + 256 * i, row = id >> 3, c = id & 7;
          ra[i] = *(const uint4*)(Ag + (size_t)row * K + (kt + 1) * 64 + c * 8);
          rb[i] = *(const uint4*)(Bg + (size_t)row * K + (kt + 1) * 64 + c * 8);
        }
      }
#pragma unroll
      for (int s = 0; s < 2; ++s) {
        bf16x8 af[4], bfr[4];
#pragma unroll
        for (int i = 0; i < 4; ++i) {
          int row = wm * 64 + 16 * i + lrow;
          af[i] = *(const bf16x8*)(smem + cur + row * 128 + (((4 * s + lq) ^ (row & 7)) << 4));
        }
#pragma unroll
        for (int j = 0; j < 4; ++j) {
          int row = wn * 64 + 16 * j + lrow;
          bfr[j] = *(const bf16x8*)(smem + cur + 16384 + row * 128 + (((4 * s + lq) ^ (row & 7)) << 4));
        }
#pragma unroll
        for (int i = 0; i < 4; ++i)
#pragma unroll
          for (int j = 0; j < 4; ++j) acc[i][j] = __builtin_amdgcn_mfma_f32_16x16x32_bf16(af[i], bfr[j], acc[i][j], 0, 0, 0);
      }
      if (kt + 1 < nk) {
#pragma unroll
        for (int i = 0; i < 4; ++i) {
          int id = tid + 256 * i, row = id >> 3, c = id & 7;
          int off = row * 128 + ((c ^ (row & 7)) << 4);
          *(uint4*)(smem + nxt + off) = ra[i];
          *(uint4*)(smem + nxt + 16384 + off) = rb[i];
        }
      }
      __syncthreads();
    }
    epi(p, acc, m0, n0, wm, wn, lane, smem);
    __syncthreads();
  }
}

constexpr int NCHUNK = TT / 64;
__device__ __forceinline__ int lru_pos(int dir, int c) { return dir == 0 ? c : (c < 4 ? 3 - c : 4 + (NCHUNK - 1 - c)); }

__device__ void ph_lru_prepw(const P& p) {
  for (int idx = GTID; idx < 2 * 2 * 4 * 2 * 4096; idx += GSZ) {
    int d = idx & 63, e = (idx >> 6) & 63, mtx = (idx >> 12) & 1, rest = idx >> 13;
    const float* w = (mtx ? p.wx : p.wa) + (size_t)rest * 4096;
    p.lruw_t[idx] = f2bf(w[d * 64 + e]);
  }
}

template <int PASS>
__device__ void lru_item(const P& p, int l, int cidx, int kb, char* smem) {
  bf16_t* u_img = (bf16_t*)smem;
  float* ab_a = (float*)(smem + 8192);
  float* ab_b = (float*)(smem + 8192 + 16384);
  float* hsum = (float*)(smem + 8192 + 32768);
  float* segagg = (float*)(smem + 8192 + 49152);
  float* ccarry = (float*)(smem + 8192 + 49152 + 2048);
  const int tid = threadIdx.x, lane = tid & 63, wv = tid >> 6, g = lane >> 4, lr = lane & 15;
  const int t0 = cidx * 64;
  const int lo = t0 < LC ? 0 : LC, hi = t0 < LC ? LC : TT;
  __syncthreads();
  {
    const int ch = tid & 63, c = kb * 64 + ch;
    const float cb = p.conv_b[l * 256 + c];
    float cw[4];
#pragma unroll
    for (int k = 0; k < 4; ++k) cw[k] = p.conv_w[(l * 4 + k) * 256 + c];
#pragma unroll
    for (int i = 0; i < 16; ++i) {
      int row = (tid >> 6) + 4 * i, t = t0 + row;
      float acc = cb;
#pragma unroll
      for (int k = 0; k < 4; ++k) {
        int tt = t + k - 2;
        if (tt >= lo && tt < hi) acc += cw[k] * p.proj[(size_t)tt * 512 + OFF_XA + c];
      }
      u_img[row * 64 + ((((ch >> 3) ^ (row & 7)) << 3) | (ch & 7))] = f2bf(acc);
    }
  }
  if (PASS == 2) {
    if (tid < 128) {
      const int ch = tid & 63, dir = tid >> 6;
      const int pos = lru_pos(dir, cidx);
      const float2* ag = (const float2*)p.lagg + (size_t)dir * NCHUNK * 256 + kb * 64 + ch;
      float h = 0.f;
      for (int q = 0; q < pos; ++q) {
        float2 v = ag[(size_t)q * 256];
        h = v.x * h + v.y;
      }
      ccarry[dir * 64 + ch] = h;
    }
  }
  __syncthreads();
  for (int dir = 0; dir < 2; ++dir) {
    const int pd = l * 2 + dir;
    {
      f32x4 ga[4], gx[4];
#pragma unroll
      for (int i = 0; i < 4; ++i) { ga[i] = (f32x4){0.f, 0.f, 0.f, 0.f}; gx[i] = (f32x4){0.f, 0.f, 0.f, 0.f}; }
      const bf16_t* wbase = p.lruw_t + (size_t)((pd * 4 + kb) * 2) * 4096 + (16 * wv + lr) * 64 + 8 * g;
#pragma unroll
      for (int s = 0; s < 2; ++s) {
        bf16x8 ba_ = *(const bf16x8*)(wbase + 32 * s);
        bf16x8 bx_ = *(const bf16x8*)(wbase + 4096 + 32 * s);
#pragma unroll
        for (int i = 0; i < 4; ++i) {
          int row = 16 * i + lr;
          bf16x8 af = *(const bf16x8*)((const char*)u_img + row * 128 + (((4 * s + g) ^ (row & 7)) << 4));
          ga[i] = __builtin_amdgcn_mfma_f32_16x16x32_bf16(af, ba_, ga[i], 0, 0, 0);
          gx[i] = __builtin_amdgcn_mfma_f32_16x16x32_bf16(af, bx_, gx[i], 0, 0, 0);
        }
      }
      const int ch = 16 * wv + lr, c = kb * 64 + ch;
      const float bav = p.ba[pd * 256 + c], bxv = p.bx[pd * 256 + c];
      const float sp = log1pf(expf(-p.lam[pd * 256 + c]));
#pragma unroll
      for (int i = 0; i < 4; ++i)
#pragma unroll
        for (int r = 0; r < 4; ++r) {
          int row = 16 * i + 4 * g + r;
          float rr = sigmoid_f(ga[i][r] + bav), ig = sigmoid_f(gx[i][r] + bxv);
          float log_a = -8.f * rr * sp;
          float a = __expf(log_a);
          float uu = bf2f(u_img[row * 64 + ((((ch >> 3) ^ (row & 7)) << 3) | (ch & 7))]);
          float b = sqrtf(-expm1f(2.f * log_a)) * ig * uu;
          ab_a[row * 64 + ch] = a;
          ab_b[row * 64 + ch] = b;
        }
    }
    __syncthreads();
    {
      const int ch = tid & 63, seg = tid >> 6;
      float Pr = 1.f, H = 0.f;
#pragma unroll
      for (int i = 0; i < 16; ++i) {
        int row = dir == 0 ? seg * 16 + i : seg * 16 + 15 - i;
        float a = ab_a[row * 64 + ch], b = ab_b[row * 64 + ch];
        H = a * H + b;
        Pr *= a;
      }
      segagg[(seg * 64 + ch) * 2] = Pr;
      segagg[(seg * 64 + ch) * 2 + 1] = H;
      __syncthreads();
      if (PASS == 1) {
        if (seg == 0) {
          float A = 1.f, B = 0.f;
#pragma unroll
          for (int s2 = 0; s2 < 4; ++s2) {
            int sg = dir == 0 ? s2 : 3 - s2;
            float pa = segagg[(sg * 64 + ch) * 2], pb = segagg[(sg * 64 + ch) * 2 + 1];
            B = pa * B + pb;
            A *= pa;
          }
          float2* ag = (float2*)p.lagg + ((size_t)dir * NCHUNK + lru_pos(dir, cidx)) * 256 + kb * 64 + ch;
          *ag = make_float2(A, B);
        }
      } else {
        float h = ccarry[dir * 64 + ch];
#pragma unroll
        for (int s2 = 0; s2 < 3; ++s2) {
          int sg = dir == 0 ? s2 : 3 - s2;
          bool before = dir == 0 ? (sg < seg) : (sg > seg);
          if (before) h = segagg[(sg * 64 + ch) * 2] * h + segagg[(sg * 64 + ch) * 2 + 1];
        }
#pragma unroll
        for (int i = 0; i < 16; ++i) {
          int row = dir == 0 ? seg * 16 + i : seg * 16 + 15 - i;
          float a = ab_a[row * 64 + ch], b = ab_b[row * 64 + ch];
          h = a * h + b;
          if (dir == 0) hsum[row * 64 + ch] = h;
          else {
            int t = t0 + row, c = kb * 64 + ch;
            float gv = p.proj[(size_t)t * 512 + OFF_GA + c];
            p.mixb[(size_t)t * 1024 + c] = f2bf((hsum[row * 64 + ch] + h) * gelu_f(gv));
          }
        }
      }
    }
    __syncthreads();
  }
}

template <int PASS>
__device__ void ph_lru(const P& p, int l, char* smem) {
  const int c_begin = (PASS == 2 && l == 1) ? 4 : 0;
  const int nitems = (NCHUNK - c_begin) * 4;
  for (int it = blockIdx.x; it < nitems; it += gridDim.x) lru_item<PASS>(p, l, c_begin + (it >> 2), it & 3, smem);
}

constexpr float LOG2E = 1.4426950408889634f;
constexpr float QSCALE = 0.125f * LOG2E;
typedef __attribute__((ext_vector_type(4))) short s16x4;

__device__ void ph_qknorm_rope2(const P& p, int l) {
  const int lane = threadIdx.x & 63;
  const int wpb = blockDim.x >> 6;
  for (int pair = blockIdx.x * wpb + (threadIdx.x >> 6); pair < TT * 28; pair += gridDim.x * wpb) {
    int t = pair / 28, slot = pair % 28;
    const float* g = nullptr; bool rope = false; float scale = 1.f;
    if (slot < 6) { g = p.win_qn + l * 64; rope = true; scale = QSCALE; }
    else if (slot < 8) { g = p.win_kn + l * 64; rope = true; }
    else if (slot < 10) { }
    else if (slot < 16) { g = p.na_qn + l * 64; scale = QSCALE; }
    else if (slot < 22) { g = p.na_kn + l * 64; }
    rope = rope && (t >= LC);
    const size_t idx = (size_t)t * DIN + 512 + slot * 64 + lane;
    float v = bf2f(p.projb[idx]);
    float y = v;
    if (g) {
      float ss = wave_sum(v * v);
      y = v * rsqrtf(ss * (1.f / 64.f) + EPS) * g[lane];
    }
    float partner = __shfl_xor(y, 16);
    if (rope) {
      int pos = t - LC, row = pos >> 6, col = pos & 63;
      int j = lane & 15, axis = lane >> 5;
      float inv = __expf(-(float)j * (1.f / 16.f) * 9.210340371976184f);
      float ang = (float)(axis ? col : row) * inv;
      float k = rintf(ang * 0.15915494309189535f);
      float r = fmaf(-k, 6.2831854820251465f, ang);
      r = fmaf(-k, -1.7484555e-07f, r);
      float cs = __cosf(r), sn = __sinf(r);
      bool first = ((lane >> 4) & 1) == 0;
      y = first ? (y * cs - partner * sn) : (partner * sn + y * cs);
    }
    p.projb[idx] = f2bf(y * scale);
  }
}

__device__ __forceinline__ float wave_max(float v) {
#pragma unroll
  for (int o = 32; o > 0; o >>= 1) v = fmaxf(v, __shfl_xor(v, o));
  return v;
}

struct KVRegs { uint4 k[2], v[2]; };
template <class TokFn>
__device__ __forceinline__ void kv_load(const P& p, KVRegs& r, int koff, int voff, TokFn tok) {
  const int tid = threadIdx.x;
#pragma unroll
  for (int i = 0; i < 2; ++i) {
    int id = tid + 256 * i, row = id >> 3, c = id & 7;
    const bf16_t* base = p.projb + (size_t)tok(row) * DIN + c * 8;
    r.k[i] = *(const uint4*)(base + koff);
    r.v[i] = *(const uint4*)(base + voff);
  }
}
__device__ __forceinline__ void kv_store(const KVRegs& r, char* stage) {
  const int tid = threadIdx.x;
#pragma unroll
  for (int i = 0; i < 2; ++i) {
    int id = tid + 256 * i, row = id >> 3, c = id & 7;
    int off = row * 128 + ((c ^ (row & 7)) << 4);
    *(uint4*)(stage + off) = r.k[i];
    *(uint4*)(stage + 8192 + off) = r.v[i];
  }
}

template <class MaskFn>
__device__ __forceinline__ void attn_step(const char* stage, int kr0, const bf16x8 (&qf)[2], f32x4 (&o)[4], float& lsum, MaskFn mb) {
  const int lane = threadIdx.x & 63, g = lane >> 4, lr = lane & 15;
  f32x4 st[2];
#pragma unroll
  for (int t2 = 0; t2 < 2; ++t2) {
    st[t2] = (f32x4){0.f, 0.f, 0.f, 0.f};
    const int row = kr0 + 16 * t2 + lr;
#pragma unroll
    for (int s = 0; s < 2; ++s) {
      bf16x8 kf = *(const bf16x8*)(stage + row * 128 + (((4 * s + g) ^ (row & 7)) << 4));
      st[t2] = __builtin_amdgcn_mfma_f32_16x16x32_bf16(kf, qf[s], st[t2], 0, 0, 0);
    }
  }
  bf16x8 pb;
#pragma unroll
  for (int t2 = 0; t2 < 2; ++t2)
#pragma unroll
    for (int r = 0; r < 4; ++r) {
      float pv = exp2f(mb(t2, r, st[t2][r]));
      lsum += pv;
      pb[t2 * 4 + r] = (short)f2bf(pv);
    }
  const int q = lr >> 2, pp = lane & 3;
#pragma unroll
  for (int m = 0; m < 4; ++m) {
    bf16x8 vf;
#pragma unroll
    for (int t = 0; t < 2; ++t) {
      const int row = kr0 + 16 * t + 4 * g + q;
      const char* addr = stage + 8192 + row * 128 + (((2 * m + (pp >> 1)) ^ (row & 7)) << 4) + 8 * (pp & 1);
      s16x4 v4 = __builtin_amdgcn_ds_read_tr16_b64_v4i16((__attribute__((address_space(3))) s16x4*)addr);
      vf[4 * t + 0] = v4[0]; vf[4 * t + 1] = v4[1]; vf[4 * t + 2] = v4[2]; vf[4 * t + 3] = v4[3];
    }
    o[m] = __builtin_amdgcn_mfma_f32_16x16x32_bf16(vf, pb, o[m], 0, 0, 0);
  }
}

__device__ __forceinline__ void attn_store_out(const P& p, const f32x4 (&o)[4], float lsum, int tok, int col0) {
  const int lane = threadIdx.x & 63, g = lane >> 4;
  lsum += __shfl_xor(lsum, 16);
  lsum += __shfl_xor(lsum, 32);
  const float inv = 1.f / lsum;
  bf16_t* op = p.mixb + (size_t)tok * 1024 + col0 + 4 * g;
#pragma unroll
  for (int m = 0; m < 4; ++m)
    *(uint2*)(op + 16 * m) = make_uint2(pack2bf(o[m][0] * inv, o[m][1] * inv), pack2bf(o[m][2] * inv, o[m][3] * inv));
}

__device__ void attn_win_item(const P& p, int l, int kind, int qb, int hs, char* smem) {
  const int tid = threadIdx.x, lane = tid & 63, wv = tid >> 6, g = lane >> 4, lr = lane & 15;
  int qoff, koff, voff, ooff; const float *gq, *gk; float sink2 = -1e30f; bool has_sink = false;
  if (kind == 0 || hs < 6) {
    const int h = hs, kvh = h / 3;
    qoff = OFF_QW + h * 64; koff = OFF_KW + kvh * 64; voff = OFF_VW + kvh * 64; ooff = 256 + h * 64;
    gq = p.win_qn + l * 64; gk = p.win_kn + l * 64; sink2 = p.win_sink[l * 6 + h] * LOG2E; has_sink = true;
  } else {
    const int h = hs - 6;
    qoff = OFF_QN + h * 64; koff = OFF_KN + h * 64; voff = OFF_VN + h * 64; ooff = 640 + h * 64;
    gq = p.na_qn + l * 64; gk = p.na_kn + l * 64;
  }
  float bound = 8.f * LOG2E * wave_max(fabsf(gq[lane])) * wave_max(fabsf(gk[lane])) * 1.0001f + 1e-3f;
  if (has_sink) bound = fmaxf(bound, sink2);
  const int q0 = qb * 64;
  const int qtok = (kind == 0 ? LC : 0) + q0 + 16 * wv + lr;
  bf16x8 qf[2];
#pragma unroll
  for (int s = 0; s < 2; ++s) qf[s] = *(const bf16x8*)(p.projb + (size_t)qtok * DIN + qoff + 32 * s + 8 * g);
  f32x4 o[4];
#pragma unroll
  for (int m = 0; m < 4; ++m) o[m] = (f32x4){0.f, 0.f, 0.f, 0.f};
  float lsum = 0.f;
  const int nloc = (kind == 0) ? 5 : 0, nch = nloc + 4;
  auto tokfn = [&](int c) {
    return [=](int row) {
      if (c < nloc) { int pos = q0 - 128 + 64 * c + row; pos = pos < 0 ? 0 : (pos > SEQ - 1 ? SEQ - 1 : pos); return LC + pos; }
      return 64 * (c - nloc) + row;
    };
  };
  KVRegs kr;
  __syncthreads();
  kv_load(p, kr, koff, voff, tokfn(0));
  kv_store(kr, smem);
  __syncthreads();
  for (int c = 0; c < nch; ++c) {
    const char* stage = smem + (c & 1) * 16384;
    if (c + 1 < nch) kv_load(p, kr, koff, voff, tokfn(c + 1));
    if (c < nloc) {
      const int qpos = q0 + 16 * wv + lr;
#pragma unroll
      for (int st = 0; st < 2; ++st) {
        const int kbase = q0 - 128 + 64 * c + 32 * st;
        attn_step(stage, 32 * st, qf, o, lsum, [&](int t2, int r, float s) {
          int kpos = kbase + 16 * t2 + 4 * g + r;
          int dlt = kpos - qpos; dlt = dlt < 0 ? -dlt : dlt;
          bool valid = (kpos >= 0) && (kpos < SEQ) && (dlt <= 128);
          return valid ? s - bound : -1e30f;
        });
      }
    } else {
#pragma unroll
      for (int st = 0; st < 2; ++st) attn_step(stage, 32 * st, qf, o, lsum, [&](int t2, int r, float s) { return s - bound; });
    }
    if (c + 1 < nch) kv_store(kr, smem + ((c + 1) & 1) * 16384);
    __syncthreads();
  }
  if (has_sink && g == 0) lsum += exp2f(sink2 - bound);
  attn_store_out(p, o, lsum, qtok, ooff);
}

__device__ void attn_na_item(const P& p, int l, int r, int h, char* smem) {
  const int tid = threadIdx.x, lane = tid & 63, wv = tid >> 6, g = lane >> 4, lr = lane & 15;
  const int qoff = OFF_QN + h * 64, koff = OFF_KN + h * 64, voff = OFF_VN + h * 64, ooff = 640 + h * 64;
  float* rpbl = (float*)(smem + 32768);
  const float* rpbg = p.rpb + (size_t)(l * 6 + h) * 465;
  float bmax = 0.f;
  __syncthreads();
  for (int i = tid; i < 465; i += 256) { float b = rpbg[i] * LOG2E; rpbl[i] = b; }
  for (int i = lane; i < 465; i += 64) bmax = fmaxf(bmax, fabsf(rpbg[i]) * LOG2E);
  bmax = wave_max(bmax);
  const float bound = 8.f * LOG2E * wave_max(fabsf(p.na_qn[l * 64 + lane])) * wave_max(fabsf(p.na_kn[l * 64 + lane])) * 1.0001f + bmax + 1e-3f;
  const int qcol = 16 * wv + lr;
  const int qtok = LC + r * 64 + qcol;
  const int kr0r = min(max(r - 4, 0), 248);
  const int kc0 = min(max(16 * wv - 8, 0), 32);
  const int qs = min(max(qcol - 8, 0), 48);
  bf16x8 qf[2];
#pragma unroll
  for (int s = 0; s < 2; ++s) qf[s] = *(const bf16x8*)(p.projb + (size_t)qtok * DIN + qoff + 32 * s + 8 * g);
  f32x4 o[4];
#pragma unroll
  for (int m = 0; m < 4; ++m) o[m] = (f32x4){0.f, 0.f, 0.f, 0.f};
  float lsum = 0.f;
  auto tokfn = [&](int c) {
    return [=](int row) { return c < 8 ? LC + (kr0r + c) * 64 + row : 64 * (c - 8) + row; };
  };
  KVRegs kr;
  kv_load(p, kr, koff, voff, tokfn(0));
  kv_store(kr, smem);
  __syncthreads();
  for (int c = 0; c < 12; ++c) {
    const char* stage = smem + (c & 1) * 16384;
    if (c + 1 < 12) kv_load(p, kr, koff, voff, tokfn(c + 1));
    if (c < 8) {
      const int dr = kr0r + c - r + 7;
      attn_step(stage, kc0, qf, o, lsum, [&](int t2, int rr, float s) {
        int kcol = kc0 + 16 * t2 + 4 * g + rr;
        bool valid = (kcol >= qs) && (kcol < qs + 16);
        int dc = kcol - qcol + 15; dc = dc < 0 ? 0 : (dc > 30 ? 30 : dc);
        return valid ? s + rpbl[dr * 31 + dc] - bound : -1e30f;
      });
    } else {
#pragma unroll
      for (int st = 0; st < 2; ++st) attn_step(stage, 32 * st, qf, o, lsum, [&](int t2, int rr, float s) { return s - bound; });
    }
    if (c + 1 < 12) kv_store(kr, smem + ((c + 1) & 1) * 16384);
    __syncthreads();
  }
  attn_store_out(p, o, lsum, qtok, ooff);
}

__device__ void ph_attn(const P& p, int l, char* smem) {
  const int nitems = 3072 + (l == 0 ? 48 : 0);
  for (int it = blockIdx.x; it < nitems; it += gridDim.x) {
    if (it < 1536) attn_win_item(p, l, 0, it / 6, it % 6, smem);
    else if (it < 3072) { int j = it - 1536; attn_na_item(p, l, j / 6, j % 6, smem); }
    else { int j = it - 3072; attn_win_item(p, l, 1, j / 12, j % 12, smem); }
  }
}

__device__ __forceinline__ unsigned ord_key(float s) {
  unsigned u = __float_as_uint(s);
  return (u & 0x80000000u) ? ~u : (u | 0x80000000u);
}
__device__ __forceinline__ float ord_val(unsigned pk) {
  unsigned u = pk & ~127u;
  unsigned b = (u & 0x80000000u) ? (u & 0x7fffffffu) : ~u;
  return __uint_as_float(b);
}
__device__ __forceinline__ void ce_desc(unsigned& a, unsigned& b) {
  unsigned mx = a > b ? a : b, mn = a > b ? b : a;
  a = mx; b = mn;
}
__device__ __forceinline__ void sort16_desc(unsigned (&v)[16]) {
#pragma unroll
  for (int k = 2; k <= 16; k <<= 1) {
#pragma unroll
    for (int j = k >> 1; j > 0; j >>= 1) {
#pragma unroll
      for (int i = 0; i < 16; ++i) {
        int m = i ^ j;
        if (m > i) {
          if ((i & k) == 0) ce_desc(v[i], v[m]); else ce_desc(v[m], v[i]);
        }
      }
    }
  }
}
__device__ __forceinline__ void merge16_desc(unsigned (&a)[16], const unsigned (&b)[16]) {
#pragma unroll
  for (int i = 0; i < 16; ++i) { unsigned o = b[15 - i]; a[i] = a[i] > o ? a[i] : o; }
#pragma unroll
  for (int j = 8; j > 0; j >>= 1) {
#pragma unroll
    for (int i = 0; i < 16; ++i) {
      int m = i ^ j;
      if (m > i) ce_desc(a[i], a[m]);
    }
  }
}

__device__ void ph_prep_peer(const P& p) {
  const size_t n4 = (size_t)2 * 16384 * 1024 / 4;
  for (size_t i = GTID; i < n4; i += GSZ) {
    float4 a = ((const float4*)p.pu)[i], b = ((const float4*)p.pv)[i];
    ((uint2*)p.ub16)[i] = make_uint2(pack2bf(a.x, a.y), pack2bf(a.z, a.w));
    ((uint2*)p.vb16)[i] = make_uint2(pack2bf(b.x, b.y), pack2bf(b.z, b.w));
  }
  for (int i = GTID; i < 2 * 128 * 128; i += GSZ) { p.k1b[i] = f2bf(p.k1[i]); p.k2b[i] = f2bf(p.k2[i]); }
}

struct EpiPeerTopk {
  int l;
  __device__ __forceinline__ void operator()(const P& p, f32x4 (&acc)[4][4], int m0, int n0, int wm, int wn, int lane, char* smem) const {
    const int tid = threadIdx.x, g = lane >> 4, lr = lane & 15;
    const int nt = n0 >> 7, head = nt >> 1, hf = nt & 1;
    char* qimg = smem;
    char* kimg = smem + 34816;
    {
      char* qw = qimg + (wm * 64 + 4 * g) * 272 + (wn * 64 + lr) * 2;
#pragma unroll
      for (int i = 0; i < 4; ++i)
#pragma unroll
        for (int r = 0; r < 4; ++r)
#pragma unroll
          for (int j = 0; j < 4; ++j) *(bf16_t*)(qw + (16 * i + r) * 272 + 32 * j) = f2bf(acc[i][j][r]);
      const bf16_t* kk = (hf ? p.k2b : p.k1b) + (size_t)l * 16384 + (tid >> 4) * 128 + (tid & 15) * 8;
      char* kw = kimg + (tid >> 4) * 272 + (tid & 15) * 16;
#pragma unroll
      for (int i = 0; i < 8; ++i) *(uint4*)(kw + i * 16 * 272) = *(const uint4*)(kk + i * 16 * 128);
    }
    __syncthreads();
#pragma unroll
    for (int i = 0; i < 4; ++i)
#pragma unroll
      for (int j = 0; j < 4; ++j) acc[i][j] = (f32x4){0.f, 0.f, 0.f, 0.f};
    {
      const char* qa = qimg + (wm * 64 + lr) * 272 + g * 16;
      const char* kb = kimg + (wn * 64 + lr) * 272 + g * 16;
#pragma unroll
      for (int s = 0; s < 4; ++s) {
        bf16x8 af[4], bfr[4];
#pragma unroll
        for (int i = 0; i < 4; ++i) af[i] = *(const bf16x8*)(qa + i * 16 * 272 + s * 64);
#pragma unroll
        for (int j = 0; j < 4; ++j) bfr[j] = *(const bf16x8*)(kb + j * 16 * 272 + s * 64);
#pragma unroll
        for (int i = 0; i < 4; ++i)
#pragma unroll
          for (int j = 0; j < 4; ++j) acc[i][j] = __builtin_amdgcn_mfma_f32_16x16x32_bf16(af[i], bfr[j], acc[i][j], 0, 0, 0);
      }
    }
    __syncthreads();
    unsigned* simg = (unsigned*)smem;
    {
      unsigned* sw = simg + (wm * 64 + 4 * g) * 129 + wn * 64 + lr;
#pragma unroll
      for (int i = 0; i < 4; ++i)
#pragma unroll
        for (int r = 0; r < 4; ++r)
#pragma unroll
          for (int j = 0; j < 4; ++j)
            sw[(16 * i + r) * 129 + 16 * j] = (ord_key(acc[i][j][r]) & ~127u) | (unsigned)(wn * 64 + 16 * j + lr);
    }
    __syncthreads();
    const int row = tid & 127, half = tid >> 7;
    unsigned top[16];
    {
      const unsigned* sr = simg + row * 129 + half * 64;
#pragma unroll
      for (int k = 0; k < 16; ++k) top[k] = sr[k];
      sort16_desc(top);
#pragma unroll 1
      for (int gi = 1; gi < 4; ++gi) {
        unsigned v1[16];
#pragma unroll
        for (int k = 0; k < 16; ++k) v1[k] = sr[gi * 16 + k];
        sort16_desc(v1);
        merge16_desc(top, v1);
      }
    }
    __syncthreads();
    if (half == 1) {
#pragma unroll
      for (int k = 0; k < 16; ++k) simg[k * 128 + row] = top[k];
    }
    __syncthreads();
    if (half == 0) {
      unsigned o[16];
#pragma unroll
      for (int k = 0; k < 16; ++k) o[k] = simg[k * 128 + row];
      merge16_desc(top, o);
      uint4* dst = (uint4*)(p.pk + (((size_t)(m0 + row) * 8 + head) * 2 + hf) * 16);
#pragma unroll
      for (int k = 0; k < 4; ++k) dst[k] = make_uint4(top[4 * k], top[4 * k + 1], top[4 * k + 2], top[4 * k + 3]);
    }
  }
};

__device__ const unsigned char CAND_A[64] = {0,0,0,0,0,0,0,0,0,0,0,0,0,0,0,0, 1,1,1,1,1,1,1,1, 2,2,2,2,2, 3,3,3,3, 4,4,4, 5,5, 6,6, 7,7,
                                             8,9,10,11,12,13,14,15, 0,0,0,0,0,0,0,0,0,0,0,0,0,0};
__device__ const unsigned char CAND_B[64] = {0,1,2,3,4,5,6,7,8,9,10,11,12,13,14,15, 0,1,2,3,4,5,6,7, 0,1,2,3,4, 0,1,2,3, 0,1,2, 0,1, 0,1, 0,1,
                                             0,0,0,0,0,0,0,0, 0,0,0,0,0,0,0,0,0,0,0,0,0,0};

__device__ void ph_peer_apply2(const P& p, int l, int t0, char* smem) {
  const int tid = threadIdx.x, lane = tid & 63, wv = tid >> 6;
  int* lds_e = (int*)(smem + wv * 1024);
  float* lds_g = (float*)(smem + wv * 1024 + 512);
  const bf16_t* U = p.ub16 + (size_t)l * 16384 * 1024;
  const bf16_t* V = p.vb16 + (size_t)l * 16384 * 1024;
  const float* n2g = p.norm2_g + l * 1024;
  const int ca = CAND_A[lane], cb = CAND_B[lane];
  for (int tk = t0 + blockIdx.x * 4 + wv; tk < TT; tk += gridDim.x * 4) {
    const float* mod = p.mod + (l * 2 + (tk < LC ? 1 : 0)) * 6144;
    float xv[16], hv[16];
    {
      const float4* xp = (const float4*)(p.xall + (size_t)tk * 1024);
      float ss = 0.f;
#pragma unroll
      for (int i = 0; i < 2; ++i)
#pragma unroll
        for (int q = 0; q < 2; ++q) {
          float4 v = xp[(i * 64 + lane) * 2 + q];
          xv[i * 8 + q * 4 + 0] = v.x; xv[i * 8 + q * 4 + 1] = v.y; xv[i * 8 + q * 4 + 2] = v.z; xv[i * 8 + q * 4 + 3] = v.w;
          ss += v.x * v.x + v.y * v.y + v.z * v.z + v.w * v.w;
        }
      ss = wave_sum(ss);
      float rinv = rsqrtf(ss * (1.f / 1024.f) + EPS);
#pragma unroll
      for (int i = 0; i < 2; ++i)
#pragma unroll
        for (int k = 0; k < 8; ++k) {
          int d = (i * 64 + lane) * 8 + k;
          hv[i * 8 + k] = xv[i * 8 + k] * rinv * n2g[d] * (1.f + mod[4096 + d]) + mod[3072 + d];
        }
    }
    for (int head = 0; head < 8; ++head) {
      const unsigned* pk = p.pk + ((size_t)tk * 8 + head) * 32;
      unsigned p1 = pk[ca], p2 = pk[16 + cb];
      float sum = lane < 50 ? ord_val(p1) + ord_val(p2) : -3.0e38f;
      int eid = (int)(p1 & 127u) * 128 + (int)(p2 & 127u);
      int rank = 0;
      for (int m = 0; m < 50; ++m) {
        float sm = __shfl(sum, m);
        rank += (sm > sum || (sm == sum && m < lane)) ? 1 : 0;
      }
      float mx = sum;
#pragma unroll
      for (int o = 32; o > 0; o >>= 1) mx = fmaxf(mx, __shfl_xor(mx, o));
      bool sel = (lane < 50) && (rank < 16);
      float e = sel ? __expf(sum - mx) : 0.f;
      float tot = wave_sum(e);
      if (sel) { lds_e[head * 16 + rank] = eid; lds_g[head * 16 + rank] = e / tot; }
    }
    float acc[16];
#pragma unroll
    for (int k = 0; k < 16; ++k) acc[k] = 0.f;
    for (int e0 = 0; e0 < 128; e0 += 4) {
      uint4 ur[4][2], vr[4][2];
      float gt[4];
#pragma unroll
      for (int k = 0; k < 4; ++k) {
        int ex = __builtin_amdgcn_readfirstlane(lds_e[e0 + k]);
        gt[k] = lds_g[e0 + k];
        const uint4* up = (const uint4*)(U + (size_t)ex * 1024);
        const uint4* vp = (const uint4*)(V + (size_t)ex * 1024);
        ur[k][0] = up[lane]; ur[k][1] = up[64 + lane];
        vr[k][0] = vp[lane]; vr[k][1] = vp[64 + lane];
      }
#pragma unroll
      for (int k = 0; k < 4; ++k) {
        float dot = 0.f;
#pragma unroll
        for (int i = 0; i < 2; ++i) {
          unsigned w[4] = {ur[k][i].x, ur[k][i].y, ur[k][i].z, ur[k][i].w};
#pragma unroll
          for (int q = 0; q < 4; ++q) {
            dot += __uint_as_float(w[q] << 16) * hv[i * 8 + 2 * q];
            dot += __uint_as_float(w[q] & 0xffff0000u) * hv[i * 8 + 2 * q + 1];
          }
        }
        dot = wave_sum(dot);
        float a = gt[k] * gelu_f(dot);
#pragma unroll
        for (int i = 0; i < 2; ++i) {
          unsigned w[4] = {vr[k][i].x, vr[k][i].y, vr[k][i].z, vr[k][i].w};
#pragma unroll
          for (int q = 0; q < 4; ++q) {
            acc[i * 8 + 2 * q] += a * __uint_as_float(w[q] << 16);
            acc[i * 8 + 2 * q + 1] += a * __uint_as_float(w[q] & 0xffff0000u);
          }
        }
      }
    }
    {
      float4* xp = (float4*)(p.xall + (size_t)tk * 1024);
#pragma unroll
      for (int i = 0; i < 2; ++i)
#pragma unroll
        for (int q = 0; q < 2; ++q) {
          int d = (i * 64 + lane) * 8 + q * 4;
          float4 gg = *(const float4*)(mod + 5120 + d);
          float4 o;
          o.x = xv[i * 8 + q * 4 + 0] + gg.x * acc[i * 8 + q * 4 + 0];
          o.y = xv[i * 8 + q * 4 + 1] + gg.y * acc[i * 8 + q * 4 + 1];
          o.z = xv[i * 8 + q * 4 + 2] + gg.z * acc[i * 8 + q * 4 + 2];
          o.w = xv[i * 8 + q * 4 + 3] + gg.w * acc[i * 8 + q * 4 + 3];
          xp[(i * 64 + lane) * 2 + q] = o;
        }
    }
  }
}

constexpr int N_PH_PRE = 2;
constexpr int N_PH_LAYER = 15;
constexpr int N_PHASES = N_PH_PRE + 2 * N_PH_LAYER + 1;

__device__ __forceinline__ void run_phase(const P& p, int ph, float* smem) {
  if (ph == 0) { ph_mod(p); return; }
  if (ph == 1) { ph_copy_in(p); ph_prep(p, smem); ph_lru_prepw(p); ph_prep_peer(p); return; }
  if (ph == N_PHASES - 1) { ph_copy_out(p); return; }
  int l = (ph - N_PH_PRE) / N_PH_LAYER, s = (ph - N_PH_PRE) % N_PH_LAYER;
  int t0 = (l == 0) ? 0 : LC;
  switch (s) {
    case 0: ph_norm_mod(p, l, 0, 0, smem); break;
    case 1: gemm_bf16_128(p, p.hb, p.w_in_t + (size_t)l * 1024 * DIN, 1024, 0, TT, DIN, (char*)smem, EpiProjSplit{}); break;
    case 2: ph_qknorm_rope2(p, l); break;
    case 3: ph_lru<1>(p, l, (char*)smem); break;
    case 4: ph_lru<2>(p, l, (char*)smem); break;
    case 5: break;
    case 6: break;
    case 7: ph_attn(p, l, (char*)smem); break;
    case 10: gemm_bf16_128(p, p.mixb, p.w_out_t + (size_t)l * 1024 * 1024, 1024, t0, TT, 1024, (char*)smem, EpiResid{l, 2048}); break;
    case 11: ph_norm_mod(p, l, 1, t0, smem); break;
    case 12: gemm_bf16_128(p, p.hb, p.wq_t + (size_t)l * 1024 * NPQ, 1024, t0, TT, NPQ, (char*)smem, EpiPeerTopk{l}); break;
    case 13: break;
    case 14: ph_peer_apply2(p, l, t0, (char*)smem); break;
  }
}

#if !SINGLE_LAUNCH
__global__ void __launch_bounds__(256) k_phase(P p, int ph) {
  __shared__ __attribute__((aligned(16))) float smem[18432];
  run_phase(p, ph, smem);
}
#endif

__global__ void __launch_bounds__(256) k_mega(P p) {
  __shared__ __attribute__((aligned(16))) float smem[18432];
  cg::grid_group grid = cg::this_grid();
  for (int ph = 0; ph < N_PHASES; ++ph) {
    run_phase(p, ph, smem);
    if (ph + 1 < N_PHASES) grid.sync();
  }
}

extern "C" void kernel_launch(void* const* d_in, const int* in_sizes, int n_in, void* d_out, int out_size, void* d_ws,
                              size_t ws_size, hipStream_t stream) {
  P p{};
  const float** fp = (const float**)&p;
  for (int i = 0; i < 28; ++i) fp[i] = (const float*)d_in[i];
  p.out = (float*)d_out;
  float* w = (float*)d_ws;
  size_t o = 0;
  auto carve = [&](size_t n) { float* r = w + o; o += (n + 63) & ~(size_t)63; return r; };
  p.mod = carve(4 * 6144);
  p.xall = carve((size_t)TT * 1024);
  p.proj = carve((size_t)TT * 512);
  p.projb = (bf16_t*)carve((size_t)TT * DIN / 2);
  p.mixb = (bf16_t*)carve((size_t)TT * 512);
  p.hb = (bf16_t*)carve((size_t)TT * 512);
  p.w_in_t = (bf16_t*)carve((size_t)1024 * DIN);
  p.w_out_t = (bf16_t*)carve((size_t)1024 * 1024);
  p.wq_t = (bf16_t*)carve((size_t)1024 * NPQ);
  p.lruw_t = (bf16_t*)carve((size_t)2 * 2 * 4 * 2 * 4096 / 2);
  p.lagg = carve((size_t)2 * NCHUNK * 256 * 2);
  p.pk = (unsigned*)carve((size_t)TT * 256);
  p.ub16 = (bf16_t*)carve((size_t)16384 * 1024);
  p.vb16 = (bf16_t*)carve((size_t)16384 * 1024);
  p.k1b = (bf16_t*)carve(16384);
  p.k2b = (bf16_t*)carve(16384);
  if (o * 4 > ws_size) { fprintf(stderr, "workspace too small: need %zu have %zu\n", o * 4, ws_size); return; }
#if SINGLE_LAUNCH
  static int grid_blocks = 0;
  if (!grid_blocks) {
    int dev = 0, cus = 0, per_cu = 0;
    hipGetDevice(&dev);
    hipDeviceGetAttribute(&cus, hipDeviceAttributeMultiprocessorCount, dev);
    hipOccupancyMaxActiveBlocksPerMultiprocessor(&per_cu, k_mega, 256, 0);
    if (per_cu > 2) per_cu = 2;
    grid_blocks = cus * per_cu;
  }
  void* args[] = {&p};
  hipError_t e = hipLaunchCooperativeKernel((void*)k_mega, dim3(grid_blocks), dim3(256), args, 0, stream);
  if (e != hipSuccess) fprintf(stderr, "cooperative launch failed: %s (grid %d)\n", hipGetErrorString(e), grid_blocks);
#else
  for (int ph = 0; ph < N_PHASES; ++ph) {
    if ((ph - N_PH_PRE) % N_PH_LAYER == 9 && ph >= N_PH_PRE + N_PH_LAYER && ph != N_PHASES - 1) continue;
    k_phase<<<2048, 256, 0, stream>>>(p, ph);
  }
#endif
}
```

```cpp
#include <hip/hip_runtime.h>
#include <hip/hip_cooperative_groups.h>
#include <stdint.h>
#include <stdio.h>
namespace cg = cooperative_groups;

#ifndef SINGLE_LAUNCH
#define SINGLE_LAUNCH 1
#endif

constexpr int DM = 1024, SEQ = 16384, LC = 256, TT = SEQ + LC, DIN = 2304, NPQ = 2048;
constexpr int OFF_XA = 0, OFF_GA = 256, OFF_QW = 512, OFF_KW = 896, OFF_VW = 1024, OFF_QN = 1152, OFF_KN = 1536, OFF_VN = 1920;
constexpr float EPS = 1e-6f;

struct P {
  const float *x, *c, *ctx, *c_ctx, *w_mod, *b_mod, *norm1_g, *norm2_g, *w_in, *w_out,
      *conv_w, *conv_b, *wa, *ba, *wx, *bx, *lam, *win_qn, *win_kn, *win_sink, *na_qn, *na_kn, *rpb,
      *wq, *k1, *k2, *pu, *pv;
  float* out;
  float *mod, *xall, *proj;
  unsigned short* projb;
  unsigned* pk;
  unsigned* bar;
  unsigned short *ub16, *vb16, *k1b, *k2b;
  unsigned short *hb, *mixb, *w_in_t, *w_out_t, *wq_t, *lruw_t;
  float* lagg;
};

typedef unsigned short bf16_t;
typedef __attribute__((ext_vector_type(8))) short bf16x8;
typedef __attribute__((ext_vector_type(4))) float f32x4;
__device__ __forceinline__ unsigned short f2bf(float f) {
  unsigned u = __float_as_uint(f);
  u += 0x7fffu + ((u >> 16) & 1u);
  return (unsigned short)(u >> 16);
}
__device__ __forceinline__ unsigned pack2bf(float a, float b) { return (unsigned)f2bf(a) | ((unsigned)f2bf(b) << 16); }
__device__ __forceinline__ float bf2f(unsigned short h) { return __uint_as_float(((unsigned)h) << 16); }


__device__ __forceinline__ float silu_f(float x) { return x / (1.f + __expf(-x)); }
__device__ __forceinline__ float sigmoid_f(float x) { return 1.f / (1.f + __expf(-x)); }
__device__ __forceinline__ float gelu_f(float x) {
  float u = 0.7978845608028654f * (x + 0.044715f * x * x * x);
  float e = __expf(2.f * u);
  float th = 1.f - 2.f / (e + 1.f);
  return 0.5f * x * (1.f + th);
}
__device__ __forceinline__ float wave_sum(float v) {
#pragma unroll
  for (int o = 32; o > 0; o >>= 1) v += __shfl_xor(v, o);
  return v;
}

__device__ __forceinline__ int tid_opaque() { int t = threadIdx.x; asm volatile("" : "+v"(t)); return t; }
#define GTID (blockIdx.x * blockDim.x + tid_opaque())
#define GSZ (gridDim.x * blockDim.x)

__device__ void ph_mod(const P& p) {
  for (int idx = GTID; idx < 4 * 6144; idx += GSZ) {
    int n = idx % 6144, lw = idx / 6144, l = lw >> 1, which = lw & 1;
    const float* vec = which ? p.c_ctx : p.c;
    const float* w = p.w_mod + (size_t)l * 1024 * 6144 + n;
    float acc = 0.f;
    for (int k = 0; k < 1024; ++k) acc += silu_f(vec[k]) * w[(size_t)k * 6144];
    p.mod[idx] = acc + p.b_mod[l * 6144 + n];
  }
}

__device__ void ph_copy_in(const P& p) {
  const float4* xs = (const float4*)p.x;
  const float4* cs = (const float4*)p.ctx;
  float4* d = (float4*)p.xall;
  for (int i = GTID; i < TT * 256; i += GSZ) d[i] = (i < LC * 256) ? cs[i] : xs[i - LC * 256];
}

__device__ void ph_copy_out(const P& p) {
  const float4* s = (const float4*)(p.xall + (size_t)LC * 1024);
  float4* d = (float4*)p.out;
  for (int i = GTID; i < SEQ * 256; i += GSZ) d[i] = s[i];
}

__device__ void ph_norm_mod(const P& p, int l, int which_norm, int t0, float* smem, bool from_input = false) {
  const float* g = (which_norm ? p.norm2_g : p.norm1_g) + l * 1024;
  const int sh_off = which_norm ? 3072 : 0, sc_off = which_norm ? 4096 : 1024;
  const int tid = tid_opaque();
  for (int t = t0 + blockIdx.x; t < TT; t += gridDim.x) {
    const float* mod = p.mod + (l * 2 + (t < LC ? 1 : 0)) * 6144;
    float4 v;
    if (from_input) {
      v = t < LC ? ((const float4*)(p.ctx + (size_t)t * 1024))[tid] : ((const float4*)(p.x + (size_t)(t - LC) * 1024))[tid];
      ((float4*)(p.xall + (size_t)t * 1024))[tid] = v;
    } else v = ((const float4*)(p.xall + (size_t)t * 1024))[tid];
    float ss = wave_sum(v.x * v.x + v.y * v.y + v.z * v.z + v.w * v.w);
    __syncthreads();
    if ((tid & 63) == 0) smem[tid >> 6] = ss;
    __syncthreads();
    float tot = smem[0] + smem[1] + smem[2] + smem[3];
    float rinv = rsqrtf(tot * (1.f / 1024.f) + EPS);
    float4 gg = ((const float4*)g)[tid];
    float4 sc = ((const float4*)(mod + sc_off))[tid];
    float4 sh = ((const float4*)(mod + sh_off))[tid];
    float4 o;
    o.x = v.x * rinv * gg.x * (1.f + sc.x) + sh.x;
    o.y = v.y * rinv * gg.y * (1.f + sc.y) + sh.y;
    o.z = v.z * rinv * gg.z * (1.f + sc.z) + sh.z;
    o.w = v.w * rinv * gg.w * (1.f + sc.w) + sh.w;
    ((uint2*)(p.hb + (size_t)t * 1024))[tid] = make_uint2(pack2bf(o.x, o.y), pack2bf(o.z, o.w));
  }
}

__device__ void prep_transpose(const float* W, bf16_t* Wt, int K, int N, int item0, int nitems_total, float* smem) {
  (void)nitems_total;
  float(*ts)[65] = (float(*)[65])smem;
  const int tid = tid_opaque();
  const int tn = N / 64, nt = (K / 64) * tn;
  for (int it = blockIdx.x; it < nt; it += gridDim.x) {
    int k0 = (it / tn) * 64, n0 = (it % tn) * 64;
    __syncthreads();
#pragma unroll
    for (int i = 0; i < 16; ++i) {
      int r = (tid >> 6) + i * 4, c = tid & 63;
      ts[r][c] = W[(size_t)(k0 + r) * N + n0 + c];
    }
    __syncthreads();
#pragma unroll
    for (int i = 0; i < 16; ++i) {
      int r = (tid >> 6) + i * 4, c = tid & 63;
      Wt[(size_t)(n0 + r) * K + k0 + c] = f2bf(ts[c][r]);
    }
  }
  (void)item0;
}

__device__ void ph_prep(const P& p, float* smem) {
  for (int l = 0; l < 2; ++l) {
    prep_transpose(p.w_in + (size_t)l * 1024 * DIN, p.w_in_t + (size_t)l * 1024 * DIN, 1024, DIN, 0, 0, smem);
    prep_transpose(p.w_out + (size_t)l * 1024 * 1024, p.w_out_t + (size_t)l * 1024 * 1024, 1024, 1024, 0, 0, smem);
    prep_transpose(p.wq + (size_t)l * 1024 * NPQ, p.wq_t + (size_t)l * 1024 * NPQ, 1024, NPQ, 0, 0, smem);
  }
}

struct EpiStoreF32 {
  float* C; int ldc;
  __device__ __forceinline__ void operator()(const P& p, f32x4 (&acc)[4][4], int m0, int n0, int wm, int wn, int lane, char* smem) const {
    const int mw0 = m0 + wm * 64, nw0 = n0 + wn * 64;
#pragma unroll
    for (int i = 0; i < 4; ++i)
#pragma unroll
      for (int r = 0; r < 4; ++r) {
        int row = mw0 + 16 * i + (lane >> 4) * 4 + r;
#pragma unroll
        for (int j = 0; j < 4; ++j) C[(size_t)row * ldc + nw0 + 16 * j + (lane & 15)] = acc[i][j][r];
      }
  }
};
struct EpiProjSplit {
  __device__ __forceinline__ void operator()(const P& p, f32x4 (&acc)[4][4], int m0, int n0, int wm, int wn, int lane, char* smem) const {
    const int mw0 = m0 + wm * 64, nw0 = n0 + wn * 64;
#pragma unroll
    for (int i = 0; i < 4; ++i)
#pragma unroll
      for (int r = 0; r < 4; ++r) {
        int row = mw0 + 16 * i + (lane >> 4) * 4 + r;
#pragma unroll
        for (int j = 0; j < 4; ++j) {
          int col = nw0 + 16 * j + (lane & 15);
          if (n0 < 512) p.proj[(size_t)row * 512 + col] = acc[i][j][r];
          else p.projb[(size_t)row * DIN + col] = f2bf(acc[i][j][r]);
        }
      }
  }
};
struct EpiResid {
  int l, gofs;
  __device__ __forceinline__ void operator()(const P& p, f32x4 (&acc)[4][4], int m0, int n0, int wm, int wn, int lane, char* smem) const {
    const int mw0 = m0 + wm * 64, nw0 = n0 + wn * 64;
#pragma unroll
    for (int i = 0; i < 4; ++i)
#pragma unroll
      for (int r = 0; r < 4; ++r) {
        int row = mw0 + 16 * i + (lane >> 4) * 4 + r;
        const float* gt = p.mod + (l * 2 + (row < LC ? 1 : 0)) * 6144 + gofs;
#pragma unroll
        for (int j = 0; j < 4; ++j) {
          int col = nw0 + 16 * j + (lane & 15);
          p.xall[(size_t)row * 1024 + col] += gt[col] * acc[i][j][r];
        }
      }
  }
};

template <class Epi>
__device__ void gemm_bf16_128(const P& p, const bf16_t* __restrict__ A, const bf16_t* __restrict__ Bt, int K, int m_begin, int m_end,
                              int N, char* smem, const Epi& epi) {
  const int tid = tid_opaque(), lane = tid & 63, wv = tid >> 6, wm = wv >> 1, wn = wv & 1;
  const int tiles_n = N / 128, tiles_m = (m_end - m_begin) / 128;
  const int nk = K / 64;
  const int lrow = lane & 15, lq = lane >> 4;
  for (int tile = blockIdx.x; tile < tiles_m * tiles_n; tile += gridDim.x) {
    const int m0 = m_begin + (tile / tiles_n) * 128, n0 = (tile % tiles_n) * 128;
    f32x4 acc[4][4];
#pragma unroll
    for (int i = 0; i < 4; ++i)
#pragma unroll
      for (int j = 0; j < 4; ++j) acc[i][j] = (f32x4){0.f, 0.f, 0.f, 0.f};
    uint4 ra[4], rb[4];
    const bf16_t* Ag = A + (size_t)m0 * K;
    const bf16_t* Bg = Bt + (size_t)n0 * K;
#pragma unroll
    for (int i = 0; i < 4; ++i) {
      int id = tid + 256 * i, row = id >> 3, c = id & 7;
      ra[i] = *(const uint4*)(Ag + (size_t)row * K + c * 8);
      rb[i] = *(const uint4*)(Bg + (size_t)row * K + c * 8);
    }
#pragma unroll
    for (int i = 0; i < 4; ++i) {
      int id = tid + 256 * i, row = id >> 3, c = id & 7;
      int off = row * 128 + ((c ^ (row & 7)) << 4);
      *(uint4*)(smem + off) = ra[i];
      *(uint4*)(smem + 16384 + off) = rb[i];
    }
    __syncthreads();
    for (int kt = 0; kt < nk; ++kt) {
      const int cur = (kt & 1) * 32768, nxt = ((kt + 1) & 1) * 32768;
      if (kt + 1 < nk) {
#pragma unroll
        for (int i = 0; i < 4; ++i) {
          int id = tid + 256 * i, row = id >> 3, c = id & 7;
          ra[i] = *(const uint4*)(Ag + (size_t)row * K + (kt + 1) * 64 + c * 8);
          rb[i] = *(const uint4*)(Bg + (size_t)row * K + (kt + 1) * 64 + c * 8);
        }
      }
#pragma unroll
      for (int s = 0; s < 2; ++s) {
        bf16x8 af[4], bfr[4];
#pragma unroll
        for (int i = 0; i < 4; ++i) {
          int row = wm * 64 + 16 * i + lrow;
          af[i] = *(const bf16x8*)(smem + cur + row * 128 + (((4 * s + lq) ^ (row & 7)) << 4));
        }
#pragma unroll
        for (int j = 0; j < 4; ++j) {
          int row = wn * 64 + 16 * j + lrow;
          bfr[j] = *(const bf16x8*)(smem + cur + 16384 + row * 128 + (((4 * s + lq) ^ (row & 7)) << 4));
        }
#pragma unroll
        for (int i = 0; i < 4; ++i)
#pragma unroll
          for (int j = 0; j < 4; ++j) acc[i][j] = __builtin_amdgcn_mfma_f32_16x16x32_bf16(af[i], bfr[j], acc[i][j], 0, 0, 0);
      }
      if (kt + 1 < nk) {
#pragma unroll
        for (int i = 0; i < 4; ++i) {
          int id = tid + 256 * i, row = id >> 3, c = id & 7;
          int off = row * 128 + ((c ^ (row & 7)) << 4);
          *(uint4*)(smem + nxt + off) = ra[i];
          *(uint4*)(smem + nxt + 16384 + off) = rb[i];
        }
      }
      __syncthreads();
    }
    epi(p, acc, m0, n0, wm, wn, lane, smem);
    __syncthreads();
  }
}

constexpr int NCHUNK = TT / 64;
__device__ __forceinline__ int lru_pos(int dir, int c) { return dir == 0 ? c : (c < 4 ? 3 - c : 4 + (NCHUNK - 1 - c)); }

__device__ void ph_lru_prepw(const P& p) {
  for (int idx = GTID; idx < 2 * 2 * 4 * 2 * 4096; idx += GSZ) {
    int d = idx & 63, e = (idx >> 6) & 63, mtx = (idx >> 12) & 1, rest = idx >> 13;
    const float* w = (mtx ? p.wx : p.wa) + (size_t)rest * 4096;
    p.lruw_t[idx] = f2bf(w[d * 64 + e]);
  }
}

template <int PASS>
__device__ void lru_item(const P& p, int l, int cidx, int kb, char* smem) {
  bf16_t* u_img = (bf16_t*)smem;
  float* ab_a = (float*)(smem + 8192);
  float* ab_b = (float*)(smem + 8192 + 16384);
  float* hsum = (float*)(smem + 8192 + 32768);
  float* segagg = (float*)(smem + 8192 + 49152);
  float* ccarry = (float*)(smem + 8192 + 49152 + 2048);
  const int tid = tid_opaque(), lane = tid & 63, wv = tid >> 6, g = lane >> 4, lr = lane & 15;
  const int t0 = cidx * 64;
  const int lo = t0 < LC ? 0 : LC, hi = t0 < LC ? LC : TT;
  __syncthreads();
  {
    const int ch = tid & 63, c = kb * 64 + ch;
    const float cb = p.conv_b[l * 256 + c];
    float cw[4];
#pragma unroll
    for (int k = 0; k < 4; ++k) cw[k] = p.conv_w[(l * 4 + k) * 256 + c];
#pragma unroll
    for (int i = 0; i < 16; ++i) {
      int row = (tid >> 6) + 4 * i, t = t0 + row;
      float acc = cb;
#pragma unroll
      for (int k = 0; k < 4; ++k) {
        int tt = t + k - 2;
        if (tt >= lo && tt < hi) acc += cw[k] * p.proj[(size_t)tt * 512 + OFF_XA + c];
      }
      u_img[row * 64 + ((((ch >> 3) ^ (row & 7)) << 3) | (ch & 7))] = f2bf(acc);
    }
  }
  if (PASS == 2) {
    if (tid < 128) {
      const int ch = tid & 63, dir = tid >> 6;
      const int pos = lru_pos(dir, cidx);
      const float2* ag = (const float2*)p.lagg + (size_t)dir * NCHUNK * 256 + kb * 64 + ch;
      float h = 0.f;
      for (int q = 0; q < pos; ++q) {
        float2 v = ag[(size_t)q * 256];
        h = v.x * h + v.y;
      }
      ccarry[dir * 64 + ch] = h;
    }
  }
  __syncthreads();
  for (int dir = 0; dir < 2; ++dir) {
    const int pd = l * 2 + dir;
    {
      f32x4 ga[4], gx[4];
#pragma unroll
      for (int i = 0; i < 4; ++i) { ga[i] = (f32x4){0.f, 0.f, 0.f, 0.f}; gx[i] = (f32x4){0.f, 0.f, 0.f, 0.f}; }
      const bf16_t* wbase = p.lruw_t + (size_t)((pd * 4 + kb) * 2) * 4096 + (16 * wv + lr) * 64 + 8 * g;
#pragma unroll
      for (int s = 0; s < 2; ++s) {
        bf16x8 ba_ = *(const bf16x8*)(wbase + 32 * s);
        bf16x8 bx_ = *(const bf16x8*)(wbase + 4096 + 32 * s);
#pragma unroll
        for (int i = 0; i < 4; ++i) {
          int row = 16 * i + lr;
          bf16x8 af = *(const bf16x8*)((const char*)u_img + row * 128 + (((4 * s + g) ^ (row & 7)) << 4));
          ga[i] = __builtin_amdgcn_mfma_f32_16x16x32_bf16(af, ba_, ga[i], 0, 0, 0);
          gx[i] = __builtin_amdgcn_mfma_f32_16x16x32_bf16(af, bx_, gx[i], 0, 0, 0);
        }
      }
      const int ch = 16 * wv + lr, c = kb * 64 + ch;
      const float bav = p.ba[pd * 256 + c], bxv = p.bx[pd * 256 + c];
      const float sp = log1pf(expf(-p.lam[pd * 256 + c]));
#pragma unroll
      for (int i = 0; i < 4; ++i)
#pragma unroll
        for (int r = 0; r < 4; ++r) {
          int row = 16 * i + 4 * g + r;
          float rr = sigmoid_f(ga[i][r] + bav), ig = sigmoid_f(gx[i][r] + bxv);
          float log_a = -8.f * rr * sp;
          float a = __expf(log_a);
          float uu = bf2f(u_img[row * 64 + ((((ch >> 3) ^ (row & 7)) << 3) | (ch & 7))]);
          float b = sqrtf(-expm1f(2.f * log_a)) * ig * uu;
          ab_a[row * 64 + ch] = a;
          ab_b[row * 64 + ch] = b;
        }
    }
    __syncthreads();
    {
      const int ch = tid & 63, seg = tid >> 6;
      float Pr = 1.f, H = 0.f;
#pragma unroll
      for (int i = 0; i < 16; ++i) {
        int row = dir == 0 ? seg * 16 + i : seg * 16 + 15 - i;
        float a = ab_a[row * 64 + ch], b = ab_b[row * 64 + ch];
        H = a * H + b;
        Pr *= a;
      }
      segagg[(seg * 64 + ch) * 2] = Pr;
      segagg[(seg * 64 + ch) * 2 + 1] = H;
      __syncthreads();
      if (PASS == 1) {
        if (seg == 0) {
          float A = 1.f, B = 0.f;
#pragma unroll
          for (int s2 = 0; s2 < 4; ++s2) {
            int sg = dir == 0 ? s2 : 3 - s2;
            float pa = segagg[(sg * 64 + ch) * 2], pb = segagg[(sg * 64 + ch) * 2 + 1];
            B = pa * B + pb;
            A *= pa;
          }
          float2* ag = (float2*)p.lagg + ((size_t)dir * NCHUNK + lru_pos(dir, cidx)) * 256 + kb * 64 + ch;
          *ag = make_float2(A, B);
        }
      } else {
        float h = ccarry[dir * 64 + ch];
#pragma unroll
        for (int s2 = 0; s2 < 3; ++s2) {
          int sg = dir == 0 ? s2 : 3 - s2;
          bool before = dir == 0 ? (sg < seg) : (sg > seg);
          if (before) h = segagg[(sg * 64 + ch) * 2] * h + segagg[(sg * 64 + ch) * 2 + 1];
        }
#pragma unroll
        for (int i = 0; i < 16; ++i) {
          int row = dir == 0 ? seg * 16 + i : seg * 16 + 15 - i;
          float a = ab_a[row * 64 + ch], b = ab_b[row * 64 + ch];
          h = a * h + b;
          if (dir == 0) hsum[row * 64 + ch] = h;
          else {
            int t = t0 + row, c = kb * 64 + ch;
            float gv = p.proj[(size_t)t * 512 + OFF_GA + c];
            p.mixb[(size_t)t * 1024 + c] = f2bf((hsum[row * 64 + ch] + h) * gelu_f(gv));
          }
        }
      }
    }
    __syncthreads();
  }
}

template <int PASS>
__device__ void ph_lru(const P& p, int l, char* smem) {
  const int c_begin = (PASS == 2 && l == 1) ? 4 : 0;
  const int nitems = (NCHUNK - c_begin) * 4;
  for (int it = blockIdx.x; it < nitems; it += gridDim.x) lru_item<PASS>(p, l, c_begin + (it >> 2), it & 3, smem);
}

constexpr float LOG2E = 1.4426950408889634f;
constexpr float QSCALE = 0.125f * LOG2E;
typedef __attribute__((ext_vector_type(4))) short s16x4;

__device__ void ph_qknorm_rope2(const P& p, int l) {
  const int tid_ = tid_opaque();
  const int lane = tid_ & 63;
  const int wpb = blockDim.x >> 6;
  for (int pair = blockIdx.x * wpb + (tid_ >> 6); pair < TT * 28; pair += gridDim.x * wpb) {
    int t = pair / 28, slot = pair % 28;
    const float* g = nullptr; bool rope = false; float scale = 1.f;
    if (slot < 6) { g = p.win_qn + l * 64; rope = true; scale = QSCALE; }
    else if (slot < 8) { g = p.win_kn + l * 64; rope = true; }
    else if (slot < 10) { }
    else if (slot < 16) { g = p.na_qn + l * 64; scale = QSCALE; }
    else if (slot < 22) { g = p.na_kn + l * 64; }
    rope = rope && (t >= LC);
    const size_t idx = (size_t)t * DIN + 512 + slot * 64 + lane;
    float v = bf2f(p.projb[idx]);
    float y = v;
    if (g) {
      float ss = wave_sum(v * v);
      y = v * rsqrtf(ss * (1.f / 64.f) + EPS) * g[lane];
    }
    float partner = __shfl_xor(y, 16);
    if (rope) {
      int pos = t - LC, row = pos >> 6, col = pos & 63;
      int j = lane & 15, axis = lane >> 5;
      float inv = __expf(-(float)j * (1.f / 16.f) * 9.210340371976184f);
      float ang = (float)(axis ? col : row) * inv;
      float k = rintf(ang * 0.15915494309189535f);
      float r = fmaf(-k, 6.2831854820251465f, ang);
      r = fmaf(-k, -1.7484555e-07f, r);
      float cs = __cosf(r), sn = __sinf(r);
      bool first = ((lane >> 4) & 1) == 0;
      y = first ? (y * cs - partner * sn) : (partner * sn + y * cs);
    }
    p.projb[idx] = f2bf(y * scale);
  }
}

__device__ __forceinline__ float wave_max(float v) {
#pragma unroll
  for (int o = 32; o > 0; o >>= 1) v = fmaxf(v, __shfl_xor(v, o));
  return v;
}

struct KVRegs { uint4 k[2], v[2]; };
template <class TokFn>
__device__ __forceinline__ void kv_load(const P& p, KVRegs& r, int koff, int voff, TokFn tok, int tid) {
#pragma unroll
  for (int i = 0; i < 2; ++i) {
    int id = tid + 256 * i, row = id >> 3, c = id & 7;
    const bf16_t* base = p.projb + (size_t)tok(row) * DIN + c * 8;
    r.k[i] = *(const uint4*)(base + koff);
    r.v[i] = *(const uint4*)(base + voff);
  }
}
__device__ __forceinline__ void kv_store(const KVRegs& r, char* stage, int tid) {
#pragma unroll
  for (int i = 0; i < 2; ++i) {
    int id = tid + 256 * i, row = id >> 3, c = id & 7;
    int off = row * 128 + ((c ^ (row & 7)) << 4);
    *(uint4*)(stage + off) = r.k[i];
    *(uint4*)(stage + 8192 + off) = r.v[i];
  }
}

template <class MaskFn>
__device__ __forceinline__ void attn_step(const char* stage, int kr0, const bf16x8 (&qf)[2], f32x4 (&o)[4], float& lsum, MaskFn mb, int lane) {
  const int g = lane >> 4, lr = lane & 15;
  f32x4 st[2];
#pragma unroll
  for (int t2 = 0; t2 < 2; ++t2) {
    st[t2] = (f32x4){0.f, 0.f, 0.f, 0.f};
    const int row = kr0 + 16 * t2 + lr;
#pragma unroll
    for (int s = 0; s < 2; ++s) {
      bf16x8 kf = *(const bf16x8*)(stage + row * 128 + (((4 * s + g) ^ (row & 7)) << 4));
      st[t2] = __builtin_amdgcn_mfma_f32_16x16x32_bf16(kf, qf[s], st[t2], 0, 0, 0);
    }
  }
  bf16x8 pb;
#pragma unroll
  for (int t2 = 0; t2 < 2; ++t2)
#pragma unroll
    for (int r = 0; r < 4; ++r) {
      float pv = exp2f(mb(t2, r, st[t2][r]));
      lsum += pv;
      pb[t2 * 4 + r] = (short)f2bf(pv);
    }
  const int q = lr >> 2, pp = lane & 3;
#pragma unroll
  for (int m = 0; m < 4; ++m) {
    bf16x8 vf;
#pragma unroll
    for (int t = 0; t < 2; ++t) {
      const int row = kr0 + 16 * t + 4 * g + q;
      const char* addr = stage + 8192 + row * 128 + (((2 * m + (pp >> 1)) ^ (row & 7)) << 4) + 8 * (pp & 1);
      s16x4 v4 = __builtin_amdgcn_ds_read_tr16_b64_v4i16((__attribute__((address_space(3))) s16x4*)addr);
      vf[4 * t + 0] = v4[0]; vf[4 * t + 1] = v4[1]; vf[4 * t + 2] = v4[2]; vf[4 * t + 3] = v4[3];
    }
    o[m] = __builtin_amdgcn_mfma_f32_16x16x32_bf16(vf, pb, o[m], 0, 0, 0);
  }
}

__device__ __forceinline__ void attn_store_out(const P& p, const f32x4 (&o)[4], float lsum, int tok, int col0, int lane) {
  const int g = lane >> 4;
  lsum += __shfl_xor(lsum, 16);
  lsum += __shfl_xor(lsum, 32);
  const float inv = 1.f / lsum;
  bf16_t* op = p.mixb + (size_t)tok * 1024 + col0 + 4 * g;
#pragma unroll
  for (int m = 0; m < 4; ++m)
    *(uint2*)(op + 16 * m) = make_uint2(pack2bf(o[m][0] * inv, o[m][1] * inv), pack2bf(o[m][2] * inv, o[m][3] * inv));
}

__device__ void attn_win_item(const P& p, int l, int kind, int qb, int hs, char* smem) {
  const int tid = tid_opaque(), lane = tid & 63, wv = tid >> 6, g = lane >> 4, lr = lane & 15;
  int qoff, koff, voff, ooff; const float *gq, *gk; float sink2 = -1e30f; bool has_sink = false;
  if (kind == 0 || hs < 6) {
    const int h = hs, kvh = h / 3;
    qoff = OFF_QW + h * 64; koff = OFF_KW + kvh * 64; voff = OFF_VW + kvh * 64; ooff = 256 + h * 64;
    gq = p.win_qn + l * 64; gk = p.win_kn + l * 64; sink2 = p.win_sink[l * 6 + h] * LOG2E; has_sink = true;
  } else {
    const int h = hs - 6;
    qoff = OFF_QN + h * 64; koff = OFF_KN + h * 64; voff = OFF_VN + h * 64; ooff = 640 + h * 64;
    gq = p.na_qn + l * 64; gk = p.na_kn + l * 64;
  }
  float bound = 8.f * LOG2E * wave_max(fabsf(gq[lane])) * wave_max(fabsf(gk[lane])) * 1.0001f + 1e-3f;
  if (has_sink) bound = fmaxf(bound, sink2);
  const int q0 = qb * 64;
  const int qtok = (kind == 0 ? LC : 0) + q0 + 16 * wv + lr;
  bf16x8 qf[2];
#pragma unroll
  for (int s = 0; s < 2; ++s) qf[s] = *(const bf16x8*)(p.projb + (size_t)qtok * DIN + qoff + 32 * s + 8 * g);
  f32x4 o[4];
#pragma unroll
  for (int m = 0; m < 4; ++m) o[m] = (f32x4){0.f, 0.f, 0.f, 0.f};
  float lsum = 0.f;
  const int nloc = (kind == 0) ? 5 : 0, nch = nloc + 4;
  auto tokfn = [&](int c) {
    return [=](int row) {
      if (c < nloc) { int pos = q0 - 128 + 64 * c + row; pos = pos < 0 ? 0 : (pos > SEQ - 1 ? SEQ - 1 : pos); return LC + pos; }
      return 64 * (c - nloc) + row;
    };
  };
  KVRegs kr;
  __syncthreads();
  kv_load(p, kr, koff, voff, tokfn(0), tid);
  kv_store(kr, smem, tid);
  __syncthreads();
  for (int c = 0; c < nch; ++c) {
    const char* stage = smem + (c & 1) * 16384;
    if (c + 1 < nch) kv_load(p, kr, koff, voff, tokfn(c + 1), tid);
    if (c < nloc) {
      const int qpos = q0 + 16 * wv + lr;
#pragma unroll
      for (int st = 0; st < 2; ++st) {
        const int kbase = q0 - 128 + 64 * c + 32 * st;
        attn_step(stage, 32 * st, qf, o, lsum, [&](int t2, int r, float s) {
          int kpos = kbase + 16 * t2 + 4 * g + r;
          int dlt = kpos - qpos; dlt = dlt < 0 ? -dlt : dlt;
          bool valid = (kpos >= 0) && (kpos < SEQ) && (dlt <= 128);
          return valid ? s - bound : -1e30f;
        }, lane);
      }
    } else {
#pragma unroll
      for (int st = 0; st < 2; ++st) attn_step(stage, 32 * st, qf, o, lsum, [&](int t2, int r, float s) { return s - bound; }, lane);
    }
    if (c + 1 < nch) kv_store(kr, smem + ((c + 1) & 1) * 16384, tid);
    __syncthreads();
  }
  if (has_sink && g == 0) lsum += exp2f(sink2 - bound);
  attn_store_out(p, o, lsum, qtok, ooff, lane);
}

__device__ void attn_na_item(const P& p, int l, int r, int h, char* smem) {
  const int tid = tid_opaque(), lane = tid & 63, wv = tid >> 6, g = lane >> 4, lr = lane & 15;
  const int qoff = OFF_QN + h * 64, koff = OFF_KN + h * 64, voff = OFF_VN + h * 64, ooff = 640 + h * 64;
  float* rpbl = (float*)(smem + 32768);
  const float* rpbg = p.rpb + (size_t)(l * 6 + h) * 465;
  float bmax = 0.f;
  __syncthreads();
  for (int i = tid; i < 465; i += 256) { float b = rpbg[i] * LOG2E; rpbl[i] = b; }
  for (int i = lane; i < 465; i += 64) bmax = fmaxf(bmax, fabsf(rpbg[i]) * LOG2E);
  bmax = wave_max(bmax);
  const float bound = 8.f * LOG2E * wave_max(fabsf(p.na_qn[l * 64 + lane])) * wave_max(fabsf(p.na_kn[l * 64 + lane])) * 1.0001f + bmax + 1e-3f;
  const int qcol = 16 * wv + lr;
  const int qtok = LC + r * 64 + qcol;
  const int kr0r = min(max(r - 4, 0), 248);
  const int kc0 = min(max(16 * wv - 8, 0), 32);
  const int qs = min(max(qcol - 8, 0), 48);
  bf16x8 qf[2];
#pragma unroll
  for (int s = 0; s < 2; ++s) qf[s] = *(const bf16x8*)(p.projb + (size_t)qtok * DIN + qoff + 32 * s + 8 * g);
  f32x4 o[4];
#pragma unroll
  for (int m = 0; m < 4; ++m) o[m] = (f32x4){0.f, 0.f, 0.f, 0.f};
  float lsum = 0.f;
  auto tokfn = [&](int c) {
    return [=](int row) { return c < 8 ? LC + (kr0r + c) * 64 + row : 64 * (c - 8) + row; };
  };
  KVRegs kr;
  kv_load(p, kr, koff, voff, tokfn(0), tid);
  kv_store(kr, smem, tid);
  __syncthreads();
  for (int c = 0; c < 12; ++c) {
    const char* stage = smem + (c & 1) * 16384;
    if (c + 1 < 12) kv_load(p, kr, koff, voff, tokfn(c + 1), tid);
    if (c < 8) {
      const int dr = kr0r + c - r + 7;
      attn_step(stage, kc0, qf, o, lsum, [&](int t2, int rr, float s) {
        int kcol = kc0 + 16 * t2 + 4 * g + rr;
        bool valid = (kcol >= qs) && (kcol < qs + 16);
        int dc = kcol - qcol + 15; dc = dc < 0 ? 0 : (dc > 30 ? 30 : dc);
        return valid ? s + rpbl[dr * 31 + dc] - bound : -1e30f;
      }, lane);
    } else {
#pragma unroll
      for (int st = 0; st < 2; ++st) attn_step(stage, 32 * st, qf, o, lsum, [&](int t2, int rr, float s) { return s - bound; }, lane);
    }
    if (c + 1 < 12) kv_store(kr, smem + ((c + 1) & 1) * 16384, tid);
    __syncthreads();
  }
  attn_store_out(p, o, lsum, qtok, ooff, lane);
}

__device__ void ph_attn(const P& p, int l, char* smem) {
  const int nitems = 3072 + (l == 0 ? 48 : 0);
  for (int it = blockIdx.x; it < nitems; it += gridDim.x) {
    if (it < 1536) attn_win_item(p, l, 0, it / 6, it % 6, smem);
    else if (it < 3072) { int j = it - 1536; attn_na_item(p, l, j / 6, j % 6, smem); }
    else { int j = it - 3072; attn_win_item(p, l, 1, j / 12, j % 12, smem); }
  }
}

__device__ __forceinline__ unsigned ord_key(float s) {
  unsigned u = __float_as_uint(s);
  return (u & 0x80000000u) ? ~u : (u | 0x80000000u);
}
__device__ __forceinline__ float ord_val(unsigned pk) {
  unsigned u = pk & ~127u;
  unsigned b = (u & 0x80000000u) ? (u & 0x7fffffffu) : ~u;
  return __uint_as_float(b);
}
__device__ __forceinline__ void ce_desc(unsigned& a, unsigned& b) {
  unsigned mx = a > b ? a : b, mn = a > b ? b : a;
  a = mx; b = mn;
}
__device__ __forceinline__ void sort16_desc(unsigned (&v)[16]) {
#pragma unroll
  for (int k = 2; k <= 16; k <<= 1) {
#pragma unroll
    for (int j = k >> 1; j > 0; j >>= 1) {
#pragma unroll
      for (int i = 0; i < 16; ++i) {
        int m = i ^ j;
        if (m > i) {
          if ((i & k) == 0) ce_desc(v[i], v[m]); else ce_desc(v[m], v[i]);
        }
      }
    }
  }
}
__device__ __forceinline__ void merge16_desc(unsigned (&a)[16], const unsigned (&b)[16]) {
#pragma unroll
  for (int i = 0; i < 16; ++i) { unsigned o = b[15 - i]; a[i] = a[i] > o ? a[i] : o; }
#pragma unroll
  for (int j = 8; j > 0; j >>= 1) {
#pragma unroll
    for (int i = 0; i < 16; ++i) {
      int m = i ^ j;
      if (m > i) ce_desc(a[i], a[m]);
    }
  }
}

__device__ void ph_prep_peer(const P& p) {
  const size_t n4 = (size_t)2 * 16384 * 1024 / 4;
  for (size_t i = GTID; i < n4; i += GSZ) {
    float4 a = ((const float4*)p.pu)[i], b = ((const float4*)p.pv)[i];
    ((uint2*)p.ub16)[i] = make_uint2(pack2bf(a.x, a.y), pack2bf(a.z, a.w));
    ((uint2*)p.vb16)[i] = make_uint2(pack2bf(b.x, b.y), pack2bf(b.z, b.w));
  }
  for (int i = GTID; i < 2 * 128 * 128; i += GSZ) { p.k1b[i] = f2bf(p.k1[i]); p.k2b[i] = f2bf(p.k2[i]); }
}

struct EpiPeerTopk {
  int l;
  __device__ __forceinline__ void operator()(const P& p, f32x4 (&acc)[4][4], int m0, int n0, int wm, int wn, int lane, char* smem) const {
    const int tid = ((wm * 2 + wn) << 6) | lane, g = lane >> 4, lr = lane & 15;
    const int nt = n0 >> 7, head = nt >> 1, hf = nt & 1;
    char* qimg = smem;
    char* kimg = smem + 34816;
    {
      char* qw = qimg + (wm * 64 + 4 * g) * 272 + (wn * 64 + lr) * 2;
#pragma unroll
      for (int i = 0; i < 4; ++i)
#pragma unroll
        for (int r = 0; r < 4; ++r)
#pragma unroll
          for (int j = 0; j < 4; ++j) *(bf16_t*)(qw + (16 * i + r) * 272 + 32 * j) = f2bf(acc[i][j][r]);
      const bf16_t* kk = (hf ? p.k2b : p.k1b) + (size_t)l * 16384 + (tid >> 4) * 128 + (tid & 15) * 8;
      char* kw = kimg + (tid >> 4) * 272 + (tid & 15) * 16;
#pragma unroll
      for (int i = 0; i < 8; ++i) *(uint4*)(kw + i * 16 * 272) = *(const uint4*)(kk + i * 16 * 128);
    }
    __syncthreads();
#pragma unroll
    for (int i = 0; i < 4; ++i)
#pragma unroll
      for (int j = 0; j < 4; ++j) acc[i][j] = (f32x4){0.f, 0.f, 0.f, 0.f};
    {
      const char* qa = qimg + (wm * 64 + lr) * 272 + g * 16;
      const char* kb = kimg + (wn * 64 + lr) * 272 + g * 16;
#pragma unroll
      for (int s = 0; s < 4; ++s) {
        bf16x8 af[4], bfr[4];
#pragma unroll
        for (int i = 0; i < 4; ++i) af[i] = *(const bf16x8*)(qa + i * 16 * 272 + s * 64);
#pragma unroll
        for (int j = 0; j < 4; ++j) bfr[j] = *(const bf16x8*)(kb + j * 16 * 272 + s * 64);
#pragma unroll
        for (int i = 0; i < 4; ++i)
#pragma unroll
          for (int j = 0; j < 4; ++j) acc[i][j] = __builtin_amdgcn_mfma_f32_16x16x32_bf16(af[i], bfr[j], acc[i][j], 0, 0, 0);
      }
    }
    __syncthreads();
    unsigned* simg = (unsigned*)smem;
    {
      unsigned* sw = simg + (wm * 64 + 4 * g) * 129 + wn * 64 + lr;
#pragma unroll
      for (int i = 0; i < 4; ++i)
#pragma unroll
        for (int r = 0; r < 4; ++r)
#pragma unroll
          for (int j = 0; j < 4; ++j)
            sw[(16 * i + r) * 129 + 16 * j] = (ord_key(acc[i][j][r]) & ~127u) | (unsigned)(wn * 64 + 16 * j + lr);
    }
    __syncthreads();
    const int row = tid & 127, half = tid >> 7;
    unsigned top[16];
    {
      const unsigned* sr = simg + row * 129 + half * 64;
#pragma unroll
      for (int k = 0; k < 16; ++k) top[k] = sr[k];
      sort16_desc(top);
#pragma unroll 1
      for (int gi = 1; gi < 4; ++gi) {
        unsigned v1[16];
#pragma unroll
        for (int k = 0; k < 16; ++k) v1[k] = sr[gi * 16 + k];
        sort16_desc(v1);
        merge16_desc(top, v1);
      }
    }
    __syncthreads();
    if (half == 1) {
#pragma unroll
      for (int k = 0; k < 16; ++k) simg[k * 128 + row] = top[k];
    }
    __syncthreads();
    if (half == 0) {
      unsigned o[16];
#pragma unroll
      for (int k = 0; k < 16; ++k) o[k] = simg[k * 128 + row];
      merge16_desc(top, o);
      uint4* dst = (uint4*)(p.pk + (((size_t)(m0 + row) * 8 + head) * 2 + hf) * 16);
#pragma unroll
      for (int k = 0; k < 4; ++k) dst[k] = make_uint4(top[4 * k], top[4 * k + 1], top[4 * k + 2], top[4 * k + 3]);
    }
  }
};

__device__ const unsigned char CAND_A[64] = {0,0,0,0,0,0,0,0,0,0,0,0,0,0,0,0, 1,1,1,1,1,1,1,1, 2,2,2,2,2, 3,3,3,3, 4,4,4, 5,5, 6,6, 7,7,
                                             8,9,10,11,12,13,14,15, 0,0,0,0,0,0,0,0,0,0,0,0,0,0};
__device__ const unsigned char CAND_B[64] = {0,1,2,3,4,5,6,7,8,9,10,11,12,13,14,15, 0,1,2,3,4,5,6,7, 0,1,2,3,4, 0,1,2,3, 0,1,2, 0,1, 0,1, 0,1,
                                             0,0,0,0,0,0,0,0, 0,0,0,0,0,0,0,0,0,0,0,0,0,0};

__device__ void ph_peer_apply2(const P& p, int l, int t0, char* smem) {
  const int tid = tid_opaque(), lane = tid & 63, wv = tid >> 6;
  int* lds_e = (int*)(smem + wv * 1024);
  float* lds_g = (float*)(smem + wv * 1024 + 512);
  const bf16_t* U = p.ub16 + (size_t)l * 16384 * 1024;
  const bf16_t* V = p.vb16 + (size_t)l * 16384 * 1024;
  const float* n2g = p.norm2_g + l * 1024;
  const int ca = CAND_A[lane], cb = CAND_B[lane];
  for (int tk = t0 + blockIdx.x * 4 + wv; tk < TT; tk += gridDim.x * 4) {
    const float* mod = p.mod + (l * 2 + (tk < LC ? 1 : 0)) * 6144;
    float xv[16], hv[16];
    {
      const float4* xp = (const float4*)(p.xall + (size_t)tk * 1024);
      float ss = 0.f;
#pragma unroll
      for (int i = 0; i < 2; ++i)
#pragma unroll
        for (int q = 0; q < 2; ++q) {
          float4 v = xp[(i * 64 + lane) * 2 + q];
          xv[i * 8 + q * 4 + 0] = v.x; xv[i * 8 + q * 4 + 1] = v.y; xv[i * 8 + q * 4 + 2] = v.z; xv[i * 8 + q * 4 + 3] = v.w;
          ss += v.x * v.x + v.y * v.y + v.z * v.z + v.w * v.w;
        }
      ss = wave_sum(ss);
      float rinv = rsqrtf(ss * (1.f / 1024.f) + EPS);
#pragma unroll
      for (int i = 0; i < 2; ++i)
#pragma unroll
        for (int k = 0; k < 8; ++k) {
          int d = (i * 64 + lane) * 8 + k;
          hv[i * 8 + k] = xv[i * 8 + k] * rinv * n2g[d] * (1.f + mod[4096 + d]) + mod[3072 + d];
        }
    }
    for (int head = 0; head < 8; ++head) {
      const unsigned* pk = p.pk + ((size_t)tk * 8 + head) * 32;
      unsigned p1 = pk[ca], p2 = pk[16 + cb];
      float sum = lane < 50 ? ord_val(p1) + ord_val(p2) : -3.0e38f;
      int eid = (int)(p1 & 127u) * 128 + (int)(p2 & 127u);
      int rank = 0;
      for (int m = 0; m < 50; ++m) {
        float sm = __shfl(sum, m);
        rank += (sm > sum || (sm == sum && m < lane)) ? 1 : 0;
      }
      float mx = sum;
#pragma unroll
      for (int o = 32; o > 0; o >>= 1) mx = fmaxf(mx, __shfl_xor(mx, o));
      bool sel = (lane < 50) && (rank < 16);
      float e = sel ? __expf(sum - mx) : 0.f;
      float tot = wave_sum(e);
      if (sel) { lds_e[head * 16 + rank] = eid; lds_g[head * 16 + rank] = e / tot; }
    }
    float acc[16];
#pragma unroll
    for (int k = 0; k < 16; ++k) acc[k] = 0.f;
    for (int e0 = 0; e0 < 128; e0 += 4) {
      uint4 ur[4][2], vr[4][2];
      float gt[4];
#pragma unroll
      for (int k = 0; k < 4; ++k) {
        int ex = __builtin_amdgcn_readfirstlane(lds_e[e0 + k]);
        gt[k] = lds_g[e0 + k];
        const uint4* up = (const uint4*)(U + (size_t)ex * 1024);
        const uint4* vp = (const uint4*)(V + (size_t)ex * 1024);
        ur[k][0] = up[lane]; ur[k][1] = up[64 + lane];
        vr[k][0] = vp[lane]; vr[k][1] = vp[64 + lane];
      }
#pragma unroll
      for (int k = 0; k < 4; ++k) {
        float dot = 0.f;
#pragma unroll
        for (int i = 0; i < 2; ++i) {
          unsigned w[4] = {ur[k][i].x, ur[k][i].y, ur[k][i].z, ur[k][i].w};
#pragma unroll
          for (int q = 0; q < 4; ++q) {
            dot += __uint_as_float(w[q] << 16) * hv[i * 8 + 2 * q];
            dot += __uint_as_float(w[q] & 0xffff0000u) * hv[i * 8 + 2 * q + 1];
          }
        }
        dot = wave_sum(dot);
        float a = gt[k] * gelu_f(dot);
#pragma unroll
        for (int i = 0; i < 2; ++i) {
          unsigned w[4] = {vr[k][i].x, vr[k][i].y, vr[k][i].z, vr[k][i].w};
#pragma unroll
          for (int q = 0; q < 4; ++q) {
            acc[i * 8 + 2 * q] += a * __uint_as_float(w[q] << 16);
            acc[i * 8 + 2 * q + 1] += a * __uint_as_float(w[q] & 0xffff0000u);
          }
        }
      }
    }
    {
      float4* xp = (l == 1) ? (float4*)(p.out + (size_t)(tk - LC) * 1024) : (float4*)(p.xall + (size_t)tk * 1024);
#pragma unroll
      for (int i = 0; i < 2; ++i)
#pragma unroll
        for (int q = 0; q < 2; ++q) {
          int d = (i * 64 + lane) * 8 + q * 4;
          float4 gg = *(const float4*)(mod + 5120 + d);
          float4 o;
          o.x = xv[i * 8 + q * 4 + 0] + gg.x * acc[i * 8 + q * 4 + 0];
          o.y = xv[i * 8 + q * 4 + 1] + gg.y * acc[i * 8 + q * 4 + 1];
          o.z = xv[i * 8 + q * 4 + 2] + gg.z * acc[i * 8 + q * 4 + 2];
          o.w = xv[i * 8 + q * 4 + 3] + gg.w * acc[i * 8 + q * 4 + 3];
          xp[(i * 64 + lane) * 2 + q] = o;
        }
    }
  }
}

#define XB_TMO      128
#define XB_XCNT(j)  (256  + 64 * (j))
#define XB_XSUB(j)  (1280 + 64 * (j))
#define XB_XGEN(j)  (2304 + 64 * (j))
#define XB_TOP      3328
#define XB_TOPGEN   3392
#define XCD_BAR_WORDS 3456
#define XB_SPIN_CAP (1u << 22)
#define LAS __attribute__((address_space(3)))
__device__ __forceinline__ unsigned xb_ld(unsigned* q) { return __hip_atomic_load(q, __ATOMIC_RELAXED, __HIP_MEMORY_SCOPE_AGENT); }
__device__ __forceinline__ unsigned xb_add(unsigned* q, unsigned v) { return __hip_atomic_fetch_add(q, v, __ATOMIC_RELAXED, __HIP_MEMORY_SCOPE_AGENT); }
__device__ __forceinline__ unsigned xb_xcc_id() { return (unsigned)__builtin_amdgcn_s_getreg((3 << 11) | 20) & 0xFu; }
#define XB_SPIN(cond, bar) do { unsigned _sp = 0; while (cond) { __builtin_amdgcn_s_sleep(1); \
    if ((++_sp & 255u) == 0u) { if (xb_ld(&(bar)[XB_TMO])) break; if (_sp > XB_SPIN_CAP) { atomicAdd(&(bar)[XB_TMO], 1u); break; } } } } while (0)
struct XcdBarrier { unsigned* bar; unsigned x; volatile LAS unsigned* st; };
__device__ __forceinline__ XcdBarrier xcd_barrier_post(unsigned* bar, volatile LAS unsigned* st) {
  XcdBarrier b; b.bar = bar; b.x = xb_xcc_id(); b.st = st;
  if (threadIdx.x == 0) (void)xb_add(&bar[XB_XCNT(b.x)], 1u);
  return b;
}
__device__ __forceinline__ void xcd_barrier_complete(unsigned* bar, unsigned x, unsigned& nloc, unsigned& nx) {
  const unsigned G = gridDim.x * gridDim.y * gridDim.z;
  unsigned sum, cnt, mine, sp = 0u;
  for (;;) {
    sum = 0u; cnt = 0u; mine = 0u;
#pragma unroll
    for (unsigned j = 0; j < 16; ++j) { const unsigned c = xb_ld(&bar[XB_XCNT(j)]); sum += c; cnt += (c > 0u) ? 1u : 0u; mine = (j == x) ? c : mine; }
    if (sum == G) break;
    __builtin_amdgcn_s_sleep(1);
    if ((++sp & 255u) == 0u) { if (xb_ld(&bar[XB_TMO])) break; if (sp > XB_SPIN_CAP) { atomicAdd(&bar[XB_TMO], 1u); break; } }
  }
  nloc = mine > 0u ? mine : 1u; nx = cnt > 0u ? cnt : 1u;
}
__device__ __forceinline__ void xcd_barrier(const XcdBarrier& b) {
  asm volatile("s_waitcnt vmcnt(0)" ::: "memory");
  __syncthreads();
  if (threadIdx.x == 0) {
    unsigned* bar = b.bar;
    __builtin_amdgcn_s_waitcnt(0);
    unsigned nloc = b.st[0], nx = b.st[1];
    if (nloc == 0u) { xcd_barrier_complete(bar, b.x, nloc, nx); b.st[0] = nloc; b.st[1] = nx; }
    const unsigned old = xb_add(&bar[XB_XSUB(b.x)], 1u);
    const unsigned gen = old / nloc;
    if (old + 1u == (gen + 1u) * nloc) {
      __builtin_amdgcn_fence(__ATOMIC_RELEASE, "agent");
      asm volatile("s_waitcnt vmcnt(0)" ::: "memory");
      const unsigned og = xb_add(&bar[XB_TOP], 1u);
      const unsigned tg = og / nx;
      if (og + 1u == (tg + 1u) * nx) xb_add(&bar[XB_TOPGEN], 1u);
      else XB_SPIN(xb_ld(&bar[XB_TOPGEN]) == tg, bar);
      __builtin_amdgcn_fence(__ATOMIC_ACQUIRE, "agent");
      xb_add(&bar[XB_XGEN(b.x)], 1u);
      asm volatile("s_waitcnt vmcnt(0)" ::: "memory");
    } else {
      XB_SPIN(xb_ld(&bar[XB_XGEN(b.x)]) == gen, bar);
      __builtin_amdgcn_fence(__ATOMIC_ACQUIRE, "agent");
      asm volatile("s_waitcnt vmcnt(0)" ::: "memory");
    }
  }
  __syncthreads();
}

__global__ void __launch_bounds__(256, 2) k_mega(P p) {
  __shared__ __attribute__((aligned(16))) float smem[18432];
  __shared__ uint4 xb_words;
  cg::grid_group grid = cg::this_grid();
  if (threadIdx.x == 0) xb_words = make_uint4(0u, 0u, 0u, 0u);
  __syncthreads();
  ph_mod(p);
  ph_prep(p, smem);
  ph_lru_prepw(p);
  ph_prep_peer(p);
  grid.sync();
  XcdBarrier xb = xcd_barrier_post(p.bar, (volatile LAS unsigned*)&xb_words);
  ph_norm_mod(p, 0, 0, 0, smem, true);
  xcd_barrier(xb);
  for (int l = 0; l < 2; ++l) {
    const int t0 = (l == 0) ? 0 : LC;
    gemm_bf16_128(p, p.hb, p.w_in_t + (size_t)l * 1024 * DIN, 1024, 0, TT, DIN, (char*)smem, EpiProjSplit{});
    xcd_barrier(xb);
    ph_qknorm_rope2(p, l);
    xcd_barrier(xb);
    ph_lru<1>(p, l, (char*)smem);
    ph_attn(p, l, (char*)smem);
    xcd_barrier(xb);
    ph_lru<2>(p, l, (char*)smem);
    xcd_barrier(xb);
    gemm_bf16_128(p, p.mixb, p.w_out_t + (size_t)l * 1024 * 1024, 1024, t0, TT, 1024, (char*)smem, EpiResid{l, 2048});
    xcd_barrier(xb);
    ph_norm_mod(p, l, 1, t0, smem);
    xcd_barrier(xb);
    gemm_bf16_128(p, p.hb, p.wq_t + (size_t)l * 1024 * NPQ, 1024, t0, TT, NPQ, (char*)smem, EpiPeerTopk{l});
    xcd_barrier(xb);
    ph_peer_apply2(p, l, t0, (char*)smem);
    if (l == 0) {
      xcd_barrier(xb);
      ph_norm_mod(p, 1, 0, 0, smem);
      xcd_barrier(xb);
    }
  }
}

extern "C" void kernel_launch(void* const* d_in, const int* in_sizes, int n_in, void* d_out, int out_size, void* d_ws,
                              size_t ws_size, hipStream_t stream) {
  P p{};
  const float** fp = (const float**)&p;
  for (int i = 0; i < 28; ++i) fp[i] = (const float*)d_in[i];
  p.out = (float*)d_out;
  float* w = (float*)d_ws;
  size_t o = 0;
  auto carve = [&](size_t n) { float* r = w + o; o += (n + 63) & ~(size_t)63; return r; };
  p.bar = (unsigned*)carve(4096);
  p.mod = carve(4 * 6144);
  p.xall = carve((size_t)TT * 1024);
  p.proj = carve((size_t)TT * 512);
  p.projb = (bf16_t*)carve((size_t)TT * DIN / 2);
  p.mixb = (bf16_t*)carve((size_t)TT * 512);
  p.hb = (bf16_t*)carve((size_t)TT * 512);
  p.w_in_t = (bf16_t*)carve((size_t)1024 * DIN);
  p.w_out_t = (bf16_t*)carve((size_t)1024 * 1024);
  p.wq_t = (bf16_t*)carve((size_t)1024 * NPQ);
  p.lruw_t = (bf16_t*)carve((size_t)2 * 2 * 4 * 2 * 4096 / 2);
  p.lagg = carve((size_t)2 * NCHUNK * 256 * 2);
  p.pk = (unsigned*)carve((size_t)TT * 256);
  p.ub16 = (bf16_t*)carve((size_t)16384 * 1024);
  p.vb16 = (bf16_t*)carve((size_t)16384 * 1024);
  p.k1b = (bf16_t*)carve(16384);
  p.k2b = (bf16_t*)carve(16384);
  if (o * 4 > ws_size) { fprintf(stderr, "workspace too small: need %zu have %zu\n", o * 4, ws_size); return; }
  static int grid_blocks = 0;
  if (!grid_blocks) {
    int dev = 0, cus = 0, per_cu = 0;
    (void)hipGetDevice(&dev);
    (void)hipDeviceGetAttribute(&cus, hipDeviceAttributeMultiprocessorCount, dev);
    (void)hipOccupancyMaxActiveBlocksPerMultiprocessor(&per_cu, k_mega, 256, 0);
    if (per_cu > 2) per_cu = 2;
    grid_blocks = cus * per_cu;
  }
  (void)hipMemsetAsync(p.bar, 0, XCD_BAR_WORDS * 4, stream);
  void* args[] = {&p};
  hipError_t e = hipLaunchCooperativeKernel((void*)k_mega, dim3(grid_blocks), dim3(256), args, 0, stream);
  if (e != hipSuccess) fprintf(stderr, "cooperative launch failed: %s (grid %d)\n", hipGetErrorString(e), grid_blocks);
}
```

```cpp
#include <hip/hip_runtime.h>
#include <hip/hip_cooperative_groups.h>
#include <stdint.h>
#include <stdio.h>
namespace cg = cooperative_groups;

#ifndef SINGLE_LAUNCH
#define SINGLE_LAUNCH 1
#endif

constexpr int DM = 1024, SEQ = 16384, LC = 256, TT = SEQ + LC, DIN = 2304, NPQ = 2048;
constexpr int OFF_XA = 0, OFF_GA = 256, OFF_QW = 512, OFF_KW = 896, OFF_VW = 1024, OFF_QN = 1152, OFF_KN = 1536, OFF_VN = 1920;
constexpr float EPS = 1e-6f;

struct P {
  const float *x, *c, *ctx, *c_ctx, *w_mod, *b_mod, *norm1_g, *norm2_g, *w_in, *w_out,
      *conv_w, *conv_b, *wa, *ba, *wx, *bx, *lam, *win_qn, *win_kn, *win_sink, *na_qn, *na_kn, *rpb,
      *wq, *k1, *k2, *pu, *pv;
  float* out;
  float *mod, *xall, *proj;
  unsigned short* projb;
  unsigned* pk;
  unsigned* bar;
  unsigned short *k1b, *k2b;
  unsigned char *ub8, *vb8;
  float *usc, *vsc;
  unsigned short *hb, *mixb, *w_in_t, *w_out_t, *wq_t, *lruw_t;
  float* lagg;
};

typedef unsigned short bf16_t;
typedef __attribute__((ext_vector_type(8))) short bf16x8;
typedef __attribute__((ext_vector_type(4))) float f32x4;
__device__ __forceinline__ unsigned short f2bf(float f) {
  unsigned u = __float_as_uint(f);
  u += 0x7fffu + ((u >> 16) & 1u);
  return (unsigned short)(u >> 16);
}
__device__ __forceinline__ unsigned pack2bf(float a, float b) { return (unsigned)f2bf(a) | ((unsigned)f2bf(b) << 16); }
__device__ __forceinline__ float bf2f(unsigned short h) { return __uint_as_float(((unsigned)h) << 16); }


__device__ __forceinline__ float silu_f(float x) { return x / (1.f + __expf(-x)); }
__device__ __forceinline__ float sigmoid_f(float x) { return 1.f / (1.f + __expf(-x)); }
__device__ __forceinline__ float gelu_f(float x) {
  float u = 0.7978845608028654f * (x + 0.044715f * x * x * x);
  float e = __expf(2.f * u);
  float th = 1.f - 2.f / (e + 1.f);
  return 0.5f * x * (1.f + th);
}
template <int CTRL, int RMASK>
__device__ __forceinline__ float dpp_mov(float v) {
  return __int_as_float(__builtin_amdgcn_update_dpp(0, __float_as_int(v), CTRL, RMASK, 0xf, false));
}
__device__ __forceinline__ float wave_sum(float v) {
  v += dpp_mov<0xB1, 0xf>(v);
  v += dpp_mov<0x4E, 0xf>(v);
  v += dpp_mov<0x141, 0xf>(v);
  v += dpp_mov<0x140, 0xf>(v);
  v += dpp_mov<0x142, 0xa>(v);
  v += dpp_mov<0x143, 0xc>(v);
  return __int_as_float(__builtin_amdgcn_readlane(__float_as_int(v), 63));
}

__device__ __forceinline__ int tid_opaque() { int t = threadIdx.x; asm volatile("" : "+v"(t)); return t; }
#define GTID (blockIdx.x * blockDim.x + tid_opaque())
#define GSZ (gridDim.x * blockDim.x)

__device__ void ph_mod(const P& p, float* smem) {
  const int tid = tid_opaque(), cl = tid & 31, ks = tid >> 5;
  for (int it = blockIdx.x; it < 2 * 192; it += gridDim.x) {
    const int nc = it % 192, l = it / 192;
    const int n = nc * 32 + cl;
    const float* w = p.w_mod + (size_t)l * 1024 * 6144 + n;
    float a0 = 0.f, a1 = 0.f;
#pragma unroll 8
    for (int i = 0; i < 128; ++i) {
      int k = i * 8 + ks;
      float wv = w[(size_t)k * 6144];
      a0 += silu_f(p.c[k]) * wv;
      a1 += silu_f(p.c_ctx[k]) * wv;
    }
    __syncthreads();
    smem[tid] = a0; smem[256 + tid] = a1;
    __syncthreads();
    if (tid < 64) {
      const int which = tid >> 5;
      float s = p.b_mod[l * 6144 + n];
#pragma unroll
      for (int q = 0; q < 8; ++q) s += smem[which * 256 + q * 32 + cl];
      p.mod[(l * 2 + which) * 6144 + n] = s;
    }
  }
}

__device__ void ph_copy_in(const P& p) {
  const float4* xs = (const float4*)p.x;
  const float4* cs = (const float4*)p.ctx;
  float4* d = (float4*)p.xall;
  for (int i = GTID; i < TT * 256; i += GSZ) d[i] = (i < LC * 256) ? cs[i] : xs[i - LC * 256];
}

__device__ void ph_copy_out(const P& p) {
  const float4* s = (const float4*)(p.xall + (size_t)LC * 1024);
  float4* d = (float4*)p.out;
  for (int i = GTID; i < SEQ * 256; i += GSZ) d[i] = s[i];
}

__device__ void ph_norm_mod(const P& p, int l, int which_norm, int t0, float* smem, bool from_input = false) {
  const float* g = (which_norm ? p.norm2_g : p.norm1_g) + l * 1024;
  const int sh_off = which_norm ? 3072 : 0, sc_off = which_norm ? 4096 : 1024;
  const int tid = tid_opaque();
  for (int t = t0 + blockIdx.x; t < TT; t += gridDim.x) {
    const float* mod = p.mod + (l * 2 + (t < LC ? 1 : 0)) * 6144;
    float4 v;
    if (from_input) {
      v = t < LC ? ((const float4*)(p.ctx + (size_t)t * 1024))[tid] : ((const float4*)(p.x + (size_t)(t - LC) * 1024))[tid];
      ((float4*)(p.xall + (size_t)t * 1024))[tid] = v;
    } else v = ((const float4*)(p.xall + (size_t)t * 1024))[tid];
    float ss = wave_sum(v.x * v.x + v.y * v.y + v.z * v.z + v.w * v.w);
    __syncthreads();
    if ((tid & 63) == 0) smem[tid >> 6] = ss;
    __syncthreads();
    float tot = smem[0] + smem[1] + smem[2] + smem[3];
    float rinv = rsqrtf(tot * (1.f / 1024.f) + EPS);
    float4 gg = ((const float4*)g)[tid];
    float4 sc = ((const float4*)(mod + sc_off))[tid];
    float4 sh = ((const float4*)(mod + sh_off))[tid];
    float4 o;
    o.x = v.x * rinv * gg.x * (1.f + sc.x) + sh.x;
    o.y = v.y * rinv * gg.y * (1.f + sc.y) + sh.y;
    o.z = v.z * rinv * gg.z * (1.f + sc.z) + sh.z;
    o.w = v.w * rinv * gg.w * (1.f + sc.w) + sh.w;
    ((uint2*)(p.hb + (size_t)t * 1024))[tid] = make_uint2(pack2bf(o.x, o.y), pack2bf(o.z, o.w));
  }
}

__device__ void prep_transpose(const float* W, bf16_t* Wt, int K, int N, int item0, int nitems_total, float* smem) {
  (void)nitems_total;
  float(*ts)[65] = (float(*)[65])smem;
  const int tid = tid_opaque();
  const int tn = N / 64, nt = (K / 64) * tn;
  for (int it = blockIdx.x; it < nt; it += gridDim.x) {
    int k0 = (it / tn) * 64, n0 = (it % tn) * 64;
    __syncthreads();
#pragma unroll
    for (int i = 0; i < 16; ++i) {
      int r = (tid >> 6) + i * 4, c = tid & 63;
      ts[r][c] = W[(size_t)(k0 + r) * N + n0 + c];
    }
    __syncthreads();
#pragma unroll
    for (int i = 0; i < 16; ++i) {
      int r = (tid >> 6) + i * 4, c = tid & 63;
      Wt[(size_t)(n0 + r) * K + k0 + c] = f2bf(ts[c][r]);
    }
  }
  (void)item0;
}

__device__ void ph_prep(const P& p, float* smem) {
  for (int l = 0; l < 2; ++l) {
    prep_transpose(p.w_in + (size_t)l * 1024 * DIN, p.w_in_t + (size_t)l * 1024 * DIN, 1024, DIN, 0, 0, smem);
    prep_transpose(p.w_out + (size_t)l * 1024 * 1024, p.w_out_t + (size_t)l * 1024 * 1024, 1024, 1024, 0, 0, smem);
    prep_transpose(p.wq + (size_t)l * 1024 * NPQ, p.wq_t + (size_t)l * 1024 * NPQ, 1024, NPQ, 0, 0, smem);
  }
}

struct EpiStoreF32 {
  float* C; int ldc;
  __device__ __forceinline__ void operator()(const P& p, f32x4 (&acc)[4][4], int m0, int n0, int wm, int wn, int lane, char* smem) const {
    const int mw0 = m0 + wm * 64, nw0 = n0 + wn * 64;
#pragma unroll
    for (int i = 0; i < 4; ++i)
#pragma unroll
      for (int r = 0; r < 4; ++r) {
        int row = mw0 + 16 * i + (lane >> 4) * 4 + r;
#pragma unroll
        for (int j = 0; j < 4; ++j) C[(size_t)row * ldc + nw0 + 16 * j + (lane & 15)] = acc[i][j][r];
      }
  }
};
struct EpiProjSplit {
  __device__ __forceinline__ void operator()(const P& p, f32x4 (&acc)[4][4], int m0, int n0, int wm, int wn, int lane, char* smem) const {
    const int mw0 = m0 + wm * 64, nw0 = n0 + wn * 64;
#pragma unroll
    for (int i = 0; i < 4; ++i)
#pragma unroll
      for (int r = 0; r < 4; ++r) {
        int row = mw0 + 16 * i + (lane >> 4) * 4 + r;
#pragma unroll
        for (int j = 0; j < 4; ++j) {
          int col = nw0 + 16 * j + (lane & 15);
          if (n0 < 512) p.proj[(size_t)row * 512 + col] = acc[i][j][r];
          else p.projb[(size_t)row * DIN + col] = f2bf(acc[i][j][r]);
        }
      }
  }
};
struct EpiResid {
  int l, gofs;
  __device__ __forceinline__ void operator()(const P& p, f32x4 (&acc)[4][4], int m0, int n0, int wm, int wn, int lane, char* smem) const {
    const int mw0 = m0 + wm * 64, nw0 = n0 + wn * 64;
#pragma unroll
    for (int i = 0; i < 4; ++i)
#pragma unroll
      for (int r = 0; r < 4; ++r) {
        int row = mw0 + 16 * i + (lane >> 4) * 4 + r;
        const float* gt = p.mod + (l * 2 + (row < LC ? 1 : 0)) * 6144 + gofs;
#pragma unroll
        for (int j = 0; j < 4; ++j) {
          int col = nw0 + 16 * j + (lane & 15);
          p.xall[(size_t)row * 1024 + col] += gt[col] * acc[i][j][r];
        }
      }
  }
};

template <class Epi>
__device__ void gemm_bf16_128(const P& p, const bf16_t* __restrict__ A, const bf16_t* __restrict__ Bt, int K, int m_begin, int m_end,
                              int N, char* smem, const Epi& epi) {
  const int tid = tid_opaque(), lane = tid & 63, wv = tid >> 6, wm = wv >> 1, wn = wv & 1;
  const int tiles_n = N / 128, tiles_m = (m_end - m_begin) / 128;
  const int nk = K / 64;
  const int lrow = lane & 15, lq = lane >> 4;
  for (int tile = blockIdx.x; tile < tiles_m * tiles_n; tile += gridDim.x) {
    const int m0 = m_begin + (tile / tiles_n) * 128, n0 = (tile % tiles_n) * 128;
    f32x4 acc[4][4];
#pragma unroll
    for (int i = 0; i < 4; ++i)
#pragma unroll
      for (int j = 0; j < 4; ++j) acc[i][j] = (f32x4){0.f, 0.f, 0.f, 0.f};
    uint4 ra[4], rb[4];
    const bf16_t* Ag = A + (size_t)m0 * K;
    const bf16_t* Bg = Bt + (size_t)n0 * K;
#pragma unroll
    for (int i = 0; i < 4; ++i) {
      int id = tid + 256 * i, row = id >> 3, c = id & 7;
      ra[i] = *(const uint4*)(Ag + (size_t)row * K + c * 8);
      rb[i] = *(const uint4*)(Bg + (size_t)row * K + c * 8);
    }
#pragma unroll
    for (int i = 0; i < 4; ++i) {
      int id = tid + 256 * i, row = id >> 3, c = id & 7;
      int off = row * 128 + ((c ^ (row & 7)) << 4);
      *(uint4*)(smem + off) = ra[i];
      *(uint4*)(smem + 16384 + off) = rb[i];
    }
    __syncthreads();
    for (int kt = 0; kt < nk; ++kt) {
      const int cur = (kt & 1) * 32768, nxt = ((kt + 1) & 1) * 32768;
      if (kt + 1 < nk) {
#pragma unroll
        for (int i = 0; i < 4; ++i) {
          int id = tid + 256 * i, row = id >> 3, c = id & 7;
          ra[i] = *(const uint4*)(Ag + (size_t)row * K + (kt + 1) * 64 + c * 8);
          rb[i] = *(const uint4*)(Bg + (size_t)row * K + (kt + 1) * 64 + c * 8);
        }
      }
#pragma unroll
      for (int s = 0; s < 2; ++s) {
        bf16x8 af[4], bfr[4];
#pragma unroll
        for (int i = 0; i < 4; ++i) {
          int row = wm * 64 + 16 * i + lrow;
          af[i] = *(const bf16x8*)(smem + cur + row * 128 + (((4 * s + lq) ^ (row & 7)) << 4));
        }
#pragma unroll
        for (int j = 0; j < 4; ++j) {
          int row = wn * 64 + 16 * j + lrow;
          bfr[j] = *(const bf16x8*)(smem + cur + 16384 + row * 128 + (((4 * s + lq) ^ (row & 7)) << 4));
        }
#pragma unroll
        for (int i = 0; i < 4; ++i)
#pragma unroll
          for (int j = 0; j < 4; ++j) acc[i][j] = __builtin_amdgcn_mfma_f32_16x16x32_bf16(af[i], bfr[j], acc[i][j], 0, 0, 0);
      }
      if (kt + 1 < nk) {
#pragma unroll
        for (int i = 0; i < 4; ++i) {
          int id = tid + 256 * i, row = id >> 3, c = id & 7;
          int off = row * 128 + ((c ^ (row & 7)) << 4);
          *(uint4*)(smem + nxt + off) = ra[i];
          *(uint4*)(smem + nxt + 16384 + off) = rb[i];
        }
      }
      __syncthreads();
    }
    epi(p, acc, m0, n0, wm, wn, lane, smem);
    __syncthreads();
  }
}

constexpr int NCHUNK = TT / 64;
__device__ __forceinline__ int lru_pos(int dir, int c) { return dir == 0 ? c : (c < 4 ? 3 - c : 4 + (NCHUNK - 1 - c)); }

__device__ void ph_lru_prepw(const P& p) {
  for (int idx = GTID; idx < 2 * 2 * 4 * 2 * 4096; idx += GSZ) {
    int d = idx & 63, e = (idx >> 6) & 63, mtx = (idx >> 12) & 1, rest = idx >> 13;
    const float* w = (mtx ? p.wx : p.wa) + (size_t)rest * 4096;
    p.lruw_t[idx] = f2bf(w[d * 64 + e]);
  }
}

template <int PASS>
__device__ void lru_item(const P& p, int l, int cidx, int kb, char* smem) {
  bf16_t* u_img = (bf16_t*)smem;
  float* ab_a = (float*)(smem + 8192);
  float* ab_b = (float*)(smem + 8192 + 16384);
  float* hsum = (float*)(smem + 8192 + 32768);
  float* segagg = (float*)(smem + 8192 + 49152);
  float* ccarry = (float*)(smem + 8192 + 49152 + 2048);
  const int tid = tid_opaque(), lane = tid & 63, wv = tid >> 6, g = lane >> 4, lr = lane & 15;
  const int t0 = cidx * 64;
  const int lo = t0 < LC ? 0 : LC, hi = t0 < LC ? LC : TT;
  __syncthreads();
  {
    const int ch = tid & 63, c = kb * 64 + ch;
    const float cb = p.conv_b[l * 256 + c];
    float cw[4];
#pragma unroll
    for (int k = 0; k < 4; ++k) cw[k] = p.conv_w[(l * 4 + k) * 256 + c];
#pragma unroll
    for (int i = 0; i < 16; ++i) {
      int row = (tid >> 6) + 4 * i, t = t0 + row;
      float acc = cb;
#pragma unroll
      for (int k = 0; k < 4; ++k) {
        int tt = t + k - 2;
        if (tt >= lo && tt < hi) acc += cw[k] * p.proj[(size_t)tt * 512 + OFF_XA + c];
      }
      u_img[row * 64 + ((((ch >> 3) ^ (row & 7)) << 3) | (ch & 7))] = f2bf(acc);
    }
  }
  if (PASS == 2) {
    if (tid < 128) {
      const int ch = tid & 63, dir = tid >> 6;
      const int pos = lru_pos(dir, cidx);
      const float2* ag = (const float2*)p.lagg + (size_t)dir * NCHUNK * 256 + kb * 64 + ch;
      float h = 0.f;
      for (int q = 0; q < pos; ++q) {
        float2 v = ag[(size_t)q * 256];
        h = v.x * h + v.y;
      }
      ccarry[dir * 64 + ch] = h;
    }
  }
  __syncthreads();
  for (int dir = 0; dir < 2; ++dir) {
    const int pd = l * 2 + dir;
    {
      f32x4 ga[4], gx[4];
#pragma unroll
      for (int i = 0; i < 4; ++i) { ga[i] = (f32x4){0.f, 0.f, 0.f, 0.f}; gx[i] = (f32x4){0.f, 0.f, 0.f, 0.f}; }
      const bf16_t* wbase = p.lruw_t + (size_t)((pd * 4 + kb) * 2) * 4096 + (16 * wv + lr) * 64 + 8 * g;
#pragma unroll
      for (int s = 0; s < 2; ++s) {
        bf16x8 ba_ = *(const bf16x8*)(wbase + 32 * s);
        bf16x8 bx_ = *(const bf16x8*)(wbase + 4096 + 32 * s);
#pragma unroll
        for (int i = 0; i < 4; ++i) {
          int row = 16 * i + lr;
          bf16x8 af = *(const bf16x8*)((const char*)u_img + row * 128 + (((4 * s + g) ^ (row & 7)) << 4));
          ga[i] = __builtin_amdgcn_mfma_f32_16x16x32_bf16(af, ba_, ga[i], 0, 0, 0);
          gx[i] = __builtin_amdgcn_mfma_f32_16x16x32_bf16(af, bx_, gx[i], 0, 0, 0);
        }
      }
      const int ch = 16 * wv + lr, c = kb * 64 + ch;
      const float bav = p.ba[pd * 256 + c], bxv = p.bx[pd * 256 + c];
      const float sp = log1pf(expf(-p.lam[pd * 256 + c]));
#pragma unroll
      for (int i = 0; i < 4; ++i)
#pragma unroll
        for (int r = 0; r < 4; ++r) {
          int row = 16 * i + 4 * g + r;
          float rr = sigmoid_f(ga[i][r] + bav), ig = sigmoid_f(gx[i][r] + bxv);
          float log_a = -8.f * rr * sp;
          float a = __expf(log_a);
          float uu = bf2f(u_img[row * 64 + ((((ch >> 3) ^ (row & 7)) << 3) | (ch & 7))]);
          float b = sqrtf(-expm1f(2.f * log_a)) * ig * uu;
          ab_a[row * 64 + ch] = a;
          ab_b[row * 64 + ch] = b;
        }
    }
    __syncthreads();
    {
      const int ch = tid & 63, seg = tid >> 6;
      float Pr = 1.f, H = 0.f;
#pragma unroll
      for (int i = 0; i < 16; ++i) {
        int row = dir == 0 ? seg * 16 + i : seg * 16 + 15 - i;
        float a = ab_a[row * 64 + ch], b = ab_b[row * 64 + ch];
        H = a * H + b;
        Pr *= a;
      }
      segagg[(seg * 64 + ch) * 2] = Pr;
      segagg[(seg * 64 + ch) * 2 + 1] = H;
      __syncthreads();
      if (PASS == 1) {
        if (seg == 0) {
          float A = 1.f, B = 0.f;
#pragma unroll
          for (int s2 = 0; s2 < 4; ++s2) {
            int sg = dir == 0 ? s2 : 3 - s2;
            float pa = segagg[(sg * 64 + ch) * 2], pb = segagg[(sg * 64 + ch) * 2 + 1];
            B = pa * B + pb;
            A *= pa;
          }
          float2* ag = (float2*)p.lagg + ((size_t)dir * NCHUNK + lru_pos(dir, cidx)) * 256 + kb * 64 + ch;
          *ag = make_float2(A, B);
        }
      } else {
        float h = ccarry[dir * 64 + ch];
#pragma unroll
        for (int s2 = 0; s2 < 3; ++s2) {
          int sg = dir == 0 ? s2 : 3 - s2;
          bool before = dir == 0 ? (sg < seg) : (sg > seg);
          if (before) h = segagg[(sg * 64 + ch) * 2] * h + segagg[(sg * 64 + ch) * 2 + 1];
        }
#pragma unroll
        for (int i = 0; i < 16; ++i) {
          int row = dir == 0 ? seg * 16 + i : seg * 16 + 15 - i;
          float a = ab_a[row * 64 + ch], b = ab_b[row * 64 + ch];
          h = a * h + b;
          if (dir == 0) hsum[row * 64 + ch] = h;
          else {
            int t = t0 + row, c = kb * 64 + ch;
            float gv = p.proj[(size_t)t * 512 + OFF_GA + c];
            p.mixb[(size_t)t * 1024 + c] = f2bf((hsum[row * 64 + ch] + h) * gelu_f(gv));
          }
        }
      }
    }
    __syncthreads();
  }
}

template <int PASS>
__device__ void ph_lru(const P& p, int l, char* smem) {
  const int c_begin = (PASS == 2 && l == 1) ? 4 : 0;
  const int nitems = (NCHUNK - c_begin) * 4;
  for (int it = blockIdx.x; it < nitems; it += gridDim.x) lru_item<PASS>(p, l, c_begin + (it >> 2), it & 3, smem);
}

constexpr float LOG2E = 1.4426950408889634f;
constexpr float QSCALE = 0.125f * LOG2E;
typedef __attribute__((ext_vector_type(4))) short s16x4;

__device__ void ph_qknorm_rope2(const P& p, int l) {
  const int tid_ = tid_opaque();
  const int lane = tid_ & 63;
  const int wpb = blockDim.x >> 6;
  for (int pair = blockIdx.x * wpb + (tid_ >> 6); pair < TT * 28; pair += gridDim.x * wpb) {
    int t = pair / 28, slot = pair % 28;
    const float* g = nullptr; bool rope = false; float scale = 1.f;
    if (slot < 6) { g = p.win_qn + l * 64; rope = true; scale = QSCALE; }
    else if (slot < 8) { g = p.win_kn + l * 64; rope = true; }
    else if (slot < 10) { }
    else if (slot < 16) { g = p.na_qn + l * 64; scale = QSCALE; }
    else if (slot < 22) { g = p.na_kn + l * 64; }
    rope = rope && (t >= LC);
    const size_t idx = (size_t)t * DIN + 512 + slot * 64 + lane;
    float v = bf2f(p.projb[idx]);
    float y = v;
    if (g) {
      float ss = wave_sum(v * v);
      y = v * rsqrtf(ss * (1.f / 64.f) + EPS) * g[lane];
    }
    float partner = __shfl_xor(y, 16);
    if (rope) {
      int pos = t - LC, row = pos >> 6, col = pos & 63;
      int j = lane & 15, axis = lane >> 5;
      float inv = __expf(-(float)j * (1.f / 16.f) * 9.210340371976184f);
      float ang = (float)(axis ? col : row) * inv;
      float k = rintf(ang * 0.15915494309189535f);
      float r = fmaf(-k, 6.2831854820251465f, ang);
      r = fmaf(-k, -1.7484555e-07f, r);
      float cs = __cosf(r), sn = __sinf(r);
      bool first = ((lane >> 4) & 1) == 0;
      y = first ? (y * cs - partner * sn) : (partner * sn + y * cs);
    }
    p.projb[idx] = f2bf(y * scale);
  }
}

template <int CTRL, int RMASK>
__device__ __forceinline__ float dpp_mov_id(float v) {
  return __int_as_float(__builtin_amdgcn_update_dpp(__float_as_int(v), __float_as_int(v), CTRL, RMASK, 0xf, false));
}
__device__ __forceinline__ float wave_max(float v) {
  v = fmaxf(v, dpp_mov_id<0xB1, 0xf>(v));
  v = fmaxf(v, dpp_mov_id<0x4E, 0xf>(v));
  v = fmaxf(v, dpp_mov_id<0x141, 0xf>(v));
  v = fmaxf(v, dpp_mov_id<0x140, 0xf>(v));
  v = fmaxf(v, dpp_mov_id<0x142, 0xa>(v));
  v = fmaxf(v, dpp_mov_id<0x143, 0xc>(v));
  return __int_as_float(__builtin_amdgcn_readlane(__float_as_int(v), 63));
}

struct KVRegs { uint4 k[2], v[2]; };
template <class TokFn>
__device__ __forceinline__ void kv_load(const P& p, KVRegs& r, int koff, int voff, TokFn tok, int tid) {
#pragma unroll
  for (int i = 0; i < 2; ++i) {
    int id = tid + 256 * i, row = id >> 3, c = id & 7;
    const bf16_t* base = p.projb + (size_t)tok(row) * DIN + c * 8;
    r.k[i] = *(const uint4*)(base + koff);
    r.v[i] = *(const uint4*)(base + voff);
  }
}
__device__ __forceinline__ void kv_store(const KVRegs& r, char* stage, int tid) {
#pragma unroll
  for (int i = 0; i < 2; ++i) {
    int id = tid + 256 * i, row = id >> 3, c = id & 7;
    int off = row * 128 + ((c ^ (row & 7)) << 4);
    *(uint4*)(stage + off) = r.k[i];
    *(uint4*)(stage + 8192 + off) = r.v[i];
  }
}

template <class MaskFn>
__device__ __forceinline__ void attn_step(const char* stage, int kr0, const bf16x8 (&qf)[2], f32x4 (&o)[4], float& lsum, MaskFn mb, int lane) {
  const int g = lane >> 4, lr = lane & 15;
  f32x4 st[2];
#pragma unroll
  for (int t2 = 0; t2 < 2; ++t2) {
    st[t2] = (f32x4){0.f, 0.f, 0.f, 0.f};
    const int row = kr0 + 16 * t2 + lr;
#pragma unroll
    for (int s = 0; s < 2; ++s) {
      bf16x8 kf = *(const bf16x8*)(stage + row * 128 + (((4 * s + g) ^ (row & 7)) << 4));
      st[t2] = __builtin_amdgcn_mfma_f32_16x16x32_bf16(kf, qf[s], st[t2], 0, 0, 0);
    }
  }
  bf16x8 pb;
#pragma unroll
  for (int t2 = 0; t2 < 2; ++t2)
#pragma unroll
    for (int r = 0; r < 4; ++r) {
      float pv = exp2f(mb(t2, r, st[t2][r]));
      lsum += pv;
      pb[t2 * 4 + r] = (short)f2bf(pv);
    }
  const int q = lr >> 2, pp = lane & 3;
#pragma unroll
  for (int m = 0; m < 4; ++m) {
    bf16x8 vf;
#pragma unroll
    for (int t = 0; t < 2; ++t) {
      const int row = kr0 + 16 * t + 4 * g + q;
      const char* addr = stage + 8192 + row * 128 + (((2 * m + (pp >> 1)) ^ (row & 7)) << 4) + 8 * (pp & 1);
      s16x4 v4 = __builtin_amdgcn_ds_read_tr16_b64_v4i16((__attribute__((address_space(3))) s16x4*)addr);
      vf[4 * t + 0] = v4[0]; vf[4 * t + 1] = v4[1]; vf[4 * t + 2] = v4[2]; vf[4 * t + 3] = v4[3];
    }
    o[m] = __builtin_amdgcn_mfma_f32_16x16x32_bf16(vf, pb, o[m], 0, 0, 0);
  }
}

__device__ __forceinline__ void attn_store_out(const P& p, const f32x4 (&o)[4], float lsum, int tok, int col0, int lane) {
  const int g = lane >> 4;
  lsum += __shfl_xor(lsum, 16);
  lsum += __shfl_xor(lsum, 32);
  const float inv = 1.f / lsum;
  bf16_t* op = p.mixb + (size_t)tok * 1024 + col0 + 4 * g;
#pragma unroll
  for (int m = 0; m < 4; ++m)
    *(uint2*)(op + 16 * m) = make_uint2(pack2bf(o[m][0] * inv, o[m][1] * inv), pack2bf(o[m][2] * inv, o[m][3] * inv));
}

__device__ void attn_win_item(const P& p, int l, int kind, int qb, int hs, char* smem) {
  const int tid = tid_opaque(), lane = tid & 63, wv = tid >> 6, g = lane >> 4, lr = lane & 15;
  int qoff, koff, voff, ooff; const float *gq, *gk; float sink2 = -1e30f; bool has_sink = false;
  if (kind == 0 || hs < 6) {
    const int h = hs, kvh = h / 3;
    qoff = OFF_QW + h * 64; koff = OFF_KW + kvh * 64; voff = OFF_VW + kvh * 64; ooff = 256 + h * 64;
    gq = p.win_qn + l * 64; gk = p.win_kn + l * 64; sink2 = p.win_sink[l * 6 + h] * LOG2E; has_sink = true;
  } else {
    const int h = hs - 6;
    qoff = OFF_QN + h * 64; koff = OFF_KN + h * 64; voff = OFF_VN + h * 64; ooff = 640 + h * 64;
    gq = p.na_qn + l * 64; gk = p.na_kn + l * 64;
  }
  float bound = 8.f * LOG2E * wave_max(fabsf(gq[lane])) * wave_max(fabsf(gk[lane])) * 1.0001f + 1e-3f;
  if (has_sink) bound = fmaxf(bound, sink2);
  const int q0 = qb * 64;
  const int qtok = (kind == 0 ? LC : 0) + q0 + 16 * wv + lr;
  bf16x8 qf[2];
#pragma unroll
  for (int s = 0; s < 2; ++s) qf[s] = *(const bf16x8*)(p.projb + (size_t)qtok * DIN + qoff + 32 * s + 8 * g);
  f32x4 o[4];
#pragma unroll
  for (int m = 0; m < 4; ++m) o[m] = (f32x4){0.f, 0.f, 0.f, 0.f};
  float lsum = 0.f;
  const int nloc = (kind == 0) ? 5 : 0, nch = nloc + 4;
  auto tokfn = [&](int c) {
    return [=](int row) {
      if (c < nloc) { int pos = q0 - 128 + 64 * c + row; pos = pos < 0 ? 0 : (pos > SEQ - 1 ? SEQ - 1 : pos); return LC + pos; }
      return 64 * (c - nloc) + row;
    };
  };
  KVRegs kr;
  __syncthreads();
  kv_load(p, kr, koff, voff, tokfn(0), tid);
  kv_store(kr, smem, tid);
  __syncthreads();
  for (int c = 0; c < nch; ++c) {
    const char* stage = smem + (c & 1) * 16384;
    if (c + 1 < nch) kv_load(p, kr, koff, voff, tokfn(c + 1), tid);
    if (c < nloc) {
      const int qpos = q0 + 16 * wv + lr;
#pragma unroll
      for (int st = 0; st < 2; ++st) {
        const int kbase = q0 - 128 + 64 * c + 32 * st;
        attn_step(stage, 32 * st, qf, o, lsum, [&](int t2, int r, float s) {
          int kpos = kbase + 16 * t2 + 4 * g + r;
          int dlt = kpos - qpos; dlt = dlt < 0 ? -dlt : dlt;
          bool valid = (kpos >= 0) && (kpos < SEQ) && (dlt <= 128);
          return valid ? s - bound : -1e30f;
        }, lane);
      }
    } else {
#pragma unroll
      for (int st = 0; st < 2; ++st) attn_step(stage, 32 * st, qf, o, lsum, [&](int t2, int r, float s) { return s - bound; }, lane);
    }
    if (c + 1 < nch) kv_store(kr, smem + ((c + 1) & 1) * 16384, tid);
    __syncthreads();
  }
  if (has_sink && g == 0) lsum += exp2f(sink2 - bound);
  attn_store_out(p, o, lsum, qtok, ooff, lane);
}

__device__ void attn_na_item(const P& p, int l, int r, int h, char* smem) {
  const int tid = tid_opaque(), lane = tid & 63, wv = tid >> 6, g = lane >> 4, lr = lane & 15;
  const int qoff = OFF_QN + h * 64, koff = OFF_KN + h * 64, voff = OFF_VN + h * 64, ooff = 640 + h * 64;
  float* rpbl = (float*)(smem + 32768);
  const float* rpbg = p.rpb + (size_t)(l * 6 + h) * 465;
  float bmax = 0.f;
  __syncthreads();
  for (int i = tid; i < 465; i += 256) { float b = rpbg[i] * LOG2E; rpbl[i] = b; }
  for (int i = lane; i < 465; i += 64) bmax = fmaxf(bmax, fabsf(rpbg[i]) * LOG2E);
  bmax = wave_max(bmax);
  const float bound = 8.f * LOG2E * wave_max(fabsf(p.na_qn[l * 64 + lane])) * wave_max(fabsf(p.na_kn[l * 64 + lane])) * 1.0001f + bmax + 1e-3f;
  const int qcol = 16 * wv + lr;
  const int qtok = LC + r * 64 + qcol;
  const int kr0r = min(max(r - 4, 0), 248);
  const int kc0 = min(max(16 * wv - 8, 0), 32);
  const int qs = min(max(qcol - 8, 0), 48);
  bf16x8 qf[2];
#pragma unroll
  for (int s = 0; s < 2; ++s) qf[s] = *(const bf16x8*)(p.projb + (size_t)qtok * DIN + qoff + 32 * s + 8 * g);
  f32x4 o[4];
#pragma unroll
  for (int m = 0; m < 4; ++m) o[m] = (f32x4){0.f, 0.f, 0.f, 0.f};
  float lsum = 0.f;
  auto tokfn = [&](int c) {
    return [=](int row) { return c < 8 ? LC + (kr0r + c) * 64 + row : 64 * (c - 8) + row; };
  };
  KVRegs kr;
  kv_load(p, kr, koff, voff, tokfn(0), tid);
  kv_store(kr, smem, tid);
  __syncthreads();
  for (int c = 0; c < 12; ++c) {
    const char* stage = smem + (c & 1) * 16384;
    if (c + 1 < 12) kv_load(p, kr, koff, voff, tokfn(c + 1), tid);
    if (c < 8) {
      const int dr = kr0r + c - r + 7;
      attn_step(stage, kc0, qf, o, lsum, [&](int t2, int rr, float s) {
        int kcol = kc0 + 16 * t2 + 4 * g + rr;
        bool valid = (kcol >= qs) && (kcol < qs + 16);
        int dc = kcol - qcol + 15; dc = dc < 0 ? 0 : (dc > 30 ? 30 : dc);
        return valid ? s + rpbl[dr * 31 + dc] - bound : -1e30f;
      }, lane);
    } else {
#pragma unroll
      for (int st = 0; st < 2; ++st) attn_step(stage, 32 * st, qf, o, lsum, [&](int t2, int rr, float s) { return s - bound; }, lane);
    }
    if (c + 1 < 12) kv_store(kr, smem + ((c + 1) & 1) * 16384, tid);
    __syncthreads();
  }
  attn_store_out(p, o, lsum, qtok, ooff, lane);
}

__device__ void ph_attn(const P& p, int l, char* smem) {
  const int nitems = 3072 + (l == 0 ? 48 : 0);
  for (int it = blockIdx.x; it < nitems; it += gridDim.x) {
    if (it < 1536) attn_win_item(p, l, 0, it / 6, it % 6, smem);
    else if (it < 3072) { int j = it - 1536; attn_na_item(p, l, j / 6, j % 6, smem); }
    else { int j = it - 3072; attn_win_item(p, l, 1, j / 12, j % 12, smem); }
  }
}

__device__ __forceinline__ unsigned ord_key(float s) {
  unsigned u = __float_as_uint(s);
  return (u & 0x80000000u) ? ~u : (u | 0x80000000u);
}
__device__ __forceinline__ float ord_val(unsigned pk) {
  unsigned u = pk & ~127u;
  unsigned b = (u & 0x80000000u) ? (u & 0x7fffffffu) : ~u;
  return __uint_as_float(b);
}
__device__ __forceinline__ void ce_desc(unsigned& a, unsigned& b) {
  unsigned mx = a > b ? a : b, mn = a > b ? b : a;
  a = mx; b = mn;
}
__device__ __forceinline__ void sort16_desc(unsigned (&v)[16]) {
#pragma unroll
  for (int k = 2; k <= 16; k <<= 1) {
#pragma unroll
    for (int j = k >> 1; j > 0; j >>= 1) {
#pragma unroll
      for (int i = 0; i < 16; ++i) {
        int m = i ^ j;
        if (m > i) {
          if ((i & k) == 0) ce_desc(v[i], v[m]); else ce_desc(v[m], v[i]);
        }
      }
    }
  }
}
__device__ __forceinline__ void merge16_desc(unsigned (&a)[16], const unsigned (&b)[16]) {
#pragma unroll
  for (int i = 0; i < 16; ++i) { unsigned o = b[15 - i]; a[i] = a[i] > o ? a[i] : o; }
#pragma unroll
  for (int j = 8; j > 0; j >>= 1) {
#pragma unroll
    for (int i = 0; i < 16; ++i) {
      int m = i ^ j;
      if (m > i) ce_desc(a[i], a[m]);
    }
  }
}

typedef __attribute__((ext_vector_type(2))) float f32x2;
__device__ void ph_prep_peer(const P& p) {
  const int tid = tid_opaque(), lane = tid & 63;
  const int nw = gridDim.x * 4;
  for (int row = blockIdx.x * 4 + (tid >> 6); row < 4 * 16384; row += nw) {
    const int tbl = row >> 15, le = row & 32767;
    const float4* src = (const float4*)((tbl ? p.pv : p.pu) + (size_t)le * 1024) + lane * 4;
    float4 v[4];
    float am = 0.f;
#pragma unroll
    for (int i = 0; i < 4; ++i) {
      v[i] = src[i];
      am = fmaxf(am, fmaxf(fmaxf(fabsf(v[i].x), fabsf(v[i].y)), fmaxf(fabsf(v[i].z), fabsf(v[i].w))));
    }
    am = wave_max(am);
    const float sc = am > 0.f ? 224.f / am : 1.f;
    unsigned w[4];
#pragma unroll
    for (int i = 0; i < 4; ++i) {
      int t = __builtin_amdgcn_cvt_pk_fp8_f32(v[i].x * sc, v[i].y * sc, 0, false);
      t = __builtin_amdgcn_cvt_pk_fp8_f32(v[i].z * sc, v[i].w * sc, t, true);
      w[i] = (unsigned)t;
    }
    ((uint4*)((tbl ? p.vb8 : p.ub8) + (size_t)le * 1024))[lane] = make_uint4(w[0], w[1], w[2], w[3]);
    if (lane == 0) (tbl ? p.vsc : p.usc)[le] = am > 0.f ? am / 224.f : 1.f;
  }
  for (int i = GTID; i < 2 * 128 * 128; i += GSZ) { p.k1b[i] = f2bf(p.k1[i]); p.k2b[i] = f2bf(p.k2[i]); }
}

struct EpiPeerTopk {
  int l;
  __device__ __forceinline__ void operator()(const P& p, f32x4 (&acc)[4][4], int m0, int n0, int wm, int wn, int lane, char* smem) const {
    const int tid = ((wm * 2 + wn) << 6) | lane, g = lane >> 4, lr = lane & 15;
    const int nt = n0 >> 7, head = nt >> 1, hf = nt & 1;
    char* qimg = smem;
    char* kimg = smem + 34816;
    {
      char* qw = qimg + (wm * 64 + 4 * g) * 272 + (wn * 64 + lr) * 2;
#pragma unroll
      for (int i = 0; i < 4; ++i)
#pragma unroll
        for (int r = 0; r < 4; ++r)
#pragma unroll
          for (int j = 0; j < 4; ++j) *(bf16_t*)(qw + (16 * i + r) * 272 + 32 * j) = f2bf(acc[i][j][r]);
      const bf16_t* kk = (hf ? p.k2b : p.k1b) + (size_t)l * 16384 + (tid >> 4) * 128 + (tid & 15) * 8;
      char* kw = kimg + (tid >> 4) * 272 + (tid & 15) * 16;
#pragma unroll
      for (int i = 0; i < 8; ++i) *(uint4*)(kw + i * 16 * 272) = *(const uint4*)(kk + i * 16 * 128);
    }
    __syncthreads();
#pragma unroll
    for (int i = 0; i < 4; ++i)
#pragma unroll
      for (int j = 0; j < 4; ++j) acc[i][j] = (f32x4){0.f, 0.f, 0.f, 0.f};
    {
      const char* qa = qimg + (wm * 64 + lr) * 272 + g * 16;
      const char* kb = kimg + (wn * 64 + lr) * 272 + g * 16;
#pragma unroll
      for (int s = 0; s < 4; ++s) {
        bf16x8 af[4], bfr[4];
#pragma unroll
        for (int i = 0; i < 4; ++i) af[i] = *(const bf16x8*)(qa + i * 16 * 272 + s * 64);
#pragma unroll
        for (int j = 0; j < 4; ++j) bfr[j] = *(const bf16x8*)(kb + j * 16 * 272 + s * 64);
#pragma unroll
        for (int i = 0; i < 4; ++i)
#pragma unroll
          for (int j = 0; j < 4; ++j) acc[i][j] = __builtin_amdgcn_mfma_f32_16x16x32_bf16(af[i], bfr[j], acc[i][j], 0, 0, 0);
      }
    }
    __syncthreads();
    unsigned* simg = (unsigned*)smem;
    {
      unsigned* sw = simg + (wm * 64 + 4 * g) * 129 + wn * 64 + lr;
#pragma unroll
      for (int i = 0; i < 4; ++i)
#pragma unroll
        for (int r = 0; r < 4; ++r)
#pragma unroll
          for (int j = 0; j < 4; ++j)
            sw[(16 * i + r) * 129 + 16 * j] = (ord_key(acc[i][j][r]) & ~127u) | (unsigned)(wn * 64 + 16 * j + lr);
    }
    __syncthreads();
    const int row = tid & 127, half = tid >> 7;
    unsigned top[16];
    {
      const unsigned* sr = simg + row * 129 + half * 64;
#pragma unroll
      for (int k = 0; k < 16; ++k) top[k] = sr[k];
      sort16_desc(top);
#pragma unroll 1
      for (int gi = 1; gi < 4; ++gi) {
        unsigned v1[16];
#pragma unroll
        for (int k = 0; k < 16; ++k) v1[k] = sr[gi * 16 + k];
        sort16_desc(v1);
        merge16_desc(top, v1);
      }
    }
    __syncthreads();
    if (half == 1) {
#pragma unroll
      for (int k = 0; k < 16; ++k) simg[k * 128 + row] = top[k];
    }
    __syncthreads();
    if (half == 0) {
      unsigned o[16];
#pragma unroll
      for (int k = 0; k < 16; ++k) o[k] = simg[k * 128 + row];
      merge16_desc(top, o);
      uint4* dst = (uint4*)(p.pk + (((size_t)(m0 + row) * 8 + head) * 2 + hf) * 16);
#pragma unroll
      for (int k = 0; k < 4; ++k) dst[k] = make_uint4(top[4 * k], top[4 * k + 1], top[4 * k + 2], top[4 * k + 3]);
    }
  }
};

__device__ const unsigned char CAND_A[64] = {0,0,0,0,0,0,0,0,0,0,0,0,0,0,0,0, 1,1,1,1,1,1,1,1, 2,2,2,2,2, 3,3,3,3, 4,4,4, 5,5, 6,6, 7,7,
                                             8,9,10,11,12,13,14,15, 0,0,0,0,0,0,0,0,0,0,0,0,0,0};
__device__ const unsigned char CAND_B[64] = {0,1,2,3,4,5,6,7,8,9,10,11,12,13,14,15, 0,1,2,3,4,5,6,7, 0,1,2,3,4, 0,1,2,3, 0,1,2, 0,1, 0,1, 0,1,
                                             0,0,0,0,0,0,0,0, 0,0,0,0,0,0,0,0,0,0,0,0,0,0};

__device__ void ph_peer_apply2(const P& p, int l, int t0, char* smem) {
  const int tid = tid_opaque(), lane = tid & 63, wv = tid >> 6;
  int* lds_e = (int*)(smem + wv * 1024);
  float* lds_g = (float*)(smem + wv * 1024 + 512);
  const unsigned char* U = p.ub8 + (size_t)l * 16384 * 1024;
  const unsigned char* V = p.vb8 + (size_t)l * 16384 * 1024;
  const float* usc = p.usc + l * 16384;
  const float* vsc = p.vsc + l * 16384;
  const float* n2g = p.norm2_g + l * 1024;
  const int ca = CAND_A[lane], cb = CAND_B[lane];
  for (int tk = t0 + blockIdx.x * 4 + wv; tk < TT; tk += gridDim.x * 4) {
    const float* mod = p.mod + (l * 2 + (tk < LC ? 1 : 0)) * 6144;
    float xv[16], hv[16];
    {
      const float4* xp = (const float4*)(p.xall + (size_t)tk * 1024) + lane * 4;
      float ss = 0.f;
#pragma unroll
      for (int q = 0; q < 4; ++q) {
        float4 v = xp[q];
        xv[q * 4 + 0] = v.x; xv[q * 4 + 1] = v.y; xv[q * 4 + 2] = v.z; xv[q * 4 + 3] = v.w;
        ss += v.x * v.x + v.y * v.y + v.z * v.z + v.w * v.w;
      }
      ss = wave_sum(ss);
      float rinv = rsqrtf(ss * (1.f / 1024.f) + EPS);
#pragma unroll
      for (int q = 0; q < 4; ++q) {
        float4 gg = ((const float4*)n2g)[lane * 4 + q], sc = ((const float4*)(mod + 4096))[lane * 4 + q], sh = ((const float4*)(mod + 3072))[lane * 4 + q];
        hv[q * 4 + 0] = xv[q * 4 + 0] * rinv * gg.x * (1.f + sc.x) + sh.x;
        hv[q * 4 + 1] = xv[q * 4 + 1] * rinv * gg.y * (1.f + sc.y) + sh.y;
        hv[q * 4 + 2] = xv[q * 4 + 2] * rinv * gg.z * (1.f + sc.z) + sh.z;
        hv[q * 4 + 3] = xv[q * 4 + 3] * rinv * gg.w * (1.f + sc.w) + sh.w;
      }
    }
    for (int head = 0; head < 8; ++head) {
      const unsigned* pk = p.pk + ((size_t)tk * 8 + head) * 32;
      unsigned p1 = pk[ca], p2 = pk[16 + cb];
      float sum = lane < 50 ? ord_val(p1) + ord_val(p2) : -3.0e38f;
      int eid = (int)(p1 & 127u) * 128 + (int)(p2 & 127u);
      int rank = 0;
      for (int m = 0; m < 50; ++m) {
        float sm = __shfl(sum, m);
        rank += (sm > sum || (sm == sum && m < lane)) ? 1 : 0;
      }
      float mx = wave_max(sum);
      bool sel = (lane < 50) && (rank < 16);
      float e = sel ? __expf(sum - mx) : 0.f;
      float tot = wave_sum(e);
      if (sel) { lds_e[head * 16 + rank] = eid; lds_g[head * 16 + rank] = e / tot; }
    }
    float acc[16];
#pragma unroll
    for (int k = 0; k < 16; ++k) acc[k] = 0.f;
    for (int e0 = 0; e0 < 128; e0 += 8) {
      uint4 ur[8], vr[8];
      float gt[8], us[8], vs[8];
#pragma unroll
      for (int k = 0; k < 8; ++k) {
        int ex = __builtin_amdgcn_readfirstlane(lds_e[e0 + k]);
        gt[k] = lds_g[e0 + k];
        ur[k] = ((const uint4*)(U + (size_t)ex * 1024))[lane];
        vr[k] = ((const uint4*)(V + (size_t)ex * 1024))[lane];
        us[k] = usc[ex]; vs[k] = vsc[ex];
      }
#pragma unroll
      for (int k = 0; k < 8; ++k) {
        float dot = 0.f;
        unsigned w[4] = {ur[k].x, ur[k].y, ur[k].z, ur[k].w};
#pragma unroll
        for (int q = 0; q < 4; ++q) {
          f32x2 lo = __builtin_amdgcn_cvt_pk_f32_fp8((int)w[q], false), hi = __builtin_amdgcn_cvt_pk_f32_fp8((int)w[q], true);
          dot += lo[0] * hv[q * 4] + lo[1] * hv[q * 4 + 1] + hi[0] * hv[q * 4 + 2] + hi[1] * hv[q * 4 + 3];
        }
        dot = wave_sum(dot) * us[k];
        float a = gt[k] * gelu_f(dot) * vs[k];
        unsigned y[4] = {vr[k].x, vr[k].y, vr[k].z, vr[k].w};
#pragma unroll
        for (int q = 0; q < 4; ++q) {
          f32x2 lo = __builtin_amdgcn_cvt_pk_f32_fp8((int)y[q], false), hi = __builtin_amdgcn_cvt_pk_f32_fp8((int)y[q], true);
          acc[q * 4] += a * lo[0]; acc[q * 4 + 1] += a * lo[1]; acc[q * 4 + 2] += a * hi[0]; acc[q * 4 + 3] += a * hi[1];
        }
      }
    }
    {
      float4* xp = ((l == 1) ? (float4*)(p.out + (size_t)(tk - LC) * 1024) : (float4*)(p.xall + (size_t)tk * 1024)) + lane * 4;
#pragma unroll
      for (int q = 0; q < 4; ++q) {
        float4 gg = ((const float4*)(mod + 5120))[lane * 4 + q];
        float4 o;
        o.x = xv[q * 4 + 0] + gg.x * acc[q * 4 + 0];
        o.y = xv[q * 4 + 1] + gg.y * acc[q * 4 + 1];
        o.z = xv[q * 4 + 2] + gg.z * acc[q * 4 + 2];
        o.w = xv[q * 4 + 3] + gg.w * acc[q * 4 + 3];
        xp[q] = o;
      }
    }
  }
}

#define XB_TMO      128
#define XB_XCNT(j)  (256  + 64 * (j))
#define XB_XSUB(j)  (1280 + 64 * (j))
#define XB_XGEN(j)  (2304 + 64 * (j))
#define XB_TOP      3328
#define XB_TOPGEN   3392
#define XCD_BAR_WORDS 3456
#define XB_SPIN_CAP (1u << 22)
#define LAS __attribute__((address_space(3)))
__device__ __forceinline__ unsigned xb_ld(unsigned* q) { return __hip_atomic_load(q, __ATOMIC_RELAXED, __HIP_MEMORY_SCOPE_AGENT); }
__device__ __forceinline__ unsigned xb_add(unsigned* q, unsigned v) { return __hip_atomic_fetch_add(q, v, __ATOMIC_RELAXED, __HIP_MEMORY_SCOPE_AGENT); }
__device__ __forceinline__ unsigned xb_xcc_id() { return (unsigned)__builtin_amdgcn_s_getreg((3 << 11) | 20) & 0xFu; }
#define XB_SPIN(cond, bar) do { unsigned _sp = 0; while (cond) { __builtin_amdgcn_s_sleep(1); \
    if ((++_sp & 255u) == 0u) { if (xb_ld(&(bar)[XB_TMO])) break; if (_sp > XB_SPIN_CAP) { atomicAdd(&(bar)[XB_TMO], 1u); break; } } } } while (0)
struct XcdBarrier { unsigned* bar; unsigned x; volatile LAS unsigned* st; };
__device__ __forceinline__ XcdBarrier xcd_barrier_post(unsigned* bar, volatile LAS unsigned* st) {
  XcdBarrier b; b.bar = bar; b.x = xb_xcc_id(); b.st = st;
  if (threadIdx.x == 0) (void)xb_add(&bar[XB_XCNT(b.x)], 1u);
  return b;
}
__device__ __forceinline__ void xcd_barrier_complete(unsigned* bar, unsigned x, unsigned& nloc, unsigned& nx) {
  const unsigned G = gridDim.x * gridDim.y * gridDim.z;
  unsigned sum, cnt, mine, sp = 0u;
  for (;;) {
    sum = 0u; cnt = 0u; mine = 0u;
#pragma unroll
    for (unsigned j = 0; j < 16; ++j) { const unsigned c = xb_ld(&bar[XB_XCNT(j)]); sum += c; cnt += (c > 0u) ? 1u : 0u; mine = (j == x) ? c : mine; }
    if (sum == G) break;
    __builtin_amdgcn_s_sleep(1);
    if ((++sp & 255u) == 0u) { if (xb_ld(&bar[XB_TMO])) break; if (sp > XB_SPIN_CAP) { atomicAdd(&bar[XB_TMO], 1u); break; } }
  }
  nloc = mine > 0u ? mine : 1u; nx = cnt > 0u ? cnt : 1u;
}
__device__ __forceinline__ void xcd_barrier(const XcdBarrier& b) {
  asm volatile("s_waitcnt vmcnt(0)" ::: "memory");
  __syncthreads();
  if (threadIdx.x == 0) {
    unsigned* bar = b.bar;
    __builtin_amdgcn_s_waitcnt(0);
    unsigned nloc = b.st[0], nx = b.st[1];
    if (nloc == 0u) { xcd_barrier_complete(bar, b.x, nloc, nx); b.st[0] = nloc; b.st[1] = nx; }
    const unsigned old = xb_add(&bar[XB_XSUB(b.x)], 1u);
    const unsigned gen = old / nloc;
    if (old + 1u == (gen + 1u) * nloc) {
      __builtin_amdgcn_fence(__ATOMIC_RELEASE, "agent");
      asm volatile("s_waitcnt vmcnt(0)" ::: "memory");
      const unsigned og = xb_add(&bar[XB_TOP], 1u);
      const unsigned tg = og / nx;
      if (og + 1u == (tg + 1u) * nx) xb_add(&bar[XB_TOPGEN], 1u);
      else XB_SPIN(xb_ld(&bar[XB_TOPGEN]) == tg, bar);
      __builtin_amdgcn_fence(__ATOMIC_ACQUIRE, "agent");
      xb_add(&bar[XB_XGEN(b.x)], 1u);
      asm volatile("s_waitcnt vmcnt(0)" ::: "memory");
    } else {
      XB_SPIN(xb_ld(&bar[XB_XGEN(b.x)]) == gen, bar);
      __builtin_amdgcn_fence(__ATOMIC_ACQUIRE, "agent");
      asm volatile("s_waitcnt vmcnt(0)" ::: "memory");
    }
  }
  __syncthreads();
}

__global__ void __launch_bounds__(256, 2) k_mega(P p) {
  __shared__ __attribute__((aligned(16))) float smem[18432];
  __shared__ uint4 xb_words;
  cg::grid_group grid = cg::this_grid();
  if (threadIdx.x == 0) xb_words = make_uint4(0u, 0u, 0u, 0u);
  __syncthreads();
  ph_mod(p, smem);
  ph_prep(p, smem);
  ph_lru_prepw(p);
  ph_prep_peer(p);
  grid.sync();
  XcdBarrier xb = xcd_barrier_post(p.bar, (volatile LAS unsigned*)&xb_words);
  ph_norm_mod(p, 0, 0, 0, smem, true);
  xcd_barrier(xb);
  for (int l = 0; l < 2; ++l) {
    const int t0 = (l == 0) ? 0 : LC;
    gemm_bf16_128(p, p.hb, p.w_in_t + (size_t)l * 1024 * DIN, 1024, 0, TT, DIN, (char*)smem, EpiProjSplit{});
    xcd_barrier(xb);
    ph_qknorm_rope2(p, l);
    xcd_barrier(xb);
    ph_lru<1>(p, l, (char*)smem);
    ph_attn(p, l, (char*)smem);
    xcd_barrier(xb);
    ph_lru<2>(p, l, (char*)smem);
    xcd_barrier(xb);
    gemm_bf16_128(p, p.mixb, p.w_out_t + (size_t)l * 1024 * 1024, 1024, t0, TT, 1024, (char*)smem, EpiResid{l, 2048});
    xcd_barrier(xb);
    ph_norm_mod(p, l, 1, t0, smem);
    xcd_barrier(xb);
    gemm_bf16_128(p, p.hb, p.wq_t + (size_t)l * 1024 * NPQ, 1024, t0, TT, NPQ, (char*)smem, EpiPeerTopk{l});
    xcd_barrier(xb);
    ph_peer_apply2(p, l, t0, (char*)smem);
    if (l == 0) {
      xcd_barrier(xb);
      ph_norm_mod(p, 1, 0, 0, smem);
      xcd_barrier(xb);
    }
  }
}

extern "C" void kernel_launch(void* const* d_in, const int* in_sizes, int n_in, void* d_out, int out_size, void* d_ws,
                              size_t ws_size, hipStream_t stream) {
  P p{};
  const float** fp = (const float**)&p;
  for (int i = 0; i < 28; ++i) fp[i] = (const float*)d_in[i];
  p.out = (float*)d_out;
  float* w = (float*)d_ws;
  size_t o = 0;
  auto carve = [&](size_t n) { float* r = w + o; o += (n + 63) & ~(size_t)63; return r; };
  p.bar = (unsigned*)carve(4096);
  p.mod = carve(4 * 6144);
  p.xall = carve((size_t)TT * 1024);
  p.proj = carve((size_t)TT * 512);
  p.projb = (bf16_t*)carve((size_t)TT * DIN / 2);
  p.mixb = (bf16_t*)carve((size_t)TT * 512);
  p.hb = (bf16_t*)carve((size_t)TT * 512);
  p.w_in_t = (bf16_t*)carve((size_t)1024 * DIN);
  p.w_out_t = (bf16_t*)carve((size_t)1024 * 1024);
  p.wq_t = (bf16_t*)carve((size_t)1024 * NPQ);
  p.lruw_t = (bf16_t*)carve((size_t)2 * 2 * 4 * 2 * 4096 / 2);
  p.lagg = carve((size_t)2 * NCHUNK * 256 * 2);
  p.pk = (unsigned*)carve((size_t)TT * 256);
  p.ub8 = (unsigned char*)carve((size_t)2 * 16384 * 1024 / 4);
  p.vb8 = (unsigned char*)carve((size_t)2 * 16384 * 1024 / 4);
  p.usc = carve(2 * 16384);
  p.vsc = carve(2 * 16384);
  p.k1b = (bf16_t*)carve(16384);
  p.k2b = (bf16_t*)carve(16384);
  if (o * 4 > ws_size) { fprintf(stderr, "workspace too small: need %zu have %zu\n", o * 4, ws_size); return; }
  static int grid_blocks = 0;
  if (!grid_blocks) {
    int dev = 0, cus = 0, per_cu = 0;
    (void)hipGetDevice(&dev);
    (void)hipDeviceGetAttribute(&cus, hipDeviceAttributeMultiprocessorCount, dev);
    (void)hipOccupancyMaxActiveBlocksPerMultiprocessor(&per_cu, k_mega, 256, 0);
    if (per_cu > 2) per_cu = 2;
    grid_blocks = cus * per_cu;
  }
  (void)hipMemsetAsync(p.bar, 0, XCD_BAR_WORDS * 4, stream);
  void* args[] = {&p};
  hipError_t e = hipLaunchCooperativeKernel((void*)k_mega, dim3(grid_blocks), dim3(256), args, 0, stream);
  if (e != hipSuccess) fprintf(stderr, "cooperative launch failed: %s (grid %d)\n", hipGetErrorString(e), grid_blocks);
}
```

```cpp
#include <hip/hip_runtime.h>
#include <hip/hip_cooperative_groups.h>
#include <stdint.h>
#include <stdio.h>
namespace cg = cooperative_groups;

#ifndef SINGLE_LAUNCH
#define SINGLE_LAUNCH 1
#endif

constexpr int DM = 1024, SEQ = 16384, LC = 256, TT = SEQ + LC, DIN = 2304, NPQ = 2048;
constexpr int OFF_XA = 0, OFF_GA = 256, OFF_QW = 512, OFF_KW = 896, OFF_VW = 1024, OFF_QN = 1152, OFF_KN = 1536, OFF_VN = 1920;
constexpr float EPS = 1e-6f;

struct P {
  const float *x, *c, *ctx, *c_ctx, *w_mod, *b_mod, *norm1_g, *norm2_g, *w_in, *w_out,
      *conv_w, *conv_b, *wa, *ba, *wx, *bx, *lam, *win_qn, *win_kn, *win_sink, *na_qn, *na_kn, *rpb,
      *wq, *k1, *k2, *pu, *pv;
  float* out;
  float *mod, *xall, *proj;
  unsigned short* projb;
  unsigned* pk;
  unsigned* bar;
  unsigned short *k1b, *k2b;
  unsigned char *ub8, *vb8;
  float *usc, *vsc;
  unsigned short *hb, *mixb, *w_in_t, *w_out_t, *wq_t, *lruw_t;
  float* lagg;
};

typedef unsigned short bf16_t;
typedef __attribute__((ext_vector_type(8))) short bf16x8;
typedef __attribute__((ext_vector_type(4))) float f32x4;
__device__ __forceinline__ unsigned short f2bf(float f) {
  unsigned u = __float_as_uint(f);
  u += 0x7fffu + ((u >> 16) & 1u);
  return (unsigned short)(u >> 16);
}
__device__ __forceinline__ unsigned pack2bf(float a, float b) { return (unsigned)f2bf(a) | ((unsigned)f2bf(b) << 16); }
__device__ __forceinline__ float bf2f(unsigned short h) { return __uint_as_float(((unsigned)h) << 16); }


__device__ __forceinline__ float silu_f(float x) { return x / (1.f + __expf(-x)); }
__device__ __forceinline__ float sigmoid_f(float x) { return 1.f / (1.f + __expf(-x)); }
__device__ __forceinline__ float gelu_f(float x) {
  float u = 0.7978845608028654f * (x + 0.044715f * x * x * x);
  float e = __expf(2.f * u);
  float th = 1.f - 2.f / (e + 1.f);
  return 0.5f * x * (1.f + th);
}
template <int CTRL, int RMASK>
__device__ __forceinline__ float dpp_mov(float v) {
  return __int_as_float(__builtin_amdgcn_update_dpp(0, __float_as_int(v), CTRL, RMASK, 0xf, false));
}
__device__ __forceinline__ float wave_sum(float v) {
  v += dpp_mov<0xB1, 0xf>(v);
  v += dpp_mov<0x4E, 0xf>(v);
  v += dpp_mov<0x141, 0xf>(v);
  v += dpp_mov<0x140, 0xf>(v);
  v += dpp_mov<0x142, 0xa>(v);
  v += dpp_mov<0x143, 0xc>(v);
  return __int_as_float(__builtin_amdgcn_readlane(__float_as_int(v), 63));
}

__device__ __forceinline__ int tid_opaque() { int t = threadIdx.x; asm volatile("" : "+v"(t)); return t; }
#define GTID (blockIdx.x * blockDim.x + tid_opaque())
#define GSZ (gridDim.x * blockDim.x)

__device__ __forceinline__ void ph_mod(const P& p, float* smem) {
  const int tid = tid_opaque(), cl = tid & 31, ks = tid >> 5;
  for (int it = blockIdx.x; it < 2 * 192; it += gridDim.x) {
    const int nc = it % 192, l = it / 192;
    const int n = nc * 32 + cl;
    const float* w = p.w_mod + (size_t)l * 1024 * 6144 + n;
    float a0 = 0.f, a1 = 0.f;
#pragma unroll 8
    for (int i = 0; i < 128; ++i) {
      int k = i * 8 + ks;
      float wv = w[(size_t)k * 6144];
      a0 += silu_f(p.c[k]) * wv;
      a1 += silu_f(p.c_ctx[k]) * wv;
    }
    __syncthreads();
    smem[tid] = a0; smem[256 + tid] = a1;
    __syncthreads();
    if (tid < 64) {
      const int which = tid >> 5;
      float s = p.b_mod[l * 6144 + n];
#pragma unroll
      for (int q = 0; q < 8; ++q) s += smem[which * 256 + q * 32 + cl];
      p.mod[(l * 2 + which) * 6144 + n] = s;
    }
  }
}

__device__ __forceinline__ void ph_copy_in(const P& p) {
  const float4* xs = (const float4*)p.x;
  const float4* cs = (const float4*)p.ctx;
  float4* d = (float4*)p.xall;
  for (int i = GTID; i < TT * 256; i += GSZ) d[i] = (i < LC * 256) ? cs[i] : xs[i - LC * 256];
}

__device__ __forceinline__ void ph_copy_out(const P& p) {
  const float4* s = (const float4*)(p.xall + (size_t)LC * 1024);
  float4* d = (float4*)p.out;
  for (int i = GTID; i < SEQ * 256; i += GSZ) d[i] = s[i];
}

__device__ __forceinline__ void ph_norm_mod(const P& p, int l, int which_norm, int t0, float* smem, bool from_input = false) {
  const float* g = (which_norm ? p.norm2_g : p.norm1_g) + l * 1024;
  const int sh_off = which_norm ? 3072 : 0, sc_off = which_norm ? 4096 : 1024;
  const int tid = tid_opaque();
  for (int t = t0 + blockIdx.x; t < TT; t += gridDim.x) {
    const float* mod = p.mod + (l * 2 + (t < LC ? 1 : 0)) * 6144;
    float4 v;
    if (from_input) {
      v = t < LC ? ((const float4*)(p.ctx + (size_t)t * 1024))[tid] : ((const float4*)(p.x + (size_t)(t - LC) * 1024))[tid];
      ((float4*)(p.xall + (size_t)t * 1024))[tid] = v;
    } else v = ((const float4*)(p.xall + (size_t)t * 1024))[tid];
    float ss = wave_sum(v.x * v.x + v.y * v.y + v.z * v.z + v.w * v.w);
    __syncthreads();
    if ((tid & 63) == 0) smem[tid >> 6] = ss;
    __syncthreads();
    float tot = smem[0] + smem[1] + smem[2] + smem[3];
    float rinv = rsqrtf(tot * (1.f / 1024.f) + EPS);
    float4 gg = ((const float4*)g)[tid];
    float4 sc = ((const float4*)(mod + sc_off))[tid];
    float4 sh = ((const float4*)(mod + sh_off))[tid];
    float4 o;
    o.x = v.x * rinv * gg.x * (1.f + sc.x) + sh.x;
    o.y = v.y * rinv * gg.y * (1.f + sc.y) + sh.y;
    o.z = v.z * rinv * gg.z * (1.f + sc.z) + sh.z;
    o.w = v.w * rinv * gg.w * (1.f + sc.w) + sh.w;
    ((uint2*)(p.hb + (size_t)t * 1024))[tid] = make_uint2(pack2bf(o.x, o.y), pack2bf(o.z, o.w));
  }
}

__device__ __forceinline__ void prep_transpose(const float* W, bf16_t* Wt, int K, int N, int item0, int nitems_total, float* smem) {
  (void)nitems_total;
  float(*ts)[65] = (float(*)[65])smem;
  const int tid = tid_opaque();
  const int tn = N / 64, nt = (K / 64) * tn;
  for (int it = blockIdx.x; it < nt; it += gridDim.x) {
    int k0 = (it / tn) * 64, n0 = (it % tn) * 64;
    __syncthreads();
#pragma unroll
    for (int i = 0; i < 16; ++i) {
      int r = (tid >> 6) + i * 4, c = tid & 63;
      ts[r][c] = W[(size_t)(k0 + r) * N + n0 + c];
    }
    __syncthreads();
#pragma unroll
    for (int i = 0; i < 16; ++i) {
      int r = (tid >> 6) + i * 4, c = tid & 63;
      Wt[(size_t)(n0 + r) * K + k0 + c] = f2bf(ts[c][r]);
    }
  }
  (void)item0;
}

__device__ __forceinline__ void ph_prep(const P& p, float* smem) {
  for (int l = 0; l < 2; ++l) {
    prep_transpose(p.w_in + (size_t)l * 1024 * DIN, p.w_in_t + (size_t)l * 1024 * DIN, 1024, DIN, 0, 0, smem);
    prep_transpose(p.w_out + (size_t)l * 1024 * 1024, p.w_out_t + (size_t)l * 1024 * 1024, 1024, 1024, 0, 0, smem);
    prep_transpose(p.wq + (size_t)l * 1024 * NPQ, p.wq_t + (size_t)l * 1024 * NPQ, 1024, NPQ, 0, 0, smem);
  }
}

struct EpiStoreF32 {
  float* C; int ldc;
  __device__ __forceinline__ void operator()(const P& p, f32x4 (&acc)[4][4], int m0, int n0, int wm, int wn, int lane, char* smem) const {
    const int mw0 = m0 + wm * 64, nw0 = n0 + wn * 64;
#pragma unroll
    for (int i = 0; i < 4; ++i)
#pragma unroll
      for (int r = 0; r < 4; ++r) {
        int row = mw0 + 16 * i + (lane >> 4) * 4 + r;
#pragma unroll
        for (int j = 0; j < 4; ++j) C[(size_t)row * ldc + nw0 + 16 * j + (lane & 15)] = acc[i][j][r];
      }
  }
};
struct EpiProjSplit {
  __device__ __forceinline__ void operator()(const P& p, f32x4 (&acc)[4][4], int m0, int n0, int wm, int wn, int lane, char* smem) const {
    const int mw0 = m0 + wm * 64, nw0 = n0 + wn * 64;
#pragma unroll
    for (int i = 0; i < 4; ++i)
#pragma unroll
      for (int r = 0; r < 4; ++r) {
        int row = mw0 + 16 * i + (lane >> 4) * 4 + r;
#pragma unroll
        for (int j = 0; j < 4; ++j) {
          int col = nw0 + 16 * j + (lane & 15);
          if (n0 < 512) p.proj[(size_t)row * 512 + col] = acc[i][j][r];
          else p.projb[(size_t)row * DIN + col] = f2bf(acc[i][j][r]);
        }
      }
  }
};
struct EpiResid {
  int l, gofs;
  __device__ __forceinline__ void operator()(const P& p, f32x4 (&acc)[4][4], int m0, int n0, int wm, int wn, int lane, char* smem) const {
    const int mw0 = m0 + wm * 64, nw0 = n0 + wn * 64;
#pragma unroll
    for (int i = 0; i < 4; ++i)
#pragma unroll
      for (int r = 0; r < 4; ++r) {
        int row = mw0 + 16 * i + (lane >> 4) * 4 + r;
        const float* gt = p.mod + (l * 2 + (row < LC ? 1 : 0)) * 6144 + gofs;
#pragma unroll
        for (int j = 0; j < 4; ++j) {
          int col = nw0 + 16 * j + (lane & 15);
          p.xall[(size_t)row * 1024 + col] += gt[col] * acc[i][j][r];
        }
      }
  }
};

template <class Epi>
__device__ __forceinline__ void gemm_bf16_128(const P& p, const bf16_t* __restrict__ A, const bf16_t* __restrict__ Bt, int K, int m_begin, int m_end,
                              int N, char* smem, const Epi& epi) {
  const int tid = tid_opaque(), lane = tid & 63, wv = tid >> 6, wm = wv >> 1, wn = wv & 1;
  const int tiles_n = N / 128, tiles_m = (m_end - m_begin) / 128;
  const int nk = K / 64;
  const int lrow = lane & 15, lq = lane >> 4;
  for (int tile = blockIdx.x; tile < tiles_m * tiles_n; tile += gridDim.x) {
    const int m0 = m_begin + (tile / tiles_n) * 128, n0 = (tile % tiles_n) * 128;
    f32x4 acc[4][4];
#pragma unroll
    for (int i = 0; i < 4; ++i)
#pragma unroll
      for (int j = 0; j < 4; ++j) acc[i][j] = (f32x4){0.f, 0.f, 0.f, 0.f};
    uint4 ra[4], rb[4];
    const bf16_t* Ag = A + (size_t)m0 * K;
    const bf16_t* Bg = Bt + (size_t)n0 * K;
#pragma unroll
    for (int i = 0; i < 4; ++i) {
      int id = tid + 256 * i, row = id >> 3, c = id & 7;
      ra[i] = *(const uint4*)(Ag + (size_t)row * K + c * 8);
      rb[i] = *(const uint4*)(Bg + (size_t)row * K + c * 8);
    }
#pragma unroll
    for (int i = 0; i < 4; ++i) {
      int id = tid + 256 * i, row = id >> 3, c = id & 7;
      int off = row * 128 + ((c ^ (row & 7)) << 4);
      *(uint4*)(smem + off) = ra[i];
      *(uint4*)(smem + 16384 + off) = rb[i];
    }
    __syncthreads();
    for (int kt = 0; kt < nk; ++kt) {
      const int cur = (kt & 1) * 32768, nxt = ((kt + 1) & 1) * 32768;
      if (kt + 1 < nk) {
#pragma unroll
        for (int i = 0; i < 4; ++i) {
          int id = tid + 256 * i, row = id >> 3, c = id & 7;
          ra[i] = *(const uint4*)(Ag + (size_t)row * K + (kt + 1) * 64 + c * 8);
          rb[i] = *(const uint4*)(Bg + (size_t)row * K + (kt + 1) * 64 + c * 8);
        }
      }
#pragma unroll
      for (int s = 0; s < 2; ++s) {
        bf16x8 af[4], bfr[4];
#pragma unroll
        for (int i = 0; i < 4; ++i) {
          int row = wm * 64 + 16 * i + lrow;
          af[i] = *(const bf16x8*)(smem + cur + row * 128 + (((4 * s + lq) ^ (row & 7)) << 4));
        }
#pragma unroll
        for (int j = 0; j < 4; ++j) {
          int row = wn * 64 + 16 * j + lrow;
          bfr[j] = *(const bf16x8*)(smem + cur + 16384 + row * 128 + (((4 * s + lq) ^ (row & 7)) << 4));
        }
#pragma unroll
        for (int i = 0; i < 4; ++i)
#pragma unroll
          for (int j = 0; j < 4; ++j) acc[i][j] = __builtin_amdgcn_mfma_f32_16x16x32_bf16(af[i], bfr[j], acc[i][j], 0, 0, 0);
      }
      if (kt + 1 < nk) {
#pragma unroll
        for (int i = 0; i < 4; ++i) {
          int id = tid + 256 * i, row = id >> 3, c = id & 7;
          int off = row * 128 + ((c ^ (row & 7)) << 4);
          *(uint4*)(smem + nxt + off) = ra[i];
          *(uint4*)(smem + nxt + 16384 + off) = rb[i];
        }
      }
      __syncthreads();
    }
    epi(p, acc, m0, n0, wm, wn, lane, smem);
    __syncthreads();
  }
}

constexpr int NCHUNK = TT / 64;
__device__ __forceinline__ int lru_pos(int dir, int c) { return dir == 0 ? c : (c < 4 ? 3 - c : 4 + (NCHUNK - 1 - c)); }

__device__ __forceinline__ void ph_lru_prepw(const P& p) {
  for (int idx = GTID; idx < 2 * 2 * 4 * 2 * 4096; idx += GSZ) {
    int d = idx & 63, e = (idx >> 6) & 63, mtx = (idx >> 12) & 1, rest = idx >> 13;
    const float* w = (mtx ? p.wx : p.wa) + (size_t)rest * 4096;
    p.lruw_t[idx] = f2bf(w[d * 64 + e]);
  }
}

template <int PASS>
__device__ __forceinline__ void lru_item(const P& p, int l, int cidx, int kb, char* smem) {
  bf16_t* u_img = (bf16_t*)smem;
  float* ab_a = (float*)(smem + 8192);
  float* ab_b = (float*)(smem + 8192 + 16384);
  float* hsum = (float*)(smem + 8192 + 32768);
  float* segagg = (float*)(smem + 8192 + 49152);
  float* ccarry = (float*)(smem + 8192 + 49152 + 2048);
  const int tid = tid_opaque(), lane = tid & 63, wv = tid >> 6, g = lane >> 4, lr = lane & 15;
  const int t0 = cidx * 64;
  const int lo = t0 < LC ? 0 : LC, hi = t0 < LC ? LC : TT;
  __syncthreads();
  {
    const int ch = tid & 63, c = kb * 64 + ch;
    const float cb = p.conv_b[l * 256 + c];
    float cw[4];
#pragma unroll
    for (int k = 0; k < 4; ++k) cw[k] = p.conv_w[(l * 4 + k) * 256 + c];
#pragma unroll
    for (int i = 0; i < 16; ++i) {
      int row = (tid >> 6) + 4 * i, t = t0 + row;
      float acc = cb;
#pragma unroll
      for (int k = 0; k < 4; ++k) {
        int tt = t + k - 2;
        if (tt >= lo && tt < hi) acc += cw[k] * p.proj[(size_t)tt * 512 + OFF_XA + c];
      }
      u_img[row * 64 + ((((ch >> 3) ^ (row & 7)) << 3) | (ch & 7))] = f2bf(acc);
    }
  }
  if (PASS == 2) {
    if (tid < 128) {
      const int ch = tid & 63, dir = tid >> 6;
      const int pos = lru_pos(dir, cidx);
      const float2* ag = (const float2*)p.lagg + (size_t)dir * NCHUNK * 256 + kb * 64 + ch;
      float h = 0.f;
      for (int q = 0; q < pos; ++q) {
        float2 v = ag[(size_t)q * 256];
        h = v.x * h + v.y;
      }
      ccarry[dir * 64 + ch] = h;
    }
  }
  __syncthreads();
  for (int dir = 0; dir < 2; ++dir) {
    const int pd = l * 2 + dir;
    {
      f32x4 ga[4], gx[4];
#pragma unroll
      for (int i = 0; i < 4; ++i) { ga[i] = (f32x4){0.f, 0.f, 0.f, 0.f}; gx[i] = (f32x4){0.f, 0.f, 0.f, 0.f}; }
      const bf16_t* wbase = p.lruw_t + (size_t)((pd * 4 + kb) * 2) * 4096 + (16 * wv + lr) * 64 + 8 * g;
#pragma unroll
      for (int s = 0; s < 2; ++s) {
        bf16x8 ba_ = *(const bf16x8*)(wbase + 32 * s);
        bf16x8 bx_ = *(const bf16x8*)(wbase + 4096 + 32 * s);
#pragma unroll
        for (int i = 0; i < 4; ++i) {
          int row = 16 * i + lr;
          bf16x8 af = *(const bf16x8*)((const char*)u_img + row * 128 + (((4 * s + g) ^ (row & 7)) << 4));
          ga[i] = __builtin_amdgcn_mfma_f32_16x16x32_bf16(af, ba_, ga[i], 0, 0, 0);
          gx[i] = __builtin_amdgcn_mfma_f32_16x16x32_bf16(af, bx_, gx[i], 0, 0, 0);
        }
      }
      const int ch = 16 * wv + lr, c = kb * 64 + ch;
      const float bav = p.ba[pd * 256 + c], bxv = p.bx[pd * 256 + c];
      const float sp = log1pf(expf(-p.lam[pd * 256 + c]));
#pragma unroll
      for (int i = 0; i < 4; ++i)
#pragma unroll
        for (int r = 0; r < 4; ++r) {
          int row = 16 * i + 4 * g + r;
          float rr = sigmoid_f(ga[i][r] + bav), ig = sigmoid_f(gx[i][r] + bxv);
          float log_a = -8.f * rr * sp;
          float a = __expf(log_a);
          float uu = bf2f(u_img[row * 64 + ((((ch >> 3) ^ (row & 7)) << 3) | (ch & 7))]);
          float b = sqrtf(-expm1f(2.f * log_a)) * ig * uu;
          ab_a[row * 64 + ch] = a;
          ab_b[row * 64 + ch] = b;
        }
    }
    __syncthreads();
    {
      const int ch = tid & 63, seg = tid >> 6;
      float Pr = 1.f, H = 0.f;
#pragma unroll
      for (int i = 0; i < 16; ++i) {
        int row = dir == 0 ? seg * 16 + i : seg * 16 + 15 - i;
        float a = ab_a[row * 64 + ch], b = ab_b[row * 64 + ch];
        H = a * H + b;
        Pr *= a;
      }
      segagg[(seg * 64 + ch) * 2] = Pr;
      segagg[(seg * 64 + ch) * 2 + 1] = H;
      __syncthreads();
      if (PASS == 1) {
        if (seg == 0) {
          float A = 1.f, B = 0.f;
#pragma unroll
          for (int s2 = 0; s2 < 4; ++s2) {
            int sg = dir == 0 ? s2 : 3 - s2;
            float pa = segagg[(sg * 64 + ch) * 2], pb = segagg[(sg * 64 + ch) * 2 + 1];
            B = pa * B + pb;
            A *= pa;
          }
          float2* ag = (float2*)p.lagg + ((size_t)dir * NCHUNK + lru_pos(dir, cidx)) * 256 + kb * 64 + ch;
          *ag = make_float2(A, B);
        }
      } else {
        float h = ccarry[dir * 64 + ch];
#pragma unroll
        for (int s2 = 0; s2 < 3; ++s2) {
          int sg = dir == 0 ? s2 : 3 - s2;
          bool before = dir == 0 ? (sg < seg) : (sg > seg);
          if (before) h = segagg[(sg * 64 + ch) * 2] * h + segagg[(sg * 64 + ch) * 2 + 1];
        }
#pragma unroll
        for (int i = 0; i < 16; ++i) {
          int row = dir == 0 ? seg * 16 + i : seg * 16 + 15 - i;
          float a = ab_a[row * 64 + ch], b = ab_b[row * 64 + ch];
          h = a * h + b;
          if (dir == 0) hsum[row * 64 + ch] = h;
          else {
            int t = t0 + row, c = kb * 64 + ch;
            float gv = p.proj[(size_t)t * 512 + OFF_GA + c];
            p.mixb[(size_t)t * 1024 + c] = f2bf((hsum[row * 64 + ch] + h) * gelu_f(gv));
          }
        }
      }
    }
    __syncthreads();
  }
}

template <int PASS>
__device__ __forceinline__ void ph_lru(const P& p, int l, char* smem) {
  const int c_begin = (PASS == 2 && l == 1) ? 4 : 0;
  const int nitems = (NCHUNK - c_begin) * 4;
  for (int it = blockIdx.x; it < nitems; it += gridDim.x) lru_item<PASS>(p, l, c_begin + (it >> 2), it & 3, smem);
}

constexpr float LOG2E = 1.4426950408889634f;
constexpr float QSCALE = 0.125f * LOG2E;
typedef __attribute__((ext_vector_type(4))) short s16x4;

__device__ __forceinline__ void ph_qknorm_rope2(const P& p, int l) {
  const int tid_ = tid_opaque();
  const int lane = tid_ & 63;
  const int wpb = blockDim.x >> 6;
  for (int pair = blockIdx.x * wpb + (tid_ >> 6); pair < TT * 28; pair += gridDim.x * wpb) {
    int t = pair / 28, slot = pair % 28;
    const float* g = nullptr; bool rope = false; float scale = 1.f;
    if (slot < 6) { g = p.win_qn + l * 64; rope = true; scale = QSCALE; }
    else if (slot < 8) { g = p.win_kn + l * 64; rope = true; }
    else if (slot < 10) { }
    else if (slot < 16) { g = p.na_qn + l * 64; scale = QSCALE; }
    else if (slot < 22) { g = p.na_kn + l * 64; }
    rope = rope && (t >= LC);
    const size_t idx = (size_t)t * DIN + 512 + slot * 64 + lane;
    float v = bf2f(p.projb[idx]);
    float y = v;
    if (g) {
      float ss = wave_sum(v * v);
      y = v * rsqrtf(ss * (1.f / 64.f) + EPS) * g[lane];
    }
    float partner = __shfl_xor(y, 16);
    if (rope) {
      int pos = t - LC, row = pos >> 6, col = pos & 63;
      int j = lane & 15, axis = lane >> 5;
      float inv = __expf(-(float)j * (1.f / 16.f) * 9.210340371976184f);
      float ang = (float)(axis ? col : row) * inv;
      float k = rintf(ang * 0.15915494309189535f);
      float r = fmaf(-k, 6.2831854820251465f, ang);
      r = fmaf(-k, -1.7484555e-07f, r);
      float cs = __cosf(r), sn = __sinf(r);
      bool first = ((lane >> 4) & 1) == 0;
      y = first ? (y * cs - partner * sn) : (partner * sn + y * cs);
    }
    p.projb[idx] = f2bf(y * scale);
  }
}

template <int CTRL, int RMASK>
__device__ __forceinline__ float dpp_mov_id(float v) {
  return __int_as_float(__builtin_amdgcn_update_dpp(__float_as_int(v), __float_as_int(v), CTRL, RMASK, 0xf, false));
}
__device__ __forceinline__ float wave_max(float v) {
  v = fmaxf(v, dpp_mov_id<0xB1, 0xf>(v));
  v = fmaxf(v, dpp_mov_id<0x4E, 0xf>(v));
  v = fmaxf(v, dpp_mov_id<0x141, 0xf>(v));
  v = fmaxf(v, dpp_mov_id<0x140, 0xf>(v));
  v = fmaxf(v, dpp_mov_id<0x142, 0xa>(v));
  v = fmaxf(v, dpp_mov_id<0x143, 0xc>(v));
  return __int_as_float(__builtin_amdgcn_readlane(__float_as_int(v), 63));
}

struct KVRegs { uint4 k[2], v[2]; };
template <class TokFn>
__device__ __forceinline__ void kv_load(const P& p, KVRegs& r, int koff, int voff, TokFn tok, int tid) {
#pragma unroll
  for (int i = 0; i < 2; ++i) {
    int id = tid + 256 * i, row = id >> 3, c = id & 7;
    const bf16_t* base = p.projb + (size_t)tok(row) * DIN + c * 8;
    r.k[i] = *(const uint4*)(base + koff);
    r.v[i] = *(const uint4*)(base + voff);
  }
}
__device__ __forceinline__ void kv_store(const KVRegs& r, char* stage, int tid) {
#pragma unroll
  for (int i = 0; i < 2; ++i) {
    int id = tid + 256 * i, row = id >> 3, c = id & 7;
    int off = row * 128 + ((c ^ (row & 7)) << 4);
    *(uint4*)(stage + off) = r.k[i];
    *(uint4*)(stage + 8192 + off) = r.v[i];
  }
}

template <class MaskFn>
__device__ __forceinline__ void attn_step(const char* stage, int kr0, const bf16x8 (&qf)[2], f32x4 (&o)[4], float& lsum, MaskFn mb, int lane) {
  const int g = lane >> 4, lr = lane & 15;
  f32x4 st[2];
#pragma unroll
  for (int t2 = 0; t2 < 2; ++t2) {
    st[t2] = (f32x4){0.f, 0.f, 0.f, 0.f};
    const int row = kr0 + 16 * t2 + lr;
#pragma unroll
    for (int s = 0; s < 2; ++s) {
      bf16x8 kf = *(const bf16x8*)(stage + row * 128 + (((4 * s + g) ^ (row & 7)) << 4));
      st[t2] = __builtin_amdgcn_mfma_f32_16x16x32_bf16(kf, qf[s], st[t2], 0, 0, 0);
    }
  }
  bf16x8 pb;
#pragma unroll
  for (int t2 = 0; t2 < 2; ++t2)
#pragma unroll
    for (int r = 0; r < 4; ++r) {
      float pv = exp2f(mb(t2, r, st[t2][r]));
      lsum += pv;
      pb[t2 * 4 + r] = (short)f2bf(pv);
    }
  const int q = lr >> 2, pp = lane & 3;
#pragma unroll
  for (int m = 0; m < 4; ++m) {
    bf16x8 vf;
#pragma unroll
    for (int t = 0; t < 2; ++t) {
      const int row = kr0 + 16 * t + 4 * g + q;
      const char* addr = stage + 8192 + row * 128 + (((2 * m + (pp >> 1)) ^ (row & 7)) << 4) + 8 * (pp & 1);
      s16x4 v4 = __builtin_amdgcn_ds_read_tr16_b64_v4i16((__attribute__((address_space(3))) s16x4*)addr);
      vf[4 * t + 0] = v4[0]; vf[4 * t + 1] = v4[1]; vf[4 * t + 2] = v4[2]; vf[4 * t + 3] = v4[3];
    }
    o[m] = __builtin_amdgcn_mfma_f32_16x16x32_bf16(vf, pb, o[m], 0, 0, 0);
  }
}

__device__ __forceinline__ void attn_store_out(const P& p, const f32x4 (&o)[4], float lsum, int tok, int col0, int lane) {
  const int g = lane >> 4;
  lsum += __shfl_xor(lsum, 16);
  lsum += __shfl_xor(lsum, 32);
  const float inv = 1.f / lsum;
  bf16_t* op = p.mixb + (size_t)tok * 1024 + col0 + 4 * g;
#pragma unroll
  for (int m = 0; m < 4; ++m)
    *(uint2*)(op + 16 * m) = make_uint2(pack2bf(o[m][0] * inv, o[m][1] * inv), pack2bf(o[m][2] * inv, o[m][3] * inv));
}

__device__ __forceinline__ void attn_win_item(const P& p, int l, int kind, int qb, int hs, char* smem) {
  const int tid = tid_opaque(), lane = tid & 63, wv = tid >> 6, g = lane >> 4, lr = lane & 15;
  int qoff, koff, voff, ooff; const float *gq, *gk; float sink2 = -1e30f; bool has_sink = false;
  if (kind == 0 || hs < 6) {
    const int h = hs, kvh = h / 3;
    qoff = OFF_QW + h * 64; koff = OFF_KW + kvh * 64; voff = OFF_VW + kvh * 64; ooff = 256 + h * 64;
    gq = p.win_qn + l * 64; gk = p.win_kn + l * 64; sink2 = p.win_sink[l * 6 + h] * LOG2E; has_sink = true;
  } else {
    const int h = hs - 6;
    qoff = OFF_QN + h * 64; koff = OFF_KN + h * 64; voff = OFF_VN + h * 64; ooff = 640 + h * 64;
    gq = p.na_qn + l * 64; gk = p.na_kn + l * 64;
  }
  float bound = 8.f * LOG2E * wave_max(fabsf(gq[lane])) * wave_max(fabsf(gk[lane])) * 1.0001f + 1e-3f;
  if (has_sink) bound = fmaxf(bound, sink2);
  const int q0 = qb * 64;
  const int qtok = (kind == 0 ? LC : 0) + q0 + 16 * wv + lr;
  bf16x8 qf[2];
#pragma unroll
  for (int s = 0; s < 2; ++s) qf[s] = *(const bf16x8*)(p.projb + (size_t)qtok * DIN + qoff + 32 * s + 8 * g);
  f32x4 o[4];
#pragma unroll
  for (int m = 0; m < 4; ++m) o[m] = (f32x4){0.f, 0.f, 0.f, 0.f};
  float lsum = 0.f;
  const int nloc = (kind == 0) ? 5 : 0, nch = nloc + 4;
  auto tokfn = [&](int c) {
    return [=](int row) {
      if (c < nloc) { int pos = q0 - 128 + 64 * c + row; pos = pos < 0 ? 0 : (pos > SEQ - 1 ? SEQ - 1 : pos); return LC + pos; }
      return 64 * (c - nloc) + row;
    };
  };
  KVRegs kr;
  __syncthreads();
  kv_load(p, kr, koff, voff, tokfn(0), tid);
  kv_store(kr, smem, tid);
  __syncthreads();
  for (int c = 0; c < nch; ++c) {
    const char* stage = smem + (c & 1) * 16384;
    if (c + 1 < nch) kv_load(p, kr, koff, voff, tokfn(c + 1), tid);
    if (c < nloc) {
      const int qpos = q0 + 16 * wv + lr;
#pragma unroll
      for (int st = 0; st < 2; ++st) {
        const int kbase = q0 - 128 + 64 * c + 32 * st;
        attn_step(stage, 32 * st, qf, o, lsum, [&](int t2, int r, float s) {
          int kpos = kbase + 16 * t2 + 4 * g + r;
          int dlt = kpos - qpos; dlt = dlt < 0 ? -dlt : dlt;
          bool valid = (kpos >= 0) && (kpos < SEQ) && (dlt <= 128);
          return valid ? s - bound : -1e30f;
        }, lane);
      }
    } else {
#pragma unroll
      for (int st = 0; st < 2; ++st) attn_step(stage, 32 * st, qf, o, lsum, [&](int t2, int r, float s) { return s - bound; }, lane);
    }
    if (c + 1 < nch) kv_store(kr, smem + ((c + 1) & 1) * 16384, tid);
    __syncthreads();
  }
  if (has_sink && g == 0) lsum += exp2f(sink2 - bound);
  attn_store_out(p, o, lsum, qtok, ooff, lane);
}

__device__ __forceinline__ void attn_na_item(const P& p, int l, int r, int h, char* smem) {
  const int tid = tid_opaque(), lane = tid & 63, wv = tid >> 6, g = lane >> 4, lr = lane & 15;
  const int qoff = OFF_QN + h * 64, koff = OFF_KN + h * 64, voff = OFF_VN + h * 64, ooff = 640 + h * 64;
  float* rpbl = (float*)(smem + 32768);
  const float* rpbg = p.rpb + (size_t)(l * 6 + h) * 465;
  float bmax = 0.f;
  __syncthreads();
  for (int i = tid; i < 465; i += 256) { float b = rpbg[i] * LOG2E; rpbl[i] = b; }
  for (int i = lane; i < 465; i += 64) bmax = fmaxf(bmax, fabsf(rpbg[i]) * LOG2E);
  bmax = wave_max(bmax);
  const float bound = 8.f * LOG2E * wave_max(fabsf(p.na_qn[l * 64 + lane])) * wave_max(fabsf(p.na_kn[l * 64 + lane])) * 1.0001f + bmax + 1e-3f;
  const int qcol = 16 * wv + lr;
  const int qtok = LC + r * 64 + qcol;
  const int kr0r = min(max(r - 4, 0), 248);
  const int kc0 = min(max(16 * wv - 8, 0), 32);
  const int qs = min(max(qcol - 8, 0), 48);
  bf16x8 qf[2];
#pragma unroll
  for (int s = 0; s < 2; ++s) qf[s] = *(const bf16x8*)(p.projb + (size_t)qtok * DIN + qoff + 32 * s + 8 * g);
  f32x4 o[4];
#pragma unroll
  for (int m = 0; m < 4; ++m) o[m] = (f32x4){0.f, 0.f, 0.f, 0.f};
  float lsum = 0.f;
  auto tokfn = [&](int c) {
    return [=](int row) { return c < 8 ? LC + (kr0r + c) * 64 + row : 64 * (c - 8) + row; };
  };
  KVRegs kr;
  kv_load(p, kr, koff, voff, tokfn(0), tid);
  kv_store(kr, smem, tid);
  __syncthreads();
  for (int c = 0; c < 12; ++c) {
    const char* stage = smem + (c & 1) * 16384;
    if (c + 1 < 12) kv_load(p, kr, koff, voff, tokfn(c + 1), tid);
    if (c < 8) {
      const int dr = kr0r + c - r + 7;
      attn_step(stage, kc0, qf, o, lsum, [&](int t2, int rr, float s) {
        int kcol = kc0 + 16 * t2 + 4 * g + rr;
        bool valid = (kcol >= qs) && (kcol < qs + 16);
        int dc = kcol - qcol + 15; dc = dc < 0 ? 0 : (dc > 30 ? 30 : dc);
        return valid ? s + rpbl[dr * 31 + dc] - bound : -1e30f;
      }, lane);
    } else {
#pragma unroll
      for (int st = 0; st < 2; ++st) attn_step(stage, 32 * st, qf, o, lsum, [&](int t2, int rr, float s) { return s - bound; }, lane);
    }
    if (c + 1 < 12) kv_store(kr, smem + ((c + 1) & 1) * 16384, tid);
    __syncthreads();
  }
  attn_store_out(p, o, lsum, qtok, ooff, lane);
}

__device__ __forceinline__ void ph_attn(const P& p, int l, char* smem) {
  const int nitems = 3072 + (l == 0 ? 48 : 0);
  for (int it = blockIdx.x; it < nitems; it += gridDim.x) {
    if (it < 1536) attn_win_item(p, l, 0, it / 6, it % 6, smem);
    else if (it < 3072) { int j = it - 1536; attn_na_item(p, l, j / 6, j % 6, smem); }
    else { int j = it - 3072; attn_win_item(p, l, 1, j / 12, j % 12, smem); }
  }
}

__device__ __forceinline__ unsigned ord_key(float s) {
  unsigned u = __float_as_uint(s);
  return (u & 0x80000000u) ? ~u : (u | 0x80000000u);
}
__device__ __forceinline__ float ord_val(unsigned pk) {
  unsigned u = pk & ~127u;
  unsigned b = (u & 0x80000000u) ? (u & 0x7fffffffu) : ~u;
  return __uint_as_float(b);
}
__device__ __forceinline__ void ce_desc(unsigned& a, unsigned& b) {
  unsigned mx = a > b ? a : b, mn = a > b ? b : a;
  a = mx; b = mn;
}
__device__ __forceinline__ void sort16_desc(unsigned (&v)[16]) {
#pragma unroll
  for (int k = 2; k <= 16; k <<= 1) {
#pragma unroll
    for (int j = k >> 1; j > 0; j >>= 1) {
#pragma unroll
      for (int i = 0; i < 16; ++i) {
        int m = i ^ j;
        if (m > i) {
          if ((i & k) == 0) ce_desc(v[i], v[m]); else ce_desc(v[m], v[i]);
        }
      }
    }
  }
}
__device__ __forceinline__ void merge16_desc(unsigned (&a)[16], const unsigned (&b)[16]) {
#pragma unroll
  for (int i = 0; i < 16; ++i) { unsigned o = b[15 - i]; a[i] = a[i] > o ? a[i] : o; }
#pragma unroll
  for (int j = 8; j > 0; j >>= 1) {
#pragma unroll
    for (int i = 0; i < 16; ++i) {
      int m = i ^ j;
      if (m > i) ce_desc(a[i], a[m]);
    }
  }
}

typedef __attribute__((ext_vector_type(2))) float f32x2;
__device__ __forceinline__ void ph_prep_peer(const P& p) {
  const int tid = tid_opaque(), lane = tid & 63;
  const int nw = gridDim.x * 4;
  for (int row = blockIdx.x * 4 + (tid >> 6); row < 4 * 16384; row += nw) {
    const int tbl = row >> 15, le = row & 32767;
    const float4* src = (const float4*)((tbl ? p.pv : p.pu) + (size_t)le * 1024) + lane * 4;
    float4 v[4];
    float am = 0.f;
#pragma unroll
    for (int i = 0; i < 4; ++i) {
      v[i] = src[i];
      am = fmaxf(am, fmaxf(fmaxf(fabsf(v[i].x), fabsf(v[i].y)), fmaxf(fabsf(v[i].z), fabsf(v[i].w))));
    }
    am = wave_max(am);
    const float sc = am > 0.f ? 224.f / am : 1.f;
    unsigned w[4];
#pragma unroll
    for (int i = 0; i < 4; ++i) {
      int t = __builtin_amdgcn_cvt_pk_fp8_f32(v[i].x * sc, v[i].y * sc, 0, false);
      t = __builtin_amdgcn_cvt_pk_fp8_f32(v[i].z * sc, v[i].w * sc, t, true);
      w[i] = (unsigned)t;
    }
    ((uint4*)((tbl ? p.vb8 : p.ub8) + (size_t)le * 1024))[lane] = make_uint4(w[0], w[1], w[2], w[3]);
    if (lane == 0) (tbl ? p.vsc : p.usc)[le] = am > 0.f ? am / 224.f : 1.f;
  }
  for (int i = GTID; i < 2 * 128 * 128; i += GSZ) { p.k1b[i] = f2bf(p.k1[i]); p.k2b[i] = f2bf(p.k2[i]); }
}

struct EpiPeerTopk {
  int l;
  __device__ __forceinline__ void operator()(const P& p, f32x4 (&acc)[4][4], int m0, int n0, int wm, int wn, int lane, char* smem) const {
    const int tid = ((wm * 2 + wn) << 6) | lane, g = lane >> 4, lr = lane & 15;
    const int nt = n0 >> 7, head = nt >> 1, hf = nt & 1;
    char* qimg = smem;
    char* kimg = smem + 34816;
    {
      char* qw = qimg + (wm * 64 + 4 * g) * 272 + (wn * 64 + lr) * 2;
#pragma unroll
      for (int i = 0; i < 4; ++i)
#pragma unroll
        for (int r = 0; r < 4; ++r)
#pragma unroll
          for (int j = 0; j < 4; ++j) *(bf16_t*)(qw + (16 * i + r) * 272 + 32 * j) = f2bf(acc[i][j][r]);
      const bf16_t* kk = (hf ? p.k2b : p.k1b) + (size_t)l * 16384 + (tid >> 4) * 128 + (tid & 15) * 8;
      char* kw = kimg + (tid >> 4) * 272 + (tid & 15) * 16;
#pragma unroll
      for (int i = 0; i < 8; ++i) *(uint4*)(kw + i * 16 * 272) = *(const uint4*)(kk + i * 16 * 128);
    }
    __syncthreads();
#pragma unroll
    for (int i = 0; i < 4; ++i)
#pragma unroll
      for (int j = 0; j < 4; ++j) acc[i][j] = (f32x4){0.f, 0.f, 0.f, 0.f};
    {
      const char* qa = qimg + (wm * 64 + lr) * 272 + g * 16;
      const char* kb = kimg + (wn * 64 + lr) * 272 + g * 16;
#pragma unroll
      for (int s = 0; s < 4; ++s) {
        bf16x8 af[4], bfr[4];
#pragma unroll
        for (int i = 0; i < 4; ++i) af[i] = *(const bf16x8*)(qa + i * 16 * 272 + s * 64);
#pragma unroll
        for (int j = 0; j < 4; ++j) bfr[j] = *(const bf16x8*)(kb + j * 16 * 272 + s * 64);
#pragma unroll
        for (int i = 0; i < 4; ++i)
#pragma unroll
          for (int j = 0; j < 4; ++j) acc[i][j] = __builtin_amdgcn_mfma_f32_16x16x32_bf16(af[i], bfr[j], acc[i][j], 0, 0, 0);
      }
    }
    __syncthreads();
    unsigned* simg = (unsigned*)smem;
    {
      unsigned* sw = simg + (wm * 64 + 4 * g) * 129 + wn * 64 + lr;
#pragma unroll
      for (int i = 0; i < 4; ++i)
#pragma unroll
        for (int r = 0; r < 4; ++r)
#pragma unroll
          for (int j = 0; j < 4; ++j)
            sw[(16 * i + r) * 129 + 16 * j] = (ord_key(acc[i][j][r]) & ~127u) | (unsigned)(wn * 64 + 16 * j + lr);
    }
    __syncthreads();
    const int row = tid & 127, half = tid >> 7;
    unsigned top[16];
    {
      const unsigned* sr = simg + row * 129 + half * 64;
#pragma unroll
      for (int k = 0; k < 16; ++k) top[k] = sr[k];
      sort16_desc(top);
#pragma unroll 1
      for (int gi = 1; gi < 4; ++gi) {
        unsigned v1[16];
#pragma unroll
        for (int k = 0; k < 16; ++k) v1[k] = sr[gi * 16 + k];
        sort16_desc(v1);
        merge16_desc(top, v1);
      }
    }
    __syncthreads();
    if (half == 1) {
#pragma unroll
      for (int k = 0; k < 16; ++k) simg[k * 128 + row] = top[k];
    }
    __syncthreads();
    if (half == 0) {
      unsigned o[16];
#pragma unroll
      for (int k = 0; k < 16; ++k) o[k] = simg[k * 128 + row];
      merge16_desc(top, o);
      uint4* dst = (uint4*)(p.pk + (((size_t)(m0 + row) * 8 + head) * 2 + hf) * 16);
#pragma unroll
      for (int k = 0; k < 4; ++k) dst[k] = make_uint4(top[4 * k], top[4 * k + 1], top[4 * k + 2], top[4 * k + 3]);
    }
  }
};

__device__ const unsigned char CAND_A[64] = {0,0,0,0,0,0,0,0,0,0,0,0,0,0,0,0, 1,1,1,1,1,1,1,1, 2,2,2,2,2, 3,3,3,3, 4,4,4, 5,5, 6,6, 7,7,
                                             8,9,10,11,12,13,14,15, 0,0,0,0,0,0,0,0,0,0,0,0,0,0};
__device__ const unsigned char CAND_B[64] = {0,1,2,3,4,5,6,7,8,9,10,11,12,13,14,15, 0,1,2,3,4,5,6,7, 0,1,2,3,4, 0,1,2,3, 0,1,2, 0,1, 0,1, 0,1,
                                             0,0,0,0,0,0,0,0, 0,0,0,0,0,0,0,0,0,0,0,0,0,0};

__device__ __forceinline__ void ph_peer_apply2(const P& p, int l, int t0, char* smem) {
  const int tid = tid_opaque(), lane = tid & 63, wv = tid >> 6;
  int* lds_e = (int*)(smem + wv * 1024);
  float* lds_g = (float*)(smem + wv * 1024 + 512);
  const unsigned char* U = p.ub8 + (size_t)l * 16384 * 1024;
  const unsigned char* V = p.vb8 + (size_t)l * 16384 * 1024;
  const float* usc = p.usc + l * 16384;
  const float* vsc = p.vsc + l * 16384;
  const float* n2g = p.norm2_g + l * 1024;
  const int ca = CAND_A[lane], cb = CAND_B[lane];
  for (int tk = t0 + blockIdx.x * 4 + wv; tk < TT; tk += gridDim.x * 4) {
    const float* mod = p.mod + (l * 2 + (tk < LC ? 1 : 0)) * 6144;
    float xv[16], hv[16];
    {
      const float4* xp = (const float4*)(p.xall + (size_t)tk * 1024) + lane * 4;
      float ss = 0.f;
#pragma unroll
      for (int q = 0; q < 4; ++q) {
        float4 v = xp[q];
        xv[q * 4 + 0] = v.x; xv[q * 4 + 1] = v.y; xv[q * 4 + 2] = v.z; xv[q * 4 + 3] = v.w;
        ss += v.x * v.x + v.y * v.y + v.z * v.z + v.w * v.w;
      }
      ss = wave_sum(ss);
      float rinv = rsqrtf(ss * (1.f / 1024.f) + EPS);
#pragma unroll
      for (int q = 0; q < 4; ++q) {
        float4 gg = ((const float4*)n2g)[lane * 4 + q], sc = ((const float4*)(mod + 4096))[lane * 4 + q], sh = ((const float4*)(mod + 3072))[lane * 4 + q];
        hv[q * 4 + 0] = xv[q * 4 + 0] * rinv * gg.x * (1.f + sc.x) + sh.x;
        hv[q * 4 + 1] = xv[q * 4 + 1] * rinv * gg.y * (1.f + sc.y) + sh.y;
        hv[q * 4 + 2] = xv[q * 4 + 2] * rinv * gg.z * (1.f + sc.z) + sh.z;
        hv[q * 4 + 3] = xv[q * 4 + 3] * rinv * gg.w * (1.f + sc.w) + sh.w;
      }
    }
    for (int head = 0; head < 8; ++head) {
      const unsigned* pk = p.pk + ((size_t)tk * 8 + head) * 32;
      unsigned p1 = pk[ca], p2 = pk[16 + cb];
      float sum = lane < 50 ? ord_val(p1) + ord_val(p2) : -3.0e38f;
      int eid = (int)(p1 & 127u) * 128 + (int)(p2 & 127u);
      int rank = 0;
      for (int m = 0; m < 50; ++m) {
        float sm = __shfl(sum, m);
        rank += (sm > sum || (sm == sum && m < lane)) ? 1 : 0;
      }
      float mx = wave_max(sum);
      bool sel = (lane < 50) && (rank < 16);
      float e = sel ? __expf(sum - mx) : 0.f;
      float tot = wave_sum(e);
      if (sel) { lds_e[head * 16 + rank] = eid; lds_g[head * 16 + rank] = e / tot; }
    }
    float acc[16];
#pragma unroll
    for (int k = 0; k < 16; ++k) acc[k] = 0.f;
    for (int e0 = 0; e0 < 128; e0 += 8) {
      uint4 ur[8], vr[8];
      float gt[8], us[8], vs[8];
#pragma unroll
      for (int k = 0; k < 8; ++k) {
        int ex = __builtin_amdgcn_readfirstlane(lds_e[e0 + k]);
        gt[k] = lds_g[e0 + k];
        ur[k] = ((const uint4*)(U + (size_t)ex * 1024))[lane];
        vr[k] = ((const uint4*)(V + (size_t)ex * 1024))[lane];
        us[k] = usc[ex]; vs[k] = vsc[ex];
      }
#pragma unroll
      for (int k = 0; k < 8; ++k) {
        float dot = 0.f;
        unsigned w[4] = {ur[k].x, ur[k].y, ur[k].z, ur[k].w};
#pragma unroll
        for (int q = 0; q < 4; ++q) {
          f32x2 lo = __builtin_amdgcn_cvt_pk_f32_fp8((int)w[q], false), hi = __builtin_amdgcn_cvt_pk_f32_fp8((int)w[q], true);
          dot += lo[0] * hv[q * 4] + lo[1] * hv[q * 4 + 1] + hi[0] * hv[q * 4 + 2] + hi[1] * hv[q * 4 + 3];
        }
        dot = wave_sum(dot) * us[k];
        float a = gt[k] * gelu_f(dot) * vs[k];
        unsigned y[4] = {vr[k].x, vr[k].y, vr[k].z, vr[k].w};
#pragma unroll
        for (int q = 0; q < 4; ++q) {
          f32x2 lo = __builtin_amdgcn_cvt_pk_f32_fp8((int)y[q], false), hi = __builtin_amdgcn_cvt_pk_f32_fp8((int)y[q], true);
          acc[q * 4] += a * lo[0]; acc[q * 4 + 1] += a * lo[1]; acc[q * 4 + 2] += a * hi[0]; acc[q * 4 + 3] += a * hi[1];
        }
      }
    }
    {
      float4* xp = ((l == 1) ? (float4*)(p.out + (size_t)(tk - LC) * 1024) : (float4*)(p.xall + (size_t)tk * 1024)) + lane * 4;
#pragma unroll
      for (int q = 0; q < 4; ++q) {
        float4 gg = ((const float4*)(mod + 5120))[lane * 4 + q];
        float4 o;
        o.x = xv[q * 4 + 0] + gg.x * acc[q * 4 + 0];
        o.y = xv[q * 4 + 1] + gg.y * acc[q * 4 + 1];
        o.z = xv[q * 4 + 2] + gg.z * acc[q * 4 + 2];
        o.w = xv[q * 4 + 3] + gg.w * acc[q * 4 + 3];
        xp[q] = o;
      }
    }
  }
}

#define XB_TMO      128
#define XB_XCNT(j)  (256  + 64 * (j))
#define XB_XSUB(j)  (1280 + 64 * (j))
#define XB_XGEN(j)  (2304 + 64 * (j))
#define XB_TOP      3328
#define XB_TOPGEN   3392
#define XCD_BAR_WORDS 3456
#define XB_SPIN_CAP (1u << 22)
#define LAS __attribute__((address_space(3)))
__device__ __forceinline__ unsigned xb_ld(unsigned* q) { return __hip_atomic_load(q, __ATOMIC_RELAXED, __HIP_MEMORY_SCOPE_AGENT); }
__device__ __forceinline__ unsigned xb_add(unsigned* q, unsigned v) { return __hip_atomic_fetch_add(q, v, __ATOMIC_RELAXED, __HIP_MEMORY_SCOPE_AGENT); }
__device__ __forceinline__ unsigned xb_xcc_id() { return (unsigned)__builtin_amdgcn_s_getreg((3 << 11) | 20) & 0xFu; }
#define XB_SPIN(cond, bar) do { unsigned _sp = 0; while (cond) { __builtin_amdgcn_s_sleep(1); \
    if ((++_sp & 255u) == 0u) { if (xb_ld(&(bar)[XB_TMO])) break; if (_sp > XB_SPIN_CAP) { atomicAdd(&(bar)[XB_TMO], 1u); break; } } } } while (0)
struct XcdBarrier { unsigned* bar; unsigned x; volatile LAS unsigned* st; };
__device__ __forceinline__ XcdBarrier xcd_barrier_post(unsigned* bar, volatile LAS unsigned* st) {
  XcdBarrier b; b.bar = bar; b.x = xb_xcc_id(); b.st = st;
  if (threadIdx.x == 0) (void)xb_add(&bar[XB_XCNT(b.x)], 1u);
  return b;
}
__device__ __forceinline__ void xcd_barrier_complete(unsigned* bar, unsigned x, unsigned& nloc, unsigned& nx) {
  const unsigned G = gridDim.x * gridDim.y * gridDim.z;
  unsigned sum, cnt, mine, sp = 0u;
  for (;;) {
    sum = 0u; cnt = 0u; mine = 0u;
#pragma unroll
    for (unsigned j = 0; j < 16; ++j) { const unsigned c = xb_ld(&bar[XB_XCNT(j)]); sum += c; cnt += (c > 0u) ? 1u : 0u; mine = (j == x) ? c : mine; }
    if (sum == G) break;
    __builtin_amdgcn_s_sleep(1);
    if ((++sp & 255u) == 0u) { if (xb_ld(&bar[XB_TMO])) break; if (sp > XB_SPIN_CAP) { atomicAdd(&bar[XB_TMO], 1u); break; } }
  }
  nloc = mine > 0u ? mine : 1u; nx = cnt > 0u ? cnt : 1u;
}
__device__ __forceinline__ void xcd_barrier(const XcdBarrier& b) {
  asm volatile("s_waitcnt vmcnt(0)" ::: "memory");
  __syncthreads();
  if (threadIdx.x == 0) {
    unsigned* bar = b.bar;
    __builtin_amdgcn_s_waitcnt(0);
    unsigned nloc = b.st[0], nx = b.st[1];
    if (nloc == 0u) { xcd_barrier_complete(bar, b.x, nloc, nx); b.st[0] = nloc; b.st[1] = nx; }
    const unsigned old = xb_add(&bar[XB_XSUB(b.x)], 1u);
    const unsigned gen = old / nloc;
    if (old + 1u == (gen + 1u) * nloc) {
      __builtin_amdgcn_fence(__ATOMIC_RELEASE, "agent");
      asm volatile("s_waitcnt vmcnt(0)" ::: "memory");
      const unsigned og = xb_add(&bar[XB_TOP], 1u);
      const unsigned tg = og / nx;
      if (og + 1u == (tg + 1u) * nx) xb_add(&bar[XB_TOPGEN], 1u);
      else XB_SPIN(xb_ld(&bar[XB_TOPGEN]) == tg, bar);
      __builtin_amdgcn_fence(__ATOMIC_ACQUIRE, "agent");
      xb_add(&bar[XB_XGEN(b.x)], 1u);
      asm volatile("s_waitcnt vmcnt(0)" ::: "memory");
    } else {
      XB_SPIN(xb_ld(&bar[XB_XGEN(b.x)]) == gen, bar);
      __builtin_amdgcn_fence(__ATOMIC_ACQUIRE, "agent");
      asm volatile("s_waitcnt vmcnt(0)" ::: "memory");
    }
  }
  __syncthreads();
}

#ifndef PROBE_IV
#define PROBE_IV -1
#endif
__device__ __forceinline__ void probe_tick(int& cnt, unsigned long long* slots) {
  if (PROBE_IV >= 0) {
    if (threadIdx.x == 0 && (cnt == PROBE_IV || cnt == PROBE_IV + 1)) slots[cnt - PROBE_IV] = __builtin_amdgcn_s_memrealtime();
    cnt = __builtin_amdgcn_readfirstlane(cnt + 1);
  }
}
#define BARRIER() do { xcd_barrier(xb); probe_tick(pcnt, probe_t); } while (0)

typedef const __attribute__((address_space(4))) P* KP;
__device__ __forceinline__ P load_params(KP kp) {
#if defined(__HIP_DEVICE_COMPILE__)
  asm volatile("" : "+s"(kp));
  return *kp;
#else
  return P{};
#endif
}
#define PP load_params(kp)
__global__ void __launch_bounds__(256, 2) k_mega(P p_unused) {
  KP kp = (KP)__builtin_amdgcn_kernarg_segment_ptr();
  __shared__ __attribute__((aligned(16))) float smem[18432];
  __shared__ uint4 xb_words;
  cg::grid_group grid = cg::this_grid();
  if (threadIdx.x == 0) xb_words = make_uint4(0u, 0u, 0u, 0u);
  __syncthreads();
  __shared__ unsigned long long probe_t[2];
  int pcnt = 0;
  asm volatile("" : "+s"(pcnt));
  probe_tick(pcnt, probe_t);
  ph_mod(PP, smem);
  ph_prep(PP, smem);
  ph_lru_prepw(PP);
  ph_prep_peer(PP);
  grid.sync();
  probe_tick(pcnt, probe_t);
  XcdBarrier xb = xcd_barrier_post(PP.bar, (volatile LAS unsigned*)&xb_words);
  ph_norm_mod(PP, 0, 0, 0, smem, true);
  BARRIER();
#pragma unroll 1
  for (int l = 0; l < 2; ++l) {
    const int t0 = (l == 0) ? 0 : LC;
    { const P lp = PP; gemm_bf16_128(lp, lp.hb, lp.w_in_t + (size_t)l * 1024 * DIN, 1024, 0, TT, DIN, (char*)smem, EpiProjSplit{}); }
    BARRIER();
    ph_qknorm_rope2(PP, l);
    BARRIER();
    ph_lru<1>(PP, l, (char*)smem);
    ph_attn(PP, l, (char*)smem);
    BARRIER();
    ph_lru<2>(PP, l, (char*)smem);
    BARRIER();
    { const P lp = PP; gemm_bf16_128(lp, lp.mixb, lp.w_out_t + (size_t)l * 1024 * 1024, 1024, t0, TT, 1024, (char*)smem, EpiResid{l, 2048}); }
    BARRIER();
    ph_norm_mod(PP, l, 1, t0, smem);
    BARRIER();
    { const P lp = PP; gemm_bf16_128(lp, lp.hb, lp.wq_t + (size_t)l * 1024 * NPQ, 1024, t0, TT, NPQ, (char*)smem, EpiPeerTopk{l}); }
    BARRIER();
    ph_peer_apply2(PP, l, t0, (char*)smem);
    if (l == 0) {
      BARRIER();
      ph_norm_mod(PP, 1, 0, 0, smem);
      BARRIER();
    }
  }
  if (PROBE_IV >= 0) {
    probe_tick(pcnt, probe_t);
    __syncthreads();
    if (blockIdx.x == 0 && threadIdx.x == 0) {
      const unsigned long long dt = (probe_t[1] - probe_t[0]) * 8ull, ts = __builtin_amdgcn_s_memrealtime();
      while (__builtin_amdgcn_s_memrealtime() - ts < dt) __builtin_amdgcn_s_sleep(8);
    }
  }
}

extern "C" void kernel_launch(void* const* d_in, const int* in_sizes, int n_in, void* d_out, int out_size, void* d_ws,
                              size_t ws_size, hipStream_t stream) {
  P p{};
  const float** fp = (const float**)&p;
  for (int i = 0; i < 28; ++i) fp[i] = (const float*)d_in[i];
  p.out = (float*)d_out;
  float* w = (float*)d_ws;
  size_t o = 0;
  auto carve = [&](size_t n) { float* r = w + o; o += (n + 63) & ~(size_t)63; return r; };
  p.bar = (unsigned*)carve(4096);
  p.mod = carve(4 * 6144);
  p.xall = carve((size_t)TT * 1024);
  p.proj = carve((size_t)TT * 512);
  p.projb = (bf16_t*)carve((size_t)TT * DIN / 2);
  p.mixb = (bf16_t*)carve((size_t)TT * 512);
  p.hb = (bf16_t*)carve((size_t)TT * 512);
  p.w_in_t = (bf16_t*)carve((size_t)1024 * DIN);
  p.w_out_t = (bf16_t*)carve((size_t)1024 * 1024);
  p.wq_t = (bf16_t*)carve((size_t)1024 * NPQ);
  p.lruw_t = (bf16_t*)carve((size_t)2 * 2 * 4 * 2 * 4096 / 2);
  p.lagg = carve((size_t)2 * NCHUNK * 256 * 2);
  p.pk = (unsigned*)carve((size_t)TT * 256);
  p.ub8 = (unsigned char*)carve((size_t)2 * 16384 * 1024 / 4);
  p.vb8 = (unsigned char*)carve((size_t)2 * 16384 * 1024 / 4);
  p.usc = carve(2 * 16384);
  p.vsc = carve(2 * 16384);
  p.k1b = (bf16_t*)carve(16384);
  p.k2b = (bf16_t*)carve(16384);
  if (o * 4 > ws_size) { fprintf(stderr, "workspace too small: need %zu have %zu\n", o * 4, ws_size); return; }
  static int grid_blocks = 0;
  if (!grid_blocks) {
    int dev = 0, cus = 0, per_cu = 0;
    (void)hipGetDevice(&dev);
    (void)hipDeviceGetAttribute(&cus, hipDeviceAttributeMultiprocessorCount, dev);
    (void)hipOccupancyMaxActiveBlocksPerMultiprocessor(&per_cu, k_mega, 256, 0);
    if (per_cu > 2) per_cu = 2;
    grid_blocks = cus * per_cu;
  }
  (void)hipMemsetAsync(p.bar, 0, XCD_BAR_WORDS * 4, stream);
  void* args[] = {&p};
  hipError_t e = hipLaunchCooperativeKernel((void*)k_mega, dim3(grid_blocks), dim3(256), args, 0, stream);
  if (e != hipSuccess) fprintf(stderr, "cooperative launch failed: %s (grid %d)\n", hipGetErrorString(e), grid_blocks);
}
```

```cpp
#include <hip/hip_runtime.h>
#include <hip/hip_cooperative_groups.h>
#include <stdint.h>
#include <stdio.h>
namespace cg = cooperative_groups;

#ifndef SINGLE_LAUNCH
#define SINGLE_LAUNCH 1
#endif

constexpr int DM = 1024, SEQ = 16384, LC = 256, TT = SEQ + LC, DIN = 2304, NPQ = 2048;
constexpr int OFF_XA = 0, OFF_GA = 256, OFF_QW = 512, OFF_KW = 896, OFF_VW = 1024, OFF_QN = 1152, OFF_KN = 1536, OFF_VN = 1920;
constexpr float EPS = 1e-6f;

struct P {
  const float *x, *c, *ctx, *c_ctx, *w_mod, *b_mod, *norm1_g, *norm2_g, *w_in, *w_out,
      *conv_w, *conv_b, *wa, *ba, *wx, *bx, *lam, *win_qn, *win_kn, *win_sink, *na_qn, *na_kn, *rpb,
      *wq, *k1, *k2, *pu, *pv;
  float* out;
  float *mod, *xall, *proj;
  unsigned short* projb;
  unsigned* pk;
  unsigned* bar;
  unsigned short *k1b, *k2b;
  unsigned char *ub8, *vb8;
  float *usc, *vsc;
  unsigned short *hb, *mixb, *w_in_t, *w_out_t, *wq_t, *lruw_t;
  float* lagg;
};

typedef unsigned short bf16_t;
typedef __attribute__((ext_vector_type(8))) short bf16x8;
typedef __attribute__((ext_vector_type(4))) float f32x4;
__device__ __forceinline__ unsigned short f2bf(float f) {
  unsigned u = __float_as_uint(f);
  u += 0x7fffu + ((u >> 16) & 1u);
  return (unsigned short)(u >> 16);
}
__device__ __forceinline__ unsigned pack2bf(float a, float b) { return (unsigned)f2bf(a) | ((unsigned)f2bf(b) << 16); }
__device__ __forceinline__ float bf2f(unsigned short h) { return __uint_as_float(((unsigned)h) << 16); }


__device__ __forceinline__ float silu_f(float x) { return x / (1.f + __expf(-x)); }
__device__ __forceinline__ float sigmoid_f(float x) { return 1.f / (1.f + __expf(-x)); }
__device__ __forceinline__ float gelu_f(float x) {
  float u = 0.7978845608028654f * (x + 0.044715f * x * x * x);
  float e = __expf(2.f * u);
  float th = 1.f - 2.f / (e + 1.f);
  return 0.5f * x * (1.f + th);
}
template <int CTRL, int RMASK>
__device__ __forceinline__ float dpp_mov(float v) {
  return __int_as_float(__builtin_amdgcn_update_dpp(0, __float_as_int(v), CTRL, RMASK, 0xf, false));
}
__device__ __forceinline__ float wave_sum(float v) {
  v += dpp_mov<0xB1, 0xf>(v);
  v += dpp_mov<0x4E, 0xf>(v);
  v += dpp_mov<0x141, 0xf>(v);
  v += dpp_mov<0x140, 0xf>(v);
  v += dpp_mov<0x142, 0xa>(v);
  v += dpp_mov<0x143, 0xc>(v);
  return __int_as_float(__builtin_amdgcn_readlane(__float_as_int(v), 63));
}

__device__ __forceinline__ int tid_opaque() { int t = threadIdx.x; asm volatile("" : "+v"(t)); return t; }
#define GTID (blockIdx.x * blockDim.x + tid_opaque())
#define GSZ (gridDim.x * blockDim.x)

__device__ __forceinline__ void ph_mod(const P& p, float* smem) {
  const int tid = tid_opaque(), cl = tid & 31, ks = tid >> 5;
  for (int it = blockIdx.x; it < 2 * 192; it += gridDim.x) {
    const int nc = it % 192, l = it / 192;
    const int n = nc * 32 + cl;
    const float* w = p.w_mod + (size_t)l * 1024 * 6144 + n;
    float a0 = 0.f, a1 = 0.f;
#pragma unroll 8
    for (int i = 0; i < 128; ++i) {
      int k = i * 8 + ks;
      float wv = w[(size_t)k * 6144];
      a0 += silu_f(p.c[k]) * wv;
      a1 += silu_f(p.c_ctx[k]) * wv;
    }
    __syncthreads();
    smem[tid] = a0; smem[256 + tid] = a1;
    __syncthreads();
    if (tid < 64) {
      const int which = tid >> 5;
      float s = p.b_mod[l * 6144 + n];
#pragma unroll
      for (int q = 0; q < 8; ++q) s += smem[which * 256 + q * 32 + cl];
      p.mod[(l * 2 + which) * 6144 + n] = s;
    }
  }
}

__device__ __forceinline__ void ph_copy_in(const P& p) {
  const float4* xs = (const float4*)p.x;
  const float4* cs = (const float4*)p.ctx;
  float4* d = (float4*)p.xall;
  for (int i = GTID; i < TT * 256; i += GSZ) d[i] = (i < LC * 256) ? cs[i] : xs[i - LC * 256];
}

__device__ __forceinline__ void ph_copy_out(const P& p) {
  const float4* s = (const float4*)(p.xall + (size_t)LC * 1024);
  float4* d = (float4*)p.out;
  for (int i = GTID; i < SEQ * 256; i += GSZ) d[i] = s[i];
}

__device__ __forceinline__ void ph_norm_mod(const P& p, int l, int which_norm, int t0, float* smem, bool from_input = false) {
  const float* g = (which_norm ? p.norm2_g : p.norm1_g) + l * 1024;
  const int sh_off = which_norm ? 3072 : 0, sc_off = which_norm ? 4096 : 1024;
  const int tid = tid_opaque();
  for (int t = t0 + blockIdx.x; t < TT; t += gridDim.x) {
    const float* mod = p.mod + (l * 2 + (t < LC ? 1 : 0)) * 6144;
    float4 v;
    if (from_input) {
      v = t < LC ? ((const float4*)(p.ctx + (size_t)t * 1024))[tid] : ((const float4*)(p.x + (size_t)(t - LC) * 1024))[tid];
      ((float4*)(p.xall + (size_t)t * 1024))[tid] = v;
    } else v = ((const float4*)(p.xall + (size_t)t * 1024))[tid];
    float ss = wave_sum(v.x * v.x + v.y * v.y + v.z * v.z + v.w * v.w);
    __syncthreads();
    if ((tid & 63) == 0) smem[tid >> 6] = ss;
    __syncthreads();
    float tot = smem[0] + smem[1] + smem[2] + smem[3];
    float rinv = rsqrtf(tot * (1.f / 1024.f) + EPS);
    float4 gg = ((const float4*)g)[tid];
    float4 sc = ((const float4*)(mod + sc_off))[tid];
    float4 sh = ((const float4*)(mod + sh_off))[tid];
    float4 o;
    o.x = v.x * rinv * gg.x * (1.f + sc.x) + sh.x;
    o.y = v.y * rinv * gg.y * (1.f + sc.y) + sh.y;
    o.z = v.z * rinv * gg.z * (1.f + sc.z) + sh.z;
    o.w = v.w * rinv * gg.w * (1.f + sc.w) + sh.w;
    ((uint2*)(p.hb + (size_t)t * 1024))[tid] = make_uint2(pack2bf(o.x, o.y), pack2bf(o.z, o.w));
  }
}

__device__ __forceinline__ void prep_transpose(const float* W, bf16_t* Wt, int K, int N, int item0, int nitems_total, float* smem) {
  (void)nitems_total;
  float(*ts)[65] = (float(*)[65])smem;
  const int tid = tid_opaque();
  const int tn = N / 64, nt = (K / 64) * tn;
  for (int it = blockIdx.x; it < nt; it += gridDim.x) {
    int k0 = (it / tn) * 64, n0 = (it % tn) * 64;
    __syncthreads();
#pragma unroll
    for (int i = 0; i < 16; ++i) {
      int r = (tid >> 6) + i * 4, c = tid & 63;
      ts[r][c] = W[(size_t)(k0 + r) * N + n0 + c];
    }
    __syncthreads();
#pragma unroll
    for (int i = 0; i < 16; ++i) {
      int r = (tid >> 6) + i * 4, c = tid & 63;
      Wt[(size_t)(n0 + r) * K + k0 + c] = f2bf(ts[c][r]);
    }
  }
  (void)item0;
}

__device__ __forceinline__ void ph_prep(const P& p, float* smem) {
  for (int l = 0; l < 2; ++l) {
    prep_transpose(p.w_in + (size_t)l * 1024 * DIN, p.w_in_t + (size_t)l * 1024 * DIN, 1024, DIN, 0, 0, smem);
    prep_transpose(p.w_out + (size_t)l * 1024 * 1024, p.w_out_t + (size_t)l * 1024 * 1024, 1024, 1024, 0, 0, smem);
    prep_transpose(p.wq + (size_t)l * 1024 * NPQ, p.wq_t + (size_t)l * 1024 * NPQ, 1024, NPQ, 0, 0, smem);
  }
}

struct EpiStoreF32 {
  float* C; int ldc;
  __device__ __forceinline__ void operator()(const P& p, f32x4 (&acc)[4][4], int m0, int n0, int wm, int wn, int lane, char* smem) const {
    const int mw0 = m0 + wm * 64, nw0 = n0 + wn * 64;
#pragma unroll
    for (int i = 0; i < 4; ++i)
#pragma unroll
      for (int r = 0; r < 4; ++r) {
        int row = mw0 + 16 * i + (lane >> 4) * 4 + r;
#pragma unroll
        for (int j = 0; j < 4; ++j) C[(size_t)row * ldc + nw0 + 16 * j + (lane & 15)] = acc[i][j][r];
      }
  }
};
struct EpiProjSplit {
  __device__ __forceinline__ void operator()(const P& p, f32x4 (&acc)[4][4], int m0, int n0, int wm, int wn, int lane, char* smem) const {
    const int mw0 = m0 + wm * 64, nw0 = n0 + wn * 64;
#pragma unroll
    for (int i = 0; i < 4; ++i)
#pragma unroll
      for (int r = 0; r < 4; ++r) {
        int row = mw0 + 16 * i + (lane >> 4) * 4 + r;
#pragma unroll
        for (int j = 0; j < 4; ++j) {
          int col = nw0 + 16 * j + (lane & 15);
          if (n0 < 512) p.proj[(size_t)row * 512 + col] = acc[i][j][r];
          else p.projb[(size_t)row * DIN + col] = f2bf(acc[i][j][r]);
        }
      }
  }
};
struct EpiResid {
  int l, gofs;
  __device__ __forceinline__ void operator()(const P& p, f32x4 (&acc)[4][4], int m0, int n0, int wm, int wn, int lane, char* smem) const {
    const int mw0 = m0 + wm * 64, nw0 = n0 + wn * 64;
#pragma unroll
    for (int i = 0; i < 4; ++i)
#pragma unroll
      for (int r = 0; r < 4; ++r) {
        int row = mw0 + 16 * i + (lane >> 4) * 4 + r;
        const float* gt = p.mod + (l * 2 + (row < LC ? 1 : 0)) * 6144 + gofs;
#pragma unroll
        for (int j = 0; j < 4; ++j) {
          int col = nw0 + 16 * j + (lane & 15);
          p.xall[(size_t)row * 1024 + col] += gt[col] * acc[i][j][r];
        }
      }
  }
};

__device__ __forceinline__ int gemm_swz(int row) { return (0x78 >> (((row >> 2) & 3) * 2)) & 3; }
template <class Epi>
__device__ __forceinline__ void gemm_bf16_128(const P& p, const bf16_t* __restrict__ A, const bf16_t* __restrict__ Bt, int K, int m_begin, int m_end,
                              int N, char* smem, const Epi& epi) {
  const int tid = tid_opaque(), lane = tid & 63, wv = __builtin_amdgcn_readfirstlane(tid >> 6), wm = wv >> 1, wn = wv & 1;
  const int tiles_n = N / 128, tiles_m = (m_end - m_begin) / 128;
  const int nk = K / 32;
  const int lr = lane & 15, g = lane >> 4;
  const int a_rd = (wm * 64 + lr) * 64 + ((g ^ gemm_swz(lr)) << 4);
  const int b_rd = 8192 + (wn * 64 + lr) * 64 + ((g ^ gemm_swz(lr)) << 4);
  const int ld_row = lane >> 2, ld_c = (lane & 3) ^ gemm_swz(ld_row);
  for (int tile = blockIdx.x; tile < tiles_m * tiles_n; tile += gridDim.x) {
    const int m0 = m_begin + (tile / tiles_n) * 128, n0 = (tile % tiles_n) * 128;
    f32x4 acc[4][4];
#pragma unroll
    for (int i = 0; i < 4; ++i)
#pragma unroll
      for (int j = 0; j < 4; ++j) acc[i][j] = (f32x4){0.f, 0.f, 0.f, 0.f};
    const bf16_t* Ag = A + (size_t)(m0 + wv * 32 + ld_row) * K + ld_c * 8;
    const bf16_t* Bg = Bt + (size_t)(n0 + wv * 32 + ld_row) * K + ld_c * 8;
    auto issue = [&](int st, int kt) {
      char* base = smem + st * 16384 + wv * 2048;
#pragma unroll
      for (int i = 0; i < 2; ++i) {
        __builtin_amdgcn_global_load_lds((const unsigned*)(Ag + (size_t)i * 16 * K + kt * 32), (__attribute__((address_space(3))) unsigned*)(base + i * 1024), 16, 0, 0);
        __builtin_amdgcn_global_load_lds((const unsigned*)(Bg + (size_t)i * 16 * K + kt * 32), (__attribute__((address_space(3))) unsigned*)(base + 8192 + i * 1024), 16, 0, 0);
      }
    };
    issue(0, 0); issue(1, 1); issue(2, 2);
    for (int kt0 = 0; kt0 < nk; kt0 += 4) {
#pragma unroll
      for (int u = 0; u < 4; ++u) {
        const int kt = kt0 + u, rem = nk - kt;
        if (rem >= 3) asm volatile("s_waitcnt vmcnt(8) lgkmcnt(0)" ::: "memory");
        else if (rem == 2) asm volatile("s_waitcnt vmcnt(4) lgkmcnt(0)" ::: "memory");
        else asm volatile("s_waitcnt vmcnt(0) lgkmcnt(0)" ::: "memory");
        __builtin_amdgcn_s_barrier();
        if (kt + 3 < nk) issue((u + 3) & 3, kt + 3);
        bf16x8 af[4], bfr[4];
#pragma unroll
        for (int i = 0; i < 4; ++i) af[i] = *(const bf16x8*)(smem + u * 16384 + a_rd + i * 1024);
#pragma unroll
        for (int j = 0; j < 4; ++j) bfr[j] = *(const bf16x8*)(smem + u * 16384 + b_rd + j * 1024);
#pragma unroll
        for (int i = 0; i < 4; ++i)
#pragma unroll
          for (int j = 0; j < 4; ++j) acc[i][j] = __builtin_amdgcn_mfma_f32_16x16x32_bf16(af[i], bfr[j], acc[i][j], 0, 0, 0);
      }
    }
    __syncthreads();
    epi(p, acc, m0, n0, wm, wn, lane, smem);
    __syncthreads();
  }
}

constexpr int NCHUNK = TT / 64;
__device__ __forceinline__ int lru_pos(int dir, int c) { return dir == 0 ? c : (c < 4 ? 3 - c : 4 + (NCHUNK - 1 - c)); }

__device__ __forceinline__ void ph_lru_prepw(const P& p) {
  for (int idx = GTID; idx < 2 * 2 * 4 * 2 * 4096; idx += GSZ) {
    int d = idx & 63, e = (idx >> 6) & 63, mtx = (idx >> 12) & 1, rest = idx >> 13;
    const float* w = (mtx ? p.wx : p.wa) + (size_t)rest * 4096;
    p.lruw_t[idx] = f2bf(w[d * 64 + e]);
  }
}

template <int PASS>
__device__ __forceinline__ void lru_item(const P& p, int l, int cidx, int kb, char* smem) {
  bf16_t* u_img = (bf16_t*)smem;
  float* ab_a = (float*)(smem + 8192);
  float* ab_b = (float*)(smem + 8192 + 16384);
  float* hsum = (float*)(smem + 8192 + 32768);
  float* segagg = (float*)(smem + 8192 + 49152);
  float* ccarry = (float*)(smem + 8192 + 49152 + 2048);
  const int tid = tid_opaque(), lane = tid & 63, wv = tid >> 6, g = lane >> 4, lr = lane & 15;
  const int t0 = cidx * 64;
  const int lo = t0 < LC ? 0 : LC, hi = t0 < LC ? LC : TT;
  __syncthreads();
  {
    const int ch = tid & 63, c = kb * 64 + ch;
    const float cb = p.conv_b[l * 256 + c];
    float cw[4];
#pragma unroll
    for (int k = 0; k < 4; ++k) cw[k] = p.conv_w[(l * 4 + k) * 256 + c];
#pragma unroll
    for (int i = 0; i < 16; ++i) {
      int row = (tid >> 6) + 4 * i, t = t0 + row;
      float acc = cb;
#pragma unroll
      for (int k = 0; k < 4; ++k) {
        int tt = t + k - 2;
        if (tt >= lo && tt < hi) acc += cw[k] * p.proj[(size_t)tt * 512 + OFF_XA + c];
      }
      u_img[row * 64 + ((((ch >> 3) ^ (row & 7)) << 3) | (ch & 7))] = f2bf(acc);
    }
  }
  if (PASS == 2) {
    if (tid < 128) {
      const int ch = tid & 63, dir = tid >> 6;
      const int pos = lru_pos(dir, cidx);
      const float2* ag = (const float2*)p.lagg + (size_t)dir * NCHUNK * 256 + kb * 64 + ch;
      float h = 0.f;
      for (int q = 0; q < pos; ++q) {
        float2 v = ag[(size_t)q * 256];
        h = v.x * h + v.y;
      }
      ccarry[dir * 64 + ch] = h;
    }
  }
  __syncthreads();
  for (int dir = 0; dir < 2; ++dir) {
    const int pd = l * 2 + dir;
    {
      f32x4 ga[4], gx[4];
#pragma unroll
      for (int i = 0; i < 4; ++i) { ga[i] = (f32x4){0.f, 0.f, 0.f, 0.f}; gx[i] = (f32x4){0.f, 0.f, 0.f, 0.f}; }
      const bf16_t* wbase = p.lruw_t + (size_t)((pd * 4 + kb) * 2) * 4096 + (16 * wv + lr) * 64 + 8 * g;
#pragma unroll
      for (int s = 0; s < 2; ++s) {
        bf16x8 ba_ = *(const bf16x8*)(wbase + 32 * s);
        bf16x8 bx_ = *(const bf16x8*)(wbase + 4096 + 32 * s);
#pragma unroll
        for (int i = 0; i < 4; ++i) {
          int row = 16 * i + lr;
          bf16x8 af = *(const bf16x8*)((const char*)u_img + row * 128 + (((4 * s + g) ^ (row & 7)) << 4));
          ga[i] = __builtin_amdgcn_mfma_f32_16x16x32_bf16(af, ba_, ga[i], 0, 0, 0);
          gx[i] = __builtin_amdgcn_mfma_f32_16x16x32_bf16(af, bx_, gx[i], 0, 0, 0);
        }
      }
      const int ch = 16 * wv + lr, c = kb * 64 + ch;
      const float bav = p.ba[pd * 256 + c], bxv = p.bx[pd * 256 + c];
      const float sp = log1pf(expf(-p.lam[pd * 256 + c]));
#pragma unroll
      for (int i = 0; i < 4; ++i)
#pragma unroll
        for (int r = 0; r < 4; ++r) {
          int row = 16 * i + 4 * g + r;
          float rr = sigmoid_f(ga[i][r] + bav), ig = sigmoid_f(gx[i][r] + bxv);
          float log_a = -8.f * rr * sp;
          float a = __expf(log_a);
          float uu = bf2f(u_img[row * 64 + ((((ch >> 3) ^ (row & 7)) << 3) | (ch & 7))]);
          float b = sqrtf(-expm1f(2.f * log_a)) * ig * uu;
          ab_a[row * 64 + ch] = a;
          ab_b[row * 64 + ch] = b;
        }
    }
    __syncthreads();
    {
      const int ch = tid & 63, seg = tid >> 6;
      float Pr = 1.f, H = 0.f;
#pragma unroll
      for (int i = 0; i < 16; ++i) {
        int row = dir == 0 ? seg * 16 + i : seg * 16 + 15 - i;
        float a = ab_a[row * 64 + ch], b = ab_b[row * 64 + ch];
        H = a * H + b;
        Pr *= a;
      }
      segagg[(seg * 64 + ch) * 2] = Pr;
      segagg[(seg * 64 + ch) * 2 + 1] = H;
      __syncthreads();
      if (PASS == 1) {
        if (seg == 0) {
          float A = 1.f, B = 0.f;
#pragma unroll
          for (int s2 = 0; s2 < 4; ++s2) {
            int sg = dir == 0 ? s2 : 3 - s2;
            float pa = segagg[(sg * 64 + ch) * 2], pb = segagg[(sg * 64 + ch) * 2 + 1];
            B = pa * B + pb;
            A *= pa;
          }
          float2* ag = (float2*)p.lagg + ((size_t)dir * NCHUNK + lru_pos(dir, cidx)) * 256 + kb * 64 + ch;
          *ag = make_float2(A, B);
        }
      } else {
        float h = ccarry[dir * 64 + ch];
#pragma unroll
        for (int s2 = 0; s2 < 3; ++s2) {
          int sg = dir == 0 ? s2 : 3 - s2;
          bool before = dir == 0 ? (sg < seg) : (sg > seg);
          if (before) h = segagg[(sg * 64 + ch) * 2] * h + segagg[(sg * 64 + ch) * 2 + 1];
        }
#pragma unroll
        for (int i = 0; i < 16; ++i) {
          int row = dir == 0 ? seg * 16 + i : seg * 16 + 15 - i;
          float a = ab_a[row * 64 + ch], b = ab_b[row * 64 + ch];
          h = a * h + b;
          if (dir == 0) hsum[row * 64 + ch] = h;
          else {
            int t = t0 + row, c = kb * 64 + ch;
            float gv = p.proj[(size_t)t * 512 + OFF_GA + c];
            p.mixb[(size_t)t * 1024 + c] = f2bf((hsum[row * 64 + ch] + h) * gelu_f(gv));
          }
        }
      }
    }
    __syncthreads();
  }
}

template <int PASS>
__device__ __forceinline__ void ph_lru(const P& p, int l, char* smem) {
  const int c_begin = (PASS == 2 && l == 1) ? 4 : 0;
  const int nitems = (NCHUNK - c_begin) * 4;
  for (int it = blockIdx.x; it < nitems; it += gridDim.x) lru_item<PASS>(p, l, c_begin + (it >> 2), it & 3, smem);
}

constexpr float LOG2E = 1.4426950408889634f;
constexpr float QSCALE = 0.125f * LOG2E;
typedef __attribute__((ext_vector_type(4))) short s16x4;

__device__ __forceinline__ void ph_qknorm_rope2(const P& p, int l) {
  const int tid_ = tid_opaque();
  const int lane = tid_ & 63;
  const int wpb = blockDim.x >> 6;
  for (int pair = blockIdx.x * wpb + (tid_ >> 6); pair < TT * 28; pair += gridDim.x * wpb) {
    int t = pair / 28, slot = pair % 28;
    const float* g = nullptr; bool rope = false; float scale = 1.f;
    if (slot < 6) { g = p.win_qn + l * 64; rope = true; scale = QSCALE; }
    else if (slot < 8) { g = p.win_kn + l * 64; rope = true; }
    else if (slot < 10) { }
    else if (slot < 16) { g = p.na_qn + l * 64; scale = QSCALE; }
    else if (slot < 22) { g = p.na_kn + l * 64; }
    rope = rope && (t >= LC);
    const size_t idx = (size_t)t * DIN + 512 + slot * 64 + lane;
    float v = bf2f(p.projb[idx]);
    float y = v;
    if (g) {
      float ss = wave_sum(v * v);
      y = v * rsqrtf(ss * (1.f / 64.f) + EPS) * g[lane];
    }
    float partner = __shfl_xor(y, 16);
    if (rope) {
      int pos = t - LC, row = pos >> 6, col = pos & 63;
      int j = lane & 15, axis = lane >> 5;
      float inv = __expf(-(float)j * (1.f / 16.f) * 9.210340371976184f);
      float ang = (float)(axis ? col : row) * inv;
      float k = rintf(ang * 0.15915494309189535f);
      float r = fmaf(-k, 6.2831854820251465f, ang);
      r = fmaf(-k, -1.7484555e-07f, r);
      float cs = __cosf(r), sn = __sinf(r);
      bool first = ((lane >> 4) & 1) == 0;
      y = first ? (y * cs - partner * sn) : (partner * sn + y * cs);
    }
    p.projb[idx] = f2bf(y * scale);
  }
}

template <int CTRL, int RMASK>
__device__ __forceinline__ float dpp_mov_id(float v) {
  return __int_as_float(__builtin_amdgcn_update_dpp(__float_as_int(v), __float_as_int(v), CTRL, RMASK, 0xf, false));
}
__device__ __forceinline__ float wave_max(float v) {
  v = fmaxf(v, dpp_mov_id<0xB1, 0xf>(v));
  v = fmaxf(v, dpp_mov_id<0x4E, 0xf>(v));
  v = fmaxf(v, dpp_mov_id<0x141, 0xf>(v));
  v = fmaxf(v, dpp_mov_id<0x140, 0xf>(v));
  v = fmaxf(v, dpp_mov_id<0x142, 0xa>(v));
  v = fmaxf(v, dpp_mov_id<0x143, 0xc>(v));
  return __int_as_float(__builtin_amdgcn_readlane(__float_as_int(v), 63));
}

struct KVRegs { uint4 k[2], v[2]; };
template <class TokFn>
__device__ __forceinline__ void kv_load(const P& p, KVRegs& r, int koff, int voff, TokFn tok, int tid) {
#pragma unroll
  for (int i = 0; i < 2; ++i) {
    int id = tid + 256 * i, row = id >> 3, c = id & 7;
    const bf16_t* base = p.projb + (size_t)tok(row) * DIN + c * 8;
    r.k[i] = *(const uint4*)(base + koff);
    r.v[i] = *(const uint4*)(base + voff);
  }
}
__device__ __forceinline__ void kv_store(const KVRegs& r, char* stage, int tid) {
#pragma unroll
  for (int i = 0; i < 2; ++i) {
    int id = tid + 256 * i, row = id >> 3, c = id & 7;
    int off = row * 128 + ((c ^ (row & 7)) << 4);
    *(uint4*)(stage + off) = r.k[i];
    *(uint4*)(stage + 8192 + off) = r.v[i];
  }
}

template <class MaskFn>
__device__ __forceinline__ void attn_step(const char* stage, int kr0, const bf16x8 (&qf)[2], f32x4 (&o)[4], float& lsum, MaskFn mb, int lane) {
  const int g = lane >> 4, lr = lane & 15;
  f32x4 st[2];
#pragma unroll
  for (int t2 = 0; t2 < 2; ++t2) {
    st[t2] = (f32x4){0.f, 0.f, 0.f, 0.f};
    const int row = kr0 + 16 * t2 + lr;
#pragma unroll
    for (int s = 0; s < 2; ++s) {
      bf16x8 kf = *(const bf16x8*)(stage + row * 128 + (((4 * s + g) ^ (row & 7)) << 4));
      st[t2] = __builtin_amdgcn_mfma_f32_16x16x32_bf16(kf, qf[s], st[t2], 0, 0, 0);
    }
  }
  bf16x8 pb;
#pragma unroll
  for (int t2 = 0; t2 < 2; ++t2)
#pragma unroll
    for (int r = 0; r < 4; ++r) {
      float pv = exp2f(mb(t2, r, st[t2][r]));
      lsum += pv;
      pb[t2 * 4 + r] = (short)f2bf(pv);
    }
  const int q = lr >> 2, pp = lane & 3;
#pragma unroll
  for (int m = 0; m < 4; ++m) {
    bf16x8 vf;
#pragma unroll
    for (int t = 0; t < 2; ++t) {
      const int row = kr0 + 16 * t + 4 * g + q;
      const char* addr = stage + 8192 + row * 128 + (((2 * m + (pp >> 1)) ^ (row & 7)) << 4) + 8 * (pp & 1);
      s16x4 v4 = __builtin_amdgcn_ds_read_tr16_b64_v4i16((__attribute__((address_space(3))) s16x4*)addr);
      vf[4 * t + 0] = v4[0]; vf[4 * t + 1] = v4[1]; vf[4 * t + 2] = v4[2]; vf[4 * t + 3] = v4[3];
    }
    o[m] = __builtin_amdgcn_mfma_f32_16x16x32_bf16(vf, pb, o[m], 0, 0, 0);
  }
}

__device__ __forceinline__ void attn_store_out(const P& p, const f32x4 (&o)[4], float lsum, int tok, int col0, int lane) {
  const int g = lane >> 4;
  lsum += __shfl_xor(lsum, 16);
  lsum += __shfl_xor(lsum, 32);
  const float inv = 1.f / lsum;
  bf16_t* op = p.mixb + (size_t)tok * 1024 + col0 + 4 * g;
#pragma unroll
  for (int m = 0; m < 4; ++m)
    *(uint2*)(op + 16 * m) = make_uint2(pack2bf(o[m][0] * inv, o[m][1] * inv), pack2bf(o[m][2] * inv, o[m][3] * inv));
}

__device__ __forceinline__ void attn_win_item(const P& p, int l, int kind, int qb, int hs, char* smem) {
  const int tid = tid_opaque(), lane = tid & 63, wv = tid >> 6, g = lane >> 4, lr = lane & 15;
  int qoff, koff, voff, ooff; const float *gq, *gk; float sink2 = -1e30f; bool has_sink = false;
  if (kind == 0 || hs < 6) {
    const int h = hs, kvh = h / 3;
    qoff = OFF_QW + h * 64; koff = OFF_KW + kvh * 64; voff = OFF_VW + kvh * 64; ooff = 256 + h * 64;
    gq = p.win_qn + l * 64; gk = p.win_kn + l * 64; sink2 = p.win_sink[l * 6 + h] * LOG2E; has_sink = true;
  } else {
    const int h = hs - 6;
    qoff = OFF_QN + h * 64; koff = OFF_KN + h * 64; voff = OFF_VN + h * 64; ooff = 640 + h * 64;
    gq = p.na_qn + l * 64; gk = p.na_kn + l * 64;
  }
  float bound = 8.f * LOG2E * wave_max(fabsf(gq[lane])) * wave_max(fabsf(gk[lane])) * 1.0001f + 1e-3f;
  if (has_sink) bound = fmaxf(bound, sink2);
  const int q0 = qb * 64;
  const int qtok = (kind == 0 ? LC : 0) + q0 + 16 * wv + lr;
  bf16x8 qf[2];
#pragma unroll
  for (int s = 0; s < 2; ++s) qf[s] = *(const bf16x8*)(p.projb + (size_t)qtok * DIN + qoff + 32 * s + 8 * g);
  f32x4 o[4];
#pragma unroll
  for (int m = 0; m < 4; ++m) o[m] = (f32x4){0.f, 0.f, 0.f, 0.f};
  float lsum = 0.f;
  const int nloc = (kind == 0) ? 5 : 0, nch = nloc + 4;
  auto tokfn = [&](int c) {
    return [=](int row) {
      if (c < nloc) { int pos = q0 - 128 + 64 * c + row; pos = pos < 0 ? 0 : (pos > SEQ - 1 ? SEQ - 1 : pos); return LC + pos; }
      return 64 * (c - nloc) + row;
    };
  };
  KVRegs kr;
  __syncthreads();
  kv_load(p, kr, koff, voff, tokfn(0), tid);
  kv_store(kr, smem, tid);
  __syncthreads();
  for (int c = 0; c < nch; ++c) {
    const char* stage = smem + (c & 1) * 16384;
    if (c + 1 < nch) kv_load(p, kr, koff, voff, tokfn(c + 1), tid);
    if (c < nloc) {
      const int qpos = q0 + 16 * wv + lr;
#pragma unroll
      for (int st = 0; st < 2; ++st) {
        const int kbase = q0 - 128 + 64 * c + 32 * st;
        attn_step(stage, 32 * st, qf, o, lsum, [&](int t2, int r, float s) {
          int kpos = kbase + 16 * t2 + 4 * g + r;
          int dlt = kpos - qpos; dlt = dlt < 0 ? -dlt : dlt;
          bool valid = (kpos >= 0) && (kpos < SEQ) && (dlt <= 128);
          return valid ? s - bound : -1e30f;
        }, lane);
      }
    } else {
#pragma unroll
      for (int st = 0; st < 2; ++st) attn_step(stage, 32 * st, qf, o, lsum, [&](int t2, int r, float s) { return s - bound; }, lane);
    }
    if (c + 1 < nch) kv_store(kr, smem + ((c + 1) & 1) * 16384, tid);
    __syncthreads();
  }
  if (has_sink && g == 0) lsum += exp2f(sink2 - bound);
  attn_store_out(p, o, lsum, qtok, ooff, lane);
}

__device__ __forceinline__ void attn_na_item(const P& p, int l, int r, int h, char* smem) {
  const int tid = tid_opaque(), lane = tid & 63, wv = tid >> 6, g = lane >> 4, lr = lane & 15;
  const int qoff = OFF_QN + h * 64, koff = OFF_KN + h * 64, voff = OFF_VN + h * 64, ooff = 640 + h * 64;
  float* rpbl = (float*)(smem + 32768);
  const float* rpbg = p.rpb + (size_t)(l * 6 + h) * 465;
  float bmax = 0.f;
  __syncthreads();
  for (int i = tid; i < 465; i += 256) { float b = rpbg[i] * LOG2E; rpbl[i] = b; }
  for (int i = lane; i < 465; i += 64) bmax = fmaxf(bmax, fabsf(rpbg[i]) * LOG2E);
  bmax = wave_max(bmax);
  const float bound = 8.f * LOG2E * wave_max(fabsf(p.na_qn[l * 64 + lane])) * wave_max(fabsf(p.na_kn[l * 64 + lane])) * 1.0001f + bmax + 1e-3f;
  const int qcol = 16 * wv + lr;
  const int qtok = LC + r * 64 + qcol;
  const int kr0r = min(max(r - 4, 0), 248);
  const int kc0 = min(max(16 * wv - 8, 0), 32);
  const int qs = min(max(qcol - 8, 0), 48);
  bf16x8 qf[2];
#pragma unroll
  for (int s = 0; s < 2; ++s) qf[s] = *(const bf16x8*)(p.projb + (size_t)qtok * DIN + qoff + 32 * s + 8 * g);
  f32x4 o[4];
#pragma unroll
  for (int m = 0; m < 4; ++m) o[m] = (f32x4){0.f, 0.f, 0.f, 0.f};
  float lsum = 0.f;
  auto tokfn = [&](int c) {
    return [=](int row) { return c < 8 ? LC + (kr0r + c) * 64 + row : 64 * (c - 8) + row; };
  };
  KVRegs kr;
  kv_load(p, kr, koff, voff, tokfn(0), tid);
  kv_store(kr, smem, tid);
  __syncthreads();
  for (int c = 0; c < 12; ++c) {
    const char* stage = smem + (c & 1) * 16384;
    if (c + 1 < 12) kv_load(p, kr, koff, voff, tokfn(c + 1), tid);
    if (c < 8) {
      const int dr = kr0r + c - r + 7;
      attn_step(stage, kc0, qf, o, lsum, [&](int t2, int rr, float s) {
        int kcol = kc0 + 16 * t2 + 4 * g + rr;
        bool valid = (kcol >= qs) && (kcol < qs + 16);
        int dc = kcol - qcol + 15; dc = dc < 0 ? 0 : (dc > 30 ? 30 : dc);
        return valid ? s + rpbl[dr * 31 + dc] - bound : -1e30f;
      }, lane);
    } else {
#pragma unroll
      for (int st = 0; st < 2; ++st) attn_step(stage, 32 * st, qf, o, lsum, [&](int t2, int rr, float s) { return s - bound; }, lane);
    }
    if (c + 1 < 12) kv_store(kr, smem + ((c + 1) & 1) * 16384, tid);
    __syncthreads();
  }
  attn_store_out(p, o, lsum, qtok, ooff, lane);
}

__device__ __forceinline__ void ph_attn(const P& p, int l, char* smem) {
  const int nitems = 3072 + (l == 0 ? 48 : 0);
  for (int it = blockIdx.x; it < nitems; it += gridDim.x) {
    if (it < 1536) attn_win_item(p, l, 0, it / 6, it % 6, smem);
    else if (it < 3072) { int j = it - 1536; attn_na_item(p, l, j / 6, j % 6, smem); }
    else { int j = it - 3072; attn_win_item(p, l, 1, j / 12, j % 12, smem); }
  }
}

__device__ __forceinline__ unsigned ord_key(float s) {
  unsigned u = __float_as_uint(s);
  return (u & 0x80000000u) ? ~u : (u | 0x80000000u);
}
__device__ __forceinline__ float ord_val(unsigned pk) {
  unsigned u = pk & ~127u;
  unsigned b = (u & 0x80000000u) ? (u & 0x7fffffffu) : ~u;
  return __uint_as_float(b);
}
__device__ __forceinline__ void ce_desc(unsigned& a, unsigned& b) {
  unsigned mx = a > b ? a : b, mn = a > b ? b : a;
  a = mx; b = mn;
}
__device__ __forceinline__ void sort16_desc(unsigned (&v)[16]) {
#pragma unroll
  for (int k = 2; k <= 16; k <<= 1) {
#pragma unroll
    for (int j = k >> 1; j > 0; j >>= 1) {
#pragma unroll
      for (int i = 0; i < 16; ++i) {
        int m = i ^ j;
        if (m > i) {
          if ((i & k) == 0) ce_desc(v[i], v[m]); else ce_desc(v[m], v[i]);
        }
      }
    }
  }
}
__device__ __forceinline__ void merge16_desc(unsigned (&a)[16], const unsigned (&b)[16]) {
#pragma unroll
  for (int i = 0; i < 16; ++i) { unsigned o = b[15 - i]; a[i] = a[i] > o ? a[i] : o; }
#pragma unroll
  for (int j = 8; j > 0; j >>= 1) {
#pragma unroll
    for (int i = 0; i < 16; ++i) {
      int m = i ^ j;
      if (m > i) ce_desc(a[i], a[m]);
    }
  }
}

typedef __attribute__((ext_vector_type(2))) float f32x2;
__device__ __forceinline__ void ph_prep_peer(const P& p) {
  const int tid = tid_opaque(), lane = tid & 63;
  const int nw = gridDim.x * 4;
  for (int row = blockIdx.x * 4 + (tid >> 6); row < 4 * 16384; row += nw) {
    const int tbl = row >> 15, le = row & 32767;
    const float4* src = (const float4*)((tbl ? p.pv : p.pu) + (size_t)le * 1024) + lane * 4;
    float4 v[4];
    float am = 0.f;
#pragma unroll
    for (int i = 0; i < 4; ++i) {
      v[i] = src[i];
      am = fmaxf(am, fmaxf(fmaxf(fabsf(v[i].x), fabsf(v[i].y)), fmaxf(fabsf(v[i].z), fabsf(v[i].w))));
    }
    am = wave_max(am);
    const float sc = am > 0.f ? 224.f / am : 1.f;
    unsigned w[4];
#pragma unroll
    for (int i = 0; i < 4; ++i) {
      int t = __builtin_amdgcn_cvt_pk_fp8_f32(v[i].x * sc, v[i].y * sc, 0, false);
      t = __builtin_amdgcn_cvt_pk_fp8_f32(v[i].z * sc, v[i].w * sc, t, true);
      w[i] = (unsigned)t;
    }
    ((uint4*)((tbl ? p.vb8 : p.ub8) + (size_t)le * 1024))[lane] = make_uint4(w[0], w[1], w[2], w[3]);
    if (lane == 0) (tbl ? p.vsc : p.usc)[le] = am > 0.f ? am / 224.f : 1.f;
  }
  for (int i = GTID; i < 2 * 128 * 128; i += GSZ) { p.k1b[i] = f2bf(p.k1[i]); p.k2b[i] = f2bf(p.k2[i]); }
}

struct EpiPeerTopk {
  int l;
  __device__ __forceinline__ void operator()(const P& p, f32x4 (&acc)[4][4], int m0, int n0, int wm, int wn, int lane, char* smem) const {
    const int tid = ((wm * 2 + wn) << 6) | lane, g = lane >> 4, lr = lane & 15;
    const int nt = n0 >> 7, head = nt >> 1, hf = nt & 1;
    char* qimg = smem;
    char* kimg = smem + 34816;
    {
      char* qw = qimg + (wm * 64 + 4 * g) * 272 + (wn * 64 + lr) * 2;
#pragma unroll
      for (int i = 0; i < 4; ++i)
#pragma unroll
        for (int r = 0; r < 4; ++r)
#pragma unroll
          for (int j = 0; j < 4; ++j) *(bf16_t*)(qw + (16 * i + r) * 272 + 32 * j) = f2bf(acc[i][j][r]);
      const bf16_t* kk = (hf ? p.k2b : p.k1b) + (size_t)l * 16384 + (tid >> 4) * 128 + (tid & 15) * 8;
      char* kw = kimg + (tid >> 4) * 272 + (tid & 15) * 16;
#pragma unroll
      for (int i = 0; i < 8; ++i) *(uint4*)(kw + i * 16 * 272) = *(const uint4*)(kk + i * 16 * 128);
    }
    __syncthreads();
#pragma unroll
    for (int i = 0; i < 4; ++i)
#pragma unroll
      for (int j = 0; j < 4; ++j) acc[i][j] = (f32x4){0.f, 0.f, 0.f, 0.f};
    {
      const char* qa = qimg + (wm * 64 + lr) * 272 + g * 16;
      const char* kb = kimg + (wn * 64 + lr) * 272 + g * 16;
#pragma unroll
      for (int s = 0; s < 4; ++s) {
        bf16x8 af[4], bfr[4];
#pragma unroll
        for (int i = 0; i < 4; ++i) af[i] = *(const bf16x8*)(qa + i * 16 * 272 + s * 64);
#pragma unroll
        for (int j = 0; j < 4; ++j) bfr[j] = *(const bf16x8*)(kb + j * 16 * 272 + s * 64);
#pragma unroll
        for (int i = 0; i < 4; ++i)
#pragma unroll
          for (int j = 0; j < 4; ++j) acc[i][j] = __builtin_amdgcn_mfma_f32_16x16x32_bf16(af[i], bfr[j], acc[i][j], 0, 0, 0);
      }
    }
    __syncthreads();
    unsigned* simg = (unsigned*)smem;
    {
      unsigned* sw = simg + (wm * 64 + 4 * g) * 129 + wn * 64 + lr;
#pragma unroll
      for (int i = 0; i < 4; ++i)
#pragma unroll
        for (int r = 0; r < 4; ++r)
#pragma unroll
          for (int j = 0; j < 4; ++j)
            sw[(16 * i + r) * 129 + 16 * j] = (ord_key(acc[i][j][r]) & ~127u) | (unsigned)(wn * 64 + 16 * j + lr);
    }
    __syncthreads();
    const int row = tid & 127, half = tid >> 7;
    unsigned top[16];
    {
      const unsigned* sr = simg + row * 129 + half * 64;
#pragma unroll
      for (int k = 0; k < 16; ++k) top[k] = sr[k];
      sort16_desc(top);
#pragma unroll 1
      for (int gi = 1; gi < 4; ++gi) {
        unsigned v1[16];
#pragma unroll
        for (int k = 0; k < 16; ++k) v1[k] = sr[gi * 16 + k];
        sort16_desc(v1);
        merge16_desc(top, v1);
      }
    }
    __syncthreads();
    if (half == 1) {
#pragma unroll
      for (int k = 0; k < 16; ++k) simg[k * 128 + row] = top[k];
    }
    __syncthreads();
    if (half == 0) {
      unsigned o[16];
#pragma unroll
      for (int k = 0; k < 16; ++k) o[k] = simg[k * 128 + row];
      merge16_desc(top, o);
      uint4* dst = (uint4*)(p.pk + (((size_t)(m0 + row) * 8 + head) * 2 + hf) * 16);
#pragma unroll
      for (int k = 0; k < 4; ++k) dst[k] = make_uint4(top[4 * k], top[4 * k + 1], top[4 * k + 2], top[4 * k + 3]);
    }
  }
};

__device__ const unsigned char CAND_A[64] = {0,0,0,0,0,0,0,0,0,0,0,0,0,0,0,0, 1,1,1,1,1,1,1,1, 2,2,2,2,2, 3,3,3,3, 4,4,4, 5,5, 6,6, 7,7,
                                             8,9,10,11,12,13,14,15, 0,0,0,0,0,0,0,0,0,0,0,0,0,0};
__device__ const unsigned char CAND_B[64] = {0,1,2,3,4,5,6,7,8,9,10,11,12,13,14,15, 0,1,2,3,4,5,6,7, 0,1,2,3,4, 0,1,2,3, 0,1,2, 0,1, 0,1, 0,1,
                                             0,0,0,0,0,0,0,0, 0,0,0,0,0,0,0,0,0,0,0,0,0,0};

__device__ __forceinline__ void ph_peer_apply2(const P& p, int l, int t0, char* smem) {
  const int tid = tid_opaque(), lane = tid & 63, wv = tid >> 6;
  int* lds_e = (int*)(smem + wv * 1024);
  float* lds_g = (float*)(smem + wv * 1024 + 512);
  const unsigned char* U = p.ub8 + (size_t)l * 16384 * 1024;
  const unsigned char* V = p.vb8 + (size_t)l * 16384 * 1024;
  const float* usc = p.usc + l * 16384;
  const float* vsc = p.vsc + l * 16384;
  const float* n2g = p.norm2_g + l * 1024;
  const int ca = CAND_A[lane], cb = CAND_B[lane];
  for (int tk = t0 + blockIdx.x * 4 + wv; tk < TT; tk += gridDim.x * 4) {
    const float* mod = p.mod + (l * 2 + (tk < LC ? 1 : 0)) * 6144;
    float xv[16], hv[16];
    {
      const float4* xp = (const float4*)(p.xall + (size_t)tk * 1024) + lane * 4;
      float ss = 0.f;
#pragma unroll
      for (int q = 0; q < 4; ++q) {
        float4 v = xp[q];
        xv[q * 4 + 0] = v.x; xv[q * 4 + 1] = v.y; xv[q * 4 + 2] = v.z; xv[q * 4 + 3] = v.w;
        ss += v.x * v.x + v.y * v.y + v.z * v.z + v.w * v.w;
      }
      ss = wave_sum(ss);
      float rinv = rsqrtf(ss * (1.f / 1024.f) + EPS);
#pragma unroll
      for (int q = 0; q < 4; ++q) {
        float4 gg = ((const float4*)n2g)[lane * 4 + q], sc = ((const float4*)(mod + 4096))[lane * 4 + q], sh = ((const float4*)(mod + 3072))[lane * 4 + q];
        hv[q * 4 + 0] = xv[q * 4 + 0] * rinv * gg.x * (1.f + sc.x) + sh.x;
        hv[q * 4 + 1] = xv[q * 4 + 1] * rinv * gg.y * (1.f + sc.y) + sh.y;
        hv[q * 4 + 2] = xv[q * 4 + 2] * rinv * gg.z * (1.f + sc.z) + sh.z;
        hv[q * 4 + 3] = xv[q * 4 + 3] * rinv * gg.w * (1.f + sc.w) + sh.w;
      }
    }
    for (int head = 0; head < 8; ++head) {
      const unsigned* pk = p.pk + ((size_t)tk * 8 + head) * 32;
      unsigned p1 = pk[ca], p2 = pk[16 + cb];
      float sum = lane < 50 ? ord_val(p1) + ord_val(p2) : -3.0e38f;
      int eid = (int)(p1 & 127u) * 128 + (int)(p2 & 127u);
      int rank = 0;
      for (int m = 0; m < 50; ++m) {
        float sm = __shfl(sum, m);
        rank += (sm > sum || (sm == sum && m < lane)) ? 1 : 0;
      }
      float mx = wave_max(sum);
      bool sel = (lane < 50) && (rank < 16);
      float e = sel ? __expf(sum - mx) : 0.f;
      float tot = wave_sum(e);
      if (sel) { lds_e[head * 16 + rank] = eid; lds_g[head * 16 + rank] = e / tot; }
    }
    float acc[16];
#pragma unroll
    for (int k = 0; k < 16; ++k) acc[k] = 0.f;
    for (int e0 = 0; e0 < 128; e0 += 8) {
      uint4 ur[8], vr[8];
      float gt[8], us[8], vs[8];
#pragma unroll
      for (int k = 0; k < 8; ++k) {
        int ex = __builtin_amdgcn_readfirstlane(lds_e[e0 + k]);
        gt[k] = lds_g[e0 + k];
        ur[k] = ((const uint4*)(U + (size_t)ex * 1024))[lane];
        vr[k] = ((const uint4*)(V + (size_t)ex * 1024))[lane];
        us[k] = usc[ex]; vs[k] = vsc[ex];
      }
#pragma unroll
      for (int k = 0; k < 8; ++k) {
        float dot = 0.f;
        unsigned w[4] = {ur[k].x, ur[k].y, ur[k].z, ur[k].w};
#pragma unroll
        for (int q = 0; q < 4; ++q) {
          f32x2 lo = __builtin_amdgcn_cvt_pk_f32_fp8((int)w[q], false), hi = __builtin_amdgcn_cvt_pk_f32_fp8((int)w[q], true);
          dot += lo[0] * hv[q * 4] + lo[1] * hv[q * 4 + 1] + hi[0] * hv[q * 4 + 2] + hi[1] * hv[q * 4 + 3];
        }
        dot = wave_sum(dot) * us[k];
        float a = gt[k] * gelu_f(dot) * vs[k];
        unsigned y[4] = {vr[k].x, vr[k].y, vr[k].z, vr[k].w};
#pragma unroll
        for (int q = 0; q < 4; ++q) {
          f32x2 lo = __builtin_amdgcn_cvt_pk_f32_fp8((int)y[q], false), hi = __builtin_amdgcn_cvt_pk_f32_fp8((int)y[q], true);
          acc[q * 4] += a * lo[0]; acc[q * 4 + 1] += a * lo[1]; acc[q * 4 + 2] += a * hi[0]; acc[q * 4 + 3] += a * hi[1];
        }
      }
    }
    {
      float4* xp = ((l == 1) ? (float4*)(p.out + (size_t)(tk - LC) * 1024) : (float4*)(p.xall + (size_t)tk * 1024)) + lane * 4;
#pragma unroll
      for (int q = 0; q < 4; ++q) {
        float4 gg = ((const float4*)(mod + 5120))[lane * 4 + q];
        float4 o;
        o.x = xv[q * 4 + 0] + gg.x * acc[q * 4 + 0];
        o.y = xv[q * 4 + 1] + gg.y * acc[q * 4 + 1];
        o.z = xv[q * 4 + 2] + gg.z * acc[q * 4 + 2];
        o.w = xv[q * 4 + 3] + gg.w * acc[q * 4 + 3];
        xp[q] = o;
      }
    }
  }
}

#define XB_TMO      128
#define XB_XCNT(j)  (256  + 64 * (j))
#define XB_XSUB(j)  (1280 + 64 * (j))
#define XB_XGEN(j)  (2304 + 64 * (j))
#define XB_TOP      3328
#define XB_TOPGEN   3392
#define XCD_BAR_WORDS 3456
#define XB_SPIN_CAP (1u << 22)
#define LAS __attribute__((address_space(3)))
__device__ __forceinline__ unsigned xb_ld(unsigned* q) { return __hip_atomic_load(q, __ATOMIC_RELAXED, __HIP_MEMORY_SCOPE_AGENT); }
__device__ __forceinline__ unsigned xb_add(unsigned* q, unsigned v) { return __hip_atomic_fetch_add(q, v, __ATOMIC_RELAXED, __HIP_MEMORY_SCOPE_AGENT); }
__device__ __forceinline__ unsigned xb_xcc_id() { return (unsigned)__builtin_amdgcn_s_getreg((3 << 11) | 20) & 0xFu; }
#define XB_SPIN(cond, bar) do { unsigned _sp = 0; while (cond) { __builtin_amdgcn_s_sleep(1); \
    if ((++_sp & 255u) == 0u) { if (xb_ld(&(bar)[XB_TMO])) break; if (_sp > XB_SPIN_CAP) { atomicAdd(&(bar)[XB_TMO], 1u); break; } } } } while (0)
struct XcdBarrier { unsigned* bar; unsigned x; volatile LAS unsigned* st; };
__device__ __forceinline__ XcdBarrier xcd_barrier_post(unsigned* bar, volatile LAS unsigned* st) {
  XcdBarrier b; b.bar = bar; b.x = xb_xcc_id(); b.st = st;
  if (threadIdx.x == 0) (void)xb_add(&bar[XB_XCNT(b.x)], 1u);
  return b;
}
__device__ __forceinline__ void xcd_barrier_complete(unsigned* bar, unsigned x, unsigned& nloc, unsigned& nx) {
  const unsigned G = gridDim.x * gridDim.y * gridDim.z;
  unsigned sum, cnt, mine, sp = 0u;
  for (;;) {
    sum = 0u; cnt = 0u; mine = 0u;
#pragma unroll
    for (unsigned j = 0; j < 16; ++j) { const unsigned c = xb_ld(&bar[XB_XCNT(j)]); sum += c; cnt += (c > 0u) ? 1u : 0u; mine = (j == x) ? c : mine; }
    if (sum == G) break;
    __builtin_amdgcn_s_sleep(1);
    if ((++sp & 255u) == 0u) { if (xb_ld(&bar[XB_TMO])) break; if (sp > XB_SPIN_CAP) { atomicAdd(&bar[XB_TMO], 1u); break; } }
  }
  nloc = mine > 0u ? mine : 1u; nx = cnt > 0u ? cnt : 1u;
}
__device__ __forceinline__ void xcd_barrier(const XcdBarrier& b) {
  asm volatile("s_waitcnt vmcnt(0)" ::: "memory");
  __syncthreads();
  if (threadIdx.x == 0) {
    unsigned* bar = b.bar;
    __builtin_amdgcn_s_waitcnt(0);
    unsigned nloc = b.st[0], nx = b.st[1];
    if (nloc == 0u) { xcd_barrier_complete(bar, b.x, nloc, nx); b.st[0] = nloc; b.st[1] = nx; }
    const unsigned old = xb_add(&bar[XB_XSUB(b.x)], 1u);
    const unsigned gen = old / nloc;
    if (old + 1u == (gen + 1u) * nloc) {
      __builtin_amdgcn_fence(__ATOMIC_RELEASE, "agent");
      asm volatile("s_waitcnt vmcnt(0)" ::: "memory");
      const unsigned og = xb_add(&bar[XB_TOP], 1u);
      const unsigned tg = og / nx;
      if (og + 1u == (tg + 1u) * nx) xb_add(&bar[XB_TOPGEN], 1u);
      else XB_SPIN(xb_ld(&bar[XB_TOPGEN]) == tg, bar);
      __builtin_amdgcn_fence(__ATOMIC_ACQUIRE, "agent");
      xb_add(&bar[XB_XGEN(b.x)], 1u);
      asm volatile("s_waitcnt vmcnt(0)" ::: "memory");
    } else {
      XB_SPIN(xb_ld(&bar[XB_XGEN(b.x)]) == gen, bar);
      __builtin_amdgcn_fence(__ATOMIC_ACQUIRE, "agent");
      asm volatile("s_waitcnt vmcnt(0)" ::: "memory");
    }
  }
  __syncthreads();
}

#ifndef PROBE_IV
#define PROBE_IV -1
#endif
__device__ __forceinline__ void probe_tick(int& cnt, unsigned long long* slots) {
  if (PROBE_IV >= 0) {
    if (threadIdx.x == 0 && (cnt == PROBE_IV || cnt == PROBE_IV + 1)) slots[cnt - PROBE_IV] = __builtin_amdgcn_s_memrealtime();
    cnt = __builtin_amdgcn_readfirstlane(cnt + 1);
  }
}
#define BARRIER() do { xcd_barrier(xb); probe_tick(pcnt, probe_t); } while (0)

typedef const __attribute__((address_space(4))) P* KP;
__device__ __forceinline__ P load_params(KP kp) {
#if defined(__HIP_DEVICE_COMPILE__)
  asm volatile("" : "+s"(kp));
  return *kp;
#else
  return P{};
#endif
}
#define PP load_params(kp)
__global__ void __launch_bounds__(256, 2) k_mega(P p_unused) {
  KP kp = (KP)__builtin_amdgcn_kernarg_segment_ptr();
  __shared__ __attribute__((aligned(16))) float smem[18432 + 8];
  uint4& xb_words = *(uint4*)(smem + 18432);
  cg::grid_group grid = cg::this_grid();
  if (threadIdx.x == 0) xb_words = make_uint4(0u, 0u, 0u, 0u);
  __syncthreads();
  unsigned long long* probe_t = (unsigned long long*)(smem + 18436);
  int pcnt = 0;
  asm volatile("" : "+s"(pcnt));
  probe_tick(pcnt, probe_t);
  ph_mod(PP, smem);
  ph_prep(PP, smem);
  ph_lru_prepw(PP);
  ph_prep_peer(PP);
  grid.sync();
  probe_tick(pcnt, probe_t);
  XcdBarrier xb = xcd_barrier_post(PP.bar, (volatile LAS unsigned*)&xb_words);
  ph_norm_mod(PP, 0, 0, 0, smem, true);
  BARRIER();
#pragma unroll 1
  for (int l = 0; l < 2; ++l) {
    const int t0 = (l == 0) ? 0 : LC;
    { const P lp = PP; gemm_bf16_128(lp, lp.hb, lp.w_in_t + (size_t)l * 1024 * DIN, 1024, 0, TT, DIN, (char*)smem, EpiProjSplit{}); }
    BARRIER();
    ph_qknorm_rope2(PP, l);
    BARRIER();
    ph_lru<1>(PP, l, (char*)smem);
    ph_attn(PP, l, (char*)smem);
    BARRIER();
    ph_lru<2>(PP, l, (char*)smem);
    BARRIER();
    { const P lp = PP; gemm_bf16_128(lp, lp.mixb, lp.w_out_t + (size_t)l * 1024 * 1024, 1024, t0, TT, 1024, (char*)smem, EpiResid{l, 2048}); }
    BARRIER();
    ph_norm_mod(PP, l, 1, t0, smem);
    BARRIER();
    { const P lp = PP; gemm_bf16_128(lp, lp.hb, lp.wq_t + (size_t)l * 1024 * NPQ, 1024, t0, TT, NPQ, (char*)smem, EpiPeerTopk{l}); }
    BARRIER();
    ph_peer_apply2(PP, l, t0, (char*)smem);
    if (l == 0) {
      BARRIER();
      ph_norm_mod(PP, 1, 0, 0, smem);
      BARRIER();
    }
  }
  if (PROBE_IV >= 0) {
    probe_tick(pcnt, probe_t);
    __syncthreads();
    if (blockIdx.x == 0 && threadIdx.x == 0) {
      const unsigned long long dt = (probe_t[1] - probe_t[0]) * 8ull, ts = __builtin_amdgcn_s_memrealtime();
      while (__builtin_amdgcn_s_memrealtime() - ts < dt) __builtin_amdgcn_s_sleep(8);
    }
  }
}

extern "C" void kernel_launch(void* const* d_in, const int* in_sizes, int n_in, void* d_out, int out_size, void* d_ws,
                              size_t ws_size, hipStream_t stream) {
  P p{};
  const float** fp = (const float**)&p;
  for (int i = 0; i < 28; ++i) fp[i] = (const float*)d_in[i];
  p.out = (float*)d_out;
  float* w = (float*)d_ws;
  size_t o = 0;
  auto carve = [&](size_t n) { float* r = w + o; o += (n + 63) & ~(size_t)63; return r; };
  p.bar = (unsigned*)carve(4096);
  p.mod = carve(4 * 6144);
  p.xall = carve((size_t)TT * 1024);
  p.proj = carve((size_t)TT * 512);
  p.projb = (bf16_t*)carve((size_t)TT * DIN / 2);
  p.mixb = (bf16_t*)carve((size_t)TT * 512);
  p.hb = (bf16_t*)carve((size_t)TT * 512);
  p.w_in_t = (bf16_t*)carve((size_t)1024 * DIN);
  p.w_out_t = (bf16_t*)carve((size_t)1024 * 1024);
  p.wq_t = (bf16_t*)carve((size_t)1024 * NPQ);
  p.lruw_t = (bf16_t*)carve((size_t)2 * 2 * 4 * 2 * 4096 / 2);
  p.lagg = carve((size_t)2 * NCHUNK * 256 * 2);
  p.pk = (unsigned*)carve((size_t)TT * 256);
  p.ub8 = (unsigned char*)carve((size_t)2 * 16384 * 1024 / 4);
  p.vb8 = (unsigned char*)carve((size_t)2 * 16384 * 1024 / 4);
  p.usc = carve(2 * 16384);
  p.vsc = carve(2 * 16384);
  p.k1b = (bf16_t*)carve(16384);
  p.k2b = (bf16_t*)carve(16384);
  if (o * 4 > ws_size) { fprintf(stderr, "workspace too small: need %zu have %zu\n", o * 4, ws_size); return; }
  static int grid_blocks = 0;
  if (!grid_blocks) {
    int dev = 0, cus = 0, per_cu = 0;
    (void)hipGetDevice(&dev);
    (void)hipDeviceGetAttribute(&cus, hipDeviceAttributeMultiprocessorCount, dev);
    (void)hipOccupancyMaxActiveBlocksPerMultiprocessor(&per_cu, k_mega, 256, 0);
    if (per_cu > 2) per_cu = 2;
    grid_blocks = cus * per_cu;
  }
  (void)hipMemsetAsync(p.bar, 0, XCD_BAR_WORDS * 4, stream);
  void* args[] = {&p};
  hipError_t e = hipLaunchCooperativeKernel((void*)k_mega, dim3(grid_blocks), dim3(256), args, 0, stream);
  if (e != hipSuccess) fprintf(stderr, "cooperative launch failed: %s (grid %d)\n", hipGetErrorString(e), grid_blocks);
}
```

```cpp
#include <hip/hip_runtime.h>
#include <hip/hip_cooperative_groups.h>
#include <stdint.h>
#include <stdio.h>
namespace cg = cooperative_groups;

#ifndef SINGLE_LAUNCH
#define SINGLE_LAUNCH 1
#endif

constexpr int DM = 1024, SEQ = 16384, LC = 256, TT = SEQ + LC, DIN = 2304, NPQ = 2048;
constexpr int OFF_XA = 0, OFF_GA = 256, OFF_QW = 512, OFF_KW = 896, OFF_VW = 1024, OFF_QN = 1152, OFF_KN = 1536, OFF_VN = 1920;
constexpr float EPS = 1e-6f;
constexpr float LOG2E = 1.4426950408889634f;
constexpr float QSCALE = 0.125f * LOG2E;

struct P {
  const float *x, *c, *ctx, *c_ctx, *w_mod, *b_mod, *norm1_g, *norm2_g, *w_in, *w_out,
      *conv_w, *conv_b, *wa, *ba, *wx, *bx, *lam, *win_qn, *win_kn, *win_sink, *na_qn, *na_kn, *rpb,
      *wq, *k1, *k2, *pu, *pv;
  float* out;
  float *mod, *xall, *proj;
  unsigned short* projb;
  unsigned* pk;
  unsigned* bar;
  unsigned short *k1b, *k2b;
  unsigned char *ub8, *vb8;
  float *usc, *vsc;
  unsigned short *hb, *mixb, *w_in_t, *w_out_t, *wq_t, *lruw_t;
  float *lagg, *lcarry;
};

typedef unsigned short bf16_t;
typedef __attribute__((ext_vector_type(8))) short bf16x8;
typedef __attribute__((ext_vector_type(4))) float f32x4;
__device__ __forceinline__ unsigned short f2bf(float f) {
  unsigned u = __float_as_uint(f);
  u += 0x7fffu + ((u >> 16) & 1u);
  return (unsigned short)(u >> 16);
}
__device__ __forceinline__ unsigned pack2bf(float a, float b) { return (unsigned)f2bf(a) | ((unsigned)f2bf(b) << 16); }
__device__ __forceinline__ float bf2f(unsigned short h) { return __uint_as_float(((unsigned)h) << 16); }


__device__ __forceinline__ float silu_f(float x) { return x / (1.f + __expf(-x)); }
__device__ __forceinline__ float sigmoid_f(float x) { return 1.f / (1.f + __expf(-x)); }
__device__ __forceinline__ float gelu_f(float x) {
  float u = 0.7978845608028654f * (x + 0.044715f * x * x * x);
  float e = __expf(2.f * u);
  float th = 1.f - 2.f / (e + 1.f);
  return 0.5f * x * (1.f + th);
}
template <int CTRL, int RMASK>
__device__ __forceinline__ float dpp_mov(float v) {
  return __int_as_float(__builtin_amdgcn_update_dpp(0, __float_as_int(v), CTRL, RMASK, 0xf, false));
}
__device__ __forceinline__ float wave_sum(float v) {
  v += dpp_mov<0xB1, 0xf>(v);
  v += dpp_mov<0x4E, 0xf>(v);
  v += dpp_mov<0x141, 0xf>(v);
  v += dpp_mov<0x140, 0xf>(v);
  v += dpp_mov<0x142, 0xa>(v);
  v += dpp_mov<0x143, 0xc>(v);
  return __int_as_float(__builtin_amdgcn_readlane(__float_as_int(v), 63));
}

__device__ __forceinline__ int tid_opaque() { int t = threadIdx.x; asm volatile("" : "+v"(t)); return t; }
#define GTID (blockIdx.x * blockDim.x + tid_opaque())
#define GSZ (gridDim.x * blockDim.x)

__device__ __forceinline__ void ph_mod(const P& p, float* smem) {
  const int tid = tid_opaque(), cl = tid & 31, ks = tid >> 5;
  for (int it = blockIdx.x; it < 2 * 192; it += gridDim.x) {
    const int nc = it % 192, l = it / 192;
    const int n = nc * 32 + cl;
    const float* w = p.w_mod + (size_t)l * 1024 * 6144 + n;
    float a0 = 0.f, a1 = 0.f;
#pragma unroll 8
    for (int i = 0; i < 128; ++i) {
      int k = i * 8 + ks;
      float wv = w[(size_t)k * 6144];
      a0 += silu_f(p.c[k]) * wv;
      a1 += silu_f(p.c_ctx[k]) * wv;
    }
    __syncthreads();
    smem[tid] = a0; smem[256 + tid] = a1;
    __syncthreads();
    if (tid < 64) {
      const int which = tid >> 5;
      float s = p.b_mod[l * 6144 + n];
#pragma unroll
      for (int q = 0; q < 8; ++q) s += smem[which * 256 + q * 32 + cl];
      p.mod[(l * 2 + which) * 6144 + n] = s;
    }
  }
}

__device__ __forceinline__ void ph_copy_in(const P& p) {
  const float4* xs = (const float4*)p.x;
  const float4* cs = (const float4*)p.ctx;
  float4* d = (float4*)p.xall;
  for (int i = GTID; i < TT * 256; i += GSZ) d[i] = (i < LC * 256) ? cs[i] : xs[i - LC * 256];
}

__device__ __forceinline__ void ph_copy_out(const P& p) {
  const float4* s = (const float4*)(p.xall + (size_t)LC * 1024);
  float4* d = (float4*)p.out;
  for (int i = GTID; i < SEQ * 256; i += GSZ) d[i] = s[i];
}

__device__ __forceinline__ void ph_norm_mod(const P& p, int l, int which_norm, int t0, float* smem, bool from_input = false) {
  const float* g = (which_norm ? p.norm2_g : p.norm1_g) + l * 1024;
  const int sh_off = which_norm ? 3072 : 0, sc_off = which_norm ? 4096 : 1024;
  const int tid = tid_opaque();
  for (int t = t0 + blockIdx.x; t < TT; t += gridDim.x) {
    const float* mod = p.mod + (l * 2 + (t < LC ? 1 : 0)) * 6144;
    float4 v;
    if (from_input) {
      v = t < LC ? ((const float4*)(p.ctx + (size_t)t * 1024))[tid] : ((const float4*)(p.x + (size_t)(t - LC) * 1024))[tid];
      ((float4*)(p.xall + (size_t)t * 1024))[tid] = v;
    } else v = ((const float4*)(p.xall + (size_t)t * 1024))[tid];
    float ss = wave_sum(v.x * v.x + v.y * v.y + v.z * v.z + v.w * v.w);
    __syncthreads();
    if ((tid & 63) == 0) smem[tid >> 6] = ss;
    __syncthreads();
    float tot = smem[0] + smem[1] + smem[2] + smem[3];
    float rinv = rsqrtf(tot * (1.f / 1024.f) + EPS);
    float4 gg = ((const float4*)g)[tid];
    float4 sc = ((const float4*)(mod + sc_off))[tid];
    float4 sh = ((const float4*)(mod + sh_off))[tid];
    float4 o;
    o.x = v.x * rinv * gg.x * (1.f + sc.x) + sh.x;
    o.y = v.y * rinv * gg.y * (1.f + sc.y) + sh.y;
    o.z = v.z * rinv * gg.z * (1.f + sc.z) + sh.z;
    o.w = v.w * rinv * gg.w * (1.f + sc.w) + sh.w;
    ((uint2*)(p.hb + (size_t)t * 1024))[tid] = make_uint2(pack2bf(o.x, o.y), pack2bf(o.z, o.w));
  }
}

__device__ __forceinline__ void prep_transpose(const float* W, bf16_t* Wt, int K, int N, int item0, int nitems_total, float* smem) {
  (void)nitems_total;
  float(*ts)[65] = (float(*)[65])smem;
  const int tid = tid_opaque();
  const int tn = N / 64, nt = (K / 64) * tn;
  for (int it = blockIdx.x; it < nt; it += gridDim.x) {
    int k0 = (it / tn) * 64, n0 = (it % tn) * 64;
    __syncthreads();
#pragma unroll
    for (int i = 0; i < 16; ++i) {
      int r = (tid >> 6) + i * 4, c = tid & 63;
      ts[r][c] = W[(size_t)(k0 + r) * N + n0 + c];
    }
    __syncthreads();
#pragma unroll
    for (int i = 0; i < 16; ++i) {
      int r = (tid >> 6) + i * 4, c = tid & 63;
      Wt[(size_t)(n0 + r) * K + k0 + c] = f2bf(ts[c][r]);
    }
  }
  (void)item0;
}

__device__ __forceinline__ void ph_prep(const P& p, float* smem) {
  for (int l = 0; l < 2; ++l) {
    prep_transpose(p.w_in + (size_t)l * 1024 * DIN, p.w_in_t + (size_t)l * 1024 * DIN, 1024, DIN, 0, 0, smem);
    prep_transpose(p.w_out + (size_t)l * 1024 * 1024, p.w_out_t + (size_t)l * 1024 * 1024, 1024, 1024, 0, 0, smem);
    prep_transpose(p.wq + (size_t)l * 1024 * NPQ, p.wq_t + (size_t)l * 1024 * NPQ, 1024, NPQ, 0, 0, smem);
  }
}

struct EpiStoreF32 {
  float* C; int ldc;
  __device__ __forceinline__ void operator()(const P& p, f32x4 (&acc)[4][4], int m0, int n0, int wm, int wn, int lane, char* smem) const {
    const int mw0 = m0 + wm * 64, nw0 = n0 + wn * 64;
#pragma unroll
    for (int i = 0; i < 4; ++i)
#pragma unroll
      for (int r = 0; r < 4; ++r) {
        int row = mw0 + 16 * i + (lane >> 4) * 4 + r;
#pragma unroll
        for (int j = 0; j < 4; ++j) C[(size_t)row * ldc + nw0 + 16 * j + (lane & 15)] = acc[i][j][r];
      }
  }
};
struct EpiProjSplit {
  __device__ __forceinline__ void operator()(const P& p, f32x4 (&acc)[4][4], int m0, int n0, int wm, int wn, int lane, char* smem) const {
    const int mw0 = m0 + wm * 64, nw0 = n0 + wn * 64;
#pragma unroll
    for (int i = 0; i < 4; ++i)
#pragma unroll
      for (int r = 0; r < 4; ++r) {
        int row = mw0 + 16 * i + (lane >> 4) * 4 + r;
#pragma unroll
        for (int j = 0; j < 4; ++j) {
          int col = nw0 + 16 * j + (lane & 15);
          if (n0 < 512) p.proj[(size_t)row * 512 + col] = acc[i][j][r];
          else p.projb[(size_t)row * DIN + col] = f2bf(acc[i][j][r]);
        }
      }
  }
};
template <int CTRL>
__device__ __forceinline__ float dpp_row(float v) {
  return __int_as_float(__builtin_amdgcn_update_dpp(0, __float_as_int(v), CTRL, 0xf, 0xf, false));
}
struct EpiProj {
  int l;
  __device__ __forceinline__ void operator()(const P& p, f32x4 (&acc)[4][4], int m0, int n0, int wm, int wn, int lane, char* smem) const {
    const int g = lane >> 4, lr = lane & 15;
    const int mw0 = m0 + wm * 64, nw0 = n0 + wn * 64;
    if (n0 < 512) {
#pragma unroll
      for (int i = 0; i < 4; ++i)
#pragma unroll
        for (int r = 0; r < 4; ++r) {
          int row = mw0 + 16 * i + 4 * g + r;
#pragma unroll
          for (int j = 0; j < 4; ++j) p.proj[(size_t)row * 512 + nw0 + 16 * j + lr] = acc[i][j][r];
        }
      return;
    }
    const float* gain = nullptr; bool rope = false; float scale = 1.f;
    if (nw0 < 896) { gain = p.win_qn + l * 64; rope = true; scale = QSCALE; }
    else if (nw0 < 1024) { gain = p.win_kn + l * 64; rope = true; }
    else if (nw0 < 1152) { }
    else if (nw0 < 1536) { gain = p.na_qn + l * 64; scale = QSCALE; }
    else if (nw0 < 1920) { gain = p.na_kn + l * 64; }
    rope = rope && (m0 >= LC);
    float gj[4] = {1.f, 1.f, 1.f, 1.f};
    if (gain) {
#pragma unroll
      for (int j = 0; j < 4; ++j) gj[j] = gain[16 * j + lr] * scale;
    }
    const float inv = __expf(-(float)lr * (1.f / 16.f) * 9.210340371976184f);
#pragma unroll
    for (int i = 0; i < 4; ++i)
#pragma unroll
      for (int r = 0; r < 4; ++r) {
        const int row = mw0 + 16 * i + 4 * g + r;
        float y[4] = {acc[i][0][r], acc[i][1][r], acc[i][2][r], acc[i][3][r]};
        if (gain) {
          float ss = y[0] * y[0] + y[1] * y[1] + y[2] * y[2] + y[3] * y[3];
          ss += dpp_row<0xB1>(ss);
          ss += dpp_row<0x4E>(ss);
          ss += dpp_row<0x141>(ss);
          ss += dpp_row<0x140>(ss);
          const float rinv = rsqrtf(ss * (1.f / 64.f) + EPS);
#pragma unroll
          for (int j = 0; j < 4; ++j) y[j] *= rinv * gj[j];
        }
        if (rope) {
          const int pos = row - LC;
          float cs[2], sn[2];
#pragma unroll
          for (int ax = 0; ax < 2; ++ax) {
            float ang = (float)(ax ? (pos & 63) : (pos >> 6)) * inv;
            float k = rintf(ang * 0.15915494309189535f);
            float rr = fmaf(-k, 6.2831854820251465f, ang);
            rr = fmaf(-k, -1.7484555e-07f, rr);
            cs[ax] = __cosf(rr); sn[ax] = __sinf(rr);
          }
          float a0 = y[0] * cs[0] - y[1] * sn[0], a1 = y[0] * sn[0] + y[1] * cs[0];
          float a2 = y[2] * cs[1] - y[3] * sn[1], a3 = y[2] * sn[1] + y[3] * cs[1];
          y[0] = a0; y[1] = a1; y[2] = a2; y[3] = a3;
        }
#pragma unroll
        for (int j = 0; j < 4; ++j) p.projb[(size_t)row * DIN + nw0 + 16 * j + lr] = f2bf(y[j]);
      }
  }
};
struct EpiResid {
  int l, gofs;
  __device__ __forceinline__ void operator()(const P& p, f32x4 (&acc)[4][4], int m0, int n0, int wm, int wn, int lane, char* smem) const {
    const int mw0 = m0 + wm * 64, nw0 = n0 + wn * 64;
#pragma unroll
    for (int i = 0; i < 4; ++i)
#pragma unroll
      for (int r = 0; r < 4; ++r) {
        int row = mw0 + 16 * i + (lane >> 4) * 4 + r;
        const float* gt = p.mod + (l * 2 + (row < LC ? 1 : 0)) * 6144 + gofs;
#pragma unroll
        for (int j = 0; j < 4; ++j) {
          int col = nw0 + 16 * j + (lane & 15);
          p.xall[(size_t)row * 1024 + col] += gt[col] * acc[i][j][r];
        }
      }
  }
};

__device__ __forceinline__ int gemm_swz(int row) { return (0x78 >> (((row >> 2) & 3) * 2)) & 3; }
template <class Epi>
__device__ __forceinline__ void gemm_bf16_128(const P& p, const bf16_t* __restrict__ A, const bf16_t* __restrict__ Bt, int K, int m_begin, int m_end,
                              int N, char* smem, const Epi& epi) {
  const int tid = tid_opaque(), lane = tid & 63, wv = __builtin_amdgcn_readfirstlane(tid >> 6), wm = wv >> 1, wn = wv & 1;
  const int tiles_n = N / 128, tiles_m = (m_end - m_begin) / 128;
  const int nk = K / 32;
  const int lr = lane & 15, g = lane >> 4;
  const int a_rd = (wm * 64 + lr) * 64 + ((g ^ gemm_swz(lr)) << 4);
  const int b_rd = 8192 + (wn * 64 + lr) * 64 + ((g ^ gemm_swz(lr)) << 4);
  const int ld_row = lane >> 2, ld_c = (lane & 3) ^ gemm_swz(ld_row);
  for (int tile = blockIdx.x; tile < tiles_m * tiles_n; tile += gridDim.x) {
    const int m0 = m_begin + (tile / tiles_n) * 128, n0 = (tile % tiles_n) * 128;
    f32x4 acc[4][4];
#pragma unroll
    for (int i = 0; i < 4; ++i)
#pragma unroll
      for (int j = 0; j < 4; ++j) acc[i][j] = (f32x4){0.f, 0.f, 0.f, 0.f};
    const bf16_t* Ag = A + (size_t)(m0 + wv * 32 + ld_row) * K + ld_c * 8;
    const bf16_t* Bg = Bt + (size_t)(n0 + wv * 32 + ld_row) * K + ld_c * 8;
    auto issue = [&](int st, int kt) {
      char* base = smem + st * 16384 + wv * 2048;
#pragma unroll
      for (int i = 0; i < 2; ++i) {
        __builtin_amdgcn_global_load_lds((const unsigned*)(Ag + (size_t)i * 16 * K + kt * 32), (__attribute__((address_space(3))) unsigned*)(base + i * 1024), 16, 0, 0);
        __builtin_amdgcn_global_load_lds((const unsigned*)(Bg + (size_t)i * 16 * K + kt * 32), (__attribute__((address_space(3))) unsigned*)(base + 8192 + i * 1024), 16, 0, 0);
      }
    };
    issue(0, 0); issue(1, 1); issue(2, 2);
    for (int kt0 = 0; kt0 < nk; kt0 += 4) {
#pragma unroll
      for (int u = 0; u < 4; ++u) {
        const int kt = kt0 + u, rem = nk - kt;
        if (rem >= 3) asm volatile("s_waitcnt vmcnt(8) lgkmcnt(0)" ::: "memory");
        else if (rem == 2) asm volatile("s_waitcnt vmcnt(4) lgkmcnt(0)" ::: "memory");
        else asm volatile("s_waitcnt vmcnt(0) lgkmcnt(0)" ::: "memory");
        __builtin_amdgcn_s_barrier();
        if (kt + 3 < nk) issue((u + 3) & 3, kt + 3);
        bf16x8 af[4], bfr[4];
#pragma unroll
        for (int i = 0; i < 4; ++i) af[i] = *(const bf16x8*)(smem + u * 16384 + a_rd + i * 1024);
#pragma unroll
        for (int j = 0; j < 4; ++j) bfr[j] = *(const bf16x8*)(smem + u * 16384 + b_rd + j * 1024);
#pragma unroll
        for (int i = 0; i < 4; ++i)
#pragma unroll
          for (int j = 0; j < 4; ++j) acc[i][j] = __builtin_amdgcn_mfma_f32_16x16x32_bf16(af[i], bfr[j], acc[i][j], 0, 0, 0);
      }
    }
    __syncthreads();
    epi(p, acc, m0, n0, wm, wn, lane, smem);
    __syncthreads();
  }
}

constexpr int NCHUNK = TT / 64;
__device__ __forceinline__ int lru_pos(int dir, int c) { return dir == 0 ? c : (c < 4 ? 3 - c : 4 + (NCHUNK - 1 - c)); }

__device__ __forceinline__ void ph_lru_prepw(const P& p) {
  for (int idx = GTID; idx < 2 * 2 * 4 * 2 * 4096; idx += GSZ) {
    int d = idx & 63, e = (idx >> 6) & 63, mtx = (idx >> 12) & 1, rest = idx >> 13;
    const float* w = (mtx ? p.wx : p.wa) + (size_t)rest * 4096;
    p.lruw_t[idx] = f2bf(w[d * 64 + e]);
  }
}

template <int PASS>
__device__ __forceinline__ void lru_item(const P& p, int l, int cidx, int kb, char* smem) {
  bf16_t* u_img = (bf16_t*)smem;
  float* ab_a = (float*)(smem + 8192);
  float* ab_b = (float*)(smem + 8192 + 16384);
  float* hsum = (float*)(smem + 8192 + 32768);
  float* segagg = (float*)(smem + 8192 + 49152);
  float* ccarry = (float*)(smem + 8192 + 49152 + 2048);
  const int tid = tid_opaque(), lane = tid & 63, wv = tid >> 6, g = lane >> 4, lr = lane & 15;
  const int t0 = cidx * 64;
  const int lo = t0 < LC ? 0 : LC, hi = t0 < LC ? LC : TT;
  __syncthreads();
  {
    const int ch = tid & 63, c = kb * 64 + ch;
    const float cb = p.conv_b[l * 256 + c];
    float cw[4];
#pragma unroll
    for (int k = 0; k < 4; ++k) cw[k] = p.conv_w[(l * 4 + k) * 256 + c];
#pragma unroll
    for (int i = 0; i < 16; ++i) {
      int row = (tid >> 6) + 4 * i, t = t0 + row;
      float acc = cb;
#pragma unroll
      for (int k = 0; k < 4; ++k) {
        int tt = t + k - 2;
        if (tt >= lo && tt < hi) acc += cw[k] * p.proj[(size_t)tt * 512 + OFF_XA + c];
      }
      u_img[row * 64 + ((((ch >> 3) ^ (row & 7)) << 3) | (ch & 7))] = f2bf(acc);
    }
  }
  if (PASS == 2) {
    if (tid < 128) {
      const int ch = tid & 63, dir = tid >> 6;
      ccarry[dir * 64 + ch] = p.lcarry[((size_t)dir * NCHUNK + lru_pos(dir, cidx)) * 256 + kb * 64 + ch];
    }
  }
  __syncthreads();
  for (int dir = 0; dir < 2; ++dir) {
    const int pd = l * 2 + dir;
    {
      f32x4 ga[4], gx[4];
#pragma unroll
      for (int i = 0; i < 4; ++i) { ga[i] = (f32x4){0.f, 0.f, 0.f, 0.f}; gx[i] = (f32x4){0.f, 0.f, 0.f, 0.f}; }
      const bf16_t* wbase = p.lruw_t + (size_t)((pd * 4 + kb) * 2) * 4096 + (16 * wv + lr) * 64 + 8 * g;
#pragma unroll
      for (int s = 0; s < 2; ++s) {
        bf16x8 ba_ = *(const bf16x8*)(wbase + 32 * s);
        bf16x8 bx_ = *(const bf16x8*)(wbase + 4096 + 32 * s);
#pragma unroll
        for (int i = 0; i < 4; ++i) {
          int row = 16 * i + lr;
          bf16x8 af = *(const bf16x8*)((const char*)u_img + row * 128 + (((4 * s + g) ^ (row & 7)) << 4));
          ga[i] = __builtin_amdgcn_mfma_f32_16x16x32_bf16(af, ba_, ga[i], 0, 0, 0);
          gx[i] = __builtin_amdgcn_mfma_f32_16x16x32_bf16(af, bx_, gx[i], 0, 0, 0);
        }
      }
      const int ch = 16 * wv + lr, c = kb * 64 + ch;
      const float bav = p.ba[pd * 256 + c], bxv = p.bx[pd * 256 + c];
      const float sp = log1pf(expf(-p.lam[pd * 256 + c]));
#pragma unroll
      for (int i = 0; i < 4; ++i)
#pragma unroll
        for (int r = 0; r < 4; ++r) {
          int row = 16 * i + 4 * g + r;
          float rr = sigmoid_f(ga[i][r] + bav), ig = sigmoid_f(gx[i][r] + bxv);
          float log_a = -8.f * rr * sp;
          float a = __expf(log_a);
          float uu = bf2f(u_img[row * 64 + ((((ch >> 3) ^ (row & 7)) << 3) | (ch & 7))]);
          float b = sqrtf(-expm1f(2.f * log_a)) * ig * uu;
          ab_a[row * 64 + ch] = a;
          ab_b[row * 64 + ch] = b;
        }
    }
    __syncthreads();
    {
      const int ch = tid & 63, seg = tid >> 6;
      float Pr = 1.f, H = 0.f;
#pragma unroll
      for (int i = 0; i < 16; ++i) {
        int row = dir == 0 ? seg * 16 + i : seg * 16 + 15 - i;
        float a = ab_a[row * 64 + ch], b = ab_b[row * 64 + ch];
        H = a * H + b;
        Pr *= a;
      }
      segagg[(seg * 64 + ch) * 2] = Pr;
      segagg[(seg * 64 + ch) * 2 + 1] = H;
      __syncthreads();
      if (PASS == 1) {
        if (seg == 0) {
          float A = 1.f, B = 0.f;
#pragma unroll
          for (int s2 = 0; s2 < 4; ++s2) {
            int sg = dir == 0 ? s2 : 3 - s2;
            float pa = segagg[(sg * 64 + ch) * 2], pb = segagg[(sg * 64 + ch) * 2 + 1];
            B = pa * B + pb;
            A *= pa;
          }
          float2* ag = (float2*)p.lagg + ((size_t)dir * NCHUNK + lru_pos(dir, cidx)) * 256 + kb * 64 + ch;
          *ag = make_float2(A, B);
        }
      } else {
        float h = ccarry[dir * 64 + ch];
#pragma unroll
        for (int s2 = 0; s2 < 3; ++s2) {
          int sg = dir == 0 ? s2 : 3 - s2;
          bool before = dir == 0 ? (sg < seg) : (sg > seg);
          if (before) h = segagg[(sg * 64 + ch) * 2] * h + segagg[(sg * 64 + ch) * 2 + 1];
        }
#pragma unroll
        for (int i = 0; i < 16; ++i) {
          int row = dir == 0 ? seg * 16 + i : seg * 16 + 15 - i;
          float a = ab_a[row * 64 + ch], b = ab_b[row * 64 + ch];
          h = a * h + b;
          if (dir == 0) hsum[row * 64 + ch] = h;
          else {
            int t = t0 + row, c = kb * 64 + ch;
            float gv = p.proj[(size_t)t * 512 + OFF_GA + c];
            p.mixb[(size_t)t * 1024 + c] = f2bf((hsum[row * 64 + ch] + h) * gelu_f(gv));
          }
        }
      }
    }
    __syncthreads();
  }
}

__device__ __forceinline__ void ph_lru_carry(const P& p, float* smem) {
  const int tid = tid_opaque(), seg = tid >> 4, c16 = tid & 15;
  for (int blk = blockIdx.x; blk < 32; blk += gridDim.x) {
    const int dc = blk * 16 + c16, dir = dc >> 8, ch = dc & 255;
    const float2* ag = (const float2*)p.lagg + (size_t)dir * NCHUNK * 256 + ch;
    float2 v[17];
#pragma unroll
    for (int i = 0; i < 17; ++i) {
      int pos = seg * 17 + i;
      v[i] = pos < NCHUNK ? ag[(size_t)pos * 256] : make_float2(1.f, 0.f);
    }
    float A = 1.f, B = 0.f;
#pragma unroll
    for (int i = 0; i < 17; ++i) { B = v[i].x * B + v[i].y; A *= v[i].x; }
    __syncthreads();
    smem[(seg * 16 + c16) * 2] = A; smem[(seg * 16 + c16) * 2 + 1] = B;
    __syncthreads();
    float h = 0.f;
    for (int s2 = 0; s2 < seg; ++s2) h = smem[(s2 * 16 + c16) * 2] * h + smem[(s2 * 16 + c16) * 2 + 1];
    float* cr = p.lcarry + (size_t)dir * NCHUNK * 256 + ch;
#pragma unroll
    for (int i = 0; i < 17; ++i) {
      int pos = seg * 17 + i;
      if (pos < NCHUNK) cr[(size_t)pos * 256] = h;
      h = v[i].x * h + v[i].y;
    }
  }
}

template <int PASS>
__device__ __forceinline__ void ph_lru(const P& p, int l, char* smem) {
  const int c_begin = (PASS == 2 && l == 1) ? 4 : 0;
  const int nitems = (NCHUNK - c_begin) * 4;
  for (int it = blockIdx.x; it < nitems; it += gridDim.x) lru_item<PASS>(p, l, c_begin + (it >> 2), it & 3, smem);
}

typedef __attribute__((ext_vector_type(4))) short s16x4;

__device__ __forceinline__ void ph_qknorm_rope2(const P& p, int l) {
  const int tid_ = tid_opaque();
  const int lane = tid_ & 63;
  const int wpb = blockDim.x >> 6;
  for (int pair = blockIdx.x * wpb + (tid_ >> 6); pair < TT * 28; pair += gridDim.x * wpb) {
    int t = pair / 28, slot = pair % 28;
    const float* g = nullptr; bool rope = false; float scale = 1.f;
    if (slot < 6) { g = p.win_qn + l * 64; rope = true; scale = QSCALE; }
    else if (slot < 8) { g = p.win_kn + l * 64; rope = true; }
    else if (slot < 10) { }
    else if (slot < 16) { g = p.na_qn + l * 64; scale = QSCALE; }
    else if (slot < 22) { g = p.na_kn + l * 64; }
    rope = rope && (t >= LC);
    const size_t idx = (size_t)t * DIN + 512 + slot * 64 + lane;
    float v = bf2f(p.projb[idx]);
    float y = v;
    if (g) {
      float ss = wave_sum(v * v);
      y = v * rsqrtf(ss * (1.f / 64.f) + EPS) * g[lane];
    }
    float partner = __shfl_xor(y, 16);
    if (rope) {
      int pos = t - LC, row = pos >> 6, col = pos & 63;
      int j = lane & 15, axis = lane >> 5;
      float inv = __expf(-(float)j * (1.f / 16.f) * 9.210340371976184f);
      float ang = (float)(axis ? col : row) * inv;
      float k = rintf(ang * 0.15915494309189535f);
      float r = fmaf(-k, 6.2831854820251465f, ang);
      r = fmaf(-k, -1.7484555e-07f, r);
      float cs = __cosf(r), sn = __sinf(r);
      bool first = ((lane >> 4) & 1) == 0;
      y = first ? (y * cs - partner * sn) : (partner * sn + y * cs);
    }
    p.projb[idx] = f2bf(y * scale);
  }
}

template <int CTRL, int RMASK>
__device__ __forceinline__ float dpp_mov_id(float v) {
  return __int_as_float(__builtin_amdgcn_update_dpp(__float_as_int(v), __float_as_int(v), CTRL, RMASK, 0xf, false));
}
__device__ __forceinline__ float wave_max(float v) {
  v = fmaxf(v, dpp_mov_id<0xB1, 0xf>(v));
  v = fmaxf(v, dpp_mov_id<0x4E, 0xf>(v));
  v = fmaxf(v, dpp_mov_id<0x141, 0xf>(v));
  v = fmaxf(v, dpp_mov_id<0x140, 0xf>(v));
  v = fmaxf(v, dpp_mov_id<0x142, 0xa>(v));
  v = fmaxf(v, dpp_mov_id<0x143, 0xc>(v));
  return __int_as_float(__builtin_amdgcn_readlane(__float_as_int(v), 63));
}

struct KVRegs { uint4 k[2], v[2]; };
template <class TokFn>
__device__ __forceinline__ void kv_load(const P& p, KVRegs& r, int koff, int voff, TokFn tok, int tid) {
#pragma unroll
  for (int i = 0; i < 2; ++i) {
    int id = tid + 256 * i, row = id >> 3, c = id & 7;
    const bf16_t* base = p.projb + (size_t)tok(row) * DIN + c * 8;
    r.k[i] = *(const uint4*)(base + koff);
    r.v[i] = *(const uint4*)(base + voff);
  }
}
__device__ __forceinline__ void kv_store(const KVRegs& r, char* stage, int tid) {
#pragma unroll
  for (int i = 0; i < 2; ++i) {
    int id = tid + 256 * i, row = id >> 3, c = id & 7;
    int off = row * 128 + ((c ^ (row & 7)) << 4);
    *(uint4*)(stage + off) = r.k[i];
    *(uint4*)(stage + 8192 + off) = r.v[i];
  }
}

template <class MaskFn>
__device__ __forceinline__ void attn_step(const char* stage, int kr0, const bf16x8 (&qf)[2], f32x4 (&o)[4], float& lsum, MaskFn mb, int lane) {
  const int g = lane >> 4, lr = lane & 15;
  f32x4 st[2];
#pragma unroll
  for (int t2 = 0; t2 < 2; ++t2) {
    st[t2] = (f32x4){0.f, 0.f, 0.f, 0.f};
    const int row = kr0 + 16 * t2 + lr;
#pragma unroll
    for (int s = 0; s < 2; ++s) {
      bf16x8 kf = *(const bf16x8*)(stage + row * 128 + (((4 * s + g) ^ (row & 7)) << 4));
      st[t2] = __builtin_amdgcn_mfma_f32_16x16x32_bf16(kf, qf[s], st[t2], 0, 0, 0);
    }
  }
  bf16x8 pb;
#pragma unroll
  for (int t2 = 0; t2 < 2; ++t2)
#pragma unroll
    for (int r = 0; r < 4; ++r) {
      float pv = exp2f(mb(t2, r, st[t2][r]));
      lsum += pv;
      pb[t2 * 4 + r] = (short)f2bf(pv);
    }
  const int q = lr >> 2, pp = lane & 3;
#pragma unroll
  for (int m = 0; m < 4; ++m) {
    bf16x8 vf;
#pragma unroll
    for (int t = 0; t < 2; ++t) {
      const int row = kr0 + 16 * t + 4 * g + q;
      const char* addr = stage + 8192 + row * 128 + (((2 * m + (pp >> 1)) ^ (row & 7)) << 4) + 8 * (pp & 1);
      s16x4 v4 = __builtin_amdgcn_ds_read_tr16_b64_v4i16((__attribute__((address_space(3))) s16x4*)addr);
      vf[4 * t + 0] = v4[0]; vf[4 * t + 1] = v4[1]; vf[4 * t + 2] = v4[2]; vf[4 * t + 3] = v4[3];
    }
    o[m] = __builtin_amdgcn_mfma_f32_16x16x32_bf16(vf, pb, o[m], 0, 0, 0);
  }
}

__device__ __forceinline__ void attn_store_out(const P& p, const f32x4 (&o)[4], float lsum, int tok, int col0, int lane) {
  const int g = lane >> 4;
  lsum += __shfl_xor(lsum, 16);
  lsum += __shfl_xor(lsum, 32);
  const float inv = 1.f / lsum;
  bf16_t* op = p.mixb + (size_t)tok * 1024 + col0 + 4 * g;
#pragma unroll
  for (int m = 0; m < 4; ++m)
    *(uint2*)(op + 16 * m) = make_uint2(pack2bf(o[m][0] * inv, o[m][1] * inv), pack2bf(o[m][2] * inv, o[m][3] * inv));
}

__device__ __forceinline__ void attn_win_item(const P& p, int l, int kind, int qb, int hs, char* smem) {
  const int tid = tid_opaque(), lane = tid & 63, wv = tid >> 6, g = lane >> 4, lr = lane & 15;
  int qoff, koff, voff, ooff; const float *gq, *gk; float sink2 = -1e30f; bool has_sink = false;
  if (kind == 0 || hs < 6) {
    const int h = hs, kvh = h / 3;
    qoff = OFF_QW + h * 64; koff = OFF_KW + kvh * 64; voff = OFF_VW + kvh * 64; ooff = 256 + h * 64;
    gq = p.win_qn + l * 64; gk = p.win_kn + l * 64; sink2 = p.win_sink[l * 6 + h] * LOG2E; has_sink = true;
  } else {
    const int h = hs - 6;
    qoff = OFF_QN + h * 64; koff = OFF_KN + h * 64; voff = OFF_VN + h * 64; ooff = 640 + h * 64;
    gq = p.na_qn + l * 64; gk = p.na_kn + l * 64;
  }
  float bound = 8.f * LOG2E * wave_max(fabsf(gq[lane])) * wave_max(fabsf(gk[lane])) * 1.0001f + 1e-3f;
  if (has_sink) bound = fmaxf(bound, sink2);
  const int q0 = qb * 64;
  const int qtok = (kind == 0 ? LC : 0) + q0 + 16 * wv + lr;
  bf16x8 qf[2];
#pragma unroll
  for (int s = 0; s < 2; ++s) qf[s] = *(const bf16x8*)(p.projb + (size_t)qtok * DIN + qoff + 32 * s + 8 * g);
  f32x4 o[4];
#pragma unroll
  for (int m = 0; m < 4; ++m) o[m] = (f32x4){0.f, 0.f, 0.f, 0.f};
  float lsum = 0.f;
  const int nloc = (kind == 0) ? 5 : 0, nch = nloc + 4;
  auto tokfn = [&](int c) {
    return [=](int row) {
      if (c < nloc) { int pos = q0 - 128 + 64 * c + row; pos = pos < 0 ? 0 : (pos > SEQ - 1 ? SEQ - 1 : pos); return LC + pos; }
      return 64 * (c - nloc) + row;
    };
  };
  KVRegs kr;
  __syncthreads();
  kv_load(p, kr, koff, voff, tokfn(0), tid);
  kv_store(kr, smem, tid);
  __syncthreads();
  for (int c = 0; c < nch; ++c) {
    const char* stage = smem + (c & 1) * 16384;
    if (c + 1 < nch) kv_load(p, kr, koff, voff, tokfn(c + 1), tid);
    if (c < nloc) {
      const int qpos = q0 + 16 * wv + lr;
#pragma unroll
      for (int st = 0; st < 2; ++st) {
        const int kbase = q0 - 128 + 64 * c + 32 * st;
        attn_step(stage, 32 * st, qf, o, lsum, [&](int t2, int r, float s) {
          int kpos = kbase + 16 * t2 + 4 * g + r;
          int dlt = kpos - qpos; dlt = dlt < 0 ? -dlt : dlt;
          bool valid = (kpos >= 0) && (kpos < SEQ) && (dlt <= 128);
          return valid ? s - bound : -1e30f;
        }, lane);
      }
    } else {
#pragma unroll
      for (int st = 0; st < 2; ++st) attn_step(stage, 32 * st, qf, o, lsum, [&](int t2, int r, float s) { return s - bound; }, lane);
    }
    if (c + 1 < nch) kv_store(kr, smem + ((c + 1) & 1) * 16384, tid);
    __syncthreads();
  }
  if (has_sink && g == 0) lsum += exp2f(sink2 - bound);
  attn_store_out(p, o, lsum, qtok, ooff, lane);
}

__device__ __forceinline__ void attn_na_item(const P& p, int l, int r, int h, char* smem) {
  const int tid = tid_opaque(), lane = tid & 63, wv = tid >> 6, g = lane >> 4, lr = lane & 15;
  const int qoff = OFF_QN + h * 64, koff = OFF_KN + h * 64, voff = OFF_VN + h * 64, ooff = 640 + h * 64;
  float* rpbl = (float*)(smem + 32768);
  const float* rpbg = p.rpb + (size_t)(l * 6 + h) * 465;
  float bmax = 0.f;
  __syncthreads();
  for (int i = tid; i < 465; i += 256) { float b = rpbg[i] * LOG2E; rpbl[i] = b; }
  for (int i = lane; i < 465; i += 64) bmax = fmaxf(bmax, fabsf(rpbg[i]) * LOG2E);
  bmax = wave_max(bmax);
  const float bound = 8.f * LOG2E * wave_max(fabsf(p.na_qn[l * 64 + lane])) * wave_max(fabsf(p.na_kn[l * 64 + lane])) * 1.0001f + bmax + 1e-3f;
  const int qcol = 16 * wv + lr;
  const int qtok = LC + r * 64 + qcol;
  const int kr0r = min(max(r - 4, 0), 248);
  const int kc0 = min(max(16 * wv - 8, 0), 32);
  const int qs = min(max(qcol - 8, 0), 48);
  bf16x8 qf[2];
#pragma unroll
  for (int s = 0; s < 2; ++s) qf[s] = *(const bf16x8*)(p.projb + (size_t)qtok * DIN + qoff + 32 * s + 8 * g);
  f32x4 o[4];
#pragma unroll
  for (int m = 0; m < 4; ++m) o[m] = (f32x4){0.f, 0.f, 0.f, 0.f};
  float lsum = 0.f;
  auto tokfn = [&](int c) {
    return [=](int row) { return c < 8 ? LC + (kr0r + c) * 64 + row : 64 * (c - 8) + row; };
  };
  KVRegs kr;
  kv_load(p, kr, koff, voff, tokfn(0), tid);
  kv_store(kr, smem, tid);
  __syncthreads();
  for (int c = 0; c < 12; ++c) {
    const char* stage = smem + (c & 1) * 16384;
    if (c + 1 < 12) kv_load(p, kr, koff, voff, tokfn(c + 1), tid);
    if (c < 8) {
      const int dr = kr0r + c - r + 7;
      attn_step(stage, kc0, qf, o, lsum, [&](int t2, int rr, float s) {
        int kcol = kc0 + 16 * t2 + 4 * g + rr;
        bool valid = (kcol >= qs) && (kcol < qs + 16);
        int dc = kcol - qcol + 15; dc = dc < 0 ? 0 : (dc > 30 ? 30 : dc);
        return valid ? s + rpbl[dr * 31 + dc] - bound : -1e30f;
      }, lane);
    } else {
#pragma unroll
      for (int st = 0; st < 2; ++st) attn_step(stage, 32 * st, qf, o, lsum, [&](int t2, int rr, float s) { return s - bound; }, lane);
    }
    if (c + 1 < 12) kv_store(kr, smem + ((c + 1) & 1) * 16384, tid);
    __syncthreads();
  }
  attn_store_out(p, o, lsum, qtok, ooff, lane);
}

__device__ __forceinline__ void ph_attn(const P& p, int l, char* smem) {
  const int nitems = 3072 + (l == 0 ? 48 : 0);
  for (int it = blockIdx.x; it < nitems; it += gridDim.x) {
    if (it < 1536) attn_win_item(p, l, 0, it / 6, it % 6, smem);
    else if (it < 3072) { int j = it - 1536; attn_na_item(p, l, j / 6, j % 6, smem); }
    else { int j = it - 3072; attn_win_item(p, l, 1, j / 12, j % 12, smem); }
  }
}

__device__ __forceinline__ unsigned ord_key(float s) {
  unsigned u = __float_as_uint(s);
  return (u & 0x80000000u) ? ~u : (u | 0x80000000u);
}
__device__ __forceinline__ float ord_val(unsigned pk) {
  unsigned u = pk & ~127u;
  unsigned b = (u & 0x80000000u) ? (u & 0x7fffffffu) : ~u;
  return __uint_as_float(b);
}
__device__ __forceinline__ void ce_desc(unsigned& a, unsigned& b) {
  unsigned mx = a > b ? a : b, mn = a > b ? b : a;
  a = mx; b = mn;
}
__device__ __forceinline__ void sort16_desc(unsigned (&v)[16]) {
#pragma unroll
  for (int k = 2; k <= 16; k <<= 1) {
#pragma unroll
    for (int j = k >> 1; j > 0; j >>= 1) {
#pragma unroll
      for (int i = 0; i < 16; ++i) {
        int m = i ^ j;
        if (m > i) {
          if ((i & k) == 0) ce_desc(v[i], v[m]); else ce_desc(v[m], v[i]);
        }
      }
    }
  }
}
__device__ __forceinline__ void merge16_desc(unsigned (&a)[16], const unsigned (&b)[16]) {
#pragma unroll
  for (int i = 0; i < 16; ++i) { unsigned o = b[15 - i]; a[i] = a[i] > o ? a[i] : o; }
#pragma unroll
  for (int j = 8; j > 0; j >>= 1) {
#pragma unroll
    for (int i = 0; i < 16; ++i) {
      int m = i ^ j;
      if (m > i) ce_desc(a[i], a[m]);
    }
  }
}

typedef __attribute__((ext_vector_type(2))) float f32x2;
__device__ __forceinline__ void ph_prep_peer(const P& p) {
  const int tid = tid_opaque(), lane = tid & 63;
  const int nw = gridDim.x * 4;
  for (int row = blockIdx.x * 4 + (tid >> 6); row < 4 * 16384; row += nw) {
    const int tbl = row >> 15, le = row & 32767;
    const float4* src = (const float4*)((tbl ? p.pv : p.pu) + (size_t)le * 1024) + lane * 4;
    float4 v[4];
    float am = 0.f;
#pragma unroll
    for (int i = 0; i < 4; ++i) {
      v[i] = src[i];
      am = fmaxf(am, fmaxf(fmaxf(fabsf(v[i].x), fabsf(v[i].y)), fmaxf(fabsf(v[i].z), fabsf(v[i].w))));
    }
    am = wave_max(am);
    const float sc = am > 0.f ? 224.f / am : 1.f;
    unsigned w[4];
#pragma unroll
    for (int i = 0; i < 4; ++i) {
      int t = __builtin_amdgcn_cvt_pk_fp8_f32(v[i].x * sc, v[i].y * sc, 0, false);
      t = __builtin_amdgcn_cvt_pk_fp8_f32(v[i].z * sc, v[i].w * sc, t, true);
      w[i] = (unsigned)t;
    }
    ((uint4*)((tbl ? p.vb8 : p.ub8) + (size_t)le * 1024))[lane] = make_uint4(w[0], w[1], w[2], w[3]);
    if (lane == 0) (tbl ? p.vsc : p.usc)[le] = am > 0.f ? am / 224.f : 1.f;
  }
  for (int i = GTID; i < 2 * 128 * 128; i += GSZ) { p.k1b[i] = f2bf(p.k1[i]); p.k2b[i] = f2bf(p.k2[i]); }
}

struct EpiPeerTopk {
  int l;
  __device__ __forceinline__ void operator()(const P& p, f32x4 (&acc)[4][4], int m0, int n0, int wm, int wn, int lane, char* smem) const {
    const int tid = ((wm * 2 + wn) << 6) | lane, g = lane >> 4, lr = lane & 15;
    const int nt = n0 >> 7, head = nt >> 1, hf = nt & 1;
    char* qimg = smem;
    char* kimg = smem + 34816;
    {
      char* qw = qimg + (wm * 64 + 4 * g) * 272 + (wn * 64 + lr) * 2;
#pragma unroll
      for (int i = 0; i < 4; ++i)
#pragma unroll
        for (int r = 0; r < 4; ++r)
#pragma unroll
          for (int j = 0; j < 4; ++j) *(bf16_t*)(qw + (16 * i + r) * 272 + 32 * j) = f2bf(acc[i][j][r]);
      const bf16_t* kk = (hf ? p.k2b : p.k1b) + (size_t)l * 16384 + (tid >> 4) * 128 + (tid & 15) * 8;
      char* kw = kimg + (tid >> 4) * 272 + (tid & 15) * 16;
#pragma unroll
      for (int i = 0; i < 8; ++i) *(uint4*)(kw + i * 16 * 272) = *(const uint4*)(kk + i * 16 * 128);
    }
    __syncthreads();
#pragma unroll
    for (int i = 0; i < 4; ++i)
#pragma unroll
      for (int j = 0; j < 4; ++j) acc[i][j] = (f32x4){0.f, 0.f, 0.f, 0.f};
    {
      const char* qa = qimg + (wm * 64 + lr) * 272 + g * 16;
      const char* kb = kimg + (wn * 64 + lr) * 272 + g * 16;
#pragma unroll
      for (int s = 0; s < 4; ++s) {
        bf16x8 af[4], bfr[4];
#pragma unroll
        for (int i = 0; i < 4; ++i) af[i] = *(const bf16x8*)(qa + i * 16 * 272 + s * 64);
#pragma unroll
        for (int j = 0; j < 4; ++j) bfr[j] = *(const bf16x8*)(kb + j * 16 * 272 + s * 64);
#pragma unroll
        for (int i = 0; i < 4; ++i)
#pragma unroll
          for (int j = 0; j < 4; ++j) acc[i][j] = __builtin_amdgcn_mfma_f32_16x16x32_bf16(af[i], bfr[j], acc[i][j], 0, 0, 0);
      }
    }
    __syncthreads();
    unsigned* simg = (unsigned*)smem;
    {
      unsigned* sw = simg + (wm * 64 + 4 * g) * 129 + wn * 64 + lr;
#pragma unroll
      for (int i = 0; i < 4; ++i)
#pragma unroll
        for (int r = 0; r < 4; ++r)
#pragma unroll
          for (int j = 0; j < 4; ++j)
            sw[(16 * i + r) * 129 + 16 * j] = (ord_key(acc[i][j][r]) & ~127u) | (unsigned)(wn * 64 + 16 * j + lr);
    }
    __syncthreads();
    const int row = tid & 127, half = tid >> 7;
    unsigned top[16];
    {
      const unsigned* sr = simg + row * 129 + half * 64;
#pragma unroll
      for (int k = 0; k < 16; ++k) top[k] = sr[k];
      sort16_desc(top);
#pragma unroll 1
      for (int gi = 1; gi < 4; ++gi) {
        unsigned v1[16];
#pragma unroll
        for (int k = 0; k < 16; ++k) v1[k] = sr[gi * 16 + k];
        sort16_desc(v1);
        merge16_desc(top, v1);
      }
    }
    __syncthreads();
    if (half == 1) {
#pragma unroll
      for (int k = 0; k < 16; ++k) simg[k * 128 + row] = top[k];
    }
    __syncthreads();
    if (half == 0) {
      unsigned o[16];
#pragma unroll
      for (int k = 0; k < 16; ++k) o[k] = simg[k * 128 + row];
      merge16_desc(top, o);
      uint4* dst = (uint4*)(p.pk + (((size_t)(m0 + row) * 8 + head) * 2 + hf) * 16);
#pragma unroll
      for (int k = 0; k < 4; ++k) dst[k] = make_uint4(top[4 * k], top[4 * k + 1], top[4 * k + 2], top[4 * k + 3]);
    }
  }
};

__device__ const unsigned char CAND_A[64] = {0,0,0,0,0,0,0,0,0,0,0,0,0,0,0,0, 1,1,1,1,1,1,1,1, 2,2,2,2,2, 3,3,3,3, 4,4,4, 5,5, 6,6, 7,7,
                                             8,9,10,11,12,13,14,15, 0,0,0,0,0,0,0,0,0,0,0,0,0,0};
__device__ const unsigned char CAND_B[64] = {0,1,2,3,4,5,6,7,8,9,10,11,12,13,14,15, 0,1,2,3,4,5,6,7, 0,1,2,3,4, 0,1,2,3, 0,1,2, 0,1, 0,1, 0,1,
                                             0,0,0,0,0,0,0,0, 0,0,0,0,0,0,0,0,0,0,0,0,0,0};

__device__ __forceinline__ void ph_peer_apply2(const P& p, int l, int t0, char* smem) {
  const int tid = tid_opaque(), lane = tid & 63, wv = tid >> 6;
  int* lds_e = (int*)(smem + wv * 1024);
  float* lds_g = (float*)(smem + wv * 1024 + 512);
  const unsigned char* U = p.ub8 + (size_t)l * 16384 * 1024;
  const unsigned char* V = p.vb8 + (size_t)l * 16384 * 1024;
  const float* usc = p.usc + l * 16384;
  const float* vsc = p.vsc + l * 16384;
  const float* n2g = p.norm2_g + l * 1024;
  const int ca = CAND_A[lane], cb = CAND_B[lane];
  for (int tk = t0 + blockIdx.x * 4 + wv; tk < TT; tk += gridDim.x * 4) {
    const float* mod = p.mod + (l * 2 + (tk < LC ? 1 : 0)) * 6144;
    float xv[16], hv[16];
    {
      const float4* xp = (const float4*)(p.xall + (size_t)tk * 1024) + lane * 4;
      float ss = 0.f;
#pragma unroll
      for (int q = 0; q < 4; ++q) {
        float4 v = xp[q];
        xv[q * 4 + 0] = v.x; xv[q * 4 + 1] = v.y; xv[q * 4 + 2] = v.z; xv[q * 4 + 3] = v.w;
        ss += v.x * v.x + v.y * v.y + v.z * v.z + v.w * v.w;
      }
      ss = wave_sum(ss);
      float rinv = rsqrtf(ss * (1.f / 1024.f) + EPS);
#pragma unroll
      for (int q = 0; q < 4; ++q) {
        float4 gg = ((const float4*)n2g)[lane * 4 + q], sc = ((const float4*)(mod + 4096))[lane * 4 + q], sh = ((const float4*)(mod + 3072))[lane * 4 + q];
        hv[q * 4 + 0] = xv[q * 4 + 0] * rinv * gg.x * (1.f + sc.x) + sh.x;
        hv[q * 4 + 1] = xv[q * 4 + 1] * rinv * gg.y * (1.f + sc.y) + sh.y;
        hv[q * 4 + 2] = xv[q * 4 + 2] * rinv * gg.z * (1.f + sc.z) + sh.z;
        hv[q * 4 + 3] = xv[q * 4 + 3] * rinv * gg.w * (1.f + sc.w) + sh.w;
      }
    }
    for (int head = 0; head < 8; ++head) {
      const unsigned* pk = p.pk + ((size_t)tk * 8 + head) * 32;
      unsigned p1 = pk[ca], p2 = pk[16 + cb];
      float sum = lane < 50 ? ord_val(p1) + ord_val(p2) : -3.0e38f;
      int eid = (int)(p1 & 127u) * 128 + (int)(p2 & 127u);
      int rank = 0;
      for (int m = 0; m < 50; ++m) {
        float sm = __shfl(sum, m);
        rank += (sm > sum || (sm == sum && m < lane)) ? 1 : 0;
      }
      float mx = wave_max(sum);
      bool sel = (lane < 50) && (rank < 16);
      float e = sel ? __expf(sum - mx) : 0.f;
      float tot = wave_sum(e);
      if (sel) { lds_e[head * 16 + rank] = eid; lds_g[head * 16 + rank] = e / tot; }
    }
    float acc[16];
#pragma unroll
    for (int k = 0; k < 16; ++k) acc[k] = 0.f;
    for (int e0 = 0; e0 < 128; e0 += 8) {
      uint4 ur[8], vr[8];
      float gt[8], us[8], vs[8];
#pragma unroll
      for (int k = 0; k < 8; ++k) {
        int ex = __builtin_amdgcn_readfirstlane(lds_e[e0 + k]);
        gt[k] = lds_g[e0 + k];
        ur[k] = ((const uint4*)(U + (size_t)ex * 1024))[lane];
        vr[k] = ((const uint4*)(V + (size_t)ex * 1024))[lane];
        us[k] = usc[ex]; vs[k] = vsc[ex];
      }
#pragma unroll
      for (int k = 0; k < 8; ++k) {
        float dot = 0.f;
        unsigned w[4] = {ur[k].x, ur[k].y, ur[k].z, ur[k].w};
#pragma unroll
        for (int q = 0; q < 4; ++q) {
          f32x2 lo = __builtin_amdgcn_cvt_pk_f32_fp8((int)w[q], false), hi = __builtin_amdgcn_cvt_pk_f32_fp8((int)w[q], true);
          dot += lo[0] * hv[q * 4] + lo[1] * hv[q * 4 + 1] + hi[0] * hv[q * 4 + 2] + hi[1] * hv[q * 4 + 3];
        }
        dot = wave_sum(dot) * us[k];
        float a = gt[k] * gelu_f(dot) * vs[k];
        unsigned y[4] = {vr[k].x, vr[k].y, vr[k].z, vr[k].w};
#pragma unroll
        for (int q = 0; q < 4; ++q) {
          f32x2 lo = __builtin_amdgcn_cvt_pk_f32_fp8((int)y[q], false), hi = __builtin_amdgcn_cvt_pk_f32_fp8((int)y[q], true);
          acc[q * 4] += a * lo[0]; acc[q * 4 + 1] += a * lo[1]; acc[q * 4 + 2] += a * hi[0]; acc[q * 4 + 3] += a * hi[1];
        }
      }
    }
    {
      float4* xp = ((l == 1) ? (float4*)(p.out + (size_t)(tk - LC) * 1024) : (float4*)(p.xall + (size_t)tk * 1024)) + lane * 4;
#pragma unroll
      for (int q = 0; q < 4; ++q) {
        float4 gg = ((const float4*)(mod + 5120))[lane * 4 + q];
        float4 o;
        o.x = xv[q * 4 + 0] + gg.x * acc[q * 4 + 0];
        o.y = xv[q * 4 + 1] + gg.y * acc[q * 4 + 1];
        o.z = xv[q * 4 + 2] + gg.z * acc[q * 4 + 2];
        o.w = xv[q * 4 + 3] + gg.w * acc[q * 4 + 3];
        xp[q] = o;
      }
    }
  }
}

#define XB_TMO      128
#define XB_XCNT(j)  (256  + 64 * (j))
#define XB_XSUB(j)  (1280 + 64 * (j))
#define XB_XGEN(j)  (2304 + 64 * (j))
#define XB_TOP      3328
#define XB_TOPGEN   3392
#define XCD_BAR_WORDS 3456
#define XB_SPIN_CAP (1u << 22)
#define LAS __attribute__((address_space(3)))
__device__ __forceinline__ unsigned xb_ld(unsigned* q) { return __hip_atomic_load(q, __ATOMIC_RELAXED, __HIP_MEMORY_SCOPE_AGENT); }
__device__ __forceinline__ unsigned xb_add(unsigned* q, unsigned v) { return __hip_atomic_fetch_add(q, v, __ATOMIC_RELAXED, __HIP_MEMORY_SCOPE_AGENT); }
__device__ __forceinline__ unsigned xb_xcc_id() { return (unsigned)__builtin_amdgcn_s_getreg((3 << 11) | 20) & 0xFu; }
#define XB_SPIN(cond, bar) do { unsigned _sp = 0; while (cond) { __builtin_amdgcn_s_sleep(1); \
    if ((++_sp & 255u) == 0u) { if (xb_ld(&(bar)[XB_TMO])) break; if (_sp > XB_SPIN_CAP) { atomicAdd(&(bar)[XB_TMO], 1u); break; } } } } while (0)
struct XcdBarrier { unsigned* bar; unsigned x; volatile LAS unsigned* st; };
__device__ __forceinline__ XcdBarrier xcd_barrier_post(unsigned* bar, volatile LAS unsigned* st) {
  XcdBarrier b; b.bar = bar; b.x = xb_xcc_id(); b.st = st;
  if (threadIdx.x == 0) (void)xb_add(&bar[XB_XCNT(b.x)], 1u);
  return b;
}
__device__ __forceinline__ void xcd_barrier_complete(unsigned* bar, unsigned x, unsigned& nloc, unsigned& nx) {
  const unsigned G = gridDim.x * gridDim.y * gridDim.z;
  unsigned sum, cnt, mine, sp = 0u;
  for (;;) {
    sum = 0u; cnt = 0u; mine = 0u;
#pragma unroll
    for (unsigned j = 0; j < 16; ++j) { const unsigned c = xb_ld(&bar[XB_XCNT(j)]); sum += c; cnt += (c > 0u) ? 1u : 0u; mine = (j == x) ? c : mine; }
    if (sum == G) break;
    __builtin_amdgcn_s_sleep(1);
    if ((++sp & 255u) == 0u) { if (xb_ld(&bar[XB_TMO])) break; if (sp > XB_SPIN_CAP) { atomicAdd(&bar[XB_TMO], 1u); break; } }
  }
  nloc = mine > 0u ? mine : 1u; nx = cnt > 0u ? cnt : 1u;
}
__device__ __forceinline__ void xcd_barrier(const XcdBarrier& b) {
  asm volatile("s_waitcnt vmcnt(0)" ::: "memory");
  __syncthreads();
  if (threadIdx.x == 0) {
    unsigned* bar = b.bar;
    __builtin_amdgcn_s_waitcnt(0);
    unsigned nloc = b.st[0], nx = b.st[1];
    if (nloc == 0u) { xcd_barrier_complete(bar, b.x, nloc, nx); b.st[0] = nloc; b.st[1] = nx; }
    const unsigned old = xb_add(&bar[XB_XSUB(b.x)], 1u);
    const unsigned gen = old / nloc;
    if (old + 1u == (gen + 1u) * nloc) {
      __builtin_amdgcn_fence(__ATOMIC_RELEASE, "agent");
      asm volatile("s_waitcnt vmcnt(0)" ::: "memory");
      const unsigned og = xb_add(&bar[XB_TOP], 1u);
      const unsigned tg = og / nx;
      if (og + 1u == (tg + 1u) * nx) xb_add(&bar[XB_TOPGEN], 1u);
      else XB_SPIN(xb_ld(&bar[XB_TOPGEN]) == tg, bar);
      __builtin_amdgcn_fence(__ATOMIC_ACQUIRE, "agent");
      xb_add(&bar[XB_XGEN(b.x)], 1u);
      asm volatile("s_waitcnt vmcnt(0)" ::: "memory");
    } else {
      XB_SPIN(xb_ld(&bar[XB_XGEN(b.x)]) == gen, bar);
      __builtin_amdgcn_fence(__ATOMIC_ACQUIRE, "agent");
      asm volatile("s_waitcnt vmcnt(0)" ::: "memory");
    }
  }
  __syncthreads();
}

#ifndef PROBE_IV
#define PROBE_IV -1
#endif
__device__ __forceinline__ void probe_tick(int& cnt, unsigned long long* slots) {
  if (PROBE_IV >= 0) {
    if (threadIdx.x == 0 && (cnt == PROBE_IV || cnt == PROBE_IV + 1)) slots[cnt - PROBE_IV] = __builtin_amdgcn_s_memrealtime();
    cnt = __builtin_amdgcn_readfirstlane(cnt + 1);
  }
}
#define BARRIER() do { xcd_barrier(xb); probe_tick(pcnt, probe_t); } while (0)

typedef const __attribute__((address_space(4))) P* KP;
__device__ __forceinline__ P load_params(KP kp) {
#if defined(__HIP_DEVICE_COMPILE__)
  asm volatile("" : "+s"(kp));
  return *kp;
#else
  return P{};
#endif
}
#define PP load_params(kp)
__global__ void __launch_bounds__(256, 2) k_mega(P p_unused) {
  KP kp = (KP)__builtin_amdgcn_kernarg_segment_ptr();
  __shared__ __attribute__((aligned(16))) float smem[18432 + 8];
  uint4& xb_words = *(uint4*)(smem + 18432);
  cg::grid_group grid = cg::this_grid();
  if (threadIdx.x == 0) xb_words = make_uint4(0u, 0u, 0u, 0u);
  __syncthreads();
  unsigned long long* probe_t = (unsigned long long*)(smem + 18436);
  int pcnt = 0;
  asm volatile("" : "+s"(pcnt));
  probe_tick(pcnt, probe_t);
  ph_mod(PP, smem);
  ph_prep(PP, smem);
  ph_lru_prepw(PP);
  ph_prep_peer(PP);
  grid.sync();
  probe_tick(pcnt, probe_t);
  XcdBarrier xb = xcd_barrier_post(PP.bar, (volatile LAS unsigned*)&xb_words);
  ph_norm_mod(PP, 0, 0, 0, smem, true);
  BARRIER();
#pragma unroll 1
  for (int l = 0; l < 2; ++l) {
    const int t0 = (l == 0) ? 0 : LC;
    { const P lp = PP; gemm_bf16_128(lp, lp.hb, lp.w_in_t + (size_t)l * 1024 * DIN, 1024, 0, TT, DIN, (char*)smem, EpiProjSplit{}); }
    BARRIER();
    ph_qknorm_rope2(PP, l);
    BARRIER();
    ph_lru<1>(PP, l, (char*)smem);
    ph_attn(PP, l, (char*)smem);
    BARRIER();
    ph_lru_carry(PP, smem);
    BARRIER();
    ph_lru<2>(PP, l, (char*)smem);
    BARRIER();
    { const P lp = PP; gemm_bf16_128(lp, lp.mixb, lp.w_out_t + (size_t)l * 1024 * 1024, 1024, t0, TT, 1024, (char*)smem, EpiResid{l, 2048}); }
    BARRIER();
    ph_norm_mod(PP, l, 1, t0, smem);
    BARRIER();
    { const P lp = PP; gemm_bf16_128(lp, lp.hb, lp.wq_t + (size_t)l * 1024 * NPQ, 1024, t0, TT, NPQ, (char*)smem, EpiPeerTopk{l}); }
    BARRIER();
    ph_peer_apply2(PP, l, t0, (char*)smem);
    if (l == 0) {
      BARRIER();
      ph_norm_mod(PP, 1, 0, 0, smem);
      BARRIER();
    }
  }
  if (PROBE_IV >= 0) {
    probe_tick(pcnt, probe_t);
    __syncthreads();
    if (blockIdx.x == 0 && threadIdx.x == 0) {
      const unsigned long long dt = (probe_t[1] - probe_t[0]) * 8ull, ts = __builtin_amdgcn_s_memrealtime();
      while (__builtin_amdgcn_s_memrealtime() - ts < dt) __builtin_amdgcn_s_sleep(8);
    }
  }
}

extern "C" void kernel_launch(void* const* d_in, const int* in_sizes, int n_in, void* d_out, int out_size, void* d_ws,
                              size_t ws_size, hipStream_t stream) {
  P p{};
  const float** fp = (const float**)&p;
  for (int i = 0; i < 28; ++i) fp[i] = (const float*)d_in[i];
  p.out = (float*)d_out;
  float* w = (float*)d_ws;
  size_t o = 0;
  auto carve = [&](size_t n) { float* r = w + o; o += (n + 63) & ~(size_t)63; return r; };
  p.bar = (unsigned*)carve(4096);
  p.mod = carve(4 * 6144);
  p.xall = carve((size_t)TT * 1024);
  p.proj = carve((size_t)TT * 512);
  p.projb = (bf16_t*)carve((size_t)TT * DIN / 2);
  p.mixb = (bf16_t*)carve((size_t)TT * 512);
  p.hb = (bf16_t*)carve((size_t)TT * 512);
  p.w_in_t = (bf16_t*)carve((size_t)1024 * DIN);
  p.w_out_t = (bf16_t*)carve((size_t)1024 * 1024);
  p.wq_t = (bf16_t*)carve((size_t)1024 * NPQ);
  p.lruw_t = (bf16_t*)carve((size_t)2 * 2 * 4 * 2 * 4096 / 2);
  p.lagg = carve((size_t)2 * NCHUNK * 256 * 2);
  p.lcarry = carve((size_t)2 * NCHUNK * 256);
  p.pk = (unsigned*)carve((size_t)TT * 256);
  p.ub8 = (unsigned char*)carve((size_t)2 * 16384 * 1024 / 4);
  p.vb8 = (unsigned char*)carve((size_t)2 * 16384 * 1024 / 4);
  p.usc = carve(2 * 16384);
  p.vsc = carve(2 * 16384);
  p.k1b = (bf16_t*)carve(16384);
  p.k2b = (bf16_t*)carve(16384);
  if (o * 4 > ws_size) { fprintf(stderr, "workspace too small: need %zu have %zu\n", o * 4, ws_size); return; }
  static int grid_blocks = 0;
  if (!grid_blocks) {
    int dev = 0, cus = 0, per_cu = 0;
    (void)hipGetDevice(&dev);
    (void)hipDeviceGetAttribute(&cus, hipDeviceAttributeMultiprocessorCount, dev);
    (void)hipOccupancyMaxActiveBlocksPerMultiprocessor(&per_cu, k_mega, 256, 0);
    if (per_cu > 2) per_cu = 2;
    grid_blocks = cus * per_cu;
  }
  (void)hipMemsetAsync(p.bar, 0, XCD_BAR_WORDS * 4, stream);
  void* args[] = {&p};
  hipError_t e = hipLaunchCooperativeKernel((void*)k_mega, dim3(grid_blocks), dim3(256), args, 0, stream);
  if (e != hipSuccess) fprintf(stderr, "cooperative launch failed: %s (grid %d)\n", hipGetErrorString(e), grid_blocks);
}
```

```cpp
#include <hip/hip_runtime.h>
#include <hip/hip_cooperative_groups.h>
#include <stdint.h>
#include <stdio.h>
namespace cg = cooperative_groups;

#ifndef SINGLE_LAUNCH
#define SINGLE_LAUNCH 1
#endif

constexpr int DM = 1024, SEQ = 16384, LC = 256, TT = SEQ + LC, DIN = 2304, NPQ = 2048;
constexpr int OFF_XA = 0, OFF_GA = 256, OFF_QW = 512, OFF_KW = 896, OFF_VW = 1024, OFF_QN = 1152, OFF_KN = 1536, OFF_VN = 1920;
constexpr float EPS = 1e-6f;
constexpr float LOG2E = 1.4426950408889634f;
constexpr float QSCALE = 0.125f * LOG2E;

struct P {
  const float *x, *c, *ctx, *c_ctx, *w_mod, *b_mod, *norm1_g, *norm2_g, *w_in, *w_out,
      *conv_w, *conv_b, *wa, *ba, *wx, *bx, *lam, *win_qn, *win_kn, *win_sink, *na_qn, *na_kn, *rpb,
      *wq, *k1, *k2, *pu, *pv;
  float* out;
  float *mod, *xall, *proj;
  unsigned short* projb;
  unsigned* pk;
  unsigned* bar;
  unsigned short *k1b, *k2b;
  unsigned char *ub8, *vb8;
  float *usc, *vsc;
  unsigned short *hb, *mixb, *w_in_t, *w_out_t, *wq_t, *lruw_t;
  float *lagg, *lcarry, *ropetab;
};

typedef unsigned short bf16_t;
typedef __attribute__((ext_vector_type(8))) short bf16x8;
typedef __attribute__((ext_vector_type(4))) float f32x4;
__device__ __forceinline__ unsigned short f2bf(float f) {
  unsigned u = __float_as_uint(f);
  u += 0x7fffu + ((u >> 16) & 1u);
  return (unsigned short)(u >> 16);
}
__device__ __forceinline__ unsigned pack2bf(float a, float b) { return (unsigned)f2bf(a) | ((unsigned)f2bf(b) << 16); }
__device__ __forceinline__ float bf2f(unsigned short h) { return __uint_as_float(((unsigned)h) << 16); }


__device__ __forceinline__ float silu_f(float x) { return x / (1.f + __expf(-x)); }
__device__ __forceinline__ float sigmoid_f(float x) { return 1.f / (1.f + __expf(-x)); }
__device__ __forceinline__ float gelu_f(float x) {
  float u = 0.7978845608028654f * (x + 0.044715f * x * x * x);
  float e = __expf(2.f * u);
  float th = 1.f - 2.f / (e + 1.f);
  return 0.5f * x * (1.f + th);
}
template <int CTRL, int RMASK>
__device__ __forceinline__ float dpp_mov(float v) {
  return __int_as_float(__builtin_amdgcn_update_dpp(0, __float_as_int(v), CTRL, RMASK, 0xf, false));
}
__device__ __forceinline__ float wave_sum(float v) {
  v += dpp_mov<0xB1, 0xf>(v);
  v += dpp_mov<0x4E, 0xf>(v);
  v += dpp_mov<0x141, 0xf>(v);
  v += dpp_mov<0x140, 0xf>(v);
  v += dpp_mov<0x142, 0xa>(v);
  v += dpp_mov<0x143, 0xc>(v);
  return __int_as_float(__builtin_amdgcn_readlane(__float_as_int(v), 63));
}

__device__ __forceinline__ int tid_opaque() { int t = threadIdx.x; asm volatile("" : "+v"(t)); return t; }
#define GTID (blockIdx.x * blockDim.x + tid_opaque())
#define GSZ (gridDim.x * blockDim.x)

__device__ __forceinline__ void ph_mod(const P& p, float* smem) {
  const int tid = tid_opaque(), cl = tid & 31, ks = tid >> 5;
  for (int it = blockIdx.x; it < 2 * 192; it += gridDim.x) {
    const int nc = it % 192, l = it / 192;
    const int n = nc * 32 + cl;
    const float* w = p.w_mod + (size_t)l * 1024 * 6144 + n;
    float a0 = 0.f, a1 = 0.f;
#pragma unroll 8
    for (int i = 0; i < 128; ++i) {
      int k = i * 8 + ks;
      float wv = w[(size_t)k * 6144];
      a0 += silu_f(p.c[k]) * wv;
      a1 += silu_f(p.c_ctx[k]) * wv;
    }
    __syncthreads();
    smem[tid] = a0; smem[256 + tid] = a1;
    __syncthreads();
    if (tid < 64) {
      const int which = tid >> 5;
      float s = p.b_mod[l * 6144 + n];
#pragma unroll
      for (int q = 0; q < 8; ++q) s += smem[which * 256 + q * 32 + cl];
      p.mod[(l * 2 + which) * 6144 + n] = s;
    }
  }
}

__device__ __forceinline__ void ph_copy_in(const P& p) {
  const float4* xs = (const float4*)p.x;
  const float4* cs = (const float4*)p.ctx;
  float4* d = (float4*)p.xall;
  for (int i = GTID; i < TT * 256; i += GSZ) d[i] = (i < LC * 256) ? cs[i] : xs[i - LC * 256];
}

__device__ __forceinline__ void ph_copy_out(const P& p) {
  const float4* s = (const float4*)(p.xall + (size_t)LC * 1024);
  float4* d = (float4*)p.out;
  for (int i = GTID; i < SEQ * 256; i += GSZ) d[i] = s[i];
}

__device__ __forceinline__ void ph_norm_mod(const P& p, int l, int which_norm, int t0, float* smem, bool from_input = false) {
  const float* g = (which_norm ? p.norm2_g : p.norm1_g) + l * 1024;
  const int sh_off = which_norm ? 3072 : 0, sc_off = which_norm ? 4096 : 1024;
  const int tid = tid_opaque();
  for (int t = t0 + blockIdx.x; t < TT; t += gridDim.x) {
    const float* mod = p.mod + (l * 2 + (t < LC ? 1 : 0)) * 6144;
    float4 v;
    if (from_input) {
      v = t < LC ? ((const float4*)(p.ctx + (size_t)t * 1024))[tid] : ((const float4*)(p.x + (size_t)(t - LC) * 1024))[tid];
      ((float4*)(p.xall + (size_t)t * 1024))[tid] = v;
    } else v = ((const float4*)(p.xall + (size_t)t * 1024))[tid];
    float ss = wave_sum(v.x * v.x + v.y * v.y + v.z * v.z + v.w * v.w);
    __syncthreads();
    if ((tid & 63) == 0) smem[tid >> 6] = ss;
    __syncthreads();
    float tot = smem[0] + smem[1] + smem[2] + smem[3];
    float rinv = rsqrtf(tot * (1.f / 1024.f) + EPS);
    float4 gg = ((const float4*)g)[tid];
    float4 sc = ((const float4*)(mod + sc_off))[tid];
    float4 sh = ((const float4*)(mod + sh_off))[tid];
    float4 o;
    o.x = v.x * rinv * gg.x * (1.f + sc.x) + sh.x;
    o.y = v.y * rinv * gg.y * (1.f + sc.y) + sh.y;
    o.z = v.z * rinv * gg.z * (1.f + sc.z) + sh.z;
    o.w = v.w * rinv * gg.w * (1.f + sc.w) + sh.w;
    ((uint2*)(p.hb + (size_t)t * 1024))[tid] = make_uint2(pack2bf(o.x, o.y), pack2bf(o.z, o.w));
  }
}

__device__ __forceinline__ void prep_transpose(const float* W, bf16_t* Wt, int K, int N, int item0, int nitems_total, float* smem) {
  (void)nitems_total;
  float(*ts)[65] = (float(*)[65])smem;
  const int tid = tid_opaque();
  const int tn = N / 64, nt = (K / 64) * tn;
  for (int it = blockIdx.x; it < nt; it += gridDim.x) {
    int k0 = (it / tn) * 64, n0 = (it % tn) * 64;
    __syncthreads();
#pragma unroll
    for (int i = 0; i < 16; ++i) {
      int r = (tid >> 6) + i * 4, c = tid & 63;
      ts[r][c] = W[(size_t)(k0 + r) * N + n0 + c];
    }
    __syncthreads();
#pragma unroll
    for (int i = 0; i < 16; ++i) {
      int r = (tid >> 6) + i * 4, c = tid & 63;
      Wt[(size_t)(n0 + r) * K + k0 + c] = f2bf(ts[c][r]);
    }
  }
  (void)item0;
}

__device__ __forceinline__ void ph_prep(const P& p, float* smem) {
  for (int l = 0; l < 2; ++l) {
    prep_transpose(p.w_in + (size_t)l * 1024 * DIN, p.w_in_t + (size_t)l * 1024 * DIN, 1024, DIN, 0, 0, smem);
    prep_transpose(p.w_out + (size_t)l * 1024 * 1024, p.w_out_t + (size_t)l * 1024 * 1024, 1024, 1024, 0, 0, smem);
    prep_transpose(p.wq + (size_t)l * 1024 * NPQ, p.wq_t + (size_t)l * 1024 * NPQ, 1024, NPQ, 0, 0, smem);
  }
}

struct EpiStoreF32 {
  float* C; int ldc;
  __device__ __forceinline__ void operator()(const P& p, f32x4 (&acc)[4][4], int m0, int n0, int wm, int wn, int lane, char* smem) const {
    const int mw0 = m0 + wm * 64, nw0 = n0 + wn * 64;
#pragma unroll
    for (int i = 0; i < 4; ++i)
#pragma unroll
      for (int r = 0; r < 4; ++r) {
        int row = mw0 + 16 * i + (lane >> 4) * 4 + r;
#pragma unroll
        for (int j = 0; j < 4; ++j) C[(size_t)row * ldc + nw0 + 16 * j + (lane & 15)] = acc[i][j][r];
      }
  }
};
struct EpiProjSplit {
  __device__ __forceinline__ void operator()(const P& p, f32x4 (&acc)[4][4], int m0, int n0, int wm, int wn, int lane, char* smem) const {
    const int mw0 = m0 + wm * 64, nw0 = n0 + wn * 64;
#pragma unroll
    for (int i = 0; i < 4; ++i)
#pragma unroll
      for (int r = 0; r < 4; ++r) {
        int row = mw0 + 16 * i + (lane >> 4) * 4 + r;
#pragma unroll
        for (int j = 0; j < 4; ++j) {
          int col = nw0 + 16 * j + (lane & 15);
          if (n0 < 512) p.proj[(size_t)row * 512 + col] = acc[i][j][r];
          else p.projb[(size_t)row * DIN + col] = f2bf(acc[i][j][r]);
        }
      }
  }
};
__device__ __forceinline__ void ph_rope_tab(const P& p) {
  for (int idx = GTID; idx < 320 * 16; idx += GSZ) {
    int v = idx >> 4, j = idx & 15;
    float inv = __expf(-(float)j * (1.f / 16.f) * 9.210340371976184f);
    float ang = (float)(v < 256 ? v : v - 256) * inv;
    float k = rintf(ang * 0.15915494309189535f);
    float r = fmaf(-k, 6.2831854820251465f, ang);
    r = fmaf(-k, -1.7484555e-07f, r);
    ((float2*)p.ropetab)[idx] = make_float2(__cosf(r), __sinf(r));
  }
}

template <int CTRL>
__device__ __forceinline__ float dpp_row(float v) {
  return __int_as_float(__builtin_amdgcn_update_dpp(0, __float_as_int(v), CTRL, 0xf, 0xf, false));
}
struct EpiProj {
  int l;
  __device__ __forceinline__ void operator()(const P& p, f32x4 (&acc)[4][4], int m0, int n0, int wm, int wn, int lane, char* smem) const {
    const int g = lane >> 4, lr = lane & 15;
    const int mw0 = m0 + wm * 64, nw0 = n0 + wn * 64;
    if (n0 < 512) {
#pragma unroll
      for (int i = 0; i < 4; ++i)
#pragma unroll
        for (int r = 0; r < 4; ++r) {
          int row = mw0 + 16 * i + 4 * g + r;
#pragma unroll
          for (int j = 0; j < 4; ++j) p.proj[(size_t)row * 512 + nw0 + 16 * j + lr] = acc[i][j][r];
        }
      return;
    }
    const float* gain = nullptr; bool rope = false; float scale = 1.f;
    if (nw0 < 896) { gain = p.win_qn + l * 64; rope = true; scale = QSCALE; }
    else if (nw0 < 1024) { gain = p.win_kn + l * 64; rope = true; }
    else if (nw0 < 1152) { }
    else if (nw0 < 1536) { gain = p.na_qn + l * 64; scale = QSCALE; }
    else if (nw0 < 1920) { gain = p.na_kn + l * 64; }
    rope = rope && (m0 >= LC);
    float gj[4] = {1.f, 1.f, 1.f, 1.f};
    if (gain) {
#pragma unroll
      for (int j = 0; j < 4; ++j) gj[j] = gain[16 * j + lr] * scale;
    }
#pragma unroll
    for (int i = 0; i < 4; ++i)
#pragma unroll
      for (int r = 0; r < 4; ++r) {
        const int row = mw0 + 16 * i + 4 * g + r;
        float y[4] = {acc[i][0][r], acc[i][1][r], acc[i][2][r], acc[i][3][r]};
        if (gain) {
          float ss = y[0] * y[0] + y[1] * y[1] + y[2] * y[2] + y[3] * y[3];
          ss += dpp_row<0xB1>(ss);
          ss += dpp_row<0x4E>(ss);
          ss += dpp_row<0x141>(ss);
          ss += dpp_row<0x140>(ss);
          const float rinv = rsqrtf(ss * (1.f / 64.f) + EPS);
#pragma unroll
          for (int j = 0; j < 4; ++j) y[j] *= rinv * gj[j];
        }
        if (rope) {
          const int pos = row - LC;
          const float2 tr = ((const float2*)p.ropetab)[(pos >> 6) * 16 + lr];
          const float2 tc = ((const float2*)p.ropetab)[(256 + (pos & 63)) * 16 + lr];
          float a0 = y[0] * tr.x - y[1] * tr.y, a1 = y[0] * tr.y + y[1] * tr.x;
          float a2 = y[2] * tc.x - y[3] * tc.y, a3 = y[2] * tc.y + y[3] * tc.x;
          y[0] = a0; y[1] = a1; y[2] = a2; y[3] = a3;
        }
#pragma unroll
        for (int j = 0; j < 4; ++j) p.projb[(size_t)row * DIN + nw0 + 16 * j + lr] = f2bf(y[j]);
      }
  }
};
struct EpiResid {
  int l, gofs;
  __device__ __forceinline__ void operator()(const P& p, f32x4 (&acc)[4][4], int m0, int n0, int wm, int wn, int lane, char* smem) const {
    const int mw0 = m0 + wm * 64, nw0 = n0 + wn * 64;
#pragma unroll
    for (int i = 0; i < 4; ++i)
#pragma unroll
      for (int r = 0; r < 4; ++r) {
        int row = mw0 + 16 * i + (lane >> 4) * 4 + r;
        const float* gt = p.mod + (l * 2 + (row < LC ? 1 : 0)) * 6144 + gofs;
#pragma unroll
        for (int j = 0; j < 4; ++j) {
          int col = nw0 + 16 * j + (lane & 15);
          p.xall[(size_t)row * 1024 + col] += gt[col] * acc[i][j][r];
        }
      }
  }
};

__device__ __forceinline__ int gemm_swz(int row) { return (0x78 >> (((row >> 2) & 3) * 2)) & 3; }
template <class Epi>
__device__ __forceinline__ void gemm_bf16_128(const P& p, const bf16_t* __restrict__ A, const bf16_t* __restrict__ Bt, int K, int m_begin, int m_end,
                              int N, char* smem, const Epi& epi) {
  const int tid = tid_opaque(), lane = tid & 63, wv = __builtin_amdgcn_readfirstlane(tid >> 6), wm = wv >> 1, wn = wv & 1;
  const int tiles_n = N / 128, tiles_m = (m_end - m_begin) / 128;
  const int nk = K / 32;
  const int lr = lane & 15, g = lane >> 4;
  const int a_rd = (wm * 64 + lr) * 64 + ((g ^ gemm_swz(lr)) << 4);
  const int b_rd = 8192 + (wn * 64 + lr) * 64 + ((g ^ gemm_swz(lr)) << 4);
  const int ld_row = lane >> 2, ld_c = (lane & 3) ^ gemm_swz(ld_row);
  for (int tile = blockIdx.x; tile < tiles_m * tiles_n; tile += gridDim.x) {
    const int m0 = m_begin + (tile / tiles_n) * 128, n0 = (tile % tiles_n) * 128;
    f32x4 acc[4][4];
#pragma unroll
    for (int i = 0; i < 4; ++i)
#pragma unroll
      for (int j = 0; j < 4; ++j) acc[i][j] = (f32x4){0.f, 0.f, 0.f, 0.f};
    const bf16_t* Ag = A + (size_t)(m0 + wv * 32 + ld_row) * K + ld_c * 8;
    const bf16_t* Bg = Bt + (size_t)(n0 + wv * 32 + ld_row) * K + ld_c * 8;
    auto issue = [&](int st, int kt) {
      char* base = smem + st * 16384 + wv * 2048;
#pragma unroll
      for (int i = 0; i < 2; ++i) {
        __builtin_amdgcn_global_load_lds((const unsigned*)(Ag + (size_t)i * 16 * K + kt * 32), (__attribute__((address_space(3))) unsigned*)(base + i * 1024), 16, 0, 0);
        __builtin_amdgcn_global_load_lds((const unsigned*)(Bg + (size_t)i * 16 * K + kt * 32), (__attribute__((address_space(3))) unsigned*)(base + 8192 + i * 1024), 16, 0, 0);
      }
    };
    issue(0, 0); issue(1, 1); issue(2, 2);
    for (int kt0 = 0; kt0 < nk; kt0 += 4) {
#pragma unroll
      for (int u = 0; u < 4; ++u) {
        const int kt = kt0 + u, rem = nk - kt;
        if (rem >= 3) asm volatile("s_waitcnt vmcnt(8) lgkmcnt(0)" ::: "memory");
        else if (rem == 2) asm volatile("s_waitcnt vmcnt(4) lgkmcnt(0)" ::: "memory");
        else asm volatile("s_waitcnt vmcnt(0) lgkmcnt(0)" ::: "memory");
        __builtin_amdgcn_s_barrier();
        if (kt + 3 < nk) issue((u + 3) & 3, kt + 3);
        bf16x8 af[4], bfr[4];
#pragma unroll
        for (int i = 0; i < 4; ++i) af[i] = *(const bf16x8*)(smem + u * 16384 + a_rd + i * 1024);
#pragma unroll
        for (int j = 0; j < 4; ++j) bfr[j] = *(const bf16x8*)(smem + u * 16384 + b_rd + j * 1024);
#pragma unroll
        for (int i = 0; i < 4; ++i)
#pragma unroll
          for (int j = 0; j < 4; ++j) acc[i][j] = __builtin_amdgcn_mfma_f32_16x16x32_bf16(af[i], bfr[j], acc[i][j], 0, 0, 0);
      }
    }
    __syncthreads();
    epi(p, acc, m0, n0, wm, wn, lane, smem);
    __syncthreads();
  }
}

constexpr int NCHUNK = TT / 64;
__device__ __forceinline__ int lru_pos(int dir, int c) { return dir == 0 ? c : (c < 4 ? 3 - c : 4 + (NCHUNK - 1 - c)); }

__device__ __forceinline__ void ph_lru_prepw(const P& p) {
  for (int idx = GTID; idx < 2 * 2 * 4 * 2 * 4096; idx += GSZ) {
    int d = idx & 63, e = (idx >> 6) & 63, mtx = (idx >> 12) & 1, rest = idx >> 13;
    const float* w = (mtx ? p.wx : p.wa) + (size_t)rest * 4096;
    p.lruw_t[idx] = f2bf(w[d * 64 + e]);
  }
}

template <int PASS>
__device__ __forceinline__ void lru_item(const P& p, int l, int cidx, int kb, char* smem) {
  bf16_t* u_img = (bf16_t*)smem;
  float* ab_a = (float*)(smem + 8192);
  float* ab_b = (float*)(smem + 8192 + 16384);
  float* hsum = (float*)(smem + 8192 + 32768);
  float* segagg = (float*)(smem + 8192 + 49152);
  float* ccarry = (float*)(smem + 8192 + 49152 + 2048);
  const int tid = tid_opaque(), lane = tid & 63, wv = tid >> 6, g = lane >> 4, lr = lane & 15;
  const int t0 = cidx * 64;
  const int lo = t0 < LC ? 0 : LC, hi = t0 < LC ? LC : TT;
  __syncthreads();
  {
    const int ch = tid & 63, c = kb * 64 + ch;
    const float cb = p.conv_b[l * 256 + c];
    float cw[4];
#pragma unroll
    for (int k = 0; k < 4; ++k) cw[k] = p.conv_w[(l * 4 + k) * 256 + c];
#pragma unroll
    for (int i = 0; i < 16; ++i) {
      int row = (tid >> 6) + 4 * i, t = t0 + row;
      float acc = cb;
#pragma unroll
      for (int k = 0; k < 4; ++k) {
        int tt = t + k - 2;
        if (tt >= lo && tt < hi) acc += cw[k] * p.proj[(size_t)tt * 512 + OFF_XA + c];
      }
      u_img[row * 64 + ((((ch >> 3) ^ (row & 7)) << 3) | (ch & 7))] = f2bf(acc);
    }
  }
  if (PASS == 2) {
    if (tid < 128) {
      const int ch = tid & 63, dir = tid >> 6;
      ccarry[dir * 64 + ch] = p.lcarry[((size_t)dir * NCHUNK + lru_pos(dir, cidx)) * 256 + kb * 64 + ch];
    }
  }
  __syncthreads();
  for (int dir = 0; dir < 2; ++dir) {
    const int pd = l * 2 + dir;
    {
      f32x4 ga[4], gx[4];
#pragma unroll
      for (int i = 0; i < 4; ++i) { ga[i] = (f32x4){0.f, 0.f, 0.f, 0.f}; gx[i] = (f32x4){0.f, 0.f, 0.f, 0.f}; }
      const bf16_t* wbase = p.lruw_t + (size_t)((pd * 4 + kb) * 2) * 4096 + (16 * wv + lr) * 64 + 8 * g;
#pragma unroll
      for (int s = 0; s < 2; ++s) {
        bf16x8 ba_ = *(const bf16x8*)(wbase + 32 * s);
        bf16x8 bx_ = *(const bf16x8*)(wbase + 4096 + 32 * s);
#pragma unroll
        for (int i = 0; i < 4; ++i) {
          int row = 16 * i + lr;
          bf16x8 af = *(const bf16x8*)((const char*)u_img + row * 128 + (((4 * s + g) ^ (row & 7)) << 4));
          ga[i] = __builtin_amdgcn_mfma_f32_16x16x32_bf16(af, ba_, ga[i], 0, 0, 0);
          gx[i] = __builtin_amdgcn_mfma_f32_16x16x32_bf16(af, bx_, gx[i], 0, 0, 0);
        }
      }
      const int ch = 16 * wv + lr, c = kb * 64 + ch;
      const float bav = p.ba[pd * 256 + c], bxv = p.bx[pd * 256 + c];
      const float sp = log1pf(expf(-p.lam[pd * 256 + c]));
#pragma unroll
      for (int i = 0; i < 4; ++i)
#pragma unroll
        for (int r = 0; r < 4; ++r) {
          int row = 16 * i + 4 * g + r;
          float rr = sigmoid_f(ga[i][r] + bav), ig = sigmoid_f(gx[i][r] + bxv);
          float log_a = -8.f * rr * sp;
          float a = __expf(log_a);
          float uu = bf2f(u_img[row * 64 + ((((ch >> 3) ^ (row & 7)) << 3) | (ch & 7))]);
          float b = sqrtf(-expm1f(2.f * log_a)) * ig * uu;
          ab_a[row * 64 + ch] = a;
          ab_b[row * 64 + ch] = b;
        }
    }
    __syncthreads();
    {
      const int ch = tid & 63, seg = tid >> 6;
      float Pr = 1.f, H = 0.f;
#pragma unroll
      for (int i = 0; i < 16; ++i) {
        int row = dir == 0 ? seg * 16 + i : seg * 16 + 15 - i;
        float a = ab_a[row * 64 + ch], b = ab_b[row * 64 + ch];
        H = a * H + b;
        Pr *= a;
      }
      segagg[(seg * 64 + ch) * 2] = Pr;
      segagg[(seg * 64 + ch) * 2 + 1] = H;
      __syncthreads();
      if (PASS == 1) {
        if (seg == 0) {
          float A = 1.f, B = 0.f;
#pragma unroll
          for (int s2 = 0; s2 < 4; ++s2) {
            int sg = dir == 0 ? s2 : 3 - s2;
            float pa = segagg[(sg * 64 + ch) * 2], pb = segagg[(sg * 64 + ch) * 2 + 1];
            B = pa * B + pb;
            A *= pa;
          }
          float2* ag = (float2*)p.lagg + ((size_t)dir * NCHUNK + lru_pos(dir, cidx)) * 256 + kb * 64 + ch;
          *ag = make_float2(A, B);
        }
      } else {
        float h = ccarry[dir * 64 + ch];
#pragma unroll
        for (int s2 = 0; s2 < 3; ++s2) {
          int sg = dir == 0 ? s2 : 3 - s2;
          bool before = dir == 0 ? (sg < seg) : (sg > seg);
          if (before) h = segagg[(sg * 64 + ch) * 2] * h + segagg[(sg * 64 + ch) * 2 + 1];
        }
#pragma unroll
        for (int i = 0; i < 16; ++i) {
          int row = dir == 0 ? seg * 16 + i : seg * 16 + 15 - i;
          float a = ab_a[row * 64 + ch], b = ab_b[row * 64 + ch];
          h = a * h + b;
          if (dir == 0) hsum[row * 64 + ch] = h;
          else {
            int t = t0 + row, c = kb * 64 + ch;
            float gv = p.proj[(size_t)t * 512 + OFF_GA + c];
            p.mixb[(size_t)t * 1024 + c] = f2bf((hsum[row * 64 + ch] + h) * gelu_f(gv));
          }
        }
      }
    }
    __syncthreads();
  }
}

__device__ __forceinline__ void ph_lru_carry(const P& p, float* smem) {
  const int tid = tid_opaque(), seg = tid >> 4, c16 = tid & 15;
  for (int blk = blockIdx.x; blk < 32; blk += gridDim.x) {
    const int dc = blk * 16 + c16, dir = dc >> 8, ch = dc & 255;
    const float2* ag = (const float2*)p.lagg + (size_t)dir * NCHUNK * 256 + ch;
    float2 v[17];
#pragma unroll
    for (int i = 0; i < 17; ++i) {
      int pos = seg * 17 + i;
      v[i] = pos < NCHUNK ? ag[(size_t)pos * 256] : make_float2(1.f, 0.f);
    }
    float A = 1.f, B = 0.f;
#pragma unroll
    for (int i = 0; i < 17; ++i) { B = v[i].x * B + v[i].y; A *= v[i].x; }
    __syncthreads();
    smem[(seg * 16 + c16) * 2] = A; smem[(seg * 16 + c16) * 2 + 1] = B;
    __syncthreads();
    float h = 0.f;
    for (int s2 = 0; s2 < seg; ++s2) h = smem[(s2 * 16 + c16) * 2] * h + smem[(s2 * 16 + c16) * 2 + 1];
    float* cr = p.lcarry + (size_t)dir * NCHUNK * 256 + ch;
#pragma unroll
    for (int i = 0; i < 17; ++i) {
      int pos = seg * 17 + i;
      if (pos < NCHUNK) cr[(size_t)pos * 256] = h;
      h = v[i].x * h + v[i].y;
    }
  }
}

template <int PASS>
__device__ __forceinline__ void ph_lru(const P& p, int l, char* smem) {
  const int c_begin = (PASS == 2 && l == 1) ? 4 : 0;
  const int nitems = (NCHUNK - c_begin) * 4;
  for (int it = blockIdx.x; it < nitems; it += gridDim.x) lru_item<PASS>(p, l, c_begin + (it >> 2), it & 3, smem);
}

typedef __attribute__((ext_vector_type(4))) short s16x4;

__device__ __forceinline__ void ph_qknorm_rope2(const P& p, int l) {
  const int tid_ = tid_opaque();
  const int lane = tid_ & 63;
  const int wpb = blockDim.x >> 6;
  for (int pair = blockIdx.x * wpb + (tid_ >> 6); pair < TT * 28; pair += gridDim.x * wpb) {
    int t = pair / 28, slot = pair % 28;
    const float* g = nullptr; bool rope = false; float scale = 1.f;
    if (slot < 6) { g = p.win_qn + l * 64; rope = true; scale = QSCALE; }
    else if (slot < 8) { g = p.win_kn + l * 64; rope = true; }
    else if (slot < 10) { }
    else if (slot < 16) { g = p.na_qn + l * 64; scale = QSCALE; }
    else if (slot < 22) { g = p.na_kn + l * 64; }
    rope = rope && (t >= LC);
    const size_t idx = (size_t)t * DIN + 512 + slot * 64 + lane;
    float v = bf2f(p.projb[idx]);
    float y = v;
    if (g) {
      float ss = wave_sum(v * v);
      y = v * rsqrtf(ss * (1.f / 64.f) + EPS) * g[lane];
    }
    float partner = __shfl_xor(y, 16);
    if (rope) {
      int pos = t - LC, row = pos >> 6, col = pos & 63;
      int j = lane & 15, axis = lane >> 5;
      float inv = __expf(-(float)j * (1.f / 16.f) * 9.210340371976184f);
      float ang = (float)(axis ? col : row) * inv;
      float k = rintf(ang * 0.15915494309189535f);
      float r = fmaf(-k, 6.2831854820251465f, ang);
      r = fmaf(-k, -1.7484555e-07f, r);
      float cs = __cosf(r), sn = __sinf(r);
      bool first = ((lane >> 4) & 1) == 0;
      y = first ? (y * cs - partner * sn) : (partner * sn + y * cs);
    }
    p.projb[idx] = f2bf(y * scale);
  }
}

template <int CTRL, int RMASK>
__device__ __forceinline__ float dpp_mov_id(float v) {
  return __int_as_float(__builtin_amdgcn_update_dpp(__float_as_int(v), __float_as_int(v), CTRL, RMASK, 0xf, false));
}
__device__ __forceinline__ float wave_max(float v) {
  v = fmaxf(v, dpp_mov_id<0xB1, 0xf>(v));
  v = fmaxf(v, dpp_mov_id<0x4E, 0xf>(v));
  v = fmaxf(v, dpp_mov_id<0x141, 0xf>(v));
  v = fmaxf(v, dpp_mov_id<0x140, 0xf>(v));
  v = fmaxf(v, dpp_mov_id<0x142, 0xa>(v));
  v = fmaxf(v, dpp_mov_id<0x143, 0xc>(v));
  return __int_as_float(__builtin_amdgcn_readlane(__float_as_int(v), 63));
}

struct KVRegs { uint4 k[2], v[2]; };
template <class TokFn>
__device__ __forceinline__ void kv_load(const P& p, KVRegs& r, int koff, int voff, TokFn tok, int tid) {
#pragma unroll
  for (int i = 0; i < 2; ++i) {
    int id = tid + 256 * i, row = id >> 3, c = id & 7;
    const bf16_t* base = p.projb + (size_t)tok(row) * DIN + c * 8;
    r.k[i] = *(const uint4*)(base + koff);
    r.v[i] = *(const uint4*)(base + voff);
  }
}
__device__ __forceinline__ void kv_store(const KVRegs& r, char* stage, int tid) {
#pragma unroll
  for (int i = 0; i < 2; ++i) {
    int id = tid + 256 * i, row = id >> 3, c = id & 7;
    int off = row * 128 + ((c ^ (row & 7)) << 4);
    *(uint4*)(stage + off) = r.k[i];
    *(uint4*)(stage + 8192 + off) = r.v[i];
  }
}

template <class MaskFn>
__device__ __forceinline__ void attn_step(const char* stage, int kr0, const bf16x8 (&qf)[2], f32x4 (&o)[4], float& lsum, MaskFn mb, int lane) {
  const int g = lane >> 4, lr = lane & 15;
  f32x4 st[2];
#pragma unroll
  for (int t2 = 0; t2 < 2; ++t2) {
    st[t2] = (f32x4){0.f, 0.f, 0.f, 0.f};
    const int row = kr0 + 16 * t2 + lr;
#pragma unroll
    for (int s = 0; s < 2; ++s) {
      bf16x8 kf = *(const bf16x8*)(stage + row * 128 + (((4 * s + g) ^ (row & 7)) << 4));
      st[t2] = __builtin_amdgcn_mfma_f32_16x16x32_bf16(kf, qf[s], st[t2], 0, 0, 0);
    }
  }
  bf16x8 pb;
#pragma unroll
  for (int t2 = 0; t2 < 2; ++t2)
#pragma unroll
    for (int r = 0; r < 4; ++r) {
      float pv = exp2f(mb(t2, r, st[t2][r]));
      lsum += pv;
      pb[t2 * 4 + r] = (short)f2bf(pv);
    }
  const int q = lr >> 2, pp = lane & 3;
#pragma unroll
  for (int m = 0; m < 4; ++m) {
    bf16x8 vf;
#pragma unroll
    for (int t = 0; t < 2; ++t) {
      const int row = kr0 + 16 * t + 4 * g + q;
      const char* addr = stage + 8192 + row * 128 + (((2 * m + (pp >> 1)) ^ (row & 7)) << 4) + 8 * (pp & 1);
      s16x4 v4 = __builtin_amdgcn_ds_read_tr16_b64_v4i16((__attribute__((address_space(3))) s16x4*)addr);
      vf[4 * t + 0] = v4[0]; vf[4 * t + 1] = v4[1]; vf[4 * t + 2] = v4[2]; vf[4 * t + 3] = v4[3];
    }
    o[m] = __builtin_amdgcn_mfma_f32_16x16x32_bf16(vf, pb, o[m], 0, 0, 0);
  }
}

__device__ __forceinline__ void attn_store_out(const P& p, const f32x4 (&o)[4], float lsum, int tok, int col0, int lane) {
  const int g = lane >> 4;
  lsum += __shfl_xor(lsum, 16);
  lsum += __shfl_xor(lsum, 32);
  const float inv = 1.f / lsum;
  bf16_t* op = p.mixb + (size_t)tok * 1024 + col0 + 4 * g;
#pragma unroll
  for (int m = 0; m < 4; ++m)
    *(uint2*)(op + 16 * m) = make_uint2(pack2bf(o[m][0] * inv, o[m][1] * inv), pack2bf(o[m][2] * inv, o[m][3] * inv));
}

__device__ __forceinline__ void attn_win_item(const P& p, int l, int kind, int qb, int hs, char* smem) {
  const int tid = tid_opaque(), lane = tid & 63, wv = tid >> 6, g = lane >> 4, lr = lane & 15;
  int qoff, koff, voff, ooff; const float *gq, *gk; float sink2 = -1e30f; bool has_sink = false;
  if (kind == 0 || hs < 6) {
    const int h = hs, kvh = h / 3;
    qoff = OFF_QW + h * 64; koff = OFF_KW + kvh * 64; voff = OFF_VW + kvh * 64; ooff = 256 + h * 64;
    gq = p.win_qn + l * 64; gk = p.win_kn + l * 64; sink2 = p.win_sink[l * 6 + h] * LOG2E; has_sink = true;
  } else {
    const int h = hs - 6;
    qoff = OFF_QN + h * 64; koff = OFF_KN + h * 64; voff = OFF_VN + h * 64; ooff = 640 + h * 64;
    gq = p.na_qn + l * 64; gk = p.na_kn + l * 64;
  }
  float bound = 8.f * LOG2E * wave_max(fabsf(gq[lane])) * wave_max(fabsf(gk[lane])) * 1.0001f + 1e-3f;
  if (has_sink) bound = fmaxf(bound, sink2);
  const int q0 = qb * 64;
  const int qtok = (kind == 0 ? LC : 0) + q0 + 16 * wv + lr;
  bf16x8 qf[2];
#pragma unroll
  for (int s = 0; s < 2; ++s) qf[s] = *(const bf16x8*)(p.projb + (size_t)qtok * DIN + qoff + 32 * s + 8 * g);
  f32x4 o[4];
#pragma unroll
  for (int m = 0; m < 4; ++m) o[m] = (f32x4){0.f, 0.f, 0.f, 0.f};
  float lsum = 0.f;
  const int nloc = (kind == 0) ? 5 : 0, nch = nloc + 4;
  auto tokfn = [&](int c) {
    return [=](int row) {
      if (c < nloc) { int pos = q0 - 128 + 64 * c + row; pos = pos < 0 ? 0 : (pos > SEQ - 1 ? SEQ - 1 : pos); return LC + pos; }
      return 64 * (c - nloc) + row;
    };
  };
  KVRegs kr;
  __syncthreads();
  kv_load(p, kr, koff, voff, tokfn(0), tid);
  kv_store(kr, smem, tid);
  __syncthreads();
  for (int c = 0; c < nch; ++c) {
    const char* stage = smem + (c & 1) * 16384;
    if (c + 1 < nch) kv_load(p, kr, koff, voff, tokfn(c + 1), tid);
    if (c < nloc) {
      const int qpos = q0 + 16 * wv + lr;
#pragma unroll
      for (int st = 0; st < 2; ++st) {
        const int kbase = q0 - 128 + 64 * c + 32 * st;
        attn_step(stage, 32 * st, qf, o, lsum, [&](int t2, int r, float s) {
          int kpos = kbase + 16 * t2 + 4 * g + r;
          int dlt = kpos - qpos; dlt = dlt < 0 ? -dlt : dlt;
          bool valid = (kpos >= 0) && (kpos < SEQ) && (dlt <= 128);
          return valid ? s - bound : -1e30f;
        }, lane);
      }
    } else {
#pragma unroll
      for (int st = 0; st < 2; ++st) attn_step(stage, 32 * st, qf, o, lsum, [&](int t2, int r, float s) { return s - bound; }, lane);
    }
    if (c + 1 < nch) kv_store(kr, smem + ((c + 1) & 1) * 16384, tid);
    __syncthreads();
  }
  if (has_sink && g == 0) lsum += exp2f(sink2 - bound);
  attn_store_out(p, o, lsum, qtok, ooff, lane);
}

__device__ __forceinline__ void attn_na_item(const P& p, int l, int r, int h, char* smem) {
  const int tid = tid_opaque(), lane = tid & 63, wv = tid >> 6, g = lane >> 4, lr = lane & 15;
  const int qoff = OFF_QN + h * 64, koff = OFF_KN + h * 64, voff = OFF_VN + h * 64, ooff = 640 + h * 64;
  float* rpbl = (float*)(smem + 32768);
  const float* rpbg = p.rpb + (size_t)(l * 6 + h) * 465;
  float bmax = 0.f;
  __syncthreads();
  for (int i = tid; i < 465; i += 256) { float b = rpbg[i] * LOG2E; rpbl[i] = b; }
  for (int i = lane; i < 465; i += 64) bmax = fmaxf(bmax, fabsf(rpbg[i]) * LOG2E);
  bmax = wave_max(bmax);
  const float bound = 8.f * LOG2E * wave_max(fabsf(p.na_qn[l * 64 + lane])) * wave_max(fabsf(p.na_kn[l * 64 + lane])) * 1.0001f + bmax + 1e-3f;
  const int qcol = 16 * wv + lr;
  const int qtok = LC + r * 64 + qcol;
  const int kr0r = min(max(r - 4, 0), 248);
  const int kc0 = min(max(16 * wv - 8, 0), 32);
  const int qs = min(max(qcol - 8, 0), 48);
  bf16x8 qf[2];
#pragma unroll
  for (int s = 0; s < 2; ++s) qf[s] = *(const bf16x8*)(p.projb + (size_t)qtok * DIN + qoff + 32 * s + 8 * g);
  f32x4 o[4];
#pragma unroll
  for (int m = 0; m < 4; ++m) o[m] = (f32x4){0.f, 0.f, 0.f, 0.f};
  float lsum = 0.f;
  auto tokfn = [&](int c) {
    return [=](int row) { return c < 8 ? LC + (kr0r + c) * 64 + row : 64 * (c - 8) + row; };
  };
  KVRegs kr;
  kv_load(p, kr, koff, voff, tokfn(0), tid);
  kv_store(kr, smem, tid);
  __syncthreads();
  for (int c = 0; c < 12; ++c) {
    const char* stage = smem + (c & 1) * 16384;
    if (c + 1 < 12) kv_load(p, kr, koff, voff, tokfn(c + 1), tid);
    if (c < 8) {
      const int dr = kr0r + c - r + 7;
      attn_step(stage, kc0, qf, o, lsum, [&](int t2, int rr, float s) {
        int kcol = kc0 + 16 * t2 + 4 * g + rr;
        bool valid = (kcol >= qs) && (kcol < qs + 16);
        int dc = kcol - qcol + 15; dc = dc < 0 ? 0 : (dc > 30 ? 30 : dc);
        return valid ? s + rpbl[dr * 31 + dc] - bound : -1e30f;
      }, lane);
    } else {
#pragma unroll
      for (int st = 0; st < 2; ++st) attn_step(stage, 32 * st, qf, o, lsum, [&](int t2, int rr, float s) { return s - bound; }, lane);
    }
    if (c + 1 < 12) kv_store(kr, smem + ((c + 1) & 1) * 16384, tid);
    __syncthreads();
  }
  attn_store_out(p, o, lsum, qtok, ooff, lane);
}

__device__ __forceinline__ void ph_attn(const P& p, int l, char* smem) {
  const int nitems = 3072 + (l == 0 ? 48 : 0);
  for (int it = blockIdx.x; it < nitems; it += gridDim.x) {
    if (it < 1536) attn_win_item(p, l, 0, it / 6, it % 6, smem);
    else if (it < 3072) { int j = it - 1536; attn_na_item(p, l, j / 6, j % 6, smem); }
    else { int j = it - 3072; attn_win_item(p, l, 1, j / 12, j % 12, smem); }
  }
}

__device__ __forceinline__ unsigned ord_key(float s) {
  unsigned u = __float_as_uint(s);
  return (u & 0x80000000u) ? ~u : (u | 0x80000000u);
}
__device__ __forceinline__ float ord_val(unsigned pk) {
  unsigned u = pk & ~127u;
  unsigned b = (u & 0x80000000u) ? (u & 0x7fffffffu) : ~u;
  return __uint_as_float(b);
}
__device__ __forceinline__ void ce_desc(unsigned& a, unsigned& b) {
  unsigned mx = a > b ? a : b, mn = a > b ? b : a;
  a = mx; b = mn;
}
__device__ __forceinline__ void sort16_desc(unsigned (&v)[16]) {
#pragma unroll
  for (int k = 2; k <= 16; k <<= 1) {
#pragma unroll
    for (int j = k >> 1; j > 0; j >>= 1) {
#pragma unroll
      for (int i = 0; i < 16; ++i) {
        int m = i ^ j;
        if (m > i) {
          if ((i & k) == 0) ce_desc(v[i], v[m]); else ce_desc(v[m], v[i]);
        }
      }
    }
  }
}
__device__ __forceinline__ void merge16_desc(unsigned (&a)[16], const unsigned (&b)[16]) {
#pragma unroll
  for (int i = 0; i < 16; ++i) { unsigned o = b[15 - i]; a[i] = a[i] > o ? a[i] : o; }
#pragma unroll
  for (int j = 8; j > 0; j >>= 1) {
#pragma unroll
    for (int i = 0; i < 16; ++i) {
      int m = i ^ j;
      if (m > i) ce_desc(a[i], a[m]);
    }
  }
}

typedef __attribute__((ext_vector_type(2))) float f32x2;
__device__ __forceinline__ void ph_prep_peer(const P& p) {
  const int tid = tid_opaque(), lane = tid & 63;
  const int nw = gridDim.x * 4;
  for (int row = blockIdx.x * 4 + (tid >> 6); row < 4 * 16384; row += nw) {
    const int tbl = row >> 15, le = row & 32767;
    const float4* src = (const float4*)((tbl ? p.pv : p.pu) + (size_t)le * 1024) + lane * 4;
    float4 v[4];
    float am = 0.f;
#pragma unroll
    for (int i = 0; i < 4; ++i) {
      v[i] = src[i];
      am = fmaxf(am, fmaxf(fmaxf(fabsf(v[i].x), fabsf(v[i].y)), fmaxf(fabsf(v[i].z), fabsf(v[i].w))));
    }
    am = wave_max(am);
    const float sc = am > 0.f ? 224.f / am : 1.f;
    unsigned w[4];
#pragma unroll
    for (int i = 0; i < 4; ++i) {
      int t = __builtin_amdgcn_cvt_pk_fp8_f32(v[i].x * sc, v[i].y * sc, 0, false);
      t = __builtin_amdgcn_cvt_pk_fp8_f32(v[i].z * sc, v[i].w * sc, t, true);
      w[i] = (unsigned)t;
    }
    ((uint4*)((tbl ? p.vb8 : p.ub8) + (size_t)le * 1024))[lane] = make_uint4(w[0], w[1], w[2], w[3]);
    if (lane == 0) (tbl ? p.vsc : p.usc)[le] = am > 0.f ? am / 224.f : 1.f;
  }
  for (int i = GTID; i < 2 * 128 * 128; i += GSZ) { p.k1b[i] = f2bf(p.k1[i]); p.k2b[i] = f2bf(p.k2[i]); }
}

struct EpiPeerTopk {
  int l;
  __device__ __forceinline__ void operator()(const P& p, f32x4 (&acc)[4][4], int m0, int n0, int wm, int wn, int lane, char* smem) const {
    const int tid = ((wm * 2 + wn) << 6) | lane, g = lane >> 4, lr = lane & 15;
    const int nt = n0 >> 7, head = nt >> 1, hf = nt & 1;
    char* qimg = smem;
    char* kimg = smem + 34816;
    {
      char* qw = qimg + (wm * 64 + 4 * g) * 272 + (wn * 64 + lr) * 2;
#pragma unroll
      for (int i = 0; i < 4; ++i)
#pragma unroll
        for (int r = 0; r < 4; ++r)
#pragma unroll
          for (int j = 0; j < 4; ++j) *(bf16_t*)(qw + (16 * i + r) * 272 + 32 * j) = f2bf(acc[i][j][r]);
      const bf16_t* kk = (hf ? p.k2b : p.k1b) + (size_t)l * 16384 + (tid >> 4) * 128 + (tid & 15) * 8;
      char* kw = kimg + (tid >> 4) * 272 + (tid & 15) * 16;
#pragma unroll
      for (int i = 0; i < 8; ++i) *(uint4*)(kw + i * 16 * 272) = *(const uint4*)(kk + i * 16 * 128);
    }
    __syncthreads();
#pragma unroll
    for (int i = 0; i < 4; ++i)
#pragma unroll
      for (int j = 0; j < 4; ++j) acc[i][j] = (f32x4){0.f, 0.f, 0.f, 0.f};
    {
      const char* qa = qimg + (wm * 64 + lr) * 272 + g * 16;
      const char* kb = kimg + (wn * 64 + lr) * 272 + g * 16;
#pragma unroll
      for (int s = 0; s < 4; ++s) {
        bf16x8 af[4], bfr[4];
#pragma unroll
        for (int i = 0; i < 4; ++i) af[i] = *(const bf16x8*)(qa + i * 16 * 272 + s * 64);
#pragma unroll
        for (int j = 0; j < 4; ++j) bfr[j] = *(const bf16x8*)(kb + j * 16 * 272 + s * 64);
#pragma unroll
        for (int i = 0; i < 4; ++i)
#pragma unroll
          for (int j = 0; j < 4; ++j) acc[i][j] = __builtin_amdgcn_mfma_f32_16x16x32_bf16(af[i], bfr[j], acc[i][j], 0, 0, 0);
      }
    }
    __syncthreads();
    unsigned* simg = (unsigned*)smem;
    {
      unsigned* sw = simg + (wm * 64 + 4 * g) * 129 + wn * 64 + lr;
#pragma unroll
      for (int i = 0; i < 4; ++i)
#pragma unroll
        for (int r = 0; r < 4; ++r)
#pragma unroll
          for (int j = 0; j < 4; ++j)
            sw[(16 * i + r) * 129 + 16 * j] = (ord_key(acc[i][j][r]) & ~127u) | (unsigned)(wn * 64 + 16 * j + lr);
    }
    __syncthreads();
    const int row = tid & 127, half = tid >> 7;
    unsigned top[16];
    {
      const unsigned* sr = simg + row * 129 + half * 64;
#pragma unroll
      for (int k = 0; k < 16; ++k) top[k] = sr[k];
      sort16_desc(top);
#pragma unroll 1
      for (int gi = 1; gi < 4; ++gi) {
        unsigned v1[16];
#pragma unroll
        for (int k = 0; k < 16; ++k) v1[k] = sr[gi * 16 + k];
        sort16_desc(v1);
        merge16_desc(top, v1);
      }
    }
    __syncthreads();
    if (half == 1) {
#pragma unroll
      for (int k = 0; k < 16; ++k) simg[k * 128 + row] = top[k];
    }
    __syncthreads();
    if (half == 0) {
      unsigned o[16];
#pragma unroll
      for (int k = 0; k < 16; ++k) o[k] = simg[k * 128 + row];
      merge16_desc(top, o);
      uint4* dst = (uint4*)(p.pk + (((size_t)(m0 + row) * 8 + head) * 2 + hf) * 16);
#pragma unroll
      for (int k = 0; k < 4; ++k) dst[k] = make_uint4(top[4 * k], top[4 * k + 1], top[4 * k + 2], top[4 * k + 3]);
    }
  }
};

__device__ const unsigned char CAND_A[64] = {0,0,0,0,0,0,0,0,0,0,0,0,0,0,0,0, 1,1,1,1,1,1,1,1, 2,2,2,2,2, 3,3,3,3, 4,4,4, 5,5, 6,6, 7,7,
                                             8,9,10,11,12,13,14,15, 0,0,0,0,0,0,0,0,0,0,0,0,0,0};
__device__ const unsigned char CAND_B[64] = {0,1,2,3,4,5,6,7,8,9,10,11,12,13,14,15, 0,1,2,3,4,5,6,7, 0,1,2,3,4, 0,1,2,3, 0,1,2, 0,1, 0,1, 0,1,
                                             0,0,0,0,0,0,0,0, 0,0,0,0,0,0,0,0,0,0,0,0,0,0};

__device__ __forceinline__ void ph_peer_apply2(const P& p, int l, int t0, char* smem) {
  const int tid = tid_opaque(), lane = tid & 63, wv = tid >> 6;
  int* lds_e = (int*)(smem + wv * 1024);
  float* lds_g = (float*)(smem + wv * 1024 + 512);
  const unsigned char* U = p.ub8 + (size_t)l * 16384 * 1024;
  const unsigned char* V = p.vb8 + (size_t)l * 16384 * 1024;
  const float* usc = p.usc + l * 16384;
  const float* vsc = p.vsc + l * 16384;
  const float* n2g = p.norm2_g + l * 1024;
  const int ca = CAND_A[lane], cb = CAND_B[lane];
  for (int tk = t0 + blockIdx.x * 4 + wv; tk < TT; tk += gridDim.x * 4) {
    const float* mod = p.mod + (l * 2 + (tk < LC ? 1 : 0)) * 6144;
    float xv[16], hv[16];
    {
      const float4* xp = (const float4*)(p.xall + (size_t)tk * 1024) + lane * 4;
      float ss = 0.f;
#pragma unroll
      for (int q = 0; q < 4; ++q) {
        float4 v = xp[q];
        xv[q * 4 + 0] = v.x; xv[q * 4 + 1] = v.y; xv[q * 4 + 2] = v.z; xv[q * 4 + 3] = v.w;
        ss += v.x * v.x + v.y * v.y + v.z * v.z + v.w * v.w;
      }
      ss = wave_sum(ss);
      float rinv = rsqrtf(ss * (1.f / 1024.f) + EPS);
#pragma unroll
      for (int q = 0; q < 4; ++q) {
        float4 gg = ((const float4*)n2g)[lane * 4 + q], sc = ((const float4*)(mod + 4096))[lane * 4 + q], sh = ((const float4*)(mod + 3072))[lane * 4 + q];
        hv[q * 4 + 0] = xv[q * 4 + 0] * rinv * gg.x * (1.f + sc.x) + sh.x;
        hv[q * 4 + 1] = xv[q * 4 + 1] * rinv * gg.y * (1.f + sc.y) + sh.y;
        hv[q * 4 + 2] = xv[q * 4 + 2] * rinv * gg.z * (1.f + sc.z) + sh.z;
        hv[q * 4 + 3] = xv[q * 4 + 3] * rinv * gg.w * (1.f + sc.w) + sh.w;
      }
    }
    for (int head = 0; head < 8; ++head) {
      const unsigned* pk = p.pk + ((size_t)tk * 8 + head) * 32;
      unsigned p1 = pk[ca], p2 = pk[16 + cb];
      float sum = lane < 50 ? ord_val(p1) + ord_val(p2) : -3.0e38f;
      int eid = (int)(p1 & 127u) * 128 + (int)(p2 & 127u);
      int rank = 0;
      for (int m = 0; m < 50; ++m) {
        float sm = __shfl(sum, m);
        rank += (sm > sum || (sm == sum && m < lane)) ? 1 : 0;
      }
      float mx = wave_max(sum);
      bool sel = (lane < 50) && (rank < 16);
      float e = sel ? __expf(sum - mx) : 0.f;
      float tot = wave_sum(e);
      if (sel) { lds_e[head * 16 + rank] = eid; lds_g[head * 16 + rank] = e / tot; }
    }
    float acc[16];
#pragma unroll
    for (int k = 0; k < 16; ++k) acc[k] = 0.f;
    for (int e0 = 0; e0 < 128; e0 += 8) {
      uint4 ur[8], vr[8];
      float gt[8], us[8], vs[8];
#pragma unroll
      for (int k = 0; k < 8; ++k) {
        int ex = __builtin_amdgcn_readfirstlane(lds_e[e0 + k]);
        gt[k] = lds_g[e0 + k];
        ur[k] = ((const uint4*)(U + (size_t)ex * 1024))[lane];
        vr[k] = ((const uint4*)(V + (size_t)ex * 1024))[lane];
        us[k] = usc[ex]; vs[k] = vsc[ex];
      }
#pragma unroll
      for (int k = 0; k < 8; ++k) {
        float dot = 0.f;
        unsigned w[4] = {ur[k].x, ur[k].y, ur[k].z, ur[k].w};
#pragma unroll
        for (int q = 0; q < 4; ++q) {
          f32x2 lo = __builtin_amdgcn_cvt_pk_f32_fp8((int)w[q], false), hi = __builtin_amdgcn_cvt_pk_f32_fp8((int)w[q], true);
          dot += lo[0] * hv[q * 4] + lo[1] * hv[q * 4 + 1] + hi[0] * hv[q * 4 + 2] + hi[1] * hv[q * 4 + 3];
        }
        dot = wave_sum(dot) * us[k];
        float a = gt[k] * gelu_f(dot) * vs[k];
        unsigned y[4] = {vr[k].x, vr[k].y, vr[k].z, vr[k].w};
#pragma unroll
        for (int q = 0; q < 4; ++q) {
          f32x2 lo = __builtin_amdgcn_cvt_pk_f32_fp8((int)y[q], false), hi = __builtin_amdgcn_cvt_pk_f32_fp8((int)y[q], true);
          acc[q * 4] += a * lo[0]; acc[q * 4 + 1] += a * lo[1]; acc[q * 4 + 2] += a * hi[0]; acc[q * 4 + 3] += a * hi[1];
        }
      }
    }
    {
      float4* xp = ((l == 1) ? (float4*)(p.out + (size_t)(tk - LC) * 1024) : (float4*)(p.xall + (size_t)tk * 1024)) + lane * 4;
#pragma unroll
      for (int q = 0; q < 4; ++q) {
        float4 gg = ((const float4*)(mod + 5120))[lane * 4 + q];
        float4 o;
        o.x = xv[q * 4 + 0] + gg.x * acc[q * 4 + 0];
        o.y = xv[q * 4 + 1] + gg.y * acc[q * 4 + 1];
        o.z = xv[q * 4 + 2] + gg.z * acc[q * 4 + 2];
        o.w = xv[q * 4 + 3] + gg.w * acc[q * 4 + 3];
        xp[q] = o;
      }
    }
  }
}

#define XB_TMO      128
#define XB_XCNT(j)  (256  + 64 * (j))
#define XB_XSUB(j)  (1280 + 64 * (j))
#define XB_XGEN(j)  (2304 + 64 * (j))
#define XB_TOP      3328
#define XB_TOPGEN   3392
#define XCD_BAR_WORDS 3456
#define XB_SPIN_CAP (1u << 22)
#define LAS __attribute__((address_space(3)))
__device__ __forceinline__ unsigned xb_ld(unsigned* q) { return __hip_atomic_load(q, __ATOMIC_RELAXED, __HIP_MEMORY_SCOPE_AGENT); }
__device__ __forceinline__ unsigned xb_add(unsigned* q, unsigned v) { return __hip_atomic_fetch_add(q, v, __ATOMIC_RELAXED, __HIP_MEMORY_SCOPE_AGENT); }
__device__ __forceinline__ unsigned xb_xcc_id() { return (unsigned)__builtin_amdgcn_s_getreg((3 << 11) | 20) & 0xFu; }
#define XB_SPIN(cond, bar) do { unsigned _sp = 0; while (cond) { __builtin_amdgcn_s_sleep(1); \
    if ((++_sp & 255u) == 0u) { if (xb_ld(&(bar)[XB_TMO])) break; if (_sp > XB_SPIN_CAP) { atomicAdd(&(bar)[XB_TMO], 1u); break; } } } } while (0)
struct XcdBarrier { unsigned* bar; unsigned x; volatile LAS unsigned* st; };
__device__ __forceinline__ XcdBarrier xcd_barrier_post(unsigned* bar, volatile LAS unsigned* st) {
  XcdBarrier b; b.bar = bar; b.x = xb_xcc_id(); b.st = st;
  if (threadIdx.x == 0) (void)xb_add(&bar[XB_XCNT(b.x)], 1u);
  return b;
}
__device__ __forceinline__ void xcd_barrier_complete(unsigned* bar, unsigned x, unsigned& nloc, unsigned& nx) {
  const unsigned G = gridDim.x * gridDim.y * gridDim.z;
  unsigned sum, cnt, mine, sp = 0u;
  for (;;) {
    sum = 0u; cnt = 0u; mine = 0u;
#pragma unroll
    for (unsigned j = 0; j < 16; ++j) { const unsigned c = xb_ld(&bar[XB_XCNT(j)]); sum += c; cnt += (c > 0u) ? 1u : 0u; mine = (j == x) ? c : mine; }
    if (sum == G) break;
    __builtin_amdgcn_s_sleep(1);
    if ((++sp & 255u) == 0u) { if (xb_ld(&bar[XB_TMO])) break; if (sp > XB_SPIN_CAP) { atomicAdd(&bar[XB_TMO], 1u); break; } }
  }
  nloc = mine > 0u ? mine : 1u; nx = cnt > 0u ? cnt : 1u;
}
__device__ __forceinline__ void xcd_barrier(const XcdBarrier& b) {
  asm volatile("s_waitcnt vmcnt(0)" ::: "memory");
  __syncthreads();
  if (threadIdx.x == 0) {
    unsigned* bar = b.bar;
    __builtin_amdgcn_s_waitcnt(0);
    unsigned nloc = b.st[0], nx = b.st[1];
    if (nloc == 0u) { xcd_barrier_complete(bar, b.x, nloc, nx); b.st[0] = nloc; b.st[1] = nx; }
    const unsigned old = xb_add(&bar[XB_XSUB(b.x)], 1u);
    const unsigned gen = old / nloc;
    if (old + 1u == (gen + 1u) * nloc) {
      __builtin_amdgcn_fence(__ATOMIC_RELEASE, "agent");
      asm volatile("s_waitcnt vmcnt(0)" ::: "memory");
      const unsigned og = xb_add(&bar[XB_TOP], 1u);
      const unsigned tg = og / nx;
      if (og + 1u == (tg + 1u) * nx) xb_add(&bar[XB_TOPGEN], 1u);
      else XB_SPIN(xb_ld(&bar[XB_TOPGEN]) == tg, bar);
      __builtin_amdgcn_fence(__ATOMIC_ACQUIRE, "agent");
      xb_add(&bar[XB_XGEN(b.x)], 1u);
      asm volatile("s_waitcnt vmcnt(0)" ::: "memory");
    } else {
      XB_SPIN(xb_ld(&bar[XB_XGEN(b.x)]) == gen, bar);
      __builtin_amdgcn_fence(__ATOMIC_ACQUIRE, "agent");
      asm volatile("s_waitcnt vmcnt(0)" ::: "memory");
    }
  }
  __syncthreads();
}

#ifndef PROBE_IV
#define PROBE_IV -1
#endif
__device__ __forceinline__ void probe_tick(int& cnt, unsigned long long* slots) {
  if (PROBE_IV >= 0) {
    if (threadIdx.x == 0 && (cnt == PROBE_IV || cnt == PROBE_IV + 1)) slots[cnt - PROBE_IV] = __builtin_amdgcn_s_memrealtime();
    cnt = __builtin_amdgcn_readfirstlane(cnt + 1);
  }
}
#define BARRIER() do { xcd_barrier(xb); probe_tick(pcnt, probe_t); } while (0)

typedef const __attribute__((address_space(4))) P* KP;
__device__ __forceinline__ P load_params(KP kp) {
#if defined(__HIP_DEVICE_COMPILE__)
  asm volatile("" : "+s"(kp));
  return *kp;
#else
  return P{};
#endif
}
#define PP load_params(kp)
__global__ void __launch_bounds__(256, 2) k_mega(P p_unused) {
  KP kp = (KP)__builtin_amdgcn_kernarg_segment_ptr();
  __shared__ __attribute__((aligned(16))) float smem[18432 + 8];
  uint4& xb_words = *(uint4*)(smem + 18432);
  cg::grid_group grid = cg::this_grid();
  if (threadIdx.x == 0) xb_words = make_uint4(0u, 0u, 0u, 0u);
  __syncthreads();
  unsigned long long* probe_t = (unsigned long long*)(smem + 18436);
  int pcnt = 0;
  asm volatile("" : "+s"(pcnt));
  probe_tick(pcnt, probe_t);
  ph_mod(PP, smem);
  ph_prep(PP, smem);
  ph_lru_prepw(PP);
  ph_rope_tab(PP);
  ph_prep_peer(PP);
  grid.sync();
  probe_tick(pcnt, probe_t);
  XcdBarrier xb = xcd_barrier_post(PP.bar, (volatile LAS unsigned*)&xb_words);
  ph_norm_mod(PP, 0, 0, 0, smem, true);
  BARRIER();
#pragma unroll 1
  for (int l = 0; l < 2; ++l) {
    const int t0 = (l == 0) ? 0 : LC;
    { const P lp = PP; gemm_bf16_128(lp, lp.hb, lp.w_in_t + (size_t)l * 1024 * DIN, 1024, 0, TT, DIN, (char*)smem, EpiProj{l}); }
    BARRIER();
    ph_lru<1>(PP, l, (char*)smem);
    ph_attn(PP, l, (char*)smem);
    BARRIER();
    ph_lru_carry(PP, smem);
    BARRIER();
    ph_lru<2>(PP, l, (char*)smem);
    BARRIER();
    { const P lp = PP; gemm_bf16_128(lp, lp.mixb, lp.w_out_t + (size_t)l * 1024 * 1024, 1024, t0, TT, 1024, (char*)smem, EpiResid{l, 2048}); }
    BARRIER();
    ph_norm_mod(PP, l, 1, t0, smem);
    BARRIER();
    { const P lp = PP; gemm_bf16_128(lp, lp.hb, lp.wq_t + (size_t)l * 1024 * NPQ, 1024, t0, TT, NPQ, (char*)smem, EpiPeerTopk{l}); }
    BARRIER();
    ph_peer_apply2(PP, l, t0, (char*)smem);
    if (l == 0) {
      BARRIER();
      ph_norm_mod(PP, 1, 0, 0, smem);
      BARRIER();
    }
  }
  if (PROBE_IV >= 0) {
    probe_tick(pcnt, probe_t);
    __syncthreads();
    if (blockIdx.x == 0 && threadIdx.x == 0) {
      const unsigned long long dt = (probe_t[1] - probe_t[0]) * 8ull, ts = __builtin_amdgcn_s_memrealtime();
      while (__builtin_amdgcn_s_memrealtime() - ts < dt) __builtin_amdgcn_s_sleep(8);
    }
  }
}

extern "C" void kernel_launch(void* const* d_in, const int* in_sizes, int n_in, void* d_out, int out_size, void* d_ws,
                              size_t ws_size, hipStream_t stream) {
  P p{};
  const float** fp = (const float**)&p;
  for (int i = 0; i < 28; ++i) fp[i] = (const float*)d_in[i];
  p.out = (float*)d_out;
  float* w = (float*)d_ws;
  size_t o = 0;
  auto carve = [&](size_t n) { float* r = w + o; o += (n + 63) & ~(size_t)63; return r; };
  p.bar = (unsigned*)carve(4096);
  p.mod = carve(4 * 6144);
  p.xall = carve((size_t)TT * 1024);
  p.proj = carve((size_t)TT * 512);
  p.projb = (bf16_t*)carve((size_t)TT * DIN / 2);
  p.mixb = (bf16_t*)carve((size_t)TT * 512);
  p.hb = (bf16_t*)carve((size_t)TT * 512);
  p.w_in_t = (bf16_t*)carve((size_t)1024 * DIN);
  p.w_out_t = (bf16_t*)carve((size_t)1024 * 1024);
  p.wq_t = (bf16_t*)carve((size_t)1024 * NPQ);
  p.lruw_t = (bf16_t*)carve((size_t)2 * 2 * 4 * 2 * 4096 / 2);
  p.lagg = carve((size_t)2 * NCHUNK * 256 * 2);
  p.lcarry = carve((size_t)2 * NCHUNK * 256);
  p.ropetab = carve(320 * 16 * 2);
  p.pk = (unsigned*)carve((size_t)TT * 256);
  p.ub8 = (unsigned char*)carve((size_t)2 * 16384 * 1024 / 4);
  p.vb8 = (unsigned char*)carve((size_t)2 * 16384 * 1024 / 4);
  p.usc = carve(2 * 16384);
  p.vsc = carve(2 * 16384);
  p.k1b = (bf16_t*)carve(16384);
  p.k2b = (bf16_t*)carve(16384);
  if (o * 4 > ws_size) { fprintf(stderr, "workspace too small: need %zu have %zu\n", o * 4, ws_size); return; }
  static int grid_blocks = 0;
  if (!grid_blocks) {
    int dev = 0, cus = 0, per_cu = 0;
    (void)hipGetDevice(&dev);
    (void)hipDeviceGetAttribute(&cus, hipDeviceAttributeMultiprocessorCount, dev);
    (void)hipOccupancyMaxActiveBlocksPerMultiprocessor(&per_cu, k_mega, 256, 0);
    if (per_cu > 2) per_cu = 2;
    grid_blocks = cus * per_cu;
  }
  (void)hipMemsetAsync(p.bar, 0, XCD_BAR_WORDS * 4, stream);
  void* args[] = {&p};
  hipError_t e = hipLaunchCooperativeKernel((void*)k_mega, dim3(grid_blocks), dim3(256), args, 0, stream);
  if (e != hipSuccess) fprintf(stderr, "cooperative launch failed: %s (grid %d)\n", hipGetErrorString(e), grid_blocks);
}
```

```cpp
#include <hip/hip_runtime.h>
#include <hip/hip_cooperative_groups.h>
#include <stdint.h>
#include <stdio.h>
namespace cg = cooperative_groups;

#ifndef SINGLE_LAUNCH
#define SINGLE_LAUNCH 1
#endif

constexpr int DM = 1024, SEQ = 16384, LC = 256, TT = SEQ + LC, DIN = 2304, NPQ = 2048;
constexpr int OFF_XA = 0, OFF_GA = 256, OFF_QW = 512, OFF_KW = 896, OFF_VW = 1024, OFF_QN = 1152, OFF_KN = 1536, OFF_VN = 1920;
constexpr float EPS = 1e-6f;
constexpr float LOG2E = 1.4426950408889634f;
constexpr float QSCALE = 0.125f * LOG2E;

struct P {
  const float *x, *c, *ctx, *c_ctx, *w_mod, *b_mod, *norm1_g, *norm2_g, *w_in, *w_out,
      *conv_w, *conv_b, *wa, *ba, *wx, *bx, *lam, *win_qn, *win_kn, *win_sink, *na_qn, *na_kn, *rpb,
      *wq, *k1, *k2, *pu, *pv;
  float* out;
  float *mod, *xall, *proj;
  unsigned short* projb;
  unsigned* pk;
  unsigned* bar;
  unsigned short *k1b, *k2b;
  unsigned char *ub8, *vb8;
  float *usc, *vsc;
  unsigned short *hb, *mixb, *w_in_t, *w_out_t, *wq_t, *lruw_t;
  float *lagg, *lcarry, *ropetab;
};

typedef unsigned short bf16_t;
typedef __attribute__((ext_vector_type(8))) short bf16x8;
typedef __attribute__((ext_vector_type(4))) float f32x4;
__device__ __forceinline__ unsigned short f2bf(float f) {
  unsigned u = __float_as_uint(f);
  u += 0x7fffu + ((u >> 16) & 1u);
  return (unsigned short)(u >> 16);
}
__device__ __forceinline__ unsigned pack2bf(float a, float b) { return (unsigned)f2bf(a) | ((unsigned)f2bf(b) << 16); }
__device__ __forceinline__ float bf2f(unsigned short h) { return __uint_as_float(((unsigned)h) << 16); }


__device__ __forceinline__ float silu_f(float x) { return x / (1.f + __expf(-x)); }
__device__ __forceinline__ float sigmoid_f(float x) { return 1.f / (1.f + __expf(-x)); }
__device__ __forceinline__ float gelu_f(float x) {
  float u = 0.7978845608028654f * (x + 0.044715f * x * x * x);
  float e = __expf(2.f * u);
  float th = 1.f - 2.f / (e + 1.f);
  return 0.5f * x * (1.f + th);
}
template <int CTRL, int RMASK>
__device__ __forceinline__ float dpp_mov(float v) {
  return __int_as_float(__builtin_amdgcn_update_dpp(0, __float_as_int(v), CTRL, RMASK, 0xf, false));
}
__device__ __forceinline__ float wave_sum(float v) {
  v += dpp_mov<0xB1, 0xf>(v);
  v += dpp_mov<0x4E, 0xf>(v);
  v += dpp_mov<0x141, 0xf>(v);
  v += dpp_mov<0x140, 0xf>(v);
  v += dpp_mov<0x142, 0xa>(v);
  v += dpp_mov<0x143, 0xc>(v);
  return __int_as_float(__builtin_amdgcn_readlane(__float_as_int(v), 63));
}

__device__ __forceinline__ int tid_opaque() { int t = threadIdx.x; asm volatile("" : "+v"(t)); return t; }
#define GTID (blockIdx.x * blockDim.x + tid_opaque())
#define GSZ (gridDim.x * blockDim.x)

__device__ __forceinline__ void ph_mod(const P& p, float* smem) {
  const int tid = tid_opaque(), cl = tid & 31, ks = tid >> 5;
  for (int it = blockIdx.x; it < 2 * 192; it += gridDim.x) {
    const int nc = it % 192, l = it / 192;
    const int n = nc * 32 + cl;
    const float* w = p.w_mod + (size_t)l * 1024 * 6144 + n;
    float a0 = 0.f, a1 = 0.f;
#pragma unroll 8
    for (int i = 0; i < 128; ++i) {
      int k = i * 8 + ks;
      float wv = w[(size_t)k * 6144];
      a0 += silu_f(p.c[k]) * wv;
      a1 += silu_f(p.c_ctx[k]) * wv;
    }
    __syncthreads();
    smem[tid] = a0; smem[256 + tid] = a1;
    __syncthreads();
    if (tid < 64) {
      const int which = tid >> 5;
      float s = p.b_mod[l * 6144 + n];
#pragma unroll
      for (int q = 0; q < 8; ++q) s += smem[which * 256 + q * 32 + cl];
      p.mod[(l * 2 + which) * 6144 + n] = s;
    }
  }
}

__device__ __forceinline__ void ph_copy_in(const P& p) {
  const float4* xs = (const float4*)p.x;
  const float4* cs = (const float4*)p.ctx;
  float4* d = (float4*)p.xall;
  for (int i = GTID; i < TT * 256; i += GSZ) d[i] = (i < LC * 256) ? cs[i] : xs[i - LC * 256];
}

__device__ __forceinline__ void ph_copy_out(const P& p) {
  const float4* s = (const float4*)(p.xall + (size_t)LC * 1024);
  float4* d = (float4*)p.out;
  for (int i = GTID; i < SEQ * 256; i += GSZ) d[i] = s[i];
}

__device__ __forceinline__ void ph_norm_mod(const P& p, int l, int which_norm, int t0, float* smem, bool from_input = false) {
  const float* g = (which_norm ? p.norm2_g : p.norm1_g) + l * 1024;
  const int sh_off = which_norm ? 3072 : 0, sc_off = which_norm ? 4096 : 1024;
  const int tid = tid_opaque();
  for (int t = t0 + blockIdx.x; t < TT; t += gridDim.x) {
    const float* mod = p.mod + (l * 2 + (t < LC ? 1 : 0)) * 6144;
    float4 v;
    if (from_input) {
      v = t < LC ? ((const float4*)(p.ctx + (size_t)t * 1024))[tid] : ((const float4*)(p.x + (size_t)(t - LC) * 1024))[tid];
      ((float4*)(p.xall + (size_t)t * 1024))[tid] = v;
    } else v = ((const float4*)(p.xall + (size_t)t * 1024))[tid];
    float ss = wave_sum(v.x * v.x + v.y * v.y + v.z * v.z + v.w * v.w);
    __syncthreads();
    if ((tid & 63) == 0) smem[tid >> 6] = ss;
    __syncthreads();
    float tot = smem[0] + smem[1] + smem[2] + smem[3];
    float rinv = rsqrtf(tot * (1.f / 1024.f) + EPS);
    float4 gg = ((const float4*)g)[tid];
    float4 sc = ((const float4*)(mod + sc_off))[tid];
    float4 sh = ((const float4*)(mod + sh_off))[tid];
    float4 o;
    o.x = v.x * rinv * gg.x * (1.f + sc.x) + sh.x;
    o.y = v.y * rinv * gg.y * (1.f + sc.y) + sh.y;
    o.z = v.z * rinv * gg.z * (1.f + sc.z) + sh.z;
    o.w = v.w * rinv * gg.w * (1.f + sc.w) + sh.w;
    ((uint2*)(p.hb + (size_t)t * 1024))[tid] = make_uint2(pack2bf(o.x, o.y), pack2bf(o.z, o.w));
  }
}

__device__ __forceinline__ void prep_transpose(const float* W, bf16_t* Wt, int K, int N, int item0, int nitems_total, float* smem) {
  (void)nitems_total;
  float(*ts)[65] = (float(*)[65])smem;
  const int tid = tid_opaque();
  const int tn = N / 64, nt = (K / 64) * tn;
  for (int it = blockIdx.x; it < nt; it += gridDim.x) {
    int k0 = (it / tn) * 64, n0 = (it % tn) * 64;
    __syncthreads();
#pragma unroll
    for (int i = 0; i < 16; ++i) {
      int r = (tid >> 6) + i * 4, c = tid & 63;
      ts[r][c] = W[(size_t)(k0 + r) * N + n0 + c];
    }
    __syncthreads();
#pragma unroll
    for (int i = 0; i < 16; ++i) {
      int r = (tid >> 6) + i * 4, c = tid & 63;
      Wt[(size_t)(n0 + r) * K + k0 + c] = f2bf(ts[c][r]);
    }
  }
  (void)item0;
}

__device__ __forceinline__ void ph_prep(const P& p, float* smem) {
  for (int l = 0; l < 2; ++l) {
    prep_transpose(p.w_in + (size_t)l * 1024 * DIN, p.w_in_t + (size_t)l * 1024 * DIN, 1024, DIN, 0, 0, smem);
    prep_transpose(p.w_out + (size_t)l * 1024 * 1024, p.w_out_t + (size_t)l * 1024 * 1024, 1024, 1024, 0, 0, smem);
    prep_transpose(p.wq + (size_t)l * 1024 * NPQ, p.wq_t + (size_t)l * 1024 * NPQ, 1024, NPQ, 0, 0, smem);
  }
}

struct EpiStoreF32 {
  float* C; int ldc;
  __device__ __forceinline__ void operator()(const P& p, f32x4 (&acc)[4][4], int m0, int n0, int wm, int wn, int lane, char* smem) const {
    const int mw0 = m0 + wm * 64, nw0 = n0 + wn * 64;
#pragma unroll
    for (int i = 0; i < 4; ++i)
#pragma unroll
      for (int r = 0; r < 4; ++r) {
        int row = mw0 + 16 * i + (lane >> 4) * 4 + r;
#pragma unroll
        for (int j = 0; j < 4; ++j) C[(size_t)row * ldc + nw0 + 16 * j + (lane & 15)] = acc[i][j][r];
      }
  }
};
struct EpiProjSplit {
  __device__ __forceinline__ void operator()(const P& p, f32x4 (&acc)[4][4], int m0, int n0, int wm, int wn, int lane, char* smem) const {
    const int mw0 = m0 + wm * 64, nw0 = n0 + wn * 64;
#pragma unroll
    for (int i = 0; i < 4; ++i)
#pragma unroll
      for (int r = 0; r < 4; ++r) {
        int row = mw0 + 16 * i + (lane >> 4) * 4 + r;
#pragma unroll
        for (int j = 0; j < 4; ++j) {
          int col = nw0 + 16 * j + (lane & 15);
          if (n0 < 512) p.proj[(size_t)row * 512 + col] = acc[i][j][r];
          else p.projb[(size_t)row * DIN + col] = f2bf(acc[i][j][r]);
        }
      }
  }
};
__device__ __forceinline__ void ph_rope_tab(const P& p) {
  for (int idx = GTID; idx < 320 * 16; idx += GSZ) {
    int v = idx >> 4, j = idx & 15;
    float inv = __expf(-(float)j * (1.f / 16.f) * 9.210340371976184f);
    float ang = (float)(v < 256 ? v : v - 256) * inv;
    float k = rintf(ang * 0.15915494309189535f);
    float r = fmaf(-k, 6.2831854820251465f, ang);
    r = fmaf(-k, -1.7484555e-07f, r);
    ((float2*)p.ropetab)[idx] = make_float2(__cosf(r), __sinf(r));
  }
}

template <int CTRL>
__device__ __forceinline__ float dpp_row(float v) {
  return __int_as_float(__builtin_amdgcn_update_dpp(0, __float_as_int(v), CTRL, 0xf, 0xf, false));
}
struct EpiProj {
  int l;
  __device__ __forceinline__ void operator()(const P& p, f32x4 (&acc)[4][4], int m0, int n0, int wm, int wn, int lane, char* smem) const {
    const int g = lane >> 4, lr = lane & 15;
    const int mw0 = m0 + wm * 64, nw0 = n0 + wn * 64;
    if (n0 < 512) {
#pragma unroll
      for (int i = 0; i < 4; ++i)
#pragma unroll
        for (int r = 0; r < 4; ++r) {
          int row = mw0 + 16 * i + 4 * g + r;
#pragma unroll
          for (int j = 0; j < 4; ++j) p.proj[(size_t)row * 512 + nw0 + 16 * j + lr] = acc[i][j][r];
        }
      return;
    }
    const float* gain = nullptr; bool rope = false; float scale = 1.f;
    if (nw0 < 896) { gain = p.win_qn + l * 64; rope = true; scale = QSCALE; }
    else if (nw0 < 1024) { gain = p.win_kn + l * 64; rope = true; }
    else if (nw0 < 1152) { }
    else if (nw0 < 1536) { gain = p.na_qn + l * 64; scale = QSCALE; }
    else if (nw0 < 1920) { gain = p.na_kn + l * 64; }
    rope = rope && (m0 >= LC);
    float gj[4] = {1.f, 1.f, 1.f, 1.f};
    if (gain) {
#pragma unroll
      for (int j = 0; j < 4; ++j) gj[j] = gain[16 * j + lr] * scale;
    }
#pragma unroll
    for (int i = 0; i < 4; ++i)
#pragma unroll
      for (int r = 0; r < 4; ++r) {
        const int row = mw0 + 16 * i + 4 * g + r;
        float y[4] = {acc[i][0][r], acc[i][1][r], acc[i][2][r], acc[i][3][r]};
        if (gain) {
          float ss = y[0] * y[0] + y[1] * y[1] + y[2] * y[2] + y[3] * y[3];
          ss += dpp_row<0xB1>(ss);
          ss += dpp_row<0x4E>(ss);
          ss += dpp_row<0x141>(ss);
          ss += dpp_row<0x140>(ss);
          const float rinv = rsqrtf(ss * (1.f / 64.f) + EPS);
#pragma unroll
          for (int j = 0; j < 4; ++j) y[j] *= rinv * gj[j];
        }
        if (rope) {
          const int pos = row - LC;
          const float2 tr = ((const float2*)p.ropetab)[(pos >> 6) * 16 + lr];
          const float2 tc = ((const float2*)p.ropetab)[(256 + (pos & 63)) * 16 + lr];
          float a0 = y[0] * tr.x - y[1] * tr.y, a1 = y[0] * tr.y + y[1] * tr.x;
          float a2 = y[2] * tc.x - y[3] * tc.y, a3 = y[2] * tc.y + y[3] * tc.x;
          y[0] = a0; y[1] = a1; y[2] = a2; y[3] = a3;
        }
#pragma unroll
        for (int j = 0; j < 4; ++j) p.projb[(size_t)row * DIN + nw0 + 16 * j + lr] = f2bf(y[j]);
      }
  }
};
struct EpiResid {
  int l, gofs;
  __device__ __forceinline__ void operator()(const P& p, f32x4 (&acc)[4][4], int m0, int n0, int wm, int wn, int lane, char* smem) const {
    const int mw0 = m0 + wm * 64, nw0 = n0 + wn * 64;
#pragma unroll
    for (int i = 0; i < 4; ++i)
#pragma unroll
      for (int r = 0; r < 4; ++r) {
        int row = mw0 + 16 * i + (lane >> 4) * 4 + r;
        const float* gt = p.mod + (l * 2 + (row < LC ? 1 : 0)) * 6144 + gofs;
#pragma unroll
        for (int j = 0; j < 4; ++j) {
          int col = nw0 + 16 * j + (lane & 15);
          p.xall[(size_t)row * 1024 + col] += gt[col] * acc[i][j][r];
        }
      }
  }
};

__device__ __forceinline__ int gemm_swz(int row) { return (0x78 >> (((row >> 2) & 3) * 2)) & 3; }
template <class Epi>
__device__ __forceinline__ void gemm_bf16_128(const P& p, const bf16_t* __restrict__ A, const bf16_t* __restrict__ Bt, int K, int m_begin, int m_end,
                              int N, char* smem, const Epi& epi) {
  const int tid = tid_opaque(), lane = tid & 63, wv = __builtin_amdgcn_readfirstlane(tid >> 6), wm = wv >> 1, wn = wv & 1;
  const int tiles_n = N / 128, tiles_m = (m_end - m_begin) / 128;
  const int nk = K / 32;
  const int lr = lane & 15, g = lane >> 4;
  const int a_rd = (wm * 64 + lr) * 64 + ((g ^ gemm_swz(lr)) << 4);
  const int b_rd = 8192 + (wn * 64 + lr) * 64 + ((g ^ gemm_swz(lr)) << 4);
  const int ld_row = lane >> 2, ld_c = (lane & 3) ^ gemm_swz(ld_row);
  for (int tile = blockIdx.x; tile < tiles_m * tiles_n; tile += gridDim.x) {
    const int m0 = m_begin + (tile / tiles_n) * 128, n0 = (tile % tiles_n) * 128;
    f32x4 acc[4][4];
#pragma unroll
    for (int i = 0; i < 4; ++i)
#pragma unroll
      for (int j = 0; j < 4; ++j) acc[i][j] = (f32x4){0.f, 0.f, 0.f, 0.f};
    const bf16_t* Ag = A + (size_t)(m0 + wv * 32 + ld_row) * K + ld_c * 8;
    const bf16_t* Bg = Bt + (size_t)(n0 + wv * 32 + ld_row) * K + ld_c * 8;
    auto issue = [&](int st, int kt) {
      char* base = smem + st * 16384 + wv * 2048;
#pragma unroll
      for (int i = 0; i < 2; ++i) {
        __builtin_amdgcn_global_load_lds((const unsigned*)(Ag + (size_t)i * 16 * K + kt * 32), (__attribute__((address_space(3))) unsigned*)(base + i * 1024), 16, 0, 0);
        __builtin_amdgcn_global_load_lds((const unsigned*)(Bg + (size_t)i * 16 * K + kt * 32), (__attribute__((address_space(3))) unsigned*)(base + 8192 + i * 1024), 16, 0, 0);
      }
    };
    issue(0, 0); issue(1, 1); issue(2, 2);
    for (int kt0 = 0; kt0 < nk; kt0 += 4) {
#pragma unroll
      for (int u = 0; u < 4; ++u) {
        const int kt = kt0 + u, rem = nk - kt;
        if (rem >= 3) asm volatile("s_waitcnt vmcnt(8) lgkmcnt(0)" ::: "memory");
        else if (rem == 2) asm volatile("s_waitcnt vmcnt(4) lgkmcnt(0)" ::: "memory");
        else asm volatile("s_waitcnt vmcnt(0) lgkmcnt(0)" ::: "memory");
        __builtin_amdgcn_s_barrier();
        if (kt + 3 < nk) issue((u + 3) & 3, kt + 3);
        bf16x8 af[4], bfr[4];
#pragma unroll
        for (int i = 0; i < 4; ++i) af[i] = *(const bf16x8*)(smem + u * 16384 + a_rd + i * 1024);
#pragma unroll
        for (int j = 0; j < 4; ++j) bfr[j] = *(const bf16x8*)(smem + u * 16384 + b_rd + j * 1024);
#pragma unroll
        for (int i = 0; i < 4; ++i)
#pragma unroll
          for (int j = 0; j < 4; ++j) acc[i][j] = __builtin_amdgcn_mfma_f32_16x16x32_bf16(af[i], bfr[j], acc[i][j], 0, 0, 0);
      }
    }
    __syncthreads();
    epi(p, acc, m0, n0, wm, wn, lane, smem);
    __syncthreads();
  }
}

constexpr int NCHUNK = TT / 64;
__device__ __forceinline__ int lru_pos(int dir, int c) { return dir == 0 ? c : (c < 4 ? 3 - c : 4 + (NCHUNK - 1 - c)); }

__device__ __forceinline__ void ph_lru_prepw(const P& p) {
  for (int idx = GTID; idx < 2 * 2 * 4 * 2 * 4096; idx += GSZ) {
    int d = idx & 63, e = (idx >> 6) & 63, mtx = (idx >> 12) & 1, rest = idx >> 13;
    const float* w = (mtx ? p.wx : p.wa) + (size_t)rest * 4096;
    p.lruw_t[idx] = f2bf(w[d * 64 + e]);
  }
}

template <int PASS>
__device__ __forceinline__ void lru_item(const P& p, int l, int cidx, int kb, char* smem) {
  bf16_t* u_img = (bf16_t*)smem;
  float* ab_a = (float*)(smem + 8192);
  float* ab_b = (float*)(smem + 8192 + 16384);
  float* hsum = (float*)(smem + 8192 + 32768);
  float* segagg = (float*)(smem + 8192 + 49152);
  float* ccarry = (float*)(smem + 8192 + 49152 + 2048);
  const int tid = tid_opaque(), lane = tid & 63, wv = tid >> 6, g = lane >> 4, lr = lane & 15;
  const int t0 = cidx * 64;
  const int lo = t0 < LC ? 0 : LC, hi = t0 < LC ? LC : TT;
  __syncthreads();
  {
    const int ch = tid & 63, c = kb * 64 + ch, sg = tid >> 6;
    const float cb = p.conv_b[l * 256 + c];
    float cw[4];
#pragma unroll
    for (int k = 0; k < 4; ++k) cw[k] = p.conv_w[(l * 4 + k) * 256 + c];
    float xr[19];
#pragma unroll
    for (int i = 0; i < 19; ++i) {
      int tt = t0 + sg * 16 + i - 2;
      int tc = tt < lo ? lo : (tt >= hi ? hi - 1 : tt);
      float v = p.proj[(size_t)tc * 512 + OFF_XA + c];
      xr[i] = (tt >= lo && tt < hi) ? v : 0.f;
    }
#pragma unroll
    for (int i = 0; i < 16; ++i) {
      int row = sg * 16 + i;
      float acc = cb + cw[0] * xr[i] + cw[1] * xr[i + 1] + cw[2] * xr[i + 2] + cw[3] * xr[i + 3];
      u_img[row * 64 + ((((ch >> 3) ^ (row & 7)) << 3) | (ch & 7))] = f2bf(acc);
    }
  }
  if (PASS == 2) {
    if (tid < 128) {
      const int ch = tid & 63, dir = tid >> 6;
      ccarry[dir * 64 + ch] = p.lcarry[((size_t)dir * NCHUNK + lru_pos(dir, cidx)) * 256 + kb * 64 + ch];
    }
  }
  __syncthreads();
  for (int dir = 0; dir < 2; ++dir) {
    const int pd = l * 2 + dir;
    {
      f32x4 ga[4], gx[4];
#pragma unroll
      for (int i = 0; i < 4; ++i) { ga[i] = (f32x4){0.f, 0.f, 0.f, 0.f}; gx[i] = (f32x4){0.f, 0.f, 0.f, 0.f}; }
      const bf16_t* wbase = p.lruw_t + (size_t)((pd * 4 + kb) * 2) * 4096 + (16 * wv + lr) * 64 + 8 * g;
#pragma unroll
      for (int s = 0; s < 2; ++s) {
        bf16x8 ba_ = *(const bf16x8*)(wbase + 32 * s);
        bf16x8 bx_ = *(const bf16x8*)(wbase + 4096 + 32 * s);
#pragma unroll
        for (int i = 0; i < 4; ++i) {
          int row = 16 * i + lr;
          bf16x8 af = *(const bf16x8*)((const char*)u_img + row * 128 + (((4 * s + g) ^ (row & 7)) << 4));
          ga[i] = __builtin_amdgcn_mfma_f32_16x16x32_bf16(af, ba_, ga[i], 0, 0, 0);
          gx[i] = __builtin_amdgcn_mfma_f32_16x16x32_bf16(af, bx_, gx[i], 0, 0, 0);
        }
      }
      const int ch = 16 * wv + lr, c = kb * 64 + ch;
      const float bav = p.ba[pd * 256 + c], bxv = p.bx[pd * 256 + c];
      const float sp = log1pf(expf(-p.lam[pd * 256 + c]));
#pragma unroll
      for (int i = 0; i < 4; ++i)
#pragma unroll
        for (int r = 0; r < 4; ++r) {
          int row = 16 * i + 4 * g + r;
          float rr = sigmoid_f(ga[i][r] + bav), ig = sigmoid_f(gx[i][r] + bxv);
          float log_a = -8.f * rr * sp;
          float a = __expf(log_a);
          float uu = bf2f(u_img[row * 64 + ((((ch >> 3) ^ (row & 7)) << 3) | (ch & 7))]);
          const float x2 = 2.f * log_a;
          const float ser = -x2 * (1.f + x2 * (0.5f + x2 * (0.16666667f + x2 * (0.041666668f + x2 * 0.0083333338f))));
          const float om = x2 > -0.25f ? ser : 1.f - a * a;
          float b = sqrtf(om) * ig * uu;
          ab_a[row * 64 + ch] = a;
          ab_b[row * 64 + ch] = b;
        }
    }
    __syncthreads();
    {
      const int ch = tid & 63, seg = tid >> 6;
      float Pr = 1.f, H = 0.f;
#pragma unroll
      for (int i = 0; i < 16; ++i) {
        int row = dir == 0 ? seg * 16 + i : seg * 16 + 15 - i;
        float a = ab_a[row * 64 + ch], b = ab_b[row * 64 + ch];
        H = a * H + b;
        Pr *= a;
      }
      segagg[(seg * 64 + ch) * 2] = Pr;
      segagg[(seg * 64 + ch) * 2 + 1] = H;
      __syncthreads();
      if (PASS == 1) {
        if (seg == 0) {
          float A = 1.f, B = 0.f;
#pragma unroll
          for (int s2 = 0; s2 < 4; ++s2) {
            int sg = dir == 0 ? s2 : 3 - s2;
            float pa = segagg[(sg * 64 + ch) * 2], pb = segagg[(sg * 64 + ch) * 2 + 1];
            B = pa * B + pb;
            A *= pa;
          }
          float2* ag = (float2*)p.lagg + ((size_t)dir * NCHUNK + lru_pos(dir, cidx)) * 256 + kb * 64 + ch;
          *ag = make_float2(A, B);
        }
      } else {
        float h = ccarry[dir * 64 + ch];
        float gav[16];
        if (dir == 1) {
#pragma unroll
          for (int i = 0; i < 16; ++i) gav[i] = p.proj[(size_t)(t0 + seg * 16 + 15 - i) * 512 + OFF_GA + kb * 64 + ch];
        }
#pragma unroll
        for (int s2 = 0; s2 < 3; ++s2) {
          int sg = dir == 0 ? s2 : 3 - s2;
          bool before = dir == 0 ? (sg < seg) : (sg > seg);
          if (before) h = segagg[(sg * 64 + ch) * 2] * h + segagg[(sg * 64 + ch) * 2 + 1];
        }
#pragma unroll
        for (int i = 0; i < 16; ++i) {
          int row = dir == 0 ? seg * 16 + i : seg * 16 + 15 - i;
          float a = ab_a[row * 64 + ch], b = ab_b[row * 64 + ch];
          h = a * h + b;
          if (dir == 0) hsum[row * 64 + ch] = h;
          else {
            int t = t0 + row, c = kb * 64 + ch;
            p.mixb[(size_t)t * 1024 + c] = f2bf((hsum[row * 64 + ch] + h) * gelu_f(gav[i]));
          }
        }
      }
    }
    __syncthreads();
  }
}

__device__ __forceinline__ void ph_lru_carry(const P& p, float* smem) {
  const int tid = tid_opaque(), seg = tid >> 4, c16 = tid & 15;
  for (int blk = blockIdx.x; blk < 32; blk += gridDim.x) {
    const int dc = blk * 16 + c16, dir = dc >> 8, ch = dc & 255;
    const float2* ag = (const float2*)p.lagg + (size_t)dir * NCHUNK * 256 + ch;
    float2 v[17];
#pragma unroll
    for (int i = 0; i < 17; ++i) {
      int pos = seg * 17 + i;
      v[i] = pos < NCHUNK ? ag[(size_t)pos * 256] : make_float2(1.f, 0.f);
    }
    float A = 1.f, B = 0.f;
#pragma unroll
    for (int i = 0; i < 17; ++i) { B = v[i].x * B + v[i].y; A *= v[i].x; }
    __syncthreads();
    smem[(seg * 16 + c16) * 2] = A; smem[(seg * 16 + c16) * 2 + 1] = B;
    __syncthreads();
    float h = 0.f;
    for (int s2 = 0; s2 < seg; ++s2) h = smem[(s2 * 16 + c16) * 2] * h + smem[(s2 * 16 + c16) * 2 + 1];
    float* cr = p.lcarry + (size_t)dir * NCHUNK * 256 + ch;
#pragma unroll
    for (int i = 0; i < 17; ++i) {
      int pos = seg * 17 + i;
      if (pos < NCHUNK) cr[(size_t)pos * 256] = h;
      h = v[i].x * h + v[i].y;
    }
  }
}

template <int PASS>
__device__ __forceinline__ void ph_lru(const P& p, int l, char* smem) {
  const int c_begin = (PASS == 2 && l == 1) ? 4 : 0;
  const int nitems = (NCHUNK - c_begin) * 4;
  for (int it = blockIdx.x; it < nitems; it += gridDim.x) lru_item<PASS>(p, l, c_begin + (it >> 2), it & 3, smem);
}

typedef __attribute__((ext_vector_type(4))) short s16x4;

__device__ __forceinline__ void ph_qknorm_rope2(const P& p, int l) {
  const int tid_ = tid_opaque();
  const int lane = tid_ & 63;
  const int wpb = blockDim.x >> 6;
  for (int pair = blockIdx.x * wpb + (tid_ >> 6); pair < TT * 28; pair += gridDim.x * wpb) {
    int t = pair / 28, slot = pair % 28;
    const float* g = nullptr; bool rope = false; float scale = 1.f;
    if (slot < 6) { g = p.win_qn + l * 64; rope = true; scale = QSCALE; }
    else if (slot < 8) { g = p.win_kn + l * 64; rope = true; }
    else if (slot < 10) { }
    else if (slot < 16) { g = p.na_qn + l * 64; scale = QSCALE; }
    else if (slot < 22) { g = p.na_kn + l * 64; }
    rope = rope && (t >= LC);
    const size_t idx = (size_t)t * DIN + 512 + slot * 64 + lane;
    float v = bf2f(p.projb[idx]);
    float y = v;
    if (g) {
      float ss = wave_sum(v * v);
      y = v * rsqrtf(ss * (1.f / 64.f) + EPS) * g[lane];
    }
    float partner = __shfl_xor(y, 16);
    if (rope) {
      int pos = t - LC, row = pos >> 6, col = pos & 63;
      int j = lane & 15, axis = lane >> 5;
      float inv = __expf(-(float)j * (1.f / 16.f) * 9.210340371976184f);
      float ang = (float)(axis ? col : row) * inv;
      float k = rintf(ang * 0.15915494309189535f);
      float r = fmaf(-k, 6.2831854820251465f, ang);
      r = fmaf(-k, -1.7484555e-07f, r);
      float cs = __cosf(r), sn = __sinf(r);
      bool first = ((lane >> 4) & 1) == 0;
      y = first ? (y * cs - partner * sn) : (partner * sn + y * cs);
    }
    p.projb[idx] = f2bf(y * scale);
  }
}

template <int CTRL, int RMASK>
__device__ __forceinline__ float dpp_mov_id(float v) {
  return __int_as_float(__builtin_amdgcn_update_dpp(__float_as_int(v), __float_as_int(v), CTRL, RMASK, 0xf, false));
}
__device__ __forceinline__ float wave_max(float v) {
  v = fmaxf(v, dpp_mov_id<0xB1, 0xf>(v));
  v = fmaxf(v, dpp_mov_id<0x4E, 0xf>(v));
  v = fmaxf(v, dpp_mov_id<0x141, 0xf>(v));
  v = fmaxf(v, dpp_mov_id<0x140, 0xf>(v));
  v = fmaxf(v, dpp_mov_id<0x142, 0xa>(v));
  v = fmaxf(v, dpp_mov_id<0x143, 0xc>(v));
  return __int_as_float(__builtin_amdgcn_readlane(__float_as_int(v), 63));
}

struct KVRegs { uint4 k[2], v[2]; };
template <class TokFn>
__device__ __forceinline__ void kv_load(const P& p, KVRegs& r, int koff, int voff, TokFn tok, int tid) {
#pragma unroll
  for (int i = 0; i < 2; ++i) {
    int id = tid + 256 * i, row = id >> 3, c = id & 7;
    const bf16_t* base = p.projb + (size_t)tok(row) * DIN + c * 8;
    r.k[i] = *(const uint4*)(base + koff);
    r.v[i] = *(const uint4*)(base + voff);
  }
}
__device__ __forceinline__ void kv_store(const KVRegs& r, char* stage, int tid) {
#pragma unroll
  for (int i = 0; i < 2; ++i) {
    int id = tid + 256 * i, row = id >> 3, c = id & 7;
    int off = row * 128 + ((c ^ (row & 7)) << 4);
    *(uint4*)(stage + off) = r.k[i];
    *(uint4*)(stage + 8192 + off) = r.v[i];
  }
}

template <class MaskFn>
__device__ __forceinline__ void attn_step(const char* stage, int kr0, const bf16x8 (&qf)[2], f32x4 (&o)[4], float& lsum, MaskFn mb, int lane) {
  const int g = lane >> 4, lr = lane & 15;
  f32x4 st[2];
#pragma unroll
  for (int t2 = 0; t2 < 2; ++t2) {
    st[t2] = (f32x4){0.f, 0.f, 0.f, 0.f};
    const int row = kr0 + 16 * t2 + lr;
#pragma unroll
    for (int s = 0; s < 2; ++s) {
      bf16x8 kf = *(const bf16x8*)(stage + row * 128 + (((4 * s + g) ^ (row & 7)) << 4));
      st[t2] = __builtin_amdgcn_mfma_f32_16x16x32_bf16(kf, qf[s], st[t2], 0, 0, 0);
    }
  }
  bf16x8 pb;
#pragma unroll
  for (int t2 = 0; t2 < 2; ++t2)
#pragma unroll
    for (int r = 0; r < 4; ++r) {
      float pv = exp2f(mb(t2, r, st[t2][r]));
      lsum += pv;
      pb[t2 * 4 + r] = (short)f2bf(pv);
    }
  const int q = lr >> 2, pp = lane & 3;
#pragma unroll
  for (int m = 0; m < 4; ++m) {
    bf16x8 vf;
#pragma unroll
    for (int t = 0; t < 2; ++t) {
      const int row = kr0 + 16 * t + 4 * g + q;
      const char* addr = stage + 8192 + row * 128 + (((2 * m + (pp >> 1)) ^ (row & 7)) << 4) + 8 * (pp & 1);
      s16x4 v4 = __builtin_amdgcn_ds_read_tr16_b64_v4i16((__attribute__((address_space(3))) s16x4*)addr);
      vf[4 * t + 0] = v4[0]; vf[4 * t + 1] = v4[1]; vf[4 * t + 2] = v4[2]; vf[4 * t + 3] = v4[3];
    }
    o[m] = __builtin_amdgcn_mfma_f32_16x16x32_bf16(vf, pb, o[m], 0, 0, 0);
  }
}

__device__ __forceinline__ void attn_store_out(const P& p, const f32x4 (&o)[4], float lsum, int tok, int col0, int lane) {
  const int g = lane >> 4;
  lsum += __shfl_xor(lsum, 16);
  lsum += __shfl_xor(lsum, 32);
  const float inv = 1.f / lsum;
  bf16_t* op = p.mixb + (size_t)tok * 1024 + col0 + 4 * g;
#pragma unroll
  for (int m = 0; m < 4; ++m)
    *(uint2*)(op + 16 * m) = make_uint2(pack2bf(o[m][0] * inv, o[m][1] * inv), pack2bf(o[m][2] * inv, o[m][3] * inv));
}

__device__ __forceinline__ void attn_win_item(const P& p, int l, int kind, int qb, int hs, char* smem) {
  const int tid = tid_opaque(), lane = tid & 63, wv = tid >> 6, g = lane >> 4, lr = lane & 15;
  int qoff, koff, voff, ooff; const float *gq, *gk; float sink2 = -1e30f; bool has_sink = false;
  if (kind == 0 || hs < 6) {
    const int h = hs, kvh = h / 3;
    qoff = OFF_QW + h * 64; koff = OFF_KW + kvh * 64; voff = OFF_VW + kvh * 64; ooff = 256 + h * 64;
    gq = p.win_qn + l * 64; gk = p.win_kn + l * 64; sink2 = p.win_sink[l * 6 + h] * LOG2E; has_sink = true;
  } else {
    const int h = hs - 6;
    qoff = OFF_QN + h * 64; koff = OFF_KN + h * 64; voff = OFF_VN + h * 64; ooff = 640 + h * 64;
    gq = p.na_qn + l * 64; gk = p.na_kn + l * 64;
  }
  float bound = 8.f * LOG2E * wave_max(fabsf(gq[lane])) * wave_max(fabsf(gk[lane])) * 1.0001f + 1e-3f;
  if (has_sink) bound = fmaxf(bound, sink2);
  const int q0 = qb * 64;
  const int qtok = (kind == 0 ? LC : 0) + q0 + 16 * wv + lr;
  bf16x8 qf[2];
#pragma unroll
  for (int s = 0; s < 2; ++s) qf[s] = *(const bf16x8*)(p.projb + (size_t)qtok * DIN + qoff + 32 * s + 8 * g);
  f32x4 o[4];
#pragma unroll
  for (int m = 0; m < 4; ++m) o[m] = (f32x4){0.f, 0.f, 0.f, 0.f};
  float lsum = 0.f;
  const int nloc = (kind == 0) ? 5 : 0, nch = nloc + 4;
  auto tokfn = [&](int c) {
    return [=](int row) {
      if (c < nloc) { int pos = q0 - 128 + 64 * c + row; pos = pos < 0 ? 0 : (pos > SEQ - 1 ? SEQ - 1 : pos); return LC + pos; }
      return 64 * (c - nloc) + row;
    };
  };
  KVRegs kr;
  __syncthreads();
  kv_load(p, kr, koff, voff, tokfn(0), tid);
  kv_store(kr, smem, tid);
  __syncthreads();
  for (int c = 0; c < nch; ++c) {
    const char* stage = smem + (c & 1) * 16384;
    if (c + 1 < nch) kv_load(p, kr, koff, voff, tokfn(c + 1), tid);
    if (c < nloc) {
      const int qpos = q0 + 16 * wv + lr;
#pragma unroll
      for (int st = 0; st < 2; ++st) {
        const int kbase = q0 - 128 + 64 * c + 32 * st;
        attn_step(stage, 32 * st, qf, o, lsum, [&](int t2, int r, float s) {
          int kpos = kbase + 16 * t2 + 4 * g + r;
          int dlt = kpos - qpos; dlt = dlt < 0 ? -dlt : dlt;
          bool valid = (kpos >= 0) && (kpos < SEQ) && (dlt <= 128);
          return valid ? s - bound : -1e30f;
        }, lane);
      }
    } else {
#pragma unroll
      for (int st = 0; st < 2; ++st) attn_step(stage, 32 * st, qf, o, lsum, [&](int t2, int r, float s) { return s - bound; }, lane);
    }
    if (c + 1 < nch) kv_store(kr, smem + ((c + 1) & 1) * 16384, tid);
    __syncthreads();
  }
  if (has_sink && g == 0) lsum += exp2f(sink2 - bound);
  attn_store_out(p, o, lsum, qtok, ooff, lane);
}

__device__ __forceinline__ void attn_na_item(const P& p, int l, int r, int h, char* smem) {
  const int tid = tid_opaque(), lane = tid & 63, wv = tid >> 6, g = lane >> 4, lr = lane & 15;
  const int qoff = OFF_QN + h * 64, koff = OFF_KN + h * 64, voff = OFF_VN + h * 64, ooff = 640 + h * 64;
  float* rpbl = (float*)(smem + 32768);
  const float* rpbg = p.rpb + (size_t)(l * 6 + h) * 465;
  float bmax = 0.f;
  __syncthreads();
  for (int i = tid; i < 465; i += 256) { float b = rpbg[i] * LOG2E; rpbl[i] = b; }
  for (int i = lane; i < 465; i += 64) bmax = fmaxf(bmax, fabsf(rpbg[i]) * LOG2E);
  bmax = wave_max(bmax);
  const float bound = 8.f * LOG2E * wave_max(fabsf(p.na_qn[l * 64 + lane])) * wave_max(fabsf(p.na_kn[l * 64 + lane])) * 1.0001f + bmax + 1e-3f;
  const int qcol = 16 * wv + lr;
  const int qtok = LC + r * 64 + qcol;
  const int kr0r = min(max(r - 4, 0), 248);
  const int kc0 = min(max(16 * wv - 8, 0), 32);
  const int qs = min(max(qcol - 8, 0), 48);
  bf16x8 qf[2];
#pragma unroll
  for (int s = 0; s < 2; ++s) qf[s] = *(const bf16x8*)(p.projb + (size_t)qtok * DIN + qoff + 32 * s + 8 * g);
  f32x4 o[4];
#pragma unroll
  for (int m = 0; m < 4; ++m) o[m] = (f32x4){0.f, 0.f, 0.f, 0.f};
  float lsum = 0.f;
  auto tokfn = [&](int c) {
    return [=](int row) { return c < 8 ? LC + (kr0r + c) * 64 + row : 64 * (c - 8) + row; };
  };
  KVRegs kr;
  kv_load(p, kr, koff, voff, tokfn(0), tid);
  kv_store(kr, smem, tid);
  __syncthreads();
  for (int c = 0; c < 12; ++c) {
    const char* stage = smem + (c & 1) * 16384;
    if (c + 1 < 12) kv_load(p, kr, koff, voff, tokfn(c + 1), tid);
    if (c < 8) {
      const int dr = kr0r + c - r + 7;
      attn_step(stage, kc0, qf, o, lsum, [&](int t2, int rr, float s) {
        int kcol = kc0 + 16 * t2 + 4 * g + rr;
        bool valid = (kcol >= qs) && (kcol < qs + 16);
        int dc = kcol - qcol + 15; dc = dc < 0 ? 0 : (dc > 30 ? 30 : dc);
        return valid ? s + rpbl[dr * 31 + dc] - bound : -1e30f;
      }, lane);
    } else {
#pragma unroll
      for (int st = 0; st < 2; ++st) attn_step(stage, 32 * st, qf, o, lsum, [&](int t2, int rr, float s) { return s - bound; }, lane);
    }
    if (c + 1 < 12) kv_store(kr, smem + ((c + 1) & 1) * 16384, tid);
    __syncthreads();
  }
  attn_store_out(p, o, lsum, qtok, ooff, lane);
}

__device__ __forceinline__ void ph_attn(const P& p, int l, char* smem) {
  const int nitems = 3072 + (l == 0 ? 48 : 0);
  for (int it = blockIdx.x; it < nitems; it += gridDim.x) {
    if (it < 1536) attn_win_item(p, l, 0, it / 6, it % 6, smem);
    else if (it < 3072) { int j = it - 1536; attn_na_item(p, l, j / 6, j % 6, smem); }
    else { int j = it - 3072; attn_win_item(p, l, 1, j / 12, j % 12, smem); }
  }
}

__device__ __forceinline__ unsigned ord_key(float s) {
  unsigned u = __float_as_uint(s);
  return (u & 0x80000000u) ? ~u : (u | 0x80000000u);
}
__device__ __forceinline__ float ord_val(unsigned pk) {
  unsigned u = pk & ~127u;
  unsigned b = (u & 0x80000000u) ? (u & 0x7fffffffu) : ~u;
  return __uint_as_float(b);
}
__device__ __forceinline__ void ce_desc(unsigned& a, unsigned& b) {
  unsigned mx = a > b ? a : b, mn = a > b ? b : a;
  a = mx; b = mn;
}
__device__ __forceinline__ void sort16_desc(unsigned (&v)[16]) {
#pragma unroll
  for (int k = 2; k <= 16; k <<= 1) {
#pragma unroll
    for (int j = k >> 1; j > 0; j >>= 1) {
#pragma unroll
      for (int i = 0; i < 16; ++i) {
        int m = i ^ j;
        if (m > i) {
          if ((i & k) == 0) ce_desc(v[i], v[m]); else ce_desc(v[m], v[i]);
        }
      }
    }
  }
}
__device__ __forceinline__ void merge16_desc(unsigned (&a)[16], const unsigned (&b)[16]) {
#pragma unroll
  for (int i = 0; i < 16; ++i) { unsigned o = b[15 - i]; a[i] = a[i] > o ? a[i] : o; }
#pragma unroll
  for (int j = 8; j > 0; j >>= 1) {
#pragma unroll
    for (int i = 0; i < 16; ++i) {
      int m = i ^ j;
      if (m > i) ce_desc(a[i], a[m]);
    }
  }
}

typedef __attribute__((ext_vector_type(2))) float f32x2;
__device__ __forceinline__ void ph_prep_peer(const P& p) {
  const int tid = tid_opaque(), lane = tid & 63;
  const int nw = gridDim.x * 4;
  for (int row = blockIdx.x * 4 + (tid >> 6); row < 4 * 16384; row += nw) {
    const int tbl = row >> 15, le = row & 32767;
    const float4* src = (const float4*)((tbl ? p.pv : p.pu) + (size_t)le * 1024) + lane * 4;
    float4 v[4];
    float am = 0.f;
#pragma unroll
    for (int i = 0; i < 4; ++i) {
      v[i] = src[i];
      am = fmaxf(am, fmaxf(fmaxf(fabsf(v[i].x), fabsf(v[i].y)), fmaxf(fabsf(v[i].z), fabsf(v[i].w))));
    }
    am = wave_max(am);
    const float sc = am > 0.f ? 224.f / am : 1.f;
    unsigned w[4];
#pragma unroll
    for (int i = 0; i < 4; ++i) {
      int t = __builtin_amdgcn_cvt_pk_fp8_f32(v[i].x * sc, v[i].y * sc, 0, false);
      t = __builtin_amdgcn_cvt_pk_fp8_f32(v[i].z * sc, v[i].w * sc, t, true);
      w[i] = (unsigned)t;
    }
    ((uint4*)((tbl ? p.vb8 : p.ub8) + (size_t)le * 1024))[lane] = make_uint4(w[0], w[1], w[2], w[3]);
    if (lane == 0) (tbl ? p.vsc : p.usc)[le] = am > 0.f ? am / 224.f : 1.f;
  }
  for (int i = GTID; i < 2 * 128 * 128; i += GSZ) { p.k1b[i] = f2bf(p.k1[i]); p.k2b[i] = f2bf(p.k2[i]); }
}

struct EpiPeerTopk {
  int l;
  __device__ __forceinline__ void operator()(const P& p, f32x4 (&acc)[4][4], int m0, int n0, int wm, int wn, int lane, char* smem) const {
    const int tid = ((wm * 2 + wn) << 6) | lane, g = lane >> 4, lr = lane & 15;
    const int nt = n0 >> 7, head = nt >> 1, hf = nt & 1;
    char* qimg = smem;
    char* kimg = smem + 34816;
    {
      char* qw = qimg + (wm * 64 + 4 * g) * 272 + (wn * 64 + lr) * 2;
#pragma unroll
      for (int i = 0; i < 4; ++i)
#pragma unroll
        for (int r = 0; r < 4; ++r)
#pragma unroll
          for (int j = 0; j < 4; ++j) *(bf16_t*)(qw + (16 * i + r) * 272 + 32 * j) = f2bf(acc[i][j][r]);
      const bf16_t* kk = (hf ? p.k2b : p.k1b) + (size_t)l * 16384 + (tid >> 4) * 128 + (tid & 15) * 8;
      char* kw = kimg + (tid >> 4) * 272 + (tid & 15) * 16;
#pragma unroll
      for (int i = 0; i < 8; ++i) *(uint4*)(kw + i * 16 * 272) = *(const uint4*)(kk + i * 16 * 128);
    }
    __syncthreads();
#pragma unroll
    for (int i = 0; i < 4; ++i)
#pragma unroll
      for (int j = 0; j < 4; ++j) acc[i][j] = (f32x4){0.f, 0.f, 0.f, 0.f};
    {
      const char* qa = qimg + (wm * 64 + lr) * 272 + g * 16;
      const char* kb = kimg + (wn * 64 + lr) * 272 + g * 16;
#pragma unroll
      for (int s = 0; s < 4; ++s) {
        bf16x8 af[4], bfr[4];
#pragma unroll
        for (int i = 0; i < 4; ++i) af[i] = *(const bf16x8*)(qa + i * 16 * 272 + s * 64);
#pragma unroll
        for (int j = 0; j < 4; ++j) bfr[j] = *(const bf16x8*)(kb + j * 16 * 272 + s * 64);
#pragma unroll
        for (int i = 0; i < 4; ++i)
#pragma unroll
          for (int j = 0; j < 4; ++j) acc[i][j] = __builtin_amdgcn_mfma_f32_16x16x32_bf16(af[i], bfr[j], acc[i][j], 0, 0, 0);
      }
    }
    __syncthreads();
    unsigned* simg = (unsigned*)smem;
    {
      unsigned* sw = simg + (wm * 64 + 4 * g) * 129 + wn * 64 + lr;
#pragma unroll
      for (int i = 0; i < 4; ++i)
#pragma unroll
        for (int r = 0; r < 4; ++r)
#pragma unroll
          for (int j = 0; j < 4; ++j)
            sw[(16 * i + r) * 129 + 16 * j] = (ord_key(acc[i][j][r]) & ~127u) | (unsigned)(wn * 64 + 16 * j + lr);
    }
    __syncthreads();
    const int row = tid & 127, half = tid >> 7;
    unsigned top[16];
    {
      const unsigned* sr = simg + row * 129 + half * 64;
#pragma unroll
      for (int k = 0; k < 16; ++k) top[k] = sr[k];
      sort16_desc(top);
#pragma unroll 1
      for (int gi = 1; gi < 4; ++gi) {
        unsigned v1[16];
#pragma unroll
        for (int k = 0; k < 16; ++k) v1[k] = sr[gi * 16 + k];
        sort16_desc(v1);
        merge16_desc(top, v1);
      }
    }
    __syncthreads();
    if (half == 1) {
#pragma unroll
      for (int k = 0; k < 16; ++k) simg[k * 128 + row] = top[k];
    }
    __syncthreads();
    if (half == 0) {
      unsigned o[16];
#pragma unroll
      for (int k = 0; k < 16; ++k) o[k] = simg[k * 128 + row];
      merge16_desc(top, o);
      uint4* dst = (uint4*)(p.pk + (((size_t)(m0 + row) * 8 + head) * 2 + hf) * 16);
#pragma unroll
      for (int k = 0; k < 4; ++k) dst[k] = make_uint4(top[4 * k], top[4 * k + 1], top[4 * k + 2], top[4 * k + 3]);
    }
  }
};

__device__ const unsigned char CAND_A[64] = {0,0,0,0,0,0,0,0,0,0,0,0,0,0,0,0, 1,1,1,1,1,1,1,1, 2,2,2,2,2, 3,3,3,3, 4,4,4, 5,5, 6,6, 7,7,
                                             8,9,10,11,12,13,14,15, 0,0,0,0,0,0,0,0,0,0,0,0,0,0};
__device__ const unsigned char CAND_B[64] = {0,1,2,3,4,5,6,7,8,9,10,11,12,13,14,15, 0,1,2,3,4,5,6,7, 0,1,2,3,4, 0,1,2,3, 0,1,2, 0,1, 0,1, 0,1,
                                             0,0,0,0,0,0,0,0, 0,0,0,0,0,0,0,0,0,0,0,0,0,0};

__device__ __forceinline__ void ph_peer_apply2(const P& p, int l, int t0, char* smem) {
  const int tid = tid_opaque(), lane = tid & 63, wv = tid >> 6;
  int* lds_e = (int*)(smem + wv * 1024);
  float* lds_g = (float*)(smem + wv * 1024 + 512);
  const unsigned char* U = p.ub8 + (size_t)l * 16384 * 1024;
  const unsigned char* V = p.vb8 + (size_t)l * 16384 * 1024;
  const float* usc = p.usc + l * 16384;
  const float* vsc = p.vsc + l * 16384;
  const float* n2g = p.norm2_g + l * 1024;
  const int ca = CAND_A[lane], cb = CAND_B[lane];
  for (int tk = t0 + blockIdx.x * 4 + wv; tk < TT; tk += gridDim.x * 4) {
    const float* mod = p.mod + (l * 2 + (tk < LC ? 1 : 0)) * 6144;
    float xv[16], hv[16];
    {
      const float4* xp = (const float4*)(p.xall + (size_t)tk * 1024) + lane * 4;
      float ss = 0.f;
#pragma unroll
      for (int q = 0; q < 4; ++q) {
        float4 v = xp[q];
        xv[q * 4 + 0] = v.x; xv[q * 4 + 1] = v.y; xv[q * 4 + 2] = v.z; xv[q * 4 + 3] = v.w;
        ss += v.x * v.x + v.y * v.y + v.z * v.z + v.w * v.w;
      }
      ss = wave_sum(ss);
      float rinv = rsqrtf(ss * (1.f / 1024.f) + EPS);
#pragma unroll
      for (int q = 0; q < 4; ++q) {
        float4 gg = ((const float4*)n2g)[lane * 4 + q], sc = ((const float4*)(mod + 4096))[lane * 4 + q], sh = ((const float4*)(mod + 3072))[lane * 4 + q];
        hv[q * 4 + 0] = xv[q * 4 + 0] * rinv * gg.x * (1.f + sc.x) + sh.x;
        hv[q * 4 + 1] = xv[q * 4 + 1] * rinv * gg.y * (1.f + sc.y) + sh.y;
        hv[q * 4 + 2] = xv[q * 4 + 2] * rinv * gg.z * (1.f + sc.z) + sh.z;
        hv[q * 4 + 3] = xv[q * 4 + 3] * rinv * gg.w * (1.f + sc.w) + sh.w;
      }
    }
    for (int head = 0; head < 8; ++head) {
      const unsigned* pk = p.pk + ((size_t)tk * 8 + head) * 32;
      unsigned p1 = pk[ca], p2 = pk[16 + cb];
      float sum = lane < 50 ? ord_val(p1) + ord_val(p2) : -3.0e38f;
      int eid = (int)(p1 & 127u) * 128 + (int)(p2 & 127u);
      int rank = 0;
      for (int m = 0; m < 50; ++m) {
        float sm = __shfl(sum, m);
        rank += (sm > sum || (sm == sum && m < lane)) ? 1 : 0;
      }
      float mx = wave_max(sum);
      bool sel = (lane < 50) && (rank < 16);
      float e = sel ? __expf(sum - mx) : 0.f;
      float tot = wave_sum(e);
      if (sel) { lds_e[head * 16 + rank] = eid; lds_g[head * 16 + rank] = e / tot; }
    }
    float acc[16];
#pragma unroll
    for (int k = 0; k < 16; ++k) acc[k] = 0.f;
    for (int e0 = 0; e0 < 128; e0 += 8) {
      uint4 ur[8], vr[8];
      float gt[8], us[8], vs[8];
#pragma unroll
      for (int k = 0; k < 8; ++k) {
        int ex = __builtin_amdgcn_readfirstlane(lds_e[e0 + k]);
        gt[k] = lds_g[e0 + k];
        ur[k] = ((const uint4*)(U + (size_t)ex * 1024))[lane];
        vr[k] = ((const uint4*)(V + (size_t)ex * 1024))[lane];
        us[k] = usc[ex]; vs[k] = vsc[ex];
      }
#pragma unroll
      for (int k = 0; k < 8; ++k) {
        float dot = 0.f;
        unsigned w[4] = {ur[k].x, ur[k].y, ur[k].z, ur[k].w};
#pragma unroll
        for (int q = 0; q < 4; ++q) {
          f32x2 lo = __builtin_amdgcn_cvt_pk_f32_fp8((int)w[q], false), hi = __builtin_amdgcn_cvt_pk_f32_fp8((int)w[q], true);
          dot += lo[0] * hv[q * 4] + lo[1] * hv[q * 4 + 1] + hi[0] * hv[q * 4 + 2] + hi[1] * hv[q * 4 + 3];
        }
        dot = wave_sum(dot) * us[k];
        float a = gt[k] * gelu_f(dot) * vs[k];
        unsigned y[4] = {vr[k].x, vr[k].y, vr[k].z, vr[k].w};
#pragma unroll
        for (int q = 0; q < 4; ++q) {
          f32x2 lo = __builtin_amdgcn_cvt_pk_f32_fp8((int)y[q], false), hi = __builtin_amdgcn_cvt_pk_f32_fp8((int)y[q], true);
          acc[q * 4] += a * lo[0]; acc[q * 4 + 1] += a * lo[1]; acc[q * 4 + 2] += a * hi[0]; acc[q * 4 + 3] += a * hi[1];
        }
      }
    }
    {
      float4* xp = ((l == 1) ? (float4*)(p.out + (size_t)(tk - LC) * 1024) : (float4*)(p.xall + (size_t)tk * 1024)) + lane * 4;
#pragma unroll
      for (int q = 0; q < 4; ++q) {
        float4 gg = ((const float4*)(mod + 5120))[lane * 4 + q];
        float4 o;
        o.x = xv[q * 4 + 0] + gg.x * acc[q * 4 + 0];
        o.y = xv[q * 4 + 1] + gg.y * acc[q * 4 + 1];
        o.z = xv[q * 4 + 2] + gg.z * acc[q * 4 + 2];
        o.w = xv[q * 4 + 3] + gg.w * acc[q * 4 + 3];
        xp[q] = o;
      }
    }
  }
}

#define XB_TMO      128
#define XB_XCNT(j)  (256  + 64 * (j))
#define XB_XSUB(j)  (1280 + 64 * (j))
#define XB_XGEN(j)  (2304 + 64 * (j))
#define XB_TOP      3328
#define XB_TOPGEN   3392
#define XCD_BAR_WORDS 3456
#define XB_SPIN_CAP (1u << 22)
#define LAS __attribute__((address_space(3)))
__device__ __forceinline__ unsigned xb_ld(unsigned* q) { return __hip_atomic_load(q, __ATOMIC_RELAXED, __HIP_MEMORY_SCOPE_AGENT); }
__device__ __forceinline__ unsigned xb_add(unsigned* q, unsigned v) { return __hip_atomic_fetch_add(q, v, __ATOMIC_RELAXED, __HIP_MEMORY_SCOPE_AGENT); }
__device__ __forceinline__ unsigned xb_xcc_id() { return (unsigned)__builtin_amdgcn_s_getreg((3 << 11) | 20) & 0xFu; }
#define XB_SPIN(cond, bar) do { unsigned _sp = 0; while (cond) { __builtin_amdgcn_s_sleep(1); \
    if ((++_sp & 255u) == 0u) { if (xb_ld(&(bar)[XB_TMO])) break; if (_sp > XB_SPIN_CAP) { atomicAdd(&(bar)[XB_TMO], 1u); break; } } } } while (0)
struct XcdBarrier { unsigned* bar; unsigned x; volatile LAS unsigned* st; };
__device__ __forceinline__ XcdBarrier xcd_barrier_post(unsigned* bar, volatile LAS unsigned* st) {
  XcdBarrier b; b.bar = bar; b.x = xb_xcc_id(); b.st = st;
  if (threadIdx.x == 0) (void)xb_add(&bar[XB_XCNT(b.x)], 1u);
  return b;
}
__device__ __forceinline__ void xcd_barrier_complete(unsigned* bar, unsigned x, unsigned& nloc, unsigned& nx) {
  const unsigned G = gridDim.x * gridDim.y * gridDim.z;
  unsigned sum, cnt, mine, sp = 0u;
  for (;;) {
    sum = 0u; cnt = 0u; mine = 0u;
#pragma unroll
    for (unsigned j = 0; j < 16; ++j) { const unsigned c = xb_ld(&bar[XB_XCNT(j)]); sum += c; cnt += (c > 0u) ? 1u : 0u; mine = (j == x) ? c : mine; }
    if (sum == G) break;
    __builtin_amdgcn_s_sleep(1);
    if ((++sp & 255u) == 0u) { if (xb_ld(&bar[XB_TMO])) break; if (sp > XB_SPIN_CAP) { atomicAdd(&bar[XB_TMO], 1u); break; } }
  }
  nloc = mine > 0u ? mine : 1u; nx = cnt > 0u ? cnt : 1u;
}
__device__ __forceinline__ void xcd_barrier(const XcdBarrier& b) {
  asm volatile("s_waitcnt vmcnt(0)" ::: "memory");
  __syncthreads();
  if (threadIdx.x == 0) {
    unsigned* bar = b.bar;
    __builtin_amdgcn_s_waitcnt(0);
    unsigned nloc = b.st[0], nx = b.st[1];
    if (nloc == 0u) { xcd_barrier_complete(bar, b.x, nloc, nx); b.st[0] = nloc; b.st[1] = nx; }
    const unsigned old = xb_add(&bar[XB_XSUB(b.x)], 1u);
    const unsigned gen = old / nloc;
    if (old + 1u == (gen + 1u) * nloc) {
      __builtin_amdgcn_fence(__ATOMIC_RELEASE, "agent");
      asm volatile("s_waitcnt vmcnt(0)" ::: "memory");
      const unsigned og = xb_add(&bar[XB_TOP], 1u);
      const unsigned tg = og / nx;
      if (og + 1u == (tg + 1u) * nx) xb_add(&bar[XB_TOPGEN], 1u);
      else XB_SPIN(xb_ld(&bar[XB_TOPGEN]) == tg, bar);
      __builtin_amdgcn_fence(__ATOMIC_ACQUIRE, "agent");
      xb_add(&bar[XB_XGEN(b.x)], 1u);
      asm volatile("s_waitcnt vmcnt(0)" ::: "memory");
    } else {
      XB_SPIN(xb_ld(&bar[XB_XGEN(b.x)]) == gen, bar);
      __builtin_amdgcn_fence(__ATOMIC_ACQUIRE, "agent");
      asm volatile("s_waitcnt vmcnt(0)" ::: "memory");
    }
  }
  __syncthreads();
}

#ifndef PROBE_IV
#define PROBE_IV -1
#endif
__device__ __forceinline__ void probe_tick(int& cnt, unsigned long long* slots) {
  if (PROBE_IV >= 0) {
    if (threadIdx.x == 0 && (cnt == PROBE_IV || cnt == PROBE_IV + 1)) slots[cnt - PROBE_IV] = __builtin_amdgcn_s_memrealtime();
    cnt = __builtin_amdgcn_readfirstlane(cnt + 1);
  }
}
#define BARRIER() do { xcd_barrier(xb); probe_tick(pcnt, probe_t); } while (0)

typedef const __attribute__((address_space(4))) P* KP;
__device__ __forceinline__ P load_params(KP kp) {
#if defined(__HIP_DEVICE_COMPILE__)
  asm volatile("" : "+s"(kp));
  return *kp;
#else
  return P{};
#endif
}
#define PP load_params(kp)
__global__ void __launch_bounds__(256, 2) k_mega(P p_unused) {
  KP kp = (KP)__builtin_amdgcn_kernarg_segment_ptr();
  __shared__ __attribute__((aligned(16))) float smem[18432 + 8];
  uint4& xb_words = *(uint4*)(smem + 18432);
  cg::grid_group grid = cg::this_grid();
  if (threadIdx.x == 0) xb_words = make_uint4(0u, 0u, 0u, 0u);
  __syncthreads();
  unsigned long long* probe_t = (unsigned long long*)(smem + 18436);
  int pcnt = 0;
  asm volatile("" : "+s"(pcnt));
  probe_tick(pcnt, probe_t);
  ph_mod(PP, smem);
  ph_prep(PP, smem);
  ph_lru_prepw(PP);
  ph_rope_tab(PP);
  ph_prep_peer(PP);
  grid.sync();
  probe_tick(pcnt, probe_t);
  XcdBarrier xb = xcd_barrier_post(PP.bar, (volatile LAS unsigned*)&xb_words);
  ph_norm_mod(PP, 0, 0, 0, smem, true);
  BARRIER();
#pragma unroll 1
  for (int l = 0; l < 2; ++l) {
    const int t0 = (l == 0) ? 0 : LC;
    { const P lp = PP; gemm_bf16_128(lp, lp.hb, lp.w_in_t + (size_t)l * 1024 * DIN, 1024, 0, TT, DIN, (char*)smem, EpiProj{l}); }
    BARRIER();
    ph_lru<1>(PP, l, (char*)smem);
    ph_attn(PP, l, (char*)smem);
    BARRIER();
    ph_lru_carry(PP, smem);
    BARRIER();
    ph_lru<2>(PP, l, (char*)smem);
    BARRIER();
    { const P lp = PP; gemm_bf16_128(lp, lp.mixb, lp.w_out_t + (size_t)l * 1024 * 1024, 1024, t0, TT, 1024, (char*)smem, EpiResid{l, 2048}); }
    BARRIER();
    ph_norm_mod(PP, l, 1, t0, smem);
    BARRIER();
    { const P lp = PP; gemm_bf16_128(lp, lp.hb, lp.wq_t + (size_t)l * 1024 * NPQ, 1024, t0, TT, NPQ, (char*)smem, EpiPeerTopk{l}); }
    BARRIER();
    ph_peer_apply2(PP, l, t0, (char*)smem);
    if (l == 0) {
      BARRIER();
      ph_norm_mod(PP, 1, 0, 0, smem);
      BARRIER();
    }
  }
  if (PROBE_IV >= 0) {
    probe_tick(pcnt, probe_t);
    __syncthreads();
    if (blockIdx.x == 0 && threadIdx.x == 0) {
      const unsigned long long dt = (probe_t[1] - probe_t[0]) * 8ull, ts = __builtin_amdgcn_s_memrealtime();
      while (__builtin_amdgcn_s_memrealtime() - ts < dt) __builtin_amdgcn_s_sleep(8);
    }
  }
}

extern "C" void kernel_launch(void* const* d_in, const int* in_sizes, int n_in, void* d_out, int out_size, void* d_ws,
                              size_t ws_size, hipStream_t stream) {
  P p{};
  const float** fp = (const float**)&p;
  for (int i = 0; i < 28; ++i) fp[i] = (const float*)d_in[i];
  p.out = (float*)d_out;
  float* w = (float*)d_ws;
  size_t o = 0;
  auto carve = [&](size_t n) { float* r = w + o; o += (n + 63) & ~(size_t)63; return r; };
  p.bar = (unsigned*)carve(4096);
  p.mod = carve(4 * 6144);
  p.xall = carve((size_t)TT * 1024);
  p.proj = carve((size_t)TT * 512);
  p.projb = (bf16_t*)carve((size_t)TT * DIN / 2);
  p.mixb = (bf16_t*)carve((size_t)TT * 512);
  p.hb = (bf16_t*)carve((size_t)TT * 512);
  p.w_in_t = (bf16_t*)carve((size_t)1024 * DIN);
  p.w_out_t = (bf16_t*)carve((size_t)1024 * 1024);
  p.wq_t = (bf16_t*)carve((size_t)1024 * NPQ);
  p.lruw_t = (bf16_t*)carve((size_t)2 * 2 * 4 * 2 * 4096 / 2);
  p.lagg = carve((size_t)2 * NCHUNK * 256 * 2);
  p.lcarry = carve((size_t)2 * NCHUNK * 256);
  p.ropetab = carve(320 * 16 * 2);
  p.pk = (unsigned*)carve((size_t)TT * 256);
  p.ub8 = (unsigned char*)carve((size_t)2 * 16384 * 1024 / 4);
  p.vb8 = (unsigned char*)carve((size_t)2 * 16384 * 1024 / 4);
  p.usc = carve(2 * 16384);
  p.vsc = carve(2 * 16384);
  p.k1b = (bf16_t*)carve(16384);
  p.k2b = (bf16_t*)carve(16384);
  if (o * 4 > ws_size) { fprintf(stderr, "workspace too small: need %zu have %zu\n", o * 4, ws_size); return; }
  static int grid_blocks = 0;
  if (!grid_blocks) {
    int dev = 0, cus = 0, per_cu = 0;
    (void)hipGetDevice(&dev);
    (void)hipDeviceGetAttribute(&cus, hipDeviceAttributeMultiprocessorCount, dev);
    (void)hipOccupancyMaxActiveBlocksPerMultiprocessor(&per_cu, k_mega, 256, 0);
    if (per_cu > 2) per_cu = 2;
    grid_blocks = cus * per_cu;
  }
  (void)hipMemsetAsync(p.bar, 0, XCD_BAR_WORDS * 4, stream);
  void* args[] = {&p};
  hipError_t e = hipLaunchCooperativeKernel((void*)k_mega, dim3(grid_blocks), dim3(256), args, 0, stream);
  if (e != hipSuccess) fprintf(stderr, "cooperative launch failed: %s (grid %d)\n", hipGetErrorString(e), grid_blocks);
}
```

```cpp
#include <hip/hip_runtime.h>
#include <hip/hip_cooperative_groups.h>
#include <stdint.h>
#include <stdio.h>
namespace cg = cooperative_groups;

#ifndef SINGLE_LAUNCH
#define SINGLE_LAUNCH 1
#endif

constexpr int DM = 1024, SEQ = 16384, LC = 256, TT = SEQ + LC, DIN = 2304, NPQ = 2048;
constexpr int OFF_XA = 0, OFF_GA = 256, OFF_QW = 512, OFF_KW = 896, OFF_VW = 1024, OFF_QN = 1152, OFF_KN = 1536, OFF_VN = 1920;
constexpr float EPS = 1e-6f;
constexpr float LOG2E = 1.4426950408889634f;
constexpr float QSCALE = 0.125f * LOG2E;

struct P {
  const float *x, *c, *ctx, *c_ctx, *w_mod, *b_mod, *norm1_g, *norm2_g, *w_in, *w_out,
      *conv_w, *conv_b, *wa, *ba, *wx, *bx, *lam, *win_qn, *win_kn, *win_sink, *na_qn, *na_kn, *rpb,
      *wq, *k1, *k2, *pu, *pv;
  float* out;
  float *mod, *xall, *proj;
  unsigned short* projb;
  unsigned* pk;
  unsigned* bar;
  unsigned short *k1b, *k2b;
  unsigned char *ub8, *vb8;
  float *usc, *vsc;
  unsigned short *hb, *mixb, *w_in_t, *w_out_t, *wq_t, *lruw_t;
  float *lagg, *lcarry, *ropetab;
};

typedef unsigned short bf16_t;
typedef __attribute__((ext_vector_type(8))) short bf16x8;
typedef __attribute__((ext_vector_type(4))) float f32x4;
__device__ __forceinline__ unsigned short f2bf(float f) {
  unsigned u = __float_as_uint(f);
  u += 0x7fffu + ((u >> 16) & 1u);
  return (unsigned short)(u >> 16);
}
__device__ __forceinline__ unsigned pack2bf(float a, float b) { return (unsigned)f2bf(a) | ((unsigned)f2bf(b) << 16); }
__device__ __forceinline__ float bf2f(unsigned short h) { return __uint_as_float(((unsigned)h) << 16); }


__device__ __forceinline__ float silu_f(float x) { return x / (1.f + __expf(-x)); }
__device__ __forceinline__ float sigmoid_f(float x) { return 1.f / (1.f + __expf(-x)); }
__device__ __forceinline__ float gelu_f(float x) {
  float u = 0.7978845608028654f * (x + 0.044715f * x * x * x);
  float e = __expf(2.f * u);
  float th = 1.f - 2.f / (e + 1.f);
  return 0.5f * x * (1.f + th);
}
template <int CTRL, int RMASK>
__device__ __forceinline__ float dpp_mov(float v) {
  return __int_as_float(__builtin_amdgcn_update_dpp(0, __float_as_int(v), CTRL, RMASK, 0xf, false));
}
__device__ __forceinline__ float wave_sum(float v) {
  v += dpp_mov<0xB1, 0xf>(v);
  v += dpp_mov<0x4E, 0xf>(v);
  v += dpp_mov<0x141, 0xf>(v);
  v += dpp_mov<0x140, 0xf>(v);
  v += dpp_mov<0x142, 0xa>(v);
  v += dpp_mov<0x143, 0xc>(v);
  return __int_as_float(__builtin_amdgcn_readlane(__float_as_int(v), 63));
}

__device__ __forceinline__ int tid_opaque() { int t = threadIdx.x; asm volatile("" : "+v"(t)); return t; }
#define GTID (blockIdx.x * blockDim.x + tid_opaque())
#define GSZ (gridDim.x * blockDim.x)

__device__ __forceinline__ void ph_mod(const P& p, float* smem) {
  const int tid = tid_opaque(), cl = tid & 31, ks = tid >> 5;
  for (int it = blockIdx.x; it < 2 * 192; it += gridDim.x) {
    const int nc = it % 192, l = it / 192;
    const int n = nc * 32 + cl;
    const float* w = p.w_mod + (size_t)l * 1024 * 6144 + n;
    float a0 = 0.f, a1 = 0.f;
#pragma unroll 8
    for (int i = 0; i < 128; ++i) {
      int k = i * 8 + ks;
      float wv = w[(size_t)k * 6144];
      a0 += silu_f(p.c[k]) * wv;
      a1 += silu_f(p.c_ctx[k]) * wv;
    }
    __syncthreads();
    smem[tid] = a0; smem[256 + tid] = a1;
    __syncthreads();
    if (tid < 64) {
      const int which = tid >> 5;
      float s = p.b_mod[l * 6144 + n];
#pragma unroll
      for (int q = 0; q < 8; ++q) s += smem[which * 256 + q * 32 + cl];
      p.mod[(l * 2 + which) * 6144 + n] = s;
    }
  }
}

__device__ __forceinline__ void ph_copy_in(const P& p) {
  const float4* xs = (const float4*)p.x;
  const float4* cs = (const float4*)p.ctx;
  float4* d = (float4*)p.xall;
  for (int i = GTID; i < TT * 256; i += GSZ) d[i] = (i < LC * 256) ? cs[i] : xs[i - LC * 256];
}

__device__ __forceinline__ void ph_copy_out(const P& p) {
  const float4* s = (const float4*)(p.xall + (size_t)LC * 1024);
  float4* d = (float4*)p.out;
  for (int i = GTID; i < SEQ * 256; i += GSZ) d[i] = s[i];
}

__device__ __forceinline__ void ph_norm_mod(const P& p, int l, int which_norm, int t0, float* smem, bool from_input = false) {
  const float* g = (which_norm ? p.norm2_g : p.norm1_g) + l * 1024;
  const int sh_off = which_norm ? 3072 : 0, sc_off = which_norm ? 4096 : 1024;
  const int tid = tid_opaque();
  for (int t = t0 + blockIdx.x; t < TT; t += gridDim.x) {
    const float* mod = p.mod + (l * 2 + (t < LC ? 1 : 0)) * 6144;
    float4 v;
    if (from_input) {
      v = t < LC ? ((const float4*)(p.ctx + (size_t)t * 1024))[tid] : ((const float4*)(p.x + (size_t)(t - LC) * 1024))[tid];
      ((float4*)(p.xall + (size_t)t * 1024))[tid] = v;
    } else v = ((const float4*)(p.xall + (size_t)t * 1024))[tid];
    float ss = wave_sum(v.x * v.x + v.y * v.y + v.z * v.z + v.w * v.w);
    __syncthreads();
    if ((tid & 63) == 0) smem[tid >> 6] = ss;
    __syncthreads();
    float tot = smem[0] + smem[1] + smem[2] + smem[3];
    float rinv = rsqrtf(tot * (1.f / 1024.f) + EPS);
    float4 gg = ((const float4*)g)[tid];
    float4 sc = ((const float4*)(mod + sc_off))[tid];
    float4 sh = ((const float4*)(mod + sh_off))[tid];
    float4 o;
    o.x = v.x * rinv * gg.x * (1.f + sc.x) + sh.x;
    o.y = v.y * rinv * gg.y * (1.f + sc.y) + sh.y;
    o.z = v.z * rinv * gg.z * (1.f + sc.z) + sh.z;
    o.w = v.w * rinv * gg.w * (1.f + sc.w) + sh.w;
    ((uint2*)(p.hb + (size_t)t * 1024))[tid] = make_uint2(pack2bf(o.x, o.y), pack2bf(o.z, o.w));
  }
}

__device__ __forceinline__ void prep_transpose(const float* W, bf16_t* Wt, int K, int N, int item0, int nitems_total, float* smem) {
  (void)nitems_total;
  float(*ts)[65] = (float(*)[65])smem;
  const int tid = tid_opaque();
  const int tn = N / 64, nt = (K / 64) * tn;
  for (int it = blockIdx.x; it < nt; it += gridDim.x) {
    int k0 = (it / tn) * 64, n0 = (it % tn) * 64;
    __syncthreads();
#pragma unroll
    for (int i = 0; i < 16; ++i) {
      int r = (tid >> 6) + i * 4, c = tid & 63;
      ts[r][c] = W[(size_t)(k0 + r) * N + n0 + c];
    }
    __syncthreads();
#pragma unroll
    for (int i = 0; i < 16; ++i) {
      int r = (tid >> 6) + i * 4, c = tid & 63;
      Wt[(size_t)(n0 + r) * K + k0 + c] = f2bf(ts[c][r]);
    }
  }
  (void)item0;
}

__device__ __forceinline__ void ph_prep(const P& p, float* smem) {
  for (int l = 0; l < 2; ++l) {
    prep_transpose(p.w_in + (size_t)l * 1024 * DIN, p.w_in_t + (size_t)l * 1024 * DIN, 1024, DIN, 0, 0, smem);
    prep_transpose(p.w_out + (size_t)l * 1024 * 1024, p.w_out_t + (size_t)l * 1024 * 1024, 1024, 1024, 0, 0, smem);
    prep_transpose(p.wq + (size_t)l * 1024 * NPQ, p.wq_t + (size_t)l * 1024 * NPQ, 1024, NPQ, 0, 0, smem);
  }
}

struct EpiStoreF32 {
  float* C; int ldc;
  __device__ __forceinline__ void operator()(const P& p, f32x4 (&acc)[4][4], int m0, int n0, int wm, int wn, int lane, char* smem) const {
    const int mw0 = m0 + wm * 64, nw0 = n0 + wn * 64;
#pragma unroll
    for (int i = 0; i < 4; ++i)
#pragma unroll
      for (int r = 0; r < 4; ++r) {
        int row = mw0 + 16 * i + (lane >> 4) * 4 + r;
#pragma unroll
        for (int j = 0; j < 4; ++j) C[(size_t)row * ldc + nw0 + 16 * j + (lane & 15)] = acc[i][j][r];
      }
  }
};
struct EpiProjSplit {
  __device__ __forceinline__ void operator()(const P& p, f32x4 (&acc)[4][4], int m0, int n0, int wm, int wn, int lane, char* smem) const {
    const int mw0 = m0 + wm * 64, nw0 = n0 + wn * 64;
#pragma unroll
    for (int i = 0; i < 4; ++i)
#pragma unroll
      for (int r = 0; r < 4; ++r) {
        int row = mw0 + 16 * i + (lane >> 4) * 4 + r;
#pragma unroll
        for (int j = 0; j < 4; ++j) {
          int col = nw0 + 16 * j + (lane & 15);
          if (n0 < 512) p.proj[(size_t)row * 512 + col] = acc[i][j][r];
          else p.projb[(size_t)row * DIN + col] = f2bf(acc[i][j][r]);
        }
      }
  }
};
__device__ __forceinline__ void ph_rope_tab(const P& p) {
  for (int idx = GTID; idx < 320 * 16; idx += GSZ) {
    int v = idx >> 4, j = idx & 15;
    float inv = __expf(-(float)j * (1.f / 16.f) * 9.210340371976184f);
    float ang = (float)(v < 256 ? v : v - 256) * inv;
    float k = rintf(ang * 0.15915494309189535f);
    float r = fmaf(-k, 6.2831854820251465f, ang);
    r = fmaf(-k, -1.7484555e-07f, r);
    ((float2*)p.ropetab)[idx] = make_float2(__cosf(r), __sinf(r));
  }
}

template <int CTRL>
__device__ __forceinline__ float dpp_row(float v) {
  return __int_as_float(__builtin_amdgcn_update_dpp(0, __float_as_int(v), CTRL, 0xf, 0xf, false));
}
struct EpiProj {
  int l;
  __device__ __forceinline__ void operator()(const P& p, f32x4 (&acc)[4][4], int m0, int n0, int wm, int wn, int lane, char* smem) const {
    const int g = lane >> 4, lr = lane & 15;
    const int mw0 = m0 + wm * 64, nw0 = n0 + wn * 64;
    if (n0 < 512) {
#pragma unroll
      for (int i = 0; i < 4; ++i)
#pragma unroll
        for (int r = 0; r < 4; ++r) {
          int row = mw0 + 16 * i + 4 * g + r;
#pragma unroll
          for (int j = 0; j < 4; ++j) p.proj[(size_t)row * 512 + nw0 + 16 * j + lr] = acc[i][j][r];
        }
      return;
    }
    const float* gain = nullptr; bool rope = false; float scale = 1.f;
    if (nw0 < 896) { gain = p.win_qn + l * 64; rope = true; scale = QSCALE; }
    else if (nw0 < 1024) { gain = p.win_kn + l * 64; rope = true; }
    else if (nw0 < 1152) { }
    else if (nw0 < 1536) { gain = p.na_qn + l * 64; scale = QSCALE; }
    else if (nw0 < 1920) { gain = p.na_kn + l * 64; }
    rope = rope && (m0 >= LC);
    float gj[4] = {1.f, 1.f, 1.f, 1.f};
    if (gain) {
#pragma unroll
      for (int j = 0; j < 4; ++j) gj[j] = gain[16 * j + lr] * scale;
    }
#pragma unroll
    for (int i = 0; i < 4; ++i)
#pragma unroll
      for (int r = 0; r < 4; ++r) {
        const int row = mw0 + 16 * i + 4 * g + r;
        float y[4] = {acc[i][0][r], acc[i][1][r], acc[i][2][r], acc[i][3][r]};
        if (gain) {
          float ss = y[0] * y[0] + y[1] * y[1] + y[2] * y[2] + y[3] * y[3];
          ss += dpp_row<0xB1>(ss);
          ss += dpp_row<0x4E>(ss);
          ss += dpp_row<0x141>(ss);
          ss += dpp_row<0x140>(ss);
          const float rinv = rsqrtf(ss * (1.f / 64.f) + EPS);
#pragma unroll
          for (int j = 0; j < 4; ++j) y[j] *= rinv * gj[j];
        }
        if (rope) {
          const int pos = row - LC;
          const float2 tr = ((const float2*)p.ropetab)[(pos >> 6) * 16 + lr];
          const float2 tc = ((const float2*)p.ropetab)[(256 + (pos & 63)) * 16 + lr];
          float a0 = y[0] * tr.x - y[1] * tr.y, a1 = y[0] * tr.y + y[1] * tr.x;
          float a2 = y[2] * tc.x - y[3] * tc.y, a3 = y[2] * tc.y + y[3] * tc.x;
          y[0] = a0; y[1] = a1; y[2] = a2; y[3] = a3;
        }
#pragma unroll
        for (int j = 0; j < 4; ++j) p.projb[(size_t)row * DIN + nw0 + 16 * j + lr] = f2bf(y[j]);
      }
  }
};
struct EpiResid {
  int l, gofs;
  __device__ __forceinline__ void operator()(const P& p, f32x4 (&acc)[4][4], int m0, int n0, int wm, int wn, int lane, char* smem) const {
    const int mw0 = m0 + wm * 64, nw0 = n0 + wn * 64;
#pragma unroll
    for (int i = 0; i < 4; ++i)
#pragma unroll
      for (int r = 0; r < 4; ++r) {
        int row = mw0 + 16 * i + (lane >> 4) * 4 + r;
        const float* gt = p.mod + (l * 2 + (row < LC ? 1 : 0)) * 6144 + gofs;
#pragma unroll
        for (int j = 0; j < 4; ++j) {
          int col = nw0 + 16 * j + (lane & 15);
          p.xall[(size_t)row * 1024 + col] += gt[col] * acc[i][j][r];
        }
      }
  }
};

__device__ __forceinline__ int gemm_swz(int row) { return (0x78 >> (((row >> 2) & 3) * 2)) & 3; }
template <class Epi>
__device__ __forceinline__ void gemm_bf16_128(const P& p, const bf16_t* __restrict__ A, const bf16_t* __restrict__ Bt, int K, int m_begin, int m_end,
                              int N, char* smem, const Epi& epi) {
  const int tid = tid_opaque(), lane = tid & 63, wv = __builtin_amdgcn_readfirstlane(tid >> 6), wm = wv >> 1, wn = wv & 1;
  const int tiles_n = N / 128, tiles_m = (m_end - m_begin) / 128;
  const int nk = K / 32;
  const int lr = lane & 15, g = lane >> 4;
  const int a_rd = (wm * 64 + lr) * 64 + ((g ^ gemm_swz(lr)) << 4);
  const int b_rd = 8192 + (wn * 64 + lr) * 64 + ((g ^ gemm_swz(lr)) << 4);
  const int ld_row = lane >> 2, ld_c = (lane & 3) ^ gemm_swz(ld_row);
  for (int tile = blockIdx.x; tile < tiles_m * tiles_n; tile += gridDim.x) {
    const int m0 = m_begin + (tile / tiles_n) * 128, n0 = (tile % tiles_n) * 128;
    f32x4 acc[4][4];
#pragma unroll
    for (int i = 0; i < 4; ++i)
#pragma unroll
      for (int j = 0; j < 4; ++j) acc[i][j] = (f32x4){0.f, 0.f, 0.f, 0.f};
    const bf16_t* Ag = A + (size_t)(m0 + wv * 32 + ld_row) * K + ld_c * 8;
    const bf16_t* Bg = Bt + (size_t)(n0 + wv * 32 + ld_row) * K + ld_c * 8;
    auto issue = [&](int st, int kt) {
      char* base = smem + st * 16384 + wv * 2048;
#pragma unroll
      for (int i = 0; i < 2; ++i) {
        __builtin_amdgcn_global_load_lds((const unsigned*)(Ag + (size_t)i * 16 * K + kt * 32), (__attribute__((address_space(3))) unsigned*)(base + i * 1024), 16, 0, 0);
        __builtin_amdgcn_global_load_lds((const unsigned*)(Bg + (size_t)i * 16 * K + kt * 32), (__attribute__((address_space(3))) unsigned*)(base + 8192 + i * 1024), 16, 0, 0);
      }
    };
    issue(0, 0); issue(1, 1); issue(2, 2);
    for (int kt0 = 0; kt0 < nk; kt0 += 4) {
#pragma unroll
      for (int u = 0; u < 4; ++u) {
        const int kt = kt0 + u, rem = nk - kt;
        if (rem >= 3) asm volatile("s_waitcnt vmcnt(8) lgkmcnt(0)" ::: "memory");
        else if (rem == 2) asm volatile("s_waitcnt vmcnt(4) lgkmcnt(0)" ::: "memory");
        else asm volatile("s_waitcnt vmcnt(0) lgkmcnt(0)" ::: "memory");
        __builtin_amdgcn_s_barrier();
        if (kt + 3 < nk) issue((u + 3) & 3, kt + 3);
        bf16x8 af[4], bfr[4];
#pragma unroll
        for (int i = 0; i < 4; ++i) af[i] = *(const bf16x8*)(smem + u * 16384 + a_rd + i * 1024);
#pragma unroll
        for (int j = 0; j < 4; ++j) bfr[j] = *(const bf16x8*)(smem + u * 16384 + b_rd + j * 1024);
#pragma unroll
        for (int i = 0; i < 4; ++i)
#pragma unroll
          for (int j = 0; j < 4; ++j) acc[i][j] = __builtin_amdgcn_mfma_f32_16x16x32_bf16(af[i], bfr[j], acc[i][j], 0, 0, 0);
      }
    }
    __syncthreads();
    epi(p, acc, m0, n0, wm, wn, lane, smem);
    __syncthreads();
  }
}

constexpr int NCHUNK = TT / 64;
__device__ __forceinline__ int lru_pos(int dir, int c) { return dir == 0 ? c : (c < 4 ? 3 - c : 4 + (NCHUNK - 1 - c)); }

__device__ __forceinline__ void ph_lru_prepw(const P& p) {
  for (int idx = GTID; idx < 2 * 2 * 4 * 2 * 4096; idx += GSZ) {
    int d = idx & 63, e = (idx >> 6) & 63, mtx = (idx >> 12) & 1, rest = idx >> 13;
    const float* w = (mtx ? p.wx : p.wa) + (size_t)rest * 4096;
    p.lruw_t[idx] = f2bf(w[d * 64 + e]);
  }
}

template <int PASS>
__device__ __forceinline__ void lru_item(const P& p, int l, int cidx, int kb, char* smem) {
  bf16_t* u_img = (bf16_t*)smem;
  float* ab_a = (float*)(smem + 8192);
  float* ab_b = (float*)(smem + 8192 + 16384);
  float* hsum = (float*)(smem + 8192 + 32768);
  float* segagg = (float*)(smem + 8192 + 49152);
  float* ccarry = (float*)(smem + 8192 + 49152 + 2048);
  const int tid = tid_opaque(), lane = tid & 63, wv = tid >> 6, g = lane >> 4, lr = lane & 15;
  const int t0 = cidx * 64;
  const int lo = t0 < LC ? 0 : LC, hi = t0 < LC ? LC : TT;
  __syncthreads();
  {
    const int ch = tid & 63, c = kb * 64 + ch, sg = tid >> 6;
    const float cb = p.conv_b[l * 256 + c];
    float cw[4];
#pragma unroll
    for (int k = 0; k < 4; ++k) cw[k] = p.conv_w[(l * 4 + k) * 256 + c];
    float xr[19];
#pragma unroll
    for (int i = 0; i < 19; ++i) {
      int tt = t0 + sg * 16 + i - 2;
      int tc = tt < lo ? lo : (tt >= hi ? hi - 1 : tt);
      float v = p.proj[(size_t)tc * 512 + OFF_XA + c];
      xr[i] = (tt >= lo && tt < hi) ? v : 0.f;
    }
#pragma unroll
    for (int i = 0; i < 16; ++i) {
      int row = sg * 16 + i;
      float acc = cb + cw[0] * xr[i] + cw[1] * xr[i + 1] + cw[2] * xr[i + 2] + cw[3] * xr[i + 3];
      u_img[row * 64 + ((((ch >> 3) ^ (row & 7)) << 3) | (ch & 7))] = f2bf(acc);
    }
  }
  if (PASS == 2) {
    if (tid < 128) {
      const int ch = tid & 63, dir = tid >> 6;
      ccarry[dir * 64 + ch] = p.lcarry[((size_t)dir * NCHUNK + lru_pos(dir, cidx)) * 256 + kb * 64 + ch];
    }
  }
  __syncthreads();
  for (int dir = 0; dir < 2; ++dir) {
    const int pd = l * 2 + dir;
    {
      f32x4 ga[4], gx[4];
#pragma unroll
      for (int i = 0; i < 4; ++i) { ga[i] = (f32x4){0.f, 0.f, 0.f, 0.f}; gx[i] = (f32x4){0.f, 0.f, 0.f, 0.f}; }
      const bf16_t* wbase = p.lruw_t + (size_t)((pd * 4 + kb) * 2) * 4096 + (16 * wv + lr) * 64 + 8 * g;
#pragma unroll
      for (int s = 0; s < 2; ++s) {
        bf16x8 ba_ = *(const bf16x8*)(wbase + 32 * s);
        bf16x8 bx_ = *(const bf16x8*)(wbase + 4096 + 32 * s);
#pragma unroll
        for (int i = 0; i < 4; ++i) {
          int row = 16 * i + lr;
          bf16x8 af = *(const bf16x8*)((const char*)u_img + row * 128 + (((4 * s + g) ^ (row & 7)) << 4));
          ga[i] = __builtin_amdgcn_mfma_f32_16x16x32_bf16(af, ba_, ga[i], 0, 0, 0);
          gx[i] = __builtin_amdgcn_mfma_f32_16x16x32_bf16(af, bx_, gx[i], 0, 0, 0);
        }
      }
      const int ch = 16 * wv + lr, c = kb * 64 + ch;
      const float bav = p.ba[pd * 256 + c], bxv = p.bx[pd * 256 + c];
      const float sp = log1pf(expf(-p.lam[pd * 256 + c]));
#pragma unroll
      for (int i = 0; i < 4; ++i)
#pragma unroll
        for (int r = 0; r < 4; ++r) {
          int row = 16 * i + 4 * g + r;
          float rr = sigmoid_f(ga[i][r] + bav), ig = sigmoid_f(gx[i][r] + bxv);
          float log_a = -8.f * rr * sp;
          float a = __expf(log_a);
          float uu = bf2f(u_img[row * 64 + ((((ch >> 3) ^ (row & 7)) << 3) | (ch & 7))]);
          const float x2 = 2.f * log_a;
          const float ser = -x2 * (1.f + x2 * (0.5f + x2 * (0.16666667f + x2 * (0.041666668f + x2 * 0.0083333338f))));
          const float om = x2 > -0.25f ? ser : 1.f - a * a;
          float b = sqrtf(om) * ig * uu;
          ab_a[row * 64 + ch] = a;
          ab_b[row * 64 + ch] = b;
        }
    }
    __syncthreads();
    {
      const int ch = tid & 63, seg = tid >> 6;
      float Pr = 1.f, H = 0.f;
#pragma unroll
      for (int i = 0; i < 16; ++i) {
        int row = dir == 0 ? seg * 16 + i : seg * 16 + 15 - i;
        float a = ab_a[row * 64 + ch], b = ab_b[row * 64 + ch];
        H = a * H + b;
        Pr *= a;
      }
      segagg[(seg * 64 + ch) * 2] = Pr;
      segagg[(seg * 64 + ch) * 2 + 1] = H;
      __syncthreads();
      if (PASS == 1) {
        if (seg == 0) {
          float A = 1.f, B = 0.f;
#pragma unroll
          for (int s2 = 0; s2 < 4; ++s2) {
            int sg = dir == 0 ? s2 : 3 - s2;
            float pa = segagg[(sg * 64 + ch) * 2], pb = segagg[(sg * 64 + ch) * 2 + 1];
            B = pa * B + pb;
            A *= pa;
          }
          float2* ag = (float2*)p.lagg + ((size_t)dir * NCHUNK + lru_pos(dir, cidx)) * 256 + kb * 64 + ch;
          *ag = make_float2(A, B);
        }
      } else {
        float h = ccarry[dir * 64 + ch];
        float gav[16];
        if (dir == 1) {
#pragma unroll
          for (int i = 0; i < 16; ++i) gav[i] = p.proj[(size_t)(t0 + seg * 16 + 15 - i) * 512 + OFF_GA + kb * 64 + ch];
        }
#pragma unroll
        for (int s2 = 0; s2 < 3; ++s2) {
          int sg = dir == 0 ? s2 : 3 - s2;
          bool before = dir == 0 ? (sg < seg) : (sg > seg);
          if (before) h = segagg[(sg * 64 + ch) * 2] * h + segagg[(sg * 64 + ch) * 2 + 1];
        }
#pragma unroll
        for (int i = 0; i < 16; ++i) {
          int row = dir == 0 ? seg * 16 + i : seg * 16 + 15 - i;
          float a = ab_a[row * 64 + ch], b = ab_b[row * 64 + ch];
          h = a * h + b;
          if (dir == 0) hsum[row * 64 + ch] = h;
          else {
            int t = t0 + row, c = kb * 64 + ch;
            p.mixb[(size_t)t * 1024 + c] = f2bf((hsum[row * 64 + ch] + h) * gelu_f(gav[i]));
          }
        }
      }
    }
    __syncthreads();
  }
}

__device__ __forceinline__ void ph_lru_carry(const P& p, float* smem) {
  const int tid = tid_opaque(), seg = tid >> 4, c16 = tid & 15;
  for (int blk = blockIdx.x; blk < 32; blk += gridDim.x) {
    const int dc = blk * 16 + c16, dir = dc >> 8, ch = dc & 255;
    const float2* ag = (const float2*)p.lagg + (size_t)dir * NCHUNK * 256 + ch;
    float2 v[17];
#pragma unroll
    for (int i = 0; i < 17; ++i) {
      int pos = seg * 17 + i;
      v[i] = pos < NCHUNK ? ag[(size_t)pos * 256] : make_float2(1.f, 0.f);
    }
    float A = 1.f, B = 0.f;
#pragma unroll
    for (int i = 0; i < 17; ++i) { B = v[i].x * B + v[i].y; A *= v[i].x; }
    __syncthreads();
    smem[(seg * 16 + c16) * 2] = A; smem[(seg * 16 + c16) * 2 + 1] = B;
    __syncthreads();
    float h = 0.f;
    for (int s2 = 0; s2 < seg; ++s2) h = smem[(s2 * 16 + c16) * 2] * h + smem[(s2 * 16 + c16) * 2 + 1];
    float* cr = p.lcarry + (size_t)dir * NCHUNK * 256 + ch;
#pragma unroll
    for (int i = 0; i < 17; ++i) {
      int pos = seg * 17 + i;
      if (pos < NCHUNK) cr[(size_t)pos * 256] = h;
      h = v[i].x * h + v[i].y;
    }
  }
}

template <int PASS>
__device__ __forceinline__ void ph_lru(const P& p, int l, char* smem) {
  const int c_begin = (PASS == 2 && l == 1) ? 4 : 0;
  const int nitems = (NCHUNK - c_begin) * 4;
  for (int it = blockIdx.x; it < nitems; it += gridDim.x) lru_item<PASS>(p, l, c_begin + (it >> 2), it & 3, smem);
}

typedef __attribute__((ext_vector_type(4))) short s16x4;

__device__ __forceinline__ void ph_qknorm_rope2(const P& p, int l) {
  const int tid_ = tid_opaque();
  const int lane = tid_ & 63;
  const int wpb = blockDim.x >> 6;
  for (int pair = blockIdx.x * wpb + (tid_ >> 6); pair < TT * 28; pair += gridDim.x * wpb) {
    int t = pair / 28, slot = pair % 28;
    const float* g = nullptr; bool rope = false; float scale = 1.f;
    if (slot < 6) { g = p.win_qn + l * 64; rope = true; scale = QSCALE; }
    else if (slot < 8) { g = p.win_kn + l * 64; rope = true; }
    else if (slot < 10) { }
    else if (slot < 16) { g = p.na_qn + l * 64; scale = QSCALE; }
    else if (slot < 22) { g = p.na_kn + l * 64; }
    rope = rope && (t >= LC);
    const size_t idx = (size_t)t * DIN + 512 + slot * 64 + lane;
    float v = bf2f(p.projb[idx]);
    float y = v;
    if (g) {
      float ss = wave_sum(v * v);
      y = v * rsqrtf(ss * (1.f / 64.f) + EPS) * g[lane];
    }
    float partner = __shfl_xor(y, 16);
    if (rope) {
      int pos = t - LC, row = pos >> 6, col = pos & 63;
      int j = lane & 15, axis = lane >> 5;
      float inv = __expf(-(float)j * (1.f / 16.f) * 9.210340371976184f);
      float ang = (float)(axis ? col : row) * inv;
      float k = rintf(ang * 0.15915494309189535f);
      float r = fmaf(-k, 6.2831854820251465f, ang);
      r = fmaf(-k, -1.7484555e-07f, r);
      float cs = __cosf(r), sn = __sinf(r);
      bool first = ((lane >> 4) & 1) == 0;
      y = first ? (y * cs - partner * sn) : (partner * sn + y * cs);
    }
    p.projb[idx] = f2bf(y * scale);
  }
}

template <int CTRL, int RMASK>
__device__ __forceinline__ float dpp_mov_id(float v) {
  return __int_as_float(__builtin_amdgcn_update_dpp(__float_as_int(v), __float_as_int(v), CTRL, RMASK, 0xf, false));
}
__device__ __forceinline__ float wave_max(float v) {
  v = fmaxf(v, dpp_mov_id<0xB1, 0xf>(v));
  v = fmaxf(v, dpp_mov_id<0x4E, 0xf>(v));
  v = fmaxf(v, dpp_mov_id<0x141, 0xf>(v));
  v = fmaxf(v, dpp_mov_id<0x140, 0xf>(v));
  v = fmaxf(v, dpp_mov_id<0x142, 0xa>(v));
  v = fmaxf(v, dpp_mov_id<0x143, 0xc>(v));
  return __int_as_float(__builtin_amdgcn_readlane(__float_as_int(v), 63));
}

template <class TokFn>
__device__ __forceinline__ void kv_issue(const P& p, char* stage, int koff, int voff, TokFn tok, int wv, int lane) {
#pragma unroll
  for (int i = 0; i < 2; ++i) {
    const int row = 16 * wv + 8 * i + (lane >> 3);
    const bf16_t* src = p.projb + (size_t)tok(row) * DIN + (((lane & 7) ^ (row & 7)) << 3);
    char* dst = stage + (2 * wv + i) * 1024;
    __builtin_amdgcn_global_load_lds((const unsigned*)(src + koff), (__attribute__((address_space(3))) unsigned*)dst, 16, 0, 0);
    __builtin_amdgcn_global_load_lds((const unsigned*)(src + voff), (__attribute__((address_space(3))) unsigned*)(dst + 8192), 16, 0, 0);
  }
}
__device__ __forceinline__ void kv_wait(int rem) {
  if (rem >= 3) asm volatile("s_waitcnt vmcnt(8) lgkmcnt(0)" ::: "memory");
  else if (rem == 2) asm volatile("s_waitcnt vmcnt(4) lgkmcnt(0)" ::: "memory");
  else asm volatile("s_waitcnt vmcnt(0) lgkmcnt(0)" ::: "memory");
  __builtin_amdgcn_s_barrier();
}

template <class MaskFn>
__device__ __forceinline__ void attn_step2(const char* stage, int kr0, const bf16x8 (&qf)[2][2], f32x4 (&o)[2][4], float (&lsum)[2], MaskFn mb,
                                           int lane, bool act0, bool act1) {
  const int g = lane >> 4, lr = lane & 15;
  bf16x8 kf[2][2];
#pragma unroll
  for (int t2 = 0; t2 < 2; ++t2) {
    const int row = kr0 + 16 * t2 + lr;
#pragma unroll
    for (int s = 0; s < 2; ++s) kf[t2][s] = *(const bf16x8*)(stage + row * 128 + (((4 * s + g) ^ (row & 7)) << 4));
  }
  bf16x8 pb[2];
#pragma unroll
  for (int qt = 0; qt < 2; ++qt) {
    if (qt == 0 ? act0 : act1) {
      f32x4 st[2];
#pragma unroll
      for (int t2 = 0; t2 < 2; ++t2) {
        st[t2] = (f32x4){0.f, 0.f, 0.f, 0.f};
#pragma unroll
        for (int s = 0; s < 2; ++s) st[t2] = __builtin_amdgcn_mfma_f32_16x16x32_bf16(kf[t2][s], qf[qt][s], st[t2], 0, 0, 0);
      }
#pragma unroll
      for (int t2 = 0; t2 < 2; ++t2)
#pragma unroll
        for (int r = 0; r < 4; ++r) {
          float pv = exp2f(mb(qt, t2, r, st[t2][r]));
          lsum[qt] += pv;
          pb[qt][t2 * 4 + r] = (short)f2bf(pv);
        }
    }
  }
  const int q = lr >> 2, pp = lane & 3;
#pragma unroll
  for (int m = 0; m < 4; ++m) {
    bf16x8 vf;
#pragma unroll
    for (int t = 0; t < 2; ++t) {
      const int row = kr0 + 16 * t + 4 * g + q;
      const char* addr = stage + 8192 + row * 128 + (((2 * m + (pp >> 1)) ^ (row & 7)) << 4) + 8 * (pp & 1);
      s16x4 v4 = __builtin_amdgcn_ds_read_tr16_b64_v4i16((__attribute__((address_space(3))) s16x4*)addr);
      vf[4 * t + 0] = v4[0]; vf[4 * t + 1] = v4[1]; vf[4 * t + 2] = v4[2]; vf[4 * t + 3] = v4[3];
    }
    if (act0) o[0][m] = __builtin_amdgcn_mfma_f32_16x16x32_bf16(vf, pb[0], o[0][m], 0, 0, 0);
    if (act1) o[1][m] = __builtin_amdgcn_mfma_f32_16x16x32_bf16(vf, pb[1], o[1][m], 0, 0, 0);
  }
}

__device__ __forceinline__ void attn_store_out(const P& p, const f32x4 (&o)[4], float lsum, int tok, int col0, int lane) {
  const int g = lane >> 4;
  lsum += __shfl_xor(lsum, 16);
  lsum += __shfl_xor(lsum, 32);
  const float inv = 1.f / lsum;
  bf16_t* op = p.mixb + (size_t)tok * 1024 + col0 + 4 * g;
#pragma unroll
  for (int m = 0; m < 4; ++m)
    *(uint2*)(op + 16 * m) = make_uint2(pack2bf(o[m][0] * inv, o[m][1] * inv), pack2bf(o[m][2] * inv, o[m][3] * inv));
}

__device__ __forceinline__ void attn_win_item(const P& p, int l, int kind, int qb, int hs, char* smem) {
  const int tid = tid_opaque(), lane = tid & 63, wv = __builtin_amdgcn_readfirstlane(tid >> 6), g = lane >> 4, lr = lane & 15;
  int qoff, koff, voff, ooff; const float *gq, *gk; float sink2 = -1e30f; bool has_sink = false;
  if (kind == 0 || hs < 6) {
    const int h = hs, kvh = h / 3;
    qoff = OFF_QW + h * 64; koff = OFF_KW + kvh * 64; voff = OFF_VW + kvh * 64; ooff = 256 + h * 64;
    gq = p.win_qn + l * 64; gk = p.win_kn + l * 64; sink2 = p.win_sink[l * 6 + h] * LOG2E; has_sink = true;
  } else {
    const int h = hs - 6;
    qoff = OFF_QN + h * 64; koff = OFF_KN + h * 64; voff = OFF_VN + h * 64; ooff = 640 + h * 64;
    gq = p.na_qn + l * 64; gk = p.na_kn + l * 64;
  }
  float bound = 8.f * LOG2E * wave_max(fabsf(gq[lane])) * wave_max(fabsf(gk[lane])) * 1.0001f + 1e-3f;
  if (has_sink) bound = fmaxf(bound, sink2);
  const int q0 = qb * 128;
  const int qtok0 = (kind == 0 ? LC : 0) + q0 + 32 * wv;
  bf16x8 qf[2][2];
#pragma unroll
  for (int qt = 0; qt < 2; ++qt)
#pragma unroll
    for (int s = 0; s < 2; ++s) qf[qt][s] = *(const bf16x8*)(p.projb + (size_t)(qtok0 + 16 * qt + lr) * DIN + qoff + 32 * s + 8 * g);
  f32x4 o[2][4];
#pragma unroll
  for (int qt = 0; qt < 2; ++qt)
#pragma unroll
    for (int m = 0; m < 4; ++m) o[qt][m] = (f32x4){0.f, 0.f, 0.f, 0.f};
  float lsum[2] = {0.f, 0.f};
  const int nloc = (kind == 0) ? 6 : 0, nch = nloc + 4;
  auto tokfn = [&](int c) {
    return [=](int row) {
      if (c < nloc) { int pos = q0 - 128 + 64 * c + row; pos = pos < 0 ? 0 : (pos > SEQ - 1 ? SEQ - 1 : pos); return LC + pos; }
      return 64 * (c - nloc) + row;
    };
  };
  __syncthreads();
  kv_issue(p, smem, koff, voff, tokfn(0), wv, lane);
  kv_issue(p, smem + 16384, koff, voff, tokfn(1), wv, lane);
  kv_issue(p, smem + 32768, koff, voff, tokfn(2), wv, lane);
  for (int c = 0; c < nch; ++c) {
    kv_wait(nch - c);
    if (c + 3 < nch) kv_issue(p, smem + ((c + 3) & 3) * 16384, koff, voff, tokfn(c + 3), wv, lane);
    const char* stage = smem + (c & 3) * 16384;
    if (c < nloc) {
      const int qw0 = q0 + 32 * wv;
#pragma unroll
      for (int st = 0; st < 2; ++st) {
        const int kbase = q0 - 128 + 64 * c + 32 * st;
        const bool a0 = !(kbase - (qw0 + 15) > 128 || qw0 - (kbase + 31) > 128) && (kbase + 31 >= 0) && (kbase < SEQ);
        const bool a1 = !(kbase - (qw0 + 31) > 128 || (qw0 + 16) - (kbase + 31) > 128) && (kbase + 31 >= 0) && (kbase < SEQ);
        if (a0 || a1)
          attn_step2(stage, 32 * st, qf, o, lsum, [&](int qt, int t2, int r, float s) {
            int kpos = kbase + 16 * t2 + 4 * g + r;
            int dlt = kpos - (qw0 + 16 * qt + lr); dlt = dlt < 0 ? -dlt : dlt;
            bool valid = (kpos >= 0) && (kpos < SEQ) && (dlt <= 128);
            return valid ? s - bound : -1e30f;
          }, lane, a0, a1);
      }
    } else {
#pragma unroll
      for (int st = 0; st < 2; ++st)
        attn_step2(stage, 32 * st, qf, o, lsum, [&](int qt, int t2, int r, float s) { return s - bound; }, lane, true, true);
    }
  }
#pragma unroll
  for (int qt = 0; qt < 2; ++qt) {
    float ls = lsum[qt];
    if (has_sink && g == 0) ls += exp2f(sink2 - bound);
    attn_store_out(p, o[qt], ls, qtok0 + 16 * qt + lr, ooff, lane);
  }
}

__device__ __forceinline__ void attn_na_item(const P& p, int l, int rp, int h, char* smem) {
  const int tid = tid_opaque(), lane = tid & 63, wv = __builtin_amdgcn_readfirstlane(tid >> 6), g = lane >> 4, lr = lane & 15;
  const int qoff = OFF_QN + h * 64, koff = OFF_KN + h * 64, voff = OFF_VN + h * 64, ooff = 640 + h * 64;
  float* rpbl = (float*)(smem + 65536);
  const float* rpbg = p.rpb + (size_t)(l * 6 + h) * 465;
  float bmax = 0.f;
  __syncthreads();
  for (int i = tid; i < 465; i += 256) rpbl[i] = rpbg[i] * LOG2E;
  for (int i = lane; i < 465; i += 64) bmax = fmaxf(bmax, fabsf(rpbg[i]) * LOG2E);
  bmax = wave_max(bmax);
  const float bound = 8.f * LOG2E * wave_max(fabsf(p.na_qn[l * 64 + lane])) * wave_max(fabsf(p.na_kn[l * 64 + lane])) * 1.0001f + bmax + 1e-3f;
  const int r0 = 2 * rp;
  const int qcol = 16 * wv + lr;
  const int qtok0 = LC + r0 * 64 + qcol;
  const int kra = min(max(r0 - 4, 0), 248), krb = min(max(r0 + 1 - 4, 0), 248);
  const int nrow = krb + 8 - kra, nch = nrow + 4;
  const int kc0 = min(max(16 * wv - 8, 0), 32);
  const int qs = min(max(qcol - 8, 0), 48);
  bf16x8 qf[2][2];
#pragma unroll
  for (int qt = 0; qt < 2; ++qt)
#pragma unroll
    for (int s = 0; s < 2; ++s) qf[qt][s] = *(const bf16x8*)(p.projb + (size_t)(qtok0 + 64 * qt) * DIN + qoff + 32 * s + 8 * g);
  f32x4 o[2][4];
#pragma unroll
  for (int qt = 0; qt < 2; ++qt)
#pragma unroll
    for (int m = 0; m < 4; ++m) o[qt][m] = (f32x4){0.f, 0.f, 0.f, 0.f};
  float lsum[2] = {0.f, 0.f};
  auto tokfn = [&](int c) {
    return [=](int row) { return c < nrow ? LC + (kra + c) * 64 + row : 64 * (c - nrow) + row; };
  };
  kv_issue(p, smem, koff, voff, tokfn(0), wv, lane);
  kv_issue(p, smem + 16384, koff, voff, tokfn(1), wv, lane);
  kv_issue(p, smem + 32768, koff, voff, tokfn(2), wv, lane);
  for (int c = 0; c < nch; ++c) {
    kv_wait(nch - c);
    if (c + 3 < nch) kv_issue(p, smem + ((c + 3) & 3) * 16384, koff, voff, tokfn(c + 3), wv, lane);
    const char* stage = smem + (c & 3) * 16384;
    if (c < nrow) {
      const int krow = kra + c;
      const bool a0 = krow < kra + 8, a1 = krow >= krb;
      attn_step2(stage, kc0, qf, o, lsum, [&](int qt, int t2, int rr, float s) {
        int kcol = kc0 + 16 * t2 + 4 * g + rr;
        bool valid = (kcol >= qs) && (kcol < qs + 16);
        int dc = kcol - qcol + 15; dc = dc < 0 ? 0 : (dc > 30 ? 30 : dc);
        int dr = krow - (r0 + qt) + 7; dr = dr < 0 ? 0 : (dr > 14 ? 14 : dr);
        return valid ? s + rpbl[dr * 31 + dc] - bound : -1e30f;
      }, lane, a0, a1);
    } else {
#pragma unroll
      for (int st = 0; st < 2; ++st)
        attn_step2(stage, 32 * st, qf, o, lsum, [&](int qt, int t2, int rr, float s) { return s - bound; }, lane, true, true);
    }
  }
#pragma unroll
  for (int qt = 0; qt < 2; ++qt) attn_store_out(p, o[qt], lsum[qt], qtok0 + 64 * qt, ooff, lane);
}

__device__ __forceinline__ void ph_attn(const P& p, int l, char* smem) {
  const int nitems = 1536 + (l == 0 ? 24 : 0);
  for (int it = blockIdx.x; it < nitems; it += gridDim.x) {
    if (it < 768) attn_win_item(p, l, 0, it / 6, it % 6, smem);
    else if (it < 1536) { int j = it - 768; attn_na_item(p, l, j / 6, j % 6, smem); }
    else { int j = it - 1536; attn_win_item(p, l, 1, j / 12, j % 12, smem); }
  }
}

__device__ __forceinline__ unsigned ord_key(float s) {
  unsigned u = __float_as_uint(s);
  return (u & 0x80000000u) ? ~u : (u | 0x80000000u);
}
__device__ __forceinline__ float ord_val(unsigned pk) {
  unsigned u = pk & ~127u;
  unsigned b = (u & 0x80000000u) ? (u & 0x7fffffffu) : ~u;
  return __uint_as_float(b);
}
__device__ __forceinline__ void ce_desc(unsigned& a, unsigned& b) {
  unsigned mx = a > b ? a : b, mn = a > b ? b : a;
  a = mx; b = mn;
}
__device__ __forceinline__ void sort16_desc(unsigned (&v)[16]) {
#pragma unroll
  for (int k = 2; k <= 16; k <<= 1) {
#pragma unroll
    for (int j = k >> 1; j > 0; j >>= 1) {
#pragma unroll
      for (int i = 0; i < 16; ++i) {
        int m = i ^ j;
        if (m > i) {
          if ((i & k) == 0) ce_desc(v[i], v[m]); else ce_desc(v[m], v[i]);
        }
      }
    }
  }
}
__device__ __forceinline__ void merge16_desc(unsigned (&a)[16], const unsigned (&b)[16]) {
#pragma unroll
  for (int i = 0; i < 16; ++i) { unsigned o = b[15 - i]; a[i] = a[i] > o ? a[i] : o; }
#pragma unroll
  for (int j = 8; j > 0; j >>= 1) {
#pragma unroll
    for (int i = 0; i < 16; ++i) {
      int m = i ^ j;
      if (m > i) ce_desc(a[i], a[m]);
    }
  }
}

typedef __attribute__((ext_vector_type(2))) float f32x2;
__device__ __forceinline__ void ph_prep_peer(const P& p) {
  const int tid = tid_opaque(), lane = tid & 63;
  const int nw = gridDim.x * 4;
  for (int row = blockIdx.x * 4 + (tid >> 6); row < 4 * 16384; row += nw) {
    const int tbl = row >> 15, le = row & 32767;
    const float4* src = (const float4*)((tbl ? p.pv : p.pu) + (size_t)le * 1024) + lane * 4;
    float4 v[4];
    float am = 0.f;
#pragma unroll
    for (int i = 0; i < 4; ++i) {
      v[i] = src[i];
      am = fmaxf(am, fmaxf(fmaxf(fabsf(v[i].x), fabsf(v[i].y)), fmaxf(fabsf(v[i].z), fabsf(v[i].w))));
    }
    am = wave_max(am);
    const float sc = am > 0.f ? 224.f / am : 1.f;
    unsigned w[4];
#pragma unroll
    for (int i = 0; i < 4; ++i) {
      int t = __builtin_amdgcn_cvt_pk_fp8_f32(v[i].x * sc, v[i].y * sc, 0, false);
      t = __builtin_amdgcn_cvt_pk_fp8_f32(v[i].z * sc, v[i].w * sc, t, true);
      w[i] = (unsigned)t;
    }
    ((uint4*)((tbl ? p.vb8 : p.ub8) + (size_t)le * 1024))[lane] = make_uint4(w[0], w[1], w[2], w[3]);
    if (lane == 0) (tbl ? p.vsc : p.usc)[le] = am > 0.f ? am / 224.f : 1.f;
  }
  for (int i = GTID; i < 2 * 128 * 128; i += GSZ) { p.k1b[i] = f2bf(p.k1[i]); p.k2b[i] = f2bf(p.k2[i]); }
}

struct EpiPeerTopk {
  int l;
  __device__ __forceinline__ void operator()(const P& p, f32x4 (&acc)[4][4], int m0, int n0, int wm, int wn, int lane, char* smem) const {
    const int tid = ((wm * 2 + wn) << 6) | lane, g = lane >> 4, lr = lane & 15;
    const int nt = n0 >> 7, head = nt >> 1, hf = nt & 1;
    char* qimg = smem;
    char* kimg = smem + 34816;
    {
      char* qw = qimg + (wm * 64 + 4 * g) * 272 + (wn * 64 + lr) * 2;
#pragma unroll
      for (int i = 0; i < 4; ++i)
#pragma unroll
        for (int r = 0; r < 4; ++r)
#pragma unroll
          for (int j = 0; j < 4; ++j) *(bf16_t*)(qw + (16 * i + r) * 272 + 32 * j) = f2bf(acc[i][j][r]);
      const bf16_t* kk = (hf ? p.k2b : p.k1b) + (size_t)l * 16384 + (tid >> 4) * 128 + (tid & 15) * 8;
      char* kw = kimg + (tid >> 4) * 272 + (tid & 15) * 16;
#pragma unroll
      for (int i = 0; i < 8; ++i) *(uint4*)(kw + i * 16 * 272) = *(const uint4*)(kk + i * 16 * 128);
    }
    __syncthreads();
#pragma unroll
    for (int i = 0; i < 4; ++i)
#pragma unroll
      for (int j = 0; j < 4; ++j) acc[i][j] = (f32x4){0.f, 0.f, 0.f, 0.f};
    {
      const char* qa = qimg + (wm * 64 + lr) * 272 + g * 16;
      const char* kb = kimg + (wn * 64 + lr) * 272 + g * 16;
#pragma unroll
      for (int s = 0; s < 4; ++s) {
        bf16x8 af[4], bfr[4];
#pragma unroll
        for (int i = 0; i < 4; ++i) af[i] = *(const bf16x8*)(qa + i * 16 * 272 + s * 64);
#pragma unroll
        for (int j = 0; j < 4; ++j) bfr[j] = *(const bf16x8*)(kb + j * 16 * 272 + s * 64);
#pragma unroll
        for (int i = 0; i < 4; ++i)
#pragma unroll
          for (int j = 0; j < 4; ++j) acc[i][j] = __builtin_amdgcn_mfma_f32_16x16x32_bf16(af[i], bfr[j], acc[i][j], 0, 0, 0);
      }
    }
    __syncthreads();
    unsigned* simg = (unsigned*)smem;
    {
      unsigned* sw = simg + (wm * 64 + 4 * g) * 129 + wn * 64 + lr;
#pragma unroll
      for (int i = 0; i < 4; ++i)
#pragma unroll
        for (int r = 0; r < 4; ++r)
#pragma unroll
          for (int j = 0; j < 4; ++j)
            sw[(16 * i + r) * 129 + 16 * j] = (ord_key(acc[i][j][r]) & ~127u) | (unsigned)(wn * 64 + 16 * j + lr);
    }
    __syncthreads();
    const int row = tid & 127, half = tid >> 7;
    unsigned top[16];
    {
      const unsigned* sr = simg + row * 129 + half * 64;
#pragma unroll
      for (int k = 0; k < 16; ++k) top[k] = sr[k];
      sort16_desc(top);
#pragma unroll 1
      for (int gi = 1; gi < 4; ++gi) {
        unsigned v1[16];
#pragma unroll
        for (int k = 0; k < 16; ++k) v1[k] = sr[gi * 16 + k];
        sort16_desc(v1);
        merge16_desc(top, v1);
      }
    }
    __syncthreads();
    if (half == 1) {
#pragma unroll
      for (int k = 0; k < 16; ++k) simg[k * 128 + row] = top[k];
    }
    __syncthreads();
    if (half == 0) {
      unsigned o[16];
#pragma unroll
      for (int k = 0; k < 16; ++k) o[k] = simg[k * 128 + row];
      merge16_desc(top, o);
      uint4* dst = (uint4*)(p.pk + (((size_t)(m0 + row) * 8 + head) * 2 + hf) * 16);
#pragma unroll
      for (int k = 0; k < 4; ++k) dst[k] = make_uint4(top[4 * k], top[4 * k + 1], top[4 * k + 2], top[4 * k + 3]);
    }
  }
};

__device__ const unsigned char CAND_A[64] = {0,0,0,0,0,0,0,0,0,0,0,0,0,0,0,0, 1,1,1,1,1,1,1,1, 2,2,2,2,2, 3,3,3,3, 4,4,4, 5,5, 6,6, 7,7,
                                             8,9,10,11,12,13,14,15, 0,0,0,0,0,0,0,0,0,0,0,0,0,0};
__device__ const unsigned char CAND_B[64] = {0,1,2,3,4,5,6,7,8,9,10,11,12,13,14,15, 0,1,2,3,4,5,6,7, 0,1,2,3,4, 0,1,2,3, 0,1,2, 0,1, 0,1, 0,1,
                                             0,0,0,0,0,0,0,0, 0,0,0,0,0,0,0,0,0,0,0,0,0,0};

__device__ __forceinline__ void ph_peer_apply2(const P& p, int l, int t0, char* smem) {
  const int tid = tid_opaque(), lane = tid & 63, wv = tid >> 6;
  int* lds_e = (int*)(smem + wv * 1024);
  float* lds_g = (float*)(smem + wv * 1024 + 512);
  const unsigned char* U = p.ub8 + (size_t)l * 16384 * 1024;
  const unsigned char* V = p.vb8 + (size_t)l * 16384 * 1024;
  const float* usc = p.usc + l * 16384;
  const float* vsc = p.vsc + l * 16384;
  const float* n2g = p.norm2_g + l * 1024;
  const int ca = CAND_A[lane], cb = CAND_B[lane];
  for (int tk = t0 + blockIdx.x * 4 + wv; tk < TT; tk += gridDim.x * 4) {
    const float* mod = p.mod + (l * 2 + (tk < LC ? 1 : 0)) * 6144;
    float xv[16], hv[16];
    {
      const float4* xp = (const float4*)(p.xall + (size_t)tk * 1024) + lane * 4;
      float ss = 0.f;
#pragma unroll
      for (int q = 0; q < 4; ++q) {
        float4 v = xp[q];
        xv[q * 4 + 0] = v.x; xv[q * 4 + 1] = v.y; xv[q * 4 + 2] = v.z; xv[q * 4 + 3] = v.w;
        ss += v.x * v.x + v.y * v.y + v.z * v.z + v.w * v.w;
      }
      ss = wave_sum(ss);
      float rinv = rsqrtf(ss * (1.f / 1024.f) + EPS);
#pragma unroll
      for (int q = 0; q < 4; ++q) {
        float4 gg = ((const float4*)n2g)[lane * 4 + q], sc = ((const float4*)(mod + 4096))[lane * 4 + q], sh = ((const float4*)(mod + 3072))[lane * 4 + q];
        hv[q * 4 + 0] = xv[q * 4 + 0] * rinv * gg.x * (1.f + sc.x) + sh.x;
        hv[q * 4 + 1] = xv[q * 4 + 1] * rinv * gg.y * (1.f + sc.y) + sh.y;
        hv[q * 4 + 2] = xv[q * 4 + 2] * rinv * gg.z * (1.f + sc.z) + sh.z;
        hv[q * 4 + 3] = xv[q * 4 + 3] * rinv * gg.w * (1.f + sc.w) + sh.w;
      }
    }
    for (int head = 0; head < 8; ++head) {
      const unsigned* pk = p.pk + ((size_t)tk * 8 + head) * 32;
      unsigned p1 = pk[ca], p2 = pk[16 + cb];
      float sum = lane < 50 ? ord_val(p1) + ord_val(p2) : -3.0e38f;
      int eid = (int)(p1 & 127u) * 128 + (int)(p2 & 127u);
      int rank = 0;
      for (int m = 0; m < 50; ++m) {
        float sm = __shfl(sum, m);
        rank += (sm > sum || (sm == sum && m < lane)) ? 1 : 0;
      }
      float mx = wave_max(sum);
      bool sel = (lane < 50) && (rank < 16);
      float e = sel ? __expf(sum - mx) : 0.f;
      float tot = wave_sum(e);
      if (sel) { lds_e[head * 16 + rank] = eid; lds_g[head * 16 + rank] = e / tot; }
    }
    float acc[16];
#pragma unroll
    for (int k = 0; k < 16; ++k) acc[k] = 0.f;
    for (int e0 = 0; e0 < 128; e0 += 8) {
      uint4 ur[8], vr[8];
      float gt[8], us[8], vs[8];
#pragma unroll
      for (int k = 0; k < 8; ++k) {
        int ex = __builtin_amdgcn_readfirstlane(lds_e[e0 + k]);
        gt[k] = lds_g[e0 + k];
        ur[k] = ((const uint4*)(U + (size_t)ex * 1024))[lane];
        vr[k] = ((const uint4*)(V + (size_t)ex * 1024))[lane];
        us[k] = usc[ex]; vs[k] = vsc[ex];
      }
#pragma unroll
      for (int k = 0; k < 8; ++k) {
        float dot = 0.f;
        unsigned w[4] = {ur[k].x, ur[k].y, ur[k].z, ur[k].w};
#pragma unroll
        for (int q = 0; q < 4; ++q) {
          f32x2 lo = __builtin_amdgcn_cvt_pk_f32_fp8((int)w[q], false), hi = __builtin_amdgcn_cvt_pk_f32_fp8((int)w[q], true);
          dot += lo[0] * hv[q * 4] + lo[1] * hv[q * 4 + 1] + hi[0] * hv[q * 4 + 2] + hi[1] * hv[q * 4 + 3];
        }
        dot = wave_sum(dot) * us[k];
        float a = gt[k] * gelu_f(dot) * vs[k];
        unsigned y[4] = {vr[k].x, vr[k].y, vr[k].z, vr[k].w};
#pragma unroll
        for (int q = 0; q < 4; ++q) {
          f32x2 lo = __builtin_amdgcn_cvt_pk_f32_fp8((int)y[q], false), hi = __builtin_amdgcn_cvt_pk_f32_fp8((int)y[q], true);
          acc[q * 4] += a * lo[0]; acc[q * 4 + 1] += a * lo[1]; acc[q * 4 + 2] += a * hi[0]; acc[q * 4 + 3] += a * hi[1];
        }
      }
    }
    {
      float4* xp = ((l == 1) ? (float4*)(p.out + (size_t)(tk - LC) * 1024) : (float4*)(p.xall + (size_t)tk * 1024)) + lane * 4;
#pragma unroll
      for (int q = 0; q < 4; ++q) {
        float4 gg = ((const float4*)(mod + 5120))[lane * 4 + q];
        float4 o;
        o.x = xv[q * 4 + 0] + gg.x * acc[q * 4 + 0];
        o.y = xv[q * 4 + 1] + gg.y * acc[q * 4 + 1];
        o.z = xv[q * 4 + 2] + gg.z * acc[q * 4 + 2];
        o.w = xv[q * 4 + 3] + gg.w * acc[q * 4 + 3];
        xp[q] = o;
      }
    }
  }
}

#define XB_TMO      128
#define XB_XCNT(j)  (256  + 64 * (j))
#define XB_XSUB(j)  (1280 + 64 * (j))
#define XB_XGEN(j)  (2304 + 64 * (j))
#define XB_TOP      3328
#define XB_TOPGEN   3392
#define XCD_BAR_WORDS 3456
#define XB_SPIN_CAP (1u << 22)
#define LAS __attribute__((address_space(3)))
__device__ __forceinline__ unsigned xb_ld(unsigned* q) { return __hip_atomic_load(q, __ATOMIC_RELAXED, __HIP_MEMORY_SCOPE_AGENT); }
__device__ __forceinline__ unsigned xb_add(unsigned* q, unsigned v) { return __hip_atomic_fetch_add(q, v, __ATOMIC_RELAXED, __HIP_MEMORY_SCOPE_AGENT); }
__device__ __forceinline__ unsigned xb_xcc_id() { return (unsigned)__builtin_amdgcn_s_getreg((3 << 11) | 20) & 0xFu; }
#define XB_SPIN(cond, bar) do { unsigned _sp = 0; while (cond) { __builtin_amdgcn_s_sleep(1); \
    if ((++_sp & 255u) == 0u) { if (xb_ld(&(bar)[XB_TMO])) break; if (_sp > XB_SPIN_CAP) { atomicAdd(&(bar)[XB_TMO], 1u); break; } } } } while (0)
struct XcdBarrier { unsigned* bar; unsigned x; volatile LAS unsigned* st; };
__device__ __forceinline__ XcdBarrier xcd_barrier_post(unsigned* bar, volatile LAS unsigned* st) {
  XcdBarrier b; b.bar = bar; b.x = xb_xcc_id(); b.st = st;
  if (threadIdx.x == 0) (void)xb_add(&bar[XB_XCNT(b.x)], 1u);
  return b;
}
__device__ __forceinline__ void xcd_barrier_complete(unsigned* bar, unsigned x, unsigned& nloc, unsigned& nx) {
  const unsigned G = gridDim.x * gridDim.y * gridDim.z;
  unsigned sum, cnt, mine, sp = 0u;
  for (;;) {
    sum = 0u; cnt = 0u; mine = 0u;
#pragma unroll
    for (unsigned j = 0; j < 16; ++j) { const unsigned c = xb_ld(&bar[XB_XCNT(j)]); sum += c; cnt += (c > 0u) ? 1u : 0u; mine = (j == x) ? c : mine; }
    if (sum == G) break;
    __builtin_amdgcn_s_sleep(1);
    if ((++sp & 255u) == 0u) { if (xb_ld(&bar[XB_TMO])) break; if (sp > XB_SPIN_CAP) { atomicAdd(&bar[XB_TMO], 1u); break; } }
  }
  nloc = mine > 0u ? mine : 1u; nx = cnt > 0u ? cnt : 1u;
}
__device__ __forceinline__ void xcd_barrier(const XcdBarrier& b) {
  asm volatile("s_waitcnt vmcnt(0)" ::: "memory");
  __syncthreads();
  if (threadIdx.x == 0) {
    unsigned* bar = b.bar;
    __builtin_amdgcn_s_waitcnt(0);
    unsigned nloc = b.st[0], nx = b.st[1];
    if (nloc == 0u) { xcd_barrier_complete(bar, b.x, nloc, nx); b.st[0] = nloc; b.st[1] = nx; }
    const unsigned old = xb_add(&bar[XB_XSUB(b.x)], 1u);
    const unsigned gen = old / nloc;
    if (old + 1u == (gen + 1u) * nloc) {
      __builtin_amdgcn_fence(__ATOMIC_RELEASE, "agent");
      asm volatile("s_waitcnt vmcnt(0)" ::: "memory");
      const unsigned og = xb_add(&bar[XB_TOP], 1u);
      const unsigned tg = og / nx;
      if (og + 1u == (tg + 1u) * nx) xb_add(&bar[XB_TOPGEN], 1u);
      else XB_SPIN(xb_ld(&bar[XB_TOPGEN]) == tg, bar);
      __builtin_amdgcn_fence(__ATOMIC_ACQUIRE, "agent");
      xb_add(&bar[XB_XGEN(b.x)], 1u);
      asm volatile("s_waitcnt vmcnt(0)" ::: "memory");
    } else {
      XB_SPIN(xb_ld(&bar[XB_XGEN(b.x)]) == gen, bar);
      __builtin_amdgcn_fence(__ATOMIC_ACQUIRE, "agent");
      asm volatile("s_waitcnt vmcnt(0)" ::: "memory");
    }
  }
  __syncthreads();
}

#ifndef PROBE_IV
#define PROBE_IV -1
#endif
__device__ __forceinline__ void probe_tick(int& cnt, unsigned long long* slots) {
  if (PROBE_IV >= 0) {
    if (threadIdx.x == 0 && (cnt == PROBE_IV || cnt == PROBE_IV + 1)) slots[cnt - PROBE_IV] = __builtin_amdgcn_s_memrealtime();
    cnt = __builtin_amdgcn_readfirstlane(cnt + 1);
  }
}
#define BARRIER() do { xcd_barrier(xb); probe_tick(pcnt, probe_t); } while (0)

typedef const __attribute__((address_space(4))) P* KP;
__device__ __forceinline__ P load_params(KP kp) {
#if defined(__HIP_DEVICE_COMPILE__)
  asm volatile("" : "+s"(kp));
  return *kp;
#else
  return P{};
#endif
}
#define PP load_params(kp)
__global__ void __launch_bounds__(256, 2) k_mega(P p_unused) {
  KP kp = (KP)__builtin_amdgcn_kernarg_segment_ptr();
  __shared__ __attribute__((aligned(16))) float smem[18432 + 8];
  uint4& xb_words = *(uint4*)(smem + 18432);
  cg::grid_group grid = cg::this_grid();
  if (threadIdx.x == 0) xb_words = make_uint4(0u, 0u, 0u, 0u);
  __syncthreads();
  unsigned long long* probe_t = (unsigned long long*)(smem + 18436);
  int pcnt = 0;
  asm volatile("" : "+s"(pcnt));
  probe_tick(pcnt, probe_t);
  ph_mod(PP, smem);
  ph_prep(PP, smem);
  ph_lru_prepw(PP);
  ph_rope_tab(PP);
  ph_prep_peer(PP);
  grid.sync();
  probe_tick(pcnt, probe_t);
  XcdBarrier xb = xcd_barrier_post(PP.bar, (volatile LAS unsigned*)&xb_words);
  ph_norm_mod(PP, 0, 0, 0, smem, true);
  BARRIER();
#pragma unroll 1
  for (int l = 0; l < 2; ++l) {
    const int t0 = (l == 0) ? 0 : LC;
    { const P lp = PP; gemm_bf16_128(lp, lp.hb, lp.w_in_t + (size_t)l * 1024 * DIN, 1024, 0, TT, DIN, (char*)smem, EpiProj{l}); }
    BARRIER();
    ph_lru<1>(PP, l, (char*)smem);
    ph_attn(PP, l, (char*)smem);
    BARRIER();
    ph_lru_carry(PP, smem);
    BARRIER();
    ph_lru<2>(PP, l, (char*)smem);
    BARRIER();
    { const P lp = PP; gemm_bf16_128(lp, lp.mixb, lp.w_out_t + (size_t)l * 1024 * 1024, 1024, t0, TT, 1024, (char*)smem, EpiResid{l, 2048}); }
    BARRIER();
    ph_norm_mod(PP, l, 1, t0, smem);
    BARRIER();
    { const P lp = PP; gemm_bf16_128(lp, lp.hb, lp.wq_t + (size_t)l * 1024 * NPQ, 1024, t0, TT, NPQ, (char*)smem, EpiPeerTopk{l}); }
    BARRIER();
    ph_peer_apply2(PP, l, t0, (char*)smem);
    if (l == 0) {
      BARRIER();
      ph_norm_mod(PP, 1, 0, 0, smem);
      BARRIER();
    }
  }
  if (PROBE_IV >= 0) {
    probe_tick(pcnt, probe_t);
    __syncthreads();
    if (blockIdx.x == 0 && threadIdx.x == 0) {
      const unsigned long long dt = (probe_t[1] - probe_t[0]) * 8ull, ts = __builtin_amdgcn_s_memrealtime();
      while (__builtin_amdgcn_s_memrealtime() - ts < dt) __builtin_amdgcn_s_sleep(8);
    }
  }
}

extern "C" void kernel_launch(void* const* d_in, const int* in_sizes, int n_in, void* d_out, int out_size, void* d_ws,
                              size_t ws_size, hipStream_t stream) {
  P p{};
  const float** fp = (const float**)&p;
  for (int i = 0; i < 28; ++i) fp[i] = (const float*)d_in[i];
  p.out = (float*)d_out;
  float* w = (float*)d_ws;
  size_t o = 0;
  auto carve = [&](size_t n) { float* r = w + o; o += (n + 63) & ~(size_t)63; return r; };
  p.bar = (unsigned*)carve(4096);
  p.mod = carve(4 * 6144);
  p.xall = carve((size_t)TT * 1024);
  p.proj = carve((size_t)TT * 512);
  p.projb = (bf16_t*)carve((size_t)TT * DIN / 2);
  p.mixb = (bf16_t*)carve((size_t)TT * 512);
  p.hb = (bf16_t*)carve((size_t)TT * 512);
  p.w_in_t = (bf16_t*)carve((size_t)1024 * DIN);
  p.w_out_t = (bf16_t*)carve((size_t)1024 * 1024);
  p.wq_t = (bf16_t*)carve((size_t)1024 * NPQ);
  p.lruw_t = (bf16_t*)carve((size_t)2 * 2 * 4 * 2 * 4096 / 2);
  p.lagg = carve((size_t)2 * NCHUNK * 256 * 2);
  p.lcarry = carve((size_t)2 * NCHUNK * 256);
  p.ropetab = carve(320 * 16 * 2);
  p.pk = (unsigned*)carve((size_t)TT * 256);
  p.ub8 = (unsigned char*)carve((size_t)2 * 16384 * 1024 / 4);
  p.vb8 = (unsigned char*)carve((size_t)2 * 16384 * 1024 / 4);
  p.usc = carve(2 * 16384);
  p.vsc = carve(2 * 16384);
  p.k1b = (bf16_t*)carve(16384);
  p.k2b = (bf16_t*)carve(16384);
  if (o * 4 > ws_size) { fprintf(stderr, "workspace too small: need %zu have %zu\n", o * 4, ws_size); return; }
  static int grid_blocks = 0;
  if (!grid_blocks) {
    int dev = 0, cus = 0, per_cu = 0;
    (void)hipGetDevice(&dev);
    (void)hipDeviceGetAttribute(&cus, hipDeviceAttributeMultiprocessorCount, dev);
    (void)hipOccupancyMaxActiveBlocksPerMultiprocessor(&per_cu, k_mega, 256, 0);
    if (per_cu > 2) per_cu = 2;
    grid_blocks = cus * per_cu;
  }
  (void)hipMemsetAsync(p.bar, 0, XCD_BAR_WORDS * 4, stream);
  void* args[] = {&p};
  hipError_t e = hipLaunchCooperativeKernel((void*)k_mega, dim3(grid_blocks), dim3(256), args, 0, stream);
  if (e != hipSuccess) fprintf(stderr, "cooperative launch failed: %s (grid %d)\n", hipGetErrorString(e), grid_blocks);
}
```

```cpp
#include <hip/hip_runtime.h>
#include <hip/hip_cooperative_groups.h>
#include <stdint.h>
#include <stdio.h>
namespace cg = cooperative_groups;

#ifndef SINGLE_LAUNCH
#define SINGLE_LAUNCH 1
#endif

constexpr int DM = 1024, SEQ = 16384, LC = 256, TT = SEQ + LC, DIN = 2304, NPQ = 2048;
constexpr int OFF_XA = 0, OFF_GA = 256, OFF_QW = 512, OFF_KW = 896, OFF_VW = 1024, OFF_QN = 1152, OFF_KN = 1536, OFF_VN = 1920;
constexpr float EPS = 1e-6f;
constexpr float LOG2E = 1.4426950408889634f;
constexpr float QSCALE = 0.125f * LOG2E;

struct P {
  const float *x, *c, *ctx, *c_ctx, *w_mod, *b_mod, *norm1_g, *norm2_g, *w_in, *w_out,
      *conv_w, *conv_b, *wa, *ba, *wx, *bx, *lam, *win_qn, *win_kn, *win_sink, *na_qn, *na_kn, *rpb,
      *wq, *k1, *k2, *pu, *pv;
  float* out;
  float *mod, *xall, *proj;
  unsigned short* projb;
  unsigned* pk;
  unsigned* bar;
  unsigned short *k1b, *k2b;
  unsigned char *ub8, *vb8;
  float *usc, *vsc;
  unsigned short *hb, *mixb, *w_in_t, *w_out_t, *wq_t, *lruw_t;
  float *lagg, *lcarry, *ropetab, *rowss, *bq;
};

typedef unsigned short bf16_t;
typedef __attribute__((ext_vector_type(8))) short bf16x8;
typedef __attribute__((ext_vector_type(4))) float f32x4;
__device__ __forceinline__ unsigned short f2bf(float f) {
  unsigned u = __float_as_uint(f);
  u += 0x7fffu + ((u >> 16) & 1u);
  return (unsigned short)(u >> 16);
}
__device__ __forceinline__ unsigned pack2bf(float a, float b) { return (unsigned)f2bf(a) | ((unsigned)f2bf(b) << 16); }
__device__ __forceinline__ float bf2f(unsigned short h) { return __uint_as_float(((unsigned)h) << 16); }


__device__ __forceinline__ float silu_f(float x) { return x / (1.f + __expf(-x)); }
__device__ __forceinline__ float sigmoid_f(float x) { return 1.f / (1.f + __expf(-x)); }
__device__ __forceinline__ float gelu_f(float x) {
  float u = 0.7978845608028654f * (x + 0.044715f * x * x * x);
  float e = __expf(2.f * u);
  float th = 1.f - 2.f / (e + 1.f);
  return 0.5f * x * (1.f + th);
}
template <int CTRL, int RMASK>
__device__ __forceinline__ float dpp_mov(float v) {
  return __int_as_float(__builtin_amdgcn_update_dpp(0, __float_as_int(v), CTRL, RMASK, 0xf, false));
}
__device__ __forceinline__ float wave_sum(float v) {
  v += dpp_mov<0xB1, 0xf>(v);
  v += dpp_mov<0x4E, 0xf>(v);
  v += dpp_mov<0x141, 0xf>(v);
  v += dpp_mov<0x140, 0xf>(v);
  v += dpp_mov<0x142, 0xa>(v);
  v += dpp_mov<0x143, 0xc>(v);
  return __int_as_float(__builtin_amdgcn_readlane(__float_as_int(v), 63));
}

__device__ __forceinline__ int tid_opaque() { int t = threadIdx.x; asm volatile("" : "+v"(t)); return t; }
#define GTID (blockIdx.x * blockDim.x + tid_opaque())
#define GSZ (gridDim.x * blockDim.x)

__device__ __forceinline__ void ph_mod(const P& p, float* smem) {
  const int tid = tid_opaque(), cl = tid & 31, ks = tid >> 5;
  for (int it = blockIdx.x; it < 2 * 192; it += gridDim.x) {
    const int nc = it % 192, l = it / 192;
    const int n = nc * 32 + cl;
    const float* w = p.w_mod + (size_t)l * 1024 * 6144 + n;
    float a0 = 0.f, a1 = 0.f;
#pragma unroll 8
    for (int i = 0; i < 128; ++i) {
      int k = i * 8 + ks;
      float wv = w[(size_t)k * 6144];
      a0 += silu_f(p.c[k]) * wv;
      a1 += silu_f(p.c_ctx[k]) * wv;
    }
    __syncthreads();
    smem[tid] = a0; smem[256 + tid] = a1;
    __syncthreads();
    if (tid < 64) {
      const int which = tid >> 5;
      float s = p.b_mod[l * 6144 + n];
#pragma unroll
      for (int q = 0; q < 8; ++q) s += smem[which * 256 + q * 32 + cl];
      p.mod[(l * 2 + which) * 6144 + n] = s;
    }
  }
}

__device__ __forceinline__ void ph_bq(const P& p, float* smem) {
  const int tid = tid_opaque(), cl = tid & 31, ks = tid >> 5;
  for (int it = blockIdx.x; it < 2 * 64; it += gridDim.x) {
    const int nc = it % 64, l = it / 64;
    const int n = nc * 32 + cl;
    const float* w = p.wq + (size_t)l * 1024 * NPQ + n;
    const float* v0 = p.mod + (l * 2 + 0) * 6144 + 3072;
    const float* v1 = p.mod + (l * 2 + 1) * 6144 + 3072;
    float a0 = 0.f, a1 = 0.f;
#pragma unroll 8
    for (int i = 0; i < 128; ++i) {
      int k = i * 8 + ks;
      float wv = w[(size_t)k * NPQ];
      a0 += v0[k] * wv;
      a1 += v1[k] * wv;
    }
    __syncthreads();
    smem[tid] = a0; smem[256 + tid] = a1;
    __syncthreads();
    if (tid < 64) {
      const int which = tid >> 5;
      float s = 0.f;
#pragma unroll
      for (int q = 0; q < 8; ++q) s += smem[which * 256 + q * 32 + cl];
      p.bq[(l * 2 + which) * NPQ + n] = s;
    }
  }
}

__device__ __forceinline__ void ph_copy_in(const P& p) {
  const float4* xs = (const float4*)p.x;
  const float4* cs = (const float4*)p.ctx;
  float4* d = (float4*)p.xall;
  for (int i = GTID; i < TT * 256; i += GSZ) d[i] = (i < LC * 256) ? cs[i] : xs[i - LC * 256];
}

__device__ __forceinline__ void ph_copy_out(const P& p) {
  const float4* s = (const float4*)(p.xall + (size_t)LC * 1024);
  float4* d = (float4*)p.out;
  for (int i = GTID; i < SEQ * 256; i += GSZ) d[i] = s[i];
}

__device__ __forceinline__ void ph_norm_mod(const P& p, int l, int which_norm, int t0, float* smem, bool from_input = false) {
  const float* g = (which_norm ? p.norm2_g : p.norm1_g) + l * 1024;
  const int sh_off = which_norm ? 3072 : 0, sc_off = which_norm ? 4096 : 1024;
  const int tid = tid_opaque();
  for (int t = t0 + blockIdx.x; t < TT; t += gridDim.x) {
    const float* mod = p.mod + (l * 2 + (t < LC ? 1 : 0)) * 6144;
    float4 v;
    if (from_input) {
      v = t < LC ? ((const float4*)(p.ctx + (size_t)t * 1024))[tid] : ((const float4*)(p.x + (size_t)(t - LC) * 1024))[tid];
      ((float4*)(p.xall + (size_t)t * 1024))[tid] = v;
    } else v = ((const float4*)(p.xall + (size_t)t * 1024))[tid];
    float ss = wave_sum(v.x * v.x + v.y * v.y + v.z * v.z + v.w * v.w);
    __syncthreads();
    if ((tid & 63) == 0) smem[tid >> 6] = ss;
    __syncthreads();
    float tot = smem[0] + smem[1] + smem[2] + smem[3];
    float rinv = rsqrtf(tot * (1.f / 1024.f) + EPS);
    float4 gg = ((const float4*)g)[tid];
    float4 sc = ((const float4*)(mod + sc_off))[tid];
    float4 sh = ((const float4*)(mod + sh_off))[tid];
    float4 o;
    o.x = v.x * rinv * gg.x * (1.f + sc.x) + sh.x;
    o.y = v.y * rinv * gg.y * (1.f + sc.y) + sh.y;
    o.z = v.z * rinv * gg.z * (1.f + sc.z) + sh.z;
    o.w = v.w * rinv * gg.w * (1.f + sc.w) + sh.w;
    ((uint2*)(p.hb + (size_t)t * 1024))[tid] = make_uint2(pack2bf(o.x, o.y), pack2bf(o.z, o.w));
  }
}

__device__ __forceinline__ void prep_transpose(const float* W, bf16_t* Wt, int K, int N, int item0, int nitems_total, float* smem) {
  (void)nitems_total;
  float(*ts)[65] = (float(*)[65])smem;
  const int tid = tid_opaque();
  const int tn = N / 64, nt = (K / 64) * tn;
  for (int it = blockIdx.x; it < nt; it += gridDim.x) {
    int k0 = (it / tn) * 64, n0 = (it % tn) * 64;
    __syncthreads();
#pragma unroll
    for (int i = 0; i < 16; ++i) {
      int r = (tid >> 6) + i * 4, c = tid & 63;
      ts[r][c] = W[(size_t)(k0 + r) * N + n0 + c];
    }
    __syncthreads();
#pragma unroll
    for (int i = 0; i < 16; ++i) {
      int r = (tid >> 6) + i * 4, c = tid & 63;
      Wt[(size_t)(n0 + r) * K + k0 + c] = f2bf(ts[c][r]);
    }
  }
  (void)item0;
}

__device__ __forceinline__ void ph_prep(const P& p, float* smem) {
  for (int l = 0; l < 2; ++l) {
    prep_transpose(p.w_in + (size_t)l * 1024 * DIN, p.w_in_t + (size_t)l * 1024 * DIN, 1024, DIN, 0, 0, smem);
    prep_transpose(p.w_out + (size_t)l * 1024 * 1024, p.w_out_t + (size_t)l * 1024 * 1024, 1024, 1024, 0, 0, smem);
    prep_transpose(p.wq + (size_t)l * 1024 * NPQ, p.wq_t + (size_t)l * 1024 * NPQ, 1024, NPQ, 0, 0, smem);
  }
}

struct EpiStoreF32 {
  float* C; int ldc;
  __device__ __forceinline__ void operator()(const P& p, f32x4 (&acc)[4][4], int m0, int n0, int wm, int wn, int lane, char* smem) const {
    const int mw0 = m0 + wm * 64, nw0 = n0 + wn * 64;
#pragma unroll
    for (int i = 0; i < 4; ++i)
#pragma unroll
      for (int r = 0; r < 4; ++r) {
        int row = mw0 + 16 * i + (lane >> 4) * 4 + r;
#pragma unroll
        for (int j = 0; j < 4; ++j) C[(size_t)row * ldc + nw0 + 16 * j + (lane & 15)] = acc[i][j][r];
      }
  }
};
struct EpiProjSplit {
  __device__ __forceinline__ void operator()(const P& p, f32x4 (&acc)[4][4], int m0, int n0, int wm, int wn, int lane, char* smem) const {
    const int mw0 = m0 + wm * 64, nw0 = n0 + wn * 64;
#pragma unroll
    for (int i = 0; i < 4; ++i)
#pragma unroll
      for (int r = 0; r < 4; ++r) {
        int row = mw0 + 16 * i + (lane >> 4) * 4 + r;
#pragma unroll
        for (int j = 0; j < 4; ++j) {
          int col = nw0 + 16 * j + (lane & 15);
          if (n0 < 512) p.proj[(size_t)row * 512 + col] = acc[i][j][r];
          else p.projb[(size_t)row * DIN + col] = f2bf(acc[i][j][r]);
        }
      }
  }
};
__device__ __forceinline__ void ph_rope_tab(const P& p) {
  for (int idx = GTID; idx < 320 * 16; idx += GSZ) {
    int v = idx >> 4, j = idx & 15;
    float inv = __expf(-(float)j * (1.f / 16.f) * 9.210340371976184f);
    float ang = (float)(v < 256 ? v : v - 256) * inv;
    float k = rintf(ang * 0.15915494309189535f);
    float r = fmaf(-k, 6.2831854820251465f, ang);
    r = fmaf(-k, -1.7484555e-07f, r);
    ((float2*)p.ropetab)[idx] = make_float2(__cosf(r), __sinf(r));
  }
}

template <int CTRL>
__device__ __forceinline__ float dpp_row(float v) {
  return __int_as_float(__builtin_amdgcn_update_dpp(0, __float_as_int(v), CTRL, 0xf, 0xf, false));
}
struct EpiProj {
  int l;
  __device__ __forceinline__ void operator()(const P& p, f32x4 (&acc)[4][4], int m0, int n0, int wm, int wn, int lane, char* smem) const {
    const int g = lane >> 4, lr = lane & 15;
    const int mw0 = m0 + wm * 64, nw0 = n0 + wn * 64;
    if (n0 < 512) {
#pragma unroll
      for (int i = 0; i < 4; ++i)
#pragma unroll
        for (int r = 0; r < 4; ++r) {
          int row = mw0 + 16 * i + 4 * g + r;
#pragma unroll
          for (int j = 0; j < 4; ++j) p.proj[(size_t)row * 512 + nw0 + 16 * j + lr] = acc[i][j][r];
        }
      return;
    }
    const float* gain = nullptr; bool rope = false; float scale = 1.f;
    if (nw0 < 896) { gain = p.win_qn + l * 64; rope = true; scale = QSCALE; }
    else if (nw0 < 1024) { gain = p.win_kn + l * 64; rope = true; }
    else if (nw0 < 1152) { }
    else if (nw0 < 1536) { gain = p.na_qn + l * 64; scale = QSCALE; }
    else if (nw0 < 1920) { gain = p.na_kn + l * 64; }
    rope = rope && (m0 >= LC);
    float gj[4] = {1.f, 1.f, 1.f, 1.f};
    if (gain) {
#pragma unroll
      for (int j = 0; j < 4; ++j) gj[j] = gain[16 * j + lr] * scale;
    }
#pragma unroll
    for (int i = 0; i < 4; ++i)
#pragma unroll
      for (int r = 0; r < 4; ++r) {
        const int row = mw0 + 16 * i + 4 * g + r;
        float y[4] = {acc[i][0][r], acc[i][1][r], acc[i][2][r], acc[i][3][r]};
        if (gain) {
          float ss = y[0] * y[0] + y[1] * y[1] + y[2] * y[2] + y[3] * y[3];
          ss += dpp_row<0xB1>(ss);
          ss += dpp_row<0x4E>(ss);
          ss += dpp_row<0x141>(ss);
          ss += dpp_row<0x140>(ss);
          const float rinv = rsqrtf(ss * (1.f / 64.f) + EPS);
#pragma unroll
          for (int j = 0; j < 4; ++j) y[j] *= rinv * gj[j];
        }
        if (rope) {
          const int pos = row - LC;
          const float2 tr = ((const float2*)p.ropetab)[(pos >> 6) * 16 + lr];
          const float2 tc = ((const float2*)p.ropetab)[(256 + (pos & 63)) * 16 + lr];
          float a0 = y[0] * tr.x - y[1] * tr.y, a1 = y[0] * tr.y + y[1] * tr.x;
          float a2 = y[2] * tc.x - y[3] * tc.y, a3 = y[2] * tc.y + y[3] * tc.x;
          y[0] = a0; y[1] = a1; y[2] = a2; y[3] = a3;
        }
#pragma unroll
        for (int j = 0; j < 4; ++j) p.projb[(size_t)row * DIN + nw0 + 16 * j + lr] = f2bf(y[j]);
      }
  }
};
struct EpiResid {
  int l;
  __device__ __forceinline__ void operator()(const P& p, f32x4 (&acc)[4][4], int m0, int n0, int wm, int wn, int lane, char* smem) const {
    float* tile = (float*)smem;
    {
      const int g = lane >> 4, lr = lane & 15;
      float* tw = tile + (wm * 64 + 4 * g) * 132 + wn * 64 + lr;
#pragma unroll
      for (int i = 0; i < 4; ++i)
#pragma unroll
        for (int r = 0; r < 4; ++r)
#pragma unroll
          for (int j = 0; j < 4; ++j) tw[(16 * i + r) * 132 + 16 * j] = acc[i][j][r];
    }
    __syncthreads();
    const int tid = ((wm * 2 + wn) << 6) | lane, c8 = tid & 15, rsub = tid >> 4;
    const float* mod = p.mod + (l * 2 + (m0 < LC ? 1 : 0)) * 6144;
    const int col = n0 + 8 * c8;
    float g1v[8], gs[8];
    {
      const float4 a0 = *(const float4*)(mod + 2048 + col), a1 = *(const float4*)(mod + 2048 + col + 4);
      const float4 s0 = *(const float4*)(mod + 4096 + col), s1 = *(const float4*)(mod + 4096 + col + 4);
      const float4 n0v = *(const float4*)(p.norm2_g + l * 1024 + col), n1v = *(const float4*)(p.norm2_g + l * 1024 + col + 4);
      g1v[0] = a0.x; g1v[1] = a0.y; g1v[2] = a0.z; g1v[3] = a0.w; g1v[4] = a1.x; g1v[5] = a1.y; g1v[6] = a1.z; g1v[7] = a1.w;
      gs[0] = n0v.x * (1.f + s0.x); gs[1] = n0v.y * (1.f + s0.y); gs[2] = n0v.z * (1.f + s0.z); gs[3] = n0v.w * (1.f + s0.w);
      gs[4] = n1v.x * (1.f + s1.x); gs[5] = n1v.y * (1.f + s1.y); gs[6] = n1v.z * (1.f + s1.z); gs[7] = n1v.w * (1.f + s1.w);
    }
#pragma unroll
    for (int it = 0; it < 8; ++it) {
      const int rl = it * 16 + rsub, row = m0 + rl;
      float4* xp = (float4*)(p.xall + (size_t)row * 1024 + col);
      float4 x0 = xp[0], x1 = xp[1];
      const float4 t0 = *(const float4*)(tile + rl * 132 + 8 * c8), t1 = *(const float4*)(tile + rl * 132 + 8 * c8 + 4);
      x0.x += g1v[0] * t0.x; x0.y += g1v[1] * t0.y; x0.z += g1v[2] * t0.z; x0.w += g1v[3] * t0.w;
      x1.x += g1v[4] * t1.x; x1.y += g1v[5] * t1.y; x1.z += g1v[6] * t1.z; x1.w += g1v[7] * t1.w;
      xp[0] = x0; xp[1] = x1;
      float ss = x0.x * x0.x + x0.y * x0.y + x0.z * x0.z + x0.w * x0.w + x1.x * x1.x + x1.y * x1.y + x1.z * x1.z + x1.w * x1.w;
      ss += dpp_row<0xB1>(ss);
      ss += dpp_row<0x4E>(ss);
      ss += dpp_row<0x141>(ss);
      ss += dpp_row<0x140>(ss);
      *(uint4*)(p.hb + (size_t)row * 1024 + col) = make_uint4(pack2bf(x0.x * gs[0], x0.y * gs[1]), pack2bf(x0.z * gs[2], x0.w * gs[3]),
                                                            pack2bf(x1.x * gs[4], x1.y * gs[5]), pack2bf(x1.z * gs[6], x1.w * gs[7]));
      if (c8 == 0) p.rowss[(size_t)(n0 >> 7) * TT + row] = ss;
    }
  }
};

__device__ __forceinline__ int gemm_swz(int row) { return (0x78 >> (((row >> 2) & 3) * 2)) & 3; }
template <class Epi>
__device__ __forceinline__ void gemm_bf16_128(const P& p, const bf16_t* __restrict__ A, const bf16_t* __restrict__ Bt, int K, int m_begin, int m_end,
                              int N, char* smem, const Epi& epi) {
  const int tid = tid_opaque(), lane = tid & 63, wv = __builtin_amdgcn_readfirstlane(tid >> 6), wm = wv >> 1, wn = wv & 1;
  const int tiles_n = N / 128, tiles_m = (m_end - m_begin) / 128;
  const int nk = K / 32;
  const int lr = lane & 15, g = lane >> 4;
  const int a_rd = (wm * 64 + lr) * 64 + ((g ^ gemm_swz(lr)) << 4);
  const int b_rd = 8192 + (wn * 64 + lr) * 64 + ((g ^ gemm_swz(lr)) << 4);
  const int ld_row = lane >> 2, ld_c = (lane & 3) ^ gemm_swz(ld_row);
  for (int tile = blockIdx.x; tile < tiles_m * tiles_n; tile += gridDim.x) {
    const int m0 = m_begin + (tile / tiles_n) * 128, n0 = (tile % tiles_n) * 128;
    f32x4 acc[4][4];
#pragma unroll
    for (int i = 0; i < 4; ++i)
#pragma unroll
      for (int j = 0; j < 4; ++j) acc[i][j] = (f32x4){0.f, 0.f, 0.f, 0.f};
    const bf16_t* Ag = A + (size_t)(m0 + wv * 32 + ld_row) * K + ld_c * 8;
    const bf16_t* Bg = Bt + (size_t)(n0 + wv * 32 + ld_row) * K + ld_c * 8;
    auto issue = [&](int st, int kt) {
      char* base = smem + st * 16384 + wv * 2048;
#pragma unroll
      for (int i = 0; i < 2; ++i) {
        __builtin_amdgcn_global_load_lds((const unsigned*)(Ag + (size_t)i * 16 * K + kt * 32), (__attribute__((address_space(3))) unsigned*)(base + i * 1024), 16, 0, 0);
        __builtin_amdgcn_global_load_lds((const unsigned*)(Bg + (size_t)i * 16 * K + kt * 32), (__attribute__((address_space(3))) unsigned*)(base + 8192 + i * 1024), 16, 0, 0);
      }
    };
    issue(0, 0); issue(1, 1); issue(2, 2);
    for (int kt0 = 0; kt0 < nk; kt0 += 4) {
#pragma unroll
      for (int u = 0; u < 4; ++u) {
        const int kt = kt0 + u, rem = nk - kt;
        if (rem >= 3) asm volatile("s_waitcnt vmcnt(8) lgkmcnt(0)" ::: "memory");
        else if (rem == 2) asm volatile("s_waitcnt vmcnt(4) lgkmcnt(0)" ::: "memory");
        else asm volatile("s_waitcnt vmcnt(0) lgkmcnt(0)" ::: "memory");
        __builtin_amdgcn_s_barrier();
        if (kt + 3 < nk) issue((u + 3) & 3, kt + 3);
        bf16x8 af[4], bfr[4];
#pragma unroll
        for (int i = 0; i < 4; ++i) af[i] = *(const bf16x8*)(smem + u * 16384 + a_rd + i * 1024);
#pragma unroll
        for (int j = 0; j < 4; ++j) bfr[j] = *(const bf16x8*)(smem + u * 16384 + b_rd + j * 1024);
#pragma unroll
        for (int i = 0; i < 4; ++i)
#pragma unroll
          for (int j = 0; j < 4; ++j) acc[i][j] = __builtin_amdgcn_mfma_f32_16x16x32_bf16(af[i], bfr[j], acc[i][j], 0, 0, 0);
      }
    }
    __syncthreads();
    epi(p, acc, m0, n0, wm, wn, lane, smem);
    __syncthreads();
  }
}

constexpr int NCHUNK = TT / 64;
__device__ __forceinline__ int lru_pos(int dir, int c) { return dir == 0 ? c : (c < 4 ? 3 - c : 4 + (NCHUNK - 1 - c)); }

__device__ __forceinline__ void ph_lru_prepw(const P& p) {
  for (int idx = GTID; idx < 2 * 2 * 4 * 2 * 4096; idx += GSZ) {
    int d = idx & 63, e = (idx >> 6) & 63, mtx = (idx >> 12) & 1, rest = idx >> 13;
    const float* w = (mtx ? p.wx : p.wa) + (size_t)rest * 4096;
    p.lruw_t[idx] = f2bf(w[d * 64 + e]);
  }
}

template <int PASS>
__device__ __forceinline__ void lru_item(const P& p, int l, int cidx, int kb, char* smem) {
  bf16_t* u_img = (bf16_t*)smem;
  float* ab_a = (float*)(smem + 8192);
  float* ab_b = (float*)(smem + 8192 + 16384);
  float* hsum = (float*)(smem + 8192 + 32768);
  float* segagg = (float*)(smem + 8192 + 49152);
  float* ccarry = (float*)(smem + 8192 + 49152 + 2048);
  const int tid = tid_opaque(), lane = tid & 63, wv = tid >> 6, g = lane >> 4, lr = lane & 15;
  const int t0 = cidx * 64;
  const int lo = t0 < LC ? 0 : LC, hi = t0 < LC ? LC : TT;
  __syncthreads();
  {
    const int ch = tid & 63, c = kb * 64 + ch, sg = tid >> 6;
    const float cb = p.conv_b[l * 256 + c];
    float cw[4];
#pragma unroll
    for (int k = 0; k < 4; ++k) cw[k] = p.conv_w[(l * 4 + k) * 256 + c];
    float xr[19];
#pragma unroll
    for (int i = 0; i < 19; ++i) {
      int tt = t0 + sg * 16 + i - 2;
      int tc = tt < lo ? lo : (tt >= hi ? hi - 1 : tt);
      float v = p.proj[(size_t)tc * 512 + OFF_XA + c];
      xr[i] = (tt >= lo && tt < hi) ? v : 0.f;
    }
#pragma unroll
    for (int i = 0; i < 16; ++i) {
      int row = sg * 16 + i;
      float acc = cb + cw[0] * xr[i] + cw[1] * xr[i + 1] + cw[2] * xr[i + 2] + cw[3] * xr[i + 3];
      u_img[row * 64 + ((((ch >> 3) ^ (row & 7)) << 3) | (ch & 7))] = f2bf(acc);
    }
  }
  if (PASS == 2) {
    if (tid < 128) {
      const int ch = tid & 63, dir = tid >> 6;
      ccarry[dir * 64 + ch] = p.lcarry[((size_t)dir * NCHUNK + lru_pos(dir, cidx)) * 256 + kb * 64 + ch];
    }
  }
  __syncthreads();
  for (int dir = 0; dir < 2; ++dir) {
    const int pd = l * 2 + dir;
    {
      f32x4 ga[4], gx[4];
#pragma unroll
      for (int i = 0; i < 4; ++i) { ga[i] = (f32x4){0.f, 0.f, 0.f, 0.f}; gx[i] = (f32x4){0.f, 0.f, 0.f, 0.f}; }
      const bf16_t* wbase = p.lruw_t + (size_t)((pd * 4 + kb) * 2) * 4096 + (16 * wv + lr) * 64 + 8 * g;
#pragma unroll
      for (int s = 0; s < 2; ++s) {
        bf16x8 ba_ = *(const bf16x8*)(wbase + 32 * s);
        bf16x8 bx_ = *(const bf16x8*)(wbase + 4096 + 32 * s);
#pragma unroll
        for (int i = 0; i < 4; ++i) {
          int row = 16 * i + lr;
          bf16x8 af = *(const bf16x8*)((const char*)u_img + row * 128 + (((4 * s + g) ^ (row & 7)) << 4));
          ga[i] = __builtin_amdgcn_mfma_f32_16x16x32_bf16(af, ba_, ga[i], 0, 0, 0);
          gx[i] = __builtin_amdgcn_mfma_f32_16x16x32_bf16(af, bx_, gx[i], 0, 0, 0);
        }
      }
      const int ch = 16 * wv + lr, c = kb * 64 + ch;
      const float bav = p.ba[pd * 256 + c], bxv = p.bx[pd * 256 + c];
      const float sp = log1pf(expf(-p.lam[pd * 256 + c]));
#pragma unroll
      for (int i = 0; i < 4; ++i)
#pragma unroll
        for (int r = 0; r < 4; ++r) {
          int row = 16 * i + 4 * g + r;
          float rr = sigmoid_f(ga[i][r] + bav), ig = sigmoid_f(gx[i][r] + bxv);
          float log_a = -8.f * rr * sp;
          float a = __expf(log_a);
          float uu = bf2f(u_img[row * 64 + ((((ch >> 3) ^ (row & 7)) << 3) | (ch & 7))]);
          const float x2 = 2.f * log_a;
          const float ser = -x2 * (1.f + x2 * (0.5f + x2 * (0.16666667f + x2 * (0.041666668f + x2 * 0.0083333338f))));
          const float om = x2 > -0.25f ? ser : 1.f - a * a;
          float b = sqrtf(om) * ig * uu;
          ab_a[row * 64 + ch] = a;
          ab_b[row * 64 + ch] = b;
        }
    }
    __syncthreads();
    {
      const int ch = tid & 63, seg = tid >> 6;
      float Pr = 1.f, H = 0.f;
#pragma unroll
      for (int i = 0; i < 16; ++i) {
        int row = dir == 0 ? seg * 16 + i : seg * 16 + 15 - i;
        float a = ab_a[row * 64 + ch], b = ab_b[row * 64 + ch];
        H = a * H + b;
        Pr *= a;
      }
      segagg[(seg * 64 + ch) * 2] = Pr;
      segagg[(seg * 64 + ch) * 2 + 1] = H;
      __syncthreads();
      if (PASS == 1) {
        if (seg == 0) {
          float A = 1.f, B = 0.f;
#pragma unroll
          for (int s2 = 0; s2 < 4; ++s2) {
            int sg = dir == 0 ? s2 : 3 - s2;
            float pa = segagg[(sg * 64 + ch) * 2], pb = segagg[(sg * 64 + ch) * 2 + 1];
            B = pa * B + pb;
            A *= pa;
          }
          float2* ag = (float2*)p.lagg + ((size_t)dir * NCHUNK + lru_pos(dir, cidx)) * 256 + kb * 64 + ch;
          *ag = make_float2(A, B);
        }
      } else {
        float h = ccarry[dir * 64 + ch];
        float gav[16];
        if (dir == 1) {
#pragma unroll
          for (int i = 0; i < 16; ++i) gav[i] = p.proj[(size_t)(t0 + seg * 16 + 15 - i) * 512 + OFF_GA + kb * 64 + ch];
        }
#pragma unroll
        for (int s2 = 0; s2 < 3; ++s2) {
          int sg = dir == 0 ? s2 : 3 - s2;
          bool before = dir == 0 ? (sg < seg) : (sg > seg);
          if (before) h = segagg[(sg * 64 + ch) * 2] * h + segagg[(sg * 64 + ch) * 2 + 1];
        }
#pragma unroll
        for (int i = 0; i < 16; ++i) {
          int row = dir == 0 ? seg * 16 + i : seg * 16 + 15 - i;
          float a = ab_a[row * 64 + ch], b = ab_b[row * 64 + ch];
          h = a * h + b;
          if (dir == 0) hsum[row * 64 + ch] = h;
          else {
            int t = t0 + row, c = kb * 64 + ch;
            p.mixb[(size_t)t * 1024 + c] = f2bf((hsum[row * 64 + ch] + h) * gelu_f(gav[i]));
          }
        }
      }
    }
    __syncthreads();
  }
}

__device__ __forceinline__ void ph_lru_carry(const P& p, float* smem) {
  const int tid = tid_opaque(), seg = tid >> 4, c16 = tid & 15;
  for (int blk = blockIdx.x; blk < 32; blk += gridDim.x) {
    const int dc = blk * 16 + c16, dir = dc >> 8, ch = dc & 255;
    const float2* ag = (const float2*)p.lagg + (size_t)dir * NCHUNK * 256 + ch;
    float2 v[17];
#pragma unroll
    for (int i = 0; i < 17; ++i) {
      int pos = seg * 17 + i;
      v[i] = pos < NCHUNK ? ag[(size_t)pos * 256] : make_float2(1.f, 0.f);
    }
    float A = 1.f, B = 0.f;
#pragma unroll
    for (int i = 0; i < 17; ++i) { B = v[i].x * B + v[i].y; A *= v[i].x; }
    __syncthreads();
    smem[(seg * 16 + c16) * 2] = A; smem[(seg * 16 + c16) * 2 + 1] = B;
    __syncthreads();
    float h = 0.f;
    for (int s2 = 0; s2 < seg; ++s2) h = smem[(s2 * 16 + c16) * 2] * h + smem[(s2 * 16 + c16) * 2 + 1];
    float* cr = p.lcarry + (size_t)dir * NCHUNK * 256 + ch;
#pragma unroll
    for (int i = 0; i < 17; ++i) {
      int pos = seg * 17 + i;
      if (pos < NCHUNK) cr[(size_t)pos * 256] = h;
      h = v[i].x * h + v[i].y;
    }
  }
}

template <int PASS>
__device__ __forceinline__ void ph_lru(const P& p, int l, char* smem) {
  const int c_begin = (PASS == 2 && l == 1) ? 4 : 0;
  const int nitems = (NCHUNK - c_begin) * 4;
  for (int it = blockIdx.x; it < nitems; it += gridDim.x) lru_item<PASS>(p, l, c_begin + (it >> 2), it & 3, smem);
}

typedef __attribute__((ext_vector_type(4))) short s16x4;

__device__ __forceinline__ void ph_qknorm_rope2(const P& p, int l) {
  const int tid_ = tid_opaque();
  const int lane = tid_ & 63;
  const int wpb = blockDim.x >> 6;
  for (int pair = blockIdx.x * wpb + (tid_ >> 6); pair < TT * 28; pair += gridDim.x * wpb) {
    int t = pair / 28, slot = pair % 28;
    const float* g = nullptr; bool rope = false; float scale = 1.f;
    if (slot < 6) { g = p.win_qn + l * 64; rope = true; scale = QSCALE; }
    else if (slot < 8) { g = p.win_kn + l * 64; rope = true; }
    else if (slot < 10) { }
    else if (slot < 16) { g = p.na_qn + l * 64; scale = QSCALE; }
    else if (slot < 22) { g = p.na_kn + l * 64; }
    rope = rope && (t >= LC);
    const size_t idx = (size_t)t * DIN + 512 + slot * 64 + lane;
    float v = bf2f(p.projb[idx]);
    float y = v;
    if (g) {
      float ss = wave_sum(v * v);
      y = v * rsqrtf(ss * (1.f / 64.f) + EPS) * g[lane];
    }
    float partner = __shfl_xor(y, 16);
    if (rope) {
      int pos = t - LC, row = pos >> 6, col = pos & 63;
      int j = lane & 15, axis = lane >> 5;
      float inv = __expf(-(float)j * (1.f / 16.f) * 9.210340371976184f);
      float ang = (float)(axis ? col : row) * inv;
      float k = rintf(ang * 0.15915494309189535f);
      float r = fmaf(-k, 6.2831854820251465f, ang);
      r = fmaf(-k, -1.7484555e-07f, r);
      float cs = __cosf(r), sn = __sinf(r);
      bool first = ((lane >> 4) & 1) == 0;
      y = first ? (y * cs - partner * sn) : (partner * sn + y * cs);
    }
    p.projb[idx] = f2bf(y * scale);
  }
}

template <int CTRL, int RMASK>
__device__ __forceinline__ float dpp_mov_id(float v) {
  return __int_as_float(__builtin_amdgcn_update_dpp(__float_as_int(v), __float_as_int(v), CTRL, RMASK, 0xf, false));
}
__device__ __forceinline__ float wave_max(float v) {
  v = fmaxf(v, dpp_mov_id<0xB1, 0xf>(v));
  v = fmaxf(v, dpp_mov_id<0x4E, 0xf>(v));
  v = fmaxf(v, dpp_mov_id<0x141, 0xf>(v));
  v = fmaxf(v, dpp_mov_id<0x140, 0xf>(v));
  v = fmaxf(v, dpp_mov_id<0x142, 0xa>(v));
  v = fmaxf(v, dpp_mov_id<0x143, 0xc>(v));
  return __int_as_float(__builtin_amdgcn_readlane(__float_as_int(v), 63));
}

template <class TokFn>
__device__ __forceinline__ void kv_issue(const P& p, char* stage, int koff, int voff, TokFn tok, int wv, int lane) {
#pragma unroll
  for (int i = 0; i < 2; ++i) {
    const int row = 16 * wv + 8 * i + (lane >> 3);
    const bf16_t* src = p.projb + (size_t)tok(row) * DIN + (((lane & 7) ^ (row & 7)) << 3);
    char* dst = stage + (2 * wv + i) * 1024;
    __builtin_amdgcn_global_load_lds((const unsigned*)(src + koff), (__attribute__((address_space(3))) unsigned*)dst, 16, 0, 0);
    __builtin_amdgcn_global_load_lds((const unsigned*)(src + voff), (__attribute__((address_space(3))) unsigned*)(dst + 8192), 16, 0, 0);
  }
}
__device__ __forceinline__ void kv_wait(int rem) {
  if (rem >= 3) asm volatile("s_waitcnt vmcnt(8) lgkmcnt(0)" ::: "memory");
  else if (rem == 2) asm volatile("s_waitcnt vmcnt(4) lgkmcnt(0)" ::: "memory");
  else asm volatile("s_waitcnt vmcnt(0) lgkmcnt(0)" ::: "memory");
  __builtin_amdgcn_s_barrier();
}

template <class MaskFn>
__device__ __forceinline__ void attn_step2(const char* stage, int kr0, const bf16x8 (&qf)[2][2], f32x4 (&o)[2][4], float (&lsum)[2], MaskFn mb,
                                           int lane, bool act0, bool act1) {
  const int g = lane >> 4, lr = lane & 15;
  bf16x8 kf[2][2];
#pragma unroll
  for (int t2 = 0; t2 < 2; ++t2) {
    const int row = kr0 + 16 * t2 + lr;
#pragma unroll
    for (int s = 0; s < 2; ++s) kf[t2][s] = *(const bf16x8*)(stage + row * 128 + (((4 * s + g) ^ (row & 7)) << 4));
  }
  bf16x8 pb[2];
#pragma unroll
  for (int qt = 0; qt < 2; ++qt) {
    if (qt == 0 ? act0 : act1) {
      f32x4 st[2];
#pragma unroll
      for (int t2 = 0; t2 < 2; ++t2) {
        st[t2] = (f32x4){0.f, 0.f, 0.f, 0.f};
#pragma unroll
        for (int s = 0; s < 2; ++s) st[t2] = __builtin_amdgcn_mfma_f32_16x16x32_bf16(kf[t2][s], qf[qt][s], st[t2], 0, 0, 0);
      }
#pragma unroll
      for (int t2 = 0; t2 < 2; ++t2)
#pragma unroll
        for (int r = 0; r < 4; ++r) {
          float pv = exp2f(mb(qt, t2, r, st[t2][r]));
          lsum[qt] += pv;
          pb[qt][t2 * 4 + r] = (short)f2bf(pv);
        }
    }
  }
  const int q = lr >> 2, pp = lane & 3;
#pragma unroll
  for (int m = 0; m < 4; ++m) {
    bf16x8 vf;
#pragma unroll
    for (int t = 0; t < 2; ++t) {
      const int row = kr0 + 16 * t + 4 * g + q;
      const char* addr = stage + 8192 + row * 128 + (((2 * m + (pp >> 1)) ^ (row & 7)) << 4) + 8 * (pp & 1);
      s16x4 v4 = __builtin_amdgcn_ds_read_tr16_b64_v4i16((__attribute__((address_space(3))) s16x4*)addr);
      vf[4 * t + 0] = v4[0]; vf[4 * t + 1] = v4[1]; vf[4 * t + 2] = v4[2]; vf[4 * t + 3] = v4[3];
    }
    if (act0) o[0][m] = __builtin_amdgcn_mfma_f32_16x16x32_bf16(vf, pb[0], o[0][m], 0, 0, 0);
    if (act1) o[1][m] = __builtin_amdgcn_mfma_f32_16x16x32_bf16(vf, pb[1], o[1][m], 0, 0, 0);
  }
}

__device__ __forceinline__ void attn_store_out(const P& p, const f32x4 (&o)[4], float lsum, int tok, int col0, int lane) {
  const int g = lane >> 4;
  lsum += __shfl_xor(lsum, 16);
  lsum += __shfl_xor(lsum, 32);
  const float inv = 1.f / lsum;
  bf16_t* op = p.mixb + (size_t)tok * 1024 + col0 + 4 * g;
#pragma unroll
  for (int m = 0; m < 4; ++m)
    *(uint2*)(op + 16 * m) = make_uint2(pack2bf(o[m][0] * inv, o[m][1] * inv), pack2bf(o[m][2] * inv, o[m][3] * inv));
}

__device__ __forceinline__ void attn_win_item(const P& p, int l, int kind, int qb, int hs, char* smem) {
  const int tid = tid_opaque(), lane = tid & 63, wv = __builtin_amdgcn_readfirstlane(tid >> 6), g = lane >> 4, lr = lane & 15;
  int qoff, koff, voff, ooff; const float *gq, *gk; float sink2 = -1e30f; bool has_sink = false;
  if (kind == 0 || hs < 6) {
    const int h = hs, kvh = h / 3;
    qoff = OFF_QW + h * 64; koff = OFF_KW + kvh * 64; voff = OFF_VW + kvh * 64; ooff = 256 + h * 64;
    gq = p.win_qn + l * 64; gk = p.win_kn + l * 64; sink2 = p.win_sink[l * 6 + h] * LOG2E; has_sink = true;
  } else {
    const int h = hs - 6;
    qoff = OFF_QN + h * 64; koff = OFF_KN + h * 64; voff = OFF_VN + h * 64; ooff = 640 + h * 64;
    gq = p.na_qn + l * 64; gk = p.na_kn + l * 64;
  }
  float bound = 8.f * LOG2E * wave_max(fabsf(gq[lane])) * wave_max(fabsf(gk[lane])) * 1.0001f + 1e-3f;
  if (has_sink) bound = fmaxf(bound, sink2);
  const int q0 = qb * 128;
  const int qtok0 = (kind == 0 ? LC : 0) + q0 + 32 * wv;
  bf16x8 qf[2][2];
#pragma unroll
  for (int qt = 0; qt < 2; ++qt)
#pragma unroll
    for (int s = 0; s < 2; ++s) qf[qt][s] = *(const bf16x8*)(p.projb + (size_t)(qtok0 + 16 * qt + lr) * DIN + qoff + 32 * s + 8 * g);
  f32x4 o[2][4];
#pragma unroll
  for (int qt = 0; qt < 2; ++qt)
#pragma unroll
    for (int m = 0; m < 4; ++m) o[qt][m] = (f32x4){0.f, 0.f, 0.f, 0.f};
  float lsum[2] = {0.f, 0.f};
  const int nloc = (kind == 0) ? 6 : 0, nch = nloc + 4;
  auto tokfn = [&](int c) {
    return [=](int row) {
      if (c < nloc) { int pos = q0 - 128 + 64 * c + row; pos = pos < 0 ? 0 : (pos > SEQ - 1 ? SEQ - 1 : pos); return LC + pos; }
      return 64 * (c - nloc) + row;
    };
  };
  __syncthreads();
  kv_issue(p, smem, koff, voff, tokfn(0), wv, lane);
  kv_issue(p, smem + 16384, koff, voff, tokfn(1), wv, lane);
  kv_issue(p, smem + 32768, koff, voff, tokfn(2), wv, lane);
  for (int c = 0; c < nch; ++c) {
    kv_wait(nch - c);
    if (c + 3 < nch) kv_issue(p, smem + ((c + 3) & 3) * 16384, koff, voff, tokfn(c + 3), wv, lane);
    const char* stage = smem + (c & 3) * 16384;
    if (c < nloc) {
      const int qw0 = q0 + 32 * wv;
#pragma unroll
      for (int st = 0; st < 2; ++st) {
        const int kbase = q0 - 128 + 64 * c + 32 * st;
        const bool a0 = !(kbase - (qw0 + 15) > 128 || qw0 - (kbase + 31) > 128) && (kbase + 31 >= 0) && (kbase < SEQ);
        const bool a1 = !(kbase - (qw0 + 31) > 128 || (qw0 + 16) - (kbase + 31) > 128) && (kbase + 31 >= 0) && (kbase < SEQ);
        if (a0 || a1)
          attn_step2(stage, 32 * st, qf, o, lsum, [&](int qt, int t2, int r, float s) {
            int kpos = kbase + 16 * t2 + 4 * g + r;
            int dlt = kpos - (qw0 + 16 * qt + lr); dlt = dlt < 0 ? -dlt : dlt;
            bool valid = (kpos >= 0) && (kpos < SEQ) && (dlt <= 128);
            return valid ? s - bound : -1e30f;
          }, lane, a0, a1);
      }
    } else {
#pragma unroll
      for (int st = 0; st < 2; ++st)
        attn_step2(stage, 32 * st, qf, o, lsum, [&](int qt, int t2, int r, float s) { return s - bound; }, lane, true, true);
    }
  }
#pragma unroll
  for (int qt = 0; qt < 2; ++qt) {
    float ls = lsum[qt];
    if (has_sink && g == 0) ls += exp2f(sink2 - bound);
    attn_store_out(p, o[qt], ls, qtok0 + 16 * qt + lr, ooff, lane);
  }
}

__device__ __forceinline__ void attn_na_item(const P& p, int l, int rp, int h, char* smem) {
  const int tid = tid_opaque(), lane = tid & 63, wv = __builtin_amdgcn_readfirstlane(tid >> 6), g = lane >> 4, lr = lane & 15;
  const int qoff = OFF_QN + h * 64, koff = OFF_KN + h * 64, voff = OFF_VN + h * 64, ooff = 640 + h * 64;
  float* rpbl = (float*)(smem + 65536);
  const float* rpbg = p.rpb + (size_t)(l * 6 + h) * 465;
  float bmax = 0.f;
  __syncthreads();
  for (int i = tid; i < 465; i += 256) rpbl[i] = rpbg[i] * LOG2E;
  for (int i = lane; i < 465; i += 64) bmax = fmaxf(bmax, fabsf(rpbg[i]) * LOG2E);
  bmax = wave_max(bmax);
  const float bound = 8.f * LOG2E * wave_max(fabsf(p.na_qn[l * 64 + lane])) * wave_max(fabsf(p.na_kn[l * 64 + lane])) * 1.0001f + bmax + 1e-3f;
  const int r0 = 2 * rp;
  const int qcol = 16 * wv + lr;
  const int qtok0 = LC + r0 * 64 + qcol;
  const int kra = min(max(r0 - 4, 0), 248), krb = min(max(r0 + 1 - 4, 0), 248);
  const int nrow = krb + 8 - kra, nch = nrow + 4;
  const int kc0 = min(max(16 * wv - 8, 0), 32);
  const int qs = min(max(qcol - 8, 0), 48);
  bf16x8 qf[2][2];
#pragma unroll
  for (int qt = 0; qt < 2; ++qt)
#pragma unroll
    for (int s = 0; s < 2; ++s) qf[qt][s] = *(const bf16x8*)(p.projb + (size_t)(qtok0 + 64 * qt) * DIN + qoff + 32 * s + 8 * g);
  f32x4 o[2][4];
#pragma unroll
  for (int qt = 0; qt < 2; ++qt)
#pragma unroll
    for (int m = 0; m < 4; ++m) o[qt][m] = (f32x4){0.f, 0.f, 0.f, 0.f};
  float lsum[2] = {0.f, 0.f};
  auto tokfn = [&](int c) {
    return [=](int row) { return c < nrow ? LC + (kra + c) * 64 + row : 64 * (c - nrow) + row; };
  };
  kv_issue(p, smem, koff, voff, tokfn(0), wv, lane);
  kv_issue(p, smem + 16384, koff, voff, tokfn(1), wv, lane);
  kv_issue(p, smem + 32768, koff, voff, tokfn(2), wv, lane);
  for (int c = 0; c < nch; ++c) {
    kv_wait(nch - c);
    if (c + 3 < nch) kv_issue(p, smem + ((c + 3) & 3) * 16384, koff, voff, tokfn(c + 3), wv, lane);
    const char* stage = smem + (c & 3) * 16384;
    if (c < nrow) {
      const int krow = kra + c;
      const bool a0 = krow < kra + 8, a1 = krow >= krb;
      attn_step2(stage, kc0, qf, o, lsum, [&](int qt, int t2, int rr, float s) {
        int kcol = kc0 + 16 * t2 + 4 * g + rr;
        bool valid = (kcol >= qs) && (kcol < qs + 16);
        int dc = kcol - qcol + 15; dc = dc < 0 ? 0 : (dc > 30 ? 30 : dc);
        int dr = krow - (r0 + qt) + 7; dr = dr < 0 ? 0 : (dr > 14 ? 14 : dr);
        return valid ? s + rpbl[dr * 31 + dc] - bound : -1e30f;
      }, lane, a0, a1);
    } else {
#pragma unroll
      for (int st = 0; st < 2; ++st)
        attn_step2(stage, 32 * st, qf, o, lsum, [&](int qt, int t2, int rr, float s) { return s - bound; }, lane, true, true);
    }
  }
#pragma unroll
  for (int qt = 0; qt < 2; ++qt) attn_store_out(p, o[qt], lsum[qt], qtok0 + 64 * qt, ooff, lane);
}

__device__ __forceinline__ void ph_attn(const P& p, int l, char* smem) {
  const int nitems = 1536 + (l == 0 ? 24 : 0);
  for (int it = blockIdx.x; it < nitems; it += gridDim.x) {
    if (it < 768) attn_win_item(p, l, 0, it / 6, it % 6, smem);
    else if (it < 1536) { int j = it - 768; attn_na_item(p, l, j / 6, j % 6, smem); }
    else { int j = it - 1536; attn_win_item(p, l, 1, j / 12, j % 12, smem); }
  }
}

__device__ __forceinline__ unsigned ord_key(float s) {
  unsigned u = __float_as_uint(s);
  return (u & 0x80000000u) ? ~u : (u | 0x80000000u);
}
__device__ __forceinline__ float ord_val(unsigned pk) {
  unsigned u = pk & ~127u;
  unsigned b = (u & 0x80000000u) ? (u & 0x7fffffffu) : ~u;
  return __uint_as_float(b);
}
__device__ __forceinline__ void ce_desc(unsigned& a, unsigned& b) {
  unsigned mx = a > b ? a : b, mn = a > b ? b : a;
  a = mx; b = mn;
}
__device__ __forceinline__ void sort16_desc(unsigned (&v)[16]) {
#pragma unroll
  for (int k = 2; k <= 16; k <<= 1) {
#pragma unroll
    for (int j = k >> 1; j > 0; j >>= 1) {
#pragma unroll
      for (int i = 0; i < 16; ++i) {
        int m = i ^ j;
        if (m > i) {
          if ((i & k) == 0) ce_desc(v[i], v[m]); else ce_desc(v[m], v[i]);
        }
      }
    }
  }
}
__device__ __forceinline__ void merge16_desc(unsigned (&a)[16], const unsigned (&b)[16]) {
#pragma unroll
  for (int i = 0; i < 16; ++i) { unsigned o = b[15 - i]; a[i] = a[i] > o ? a[i] : o; }
#pragma unroll
  for (int j = 8; j > 0; j >>= 1) {
#pragma unroll
    for (int i = 0; i < 16; ++i) {
      int m = i ^ j;
      if (m > i) ce_desc(a[i], a[m]);
    }
  }
}

typedef __attribute__((ext_vector_type(2))) float f32x2;
__device__ __forceinline__ void ph_prep_peer(const P& p) {
  const int tid = tid_opaque(), lane = tid & 63;
  const int nw = gridDim.x * 4;
  for (int row = blockIdx.x * 4 + (tid >> 6); row < 4 * 16384; row += nw) {
    const int tbl = row >> 15, le = row & 32767;
    const float4* src = (const float4*)((tbl ? p.pv : p.pu) + (size_t)le * 1024) + lane * 4;
    float4 v[4];
    float am = 0.f;
#pragma unroll
    for (int i = 0; i < 4; ++i) {
      v[i] = src[i];
      am = fmaxf(am, fmaxf(fmaxf(fabsf(v[i].x), fabsf(v[i].y)), fmaxf(fabsf(v[i].z), fabsf(v[i].w))));
    }
    am = wave_max(am);
    const float sc = am > 0.f ? 224.f / am : 1.f;
    unsigned w[4];
#pragma unroll
    for (int i = 0; i < 4; ++i) {
      int t = __builtin_amdgcn_cvt_pk_fp8_f32(v[i].x * sc, v[i].y * sc, 0, false);
      t = __builtin_amdgcn_cvt_pk_fp8_f32(v[i].z * sc, v[i].w * sc, t, true);
      w[i] = (unsigned)t;
    }
    ((uint4*)((tbl ? p.vb8 : p.ub8) + (size_t)le * 1024))[lane] = make_uint4(w[0], w[1], w[2], w[3]);
    if (lane == 0) (tbl ? p.vsc : p.usc)[le] = am > 0.f ? am / 224.f : 1.f;
  }
  for (int i = GTID; i < 2 * 128 * 128; i += GSZ) { p.k1b[i] = f2bf(p.k1[i]); p.k2b[i] = f2bf(p.k2[i]); }
}

struct EpiPeerTopk {
  int l;
  __device__ __forceinline__ void operator()(const P& p, f32x4 (&acc)[4][4], int m0, int n0, int wm, int wn, int lane, char* smem) const {
    const int tid = ((wm * 2 + wn) << 6) | lane, g = lane >> 4, lr = lane & 15;
    const int nt = n0 >> 7, head = nt >> 1, hf = nt & 1;
    char* qimg = smem;
    char* kimg = smem + 34816;
    float* rinvl = (float*)(smem + 69632);
    if (tid < 128) {
      float s = 0.f;
#pragma unroll
      for (int q = 0; q < 8; ++q) s += p.rowss[(size_t)q * TT + m0 + tid];
      rinvl[tid] = rsqrtf(s * (1.f / 1024.f) + EPS);
    }
    __syncthreads();
    {
      const float* bq = p.bq + (l * 2 + (m0 < LC ? 1 : 0)) * NPQ + n0 + wn * 64 + lr;
      float bqv[4];
#pragma unroll
      for (int j = 0; j < 4; ++j) bqv[j] = bq[16 * j];
      char* qw = qimg + (wm * 64 + 4 * g) * 272 + (wn * 64 + lr) * 2;
#pragma unroll
      for (int i = 0; i < 4; ++i)
#pragma unroll
        for (int r = 0; r < 4; ++r) {
          const float rv = rinvl[wm * 64 + 16 * i + 4 * g + r];
#pragma unroll
          for (int j = 0; j < 4; ++j) *(bf16_t*)(qw + (16 * i + r) * 272 + 32 * j) = f2bf(acc[i][j][r] * rv + bqv[j]);
        }
      const bf16_t* kk = (hf ? p.k2b : p.k1b) + (size_t)l * 16384 + (tid >> 4) * 128 + (tid & 15) * 8;
      char* kw = kimg + (tid >> 4) * 272 + (tid & 15) * 16;
#pragma unroll
      for (int i = 0; i < 8; ++i) *(uint4*)(kw + i * 16 * 272) = *(const uint4*)(kk + i * 16 * 128);
    }
    __syncthreads();
#pragma unroll
    for (int i = 0; i < 4; ++i)
#pragma unroll
      for (int j = 0; j < 4; ++j) acc[i][j] = (f32x4){0.f, 0.f, 0.f, 0.f};
    {
      const char* qa = qimg + (wm * 64 + lr) * 272 + g * 16;
      const char* kb = kimg + (wn * 64 + lr) * 272 + g * 16;
#pragma unroll
      for (int s = 0; s < 4; ++s) {
        bf16x8 af[4], bfr[4];
#pragma unroll
        for (int i = 0; i < 4; ++i) af[i] = *(const bf16x8*)(qa + i * 16 * 272 + s * 64);
#pragma unroll
        for (int j = 0; j < 4; ++j) bfr[j] = *(const bf16x8*)(kb + j * 16 * 272 + s * 64);
#pragma unroll
        for (int i = 0; i < 4; ++i)
#pragma unroll
          for (int j = 0; j < 4; ++j) acc[i][j] = __builtin_amdgcn_mfma_f32_16x16x32_bf16(af[i], bfr[j], acc[i][j], 0, 0, 0);
      }
    }
    __syncthreads();
    unsigned* simg = (unsigned*)smem;
    {
      unsigned* sw = simg + (wm * 64 + 4 * g) * 129 + wn * 64 + lr;
#pragma unroll
      for (int i = 0; i < 4; ++i)
#pragma unroll
        for (int r = 0; r < 4; ++r)
#pragma unroll
          for (int j = 0; j < 4; ++j)
            sw[(16 * i + r) * 129 + 16 * j] = (ord_key(acc[i][j][r]) & ~127u) | (unsigned)(wn * 64 + 16 * j + lr);
    }
    __syncthreads();
    const int row = tid & 127, half = tid >> 7;
    unsigned top[16];
    {
      const unsigned* sr = simg + row * 129 + half * 64;
#pragma unroll
      for (int k = 0; k < 16; ++k) top[k] = sr[k];
      sort16_desc(top);
#pragma unroll 1
      for (int gi = 1; gi < 4; ++gi) {
        unsigned v1[16];
#pragma unroll
        for (int k = 0; k < 16; ++k) v1[k] = sr[gi * 16 + k];
        sort16_desc(v1);
        merge16_desc(top, v1);
      }
    }
    __syncthreads();
    if (half == 1) {
#pragma unroll
      for (int k = 0; k < 16; ++k) simg[k * 128 + row] = top[k];
    }
    __syncthreads();
    if (half == 0) {
      unsigned o[16];
#pragma unroll
      for (int k = 0; k < 16; ++k) o[k] = simg[k * 128 + row];
      merge16_desc(top, o);
      uint4* dst = (uint4*)(p.pk + (((size_t)(m0 + row) * 8 + head) * 2 + hf) * 16);
#pragma unroll
      for (int k = 0; k < 4; ++k) dst[k] = make_uint4(top[4 * k], top[4 * k + 1], top[4 * k + 2], top[4 * k + 3]);
    }
  }
};

__device__ const unsigned char CAND_A[64] = {0,0,0,0,0,0,0,0,0,0,0,0,0,0,0,0, 1,1,1,1,1,1,1,1, 2,2,2,2,2, 3,3,3,3, 4,4,4, 5,5, 6,6, 7,7,
                                             8,9,10,11,12,13,14,15, 0,0,0,0,0,0,0,0,0,0,0,0,0,0};
__device__ const unsigned char CAND_B[64] = {0,1,2,3,4,5,6,7,8,9,10,11,12,13,14,15, 0,1,2,3,4,5,6,7, 0,1,2,3,4, 0,1,2,3, 0,1,2, 0,1, 0,1, 0,1,
                                             0,0,0,0,0,0,0,0, 0,0,0,0,0,0,0,0,0,0,0,0,0,0};

__device__ __forceinline__ void ph_peer_apply2(const P& p, int l, int t0, char* smem) {
  const int tid = tid_opaque(), lane = tid & 63, wv = tid >> 6;
  int* lds_e = (int*)(smem + wv * 1024);
  float* lds_g = (float*)(smem + wv * 1024 + 512);
  const unsigned char* U = p.ub8 + (size_t)l * 16384 * 1024;
  const unsigned char* V = p.vb8 + (size_t)l * 16384 * 1024;
  const float* usc = p.usc + l * 16384;
  const float* vsc = p.vsc + l * 16384;
  const float* n2g = p.norm2_g + l * 1024;
  const int ca = CAND_A[lane], cb = CAND_B[lane];
  for (int tk = t0 + blockIdx.x * 4 + wv; tk < TT; tk += gridDim.x * 4) {
    const float* mod = p.mod + (l * 2 + (tk < LC ? 1 : 0)) * 6144;
    float xv[16], hv[16];
    {
      const float4* xp = (const float4*)(p.xall + (size_t)tk * 1024) + lane * 4;
      float ss = 0.f;
#pragma unroll
      for (int q = 0; q < 4; ++q) {
        float4 v = xp[q];
        xv[q * 4 + 0] = v.x; xv[q * 4 + 1] = v.y; xv[q * 4 + 2] = v.z; xv[q * 4 + 3] = v.w;
        ss += v.x * v.x + v.y * v.y + v.z * v.z + v.w * v.w;
      }
      ss = wave_sum(ss);
      float rinv = rsqrtf(ss * (1.f / 1024.f) + EPS);
#pragma unroll
      for (int q = 0; q < 4; ++q) {
        float4 gg = ((const float4*)n2g)[lane * 4 + q], sc = ((const float4*)(mod + 4096))[lane * 4 + q], sh = ((const float4*)(mod + 3072))[lane * 4 + q];
        hv[q * 4 + 0] = xv[q * 4 + 0] * rinv * gg.x * (1.f + sc.x) + sh.x;
        hv[q * 4 + 1] = xv[q * 4 + 1] * rinv * gg.y * (1.f + sc.y) + sh.y;
        hv[q * 4 + 2] = xv[q * 4 + 2] * rinv * gg.z * (1.f + sc.z) + sh.z;
        hv[q * 4 + 3] = xv[q * 4 + 3] * rinv * gg.w * (1.f + sc.w) + sh.w;
      }
    }
    for (int head = 0; head < 8; ++head) {
      const unsigned* pk = p.pk + ((size_t)tk * 8 + head) * 32;
      unsigned p1 = pk[ca], p2 = pk[16 + cb];
      float sum = lane < 50 ? ord_val(p1) + ord_val(p2) : -3.0e38f;
      int eid = (int)(p1 & 127u) * 128 + (int)(p2 & 127u);
      int rank = 0;
      for (int m = 0; m < 50; ++m) {
        float sm = __shfl(sum, m);
        rank += (sm > sum || (sm == sum && m < lane)) ? 1 : 0;
      }
      float mx = wave_max(sum);
      bool sel = (lane < 50) && (rank < 16);
      float e = sel ? __expf(sum - mx) : 0.f;
      float tot = wave_sum(e);
      if (sel) { lds_e[head * 16 + rank] = eid; lds_g[head * 16 + rank] = e / tot; }
    }
    float acc[16];
#pragma unroll
    for (int k = 0; k < 16; ++k) acc[k] = 0.f;
    for (int e0 = 0; e0 < 128; e0 += 8) {
      uint4 ur[8], vr[8];
      float gt[8], us[8], vs[8];
#pragma unroll
      for (int k = 0; k < 8; ++k) {
        int ex = __builtin_amdgcn_readfirstlane(lds_e[e0 + k]);
        gt[k] = lds_g[e0 + k];
        ur[k] = ((const uint4*)(U + (size_t)ex * 1024))[lane];
        vr[k] = ((const uint4*)(V + (size_t)ex * 1024))[lane];
        us[k] = usc[ex]; vs[k] = vsc[ex];
      }
#pragma unroll
      for (int k = 0; k < 8; ++k) {
        float dot = 0.f;
        unsigned w[4] = {ur[k].x, ur[k].y, ur[k].z, ur[k].w};
#pragma unroll
        for (int q = 0; q < 4; ++q) {
          f32x2 lo = __builtin_amdgcn_cvt_pk_f32_fp8((int)w[q], false), hi = __builtin_amdgcn_cvt_pk_f32_fp8((int)w[q], true);
          dot += lo[0] * hv[q * 4] + lo[1] * hv[q * 4 + 1] + hi[0] * hv[q * 4 + 2] + hi[1] * hv[q * 4 + 3];
        }
        dot = wave_sum(dot) * us[k];
        float a = gt[k] * gelu_f(dot) * vs[k];
        unsigned y[4] = {vr[k].x, vr[k].y, vr[k].z, vr[k].w};
#pragma unroll
        for (int q = 0; q < 4; ++q) {
          f32x2 lo = __builtin_amdgcn_cvt_pk_f32_fp8((int)y[q], false), hi = __builtin_amdgcn_cvt_pk_f32_fp8((int)y[q], true);
          acc[q * 4] += a * lo[0]; acc[q * 4 + 1] += a * lo[1]; acc[q * 4 + 2] += a * hi[0]; acc[q * 4 + 3] += a * hi[1];
        }
      }
    }
    {
      float4* xp = ((l == 1) ? (float4*)(p.out + (size_t)(tk - LC) * 1024) : (float4*)(p.xall + (size_t)tk * 1024)) + lane * 4;
      float ss2 = 0.f;
#pragma unroll
      for (int q = 0; q < 4; ++q) {
        float4 gg = ((const float4*)(mod + 5120))[lane * 4 + q];
        float4 o;
        o.x = xv[q * 4 + 0] + gg.x * acc[q * 4 + 0];
        o.y = xv[q * 4 + 1] + gg.y * acc[q * 4 + 1];
        o.z = xv[q * 4 + 2] + gg.z * acc[q * 4 + 2];
        o.w = xv[q * 4 + 3] + gg.w * acc[q * 4 + 3];
        xp[q] = o;
        xv[q * 4 + 0] = o.x; xv[q * 4 + 1] = o.y; xv[q * 4 + 2] = o.z; xv[q * 4 + 3] = o.w;
        ss2 += o.x * o.x + o.y * o.y + o.z * o.z + o.w * o.w;
      }
      if (l == 0) {
        ss2 = wave_sum(ss2);
        const float rinv2 = rsqrtf(ss2 * (1.f / 1024.f) + EPS);
        const float* mod1 = p.mod + (2 + (tk < LC ? 1 : 0)) * 6144;
        const float* n1g = p.norm1_g + 1024;
        uint2* hp = (uint2*)(p.hb + (size_t)tk * 1024) + lane * 4;
#pragma unroll
        for (int q = 0; q < 4; ++q) {
          float4 gg = ((const float4*)n1g)[lane * 4 + q], sc = ((const float4*)(mod1 + 1024))[lane * 4 + q], sh = ((const float4*)mod1)[lane * 4 + q];
          float h0 = xv[q * 4 + 0] * rinv2 * gg.x * (1.f + sc.x) + sh.x;
          float h1 = xv[q * 4 + 1] * rinv2 * gg.y * (1.f + sc.y) + sh.y;
          float h2 = xv[q * 4 + 2] * rinv2 * gg.z * (1.f + sc.z) + sh.z;
          float h3 = xv[q * 4 + 3] * rinv2 * gg.w * (1.f + sc.w) + sh.w;
          hp[q] = make_uint2(pack2bf(h0, h1), pack2bf(h2, h3));
        }
      }
    }
  }
}

#define XB_TMO      128
#define XB_XCNT(j)  (256  + 64 * (j))
#define XB_XSUB(j)  (1280 + 64 * (j))
#define XB_XGEN(j)  (2304 + 64 * (j))
#define XB_TOP      3328
#define XB_TOPGEN   3392
#define XCD_BAR_WORDS 3456
#define XB_SPIN_CAP (1u << 22)
#define LAS __attribute__((address_space(3)))
__device__ __forceinline__ unsigned xb_ld(unsigned* q) { return __hip_atomic_load(q, __ATOMIC_RELAXED, __HIP_MEMORY_SCOPE_AGENT); }
__device__ __forceinline__ unsigned xb_add(unsigned* q, unsigned v) { return __hip_atomic_fetch_add(q, v, __ATOMIC_RELAXED, __HIP_MEMORY_SCOPE_AGENT); }
__device__ __forceinline__ unsigned xb_xcc_id() { return (unsigned)__builtin_amdgcn_s_getreg((3 << 11) | 20) & 0xFu; }
#define XB_SPIN(cond, bar) do { unsigned _sp = 0; while (cond) { __builtin_amdgcn_s_sleep(1); \
    if ((++_sp & 255u) == 0u) { if (xb_ld(&(bar)[XB_TMO])) break; if (_sp > XB_SPIN_CAP) { atomicAdd(&(bar)[XB_TMO], 1u); break; } } } } while (0)
struct XcdBarrier { unsigned* bar; unsigned x; volatile LAS unsigned* st; };
__device__ __forceinline__ XcdBarrier xcd_barrier_post(unsigned* bar, volatile LAS unsigned* st) {
  XcdBarrier b; b.bar = bar; b.x = xb_xcc_id(); b.st = st;
  if (threadIdx.x == 0) (void)xb_add(&bar[XB_XCNT(b.x)], 1u);
  return b;
}
__device__ __forceinline__ void xcd_barrier_complete(unsigned* bar, unsigned x, unsigned& nloc, unsigned& nx) {
  const unsigned G = gridDim.x * gridDim.y * gridDim.z;
  unsigned sum, cnt, mine, sp = 0u;
  for (;;) {
    sum = 0u; cnt = 0u; mine = 0u;
#pragma unroll
    for (unsigned j = 0; j < 16; ++j) { const unsigned c = xb_ld(&bar[XB_XCNT(j)]); sum += c; cnt += (c > 0u) ? 1u : 0u; mine = (j == x) ? c : mine; }
    if (sum == G) break;
    __builtin_amdgcn_s_sleep(1);
    if ((++sp & 255u) == 0u) { if (xb_ld(&bar[XB_TMO])) break; if (sp > XB_SPIN_CAP) { atomicAdd(&bar[XB_TMO], 1u); break; } }
  }
  nloc = mine > 0u ? mine : 1u; nx = cnt > 0u ? cnt : 1u;
}
__device__ __forceinline__ void xcd_barrier(const XcdBarrier& b) {
  asm volatile("s_waitcnt vmcnt(0)" ::: "memory");
  __syncthreads();
  if (threadIdx.x == 0) {
    unsigned* bar = b.bar;
    __builtin_amdgcn_s_waitcnt(0);
    unsigned nloc = b.st[0], nx = b.st[1];
    if (nloc == 0u) { xcd_barrier_complete(bar, b.x, nloc, nx); b.st[0] = nloc; b.st[1] = nx; }
    const unsigned old = xb_add(&bar[XB_XSUB(b.x)], 1u);
    const unsigned gen = old / nloc;
    if (old + 1u == (gen + 1u) * nloc) {
      __builtin_amdgcn_fence(__ATOMIC_RELEASE, "agent");
      asm volatile("s_waitcnt vmcnt(0)" ::: "memory");
      const unsigned og = xb_add(&bar[XB_TOP], 1u);
      const unsigned tg = og / nx;
      if (og + 1u == (tg + 1u) * nx) xb_add(&bar[XB_TOPGEN], 1u);
      else XB_SPIN(xb_ld(&bar[XB_TOPGEN]) == tg, bar);
      __builtin_amdgcn_fence(__ATOMIC_ACQUIRE, "agent");
      xb_add(&bar[XB_XGEN(b.x)], 1u);
      asm volatile("s_waitcnt vmcnt(0)" ::: "memory");
    } else {
      XB_SPIN(xb_ld(&bar[XB_XGEN(b.x)]) == gen, bar);
      __builtin_amdgcn_fence(__ATOMIC_ACQUIRE, "agent");
      asm volatile("s_waitcnt vmcnt(0)" ::: "memory");
    }
  }
  __syncthreads();
}

#ifndef PROBE_IV
#define PROBE_IV -1
#endif
__device__ __forceinline__ void probe_tick(int& cnt, unsigned long long* slots) {
  if (PROBE_IV >= 0) {
    if (threadIdx.x == 0 && (cnt == PROBE_IV || cnt == PROBE_IV + 1)) slots[cnt - PROBE_IV] = __builtin_amdgcn_s_memrealtime();
    cnt = __builtin_amdgcn_readfirstlane(cnt + 1);
  }
}
#define BARRIER() do { xcd_barrier(xb); probe_tick(pcnt, probe_t); } while (0)

typedef const __attribute__((address_space(4))) P* KP;
__device__ __forceinline__ P load_params(KP kp) {
#if defined(__HIP_DEVICE_COMPILE__)
  asm volatile("" : "+s"(kp));
  return *kp;
#else
  return P{};
#endif
}
#define PP load_params(kp)
__global__ void __launch_bounds__(256, 2) k_mega(P p_unused) {
  KP kp = (KP)__builtin_amdgcn_kernarg_segment_ptr();
  __shared__ __attribute__((aligned(16))) float smem[18432 + 8];
  uint4& xb_words = *(uint4*)(smem + 18432);
  cg::grid_group grid = cg::this_grid();
  if (threadIdx.x == 0) xb_words = make_uint4(0u, 0u, 0u, 0u);
  __syncthreads();
  unsigned long long* probe_t = (unsigned long long*)(smem + 18436);
  int pcnt = 0;
  asm volatile("" : "+s"(pcnt));
  probe_tick(pcnt, probe_t);
  ph_mod(PP, smem);
  ph_prep(PP, smem);
  ph_lru_prepw(PP);
  ph_rope_tab(PP);
  ph_prep_peer(PP);
  grid.sync();
  probe_tick(pcnt, probe_t);
  XcdBarrier xb = xcd_barrier_post(PP.bar, (volatile LAS unsigned*)&xb_words);
  ph_norm_mod(PP, 0, 0, 0, smem, true);
  ph_bq(PP, smem);
  BARRIER();
#pragma unroll 1
  for (int l = 0; l < 2; ++l) {
    const int t0 = (l == 0) ? 0 : LC;
    { const P lp = PP; gemm_bf16_128(lp, lp.hb, lp.w_in_t + (size_t)l * 1024 * DIN, 1024, 0, TT, DIN, (char*)smem, EpiProj{l}); }
    BARRIER();
    ph_lru<1>(PP, l, (char*)smem);
    ph_attn(PP, l, (char*)smem);
    BARRIER();
    ph_lru_carry(PP, smem);
    BARRIER();
    ph_lru<2>(PP, l, (char*)smem);
    BARRIER();
    { const P lp = PP; gemm_bf16_128(lp, lp.mixb, lp.w_out_t + (size_t)l * 1024 * 1024, 1024, t0, TT, 1024, (char*)smem, EpiResid{l}); }
    BARRIER();
    { const P lp = PP; gemm_bf16_128(lp, lp.hb, lp.wq_t + (size_t)l * 1024 * NPQ, 1024, t0, TT, NPQ, (char*)smem, EpiPeerTopk{l}); }
    BARRIER();
    ph_peer_apply2(PP, l, t0, (char*)smem);
    if (l == 0) BARRIER();
  }
  if (PROBE_IV >= 0) {
    probe_tick(pcnt, probe_t);
    __syncthreads();
    if (blockIdx.x == 0 && threadIdx.x == 0) {
      const unsigned long long dt = (probe_t[1] - probe_t[0]) * 8ull, ts = __builtin_amdgcn_s_memrealtime();
      while (__builtin_amdgcn_s_memrealtime() - ts < dt) __builtin_amdgcn_s_sleep(8);
    }
  }
}

extern "C" void kernel_launch(void* const* d_in, const int* in_sizes, int n_in, void* d_out, int out_size, void* d_ws,
                              size_t ws_size, hipStream_t stream) {
  P p{};
  const float** fp = (const float**)&p;
  for (int i = 0; i < 28; ++i) fp[i] = (const float*)d_in[i];
  p.out = (float*)d_out;
  float* w = (float*)d_ws;
  size_t o = 0;
  auto carve = [&](size_t n) { float* r = w + o; o += (n + 63) & ~(size_t)63; return r; };
  p.bar = (unsigned*)carve(4096);
  p.mod = carve(4 * 6144);
  p.xall = carve((size_t)TT * 1024);
  p.proj = carve((size_t)TT * 512);
  p.projb = (bf16_t*)carve((size_t)TT * DIN / 2);
  p.mixb = (bf16_t*)carve((size_t)TT * 512);
  p.hb = (bf16_t*)carve((size_t)TT * 512);
  p.w_in_t = (bf16_t*)carve((size_t)1024 * DIN);
  p.w_out_t = (bf16_t*)carve((size_t)1024 * 1024);
  p.wq_t = (bf16_t*)carve((size_t)1024 * NPQ);
  p.lruw_t = (bf16_t*)carve((size_t)2 * 2 * 4 * 2 * 4096 / 2);
  p.lagg = carve((size_t)2 * NCHUNK * 256 * 2);
  p.lcarry = carve((size_t)2 * NCHUNK * 256);
  p.ropetab = carve(320 * 16 * 2);
  p.rowss = carve((size_t)8 * TT);
  p.bq = carve(4 * NPQ);
  p.pk = (unsigned*)carve((size_t)TT * 256);
  p.ub8 = (unsigned char*)carve((size_t)2 * 16384 * 1024 / 4);
  p.vb8 = (unsigned char*)carve((size_t)2 * 16384 * 1024 / 4);
  p.usc = carve(2 * 16384);
  p.vsc = carve(2 * 16384);
  p.k1b = (bf16_t*)carve(16384);
  p.k2b = (bf16_t*)carve(16384);
  if (o * 4 > ws_size) { fprintf(stderr, "workspace too small: need %zu have %zu\n", o * 4, ws_size); return; }
  static int grid_blocks = 0;
  if (!grid_blocks) {
    int dev = 0, cus = 0, per_cu = 0;
    (void)hipGetDevice(&dev);
    (void)hipDeviceGetAttribute(&cus, hipDeviceAttributeMultiprocessorCount, dev);
    (void)hipOccupancyMaxActiveBlocksPerMultiprocessor(&per_cu, k_mega, 256, 0);
    if (per_cu > 2) per_cu = 2;
    grid_blocks = cus * per_cu;
  }
  (void)hipMemsetAsync(p.bar, 0, XCD_BAR_WORDS * 4, stream);
  void* args[] = {&p};
  hipError_t e = hipLaunchCooperativeKernel((void*)k_mega, dim3(grid_blocks), dim3(256), args, 0, stream);
  if (e != hipSuccess) fprintf(stderr, "cooperative launch failed: %s (grid %d)\n", hipGetErrorString(e), grid_blocks);
}
```

```cpp
#include <hip/hip_runtime.h>
#include <hip/hip_cooperative_groups.h>
#include <stdint.h>
#include <stdio.h>
namespace cg = cooperative_groups;

#ifndef SINGLE_LAUNCH
#define SINGLE_LAUNCH 1
#endif

constexpr int DM = 1024, SEQ = 16384, LC = 256, TT = SEQ + LC, DIN = 2304, NPQ = 2048;
constexpr int OFF_XA = 0, OFF_GA = 256, OFF_QW = 512, OFF_KW = 896, OFF_VW = 1024, OFF_QN = 1152, OFF_KN = 1536, OFF_VN = 1920;
constexpr float EPS = 1e-6f;
#define LAS __attribute__((address_space(3)))
constexpr float LOG2E = 1.4426950408889634f;
constexpr float QSCALE = 0.125f * LOG2E;

struct P {
  const float *x, *c, *ctx, *c_ctx, *w_mod, *b_mod, *norm1_g, *norm2_g, *w_in, *w_out,
      *conv_w, *conv_b, *wa, *ba, *wx, *bx, *lam, *win_qn, *win_kn, *win_sink, *na_qn, *na_kn, *rpb,
      *wq, *k1, *k2, *pu, *pv;
  float* out;
  float *mod, *xall, *proj;
  unsigned short* projb;
  unsigned* pk;
  unsigned* bar;
  unsigned short *k1b, *k2b;
  unsigned char *ub8, *vb8;
  float *usc, *vsc;
  unsigned short *hb, *mixb, *w_in_t, *w_out_t, *wq_t, *lruw_t;
  float *lagg, *lcarry, *ropetab, *rowss, *bq, *gl, *av, *pd;
  int* el;
};

typedef unsigned short bf16_t;
typedef __attribute__((ext_vector_type(8))) short bf16x8;
typedef __attribute__((ext_vector_type(4))) float f32x4;
__device__ __forceinline__ unsigned short f2bf(float f) {
  unsigned u = __float_as_uint(f);
  u += 0x7fffu + ((u >> 16) & 1u);
  return (unsigned short)(u >> 16);
}
__device__ __forceinline__ unsigned pack2bf(float a, float b) { return (unsigned)f2bf(a) | ((unsigned)f2bf(b) << 16); }
__device__ __forceinline__ float bf2f(unsigned short h) { return __uint_as_float(((unsigned)h) << 16); }


__device__ __forceinline__ float silu_f(float x) { return x / (1.f + __expf(-x)); }
__device__ __forceinline__ float sigmoid_f(float x) { return 1.f / (1.f + __expf(-x)); }
__device__ __forceinline__ float gelu_f(float x) {
  float u = 0.7978845608028654f * (x + 0.044715f * x * x * x);
  float e = __expf(2.f * u);
  float th = 1.f - 2.f / (e + 1.f);
  return 0.5f * x * (1.f + th);
}
template <int CTRL, int RMASK>
__device__ __forceinline__ float dpp_mov(float v) {
  return __int_as_float(__builtin_amdgcn_update_dpp(0, __float_as_int(v), CTRL, RMASK, 0xf, false));
}
__device__ __forceinline__ float wave_sum(float v) {
  v += dpp_mov<0xB1, 0xf>(v);
  v += dpp_mov<0x4E, 0xf>(v);
  v += dpp_mov<0x141, 0xf>(v);
  v += dpp_mov<0x140, 0xf>(v);
  v += dpp_mov<0x142, 0xa>(v);
  v += dpp_mov<0x143, 0xc>(v);
  return __int_as_float(__builtin_amdgcn_readlane(__float_as_int(v), 63));
}

__device__ __forceinline__ int tid_opaque() { int t = threadIdx.x; asm volatile("" : "+v"(t)); return t; }
#define GTID (blockIdx.x * blockDim.x + tid_opaque())
#define GSZ (gridDim.x * blockDim.x)

__device__ __forceinline__ void ph_mod(const P& p, float* smem) {
  const int tid = tid_opaque(), cl = tid & 31, ks = tid >> 5;
  for (int it = blockIdx.x; it < 2 * 192; it += gridDim.x) {
    const int nc = it % 192, l = it / 192;
    const int n = nc * 32 + cl;
    const float* w = p.w_mod + (size_t)l * 1024 * 6144 + n;
    float a0 = 0.f, a1 = 0.f;
#pragma unroll 8
    for (int i = 0; i < 128; ++i) {
      int k = i * 8 + ks;
      float wv = w[(size_t)k * 6144];
      a0 += silu_f(p.c[k]) * wv;
      a1 += silu_f(p.c_ctx[k]) * wv;
    }
    __syncthreads();
    smem[tid] = a0; smem[256 + tid] = a1;
    __syncthreads();
    if (tid < 64) {
      const int which = tid >> 5;
      float s = p.b_mod[l * 6144 + n];
#pragma unroll
      for (int q = 0; q < 8; ++q) s += smem[which * 256 + q * 32 + cl];
      p.mod[(l * 2 + which) * 6144 + n] = s;
    }
  }
}

__device__ __forceinline__ void ph_bq(const P& p, float* smem) {
  const int tid = tid_opaque(), cl = tid & 31, ks = tid >> 5;
  for (int it = blockIdx.x; it < 2 * 64; it += gridDim.x) {
    const int nc = it % 64, l = it / 64;
    const int n = nc * 32 + cl;
    const float* w = p.wq + (size_t)l * 1024 * NPQ + n;
    const float* v0 = p.mod + (l * 2 + 0) * 6144 + 3072;
    const float* v1 = p.mod + (l * 2 + 1) * 6144 + 3072;
    float a0 = 0.f, a1 = 0.f;
#pragma unroll 8
    for (int i = 0; i < 128; ++i) {
      int k = i * 8 + ks;
      float wv = w[(size_t)k * NPQ];
      a0 += v0[k] * wv;
      a1 += v1[k] * wv;
    }
    __syncthreads();
    smem[tid] = a0; smem[256 + tid] = a1;
    __syncthreads();
    if (tid < 64) {
      const int which = tid >> 5;
      float s = 0.f;
#pragma unroll
      for (int q = 0; q < 8; ++q) s += smem[which * 256 + q * 32 + cl];
      p.bq[(l * 2 + which) * NPQ + n] = s;
    }
  }
}

__device__ __forceinline__ void ph_copy_in(const P& p) {
  const float4* xs = (const float4*)p.x;
  const float4* cs = (const float4*)p.ctx;
  float4* d = (float4*)p.xall;
  for (int i = GTID; i < TT * 256; i += GSZ) d[i] = (i < LC * 256) ? cs[i] : xs[i - LC * 256];
}

__device__ __forceinline__ void ph_copy_out(const P& p) {
  const float4* s = (const float4*)(p.xall + (size_t)LC * 1024);
  float4* d = (float4*)p.out;
  for (int i = GTID; i < SEQ * 256; i += GSZ) d[i] = s[i];
}

__device__ __forceinline__ void ph_norm_mod(const P& p, int l, int which_norm, int t0, float* smem, bool from_input = false) {
  const float* g = (which_norm ? p.norm2_g : p.norm1_g) + l * 1024;
  const int sh_off = which_norm ? 3072 : 0, sc_off = which_norm ? 4096 : 1024;
  const int tid = tid_opaque();
  for (int t = t0 + blockIdx.x; t < TT; t += gridDim.x) {
    const float* mod = p.mod + (l * 2 + (t < LC ? 1 : 0)) * 6144;
    float4 v;
    if (from_input) {
      v = t < LC ? ((const float4*)(p.ctx + (size_t)t * 1024))[tid] : ((const float4*)(p.x + (size_t)(t - LC) * 1024))[tid];
      ((float4*)(p.xall + (size_t)t * 1024))[tid] = v;
    } else v = ((const float4*)(p.xall + (size_t)t * 1024))[tid];
    float ss = wave_sum(v.x * v.x + v.y * v.y + v.z * v.z + v.w * v.w);
    __syncthreads();
    if ((tid & 63) == 0) smem[tid >> 6] = ss;
    __syncthreads();
    float tot = smem[0] + smem[1] + smem[2] + smem[3];
    float rinv = rsqrtf(tot * (1.f / 1024.f) + EPS);
    float4 gg = ((const float4*)g)[tid];
    float4 sc = ((const float4*)(mod + sc_off))[tid];
    float4 sh = ((const float4*)(mod + sh_off))[tid];
    float4 o;
    o.x = v.x * rinv * gg.x * (1.f + sc.x) + sh.x;
    o.y = v.y * rinv * gg.y * (1.f + sc.y) + sh.y;
    o.z = v.z * rinv * gg.z * (1.f + sc.z) + sh.z;
    o.w = v.w * rinv * gg.w * (1.f + sc.w) + sh.w;
    ((uint2*)(p.hb + (size_t)t * 1024))[tid] = make_uint2(pack2bf(o.x, o.y), pack2bf(o.z, o.w));
  }
}

__device__ __forceinline__ void prep_transpose(const float* W, bf16_t* Wt, int K, int N, int item0, int nitems_total, float* smem) {
  (void)nitems_total;
  float(*ts)[65] = (float(*)[65])smem;
  const int tid = tid_opaque();
  const int tn = N / 64, nt = (K / 64) * tn;
  for (int it = blockIdx.x; it < nt; it += gridDim.x) {
    int k0 = (it / tn) * 64, n0 = (it % tn) * 64;
    __syncthreads();
#pragma unroll
    for (int i = 0; i < 16; ++i) {
      int r = (tid >> 6) + i * 4, c = tid & 63;
      ts[r][c] = W[(size_t)(k0 + r) * N + n0 + c];
    }
    __syncthreads();
#pragma unroll
    for (int i = 0; i < 16; ++i) {
      int r = (tid >> 6) + i * 4, c = tid & 63;
      Wt[(size_t)(n0 + r) * K + k0 + c] = f2bf(ts[c][r]);
    }
  }
  (void)item0;
}

__device__ __forceinline__ void ph_prep(const P& p, float* smem) {
  for (int l = 0; l < 2; ++l) {
    prep_transpose(p.w_in + (size_t)l * 1024 * DIN, p.w_in_t + (size_t)l * 1024 * DIN, 1024, DIN, 0, 0, smem);
    prep_transpose(p.w_out + (size_t)l * 1024 * 1024, p.w_out_t + (size_t)l * 1024 * 1024, 1024, 1024, 0, 0, smem);
    prep_transpose(p.wq + (size_t)l * 1024 * NPQ, p.wq_t + (size_t)l * 1024 * NPQ, 1024, NPQ, 0, 0, smem);
  }
}

struct EpiStoreF32 {
  float* C; int ldc;
  __device__ __forceinline__ void operator()(const P& p, f32x4 (&acc)[4][4], int m0, int n0, int wm, int wn, int lane, char* smem) const {
    const int mw0 = m0 + wm * 64, nw0 = n0 + wn * 64;
#pragma unroll
    for (int i = 0; i < 4; ++i)
#pragma unroll
      for (int r = 0; r < 4; ++r) {
        int row = mw0 + 16 * i + (lane >> 4) * 4 + r;
#pragma unroll
        for (int j = 0; j < 4; ++j) C[(size_t)row * ldc + nw0 + 16 * j + (lane & 15)] = acc[i][j][r];
      }
  }
};
struct EpiProjSplit {
  __device__ __forceinline__ void operator()(const P& p, f32x4 (&acc)[4][4], int m0, int n0, int wm, int wn, int lane, char* smem) const {
    const int mw0 = m0 + wm * 64, nw0 = n0 + wn * 64;
#pragma unroll
    for (int i = 0; i < 4; ++i)
#pragma unroll
      for (int r = 0; r < 4; ++r) {
        int row = mw0 + 16 * i + (lane >> 4) * 4 + r;
#pragma unroll
        for (int j = 0; j < 4; ++j) {
          int col = nw0 + 16 * j + (lane & 15);
          if (n0 < 512) p.proj[(size_t)row * 512 + col] = acc[i][j][r];
          else p.projb[(size_t)row * DIN + col] = f2bf(acc[i][j][r]);
        }
      }
  }
};
__device__ __forceinline__ void ph_rope_tab(const P& p) {
  for (int idx = GTID; idx < 320 * 16; idx += GSZ) {
    int v = idx >> 4, j = idx & 15;
    float inv = __expf(-(float)j * (1.f / 16.f) * 9.210340371976184f);
    float ang = (float)(v < 256 ? v : v - 256) * inv;
    float k = rintf(ang * 0.15915494309189535f);
    float r = fmaf(-k, 6.2831854820251465f, ang);
    r = fmaf(-k, -1.7484555e-07f, r);
    ((float2*)p.ropetab)[idx] = make_float2(__cosf(r), __sinf(r));
  }
}

template <int CTRL>
__device__ __forceinline__ float dpp_row(float v) {
  return __int_as_float(__builtin_amdgcn_update_dpp(0, __float_as_int(v), CTRL, 0xf, 0xf, false));
}
struct EpiProj {
  int l;
  __device__ __forceinline__ void operator()(const P& p, f32x4 (&acc)[4][4], int m0, int n0, int wm, int wn, int lane, char* smem) const {
    const int g = lane >> 4, lr = lane & 15;
    const int mw0 = m0 + wm * 64, nw0 = n0 + wn * 64;
    if (n0 < 512) {
#pragma unroll
      for (int i = 0; i < 4; ++i)
#pragma unroll
        for (int r = 0; r < 4; ++r) {
          int row = mw0 + 16 * i + 4 * g + r;
#pragma unroll
          for (int j = 0; j < 4; ++j) p.proj[(size_t)row * 512 + nw0 + 16 * j + lr] = acc[i][j][r];
        }
      return;
    }
    const float* gain = nullptr; bool rope = false; float scale = 1.f;
    if (nw0 < 896) { gain = p.win_qn + l * 64; rope = true; scale = QSCALE; }
    else if (nw0 < 1024) { gain = p.win_kn + l * 64; rope = true; }
    else if (nw0 < 1152) { }
    else if (nw0 < 1536) { gain = p.na_qn + l * 64; scale = QSCALE; }
    else if (nw0 < 1920) { gain = p.na_kn + l * 64; }
    rope = rope && (m0 >= LC);
    float gj[4] = {1.f, 1.f, 1.f, 1.f};
    if (gain) {
#pragma unroll
      for (int j = 0; j < 4; ++j) gj[j] = gain[16 * j + lr] * scale;
    }
#pragma unroll
    for (int i = 0; i < 4; ++i)
#pragma unroll
      for (int r = 0; r < 4; ++r) {
        const int row = mw0 + 16 * i + 4 * g + r;
        float y[4] = {acc[i][0][r], acc[i][1][r], acc[i][2][r], acc[i][3][r]};
        if (gain) {
          float ss = y[0] * y[0] + y[1] * y[1] + y[2] * y[2] + y[3] * y[3];
          ss += dpp_row<0xB1>(ss);
          ss += dpp_row<0x4E>(ss);
          ss += dpp_row<0x141>(ss);
          ss += dpp_row<0x140>(ss);
          const float rinv = rsqrtf(ss * (1.f / 64.f) + EPS);
#pragma unroll
          for (int j = 0; j < 4; ++j) y[j] *= rinv * gj[j];
        }
        if (rope) {
          const int pos = row - LC;
          const float2 tr = ((const float2*)p.ropetab)[(pos >> 6) * 16 + lr];
          const float2 tc = ((const float2*)p.ropetab)[(256 + (pos & 63)) * 16 + lr];
          float a0 = y[0] * tr.x - y[1] * tr.y, a1 = y[0] * tr.y + y[1] * tr.x;
          float a2 = y[2] * tc.x - y[3] * tc.y, a3 = y[2] * tc.y + y[3] * tc.x;
          y[0] = a0; y[1] = a1; y[2] = a2; y[3] = a3;
        }
#pragma unroll
        for (int j = 0; j < 4; ++j) p.projb[(size_t)row * DIN + nw0 + 16 * j + lr] = f2bf(y[j]);
      }
  }
};
struct EpiResid {
  int l;
  __device__ __forceinline__ void operator()(const P& p, f32x4 (&acc)[4][4], int m0, int n0, int wm, int wn, int lane, char* smem) const {
    float* tile = (float*)smem;
    {
      const int g = lane >> 4, lr = lane & 15;
      float* tw = tile + (wm * 64 + 4 * g) * 132 + wn * 64 + lr;
#pragma unroll
      for (int i = 0; i < 4; ++i)
#pragma unroll
        for (int r = 0; r < 4; ++r)
#pragma unroll
          for (int j = 0; j < 4; ++j) tw[(16 * i + r) * 132 + 16 * j] = acc[i][j][r];
    }
    __syncthreads();
    const int tid = ((wm * 2 + wn) << 6) | lane, c8 = tid & 15, rsub = tid >> 4;
    const float* mod = p.mod + (l * 2 + (m0 < LC ? 1 : 0)) * 6144;
    const int col = n0 + 8 * c8;
    float g1v[8], gs[8];
    {
      const float4 a0 = *(const float4*)(mod + 2048 + col), a1 = *(const float4*)(mod + 2048 + col + 4);
      const float4 s0 = *(const float4*)(mod + 4096 + col), s1 = *(const float4*)(mod + 4096 + col + 4);
      const float4 n0v = *(const float4*)(p.norm2_g + l * 1024 + col), n1v = *(const float4*)(p.norm2_g + l * 1024 + col + 4);
      g1v[0] = a0.x; g1v[1] = a0.y; g1v[2] = a0.z; g1v[3] = a0.w; g1v[4] = a1.x; g1v[5] = a1.y; g1v[6] = a1.z; g1v[7] = a1.w;
      gs[0] = n0v.x * (1.f + s0.x); gs[1] = n0v.y * (1.f + s0.y); gs[2] = n0v.z * (1.f + s0.z); gs[3] = n0v.w * (1.f + s0.w);
      gs[4] = n1v.x * (1.f + s1.x); gs[5] = n1v.y * (1.f + s1.y); gs[6] = n1v.z * (1.f + s1.z); gs[7] = n1v.w * (1.f + s1.w);
    }
#pragma unroll
    for (int it = 0; it < 8; ++it) {
      const int rl = it * 16 + rsub, row = m0 + rl;
      float4* xp = (float4*)(p.xall + (size_t)row * 1024 + col);
      float4 x0 = xp[0], x1 = xp[1];
      const float4 t0 = *(const float4*)(tile + rl * 132 + 8 * c8), t1 = *(const float4*)(tile + rl * 132 + 8 * c8 + 4);
      x0.x += g1v[0] * t0.x; x0.y += g1v[1] * t0.y; x0.z += g1v[2] * t0.z; x0.w += g1v[3] * t0.w;
      x1.x += g1v[4] * t1.x; x1.y += g1v[5] * t1.y; x1.z += g1v[6] * t1.z; x1.w += g1v[7] * t1.w;
      xp[0] = x0; xp[1] = x1;
      float ss = x0.x * x0.x + x0.y * x0.y + x0.z * x0.z + x0.w * x0.w + x1.x * x1.x + x1.y * x1.y + x1.z * x1.z + x1.w * x1.w;
      ss += dpp_row<0xB1>(ss);
      ss += dpp_row<0x4E>(ss);
      ss += dpp_row<0x141>(ss);
      ss += dpp_row<0x140>(ss);
      *(uint4*)(p.hb + (size_t)row * 1024 + col) = make_uint4(pack2bf(x0.x * gs[0], x0.y * gs[1]), pack2bf(x0.z * gs[2], x0.w * gs[3]),
                                                            pack2bf(x1.x * gs[4], x1.y * gs[5]), pack2bf(x1.z * gs[6], x1.w * gs[7]));
      if (c8 == 0) p.rowss[(size_t)(n0 >> 7) * TT + row] = ss;
    }
  }
};

__device__ __forceinline__ int gemm_swz(int row) { return (0x78 >> (((row >> 2) & 3) * 2)) & 3; }
template <class Epi>
__device__ __forceinline__ void gemm_bf16_128(const P& p, const bf16_t* __restrict__ A, const bf16_t* __restrict__ Bt, int K, int m_begin, int m_end,
                              int N, char* smem, const Epi& epi) {
  const int tid = tid_opaque(), lane = tid & 63, wv = __builtin_amdgcn_readfirstlane(tid >> 6), wm = wv >> 1, wn = wv & 1;
  const int tiles_n = N / 128, tiles_m = (m_end - m_begin) / 128;
  const int nk = K / 32;
  const int lr = lane & 15, g = lane >> 4;
  const int a_rd = (wm * 64 + lr) * 64 + ((g ^ gemm_swz(lr)) << 4);
  const int b_rd = 8192 + (wn * 64 + lr) * 64 + ((g ^ gemm_swz(lr)) << 4);
  const int ld_row = lane >> 2, ld_c = (lane & 3) ^ gemm_swz(ld_row);
  for (int tile = blockIdx.x; tile < tiles_m * tiles_n; tile += gridDim.x) {
    const int m0 = m_begin + (tile / tiles_n) * 128, n0 = (tile % tiles_n) * 128;
    f32x4 acc[4][4];
#pragma unroll
    for (int i = 0; i < 4; ++i)
#pragma unroll
      for (int j = 0; j < 4; ++j) acc[i][j] = (f32x4){0.f, 0.f, 0.f, 0.f};
    const bf16_t* Ag = A + (size_t)(m0 + wv * 32 + ld_row) * K + ld_c * 8;
    const bf16_t* Bg = Bt + (size_t)(n0 + wv * 32 + ld_row) * K + ld_c * 8;
    auto issue = [&](int st, int kt) {
      char* base = smem + st * 16384 + wv * 2048;
#pragma unroll
      for (int i = 0; i < 2; ++i) {
        __builtin_amdgcn_global_load_lds((const unsigned*)(Ag + (size_t)i * 16 * K + kt * 32), (__attribute__((address_space(3))) unsigned*)(base + i * 1024), 16, 0, 0);
        __builtin_amdgcn_global_load_lds((const unsigned*)(Bg + (size_t)i * 16 * K + kt * 32), (__attribute__((address_space(3))) unsigned*)(base + 8192 + i * 1024), 16, 0, 0);
      }
    };
    issue(0, 0); issue(1, 1); issue(2, 2);
    for (int kt0 = 0; kt0 < nk; kt0 += 4) {
#pragma unroll
      for (int u = 0; u < 4; ++u) {
        const int kt = kt0 + u, rem = nk - kt;
        if (rem >= 3) asm volatile("s_waitcnt vmcnt(8) lgkmcnt(0)" ::: "memory");
        else if (rem == 2) asm volatile("s_waitcnt vmcnt(4) lgkmcnt(0)" ::: "memory");
        else asm volatile("s_waitcnt vmcnt(0) lgkmcnt(0)" ::: "memory");
        __builtin_amdgcn_s_barrier();
        if (kt + 3 < nk) issue((u + 3) & 3, kt + 3);
        bf16x8 af[4], bfr[4];
#pragma unroll
        for (int i = 0; i < 4; ++i) af[i] = *(const bf16x8*)(smem + u * 16384 + a_rd + i * 1024);
#pragma unroll
        for (int j = 0; j < 4; ++j) bfr[j] = *(const bf16x8*)(smem + u * 16384 + b_rd + j * 1024);
#pragma unroll
        for (int i = 0; i < 4; ++i)
#pragma unroll
          for (int j = 0; j < 4; ++j) acc[i][j] = __builtin_amdgcn_mfma_f32_16x16x32_bf16(af[i], bfr[j], acc[i][j], 0, 0, 0);
      }
    }
    __syncthreads();
    epi(p, acc, m0, n0, wm, wn, lane, smem);
    __syncthreads();
  }
}

constexpr int NCHUNK = TT / 64;
__device__ __forceinline__ int lru_pos(int dir, int c) { return dir == 0 ? c : (c < 4 ? 3 - c : 4 + (NCHUNK - 1 - c)); }

__device__ __forceinline__ void ph_lru_prepw(const P& p) {
  for (int idx = GTID; idx < 2 * 2 * 4 * 2 * 4096; idx += GSZ) {
    int d = idx & 63, e = (idx >> 6) & 63, mtx = (idx >> 12) & 1, rest = idx >> 13;
    const float* w = (mtx ? p.wx : p.wa) + (size_t)rest * 4096;
    p.lruw_t[idx] = f2bf(w[d * 64 + e]);
  }
}

template <int PASS>
__device__ __forceinline__ void lru_item(const P& p, int l, int cidx, int kb, char* smem) {
  bf16_t* u_img = (bf16_t*)smem;
  float* ab_a = (float*)(smem + 8192);
  float* ab_b = (float*)(smem + 8192 + 16384);
  float* hsum = (float*)(smem + 8192 + 32768);
  float* segagg = (float*)(smem + 8192 + 49152);
  float* ccarry = (float*)(smem + 8192 + 49152 + 2048);
  const int tid = tid_opaque(), lane = tid & 63, wv = tid >> 6, g = lane >> 4, lr = lane & 15;
  const int t0 = cidx * 64;
  const int lo = t0 < LC ? 0 : LC, hi = t0 < LC ? LC : TT;
  __syncthreads();
  {
    const int ch = tid & 63, c = kb * 64 + ch, sg = tid >> 6;
    const float cb = p.conv_b[l * 256 + c];
    float cw[4];
#pragma unroll
    for (int k = 0; k < 4; ++k) cw[k] = p.conv_w[(l * 4 + k) * 256 + c];
    float xr[19];
#pragma unroll
    for (int i = 0; i < 19; ++i) {
      int tt = t0 + sg * 16 + i - 2;
      int tc = tt < lo ? lo : (tt >= hi ? hi - 1 : tt);
      float v = p.proj[(size_t)tc * 512 + OFF_XA + c];
      xr[i] = (tt >= lo && tt < hi) ? v : 0.f;
    }
#pragma unroll
    for (int i = 0; i < 16; ++i) {
      int row = sg * 16 + i;
      float acc = cb + cw[0] * xr[i] + cw[1] * xr[i + 1] + cw[2] * xr[i + 2] + cw[3] * xr[i + 3];
      u_img[row * 64 + ((((ch >> 3) ^ (row & 7)) << 3) | (ch & 7))] = f2bf(acc);
    }
  }
  if (PASS == 2) {
    if (tid < 128) {
      const int ch = tid & 63, dir = tid >> 6;
      ccarry[dir * 64 + ch] = p.lcarry[((size_t)dir * NCHUNK + lru_pos(dir, cidx)) * 256 + kb * 64 + ch];
    }
  }
  __syncthreads();
  for (int dir = 0; dir < 2; ++dir) {
    const int pd = l * 2 + dir;
    {
      f32x4 ga[4], gx[4];
#pragma unroll
      for (int i = 0; i < 4; ++i) { ga[i] = (f32x4){0.f, 0.f, 0.f, 0.f}; gx[i] = (f32x4){0.f, 0.f, 0.f, 0.f}; }
      const bf16_t* wbase = p.lruw_t + (size_t)((pd * 4 + kb) * 2) * 4096 + (16 * wv + lr) * 64 + 8 * g;
#pragma unroll
      for (int s = 0; s < 2; ++s) {
        bf16x8 ba_ = *(const bf16x8*)(wbase + 32 * s);
        bf16x8 bx_ = *(const bf16x8*)(wbase + 4096 + 32 * s);
#pragma unroll
        for (int i = 0; i < 4; ++i) {
          int row = 16 * i + lr;
          bf16x8 af = *(const bf16x8*)((const char*)u_img + row * 128 + (((4 * s + g) ^ (row & 7)) << 4));
          ga[i] = __builtin_amdgcn_mfma_f32_16x16x32_bf16(af, ba_, ga[i], 0, 0, 0);
          gx[i] = __builtin_amdgcn_mfma_f32_16x16x32_bf16(af, bx_, gx[i], 0, 0, 0);
        }
      }
      const int ch = 16 * wv + lr, c = kb * 64 + ch;
      const float bav = p.ba[pd * 256 + c], bxv = p.bx[pd * 256 + c];
      const float sp = log1pf(expf(-p.lam[pd * 256 + c]));
#pragma unroll
      for (int i = 0; i < 4; ++i)
#pragma unroll
        for (int r = 0; r < 4; ++r) {
          int row = 16 * i + 4 * g + r;
          float rr = sigmoid_f(ga[i][r] + bav), ig = sigmoid_f(gx[i][r] + bxv);
          float log_a = -8.f * rr * sp;
          float a = __expf(log_a);
          float uu = bf2f(u_img[row * 64 + ((((ch >> 3) ^ (row & 7)) << 3) | (ch & 7))]);
          const float x2 = 2.f * log_a;
          const float ser = -x2 * (1.f + x2 * (0.5f + x2 * (0.16666667f + x2 * (0.041666668f + x2 * 0.0083333338f))));
          const float om = x2 > -0.25f ? ser : 1.f - a * a;
          float b = sqrtf(om) * ig * uu;
          ab_a[row * 64 + ch] = a;
          ab_b[row * 64 + ch] = b;
        }
    }
    __syncthreads();
    {
      const int ch = tid & 63, seg = tid >> 6;
      float Pr = 1.f, H = 0.f;
#pragma unroll
      for (int i = 0; i < 16; ++i) {
        int row = dir == 0 ? seg * 16 + i : seg * 16 + 15 - i;
        float a = ab_a[row * 64 + ch], b = ab_b[row * 64 + ch];
        H = a * H + b;
        Pr *= a;
      }
      segagg[(seg * 64 + ch) * 2] = Pr;
      segagg[(seg * 64 + ch) * 2 + 1] = H;
      __syncthreads();
      if (PASS == 1) {
        if (seg == 0) {
          float A = 1.f, B = 0.f;
#pragma unroll
          for (int s2 = 0; s2 < 4; ++s2) {
            int sg = dir == 0 ? s2 : 3 - s2;
            float pa = segagg[(sg * 64 + ch) * 2], pb = segagg[(sg * 64 + ch) * 2 + 1];
            B = pa * B + pb;
            A *= pa;
          }
          float2* ag = (float2*)p.lagg + ((size_t)dir * NCHUNK + lru_pos(dir, cidx)) * 256 + kb * 64 + ch;
          *ag = make_float2(A, B);
        }
      } else {
        float h = ccarry[dir * 64 + ch];
        float gav[16];
        if (dir == 1) {
#pragma unroll
          for (int i = 0; i < 16; ++i) gav[i] = p.proj[(size_t)(t0 + seg * 16 + 15 - i) * 512 + OFF_GA + kb * 64 + ch];
        }
#pragma unroll
        for (int s2 = 0; s2 < 3; ++s2) {
          int sg = dir == 0 ? s2 : 3 - s2;
          bool before = dir == 0 ? (sg < seg) : (sg > seg);
          if (before) h = segagg[(sg * 64 + ch) * 2] * h + segagg[(sg * 64 + ch) * 2 + 1];
        }
#pragma unroll
        for (int i = 0; i < 16; ++i) {
          int row = dir == 0 ? seg * 16 + i : seg * 16 + 15 - i;
          float a = ab_a[row * 64 + ch], b = ab_b[row * 64 + ch];
          h = a * h + b;
          if (dir == 0) hsum[row * 64 + ch] = h;
          else {
            int t = t0 + row, c = kb * 64 + ch;
            p.mixb[(size_t)t * 1024 + c] = f2bf((hsum[row * 64 + ch] + h) * gelu_f(gav[i]));
          }
        }
      }
    }
    __syncthreads();
  }
}

__device__ __forceinline__ void ph_lru_carry(const P& p, float* smem) {
  const int tid = tid_opaque(), seg = tid >> 4, c16 = tid & 15;
  for (int blk = blockIdx.x; blk < 32; blk += gridDim.x) {
    const int dc = blk * 16 + c16, dir = dc >> 8, ch = dc & 255;
    const float2* ag = (const float2*)p.lagg + (size_t)dir * NCHUNK * 256 + ch;
    float2 v[17];
#pragma unroll
    for (int i = 0; i < 17; ++i) {
      int pos = seg * 17 + i;
      v[i] = pos < NCHUNK ? ag[(size_t)pos * 256] : make_float2(1.f, 0.f);
    }
    float A = 1.f, B = 0.f;
#pragma unroll
    for (int i = 0; i < 17; ++i) { B = v[i].x * B + v[i].y; A *= v[i].x; }
    __syncthreads();
    smem[(seg * 16 + c16) * 2] = A; smem[(seg * 16 + c16) * 2 + 1] = B;
    __syncthreads();
    float h = 0.f;
    for (int s2 = 0; s2 < seg; ++s2) h = smem[(s2 * 16 + c16) * 2] * h + smem[(s2 * 16 + c16) * 2 + 1];
    float* cr = p.lcarry + (size_t)dir * NCHUNK * 256 + ch;
#pragma unroll
    for (int i = 0; i < 17; ++i) {
      int pos = seg * 17 + i;
      if (pos < NCHUNK) cr[(size_t)pos * 256] = h;
      h = v[i].x * h + v[i].y;
    }
  }
}

template <int PASS>
__device__ __forceinline__ void ph_lru(const P& p, int l, char* smem) {
  const int c_begin = (PASS == 2 && l == 1) ? 4 : 0;
  const int nitems = (NCHUNK - c_begin) * 4;
  for (int it = blockIdx.x; it < nitems; it += gridDim.x) lru_item<PASS>(p, l, c_begin + (it >> 2), it & 3, smem);
}

typedef __attribute__((ext_vector_type(4))) short s16x4;

__device__ __forceinline__ void ph_qknorm_rope2(const P& p, int l) {
  const int tid_ = tid_opaque();
  const int lane = tid_ & 63;
  const int wpb = blockDim.x >> 6;
  for (int pair = blockIdx.x * wpb + (tid_ >> 6); pair < TT * 28; pair += gridDim.x * wpb) {
    int t = pair / 28, slot = pair % 28;
    const float* g = nullptr; bool rope = false; float scale = 1.f;
    if (slot < 6) { g = p.win_qn + l * 64; rope = true; scale = QSCALE; }
    else if (slot < 8) { g = p.win_kn + l * 64; rope = true; }
    else if (slot < 10) { }
    else if (slot < 16) { g = p.na_qn + l * 64; scale = QSCALE; }
    else if (slot < 22) { g = p.na_kn + l * 64; }
    rope = rope && (t >= LC);
    const size_t idx = (size_t)t * DIN + 512 + slot * 64 + lane;
    float v = bf2f(p.projb[idx]);
    float y = v;
    if (g) {
      float ss = wave_sum(v * v);
      y = v * rsqrtf(ss * (1.f / 64.f) + EPS) * g[lane];
    }
    float partner = __shfl_xor(y, 16);
    if (rope) {
      int pos = t - LC, row = pos >> 6, col = pos & 63;
      int j = lane & 15, axis = lane >> 5;
      float inv = __expf(-(float)j * (1.f / 16.f) * 9.210340371976184f);
      float ang = (float)(axis ? col : row) * inv;
      float k = rintf(ang * 0.15915494309189535f);
      float r = fmaf(-k, 6.2831854820251465f, ang);
      r = fmaf(-k, -1.7484555e-07f, r);
      float cs = __cosf(r), sn = __sinf(r);
      bool first = ((lane >> 4) & 1) == 0;
      y = first ? (y * cs - partner * sn) : (partner * sn + y * cs);
    }
    p.projb[idx] = f2bf(y * scale);
  }
}

template <int CTRL, int RMASK>
__device__ __forceinline__ float dpp_mov_id(float v) {
  return __int_as_float(__builtin_amdgcn_update_dpp(__float_as_int(v), __float_as_int(v), CTRL, RMASK, 0xf, false));
}
__device__ __forceinline__ float wave_max(float v) {
  v = fmaxf(v, dpp_mov_id<0xB1, 0xf>(v));
  v = fmaxf(v, dpp_mov_id<0x4E, 0xf>(v));
  v = fmaxf(v, dpp_mov_id<0x141, 0xf>(v));
  v = fmaxf(v, dpp_mov_id<0x140, 0xf>(v));
  v = fmaxf(v, dpp_mov_id<0x142, 0xa>(v));
  v = fmaxf(v, dpp_mov_id<0x143, 0xc>(v));
  return __int_as_float(__builtin_amdgcn_readlane(__float_as_int(v), 63));
}

template <class TokFn>
__device__ __forceinline__ void kv_issue(const P& p, char* stage, int koff, int voff, TokFn tok, int wv, int lane) {
#pragma unroll
  for (int i = 0; i < 2; ++i) {
    const int row = 16 * wv + 8 * i + (lane >> 3);
    const bf16_t* src = p.projb + (size_t)tok(row) * DIN + (((lane & 7) ^ (row & 7)) << 3);
    char* dst = stage + (2 * wv + i) * 1024;
    __builtin_amdgcn_global_load_lds((const unsigned*)(src + koff), (__attribute__((address_space(3))) unsigned*)dst, 16, 0, 0);
    __builtin_amdgcn_global_load_lds((const unsigned*)(src + voff), (__attribute__((address_space(3))) unsigned*)(dst + 8192), 16, 0, 0);
  }
}
__device__ __forceinline__ void kv_wait(int rem) {
  if (rem >= 3) asm volatile("s_waitcnt vmcnt(8) lgkmcnt(0)" ::: "memory");
  else if (rem == 2) asm volatile("s_waitcnt vmcnt(4) lgkmcnt(0)" ::: "memory");
  else asm volatile("s_waitcnt vmcnt(0) lgkmcnt(0)" ::: "memory");
  __builtin_amdgcn_s_barrier();
}

template <class MaskFn>
__device__ __forceinline__ void attn_step2(const char* stage, int kr0, const bf16x8 (&qf)[2][2], f32x4 (&o)[2][4], float (&lsum)[2], MaskFn mb,
                                           int lane, bool act0, bool act1) {
  const int g = lane >> 4, lr = lane & 15;
  bf16x8 kf[2][2];
#pragma unroll
  for (int t2 = 0; t2 < 2; ++t2) {
    const int row = kr0 + 16 * t2 + lr;
#pragma unroll
    for (int s = 0; s < 2; ++s) kf[t2][s] = *(const bf16x8*)(stage + row * 128 + (((4 * s + g) ^ (row & 7)) << 4));
  }
  bf16x8 pb[2];
#pragma unroll
  for (int qt = 0; qt < 2; ++qt) {
    if (qt == 0 ? act0 : act1) {
      f32x4 st[2];
#pragma unroll
      for (int t2 = 0; t2 < 2; ++t2) {
        st[t2] = (f32x4){0.f, 0.f, 0.f, 0.f};
#pragma unroll
        for (int s = 0; s < 2; ++s) st[t2] = __builtin_amdgcn_mfma_f32_16x16x32_bf16(kf[t2][s], qf[qt][s], st[t2], 0, 0, 0);
      }
#pragma unroll
      for (int t2 = 0; t2 < 2; ++t2)
#pragma unroll
        for (int r = 0; r < 4; ++r) {
          float pv = exp2f(mb(qt, t2, r, st[t2][r]));
          lsum[qt] += pv;
          pb[qt][t2 * 4 + r] = (short)f2bf(pv);
        }
    }
  }
  const int q = lr >> 2, pp = lane & 3;
#pragma unroll
  for (int m = 0; m < 4; ++m) {
    bf16x8 vf;
#pragma unroll
    for (int t = 0; t < 2; ++t) {
      const int row = kr0 + 16 * t + 4 * g + q;
      const char* addr = stage + 8192 + row * 128 + (((2 * m + (pp >> 1)) ^ (row & 7)) << 4) + 8 * (pp & 1);
      s16x4 v4 = __builtin_amdgcn_ds_read_tr16_b64_v4i16((__attribute__((address_space(3))) s16x4*)addr);
      vf[4 * t + 0] = v4[0]; vf[4 * t + 1] = v4[1]; vf[4 * t + 2] = v4[2]; vf[4 * t + 3] = v4[3];
    }
    if (act0) o[0][m] = __builtin_amdgcn_mfma_f32_16x16x32_bf16(vf, pb[0], o[0][m], 0, 0, 0);
    if (act1) o[1][m] = __builtin_amdgcn_mfma_f32_16x16x32_bf16(vf, pb[1], o[1][m], 0, 0, 0);
  }
}

__device__ __forceinline__ void attn_store_out(const P& p, const f32x4 (&o)[4], float lsum, int tok, int col0, int lane) {
  const int g = lane >> 4;
  lsum += __shfl_xor(lsum, 16);
  lsum += __shfl_xor(lsum, 32);
  const float inv = 1.f / lsum;
  bf16_t* op = p.mixb + (size_t)tok * 1024 + col0 + 4 * g;
#pragma unroll
  for (int m = 0; m < 4; ++m)
    *(uint2*)(op + 16 * m) = make_uint2(pack2bf(o[m][0] * inv, o[m][1] * inv), pack2bf(o[m][2] * inv, o[m][3] * inv));
}

__device__ __forceinline__ void attn_win_item(const P& p, int l, int kind, int qb, int hs, char* smem) {
  const int tid = tid_opaque(), lane = tid & 63, wv = __builtin_amdgcn_readfirstlane(tid >> 6), g = lane >> 4, lr = lane & 15;
  int qoff, koff, voff, ooff; const float *gq, *gk; float sink2 = -1e30f; bool has_sink = false;
  if (kind == 0 || hs < 6) {
    const int h = hs, kvh = h / 3;
    qoff = OFF_QW + h * 64; koff = OFF_KW + kvh * 64; voff = OFF_VW + kvh * 64; ooff = 256 + h * 64;
    gq = p.win_qn + l * 64; gk = p.win_kn + l * 64; sink2 = p.win_sink[l * 6 + h] * LOG2E; has_sink = true;
  } else {
    const int h = hs - 6;
    qoff = OFF_QN + h * 64; koff = OFF_KN + h * 64; voff = OFF_VN + h * 64; ooff = 640 + h * 64;
    gq = p.na_qn + l * 64; gk = p.na_kn + l * 64;
  }
  float bound = 8.f * LOG2E * wave_max(fabsf(gq[lane])) * wave_max(fabsf(gk[lane])) * 1.0001f + 1e-3f;
  if (has_sink) bound = fmaxf(bound, sink2);
  const int q0 = qb * 128;
  const int qtok0 = (kind == 0 ? LC : 0) + q0 + 32 * wv;
  bf16x8 qf[2][2];
#pragma unroll
  for (int qt = 0; qt < 2; ++qt)
#pragma unroll
    for (int s = 0; s < 2; ++s) qf[qt][s] = *(const bf16x8*)(p.projb + (size_t)(qtok0 + 16 * qt + lr) * DIN + qoff + 32 * s + 8 * g);
  f32x4 o[2][4];
#pragma unroll
  for (int qt = 0; qt < 2; ++qt)
#pragma unroll
    for (int m = 0; m < 4; ++m) o[qt][m] = (f32x4){0.f, 0.f, 0.f, 0.f};
  float lsum[2] = {0.f, 0.f};
  const int nloc = (kind == 0) ? 6 : 0, nch = nloc + 4;
  auto tokfn = [&](int c) {
    return [=](int row) {
      if (c < nloc) { int pos = q0 - 128 + 64 * c + row; pos = pos < 0 ? 0 : (pos > SEQ - 1 ? SEQ - 1 : pos); return LC + pos; }
      return 64 * (c - nloc) + row;
    };
  };
  __syncthreads();
  kv_issue(p, smem, koff, voff, tokfn(0), wv, lane);
  kv_issue(p, smem + 16384, koff, voff, tokfn(1), wv, lane);
  kv_issue(p, smem + 32768, koff, voff, tokfn(2), wv, lane);
  for (int c = 0; c < nch; ++c) {
    kv_wait(nch - c);
    if (c + 3 < nch) kv_issue(p, smem + ((c + 3) & 3) * 16384, koff, voff, tokfn(c + 3), wv, lane);
    const char* stage = smem + (c & 3) * 16384;
    if (c < nloc) {
      const int qw0 = q0 + 32 * wv;
#pragma unroll
      for (int st = 0; st < 2; ++st) {
        const int kbase = q0 - 128 + 64 * c + 32 * st;
        const bool a0 = !(kbase - (qw0 + 15) > 128 || qw0 - (kbase + 31) > 128) && (kbase + 31 >= 0) && (kbase < SEQ);
        const bool a1 = !(kbase - (qw0 + 31) > 128 || (qw0 + 16) - (kbase + 31) > 128) && (kbase + 31 >= 0) && (kbase < SEQ);
        if (a0 || a1)
          attn_step2(stage, 32 * st, qf, o, lsum, [&](int qt, int t2, int r, float s) {
            int kpos = kbase + 16 * t2 + 4 * g + r;
            int dlt = kpos - (qw0 + 16 * qt + lr); dlt = dlt < 0 ? -dlt : dlt;
            bool valid = (kpos >= 0) && (kpos < SEQ) && (dlt <= 128);
            return valid ? s - bound : -1e30f;
          }, lane, a0, a1);
      }
    } else {
#pragma unroll
      for (int st = 0; st < 2; ++st)
        attn_step2(stage, 32 * st, qf, o, lsum, [&](int qt, int t2, int r, float s) { return s - bound; }, lane, true, true);
    }
  }
#pragma unroll
  for (int qt = 0; qt < 2; ++qt) {
    float ls = lsum[qt];
    if (has_sink && g == 0) ls += exp2f(sink2 - bound);
    attn_store_out(p, o[qt], ls, qtok0 + 16 * qt + lr, ooff, lane);
  }
}

__device__ __forceinline__ void attn_na_item(const P& p, int l, int rp, int h, char* smem) {
  const int tid = tid_opaque(), lane = tid & 63, wv = __builtin_amdgcn_readfirstlane(tid >> 6), g = lane >> 4, lr = lane & 15;
  const int qoff = OFF_QN + h * 64, koff = OFF_KN + h * 64, voff = OFF_VN + h * 64, ooff = 640 + h * 64;
  float* rpbl = (float*)(smem + 65536);
  const float* rpbg = p.rpb + (size_t)(l * 6 + h) * 465;
  float bmax = 0.f;
  __syncthreads();
  for (int i = tid; i < 465; i += 256) rpbl[i] = rpbg[i] * LOG2E;
  for (int i = lane; i < 465; i += 64) bmax = fmaxf(bmax, fabsf(rpbg[i]) * LOG2E);
  bmax = wave_max(bmax);
  const float bound = 8.f * LOG2E * wave_max(fabsf(p.na_qn[l * 64 + lane])) * wave_max(fabsf(p.na_kn[l * 64 + lane])) * 1.0001f + bmax + 1e-3f;
  const int r0 = 2 * rp;
  const int qcol = 16 * wv + lr;
  const int qtok0 = LC + r0 * 64 + qcol;
  const int kra = min(max(r0 - 4, 0), 248), krb = min(max(r0 + 1 - 4, 0), 248);
  const int nrow = krb + 8 - kra, nch = nrow + 4;
  const int kc0 = min(max(16 * wv - 8, 0), 32);
  const int qs = min(max(qcol - 8, 0), 48);
  bf16x8 qf[2][2];
#pragma unroll
  for (int qt = 0; qt < 2; ++qt)
#pragma unroll
    for (int s = 0; s < 2; ++s) qf[qt][s] = *(const bf16x8*)(p.projb + (size_t)(qtok0 + 64 * qt) * DIN + qoff + 32 * s + 8 * g);
  f32x4 o[2][4];
#pragma unroll
  for (int qt = 0; qt < 2; ++qt)
#pragma unroll
    for (int m = 0; m < 4; ++m) o[qt][m] = (f32x4){0.f, 0.f, 0.f, 0.f};
  float lsum[2] = {0.f, 0.f};
  auto tokfn = [&](int c) {
    return [=](int row) { return c < nrow ? LC + (kra + c) * 64 + row : 64 * (c - nrow) + row; };
  };
  kv_issue(p, smem, koff, voff, tokfn(0), wv, lane);
  kv_issue(p, smem + 16384, koff, voff, tokfn(1), wv, lane);
  kv_issue(p, smem + 32768, koff, voff, tokfn(2), wv, lane);
  for (int c = 0; c < nch; ++c) {
    kv_wait(nch - c);
    if (c + 3 < nch) kv_issue(p, smem + ((c + 3) & 3) * 16384, koff, voff, tokfn(c + 3), wv, lane);
    const char* stage = smem + (c & 3) * 16384;
    if (c < nrow) {
      const int krow = kra + c;
      const bool a0 = krow < kra + 8, a1 = krow >= krb;
      attn_step2(stage, kc0, qf, o, lsum, [&](int qt, int t2, int rr, float s) {
        int kcol = kc0 + 16 * t2 + 4 * g + rr;
        bool valid = (kcol >= qs) && (kcol < qs + 16);
        int dc = kcol - qcol + 15; dc = dc < 0 ? 0 : (dc > 30 ? 30 : dc);
        int dr = krow - (r0 + qt) + 7; dr = dr < 0 ? 0 : (dr > 14 ? 14 : dr);
        return valid ? s + rpbl[dr * 31 + dc] - bound : -1e30f;
      }, lane, a0, a1);
    } else {
#pragma unroll
      for (int st = 0; st < 2; ++st)
        attn_step2(stage, 32 * st, qf, o, lsum, [&](int qt, int t2, int rr, float s) { return s - bound; }, lane, true, true);
    }
  }
#pragma unroll
  for (int qt = 0; qt < 2; ++qt) attn_store_out(p, o[qt], lsum[qt], qtok0 + 64 * qt, ooff, lane);
}

__device__ __forceinline__ void ph_attn(const P& p, int l, char* smem) {
  const int nitems = 1536 + (l == 0 ? 24 : 0);
  for (int it = blockIdx.x; it < nitems; it += gridDim.x) {
    if (it < 768) attn_win_item(p, l, 0, it / 6, it % 6, smem);
    else if (it < 1536) { int j = it - 768; attn_na_item(p, l, j / 6, j % 6, smem); }
    else { int j = it - 1536; attn_win_item(p, l, 1, j / 12, j % 12, smem); }
  }
}

__device__ __forceinline__ unsigned ord_key(float s) {
  unsigned u = __float_as_uint(s);
  return (u & 0x80000000u) ? ~u : (u | 0x80000000u);
}
__device__ __forceinline__ float ord_val(unsigned pk) {
  unsigned u = pk & ~127u;
  unsigned b = (u & 0x80000000u) ? (u & 0x7fffffffu) : ~u;
  return __uint_as_float(b);
}
__device__ __forceinline__ void ce_desc(unsigned& a, unsigned& b) {
  unsigned mx = a > b ? a : b, mn = a > b ? b : a;
  a = mx; b = mn;
}
__device__ __forceinline__ void sort16_desc(unsigned (&v)[16]) {
#pragma unroll
  for (int k = 2; k <= 16; k <<= 1) {
#pragma unroll
    for (int j = k >> 1; j > 0; j >>= 1) {
#pragma unroll
      for (int i = 0; i < 16; ++i) {
        int m = i ^ j;
        if (m > i) {
          if ((i & k) == 0) ce_desc(v[i], v[m]); else ce_desc(v[m], v[i]);
        }
      }
    }
  }
}
__device__ __forceinline__ void merge16_desc(unsigned (&a)[16], const unsigned (&b)[16]) {
#pragma unroll
  for (int i = 0; i < 16; ++i) { unsigned o = b[15 - i]; a[i] = a[i] > o ? a[i] : o; }
#pragma unroll
  for (int j = 8; j > 0; j >>= 1) {
#pragma unroll
    for (int i = 0; i < 16; ++i) {
      int m = i ^ j;
      if (m > i) ce_desc(a[i], a[m]);
    }
  }
}

typedef __attribute__((ext_vector_type(2))) float f32x2;
__device__ __forceinline__ void ph_prep_peer(const P& p) {
  const int tid = tid_opaque(), lane = tid & 63;
  const int nw = gridDim.x * 4;
  for (int row = blockIdx.x * 4 + (tid >> 6); row < 4 * 16384; row += nw) {
    const int tbl = row >> 15, le = row & 32767;
    const float4* src = (const float4*)((tbl ? p.pv : p.pu) + (size_t)le * 1024) + lane * 4;
    float4 v[4];
    float am = 0.f;
#pragma unroll
    for (int i = 0; i < 4; ++i) {
      v[i] = src[i];
      am = fmaxf(am, fmaxf(fmaxf(fabsf(v[i].x), fabsf(v[i].y)), fmaxf(fabsf(v[i].z), fabsf(v[i].w))));
    }
    am = wave_max(am);
    const float sc = am > 0.f ? 224.f / am : 1.f;
    unsigned w[4];
#pragma unroll
    for (int i = 0; i < 4; ++i) {
      int t = __builtin_amdgcn_cvt_pk_fp8_f32(v[i].x * sc, v[i].y * sc, 0, false);
      t = __builtin_amdgcn_cvt_pk_fp8_f32(v[i].z * sc, v[i].w * sc, t, true);
      w[i] = (unsigned)t;
    }
    ((uint4*)((tbl ? p.vb8 : p.ub8) + (size_t)le * 1024))[lane] = make_uint4(w[0], w[1], w[2], w[3]);
    if (lane == 0) (tbl ? p.vsc : p.usc)[le] = am > 0.f ? am / 224.f : 1.f;
  }
  for (int i = GTID; i < 2 * 128 * 128; i += GSZ) { p.k1b[i] = f2bf(p.k1[i]); p.k2b[i] = f2bf(p.k2[i]); }
}

struct EpiPeerTopk {
  int l;
  __device__ __forceinline__ void operator()(const P& p, f32x4 (&acc)[4][4], int m0, int n0, int wm, int wn, int lane, char* smem) const {
    const int tid = ((wm * 2 + wn) << 6) | lane, g = lane >> 4, lr = lane & 15;
    const int nt = n0 >> 7, head = nt >> 1, hf = nt & 1;
    char* qimg = smem;
    char* kimg = smem + 34816;
    float* rinvl = (float*)(smem + 69632);
    if (tid < 128) {
      float s = 0.f;
#pragma unroll
      for (int q = 0; q < 8; ++q) s += p.rowss[(size_t)q * TT + m0 + tid];
      rinvl[tid] = rsqrtf(s * (1.f / 1024.f) + EPS);
    }
    __syncthreads();
    {
      const float* bq = p.bq + (l * 2 + (m0 < LC ? 1 : 0)) * NPQ + n0 + wn * 64 + lr;
      float bqv[4];
#pragma unroll
      for (int j = 0; j < 4; ++j) bqv[j] = bq[16 * j];
      char* qw = qimg + (wm * 64 + 4 * g) * 272 + (wn * 64 + lr) * 2;
#pragma unroll
      for (int i = 0; i < 4; ++i)
#pragma unroll
        for (int r = 0; r < 4; ++r) {
          const float rv = rinvl[wm * 64 + 16 * i + 4 * g + r];
#pragma unroll
          for (int j = 0; j < 4; ++j) *(bf16_t*)(qw + (16 * i + r) * 272 + 32 * j) = f2bf(acc[i][j][r] * rv + bqv[j]);
        }
      const bf16_t* kk = (hf ? p.k2b : p.k1b) + (size_t)l * 16384 + (tid >> 4) * 128 + (tid & 15) * 8;
      char* kw = kimg + (tid >> 4) * 272 + (tid & 15) * 16;
#pragma unroll
      for (int i = 0; i < 8; ++i) *(uint4*)(kw + i * 16 * 272) = *(const uint4*)(kk + i * 16 * 128);
    }
    __syncthreads();
#pragma unroll
    for (int i = 0; i < 4; ++i)
#pragma unroll
      for (int j = 0; j < 4; ++j) acc[i][j] = (f32x4){0.f, 0.f, 0.f, 0.f};
    {
      const char* qa = qimg + (wm * 64 + lr) * 272 + g * 16;
      const char* kb = kimg + (wn * 64 + lr) * 272 + g * 16;
#pragma unroll
      for (int s = 0; s < 4; ++s) {
        bf16x8 af[4], bfr[4];
#pragma unroll
        for (int i = 0; i < 4; ++i) af[i] = *(const bf16x8*)(qa + i * 16 * 272 + s * 64);
#pragma unroll
        for (int j = 0; j < 4; ++j) bfr[j] = *(const bf16x8*)(kb + j * 16 * 272 + s * 64);
#pragma unroll
        for (int i = 0; i < 4; ++i)
#pragma unroll
          for (int j = 0; j < 4; ++j) acc[i][j] = __builtin_amdgcn_mfma_f32_16x16x32_bf16(af[i], bfr[j], acc[i][j], 0, 0, 0);
      }
    }
    __syncthreads();
    unsigned* simg = (unsigned*)smem;
    {
      unsigned* sw = simg + (wm * 64 + 4 * g) * 129 + wn * 64 + lr;
#pragma unroll
      for (int i = 0; i < 4; ++i)
#pragma unroll
        for (int r = 0; r < 4; ++r)
#pragma unroll
          for (int j = 0; j < 4; ++j)
            sw[(16 * i + r) * 129 + 16 * j] = (ord_key(acc[i][j][r]) & ~127u) | (unsigned)(wn * 64 + 16 * j + lr);
    }
    __syncthreads();
    const int row = tid & 127, half = tid >> 7;
    unsigned top[16];
    {
      const unsigned* sr = simg + row * 129 + half * 64;
#pragma unroll
      for (int k = 0; k < 16; ++k) top[k] = sr[k];
      sort16_desc(top);
#pragma unroll 1
      for (int gi = 1; gi < 4; ++gi) {
        unsigned v1[16];
#pragma unroll
        for (int k = 0; k < 16; ++k) v1[k] = sr[gi * 16 + k];
        sort16_desc(v1);
        merge16_desc(top, v1);
      }
    }
    __syncthreads();
    if (half == 1) {
#pragma unroll
      for (int k = 0; k < 16; ++k) simg[k * 128 + row] = top[k];
    }
    __syncthreads();
    if (half == 0) {
      unsigned o[16];
#pragma unroll
      for (int k = 0; k < 16; ++k) o[k] = simg[k * 128 + row];
      merge16_desc(top, o);
      uint4* dst = (uint4*)(p.pk + (((size_t)(m0 + row) * 8 + head) * 2 + hf) * 16);
#pragma unroll
      for (int k = 0; k < 4; ++k) dst[k] = make_uint4(top[4 * k], top[4 * k + 1], top[4 * k + 2], top[4 * k + 3]);
    }
  }
};

__device__ const unsigned char CAND_A[64] = {0,0,0,0,0,0,0,0,0,0,0,0,0,0,0,0, 1,1,1,1,1,1,1,1, 2,2,2,2,2, 3,3,3,3, 4,4,4, 5,5, 6,6, 7,7,
                                             8,9,10,11,12,13,14,15, 0,0,0,0,0,0,0,0,0,0,0,0,0,0};
__device__ const unsigned char CAND_B[64] = {0,1,2,3,4,5,6,7,8,9,10,11,12,13,14,15, 0,1,2,3,4,5,6,7, 0,1,2,3,4, 0,1,2,3, 0,1,2, 0,1, 0,1, 0,1,
                                             0,0,0,0,0,0,0,0, 0,0,0,0,0,0,0,0,0,0,0,0,0,0};

__device__ __forceinline__ void ph_peer_apply2(const P& p, int l, int t0, char* smem) {
  const int tid = tid_opaque(), lane = tid & 63, wv = tid >> 6;
  int* lds_e = (int*)(smem + wv * 1024);
  float* lds_g = (float*)(smem + wv * 1024 + 512);
  const unsigned char* U = p.ub8 + (size_t)l * 16384 * 1024;
  const unsigned char* V = p.vb8 + (size_t)l * 16384 * 1024;
  const float* usc = p.usc + l * 16384;
  const float* vsc = p.vsc + l * 16384;
  const float* n2g = p.norm2_g + l * 1024;
  const int ca = CAND_A[lane], cb = CAND_B[lane];
  for (int tk = t0 + blockIdx.x * 4 + wv; tk < TT; tk += gridDim.x * 4) {
    const float* mod = p.mod + (l * 2 + (tk < LC ? 1 : 0)) * 6144;
    float xv[16], hv[16];
    {
      const float4* xp = (const float4*)(p.xall + (size_t)tk * 1024) + lane * 4;
      float ss = 0.f;
#pragma unroll
      for (int q = 0; q < 4; ++q) {
        float4 v = xp[q];
        xv[q * 4 + 0] = v.x; xv[q * 4 + 1] = v.y; xv[q * 4 + 2] = v.z; xv[q * 4 + 3] = v.w;
        ss += v.x * v.x + v.y * v.y + v.z * v.z + v.w * v.w;
      }
      ss = wave_sum(ss);
      float rinv = rsqrtf(ss * (1.f / 1024.f) + EPS);
#pragma unroll
      for (int q = 0; q < 4; ++q) {
        float4 gg = ((const float4*)n2g)[lane * 4 + q], sc = ((const float4*)(mod + 4096))[lane * 4 + q], sh = ((const float4*)(mod + 3072))[lane * 4 + q];
        hv[q * 4 + 0] = xv[q * 4 + 0] * rinv * gg.x * (1.f + sc.x) + sh.x;
        hv[q * 4 + 1] = xv[q * 4 + 1] * rinv * gg.y * (1.f + sc.y) + sh.y;
        hv[q * 4 + 2] = xv[q * 4 + 2] * rinv * gg.z * (1.f + sc.z) + sh.z;
        hv[q * 4 + 3] = xv[q * 4 + 3] * rinv * gg.w * (1.f + sc.w) + sh.w;
      }
    }
    for (int head = 0; head < 8; ++head) {
      const unsigned* pk = p.pk + ((size_t)tk * 8 + head) * 32;
      unsigned p1 = pk[ca], p2 = pk[16 + cb];
      float sum = lane < 50 ? ord_val(p1) + ord_val(p2) : -3.0e38f;
      int eid = (int)(p1 & 127u) * 128 + (int)(p2 & 127u);
      int rank = 0;
      for (int m = 0; m < 50; ++m) {
        float sm = __shfl(sum, m);
        rank += (sm > sum || (sm == sum && m < lane)) ? 1 : 0;
      }
      float mx = wave_max(sum);
      bool sel = (lane < 50) && (rank < 16);
      float e = sel ? __expf(sum - mx) : 0.f;
      float tot = wave_sum(e);
      if (sel) { lds_e[head * 16 + rank] = eid; lds_g[head * 16 + rank] = e / tot; }
    }
    float acc[16];
#pragma unroll
    for (int k = 0; k < 16; ++k) acc[k] = 0.f;
    for (int e0 = 0; e0 < 128; e0 += 8) {
      uint4 ur[8], vr[8];
      float gt[8], us[8], vs[8];
#pragma unroll
      for (int k = 0; k < 8; ++k) {
        int ex = __builtin_amdgcn_readfirstlane(lds_e[e0 + k]);
        gt[k] = lds_g[e0 + k];
        ur[k] = ((const uint4*)(U + (size_t)ex * 1024))[lane];
        vr[k] = ((const uint4*)(V + (size_t)ex * 1024))[lane];
        us[k] = usc[ex]; vs[k] = vsc[ex];
      }
#pragma unroll
      for (int k = 0; k < 8; ++k) {
        float dot = 0.f;
        unsigned w[4] = {ur[k].x, ur[k].y, ur[k].z, ur[k].w};
#pragma unroll
        for (int q = 0; q < 4; ++q) {
          f32x2 lo = __builtin_amdgcn_cvt_pk_f32_fp8((int)w[q], false), hi = __builtin_amdgcn_cvt_pk_f32_fp8((int)w[q], true);
          dot += lo[0] * hv[q * 4] + lo[1] * hv[q * 4 + 1] + hi[0] * hv[q * 4 + 2] + hi[1] * hv[q * 4 + 3];
        }
        dot = wave_sum(dot) * us[k];
        float a = gt[k] * gelu_f(dot) * vs[k];
        unsigned y[4] = {vr[k].x, vr[k].y, vr[k].z, vr[k].w};
#pragma unroll
        for (int q = 0; q < 4; ++q) {
          f32x2 lo = __builtin_amdgcn_cvt_pk_f32_fp8((int)y[q], false), hi = __builtin_amdgcn_cvt_pk_f32_fp8((int)y[q], true);
          acc[q * 4] += a * lo[0]; acc[q * 4 + 1] += a * lo[1]; acc[q * 4 + 2] += a * hi[0]; acc[q * 4 + 3] += a * hi[1];
        }
      }
    }
    {
      float4* xp = ((l == 1) ? (float4*)(p.out + (size_t)(tk - LC) * 1024) : (float4*)(p.xall + (size_t)tk * 1024)) + lane * 4;
      float ss2 = 0.f;
#pragma unroll
      for (int q = 0; q < 4; ++q) {
        float4 gg = ((const float4*)(mod + 5120))[lane * 4 + q];
        float4 o;
        o.x = xv[q * 4 + 0] + gg.x * acc[q * 4 + 0];
        o.y = xv[q * 4 + 1] + gg.y * acc[q * 4 + 1];
        o.z = xv[q * 4 + 2] + gg.z * acc[q * 4 + 2];
        o.w = xv[q * 4 + 3] + gg.w * acc[q * 4 + 3];
        xp[q] = o;
        xv[q * 4 + 0] = o.x; xv[q * 4 + 1] = o.y; xv[q * 4 + 2] = o.z; xv[q * 4 + 3] = o.w;
        ss2 += o.x * o.x + o.y * o.y + o.z * o.z + o.w * o.w;
      }
      if (l == 0) {
        ss2 = wave_sum(ss2);
        const float rinv2 = rsqrtf(ss2 * (1.f / 1024.f) + EPS);
        const float* mod1 = p.mod + (2 + (tk < LC ? 1 : 0)) * 6144;
        const float* n1g = p.norm1_g + 1024;
        uint2* hp = (uint2*)(p.hb + (size_t)tk * 1024) + lane * 4;
#pragma unroll
        for (int q = 0; q < 4; ++q) {
          float4 gg = ((const float4*)n1g)[lane * 4 + q], sc = ((const float4*)(mod1 + 1024))[lane * 4 + q], sh = ((const float4*)mod1)[lane * 4 + q];
          float h0 = xv[q * 4 + 0] * rinv2 * gg.x * (1.f + sc.x) + sh.x;
          float h1 = xv[q * 4 + 1] * rinv2 * gg.y * (1.f + sc.y) + sh.y;
          float h2 = xv[q * 4 + 2] * rinv2 * gg.z * (1.f + sc.z) + sh.z;
          float h3 = xv[q * 4 + 3] * rinv2 * gg.w * (1.f + sc.w) + sh.w;
          hp[q] = make_uint2(pack2bf(h0, h1), pack2bf(h2, h3));
        }
      }
    }
  }
}

__device__ __forceinline__ void ph_peer_merge(const P& p, int l, int t0) {
  const int tid = tid_opaque(), lane = tid & 63, wv = tid >> 6;
  const float* n2g = p.norm2_g + l * 1024;
  const int ca = CAND_A[lane], cb = CAND_B[lane];
  for (int tk = t0 + blockIdx.x * 4 + wv; tk < TT; tk += gridDim.x * 4) {
    const float* mod = p.mod + (l * 2 + (tk < LC ? 1 : 0)) * 6144;
    unsigned p1[8], p2[8];
    {
      const unsigned* pk = p.pk + (size_t)tk * 256;
#pragma unroll
      for (int head = 0; head < 8; ++head) { p1[head] = pk[head * 32 + ca]; p2[head] = pk[head * 32 + 16 + cb]; }
    }
    {
      const float4* xp = (const float4*)(p.xall + (size_t)tk * 1024) + lane * 4;
      float4 v[4];
      float ss = 0.f;
#pragma unroll
      for (int q = 0; q < 4; ++q) { v[q] = xp[q]; ss += v[q].x * v[q].x + v[q].y * v[q].y + v[q].z * v[q].z + v[q].w * v[q].w; }
      ss = wave_sum(ss);
      const float rinv = rsqrtf(ss * (1.f / 1024.f) + EPS);
      uint2* hp = (uint2*)(p.hb + (size_t)tk * 1024) + lane * 4;
#pragma unroll
      for (int q = 0; q < 4; ++q) {
        float4 gg = ((const float4*)n2g)[lane * 4 + q], sc = ((const float4*)(mod + 4096))[lane * 4 + q], sh = ((const float4*)(mod + 3072))[lane * 4 + q];
        float h0 = v[q].x * rinv * gg.x * (1.f + sc.x) + sh.x, h1 = v[q].y * rinv * gg.y * (1.f + sc.y) + sh.y;
        float h2 = v[q].z * rinv * gg.z * (1.f + sc.z) + sh.z, h3 = v[q].w * rinv * gg.w * (1.f + sc.w) + sh.w;
        hp[q] = make_uint2(pack2bf(h0, h1), pack2bf(h2, h3));
      }
    }
#pragma unroll
    for (int head = 0; head < 8; ++head) {
      float sum = lane < 50 ? ord_val(p1[head]) + ord_val(p2[head]) : -3.0e38f;
      int eid = (int)(p1[head] & 127u) * 128 + (int)(p2[head] & 127u);
      int rank = 0;
#pragma unroll 10
      for (int m = 0; m < 50; ++m) {
        float sm = __int_as_float(__builtin_amdgcn_readlane(__float_as_int(sum), m));
        rank += (sm > sum || (sm == sum && m < lane)) ? 1 : 0;
      }
      float mx = wave_max(sum);
      bool sel = (lane < 50) && (rank < 16);
      float e = sel ? __expf(sum - mx) : 0.f;
      float tot = wave_sum(e);
      if (sel) {
        const int n = head * 16 + rank, idx = (n & 7) * 16 + (n >> 3);
        p.el[(size_t)tk * 128 + idx] = eid;
        p.gl[(size_t)tk * 128 + idx] = e / tot;
      }
    }
  }
}

struct XcdWork { int li, np, rank, nloc; };

__device__ __forceinline__ XcdWork load_xw(const float* smem) {
  const volatile LAS unsigned* st = (const volatile LAS unsigned*)(smem + 18432);
  XcdWork xw;
  xw.nloc = __builtin_amdgcn_readfirstlane((int)st[0]); xw.np = __builtin_amdgcn_readfirstlane((int)st[1]);
  xw.rank = __builtin_amdgcn_readfirstlane((int)st[2]); xw.li = __builtin_amdgcn_readfirstlane((int)st[3]);
  return xw;
}
__device__ __forceinline__ void ph_peer_s1(const P& p, int l, int t0, const XcdWork& xw) {
  const int tid = tid_opaque(), lane = tid & 63, wv = tid >> 6, j = lane >> 3, k = lane & 7;
  const unsigned char* U = p.ub8 + (size_t)l * 16384 * 1024;
  const int step = xw.nloc * 4;
  for (int s = xw.li; s < 8; s += xw.np) {
    const unsigned roff = 128u * s + 16u * k;
    int tk = t0 + xw.rank * 4 + wv;
    int4 en[4];
    if (tk < TT) {
      const int4* ep = (const int4*)(p.el + (size_t)tk * 128 + j * 16);
#pragma unroll
      for (int q = 0; q < 4; ++q) en[q] = ep[q];
    }
    for (; tk < TT; tk += step) {
      uint4 ur[16];
#pragma unroll
      for (int q = 0; q < 4; ++q) {
        ur[4 * q + 0] = *(const uint4*)(U + ((unsigned)en[q].x * 1024u + roff));
        ur[4 * q + 1] = *(const uint4*)(U + ((unsigned)en[q].y * 1024u + roff));
        ur[4 * q + 2] = *(const uint4*)(U + ((unsigned)en[q].z * 1024u + roff));
        ur[4 * q + 3] = *(const uint4*)(U + ((unsigned)en[q].w * 1024u + roff));
      }
      const uint4* hp = (const uint4*)(p.hb + (size_t)tk * 1024 + roff);
      const uint4 h0 = hp[0], h1 = hp[1];
      if (tk + step < TT) {
        const int4* ep = (const int4*)(p.el + (size_t)(tk + step) * 128 + j * 16);
#pragma unroll
        for (int q = 0; q < 4; ++q) en[q] = ep[q];
      }
      float hv[16];
      {
        unsigned w[8] = {h0.x, h0.y, h0.z, h0.w, h1.x, h1.y, h1.z, h1.w};
#pragma unroll
        for (int q = 0; q < 8; ++q) { hv[2 * q] = __uint_as_float(w[q] << 16); hv[2 * q + 1] = __uint_as_float(w[q] & 0xffff0000u); }
      }
      float keep0 = 0.f, keep1 = 0.f;
#pragma unroll
      for (int i = 0; i < 16; ++i) {
        unsigned w[4] = {ur[i].x, ur[i].y, ur[i].z, ur[i].w};
        float dot = 0.f;
#pragma unroll
        for (int q = 0; q < 4; ++q) {
          f32x2 lo = __builtin_amdgcn_cvt_pk_f32_fp8((int)w[q], false), hi = __builtin_amdgcn_cvt_pk_f32_fp8((int)w[q], true);
          dot += lo[0] * hv[q * 4] + lo[1] * hv[q * 4 + 1] + hi[0] * hv[q * 4 + 2] + hi[1] * hv[q * 4 + 3];
        }
        dot += dpp_row<0xB1>(dot);
        dot += dpp_row<0x4E>(dot);
        dot += dpp_row<0x141>(dot);
        if (i < 8) keep0 = (k == i) ? dot : keep0; else keep1 = (k == i - 8) ? dot : keep1;
      }
      float* pd = p.pd + ((size_t)s * TT + tk) * 128;
      pd[8 * k + j] = keep0;
      pd[8 * (k + 8) + j] = keep1;
    }
  }
}

__device__ __forceinline__ void ph_peer_r(const P& p, int l, int t0) {
  const float* usc = p.usc + l * 16384;
  const float* vsc = p.vsc + l * 16384;
  for (int idx = GTID; idx < (TT - t0) * 128; idx += GSZ) {
    const int tk = t0 + (idx >> 7), n = idx & 127, li = (n & 7) * 16 + (n >> 3);
    float dot = 0.f;
#pragma unroll
    for (int s = 0; s < 8; ++s) dot += p.pd[((size_t)s * TT + tk) * 128 + n];
    const int ex = p.el[(size_t)tk * 128 + li];
    p.av[(size_t)tk * 128 + li] = p.gl[(size_t)tk * 128 + li] * gelu_f(dot * usc[ex]) * vsc[ex];
  }
}

__device__ __forceinline__ void ph_peer_s2(const P& p, int l, int t0, const XcdWork& xw, char* smem) {
  const int tid = tid_opaque(), lane = tid & 63, wv = tid >> 6, j = lane >> 3, k = lane & 7;
  const int ko = lane >> 3, jo = lane & 7;
  float* red = (float*)smem + wv * 1024;
  const unsigned char* V = p.vb8 + (size_t)l * 16384 * 1024;
  const int step = xw.nloc * 4;
  for (int s = xw.li; s < 8; s += xw.np) {
    const unsigned roff = 128u * s + 16u * k;
    const int dim = 128 * s + 16 * ko + 2 * jo;
    int tk = t0 + xw.rank * 4 + wv;
    int4 en[4];
    if (tk < TT) {
      const int4* ep = (const int4*)(p.el + (size_t)tk * 128 + j * 16);
#pragma unroll
      for (int q = 0; q < 4; ++q) en[q] = ep[q];
    }
    for (; tk < TT; tk += step) {
      uint4 vr[16];
#pragma unroll
      for (int q = 0; q < 4; ++q) {
        vr[4 * q + 0] = *(const uint4*)(V + ((unsigned)en[q].x * 1024u + roff));
        vr[4 * q + 1] = *(const uint4*)(V + ((unsigned)en[q].y * 1024u + roff));
        vr[4 * q + 2] = *(const uint4*)(V + ((unsigned)en[q].z * 1024u + roff));
        vr[4 * q + 3] = *(const uint4*)(V + ((unsigned)en[q].w * 1024u + roff));
      }
      float4 an[4];
      {
        const float4* ap = (const float4*)(p.av + (size_t)tk * 128 + j * 16);
#pragma unroll
        for (int q = 0; q < 4; ++q) an[q] = ap[q];
      }
      const float* mod = p.mod + (l * 2 + (tk < LC ? 1 : 0)) * 6144;
      const float2 g2 = *(const float2*)(mod + 5120 + dim);
      const float2 xin = *(const float2*)(p.xall + (size_t)tk * 1024 + dim);
      if (tk + step < TT) {
        const int4* ep = (const int4*)(p.el + (size_t)(tk + step) * 128 + j * 16);
#pragma unroll
        for (int q = 0; q < 4; ++q) en[q] = ep[q];
      }
      float acc[16];
#pragma unroll
      for (int d = 0; d < 16; ++d) acc[d] = 0.f;
#pragma unroll
      for (int i = 0; i < 16; ++i) {
        const float a = (i & 3) == 0 ? an[i >> 2].x : (i & 3) == 1 ? an[i >> 2].y : (i & 3) == 2 ? an[i >> 2].z : an[i >> 2].w;
        unsigned y[4] = {vr[i].x, vr[i].y, vr[i].z, vr[i].w};
#pragma unroll
        for (int q = 0; q < 4; ++q) {
          f32x2 lo = __builtin_amdgcn_cvt_pk_f32_fp8((int)y[q], false), hi = __builtin_amdgcn_cvt_pk_f32_fp8((int)y[q], true);
          acc[q * 4] += a * lo[0]; acc[q * 4 + 1] += a * lo[1]; acc[q * 4 + 2] += a * hi[0]; acc[q * 4 + 3] += a * hi[1];
        }
        if (i + 1 < 16) asm volatile("" : "+v"(acc[0]), "+v"(vr[i + 1].x), "+v"(vr[i + 1].y), "+v"(vr[i + 1].z), "+v"(vr[i + 1].w));
      }
#pragma unroll
      for (int q = 0; q < 4; ++q) *(float4*)(red + lane * 16 + 4 * q) = make_float4(acc[4 * q], acc[4 * q + 1], acc[4 * q + 2], acc[4 * q + 3]);
      float f0 = 0.f, f1 = 0.f;
#pragma unroll
      for (int jj = 0; jj < 8; ++jj) {
        const float2 t = *(const float2*)(red + (jj * 8 + ko) * 16 + 2 * jo);
        f0 += t.x; f1 += t.y;
      }
      float2 o = make_float2(xin.x + g2.x * f0, xin.y + g2.y * f1);
      if (l == 1) *(float2*)(p.out + (size_t)(tk - LC) * 1024 + dim) = o;
      else *(float2*)(p.xall + (size_t)tk * 1024 + dim) = o;
    }
  }
}

#define XB_TMO      128
#define XB_XCNT(j)  (256  + 64 * (j))
#define XB_XSUB(j)  (1280 + 64 * (j))
#define XB_XGEN(j)  (2304 + 64 * (j))
#define XB_TOP      3328
#define XB_TOPGEN   3392
#define XB_RANK(j)  (3456 + 64 * (j))
#define XCD_BAR_WORDS 4480
#define XB_SPIN_CAP (1u << 22)
__device__ __forceinline__ unsigned xb_ld(unsigned* q) { return __hip_atomic_load(q, __ATOMIC_RELAXED, __HIP_MEMORY_SCOPE_AGENT); }
__device__ __forceinline__ unsigned xb_add(unsigned* q, unsigned v) { return __hip_atomic_fetch_add(q, v, __ATOMIC_RELAXED, __HIP_MEMORY_SCOPE_AGENT); }
__device__ __forceinline__ unsigned xb_xcc_id() { return (unsigned)__builtin_amdgcn_s_getreg((3 << 11) | 20) & 0xFu; }
#define XB_SPIN(cond, bar) do { unsigned _sp = 0; while (cond) { __builtin_amdgcn_s_sleep(1); \
    if ((++_sp & 255u) == 0u) { if (xb_ld(&(bar)[XB_TMO])) break; if (_sp > XB_SPIN_CAP) { atomicAdd(&(bar)[XB_TMO], 1u); break; } } } } while (0)
struct XcdBarrier { unsigned* bar; unsigned x; volatile LAS unsigned* st; };
__device__ __forceinline__ XcdBarrier xcd_barrier_post(unsigned* bar, volatile LAS unsigned* st) {
  XcdBarrier b; b.bar = bar; b.x = xb_xcc_id(); b.st = st;
  if (threadIdx.x == 0) { (void)xb_add(&bar[XB_XCNT(b.x)], 1u); st[2] = xb_add(&bar[XB_RANK(b.x)], 1u); }
  return b;
}
__device__ __forceinline__ void xcd_barrier_complete(unsigned* bar, unsigned x, unsigned& nloc, unsigned& nx, unsigned& li) {
  const unsigned G = gridDim.x * gridDim.y * gridDim.z;
  unsigned sum, cnt, mine, below, sp = 0u;
  for (;;) {
    sum = 0u; cnt = 0u; mine = 0u; below = 0u;
#pragma unroll
    for (unsigned j = 0; j < 16; ++j) { const unsigned c = xb_ld(&bar[XB_XCNT(j)]); sum += c; cnt += (c > 0u) ? 1u : 0u; mine = (j == x) ? c : mine; below += (j < x && c > 0u) ? 1u : 0u; }
    if (sum == G) break;
    __builtin_amdgcn_s_sleep(1);
    if ((++sp & 255u) == 0u) { if (xb_ld(&bar[XB_TMO])) break; if (sp > XB_SPIN_CAP) { atomicAdd(&bar[XB_TMO], 1u); break; } }
  }
  nloc = mine > 0u ? mine : 1u; nx = cnt > 0u ? cnt : 1u; li = below;
}
__device__ __forceinline__ void xcd_barrier(const XcdBarrier& b) {
  asm volatile("s_waitcnt vmcnt(0)" ::: "memory");
  __syncthreads();
  if (threadIdx.x == 0) {
    unsigned* bar = b.bar;
    __builtin_amdgcn_s_waitcnt(0);
    unsigned nloc = b.st[0], nx = b.st[1];
    if (nloc == 0u) { unsigned li; xcd_barrier_complete(bar, b.x, nloc, nx, li); b.st[0] = nloc; b.st[1] = nx; b.st[3] = li; }
    const unsigned old = xb_add(&bar[XB_XSUB(b.x)], 1u);
    const unsigned gen = old / nloc;
    if (old + 1u == (gen + 1u) * nloc) {
      __builtin_amdgcn_fence(__ATOMIC_RELEASE, "agent");
      asm volatile("s_waitcnt vmcnt(0)" ::: "memory");
      const unsigned og = xb_add(&bar[XB_TOP], 1u);
      const unsigned tg = og / nx;
      if (og + 1u == (tg + 1u) * nx) xb_add(&bar[XB_TOPGEN], 1u);
      else XB_SPIN(xb_ld(&bar[XB_TOPGEN]) == tg, bar);
      __builtin_amdgcn_fence(__ATOMIC_ACQUIRE, "agent");
      xb_add(&bar[XB_XGEN(b.x)], 1u);
      asm volatile("s_waitcnt vmcnt(0)" ::: "memory");
    } else {
      XB_SPIN(xb_ld(&bar[XB_XGEN(b.x)]) == gen, bar);
      __builtin_amdgcn_fence(__ATOMIC_ACQUIRE, "agent");
      asm volatile("s_waitcnt vmcnt(0)" ::: "memory");
    }
  }
  __syncthreads();
}

#ifndef PROBE_IV
#define PROBE_IV -1
#endif
__device__ __forceinline__ void probe_tick(int& cnt, unsigned long long* slots) {
  if (PROBE_IV >= 0) {
    if (threadIdx.x == 0 && (cnt == PROBE_IV || cnt == PROBE_IV + 1)) slots[cnt - PROBE_IV] = __builtin_amdgcn_s_memrealtime();
    cnt = __builtin_amdgcn_readfirstlane(cnt + 1);
  }
}
#define BARRIER() do { XcdBarrier xb_; xb_.bar = PP.bar; xb_.x = xb_xcc_id(); xb_.st = (volatile LAS unsigned*)(smem + 18432); xcd_barrier(xb_); probe_tick(pcnt, probe_t); } while (0)

typedef const __attribute__((address_space(4))) P* KP;
__device__ __forceinline__ P load_params(KP kp) {
#if defined(__HIP_DEVICE_COMPILE__)
  asm volatile("" : "+s"(kp));
  return *kp;
#else
  return P{};
#endif
}
#define PP load_params(kp)
__global__ void __launch_bounds__(256, 2) k_mega(P p_unused) {
  KP kp = (KP)__builtin_amdgcn_kernarg_segment_ptr();
  __shared__ __attribute__((aligned(16))) float smem[18432 + 8];
  uint4& xb_words = *(uint4*)(smem + 18432);
  cg::grid_group grid = cg::this_grid();
  if (threadIdx.x == 0) xb_words = make_uint4(0u, 0u, 0u, 0u);
  __syncthreads();
  unsigned long long* probe_t = (unsigned long long*)(smem + 18436);
  int pcnt = 0;
  asm volatile("" : "+s"(pcnt));
  probe_tick(pcnt, probe_t);
  ph_mod(PP, smem);
  ph_prep(PP, smem);
  ph_lru_prepw(PP);
  ph_rope_tab(PP);
  ph_prep_peer(PP);
  grid.sync();
  probe_tick(pcnt, probe_t);
  (void)xcd_barrier_post(PP.bar, (volatile LAS unsigned*)&xb_words);
  ph_norm_mod(PP, 0, 0, 0, smem, true);
  ph_bq(PP, smem);
  BARRIER();
#pragma unroll 1
  for (int l = 0; l < 2; ++l) {
    const int t0 = (l == 0) ? 0 : LC;
    { const P lp = PP; gemm_bf16_128(lp, lp.hb, lp.w_in_t + (size_t)l * 1024 * DIN, 1024, 0, TT, DIN, (char*)smem, EpiProj{l}); }
    BARRIER();
    ph_lru<1>(PP, l, (char*)smem);
    ph_attn(PP, l, (char*)smem);
    BARRIER();
    ph_lru_carry(PP, smem);
    BARRIER();
    ph_lru<2>(PP, l, (char*)smem);
    BARRIER();
    { const P lp = PP; gemm_bf16_128(lp, lp.mixb, lp.w_out_t + (size_t)l * 1024 * 1024, 1024, t0, TT, 1024, (char*)smem, EpiResid{l}); }
    BARRIER();
    { const P lp = PP; gemm_bf16_128(lp, lp.hb, lp.wq_t + (size_t)l * 1024 * NPQ, 1024, t0, TT, NPQ, (char*)smem, EpiPeerTopk{l}); }
    BARRIER();
    ph_peer_merge(PP, l, t0);
    BARRIER();
    ph_peer_s1(PP, l, t0, load_xw(smem));
    BARRIER();
    ph_peer_r(PP, l, t0);
    BARRIER();
    ph_peer_s2(PP, l, t0, load_xw(smem), (char*)smem);
    if (l == 0) {
      BARRIER();
      ph_norm_mod(PP, 1, 0, 0, smem);
      BARRIER();
    }
  }
  if (PROBE_IV >= 0) {
    probe_tick(pcnt, probe_t);
    __syncthreads();
    if (blockIdx.x == 0 && threadIdx.x == 0) {
      const unsigned long long dt = (probe_t[1] - probe_t[0]) * 8ull, ts = __builtin_amdgcn_s_memrealtime();
      while (__builtin_amdgcn_s_memrealtime() - ts < dt) __builtin_amdgcn_s_sleep(8);
    }
  }
}

extern "C" void kernel_launch(void* const* d_in, const int* in_sizes, int n_in, void* d_out, int out_size, void* d_ws,
                              size_t ws_size, hipStream_t stream) {
  P p{};
  const float** fp = (const float**)&p;
  for (int i = 0; i < 28; ++i) fp[i] = (const float*)d_in[i];
  p.out = (float*)d_out;
  float* w = (float*)d_ws;
  size_t o = 0;
  auto carve = [&](size_t n) { float* r = w + o; o += (n + 63) & ~(size_t)63; return r; };
  p.bar = (unsigned*)carve(8192);
  p.mod = carve(4 * 6144);
  p.xall = carve((size_t)TT * 1024);
  p.proj = carve((size_t)TT * 512);
  p.projb = (bf16_t*)carve((size_t)TT * DIN / 2);
  p.mixb = (bf16_t*)carve((size_t)TT * 512);
  p.hb = (bf16_t*)carve((size_t)TT * 512);
  p.w_in_t = (bf16_t*)carve((size_t)1024 * DIN);
  p.w_out_t = (bf16_t*)carve((size_t)1024 * 1024);
  p.wq_t = (bf16_t*)carve((size_t)1024 * NPQ);
  p.lruw_t = (bf16_t*)carve((size_t)2 * 2 * 4 * 2 * 4096 / 2);
  p.lagg = carve((size_t)2 * NCHUNK * 256 * 2);
  p.lcarry = carve((size_t)2 * NCHUNK * 256);
  p.ropetab = carve(320 * 16 * 2);
  p.rowss = carve((size_t)8 * TT);
  p.bq = carve(4 * NPQ);
  p.el = (int*)carve((size_t)TT * 128);
  p.gl = carve((size_t)TT * 128);
  p.av = carve((size_t)TT * 128);
  p.pd = carve((size_t)8 * TT * 128);
  p.pk = (unsigned*)carve((size_t)TT * 256);
  p.ub8 = (unsigned char*)carve((size_t)2 * 16384 * 1024 / 4);
  p.vb8 = (unsigned char*)carve((size_t)2 * 16384 * 1024 / 4);
  p.usc = carve(2 * 16384);
  p.vsc = carve(2 * 16384);
  p.k1b = (bf16_t*)carve(16384);
  p.k2b = (bf16_t*)carve(16384);
  if (o * 4 > ws_size) { fprintf(stderr, "workspace too small: need %zu have %zu\n", o * 4, ws_size); return; }
  static int grid_blocks = 0;
  if (!grid_blocks) {
    int dev = 0, cus = 0, per_cu = 0;
    (void)hipGetDevice(&dev);
    (void)hipDeviceGetAttribute(&cus, hipDeviceAttributeMultiprocessorCount, dev);
    (void)hipOccupancyMaxActiveBlocksPerMultiprocessor(&per_cu, k_mega, 256, 0);
    if (per_cu > 2) per_cu = 2;
    grid_blocks = cus * per_cu;
  }
  (void)hipMemsetAsync(p.bar, 0, XCD_BAR_WORDS * 4, stream);
  void* args[] = {&p};
  hipError_t e = hipLaunchCooperativeKernel((void*)k_mega, dim3(grid_blocks), dim3(256), args, 0, stream);
  if (e != hipSuccess) fprintf(stderr, "cooperative launch failed: %s (grid %d)\n", hipGetErrorString(e), grid_blocks);
}
```

```cpp
#include <hip/hip_runtime.h>
#include <hip/hip_cooperative_groups.h>
#include <stdint.h>
#include <stdio.h>
namespace cg = cooperative_groups;

#ifndef SINGLE_LAUNCH
#define SINGLE_LAUNCH 1
#endif

constexpr int DM = 1024, SEQ = 16384, LC = 256, TT = SEQ + LC, DIN = 2304, NPQ = 2048;
constexpr int OFF_XA = 0, OFF_GA = 256, OFF_QW = 512, OFF_KW = 896, OFF_VW = 1024, OFF_QN = 1152, OFF_KN = 1536, OFF_VN = 1920;
constexpr float EPS = 1e-6f;
#define LAS __attribute__((address_space(3)))
constexpr float LOG2E = 1.4426950408889634f;
constexpr float QSCALE = 0.125f * LOG2E;

struct P {
  const float *x, *c, *ctx, *c_ctx, *w_mod, *b_mod, *norm1_g, *norm2_g, *w_in, *w_out,
      *conv_w, *conv_b, *wa, *ba, *wx, *bx, *lam, *win_qn, *win_kn, *win_sink, *na_qn, *na_kn, *rpb,
      *wq, *k1, *k2, *pu, *pv;
  float* out;
  float *mod, *xall, *proj;
  unsigned short* projb;
  unsigned* pk;
  unsigned* bar;
  unsigned short *k1b, *k2b;
  unsigned char *ub8, *vb8;
  float *usc, *vsc;
  unsigned short *hb, *mixb, *w_in_t, *w_out_t, *wq_t, *lruw_t;
  float *lagg, *lcarry, *ropetab, *rowss, *bq, *gl, *av, *pd;
  int* el;
};

typedef unsigned short bf16_t;
typedef __attribute__((ext_vector_type(8))) short bf16x8;
typedef __attribute__((ext_vector_type(4))) float f32x4;
__device__ __forceinline__ unsigned short f2bf(float f) {
  unsigned u = __float_as_uint(f);
  u += 0x7fffu + ((u >> 16) & 1u);
  return (unsigned short)(u >> 16);
}
__device__ __forceinline__ unsigned pack2bf(float a, float b) { return (unsigned)f2bf(a) | ((unsigned)f2bf(b) << 16); }
__device__ __forceinline__ float bf2f(unsigned short h) { return __uint_as_float(((unsigned)h) << 16); }


__device__ __forceinline__ float silu_f(float x) { return x / (1.f + __expf(-x)); }
__device__ __forceinline__ float sigmoid_f(float x) { return 1.f / (1.f + __expf(-x)); }
__device__ __forceinline__ float gelu_f(float x) {
  float u = 0.7978845608028654f * (x + 0.044715f * x * x * x);
  float e = __expf(2.f * u);
  float th = 1.f - 2.f / (e + 1.f);
  return 0.5f * x * (1.f + th);
}
template <int CTRL, int RMASK>
__device__ __forceinline__ float dpp_mov(float v) {
  return __int_as_float(__builtin_amdgcn_update_dpp(0, __float_as_int(v), CTRL, RMASK, 0xf, false));
}
__device__ __forceinline__ float wave_sum(float v) {
  v += dpp_mov<0xB1, 0xf>(v);
  v += dpp_mov<0x4E, 0xf>(v);
  v += dpp_mov<0x141, 0xf>(v);
  v += dpp_mov<0x140, 0xf>(v);
  v += dpp_mov<0x142, 0xa>(v);
  v += dpp_mov<0x143, 0xc>(v);
  return __int_as_float(__builtin_amdgcn_readlane(__float_as_int(v), 63));
}

__device__ __forceinline__ int tid_opaque() { int t = threadIdx.x; asm volatile("" : "+v"(t)); return t; }
#define GTID (blockIdx.x * blockDim.x + tid_opaque())
#define GSZ (gridDim.x * blockDim.x)

__device__ __forceinline__ void ph_mod(const P& p, float* smem) {
  const int tid = tid_opaque(), cl = tid & 31, ks = tid >> 5;
  for (int it = blockIdx.x; it < 2 * 192; it += gridDim.x) {
    const int nc = it % 192, l = it / 192;
    const int n = nc * 32 + cl;
    const float* w = p.w_mod + (size_t)l * 1024 * 6144 + n;
    float a0 = 0.f, a1 = 0.f;
#pragma unroll 8
    for (int i = 0; i < 128; ++i) {
      int k = i * 8 + ks;
      float wv = w[(size_t)k * 6144];
      a0 += silu_f(p.c[k]) * wv;
      a1 += silu_f(p.c_ctx[k]) * wv;
    }
    __syncthreads();
    smem[tid] = a0; smem[256 + tid] = a1;
    __syncthreads();
    if (tid < 64) {
      const int which = tid >> 5;
      float s = p.b_mod[l * 6144 + n];
#pragma unroll
      for (int q = 0; q < 8; ++q) s += smem[which * 256 + q * 32 + cl];
      p.mod[(l * 2 + which) * 6144 + n] = s;
    }
  }
}

__device__ __forceinline__ void ph_bq(const P& p, float* smem) {
  const int tid = tid_opaque(), cl = tid & 31, ks = tid >> 5;
  for (int it = blockIdx.x; it < 2 * 64; it += gridDim.x) {
    const int nc = it % 64, l = it / 64;
    const int n = nc * 32 + cl;
    const float* w = p.wq + (size_t)l * 1024 * NPQ + n;
    const float* v0 = p.mod + (l * 2 + 0) * 6144 + 3072;
    const float* v1 = p.mod + (l * 2 + 1) * 6144 + 3072;
    float a0 = 0.f, a1 = 0.f;
#pragma unroll 8
    for (int i = 0; i < 128; ++i) {
      int k = i * 8 + ks;
      float wv = w[(size_t)k * NPQ];
      a0 += v0[k] * wv;
      a1 += v1[k] * wv;
    }
    __syncthreads();
    smem[tid] = a0; smem[256 + tid] = a1;
    __syncthreads();
    if (tid < 64) {
      const int which = tid >> 5;
      float s = 0.f;
#pragma unroll
      for (int q = 0; q < 8; ++q) s += smem[which * 256 + q * 32 + cl];
      p.bq[(l * 2 + which) * NPQ + n] = s;
    }
  }
}

__device__ __forceinline__ void ph_copy_in(const P& p) {
  const float4* xs = (const float4*)p.x;
  const float4* cs = (const float4*)p.ctx;
  float4* d = (float4*)p.xall;
  for (int i = GTID; i < TT * 256; i += GSZ) d[i] = (i < LC * 256) ? cs[i] : xs[i - LC * 256];
}

__device__ __forceinline__ void ph_copy_out(const P& p) {
  const float4* s = (const float4*)(p.xall + (size_t)LC * 1024);
  float4* d = (float4*)p.out;
  for (int i = GTID; i < SEQ * 256; i += GSZ) d[i] = s[i];
}

__device__ __forceinline__ void ph_norm_mod(const P& p, int l, int which_norm, int t0, float* smem, bool from_input = false) {
  const float* g = (which_norm ? p.norm2_g : p.norm1_g) + l * 1024;
  const int sh_off = which_norm ? 3072 : 0, sc_off = which_norm ? 4096 : 1024;
  const int tid = tid_opaque();
  for (int t = t0 + blockIdx.x; t < TT; t += gridDim.x) {
    const float* mod = p.mod + (l * 2 + (t < LC ? 1 : 0)) * 6144;
    float4 v;
    if (from_input) {
      v = t < LC ? ((const float4*)(p.ctx + (size_t)t * 1024))[tid] : ((const float4*)(p.x + (size_t)(t - LC) * 1024))[tid];
      ((float4*)(p.xall + (size_t)t * 1024))[tid] = v;
    } else v = ((const float4*)(p.xall + (size_t)t * 1024))[tid];
    float ss = wave_sum(v.x * v.x + v.y * v.y + v.z * v.z + v.w * v.w);
    __syncthreads();
    if ((tid & 63) == 0) smem[tid >> 6] = ss;
    __syncthreads();
    float tot = smem[0] + smem[1] + smem[2] + smem[3];
    float rinv = rsqrtf(tot * (1.f / 1024.f) + EPS);
    float4 gg = ((const float4*)g)[tid];
    float4 sc = ((const float4*)(mod + sc_off))[tid];
    float4 sh = ((const float4*)(mod + sh_off))[tid];
    float4 o;
    o.x = v.x * rinv * gg.x * (1.f + sc.x) + sh.x;
    o.y = v.y * rinv * gg.y * (1.f + sc.y) + sh.y;
    o.z = v.z * rinv * gg.z * (1.f + sc.z) + sh.z;
    o.w = v.w * rinv * gg.w * (1.f + sc.w) + sh.w;
    ((uint2*)(p.hb + (size_t)t * 1024))[tid] = make_uint2(pack2bf(o.x, o.y), pack2bf(o.z, o.w));
  }
}

__device__ __forceinline__ void prep_transpose(const float* W, bf16_t* Wt, int K, int N, int item0, int nitems_total, float* smem) {
  (void)nitems_total;
  float(*ts)[65] = (float(*)[65])smem;
  const int tid = tid_opaque();
  const int tn = N / 64, nt = (K / 64) * tn;
  for (int it = blockIdx.x; it < nt; it += gridDim.x) {
    int k0 = (it / tn) * 64, n0 = (it % tn) * 64;
    __syncthreads();
#pragma unroll
    for (int i = 0; i < 16; ++i) {
      int r = (tid >> 6) + i * 4, c = tid & 63;
      ts[r][c] = W[(size_t)(k0 + r) * N + n0 + c];
    }
    __syncthreads();
#pragma unroll
    for (int i = 0; i < 16; ++i) {
      int r = (tid >> 6) + i * 4, c = tid & 63;
      Wt[(size_t)(n0 + r) * K + k0 + c] = f2bf(ts[c][r]);
    }
  }
  (void)item0;
}

__device__ __forceinline__ void ph_prep(const P& p, float* smem) {
  for (int l = 0; l < 2; ++l) {
    prep_transpose(p.w_in + (size_t)l * 1024 * DIN, p.w_in_t + (size_t)l * 1024 * DIN, 1024, DIN, 0, 0, smem);
    prep_transpose(p.w_out + (size_t)l * 1024 * 1024, p.w_out_t + (size_t)l * 1024 * 1024, 1024, 1024, 0, 0, smem);
    prep_transpose(p.wq + (size_t)l * 1024 * NPQ, p.wq_t + (size_t)l * 1024 * NPQ, 1024, NPQ, 0, 0, smem);
  }
}

struct EpiStoreF32 {
  float* C; int ldc;
  __device__ __forceinline__ void operator()(const P& p, f32x4 (&acc)[4][4], int m0, int n0, int wm, int wn, int lane, char* smem) const {
    const int mw0 = m0 + wm * 64, nw0 = n0 + wn * 64;
#pragma unroll
    for (int i = 0; i < 4; ++i)
#pragma unroll
      for (int r = 0; r < 4; ++r) {
        int row = mw0 + 16 * i + (lane >> 4) * 4 + r;
#pragma unroll
        for (int j = 0; j < 4; ++j) C[(size_t)row * ldc + nw0 + 16 * j + (lane & 15)] = acc[i][j][r];
      }
  }
};
struct EpiProjSplit {
  __device__ __forceinline__ void operator()(const P& p, f32x4 (&acc)[4][4], int m0, int n0, int wm, int wn, int lane, char* smem) const {
    const int mw0 = m0 + wm * 64, nw0 = n0 + wn * 64;
#pragma unroll
    for (int i = 0; i < 4; ++i)
#pragma unroll
      for (int r = 0; r < 4; ++r) {
        int row = mw0 + 16 * i + (lane >> 4) * 4 + r;
#pragma unroll
        for (int j = 0; j < 4; ++j) {
          int col = nw0 + 16 * j + (lane & 15);
          if (n0 < 512) p.proj[(size_t)row * 512 + col] = acc[i][j][r];
          else p.projb[(size_t)row * DIN + col] = f2bf(acc[i][j][r]);
        }
      }
  }
};
__device__ __forceinline__ void ph_rope_tab(const P& p) {
  for (int idx = GTID; idx < 320 * 16; idx += GSZ) {
    int v = idx >> 4, j = idx & 15;
    float inv = __expf(-(float)j * (1.f / 16.f) * 9.210340371976184f);
    float ang = (float)(v < 256 ? v : v - 256) * inv;
    float k = rintf(ang * 0.15915494309189535f);
    float r = fmaf(-k, 6.2831854820251465f, ang);
    r = fmaf(-k, -1.7484555e-07f, r);
    ((float2*)p.ropetab)[idx] = make_float2(__cosf(r), __sinf(r));
  }
}

template <int CTRL>
__device__ __forceinline__ float dpp_row(float v) {
  return __int_as_float(__builtin_amdgcn_update_dpp(0, __float_as_int(v), CTRL, 0xf, 0xf, false));
}
struct EpiProj {
  int l;
  __device__ __forceinline__ void operator()(const P& p, f32x4 (&acc)[4][4], int m0, int n0, int wm, int wn, int lane, char* smem) const {
    const int g = lane >> 4, lr = lane & 15;
    const int mw0 = m0 + wm * 64, nw0 = n0 + wn * 64;
    if (n0 < 512) {
#pragma unroll
      for (int i = 0; i < 4; ++i)
#pragma unroll
        for (int r = 0; r < 4; ++r) {
          int row = mw0 + 16 * i + 4 * g + r;
#pragma unroll
          for (int j = 0; j < 4; ++j) p.proj[(size_t)row * 512 + nw0 + 16 * j + lr] = acc[i][j][r];
        }
      return;
    }
    const float* gain = nullptr; bool rope = false; float scale = 1.f;
    if (nw0 < 896) { gain = p.win_qn + l * 64; rope = true; scale = QSCALE; }
    else if (nw0 < 1024) { gain = p.win_kn + l * 64; rope = true; }
    else if (nw0 < 1152) { }
    else if (nw0 < 1536) { gain = p.na_qn + l * 64; scale = QSCALE; }
    else if (nw0 < 1920) { gain = p.na_kn + l * 64; }
    rope = rope && (m0 >= LC);
    float gj[4] = {1.f, 1.f, 1.f, 1.f};
    if (gain) {
#pragma unroll
      for (int j = 0; j < 4; ++j) gj[j] = gain[16 * j + lr] * scale;
    }
#pragma unroll
    for (int i = 0; i < 4; ++i)
#pragma unroll
      for (int r = 0; r < 4; ++r) {
        const int row = mw0 + 16 * i + 4 * g + r;
        float y[4] = {acc[i][0][r], acc[i][1][r], acc[i][2][r], acc[i][3][r]};
        if (gain) {
          float ss = y[0] * y[0] + y[1] * y[1] + y[2] * y[2] + y[3] * y[3];
          ss += dpp_row<0xB1>(ss);
          ss += dpp_row<0x4E>(ss);
          ss += dpp_row<0x141>(ss);
          ss += dpp_row<0x140>(ss);
          const float rinv = rsqrtf(ss * (1.f / 64.f) + EPS);
#pragma unroll
          for (int j = 0; j < 4; ++j) y[j] *= rinv * gj[j];
        }
        if (rope) {
          const int pos = row - LC;
          const float2 tr = ((const float2*)p.ropetab)[(pos >> 6) * 16 + lr];
          const float2 tc = ((const float2*)p.ropetab)[(256 + (pos & 63)) * 16 + lr];
          float a0 = y[0] * tr.x - y[1] * tr.y, a1 = y[0] * tr.y + y[1] * tr.x;
          float a2 = y[2] * tc.x - y[3] * tc.y, a3 = y[2] * tc.y + y[3] * tc.x;
          y[0] = a0; y[1] = a1; y[2] = a2; y[3] = a3;
        }
#pragma unroll
        for (int j = 0; j < 4; ++j) p.projb[(size_t)row * DIN + nw0 + 16 * j + lr] = f2bf(y[j]);
      }
  }
};
struct EpiResid {
  int l;
  __device__ __forceinline__ void operator()(const P& p, f32x4 (&acc)[4][4], int m0, int n0, int wm, int wn, int lane, char* smem) const {
    float* tile = (float*)smem;
    {
      const int g = lane >> 4, lr = lane & 15;
      float* tw = tile + (wm * 64 + 4 * g) * 132 + wn * 64 + lr;
#pragma unroll
      for (int i = 0; i < 4; ++i)
#pragma unroll
        for (int r = 0; r < 4; ++r)
#pragma unroll
          for (int j = 0; j < 4; ++j) tw[(16 * i + r) * 132 + 16 * j] = acc[i][j][r];
    }
    __syncthreads();
    const int tid = ((wm * 2 + wn) << 6) | lane, c8 = tid & 15, rsub = tid >> 4;
    const float* mod = p.mod + (l * 2 + (m0 < LC ? 1 : 0)) * 6144;
    const int col = n0 + 8 * c8;
    float g1v[8], gs[8];
    {
      const float4 a0 = *(const float4*)(mod + 2048 + col), a1 = *(const float4*)(mod + 2048 + col + 4);
      const float4 s0 = *(const float4*)(mod + 4096 + col), s1 = *(const float4*)(mod + 4096 + col + 4);
      const float4 n0v = *(const float4*)(p.norm2_g + l * 1024 + col), n1v = *(const float4*)(p.norm2_g + l * 1024 + col + 4);
      g1v[0] = a0.x; g1v[1] = a0.y; g1v[2] = a0.z; g1v[3] = a0.w; g1v[4] = a1.x; g1v[5] = a1.y; g1v[6] = a1.z; g1v[7] = a1.w;
      gs[0] = n0v.x * (1.f + s0.x); gs[1] = n0v.y * (1.f + s0.y); gs[2] = n0v.z * (1.f + s0.z); gs[3] = n0v.w * (1.f + s0.w);
      gs[4] = n1v.x * (1.f + s1.x); gs[5] = n1v.y * (1.f + s1.y); gs[6] = n1v.z * (1.f + s1.z); gs[7] = n1v.w * (1.f + s1.w);
    }
#pragma unroll
    for (int it = 0; it < 8; ++it) {
      const int rl = it * 16 + rsub, row = m0 + rl;
      float4* xp = (float4*)(p.xall + (size_t)row * 1024 + col);
      float4 x0 = xp[0], x1 = xp[1];
      const float4 t0 = *(const float4*)(tile + rl * 132 + 8 * c8), t1 = *(const float4*)(tile + rl * 132 + 8 * c8 + 4);
      x0.x += g1v[0] * t0.x; x0.y += g1v[1] * t0.y; x0.z += g1v[2] * t0.z; x0.w += g1v[3] * t0.w;
      x1.x += g1v[4] * t1.x; x1.y += g1v[5] * t1.y; x1.z += g1v[6] * t1.z; x1.w += g1v[7] * t1.w;
      xp[0] = x0; xp[1] = x1;
      float ss = x0.x * x0.x + x0.y * x0.y + x0.z * x0.z + x0.w * x0.w + x1.x * x1.x + x1.y * x1.y + x1.z * x1.z + x1.w * x1.w;
      ss += dpp_row<0xB1>(ss);
      ss += dpp_row<0x4E>(ss);
      ss += dpp_row<0x141>(ss);
      ss += dpp_row<0x140>(ss);
      *(uint4*)(p.hb + (size_t)row * 1024 + col) = make_uint4(pack2bf(x0.x * gs[0], x0.y * gs[1]), pack2bf(x0.z * gs[2], x0.w * gs[3]),
                                                            pack2bf(x1.x * gs[4], x1.y * gs[5]), pack2bf(x1.z * gs[6], x1.w * gs[7]));
      if (c8 == 0) p.rowss[(size_t)(n0 >> 7) * TT + row] = ss;
    }
  }
};

__device__ __forceinline__ int gemm_swz(int row) { return (0x78 >> (((row >> 2) & 3) * 2)) & 3; }
template <class Epi>
__device__ __forceinline__ void gemm_bf16_128(const P& p, const bf16_t* __restrict__ A, const bf16_t* __restrict__ Bt, int K, int m_begin, int m_end,
                              int N, char* smem, const Epi& epi) {
  const int tid = tid_opaque(), lane = tid & 63, wv = __builtin_amdgcn_readfirstlane(tid >> 6), wm = wv >> 1, wn = wv & 1;
  const int tiles_n = N / 128, tiles_m = (m_end - m_begin) / 128;
  const int nk = K / 32;
  const int lr = lane & 15, g = lane >> 4;
  const int a_rd = (wm * 64 + lr) * 64 + ((g ^ gemm_swz(lr)) << 4);
  const int b_rd = 8192 + (wn * 64 + lr) * 64 + ((g ^ gemm_swz(lr)) << 4);
  const int ld_row = lane >> 2, ld_c = (lane & 3) ^ gemm_swz(ld_row);
  for (int tile = blockIdx.x; tile < tiles_m * tiles_n; tile += gridDim.x) {
    const int m0 = m_begin + (tile / tiles_n) * 128, n0 = (tile % tiles_n) * 128;
    f32x4 acc[4][4];
#pragma unroll
    for (int i = 0; i < 4; ++i)
#pragma unroll
      for (int j = 0; j < 4; ++j) acc[i][j] = (f32x4){0.f, 0.f, 0.f, 0.f};
    const bf16_t* Ag = A + (size_t)(m0 + wv * 32 + ld_row) * K + ld_c * 8;
    const bf16_t* Bg = Bt + (size_t)(n0 + wv * 32 + ld_row) * K + ld_c * 8;
    auto issue = [&](int st, int kt) {
      char* base = smem + st * 16384 + wv * 2048;
#pragma unroll
      for (int i = 0; i < 2; ++i) {
        __builtin_amdgcn_global_load_lds((const unsigned*)(Ag + (size_t)i * 16 * K + kt * 32), (__attribute__((address_space(3))) unsigned*)(base + i * 1024), 16, 0, 0);
        __builtin_amdgcn_global_load_lds((const unsigned*)(Bg + (size_t)i * 16 * K + kt * 32), (__attribute__((address_space(3))) unsigned*)(base + 8192 + i * 1024), 16, 0, 0);
      }
    };
    issue(0, 0); issue(1, 1); issue(2, 2);
    for (int kt0 = 0; kt0 < nk; kt0 += 4) {
#pragma unroll
      for (int u = 0; u < 4; ++u) {
        const int kt = kt0 + u, rem = nk - kt;
        if (rem >= 3) asm volatile("s_waitcnt vmcnt(8) lgkmcnt(0)" ::: "memory");
        else if (rem == 2) asm volatile("s_waitcnt vmcnt(4) lgkmcnt(0)" ::: "memory");
        else asm volatile("s_waitcnt vmcnt(0) lgkmcnt(0)" ::: "memory");
        __builtin_amdgcn_s_barrier();
        if (kt + 3 < nk) issue((u + 3) & 3, kt + 3);
        bf16x8 af[4], bfr[4];
#pragma unroll
        for (int i = 0; i < 4; ++i) af[i] = *(const bf16x8*)(smem + u * 16384 + a_rd + i * 1024);
#pragma unroll
        for (int j = 0; j < 4; ++j) bfr[j] = *(const bf16x8*)(smem + u * 16384 + b_rd + j * 1024);
#pragma unroll
        for (int i = 0; i < 4; ++i)
#pragma unroll
          for (int j = 0; j < 4; ++j) acc[i][j] = __builtin_amdgcn_mfma_f32_16x16x32_bf16(af[i], bfr[j], acc[i][j], 0, 0, 0);
      }
    }
    __syncthreads();
    epi(p, acc, m0, n0, wm, wn, lane, smem);
    __syncthreads();
  }
}

constexpr int NCHUNK = TT / 64;
__device__ __forceinline__ int lru_pos(int dir, int c) { return dir == 0 ? c : (c < 4 ? 3 - c : 4 + (NCHUNK - 1 - c)); }

__device__ __forceinline__ void ph_lru_prepw(const P& p) {
  for (int idx = GTID; idx < 2 * 2 * 4 * 2 * 4096; idx += GSZ) {
    int d = idx & 63, e = (idx >> 6) & 63, mtx = (idx >> 12) & 1, rest = idx >> 13;
    const float* w = (mtx ? p.wx : p.wa) + (size_t)rest * 4096;
    p.lruw_t[idx] = f2bf(w[d * 64 + e]);
  }
}

template <int PASS>
__device__ __forceinline__ void lru_item(const P& p, int l, int cidx, int kb, char* smem) {
  bf16_t* u_img = (bf16_t*)smem;
  float* ab_a = (float*)(smem + 8192);
  float* ab_b = (float*)(smem + 8192 + 16384);
  float* hsum = (float*)(smem + 8192 + 32768);
  float* segagg = (float*)(smem + 8192 + 49152);
  float* ccarry = (float*)(smem + 8192 + 49152 + 2048);
  const int tid = tid_opaque(), lane = tid & 63, wv = tid >> 6, g = lane >> 4, lr = lane & 15;
  const int t0 = cidx * 64;
  const int lo = t0 < LC ? 0 : LC, hi = t0 < LC ? LC : TT;
  __syncthreads();
  {
    const int ch = tid & 63, c = kb * 64 + ch, sg = tid >> 6;
    const float cb = p.conv_b[l * 256 + c];
    float cw[4];
#pragma unroll
    for (int k = 0; k < 4; ++k) cw[k] = p.conv_w[(l * 4 + k) * 256 + c];
    float xr[19];
#pragma unroll
    for (int i = 0; i < 19; ++i) {
      int tt = t0 + sg * 16 + i - 2;
      int tc = tt < lo ? lo : (tt >= hi ? hi - 1 : tt);
      float v = p.proj[(size_t)tc * 512 + OFF_XA + c];
      xr[i] = (tt >= lo && tt < hi) ? v : 0.f;
    }
#pragma unroll
    for (int i = 0; i < 16; ++i) {
      int row = sg * 16 + i;
      float acc = cb + cw[0] * xr[i] + cw[1] * xr[i + 1] + cw[2] * xr[i + 2] + cw[3] * xr[i + 3];
      u_img[row * 64 + ((((ch >> 3) ^ (row & 7)) << 3) | (ch & 7))] = f2bf(acc);
    }
  }
  if (PASS == 2) {
    if (tid < 128) {
      const int ch = tid & 63, dir = tid >> 6;
      ccarry[dir * 64 + ch] = p.lcarry[((size_t)dir * NCHUNK + lru_pos(dir, cidx)) * 256 + kb * 64 + ch];
    }
  }
  __syncthreads();
  for (int dir = 0; dir < 2; ++dir) {
    const int pd = l * 2 + dir;
    {
      f32x4 ga[4], gx[4];
#pragma unroll
      for (int i = 0; i < 4; ++i) { ga[i] = (f32x4){0.f, 0.f, 0.f, 0.f}; gx[i] = (f32x4){0.f, 0.f, 0.f, 0.f}; }
      const bf16_t* wbase = p.lruw_t + (size_t)((pd * 4 + kb) * 2) * 4096 + (16 * wv + lr) * 64 + 8 * g;
#pragma unroll
      for (int s = 0; s < 2; ++s) {
        bf16x8 ba_ = *(const bf16x8*)(wbase + 32 * s);
        bf16x8 bx_ = *(const bf16x8*)(wbase + 4096 + 32 * s);
#pragma unroll
        for (int i = 0; i < 4; ++i) {
          int row = 16 * i + lr;
          bf16x8 af = *(const bf16x8*)((const char*)u_img + row * 128 + (((4 * s + g) ^ (row & 7)) << 4));
          ga[i] = __builtin_amdgcn_mfma_f32_16x16x32_bf16(af, ba_, ga[i], 0, 0, 0);
          gx[i] = __builtin_amdgcn_mfma_f32_16x16x32_bf16(af, bx_, gx[i], 0, 0, 0);
        }
      }
      const int ch = 16 * wv + lr, c = kb * 64 + ch;
      const float bav = p.ba[pd * 256 + c], bxv = p.bx[pd * 256 + c];
      const float sp = log1pf(expf(-p.lam[pd * 256 + c]));
#pragma unroll
      for (int i = 0; i < 4; ++i)
#pragma unroll
        for (int r = 0; r < 4; ++r) {
          int row = 16 * i + 4 * g + r;
          float rr = sigmoid_f(ga[i][r] + bav), ig = sigmoid_f(gx[i][r] + bxv);
          float log_a = -8.f * rr * sp;
          float a = __expf(log_a);
          float uu = bf2f(u_img[row * 64 + ((((ch >> 3) ^ (row & 7)) << 3) | (ch & 7))]);
          const float x2 = 2.f * log_a;
          const float ser = -x2 * (1.f + x2 * (0.5f + x2 * (0.16666667f + x2 * (0.041666668f + x2 * 0.0083333338f))));
          const float om = x2 > -0.25f ? ser : 1.f - a * a;
          float b = sqrtf(om) * ig * uu;
          ab_a[row * 64 + ch] = a;
          ab_b[row * 64 + ch] = b;
        }
    }
    __syncthreads();
    {
      const int ch = tid & 63, seg = tid >> 6;
      float Pr = 1.f, H = 0.f;
#pragma unroll
      for (int i = 0; i < 16; ++i) {
        int row = dir == 0 ? seg * 16 + i : seg * 16 + 15 - i;
        float a = ab_a[row * 64 + ch], b = ab_b[row * 64 + ch];
        H = a * H + b;
        Pr *= a;
      }
      segagg[(seg * 64 + ch) * 2] = Pr;
      segagg[(seg * 64 + ch) * 2 + 1] = H;
      __syncthreads();
      if (PASS == 1) {
        if (seg == 0) {
          float A = 1.f, B = 0.f;
#pragma unroll
          for (int s2 = 0; s2 < 4; ++s2) {
            int sg = dir == 0 ? s2 : 3 - s2;
            float pa = segagg[(sg * 64 + ch) * 2], pb = segagg[(sg * 64 + ch) * 2 + 1];
            B = pa * B + pb;
            A *= pa;
          }
          float2* ag = (float2*)p.lagg + ((size_t)dir * NCHUNK + lru_pos(dir, cidx)) * 256 + kb * 64 + ch;
          *ag = make_float2(A, B);
        }
      } else {
        float h = ccarry[dir * 64 + ch];
        float gav[16];
        if (dir == 1) {
#pragma unroll
          for (int i = 0; i < 16; ++i) gav[i] = p.proj[(size_t)(t0 + seg * 16 + 15 - i) * 512 + OFF_GA + kb * 64 + ch];
        }
#pragma unroll
        for (int s2 = 0; s2 < 3; ++s2) {
          int sg = dir == 0 ? s2 : 3 - s2;
          bool before = dir == 0 ? (sg < seg) : (sg > seg);
          if (before) h = segagg[(sg * 64 + ch) * 2] * h + segagg[(sg * 64 + ch) * 2 + 1];
        }
#pragma unroll
        for (int i = 0; i < 16; ++i) {
          int row = dir == 0 ? seg * 16 + i : seg * 16 + 15 - i;
          float a = ab_a[row * 64 + ch], b = ab_b[row * 64 + ch];
          h = a * h + b;
          if (dir == 0) hsum[row * 64 + ch] = h;
          else {
            int t = t0 + row, c = kb * 64 + ch;
            p.mixb[(size_t)t * 1024 + c] = f2bf((hsum[row * 64 + ch] + h) * gelu_f(gav[i]));
          }
        }
      }
    }
    __syncthreads();
  }
}

__device__ __forceinline__ void ph_lru_carry(const P& p, float* smem) {
  const int tid = tid_opaque(), seg = tid >> 4, c16 = tid & 15;
  for (int blk = blockIdx.x; blk < 32; blk += gridDim.x) {
    const int dc = blk * 16 + c16, dir = dc >> 8, ch = dc & 255;
    const float2* ag = (const float2*)p.lagg + (size_t)dir * NCHUNK * 256 + ch;
    float2 v[17];
#pragma unroll
    for (int i = 0; i < 17; ++i) {
      int pos = seg * 17 + i;
      v[i] = pos < NCHUNK ? ag[(size_t)pos * 256] : make_float2(1.f, 0.f);
    }
    float A = 1.f, B = 0.f;
#pragma unroll
    for (int i = 0; i < 17; ++i) { B = v[i].x * B + v[i].y; A *= v[i].x; }
    __syncthreads();
    smem[(seg * 16 + c16) * 2] = A; smem[(seg * 16 + c16) * 2 + 1] = B;
    __syncthreads();
    float h = 0.f;
    for (int s2 = 0; s2 < seg; ++s2) h = smem[(s2 * 16 + c16) * 2] * h + smem[(s2 * 16 + c16) * 2 + 1];
    float* cr = p.lcarry + (size_t)dir * NCHUNK * 256 + ch;
#pragma unroll
    for (int i = 0; i < 17; ++i) {
      int pos = seg * 17 + i;
      if (pos < NCHUNK) cr[(size_t)pos * 256] = h;
      h = v[i].x * h + v[i].y;
    }
  }
}

template <int PASS>
__device__ __forceinline__ void ph_lru(const P& p, int l, char* smem) {
  const int c_begin = (PASS == 2 && l == 1) ? 4 : 0;
  const int nitems = (NCHUNK - c_begin) * 4;
  for (int it = blockIdx.x; it < nitems; it += gridDim.x) lru_item<PASS>(p, l, c_begin + (it >> 2), it & 3, smem);
}

typedef __attribute__((ext_vector_type(4))) short s16x4;

__device__ __forceinline__ void ph_qknorm_rope2(const P& p, int l) {
  const int tid_ = tid_opaque();
  const int lane = tid_ & 63;
  const int wpb = blockDim.x >> 6;
  for (int pair = blockIdx.x * wpb + (tid_ >> 6); pair < TT * 28; pair += gridDim.x * wpb) {
    int t = pair / 28, slot = pair % 28;
    const float* g = nullptr; bool rope = false; float scale = 1.f;
    if (slot < 6) { g = p.win_qn + l * 64; rope = true; scale = QSCALE; }
    else if (slot < 8) { g = p.win_kn + l * 64; rope = true; }
    else if (slot < 10) { }
    else if (slot < 16) { g = p.na_qn + l * 64; scale = QSCALE; }
    else if (slot < 22) { g = p.na_kn + l * 64; }
    rope = rope && (t >= LC);
    const size_t idx = (size_t)t * DIN + 512 + slot * 64 + lane;
    float v = bf2f(p.projb[idx]);
    float y = v;
    if (g) {
      float ss = wave_sum(v * v);
      y = v * rsqrtf(ss * (1.f / 64.f) + EPS) * g[lane];
    }
    float partner = __shfl_xor(y, 16);
    if (rope) {
      int pos = t - LC, row = pos >> 6, col = pos & 63;
      int j = lane & 15, axis = lane >> 5;
      float inv = __expf(-(float)j * (1.f / 16.f) * 9.210340371976184f);
      float ang = (float)(axis ? col : row) * inv;
      float k = rintf(ang * 0.15915494309189535f);
      float r = fmaf(-k, 6.2831854820251465f, ang);
      r = fmaf(-k, -1.7484555e-07f, r);
      float cs = __cosf(r), sn = __sinf(r);
      bool first = ((lane >> 4) & 1) == 0;
      y = first ? (y * cs - partner * sn) : (partner * sn + y * cs);
    }
    p.projb[idx] = f2bf(y * scale);
  }
}

template <int CTRL, int RMASK>
__device__ __forceinline__ float dpp_mov_id(float v) {
  return __int_as_float(__builtin_amdgcn_update_dpp(__float_as_int(v), __float_as_int(v), CTRL, RMASK, 0xf, false));
}
__device__ __forceinline__ float wave_max(float v) {
  v = fmaxf(v, dpp_mov_id<0xB1, 0xf>(v));
  v = fmaxf(v, dpp_mov_id<0x4E, 0xf>(v));
  v = fmaxf(v, dpp_mov_id<0x141, 0xf>(v));
  v = fmaxf(v, dpp_mov_id<0x140, 0xf>(v));
  v = fmaxf(v, dpp_mov_id<0x142, 0xa>(v));
  v = fmaxf(v, dpp_mov_id<0x143, 0xc>(v));
  return __int_as_float(__builtin_amdgcn_readlane(__float_as_int(v), 63));
}

template <class TokFn>
__device__ __forceinline__ void kv_issue(const P& p, char* stage, int koff, int voff, TokFn tok, int wv, int lane) {
#pragma unroll
  for (int i = 0; i < 2; ++i) {
    const int row = 16 * wv + 8 * i + (lane >> 3);
    const bf16_t* src = p.projb + (size_t)tok(row) * DIN + (((lane & 7) ^ (row & 7)) << 3);
    char* dst = stage + (2 * wv + i) * 1024;
    __builtin_amdgcn_global_load_lds((const unsigned*)(src + koff), (__attribute__((address_space(3))) unsigned*)dst, 16, 0, 0);
    __builtin_amdgcn_global_load_lds((const unsigned*)(src + voff), (__attribute__((address_space(3))) unsigned*)(dst + 8192), 16, 0, 0);
  }
}
__device__ __forceinline__ void kv_wait(int rem) {
  if (rem >= 3) asm volatile("s_waitcnt vmcnt(8) lgkmcnt(0)" ::: "memory");
  else if (rem == 2) asm volatile("s_waitcnt vmcnt(4) lgkmcnt(0)" ::: "memory");
  else asm volatile("s_waitcnt vmcnt(0) lgkmcnt(0)" ::: "memory");
  __builtin_amdgcn_s_barrier();
}

template <class MaskFn>
__device__ __forceinline__ void attn_step2(const char* stage, int kr0, const bf16x8 (&qf)[2][2], f32x4 (&o)[2][4], float (&lsum)[2], MaskFn mb,
                                           int lane, bool act0, bool act1) {
  const int g = lane >> 4, lr = lane & 15;
  bf16x8 kf[2][2];
#pragma unroll
  for (int t2 = 0; t2 < 2; ++t2) {
    const int row = kr0 + 16 * t2 + lr;
#pragma unroll
    for (int s = 0; s < 2; ++s) kf[t2][s] = *(const bf16x8*)(stage + row * 128 + (((4 * s + g) ^ (row & 7)) << 4));
  }
  bf16x8 pb[2];
#pragma unroll
  for (int qt = 0; qt < 2; ++qt) {
    if (qt == 0 ? act0 : act1) {
      f32x4 st[2];
#pragma unroll
      for (int t2 = 0; t2 < 2; ++t2) {
        st[t2] = (f32x4){0.f, 0.f, 0.f, 0.f};
#pragma unroll
        for (int s = 0; s < 2; ++s) st[t2] = __builtin_amdgcn_mfma_f32_16x16x32_bf16(kf[t2][s], qf[qt][s], st[t2], 0, 0, 0);
      }
#pragma unroll
      for (int t2 = 0; t2 < 2; ++t2)
#pragma unroll
        for (int r = 0; r < 4; ++r) {
          float pv = exp2f(mb(qt, t2, r, st[t2][r]));
          lsum[qt] += pv;
          pb[qt][t2 * 4 + r] = (short)f2bf(pv);
        }
    }
  }
  const int q = lr >> 2, pp = lane & 3;
#pragma unroll
  for (int m = 0; m < 4; ++m) {
    bf16x8 vf;
#pragma unroll
    for (int t = 0; t < 2; ++t) {
      const int row = kr0 + 16 * t + 4 * g + q;
      const char* addr = stage + 8192 + row * 128 + (((2 * m + (pp >> 1)) ^ (row & 7)) << 4) + 8 * (pp & 1);
      s16x4 v4 = __builtin_amdgcn_ds_read_tr16_b64_v4i16((__attribute__((address_space(3))) s16x4*)addr);
      vf[4 * t + 0] = v4[0]; vf[4 * t + 1] = v4[1]; vf[4 * t + 2] = v4[2]; vf[4 * t + 3] = v4[3];
    }
    if (act0) o[0][m] = __builtin_amdgcn_mfma_f32_16x16x32_bf16(vf, pb[0], o[0][m], 0, 0, 0);
    if (act1) o[1][m] = __builtin_amdgcn_mfma_f32_16x16x32_bf16(vf, pb[1], o[1][m], 0, 0, 0);
  }
}

__device__ __forceinline__ void attn_store_out(const P& p, const f32x4 (&o)[4], float lsum, int tok, int col0, int lane) {
  const int g = lane >> 4;
  lsum += __shfl_xor(lsum, 16);
  lsum += __shfl_xor(lsum, 32);
  const float inv = 1.f / lsum;
  bf16_t* op = p.mixb + (size_t)tok * 1024 + col0 + 4 * g;
#pragma unroll
  for (int m = 0; m < 4; ++m)
    *(uint2*)(op + 16 * m) = make_uint2(pack2bf(o[m][0] * inv, o[m][1] * inv), pack2bf(o[m][2] * inv, o[m][3] * inv));
}

__device__ __forceinline__ void attn_win_item(const P& p, int l, int kind, int qb, int hs, char* smem) {
  const int tid = tid_opaque(), lane = tid & 63, wv = __builtin_amdgcn_readfirstlane(tid >> 6), g = lane >> 4, lr = lane & 15;
  int qoff, koff, voff, ooff; const float *gq, *gk; float sink2 = -1e30f; bool has_sink = false;
  if (kind == 0 || hs < 6) {
    const int h = hs, kvh = h / 3;
    qoff = OFF_QW + h * 64; koff = OFF_KW + kvh * 64; voff = OFF_VW + kvh * 64; ooff = 256 + h * 64;
    gq = p.win_qn + l * 64; gk = p.win_kn + l * 64; sink2 = p.win_sink[l * 6 + h] * LOG2E; has_sink = true;
  } else {
    const int h = hs - 6;
    qoff = OFF_QN + h * 64; koff = OFF_KN + h * 64; voff = OFF_VN + h * 64; ooff = 640 + h * 64;
    gq = p.na_qn + l * 64; gk = p.na_kn + l * 64;
  }
  float bound = 8.f * LOG2E * wave_max(fabsf(gq[lane])) * wave_max(fabsf(gk[lane])) * 1.0001f + 1e-3f;
  if (has_sink) bound = fmaxf(bound, sink2);
  const int q0 = qb * 128;
  const int qtok0 = (kind == 0 ? LC : 0) + q0 + 32 * wv;
  bf16x8 qf[2][2];
#pragma unroll
  for (int qt = 0; qt < 2; ++qt)
#pragma unroll
    for (int s = 0; s < 2; ++s) qf[qt][s] = *(const bf16x8*)(p.projb + (size_t)(qtok0 + 16 * qt + lr) * DIN + qoff + 32 * s + 8 * g);
  f32x4 o[2][4];
#pragma unroll
  for (int qt = 0; qt < 2; ++qt)
#pragma unroll
    for (int m = 0; m < 4; ++m) o[qt][m] = (f32x4){0.f, 0.f, 0.f, 0.f};
  float lsum[2] = {0.f, 0.f};
  const int nloc = (kind == 0) ? 6 : 0, nch = nloc + 4;
  auto tokfn = [&](int c) {
    return [=](int row) {
      if (c < nloc) { int pos = q0 - 128 + 64 * c + row; pos = pos < 0 ? 0 : (pos > SEQ - 1 ? SEQ - 1 : pos); return LC + pos; }
      return 64 * (c - nloc) + row;
    };
  };
  __syncthreads();
  kv_issue(p, smem, koff, voff, tokfn(0), wv, lane);
  kv_issue(p, smem + 16384, koff, voff, tokfn(1), wv, lane);
  kv_issue(p, smem + 32768, koff, voff, tokfn(2), wv, lane);
  for (int c = 0; c < nch; ++c) {
    kv_wait(nch - c);
    if (c + 3 < nch) kv_issue(p, smem + ((c + 3) & 3) * 16384, koff, voff, tokfn(c + 3), wv, lane);
    const char* stage = smem + (c & 3) * 16384;
    if (c < nloc) {
      const int qw0 = q0 + 32 * wv;
#pragma unroll
      for (int st = 0; st < 2; ++st) {
        const int kbase = q0 - 128 + 64 * c + 32 * st;
        const bool a0 = !(kbase - (qw0 + 15) > 128 || qw0 - (kbase + 31) > 128) && (kbase + 31 >= 0) && (kbase < SEQ);
        const bool a1 = !(kbase - (qw0 + 31) > 128 || (qw0 + 16) - (kbase + 31) > 128) && (kbase + 31 >= 0) && (kbase < SEQ);
        if (a0 || a1)
          attn_step2(stage, 32 * st, qf, o, lsum, [&](int qt, int t2, int r, float s) {
            int kpos = kbase + 16 * t2 + 4 * g + r;
            int dlt = kpos - (qw0 + 16 * qt + lr); dlt = dlt < 0 ? -dlt : dlt;
            bool valid = (kpos >= 0) && (kpos < SEQ) && (dlt <= 128);
            return valid ? s - bound : -1e30f;
          }, lane, a0, a1);
      }
    } else {
#pragma unroll
      for (int st = 0; st < 2; ++st)
        attn_step2(stage, 32 * st, qf, o, lsum, [&](int qt, int t2, int r, float s) { return s - bound; }, lane, true, true);
    }
  }
#pragma unroll
  for (int qt = 0; qt < 2; ++qt) {
    float ls = lsum[qt];
    if (has_sink && g == 0) ls += exp2f(sink2 - bound);
    attn_store_out(p, o[qt], ls, qtok0 + 16 * qt + lr, ooff, lane);
  }
}

__device__ __forceinline__ void attn_na_item(const P& p, int l, int rp, int h, char* smem) {
  const int tid = tid_opaque(), lane = tid & 63, wv = __builtin_amdgcn_readfirstlane(tid >> 6), g = lane >> 4, lr = lane & 15;
  const int qoff = OFF_QN + h * 64, koff = OFF_KN + h * 64, voff = OFF_VN + h * 64, ooff = 640 + h * 64;
  float* rpbl = (float*)(smem + 65536);
  const float* rpbg = p.rpb + (size_t)(l * 6 + h) * 465;
  float bmax = 0.f;
  __syncthreads();
  for (int i = tid; i < 465; i += 256) rpbl[i] = rpbg[i] * LOG2E;
  for (int i = lane; i < 465; i += 64) bmax = fmaxf(bmax, fabsf(rpbg[i]) * LOG2E);
  bmax = wave_max(bmax);
  const float bound = 8.f * LOG2E * wave_max(fabsf(p.na_qn[l * 64 + lane])) * wave_max(fabsf(p.na_kn[l * 64 + lane])) * 1.0001f + bmax + 1e-3f;
  const int r0 = 2 * rp;
  const int qcol = 16 * wv + lr;
  const int qtok0 = LC + r0 * 64 + qcol;
  const int kra = min(max(r0 - 4, 0), 248), krb = min(max(r0 + 1 - 4, 0), 248);
  const int nrow = krb + 8 - kra, nch = nrow + 4;
  const int kc0 = min(max(16 * wv - 8, 0), 32);
  const int qs = min(max(qcol - 8, 0), 48);
  bf16x8 qf[2][2];
#pragma unroll
  for (int qt = 0; qt < 2; ++qt)
#pragma unroll
    for (int s = 0; s < 2; ++s) qf[qt][s] = *(const bf16x8*)(p.projb + (size_t)(qtok0 + 64 * qt) * DIN + qoff + 32 * s + 8 * g);
  f32x4 o[2][4];
#pragma unroll
  for (int qt = 0; qt < 2; ++qt)
#pragma unroll
    for (int m = 0; m < 4; ++m) o[qt][m] = (f32x4){0.f, 0.f, 0.f, 0.f};
  float lsum[2] = {0.f, 0.f};
  auto tokfn = [&](int c) {
    return [=](int row) { return c < nrow ? LC + (kra + c) * 64 + row : 64 * (c - nrow) + row; };
  };
  kv_issue(p, smem, koff, voff, tokfn(0), wv, lane);
  kv_issue(p, smem + 16384, koff, voff, tokfn(1), wv, lane);
  kv_issue(p, smem + 32768, koff, voff, tokfn(2), wv, lane);
  for (int c = 0; c < nch; ++c) {
    kv_wait(nch - c);
    if (c + 3 < nch) kv_issue(p, smem + ((c + 3) & 3) * 16384, koff, voff, tokfn(c + 3), wv, lane);
    const char* stage = smem + (c & 3) * 16384;
    if (c < nrow) {
      const int krow = kra + c;
      const bool a0 = krow < kra + 8, a1 = krow >= krb;
      attn_step2(stage, kc0, qf, o, lsum, [&](int qt, int t2, int rr, float s) {
        int kcol = kc0 + 16 * t2 + 4 * g + rr;
        bool valid = (kcol >= qs) && (kcol < qs + 16);
        int dc = kcol - qcol + 15; dc = dc < 0 ? 0 : (dc > 30 ? 30 : dc);
        int dr = krow - (r0 + qt) + 7; dr = dr < 0 ? 0 : (dr > 14 ? 14 : dr);
        return valid ? s + rpbl[dr * 31 + dc] - bound : -1e30f;
      }, lane, a0, a1);
    } else {
#pragma unroll
      for (int st = 0; st < 2; ++st)
        attn_step2(stage, 32 * st, qf, o, lsum, [&](int qt, int t2, int rr, float s) { return s - bound; }, lane, true, true);
    }
  }
#pragma unroll
  for (int qt = 0; qt < 2; ++qt) attn_store_out(p, o[qt], lsum[qt], qtok0 + 64 * qt, ooff, lane);
}

__device__ __forceinline__ void ph_attn(const P& p, int l, char* smem) {
  const int nitems = 1536 + (l == 0 ? 24 : 0);
  for (int it = blockIdx.x; it < nitems; it += gridDim.x) {
    if (it < 768) attn_win_item(p, l, 0, it / 6, it % 6, smem);
    else if (it < 1536) { int j = it - 768; attn_na_item(p, l, j / 6, j % 6, smem); }
    else { int j = it - 1536; attn_win_item(p, l, 1, j / 12, j % 12, smem); }
  }
}

__device__ __forceinline__ unsigned ord_key(float s) {
  unsigned u = __float_as_uint(s);
  return (u & 0x80000000u) ? ~u : (u | 0x80000000u);
}
__device__ __forceinline__ float ord_val(unsigned pk) {
  unsigned u = pk & ~127u;
  unsigned b = (u & 0x80000000u) ? (u & 0x7fffffffu) : ~u;
  return __uint_as_float(b);
}
__device__ __forceinline__ void ce_desc(unsigned& a, unsigned& b) {
  unsigned mx = a > b ? a : b, mn = a > b ? b : a;
  a = mx; b = mn;
}
__device__ __forceinline__ void sort16_desc(unsigned (&v)[16]) {
#pragma unroll
  for (int k = 2; k <= 16; k <<= 1) {
#pragma unroll
    for (int j = k >> 1; j > 0; j >>= 1) {
#pragma unroll
      for (int i = 0; i < 16; ++i) {
        int m = i ^ j;
        if (m > i) {
          if ((i & k) == 0) ce_desc(v[i], v[m]); else ce_desc(v[m], v[i]);
        }
      }
    }
  }
}
__device__ __forceinline__ void merge16_desc(unsigned (&a)[16], const unsigned (&b)[16]) {
#pragma unroll
  for (int i = 0; i < 16; ++i) { unsigned o = b[15 - i]; a[i] = a[i] > o ? a[i] : o; }
#pragma unroll
  for (int j = 8; j > 0; j >>= 1) {
#pragma unroll
    for (int i = 0; i < 16; ++i) {
      int m = i ^ j;
      if (m > i) ce_desc(a[i], a[m]);
    }
  }
}

typedef __attribute__((ext_vector_type(2))) float f32x2;
__device__ __forceinline__ void ph_prep_peer(const P& p) {
  const int tid = tid_opaque(), lane = tid & 63;
  const int nw = gridDim.x * 4;
  for (int row = blockIdx.x * 4 + (tid >> 6); row < 4 * 16384; row += nw) {
    const int tbl = row >> 15, le = row & 32767;
    const float4* src = (const float4*)((tbl ? p.pv : p.pu) + (size_t)le * 1024) + lane * 4;
    float4 v[4];
    float am = 0.f;
#pragma unroll
    for (int i = 0; i < 4; ++i) {
      v[i] = src[i];
      am = fmaxf(am, fmaxf(fmaxf(fabsf(v[i].x), fabsf(v[i].y)), fmaxf(fabsf(v[i].z), fabsf(v[i].w))));
    }
    am = wave_max(am);
    const float sc = am > 0.f ? 224.f / am : 1.f;
    unsigned w[4];
#pragma unroll
    for (int i = 0; i < 4; ++i) {
      int t = __builtin_amdgcn_cvt_pk_fp8_f32(v[i].x * sc, v[i].y * sc, 0, false);
      t = __builtin_amdgcn_cvt_pk_fp8_f32(v[i].z * sc, v[i].w * sc, t, true);
      w[i] = (unsigned)t;
    }
    ((uint4*)((tbl ? p.vb8 : p.ub8) + (size_t)le * 1024))[lane] = make_uint4(w[0], w[1], w[2], w[3]);
    if (lane == 0) (tbl ? p.vsc : p.usc)[le] = am > 0.f ? am / 224.f : 1.f;
  }
  for (int i = GTID; i < 2 * 128 * 128; i += GSZ) { p.k1b[i] = f2bf(p.k1[i]); p.k2b[i] = f2bf(p.k2[i]); }
}

struct EpiPeerTopk {
  int l;
  __device__ __forceinline__ void operator()(const P& p, f32x4 (&acc)[4][4], int m0, int n0, int wm, int wn, int lane, char* smem) const {
    const int tid = ((wm * 2 + wn) << 6) | lane, g = lane >> 4, lr = lane & 15;
    const int nt = n0 >> 7, head = nt >> 1, hf = nt & 1;
    char* qimg = smem;
    char* kimg = smem + 34816;
    float* rinvl = (float*)(smem + 69632);
    if (tid < 128) {
      float s = 0.f;
#pragma unroll
      for (int q = 0; q < 8; ++q) s += p.rowss[(size_t)q * TT + m0 + tid];
      rinvl[tid] = rsqrtf(s * (1.f / 1024.f) + EPS);
    }
    __syncthreads();
    {
      const float* bq = p.bq + (l * 2 + (m0 < LC ? 1 : 0)) * NPQ + n0 + wn * 64 + lr;
      float bqv[4];
#pragma unroll
      for (int j = 0; j < 4; ++j) bqv[j] = bq[16 * j];
      char* qw = qimg + (wm * 64 + 4 * g) * 272 + (wn * 64 + lr) * 2;
#pragma unroll
      for (int i = 0; i < 4; ++i)
#pragma unroll
        for (int r = 0; r < 4; ++r) {
          const float rv = rinvl[wm * 64 + 16 * i + 4 * g + r];
#pragma unroll
          for (int j = 0; j < 4; ++j) *(bf16_t*)(qw + (16 * i + r) * 272 + 32 * j) = f2bf(acc[i][j][r] * rv + bqv[j]);
        }
      const bf16_t* kk = (hf ? p.k2b : p.k1b) + (size_t)l * 16384 + (tid >> 4) * 128 + (tid & 15) * 8;
      char* kw = kimg + (tid >> 4) * 272 + (tid & 15) * 16;
#pragma unroll
      for (int i = 0; i < 8; ++i) *(uint4*)(kw + i * 16 * 272) = *(const uint4*)(kk + i * 16 * 128);
    }
    __syncthreads();
#pragma unroll
    for (int i = 0; i < 4; ++i)
#pragma unroll
      for (int j = 0; j < 4; ++j) acc[i][j] = (f32x4){0.f, 0.f, 0.f, 0.f};
    {
      const char* qa = qimg + (wm * 64 + lr) * 272 + g * 16;
      const char* kb = kimg + (wn * 64 + lr) * 272 + g * 16;
#pragma unroll
      for (int s = 0; s < 4; ++s) {
        bf16x8 af[4], bfr[4];
#pragma unroll
        for (int i = 0; i < 4; ++i) af[i] = *(const bf16x8*)(qa + i * 16 * 272 + s * 64);
#pragma unroll
        for (int j = 0; j < 4; ++j) bfr[j] = *(const bf16x8*)(kb + j * 16 * 272 + s * 64);
#pragma unroll
        for (int i = 0; i < 4; ++i)
#pragma unroll
          for (int j = 0; j < 4; ++j) acc[i][j] = __builtin_amdgcn_mfma_f32_16x16x32_bf16(af[i], bfr[j], acc[i][j], 0, 0, 0);
      }
    }
    __syncthreads();
    unsigned* simg = (unsigned*)smem;
    {
      unsigned* sw = simg + (wm * 64 + 4 * g) * 129 + wn * 64 + lr;
#pragma unroll
      for (int i = 0; i < 4; ++i)
#pragma unroll
        for (int r = 0; r < 4; ++r)
#pragma unroll
          for (int j = 0; j < 4; ++j)
            sw[(16 * i + r) * 129 + 16 * j] = (ord_key(acc[i][j][r]) & ~127u) | (unsigned)(wn * 64 + 16 * j + lr);
    }
    __syncthreads();
    const int row = tid & 127, half = tid >> 7;
    unsigned top[16];
    {
      const unsigned* sr = simg + row * 129 + half * 64;
#pragma unroll
      for (int k = 0; k < 16; ++k) top[k] = sr[k];
      sort16_desc(top);
#pragma unroll 1
      for (int gi = 1; gi < 4; ++gi) {
        unsigned v1[16];
#pragma unroll
        for (int k = 0; k < 16; ++k) v1[k] = sr[gi * 16 + k];
        sort16_desc(v1);
        merge16_desc(top, v1);
      }
    }
    __syncthreads();
    if (half == 1) {
#pragma unroll
      for (int k = 0; k < 16; ++k) simg[k * 128 + row] = top[k];
    }
    __syncthreads();
    if (half == 0) {
      unsigned o[16];
#pragma unroll
      for (int k = 0; k < 16; ++k) o[k] = simg[k * 128 + row];
      merge16_desc(top, o);
      uint4* dst = (uint4*)(p.pk + (((size_t)(m0 + row) * 8 + head) * 2 + hf) * 16);
#pragma unroll
      for (int k = 0; k < 4; ++k) dst[k] = make_uint4(top[4 * k], top[4 * k + 1], top[4 * k + 2], top[4 * k + 3]);
    }
  }
};

__device__ const unsigned char CAND_A[64] = {0,0,0,0,0,0,0,0,0,0,0,0,0,0,0,0, 1,1,1,1,1,1,1,1, 2,2,2,2,2, 3,3,3,3, 4,4,4, 5,5, 6,6, 7,7,
                                             8,9,10,11,12,13,14,15, 0,0,0,0,0,0,0,0,0,0,0,0,0,0};
__device__ const unsigned char CAND_B[64] = {0,1,2,3,4,5,6,7,8,9,10,11,12,13,14,15, 0,1,2,3,4,5,6,7, 0,1,2,3,4, 0,1,2,3, 0,1,2, 0,1, 0,1, 0,1,
                                             0,0,0,0,0,0,0,0, 0,0,0,0,0,0,0,0,0,0,0,0,0,0};

__device__ __forceinline__ void ph_peer_merge(const P& p, int l, int t0, char* smem) {
  const int tid = tid_opaque(), lane = tid & 63, wv = tid >> 6;
  const float* n2g = p.norm2_g + l * 1024;
  const int ca = CAND_A[lane], cb = CAND_B[lane];
  for (int tk = t0 + blockIdx.x * 4 + wv; tk < TT; tk += gridDim.x * 4) {
    const float* mod = p.mod + (l * 2 + (tk < LC ? 1 : 0)) * 6144;
    unsigned p1[8], p2[8];
    {
      const unsigned* pk = p.pk + (size_t)tk * 256;
#pragma unroll
      for (int head = 0; head < 8; ++head) { p1[head] = pk[head * 32 + ca]; p2[head] = pk[head * 32 + 16 + cb]; }
    }
    {
      const float4* xp = (const float4*)(p.xall + (size_t)tk * 1024) + lane * 4;
      float4 v[4];
      float ss = 0.f;
#pragma unroll
      for (int q = 0; q < 4; ++q) { v[q] = xp[q]; ss += v[q].x * v[q].x + v[q].y * v[q].y + v[q].z * v[q].z + v[q].w * v[q].w; }
      ss = wave_sum(ss);
      const float rinv = rsqrtf(ss * (1.f / 1024.f) + EPS);
      uint2* hp = (uint2*)(p.hb + (size_t)tk * 1024) + lane * 4;
#pragma unroll
      for (int q = 0; q < 4; ++q) {
        float4 gg = ((const float4*)n2g)[lane * 4 + q], sc = ((const float4*)(mod + 4096))[lane * 4 + q], sh = ((const float4*)(mod + 3072))[lane * 4 + q];
        float h0 = v[q].x * rinv * gg.x * (1.f + sc.x) + sh.x, h1 = v[q].y * rinv * gg.y * (1.f + sc.y) + sh.y;
        float h2 = v[q].z * rinv * gg.z * (1.f + sc.z) + sh.z, h3 = v[q].w * rinv * gg.w * (1.f + sc.w) + sh.w;
        hp[q] = make_uint2(pack2bf(h0, h1), pack2bf(h2, h3));
      }
    }
    float sums[8];
    unsigned* candk = (unsigned*)smem + wv * 512;
#pragma unroll
    for (int head = 0; head < 8; ++head) {
      sums[head] = lane < 50 ? ord_val(p1[head]) + ord_val(p2[head]) : -3.0e38f;
      candk[head * 64 + lane] = (ord_key(sums[head]) & ~63u) | (unsigned)(63 - lane);
    }
#pragma unroll
    for (int head = 0; head < 8; ++head) {
      const float sum = sums[head];
      const unsigned kme = (ord_key(sum) & ~63u) | (unsigned)(63 - lane);
      int eid = (int)(p1[head] & 127u) * 128 + (int)(p2[head] & 127u);
      int rank = 0;
#pragma unroll
      for (int m4 = 0; m4 < 13; ++m4) {
        const uint4 km = *(const uint4*)(candk + head * 64 + 4 * m4);
        rank += (km.x > kme) ? 1 : 0;
        rank += (km.y > kme) ? 1 : 0;
        rank += (km.z > kme) ? 1 : 0;
        rank += (km.w > kme) ? 1 : 0;
      }
      float mx = wave_max(sum);
      bool sel = (lane < 50) && (rank < 16);
      float e = sel ? __expf(sum - mx) : 0.f;
      float tot = wave_sum(e);
      if (sel) {
        const int n = head * 16 + rank, idx = (n & 7) * 16 + (n >> 3);
        p.el[(size_t)tk * 128 + idx] = eid;
        p.gl[(size_t)tk * 128 + idx] = e / tot;
      }
    }
  }
}

struct XcdWork { int li, np, rank, nloc; };

__device__ __forceinline__ XcdWork load_xw(const float* smem) {
  const volatile LAS unsigned* st = (const volatile LAS unsigned*)(smem + 18432);
  XcdWork xw;
  xw.nloc = __builtin_amdgcn_readfirstlane((int)st[0]); xw.np = __builtin_amdgcn_readfirstlane((int)st[1]);
  xw.rank = __builtin_amdgcn_readfirstlane((int)st[2]); xw.li = __builtin_amdgcn_readfirstlane((int)st[3]);
  return xw;
}
__device__ __forceinline__ void ph_peer_s1(const P& p, int l, int t0, const XcdWork& xw) {
  const int tid = tid_opaque(), lane = tid & 63, wv = tid >> 6, j = lane >> 3, k = lane & 7;
  const unsigned char* U = p.ub8 + (size_t)l * 16384 * 1024;
  const int step = xw.nloc * 4;
  for (int s = xw.li; s < 8; s += xw.np) {
    const unsigned roff = 128u * s + 16u * k;
    int tk = t0 + xw.rank * 4 + wv;
    int4 en[4];
    if (tk < TT) {
      const int4* ep = (const int4*)(p.el + (size_t)tk * 128 + j * 16);
#pragma unroll
      for (int q = 0; q < 4; ++q) en[q] = ep[q];
    }
    for (; tk < TT; tk += step) {
      uint4 ur[16];
#pragma unroll
      for (int q = 0; q < 4; ++q) {
        ur[4 * q + 0] = *(const uint4*)(U + ((unsigned)en[q].x * 1024u + roff));
        ur[4 * q + 1] = *(const uint4*)(U + ((unsigned)en[q].y * 1024u + roff));
        ur[4 * q + 2] = *(const uint4*)(U + ((unsigned)en[q].z * 1024u + roff));
        ur[4 * q + 3] = *(const uint4*)(U + ((unsigned)en[q].w * 1024u + roff));
      }
      const uint4* hp = (const uint4*)(p.hb + (size_t)tk * 1024 + roff);
      const uint4 h0 = hp[0], h1 = hp[1];
      if (tk + step < TT) {
        const int4* ep = (const int4*)(p.el + (size_t)(tk + step) * 128 + j * 16);
#pragma unroll
        for (int q = 0; q < 4; ++q) en[q] = ep[q];
      }
      float hv[16];
      {
        unsigned w[8] = {h0.x, h0.y, h0.z, h0.w, h1.x, h1.y, h1.z, h1.w};
#pragma unroll
        for (int q = 0; q < 8; ++q) { hv[2 * q] = __uint_as_float(w[q] << 16); hv[2 * q + 1] = __uint_as_float(w[q] & 0xffff0000u); }
      }
      float keep0 = 0.f, keep1 = 0.f;
#pragma unroll
      for (int i = 0; i < 16; ++i) {
        unsigned w[4] = {ur[i].x, ur[i].y, ur[i].z, ur[i].w};
        float dot = 0.f;
#pragma unroll
        for (int q = 0; q < 4; ++q) {
          f32x2 lo = __builtin_amdgcn_cvt_pk_f32_fp8((int)w[q], false), hi = __builtin_amdgcn_cvt_pk_f32_fp8((int)w[q], true);
          dot += lo[0] * hv[q * 4] + lo[1] * hv[q * 4 + 1] + hi[0] * hv[q * 4 + 2] + hi[1] * hv[q * 4 + 3];
        }
        dot += dpp_row<0xB1>(dot);
        dot += dpp_row<0x4E>(dot);
        dot += dpp_row<0x141>(dot);
        if (i < 8) keep0 = (k == i) ? dot : keep0; else keep1 = (k == i - 8) ? dot : keep1;
      }
      float* pd = p.pd + ((size_t)s * TT + tk) * 128;
      pd[8 * k + j] = keep0;
      pd[8 * (k + 8) + j] = keep1;
    }
  }
}

__device__ __forceinline__ void ph_peer_r(const P& p, int l, int t0) {
  const float* usc = p.usc + l * 16384;
  const float* vsc = p.vsc + l * 16384;
  for (int idx = GTID; idx < (TT - t0) * 32; idx += GSZ) {
    const int tk = t0 + (idx >> 5), n0 = (idx & 31) * 4;
    float4 d = make_float4(0.f, 0.f, 0.f, 0.f);
#pragma unroll
    for (int s = 0; s < 8; ++s) {
      const float4 v = *(const float4*)(p.pd + ((size_t)s * TT + tk) * 128 + n0);
      d.x += v.x; d.y += v.y; d.z += v.z; d.w += v.w;
    }
    float dv[4] = {d.x, d.y, d.z, d.w};
#pragma unroll
    for (int q = 0; q < 4; ++q) {
      const int n = n0 + q, li = (n & 7) * 16 + (n >> 3);
      const int ex = p.el[(size_t)tk * 128 + li];
      p.av[(size_t)tk * 128 + li] = p.gl[(size_t)tk * 128 + li] * gelu_f(dv[q] * usc[ex]) * vsc[ex];
    }
  }
}

__device__ __forceinline__ void ph_peer_s2(const P& p, int l, int t0, const XcdWork& xw, char* smem) {
  const int tid = tid_opaque(), lane = tid & 63, wv = tid >> 6, j = lane >> 3, k = lane & 7;
  const int ko = lane >> 3, jo = lane & 7;
  float* red = (float*)smem + wv * 1024;
  const unsigned char* V = p.vb8 + (size_t)l * 16384 * 1024;
  const int step = xw.nloc * 4;
  for (int s = xw.li; s < 8; s += xw.np) {
    const unsigned roff = 128u * s + 16u * k;
    const int dim = 128 * s + 16 * ko + 2 * jo;
    int tk = t0 + xw.rank * 4 + wv;
    int4 en[4];
    if (tk < TT) {
      const int4* ep = (const int4*)(p.el + (size_t)tk * 128 + j * 16);
#pragma unroll
      for (int q = 0; q < 4; ++q) en[q] = ep[q];
    }
    for (; tk < TT; tk += step) {
      uint4 vr[16];
#pragma unroll
      for (int q = 0; q < 4; ++q) {
        vr[4 * q + 0] = *(const uint4*)(V + ((unsigned)en[q].x * 1024u + roff));
        vr[4 * q + 1] = *(const uint4*)(V + ((unsigned)en[q].y * 1024u + roff));
        vr[4 * q + 2] = *(const uint4*)(V + ((unsigned)en[q].z * 1024u + roff));
        vr[4 * q + 3] = *(const uint4*)(V + ((unsigned)en[q].w * 1024u + roff));
      }
      float4 an[4];
      {
        const float4* ap = (const float4*)(p.av + (size_t)tk * 128 + j * 16);
#pragma unroll
        for (int q = 0; q < 4; ++q) an[q] = ap[q];
      }
      const float* mod = p.mod + (l * 2 + (tk < LC ? 1 : 0)) * 6144;
      const float2 g2 = *(const float2*)(mod + 5120 + dim);
      const float2 xin = *(const float2*)(p.xall + (size_t)tk * 1024 + dim);
      if (tk + step < TT) {
        const int4* ep = (const int4*)(p.el + (size_t)(tk + step) * 128 + j * 16);
#pragma unroll
        for (int q = 0; q < 4; ++q) en[q] = ep[q];
      }
      float acc[16];
#pragma unroll
      for (int d = 0; d < 16; ++d) acc[d] = 0.f;
#pragma unroll
      for (int i = 0; i < 16; ++i) {
        const float a = (i & 3) == 0 ? an[i >> 2].x : (i & 3) == 1 ? an[i >> 2].y : (i & 3) == 2 ? an[i >> 2].z : an[i >> 2].w;
        unsigned y[4] = {vr[i].x, vr[i].y, vr[i].z, vr[i].w};
#pragma unroll
        for (int q = 0; q < 4; ++q) {
          f32x2 lo = __builtin_amdgcn_cvt_pk_f32_fp8((int)y[q], false), hi = __builtin_amdgcn_cvt_pk_f32_fp8((int)y[q], true);
          acc[q * 4] += a * lo[0]; acc[q * 4 + 1] += a * lo[1]; acc[q * 4 + 2] += a * hi[0]; acc[q * 4 + 3] += a * hi[1];
        }
        if (i + 1 < 16) asm volatile("" : "+v"(acc[0]), "+v"(vr[i + 1].x), "+v"(vr[i + 1].y), "+v"(vr[i + 1].z), "+v"(vr[i + 1].w));
      }
#pragma unroll
      for (int q = 0; q < 4; ++q) *(float4*)(red + lane * 16 + 4 * q) = make_float4(acc[4 * q], acc[4 * q + 1], acc[4 * q + 2], acc[4 * q + 3]);
      float f0 = 0.f, f1 = 0.f;
#pragma unroll
      for (int jj = 0; jj < 8; ++jj) {
        const float2 t = *(const float2*)(red + (jj * 8 + ko) * 16 + 2 * jo);
        f0 += t.x; f1 += t.y;
      }
      float2 o = make_float2(xin.x + g2.x * f0, xin.y + g2.y * f1);
      if (l == 1) *(float2*)(p.out + (size_t)(tk - LC) * 1024 + dim) = o;
      else *(float2*)(p.xall + (size_t)tk * 1024 + dim) = o;
    }
  }
}

#define XB_TMO      128
#define XB_XCNT(j)  (256  + 64 * (j))
#define XB_XSUB(j)  (1280 + 64 * (j))
#define XB_XGEN(j)  (2304 + 64 * (j))
#define XB_TOP      3328
#define XB_TOPGEN   3392
#define XB_RANK(j)  (3456 + 64 * (j))
#define XCD_BAR_WORDS 4480
#define XB_SPIN_CAP (1u << 22)
__device__ __forceinline__ unsigned xb_ld(unsigned* q) { return __hip_atomic_load(q, __ATOMIC_RELAXED, __HIP_MEMORY_SCOPE_AGENT); }
__device__ __forceinline__ unsigned xb_add(unsigned* q, unsigned v) { return __hip_atomic_fetch_add(q, v, __ATOMIC_RELAXED, __HIP_MEMORY_SCOPE_AGENT); }
__device__ __forceinline__ unsigned xb_xcc_id() { return (unsigned)__builtin_amdgcn_s_getreg((3 << 11) | 20) & 0xFu; }
#define XB_SPIN(cond, bar) do { unsigned _sp = 0; while (cond) { __builtin_amdgcn_s_sleep(1); \
    if ((++_sp & 255u) == 0u) { if (xb_ld(&(bar)[XB_TMO])) break; if (_sp > XB_SPIN_CAP) { atomicAdd(&(bar)[XB_TMO], 1u); break; } } } } while (0)
struct XcdBarrier { unsigned* bar; unsigned x; volatile LAS unsigned* st; };
__device__ __forceinline__ XcdBarrier xcd_barrier_post(unsigned* bar, volatile LAS unsigned* st) {
  XcdBarrier b; b.bar = bar; b.x = xb_xcc_id(); b.st = st;
  if (threadIdx.x == 0) { (void)xb_add(&bar[XB_XCNT(b.x)], 1u); st[2] = xb_add(&bar[XB_RANK(b.x)], 1u); }
  return b;
}
__device__ __forceinline__ void xcd_barrier_complete(unsigned* bar, unsigned x, unsigned& nloc, unsigned& nx, unsigned& li) {
  const unsigned G = gridDim.x * gridDim.y * gridDim.z;
  unsigned sum, cnt, mine, below, sp = 0u;
  for (;;) {
    sum = 0u; cnt = 0u; mine = 0u; below = 0u;
#pragma unroll
    for (unsigned j = 0; j < 16; ++j) { const unsigned c = xb_ld(&bar[XB_XCNT(j)]); sum += c; cnt += (c > 0u) ? 1u : 0u; mine = (j == x) ? c : mine; below += (j < x && c > 0u) ? 1u : 0u; }
    if (sum == G) break;
    __builtin_amdgcn_s_sleep(1);
    if ((++sp & 255u) == 0u) { if (xb_ld(&bar[XB_TMO])) break; if (sp > XB_SPIN_CAP) { atomicAdd(&bar[XB_TMO], 1u); break; } }
  }
  nloc = mine > 0u ? mine : 1u; nx = cnt > 0u ? cnt : 1u; li = below;
}
__device__ __forceinline__ void xcd_barrier(const XcdBarrier& b) {
  asm volatile("s_waitcnt vmcnt(0)" ::: "memory");
  __syncthreads();
  if (threadIdx.x == 0) {
    unsigned* bar = b.bar;
    __builtin_amdgcn_s_waitcnt(0);
    unsigned nloc = b.st[0], nx = b.st[1];
    if (nloc == 0u) { unsigned li; xcd_barrier_complete(bar, b.x, nloc, nx, li); b.st[0] = nloc; b.st[1] = nx; b.st[3] = li; }
    const unsigned old = xb_add(&bar[XB_XSUB(b.x)], 1u);
    const unsigned gen = old / nloc;
    if (old + 1u == (gen + 1u) * nloc) {
      __builtin_amdgcn_fence(__ATOMIC_RELEASE, "agent");
      asm volatile("s_waitcnt vmcnt(0)" ::: "memory");
      const unsigned og = xb_add(&bar[XB_TOP], 1u);
      const unsigned tg = og / nx;
      if (og + 1u == (tg + 1u) * nx) xb_add(&bar[XB_TOPGEN], 1u);
      else XB_SPIN(xb_ld(&bar[XB_TOPGEN]) == tg, bar);
      __builtin_amdgcn_fence(__ATOMIC_ACQUIRE, "agent");
      xb_add(&bar[XB_XGEN(b.x)], 1u);
      asm volatile("s_waitcnt vmcnt(0)" ::: "memory");
    } else {
      XB_SPIN(xb_ld(&bar[XB_XGEN(b.x)]) == gen, bar);
      __builtin_amdgcn_fence(__ATOMIC_ACQUIRE, "agent");
      asm volatile("s_waitcnt vmcnt(0)" ::: "memory");
    }
  }
  __syncthreads();
}

#ifndef PROBE_IV
#define PROBE_IV -1
#endif
__device__ __forceinline__ void probe_tick(int& cnt, unsigned long long* slots) {
  if (PROBE_IV >= 0) {
    if (threadIdx.x == 0 && (cnt == PROBE_IV || cnt == PROBE_IV + 1)) slots[cnt - PROBE_IV] = __builtin_amdgcn_s_memrealtime();
    cnt = __builtin_amdgcn_readfirstlane(cnt + 1);
  }
}
#define BARRIER() do { XcdBarrier xb_; xb_.bar = PP.bar; xb_.x = xb_xcc_id(); xb_.st = (volatile LAS unsigned*)(smem + 18432); xcd_barrier(xb_); probe_tick(pcnt, probe_t); } while (0)

typedef const __attribute__((address_space(4))) P* KP;
__device__ __forceinline__ P load_params(KP kp) {
#if defined(__HIP_DEVICE_COMPILE__)
  asm volatile("" : "+s"(kp));
  return *kp;
#else
  return P{};
#endif
}
#define PP load_params(kp)
__global__ void __launch_bounds__(256, 2) k_mega(P p_unused) {
  KP kp = (KP)__builtin_amdgcn_kernarg_segment_ptr();
  __shared__ __attribute__((aligned(16))) float smem[18432 + 8];
  uint4& xb_words = *(uint4*)(smem + 18432);
  cg::grid_group grid = cg::this_grid();
  if (threadIdx.x == 0) xb_words = make_uint4(0u, 0u, 0u, 0u);
  __syncthreads();
  unsigned long long* probe_t = (unsigned long long*)(smem + 18436);
  int pcnt = 0;
  asm volatile("" : "+s"(pcnt));
  probe_tick(pcnt, probe_t);
  ph_mod(PP, smem);
  ph_prep(PP, smem);
  ph_lru_prepw(PP);
  ph_rope_tab(PP);
  ph_prep_peer(PP);
  grid.sync();
  probe_tick(pcnt, probe_t);
  (void)xcd_barrier_post(PP.bar, (volatile LAS unsigned*)&xb_words);
  ph_norm_mod(PP, 0, 0, 0, smem, true);
  ph_bq(PP, smem);
  BARRIER();
#pragma unroll 1
  for (int l = 0; l < 2; ++l) {
    const int t0 = (l == 0) ? 0 : LC;
    { const P lp = PP; gemm_bf16_128(lp, lp.hb, lp.w_in_t + (size_t)l * 1024 * DIN, 1024, 0, TT, DIN, (char*)smem, EpiProj{l}); }
    BARRIER();
    ph_lru<1>(PP, l, (char*)smem);
    ph_attn(PP, l, (char*)smem);
    BARRIER();
    ph_lru_carry(PP, smem);
    BARRIER();
    ph_lru<2>(PP, l, (char*)smem);
    BARRIER();
    { const P lp = PP; gemm_bf16_128(lp, lp.mixb, lp.w_out_t + (size_t)l * 1024 * 1024, 1024, t0, TT, 1024, (char*)smem, EpiResid{l}); }
    BARRIER();
    { const P lp = PP; gemm_bf16_128(lp, lp.hb, lp.wq_t + (size_t)l * 1024 * NPQ, 1024, t0, TT, NPQ, (char*)smem, EpiPeerTopk{l}); }
    BARRIER();
    ph_peer_merge(PP, l, t0, (char*)smem);
    BARRIER();
    ph_peer_s1(PP, l, t0, load_xw(smem));
    BARRIER();
    ph_peer_r(PP, l, t0);
    BARRIER();
    ph_peer_s2(PP, l, t0, load_xw(smem), (char*)smem);
    if (l == 0) {
      BARRIER();
      ph_norm_mod(PP, 1, 0, 0, smem);
      BARRIER();
    }
  }
  if (PROBE_IV >= 0) {
    probe_tick(pcnt, probe_t);
    __syncthreads();
    if (blockIdx.x == 0 && threadIdx.x == 0) {
      const unsigned long long dt = (probe_t[1] - probe_t[0]) * 8ull, ts = __builtin_amdgcn_s_memrealtime();
      while (__builtin_amdgcn_s_memrealtime() - ts < dt) __builtin_amdgcn_s_sleep(8);
    }
  }
}

extern "C" void kernel_launch(void* const* d_in, const int* in_sizes, int n_in, void* d_out, int out_size, void* d_ws,
                              size_t ws_size, hipStream_t stream) {
  P p{};
  const float** fp = (const float**)&p;
  for (int i = 0; i < 28; ++i) fp[i] = (const float*)d_in[i];
  p.out = (float*)d_out;
  float* w = (float*)d_ws;
  size_t o = 0;
  auto carve = [&](size_t n) { float* r = w + o; o += (n + 63) & ~(size_t)63; return r; };
  p.bar = (unsigned*)carve(8192);
  p.mod = carve(4 * 6144);
  p.xall = carve((size_t)TT * 1024);
  p.proj = carve((size_t)TT * 512);
  p.projb = (bf16_t*)carve((size_t)TT * DIN / 2);
  p.mixb = (bf16_t*)carve((size_t)TT * 512);
  p.hb = (bf16_t*)carve((size_t)TT * 512);
  p.w_in_t = (bf16_t*)carve((size_t)1024 * DIN);
  p.w_out_t = (bf16_t*)carve((size_t)1024 * 1024);
  p.wq_t = (bf16_t*)carve((size_t)1024 * NPQ);
  p.lruw_t = (bf16_t*)carve((size_t)2 * 2 * 4 * 2 * 4096 / 2);
  p.lagg = carve((size_t)2 * NCHUNK * 256 * 2);
  p.lcarry = carve((size_t)2 * NCHUNK * 256);
  p.ropetab = carve(320 * 16 * 2);
  p.rowss = carve((size_t)8 * TT);
  p.bq = carve(4 * NPQ);
  p.el = (int*)carve((size_t)TT * 128);
  p.gl = carve((size_t)TT * 128);
  p.av = carve((size_t)TT * 128);
  p.pd = carve((size_t)8 * TT * 128);
  p.pk = (unsigned*)carve((size_t)TT * 256);
  p.ub8 = (unsigned char*)carve((size_t)2 * 16384 * 1024 / 4);
  p.vb8 = (unsigned char*)carve((size_t)2 * 16384 * 1024 / 4);
  p.usc = carve(2 * 16384);
  p.vsc = carve(2 * 16384);
  p.k1b = (bf16_t*)carve(16384);
  p.k2b = (bf16_t*)carve(16384);
  if (o * 4 > ws_size) { fprintf(stderr, "workspace too small: need %zu have %zu\n", o * 4, ws_size); return; }
  static int grid_blocks = 0;
  if (!grid_blocks) {
    int dev = 0, cus = 0, per_cu = 0;
    (void)hipGetDevice(&dev);
    (void)hipDeviceGetAttribute(&cus, hipDeviceAttributeMultiprocessorCount, dev);
    (void)hipOccupancyMaxActiveBlocksPerMultiprocessor(&per_cu, k_mega, 256, 0);
    if (per_cu > 2) per_cu = 2;
    grid_blocks = cus * per_cu;
  }
  (void)hipMemsetAsync(p.bar, 0, XCD_BAR_WORDS * 4, stream);
  void* args[] = {&p};
  hipError_t e = hipLaunchCooperativeKernel((void*)k_mega, dim3(grid_blocks), dim3(256), args, 0, stream);
  if (e != hipSuccess) fprintf(stderr, "cooperative launch failed: %s (grid %d)\n", hipGetErrorString(e), grid_blocks);
}
```

```cpp
#include <hip/hip_runtime.h>
#include <hip/hip_cooperative_groups.h>
#include <stdint.h>
#include <stdio.h>
namespace cg = cooperative_groups;

#ifndef SINGLE_LAUNCH
#define SINGLE_LAUNCH 1
#endif

constexpr int DM = 1024, SEQ = 16384, LC = 256, TT = SEQ + LC, DIN = 2304, NPQ = 2048;
constexpr int OFF_XA = 0, OFF_GA = 256, OFF_QW = 512, OFF_KW = 896, OFF_VW = 1024, OFF_QN = 1152, OFF_KN = 1536, OFF_VN = 1920;
constexpr float EPS = 1e-6f;
#define LAS __attribute__((address_space(3)))
constexpr float LOG2E = 1.4426950408889634f;
constexpr float QSCALE = 0.125f * LOG2E;

struct P {
  const float *x, *c, *ctx, *c_ctx, *w_mod, *b_mod, *norm1_g, *norm2_g, *w_in, *w_out,
      *conv_w, *conv_b, *wa, *ba, *wx, *bx, *lam, *win_qn, *win_kn, *win_sink, *na_qn, *na_kn, *rpb,
      *wq, *k1, *k2, *pu, *pv;
  float* out;
  float *mod, *xall, *proj;
  unsigned short* projb;
  unsigned* pk;
  unsigned* bar;
  unsigned short *k1b, *k2b;
  unsigned char *ub8, *vb8;
  float *usc, *vsc;
  unsigned short *hb, *mixb, *w_in_t, *w_out_t, *wq_t, *lruw_t;
  float *lagg, *lcarry, *ropetab, *rowss, *bq, *gl, *av, *pd;
  int* el;
};

typedef unsigned short bf16_t;
typedef __attribute__((ext_vector_type(8))) short bf16x8;
typedef __attribute__((ext_vector_type(4))) float f32x4;
__device__ __forceinline__ unsigned short f2bf(float f) {
  unsigned u = __float_as_uint(f);
  u += 0x7fffu + ((u >> 16) & 1u);
  return (unsigned short)(u >> 16);
}
__device__ __forceinline__ unsigned pack2bf(float a, float b) { return (unsigned)f2bf(a) | ((unsigned)f2bf(b) << 16); }
__device__ __forceinline__ float bf2f(unsigned short h) { return __uint_as_float(((unsigned)h) << 16); }


__device__ __forceinline__ float silu_f(float x) { return x / (1.f + __expf(-x)); }
__device__ __forceinline__ float sigmoid_f(float x) { return 1.f / (1.f + __expf(-x)); }
__device__ __forceinline__ float gelu_f(float x) {
  float u = 0.7978845608028654f * (x + 0.044715f * x * x * x);
  float e = __expf(2.f * u);
  float th = 1.f - 2.f / (e + 1.f);
  return 0.5f * x * (1.f + th);
}
template <int CTRL, int RMASK>
__device__ __forceinline__ float dpp_mov(float v) {
  return __int_as_float(__builtin_amdgcn_update_dpp(0, __float_as_int(v), CTRL, RMASK, 0xf, false));
}
__device__ __forceinline__ float wave_sum(float v) {
  v += dpp_mov<0xB1, 0xf>(v);
  v += dpp_mov<0x4E, 0xf>(v);
  v += dpp_mov<0x141, 0xf>(v);
  v += dpp_mov<0x140, 0xf>(v);
  v += dpp_mov<0x142, 0xa>(v);
  v += dpp_mov<0x143, 0xc>(v);
  return __int_as_float(__builtin_amdgcn_readlane(__float_as_int(v), 63));
}

__device__ __forceinline__ int tid_opaque() { int t = threadIdx.x; asm volatile("" : "+v"(t)); return t; }
#define GTID (blockIdx.x * blockDim.x + tid_opaque())
#define GSZ (gridDim.x * blockDim.x)

__device__ __forceinline__ void ph_mod(const P& p, float* smem) {
  const int tid = tid_opaque(), cl = tid & 31, ks = tid >> 5;
  for (int it = blockIdx.x; it < 2 * 192; it += gridDim.x) {
    const int nc = it % 192, l = it / 192;
    const int n = nc * 32 + cl;
    const float* w = p.w_mod + (size_t)l * 1024 * 6144 + n;
    float a0 = 0.f, a1 = 0.f;
#pragma unroll 8
    for (int i = 0; i < 128; ++i) {
      int k = i * 8 + ks;
      float wv = w[(size_t)k * 6144];
      a0 += silu_f(p.c[k]) * wv;
      a1 += silu_f(p.c_ctx[k]) * wv;
    }
    __syncthreads();
    smem[tid] = a0; smem[256 + tid] = a1;
    __syncthreads();
    if (tid < 64) {
      const int which = tid >> 5;
      float s = p.b_mod[l * 6144 + n];
#pragma unroll
      for (int q = 0; q < 8; ++q) s += smem[which * 256 + q * 32 + cl];
      p.mod[(l * 2 + which) * 6144 + n] = s;
    }
  }
}

__device__ __forceinline__ void ph_bq(const P& p, float* smem) {
  const int tid = tid_opaque(), cl = tid & 31, ks = tid >> 5;
  for (int it = blockIdx.x; it < 2 * 64; it += gridDim.x) {
    const int nc = it % 64, l = it / 64;
    const int n = nc * 32 + cl;
    const float* w = p.wq + (size_t)l * 1024 * NPQ + n;
    const float* v0 = p.mod + (l * 2 + 0) * 6144 + 3072;
    const float* v1 = p.mod + (l * 2 + 1) * 6144 + 3072;
    float a0 = 0.f, a1 = 0.f;
#pragma unroll 8
    for (int i = 0; i < 128; ++i) {
      int k = i * 8 + ks;
      float wv = w[(size_t)k * NPQ];
      a0 += v0[k] * wv;
      a1 += v1[k] * wv;
    }
    __syncthreads();
    smem[tid] = a0; smem[256 + tid] = a1;
    __syncthreads();
    if (tid < 64) {
      const int which = tid >> 5;
      float s = 0.f;
#pragma unroll
      for (int q = 0; q < 8; ++q) s += smem[which * 256 + q * 32 + cl];
      p.bq[(l * 2 + which) * NPQ + n] = s;
    }
  }
}

__device__ __forceinline__ void ph_copy_in(const P& p) {
  const float4* xs = (const float4*)p.x;
  const float4* cs = (const float4*)p.ctx;
  float4* d = (float4*)p.xall;
  for (int i = GTID; i < TT * 256; i += GSZ) d[i] = (i < LC * 256) ? cs[i] : xs[i - LC * 256];
}

__device__ __forceinline__ void ph_copy_out(const P& p) {
  const float4* s = (const float4*)(p.xall + (size_t)LC * 1024);
  float4* d = (float4*)p.out;
  for (int i = GTID; i < SEQ * 256; i += GSZ) d[i] = s[i];
}

__device__ __forceinline__ void ph_norm_mod(const P& p, int l, int which_norm, int t0, float* smem, bool from_input = false) {
  const float* g = (which_norm ? p.norm2_g : p.norm1_g) + l * 1024;
  const int sh_off = which_norm ? 3072 : 0, sc_off = which_norm ? 4096 : 1024;
  const int tid = tid_opaque();
  for (int t = t0 + blockIdx.x; t < TT; t += gridDim.x) {
    const float* mod = p.mod + (l * 2 + (t < LC ? 1 : 0)) * 6144;
    float4 v;
    if (from_input) {
      v = t < LC ? ((const float4*)(p.ctx + (size_t)t * 1024))[tid] : ((const float4*)(p.x + (size_t)(t - LC) * 1024))[tid];
      ((float4*)(p.xall + (size_t)t * 1024))[tid] = v;
    } else v = ((const float4*)(p.xall + (size_t)t * 1024))[tid];
    float ss = wave_sum(v.x * v.x + v.y * v.y + v.z * v.z + v.w * v.w);
    __syncthreads();
    if ((tid & 63) == 0) smem[tid >> 6] = ss;
    __syncthreads();
    float tot = smem[0] + smem[1] + smem[2] + smem[3];
    float rinv = rsqrtf(tot * (1.f / 1024.f) + EPS);
    float4 gg = ((const float4*)g)[tid];
    float4 sc = ((const float4*)(mod + sc_off))[tid];
    float4 sh = ((const float4*)(mod + sh_off))[tid];
    float4 o;
    o.x = v.x * rinv * gg.x * (1.f + sc.x) + sh.x;
    o.y = v.y * rinv * gg.y * (1.f + sc.y) + sh.y;
    o.z = v.z * rinv * gg.z * (1.f + sc.z) + sh.z;
    o.w = v.w * rinv * gg.w * (1.f + sc.w) + sh.w;
    ((uint2*)(p.hb + (size_t)t * 1024))[tid] = make_uint2(pack2bf(o.x, o.y), pack2bf(o.z, o.w));
  }
}

__device__ __forceinline__ void prep_transpose(const float* W, bf16_t* Wt, int K, int N, int item0, int nitems_total, float* smem) {
  (void)nitems_total;
  float(*ts)[65] = (float(*)[65])smem;
  const int tid = tid_opaque();
  const int tn = N / 64, nt = (K / 64) * tn;
  for (int it = blockIdx.x; it < nt; it += gridDim.x) {
    int k0 = (it / tn) * 64, n0 = (it % tn) * 64;
    __syncthreads();
#pragma unroll
    for (int i = 0; i < 16; ++i) {
      int r = (tid >> 6) + i * 4, c = tid & 63;
      ts[r][c] = W[(size_t)(k0 + r) * N + n0 + c];
    }
    __syncthreads();
#pragma unroll
    for (int i = 0; i < 16; ++i) {
      int r = (tid >> 6) + i * 4, c = tid & 63;
      Wt[(size_t)(n0 + r) * K + k0 + c] = f2bf(ts[c][r]);
    }
  }
  (void)item0;
}

__device__ __forceinline__ void ph_prep(const P& p, float* smem) {
  for (int l = 0; l < 2; ++l) {
    prep_transpose(p.w_in + (size_t)l * 1024 * DIN, p.w_in_t + (size_t)l * 1024 * DIN, 1024, DIN, 0, 0, smem);
    prep_transpose(p.w_out + (size_t)l * 1024 * 1024, p.w_out_t + (size_t)l * 1024 * 1024, 1024, 1024, 0, 0, smem);
    prep_transpose(p.wq + (size_t)l * 1024 * NPQ, p.wq_t + (size_t)l * 1024 * NPQ, 1024, NPQ, 0, 0, smem);
  }
}

struct EpiStoreF32 {
  float* C; int ldc;
  __device__ __forceinline__ void operator()(const P& p, f32x4 (&acc)[4][4], int m0, int n0, int wm, int wn, int lane, char* smem) const {
    const int mw0 = m0 + wm * 64, nw0 = n0 + wn * 64;
#pragma unroll
    for (int i = 0; i < 4; ++i)
#pragma unroll
      for (int r = 0; r < 4; ++r) {
        int row = mw0 + 16 * i + (lane >> 4) * 4 + r;
#pragma unroll
        for (int j = 0; j < 4; ++j) C[(size_t)row * ldc + nw0 + 16 * j + (lane & 15)] = acc[i][j][r];
      }
  }
};
struct EpiProjSplit {
  __device__ __forceinline__ void operator()(const P& p, f32x4 (&acc)[4][4], int m0, int n0, int wm, int wn, int lane, char* smem) const {
    const int mw0 = m0 + wm * 64, nw0 = n0 + wn * 64;
#pragma unroll
    for (int i = 0; i < 4; ++i)
#pragma unroll
      for (int r = 0; r < 4; ++r) {
        int row = mw0 + 16 * i + (lane >> 4) * 4 + r;
#pragma unroll
        for (int j = 0; j < 4; ++j) {
          int col = nw0 + 16 * j + (lane & 15);
          if (n0 < 512) p.proj[(size_t)row * 512 + col] = acc[i][j][r];
          else p.projb[(size_t)row * DIN + col] = f2bf(acc[i][j][r]);
        }
      }
  }
};
__device__ __forceinline__ void ph_rope_tab(const P& p) {
  for (int idx = GTID; idx < 320 * 16; idx += GSZ) {
    int v = idx >> 4, j = idx & 15;
    float inv = __expf(-(float)j * (1.f / 16.f) * 9.210340371976184f);
    float ang = (float)(v < 256 ? v : v - 256) * inv;
    float k = rintf(ang * 0.15915494309189535f);
    float r = fmaf(-k, 6.2831854820251465f, ang);
    r = fmaf(-k, -1.7484555e-07f, r);
    ((float2*)p.ropetab)[idx] = make_float2(__cosf(r), __sinf(r));
  }
}

template <int CTRL>
__device__ __forceinline__ float dpp_row(float v) {
  return __int_as_float(__builtin_amdgcn_update_dpp(0, __float_as_int(v), CTRL, 0xf, 0xf, false));
}
struct EpiProj {
  int l;
  __device__ __forceinline__ void operator()(const P& p, f32x4 (&acc)[4][4], int m0, int n0, int wm, int wn, int lane, char* smem) const {
    const int g = lane >> 4, lr = lane & 15;
    const int mw0 = m0 + wm * 64, nw0 = n0 + wn * 64;
    if (n0 < 512) {
#pragma unroll
      for (int i = 0; i < 4; ++i)
#pragma unroll
        for (int r = 0; r < 4; ++r) {
          int row = mw0 + 16 * i + 4 * g + r;
#pragma unroll
          for (int j = 0; j < 4; ++j) p.proj[(size_t)row * 512 + nw0 + 16 * j + lr] = acc[i][j][r];
        }
      return;
    }
    const float* gain = nullptr; bool rope = false; float scale = 1.f;
    if (nw0 < 896) { gain = p.win_qn + l * 64; rope = true; scale = QSCALE; }
    else if (nw0 < 1024) { gain = p.win_kn + l * 64; rope = true; }
    else if (nw0 < 1152) { }
    else if (nw0 < 1536) { gain = p.na_qn + l * 64; scale = QSCALE; }
    else if (nw0 < 1920) { gain = p.na_kn + l * 64; }
    rope = rope && (m0 >= LC);
    float gj[4] = {1.f, 1.f, 1.f, 1.f};
    if (gain) {
#pragma unroll
      for (int j = 0; j < 4; ++j) gj[j] = gain[16 * j + lr] * scale;
    }
#pragma unroll
    for (int i = 0; i < 4; ++i)
#pragma unroll
      for (int r = 0; r < 4; ++r) {
        const int row = mw0 + 16 * i + 4 * g + r;
        float y[4] = {acc[i][0][r], acc[i][1][r], acc[i][2][r], acc[i][3][r]};
        if (gain) {
          float ss = y[0] * y[0] + y[1] * y[1] + y[2] * y[2] + y[3] * y[3];
          ss += dpp_row<0xB1>(ss);
          ss += dpp_row<0x4E>(ss);
          ss += dpp_row<0x141>(ss);
          ss += dpp_row<0x140>(ss);
          const float rinv = rsqrtf(ss * (1.f / 64.f) + EPS);
#pragma unroll
          for (int j = 0; j < 4; ++j) y[j] *= rinv * gj[j];
        }
        if (rope) {
          const int pos = row - LC;
          const float2 tr = ((const float2*)p.ropetab)[(pos >> 6) * 16 + lr];
          const float2 tc = ((const float2*)p.ropetab)[(256 + (pos & 63)) * 16 + lr];
          float a0 = y[0] * tr.x - y[1] * tr.y, a1 = y[0] * tr.y + y[1] * tr.x;
          float a2 = y[2] * tc.x - y[3] * tc.y, a3 = y[2] * tc.y + y[3] * tc.x;
          y[0] = a0; y[1] = a1; y[2] = a2; y[3] = a3;
        }
#pragma unroll
        for (int j = 0; j < 4; ++j) p.projb[(size_t)row * DIN + nw0 + 16 * j + lr] = f2bf(y[j]);
      }
  }
};
struct EpiResid {
  int l;
  __device__ __forceinline__ void operator()(const P& p, f32x4 (&acc)[4][4], int m0, int n0, int wm, int wn, int lane, char* smem) const {
    float* tile = (float*)smem;
    {
      const int g = lane >> 4, lr = lane & 15;
      float* tw = tile + (wm * 64 + 4 * g) * 132 + wn * 64 + lr;
#pragma unroll
      for (int i = 0; i < 4; ++i)
#pragma unroll
        for (int r = 0; r < 4; ++r)
#pragma unroll
          for (int j = 0; j < 4; ++j) tw[(16 * i + r) * 132 + 16 * j] = acc[i][j][r];
    }
    __syncthreads();
    const int tid = ((wm * 2 + wn) << 6) | lane, c8 = tid & 15, rsub = tid >> 4;
    const float* mod = p.mod + (l * 2 + (m0 < LC ? 1 : 0)) * 6144;
    const int col = n0 + 8 * c8;
    float g1v[8], gs[8];
    {
      const float4 a0 = *(const float4*)(mod + 2048 + col), a1 = *(const float4*)(mod + 2048 + col + 4);
      const float4 s0 = *(const float4*)(mod + 4096 + col), s1 = *(const float4*)(mod + 4096 + col + 4);
      const float4 n0v = *(const float4*)(p.norm2_g + l * 1024 + col), n1v = *(const float4*)(p.norm2_g + l * 1024 + col + 4);
      g1v[0] = a0.x; g1v[1] = a0.y; g1v[2] = a0.z; g1v[3] = a0.w; g1v[4] = a1.x; g1v[5] = a1.y; g1v[6] = a1.z; g1v[7] = a1.w;
      gs[0] = n0v.x * (1.f + s0.x); gs[1] = n0v.y * (1.f + s0.y); gs[2] = n0v.z * (1.f + s0.z); gs[3] = n0v.w * (1.f + s0.w);
      gs[4] = n1v.x * (1.f + s1.x); gs[5] = n1v.y * (1.f + s1.y); gs[6] = n1v.z * (1.f + s1.z); gs[7] = n1v.w * (1.f + s1.w);
    }
#pragma unroll
    for (int it = 0; it < 8; ++it) {
      const int rl = it * 16 + rsub, row = m0 + rl;
      float4* xp = (float4*)(p.xall + (size_t)row * 1024 + col);
      float4 x0 = xp[0], x1 = xp[1];
      const float4 t0 = *(const float4*)(tile + rl * 132 + 8 * c8), t1 = *(const float4*)(tile + rl * 132 + 8 * c8 + 4);
      x0.x += g1v[0] * t0.x; x0.y += g1v[1] * t0.y; x0.z += g1v[2] * t0.z; x0.w += g1v[3] * t0.w;
      x1.x += g1v[4] * t1.x; x1.y += g1v[5] * t1.y; x1.z += g1v[6] * t1.z; x1.w += g1v[7] * t1.w;
      xp[0] = x0; xp[1] = x1;
      float ss = x0.x * x0.x + x0.y * x0.y + x0.z * x0.z + x0.w * x0.w + x1.x * x1.x + x1.y * x1.y + x1.z * x1.z + x1.w * x1.w;
      ss += dpp_row<0xB1>(ss);
      ss += dpp_row<0x4E>(ss);
      ss += dpp_row<0x141>(ss);
      ss += dpp_row<0x140>(ss);
      *(uint4*)(p.hb + (size_t)row * 1024 + col) = make_uint4(pack2bf(x0.x * gs[0], x0.y * gs[1]), pack2bf(x0.z * gs[2], x0.w * gs[3]),
                                                            pack2bf(x1.x * gs[4], x1.y * gs[5]), pack2bf(x1.z * gs[6], x1.w * gs[7]));
      if (c8 == 0) p.rowss[(size_t)(n0 >> 7) * TT + row] = ss;
    }
  }
};

__device__ __forceinline__ int gemm_swz(int row) { return (0x78 >> (((row >> 2) & 3) * 2)) & 3; }
template <class Epi>
__device__ __forceinline__ void gemm_bf16_128(const P& p, const bf16_t* __restrict__ A, const bf16_t* __restrict__ Bt, int K, int m_begin, int m_end,
                              int N, char* smem, const Epi& epi) {
  const int tid = tid_opaque(), lane = tid & 63, wv = __builtin_amdgcn_readfirstlane(tid >> 6), wm = wv >> 1, wn = wv & 1;
  const int tiles_n = N / 128, tiles_m = (m_end - m_begin) / 128;
  const int nk = K / 32;
  const int lr = lane & 15, g = lane >> 4;
  const int a_rd = (wm * 64 + lr) * 64 + ((g ^ gemm_swz(lr)) << 4);
  const int b_rd = 8192 + (wn * 64 + lr) * 64 + ((g ^ gemm_swz(lr)) << 4);
  const int ld_row = lane >> 2, ld_c = (lane & 3) ^ gemm_swz(ld_row);
  for (int tile = blockIdx.x; tile < tiles_m * tiles_n; tile += gridDim.x) {
    const int m0 = m_begin + (tile / tiles_n) * 128, n0 = (tile % tiles_n) * 128;
    f32x4 acc[4][4];
#pragma unroll
    for (int i = 0; i < 4; ++i)
#pragma unroll
      for (int j = 0; j < 4; ++j) acc[i][j] = (f32x4){0.f, 0.f, 0.f, 0.f};
    const bf16_t* Ag = A + (size_t)(m0 + wv * 32 + ld_row) * K + ld_c * 8;
    const bf16_t* Bg = Bt + (size_t)(n0 + wv * 32 + ld_row) * K + ld_c * 8;
    auto issue = [&](int st, int kt) {
      char* base = smem + st * 16384 + wv * 2048;
#pragma unroll
      for (int i = 0; i < 2; ++i) {
        __builtin_amdgcn_global_load_lds((const unsigned*)(Ag + (size_t)i * 16 * K + kt * 32), (__attribute__((address_space(3))) unsigned*)(base + i * 1024), 16, 0, 0);
        __builtin_amdgcn_global_load_lds((const unsigned*)(Bg + (size_t)i * 16 * K + kt * 32), (__attribute__((address_space(3))) unsigned*)(base + 8192 + i * 1024), 16, 0, 0);
      }
    };
    issue(0, 0); issue(1, 1); issue(2, 2);
    for (int kt0 = 0; kt0 < nk; kt0 += 4) {
#pragma unroll
      for (int u = 0; u < 4; ++u) {
        const int kt = kt0 + u, rem = nk - kt;
        if (rem >= 3) asm volatile("s_waitcnt vmcnt(8) lgkmcnt(0)" ::: "memory");
        else if (rem == 2) asm volatile("s_waitcnt vmcnt(4) lgkmcnt(0)" ::: "memory");
        else asm volatile("s_waitcnt vmcnt(0) lgkmcnt(0)" ::: "memory");
        __builtin_amdgcn_s_barrier();
        if (kt + 3 < nk) issue((u + 3) & 3, kt + 3);
        bf16x8 af[4], bfr[4];
#pragma unroll
        for (int i = 0; i < 4; ++i) af[i] = *(const bf16x8*)(smem + u * 16384 + a_rd + i * 1024);
#pragma unroll
        for (int j = 0; j < 4; ++j) bfr[j] = *(const bf16x8*)(smem + u * 16384 + b_rd + j * 1024);
#pragma unroll
        for (int i = 0; i < 4; ++i)
#pragma unroll
          for (int j = 0; j < 4; ++j) acc[i][j] = __builtin_amdgcn_mfma_f32_16x16x32_bf16(af[i], bfr[j], acc[i][j], 0, 0, 0);
      }
    }
    __syncthreads();
    epi(p, acc, m0, n0, wm, wn, lane, smem);
    __syncthreads();
  }
}

constexpr int NCHUNK = TT / 64;
__device__ __forceinline__ int lru_pos(int dir, int c) { return dir == 0 ? c : (c < 4 ? 3 - c : 4 + (NCHUNK - 1 - c)); }

__device__ __forceinline__ void ph_lru_prepw(const P& p) {
  for (int idx = GTID; idx < 2 * 2 * 4 * 2 * 4096; idx += GSZ) {
    int d = idx & 63, e = (idx >> 6) & 63, mtx = (idx >> 12) & 1, rest = idx >> 13;
    const float* w = (mtx ? p.wx : p.wa) + (size_t)rest * 4096;
    p.lruw_t[idx] = f2bf(w[d * 64 + e]);
  }
}

template <int PASS>
__device__ __forceinline__ void lru_item(const P& p, int l, int cidx, int kb, char* smem) {
  bf16_t* u_img = (bf16_t*)smem;
  float* ab_a = (float*)(smem + 8192);
  float* ab_b = (float*)(smem + 8192 + 16384);
  float* hsum = (float*)(smem + 8192 + 32768);
  float* segagg = (float*)(smem + 8192 + 49152);
  float* ccarry = (float*)(smem + 8192 + 49152 + 2048);
  const int tid = tid_opaque(), lane = tid & 63, wv = tid >> 6, g = lane >> 4, lr = lane & 15;
  const int t0 = cidx * 64;
  const int lo = t0 < LC ? 0 : LC, hi = t0 < LC ? LC : TT;
  __syncthreads();
  {
    const int ch = tid & 63, c = kb * 64 + ch, sg = tid >> 6;
    const float cb = p.conv_b[l * 256 + c];
    float cw[4];
#pragma unroll
    for (int k = 0; k < 4; ++k) cw[k] = p.conv_w[(l * 4 + k) * 256 + c];
    float xr[19];
#pragma unroll
    for (int i = 0; i < 19; ++i) {
      int tt = t0 + sg * 16 + i - 2;
      int tc = tt < lo ? lo : (tt >= hi ? hi - 1 : tt);
      float v = p.proj[(size_t)tc * 512 + OFF_XA + c];
      xr[i] = (tt >= lo && tt < hi) ? v : 0.f;
    }
#pragma unroll
    for (int i = 0; i < 16; ++i) {
      int row = sg * 16 + i;
      float acc = cb + cw[0] * xr[i] + cw[1] * xr[i + 1] + cw[2] * xr[i + 2] + cw[3] * xr[i + 3];
      u_img[row * 64 + ((((ch >> 3) ^ (row & 7)) << 3) | (ch & 7))] = f2bf(acc);
    }
  }
  if (PASS == 2) {
    if (tid < 128) {
      const int ch = tid & 63, dir = tid >> 6;
      ccarry[dir * 64 + ch] = p.lcarry[((size_t)dir * NCHUNK + lru_pos(dir, cidx)) * 256 + kb * 64 + ch];
    }
  }
  __syncthreads();
  for (int dir = 0; dir < 2; ++dir) {
    const int pd = l * 2 + dir;
    {
      f32x4 ga[4], gx[4];
#pragma unroll
      for (int i = 0; i < 4; ++i) { ga[i] = (f32x4){0.f, 0.f, 0.f, 0.f}; gx[i] = (f32x4){0.f, 0.f, 0.f, 0.f}; }
      const bf16_t* wbase = p.lruw_t + (size_t)((pd * 4 + kb) * 2) * 4096 + (16 * wv + lr) * 64 + 8 * g;
#pragma unroll
      for (int s = 0; s < 2; ++s) {
        bf16x8 ba_ = *(const bf16x8*)(wbase + 32 * s);
        bf16x8 bx_ = *(const bf16x8*)(wbase + 4096 + 32 * s);
#pragma unroll
        for (int i = 0; i < 4; ++i) {
          int row = 16 * i + lr;
          bf16x8 af = *(const bf16x8*)((const char*)u_img + row * 128 + (((4 * s + g) ^ (row & 7)) << 4));
          ga[i] = __builtin_amdgcn_mfma_f32_16x16x32_bf16(af, ba_, ga[i], 0, 0, 0);
          gx[i] = __builtin_amdgcn_mfma_f32_16x16x32_bf16(af, bx_, gx[i], 0, 0, 0);
        }
      }
      const int ch = 16 * wv + lr, c = kb * 64 + ch;
      const float bav = p.ba[pd * 256 + c], bxv = p.bx[pd * 256 + c];
      const float sp = log1pf(expf(-p.lam[pd * 256 + c]));
#pragma unroll
      for (int i = 0; i < 4; ++i)
#pragma unroll
        for (int r = 0; r < 4; ++r) {
          int row = 16 * i + 4 * g + r;
          float rr = sigmoid_f(ga[i][r] + bav), ig = sigmoid_f(gx[i][r] + bxv);
          float log_a = -8.f * rr * sp;
          float a = __expf(log_a);
          float uu = bf2f(u_img[row * 64 + ((((ch >> 3) ^ (row & 7)) << 3) | (ch & 7))]);
          const float x2 = 2.f * log_a;
          const float ser = -x2 * (1.f + x2 * (0.5f + x2 * (0.16666667f + x2 * (0.041666668f + x2 * 0.0083333338f))));
          const float om = x2 > -0.25f ? ser : 1.f - a * a;
          float b = sqrtf(om) * ig * uu;
          ab_a[row * 64 + ch] = a;
          ab_b[row * 64 + ch] = b;
        }
    }
    __syncthreads();
    {
      const int ch = tid & 63, seg = tid >> 6;
      float Pr = 1.f, H = 0.f;
#pragma unroll
      for (int i = 0; i < 16; ++i) {
        int row = dir == 0 ? seg * 16 + i : seg * 16 + 15 - i;
        float a = ab_a[row * 64 + ch], b = ab_b[row * 64 + ch];
        H = a * H + b;
        Pr *= a;
      }
      segagg[(seg * 64 + ch) * 2] = Pr;
      segagg[(seg * 64 + ch) * 2 + 1] = H;
      __syncthreads();
      if (PASS == 1) {
        if (seg == 0) {
          float A = 1.f, B = 0.f;
#pragma unroll
          for (int s2 = 0; s2 < 4; ++s2) {
            int sg = dir == 0 ? s2 : 3 - s2;
            float pa = segagg[(sg * 64 + ch) * 2], pb = segagg[(sg * 64 + ch) * 2 + 1];
            B = pa * B + pb;
            A *= pa;
          }
          float2* ag = (float2*)p.lagg + ((size_t)dir * NCHUNK + lru_pos(dir, cidx)) * 256 + kb * 64 + ch;
          *ag = make_float2(A, B);
        }
      } else {
        float h = ccarry[dir * 64 + ch];
        float gav[16];
        if (dir == 1) {
#pragma unroll
          for (int i = 0; i < 16; ++i) gav[i] = p.proj[(size_t)(t0 + seg * 16 + 15 - i) * 512 + OFF_GA + kb * 64 + ch];
        }
#pragma unroll
        for (int s2 = 0; s2 < 3; ++s2) {
          int sg = dir == 0 ? s2 : 3 - s2;
          bool before = dir == 0 ? (sg < seg) : (sg > seg);
          if (before) h = segagg[(sg * 64 + ch) * 2] * h + segagg[(sg * 64 + ch) * 2 + 1];
        }
#pragma unroll
        for (int i = 0; i < 16; ++i) {
          int row = dir == 0 ? seg * 16 + i : seg * 16 + 15 - i;
          float a = ab_a[row * 64 + ch], b = ab_b[row * 64 + ch];
          h = a * h + b;
          if (dir == 0) hsum[row * 64 + ch] = h;
          else {
            int t = t0 + row, c = kb * 64 + ch;
            p.mixb[(size_t)t * 1024 + c] = f2bf((hsum[row * 64 + ch] + h) * gelu_f(gav[i]));
          }
        }
      }
    }
    __syncthreads();
  }
}

__device__ __forceinline__ void ph_lru_carry(const P& p, float* smem) {
  const int tid = tid_opaque(), seg = tid >> 4, c16 = tid & 15;
  for (int blk = blockIdx.x; blk < 32; blk += gridDim.x) {
    const int dc = blk * 16 + c16, dir = dc >> 8, ch = dc & 255;
    const float2* ag = (const float2*)p.lagg + (size_t)dir * NCHUNK * 256 + ch;
    float2 v[17];
#pragma unroll
    for (int i = 0; i < 17; ++i) {
      int pos = seg * 17 + i;
      v[i] = pos < NCHUNK ? ag[(size_t)pos * 256] : make_float2(1.f, 0.f);
    }
    float A = 1.f, B = 0.f;
#pragma unroll
    for (int i = 0; i < 17; ++i) { B = v[i].x * B + v[i].y; A *= v[i].x; }
    __syncthreads();
    smem[(seg * 16 + c16) * 2] = A; smem[(seg * 16 + c16) * 2 + 1] = B;
    __syncthreads();
    float h = 0.f;
    for (int s2 = 0; s2 < seg; ++s2) h = smem[(s2 * 16 + c16) * 2] * h + smem[(s2 * 16 + c16) * 2 + 1];
    float* cr = p.lcarry + (size_t)dir * NCHUNK * 256 + ch;
#pragma unroll
    for (int i = 0; i < 17; ++i) {
      int pos = seg * 17 + i;
      if (pos < NCHUNK) cr[(size_t)pos * 256] = h;
      h = v[i].x * h + v[i].y;
    }
  }
}

template <int PASS>
__device__ __forceinline__ void ph_lru(const P& p, int l, char* smem) {
  const int c_begin = (PASS == 2 && l == 1) ? 4 : 0;
  const int nitems = (NCHUNK - c_begin) * 4;
  for (int it = blockIdx.x; it < nitems; it += gridDim.x) lru_item<PASS>(p, l, c_begin + (it >> 2), it & 3, smem);
}

typedef __attribute__((ext_vector_type(4))) short s16x4;

__device__ __forceinline__ void ph_qknorm_rope2(const P& p, int l) {
  const int tid_ = tid_opaque();
  const int lane = tid_ & 63;
  const int wpb = blockDim.x >> 6;
  for (int pair = blockIdx.x * wpb + (tid_ >> 6); pair < TT * 28; pair += gridDim.x * wpb) {
    int t = pair / 28, slot = pair % 28;
    const float* g = nullptr; bool rope = false; float scale = 1.f;
    if (slot < 6) { g = p.win_qn + l * 64; rope = true; scale = QSCALE; }
    else if (slot < 8) { g = p.win_kn + l * 64; rope = true; }
    else if (slot < 10) { }
    else if (slot < 16) { g = p.na_qn + l * 64; scale = QSCALE; }
    else if (slot < 22) { g = p.na_kn + l * 64; }
    rope = rope && (t >= LC);
    const size_t idx = (size_t)t * DIN + 512 + slot * 64 + lane;
    float v = bf2f(p.projb[idx]);
    float y = v;
    if (g) {
      float ss = wave_sum(v * v);
      y = v * rsqrtf(ss * (1.f / 64.f) + EPS) * g[lane];
    }
    float partner = __shfl_xor(y, 16);
    if (rope) {
      int pos = t - LC, row = pos >> 6, col = pos & 63;
      int j = lane & 15, axis = lane >> 5;
      float inv = __expf(-(float)j * (1.f / 16.f) * 9.210340371976184f);
      float ang = (float)(axis ? col : row) * inv;
      float k = rintf(ang * 0.15915494309189535f);
      float r = fmaf(-k, 6.2831854820251465f, ang);
      r = fmaf(-k, -1.7484555e-07f, r);
      float cs = __cosf(r), sn = __sinf(r);
      bool first = ((lane >> 4) & 1) == 0;
      y = first ? (y * cs - partner * sn) : (partner * sn + y * cs);
    }
    p.projb[idx] = f2bf(y * scale);
  }
}

template <int CTRL, int RMASK>
__device__ __forceinline__ float dpp_mov_id(float v) {
  return __int_as_float(__builtin_amdgcn_update_dpp(__float_as_int(v), __float_as_int(v), CTRL, RMASK, 0xf, false));
}
__device__ __forceinline__ float wave_max(float v) {
  v = fmaxf(v, dpp_mov_id<0xB1, 0xf>(v));
  v = fmaxf(v, dpp_mov_id<0x4E, 0xf>(v));
  v = fmaxf(v, dpp_mov_id<0x141, 0xf>(v));
  v = fmaxf(v, dpp_mov_id<0x140, 0xf>(v));
  v = fmaxf(v, dpp_mov_id<0x142, 0xa>(v));
  v = fmaxf(v, dpp_mov_id<0x143, 0xc>(v));
  return __int_as_float(__builtin_amdgcn_readlane(__float_as_int(v), 63));
}

template <class TokFn>
__device__ __forceinline__ void kv_issue(const P& p, char* stage, int koff, int voff, TokFn tok, int wv, int lane) {
#pragma unroll
  for (int i = 0; i < 2; ++i) {
    const int row = 16 * wv + 8 * i + (lane >> 3);
    const bf16_t* src = p.projb + (size_t)tok(row) * DIN + (((lane & 7) ^ (row & 7)) << 3);
    char* dst = stage + (2 * wv + i) * 1024;
    __builtin_amdgcn_global_load_lds((const unsigned*)(src + koff), (__attribute__((address_space(3))) unsigned*)dst, 16, 0, 0);
    __builtin_amdgcn_global_load_lds((const unsigned*)(src + voff), (__attribute__((address_space(3))) unsigned*)(dst + 8192), 16, 0, 0);
  }
}
__device__ __forceinline__ void kv_wait(int rem) {
  if (rem >= 3) asm volatile("s_waitcnt vmcnt(8) lgkmcnt(0)" ::: "memory");
  else if (rem == 2) asm volatile("s_waitcnt vmcnt(4) lgkmcnt(0)" ::: "memory");
  else asm volatile("s_waitcnt vmcnt(0) lgkmcnt(0)" ::: "memory");
  __builtin_amdgcn_s_barrier();
}

template <class MaskFn>
__device__ __forceinline__ void attn_step2(const char* stage, int kr0, const bf16x8 (&qf)[2][2], f32x4 (&o)[2][4], float (&lsum)[2], MaskFn mb,
                                           int lane, bool act0, bool act1) {
  const int g = lane >> 4, lr = lane & 15;
  bf16x8 kf[2][2];
#pragma unroll
  for (int t2 = 0; t2 < 2; ++t2) {
    const int row = kr0 + 16 * t2 + lr;
#pragma unroll
    for (int s = 0; s < 2; ++s) kf[t2][s] = *(const bf16x8*)(stage + row * 128 + (((4 * s + g) ^ (row & 7)) << 4));
  }
  bf16x8 pb[2];
#pragma unroll
  for (int qt = 0; qt < 2; ++qt) {
    if (qt == 0 ? act0 : act1) {
      f32x4 st[2];
#pragma unroll
      for (int t2 = 0; t2 < 2; ++t2) {
        st[t2] = (f32x4){0.f, 0.f, 0.f, 0.f};
#pragma unroll
        for (int s = 0; s < 2; ++s) st[t2] = __builtin_amdgcn_mfma_f32_16x16x32_bf16(kf[t2][s], qf[qt][s], st[t2], 0, 0, 0);
      }
#pragma unroll
      for (int t2 = 0; t2 < 2; ++t2)
#pragma unroll
        for (int r = 0; r < 4; ++r) {
          float pv = exp2f(mb(qt, t2, r, st[t2][r]));
          lsum[qt] += pv;
          pb[qt][t2 * 4 + r] = (short)f2bf(pv);
        }
    }
  }
  const int q = lr >> 2, pp = lane & 3;
#pragma unroll
  for (int m = 0; m < 4; ++m) {
    bf16x8 vf;
#pragma unroll
    for (int t = 0; t < 2; ++t) {
      const int row = kr0 + 16 * t + 4 * g + q;
      const char* addr = stage + 8192 + row * 128 + (((2 * m + (pp >> 1)) ^ (row & 7)) << 4) + 8 * (pp & 1);
      s16x4 v4 = __builtin_amdgcn_ds_read_tr16_b64_v4i16((__attribute__((address_space(3))) s16x4*)addr);
      vf[4 * t + 0] = v4[0]; vf[4 * t + 1] = v4[1]; vf[4 * t + 2] = v4[2]; vf[4 * t + 3] = v4[3];
    }
    if (act0) o[0][m] = __builtin_amdgcn_mfma_f32_16x16x32_bf16(vf, pb[0], o[0][m], 0, 0, 0);
    if (act1) o[1][m] = __builtin_amdgcn_mfma_f32_16x16x32_bf16(vf, pb[1], o[1][m], 0, 0, 0);
  }
}

__device__ __forceinline__ void attn_store_out(const P& p, const f32x4 (&o)[4], float lsum, int tok, int col0, int lane) {
  const int g = lane >> 4;
  lsum += __shfl_xor(lsum, 16);
  lsum += __shfl_xor(lsum, 32);
  const float inv = 1.f / lsum;
  bf16_t* op = p.mixb + (size_t)tok * 1024 + col0 + 4 * g;
#pragma unroll
  for (int m = 0; m < 4; ++m)
    *(uint2*)(op + 16 * m) = make_uint2(pack2bf(o[m][0] * inv, o[m][1] * inv), pack2bf(o[m][2] * inv, o[m][3] * inv));
}

__device__ __forceinline__ void attn_win_item(const P& p, int l, int kind, int qb, int hs, char* smem) {
  const int tid = tid_opaque(), lane = tid & 63, wv = __builtin_amdgcn_readfirstlane(tid >> 6), g = lane >> 4, lr = lane & 15;
  int qoff, koff, voff, ooff; const float *gq, *gk; float sink2 = -1e30f; bool has_sink = false;
  if (kind == 0 || hs < 6) {
    const int h = hs, kvh = h / 3;
    qoff = OFF_QW + h * 64; koff = OFF_KW + kvh * 64; voff = OFF_VW + kvh * 64; ooff = 256 + h * 64;
    gq = p.win_qn + l * 64; gk = p.win_kn + l * 64; sink2 = p.win_sink[l * 6 + h] * LOG2E; has_sink = true;
  } else {
    const int h = hs - 6;
    qoff = OFF_QN + h * 64; koff = OFF_KN + h * 64; voff = OFF_VN + h * 64; ooff = 640 + h * 64;
    gq = p.na_qn + l * 64; gk = p.na_kn + l * 64;
  }
  float bound = 8.f * LOG2E * wave_max(fabsf(gq[lane])) * wave_max(fabsf(gk[lane])) * 1.0001f + 1e-3f;
  if (has_sink) bound = fmaxf(bound, sink2);
  const int q0 = qb * 128;
  const int qtok0 = (kind == 0 ? LC : 0) + q0 + 32 * wv;
  bf16x8 qf[2][2];
#pragma unroll
  for (int qt = 0; qt < 2; ++qt)
#pragma unroll
    for (int s = 0; s < 2; ++s) qf[qt][s] = *(const bf16x8*)(p.projb + (size_t)(qtok0 + 16 * qt + lr) * DIN + qoff + 32 * s + 8 * g);
  f32x4 o[2][4];
#pragma unroll
  for (int qt = 0; qt < 2; ++qt)
#pragma unroll
    for (int m = 0; m < 4; ++m) o[qt][m] = (f32x4){0.f, 0.f, 0.f, 0.f};
  float lsum[2] = {0.f, 0.f};
  const int nloc = (kind == 0) ? 6 : 0, nch = nloc + 4;
  auto tokfn = [&](int c) {
    return [=](int row) {
      if (c < nloc) { int pos = q0 - 128 + 64 * c + row; pos = pos < 0 ? 0 : (pos > SEQ - 1 ? SEQ - 1 : pos); return LC + pos; }
      return 64 * (c - nloc) + row;
    };
  };
  __syncthreads();
  kv_issue(p, smem, koff, voff, tokfn(0), wv, lane);
  kv_issue(p, smem + 16384, koff, voff, tokfn(1), wv, lane);
  kv_issue(p, smem + 32768, koff, voff, tokfn(2), wv, lane);
  for (int c = 0; c < nch; ++c) {
    kv_wait(nch - c);
    if (c + 3 < nch) kv_issue(p, smem + ((c + 3) & 3) * 16384, koff, voff, tokfn(c + 3), wv, lane);
    const char* stage = smem + (c & 3) * 16384;
    if (c < nloc) {
      const int qw0 = q0 + 32 * wv;
#pragma unroll
      for (int st = 0; st < 2; ++st) {
        const int kbase = q0 - 128 + 64 * c + 32 * st;
        const bool a0 = !(kbase - (qw0 + 15) > 128 || qw0 - (kbase + 31) > 128) && (kbase + 31 >= 0) && (kbase < SEQ);
        const bool a1 = !(kbase - (qw0 + 31) > 128 || (qw0 + 16) - (kbase + 31) > 128) && (kbase + 31 >= 0) && (kbase < SEQ);
        if (a0 || a1)
          attn_step2(stage, 32 * st, qf, o, lsum, [&](int qt, int t2, int r, float s) {
            int kpos = kbase + 16 * t2 + 4 * g + r;
            int dlt = kpos - (qw0 + 16 * qt + lr); dlt = dlt < 0 ? -dlt : dlt;
            bool valid = (kpos >= 0) && (kpos < SEQ) && (dlt <= 128);
            return valid ? s - bound : -1e30f;
          }, lane, a0, a1);
      }
    } else {
#pragma unroll
      for (int st = 0; st < 2; ++st)
        attn_step2(stage, 32 * st, qf, o, lsum, [&](int qt, int t2, int r, float s) { return s - bound; }, lane, true, true);
    }
  }
#pragma unroll
  for (int qt = 0; qt < 2; ++qt) {
    float ls = lsum[qt];
    if (has_sink && g == 0) ls += exp2f(sink2 - bound);
    attn_store_out(p, o[qt], ls, qtok0 + 16 * qt + lr, ooff, lane);
  }
}

__device__ __forceinline__ void attn_na_item(const P& p, int l, int rp, int h, char* smem) {
  const int tid = tid_opaque(), lane = tid & 63, wv = __builtin_amdgcn_readfirstlane(tid >> 6), g = lane >> 4, lr = lane & 15;
  const int qoff = OFF_QN + h * 64, koff = OFF_KN + h * 64, voff = OFF_VN + h * 64, ooff = 640 + h * 64;
  float* rpbl = (float*)(smem + 65536);
  const float* rpbg = p.rpb + (size_t)(l * 6 + h) * 465;
  float bmax = 0.f;
  __syncthreads();
  for (int i = tid; i < 465; i += 256) rpbl[i] = rpbg[i] * LOG2E;
  for (int i = lane; i < 465; i += 64) bmax = fmaxf(bmax, fabsf(rpbg[i]) * LOG2E);
  bmax = wave_max(bmax);
  const float bound = 8.f * LOG2E * wave_max(fabsf(p.na_qn[l * 64 + lane])) * wave_max(fabsf(p.na_kn[l * 64 + lane])) * 1.0001f + bmax + 1e-3f;
  const int r0 = 2 * rp;
  const int qcol = 16 * wv + lr;
  const int qtok0 = LC + r0 * 64 + qcol;
  const int kra = min(max(r0 - 4, 0), 248), krb = min(max(r0 + 1 - 4, 0), 248);
  const int nrow = krb + 8 - kra, nch = nrow + 4;
  const int kc0 = min(max(16 * wv - 8, 0), 32);
  const int qs = min(max(qcol - 8, 0), 48);
  bf16x8 qf[2][2];
#pragma unroll
  for (int qt = 0; qt < 2; ++qt)
#pragma unroll
    for (int s = 0; s < 2; ++s) qf[qt][s] = *(const bf16x8*)(p.projb + (size_t)(qtok0 + 64 * qt) * DIN + qoff + 32 * s + 8 * g);
  f32x4 o[2][4];
#pragma unroll
  for (int qt = 0; qt < 2; ++qt)
#pragma unroll
    for (int m = 0; m < 4; ++m) o[qt][m] = (f32x4){0.f, 0.f, 0.f, 0.f};
  float lsum[2] = {0.f, 0.f};
  auto tokfn = [&](int c) {
    return [=](int row) { return c < nrow ? LC + (kra + c) * 64 + row : 64 * (c - nrow) + row; };
  };
  kv_issue(p, smem, koff, voff, tokfn(0), wv, lane);
  kv_issue(p, smem + 16384, koff, voff, tokfn(1), wv, lane);
  kv_issue(p, smem + 32768, koff, voff, tokfn(2), wv, lane);
  for (int c = 0; c < nch; ++c) {
    kv_wait(nch - c);
    if (c + 3 < nch) kv_issue(p, smem + ((c + 3) & 3) * 16384, koff, voff, tokfn(c + 3), wv, lane);
    const char* stage = smem + (c & 3) * 16384;
    if (c < nrow) {
      const int krow = kra + c;
      const bool a0 = krow < kra + 8, a1 = krow >= krb;
      attn_step2(stage, kc0, qf, o, lsum, [&](int qt, int t2, int rr, float s) {
        int kcol = kc0 + 16 * t2 + 4 * g + rr;
        bool valid = (kcol >= qs) && (kcol < qs + 16);
        int dc = kcol - qcol + 15; dc = dc < 0 ? 0 : (dc > 30 ? 30 : dc);
        int dr = krow - (r0 + qt) + 7; dr = dr < 0 ? 0 : (dr > 14 ? 14 : dr);
        return valid ? s + rpbl[dr * 31 + dc] - bound : -1e30f;
      }, lane, a0, a1);
    } else {
#pragma unroll
      for (int st = 0; st < 2; ++st)
        attn_step2(stage, 32 * st, qf, o, lsum, [&](int qt, int t2, int rr, float s) { return s - bound; }, lane, true, true);
    }
  }
#pragma unroll
  for (int qt = 0; qt < 2; ++qt) attn_store_out(p, o[qt], lsum[qt], qtok0 + 64 * qt, ooff, lane);
}

__device__ __forceinline__ void ph_attn(const P& p, int l, char* smem) {
  const int nitems = 1536 + (l == 0 ? 24 : 0);
  for (int it = blockIdx.x; it < nitems; it += gridDim.x) {
    if (it < 768) attn_win_item(p, l, 0, it / 6, it % 6, smem);
    else if (it < 1536) { int j = it - 768; attn_na_item(p, l, j / 6, j % 6, smem); }
    else { int j = it - 1536; attn_win_item(p, l, 1, j / 12, j % 12, smem); }
  }
}

__device__ __forceinline__ unsigned ord_key(float s) {
  unsigned u = __float_as_uint(s);
  return (u & 0x80000000u) ? ~u : (u | 0x80000000u);
}
__device__ __forceinline__ float ord_val(unsigned pk) {
  unsigned u = pk & ~127u;
  unsigned b = (u & 0x80000000u) ? (u & 0x7fffffffu) : ~u;
  return __uint_as_float(b);
}
__device__ __forceinline__ void ce_desc(unsigned& a, unsigned& b) {
  unsigned mx = a > b ? a : b, mn = a > b ? b : a;
  a = mx; b = mn;
}
__device__ __forceinline__ void sort16_desc(unsigned (&v)[16]) {
#pragma unroll
  for (int k = 2; k <= 16; k <<= 1) {
#pragma unroll
    for (int j = k >> 1; j > 0; j >>= 1) {
#pragma unroll
      for (int i = 0; i < 16; ++i) {
        int m = i ^ j;
        if (m > i) {
          if ((i & k) == 0) ce_desc(v[i], v[m]); else ce_desc(v[m], v[i]);
        }
      }
    }
  }
}
__device__ __forceinline__ void merge16_desc(unsigned (&a)[16], const unsigned (&b)[16]) {
#pragma unroll
  for (int i = 0; i < 16; ++i) { unsigned o = b[15 - i]; a[i] = a[i] > o ? a[i] : o; }
#pragma unroll
  for (int j = 8; j > 0; j >>= 1) {
#pragma unroll
    for (int i = 0; i < 16; ++i) {
      int m = i ^ j;
      if (m > i) ce_desc(a[i], a[m]);
    }
  }
}

typedef __attribute__((ext_vector_type(2))) float f32x2;
__device__ __forceinline__ void ph_prep_peer(const P& p) {
  const int tid = tid_opaque(), lane = tid & 63;
  const int nw = gridDim.x * 4;
  for (int row = blockIdx.x * 4 + (tid >> 6); row < 4 * 16384; row += nw) {
    const int tbl = row >> 15, le = row & 32767;
    const float4* src = (const float4*)((tbl ? p.pv : p.pu) + (size_t)le * 1024) + lane * 4;
    float4 v[4];
    float am = 0.f;
#pragma unroll
    for (int i = 0; i < 4; ++i) {
      v[i] = src[i];
      am = fmaxf(am, fmaxf(fmaxf(fabsf(v[i].x), fabsf(v[i].y)), fmaxf(fabsf(v[i].z), fabsf(v[i].w))));
    }
    am = wave_max(am);
    const float sc = am > 0.f ? 224.f / am : 1.f;
    unsigned w[4];
#pragma unroll
    for (int i = 0; i < 4; ++i) {
      int t = __builtin_amdgcn_cvt_pk_fp8_f32(v[i].x * sc, v[i].y * sc, 0, false);
      t = __builtin_amdgcn_cvt_pk_fp8_f32(v[i].z * sc, v[i].w * sc, t, true);
      w[i] = (unsigned)t;
    }
    {
      const int ll = le >> 14, e = le & 16383;
      unsigned char* dst = (tbl ? p.vb8 : p.ub8) + (((size_t)ll * 8 + (lane >> 3)) * 16384 + e) * 128 + (lane & 7) * 16;
      *(uint4*)dst = make_uint4(w[0], w[1], w[2], w[3]);
    }
    if (lane == 0) (tbl ? p.vsc : p.usc)[le] = am > 0.f ? am / 224.f : 1.f;
  }
  for (int i = GTID; i < 2 * 128 * 128; i += GSZ) { p.k1b[i] = f2bf(p.k1[i]); p.k2b[i] = f2bf(p.k2[i]); }
}

struct EpiPeerTopk {
  int l;
  __device__ __forceinline__ void operator()(const P& p, f32x4 (&acc)[4][4], int m0, int n0, int wm, int wn, int lane, char* smem) const {
    const int tid = ((wm * 2 + wn) << 6) | lane, g = lane >> 4, lr = lane & 15;
    const int nt = n0 >> 7, head = nt >> 1, hf = nt & 1;
    char* qimg = smem;
    char* kimg = smem + 34816;
    float* rinvl = (float*)(smem + 69632);
    if (tid < 128) {
      float s = 0.f;
#pragma unroll
      for (int q = 0; q < 8; ++q) s += p.rowss[(size_t)q * TT + m0 + tid];
      rinvl[tid] = rsqrtf(s * (1.f / 1024.f) + EPS);
    }
    __syncthreads();
    {
      const float* bq = p.bq + (l * 2 + (m0 < LC ? 1 : 0)) * NPQ + n0 + wn * 64 + lr;
      float bqv[4];
#pragma unroll
      for (int j = 0; j < 4; ++j) bqv[j] = bq[16 * j];
      char* qw = qimg + (wm * 64 + 4 * g) * 272 + (wn * 64 + lr) * 2;
#pragma unroll
      for (int i = 0; i < 4; ++i)
#pragma unroll
        for (int r = 0; r < 4; ++r) {
          const float rv = rinvl[wm * 64 + 16 * i + 4 * g + r];
#pragma unroll
          for (int j = 0; j < 4; ++j) *(bf16_t*)(qw + (16 * i + r) * 272 + 32 * j) = f2bf(acc[i][j][r] * rv + bqv[j]);
        }
      const bf16_t* kk = (hf ? p.k2b : p.k1b) + (size_t)l * 16384 + (tid >> 4) * 128 + (tid & 15) * 8;
      char* kw = kimg + (tid >> 4) * 272 + (tid & 15) * 16;
#pragma unroll
      for (int i = 0; i < 8; ++i) *(uint4*)(kw + i * 16 * 272) = *(const uint4*)(kk + i * 16 * 128);
    }
    __syncthreads();
#pragma unroll
    for (int i = 0; i < 4; ++i)
#pragma unroll
      for (int j = 0; j < 4; ++j) acc[i][j] = (f32x4){0.f, 0.f, 0.f, 0.f};
    {
      const char* qa = qimg + (wm * 64 + lr) * 272 + g * 16;
      const char* kb = kimg + (wn * 64 + lr) * 272 + g * 16;
#pragma unroll
      for (int s = 0; s < 4; ++s) {
        bf16x8 af[4], bfr[4];
#pragma unroll
        for (int i = 0; i < 4; ++i) af[i] = *(const bf16x8*)(qa + i * 16 * 272 + s * 64);
#pragma unroll
        for (int j = 0; j < 4; ++j) bfr[j] = *(const bf16x8*)(kb + j * 16 * 272 + s * 64);
#pragma unroll
        for (int i = 0; i < 4; ++i)
#pragma unroll
          for (int j = 0; j < 4; ++j) acc[i][j] = __builtin_amdgcn_mfma_f32_16x16x32_bf16(af[i], bfr[j], acc[i][j], 0, 0, 0);
      }
    }
    __syncthreads();
    unsigned* simg = (unsigned*)smem;
    {
      unsigned* sw = simg + (wm * 64 + 4 * g) * 129 + wn * 64 + lr;
#pragma unroll
      for (int i = 0; i < 4; ++i)
#pragma unroll
        for (int r = 0; r < 4; ++r)
#pragma unroll
          for (int j = 0; j < 4; ++j)
            sw[(16 * i + r) * 129 + 16 * j] = (ord_key(acc[i][j][r]) & ~127u) | (unsigned)(wn * 64 + 16 * j + lr);
    }
    __syncthreads();
    const int row = tid & 127, half = tid >> 7;
    unsigned top[16];
    {
      const unsigned* sr = simg + row * 129 + half * 64;
#pragma unroll
      for (int k = 0; k < 16; ++k) top[k] = sr[k];
      sort16_desc(top);
#pragma unroll 1
      for (int gi = 1; gi < 4; ++gi) {
        unsigned v1[16];
#pragma unroll
        for (int k = 0; k < 16; ++k) v1[k] = sr[gi * 16 + k];
        sort16_desc(v1);
        merge16_desc(top, v1);
      }
    }
    __syncthreads();
    if (half == 1) {
#pragma unroll
      for (int k = 0; k < 16; ++k) simg[k * 128 + row] = top[k];
    }
    __syncthreads();
    if (half == 0) {
      unsigned o[16];
#pragma unroll
      for (int k = 0; k < 16; ++k) o[k] = simg[k * 128 + row];
      merge16_desc(top, o);
      uint4* dst = (uint4*)(p.pk + (((size_t)(m0 + row) * 8 + head) * 2 + hf) * 16);
#pragma unroll
      for (int k = 0; k < 4; ++k) dst[k] = make_uint4(top[4 * k], top[4 * k + 1], top[4 * k + 2], top[4 * k + 3]);
    }
  }
};

__device__ const unsigned char CAND_A[64] = {0,0,0,0,0,0,0,0,0,0,0,0,0,0,0,0, 1,1,1,1,1,1,1,1, 2,2,2,2,2, 3,3,3,3, 4,4,4, 5,5, 6,6, 7,7,
                                             8,9,10,11,12,13,14,15, 0,0,0,0,0,0,0,0,0,0,0,0,0,0};
__device__ const unsigned char CAND_B[64] = {0,1,2,3,4,5,6,7,8,9,10,11,12,13,14,15, 0,1,2,3,4,5,6,7, 0,1,2,3,4, 0,1,2,3, 0,1,2, 0,1, 0,1, 0,1,
                                             0,0,0,0,0,0,0,0, 0,0,0,0,0,0,0,0,0,0,0,0,0,0};

__device__ __forceinline__ void ph_peer_merge(const P& p, int l, int t0, char* smem) {
  const int tid = tid_opaque(), lane = tid & 63, wv = tid >> 6;
  const float* n2g = p.norm2_g + l * 1024;
  const int ca = CAND_A[lane], cb = CAND_B[lane];
  for (int tk = t0 + blockIdx.x * 4 + wv; tk < TT; tk += gridDim.x * 4) {
    const float* mod = p.mod + (l * 2 + (tk < LC ? 1 : 0)) * 6144;
    unsigned p1[8], p2[8];
    {
      const unsigned* pk = p.pk + (size_t)tk * 256;
#pragma unroll
      for (int head = 0; head < 8; ++head) { p1[head] = pk[head * 32 + ca]; p2[head] = pk[head * 32 + 16 + cb]; }
    }
    {
      const float4* xp = (const float4*)(p.xall + (size_t)tk * 1024) + lane * 4;
      float4 v[4];
      float ss = 0.f;
#pragma unroll
      for (int q = 0; q < 4; ++q) { v[q] = xp[q]; ss += v[q].x * v[q].x + v[q].y * v[q].y + v[q].z * v[q].z + v[q].w * v[q].w; }
      ss = wave_sum(ss);
      const float rinv = rsqrtf(ss * (1.f / 1024.f) + EPS);
      uint2* hp = (uint2*)(p.hb + (size_t)tk * 1024) + lane * 4;
#pragma unroll
      for (int q = 0; q < 4; ++q) {
        float4 gg = ((const float4*)n2g)[lane * 4 + q], sc = ((const float4*)(mod + 4096))[lane * 4 + q], sh = ((const float4*)(mod + 3072))[lane * 4 + q];
        float h0 = v[q].x * rinv * gg.x * (1.f + sc.x) + sh.x, h1 = v[q].y * rinv * gg.y * (1.f + sc.y) + sh.y;
        float h2 = v[q].z * rinv * gg.z * (1.f + sc.z) + sh.z, h3 = v[q].w * rinv * gg.w * (1.f + sc.w) + sh.w;
        hp[q] = make_uint2(pack2bf(h0, h1), pack2bf(h2, h3));
      }
    }
    float sums[8];
    unsigned* candk = (unsigned*)smem + wv * 512;
#pragma unroll
    for (int head = 0; head < 8; ++head) {
      sums[head] = lane < 50 ? ord_val(p1[head]) + ord_val(p2[head]) : -3.0e38f;
      candk[head * 64 + lane] = (ord_key(sums[head]) & ~63u) | (unsigned)(63 - lane);
    }
#pragma unroll
    for (int head = 0; head < 8; ++head) {
      const float sum = sums[head];
      const unsigned kme = (ord_key(sum) & ~63u) | (unsigned)(63 - lane);
      int eid = (int)(p1[head] & 127u) * 128 + (int)(p2[head] & 127u);
      int rank = 0;
#pragma unroll
      for (int m4 = 0; m4 < 13; ++m4) {
        const uint4 km = *(const uint4*)(candk + head * 64 + 4 * m4);
        rank += (km.x > kme) ? 1 : 0;
        rank += (km.y > kme) ? 1 : 0;
        rank += (km.z > kme) ? 1 : 0;
        rank += (km.w > kme) ? 1 : 0;
      }
      float mx = wave_max(sum);
      bool sel = (lane < 50) && (rank < 16);
      float e = sel ? __expf(sum - mx) : 0.f;
      float tot = wave_sum(e);
      if (sel) {
        const int n = head * 16 + rank, idx = (n & 7) * 16 + (n >> 3);
        p.el[(size_t)tk * 128 + idx] = eid;
        p.gl[(size_t)tk * 128 + idx] = e / tot;
      }
    }
  }
}

struct XcdWork { int li, np, rank, nloc; };

__device__ __forceinline__ XcdWork load_xw(const float* smem) {
  const volatile LAS unsigned* st = (const volatile LAS unsigned*)(smem + 18432);
  XcdWork xw;
  xw.nloc = __builtin_amdgcn_readfirstlane((int)st[0]); xw.np = __builtin_amdgcn_readfirstlane((int)st[1]);
  xw.rank = __builtin_amdgcn_readfirstlane((int)st[2]); xw.li = __builtin_amdgcn_readfirstlane((int)st[3]);
  return xw;
}
__device__ __forceinline__ void ph_peer_s1(const P& p, int l, int t0, const XcdWork& xw) {
  const int tid = tid_opaque(), lane = tid & 63, wv = tid >> 6, j = lane >> 3, k = lane & 7;
  const unsigned char* U = p.ub8 + (size_t)l * 16384 * 1024;
  const int step = xw.nloc * 4;
  for (int s = xw.li; s < 8; s += xw.np) {
    const unsigned roff = 128u * s + 16u * k;
    const unsigned char* Us = U + (size_t)s * 16384 * 128 + 16 * k;
    const int tk0 = t0 + xw.rank * 4 + wv;
    if (tk0 >= TT) continue;
    uint4 ur[2][16]; uint4 hh[2][2]; int4 en[4];
#define S1_LOAD_LIST(TK) { const int4* ep = (const int4*)(p.el + (size_t)(TK) * 128 + j * 16); _Pragma("unroll") for (int q = 0; q < 4; ++q) en[q] = ep[q]; }
#define S1_ISSUE(B, TK) {                                                                            \
      _Pragma("unroll") for (int q = 0; q < 4; ++q) {                                                \
        ur[B][4 * q + 0] = *(const uint4*)(Us + ((unsigned)en[q].x * 128u));                  \
        ur[B][4 * q + 1] = *(const uint4*)(Us + ((unsigned)en[q].y * 128u));                  \
        ur[B][4 * q + 2] = *(const uint4*)(Us + ((unsigned)en[q].z * 128u));                  \
        ur[B][4 * q + 3] = *(const uint4*)(Us + ((unsigned)en[q].w * 128u));                  \
      }                                                                                              \
      const uint4* hp = (const uint4*)(p.hb + (size_t)(TK) * 1024 + roff);                           \
      hh[B][0] = hp[0]; hh[B][1] = hp[1]; }
#define S1_CONSUME(B, TK) {                                                                          \
      float hv[16];                                                                                  \
      { unsigned w[8] = {hh[B][0].x, hh[B][0].y, hh[B][0].z, hh[B][0].w, hh[B][1].x, hh[B][1].y, hh[B][1].z, hh[B][1].w}; \
        _Pragma("unroll") for (int q = 0; q < 8; ++q) { hv[2 * q] = __uint_as_float(w[q] << 16); hv[2 * q + 1] = __uint_as_float(w[q] & 0xffff0000u); } } \
      float keep0 = 0.f, keep1 = 0.f;                                                                \
      _Pragma("unroll") for (int i = 0; i < 16; ++i) {                                               \
        unsigned w[4] = {ur[B][i].x, ur[B][i].y, ur[B][i].z, ur[B][i].w};                            \
        float dot = 0.f;                                                                             \
        _Pragma("unroll") for (int q = 0; q < 4; ++q) {                                              \
          f32x2 lo = __builtin_amdgcn_cvt_pk_f32_fp8((int)w[q], false), hi = __builtin_amdgcn_cvt_pk_f32_fp8((int)w[q], true); \
          dot += lo[0] * hv[q * 4] + lo[1] * hv[q * 4 + 1] + hi[0] * hv[q * 4 + 2] + hi[1] * hv[q * 4 + 3]; \
        }                                                                                            \
        dot += dpp_row<0xB1>(dot); dot += dpp_row<0x4E>(dot); dot += dpp_row<0x141>(dot);            \
        if (i < 8) keep0 = (k == i) ? dot : keep0; else keep1 = (k == i - 8) ? dot : keep1;          \
      }                                                                                              \
      float* pd = p.pd + ((size_t)s * TT + (TK)) * 128;                                              \
      pd[8 * k + j] = keep0; pd[8 * (k + 8) + j] = keep1; }
    S1_LOAD_LIST(tk0)
    S1_ISSUE(0, tk0)
    if (tk0 + step < TT) S1_LOAD_LIST(tk0 + step)
    for (int tk = tk0; tk < TT; tk += 2 * step) {
      const bool has1 = tk + step < TT, has2 = tk + 2 * step < TT;
      if (has1) { S1_ISSUE(1, tk + step) if (has2) S1_LOAD_LIST(tk + 2 * step) }
      S1_CONSUME(0, tk)
      if (has1) {
        if (has2) { S1_ISSUE(0, tk + 2 * step) if (tk + 3 * step < TT) S1_LOAD_LIST(tk + 3 * step) }
        S1_CONSUME(1, tk + step)
      }
    }
#undef S1_LOAD_LIST
#undef S1_ISSUE
#undef S1_CONSUME
  }
}

__device__ __forceinline__ void ph_peer_r(const P& p, int l, int t0) {
  const float* usc = p.usc + l * 16384;
  const float* vsc = p.vsc + l * 16384;
  for (int idx = GTID; idx < (TT - t0) * 32; idx += GSZ) {
    const int tk = t0 + (idx >> 5), n0 = (idx & 31) * 4;
    float4 d = make_float4(0.f, 0.f, 0.f, 0.f);
#pragma unroll
    for (int s = 0; s < 8; ++s) {
      const float4 v = *(const float4*)(p.pd + ((size_t)s * TT + tk) * 128 + n0);
      d.x += v.x; d.y += v.y; d.z += v.z; d.w += v.w;
    }
    float dv[4] = {d.x, d.y, d.z, d.w};
#pragma unroll
    for (int q = 0; q < 4; ++q) {
      const int n = n0 + q, li = (n & 7) * 16 + (n >> 3);
      const int ex = p.el[(size_t)tk * 128 + li];
      p.av[(size_t)tk * 128 + li] = p.gl[(size_t)tk * 128 + li] * gelu_f(dv[q] * usc[ex]) * vsc[ex];
    }
  }
}

__device__ __forceinline__ void ph_peer_s2(const P& p, int l, int t0, const XcdWork& xw, char* smem) {
  const int tid = tid_opaque(), lane = tid & 63, wv = tid >> 6, j = lane >> 3, k = lane & 7;
  const int ko = lane >> 3, jo = lane & 7;
  float* red = (float*)smem + wv * 1024;
  const unsigned char* V = p.vb8 + (size_t)l * 16384 * 1024;
  const int step = xw.nloc * 4;
  for (int s = xw.li; s < 8; s += xw.np) {
    const unsigned char* Vs = V + (size_t)s * 16384 * 128 + 16 * k;
    const int dim = 128 * s + 16 * ko + 2 * jo;
    int tk = t0 + xw.rank * 4 + wv;
    int4 en[4];
    if (tk < TT) {
      const int4* ep = (const int4*)(p.el + (size_t)tk * 128 + j * 16);
#pragma unroll
      for (int q = 0; q < 4; ++q) en[q] = ep[q];
    }
    for (; tk < TT; tk += step) {
      uint4 vr[16];
#pragma unroll
      for (int q = 0; q < 4; ++q) {
        vr[4 * q + 0] = *(const uint4*)(Vs + ((unsigned)en[q].x * 128u));
        vr[4 * q + 1] = *(const uint4*)(Vs + ((unsigned)en[q].y * 128u));
        vr[4 * q + 2] = *(const uint4*)(Vs + ((unsigned)en[q].z * 128u));
        vr[4 * q + 3] = *(const uint4*)(Vs + ((unsigned)en[q].w * 128u));
      }
      float4 an[4];
      {
        const float4* ap = (const float4*)(p.av + (size_t)tk * 128 + j * 16);
#pragma unroll
        for (int q = 0; q < 4; ++q) an[q] = ap[q];
      }
      const float* mod = p.mod + (l * 2 + (tk < LC ? 1 : 0)) * 6144;
      const float2 g2 = *(const float2*)(mod + 5120 + dim);
      const float2 xin = *(const float2*)(p.xall + (size_t)tk * 1024 + dim);
      if (tk + step < TT) {
        const int4* ep = (const int4*)(p.el + (size_t)(tk + step) * 128 + j * 16);
#pragma unroll
        for (int q = 0; q < 4; ++q) en[q] = ep[q];
      }
      float acc[16];
#pragma unroll
      for (int d = 0; d < 16; ++d) acc[d] = 0.f;
#pragma unroll
      for (int i = 0; i < 16; ++i) {
        const float a = (i & 3) == 0 ? an[i >> 2].x : (i & 3) == 1 ? an[i >> 2].y : (i & 3) == 2 ? an[i >> 2].z : an[i >> 2].w;
        unsigned y[4] = {vr[i].x, vr[i].y, vr[i].z, vr[i].w};
#pragma unroll
        for (int q = 0; q < 4; ++q) {
          f32x2 lo = __builtin_amdgcn_cvt_pk_f32_fp8((int)y[q], false), hi = __builtin_amdgcn_cvt_pk_f32_fp8((int)y[q], true);
          acc[q * 4] += a * lo[0]; acc[q * 4 + 1] += a * lo[1]; acc[q * 4 + 2] += a * hi[0]; acc[q * 4 + 3] += a * hi[1];
        }
        if (i + 1 < 16) asm volatile("" : "+v"(acc[0]), "+v"(vr[i + 1].x), "+v"(vr[i + 1].y), "+v"(vr[i + 1].z), "+v"(vr[i + 1].w));
      }
#pragma unroll
      for (int q = 0; q < 4; ++q) *(float4*)(red + lane * 16 + 4 * q) = make_float4(acc[4 * q], acc[4 * q + 1], acc[4 * q + 2], acc[4 * q + 3]);
      float f0 = 0.f, f1 = 0.f;
#pragma unroll
      for (int jj = 0; jj < 8; ++jj) {
        const float2 t = *(const float2*)(red + (jj * 8 + ko) * 16 + 2 * jo);
        f0 += t.x; f1 += t.y;
      }
      float2 o = make_float2(xin.x + g2.x * f0, xin.y + g2.y * f1);
      if (l == 1) *(float2*)(p.out + (size_t)(tk - LC) * 1024 + dim) = o;
      else *(float2*)(p.xall + (size_t)tk * 1024 + dim) = o;
    }
  }
}

#define XB_TMO      128
#define XB_XCNT(j)  (256  + 64 * (j))
#define XB_XSUB(j)  (1280 + 64 * (j))
#define XB_XGEN(j)  (2304 + 64 * (j))
#define XB_TOP      3328
#define XB_TOPGEN   3392
#define XB_RANK(j)  (3456 + 64 * (j))
#define XCD_BAR_WORDS 4480
#define XB_SPIN_CAP (1u << 22)
__device__ __forceinline__ unsigned xb_ld(unsigned* q) { return __hip_atomic_load(q, __ATOMIC_RELAXED, __HIP_MEMORY_SCOPE_AGENT); }
__device__ __forceinline__ unsigned xb_add(unsigned* q, unsigned v) { return __hip_atomic_fetch_add(q, v, __ATOMIC_RELAXED, __HIP_MEMORY_SCOPE_AGENT); }
__device__ __forceinline__ unsigned xb_xcc_id() { return (unsigned)__builtin_amdgcn_s_getreg((3 << 11) | 20) & 0xFu; }
#define XB_SPIN(cond, bar) do { unsigned _sp = 0; while (cond) { __builtin_amdgcn_s_sleep(1); \
    if ((++_sp & 255u) == 0u) { if (xb_ld(&(bar)[XB_TMO])) break; if (_sp > XB_SPIN_CAP) { atomicAdd(&(bar)[XB_TMO], 1u); break; } } } } while (0)
struct XcdBarrier { unsigned* bar; unsigned x; volatile LAS unsigned* st; };
__device__ __forceinline__ XcdBarrier xcd_barrier_post(unsigned* bar, volatile LAS unsigned* st) {
  XcdBarrier b; b.bar = bar; b.x = xb_xcc_id(); b.st = st;
  if (threadIdx.x == 0) { (void)xb_add(&bar[XB_XCNT(b.x)], 1u); st[2] = xb_add(&bar[XB_RANK(b.x)], 1u); }
  return b;
}
__device__ __forceinline__ void xcd_barrier_complete(unsigned* bar, unsigned x, unsigned& nloc, unsigned& nx, unsigned& li) {
  const unsigned G = gridDim.x * gridDim.y * gridDim.z;
  unsigned sum, cnt, mine, below, sp = 0u;
  for (;;) {
    sum = 0u; cnt = 0u; mine = 0u; below = 0u;
#pragma unroll
    for (unsigned j = 0; j < 16; ++j) { const unsigned c = xb_ld(&bar[XB_XCNT(j)]); sum += c; cnt += (c > 0u) ? 1u : 0u; mine = (j == x) ? c : mine; below += (j < x && c > 0u) ? 1u : 0u; }
    if (sum == G) break;
    __builtin_amdgcn_s_sleep(1);
    if ((++sp & 255u) == 0u) { if (xb_ld(&bar[XB_TMO])) break; if (sp > XB_SPIN_CAP) { atomicAdd(&bar[XB_TMO], 1u); break; } }
  }
  nloc = mine > 0u ? mine : 1u; nx = cnt > 0u ? cnt : 1u; li = below;
}
__device__ __forceinline__ void xcd_barrier(const XcdBarrier& b) {
  asm volatile("s_waitcnt vmcnt(0)" ::: "memory");
  __syncthreads();
  if (threadIdx.x == 0) {
    unsigned* bar = b.bar;
    __builtin_amdgcn_s_waitcnt(0);
    unsigned nloc = b.st[0], nx = b.st[1];
    if (nloc == 0u) { unsigned li; xcd_barrier_complete(bar, b.x, nloc, nx, li); b.st[0] = nloc; b.st[1] = nx; b.st[3] = li; }
    const unsigned old = xb_add(&bar[XB_XSUB(b.x)], 1u);
    const unsigned gen = old / nloc;
    if (old + 1u == (gen + 1u) * nloc) {
      __builtin_amdgcn_fence(__ATOMIC_RELEASE, "agent");
      asm volatile("s_waitcnt vmcnt(0)" ::: "memory");
      const unsigned og = xb_add(&bar[XB_TOP], 1u);
      const unsigned tg = og / nx;
      if (og + 1u == (tg + 1u) * nx) xb_add(&bar[XB_TOPGEN], 1u);
      else XB_SPIN(xb_ld(&bar[XB_TOPGEN]) == tg, bar);
      __builtin_amdgcn_fence(__ATOMIC_ACQUIRE, "agent");
      xb_add(&bar[XB_XGEN(b.x)], 1u);
      asm volatile("s_waitcnt vmcnt(0)" ::: "memory");
    } else {
      XB_SPIN(xb_ld(&bar[XB_XGEN(b.x)]) == gen, bar);
      __builtin_amdgcn_fence(__ATOMIC_ACQUIRE, "agent");
      asm volatile("s_waitcnt vmcnt(0)" ::: "memory");
    }
  }
  __syncthreads();
}

#ifndef PROBE_IV
#define PROBE_IV -1
#endif
__device__ __forceinline__ void probe_tick(int& cnt, unsigned long long* slots) {
  if (PROBE_IV >= 0) {
    if (threadIdx.x == 0 && (cnt == PROBE_IV || cnt == PROBE_IV + 1)) slots[cnt - PROBE_IV] = __builtin_amdgcn_s_memrealtime();
    cnt = __builtin_amdgcn_readfirstlane(cnt + 1);
  }
}
#define BARRIER() do { XcdBarrier xb_; xb_.bar = PP.bar; xb_.x = xb_xcc_id(); xb_.st = (volatile LAS unsigned*)(smem + 18432); xcd_barrier(xb_); probe_tick(pcnt, probe_t); } while (0)

typedef const __attribute__((address_space(4))) P* KP;
__device__ __forceinline__ P load_params(KP kp) {
#if defined(__HIP_DEVICE_COMPILE__)
  asm volatile("" : "+s"(kp));
  return *kp;
#else
  return P{};
#endif
}
#define PP load_params(kp)
__global__ void __launch_bounds__(256, 2) k_mega(P p_unused) {
  KP kp = (KP)__builtin_amdgcn_kernarg_segment_ptr();
  __shared__ __attribute__((aligned(16))) float smem[18432 + 8];
  uint4& xb_words = *(uint4*)(smem + 18432);
  cg::grid_group grid = cg::this_grid();
  if (threadIdx.x == 0) xb_words = make_uint4(0u, 0u, 0u, 0u);
  __syncthreads();
  unsigned long long* probe_t = (unsigned long long*)(smem + 18436);
  int pcnt = 0;
  asm volatile("" : "+s"(pcnt));
  probe_tick(pcnt, probe_t);
  ph_mod(PP, smem);
  ph_prep(PP, smem);
  ph_lru_prepw(PP);
  ph_rope_tab(PP);
  ph_prep_peer(PP);
  grid.sync();
  probe_tick(pcnt, probe_t);
  (void)xcd_barrier_post(PP.bar, (volatile LAS unsigned*)&xb_words);
  ph_norm_mod(PP, 0, 0, 0, smem, true);
  ph_bq(PP, smem);
  BARRIER();
#pragma unroll 1
  for (int l = 0; l < 2; ++l) {
    const int t0 = (l == 0) ? 0 : LC;
    { const P lp = PP; gemm_bf16_128(lp, lp.hb, lp.w_in_t + (size_t)l * 1024 * DIN, 1024, 0, TT, DIN, (char*)smem, EpiProj{l}); }
    BARRIER();
    ph_lru<1>(PP, l, (char*)smem);
    ph_attn(PP, l, (char*)smem);
    BARRIER();
    ph_lru_carry(PP, smem);
    BARRIER();
    ph_lru<2>(PP, l, (char*)smem);
    BARRIER();
    { const P lp = PP; gemm_bf16_128(lp, lp.mixb, lp.w_out_t + (size_t)l * 1024 * 1024, 1024, t0, TT, 1024, (char*)smem, EpiResid{l}); }
    BARRIER();
    { const P lp = PP; gemm_bf16_128(lp, lp.hb, lp.wq_t + (size_t)l * 1024 * NPQ, 1024, t0, TT, NPQ, (char*)smem, EpiPeerTopk{l}); }
    BARRIER();
    ph_peer_merge(PP, l, t0, (char*)smem);
    BARRIER();
    ph_peer_s1(PP, l, t0, load_xw(smem));
    BARRIER();
    ph_peer_r(PP, l, t0);
    BARRIER();
    ph_peer_s2(PP, l, t0, load_xw(smem), (char*)smem);
    if (l == 0) {
      BARRIER();
      ph_norm_mod(PP, 1, 0, 0, smem);
      BARRIER();
    }
  }
  if (PROBE_IV >= 0) {
    probe_tick(pcnt, probe_t);
    __syncthreads();
    if (blockIdx.x == 0 && threadIdx.x == 0) {
      const unsigned long long dt = (probe_t[1] - probe_t[0]) * 8ull, ts = __builtin_amdgcn_s_memrealtime();
      while (__builtin_amdgcn_s_memrealtime() - ts < dt) __builtin_amdgcn_s_sleep(8);
    }
  }
}

extern "C" void kernel_launch(void* const* d_in, const int* in_sizes, int n_in, void* d_out, int out_size, void* d_ws,
                              size_t ws_size, hipStream_t stream) {
  P p{};
  const float** fp = (const float**)&p;
  for (int i = 0; i < 28; ++i) fp[i] = (const float*)d_in[i];
  p.out = (float*)d_out;
  float* w = (float*)d_ws;
  size_t o = 0;
  auto carve = [&](size_t n) { float* r = w + o; o += (n + 63) & ~(size_t)63; return r; };
  p.bar = (unsigned*)carve(8192);
  p.mod = carve(4 * 6144);
  p.xall = carve((size_t)TT * 1024);
  p.proj = carve((size_t)TT * 512);
  p.projb = (bf16_t*)carve((size_t)TT * DIN / 2);
  p.mixb = (bf16_t*)carve((size_t)TT * 512);
  p.hb = (bf16_t*)carve((size_t)TT * 512);
  p.w_in_t = (bf16_t*)carve((size_t)1024 * DIN);
  p.w_out_t = (bf16_t*)carve((size_t)1024 * 1024);
  p.wq_t = (bf16_t*)carve((size_t)1024 * NPQ);
  p.lruw_t = (bf16_t*)carve((size_t)2 * 2 * 4 * 2 * 4096 / 2);
  p.lagg = carve((size_t)2 * NCHUNK * 256 * 2);
  p.lcarry = carve((size_t)2 * NCHUNK * 256);
  p.ropetab = carve(320 * 16 * 2);
  p.rowss = carve((size_t)8 * TT);
  p.bq = carve(4 * NPQ);
  p.el = (int*)carve((size_t)TT * 128);
  p.gl = carve((size_t)TT * 128);
  p.av = carve((size_t)TT * 128);
  p.pd = carve((size_t)8 * TT * 128);
  p.pk = (unsigned*)carve((size_t)TT * 256);
  p.ub8 = (unsigned char*)carve((size_t)2 * 16384 * 1024 / 4);
  p.vb8 = (unsigned char*)carve((size_t)2 * 16384 * 1024 / 4);
  p.usc = carve(2 * 16384);
  p.vsc = carve(2 * 16384);
  p.k1b = (bf16_t*)carve(16384);
  p.k2b = (bf16_t*)carve(16384);
  if (o * 4 > ws_size) { fprintf(stderr, "workspace too small: need %zu have %zu\n", o * 4, ws_size); return; }
  static int grid_blocks = 0;
  if (!grid_blocks) {
    int dev = 0, cus = 0, per_cu = 0;
    (void)hipGetDevice(&dev);
    (void)hipDeviceGetAttribute(&cus, hipDeviceAttributeMultiprocessorCount, dev);
    (void)hipOccupancyMaxActiveBlocksPerMultiprocessor(&per_cu, k_mega, 256, 0);
    if (per_cu > 2) per_cu = 2;
    grid_blocks = cus * per_cu;
  }
  (void)hipMemsetAsync(p.bar, 0, XCD_BAR_WORDS * 4, stream);
  void* args[] = {&p};
  hipError_t e = hipLaunchCooperativeKernel((void*)k_mega, dim3(grid_blocks), dim3(256), args, 0, stream);
  if (e != hipSuccess) fprintf(stderr, "cooperative launch failed: %s (grid %d)\n", hipGetErrorString(e), grid_blocks);
}
```

```cpp
#include <hip/hip_runtime.h>
#include <hip/hip_cooperative_groups.h>
#include <stdint.h>
#include <stdio.h>
namespace cg = cooperative_groups;

#ifndef SINGLE_LAUNCH
#define SINGLE_LAUNCH 1
#endif

constexpr int DM = 1024, SEQ = 16384, LC = 256, TT = SEQ + LC, DIN = 2304, NPQ = 2048;
constexpr int OFF_XA = 0, OFF_GA = 256, OFF_QW = 512, OFF_KW = 896, OFF_VW = 1024, OFF_QN = 1152, OFF_KN = 1536, OFF_VN = 1920;
constexpr float EPS = 1e-6f;
#define LAS __attribute__((address_space(3)))
constexpr float LOG2E = 1.4426950408889634f;
constexpr float QSCALE = 0.125f * LOG2E;

struct P {
  const float *x, *c, *ctx, *c_ctx, *w_mod, *b_mod, *norm1_g, *norm2_g, *w_in, *w_out,
      *conv_w, *conv_b, *wa, *ba, *wx, *bx, *lam, *win_qn, *win_kn, *win_sink, *na_qn, *na_kn, *rpb,
      *wq, *k1, *k2, *pu, *pv;
  float* out;
  float *mod, *xall, *proj;
  unsigned short* projb;
  unsigned* pk;
  unsigned* bar;
  unsigned short *k1b, *k2b;
  unsigned char *ub8, *vb8;
  float *usc, *vsc;
  unsigned short *hb, *mixb, *w_in_t, *w_out_t, *wq_t, *lruw_t;
  float *lagg, *lcarry, *ropetab, *rowss, *bq, *gl, *av, *pd;
  int* el;
};

typedef unsigned short bf16_t;
typedef __attribute__((ext_vector_type(8))) short bf16x8;
typedef __attribute__((ext_vector_type(4))) float f32x4;
__device__ __forceinline__ unsigned short f2bf(float f) {
  unsigned u = __float_as_uint(f);
  u += 0x7fffu + ((u >> 16) & 1u);
  return (unsigned short)(u >> 16);
}
__device__ __forceinline__ unsigned pack2bf(float a, float b) { return (unsigned)f2bf(a) | ((unsigned)f2bf(b) << 16); }
__device__ __forceinline__ float bf2f(unsigned short h) { return __uint_as_float(((unsigned)h) << 16); }


__device__ __forceinline__ float silu_f(float x) { return x / (1.f + __expf(-x)); }
__device__ __forceinline__ float sigmoid_f(float x) { return 1.f / (1.f + __expf(-x)); }
__device__ __forceinline__ float gelu_f(float x) {
  float u = 0.7978845608028654f * (x + 0.044715f * x * x * x);
  float e = __expf(2.f * u);
  float th = 1.f - 2.f / (e + 1.f);
  return 0.5f * x * (1.f + th);
}
template <int CTRL, int RMASK>
__device__ __forceinline__ float dpp_mov(float v) {
  return __int_as_float(__builtin_amdgcn_update_dpp(0, __float_as_int(v), CTRL, RMASK, 0xf, false));
}
__device__ __forceinline__ float wave_sum(float v) {
  v += dpp_mov<0xB1, 0xf>(v);
  v += dpp_mov<0x4E, 0xf>(v);
  v += dpp_mov<0x141, 0xf>(v);
  v += dpp_mov<0x140, 0xf>(v);
  v += dpp_mov<0x142, 0xa>(v);
  v += dpp_mov<0x143, 0xc>(v);
  return __int_as_float(__builtin_amdgcn_readlane(__float_as_int(v), 63));
}

__device__ __forceinline__ int tid_opaque() { int t = threadIdx.x; asm volatile("" : "+v"(t)); return t; }
#define GTID (blockIdx.x * blockDim.x + tid_opaque())
#define GSZ (gridDim.x * blockDim.x)

__device__ __forceinline__ void ph_mod(const P& p, float* smem) {
  const int tid = tid_opaque(), cl = tid & 31, ks = tid >> 5;
  for (int it = blockIdx.x; it < 2 * 192; it += gridDim.x) {
    const int nc = it % 192, l = it / 192;
    const int n = nc * 32 + cl;
    const float* w = p.w_mod + (size_t)l * 1024 * 6144 + n;
    float a0 = 0.f, a1 = 0.f;
#pragma unroll 8
    for (int i = 0; i < 128; ++i) {
      int k = i * 8 + ks;
      float wv = w[(size_t)k * 6144];
      a0 += silu_f(p.c[k]) * wv;
      a1 += silu_f(p.c_ctx[k]) * wv;
    }
    __syncthreads();
    smem[tid] = a0; smem[256 + tid] = a1;
    __syncthreads();
    if (tid < 64) {
      const int which = tid >> 5;
      float s = p.b_mod[l * 6144 + n];
#pragma unroll
      for (int q = 0; q < 8; ++q) s += smem[which * 256 + q * 32 + cl];
      p.mod[(l * 2 + which) * 6144 + n] = s;
    }
  }
}

__device__ __forceinline__ void ph_bq(const P& p, float* smem) {
  const int tid = tid_opaque(), cl = tid & 31, ks = tid >> 5;
  for (int it = blockIdx.x; it < 2 * 64; it += gridDim.x) {
    const int nc = it % 64, l = it / 64;
    const int n = nc * 32 + cl;
    const float* w = p.wq + (size_t)l * 1024 * NPQ + n;
    const float* v0 = p.mod + (l * 2 + 0) * 6144 + 3072;
    const float* v1 = p.mod + (l * 2 + 1) * 6144 + 3072;
    float a0 = 0.f, a1 = 0.f;
#pragma unroll 8
    for (int i = 0; i < 128; ++i) {
      int k = i * 8 + ks;
      float wv = w[(size_t)k * NPQ];
      a0 += v0[k] * wv;
      a1 += v1[k] * wv;
    }
    __syncthreads();
    smem[tid] = a0; smem[256 + tid] = a1;
    __syncthreads();
    if (tid < 64) {
      const int which = tid >> 5;
      float s = 0.f;
#pragma unroll
      for (int q = 0; q < 8; ++q) s += smem[which * 256 + q * 32 + cl];
      p.bq[(l * 2 + which) * NPQ + n] = s;
    }
  }
}

__device__ __forceinline__ void ph_copy_in(const P& p) {
  const float4* xs = (const float4*)p.x;
  const float4* cs = (const float4*)p.ctx;
  float4* d = (float4*)p.xall;
  for (int i = GTID; i < TT * 256; i += GSZ) d[i] = (i < LC * 256) ? cs[i] : xs[i - LC * 256];
}

__device__ __forceinline__ void ph_copy_out(const P& p) {
  const float4* s = (const float4*)(p.xall + (size_t)LC * 1024);
  float4* d = (float4*)p.out;
  for (int i = GTID; i < SEQ * 256; i += GSZ) d[i] = s[i];
}

__device__ __forceinline__ void ph_norm_mod(const P& p, int l, int which_norm, int t0, float* smem, bool from_input = false) {
  const float* g = (which_norm ? p.norm2_g : p.norm1_g) + l * 1024;
  const int sh_off = which_norm ? 3072 : 0, sc_off = which_norm ? 4096 : 1024;
  const int tid = tid_opaque();
  for (int t = t0 + blockIdx.x; t < TT; t += gridDim.x) {
    const float* mod = p.mod + (l * 2 + (t < LC ? 1 : 0)) * 6144;
    float4 v;
    if (from_input) {
      v = t < LC ? ((const float4*)(p.ctx + (size_t)t * 1024))[tid] : ((const float4*)(p.x + (size_t)(t - LC) * 1024))[tid];
      ((float4*)(p.xall + (size_t)t * 1024))[tid] = v;
    } else v = ((const float4*)(p.xall + (size_t)t * 1024))[tid];
    float ss = wave_sum(v.x * v.x + v.y * v.y + v.z * v.z + v.w * v.w);
    __syncthreads();
    if ((tid & 63) == 0) smem[tid >> 6] = ss;
    __syncthreads();
    float tot = smem[0] + smem[1] + smem[2] + smem[3];
    float rinv = rsqrtf(tot * (1.f / 1024.f) + EPS);
    float4 gg = ((const float4*)g)[tid];
    float4 sc = ((const float4*)(mod + sc_off))[tid];
    float4 sh = ((const float4*)(mod + sh_off))[tid];
    float4 o;
    o.x = v.x * rinv * gg.x * (1.f + sc.x) + sh.x;
    o.y = v.y * rinv * gg.y * (1.f + sc.y) + sh.y;
    o.z = v.z * rinv * gg.z * (1.f + sc.z) + sh.z;
    o.w = v.w * rinv * gg.w * (1.f + sc.w) + sh.w;
    ((uint2*)(p.hb + (size_t)t * 1024))[tid] = make_uint2(pack2bf(o.x, o.y), pack2bf(o.z, o.w));
  }
}

__device__ __forceinline__ void prep_transpose(const float* W, bf16_t* Wt, int K, int N, int item0, int nitems_total, float* smem) {
  (void)nitems_total;
  float(*ts)[65] = (float(*)[65])smem;
  const int tid = tid_opaque();
  const int tn = N / 64, nt = (K / 64) * tn;
  for (int it = blockIdx.x; it < nt; it += gridDim.x) {
    int k0 = (it / tn) * 64, n0 = (it % tn) * 64;
    __syncthreads();
#pragma unroll
    for (int i = 0; i < 16; ++i) {
      int r = (tid >> 6) + i * 4, c = tid & 63;
      ts[r][c] = W[(size_t)(k0 + r) * N + n0 + c];
    }
    __syncthreads();
#pragma unroll
    for (int i = 0; i < 16; ++i) {
      int r = (tid >> 6) + i * 4, c = tid & 63;
      Wt[(size_t)(n0 + r) * K + k0 + c] = f2bf(ts[c][r]);
    }
  }
  (void)item0;
}

__device__ __forceinline__ void ph_prep(const P& p, float* smem) {
  for (int l = 0; l < 2; ++l) {
    prep_transpose(p.w_in + (size_t)l * 1024 * DIN, p.w_in_t + (size_t)l * 1024 * DIN, 1024, DIN, 0, 0, smem);
    prep_transpose(p.w_out + (size_t)l * 1024 * 1024, p.w_out_t + (size_t)l * 1024 * 1024, 1024, 1024, 0, 0, smem);
    prep_transpose(p.wq + (size_t)l * 1024 * NPQ, p.wq_t + (size_t)l * 1024 * NPQ, 1024, NPQ, 0, 0, smem);
  }
}

struct EpiStoreF32 {
  float* C; int ldc;
  __device__ __forceinline__ void operator()(const P& p, f32x4 (&acc)[4][4], int m0, int n0, int wm, int wn, int lane, char* smem) const {
    const int mw0 = m0 + wm * 64, nw0 = n0 + wn * 64;
#pragma unroll
    for (int i = 0; i < 4; ++i)
#pragma unroll
      for (int r = 0; r < 4; ++r) {
        int row = mw0 + 16 * i + (lane >> 4) * 4 + r;
#pragma unroll
        for (int j = 0; j < 4; ++j) C[(size_t)row * ldc + nw0 + 16 * j + (lane & 15)] = acc[i][j][r];
      }
  }
};
struct EpiProjSplit {
  __device__ __forceinline__ void operator()(const P& p, f32x4 (&acc)[4][4], int m0, int n0, int wm, int wn, int lane, char* smem) const {
    const int mw0 = m0 + wm * 64, nw0 = n0 + wn * 64;
#pragma unroll
    for (int i = 0; i < 4; ++i)
#pragma unroll
      for (int r = 0; r < 4; ++r) {
        int row = mw0 + 16 * i + (lane >> 4) * 4 + r;
#pragma unroll
        for (int j = 0; j < 4; ++j) {
          int col = nw0 + 16 * j + (lane & 15);
          if (n0 < 512) p.proj[(size_t)row * 512 + col] = acc[i][j][r];
          else p.projb[(size_t)row * DIN + col] = f2bf(acc[i][j][r]);
        }
      }
  }
};
__device__ __forceinline__ void ph_rope_tab(const P& p) {
  for (int idx = GTID; idx < 320 * 16; idx += GSZ) {
    int v = idx >> 4, j = idx & 15;
    float inv = __expf(-(float)j * (1.f / 16.f) * 9.210340371976184f);
    float ang = (float)(v < 256 ? v : v - 256) * inv;
    float k = rintf(ang * 0.15915494309189535f);
    float r = fmaf(-k, 6.2831854820251465f, ang);
    r = fmaf(-k, -1.7484555e-07f, r);
    ((float2*)p.ropetab)[idx] = make_float2(__cosf(r), __sinf(r));
  }
}

template <int CTRL>
__device__ __forceinline__ float dpp_row(float v) {
  return __int_as_float(__builtin_amdgcn_update_dpp(0, __float_as_int(v), CTRL, 0xf, 0xf, false));
}
struct EpiProj {
  int l;
  __device__ __forceinline__ void operator()(const P& p, f32x4 (&acc)[4][4], int m0, int n0, int wm, int wn, int lane, char* smem) const {
    const int g = lane >> 4, lr = lane & 15;
    const int mw0 = m0 + wm * 64, nw0 = n0 + wn * 64;
    if (n0 < 512) {
#pragma unroll
      for (int i = 0; i < 4; ++i)
#pragma unroll
        for (int r = 0; r < 4; ++r) {
          int row = mw0 + 16 * i + 4 * g + r;
#pragma unroll
          for (int j = 0; j < 4; ++j) p.proj[(size_t)row * 512 + nw0 + 16 * j + lr] = acc[i][j][r];
        }
      return;
    }
    const float* gain = nullptr; bool rope = false; float scale = 1.f;
    if (nw0 < 896) { gain = p.win_qn + l * 64; rope = true; scale = QSCALE; }
    else if (nw0 < 1024) { gain = p.win_kn + l * 64; rope = true; }
    else if (nw0 < 1152) { }
    else if (nw0 < 1536) { gain = p.na_qn + l * 64; scale = QSCALE; }
    else if (nw0 < 1920) { gain = p.na_kn + l * 64; }
    rope = rope && (m0 >= LC);
    float gj[4] = {1.f, 1.f, 1.f, 1.f};
    if (gain) {
#pragma unroll
      for (int j = 0; j < 4; ++j) gj[j] = gain[16 * j + lr] * scale;
    }
#pragma unroll
    for (int i = 0; i < 4; ++i)
#pragma unroll
      for (int r = 0; r < 4; ++r) {
        const int row = mw0 + 16 * i + 4 * g + r;
        float y[4] = {acc[i][0][r], acc[i][1][r], acc[i][2][r], acc[i][3][r]};
        if (gain) {
          float ss = y[0] * y[0] + y[1] * y[1] + y[2] * y[2] + y[3] * y[3];
          ss += dpp_row<0xB1>(ss);
          ss += dpp_row<0x4E>(ss);
          ss += dpp_row<0x141>(ss);
          ss += dpp_row<0x140>(ss);
          const float rinv = rsqrtf(ss * (1.f / 64.f) + EPS);
#pragma unroll
          for (int j = 0; j < 4; ++j) y[j] *= rinv * gj[j];
        }
        if (rope) {
          const int pos = row - LC;
          const float2 tr = ((const float2*)p.ropetab)[(pos >> 6) * 16 + lr];
          const float2 tc = ((const float2*)p.ropetab)[(256 + (pos & 63)) * 16 + lr];
          float a0 = y[0] * tr.x - y[1] * tr.y, a1 = y[0] * tr.y + y[1] * tr.x;
          float a2 = y[2] * tc.x - y[3] * tc.y, a3 = y[2] * tc.y + y[3] * tc.x;
          y[0] = a0; y[1] = a1; y[2] = a2; y[3] = a3;
        }
#pragma unroll
        for (int j = 0; j < 4; ++j) p.projb[(size_t)row * DIN + nw0 + 16 * j + lr] = f2bf(y[j]);
      }
  }
};
struct EpiResid {
  int l;
  __device__ __forceinline__ void operator()(const P& p, f32x4 (&acc)[4][4], int m0, int n0, int wm, int wn, int lane, char* smem) const {
    float* tile = (float*)smem;
    {
      const int g = lane >> 4, lr = lane & 15;
      float* tw = tile + (wm * 64 + 4 * g) * 132 + wn * 64 + lr;
#pragma unroll
      for (int i = 0; i < 4; ++i)
#pragma unroll
        for (int r = 0; r < 4; ++r)
#pragma unroll
          for (int j = 0; j < 4; ++j) tw[(16 * i + r) * 132 + 16 * j] = acc[i][j][r];
    }
    __syncthreads();
    const int tid = ((wm * 2 + wn) << 6) | lane, c8 = tid & 15, rsub = tid >> 4;
    const float* mod = p.mod + (l * 2 + (m0 < LC ? 1 : 0)) * 6144;
    const int col = n0 + 8 * c8;
    float g1v[8], gs[8];
    {
      const float4 a0 = *(const float4*)(mod + 2048 + col), a1 = *(const float4*)(mod + 2048 + col + 4);
      const float4 s0 = *(const float4*)(mod + 4096 + col), s1 = *(const float4*)(mod + 4096 + col + 4);
      const float4 n0v = *(const float4*)(p.norm2_g + l * 1024 + col), n1v = *(const float4*)(p.norm2_g + l * 1024 + col + 4);
      g1v[0] = a0.x; g1v[1] = a0.y; g1v[2] = a0.z; g1v[3] = a0.w; g1v[4] = a1.x; g1v[5] = a1.y; g1v[6] = a1.z; g1v[7] = a1.w;
      gs[0] = n0v.x * (1.f + s0.x); gs[1] = n0v.y * (1.f + s0.y); gs[2] = n0v.z * (1.f + s0.z); gs[3] = n0v.w * (1.f + s0.w);
      gs[4] = n1v.x * (1.f + s1.x); gs[5] = n1v.y * (1.f + s1.y); gs[6] = n1v.z * (1.f + s1.z); gs[7] = n1v.w * (1.f + s1.w);
    }
#pragma unroll
    for (int it = 0; it < 8; ++it) {
      const int rl = it * 16 + rsub, row = m0 + rl;
      float4* xp = (float4*)(p.xall + (size_t)row * 1024 + col);
      float4 x0 = xp[0], x1 = xp[1];
      const float4 t0 = *(const float4*)(tile + rl * 132 + 8 * c8), t1 = *(const float4*)(tile + rl * 132 + 8 * c8 + 4);
      x0.x += g1v[0] * t0.x; x0.y += g1v[1] * t0.y; x0.z += g1v[2] * t0.z; x0.w += g1v[3] * t0.w;
      x1.x += g1v[4] * t1.x; x1.y += g1v[5] * t1.y; x1.z += g1v[6] * t1.z; x1.w += g1v[7] * t1.w;
      xp[0] = x0; xp[1] = x1;
      float ss = x0.x * x0.x + x0.y * x0.y + x0.z * x0.z + x0.w * x0.w + x1.x * x1.x + x1.y * x1.y + x1.z * x1.z + x1.w * x1.w;
      ss += dpp_row<0xB1>(ss);
      ss += dpp_row<0x4E>(ss);
      ss += dpp_row<0x141>(ss);
      ss += dpp_row<0x140>(ss);
      *(uint4*)(p.hb + (size_t)row * 1024 + col) = make_uint4(pack2bf(x0.x * gs[0], x0.y * gs[1]), pack2bf(x0.z * gs[2], x0.w * gs[3]),
                                                            pack2bf(x1.x * gs[4], x1.y * gs[5]), pack2bf(x1.z * gs[6], x1.w * gs[7]));
      if (c8 == 0) p.rowss[(size_t)(n0 >> 7) * TT + row] = ss;
    }
  }
};

template <int CTRL, int RMASK>
__device__ __forceinline__ float dpp_mov_id(float v) {
  return __int_as_float(__builtin_amdgcn_update_dpp(__float_as_int(v), __float_as_int(v), CTRL, RMASK, 0xf, false));
}
__device__ __forceinline__ float wave_max(float v) {
  v = fmaxf(v, dpp_mov_id<0xB1, 0xf>(v));
  v = fmaxf(v, dpp_mov_id<0x4E, 0xf>(v));
  v = fmaxf(v, dpp_mov_id<0x141, 0xf>(v));
  v = fmaxf(v, dpp_mov_id<0x140, 0xf>(v));
  v = fmaxf(v, dpp_mov_id<0x142, 0xa>(v));
  v = fmaxf(v, dpp_mov_id<0x143, 0xc>(v));
  return __int_as_float(__builtin_amdgcn_readlane(__float_as_int(v), 63));
}

typedef __attribute__((ext_vector_type(2))) float f32x2;
__device__ __forceinline__ void peer_convert_rows(const P& p, int l, int r0, int r1) {
  const int tid = tid_opaque(), lane = tid & 63;
  for (int rb = r0 + (tid >> 6); rb < r1; rb += 16) {
    float4 v[4][4];
#pragma unroll
    for (int u = 0; u < 4; ++u) {
      const int r = min(rb + 4 * u, r1 - 1);
      const int tbl = r >> 14, e = r & 16383;
      const float4* src = (const float4*)((tbl ? p.pv : p.pu) + ((size_t)l * 16384 + e) * 1024) + lane * 4;
#pragma unroll
      for (int i = 0; i < 4; ++i) v[u][i] = src[i];
    }
#pragma unroll
    for (int u = 0; u < 4; ++u) {
      const int r = rb + 4 * u;
      if (r < r1) {
        const int tbl = r >> 14, e = r & 16383;
        float am = 0.f;
#pragma unroll
        for (int i = 0; i < 4; ++i)
          am = fmaxf(am, fmaxf(fmaxf(fabsf(v[u][i].x), fabsf(v[u][i].y)), fmaxf(fabsf(v[u][i].z), fabsf(v[u][i].w))));
        am = wave_max(am);
        const float sc = am > 0.f ? 224.f / am : 1.f;
        unsigned w[4];
#pragma unroll
        for (int i = 0; i < 4; ++i) {
          int t = __builtin_amdgcn_cvt_pk_fp8_f32(v[u][i].x * sc, v[u][i].y * sc, 0, false);
          t = __builtin_amdgcn_cvt_pk_fp8_f32(v[u][i].z * sc, v[u][i].w * sc, t, true);
          w[i] = (unsigned)t;
        }
        unsigned char* dst = (tbl ? p.vb8 : p.ub8) + (((size_t)l * 8 + (lane >> 3)) * 16384 + e) * 128 + (lane & 7) * 16;
        *(uint4*)dst = make_uint4(w[0], w[1], w[2], w[3]);
        if (lane == 0) (tbl ? p.vsc : p.usc)[l * 16384 + e] = am > 0.f ? am / 224.f : 1.f;
      }
    }
  }
}
__device__ __forceinline__ int gemm_swz(int row) { return (0x78 >> (((row >> 2) & 3) * 2)) & 3; }
template <class Epi>
__device__ __forceinline__ void gemm_bf16_128(const P& p, const bf16_t* __restrict__ A, const bf16_t* __restrict__ Bt, int K, int m_begin, int m_end,
                              int N, char* smem, const Epi& epi, int cl = -1, int rpt = 0) {
  const int tid = tid_opaque(), lane = tid & 63, wv = __builtin_amdgcn_readfirstlane(tid >> 6), wm = wv >> 1, wn = wv & 1;
  const int tiles_n = N / 128, tiles_m = (m_end - m_begin) / 128;
  const int nk = K / 32;
  const int lr = lane & 15, g = lane >> 4;
  const int a_rd = (wm * 64 + lr) * 64 + ((g ^ gemm_swz(lr)) << 4);
  const int b_rd = 8192 + (wn * 64 + lr) * 64 + ((g ^ gemm_swz(lr)) << 4);
  const int ld_row = lane >> 2, ld_c = (lane & 3) ^ gemm_swz(ld_row);
  for (int tile = blockIdx.x; tile < tiles_m * tiles_n; tile += gridDim.x) {
    const int m0 = m_begin + (tile / tiles_n) * 128, n0 = (tile % tiles_n) * 128;
    f32x4 acc[4][4];
#pragma unroll
    for (int i = 0; i < 4; ++i)
#pragma unroll
      for (int j = 0; j < 4; ++j) acc[i][j] = (f32x4){0.f, 0.f, 0.f, 0.f};
    const bf16_t* Ag = A + (size_t)(m0 + wv * 32 + ld_row) * K + ld_c * 8;
    const bf16_t* Bg = Bt + (size_t)(n0 + wv * 32 + ld_row) * K + ld_c * 8;
    auto issue = [&](int st, int kt) {
      char* base = smem + st * 16384 + wv * 2048;
#pragma unroll
      for (int i = 0; i < 2; ++i) {
        __builtin_amdgcn_global_load_lds((const unsigned*)(Ag + (size_t)i * 16 * K + kt * 32), (__attribute__((address_space(3))) unsigned*)(base + i * 1024), 16, 0, 0);
        __builtin_amdgcn_global_load_lds((const unsigned*)(Bg + (size_t)i * 16 * K + kt * 32), (__attribute__((address_space(3))) unsigned*)(base + 8192 + i * 1024), 16, 0, 0);
      }
    };
    issue(0, 0); issue(1, 1); issue(2, 2);
    for (int kt0 = 0; kt0 < nk; kt0 += 4) {
#pragma unroll
      for (int u = 0; u < 4; ++u) {
        const int kt = kt0 + u, rem = nk - kt;
        if (rem >= 3) asm volatile("s_waitcnt vmcnt(8) lgkmcnt(0)" ::: "memory");
        else if (rem == 2) asm volatile("s_waitcnt vmcnt(4) lgkmcnt(0)" ::: "memory");
        else asm volatile("s_waitcnt vmcnt(0) lgkmcnt(0)" ::: "memory");
        __builtin_amdgcn_s_barrier();
        if (kt + 3 < nk) issue((u + 3) & 3, kt + 3);
        bf16x8 af[4], bfr[4];
#pragma unroll
        for (int i = 0; i < 4; ++i) af[i] = *(const bf16x8*)(smem + u * 16384 + a_rd + i * 1024);
#pragma unroll
        for (int j = 0; j < 4; ++j) bfr[j] = *(const bf16x8*)(smem + u * 16384 + b_rd + j * 1024);
#pragma unroll
        for (int i = 0; i < 4; ++i)
#pragma unroll
          for (int j = 0; j < 4; ++j) acc[i][j] = __builtin_amdgcn_mfma_f32_16x16x32_bf16(af[i], bfr[j], acc[i][j], 0, 0, 0);
      }
    }
    __syncthreads();
    epi(p, acc, m0, n0, wm, wn, lane, smem);
    if (cl >= 0) peer_convert_rows(p, cl, min(tile * rpt, 32768), min((tile + 1) * rpt, 32768));
    __syncthreads();
  }
}

constexpr int NCHUNK = TT / 64;
__device__ __forceinline__ int lru_pos(int dir, int c) { return dir == 0 ? c : (c < 4 ? 3 - c : 4 + (NCHUNK - 1 - c)); }

__device__ __forceinline__ void ph_lru_prepw(const P& p) {
  for (int idx = GTID; idx < 2 * 2 * 4 * 2 * 4096; idx += GSZ) {
    int d = idx & 63, e = (idx >> 6) & 63, mtx = (idx >> 12) & 1, rest = idx >> 13;
    const float* w = (mtx ? p.wx : p.wa) + (size_t)rest * 4096;
    p.lruw_t[idx] = f2bf(w[d * 64 + e]);
  }
}

template <int PASS>
__device__ __forceinline__ void lru_item(const P& p, int l, int cidx, int kb, char* smem) {
  bf16_t* u_img = (bf16_t*)smem;
  float* ab_a = (float*)(smem + 8192);
  float* ab_b = (float*)(smem + 8192 + 16384);
  float* hsum = (float*)(smem + 8192 + 32768);
  float* segagg = (float*)(smem + 8192 + 49152);
  float* ccarry = (float*)(smem + 8192 + 49152 + 2048);
  const int tid = tid_opaque(), lane = tid & 63, wv = tid >> 6, g = lane >> 4, lr = lane & 15;
  const int t0 = cidx * 64;
  const int lo = t0 < LC ? 0 : LC, hi = t0 < LC ? LC : TT;
  __syncthreads();
  {
    const int ch = tid & 63, c = kb * 64 + ch, sg = tid >> 6;
    const float cb = p.conv_b[l * 256 + c];
    float cw[4];
#pragma unroll
    for (int k = 0; k < 4; ++k) cw[k] = p.conv_w[(l * 4 + k) * 256 + c];
    float xr[19];
#pragma unroll
    for (int i = 0; i < 19; ++i) {
      int tt = t0 + sg * 16 + i - 2;
      int tc = tt < lo ? lo : (tt >= hi ? hi - 1 : tt);
      float v = p.proj[(size_t)tc * 512 + OFF_XA + c];
      xr[i] = (tt >= lo && tt < hi) ? v : 0.f;
    }
#pragma unroll
    for (int i = 0; i < 16; ++i) {
      int row = sg * 16 + i;
      float acc = cb + cw[0] * xr[i] + cw[1] * xr[i + 1] + cw[2] * xr[i + 2] + cw[3] * xr[i + 3];
      u_img[row * 64 + ((((ch >> 3) ^ (row & 7)) << 3) | (ch & 7))] = f2bf(acc);
    }
  }
  if (PASS == 2) {
    if (tid < 128) {
      const int ch = tid & 63, dir = tid >> 6;
      ccarry[dir * 64 + ch] = p.lcarry[((size_t)dir * NCHUNK + lru_pos(dir, cidx)) * 256 + kb * 64 + ch];
    }
  }
  __syncthreads();
  for (int dir = 0; dir < 2; ++dir) {
    const int pd = l * 2 + dir;
    {
      f32x4 ga[4], gx[4];
#pragma unroll
      for (int i = 0; i < 4; ++i) { ga[i] = (f32x4){0.f, 0.f, 0.f, 0.f}; gx[i] = (f32x4){0.f, 0.f, 0.f, 0.f}; }
      const bf16_t* wbase = p.lruw_t + (size_t)((pd * 4 + kb) * 2) * 4096 + (16 * wv + lr) * 64 + 8 * g;
#pragma unroll
      for (int s = 0; s < 2; ++s) {
        bf16x8 ba_ = *(const bf16x8*)(wbase + 32 * s);
        bf16x8 bx_ = *(const bf16x8*)(wbase + 4096 + 32 * s);
#pragma unroll
        for (int i = 0; i < 4; ++i) {
          int row = 16 * i + lr;
          bf16x8 af = *(const bf16x8*)((const char*)u_img + row * 128 + (((4 * s + g) ^ (row & 7)) << 4));
          ga[i] = __builtin_amdgcn_mfma_f32_16x16x32_bf16(af, ba_, ga[i], 0, 0, 0);
          gx[i] = __builtin_amdgcn_mfma_f32_16x16x32_bf16(af, bx_, gx[i], 0, 0, 0);
        }
      }
      const int ch = 16 * wv + lr, c = kb * 64 + ch;
      const float bav = p.ba[pd * 256 + c], bxv = p.bx[pd * 256 + c];
      const float sp = log1pf(expf(-p.lam[pd * 256 + c]));
#pragma unroll
      for (int i = 0; i < 4; ++i)
#pragma unroll
        for (int r = 0; r < 4; ++r) {
          int row = 16 * i + 4 * g + r;
          float rr = sigmoid_f(ga[i][r] + bav), ig = sigmoid_f(gx[i][r] + bxv);
          float log_a = -8.f * rr * sp;
          float a = __expf(log_a);
          float uu = bf2f(u_img[row * 64 + ((((ch >> 3) ^ (row & 7)) << 3) | (ch & 7))]);
          const float x2 = 2.f * log_a;
          const float ser = -x2 * (1.f + x2 * (0.5f + x2 * (0.16666667f + x2 * (0.041666668f + x2 * 0.0083333338f))));
          const float om = x2 > -0.25f ? ser : 1.f - a * a;
          float b = sqrtf(om) * ig * uu;
          ab_a[row * 64 + ch] = a;
          ab_b[row * 64 + ch] = b;
        }
    }
    __syncthreads();
    {
      const int ch = tid & 63, seg = tid >> 6;
      float Pr = 1.f, H = 0.f;
#pragma unroll
      for (int i = 0; i < 16; ++i) {
        int row = dir == 0 ? seg * 16 + i : seg * 16 + 15 - i;
        float a = ab_a[row * 64 + ch], b = ab_b[row * 64 + ch];
        H = a * H + b;
        Pr *= a;
      }
      segagg[(seg * 64 + ch) * 2] = Pr;
      segagg[(seg * 64 + ch) * 2 + 1] = H;
      __syncthreads();
      if (PASS == 1) {
        if (seg == 0) {
          float A = 1.f, B = 0.f;
#pragma unroll
          for (int s2 = 0; s2 < 4; ++s2) {
            int sg = dir == 0 ? s2 : 3 - s2;
            float pa = segagg[(sg * 64 + ch) * 2], pb = segagg[(sg * 64 + ch) * 2 + 1];
            B = pa * B + pb;
            A *= pa;
          }
          float2* ag = (float2*)p.lagg + ((size_t)dir * NCHUNK + lru_pos(dir, cidx)) * 256 + kb * 64 + ch;
          *ag = make_float2(A, B);
        }
      } else {
        float h = ccarry[dir * 64 + ch];
        float gav[16];
        if (dir == 1) {
#pragma unroll
          for (int i = 0; i < 16; ++i) gav[i] = p.proj[(size_t)(t0 + seg * 16 + 15 - i) * 512 + OFF_GA + kb * 64 + ch];
        }
#pragma unroll
        for (int s2 = 0; s2 < 3; ++s2) {
          int sg = dir == 0 ? s2 : 3 - s2;
          bool before = dir == 0 ? (sg < seg) : (sg > seg);
          if (before) h = segagg[(sg * 64 + ch) * 2] * h + segagg[(sg * 64 + ch) * 2 + 1];
        }
#pragma unroll
        for (int i = 0; i < 16; ++i) {
          int row = dir == 0 ? seg * 16 + i : seg * 16 + 15 - i;
          float a = ab_a[row * 64 + ch], b = ab_b[row * 64 + ch];
          h = a * h + b;
          if (dir == 0) hsum[row * 64 + ch] = h;
          else {
            int t = t0 + row, c = kb * 64 + ch;
            p.mixb[(size_t)t * 1024 + c] = f2bf((hsum[row * 64 + ch] + h) * gelu_f(gav[i]));
          }
        }
      }
    }
    __syncthreads();
  }
}

__device__ __forceinline__ void ph_lru_carry(const P& p, float* smem) {
  const int tid = tid_opaque(), seg = tid >> 4, c16 = tid & 15;
  for (int blk = blockIdx.x; blk < 32; blk += gridDim.x) {
    const int dc = blk * 16 + c16, dir = dc >> 8, ch = dc & 255;
    const float2* ag = (const float2*)p.lagg + (size_t)dir * NCHUNK * 256 + ch;
    float2 v[17];
#pragma unroll
    for (int i = 0; i < 17; ++i) {
      int pos = seg * 17 + i;
      v[i] = pos < NCHUNK ? ag[(size_t)pos * 256] : make_float2(1.f, 0.f);
    }
    float A = 1.f, B = 0.f;
#pragma unroll
    for (int i = 0; i < 17; ++i) { B = v[i].x * B + v[i].y; A *= v[i].x; }
    __syncthreads();
    smem[(seg * 16 + c16) * 2] = A; smem[(seg * 16 + c16) * 2 + 1] = B;
    __syncthreads();
    float h = 0.f;
    for (int s2 = 0; s2 < seg; ++s2) h = smem[(s2 * 16 + c16) * 2] * h + smem[(s2 * 16 + c16) * 2 + 1];
    float* cr = p.lcarry + (size_t)dir * NCHUNK * 256 + ch;
#pragma unroll
    for (int i = 0; i < 17; ++i) {
      int pos = seg * 17 + i;
      if (pos < NCHUNK) cr[(size_t)pos * 256] = h;
      h = v[i].x * h + v[i].y;
    }
  }
}

template <int PASS>
__device__ __forceinline__ void ph_lru(const P& p, int l, char* smem) {
  const int c_begin = (PASS == 2 && l == 1) ? 4 : 0;
  const int nitems = (NCHUNK - c_begin) * 4;
  for (int it = blockIdx.x; it < nitems; it += gridDim.x) lru_item<PASS>(p, l, c_begin + (it >> 2), it & 3, smem);
}

typedef __attribute__((ext_vector_type(4))) short s16x4;

__device__ __forceinline__ void ph_qknorm_rope2(const P& p, int l) {
  const int tid_ = tid_opaque();
  const int lane = tid_ & 63;
  const int wpb = blockDim.x >> 6;
  for (int pair = blockIdx.x * wpb + (tid_ >> 6); pair < TT * 28; pair += gridDim.x * wpb) {
    int t = pair / 28, slot = pair % 28;
    const float* g = nullptr; bool rope = false; float scale = 1.f;
    if (slot < 6) { g = p.win_qn + l * 64; rope = true; scale = QSCALE; }
    else if (slot < 8) { g = p.win_kn + l * 64; rope = true; }
    else if (slot < 10) { }
    else if (slot < 16) { g = p.na_qn + l * 64; scale = QSCALE; }
    else if (slot < 22) { g = p.na_kn + l * 64; }
    rope = rope && (t >= LC);
    const size_t idx = (size_t)t * DIN + 512 + slot * 64 + lane;
    float v = bf2f(p.projb[idx]);
    float y = v;
    if (g) {
      float ss = wave_sum(v * v);
      y = v * rsqrtf(ss * (1.f / 64.f) + EPS) * g[lane];
    }
    float partner = __shfl_xor(y, 16);
    if (rope) {
      int pos = t - LC, row = pos >> 6, col = pos & 63;
      int j = lane & 15, axis = lane >> 5;
      float inv = __expf(-(float)j * (1.f / 16.f) * 9.210340371976184f);
      float ang = (float)(axis ? col : row) * inv;
      float k = rintf(ang * 0.15915494309189535f);
      float r = fmaf(-k, 6.2831854820251465f, ang);
      r = fmaf(-k, -1.7484555e-07f, r);
      float cs = __cosf(r), sn = __sinf(r);
      bool first = ((lane >> 4) & 1) == 0;
      y = first ? (y * cs - partner * sn) : (partner * sn + y * cs);
    }
    p.projb[idx] = f2bf(y * scale);
  }
}

template <class TokFn>
__device__ __forceinline__ void kv_issue(const P& p, char* stage, int koff, int voff, TokFn tok, int wv, int lane) {
#pragma unroll
  for (int i = 0; i < 2; ++i) {
    const int row = 16 * wv + 8 * i + (lane >> 3);
    const bf16_t* src = p.projb + (size_t)tok(row) * DIN + (((lane & 7) ^ (row & 7)) << 3);
    char* dst = stage + (2 * wv + i) * 1024;
    __builtin_amdgcn_global_load_lds((const unsigned*)(src + koff), (__attribute__((address_space(3))) unsigned*)dst, 16, 0, 0);
    __builtin_amdgcn_global_load_lds((const unsigned*)(src + voff), (__attribute__((address_space(3))) unsigned*)(dst + 8192), 16, 0, 0);
  }
}
__device__ __forceinline__ void kv_wait(int rem) {
  if (rem >= 3) asm volatile("s_waitcnt vmcnt(8) lgkmcnt(0)" ::: "memory");
  else if (rem == 2) asm volatile("s_waitcnt vmcnt(4) lgkmcnt(0)" ::: "memory");
  else asm volatile("s_waitcnt vmcnt(0) lgkmcnt(0)" ::: "memory");
  __builtin_amdgcn_s_barrier();
}

template <class MaskFn>
__device__ __forceinline__ void attn_step2(const char* stage, int kr0, const bf16x8 (&qf)[2][2], f32x4 (&o)[2][4], float (&lsum)[2], MaskFn mb,
                                           int lane, bool act0, bool act1) {
  const int g = lane >> 4, lr = lane & 15;
  bf16x8 kf[2][2];
#pragma unroll
  for (int t2 = 0; t2 < 2; ++t2) {
    const int row = kr0 + 16 * t2 + lr;
#pragma unroll
    for (int s = 0; s < 2; ++s) kf[t2][s] = *(const bf16x8*)(stage + row * 128 + (((4 * s + g) ^ (row & 7)) << 4));
  }
  bf16x8 pb[2];
#pragma unroll
  for (int qt = 0; qt < 2; ++qt) {
    if (qt == 0 ? act0 : act1) {
      f32x4 st[2];
#pragma unroll
      for (int t2 = 0; t2 < 2; ++t2) {
        st[t2] = (f32x4){0.f, 0.f, 0.f, 0.f};
#pragma unroll
        for (int s = 0; s < 2; ++s) st[t2] = __builtin_amdgcn_mfma_f32_16x16x32_bf16(kf[t2][s], qf[qt][s], st[t2], 0, 0, 0);
      }
#pragma unroll
      for (int t2 = 0; t2 < 2; ++t2)
#pragma unroll
        for (int r = 0; r < 4; ++r) {
          float pv = exp2f(mb(qt, t2, r, st[t2][r]));
          lsum[qt] += pv;
          pb[qt][t2 * 4 + r] = (short)f2bf(pv);
        }
    }
  }
  const int q = lr >> 2, pp = lane & 3;
#pragma unroll
  for (int m = 0; m < 4; ++m) {
    bf16x8 vf;
#pragma unroll
    for (int t = 0; t < 2; ++t) {
      const int row = kr0 + 16 * t + 4 * g + q;
      const char* addr = stage + 8192 + row * 128 + (((2 * m + (pp >> 1)) ^ (row & 7)) << 4) + 8 * (pp & 1);
      s16x4 v4 = __builtin_amdgcn_ds_read_tr16_b64_v4i16((__attribute__((address_space(3))) s16x4*)addr);
      vf[4 * t + 0] = v4[0]; vf[4 * t + 1] = v4[1]; vf[4 * t + 2] = v4[2]; vf[4 * t + 3] = v4[3];
    }
    if (act0) o[0][m] = __builtin_amdgcn_mfma_f32_16x16x32_bf16(vf, pb[0], o[0][m], 0, 0, 0);
    if (act1) o[1][m] = __builtin_amdgcn_mfma_f32_16x16x32_bf16(vf, pb[1], o[1][m], 0, 0, 0);
  }
}

__device__ __forceinline__ void attn_store_out(const P& p, const f32x4 (&o)[4], float lsum, int tok, int col0, int lane) {
  const int g = lane >> 4;
  lsum += __shfl_xor(lsum, 16);
  lsum += __shfl_xor(lsum, 32);
  const float inv = 1.f / lsum;
  bf16_t* op = p.mixb + (size_t)tok * 1024 + col0 + 4 * g;
#pragma unroll
  for (int m = 0; m < 4; ++m)
    *(uint2*)(op + 16 * m) = make_uint2(pack2bf(o[m][0] * inv, o[m][1] * inv), pack2bf(o[m][2] * inv, o[m][3] * inv));
}

__device__ __forceinline__ void attn_win_item(const P& p, int l, int kind, int qb, int hs, char* smem) {
  const int tid = tid_opaque(), lane = tid & 63, wv = __builtin_amdgcn_readfirstlane(tid >> 6), g = lane >> 4, lr = lane & 15;
  int qoff, koff, voff, ooff; const float *gq, *gk; float sink2 = -1e30f; bool has_sink = false;
  if (kind == 0 || hs < 6) {
    const int h = hs, kvh = h / 3;
    qoff = OFF_QW + h * 64; koff = OFF_KW + kvh * 64; voff = OFF_VW + kvh * 64; ooff = 256 + h * 64;
    gq = p.win_qn + l * 64; gk = p.win_kn + l * 64; sink2 = p.win_sink[l * 6 + h] * LOG2E; has_sink = true;
  } else {
    const int h = hs - 6;
    qoff = OFF_QN + h * 64; koff = OFF_KN + h * 64; voff = OFF_VN + h * 64; ooff = 640 + h * 64;
    gq = p.na_qn + l * 64; gk = p.na_kn + l * 64;
  }
  float bound = 8.f * LOG2E * wave_max(fabsf(gq[lane])) * wave_max(fabsf(gk[lane])) * 1.0001f + 1e-3f;
  if (has_sink) bound = fmaxf(bound, sink2);
  const int q0 = qb * 128;
  const int qtok0 = (kind == 0 ? LC : 0) + q0 + 32 * wv;
  bf16x8 qf[2][2];
#pragma unroll
  for (int qt = 0; qt < 2; ++qt)
#pragma unroll
    for (int s = 0; s < 2; ++s) qf[qt][s] = *(const bf16x8*)(p.projb + (size_t)(qtok0 + 16 * qt + lr) * DIN + qoff + 32 * s + 8 * g);
  f32x4 o[2][4];
#pragma unroll
  for (int qt = 0; qt < 2; ++qt)
#pragma unroll
    for (int m = 0; m < 4; ++m) o[qt][m] = (f32x4){0.f, 0.f, 0.f, 0.f};
  float lsum[2] = {0.f, 0.f};
  const int nloc = (kind == 0) ? 6 : 0, nch = nloc + 4;
  auto tokfn = [&](int c) {
    return [=](int row) {
      if (c < nloc) { int pos = q0 - 128 + 64 * c + row; pos = pos < 0 ? 0 : (pos > SEQ - 1 ? SEQ - 1 : pos); return LC + pos; }
      return 64 * (c - nloc) + row;
    };
  };
  __syncthreads();
  kv_issue(p, smem, koff, voff, tokfn(0), wv, lane);
  kv_issue(p, smem + 16384, koff, voff, tokfn(1), wv, lane);
  kv_issue(p, smem + 32768, koff, voff, tokfn(2), wv, lane);
  for (int c = 0; c < nch; ++c) {
    kv_wait(nch - c);
    if (c + 3 < nch) kv_issue(p, smem + ((c + 3) & 3) * 16384, koff, voff, tokfn(c + 3), wv, lane);
    const char* stage = smem + (c & 3) * 16384;
    if (c < nloc) {
      const int qw0 = q0 + 32 * wv;
#pragma unroll
      for (int st = 0; st < 2; ++st) {
        const int kbase = q0 - 128 + 64 * c + 32 * st;
        const bool a0 = !(kbase - (qw0 + 15) > 128 || qw0 - (kbase + 31) > 128) && (kbase + 31 >= 0) && (kbase < SEQ);
        const bool a1 = !(kbase - (qw0 + 31) > 128 || (qw0 + 16) - (kbase + 31) > 128) && (kbase + 31 >= 0) && (kbase < SEQ);
        if (a0 || a1)
          attn_step2(stage, 32 * st, qf, o, lsum, [&](int qt, int t2, int r, float s) {
            int kpos = kbase + 16 * t2 + 4 * g + r;
            int dlt = kpos - (qw0 + 16 * qt + lr); dlt = dlt < 0 ? -dlt : dlt;
            bool valid = (kpos >= 0) && (kpos < SEQ) && (dlt <= 128);
            return valid ? s - bound : -1e30f;
          }, lane, a0, a1);
      }
    } else {
#pragma unroll
      for (int st = 0; st < 2; ++st)
        attn_step2(stage, 32 * st, qf, o, lsum, [&](int qt, int t2, int r, float s) { return s - bound; }, lane, true, true);
    }
  }
#pragma unroll
  for (int qt = 0; qt < 2; ++qt) {
    float ls = lsum[qt];
    if (has_sink && g == 0) ls += exp2f(sink2 - bound);
    attn_store_out(p, o[qt], ls, qtok0 + 16 * qt + lr, ooff, lane);
  }
}

__device__ __forceinline__ void attn_na_item(const P& p, int l, int rp, int h, char* smem) {
  const int tid = tid_opaque(), lane = tid & 63, wv = __builtin_amdgcn_readfirstlane(tid >> 6), g = lane >> 4, lr = lane & 15;
  const int qoff = OFF_QN + h * 64, koff = OFF_KN + h * 64, voff = OFF_VN + h * 64, ooff = 640 + h * 64;
  float* rpbl = (float*)(smem + 65536);
  const float* rpbg = p.rpb + (size_t)(l * 6 + h) * 465;
  float bmax = 0.f;
  __syncthreads();
  for (int i = tid; i < 465; i += 256) rpbl[i] = rpbg[i] * LOG2E;
  for (int i = lane; i < 465; i += 64) bmax = fmaxf(bmax, fabsf(rpbg[i]) * LOG2E);
  bmax = wave_max(bmax);
  const float bound = 8.f * LOG2E * wave_max(fabsf(p.na_qn[l * 64 + lane])) * wave_max(fabsf(p.na_kn[l * 64 + lane])) * 1.0001f + bmax + 1e-3f;
  const int r0 = 2 * rp;
  const int qcol = 16 * wv + lr;
  const int qtok0 = LC + r0 * 64 + qcol;
  const int kra = min(max(r0 - 4, 0), 248), krb = min(max(r0 + 1 - 4, 0), 248);
  const int nrow = krb + 8 - kra, nch = nrow + 4;
  const int kc0 = min(max(16 * wv - 8, 0), 32);
  const int qs = min(max(qcol - 8, 0), 48);
  bf16x8 qf[2][2];
#pragma unroll
  for (int qt = 0; qt < 2; ++qt)
#pragma unroll
    for (int s = 0; s < 2; ++s) qf[qt][s] = *(const bf16x8*)(p.projb + (size_t)(qtok0 + 64 * qt) * DIN + qoff + 32 * s + 8 * g);
  f32x4 o[2][4];
#pragma unroll
  for (int qt = 0; qt < 2; ++qt)
#pragma unroll
    for (int m = 0; m < 4; ++m) o[qt][m] = (f32x4){0.f, 0.f, 0.f, 0.f};
  float lsum[2] = {0.f, 0.f};
  auto tokfn = [&](int c) {
    return [=](int row) { return c < nrow ? LC + (kra + c) * 64 + row : 64 * (c - nrow) + row; };
  };
  kv_issue(p, smem, koff, voff, tokfn(0), wv, lane);
  kv_issue(p, smem + 16384, koff, voff, tokfn(1), wv, lane);
  kv_issue(p, smem + 32768, koff, voff, tokfn(2), wv, lane);
  for (int c = 0; c < nch; ++c) {
    kv_wait(nch - c);
    if (c + 3 < nch) kv_issue(p, smem + ((c + 3) & 3) * 16384, koff, voff, tokfn(c + 3), wv, lane);
    const char* stage = smem + (c & 3) * 16384;
    if (c < nrow) {
      const int krow = kra + c;
      const bool a0 = krow < kra + 8, a1 = krow >= krb;
      attn_step2(stage, kc0, qf, o, lsum, [&](int qt, int t2, int rr, float s) {
        int kcol = kc0 + 16 * t2 + 4 * g + rr;
        bool valid = (kcol >= qs) && (kcol < qs + 16);
        int dc = kcol - qcol + 15; dc = dc < 0 ? 0 : (dc > 30 ? 30 : dc);
        int dr = krow - (r0 + qt) + 7; dr = dr < 0 ? 0 : (dr > 14 ? 14 : dr);
        return valid ? s + rpbl[dr * 31 + dc] - bound : -1e30f;
      }, lane, a0, a1);
    } else {
#pragma unroll
      for (int st = 0; st < 2; ++st)
        attn_step2(stage, 32 * st, qf, o, lsum, [&](int qt, int t2, int rr, float s) { return s - bound; }, lane, true, true);
    }
  }
#pragma unroll
  for (int qt = 0; qt < 2; ++qt) attn_store_out(p, o[qt], lsum[qt], qtok0 + 64 * qt, ooff, lane);
}

__device__ __forceinline__ void ph_attn(const P& p, int l, char* smem) {
  const int nitems = 1536 + (l == 0 ? 24 : 0);
  for (int it = blockIdx.x; it < nitems; it += gridDim.x) {
    if (it < 768) attn_win_item(p, l, 0, it / 6, it % 6, smem);
    else if (it < 1536) { int j = it - 768; attn_na_item(p, l, j / 6, j % 6, smem); }
    else { int j = it - 1536; attn_win_item(p, l, 1, j / 12, j % 12, smem); }
  }
}

__device__ __forceinline__ unsigned ord_key(float s) {
  unsigned u = __float_as_uint(s);
  return (u & 0x80000000u) ? ~u : (u | 0x80000000u);
}
__device__ __forceinline__ float ord_val(unsigned pk) {
  unsigned u = pk & ~127u;
  unsigned b = (u & 0x80000000u) ? (u & 0x7fffffffu) : ~u;
  return __uint_as_float(b);
}
__device__ __forceinline__ void ce_desc(unsigned& a, unsigned& b) {
  unsigned mx = a > b ? a : b, mn = a > b ? b : a;
  a = mx; b = mn;
}
__device__ __forceinline__ void sort16_desc(unsigned (&v)[16]) {
#pragma unroll
  for (int k = 2; k <= 16; k <<= 1) {
#pragma unroll
    for (int j = k >> 1; j > 0; j >>= 1) {
#pragma unroll
      for (int i = 0; i < 16; ++i) {
        int m = i ^ j;
        if (m > i) {
          if ((i & k) == 0) ce_desc(v[i], v[m]); else ce_desc(v[m], v[i]);
        }
      }
    }
  }
}
__device__ __forceinline__ void merge16_desc(unsigned (&a)[16], const unsigned (&b)[16]) {
#pragma unroll
  for (int i = 0; i < 16; ++i) { unsigned o = b[15 - i]; a[i] = a[i] > o ? a[i] : o; }
#pragma unroll
  for (int j = 8; j > 0; j >>= 1) {
#pragma unroll
    for (int i = 0; i < 16; ++i) {
      int m = i ^ j;
      if (m > i) ce_desc(a[i], a[m]);
    }
  }
}

typedef __attribute__((ext_vector_type(2))) float f32x2;
__device__ __forceinline__ void peer_convert_tail(const P& p, int l, int ntiles) {
  const int G = gridDim.x, extra = ntiles % G;
  const int first = (extra == 0) ? 0 : extra, np = G - first;
  const int idx = (int)blockIdx.x - first;
  if (idx < 0) return;
  const int q = (32768 + np - 1) / np;
  const int r0 = idx * q, r1 = min(r0 + q, 32768);
  peer_convert_rows(p, l, r0, r1);
}
__device__ __forceinline__ void ph_prep_small(const P& p) {
  for (int i = GTID; i < 2 * 128 * 128; i += GSZ) { p.k1b[i] = f2bf(p.k1[i]); p.k2b[i] = f2bf(p.k2[i]); }
}

struct EpiPeerTopk {
  int l;
  __device__ __forceinline__ void operator()(const P& p, f32x4 (&acc)[4][4], int m0, int n0, int wm, int wn, int lane, char* smem) const {
    const int tid = ((wm * 2 + wn) << 6) | lane, g = lane >> 4, lr = lane & 15;
    const int nt = n0 >> 7, head = nt >> 1, hf = nt & 1;
    char* qimg = smem;
    char* kimg = smem + 34816;
    float* rinvl = (float*)(smem + 69632);
    if (tid < 128) {
      float s = 0.f;
#pragma unroll
      for (int q = 0; q < 8; ++q) s += p.rowss[(size_t)q * TT + m0 + tid];
      rinvl[tid] = rsqrtf(s * (1.f / 1024.f) + EPS);
    }
    __syncthreads();
    {
      const float* bq = p.bq + (l * 2 + (m0 < LC ? 1 : 0)) * NPQ + n0 + wn * 64 + lr;
      float bqv[4];
#pragma unroll
      for (int j = 0; j < 4; ++j) bqv[j] = bq[16 * j];
      char* qw = qimg + (wm * 64 + 4 * g) * 272 + (wn * 64 + lr) * 2;
#pragma unroll
      for (int i = 0; i < 4; ++i)
#pragma unroll
        for (int r = 0; r < 4; ++r) {
          const float rv = rinvl[wm * 64 + 16 * i + 4 * g + r];
#pragma unroll
          for (int j = 0; j < 4; ++j) *(bf16_t*)(qw + (16 * i + r) * 272 + 32 * j) = f2bf(acc[i][j][r] * rv + bqv[j]);
        }
      const bf16_t* kk = (hf ? p.k2b : p.k1b) + (size_t)l * 16384 + (tid >> 4) * 128 + (tid & 15) * 8;
      char* kw = kimg + (tid >> 4) * 272 + (tid & 15) * 16;
#pragma unroll
      for (int i = 0; i < 8; ++i) *(uint4*)(kw + i * 16 * 272) = *(const uint4*)(kk + i * 16 * 128);
    }
    __syncthreads();
#pragma unroll
    for (int i = 0; i < 4; ++i)
#pragma unroll
      for (int j = 0; j < 4; ++j) acc[i][j] = (f32x4){0.f, 0.f, 0.f, 0.f};
    {
      const char* qa = qimg + (wm * 64 + lr) * 272 + g * 16;
      const char* kb = kimg + (wn * 64 + lr) * 272 + g * 16;
#pragma unroll
      for (int s = 0; s < 4; ++s) {
        bf16x8 af[4], bfr[4];
#pragma unroll
        for (int i = 0; i < 4; ++i) af[i] = *(const bf16x8*)(qa + i * 16 * 272 + s * 64);
#pragma unroll
        for (int j = 0; j < 4; ++j) bfr[j] = *(const bf16x8*)(kb + j * 16 * 272 + s * 64);
#pragma unroll
        for (int i = 0; i < 4; ++i)
#pragma unroll
          for (int j = 0; j < 4; ++j) acc[i][j] = __builtin_amdgcn_mfma_f32_16x16x32_bf16(af[i], bfr[j], acc[i][j], 0, 0, 0);
      }
    }
    __syncthreads();
    unsigned* simg = (unsigned*)smem;
    {
      unsigned* sw = simg + (wm * 64 + 4 * g) * 129 + wn * 64 + lr;
#pragma unroll
      for (int i = 0; i < 4; ++i)
#pragma unroll
        for (int r = 0; r < 4; ++r)
#pragma unroll
          for (int j = 0; j < 4; ++j)
            sw[(16 * i + r) * 129 + 16 * j] = (ord_key(acc[i][j][r]) & ~127u) | (unsigned)(wn * 64 + 16 * j + lr);
    }
    __syncthreads();
    const int row = tid & 127, half = tid >> 7;
    unsigned top[16];
    {
      const unsigned* sr = simg + row * 129 + half * 64;
#pragma unroll
      for (int k = 0; k < 16; ++k) top[k] = sr[k];
      sort16_desc(top);
#pragma unroll 1
      for (int gi = 1; gi < 4; ++gi) {
        unsigned v1[16];
#pragma unroll
        for (int k = 0; k < 16; ++k) v1[k] = sr[gi * 16 + k];
        sort16_desc(v1);
        merge16_desc(top, v1);
      }
    }
    __syncthreads();
    if (half == 1) {
#pragma unroll
      for (int k = 0; k < 16; ++k) simg[k * 128 + row] = top[k];
    }
    __syncthreads();
    if (half == 0) {
      unsigned o[16];
#pragma unroll
      for (int k = 0; k < 16; ++k) o[k] = simg[k * 128 + row];
      merge16_desc(top, o);
      uint4* dst = (uint4*)(p.pk + (((size_t)(m0 + row) * 8 + head) * 2 + hf) * 16);
#pragma unroll
      for (int k = 0; k < 4; ++k) dst[k] = make_uint4(top[4 * k], top[4 * k + 1], top[4 * k + 2], top[4 * k + 3]);
    }
  }
};

__device__ const unsigned char CAND_A[64] = {0,0,0,0,0,0,0,0,0,0,0,0,0,0,0,0, 1,1,1,1,1,1,1,1, 2,2,2,2,2, 3,3,3,3, 4,4,4, 5,5, 6,6, 7,7,
                                             8,9,10,11,12,13,14,15, 0,0,0,0,0,0,0,0,0,0,0,0,0,0};
__device__ const unsigned char CAND_B[64] = {0,1,2,3,4,5,6,7,8,9,10,11,12,13,14,15, 0,1,2,3,4,5,6,7, 0,1,2,3,4, 0,1,2,3, 0,1,2, 0,1, 0,1, 0,1,
                                             0,0,0,0,0,0,0,0, 0,0,0,0,0,0,0,0,0,0,0,0,0,0};

__device__ __forceinline__ void ph_peer_merge(const P& p, int l, int t0, char* smem) {
  const int tid = tid_opaque(), lane = tid & 63, wv = tid >> 6;
  const float* n2g = p.norm2_g + l * 1024;
  const int ca = CAND_A[lane], cb = CAND_B[lane];
  for (int tk = t0 + blockIdx.x * 4 + wv; tk < TT; tk += gridDim.x * 4) {
    const float* mod = p.mod + (l * 2 + (tk < LC ? 1 : 0)) * 6144;
    unsigned p1[8], p2[8];
    {
      const unsigned* pk = p.pk + (size_t)tk * 256;
#pragma unroll
      for (int head = 0; head < 8; ++head) { p1[head] = pk[head * 32 + ca]; p2[head] = pk[head * 32 + 16 + cb]; }
    }
    {
      const float4* xp = (const float4*)(p.xall + (size_t)tk * 1024) + lane * 4;
      float4 v[4];
      float ss = 0.f;
#pragma unroll
      for (int q = 0; q < 4; ++q) { v[q] = xp[q]; ss += v[q].x * v[q].x + v[q].y * v[q].y + v[q].z * v[q].z + v[q].w * v[q].w; }
      ss = wave_sum(ss);
      const float rinv = rsqrtf(ss * (1.f / 1024.f) + EPS);
      uint2* hp = (uint2*)(p.hb + (size_t)tk * 1024) + lane * 4;
#pragma unroll
      for (int q = 0; q < 4; ++q) {
        float4 gg = ((const float4*)n2g)[lane * 4 + q], sc = ((const float4*)(mod + 4096))[lane * 4 + q], sh = ((const float4*)(mod + 3072))[lane * 4 + q];
        float h0 = v[q].x * rinv * gg.x * (1.f + sc.x) + sh.x, h1 = v[q].y * rinv * gg.y * (1.f + sc.y) + sh.y;
        float h2 = v[q].z * rinv * gg.z * (1.f + sc.z) + sh.z, h3 = v[q].w * rinv * gg.w * (1.f + sc.w) + sh.w;
        hp[q] = make_uint2(pack2bf(h0, h1), pack2bf(h2, h3));
      }
    }
    float sums[8];
    unsigned* candk = (unsigned*)smem + wv * 512;
#pragma unroll
    for (int head = 0; head < 8; ++head) {
      sums[head] = lane < 50 ? ord_val(p1[head]) + ord_val(p2[head]) : -3.0e38f;
      candk[head * 64 + lane] = (ord_key(sums[head]) & ~63u) | (unsigned)(63 - lane);
    }
#pragma unroll
    for (int head = 0; head < 8; ++head) {
      const float sum = sums[head];
      const unsigned kme = (ord_key(sum) & ~63u) | (unsigned)(63 - lane);
      int eid = (int)(p1[head] & 127u) * 128 + (int)(p2[head] & 127u);
      int rank = 0;
#pragma unroll
      for (int m4 = 0; m4 < 13; ++m4) {
        const uint4 km = *(const uint4*)(candk + head * 64 + 4 * m4);
        rank += (km.x > kme) ? 1 : 0;
        rank += (km.y > kme) ? 1 : 0;
        rank += (km.z > kme) ? 1 : 0;
        rank += (km.w > kme) ? 1 : 0;
      }
      float mx = wave_max(sum);
      bool sel = (lane < 50) && (rank < 16);
      float e = sel ? __expf(sum - mx) : 0.f;
      float tot = wave_sum(e);
      if (sel) {
        const int n = head * 16 + rank, idx = (n & 7) * 16 + (n >> 3);
        p.el[(size_t)tk * 128 + idx] = eid;
        p.gl[(size_t)tk * 128 + idx] = e / tot;
      }
    }
  }
}

struct XcdWork { int li, np, rank, nloc; };

__device__ __forceinline__ XcdWork load_xw(const float* smem) {
  const volatile LAS unsigned* st = (const volatile LAS unsigned*)(smem + 18432);
  XcdWork xw;
  xw.nloc = __builtin_amdgcn_readfirstlane((int)st[0]); xw.np = __builtin_amdgcn_readfirstlane((int)st[1]);
  xw.rank = __builtin_amdgcn_readfirstlane((int)st[2]); xw.li = __builtin_amdgcn_readfirstlane((int)st[3]);
  return xw;
}
__device__ __forceinline__ void ph_peer_s1(const P& p, int l, int t0, const XcdWork& xw) {
  const int tid = tid_opaque(), lane = tid & 63, wv = tid >> 6, j = lane >> 3, k = lane & 7;
  const unsigned char* U = p.ub8 + (size_t)l * 16384 * 1024;
  const int step = xw.nloc * 4;
  for (int s = xw.li; s < 8; s += xw.np) {
    const unsigned roff = 128u * s + 16u * k;
    const unsigned char* Us = U + (size_t)s * 16384 * 128 + 16 * k;
    const int tk0 = t0 + xw.rank * 4 + wv;
    if (tk0 >= TT) continue;
    uint4 ur[2][16]; uint4 hh[2][2]; int4 en[4];
#define S1_LOAD_LIST(TK) { const int4* ep = (const int4*)(p.el + (size_t)(TK) * 128 + j * 16); _Pragma("unroll") for (int q = 0; q < 4; ++q) en[q] = ep[q]; }
#define S1_ISSUE(B, TK) {                                                                            \
      _Pragma("unroll") for (int q = 0; q < 4; ++q) {                                                \
        ur[B][4 * q + 0] = *(const uint4*)(Us + ((unsigned)en[q].x * 128u));                  \
        ur[B][4 * q + 1] = *(const uint4*)(Us + ((unsigned)en[q].y * 128u));                  \
        ur[B][4 * q + 2] = *(const uint4*)(Us + ((unsigned)en[q].z * 128u));                  \
        ur[B][4 * q + 3] = *(const uint4*)(Us + ((unsigned)en[q].w * 128u));                  \
      }                                                                                              \
      const uint4* hp = (const uint4*)(p.hb + (size_t)(TK) * 1024 + roff);                           \
      hh[B][0] = hp[0]; hh[B][1] = hp[1]; }
#define S1_CONSUME(B, TK) {                                                                          \
      float hv[16];                                                                                  \
      { unsigned w[8] = {hh[B][0].x, hh[B][0].y, hh[B][0].z, hh[B][0].w, hh[B][1].x, hh[B][1].y, hh[B][1].z, hh[B][1].w}; \
        _Pragma("unroll") for (int q = 0; q < 8; ++q) { hv[2 * q] = __uint_as_float(w[q] << 16); hv[2 * q + 1] = __uint_as_float(w[q] & 0xffff0000u); } } \
      float keep0 = 0.f, keep1 = 0.f;                                                                \
      _Pragma("unroll") for (int i = 0; i < 16; ++i) {                                               \
        unsigned w[4] = {ur[B][i].x, ur[B][i].y, ur[B][i].z, ur[B][i].w};                            \
        float dot = 0.f;                                                                             \
        _Pragma("unroll") for (int q = 0; q < 4; ++q) {                                              \
          f32x2 lo = __builtin_amdgcn_cvt_pk_f32_fp8((int)w[q], false), hi = __builtin_amdgcn_cvt_pk_f32_fp8((int)w[q], true); \
          dot += lo[0] * hv[q * 4] + lo[1] * hv[q * 4 + 1] + hi[0] * hv[q * 4 + 2] + hi[1] * hv[q * 4 + 3]; \
        }                                                                                            \
        dot += dpp_row<0xB1>(dot); dot += dpp_row<0x4E>(dot); dot += dpp_row<0x141>(dot);            \
        if (i < 8) keep0 = (k == i) ? dot : keep0; else keep1 = (k == i - 8) ? dot : keep1;          \
      }                                                                                              \
      float* pd = p.pd + ((size_t)s * TT + (TK)) * 128;                                              \
      pd[8 * k + j] = keep0; pd[8 * (k + 8) + j] = keep1; }
    S1_LOAD_LIST(tk0)
    S1_ISSUE(0, tk0)
    if (tk0 + step < TT) S1_LOAD_LIST(tk0 + step)
    for (int tk = tk0; tk < TT; tk += 2 * step) {
      const bool has1 = tk + step < TT, has2 = tk + 2 * step < TT;
      if (has1) { S1_ISSUE(1, tk + step) if (has2) S1_LOAD_LIST(tk + 2 * step) }
      S1_CONSUME(0, tk)
      if (has1) {
        if (has2) { S1_ISSUE(0, tk + 2 * step) if (tk + 3 * step < TT) S1_LOAD_LIST(tk + 3 * step) }
        S1_CONSUME(1, tk + step)
      }
    }
#undef S1_LOAD_LIST
#undef S1_ISSUE
#undef S1_CONSUME
  }
}

__device__ __forceinline__ void ph_peer_r(const P& p, int l, int t0) {
  const float* usc = p.usc + l * 16384;
  const float* vsc = p.vsc + l * 16384;
  for (int idx = GTID; idx < (TT - t0) * 32; idx += GSZ) {
    const int tk = t0 + (idx >> 5), n0 = (idx & 31) * 4;
    float4 d = make_float4(0.f, 0.f, 0.f, 0.f);
#pragma unroll
    for (int s = 0; s < 8; ++s) {
      const float4 v = *(const float4*)(p.pd + ((size_t)s * TT + tk) * 128 + n0);
      d.x += v.x; d.y += v.y; d.z += v.z; d.w += v.w;
    }
    float dv[4] = {d.x, d.y, d.z, d.w};
#pragma unroll
    for (int q = 0; q < 4; ++q) {
      const int n = n0 + q, li = (n & 7) * 16 + (n >> 3);
      const int ex = p.el[(size_t)tk * 128 + li];
      p.av[(size_t)tk * 128 + li] = p.gl[(size_t)tk * 128 + li] * gelu_f(dv[q] * usc[ex]) * vsc[ex];
    }
  }
}

__device__ __forceinline__ void ph_peer_s2(const P& p, int l, int t0, const XcdWork& xw, char* smem) {
  const int tid = tid_opaque(), lane = tid & 63, wv = tid >> 6, j = lane >> 3, k = lane & 7;
  const int ko = lane >> 3, jo = lane & 7;
  float* red = (float*)smem + wv * 1024;
  const unsigned char* V = p.vb8 + (size_t)l * 16384 * 1024;
  const int step = xw.nloc * 4;
  for (int s = xw.li; s < 8; s += xw.np) {
    const unsigned char* Vs = V + (size_t)s * 16384 * 128 + 16 * k;
    const int dim = 128 * s + 16 * ko + 2 * jo;
    int tk = t0 + xw.rank * 4 + wv;
    int4 en[4];
    if (tk < TT) {
      const int4* ep = (const int4*)(p.el + (size_t)tk * 128 + j * 16);
#pragma unroll
      for (int q = 0; q < 4; ++q) en[q] = ep[q];
    }
    for (; tk < TT; tk += step) {
      uint4 vr[16];
#pragma unroll
      for (int q = 0; q < 4; ++q) {
        vr[4 * q + 0] = *(const uint4*)(Vs + ((unsigned)en[q].x * 128u));
        vr[4 * q + 1] = *(const uint4*)(Vs + ((unsigned)en[q].y * 128u));
        vr[4 * q + 2] = *(const uint4*)(Vs + ((unsigned)en[q].z * 128u));
        vr[4 * q + 3] = *(const uint4*)(Vs + ((unsigned)en[q].w * 128u));
      }
      float4 an[4];
      {
        const float4* ap = (const float4*)(p.av + (size_t)tk * 128 + j * 16);
#pragma unroll
        for (int q = 0; q < 4; ++q) an[q] = ap[q];
      }
      const float* mod = p.mod + (l * 2 + (tk < LC ? 1 : 0)) * 6144;
      const float2 g2 = *(const float2*)(mod + 5120 + dim);
      const float2 xin = *(const float2*)(p.xall + (size_t)tk * 1024 + dim);
      if (tk + step < TT) {
        const int4* ep = (const int4*)(p.el + (size_t)(tk + step) * 128 + j * 16);
#pragma unroll
        for (int q = 0; q < 4; ++q) en[q] = ep[q];
      }
      float acc[16];
#pragma unroll
      for (int d = 0; d < 16; ++d) acc[d] = 0.f;
#pragma unroll
      for (int i = 0; i < 16; ++i) {
        const float a = (i & 3) == 0 ? an[i >> 2].x : (i & 3) == 1 ? an[i >> 2].y : (i & 3) == 2 ? an[i >> 2].z : an[i >> 2].w;
        unsigned y[4] = {vr[i].x, vr[i].y, vr[i].z, vr[i].w};
#pragma unroll
        for (int q = 0; q < 4; ++q) {
          f32x2 lo = __builtin_amdgcn_cvt_pk_f32_fp8((int)y[q], false), hi = __builtin_amdgcn_cvt_pk_f32_fp8((int)y[q], true);
          acc[q * 4] += a * lo[0]; acc[q * 4 + 1] += a * lo[1]; acc[q * 4 + 2] += a * hi[0]; acc[q * 4 + 3] += a * hi[1];
        }
        if (i + 1 < 16) asm volatile("" : "+v"(acc[0]), "+v"(vr[i + 1].x), "+v"(vr[i + 1].y), "+v"(vr[i + 1].z), "+v"(vr[i + 1].w));
      }
#pragma unroll
      for (int q = 0; q < 4; ++q) *(float4*)(red + lane * 16 + 4 * q) = make_float4(acc[4 * q], acc[4 * q + 1], acc[4 * q + 2], acc[4 * q + 3]);
      float f0 = 0.f, f1 = 0.f;
#pragma unroll
      for (int jj = 0; jj < 8; ++jj) {
        const float2 t = *(const float2*)(red + (jj * 8 + ko) * 16 + 2 * jo);
        f0 += t.x; f1 += t.y;
      }
      float2 o = make_float2(xin.x + g2.x * f0, xin.y + g2.y * f1);
      if (l == 1) *(float2*)(p.out + (size_t)(tk - LC) * 1024 + dim) = o;
      else *(float2*)(p.xall + (size_t)tk * 1024 + dim) = o;
    }
  }
}

#define XB_TMO      128
#define XB_XCNT(j)  (256  + 64 * (j))
#define XB_XSUB(j)  (1280 + 64 * (j))
#define XB_XGEN(j)  (2304 + 64 * (j))
#define XB_TOP      3328
#define XB_TOPGEN   3392
#define XB_RANK(j)  (3456 + 64 * (j))
#define XCD_BAR_WORDS 4480
#define XB_SPIN_CAP (1u << 22)
__device__ __forceinline__ unsigned xb_ld(unsigned* q) { return __hip_atomic_load(q, __ATOMIC_RELAXED, __HIP_MEMORY_SCOPE_AGENT); }
__device__ __forceinline__ unsigned xb_add(unsigned* q, unsigned v) { return __hip_atomic_fetch_add(q, v, __ATOMIC_RELAXED, __HIP_MEMORY_SCOPE_AGENT); }
__device__ __forceinline__ unsigned xb_xcc_id() { return (unsigned)__builtin_amdgcn_s_getreg((3 << 11) | 20) & 0xFu; }
#define XB_SPIN(cond, bar) do { unsigned _sp = 0; while (cond) { __builtin_amdgcn_s_sleep(1); \
    if ((++_sp & 255u) == 0u) { if (xb_ld(&(bar)[XB_TMO])) break; if (_sp > XB_SPIN_CAP) { atomicAdd(&(bar)[XB_TMO], 1u); break; } } } } while (0)
struct XcdBarrier { unsigned* bar; unsigned x; volatile LAS unsigned* st; };
__device__ __forceinline__ XcdBarrier xcd_barrier_post(unsigned* bar, volatile LAS unsigned* st) {
  XcdBarrier b; b.bar = bar; b.x = xb_xcc_id(); b.st = st;
  if (threadIdx.x == 0) { (void)xb_add(&bar[XB_XCNT(b.x)], 1u); st[2] = xb_add(&bar[XB_RANK(b.x)], 1u); }
  return b;
}
__device__ __forceinline__ void xcd_barrier_complete(unsigned* bar, unsigned x, unsigned& nloc, unsigned& nx, unsigned& li) {
  const unsigned G = gridDim.x * gridDim.y * gridDim.z;
  unsigned sum, cnt, mine, below, sp = 0u;
  for (;;) {
    sum = 0u; cnt = 0u; mine = 0u; below = 0u;
#pragma unroll
    for (unsigned j = 0; j < 16; ++j) { const unsigned c = xb_ld(&bar[XB_XCNT(j)]); sum += c; cnt += (c > 0u) ? 1u : 0u; mine = (j == x) ? c : mine; below += (j < x && c > 0u) ? 1u : 0u; }
    if (sum == G) break;
    __builtin_amdgcn_s_sleep(1);
    if ((++sp & 255u) == 0u) { if (xb_ld(&bar[XB_TMO])) break; if (sp > XB_SPIN_CAP) { atomicAdd(&bar[XB_TMO], 1u); break; } }
  }
  nloc = mine > 0u ? mine : 1u; nx = cnt > 0u ? cnt : 1u; li = below;
}
__device__ __forceinline__ void xcd_barrier(const XcdBarrier& b) {
  asm volatile("s_waitcnt vmcnt(0)" ::: "memory");
  __syncthreads();
  if (threadIdx.x == 0) {
    unsigned* bar = b.bar;
    __builtin_amdgcn_s_waitcnt(0);
    unsigned nloc = b.st[0], nx = b.st[1];
    if (nloc == 0u) { unsigned li; xcd_barrier_complete(bar, b.x, nloc, nx, li); b.st[0] = nloc; b.st[1] = nx; b.st[3] = li; }
    const unsigned old = xb_add(&bar[XB_XSUB(b.x)], 1u);
    const unsigned gen = old / nloc;
    if (old + 1u == (gen + 1u) * nloc) {
      __builtin_amdgcn_fence(__ATOMIC_RELEASE, "agent");
      asm volatile("s_waitcnt vmcnt(0)" ::: "memory");
      const unsigned og = xb_add(&bar[XB_TOP], 1u);
      const unsigned tg = og / nx;
      if (og + 1u == (tg + 1u) * nx) xb_add(&bar[XB_TOPGEN], 1u);
      else XB_SPIN(xb_ld(&bar[XB_TOPGEN]) == tg, bar);
      __builtin_amdgcn_fence(__ATOMIC_ACQUIRE, "agent");
      xb_add(&bar[XB_XGEN(b.x)], 1u);
      asm volatile("s_waitcnt vmcnt(0)" ::: "memory");
    } else {
      XB_SPIN(xb_ld(&bar[XB_XGEN(b.x)]) == gen, bar);
      __builtin_amdgcn_fence(__ATOMIC_ACQUIRE, "agent");
      asm volatile("s_waitcnt vmcnt(0)" ::: "memory");
    }
  }
  __syncthreads();
}

#ifndef PROBE_IV
#define PROBE_IV -1
#endif
__device__ __forceinline__ void probe_tick(int& cnt, unsigned long long* slots) {
  if (PROBE_IV >= 0) {
    if (threadIdx.x == 0 && (cnt == PROBE_IV || cnt == PROBE_IV + 1)) slots[cnt - PROBE_IV] = __builtin_amdgcn_s_memrealtime();
    cnt = __builtin_amdgcn_readfirstlane(cnt + 1);
  }
}
#define BARRIER() do { XcdBarrier xb_; xb_.bar = PP.bar; xb_.x = xb_xcc_id(); xb_.st = (volatile LAS unsigned*)(smem + 18432); xcd_barrier(xb_); probe_tick(pcnt, probe_t); } while (0)

typedef const __attribute__((address_space(4))) P* KP;
__device__ __forceinline__ P load_params(KP kp) {
#if defined(__HIP_DEVICE_COMPILE__)
  asm volatile("" : "+s"(kp));
  return *kp;
#else
  return P{};
#endif
}
#define PP load_params(kp)
__global__ void __launch_bounds__(256, 2) k_mega(P p_unused) {
  KP kp = (KP)__builtin_amdgcn_kernarg_segment_ptr();
  __shared__ __attribute__((aligned(16))) float smem[18432 + 8];
  uint4& xb_words = *(uint4*)(smem + 18432);
  cg::grid_group grid = cg::this_grid();
  if (threadIdx.x == 0) xb_words = make_uint4(0u, 0u, 0u, 0u);
  __syncthreads();
  unsigned long long* probe_t = (unsigned long long*)(smem + 18436);
  int pcnt = 0;
  asm volatile("" : "+s"(pcnt));
  probe_tick(pcnt, probe_t);
  ph_mod(PP, smem);
  ph_prep(PP, smem);
  ph_lru_prepw(PP);
  ph_rope_tab(PP);
  ph_prep_small(PP);
  grid.sync();
  probe_tick(pcnt, probe_t);
  (void)xcd_barrier_post(PP.bar, (volatile LAS unsigned*)&xb_words);
  ph_norm_mod(PP, 0, 0, 0, smem, true);
  ph_bq(PP, smem);
  BARRIER();
#pragma unroll 1
  for (int l = 0; l < 2; ++l) {
    const int t0 = (l == 0) ? 0 : LC;
    { const P lp = PP; gemm_bf16_128(lp, lp.hb, lp.w_in_t + (size_t)l * 1024 * DIN, 1024, 0, TT, DIN, (char*)smem, EpiProj{l}, l == 0 ? 0 : -1, 15); }
    BARRIER();
    ph_lru<1>(PP, l, (char*)smem);
    ph_attn(PP, l, (char*)smem);
    BARRIER();
    ph_lru_carry(PP, smem);
    BARRIER();
    ph_lru<2>(PP, l, (char*)smem);
    BARRIER();
    { const P lp = PP; gemm_bf16_128(lp, lp.mixb, lp.w_out_t + (size_t)l * 1024 * 1024, 1024, t0, TT, 1024, (char*)smem, EpiResid{l}, l == 0 ? 1 : -1, 32); }
    BARRIER();
    { const P lp = PP; gemm_bf16_128(lp, lp.hb, lp.wq_t + (size_t)l * 1024 * NPQ, 1024, t0, TT, NPQ, (char*)smem, EpiPeerTopk{l}); }
    BARRIER();
    ph_peer_merge(PP, l, t0, (char*)smem);
    BARRIER();
    ph_peer_s1(PP, l, t0, load_xw(smem));
    BARRIER();
    ph_peer_r(PP, l, t0);
    BARRIER();
    ph_peer_s2(PP, l, t0, load_xw(smem), (char*)smem);
    if (l == 0) {
      BARRIER();
      ph_norm_mod(PP, 1, 0, 0, smem);
      BARRIER();
    }
  }
  if (PROBE_IV >= 0) {
    probe_tick(pcnt, probe_t);
    __syncthreads();
    if (blockIdx.x == 0 && threadIdx.x == 0) {
      const unsigned long long dt = (probe_t[1] - probe_t[0]) * 8ull, ts = __builtin_amdgcn_s_memrealtime();
      while (__builtin_amdgcn_s_memrealtime() - ts < dt) __builtin_amdgcn_s_sleep(8);
    }
  }
}

extern "C" void kernel_launch(void* const* d_in, const int* in_sizes, int n_in, void* d_out, int out_size, void* d_ws,
                              size_t ws_size, hipStream_t stream) {
  P p{};
  const float** fp = (const float**)&p;
  for (int i = 0; i < 28; ++i) fp[i] = (const float*)d_in[i];
  p.out = (float*)d_out;
  float* w = (float*)d_ws;
  size_t o = 0;
  auto carve = [&](size_t n) { float* r = w + o; o += (n + 63) & ~(size_t)63; return r; };
  p.bar = (unsigned*)carve(8192);
  p.mod = carve(4 * 6144);
  p.xall = carve((size_t)TT * 1024);
  p.proj = carve((size_t)TT * 512);
  p.projb = (bf16_t*)carve((size_t)TT * DIN / 2);
  p.mixb = (bf16_t*)carve((size_t)TT * 512);
  p.hb = (bf16_t*)carve((size_t)TT * 512);
  p.w_in_t = (bf16_t*)carve((size_t)1024 * DIN);
  p.w_out_t = (bf16_t*)carve((size_t)1024 * 1024);
  p.wq_t = (bf16_t*)carve((size_t)1024 * NPQ);
  p.lruw_t = (bf16_t*)carve((size_t)2 * 2 * 4 * 2 * 4096 / 2);
  p.lagg = carve((size_t)2 * NCHUNK * 256 * 2);
  p.lcarry = carve((size_t)2 * NCHUNK * 256);
  p.ropetab = carve(320 * 16 * 2);
  p.rowss = carve((size_t)8 * TT);
  p.bq = carve(4 * NPQ);
  p.el = (int*)carve((size_t)TT * 128);
  p.gl = carve((size_t)TT * 128);
  p.av = carve((size_t)TT * 128);
  p.pd = carve((size_t)8 * TT * 128);
  p.pk = (unsigned*)carve((size_t)TT * 256);
  p.ub8 = (unsigned char*)carve((size_t)2 * 16384 * 1024 / 4);
  p.vb8 = (unsigned char*)carve((size_t)2 * 16384 * 1024 / 4);
  p.usc = carve(2 * 16384);
  p.vsc = carve(2 * 16384);
  p.k1b = (bf16_t*)carve(16384);
  p.k2b = (bf16_t*)carve(16384);
  if (o * 4 > ws_size) { fprintf(stderr, "workspace too small: need %zu have %zu\n", o * 4, ws_size); return; }
  static int grid_blocks = 0;
  if (!grid_blocks) {
    int dev = 0, cus = 0, per_cu = 0;
    (void)hipGetDevice(&dev);
    (void)hipDeviceGetAttribute(&cus, hipDeviceAttributeMultiprocessorCount, dev);
    (void)hipOccupancyMaxActiveBlocksPerMultiprocessor(&per_cu, k_mega, 256, 0);
    if (per_cu > 2) per_cu = 2;
    grid_blocks = cus * per_cu;
  }
  (void)hipMemsetAsync(p.bar, 0, XCD_BAR_WORDS * 4, stream);
  void* args[] = {&p};
  hipError_t e = hipLaunchCooperativeKernel((void*)k_mega, dim3(grid_blocks), dim3(256), args, 0, stream);
  if (e != hipSuccess) fprintf(stderr, "cooperative launch failed: %s (grid %d)\n", hipGetErrorString(e), grid_blocks);
}
```

```cpp
#include <hip/hip_runtime.h>
#include <hip/hip_cooperative_groups.h>
#include <stdint.h>
#include <stdio.h>
namespace cg = cooperative_groups;

#ifndef SINGLE_LAUNCH
#define SINGLE_LAUNCH 1
#endif

constexpr int DM = 1024, SEQ = 16384, LC = 256, TT = SEQ + LC, DIN = 2304, NPQ = 2048;
constexpr int OFF_XA = 0, OFF_GA = 256, OFF_QW = 512, OFF_KW = 896, OFF_VW = 1024, OFF_QN = 1152, OFF_KN = 1536, OFF_VN = 1920;
constexpr float EPS = 1e-6f;
#define LAS __attribute__((address_space(3)))
constexpr float LOG2E = 1.4426950408889634f;
constexpr float QSCALE = 0.125f * LOG2E;

struct P {
  const float *x, *c, *ctx, *c_ctx, *w_mod, *b_mod, *norm1_g, *norm2_g, *w_in, *w_out,
      *conv_w, *conv_b, *wa, *ba, *wx, *bx, *lam, *win_qn, *win_kn, *win_sink, *na_qn, *na_kn, *rpb,
      *wq, *k1, *k2, *pu, *pv;
  float* out;
  float *mod, *xall, *proj;
  unsigned short* projb;
  unsigned* pk;
  unsigned* bar;
  unsigned short *k1b, *k2b;
  unsigned char *ub8, *vb8;
  float *usc, *vsc;
  unsigned short *hb, *mixb, *w_in_t, *w_out_t, *wq_t, *lruw_t;
  float *lagg, *lcarry, *ropetab, *rowss, *bq, *bin, *gl, *av, *pd;
  unsigned short* shb;
  int* el;
};

typedef unsigned short bf16_t;
typedef __attribute__((ext_vector_type(8))) short bf16x8;
typedef __attribute__((ext_vector_type(4))) float f32x4;
__device__ __forceinline__ unsigned short f2bf(float f) {
  unsigned u = __float_as_uint(f);
  u += 0x7fffu + ((u >> 16) & 1u);
  return (unsigned short)(u >> 16);
}
__device__ __forceinline__ unsigned pack2bf(float a, float b) { return (unsigned)f2bf(a) | ((unsigned)f2bf(b) << 16); }
__device__ __forceinline__ float bf2f(unsigned short h) { return __uint_as_float(((unsigned)h) << 16); }


__device__ __forceinline__ float silu_f(float x) { return x / (1.f + __expf(-x)); }
__device__ __forceinline__ float sigmoid_f(float x) { return 1.f / (1.f + __expf(-x)); }
__device__ __forceinline__ float gelu_f(float x) {
  float u = 0.7978845608028654f * (x + 0.044715f * x * x * x);
  float e = __expf(2.f * u);
  float th = 1.f - 2.f / (e + 1.f);
  return 0.5f * x * (1.f + th);
}
template <int CTRL, int RMASK>
__device__ __forceinline__ float dpp_mov(float v) {
  return __int_as_float(__builtin_amdgcn_update_dpp(0, __float_as_int(v), CTRL, RMASK, 0xf, false));
}
__device__ __forceinline__ float wave_sum(float v) {
  v += dpp_mov<0xB1, 0xf>(v);
  v += dpp_mov<0x4E, 0xf>(v);
  v += dpp_mov<0x141, 0xf>(v);
  v += dpp_mov<0x140, 0xf>(v);
  v += dpp_mov<0x142, 0xa>(v);
  v += dpp_mov<0x143, 0xc>(v);
  return __int_as_float(__builtin_amdgcn_readlane(__float_as_int(v), 63));
}

__device__ __forceinline__ int tid_opaque() { int t = threadIdx.x; asm volatile("" : "+v"(t)); return t; }
#define GTID (blockIdx.x * blockDim.x + tid_opaque())
#define GSZ (gridDim.x * blockDim.x)

__device__ __forceinline__ void ph_mod(const P& p, float* smem) {
  const int tid = tid_opaque(), cl = tid & 31, ks = tid >> 5;
  for (int it = blockIdx.x; it < 2 * 192; it += gridDim.x) {
    const int nc = it % 192, l = it / 192;
    const int n = nc * 32 + cl;
    const float* w = p.w_mod + (size_t)l * 1024 * 6144 + n;
    float a0 = 0.f, a1 = 0.f;
#pragma unroll 8
    for (int i = 0; i < 128; ++i) {
      int k = i * 8 + ks;
      float wv = w[(size_t)k * 6144];
      a0 += silu_f(p.c[k]) * wv;
      a1 += silu_f(p.c_ctx[k]) * wv;
    }
    __syncthreads();
    smem[tid] = a0; smem[256 + tid] = a1;
    __syncthreads();
    if (tid < 64) {
      const int which = tid >> 5;
      float s = p.b_mod[l * 6144 + n];
#pragma unroll
      for (int q = 0; q < 8; ++q) s += smem[which * 256 + q * 32 + cl];
      p.mod[(l * 2 + which) * 6144 + n] = s;
    }
  }
}

__device__ __forceinline__ void ph_bq(const P& p, float* smem) {
  const int tid = tid_opaque(), cl = tid & 31, ks = tid >> 5;
  for (int it = blockIdx.x; it < 2 * 64; it += gridDim.x) {
    const int nc = it % 64, l = it / 64;
    const int n = nc * 32 + cl;
    const float* w = p.wq + (size_t)l * 1024 * NPQ + n;
    const float* v0 = p.mod + (l * 2 + 0) * 6144 + 3072;
    const float* v1 = p.mod + (l * 2 + 1) * 6144 + 3072;
    float a0 = 0.f, a1 = 0.f;
#pragma unroll 8
    for (int i = 0; i < 128; ++i) {
      int k = i * 8 + ks;
      float wv = w[(size_t)k * NPQ];
      a0 += v0[k] * wv;
      a1 += v1[k] * wv;
    }
    __syncthreads();
    smem[tid] = a0; smem[256 + tid] = a1;
    __syncthreads();
    if (tid < 64) {
      const int which = tid >> 5;
      float s = 0.f;
#pragma unroll
      for (int q = 0; q < 8; ++q) s += smem[which * 256 + q * 32 + cl];
      p.bq[(l * 2 + which) * NPQ + n] = s;
    }
  }
}

__device__ __forceinline__ void ph_shb(const P& p) {
  for (int idx = GTID; idx < 3 * 2 * 1024; idx += GSZ) {
    const int k = idx & 1023, which = (idx >> 10) & 1, m = idx >> 11;
    const int l = (m == 0) ? 0 : 1, off = (m == 2) ? 0 : 3072;
    p.shb[((size_t)m * 128 + which) * 1024 + k] = f2bf(p.mod[(l * 2 + which) * 6144 + off + k]);
  }
}

__device__ __forceinline__ void ph_copy_in(const P& p) {
  const float4* xs = (const float4*)p.x;
  const float4* cs = (const float4*)p.ctx;
  float4* d = (float4*)p.xall;
  for (int i = GTID; i < TT * 256; i += GSZ) d[i] = (i < LC * 256) ? cs[i] : xs[i - LC * 256];
}

__device__ __forceinline__ void ph_copy_out(const P& p) {
  const float4* s = (const float4*)(p.xall + (size_t)LC * 1024);
  float4* d = (float4*)p.out;
  for (int i = GTID; i < SEQ * 256; i += GSZ) d[i] = s[i];
}

__device__ __forceinline__ void ph_norm_mod(const P& p, int l, int which_norm, int t0, float* smem, bool from_input = false) {
  const float* g = (which_norm ? p.norm2_g : p.norm1_g) + l * 1024;
  const int sh_off = which_norm ? 3072 : 0, sc_off = which_norm ? 4096 : 1024;
  const int tid = tid_opaque();
  for (int t = t0 + blockIdx.x; t < TT; t += gridDim.x) {
    const float* mod = p.mod + (l * 2 + (t < LC ? 1 : 0)) * 6144;
    float4 v;
    if (from_input) {
      v = t < LC ? ((const float4*)(p.ctx + (size_t)t * 1024))[tid] : ((const float4*)(p.x + (size_t)(t - LC) * 1024))[tid];
      ((float4*)(p.xall + (size_t)t * 1024))[tid] = v;
    } else v = ((const float4*)(p.xall + (size_t)t * 1024))[tid];
    float ss = wave_sum(v.x * v.x + v.y * v.y + v.z * v.z + v.w * v.w);
    __syncthreads();
    if ((tid & 63) == 0) smem[tid >> 6] = ss;
    __syncthreads();
    float tot = smem[0] + smem[1] + smem[2] + smem[3];
    float rinv = rsqrtf(tot * (1.f / 1024.f) + EPS);
    float4 gg = ((const float4*)g)[tid];
    float4 sc = ((const float4*)(mod + sc_off))[tid];
    float4 sh = ((const float4*)(mod + sh_off))[tid];
    float4 o;
    o.x = v.x * rinv * gg.x * (1.f + sc.x) + sh.x;
    o.y = v.y * rinv * gg.y * (1.f + sc.y) + sh.y;
    o.z = v.z * rinv * gg.z * (1.f + sc.z) + sh.z;
    o.w = v.w * rinv * gg.w * (1.f + sc.w) + sh.w;
    ((uint2*)(p.hb + (size_t)t * 1024))[tid] = make_uint2(pack2bf(o.x, o.y), pack2bf(o.z, o.w));
  }
}

__device__ __forceinline__ void prep_transpose(const float* W, bf16_t* Wt, int K, int N, int item0, int nitems_total, float* smem) {
  (void)nitems_total;
  float(*ts)[65] = (float(*)[65])smem;
  const int tid = tid_opaque();
  const int tn = N / 64, nt = (K / 64) * tn;
  for (int it = blockIdx.x; it < nt; it += gridDim.x) {
    int k0 = (it / tn) * 64, n0 = (it % tn) * 64;
    __syncthreads();
#pragma unroll
    for (int i = 0; i < 16; ++i) {
      int r = (tid >> 6) + i * 4, c = tid & 63;
      ts[r][c] = W[(size_t)(k0 + r) * N + n0 + c];
    }
    __syncthreads();
#pragma unroll
    for (int i = 0; i < 16; ++i) {
      int r = (tid >> 6) + i * 4, c = tid & 63;
      Wt[(size_t)(n0 + r) * K + k0 + c] = f2bf(ts[c][r]);
    }
  }
  (void)item0;
}

__device__ __forceinline__ void ph_prep(const P& p, float* smem) {
  for (int l = 0; l < 2; ++l) {
    prep_transpose(p.w_in + (size_t)l * 1024 * DIN, p.w_in_t + (size_t)l * 1024 * DIN, 1024, DIN, 0, 0, smem);
    prep_transpose(p.w_out + (size_t)l * 1024 * 1024, p.w_out_t + (size_t)l * 1024 * 1024, 1024, 1024, 0, 0, smem);
    prep_transpose(p.wq + (size_t)l * 1024 * NPQ, p.wq_t + (size_t)l * 1024 * NPQ, 1024, NPQ, 0, 0, smem);
  }
}

struct EpiStoreF32 {
  float* C; int ldc;
  __device__ __forceinline__ void operator()(const P& p, f32x4 (&acc)[4][4], int m0, int n0, int wm, int wn, int lane, char* smem) const {
    const int mw0 = m0 + wm * 64, nw0 = n0 + wn * 64;
#pragma unroll
    for (int i = 0; i < 4; ++i)
#pragma unroll
      for (int r = 0; r < 4; ++r) {
        int row = mw0 + 16 * i + (lane >> 4) * 4 + r;
#pragma unroll
        for (int j = 0; j < 4; ++j) C[(size_t)row * ldc + nw0 + 16 * j + (lane & 15)] = acc[i][j][r];
      }
  }
};
struct EpiProjSplit {
  __device__ __forceinline__ void operator()(const P& p, f32x4 (&acc)[4][4], int m0, int n0, int wm, int wn, int lane, char* smem) const {
    const int mw0 = m0 + wm * 64, nw0 = n0 + wn * 64;
#pragma unroll
    for (int i = 0; i < 4; ++i)
#pragma unroll
      for (int r = 0; r < 4; ++r) {
        int row = mw0 + 16 * i + (lane >> 4) * 4 + r;
#pragma unroll
        for (int j = 0; j < 4; ++j) {
          int col = nw0 + 16 * j + (lane & 15);
          if (n0 < 512) p.proj[(size_t)row * 512 + col] = acc[i][j][r];
          else p.projb[(size_t)row * DIN + col] = f2bf(acc[i][j][r]);
        }
      }
  }
};
__device__ __forceinline__ void ph_rope_tab(const P& p) {
  for (int idx = GTID; idx < 320 * 16; idx += GSZ) {
    int v = idx >> 4, j = idx & 15;
    float inv = __expf(-(float)j * (1.f / 16.f) * 9.210340371976184f);
    float ang = (float)(v < 256 ? v : v - 256) * inv;
    float k = rintf(ang * 0.15915494309189535f);
    float r = fmaf(-k, 6.2831854820251465f, ang);
    r = fmaf(-k, -1.7484555e-07f, r);
    ((float2*)p.ropetab)[idx] = make_float2(__cosf(r), __sinf(r));
  }
}

template <int CTRL>
__device__ __forceinline__ float dpp_row(float v) {
  return __int_as_float(__builtin_amdgcn_update_dpp(0, __float_as_int(v), CTRL, 0xf, 0xf, false));
}
struct EpiBias {
  float* dst; int N;
  __device__ __forceinline__ void operator()(const P& p, f32x4 (&acc)[4][4], int m0, int n0, int wm, int wn, int lane, char* smem) const {
    if (wm == 0 && (lane >> 4) == 0) {
      const int col = n0 + wn * 64 + (lane & 15);
#pragma unroll
      for (int j = 0; j < 4; ++j) { dst[col + 16 * j] = acc[0][j][0]; dst[N + col + 16 * j] = acc[0][j][1]; }
    }
  }
};
struct EpiProj {
  int l;
  __device__ __forceinline__ void operator()(const P& p, f32x4 (&acc)[4][4], int m0, int n0, int wm, int wn, int lane, char* smem) const {
    const int g = lane >> 4, lr = lane & 15;
    const int mw0 = m0 + wm * 64, nw0 = n0 + wn * 64;
    if (l == 1) {
      float* rinvl = (float*)smem;
      const int tid = ((wm * 2 + wn) << 6) | lane;
      if (tid < 128) {
        float s = 0.f;
#pragma unroll
        for (int q = 0; q < 8; ++q) s += p.rowss[(size_t)q * TT + m0 + tid];
        rinvl[tid] = rsqrtf(s * (1.f / 1024.f) + EPS);
      }
      __syncthreads();
      const float* bb = p.bin + (m0 < LC ? 1 : 0) * DIN + nw0 + lr;
      float bv[4];
#pragma unroll
      for (int j = 0; j < 4; ++j) bv[j] = bb[16 * j];
#pragma unroll
      for (int i = 0; i < 4; ++i)
#pragma unroll
        for (int r = 0; r < 4; ++r) {
          const float rv = rinvl[wm * 64 + 16 * i + 4 * g + r];
#pragma unroll
          for (int j = 0; j < 4; ++j) acc[i][j][r] = acc[i][j][r] * rv + bv[j];
        }
    }
    if (n0 < 512) {
#pragma unroll
      for (int i = 0; i < 4; ++i)
#pragma unroll
        for (int r = 0; r < 4; ++r) {
          int row = mw0 + 16 * i + 4 * g + r;
#pragma unroll
          for (int j = 0; j < 4; ++j) p.proj[(size_t)row * 512 + nw0 + 16 * j + lr] = acc[i][j][r];
        }
      return;
    }
    const float* gain = nullptr; bool rope = false; float scale = 1.f;
    if (nw0 < 896) { gain = p.win_qn + l * 64; rope = true; scale = QSCALE; }
    else if (nw0 < 1024) { gain = p.win_kn + l * 64; rope = true; }
    else if (nw0 < 1152) { }
    else if (nw0 < 1536) { gain = p.na_qn + l * 64; scale = QSCALE; }
    else if (nw0 < 1920) { gain = p.na_kn + l * 64; }
    rope = rope && (m0 >= LC);
    float gj[4] = {1.f, 1.f, 1.f, 1.f};
    if (gain) {
#pragma unroll
      for (int j = 0; j < 4; ++j) gj[j] = gain[16 * j + lr] * scale;
    }
#pragma unroll
    for (int i = 0; i < 4; ++i)
#pragma unroll
      for (int r = 0; r < 4; ++r) {
        const int row = mw0 + 16 * i + 4 * g + r;
        float y[4] = {acc[i][0][r], acc[i][1][r], acc[i][2][r], acc[i][3][r]};
        if (gain) {
          float ss = y[0] * y[0] + y[1] * y[1] + y[2] * y[2] + y[3] * y[3];
          ss += dpp_row<0xB1>(ss);
          ss += dpp_row<0x4E>(ss);
          ss += dpp_row<0x141>(ss);
          ss += dpp_row<0x140>(ss);
          const float rinv = rsqrtf(ss * (1.f / 64.f) + EPS);
#pragma unroll
          for (int j = 0; j < 4; ++j) y[j] *= rinv * gj[j];
        }
        if (rope) {
          const int pos = row - LC;
          const float2 tr = ((const float2*)p.ropetab)[(pos >> 6) * 16 + lr];
          const float2 tc = ((const float2*)p.ropetab)[(256 + (pos & 63)) * 16 + lr];
          float a0 = y[0] * tr.x - y[1] * tr.y, a1 = y[0] * tr.y + y[1] * tr.x;
          float a2 = y[2] * tc.x - y[3] * tc.y, a3 = y[2] * tc.y + y[3] * tc.x;
          y[0] = a0; y[1] = a1; y[2] = a2; y[3] = a3;
        }
#pragma unroll
        for (int j = 0; j < 4; ++j) p.projb[(size_t)row * DIN + nw0 + 16 * j + lr] = f2bf(y[j]);
      }
  }
};
struct EpiResid {
  int l;
  __device__ __forceinline__ void operator()(const P& p, f32x4 (&acc)[4][4], int m0, int n0, int wm, int wn, int lane, char* smem) const {
    float* tile = (float*)smem;
    {
      const int g = lane >> 4, lr = lane & 15;
      float* tw = tile + (wm * 64 + 4 * g) * 132 + wn * 64 + lr;
#pragma unroll
      for (int i = 0; i < 4; ++i)
#pragma unroll
        for (int r = 0; r < 4; ++r)
#pragma unroll
          for (int j = 0; j < 4; ++j) tw[(16 * i + r) * 132 + 16 * j] = acc[i][j][r];
    }
    __syncthreads();
    const int tid = ((wm * 2 + wn) << 6) | lane, c8 = tid & 15, rsub = tid >> 4;
    const float* mod = p.mod + (l * 2 + (m0 < LC ? 1 : 0)) * 6144;
    const int col = n0 + 8 * c8;
    float g1v[8], gs[8];
    {
      const float4 a0 = *(const float4*)(mod + 2048 + col), a1 = *(const float4*)(mod + 2048 + col + 4);
      const float4 s0 = *(const float4*)(mod + 4096 + col), s1 = *(const float4*)(mod + 4096 + col + 4);
      const float4 n0v = *(const float4*)(p.norm2_g + l * 1024 + col), n1v = *(const float4*)(p.norm2_g + l * 1024 + col + 4);
      g1v[0] = a0.x; g1v[1] = a0.y; g1v[2] = a0.z; g1v[3] = a0.w; g1v[4] = a1.x; g1v[5] = a1.y; g1v[6] = a1.z; g1v[7] = a1.w;
      gs[0] = n0v.x * (1.f + s0.x); gs[1] = n0v.y * (1.f + s0.y); gs[2] = n0v.z * (1.f + s0.z); gs[3] = n0v.w * (1.f + s0.w);
      gs[4] = n1v.x * (1.f + s1.x); gs[5] = n1v.y * (1.f + s1.y); gs[6] = n1v.z * (1.f + s1.z); gs[7] = n1v.w * (1.f + s1.w);
    }
#pragma unroll
    for (int it = 0; it < 8; ++it) {
      const int rl = it * 16 + rsub, row = m0 + rl;
      float4* xp = (float4*)(p.xall + (size_t)row * 1024 + col);
      float4 x0 = xp[0], x1 = xp[1];
      const float4 t0 = *(const float4*)(tile + rl * 132 + 8 * c8), t1 = *(const float4*)(tile + rl * 132 + 8 * c8 + 4);
      x0.x += g1v[0] * t0.x; x0.y += g1v[1] * t0.y; x0.z += g1v[2] * t0.z; x0.w += g1v[3] * t0.w;
      x1.x += g1v[4] * t1.x; x1.y += g1v[5] * t1.y; x1.z += g1v[6] * t1.z; x1.w += g1v[7] * t1.w;
      xp[0] = x0; xp[1] = x1;
      float ss = x0.x * x0.x + x0.y * x0.y + x0.z * x0.z + x0.w * x0.w + x1.x * x1.x + x1.y * x1.y + x1.z * x1.z + x1.w * x1.w;
      ss += dpp_row<0xB1>(ss);
      ss += dpp_row<0x4E>(ss);
      ss += dpp_row<0x141>(ss);
      ss += dpp_row<0x140>(ss);
      *(uint4*)(p.hb + (size_t)row * 1024 + col) = make_uint4(pack2bf(x0.x * gs[0], x0.y * gs[1]), pack2bf(x0.z * gs[2], x0.w * gs[3]),
                                                            pack2bf(x1.x * gs[4], x1.y * gs[5]), pack2bf(x1.z * gs[6], x1.w * gs[7]));
      if (c8 == 0) p.rowss[(size_t)(n0 >> 7) * TT + row] = ss;
    }
  }
};

template <int CTRL, int RMASK>
__device__ __forceinline__ float dpp_mov_id(float v) {
  return __int_as_float(__builtin_amdgcn_update_dpp(__float_as_int(v), __float_as_int(v), CTRL, RMASK, 0xf, false));
}
__device__ __forceinline__ float wave_max(float v) {
  v = fmaxf(v, dpp_mov_id<0xB1, 0xf>(v));
  v = fmaxf(v, dpp_mov_id<0x4E, 0xf>(v));
  v = fmaxf(v, dpp_mov_id<0x141, 0xf>(v));
  v = fmaxf(v, dpp_mov_id<0x140, 0xf>(v));
  v = fmaxf(v, dpp_mov_id<0x142, 0xa>(v));
  v = fmaxf(v, dpp_mov_id<0x143, 0xc>(v));
  return __int_as_float(__builtin_amdgcn_readlane(__float_as_int(v), 63));
}

typedef __attribute__((ext_vector_type(2))) float f32x2;
__device__ __forceinline__ void peer_convert_rows(const P& p, int l, int r0, int r1) {
  const int tid = tid_opaque(), lane = tid & 63;
  for (int rb = r0 + (tid >> 6); rb < r1; rb += 16) {
    float4 v[4][4];
#pragma unroll
    for (int u = 0; u < 4; ++u) {
      const int r = min(rb + 4 * u, r1 - 1);
      const int tbl = r >> 14, e = r & 16383;
      const float4* src = (const float4*)((tbl ? p.pv : p.pu) + ((size_t)l * 16384 + e) * 1024) + lane * 4;
#pragma unroll
      for (int i = 0; i < 4; ++i) v[u][i] = src[i];
    }
#pragma unroll
    for (int u = 0; u < 4; ++u) {
      const int r = rb + 4 * u;
      if (r < r1) {
        const int tbl = r >> 14, e = r & 16383;
        float am = 0.f;
#pragma unroll
        for (int i = 0; i < 4; ++i)
          am = fmaxf(am, fmaxf(fmaxf(fabsf(v[u][i].x), fabsf(v[u][i].y)), fmaxf(fabsf(v[u][i].z), fabsf(v[u][i].w))));
        am = wave_max(am);
        const float sc = am > 0.f ? 224.f / am : 1.f;
        unsigned w[4];
#pragma unroll
        for (int i = 0; i < 4; ++i) {
          int t = __builtin_amdgcn_cvt_pk_fp8_f32(v[u][i].x * sc, v[u][i].y * sc, 0, false);
          t = __builtin_amdgcn_cvt_pk_fp8_f32(v[u][i].z * sc, v[u][i].w * sc, t, true);
          w[i] = (unsigned)t;
        }
        unsigned char* dst = (tbl ? p.vb8 : p.ub8) + (((size_t)l * 8 + (lane >> 3)) * 16384 + e) * 128 + (lane & 7) * 16;
        *(uint4*)dst = make_uint4(w[0], w[1], w[2], w[3]);
        if (lane == 0) (tbl ? p.vsc : p.usc)[l * 16384 + e] = am > 0.f ? am / 224.f : 1.f;
      }
    }
  }
}
__device__ __forceinline__ int gemm_swz(int row) { return (0x78 >> (((row >> 2) & 3) * 2)) & 3; }
template <class Epi>
__device__ __forceinline__ void gemm_bf16_128(const P& p, const bf16_t* __restrict__ A, const bf16_t* __restrict__ Bt, int K, int m_begin, int m_end,
                              int N, char* smem, const Epi& epi, int cl = -1, int rpt = 0, int boff = 0) {
  const int tid = tid_opaque(), lane = tid & 63, wv = __builtin_amdgcn_readfirstlane(tid >> 6), wm = wv >> 1, wn = wv & 1;
  const int tiles_n = N / 128, tiles_m = (m_end - m_begin) / 128;
  const int nk = K / 32;
  const int lr = lane & 15, g = lane >> 4;
  const int a_rd = (wm * 64 + lr) * 64 + ((g ^ gemm_swz(lr)) << 4);
  const int b_rd = 8192 + (wn * 64 + lr) * 64 + ((g ^ gemm_swz(lr)) << 4);
  const int ld_row = lane >> 2, ld_c = (lane & 3) ^ gemm_swz(ld_row);
  for (int tile = ((int)blockIdx.x + (int)gridDim.x - boff) % (int)gridDim.x; tile < tiles_m * tiles_n; tile += gridDim.x) {
    const int m0 = m_begin + (tile / tiles_n) * 128, n0 = (tile % tiles_n) * 128;
    f32x4 acc[4][4];
#pragma unroll
    for (int i = 0; i < 4; ++i)
#pragma unroll
      for (int j = 0; j < 4; ++j) acc[i][j] = (f32x4){0.f, 0.f, 0.f, 0.f};
    const bf16_t* Ag = A + (size_t)(m0 + wv * 32 + ld_row) * K + ld_c * 8;
    const bf16_t* Bg = Bt + (size_t)(n0 + wv * 32 + ld_row) * K + ld_c * 8;
    auto issue = [&](int st, int kt) {
      char* base = smem + st * 16384 + wv * 2048;
#pragma unroll
      for (int i = 0; i < 2; ++i) {
        __builtin_amdgcn_global_load_lds((const unsigned*)(Ag + (size_t)i * 16 * K + kt * 32), (__attribute__((address_space(3))) unsigned*)(base + i * 1024), 16, 0, 0);
        __builtin_amdgcn_global_load_lds((const unsigned*)(Bg + (size_t)i * 16 * K + kt * 32), (__attribute__((address_space(3))) unsigned*)(base + 8192 + i * 1024), 16, 0, 0);
      }
    };
    issue(0, 0); issue(1, 1); issue(2, 2);
    for (int kt0 = 0; kt0 < nk; kt0 += 4) {
#pragma unroll
      for (int u = 0; u < 4; ++u) {
        const int kt = kt0 + u, rem = nk - kt;
        if (rem >= 3) asm volatile("s_waitcnt vmcnt(8) lgkmcnt(0)" ::: "memory");
        else if (rem == 2) asm volatile("s_waitcnt vmcnt(4) lgkmcnt(0)" ::: "memory");
        else asm volatile("s_waitcnt vmcnt(0) lgkmcnt(0)" ::: "memory");
        __builtin_amdgcn_s_barrier();
        if (kt + 3 < nk) issue((u + 3) & 3, kt + 3);
        bf16x8 af[4], bfr[4];
#pragma unroll
        for (int i = 0; i < 4; ++i) af[i] = *(const bf16x8*)(smem + u * 16384 + a_rd + i * 1024);
#pragma unroll
        for (int j = 0; j < 4; ++j) bfr[j] = *(const bf16x8*)(smem + u * 16384 + b_rd + j * 1024);
#pragma unroll
        for (int i = 0; i < 4; ++i)
#pragma unroll
          for (int j = 0; j < 4; ++j) acc[i][j] = __builtin_amdgcn_mfma_f32_16x16x32_bf16(af[i], bfr[j], acc[i][j], 0, 0, 0);
      }
    }
    __syncthreads();
    epi(p, acc, m0, n0, wm, wn, lane, smem);
    if (cl >= 0) peer_convert_rows(p, cl, min(tile * rpt, 32768), min((tile + 1) * rpt, 32768));
    __syncthreads();
  }
}

constexpr int NCHUNK = TT / 64;
__device__ __forceinline__ int lru_pos(int dir, int c) { return dir == 0 ? c : (c < 4 ? 3 - c : 4 + (NCHUNK - 1 - c)); }

__device__ __forceinline__ void ph_lru_prepw(const P& p) {
  for (int idx = GTID; idx < 2 * 2 * 4 * 2 * 4096; idx += GSZ) {
    int d = idx & 63, e = (idx >> 6) & 63, mtx = (idx >> 12) & 1, rest = idx >> 13;
    const float* w = (mtx ? p.wx : p.wa) + (size_t)rest * 4096;
    p.lruw_t[idx] = f2bf(w[d * 64 + e]);
  }
}

template <int PASS>
__device__ __forceinline__ void lru_item(const P& p, int l, int cidx, int kb, char* smem) {
  bf16_t* u_img = (bf16_t*)smem;
  float* ab_a = (float*)(smem + 8192);
  float* ab_b = (float*)(smem + 8192 + 16384);
  float* hsum = (float*)(smem + 8192 + 32768);
  float* segagg = (float*)(smem + 8192 + 49152);
  float* ccarry = (float*)(smem + 8192 + 49152 + 2048);
  const int tid = tid_opaque(), lane = tid & 63, wv = tid >> 6, g = lane >> 4, lr = lane & 15;
  const int t0 = cidx * 64;
  const int lo = t0 < LC ? 0 : LC, hi = t0 < LC ? LC : TT;
  __syncthreads();
  {
    const int ch = tid & 63, c = kb * 64 + ch, sg = tid >> 6;
    const float cb = p.conv_b[l * 256 + c];
    float cw[4];
#pragma unroll
    for (int k = 0; k < 4; ++k) cw[k] = p.conv_w[(l * 4 + k) * 256 + c];
    float xr[19];
#pragma unroll
    for (int i = 0; i < 19; ++i) {
      int tt = t0 + sg * 16 + i - 2;
      int tc = tt < lo ? lo : (tt >= hi ? hi - 1 : tt);
      float v = p.proj[(size_t)tc * 512 + OFF_XA + c];
      xr[i] = (tt >= lo && tt < hi) ? v : 0.f;
    }
#pragma unroll
    for (int i = 0; i < 16; ++i) {
      int row = sg * 16 + i;
      float acc = cb + cw[0] * xr[i] + cw[1] * xr[i + 1] + cw[2] * xr[i + 2] + cw[3] * xr[i + 3];
      u_img[row * 64 + ((((ch >> 3) ^ (row & 7)) << 3) | (ch & 7))] = f2bf(acc);
    }
  }
  if (PASS == 2) {
    if (tid < 128) {
      const int ch = tid & 63, dir = tid >> 6;
      ccarry[dir * 64 + ch] = p.lcarry[((size_t)dir * NCHUNK + lru_pos(dir, cidx)) * 256 + kb * 64 + ch];
    }
  }
  __syncthreads();
  for (int dir = 0; dir < 2; ++dir) {
    const int pd = l * 2 + dir;
    {
      f32x4 ga[4], gx[4];
#pragma unroll
      for (int i = 0; i < 4; ++i) { ga[i] = (f32x4){0.f, 0.f, 0.f, 0.f}; gx[i] = (f32x4){0.f, 0.f, 0.f, 0.f}; }
      const bf16_t* wbase = p.lruw_t + (size_t)((pd * 4 + kb) * 2) * 4096 + (16 * wv + lr) * 64 + 8 * g;
#pragma unroll
      for (int s = 0; s < 2; ++s) {
        bf16x8 ba_ = *(const bf16x8*)(wbase + 32 * s);
        bf16x8 bx_ = *(const bf16x8*)(wbase + 4096 + 32 * s);
#pragma unroll
        for (int i = 0; i < 4; ++i) {
          int row = 16 * i + lr;
          bf16x8 af = *(const bf16x8*)((const char*)u_img + row * 128 + (((4 * s + g) ^ (row & 7)) << 4));
          ga[i] = __builtin_amdgcn_mfma_f32_16x16x32_bf16(af, ba_, ga[i], 0, 0, 0);
          gx[i] = __builtin_amdgcn_mfma_f32_16x16x32_bf16(af, bx_, gx[i], 0, 0, 0);
        }
      }
      const int ch = 16 * wv + lr, c = kb * 64 + ch;
      const float bav = p.ba[pd * 256 + c], bxv = p.bx[pd * 256 + c];
      const float sp = log1pf(expf(-p.lam[pd * 256 + c]));
#pragma unroll
      for (int i = 0; i < 4; ++i)
#pragma unroll
        for (int r = 0; r < 4; ++r) {
          int row = 16 * i + 4 * g + r;
          float rr = sigmoid_f(ga[i][r] + bav), ig = sigmoid_f(gx[i][r] + bxv);
          float log_a = -8.f * rr * sp;
          float a = __expf(log_a);
          float uu = bf2f(u_img[row * 64 + ((((ch >> 3) ^ (row & 7)) << 3) | (ch & 7))]);
          const float x2 = 2.f * log_a;
          const float ser = -x2 * (1.f + x2 * (0.5f + x2 * (0.16666667f + x2 * (0.041666668f + x2 * 0.0083333338f))));
          const float om = x2 > -0.25f ? ser : 1.f - a * a;
          float b = sqrtf(om) * ig * uu;
          ab_a[row * 64 + ch] = a;
          ab_b[row * 64 + ch] = b;
        }
    }
    __syncthreads();
    {
      const int ch = tid & 63, seg = tid >> 6;
      float Pr = 1.f, H = 0.f;
#pragma unroll
      for (int i = 0; i < 16; ++i) {
        int row = dir == 0 ? seg * 16 + i : seg * 16 + 15 - i;
        float a = ab_a[row * 64 + ch], b = ab_b[row * 64 + ch];
        H = a * H + b;
        Pr *= a;
      }
      segagg[(seg * 64 + ch) * 2] = Pr;
      segagg[(seg * 64 + ch) * 2 + 1] = H;
      __syncthreads();
      if (PASS == 1) {
        if (seg == 0) {
          float A = 1.f, B = 0.f;
#pragma unroll
          for (int s2 = 0; s2 < 4; ++s2) {
            int sg = dir == 0 ? s2 : 3 - s2;
            float pa = segagg[(sg * 64 + ch) * 2], pb = segagg[(sg * 64 + ch) * 2 + 1];
            B = pa * B + pb;
            A *= pa;
          }
          float2* ag = (float2*)p.lagg + ((size_t)dir * NCHUNK + lru_pos(dir, cidx)) * 256 + kb * 64 + ch;
          *ag = make_float2(A, B);
        }
      } else {
        float h = ccarry[dir * 64 + ch];
        float gav[16];
        if (dir == 1) {
#pragma unroll
          for (int i = 0; i < 16; ++i) gav[i] = p.proj[(size_t)(t0 + seg * 16 + 15 - i) * 512 + OFF_GA + kb * 64 + ch];
        }
#pragma unroll
        for (int s2 = 0; s2 < 3; ++s2) {
          int sg = dir == 0 ? s2 : 3 - s2;
          bool before = dir == 0 ? (sg < seg) : (sg > seg);
          if (before) h = segagg[(sg * 64 + ch) * 2] * h + segagg[(sg * 64 + ch) * 2 + 1];
        }
#pragma unroll
        for (int i = 0; i < 16; ++i) {
          int row = dir == 0 ? seg * 16 + i : seg * 16 + 15 - i;
          float a = ab_a[row * 64 + ch], b = ab_b[row * 64 + ch];
          h = a * h + b;
          if (dir == 0) hsum[row * 64 + ch] = h;
          else {
            int t = t0 + row, c = kb * 64 + ch;
            p.mixb[(size_t)t * 1024 + c] = f2bf((hsum[row * 64 + ch] + h) * gelu_f(gav[i]));
          }
        }
      }
    }
    __syncthreads();
  }
}

__device__ __forceinline__ void ph_lru_carry(const P& p, float* smem) {
  const int tid = tid_opaque(), seg = tid >> 4, c16 = tid & 15;
  for (int blk = blockIdx.x; blk < 32; blk += gridDim.x) {
    const int dc = blk * 16 + c16, dir = dc >> 8, ch = dc & 255;
    const float2* ag = (const float2*)p.lagg + (size_t)dir * NCHUNK * 256 + ch;
    float2 v[17];
#pragma unroll
    for (int i = 0; i < 17; ++i) {
      int pos = seg * 17 + i;
      v[i] = pos < NCHUNK ? ag[(size_t)pos * 256] : make_float2(1.f, 0.f);
    }
    float A = 1.f, B = 0.f;
#pragma unroll
    for (int i = 0; i < 17; ++i) { B = v[i].x * B + v[i].y; A *= v[i].x; }
    __syncthreads();
    smem[(seg * 16 + c16) * 2] = A; smem[(seg * 16 + c16) * 2 + 1] = B;
    __syncthreads();
    float h = 0.f;
    for (int s2 = 0; s2 < seg; ++s2) h = smem[(s2 * 16 + c16) * 2] * h + smem[(s2 * 16 + c16) * 2 + 1];
    float* cr = p.lcarry + (size_t)dir * NCHUNK * 256 + ch;
#pragma unroll
    for (int i = 0; i < 17; ++i) {
      int pos = seg * 17 + i;
      if (pos < NCHUNK) cr[(size_t)pos * 256] = h;
      h = v[i].x * h + v[i].y;
    }
  }
}

template <int PASS>
__device__ __forceinline__ void ph_lru(const P& p, int l, char* smem) {
  const int c_begin = (PASS == 2 && l == 1) ? 4 : 0;
  const int nitems = (NCHUNK - c_begin) * 4;
  for (int it = blockIdx.x; it < nitems; it += gridDim.x) lru_item<PASS>(p, l, c_begin + (it >> 2), it & 3, smem);
}

typedef __attribute__((ext_vector_type(4))) short s16x4;
typedef __attribute__((ext_vector_type(4))) unsigned u32x4;

__device__ __forceinline__ void ph_qknorm_rope2(const P& p, int l) {
  const int tid_ = tid_opaque();
  const int lane = tid_ & 63;
  const int wpb = blockDim.x >> 6;
  for (int pair = blockIdx.x * wpb + (tid_ >> 6); pair < TT * 28; pair += gridDim.x * wpb) {
    int t = pair / 28, slot = pair % 28;
    const float* g = nullptr; bool rope = false; float scale = 1.f;
    if (slot < 6) { g = p.win_qn + l * 64; rope = true; scale = QSCALE; }
    else if (slot < 8) { g = p.win_kn + l * 64; rope = true; }
    else if (slot < 10) { }
    else if (slot < 16) { g = p.na_qn + l * 64; scale = QSCALE; }
    else if (slot < 22) { g = p.na_kn + l * 64; }
    rope = rope && (t >= LC);
    const size_t idx = (size_t)t * DIN + 512 + slot * 64 + lane;
    float v = bf2f(p.projb[idx]);
    float y = v;
    if (g) {
      float ss = wave_sum(v * v);
      y = v * rsqrtf(ss * (1.f / 64.f) + EPS) * g[lane];
    }
    float partner = __shfl_xor(y, 16);
    if (rope) {
      int pos = t - LC, row = pos >> 6, col = pos & 63;
      int j = lane & 15, axis = lane >> 5;
      float inv = __expf(-(float)j * (1.f / 16.f) * 9.210340371976184f);
      float ang = (float)(axis ? col : row) * inv;
      float k = rintf(ang * 0.15915494309189535f);
      float r = fmaf(-k, 6.2831854820251465f, ang);
      r = fmaf(-k, -1.7484555e-07f, r);
      float cs = __cosf(r), sn = __sinf(r);
      bool first = ((lane >> 4) & 1) == 0;
      y = first ? (y * cs - partner * sn) : (partner * sn + y * cs);
    }
    p.projb[idx] = f2bf(y * scale);
  }
}

template <class TokFn>
__device__ __forceinline__ void kv_issue(const P& p, char* stage, int koff, int voff, TokFn tok, int wv, int lane) {
#pragma unroll
  for (int i = 0; i < 2; ++i) {
    const int row = 16 * wv + 8 * i + (lane >> 3);
    const bf16_t* src = p.projb + (size_t)tok(row) * DIN + (((lane & 7) ^ (row & 7)) << 3);
    char* dst = stage + (2 * wv + i) * 1024;
    __builtin_amdgcn_global_load_lds((const unsigned*)(src + koff), (__attribute__((address_space(3))) unsigned*)dst, 16, 0, 0);
    __builtin_amdgcn_global_load_lds((const unsigned*)(src + voff), (__attribute__((address_space(3))) unsigned*)(dst + 8192), 16, 0, 0);
  }
}
__device__ __forceinline__ void kv_wait(int rem) {
  if (rem >= 3) asm volatile("s_waitcnt vmcnt(8) lgkmcnt(0)" ::: "memory");
  else if (rem == 2) asm volatile("s_waitcnt vmcnt(4) lgkmcnt(0)" ::: "memory");
  else asm volatile("s_waitcnt vmcnt(0) lgkmcnt(0)" ::: "memory");
  __builtin_amdgcn_s_barrier();
}

template <class MaskFn>
__device__ __forceinline__ void attn_step2(const char* stage, int kr0, const bf16x8 (&qf)[2][2], f32x4 (&o)[2][4], float (&lsum)[2], MaskFn mb,
                                           int lane, bool act0, bool act1) {
  const int g = lane >> 4, lr = lane & 15;
  bf16x8 kf[2][2];
#pragma unroll
  for (int t2 = 0; t2 < 2; ++t2) {
    const int row = kr0 + 16 * t2 + lr;
#pragma unroll
    for (int s = 0; s < 2; ++s) kf[t2][s] = *(const bf16x8*)(stage + row * 128 + (((4 * s + g) ^ (row & 7)) << 4));
  }
  bf16x8 pb[2];
#pragma unroll
  for (int qt = 0; qt < 2; ++qt) {
    if (qt == 0 ? act0 : act1) {
      f32x4 st[2];
#pragma unroll
      for (int t2 = 0; t2 < 2; ++t2) {
        st[t2] = (f32x4){0.f, 0.f, 0.f, 0.f};
#pragma unroll
        for (int s = 0; s < 2; ++s) st[t2] = __builtin_amdgcn_mfma_f32_16x16x32_bf16(kf[t2][s], qf[qt][s], st[t2], 0, 0, 0);
      }
#pragma unroll
      for (int t2 = 0; t2 < 2; ++t2)
#pragma unroll
        for (int r = 0; r < 4; ++r) {
          float pv = exp2f(mb(qt, t2, r, st[t2][r]));
          lsum[qt] += pv;
          pb[qt][t2 * 4 + r] = (short)f2bf(pv);
        }
    }
  }
  const int q = lr >> 2, pp = lane & 3;
#pragma unroll
  for (int m = 0; m < 4; ++m) {
    bf16x8 vf;
#pragma unroll
    for (int t = 0; t < 2; ++t) {
      const int row = kr0 + 16 * t + 4 * g + q;
      const char* addr = stage + 8192 + row * 128 + (((2 * m + (pp >> 1)) ^ (row & 7)) << 4) + 8 * (pp & 1);
      s16x4 v4 = __builtin_amdgcn_ds_read_tr16_b64_v4i16((__attribute__((address_space(3))) s16x4*)addr);
      vf[4 * t + 0] = v4[0]; vf[4 * t + 1] = v4[1]; vf[4 * t + 2] = v4[2]; vf[4 * t + 3] = v4[3];
    }
    if (act0) o[0][m] = __builtin_amdgcn_mfma_f32_16x16x32_bf16(vf, pb[0], o[0][m], 0, 0, 0);
    if (act1) o[1][m] = __builtin_amdgcn_mfma_f32_16x16x32_bf16(vf, pb[1], o[1][m], 0, 0, 0);
  }
}

__device__ __forceinline__ void attn_store_out(const P& p, const f32x4 (&o)[4], float lsum, int tok, int col0, int lane) {
  const int g = lane >> 4;
  lsum += __shfl_xor(lsum, 16);
  lsum += __shfl_xor(lsum, 32);
  const float inv = 1.f / lsum;
  bf16_t* op = p.mixb + (size_t)tok * 1024 + col0 + 4 * g;
#pragma unroll
  for (int m = 0; m < 4; ++m)
    *(uint2*)(op + 16 * m) = make_uint2(pack2bf(o[m][0] * inv, o[m][1] * inv), pack2bf(o[m][2] * inv, o[m][3] * inv));
}

__device__ __forceinline__ void attn_win_item(const P& p, int l, int kind, int qb, int hs, char* smem) {
  const int tid = tid_opaque(), lane = tid & 63, wv = __builtin_amdgcn_readfirstlane(tid >> 6), g = lane >> 4, lr = lane & 15;
  int qoff, koff, voff, ooff; const float *gq, *gk; float sink2 = -1e30f; bool has_sink = false;
  if (kind == 0 || hs < 6) {
    const int h = hs, kvh = h / 3;
    qoff = OFF_QW + h * 64; koff = OFF_KW + kvh * 64; voff = OFF_VW + kvh * 64; ooff = 256 + h * 64;
    gq = p.win_qn + l * 64; gk = p.win_kn + l * 64; sink2 = p.win_sink[l * 6 + h] * LOG2E; has_sink = true;
  } else {
    const int h = hs - 6;
    qoff = OFF_QN + h * 64; koff = OFF_KN + h * 64; voff = OFF_VN + h * 64; ooff = 640 + h * 64;
    gq = p.na_qn + l * 64; gk = p.na_kn + l * 64;
  }
  float bound = 8.f * LOG2E * wave_max(fabsf(gq[lane])) * wave_max(fabsf(gk[lane])) * 1.0001f + 1e-3f;
  if (has_sink) bound = fmaxf(bound, sink2);
  const int q0 = qb * 128;
  const int qtok0 = (kind == 0 ? LC : 0) + q0 + 32 * wv;
  bf16x8 qf[2][2];
#pragma unroll
  for (int qt = 0; qt < 2; ++qt)
#pragma unroll
    for (int s = 0; s < 2; ++s) qf[qt][s] = *(const bf16x8*)(p.projb + (size_t)(qtok0 + 16 * qt + lr) * DIN + qoff + 32 * s + 8 * g);
  f32x4 o[2][4];
#pragma unroll
  for (int qt = 0; qt < 2; ++qt)
#pragma unroll
    for (int m = 0; m < 4; ++m) o[qt][m] = (f32x4){0.f, 0.f, 0.f, 0.f};
  float lsum[2] = {0.f, 0.f};
  const int nloc = (kind == 0) ? 6 : 0, nch = nloc + 4;
  auto tokfn = [&](int c) {
    return [=](int row) {
      if (c < nloc) { int pos = q0 - 128 + 64 * c + row; pos = pos < 0 ? 0 : (pos > SEQ - 1 ? SEQ - 1 : pos); return LC + pos; }
      return 64 * (c - nloc) + row;
    };
  };
  __syncthreads();
  kv_issue(p, smem, koff, voff, tokfn(0), wv, lane);
  kv_issue(p, smem + 16384, koff, voff, tokfn(1), wv, lane);
  kv_issue(p, smem + 32768, koff, voff, tokfn(2), wv, lane);
  for (int c = 0; c < nch; ++c) {
    kv_wait(nch - c);
    if (c + 3 < nch) kv_issue(p, smem + ((c + 3) & 3) * 16384, koff, voff, tokfn(c + 3), wv, lane);
    const char* stage = smem + (c & 3) * 16384;
    if (c < nloc) {
      const int qw0 = q0 + 32 * wv;
#pragma unroll
      for (int st = 0; st < 2; ++st) {
        const int kbase = q0 - 128 + 64 * c + 32 * st;
        const bool a0 = !(kbase - (qw0 + 15) > 128 || qw0 - (kbase + 31) > 128) && (kbase + 31 >= 0) && (kbase < SEQ);
        const bool a1 = !(kbase - (qw0 + 31) > 128 || (qw0 + 16) - (kbase + 31) > 128) && (kbase + 31 >= 0) && (kbase < SEQ);
        if (a0 || a1)
          attn_step2(stage, 32 * st, qf, o, lsum, [&](int qt, int t2, int r, float s) {
            int kpos = kbase + 16 * t2 + 4 * g + r;
            int dlt = kpos - (qw0 + 16 * qt + lr); dlt = dlt < 0 ? -dlt : dlt;
            bool valid = (kpos >= 0) && (kpos < SEQ) && (dlt <= 128);
            return valid ? s - bound : -1e30f;
          }, lane, a0, a1);
      }
    } else {
#pragma unroll
      for (int st = 0; st < 2; ++st)
        attn_step2(stage, 32 * st, qf, o, lsum, [&](int qt, int t2, int r, float s) { return s - bound; }, lane, true, true);
    }
  }
#pragma unroll
  for (int qt = 0; qt < 2; ++qt) {
    float ls = lsum[qt];
    if (has_sink && g == 0) ls += exp2f(sink2 - bound);
    attn_store_out(p, o[qt], ls, qtok0 + 16 * qt + lr, ooff, lane);
  }
}

__device__ __forceinline__ void attn_na_item(const P& p, int l, int rp, int h, char* smem) {
  const int tid = tid_opaque(), lane = tid & 63, wv = __builtin_amdgcn_readfirstlane(tid >> 6), g = lane >> 4, lr = lane & 15;
  const int qoff = OFF_QN + h * 64, koff = OFF_KN + h * 64, voff = OFF_VN + h * 64, ooff = 640 + h * 64;
  float* rpbl = (float*)(smem + 65536);
  const float* rpbg = p.rpb + (size_t)(l * 6 + h) * 465;
  float bmax = 0.f;
  __syncthreads();
  for (int i = tid; i < 465; i += 256) rpbl[i] = rpbg[i] * LOG2E;
  for (int i = lane; i < 465; i += 64) bmax = fmaxf(bmax, fabsf(rpbg[i]) * LOG2E);
  bmax = wave_max(bmax);
  const float bound = 8.f * LOG2E * wave_max(fabsf(p.na_qn[l * 64 + lane])) * wave_max(fabsf(p.na_kn[l * 64 + lane])) * 1.0001f + bmax + 1e-3f;
  const int r0 = 2 * rp;
  const int qcol = 16 * wv + lr;
  const int qtok0 = LC + r0 * 64 + qcol;
  const int kra = min(max(r0 - 4, 0), 248), krb = min(max(r0 + 1 - 4, 0), 248);
  const int nrow = krb + 8 - kra, nch = nrow + 4;
  const int kc0 = min(max(16 * wv - 8, 0), 32);
  const int qs = min(max(qcol - 8, 0), 48);
  bf16x8 qf[2][2];
#pragma unroll
  for (int qt = 0; qt < 2; ++qt)
#pragma unroll
    for (int s = 0; s < 2; ++s) qf[qt][s] = *(const bf16x8*)(p.projb + (size_t)(qtok0 + 64 * qt) * DIN + qoff + 32 * s + 8 * g);
  f32x4 o[2][4];
#pragma unroll
  for (int qt = 0; qt < 2; ++qt)
#pragma unroll
    for (int m = 0; m < 4; ++m) o[qt][m] = (f32x4){0.f, 0.f, 0.f, 0.f};
  float lsum[2] = {0.f, 0.f};
  auto tokfn = [&](int c) {
    return [=](int row) { return c < nrow ? LC + (kra + c) * 64 + row : 64 * (c - nrow) + row; };
  };
  kv_issue(p, smem, koff, voff, tokfn(0), wv, lane);
  kv_issue(p, smem + 16384, koff, voff, tokfn(1), wv, lane);
  kv_issue(p, smem + 32768, koff, voff, tokfn(2), wv, lane);
  for (int c = 0; c < nch; ++c) {
    kv_wait(nch - c);
    if (c + 3 < nch) kv_issue(p, smem + ((c + 3) & 3) * 16384, koff, voff, tokfn(c + 3), wv, lane);
    const char* stage = smem + (c & 3) * 16384;
    if (c < nrow) {
      const int krow = kra + c;
      const bool a0 = krow < kra + 8, a1 = krow >= krb;
      attn_step2(stage, kc0, qf, o, lsum, [&](int qt, int t2, int rr, float s) {
        int kcol = kc0 + 16 * t2 + 4 * g + rr;
        bool valid = (kcol >= qs) && (kcol < qs + 16);
        int dc = kcol - qcol + 15; dc = dc < 0 ? 0 : (dc > 30 ? 30 : dc);
        int dr = krow - (r0 + qt) + 7; dr = dr < 0 ? 0 : (dr > 14 ? 14 : dr);
        return valid ? s + rpbl[dr * 31 + dc] - bound : -1e30f;
      }, lane, a0, a1);
    } else {
#pragma unroll
      for (int st = 0; st < 2; ++st)
        attn_step2(stage, 32 * st, qf, o, lsum, [&](int qt, int t2, int rr, float s) { return s - bound; }, lane, true, true);
    }
  }
#pragma unroll
  for (int qt = 0; qt < 2; ++qt) attn_store_out(p, o[qt], lsum[qt], qtok0 + 64 * qt, ooff, lane);
}

__device__ __forceinline__ void ph_attn(const P& p, int l, char* smem) {
  const int nitems = 1536 + (l == 0 ? 24 : 0);
  for (int it = blockIdx.x; it < nitems; it += gridDim.x) {
    if (it < 768) attn_win_item(p, l, 0, it / 6, it % 6, smem);
    else if (it < 1536) { int j = it - 768; attn_na_item(p, l, j / 6, j % 6, smem); }
    else { int j = it - 1536; attn_win_item(p, l, 1, j / 12, j % 12, smem); }
  }
}

__device__ __forceinline__ unsigned ord_key(float s) {
  unsigned u = __float_as_uint(s);
  return (u & 0x80000000u) ? ~u : (u | 0x80000000u);
}
__device__ __forceinline__ float ord_val(unsigned pk) {
  unsigned u = pk & ~127u;
  unsigned b = (u & 0x80000000u) ? (u & 0x7fffffffu) : ~u;
  return __uint_as_float(b);
}
__device__ __forceinline__ void ce_desc(unsigned& a, unsigned& b) {
  unsigned mx = a > b ? a : b, mn = a > b ? b : a;
  a = mx; b = mn;
}
__device__ __forceinline__ void sort16_desc(unsigned (&v)[16]) {
#pragma unroll
  for (int k = 2; k <= 16; k <<= 1) {
#pragma unroll
    for (int j = k >> 1; j > 0; j >>= 1) {
#pragma unroll
      for (int i = 0; i < 16; ++i) {
        int m = i ^ j;
        if (m > i) {
          if ((i & k) == 0) ce_desc(v[i], v[m]); else ce_desc(v[m], v[i]);
        }
      }
    }
  }
}
__device__ __forceinline__ void merge16_desc(unsigned (&a)[16], const unsigned (&b)[16]) {
#pragma unroll
  for (int i = 0; i < 16; ++i) { unsigned o = b[15 - i]; a[i] = a[i] > o ? a[i] : o; }
#pragma unroll
  for (int j = 8; j > 0; j >>= 1) {
#pragma unroll
    for (int i = 0; i < 16; ++i) {
      int m = i ^ j;
      if (m > i) ce_desc(a[i], a[m]);
    }
  }
}

typedef __attribute__((ext_vector_type(2))) float f32x2;
__device__ __forceinline__ void peer_convert_tail(const P& p, int l, int ntiles) {
  const int G = gridDim.x, extra = ntiles % G;
  const int first = (extra == 0) ? 0 : extra, np = G - first;
  const int idx = (int)blockIdx.x - first;
  if (idx < 0) return;
  const int q = (32768 + np - 1) / np;
  const int r0 = idx * q, r1 = min(r0 + q, 32768);
  peer_convert_rows(p, l, r0, r1);
}
__device__ __forceinline__ void ph_prep_small(const P& p) {
  for (int i = GTID; i < 2 * 128 * 128; i += GSZ) { p.k1b[i] = f2bf(p.k1[i]); p.k2b[i] = f2bf(p.k2[i]); }
}

struct EpiPeerTopk {
  int l;
  __device__ __forceinline__ void operator()(const P& p, f32x4 (&acc)[4][4], int m0, int n0, int wm, int wn, int lane, char* smem) const {
    const int tid = ((wm * 2 + wn) << 6) | lane, g = lane >> 4, lr = lane & 15;
    const int nt = n0 >> 7, head = nt >> 1, hf = nt & 1;
    char* qimg = smem;
    char* kimg = smem + 34816;
    float* rinvl = (float*)(smem + 69632);
    if (tid < 128) {
      float s = 0.f;
#pragma unroll
      for (int q = 0; q < 8; ++q) s += p.rowss[(size_t)q * TT + m0 + tid];
      rinvl[tid] = rsqrtf(s * (1.f / 1024.f) + EPS);
    }
    __syncthreads();
    {
      const float* bq = p.bq + (l * 2 + (m0 < LC ? 1 : 0)) * NPQ + n0 + wn * 64 + lr;
      float bqv[4];
#pragma unroll
      for (int j = 0; j < 4; ++j) bqv[j] = bq[16 * j];
      char* qw = qimg + (wm * 64 + 4 * g) * 272 + (wn * 64 + lr) * 2;
#pragma unroll
      for (int i = 0; i < 4; ++i)
#pragma unroll
        for (int r = 0; r < 4; ++r) {
          const float rv = rinvl[wm * 64 + 16 * i + 4 * g + r];
#pragma unroll
          for (int j = 0; j < 4; ++j) *(bf16_t*)(qw + (16 * i + r) * 272 + 32 * j) = f2bf(acc[i][j][r] * rv + bqv[j]);
        }
      const bf16_t* kk = (hf ? p.k2b : p.k1b) + (size_t)l * 16384 + (tid >> 4) * 128 + (tid & 15) * 8;
      char* kw = kimg + (tid >> 4) * 272 + (tid & 15) * 16;
#pragma unroll
      for (int i = 0; i < 8; ++i) *(uint4*)(kw + i * 16 * 272) = *(const uint4*)(kk + i * 16 * 128);
    }
    __syncthreads();
#pragma unroll
    for (int i = 0; i < 4; ++i)
#pragma unroll
      for (int j = 0; j < 4; ++j) acc[i][j] = (f32x4){0.f, 0.f, 0.f, 0.f};
    {
      const char* qa = qimg + (wm * 64 + lr) * 272 + g * 16;
      const char* kb = kimg + (wn * 64 + lr) * 272 + g * 16;
#pragma unroll
      for (int s = 0; s < 4; ++s) {
        bf16x8 af[4], bfr[4];
#pragma unroll
        for (int i = 0; i < 4; ++i) af[i] = *(const bf16x8*)(qa + i * 16 * 272 + s * 64);
#pragma unroll
        for (int j = 0; j < 4; ++j) bfr[j] = *(const bf16x8*)(kb + j * 16 * 272 + s * 64);
#pragma unroll
        for (int i = 0; i < 4; ++i)
#pragma unroll
          for (int j = 0; j < 4; ++j) acc[i][j] = __builtin_amdgcn_mfma_f32_16x16x32_bf16(af[i], bfr[j], acc[i][j], 0, 0, 0);
      }
    }
    __syncthreads();
    unsigned* simg = (unsigned*)smem;
    {
      unsigned* sw = simg + (wm * 64 + 4 * g) * 129 + wn * 64 + lr;
#pragma unroll
      for (int i = 0; i < 4; ++i)
#pragma unroll
        for (int r = 0; r < 4; ++r)
#pragma unroll
          for (int j = 0; j < 4; ++j)
            sw[(16 * i + r) * 129 + 16 * j] = (ord_key(acc[i][j][r]) & ~127u) | (unsigned)(wn * 64 + 16 * j + lr);
    }
    __syncthreads();
    const int row = tid & 127, half = tid >> 7;
    unsigned top[16];
    {
      const unsigned* sr = simg + row * 129 + half * 64;
#pragma unroll
      for (int k = 0; k < 16; ++k) top[k] = sr[k];
      sort16_desc(top);
#pragma unroll 1
      for (int gi = 1; gi < 4; ++gi) {
        unsigned v1[16];
#pragma unroll
        for (int k = 0; k < 16; ++k) v1[k] = sr[gi * 16 + k];
        sort16_desc(v1);
        merge16_desc(top, v1);
      }
    }
    __syncthreads();
    if (half == 1) {
#pragma unroll
      for (int k = 0; k < 16; ++k) simg[k * 128 + row] = top[k];
    }
    __syncthreads();
    if (half == 0) {
      unsigned o[16];
#pragma unroll
      for (int k = 0; k < 16; ++k) o[k] = simg[k * 128 + row];
      merge16_desc(top, o);
      uint4* dst = (uint4*)(p.pk + (((size_t)(m0 + row) * 8 + head) * 2 + hf) * 16);
#pragma unroll
      for (int k = 0; k < 4; ++k) dst[k] = make_uint4(top[4 * k], top[4 * k + 1], top[4 * k + 2], top[4 * k + 3]);
    }
  }
};

__device__ const unsigned char CAND_A[64] = {0,0,0,0,0,0,0,0,0,0,0,0,0,0,0,0, 1,1,1,1,1,1,1,1, 2,2,2,2,2, 3,3,3,3, 4,4,4, 5,5, 6,6, 7,7,
                                             8,9,10,11,12,13,14,15, 0,0,0,0,0,0,0,0,0,0,0,0,0,0};
__device__ const unsigned char CAND_B[64] = {0,1,2,3,4,5,6,7,8,9,10,11,12,13,14,15, 0,1,2,3,4,5,6,7, 0,1,2,3,4, 0,1,2,3, 0,1,2, 0,1, 0,1, 0,1,
                                             0,0,0,0,0,0,0,0, 0,0,0,0,0,0,0,0,0,0,0,0,0,0};

__device__ __forceinline__ void ph_peer_merge(const P& p, int l, int t0, char* smem) {
  const int tid = tid_opaque(), lane = tid & 63, wv = tid >> 6;
  const float* n2g = p.norm2_g + l * 1024;
  const int ca = CAND_A[lane], cb = CAND_B[lane];
  for (int tk = t0 + blockIdx.x * 4 + wv; tk < TT; tk += gridDim.x * 4) {
    const float* mod = p.mod + (l * 2 + (tk < LC ? 1 : 0)) * 6144;
    unsigned p1[8], p2[8];
    {
      const unsigned* pk = p.pk + (size_t)tk * 256;
#pragma unroll
      for (int head = 0; head < 8; ++head) { p1[head] = pk[head * 32 + ca]; p2[head] = pk[head * 32 + 16 + cb]; }
    }
    {
      const float4* xp = (const float4*)(p.xall + (size_t)tk * 1024) + lane * 4;
      float4 v[4];
      float ss = 0.f;
#pragma unroll
      for (int q = 0; q < 4; ++q) { v[q] = xp[q]; ss += v[q].x * v[q].x + v[q].y * v[q].y + v[q].z * v[q].z + v[q].w * v[q].w; }
      ss = wave_sum(ss);
      const float rinv = rsqrtf(ss * (1.f / 1024.f) + EPS);
      uint2* hp = (uint2*)(p.hb + (size_t)tk * 1024) + lane * 4;
#pragma unroll
      for (int q = 0; q < 4; ++q) {
        float4 gg = ((const float4*)n2g)[lane * 4 + q], sc = ((const float4*)(mod + 4096))[lane * 4 + q], sh = ((const float4*)(mod + 3072))[lane * 4 + q];
        float h0 = v[q].x * rinv * gg.x * (1.f + sc.x) + sh.x, h1 = v[q].y * rinv * gg.y * (1.f + sc.y) + sh.y;
        float h2 = v[q].z * rinv * gg.z * (1.f + sc.z) + sh.z, h3 = v[q].w * rinv * gg.w * (1.f + sc.w) + sh.w;
        hp[q] = make_uint2(pack2bf(h0, h1), pack2bf(h2, h3));
      }
    }
    float sums[8];
    unsigned* candk = (unsigned*)smem + wv * 512;
#pragma unroll
    for (int head = 0; head < 8; ++head) {
      sums[head] = lane < 50 ? ord_val(p1[head]) + ord_val(p2[head]) : -3.0e38f;
      candk[head * 64 + lane] = (ord_key(sums[head]) & ~63u) | (unsigned)(63 - lane);
    }
#pragma unroll
    for (int head = 0; head < 8; ++head) {
      const float sum = sums[head];
      const unsigned kme = (ord_key(sum) & ~63u) | (unsigned)(63 - lane);
      int eid = (int)(p1[head] & 127u) * 128 + (int)(p2[head] & 127u);
      int rank = 0;
#pragma unroll
      for (int m4 = 0; m4 < 13; ++m4) {
        const uint4 km = *(const uint4*)(candk + head * 64 + 4 * m4);
        rank += (km.x > kme) ? 1 : 0;
        rank += (km.y > kme) ? 1 : 0;
        rank += (km.z > kme) ? 1 : 0;
        rank += (km.w > kme) ? 1 : 0;
      }
      float mx = wave_max(sum);
      bool sel = (lane < 50) && (rank < 16);
      float e = sel ? __expf(sum - mx) : 0.f;
      float tot = wave_sum(e);
      if (sel) {
        const int n = head * 16 + rank, idx = (n & 7) * 16 + (n >> 3);
        p.el[(size_t)tk * 128 + idx] = eid;
        p.gl[(size_t)tk * 128 + idx] = e / tot;
      }
    }
  }
}

__device__ __forceinline__ uint4 bload(__amdgpu_buffer_rsrc_t rs, int voff) {
  const u32x4 v = __builtin_amdgcn_raw_buffer_load_b128(rs, voff, 0, 0);
  return make_uint4(v.x, v.y, v.z, v.w);
}
struct XcdWork { int li, np, rank, nloc; };

__device__ __forceinline__ XcdWork load_xw(const float* smem) {
  const volatile LAS unsigned* st = (const volatile LAS unsigned*)(smem + 18432);
  XcdWork xw;
  xw.nloc = __builtin_amdgcn_readfirstlane((int)st[0]); xw.np = __builtin_amdgcn_readfirstlane((int)st[1]);
  xw.rank = __builtin_amdgcn_readfirstlane((int)st[2]); xw.li = __builtin_amdgcn_readfirstlane((int)st[3]);
  return xw;
}
__device__ __forceinline__ void ph_peer_s1(const P& p, int l, int t0, const XcdWork& xw) {
  const int tid = tid_opaque(), lane = tid & 63, wv = tid >> 6, j = lane >> 3, k = lane & 7;
  const unsigned char* U = p.ub8 + (size_t)l * 16384 * 1024;
  const int step = xw.nloc * 4;
  for (int s = xw.li; s < 8; s += xw.np) {
    const unsigned roff = 128u * s + 16u * k;
    const __amdgpu_buffer_rsrc_t urs = __builtin_amdgcn_make_buffer_rsrc((void*)(U + (size_t)s * 16384 * 128), (short)0, 16384 * 128, 0x00020000);
    const int tk0 = t0 + xw.rank * 4 + wv;
    if (tk0 >= TT) continue;
    uint4 ur[2][16]; uint4 hh[2][2]; int4 en[4];
#define S1_LOAD_LIST(TK) { const int4* ep = (const int4*)(p.el + (size_t)(TK) * 128 + j * 16); _Pragma("unroll") for (int q = 0; q < 4; ++q) en[q] = ep[q]; }
#define S1_ISSUE(B, TK) {                                                                            \
      _Pragma("unroll") for (int q = 0; q < 4; ++q) {                                                \
        ur[B][4 * q + 0] = bload(urs, en[q].x * 128 + 16 * k);                  \
        ur[B][4 * q + 1] = bload(urs, en[q].y * 128 + 16 * k);                  \
        ur[B][4 * q + 2] = bload(urs, en[q].z * 128 + 16 * k);                  \
        ur[B][4 * q + 3] = bload(urs, en[q].w * 128 + 16 * k);                  \
      }                                                                                              \
      const uint4* hp = (const uint4*)(p.hb + (size_t)(TK) * 1024 + roff);                           \
      hh[B][0] = hp[0]; hh[B][1] = hp[1]; }
#define S1_CONSUME(B, TK) {                                                                          \
      float hv[16];                                                                                  \
      { unsigned w[8] = {hh[B][0].x, hh[B][0].y, hh[B][0].z, hh[B][0].w, hh[B][1].x, hh[B][1].y, hh[B][1].z, hh[B][1].w}; \
        _Pragma("unroll") for (int q = 0; q < 8; ++q) { hv[2 * q] = __uint_as_float(w[q] << 16); hv[2 * q + 1] = __uint_as_float(w[q] & 0xffff0000u); } } \
      float keep0 = 0.f, keep1 = 0.f;                                                                \
      _Pragma("unroll") for (int i = 0; i < 16; ++i) {                                               \
        unsigned w[4] = {ur[B][i].x, ur[B][i].y, ur[B][i].z, ur[B][i].w};                            \
        float dot = 0.f;                                                                             \
        _Pragma("unroll") for (int q = 0; q < 4; ++q) {                                              \
          f32x2 lo = __builtin_amdgcn_cvt_pk_f32_fp8((int)w[q], false), hi = __builtin_amdgcn_cvt_pk_f32_fp8((int)w[q], true); \
          dot += lo[0] * hv[q * 4] + lo[1] * hv[q * 4 + 1] + hi[0] * hv[q * 4 + 2] + hi[1] * hv[q * 4 + 3]; \
        }                                                                                            \
        dot += dpp_row<0xB1>(dot); dot += dpp_row<0x4E>(dot); dot += dpp_row<0x141>(dot);            \
        if (i < 8) keep0 = (k == i) ? dot : keep0; else keep1 = (k == i - 8) ? dot : keep1;          \
      }                                                                                              \
      float* pd = p.pd + ((size_t)s * TT + (TK)) * 128;                                              \
      pd[8 * k + j] = keep0; pd[8 * (k + 8) + j] = keep1; }
    S1_LOAD_LIST(tk0)
    S1_ISSUE(0, tk0)
    if (tk0 + step < TT) S1_LOAD_LIST(tk0 + step)
    for (int tk = tk0; tk < TT; tk += 2 * step) {
      const bool has1 = tk + step < TT, has2 = tk + 2 * step < TT;
      if (has1) { S1_ISSUE(1, tk + step) if (has2) S1_LOAD_LIST(tk + 2 * step) }
      S1_CONSUME(0, tk)
      if (has1) {
        if (has2) { S1_ISSUE(0, tk + 2 * step) if (tk + 3 * step < TT) S1_LOAD_LIST(tk + 3 * step) }
        S1_CONSUME(1, tk + step)
      }
    }
#undef S1_LOAD_LIST
#undef S1_ISSUE
#undef S1_CONSUME
  }
}

__device__ __forceinline__ void ph_peer_r(const P& p, int l, int t0) {
  const float* usc = p.usc + l * 16384;
  const float* vsc = p.vsc + l * 16384;
  for (int idx = GTID; idx < (TT - t0) * 32; idx += GSZ) {
    const int tk = t0 + (idx >> 5), n0 = (idx & 31) * 4;
    float4 d = make_float4(0.f, 0.f, 0.f, 0.f);
#pragma unroll
    for (int s = 0; s < 8; ++s) {
      const float4 v = *(const float4*)(p.pd + ((size_t)s * TT + tk) * 128 + n0);
      d.x += v.x; d.y += v.y; d.z += v.z; d.w += v.w;
    }
    float dv[4] = {d.x, d.y, d.z, d.w};
#pragma unroll
    for (int q = 0; q < 4; ++q) {
      const int n = n0 + q, li = (n & 7) * 16 + (n >> 3);
      const int ex = p.el[(size_t)tk * 128 + li];
      p.av[(size_t)tk * 128 + li] = p.gl[(size_t)tk * 128 + li] * gelu_f(dv[q] * usc[ex]) * vsc[ex];
    }
  }
}

__device__ __forceinline__ void ph_peer_s2(const P& p, int l, int t0, const XcdWork& xw, char* smem) {
  const int tid = tid_opaque(), lane = tid & 63, wv = tid >> 6, j = lane >> 3, k = lane & 7;
  const int ko = lane >> 3, jo = lane & 7;
  float* red = (float*)smem + wv * 1408;
  int* elb = (int*)(red + 1024);
  float* avb = red + 1024 + 256;
  const unsigned char* V = p.vb8 + (size_t)l * 16384 * 1024;
  const int step = xw.nloc * 4;
  for (int s = xw.li; s < 8; s += xw.np) {
    const __amdgpu_buffer_rsrc_t vrs = __builtin_amdgcn_make_buffer_rsrc((void*)(V + (size_t)s * 16384 * 128), (short)0, 16384 * 128, 0x00020000);
    const int dim = 128 * s + 16 * ko + 2 * jo;
    int tk = t0 + xw.rank * 4 + wv;
    if (tk >= TT) continue;
    *(int2*)(elb + 2 * lane) = *(const int2*)(p.el + (size_t)tk * 128 + 2 * lane);
    int par = 0;
    for (; tk < TT; tk += step, par ^= 1) {
      uint4 vr[16];
      {
        const int4* eb = (const int4*)(elb + par * 128 + j * 16);
#pragma unroll
        for (int q = 0; q < 4; ++q) {
          const int4 e4 = eb[q];
          vr[4 * q + 0] = bload(vrs, e4.x * 128 + 16 * k);
          vr[4 * q + 1] = bload(vrs, e4.y * 128 + 16 * k);
          vr[4 * q + 2] = bload(vrs, e4.z * 128 + 16 * k);
          vr[4 * q + 3] = bload(vrs, e4.w * 128 + 16 * k);
        }
      }
      const float2 a2 = *(const float2*)(p.av + (size_t)tk * 128 + 2 * lane);
      const float* mod = p.mod + (l * 2 + (tk < LC ? 1 : 0)) * 6144;
      const float2 g2 = *(const float2*)(mod + 5120 + dim);
      const float2 xin = *(const float2*)(p.xall + (size_t)tk * 1024 + dim);
      if (tk + step < TT) {
        const int2 e2 = *(const int2*)(p.el + (size_t)(tk + step) * 128 + 2 * lane);
        *(int2*)(elb + (par ^ 1) * 128 + 2 * lane) = e2;
      }
      *(float2*)(avb + 2 * lane) = a2;
      float acc[16];
#pragma unroll
      for (int d = 0; d < 16; ++d) acc[d] = 0.f;
#pragma unroll
      for (int i4 = 0; i4 < 4; ++i4) {
        const float4 aq = *(const float4*)(avb + j * 16 + 4 * i4);
        const float av4[4] = {aq.x, aq.y, aq.z, aq.w};
#pragma unroll
        for (int ii = 0; ii < 4; ++ii) {
          const int i = 4 * i4 + ii;
          const float a = av4[ii];
          unsigned y[4] = {vr[i].x, vr[i].y, vr[i].z, vr[i].w};
#pragma unroll
          for (int q = 0; q < 4; ++q) {
            f32x2 lo = __builtin_amdgcn_cvt_pk_f32_fp8((int)y[q], false), hi = __builtin_amdgcn_cvt_pk_f32_fp8((int)y[q], true);
            acc[q * 4] += a * lo[0]; acc[q * 4 + 1] += a * lo[1]; acc[q * 4 + 2] += a * hi[0]; acc[q * 4 + 3] += a * hi[1];
          }
          if (i + 1 < 16) asm volatile("" : "+v"(acc[0]), "+v"(vr[i + 1].x), "+v"(vr[i + 1].y), "+v"(vr[i + 1].z), "+v"(vr[i + 1].w));
        }
      }
#pragma unroll
      for (int q = 0; q < 4; ++q) *(float4*)(red + lane * 16 + 4 * q) = make_float4(acc[4 * q], acc[4 * q + 1], acc[4 * q + 2], acc[4 * q + 3]);
      float f0 = 0.f, f1 = 0.f;
#pragma unroll
      for (int jj = 0; jj < 8; ++jj) {
        const float2 t = *(const float2*)(red + (jj * 8 + ko) * 16 + 2 * jo);
        f0 += t.x; f1 += t.y;
      }
      float2 o = make_float2(xin.x + g2.x * f0, xin.y + g2.y * f1);
      if (l == 1) *(float2*)(p.out + (size_t)(tk - LC) * 1024 + dim) = o;
      else {
        *(float2*)(p.xall + (size_t)tk * 1024 + dim) = o;
        const float* mod1 = p.mod + (2 + (tk < LC ? 1 : 0)) * 6144;
        const float2 n1 = *(const float2*)(p.norm1_g + 1024 + dim), s1 = *(const float2*)(mod1 + 1024 + dim);
        *(unsigned*)(p.hb + (size_t)tk * 1024 + dim) = pack2bf(o.x * n1.x * (1.f + s1.x), o.y * n1.y * (1.f + s1.y));
        const float ssq = wave_sum(o.x * o.x + o.y * o.y);
        if (lane == 0) p.rowss[(size_t)s * TT + tk] = ssq;
      }
    }
  }
}

#define XB_TMO      128
#define XB_XCNT(j)  (256  + 64 * (j))
#define XB_XSUB(j)  (1280 + 64 * (j))
#define XB_XGEN(j)  (2304 + 64 * (j))
#define XB_TOP      3328
#define XB_TOPGEN   3392
#define XB_RANK(j)  (3456 + 64 * (j))
#define XCD_BAR_WORDS 4480
#define XB_SPIN_CAP (1u << 22)
__device__ __forceinline__ unsigned xb_ld(unsigned* q) { return __hip_atomic_load(q, __ATOMIC_RELAXED, __HIP_MEMORY_SCOPE_AGENT); }
__device__ __forceinline__ unsigned xb_add(unsigned* q, unsigned v) { return __hip_atomic_fetch_add(q, v, __ATOMIC_RELAXED, __HIP_MEMORY_SCOPE_AGENT); }
__device__ __forceinline__ unsigned xb_xcc_id() { return (unsigned)__builtin_amdgcn_s_getreg((3 << 11) | 20) & 0xFu; }
#define XB_SPIN(cond, bar) do { unsigned _sp = 0; while (cond) { __builtin_amdgcn_s_sleep(1); \
    if ((++_sp & 255u) == 0u) { if (xb_ld(&(bar)[XB_TMO])) break; if (_sp > XB_SPIN_CAP) { atomicAdd(&(bar)[XB_TMO], 1u); break; } } } } while (0)
struct XcdBarrier { unsigned* bar; unsigned x; volatile LAS unsigned* st; };
__device__ __forceinline__ XcdBarrier xcd_barrier_post(unsigned* bar, volatile LAS unsigned* st) {
  XcdBarrier b; b.bar = bar; b.x = xb_xcc_id(); b.st = st;
  if (threadIdx.x == 0) { (void)xb_add(&bar[XB_XCNT(b.x)], 1u); st[2] = xb_add(&bar[XB_RANK(b.x)], 1u); }
  return b;
}
__device__ __forceinline__ void xcd_barrier_complete(unsigned* bar, unsigned x, unsigned& nloc, unsigned& nx, unsigned& li) {
  const unsigned G = gridDim.x * gridDim.y * gridDim.z;
  unsigned sum, cnt, mine, below, sp = 0u;
  for (;;) {
    sum = 0u; cnt = 0u; mine = 0u; below = 0u;
#pragma unroll
    for (unsigned j = 0; j < 16; ++j) { const unsigned c = xb_ld(&bar[XB_XCNT(j)]); sum += c; cnt += (c > 0u) ? 1u : 0u; mine = (j == x) ? c : mine; below += (j < x && c > 0u) ? 1u : 0u; }
    if (sum == G) break;
    __builtin_amdgcn_s_sleep(1);
    if ((++sp & 255u) == 0u) { if (xb_ld(&bar[XB_TMO])) break; if (sp > XB_SPIN_CAP) { atomicAdd(&bar[XB_TMO], 1u); break; } }
  }
  nloc = mine > 0u ? mine : 1u; nx = cnt > 0u ? cnt : 1u; li = below;
}
__device__ __forceinline__ void xcd_barrier(const XcdBarrier& b) {
  asm volatile("s_waitcnt vmcnt(0)" ::: "memory");
  __syncthreads();
  if (threadIdx.x == 0) {
    unsigned* bar = b.bar;
    __builtin_amdgcn_s_waitcnt(0);
    unsigned nloc = b.st[0], nx = b.st[1];
    if (nloc == 0u) { unsigned li; xcd_barrier_complete(bar, b.x, nloc, nx, li); b.st[0] = nloc; b.st[1] = nx; b.st[3] = li; }
    const unsigned old = xb_add(&bar[XB_XSUB(b.x)], 1u);
    const unsigned gen = old / nloc;
    if (old + 1u == (gen + 1u) * nloc) {
      __builtin_amdgcn_fence(__ATOMIC_RELEASE, "agent");
      asm volatile("s_waitcnt vmcnt(0)" ::: "memory");
      const unsigned og = xb_add(&bar[XB_TOP], 1u);
      const unsigned tg = og / nx;
      if (og + 1u == (tg + 1u) * nx) xb_add(&bar[XB_TOPGEN], 1u);
      else XB_SPIN(xb_ld(&bar[XB_TOPGEN]) == tg, bar);
      __builtin_amdgcn_fence(__ATOMIC_ACQUIRE, "agent");
      xb_add(&bar[XB_XGEN(b.x)], 1u);
      asm volatile("s_waitcnt vmcnt(0)" ::: "memory");
    } else {
      XB_SPIN(xb_ld(&bar[XB_XGEN(b.x)]) == gen, bar);
      __builtin_amdgcn_fence(__ATOMIC_ACQUIRE, "agent");
      asm volatile("s_waitcnt vmcnt(0)" ::: "memory");
    }
  }
  __syncthreads();
}

#ifndef PROBE_IV
#define PROBE_IV -1
#endif
__device__ __forceinline__ void probe_tick(int& cnt, unsigned long long* slots) {
  if (PROBE_IV >= 0) {
    if (threadIdx.x == 0 && (cnt == PROBE_IV || cnt == PROBE_IV + 1)) slots[cnt - PROBE_IV] = __builtin_amdgcn_s_memrealtime();
    cnt = __builtin_amdgcn_readfirstlane(cnt + 1);
  }
}
#define BARRIER() do { XcdBarrier xb_; xb_.bar = PP.bar; xb_.x = xb_xcc_id(); xb_.st = (volatile LAS unsigned*)(smem + 18432); xcd_barrier(xb_); probe_tick(pcnt, probe_t); } while (0)

typedef const __attribute__((address_space(4))) P* KP;
__device__ __forceinline__ P load_params(KP kp) {
#if defined(__HIP_DEVICE_COMPILE__)
  asm volatile("" : "+s"(kp));
  return *kp;
#else
  return P{};
#endif
}
#define PP load_params(kp)
__global__ void __launch_bounds__(256, 2) k_mega(P p_unused) {
  KP kp = (KP)__builtin_amdgcn_kernarg_segment_ptr();
  __shared__ __attribute__((aligned(16))) float smem[18432 + 8];
  uint4& xb_words = *(uint4*)(smem + 18432);
  cg::grid_group grid = cg::this_grid();
  if (threadIdx.x == 0) xb_words = make_uint4(0u, 0u, 0u, 0u);
  __syncthreads();
  unsigned long long* probe_t = (unsigned long long*)(smem + 18436);
  int pcnt = 0;
  asm volatile("" : "+s"(pcnt));
  probe_tick(pcnt, probe_t);
  ph_mod(PP, smem);
  ph_prep(PP, smem);
  ph_lru_prepw(PP);
  ph_rope_tab(PP);
  ph_prep_small(PP);
  grid.sync();
  probe_tick(pcnt, probe_t);
  (void)xcd_barrier_post(PP.bar, (volatile LAS unsigned*)&xb_words);
  ph_norm_mod(PP, 0, 0, 0, smem, true);
  ph_shb(PP);
  BARRIER();
#pragma unroll 1
  for (int l = 0; l < 2; ++l) {
    const int t0 = (l == 0) ? 0 : LC;
    { const P lp = PP; gemm_bf16_128(lp, lp.hb, lp.w_in_t + (size_t)l * 1024 * DIN, 1024, 0, TT, DIN, (char*)smem, EpiProj{l}, l == 0 ? 0 : -1, 15); }
    if (l == 0) {
      const P lp = PP;
      const int b0 = (130 * 18) % (int)gridDim.x;
      gemm_bf16_128(lp, lp.shb, lp.wq_t, 1024, 0, 128, NPQ, (char*)smem, EpiBias{lp.bq, NPQ}, -1, 0, b0);
      gemm_bf16_128(lp, lp.shb + 128 * 1024, lp.wq_t + (size_t)1024 * NPQ, 1024, 0, 128, NPQ, (char*)smem, EpiBias{lp.bq + 2 * NPQ, NPQ}, -1, 0, (b0 + 16) % (int)gridDim.x);
      gemm_bf16_128(lp, lp.shb + 2 * 128 * 1024, lp.w_in_t + (size_t)1024 * DIN, 1024, 0, 128, DIN, (char*)smem, EpiBias{lp.bin, DIN}, -1, 0, (b0 + 32) % (int)gridDim.x);
    }
    BARRIER();
    ph_lru<1>(PP, l, (char*)smem);
    ph_attn(PP, l, (char*)smem);
    BARRIER();
    ph_lru_carry(PP, smem);
    BARRIER();
    ph_lru<2>(PP, l, (char*)smem);
    BARRIER();
    { const P lp = PP; gemm_bf16_128(lp, lp.mixb, lp.w_out_t + (size_t)l * 1024 * 1024, 1024, t0, TT, 1024, (char*)smem, EpiResid{l}, l == 0 ? 1 : -1, 32); }
    BARRIER();
    { const P lp = PP; gemm_bf16_128(lp, lp.hb, lp.wq_t + (size_t)l * 1024 * NPQ, 1024, t0, TT, NPQ, (char*)smem, EpiPeerTopk{l}); }
    BARRIER();
    ph_peer_merge(PP, l, t0, (char*)smem);
    BARRIER();
    ph_peer_s1(PP, l, t0, load_xw(smem));
    BARRIER();
    ph_peer_r(PP, l, t0);
    BARRIER();
    ph_peer_s2(PP, l, t0, load_xw(smem), (char*)smem);
    if (l == 0) BARRIER();
  }
  if (PROBE_IV >= 0) {
    probe_tick(pcnt, probe_t);
    __syncthreads();
    if (blockIdx.x == 0 && threadIdx.x == 0) {
      const unsigned long long dt = (probe_t[1] - probe_t[0]) * 8ull, ts = __builtin_amdgcn_s_memrealtime();
      while (__builtin_amdgcn_s_memrealtime() - ts < dt) __builtin_amdgcn_s_sleep(8);
    }
  }
}

extern "C" void kernel_launch(void* const* d_in, const int* in_sizes, int n_in, void* d_out, int out_size, void* d_ws,
                              size_t ws_size, hipStream_t stream) {
  P p{};
  const float** fp = (const float**)&p;
  for (int i = 0; i < 28; ++i) fp[i] = (const float*)d_in[i];
  p.out = (float*)d_out;
  float* w = (float*)d_ws;
  size_t o = 0;
  auto carve = [&](size_t n) { float* r = w + o; o += (n + 63) & ~(size_t)63; return r; };
  p.bar = (unsigned*)carve(8192);
  p.mod = carve(4 * 6144);
  p.xall = carve((size_t)TT * 1024);
  p.proj = carve((size_t)TT * 512);
  p.projb = (bf16_t*)carve((size_t)TT * DIN / 2);
  p.mixb = (bf16_t*)carve((size_t)TT * 512);
  p.hb = (bf16_t*)carve((size_t)TT * 512);
  p.w_in_t = (bf16_t*)carve((size_t)1024 * DIN);
  p.w_out_t = (bf16_t*)carve((size_t)1024 * 1024);
  p.wq_t = (bf16_t*)carve((size_t)1024 * NPQ);
  p.lruw_t = (bf16_t*)carve((size_t)2 * 2 * 4 * 2 * 4096 / 2);
  p.lagg = carve((size_t)2 * NCHUNK * 256 * 2);
  p.lcarry = carve((size_t)2 * NCHUNK * 256);
  p.ropetab = carve(320 * 16 * 2);
  p.rowss = carve((size_t)8 * TT);
  p.bq = carve(4 * NPQ);
  p.bin = carve(2 * DIN);
  p.shb = (bf16_t*)carve(3 * 128 * 1024 / 2);
  p.el = (int*)carve((size_t)TT * 128);
  p.gl = carve((size_t)TT * 128);
  p.av = carve((size_t)TT * 128);
  p.pd = carve((size_t)8 * TT * 128);
  p.pk = (unsigned*)carve((size_t)TT * 256);
  p.ub8 = (unsigned char*)carve((size_t)2 * 16384 * 1024 / 4);
  p.vb8 = (unsigned char*)carve((size_t)2 * 16384 * 1024 / 4);
  p.usc = carve(2 * 16384);
  p.vsc = carve(2 * 16384);
  p.k1b = (bf16_t*)carve(16384);
  p.k2b = (bf16_t*)carve(16384);
  if (o * 4 > ws_size) { fprintf(stderr, "workspace too small: need %zu have %zu\n", o * 4, ws_size); return; }
  static int grid_blocks = 0;
  if (!grid_blocks) {
    int dev = 0, cus = 0, per_cu = 0;
    (void)hipGetDevice(&dev);
    (void)hipDeviceGetAttribute(&cus, hipDeviceAttributeMultiprocessorCount, dev);
    (void)hipOccupancyMaxActiveBlocksPerMultiprocessor(&per_cu, k_mega, 256, 0);
    if (per_cu > 2) per_cu = 2;
    grid_blocks = cus * per_cu;
  }
  (void)hipMemsetAsync(p.bar, 0, XCD_BAR_WORDS * 4, stream);
  void* args[] = {&p};
  hipError_t e = hipLaunchCooperativeKernel((void*)k_mega, dim3(grid_blocks), dim3(256), args, 0, stream);
  if (e != hipSuccess) fprintf(stderr, "cooperative launch failed: %s (grid %d)\n", hipGetErrorString(e), grid_blocks);
}
```

```cpp
#include <hip/hip_runtime.h>
#include <hip/hip_cooperative_groups.h>
#include <stdint.h>
#include <stdio.h>
namespace cg = cooperative_groups;

#ifndef SINGLE_LAUNCH
#define SINGLE_LAUNCH 1
#endif

constexpr int DM = 1024, SEQ = 16384, LC = 256, TT = SEQ + LC, DIN = 2304, NPQ = 2048;
constexpr int OFF_XA = 0, OFF_GA = 256, OFF_QW = 512, OFF_KW = 896, OFF_VW = 1024, OFF_QN = 1152, OFF_KN = 1536, OFF_VN = 1920;
constexpr float EPS = 1e-6f;
#define LAS __attribute__((address_space(3)))
constexpr float LOG2E = 1.4426950408889634f;
constexpr float QSCALE = 0.125f * LOG2E;

struct P {
  const float *x, *c, *ctx, *c_ctx, *w_mod, *b_mod, *norm1_g, *norm2_g, *w_in, *w_out,
      *conv_w, *conv_b, *wa, *ba, *wx, *bx, *lam, *win_qn, *win_kn, *win_sink, *na_qn, *na_kn, *rpb,
      *wq, *k1, *k2, *pu, *pv;
  float* out;
  float *mod, *xall, *proj;
  unsigned short* projb;
  unsigned* pk;
  unsigned* bar;
  unsigned short *k1b, *k2b;
  unsigned char *ub8, *vb8;
  float *usc, *vsc;
  unsigned short *hb, *mixb, *w_in_t, *w_out_t, *wq_t, *lruw_t;
  float *lagg, *lcarry, *ropetab, *rowss, *bq, *bin, *gl, *av, *pd;
  unsigned short* shb;
  int* el;
};

typedef unsigned short bf16_t;
typedef __attribute__((ext_vector_type(8))) short bf16x8;
typedef __attribute__((ext_vector_type(4))) float f32x4;
__device__ __forceinline__ unsigned pack2bf(float a, float b) {
  unsigned r;
  asm("v_cvt_pk_bf16_f32 %0, %1, %2" : "=v"(r) : "v"(a), "v"(b));
  return r;
}
__device__ __forceinline__ unsigned short f2bf(float f) { return (unsigned short)(pack2bf(f, 0.f) & 0xffffu); }
__device__ __forceinline__ float bf2f(unsigned short h) { return __uint_as_float(((unsigned)h) << 16); }


__device__ __forceinline__ float silu_f(float x) { return x / (1.f + __expf(-x)); }
__device__ __forceinline__ float sigmoid_f(float x) { return 1.f / (1.f + __expf(-x)); }
__device__ __forceinline__ float gelu_f(float x) {
  float u = 0.7978845608028654f * (x + 0.044715f * x * x * x);
  float e = __expf(2.f * u);
  float th = 1.f - 2.f / (e + 1.f);
  return 0.5f * x * (1.f + th);
}
template <int CTRL, int RMASK>
__device__ __forceinline__ float dpp_mov(float v) {
  return __int_as_float(__builtin_amdgcn_update_dpp(0, __float_as_int(v), CTRL, RMASK, 0xf, false));
}
__device__ __forceinline__ float wave_sum(float v) {
  v += dpp_mov<0xB1, 0xf>(v);
  v += dpp_mov<0x4E, 0xf>(v);
  v += dpp_mov<0x141, 0xf>(v);
  v += dpp_mov<0x140, 0xf>(v);
  v += dpp_mov<0x142, 0xa>(v);
  v += dpp_mov<0x143, 0xc>(v);
  return __int_as_float(__builtin_amdgcn_readlane(__float_as_int(v), 63));
}

__device__ __forceinline__ int tid_opaque() { int t = threadIdx.x; asm volatile("" : "+v"(t)); return t; }
#define GTID (blockIdx.x * blockDim.x + tid_opaque())
#define GSZ (gridDim.x * blockDim.x)

__device__ __forceinline__ void ph_mod(const P& p, float* smem) {
  const int tid = tid_opaque(), cl = tid & 31, ks = tid >> 5;
  for (int it = blockIdx.x; it < 2 * 192; it += gridDim.x) {
    const int nc = it % 192, l = it / 192;
    const int n = nc * 32 + cl;
    const float* w = p.w_mod + (size_t)l * 1024 * 6144 + n;
    float a0 = 0.f, a1 = 0.f;
#pragma unroll 8
    for (int i = 0; i < 128; ++i) {
      int k = i * 8 + ks;
      float wv = w[(size_t)k * 6144];
      a0 += silu_f(p.c[k]) * wv;
      a1 += silu_f(p.c_ctx[k]) * wv;
    }
    __syncthreads();
    smem[tid] = a0; smem[256 + tid] = a1;
    __syncthreads();
    if (tid < 64) {
      const int which = tid >> 5;
      float s = p.b_mod[l * 6144 + n];
#pragma unroll
      for (int q = 0; q < 8; ++q) s += smem[which * 256 + q * 32 + cl];
      p.mod[(l * 2 + which) * 6144 + n] = s;
    }
  }
}

__device__ __forceinline__ void ph_bq(const P& p, float* smem) {
  const int tid = tid_opaque(), cl = tid & 31, ks = tid >> 5;
  for (int it = blockIdx.x; it < 2 * 64; it += gridDim.x) {
    const int nc = it % 64, l = it / 64;
    const int n = nc * 32 + cl;
    const float* w = p.wq + (size_t)l * 1024 * NPQ + n;
    const float* v0 = p.mod + (l * 2 + 0) * 6144 + 3072;
    const float* v1 = p.mod + (l * 2 + 1) * 6144 + 3072;
    float a0 = 0.f, a1 = 0.f;
#pragma unroll 8
    for (int i = 0; i < 128; ++i) {
      int k = i * 8 + ks;
      float wv = w[(size_t)k * NPQ];
      a0 += v0[k] * wv;
      a1 += v1[k] * wv;
    }
    __syncthreads();
    smem[tid] = a0; smem[256 + tid] = a1;
    __syncthreads();
    if (tid < 64) {
      const int which = tid >> 5;
      float s = 0.f;
#pragma unroll
      for (int q = 0; q < 8; ++q) s += smem[which * 256 + q * 32 + cl];
      p.bq[(l * 2 + which) * NPQ + n] = s;
    }
  }
}

__device__ __forceinline__ void ph_shb(const P& p) {
  for (int idx = GTID; idx < 3 * 2 * 1024; idx += GSZ) {
    const int k = idx & 1023, which = (idx >> 10) & 1, m = idx >> 11;
    const int l = (m == 0) ? 0 : 1, off = (m == 2) ? 0 : 3072;
    p.shb[((size_t)m * 128 + which) * 1024 + k] = f2bf(p.mod[(l * 2 + which) * 6144 + off + k]);
  }
}

__device__ __forceinline__ void ph_copy_in(const P& p) {
  const float4* xs = (const float4*)p.x;
  const float4* cs = (const float4*)p.ctx;
  float4* d = (float4*)p.xall;
  for (int i = GTID; i < TT * 256; i += GSZ) d[i] = (i < LC * 256) ? cs[i] : xs[i - LC * 256];
}

__device__ __forceinline__ void ph_copy_out(const P& p) {
  const float4* s = (const float4*)(p.xall + (size_t)LC * 1024);
  float4* d = (float4*)p.out;
  for (int i = GTID; i < SEQ * 256; i += GSZ) d[i] = s[i];
}

__device__ __forceinline__ void ph_norm_mod(const P& p, int l, int which_norm, int t0, float* smem, bool from_input = false) {
  const float* g = (which_norm ? p.norm2_g : p.norm1_g) + l * 1024;
  const int sh_off = which_norm ? 3072 : 0, sc_off = which_norm ? 4096 : 1024;
  const int tid = tid_opaque();
  for (int t = t0 + blockIdx.x; t < TT; t += gridDim.x) {
    const float* mod = p.mod + (l * 2 + (t < LC ? 1 : 0)) * 6144;
    float4 v;
    if (from_input) {
      v = t < LC ? ((const float4*)(p.ctx + (size_t)t * 1024))[tid] : ((const float4*)(p.x + (size_t)(t - LC) * 1024))[tid];
      ((float4*)(p.xall + (size_t)t * 1024))[tid] = v;
    } else v = ((const float4*)(p.xall + (size_t)t * 1024))[tid];
    float ss = wave_sum(v.x * v.x + v.y * v.y + v.z * v.z + v.w * v.w);
    __syncthreads();
    if ((tid & 63) == 0) smem[tid >> 6] = ss;
    __syncthreads();
    float tot = smem[0] + smem[1] + smem[2] + smem[3];
    float rinv = rsqrtf(tot * (1.f / 1024.f) + EPS);
    float4 gg = ((const float4*)g)[tid];
    float4 sc = ((const float4*)(mod + sc_off))[tid];
    float4 sh = ((const float4*)(mod + sh_off))[tid];
    float4 o;
    o.x = v.x * rinv * gg.x * (1.f + sc.x) + sh.x;
    o.y = v.y * rinv * gg.y * (1.f + sc.y) + sh.y;
    o.z = v.z * rinv * gg.z * (1.f + sc.z) + sh.z;
    o.w = v.w * rinv * gg.w * (1.f + sc.w) + sh.w;
    ((uint2*)(p.hb + (size_t)t * 1024))[tid] = make_uint2(pack2bf(o.x, o.y), pack2bf(o.z, o.w));
  }
}

__device__ __forceinline__ void prep_transpose(const float* W, bf16_t* Wt, int K, int N, int item0, int nitems_total, float* smem) {
  (void)nitems_total;
  float(*ts)[65] = (float(*)[65])smem;
  const int tid = tid_opaque();
  const int tn = N / 64, nt = (K / 64) * tn;
  for (int it = blockIdx.x; it < nt; it += gridDim.x) {
    int k0 = (it / tn) * 64, n0 = (it % tn) * 64;
    __syncthreads();
#pragma unroll
    for (int i = 0; i < 16; ++i) {
      int r = (tid >> 6) + i * 4, c = tid & 63;
      ts[r][c] = W[(size_t)(k0 + r) * N + n0 + c];
    }
    __syncthreads();
#pragma unroll
    for (int i = 0; i < 16; ++i) {
      int r = (tid >> 6) + i * 4, c = tid & 63;
      Wt[(size_t)(n0 + r) * K + k0 + c] = f2bf(ts[c][r]);
    }
  }
  (void)item0;
}

__device__ __forceinline__ void ph_prep(const P& p, float* smem) {
  for (int l = 0; l < 2; ++l) {
    prep_transpose(p.w_in + (size_t)l * 1024 * DIN, p.w_in_t + (size_t)l * 1024 * DIN, 1024, DIN, 0, 0, smem);
    prep_transpose(p.w_out + (size_t)l * 1024 * 1024, p.w_out_t + (size_t)l * 1024 * 1024, 1024, 1024, 0, 0, smem);
    prep_transpose(p.wq + (size_t)l * 1024 * NPQ, p.wq_t + (size_t)l * 1024 * NPQ, 1024, NPQ, 0, 0, smem);
  }
}

struct EpiStoreF32 {
  float* C; int ldc;
  __device__ __forceinline__ void operator()(const P& p, f32x4 (&acc)[4][4], int m0, int n0, int wm, int wn, int lane, char* smem) const {
    const int mw0 = m0 + wm * 64, nw0 = n0 + wn * 64;
#pragma unroll
    for (int i = 0; i < 4; ++i)
#pragma unroll
      for (int r = 0; r < 4; ++r) {
        int row = mw0 + 16 * i + (lane >> 4) * 4 + r;
#pragma unroll
        for (int j = 0; j < 4; ++j) C[(size_t)row * ldc + nw0 + 16 * j + (lane & 15)] = acc[i][j][r];
      }
  }
};
struct EpiProjSplit {
  __device__ __forceinline__ void operator()(const P& p, f32x4 (&acc)[4][4], int m0, int n0, int wm, int wn, int lane, char* smem) const {
    const int mw0 = m0 + wm * 64, nw0 = n0 + wn * 64;
#pragma unroll
    for (int i = 0; i < 4; ++i)
#pragma unroll
      for (int r = 0; r < 4; ++r) {
        int row = mw0 + 16 * i + (lane >> 4) * 4 + r;
#pragma unroll
        for (int j = 0; j < 4; ++j) {
          int col = nw0 + 16 * j + (lane & 15);
          if (n0 < 512) p.proj[(size_t)row * 512 + col] = acc[i][j][r];
          else p.projb[(size_t)row * DIN + col] = f2bf(acc[i][j][r]);
        }
      }
  }
};
__device__ __forceinline__ void ph_rope_tab(const P& p) {
  for (int idx = GTID; idx < 320 * 16; idx += GSZ) {
    int v = idx >> 4, j = idx & 15;
    float inv = __expf(-(float)j * (1.f / 16.f) * 9.210340371976184f);
    float ang = (float)(v < 256 ? v : v - 256) * inv;
    float k = rintf(ang * 0.15915494309189535f);
    float r = fmaf(-k, 6.2831854820251465f, ang);
    r = fmaf(-k, -1.7484555e-07f, r);
    ((float2*)p.ropetab)[idx] = make_float2(__cosf(r), __sinf(r));
  }
}

template <int CTRL>
__device__ __forceinline__ float dpp_row(float v) {
  return __int_as_float(__builtin_amdgcn_update_dpp(0, __float_as_int(v), CTRL, 0xf, 0xf, false));
}
struct EpiBias {
  float* dst; int N;
  __device__ __forceinline__ void operator()(const P& p, f32x4 (&acc)[4][4], int m0, int n0, int wm, int wn, int lane, char* smem) const {
    if (wm == 0 && (lane >> 4) == 0) {
      const int col = n0 + wn * 64 + (lane & 15);
#pragma unroll
      for (int j = 0; j < 4; ++j) { dst[col + 16 * j] = acc[0][j][0]; dst[N + col + 16 * j] = acc[0][j][1]; }
    }
  }
};
struct EpiProj {
  int l;
  __device__ __forceinline__ void operator()(const P& p, f32x4 (&acc)[4][4], int m0, int n0, int wm, int wn, int lane, char* smem) const {
    const int g = lane >> 4, lr = lane & 15;
    const int mw0 = m0 + wm * 64, nw0 = n0 + wn * 64;
    if (l == 1) {
      float* rinvl = (float*)smem;
      const int tid = ((wm * 2 + wn) << 6) | lane;
      if (tid < 128) {
        float s = 0.f;
#pragma unroll
        for (int q = 0; q < 8; ++q) s += p.rowss[(size_t)q * TT + m0 + tid];
        rinvl[tid] = rsqrtf(s * (1.f / 1024.f) + EPS);
      }
      __syncthreads();
      const float* bb = p.bin + (m0 < LC ? 1 : 0) * DIN + nw0 + lr;
      float bv[4];
#pragma unroll
      for (int j = 0; j < 4; ++j) bv[j] = bb[16 * j];
#pragma unroll
      for (int i = 0; i < 4; ++i)
#pragma unroll
        for (int r = 0; r < 4; ++r) {
          const float rv = rinvl[wm * 64 + 16 * i + 4 * g + r];
#pragma unroll
          for (int j = 0; j < 4; ++j) acc[i][j][r] = acc[i][j][r] * rv + bv[j];
        }
    }
    if (n0 < 512) {
#pragma unroll
      for (int i = 0; i < 4; ++i)
#pragma unroll
        for (int r = 0; r < 4; ++r) {
          int row = mw0 + 16 * i + 4 * g + r;
#pragma unroll
          for (int j = 0; j < 4; ++j) p.proj[(size_t)row * 512 + nw0 + 16 * j + lr] = acc[i][j][r];
        }
      return;
    }
    const float* gain = nullptr; bool rope = false; float scale = 1.f;
    if (nw0 < 896) { gain = p.win_qn + l * 64; rope = true; scale = QSCALE; }
    else if (nw0 < 1024) { gain = p.win_kn + l * 64; rope = true; }
    else if (nw0 < 1152) { }
    else if (nw0 < 1536) { gain = p.na_qn + l * 64; scale = QSCALE; }
    else if (nw0 < 1920) { gain = p.na_kn + l * 64; }
    rope = rope && (m0 >= LC);
    float gj[4] = {1.f, 1.f, 1.f, 1.f};
    if (gain) {
#pragma unroll
      for (int j = 0; j < 4; ++j) gj[j] = gain[16 * j + lr] * scale;
    }
#pragma unroll
    for (int i = 0; i < 4; ++i)
#pragma unroll
      for (int r = 0; r < 4; ++r) {
        const int row = mw0 + 16 * i + 4 * g + r;
        float y[4] = {acc[i][0][r], acc[i][1][r], acc[i][2][r], acc[i][3][r]};
        if (gain) {
          float ss = y[0] * y[0] + y[1] * y[1] + y[2] * y[2] + y[3] * y[3];
          ss += dpp_row<0xB1>(ss);
          ss += dpp_row<0x4E>(ss);
          ss += dpp_row<0x141>(ss);
          ss += dpp_row<0x140>(ss);
          const float rinv = rsqrtf(ss * (1.f / 64.f) + EPS);
#pragma unroll
          for (int j = 0; j < 4; ++j) y[j] *= rinv * gj[j];
        }
        if (rope) {
          const int pos = row - LC;
          const float2 tr = ((const float2*)p.ropetab)[(pos >> 6) * 16 + lr];
          const float2 tc = ((const float2*)p.ropetab)[(256 + (pos & 63)) * 16 + lr];
          float a0 = y[0] * tr.x - y[1] * tr.y, a1 = y[0] * tr.y + y[1] * tr.x;
          float a2 = y[2] * tc.x - y[3] * tc.y, a3 = y[2] * tc.y + y[3] * tc.x;
          y[0] = a0; y[1] = a1; y[2] = a2; y[3] = a3;
        }
#pragma unroll
        for (int j = 0; j < 4; ++j) p.projb[(size_t)row * DIN + nw0 + 16 * j + lr] = f2bf(y[j]);
      }
  }
};
struct EpiResid {
  int l;
  __device__ __forceinline__ void operator()(const P& p, f32x4 (&acc)[4][4], int m0, int n0, int wm, int wn, int lane, char* smem) const {
    float* tile = (float*)smem;
    {
      const int g = lane >> 4, lr = lane & 15;
      float* tw = tile + (wm * 64 + 4 * g) * 132 + wn * 64 + lr;
#pragma unroll
      for (int i = 0; i < 4; ++i)
#pragma unroll
        for (int r = 0; r < 4; ++r)
#pragma unroll
          for (int j = 0; j < 4; ++j) tw[(16 * i + r) * 132 + 16 * j] = acc[i][j][r];
    }
    __syncthreads();
    const int tid = ((wm * 2 + wn) << 6) | lane, c8 = tid & 15, rsub = tid >> 4;
    const float* mod = p.mod + (l * 2 + (m0 < LC ? 1 : 0)) * 6144;
    const int col = n0 + 8 * c8;
    float g1v[8], gs[8];
    {
      const float4 a0 = *(const float4*)(mod + 2048 + col), a1 = *(const float4*)(mod + 2048 + col + 4);
      const float4 s0 = *(const float4*)(mod + 4096 + col), s1 = *(const float4*)(mod + 4096 + col + 4);
      const float4 n0v = *(const float4*)(p.norm2_g + l * 1024 + col), n1v = *(const float4*)(p.norm2_g + l * 1024 + col + 4);
      g1v[0] = a0.x; g1v[1] = a0.y; g1v[2] = a0.z; g1v[3] = a0.w; g1v[4] = a1.x; g1v[5] = a1.y; g1v[6] = a1.z; g1v[7] = a1.w;
      gs[0] = n0v.x * (1.f + s0.x); gs[1] = n0v.y * (1.f + s0.y); gs[2] = n0v.z * (1.f + s0.z); gs[3] = n0v.w * (1.f + s0.w);
      gs[4] = n1v.x * (1.f + s1.x); gs[5] = n1v.y * (1.f + s1.y); gs[6] = n1v.z * (1.f + s1.z); gs[7] = n1v.w * (1.f + s1.w);
    }
#pragma unroll
    for (int it = 0; it < 8; ++it) {
      const int rl = it * 16 + rsub, row = m0 + rl;
      float4* xp = (float4*)(p.xall + (size_t)row * 1024 + col);
      float4 x0 = xp[0], x1 = xp[1];
      const float4 t0 = *(const float4*)(tile + rl * 132 + 8 * c8), t1 = *(const float4*)(tile + rl * 132 + 8 * c8 + 4);
      x0.x += g1v[0] * t0.x; x0.y += g1v[1] * t0.y; x0.z += g1v[2] * t0.z; x0.w += g1v[3] * t0.w;
      x1.x += g1v[4] * t1.x; x1.y += g1v[5] * t1.y; x1.z += g1v[6] * t1.z; x1.w += g1v[7] * t1.w;
      xp[0] = x0; xp[1] = x1;
      float ss = x0.x * x0.x + x0.y * x0.y + x0.z * x0.z + x0.w * x0.w + x1.x * x1.x + x1.y * x1.y + x1.z * x1.z + x1.w * x1.w;
      ss += dpp_row<0xB1>(ss);
      ss += dpp_row<0x4E>(ss);
      ss += dpp_row<0x141>(ss);
      ss += dpp_row<0x140>(ss);
      *(uint4*)(p.hb + (size_t)row * 1024 + col) = make_uint4(pack2bf(x0.x * gs[0], x0.y * gs[1]), pack2bf(x0.z * gs[2], x0.w * gs[3]),
                                                            pack2bf(x1.x * gs[4], x1.y * gs[5]), pack2bf(x1.z * gs[6], x1.w * gs[7]));
      if (c8 == 0) p.rowss[(size_t)(n0 >> 7) * TT + row] = ss;
    }
  }
};

template <int CTRL, int RMASK>
__device__ __forceinline__ float dpp_mov_id(float v) {
  return __int_as_float(__builtin_amdgcn_update_dpp(__float_as_int(v), __float_as_int(v), CTRL, RMASK, 0xf, false));
}
__device__ __forceinline__ float wave_max(float v) {
  v = fmaxf(v, dpp_mov_id<0xB1, 0xf>(v));
  v = fmaxf(v, dpp_mov_id<0x4E, 0xf>(v));
  v = fmaxf(v, dpp_mov_id<0x141, 0xf>(v));
  v = fmaxf(v, dpp_mov_id<0x140, 0xf>(v));
  v = fmaxf(v, dpp_mov_id<0x142, 0xa>(v));
  v = fmaxf(v, dpp_mov_id<0x143, 0xc>(v));
  return __int_as_float(__builtin_amdgcn_readlane(__float_as_int(v), 63));
}

typedef __attribute__((ext_vector_type(2))) float f32x2;
__device__ __forceinline__ void peer_convert_rows(const P& p, int l, int r0, int r1) {
  const int tid = tid_opaque(), lane = tid & 63;
  for (int rb = r0 + (tid >> 6); rb < r1; rb += 16) {
    float4 v[4][4];
#pragma unroll
    for (int u = 0; u < 4; ++u) {
      const int r = min(rb + 4 * u, r1 - 1);
      const int tbl = r >> 14, e = r & 16383;
      const float4* src = (const float4*)((tbl ? p.pv : p.pu) + ((size_t)l * 16384 + e) * 1024) + lane * 4;
#pragma unroll
      for (int i = 0; i < 4; ++i) v[u][i] = src[i];
    }
#pragma unroll
    for (int u = 0; u < 4; ++u) {
      const int r = rb + 4 * u;
      if (r < r1) {
        const int tbl = r >> 14, e = r & 16383;
        float am = 0.f;
#pragma unroll
        for (int i = 0; i < 4; ++i)
          am = fmaxf(am, fmaxf(fmaxf(fabsf(v[u][i].x), fabsf(v[u][i].y)), fmaxf(fabsf(v[u][i].z), fabsf(v[u][i].w))));
        am = wave_max(am);
        const float sc = am > 0.f ? 224.f / am : 1.f;
        unsigned w[4];
#pragma unroll
        for (int i = 0; i < 4; ++i) {
          int t = __builtin_amdgcn_cvt_pk_fp8_f32(v[u][i].x * sc, v[u][i].y * sc, 0, false);
          t = __builtin_amdgcn_cvt_pk_fp8_f32(v[u][i].z * sc, v[u][i].w * sc, t, true);
          w[i] = (unsigned)t;
        }
        unsigned char* dst = (tbl ? p.vb8 : p.ub8) + (((size_t)l * 8 + (lane >> 3)) * 16384 + e) * 128 + (lane & 7) * 16;
        *(uint4*)dst = make_uint4(w[0], w[1], w[2], w[3]);
        if (lane == 0) (tbl ? p.vsc : p.usc)[l * 16384 + e] = am > 0.f ? am / 224.f : 1.f;
      }
    }
  }
}
__device__ __forceinline__ int gemm_swz(int row) { return (0x78 >> (((row >> 2) & 3) * 2)) & 3; }
template <class Epi>
__device__ __forceinline__ void gemm_bf16_128(const P& p, const bf16_t* __restrict__ A, const bf16_t* __restrict__ Bt, int K, int m_begin, int m_end,
                              int N, char* smem, const Epi& epi, int cl = -1, int rpt = 0, int boff = 0) {
  const int tid = tid_opaque(), lane = tid & 63, wv = __builtin_amdgcn_readfirstlane(tid >> 6), wm = wv >> 1, wn = wv & 1;
  const int tiles_n = N / 128, tiles_m = (m_end - m_begin) / 128;
  const int nk = K / 32;
  const int lr = lane & 15, g = lane >> 4;
  const int a_rd = (wm * 64 + lr) * 64 + ((g ^ gemm_swz(lr)) << 4);
  const int b_rd = 8192 + (wn * 64 + lr) * 64 + ((g ^ gemm_swz(lr)) << 4);
  const int ld_row = lane >> 2, ld_c = (lane & 3) ^ gemm_swz(ld_row);
  for (int tile = ((int)blockIdx.x + (int)gridDim.x - boff) % (int)gridDim.x; tile < tiles_m * tiles_n; tile += gridDim.x) {
    const int m0 = m_begin + (tile / tiles_n) * 128, n0 = (tile % tiles_n) * 128;
    f32x4 acc[4][4];
#pragma unroll
    for (int i = 0; i < 4; ++i)
#pragma unroll
      for (int j = 0; j < 4; ++j) acc[i][j] = (f32x4){0.f, 0.f, 0.f, 0.f};
    const bf16_t* Ag = A + (size_t)(m0 + wv * 32 + ld_row) * K + ld_c * 8;
    const bf16_t* Bg = Bt + (size_t)(n0 + wv * 32 + ld_row) * K + ld_c * 8;
    auto issue = [&](int st, int kt) {
      char* base = smem + st * 16384 + wv * 2048;
#pragma unroll
      for (int i = 0; i < 2; ++i) {
        __builtin_amdgcn_global_load_lds((const unsigned*)(Ag + (size_t)i * 16 * K + kt * 32), (__attribute__((address_space(3))) unsigned*)(base + i * 1024), 16, 0, 0);
        __builtin_amdgcn_global_load_lds((const unsigned*)(Bg + (size_t)i * 16 * K + kt * 32), (__attribute__((address_space(3))) unsigned*)(base + 8192 + i * 1024), 16, 0, 0);
      }
    };
    issue(0, 0); issue(1, 1); issue(2, 2);
    for (int kt0 = 0; kt0 < nk; kt0 += 4) {
#pragma unroll
      for (int u = 0; u < 4; ++u) {
        const int kt = kt0 + u, rem = nk - kt;
        if (rem >= 3) asm volatile("s_waitcnt vmcnt(8) lgkmcnt(0)" ::: "memory");
        else if (rem == 2) asm volatile("s_waitcnt vmcnt(4) lgkmcnt(0)" ::: "memory");
        else asm volatile("s_waitcnt vmcnt(0) lgkmcnt(0)" ::: "memory");
        __builtin_amdgcn_s_barrier();
        if (kt + 3 < nk) issue((u + 3) & 3, kt + 3);
        bf16x8 af[4], bfr[4];
#pragma unroll
        for (int i = 0; i < 4; ++i) af[i] = *(const bf16x8*)(smem + u * 16384 + a_rd + i * 1024);
#pragma unroll
        for (int j = 0; j < 4; ++j) bfr[j] = *(const bf16x8*)(smem + u * 16384 + b_rd + j * 1024);
#pragma unroll
        for (int i = 0; i < 4; ++i)
#pragma unroll
          for (int j = 0; j < 4; ++j) acc[i][j] = __builtin_amdgcn_mfma_f32_16x16x32_bf16(af[i], bfr[j], acc[i][j], 0, 0, 0);
      }
    }
    __syncthreads();
    epi(p, acc, m0, n0, wm, wn, lane, smem);
    if (cl >= 0) peer_convert_rows(p, cl, min(tile * rpt, 32768), min((tile + 1) * rpt, 32768));
    __syncthreads();
  }
}

constexpr int NCHUNK = TT / 64;
__device__ __forceinline__ int lru_pos(int dir, int c) { return dir == 0 ? c : (c < 4 ? 3 - c : 4 + (NCHUNK - 1 - c)); }

__device__ __forceinline__ void ph_lru_prepw(const P& p) {
  for (int idx = GTID; idx < 2 * 2 * 4 * 2 * 4096; idx += GSZ) {
    int d = idx & 63, e = (idx >> 6) & 63, mtx = (idx >> 12) & 1, rest = idx >> 13;
    const float* w = (mtx ? p.wx : p.wa) + (size_t)rest * 4096;
    p.lruw_t[idx] = f2bf(w[d * 64 + e]);
  }
}

template <int PASS>
__device__ __forceinline__ void lru_item(const P& p, int l, int cidx, int kb, char* smem) {
  bf16_t* u_img = (bf16_t*)smem;
  const int tid = tid_opaque(), lane = tid & 63, wv = tid >> 6, g = lane >> 4, lr = lane & 15;
  const int t0 = cidx * 64;
  const int lo = t0 < LC ? 0 : LC, hi = t0 < LC ? LC : TT;
  const int chw = 16 * wv + lr, cw = kb * 64 + chw;
  __syncthreads();
  bf16x8 wfa[2][2], wfx[2][2];
  float bav2[2], bxv2[2], lam2[2], cin[2] = {0.f, 0.f};
#pragma unroll
  for (int dir = 0; dir < 2; ++dir) {
    const int pd = l * 2 + dir;
    const bf16_t* wbase = p.lruw_t + (size_t)((pd * 4 + kb) * 2) * 4096 + chw * 64 + 8 * g;
#pragma unroll
    for (int s = 0; s < 2; ++s) { wfa[dir][s] = *(const bf16x8*)(wbase + 32 * s); wfx[dir][s] = *(const bf16x8*)(wbase + 4096 + 32 * s); }
    bav2[dir] = p.ba[pd * 256 + cw]; bxv2[dir] = p.bx[pd * 256 + cw]; lam2[dir] = p.lam[pd * 256 + cw];
    if (PASS == 2) cin[dir] = p.lcarry[((size_t)dir * NCHUNK + lru_pos(dir, cidx)) * 256 + cw];
  }
  float gav[4][4];
  if (PASS == 2) {
#pragma unroll
    for (int i = 0; i < 4; ++i)
#pragma unroll
      for (int r = 0; r < 4; ++r) gav[i][r] = p.proj[(size_t)(t0 + 16 * i + 4 * g + r) * 512 + OFF_GA + cw];
  }
  {
    const int ch = tid & 63, c = kb * 64 + ch, sg = tid >> 6;
    const float cb = p.conv_b[l * 256 + c];
    float cw4[4];
#pragma unroll
    for (int k = 0; k < 4; ++k) cw4[k] = p.conv_w[(l * 4 + k) * 256 + c];
    float xr[19];
#pragma unroll
    for (int i = 0; i < 19; ++i) {
      int tt = t0 + sg * 16 + i - 2;
      int tc = tt < lo ? lo : (tt >= hi ? hi - 1 : tt);
      float v = p.proj[(size_t)tc * 512 + OFF_XA + c];
      xr[i] = (tt >= lo && tt < hi) ? v : 0.f;
    }
#pragma unroll
    for (int i = 0; i < 16; ++i) {
      int row = sg * 16 + i;
      float acc = cb + cw4[0] * xr[i] + cw4[1] * xr[i + 1] + cw4[2] * xr[i + 2] + cw4[3] * xr[i + 3];
      u_img[row * 64 + ((((ch >> 3) ^ (row & 7)) << 3) | (ch & 7))] = f2bf(acc);
    }
  }
  __syncthreads();
  float hs0[4][4];
#pragma unroll
  for (int dir = 0; dir < 2; ++dir) {
    f32x4 ga[4], gx[4];
#pragma unroll
    for (int i = 0; i < 4; ++i) { ga[i] = (f32x4){0.f, 0.f, 0.f, 0.f}; gx[i] = (f32x4){0.f, 0.f, 0.f, 0.f}; }
#pragma unroll
    for (int s = 0; s < 2; ++s) {
      const bf16x8 ba_ = dir == 0 ? wfa[0][s] : wfa[1][s];
      const bf16x8 bx_ = dir == 0 ? wfx[0][s] : wfx[1][s];
#pragma unroll
      for (int i = 0; i < 4; ++i) {
        int row = 16 * i + lr;
        bf16x8 af = *(const bf16x8*)((const char*)u_img + row * 128 + (((4 * s + g) ^ (row & 7)) << 4));
        ga[i] = __builtin_amdgcn_mfma_f32_16x16x32_bf16(af, ba_, ga[i], 0, 0, 0);
        gx[i] = __builtin_amdgcn_mfma_f32_16x16x32_bf16(af, bx_, gx[i], 0, 0, 0);
      }
    }
    const float bav = dir == 0 ? bav2[0] : bav2[1], bxv = dir == 0 ? bxv2[0] : bxv2[1];
    const float sp = log1pf(expf(-(dir == 0 ? lam2[0] : lam2[1])));
    float av[4][4], bv[4][4];
#pragma unroll
    for (int i = 0; i < 4; ++i)
#pragma unroll
      for (int r = 0; r < 4; ++r) {
        const int row = 16 * i + 4 * g + r;
        float rr = sigmoid_f(ga[i][r] + bav), ig = sigmoid_f(gx[i][r] + bxv);
        float log_a = -8.f * rr * sp;
        float a = __expf(log_a);
        float uu = bf2f(u_img[row * 64 + ((((chw >> 3) ^ (row & 7)) << 3) | (chw & 7))]);
        const float x2 = 2.f * log_a;
        const float ser = -x2 * (1.f + x2 * (0.5f + x2 * (0.16666667f + x2 * (0.041666668f + x2 * 0.0083333338f))));
        const float om = x2 > -0.25f ? ser : 1.f - a * a;
        av[i][r] = a;
        bv[i][r] = sqrtf(om) * ig * uu;
      }
    float As[4], Bs[4];
#pragma unroll
    for (int i = 0; i < 4; ++i) {
      float A = 1.f, B = 0.f;
#pragma unroll
      for (int rr = 0; rr < 4; ++rr) { const int r = dir == 0 ? rr : 3 - rr; B = av[i][r] * B + bv[i][r]; A *= av[i][r]; }
      As[i] = A; Bs[i] = B;
    }
    const int lg = dir == 0 ? g : 3 - g;
    const int src1 = dir == 0 ? lane - 16 : lane + 16, src2 = dir == 0 ? lane - 32 : lane + 32;
    float Ai[4], Bi[4];
#pragma unroll
    for (int i = 0; i < 4; ++i) {
      float A = As[i], B = Bs[i];
      { float Ap = __shfl(A, src1 & 63), Bp = __shfl(B, src1 & 63); if (lg >= 1) { B = A * Bp + B; A = Ap * A; } }
      { float Ap = __shfl(A, src2 & 63), Bp = __shfl(B, src2 & 63); if (lg >= 2) { B = A * Bp + B; A = Ap * A; } }
      Ai[i] = A; Bi[i] = B;
    }
    const int lastl = (dir == 0 ? 48 : 0) + lr;
    float Ae[4], Be[4], At[4], Bt[4];
#pragma unroll
    for (int i = 0; i < 4; ++i) {
      float Ap = __shfl(Ai[i], src1 & 63), Bp = __shfl(Bi[i], src1 & 63);
      Ae[i] = lg >= 1 ? Ap : 1.f; Be[i] = lg >= 1 ? Bp : 0.f;
      At[i] = __shfl(Ai[i], lastl); Bt[i] = __shfl(Bi[i], lastl);
    }
    if (PASS == 1) {
      float A = 1.f, B = 0.f;
#pragma unroll
      for (int ii = 0; ii < 4; ++ii) { const int i = dir == 0 ? ii : 3 - ii; B = At[i] * B + Bt[i]; A *= At[i]; }
      if (g == 0) {
        float2* ag = (float2*)p.lagg + ((size_t)dir * NCHUNK + lru_pos(dir, cidx)) * 256 + cw;
        *ag = make_float2(A, B);
      }
    } else {
      float R = dir == 0 ? cin[0] : cin[1];
#pragma unroll
      for (int ii = 0; ii < 4; ++ii) {
        const int i = dir == 0 ? ii : 3 - ii;
        float h = Ae[i] * R + Be[i];
#pragma unroll
        for (int rr = 0; rr < 4; ++rr) {
          const int r = dir == 0 ? rr : 3 - rr;
          h = av[i][r] * h + bv[i][r];
          if (dir == 0) hs0[i][r] = h;
          else p.mixb[(size_t)(t0 + 16 * i + 4 * g + r) * 1024 + cw] = f2bf((hs0[i][r] + h) * gelu_f(gav[i][r]));
        }
        R = At[i] * R + Bt[i];
      }
    }
  }
}

__device__ __forceinline__ void ph_lru_carry(const P& p, float* smem) {
  const int tid = tid_opaque(), seg = tid >> 4, c16 = tid & 15;
  for (int blk = blockIdx.x; blk < 32; blk += gridDim.x) {
    const int dc = blk * 16 + c16, dir = dc >> 8, ch = dc & 255;
    const float2* ag = (const float2*)p.lagg + (size_t)dir * NCHUNK * 256 + ch;
    float2 v[17];
#pragma unroll
    for (int i = 0; i < 17; ++i) {
      int pos = seg * 17 + i;
      v[i] = pos < NCHUNK ? ag[(size_t)pos * 256] : make_float2(1.f, 0.f);
    }
    float A = 1.f, B = 0.f;
#pragma unroll
    for (int i = 0; i < 17; ++i) { B = v[i].x * B + v[i].y; A *= v[i].x; }
    __syncthreads();
    smem[(seg * 16 + c16) * 2] = A; smem[(seg * 16 + c16) * 2 + 1] = B;
    __syncthreads();
    float h = 0.f;
    for (int s2 = 0; s2 < seg; ++s2) h = smem[(s2 * 16 + c16) * 2] * h + smem[(s2 * 16 + c16) * 2 + 1];
    float* cr = p.lcarry + (size_t)dir * NCHUNK * 256 + ch;
#pragma unroll
    for (int i = 0; i < 17; ++i) {
      int pos = seg * 17 + i;
      if (pos < NCHUNK) cr[(size_t)pos * 256] = h;
      h = v[i].x * h + v[i].y;
    }
  }
}

template <int PASS>
__device__ __forceinline__ void ph_lru(const P& p, int l, char* smem) {
  const int c_begin = (PASS == 2 && l == 1) ? 4 : 0;
  const int nitems = (NCHUNK - c_begin) * 4;
  for (int it = blockIdx.x; it < nitems; it += gridDim.x) lru_item<PASS>(p, l, c_begin + (it >> 2), it & 3, smem);
}

typedef __attribute__((ext_vector_type(4))) short s16x4;
typedef __attribute__((ext_vector_type(4))) unsigned u32x4;

__device__ __forceinline__ void ph_qknorm_rope2(const P& p, int l) {
  const int tid_ = tid_opaque();
  const int lane = tid_ & 63;
  const int wpb = blockDim.x >> 6;
  for (int pair = blockIdx.x * wpb + (tid_ >> 6); pair < TT * 28; pair += gridDim.x * wpb) {
    int t = pair / 28, slot = pair % 28;
    const float* g = nullptr; bool rope = false; float scale = 1.f;
    if (slot < 6) { g = p.win_qn + l * 64; rope = true; scale = QSCALE; }
    else if (slot < 8) { g = p.win_kn + l * 64; rope = true; }
    else if (slot < 10) { }
    else if (slot < 16) { g = p.na_qn + l * 64; scale = QSCALE; }
    else if (slot < 22) { g = p.na_kn + l * 64; }
    rope = rope && (t >= LC);
    const size_t idx = (size_t)t * DIN + 512 + slot * 64 + lane;
    float v = bf2f(p.projb[idx]);
    float y = v;
    if (g) {
      float ss = wave_sum(v * v);
      y = v * rsqrtf(ss * (1.f / 64.f) + EPS) * g[lane];
    }
    float partner = __shfl_xor(y, 16);
    if (rope) {
      int pos = t - LC, row = pos >> 6, col = pos & 63;
      int j = lane & 15, axis = lane >> 5;
      float inv = __expf(-(float)j * (1.f / 16.f) * 9.210340371976184f);
      float ang = (float)(axis ? col : row) * inv;
      float k = rintf(ang * 0.15915494309189535f);
      float r = fmaf(-k, 6.2831854820251465f, ang);
      r = fmaf(-k, -1.7484555e-07f, r);
      float cs = __cosf(r), sn = __sinf(r);
      bool first = ((lane >> 4) & 1) == 0;
      y = first ? (y * cs - partner * sn) : (partner * sn + y * cs);
    }
    p.projb[idx] = f2bf(y * scale);
  }
}

template <class TokFn>
__device__ __forceinline__ void kv_issue(const P& p, char* stage, int koff, int voff, TokFn tok, int wv, int lane) {
#pragma unroll
  for (int i = 0; i < 2; ++i) {
    const int row = 16 * wv + 8 * i + (lane >> 3);
    const bf16_t* src = p.projb + (size_t)tok(row) * DIN + (((lane & 7) ^ (row & 7)) << 3);
    char* dst = stage + (2 * wv + i) * 1024;
    __builtin_amdgcn_global_load_lds((const unsigned*)(src + koff), (__attribute__((address_space(3))) unsigned*)dst, 16, 0, 0);
    __builtin_amdgcn_global_load_lds((const unsigned*)(src + voff), (__attribute__((address_space(3))) unsigned*)(dst + 8192), 16, 0, 0);
  }
}
__device__ __forceinline__ void kv_wait(int rem) {
  if (rem >= 3) asm volatile("s_waitcnt vmcnt(8) lgkmcnt(0)" ::: "memory");
  else if (rem == 2) asm volatile("s_waitcnt vmcnt(4) lgkmcnt(0)" ::: "memory");
  else asm volatile("s_waitcnt vmcnt(0) lgkmcnt(0)" ::: "memory");
  __builtin_amdgcn_s_barrier();
}

template <class MaskFn>
__device__ __forceinline__ void attn_step2(const char* stage, int kr0, const bf16x8 (&qf)[2][2], f32x4 (&o)[2][4], float (&lsum)[2], MaskFn mb,
                                           int lane, bool act0, bool act1) {
  const int g = lane >> 4, lr = lane & 15;
  bf16x8 kf[2][2];
#pragma unroll
  for (int t2 = 0; t2 < 2; ++t2) {
    const int row = kr0 + 16 * t2 + lr;
#pragma unroll
    for (int s = 0; s < 2; ++s) kf[t2][s] = *(const bf16x8*)(stage + row * 128 + (((4 * s + g) ^ (row & 7)) << 4));
  }
  bf16x8 pb[2];
#pragma unroll
  for (int qt = 0; qt < 2; ++qt) {
    if (qt == 0 ? act0 : act1) {
      f32x4 st[2];
#pragma unroll
      for (int t2 = 0; t2 < 2; ++t2) {
        st[t2] = (f32x4){0.f, 0.f, 0.f, 0.f};
#pragma unroll
        for (int s = 0; s < 2; ++s) st[t2] = __builtin_amdgcn_mfma_f32_16x16x32_bf16(kf[t2][s], qf[qt][s], st[t2], 0, 0, 0);
      }
#pragma unroll
      for (int t2 = 0; t2 < 2; ++t2) {
        float pv[4];
#pragma unroll
        for (int r = 0; r < 4; ++r) { pv[r] = __builtin_amdgcn_exp2f(mb(qt, t2, r, st[t2][r])); lsum[qt] += pv[r]; }
        const unsigned w0 = pack2bf(pv[0], pv[1]), w1 = pack2bf(pv[2], pv[3]);
        pb[qt][t2 * 4 + 0] = (short)(w0 & 0xffffu); pb[qt][t2 * 4 + 1] = (short)(w0 >> 16);
        pb[qt][t2 * 4 + 2] = (short)(w1 & 0xffffu); pb[qt][t2 * 4 + 3] = (short)(w1 >> 16);
      }
    }
  }
  const int q = lr >> 2, pp = lane & 3;
#pragma unroll
  for (int m = 0; m < 4; ++m) {
    bf16x8 vf;
#pragma unroll
    for (int t = 0; t < 2; ++t) {
      const int row = kr0 + 16 * t + 4 * g + q;
      const char* addr = stage + 8192 + row * 128 + (((2 * m + (pp >> 1)) ^ (row & 7)) << 4) + 8 * (pp & 1);
      s16x4 v4 = __builtin_amdgcn_ds_read_tr16_b64_v4i16((__attribute__((address_space(3))) s16x4*)addr);
      vf[4 * t + 0] = v4[0]; vf[4 * t + 1] = v4[1]; vf[4 * t + 2] = v4[2]; vf[4 * t + 3] = v4[3];
    }
    if (act0) o[0][m] = __builtin_amdgcn_mfma_f32_16x16x32_bf16(vf, pb[0], o[0][m], 0, 0, 0);
    if (act1) o[1][m] = __builtin_amdgcn_mfma_f32_16x16x32_bf16(vf, pb[1], o[1][m], 0, 0, 0);
  }
}

__device__ __forceinline__ void attn_store_out(const P& p, const f32x4 (&o)[4], float lsum, int tok, int col0, int lane) {
  const int g = lane >> 4;
  lsum += __shfl_xor(lsum, 16);
  lsum += __shfl_xor(lsum, 32);
  const float inv = 1.f / lsum;
  bf16_t* op = p.mixb + (size_t)tok * 1024 + col0 + 4 * g;
#pragma unroll
  for (int m = 0; m < 4; ++m)
    *(uint2*)(op + 16 * m) = make_uint2(pack2bf(o[m][0] * inv, o[m][1] * inv), pack2bf(o[m][2] * inv, o[m][3] * inv));
}

__device__ __forceinline__ void attn_win_item(const P& p, int l, int kind, int qb, int hs, char* smem) {
  const int tid = tid_opaque(), lane = tid & 63, wv = __builtin_amdgcn_readfirstlane(tid >> 6), g = lane >> 4, lr = lane & 15;
  int qoff, koff, voff, ooff; const float *gq, *gk; float sink2 = -1e30f; bool has_sink = false;
  if (kind == 0 || hs < 6) {
    const int h = hs, kvh = h / 3;
    qoff = OFF_QW + h * 64; koff = OFF_KW + kvh * 64; voff = OFF_VW + kvh * 64; ooff = 256 + h * 64;
    gq = p.win_qn + l * 64; gk = p.win_kn + l * 64; sink2 = p.win_sink[l * 6 + h] * LOG2E; has_sink = true;
  } else {
    const int h = hs - 6;
    qoff = OFF_QN + h * 64; koff = OFF_KN + h * 64; voff = OFF_VN + h * 64; ooff = 640 + h * 64;
    gq = p.na_qn + l * 64; gk = p.na_kn + l * 64;
  }
  float bound = 8.f * LOG2E * wave_max(fabsf(gq[lane])) * wave_max(fabsf(gk[lane])) * 1.0001f + 1e-3f;
  if (has_sink) bound = fmaxf(bound, sink2);
  const int q0 = qb * 128;
  const int qtok0 = (kind == 0 ? LC : 0) + q0 + 32 * wv;
  bf16x8 qf[2][2];
#pragma unroll
  for (int qt = 0; qt < 2; ++qt)
#pragma unroll
    for (int s = 0; s < 2; ++s) qf[qt][s] = *(const bf16x8*)(p.projb + (size_t)(qtok0 + 16 * qt + lr) * DIN + qoff + 32 * s + 8 * g);
  f32x4 o[2][4];
#pragma unroll
  for (int qt = 0; qt < 2; ++qt)
#pragma unroll
    for (int m = 0; m < 4; ++m) o[qt][m] = (f32x4){0.f, 0.f, 0.f, 0.f};
  float lsum[2] = {0.f, 0.f};
  const int nloc = (kind == 0) ? 6 : 0, nch = nloc + 4;
  auto tokfn = [&](int c) {
    return [=](int row) {
      if (c < nloc) { int pos = q0 - 128 + 64 * c + row; pos = pos < 0 ? 0 : (pos > SEQ - 1 ? SEQ - 1 : pos); return LC + pos; }
      return 64 * (c - nloc) + row;
    };
  };
  __syncthreads();
  kv_issue(p, smem, koff, voff, tokfn(0), wv, lane);
  kv_issue(p, smem + 16384, koff, voff, tokfn(1), wv, lane);
  kv_issue(p, smem + 32768, koff, voff, tokfn(2), wv, lane);
  for (int c = 0; c < nch; ++c) {
    kv_wait(nch - c);
    if (c + 3 < nch) kv_issue(p, smem + ((c + 3) & 3) * 16384, koff, voff, tokfn(c + 3), wv, lane);
    const char* stage = smem + (c & 3) * 16384;
    if (c < nloc) {
      const int qw0 = q0 + 32 * wv;
#pragma unroll
      for (int st = 0; st < 2; ++st) {
        const int kbase = q0 - 128 + 64 * c + 32 * st;
        const bool a0 = !(kbase - (qw0 + 15) > 128 || qw0 - (kbase + 31) > 128) && (kbase + 31 >= 0) && (kbase < SEQ);
        const bool a1 = !(kbase - (qw0 + 31) > 128 || (qw0 + 16) - (kbase + 31) > 128) && (kbase + 31 >= 0) && (kbase < SEQ);
        const bool allv = (kbase >= 0) && (kbase + 31 < SEQ) && (kbase + 31 - qw0 <= 128) && (qw0 + 31 - kbase <= 128);
        if (allv)
          attn_step2(stage, 32 * st, qf, o, lsum, [&](int qt, int t2, int r, float s) { return s - bound; }, lane, true, true);
        else if (a0 || a1)
          attn_step2(stage, 32 * st, qf, o, lsum, [&](int qt, int t2, int r, float s) {
            int kpos = kbase + 16 * t2 + 4 * g + r;
            int dlt = kpos - (qw0 + 16 * qt + lr); dlt = dlt < 0 ? -dlt : dlt;
            bool valid = (kpos >= 0) && (kpos < SEQ) && (dlt <= 128);
            return valid ? s - bound : -1e30f;
          }, lane, a0, a1);
      }
    } else {
#pragma unroll
      for (int st = 0; st < 2; ++st)
        attn_step2(stage, 32 * st, qf, o, lsum, [&](int qt, int t2, int r, float s) { return s - bound; }, lane, true, true);
    }
  }
#pragma unroll
  for (int qt = 0; qt < 2; ++qt) {
    float ls = lsum[qt];
    if (has_sink && g == 0) ls += __builtin_amdgcn_exp2f(sink2 - bound);
    attn_store_out(p, o[qt], ls, qtok0 + 16 * qt + lr, ooff, lane);
  }
}

__device__ __forceinline__ void attn_na_item(const P& p, int l, int rp, int h, char* smem) {
  const int tid = tid_opaque(), lane = tid & 63, wv = __builtin_amdgcn_readfirstlane(tid >> 6), g = lane >> 4, lr = lane & 15;
  const int qoff = OFF_QN + h * 64, koff = OFF_KN + h * 64, voff = OFF_VN + h * 64, ooff = 640 + h * 64;
  float* rpbl = (float*)(smem + 65536);
  const float* rpbg = p.rpb + (size_t)(l * 6 + h) * 465;
  float bmax = 0.f;
  __syncthreads();
  for (int i = tid; i < 465; i += 256) rpbl[i] = rpbg[i] * LOG2E;
  for (int i = lane; i < 465; i += 64) bmax = fmaxf(bmax, fabsf(rpbg[i]) * LOG2E);
  bmax = wave_max(bmax);
  const float bound = 8.f * LOG2E * wave_max(fabsf(p.na_qn[l * 64 + lane])) * wave_max(fabsf(p.na_kn[l * 64 + lane])) * 1.0001f + bmax + 1e-3f;
  const int r0 = 2 * rp;
  const int qcol = 16 * wv + lr;
  const int qtok0 = LC + r0 * 64 + qcol;
  const int kra = min(max(r0 - 4, 0), 248), krb = min(max(r0 + 1 - 4, 0), 248);
  const int nrow = krb + 8 - kra, nch = nrow + 4;
  const int kc0 = min(max(16 * wv - 8, 0), 32);
  const int qs = min(max(qcol - 8, 0), 48);
  bf16x8 qf[2][2];
#pragma unroll
  for (int qt = 0; qt < 2; ++qt)
#pragma unroll
    for (int s = 0; s < 2; ++s) qf[qt][s] = *(const bf16x8*)(p.projb + (size_t)(qtok0 + 64 * qt) * DIN + qoff + 32 * s + 8 * g);
  f32x4 o[2][4];
#pragma unroll
  for (int qt = 0; qt < 2; ++qt)
#pragma unroll
    for (int m = 0; m < 4; ++m) o[qt][m] = (f32x4){0.f, 0.f, 0.f, 0.f};
  float lsum[2] = {0.f, 0.f};
  auto tokfn = [&](int c) {
    return [=](int row) { return c < nrow ? LC + (kra + c) * 64 + row : 64 * (c - nrow) + row; };
  };
  kv_issue(p, smem, koff, voff, tokfn(0), wv, lane);
  kv_issue(p, smem + 16384, koff, voff, tokfn(1), wv, lane);
  kv_issue(p, smem + 32768, koff, voff, tokfn(2), wv, lane);
  for (int c = 0; c < nch; ++c) {
    kv_wait(nch - c);
    if (c + 3 < nch) kv_issue(p, smem + ((c + 3) & 3) * 16384, koff, voff, tokfn(c + 3), wv, lane);
    const char* stage = smem + (c & 3) * 16384;
    if (c < nrow) {
      const int krow = kra + c;
      const bool a0 = krow < kra + 8, a1 = krow >= krb;
      attn_step2(stage, kc0, qf, o, lsum, [&](int qt, int t2, int rr, float s) {
        int kcol = kc0 + 16 * t2 + 4 * g + rr;
        bool valid = (kcol >= qs) && (kcol < qs + 16);
        int dc = kcol - qcol + 15; dc = dc < 0 ? 0 : (dc > 30 ? 30 : dc);
        int dr = krow - (r0 + qt) + 7; dr = dr < 0 ? 0 : (dr > 14 ? 14 : dr);
        return valid ? s + rpbl[dr * 31 + dc] - bound : -1e30f;
      }, lane, a0, a1);
    } else {
#pragma unroll
      for (int st = 0; st < 2; ++st)
        attn_step2(stage, 32 * st, qf, o, lsum, [&](int qt, int t2, int rr, float s) { return s - bound; }, lane, true, true);
    }
  }
#pragma unroll
  for (int qt = 0; qt < 2; ++qt) attn_store_out(p, o[qt], lsum[qt], qtok0 + 64 * qt, ooff, lane);
}

__device__ __forceinline__ void ph_attn(const P& p, int l, char* smem) {
  const int nitems = 1536 + (l == 0 ? 24 : 0);
  for (int it = blockIdx.x; it < nitems; it += gridDim.x) {
    if (it < 768) attn_win_item(p, l, 0, it / 6, it % 6, smem);
    else if (it < 1536) { int j = it - 768; attn_na_item(p, l, j / 6, j % 6, smem); }
    else { int j = it - 1536; attn_win_item(p, l, 1, j / 12, j % 12, smem); }
  }
}

__device__ __forceinline__ unsigned ord_key(float s) {
  unsigned u = __float_as_uint(s);
  return (u & 0x80000000u) ? ~u : (u | 0x80000000u);
}
__device__ __forceinline__ float ord_val(unsigned pk) {
  unsigned u = pk & ~127u;
  unsigned b = (u & 0x80000000u) ? (u & 0x7fffffffu) : ~u;
  return __uint_as_float(b);
}
__device__ __forceinline__ void ce_desc(unsigned& a, unsigned& b) {
  unsigned mx = a > b ? a : b, mn = a > b ? b : a;
  a = mx; b = mn;
}
__device__ __forceinline__ void sort16_desc(unsigned (&v)[16]) {
#pragma unroll
  for (int k = 2; k <= 16; k <<= 1) {
#pragma unroll
    for (int j = k >> 1; j > 0; j >>= 1) {
#pragma unroll
      for (int i = 0; i < 16; ++i) {
        int m = i ^ j;
        if (m > i) {
          if ((i & k) == 0) ce_desc(v[i], v[m]); else ce_desc(v[m], v[i]);
        }
      }
    }
  }
}
__device__ __forceinline__ void merge16_desc(unsigned (&a)[16], const unsigned (&b)[16]) {
#pragma unroll
  for (int i = 0; i < 16; ++i) { unsigned o = b[15 - i]; a[i] = a[i] > o ? a[i] : o; }
#pragma unroll
  for (int j = 8; j > 0; j >>= 1) {
#pragma unroll
    for (int i = 0; i < 16; ++i) {
      int m = i ^ j;
      if (m > i) ce_desc(a[i], a[m]);
    }
  }
}

typedef __attribute__((ext_vector_type(2))) float f32x2;
__device__ __forceinline__ void peer_convert_tail(const P& p, int l, int ntiles) {
  const int G = gridDim.x, extra = ntiles % G;
  const int first = (extra == 0) ? 0 : extra, np = G - first;
  const int idx = (int)blockIdx.x - first;
  if (idx < 0) return;
  const int q = (32768 + np - 1) / np;
  const int r0 = idx * q, r1 = min(r0 + q, 32768);
  peer_convert_rows(p, l, r0, r1);
}
__device__ __forceinline__ void ph_prep_small(const P& p) {
  for (int i = GTID; i < 2 * 128 * 128; i += GSZ) { p.k1b[i] = f2bf(p.k1[i]); p.k2b[i] = f2bf(p.k2[i]); }
}

struct EpiPeerTopk {
  int l;
  __device__ __forceinline__ void operator()(const P& p, f32x4 (&acc)[4][4], int m0, int n0, int wm, int wn, int lane, char* smem) const {
    const int tid = ((wm * 2 + wn) << 6) | lane, g = lane >> 4, lr = lane & 15;
    const int nt = n0 >> 7, head = nt >> 1, hf = nt & 1;
    char* qimg = smem;
    char* kimg = smem + 34816;
    float* rinvl = (float*)(smem + 69632);
    if (tid < 128) {
      float s = 0.f;
#pragma unroll
      for (int q = 0; q < 8; ++q) s += p.rowss[(size_t)q * TT + m0 + tid];
      rinvl[tid] = rsqrtf(s * (1.f / 1024.f) + EPS);
    }
    __syncthreads();
    {
      const float* bq = p.bq + (l * 2 + (m0 < LC ? 1 : 0)) * NPQ + n0 + wn * 64 + lr;
      float bqv[4];
#pragma unroll
      for (int j = 0; j < 4; ++j) bqv[j] = bq[16 * j];
      char* qw = qimg + (wm * 64 + 4 * g) * 272 + (wn * 64 + lr) * 2;
#pragma unroll
      for (int i = 0; i < 4; ++i)
#pragma unroll
        for (int r = 0; r < 4; ++r) {
          const float rv = rinvl[wm * 64 + 16 * i + 4 * g + r];
#pragma unroll
          for (int j = 0; j < 4; ++j) *(bf16_t*)(qw + (16 * i + r) * 272 + 32 * j) = f2bf(acc[i][j][r] * rv + bqv[j]);
        }
      const bf16_t* kk = (hf ? p.k2b : p.k1b) + (size_t)l * 16384 + (tid >> 4) * 128 + (tid & 15) * 8;
      char* kw = kimg + (tid >> 4) * 272 + (tid & 15) * 16;
#pragma unroll
      for (int i = 0; i < 8; ++i) *(uint4*)(kw + i * 16 * 272) = *(const uint4*)(kk + i * 16 * 128);
    }
    __syncthreads();
#pragma unroll
    for (int i = 0; i < 4; ++i)
#pragma unroll
      for (int j = 0; j < 4; ++j) acc[i][j] = (f32x4){0.f, 0.f, 0.f, 0.f};
    {
      const char* qa = qimg + (wm * 64 + lr) * 272 + g * 16;
      const char* kb = kimg + (wn * 64 + lr) * 272 + g * 16;
#pragma unroll
      for (int s = 0; s < 4; ++s) {
        bf16x8 af[4], bfr[4];
#pragma unroll
        for (int i = 0; i < 4; ++i) af[i] = *(const bf16x8*)(qa + i * 16 * 272 + s * 64);
#pragma unroll
        for (int j = 0; j < 4; ++j) bfr[j] = *(const bf16x8*)(kb + j * 16 * 272 + s * 64);
#pragma unroll
        for (int i = 0; i < 4; ++i)
#pragma unroll
          for (int j = 0; j < 4; ++j) acc[i][j] = __builtin_amdgcn_mfma_f32_16x16x32_bf16(af[i], bfr[j], acc[i][j], 0, 0, 0);
      }
    }
    __syncthreads();
    unsigned* simg = (unsigned*)smem;
    {
      unsigned* sw = simg + (wm * 64 + 4 * g) * 129 + wn * 64 + lr;
#pragma unroll
      for (int i = 0; i < 4; ++i)
#pragma unroll
        for (int r = 0; r < 4; ++r)
#pragma unroll
          for (int j = 0; j < 4; ++j)
            sw[(16 * i + r) * 129 + 16 * j] = (ord_key(acc[i][j][r]) & ~127u) | (unsigned)(wn * 64 + 16 * j + lr);
    }
    __syncthreads();
    const int row = tid & 127, half = tid >> 7;
    unsigned top[16];
    {
      const unsigned* sr = simg + row * 129 + half * 64;
#pragma unroll
      for (int k = 0; k < 16; ++k) top[k] = sr[k];
      sort16_desc(top);
#pragma unroll 1
      for (int gi = 1; gi < 4; ++gi) {
        unsigned v1[16];
#pragma unroll
        for (int k = 0; k < 16; ++k) v1[k] = sr[gi * 16 + k];
        sort16_desc(v1);
        merge16_desc(top, v1);
      }
    }
    __syncthreads();
    if (half == 1) {
#pragma unroll
      for (int k = 0; k < 16; ++k) simg[k * 128 + row] = top[k];
    }
    __syncthreads();
    if (half == 0) {
      unsigned o[16];
#pragma unroll
      for (int k = 0; k < 16; ++k) o[k] = simg[k * 128 + row];
      merge16_desc(top, o);
      uint4* dst = (uint4*)(p.pk + (((size_t)(m0 + row) * 8 + head) * 2 + hf) * 16);
#pragma unroll
      for (int k = 0; k < 4; ++k) dst[k] = make_uint4(top[4 * k], top[4 * k + 1], top[4 * k + 2], top[4 * k + 3]);
    }
  }
};

__device__ const unsigned char CAND_A[64] = {0,0,0,0,0,0,0,0,0,0,0,0,0,0,0,0, 1,1,1,1,1,1,1,1, 2,2,2,2,2, 3,3,3,3, 4,4,4, 5,5, 6,6, 7,7,
                                             8,9,10,11,12,13,14,15, 0,0,0,0,0,0,0,0,0,0,0,0,0,0};
__device__ const unsigned char CAND_B[64] = {0,1,2,3,4,5,6,7,8,9,10,11,12,13,14,15, 0,1,2,3,4,5,6,7, 0,1,2,3,4, 0,1,2,3, 0,1,2, 0,1, 0,1, 0,1,
                                             0,0,0,0,0,0,0,0, 0,0,0,0,0,0,0,0,0,0,0,0,0,0};

__device__ __forceinline__ void ph_peer_merge(const P& p, int l, int t0, char* smem) {
  const int tid = tid_opaque(), lane = tid & 63, wv = tid >> 6;
  const float* n2g = p.norm2_g + l * 1024;
  const int ca = CAND_A[lane], cb = CAND_B[lane];
  for (int tk = t0 + blockIdx.x * 4 + wv; tk < TT; tk += gridDim.x * 4) {
    const float* mod = p.mod + (l * 2 + (tk < LC ? 1 : 0)) * 6144;
    unsigned p1[8], p2[8];
    {
      const unsigned* pk = p.pk + (size_t)tk * 256;
#pragma unroll
      for (int head = 0; head < 8; ++head) { p1[head] = pk[head * 32 + ca]; p2[head] = pk[head * 32 + 16 + cb]; }
    }
    {
      const float4* xp = (const float4*)(p.xall + (size_t)tk * 1024) + lane * 4;
      float4 v[4];
      float ss = 0.f;
#pragma unroll
      for (int q = 0; q < 4; ++q) { v[q] = xp[q]; ss += v[q].x * v[q].x + v[q].y * v[q].y + v[q].z * v[q].z + v[q].w * v[q].w; }
      ss = wave_sum(ss);
      const float rinv = rsqrtf(ss * (1.f / 1024.f) + EPS);
      uint2* hp = (uint2*)(p.hb + (size_t)tk * 1024) + lane * 4;
#pragma unroll
      for (int q = 0; q < 4; ++q) {
        float4 gg = ((const float4*)n2g)[lane * 4 + q], sc = ((const float4*)(mod + 4096))[lane * 4 + q], sh = ((const float4*)(mod + 3072))[lane * 4 + q];
        float h0 = v[q].x * rinv * gg.x * (1.f + sc.x) + sh.x, h1 = v[q].y * rinv * gg.y * (1.f + sc.y) + sh.y;
        float h2 = v[q].z * rinv * gg.z * (1.f + sc.z) + sh.z, h3 = v[q].w * rinv * gg.w * (1.f + sc.w) + sh.w;
        hp[q] = make_uint2(pack2bf(h0, h1), pack2bf(h2, h3));
      }
    }
    float sums[8];
    unsigned* candk = (unsigned*)smem + wv * 512;
#pragma unroll
    for (int head = 0; head < 8; ++head) {
      sums[head] = lane < 50 ? ord_val(p1[head]) + ord_val(p2[head]) : -3.0e38f;
      candk[head * 64 + lane] = (ord_key(sums[head]) & ~63u) | (unsigned)(63 - lane);
    }
#pragma unroll
    for (int head = 0; head < 8; ++head) {
      const float sum = sums[head];
      const unsigned kme = (ord_key(sum) & ~63u) | (unsigned)(63 - lane);
      int eid = (int)(p1[head] & 127u) * 128 + (int)(p2[head] & 127u);
      int rank = 0;
#pragma unroll
      for (int m4 = 0; m4 < 13; ++m4) {
        const uint4 km = *(const uint4*)(candk + head * 64 + 4 * m4);
        rank += (km.x > kme) ? 1 : 0;
        rank += (km.y > kme) ? 1 : 0;
        rank += (km.z > kme) ? 1 : 0;
        rank += (km.w > kme) ? 1 : 0;
      }
      float mx = wave_max(sum);
      bool sel = (lane < 50) && (rank < 16);
      float e = sel ? __expf(sum - mx) : 0.f;
      float tot = wave_sum(e);
      if (sel) {
        const int n = head * 16 + rank, idx = (n & 7) * 16 + (n >> 3);
        p.el[(size_t)tk * 128 + idx] = eid;
        p.gl[(size_t)tk * 128 + idx] = e / tot;
      }
    }
  }
}

__device__ __forceinline__ uint4 bload(__amdgpu_buffer_rsrc_t rs, int voff) {
  const u32x4 v = __builtin_amdgcn_raw_buffer_load_b128(rs, voff, 0, 0);
  return make_uint4(v.x, v.y, v.z, v.w);
}
struct XcdWork { int li, np, rank, nloc; };

__device__ __forceinline__ XcdWork load_xw(const float* smem) {
  const volatile LAS unsigned* st = (const volatile LAS unsigned*)(smem + 18432);
  XcdWork xw;
  xw.nloc = __builtin_amdgcn_readfirstlane((int)st[0]); xw.np = __builtin_amdgcn_readfirstlane((int)st[1]);
  xw.rank = __builtin_amdgcn_readfirstlane((int)st[2]); xw.li = __builtin_amdgcn_readfirstlane((int)st[3]);
  return xw;
}
__device__ __forceinline__ void ph_peer_s1(const P& p, int l, int t0, const XcdWork& xw) {
  const int tid = tid_opaque(), lane = tid & 63, wv = tid >> 6, j = lane >> 3, k = lane & 7;
  const unsigned char* U = p.ub8 + (size_t)l * 16384 * 1024;
  const int step = xw.nloc * 4;
  for (int s = xw.li; s < 8; s += xw.np) {
    const unsigned roff = 128u * s + 16u * k;
    const __amdgpu_buffer_rsrc_t urs = __builtin_amdgcn_make_buffer_rsrc((void*)(U + (size_t)s * 16384 * 128), (short)0, 16384 * 128, 0x00020000);
    const int tk0 = t0 + xw.rank * 4 + wv;
    if (tk0 >= TT) continue;
    uint4 ur[2][16]; uint4 hh[2][2]; int4 en[4];
#define S1_LOAD_LIST(TK) { const int4* ep = (const int4*)(p.el + (size_t)(TK) * 128 + j * 16); _Pragma("unroll") for (int q = 0; q < 4; ++q) en[q] = ep[q]; }
#define S1_ISSUE(B, TK) {                                                                            \
      _Pragma("unroll") for (int q = 0; q < 4; ++q) {                                                \
        ur[B][4 * q + 0] = bload(urs, en[q].x * 128 + 16 * k);                  \
        ur[B][4 * q + 1] = bload(urs, en[q].y * 128 + 16 * k);                  \
        ur[B][4 * q + 2] = bload(urs, en[q].z * 128 + 16 * k);                  \
        ur[B][4 * q + 3] = bload(urs, en[q].w * 128 + 16 * k);                  \
      }                                                                                              \
      const uint4* hp = (const uint4*)(p.hb + (size_t)(TK) * 1024 + roff);                           \
      hh[B][0] = hp[0]; hh[B][1] = hp[1]; }
#define S1_CONSUME(B, TK) {                                                                          \
      float hv[16];                                                                                  \
      { unsigned w[8] = {hh[B][0].x, hh[B][0].y, hh[B][0].z, hh[B][0].w, hh[B][1].x, hh[B][1].y, hh[B][1].z, hh[B][1].w}; \
        _Pragma("unroll") for (int q = 0; q < 8; ++q) { hv[2 * q] = __uint_as_float(w[q] << 16); hv[2 * q + 1] = __uint_as_float(w[q] & 0xffff0000u); } } \
      float keep0 = 0.f, keep1 = 0.f;                                                                \
      _Pragma("unroll") for (int i = 0; i < 16; ++i) {                                               \
        unsigned w[4] = {ur[B][i].x, ur[B][i].y, ur[B][i].z, ur[B][i].w};                            \
        float dot = 0.f;                                                                             \
        _Pragma("unroll") for (int q = 0; q < 4; ++q) {                                              \
          f32x2 lo = __builtin_amdgcn_cvt_pk_f32_fp8((int)w[q], false), hi = __builtin_amdgcn_cvt_pk_f32_fp8((int)w[q], true); \
          dot += lo[0] * hv[q * 4] + lo[1] * hv[q * 4 + 1] + hi[0] * hv[q * 4 + 2] + hi[1] * hv[q * 4 + 3]; \
        }                                                                                            \
        dot += dpp_row<0xB1>(dot); dot += dpp_row<0x4E>(dot); dot += dpp_row<0x141>(dot);            \
        if (i < 8) keep0 = (k == i) ? dot : keep0; else keep1 = (k == i - 8) ? dot : keep1;          \
      }                                                                                              \
      float* pd = p.pd + ((size_t)s * TT + (TK)) * 128;                                              \
      pd[8 * k + j] = keep0; pd[8 * (k + 8) + j] = keep1; }
    S1_LOAD_LIST(tk0)
    S1_ISSUE(0, tk0)
    if (tk0 + step < TT) S1_LOAD_LIST(tk0 + step)
    for (int tk = tk0; tk < TT; tk += 2 * step) {
      const bool has1 = tk + step < TT, has2 = tk + 2 * step < TT;
      if (has1) { S1_ISSUE(1, tk + step) if (has2) S1_LOAD_LIST(tk + 2 * step) }
      S1_CONSUME(0, tk)
      if (has1) {
        if (has2) { S1_ISSUE(0, tk + 2 * step) if (tk + 3 * step < TT) S1_LOAD_LIST(tk + 3 * step) }
        S1_CONSUME(1, tk + step)
      }
    }
#undef S1_LOAD_LIST
#undef S1_ISSUE
#undef S1_CONSUME
  }
}

__device__ __forceinline__ void ph_peer_r(const P& p, int l, int t0) {
  const float* usc = p.usc + l * 16384;
  const float* vsc = p.vsc + l * 16384;
  for (int idx = GTID; idx < (TT - t0) * 32; idx += GSZ) {
    const int tk = t0 + (idx >> 5), n0 = (idx & 31) * 4;
    float4 d = make_float4(0.f, 0.f, 0.f, 0.f);
#pragma unroll
    for (int s = 0; s < 8; ++s) {
      const float4 v = *(const float4*)(p.pd + ((size_t)s * TT + tk) * 128 + n0);
      d.x += v.x; d.y += v.y; d.z += v.z; d.w += v.w;
    }
    float dv[4] = {d.x, d.y, d.z, d.w};
#pragma unroll
    for (int q = 0; q < 4; ++q) {
      const int n = n0 + q, li = (n & 7) * 16 + (n >> 3);
      const int ex = p.el[(size_t)tk * 128 + li];
      p.av[(size_t)tk * 128 + li] = p.gl[(size_t)tk * 128 + li] * gelu_f(dv[q] * usc[ex]) * vsc[ex];
    }
  }
}

__device__ __forceinline__ void ph_peer_s2(const P& p, int l, int t0, const XcdWork& xw, char* smem) {
  const int tid = tid_opaque(), lane = tid & 63, wv = tid >> 6, j = lane >> 3, k = lane & 7;
  const int ko = lane >> 3, jo = lane & 7;
  float* red = (float*)smem + wv * 1408;
  int* elb = (int*)(red + 1024);
  float* avb = red + 1024 + 256;
  const unsigned char* V = p.vb8 + (size_t)l * 16384 * 1024;
  const int step = xw.nloc * 4;
  for (int s = xw.li; s < 8; s += xw.np) {
    const __amdgpu_buffer_rsrc_t vrs = __builtin_amdgcn_make_buffer_rsrc((void*)(V + (size_t)s * 16384 * 128), (short)0, 16384 * 128, 0x00020000);
    const int dim = 128 * s + 16 * ko + 2 * jo;
    int tk = t0 + xw.rank * 4 + wv;
    if (tk >= TT) continue;
    *(int2*)(elb + 2 * lane) = *(const int2*)(p.el + (size_t)tk * 128 + 2 * lane);
    int par = 0;
    for (; tk < TT; tk += step, par ^= 1) {
      uint4 vr[16];
      {
        const int4* eb = (const int4*)(elb + par * 128 + j * 16);
#pragma unroll
        for (int q = 0; q < 4; ++q) {
          const int4 e4 = eb[q];
          vr[4 * q + 0] = bload(vrs, e4.x * 128 + 16 * k);
          vr[4 * q + 1] = bload(vrs, e4.y * 128 + 16 * k);
          vr[4 * q + 2] = bload(vrs, e4.z * 128 + 16 * k);
          vr[4 * q + 3] = bload(vrs, e4.w * 128 + 16 * k);
        }
      }
      const float2 a2 = *(const float2*)(p.av + (size_t)tk * 128 + 2 * lane);
      const float* mod = p.mod + (l * 2 + (tk < LC ? 1 : 0)) * 6144;
      const float2 g2 = *(const float2*)(mod + 5120 + dim);
      const float2 xin = *(const float2*)(p.xall + (size_t)tk * 1024 + dim);
      if (tk + step < TT) {
        const int2 e2 = *(const int2*)(p.el + (size_t)(tk + step) * 128 + 2 * lane);
        *(int2*)(elb + (par ^ 1) * 128 + 2 * lane) = e2;
      }
      *(float2*)(avb + 2 * lane) = a2;
      float acc[16];
#pragma unroll
      for (int d = 0; d < 16; ++d) acc[d] = 0.f;
#pragma unroll
      for (int i4 = 0; i4 < 4; ++i4) {
        const float4 aq = *(const float4*)(avb + j * 16 + 4 * i4);
        const float av4[4] = {aq.x, aq.y, aq.z, aq.w};
#pragma unroll
        for (int ii = 0; ii < 4; ++ii) {
          const int i = 4 * i4 + ii;
          const float a = av4[ii];
          unsigned y[4] = {vr[i].x, vr[i].y, vr[i].z, vr[i].w};
#pragma unroll
          for (int q = 0; q < 4; ++q) {
            f32x2 lo = __builtin_amdgcn_cvt_pk_f32_fp8((int)y[q], false), hi = __builtin_amdgcn_cvt_pk_f32_fp8((int)y[q], true);
            acc[q * 4] += a * lo[0]; acc[q * 4 + 1] += a * lo[1]; acc[q * 4 + 2] += a * hi[0]; acc[q * 4 + 3] += a * hi[1];
          }
          if (i + 1 < 16) asm volatile("" : "+v"(acc[0]), "+v"(vr[i + 1].x), "+v"(vr[i + 1].y), "+v"(vr[i + 1].z), "+v"(vr[i + 1].w));
        }
      }
#pragma unroll
      for (int q = 0; q < 4; ++q) *(float4*)(red + lane * 16 + 4 * q) = make_float4(acc[4 * q], acc[4 * q + 1], acc[4 * q + 2], acc[4 * q + 3]);
      float f0 = 0.f, f1 = 0.f;
#pragma unroll
      for (int jj = 0; jj < 8; ++jj) {
        const float2 t = *(const float2*)(red + (jj * 8 + ko) * 16 + 2 * jo);
        f0 += t.x; f1 += t.y;
      }
      float2 o = make_float2(xin.x + g2.x * f0, xin.y + g2.y * f1);
      if (l == 1) *(float2*)(p.out + (size_t)(tk - LC) * 1024 + dim) = o;
      else {
        *(float2*)(p.xall + (size_t)tk * 1024 + dim) = o;
        const float* mod1 = p.mod + (2 + (tk < LC ? 1 : 0)) * 6144;
        const float2 n1 = *(const float2*)(p.norm1_g + 1024 + dim), s1 = *(const float2*)(mod1 + 1024 + dim);
        *(unsigned*)(p.hb + (size_t)tk * 1024 + dim) = pack2bf(o.x * n1.x * (1.f + s1.x), o.y * n1.y * (1.f + s1.y));
        const float ssq = wave_sum(o.x * o.x + o.y * o.y);
        if (lane == 0) p.rowss[(size_t)s * TT + tk] = ssq;
      }
    }
  }
}

#define XB_TMO      128
#define XB_XCNT(j)  (256  + 64 * (j))
#define XB_XSUB(j)  (1280 + 64 * (j))
#define XB_XGEN(j)  (2304 + 64 * (j))
#define XB_TOP      3328
#define XB_TOPGEN   3392
#define XB_RANK(j)  (3456 + 64 * (j))
#define XCD_BAR_WORDS 4480
#define XB_SPIN_CAP (1u << 22)
__device__ __forceinline__ unsigned xb_ld(unsigned* q) { return __hip_atomic_load(q, __ATOMIC_RELAXED, __HIP_MEMORY_SCOPE_AGENT); }
__device__ __forceinline__ unsigned xb_add(unsigned* q, unsigned v) { return __hip_atomic_fetch_add(q, v, __ATOMIC_RELAXED, __HIP_MEMORY_SCOPE_AGENT); }
__device__ __forceinline__ unsigned xb_xcc_id() { return (unsigned)__builtin_amdgcn_s_getreg((3 << 11) | 20) & 0xFu; }
#define XB_SPIN(cond, bar) do { unsigned _sp = 0; while (cond) { __builtin_amdgcn_s_sleep(1); \
    if ((++_sp & 255u) == 0u) { if (xb_ld(&(bar)[XB_TMO])) break; if (_sp > XB_SPIN_CAP) { atomicAdd(&(bar)[XB_TMO], 1u); break; } } } } while (0)
struct XcdBarrier { unsigned* bar; unsigned x; volatile LAS unsigned* st; };
__device__ __forceinline__ XcdBarrier xcd_barrier_post(unsigned* bar, volatile LAS unsigned* st) {
  XcdBarrier b; b.bar = bar; b.x = xb_xcc_id(); b.st = st;
  if (threadIdx.x == 0) { (void)xb_add(&bar[XB_XCNT(b.x)], 1u); st[2] = xb_add(&bar[XB_RANK(b.x)], 1u); }
  return b;
}
__device__ __forceinline__ void xcd_barrier_complete(unsigned* bar, unsigned x, unsigned& nloc, unsigned& nx, unsigned& li) {
  const unsigned G = gridDim.x * gridDim.y * gridDim.z;
  unsigned sum, cnt, mine, below, sp = 0u;
  for (;;) {
    sum = 0u; cnt = 0u; mine = 0u; below = 0u;
#pragma unroll
    for (unsigned j = 0; j < 16; ++j) { const unsigned c = xb_ld(&bar[XB_XCNT(j)]); sum += c; cnt += (c > 0u) ? 1u : 0u; mine = (j == x) ? c : mine; below += (j < x && c > 0u) ? 1u : 0u; }
    if (sum == G) break;
    __builtin_amdgcn_s_sleep(1);
    if ((++sp & 255u) == 0u) { if (xb_ld(&bar[XB_TMO])) break; if (sp > XB_SPIN_CAP) { atomicAdd(&bar[XB_TMO], 1u); break; } }
  }
  nloc = mine > 0u ? mine : 1u; nx = cnt > 0u ? cnt : 1u; li = below;
}
__device__ __forceinline__ void xcd_barrier(const XcdBarrier& b) {
  asm volatile("s_waitcnt vmcnt(0)" ::: "memory");
  __syncthreads();
  if (threadIdx.x == 0) {
    unsigned* bar = b.bar;
    __builtin_amdgcn_s_waitcnt(0);
    unsigned nloc = b.st[0], nx = b.st[1];
    if (nloc == 0u) { unsigned li; xcd_barrier_complete(bar, b.x, nloc, nx, li); b.st[0] = nloc; b.st[1] = nx; b.st[3] = li; }
    const unsigned old = xb_add(&bar[XB_XSUB(b.x)], 1u);
    const unsigned gen = old / nloc;
    if (old + 1u == (gen + 1u) * nloc) {
      __builtin_amdgcn_fence(__ATOMIC_RELEASE, "agent");
      asm volatile("s_waitcnt vmcnt(0)" ::: "memory");
      const unsigned og = xb_add(&bar[XB_TOP], 1u);
      const unsigned tg = og / nx;
      if (og + 1u == (tg + 1u) * nx) xb_add(&bar[XB_TOPGEN], 1u);
      else XB_SPIN(xb_ld(&bar[XB_TOPGEN]) == tg, bar);
      __builtin_amdgcn_fence(__ATOMIC_ACQUIRE, "agent");
      xb_add(&bar[XB_XGEN(b.x)], 1u);
      asm volatile("s_waitcnt vmcnt(0)" ::: "memory");
    } else {
      XB_SPIN(xb_ld(&bar[XB_XGEN(b.x)]) == gen, bar);
      __builtin_amdgcn_fence(__ATOMIC_ACQUIRE, "agent");
      asm volatile("s_waitcnt vmcnt(0)" ::: "memory");
    }
  }
  __syncthreads();
}

#ifndef PROBE_IV
#define PROBE_IV -1
#endif
__device__ __forceinline__ void probe_tick(int& cnt, unsigned long long* slots) {
  if (PROBE_IV >= 0) {
    if (threadIdx.x == 0 && (cnt == PROBE_IV || cnt == PROBE_IV + 1)) slots[cnt - PROBE_IV] = __builtin_amdgcn_s_memrealtime();
    cnt = __builtin_amdgcn_readfirstlane(cnt + 1);
  }
}
#define BARRIER() do { XcdBarrier xb_; xb_.bar = PP.bar; xb_.x = xb_xcc_id(); xb_.st = (volatile LAS unsigned*)(smem + 18432); xcd_barrier(xb_); probe_tick(pcnt, probe_t); } while (0)

typedef const __attribute__((address_space(4))) P* KP;
__device__ __forceinline__ P load_params(KP kp) {
#if defined(__HIP_DEVICE_COMPILE__)
  asm volatile("" : "+s"(kp));
  return *kp;
#else
  return P{};
#endif
}
#define PP load_params(kp)
__global__ void __launch_bounds__(256, 2) k_mega(P p_unused) {
  KP kp = (KP)__builtin_amdgcn_kernarg_segment_ptr();
  __shared__ __attribute__((aligned(16))) float smem[18432 + 8];
  uint4& xb_words = *(uint4*)(smem + 18432);
  cg::grid_group grid = cg::this_grid();
  if (threadIdx.x == 0) xb_words = make_uint4(0u, 0u, 0u, 0u);
  __syncthreads();
  unsigned long long* probe_t = (unsigned long long*)(smem + 18436);
  int pcnt = 0;
  asm volatile("" : "+s"(pcnt));
  probe_tick(pcnt, probe_t);
  ph_mod(PP, smem);
  ph_prep(PP, smem);
  ph_lru_prepw(PP);
  ph_rope_tab(PP);
  ph_prep_small(PP);
  grid.sync();
  probe_tick(pcnt, probe_t);
  (void)xcd_barrier_post(PP.bar, (volatile LAS unsigned*)&xb_words);
  ph_norm_mod(PP, 0, 0, 0, smem, true);
  ph_shb(PP);
  BARRIER();
#pragma unroll 1
  for (int l = 0; l < 2; ++l) {
    const int t0 = (l == 0) ? 0 : LC;
    { const P lp = PP; gemm_bf16_128(lp, lp.hb, lp.w_in_t + (size_t)l * 1024 * DIN, 1024, 0, TT, DIN, (char*)smem, EpiProj{l}, l == 0 ? 0 : -1, 15); }
    if (l == 0) {
      const P lp = PP;
      const int b0 = (130 * 18) % (int)gridDim.x;
      gemm_bf16_128(lp, lp.shb, lp.wq_t, 1024, 0, 128, NPQ, (char*)smem, EpiBias{lp.bq, NPQ}, -1, 0, b0);
      gemm_bf16_128(lp, lp.shb + 128 * 1024, lp.wq_t + (size_t)1024 * NPQ, 1024, 0, 128, NPQ, (char*)smem, EpiBias{lp.bq + 2 * NPQ, NPQ}, -1, 0, (b0 + 16) % (int)gridDim.x);
      gemm_bf16_128(lp, lp.shb + 2 * 128 * 1024, lp.w_in_t + (size_t)1024 * DIN, 1024, 0, 128, DIN, (char*)smem, EpiBias{lp.bin, DIN}, -1, 0, (b0 + 32) % (int)gridDim.x);
    }
    BARRIER();
    ph_lru<1>(PP, l, (char*)smem);
    ph_attn(PP, l, (char*)smem);
    BARRIER();
    ph_lru_carry(PP, smem);
    BARRIER();
    ph_lru<2>(PP, l, (char*)smem);
    BARRIER();
    { const P lp = PP; gemm_bf16_128(lp, lp.mixb, lp.w_out_t + (size_t)l * 1024 * 1024, 1024, t0, TT, 1024, (char*)smem, EpiResid{l}, l == 0 ? 1 : -1, 32); }
    BARRIER();
    { const P lp = PP; gemm_bf16_128(lp, lp.hb, lp.wq_t + (size_t)l * 1024 * NPQ, 1024, t0, TT, NPQ, (char*)smem, EpiPeerTopk{l}); }
    BARRIER();
    ph_peer_merge(PP, l, t0, (char*)smem);
    BARRIER();
    ph_peer_s1(PP, l, t0, load_xw(smem));
    BARRIER();
    ph_peer_r(PP, l, t0);
    BARRIER();
    ph_peer_s2(PP, l, t0, load_xw(smem), (char*)smem);
    if (l == 0) BARRIER();
  }
  if (PROBE_IV >= 0) {
    probe_tick(pcnt, probe_t);
    __syncthreads();
    if (blockIdx.x == 0 && threadIdx.x == 0) {
      const unsigned long long dt = (probe_t[1] - probe_t[0]) * 8ull, ts = __builtin_amdgcn_s_memrealtime();
      while (__builtin_amdgcn_s_memrealtime() - ts < dt) __builtin_amdgcn_s_sleep(8);
    }
  }
}

extern "C" void kernel_launch(void* const* d_in, const int* in_sizes, int n_in, void* d_out, int out_size, void* d_ws,
                              size_t ws_size, hipStream_t stream) {
  P p{};
  const float** fp = (const float**)&p;
  for (int i = 0; i < 28; ++i) fp[i] = (const float*)d_in[i];
  p.out = (float*)d_out;
  float* w = (float*)d_ws;
  size_t o = 0;
  auto carve = [&](size_t n) { float* r = w + o; o += (n + 63) & ~(size_t)63; return r; };
  p.bar = (unsigned*)carve(8192);
  p.mod = carve(4 * 6144);
  p.xall = carve((size_t)TT * 1024);
  p.proj = carve((size_t)TT * 512);
  p.projb = (bf16_t*)carve((size_t)TT * DIN / 2);
  p.mixb = (bf16_t*)carve((size_t)TT * 512);
  p.hb = (bf16_t*)carve((size_t)TT * 512);
  p.w_in_t = (bf16_t*)carve((size_t)1024 * DIN);
  p.w_out_t = (bf16_t*)carve((size_t)1024 * 1024);
  p.wq_t = (bf16_t*)carve((size_t)1024 * NPQ);
  p.lruw_t = (bf16_t*)carve((size_t)2 * 2 * 4 * 2 * 4096 / 2);
  p.lagg = carve((size_t)2 * NCHUNK * 256 * 2);
  p.lcarry = carve((size_t)2 * NCHUNK * 256);
  p.ropetab = carve(320 * 16 * 2);
  p.rowss = carve((size_t)8 * TT);
  p.bq = carve(4 * NPQ);
  p.bin = carve(2 * DIN);
  p.shb = (bf16_t*)carve(3 * 128 * 1024 / 2);
  p.el = (int*)carve((size_t)TT * 128);
  p.gl = carve((size_t)TT * 128);
  p.av = carve((size_t)TT * 128);
  p.pd = carve((size_t)8 * TT * 128);
  p.pk = (unsigned*)carve((size_t)TT * 256);
  p.ub8 = (unsigned char*)carve((size_t)2 * 16384 * 1024 / 4);
  p.vb8 = (unsigned char*)carve((size_t)2 * 16384 * 1024 / 4);
  p.usc = carve(2 * 16384);
  p.vsc = carve(2 * 16384);
  p.k1b = (bf16_t*)carve(16384);
  p.k2b = (bf16_t*)carve(16384);
  if (o * 4 > ws_size) { fprintf(stderr, "workspace too small: need %zu have %zu\n", o * 4, ws_size); return; }
  static int grid_blocks = 0;
  if (!grid_blocks) {
    int dev = 0, cus = 0, per_cu = 0;
    (void)hipGetDevice(&dev);
    (void)hipDeviceGetAttribute(&cus, hipDeviceAttributeMultiprocessorCount, dev);
    (void)hipOccupancyMaxActiveBlocksPerMultiprocessor(&per_cu, k_mega, 256, 0);
    if (per_cu > 2) per_cu = 2;
    grid_blocks = cus * per_cu;
  }
  (void)hipMemsetAsync(p.bar, 0, XCD_BAR_WORDS * 4, stream);
  void* args[] = {&p};
  hipError_t e = hipLaunchCooperativeKernel((void*)k_mega, dim3(grid_blocks), dim3(256), args, 0, stream);
  if (e != hipSuccess) fprintf(stderr, "cooperative launch failed: %s (grid %d)\n", hipGetErrorString(e), grid_blocks);
}
```

```cpp
#include <hip/hip_runtime.h>
#include <hip/hip_cooperative_groups.h>
#include <stdint.h>
#include <stdio.h>
namespace cg = cooperative_groups;

#ifndef SINGLE_LAUNCH
#define SINGLE_LAUNCH 1
#endif

constexpr int DM = 1024, SEQ = 16384, LC = 256, TT = SEQ + LC, DIN = 2304, NPQ = 2048;
constexpr int OFF_XA = 0, OFF_GA = 256, OFF_QW = 512, OFF_KW = 896, OFF_VW = 1024, OFF_QN = 1152, OFF_KN = 1536, OFF_VN = 1920;
constexpr float EPS = 1e-6f;
#define LAS __attribute__((address_space(3)))
constexpr float LOG2E = 1.4426950408889634f;
constexpr float QSCALE = 0.125f * LOG2E;

struct P {
  const float *x, *c, *ctx, *c_ctx, *w_mod, *b_mod, *norm1_g, *norm2_g, *w_in, *w_out,
      *conv_w, *conv_b, *wa, *ba, *wx, *bx, *lam, *win_qn, *win_kn, *win_sink, *na_qn, *na_kn, *rpb,
      *wq, *k1, *k2, *pu, *pv;
  float* out;
  float *mod, *xall, *proj;
  unsigned short* projb;
  unsigned* pk;
  unsigned* bar;
  unsigned short *k1b, *k2b;
  unsigned char *ub8, *vb8;
  float *usc, *vsc;
  unsigned short *hb, *mixb, *w_in_t, *w_out_t, *wq_t, *lruw_t;
  float *lagg, *lcarry, *ropetab, *rowss, *bq, *bin, *gl, *av, *pd;
  unsigned short* shb;
  int* el;
};

typedef unsigned short bf16_t;
typedef __attribute__((ext_vector_type(8))) short bf16x8;
typedef __attribute__((ext_vector_type(4))) float f32x4;
__device__ __forceinline__ unsigned pack2bf(float a, float b) {
  unsigned r;
  asm("v_cvt_pk_bf16_f32 %0, %1, %2" : "=v"(r) : "v"(a), "v"(b));
  return r;
}
__device__ __forceinline__ unsigned short f2bf(float f) { return (unsigned short)(pack2bf(f, 0.f) & 0xffffu); }
__device__ __forceinline__ float bf2f(unsigned short h) { return __uint_as_float(((unsigned)h) << 16); }


__device__ __forceinline__ float silu_f(float x) { return x / (1.f + __expf(-x)); }
__device__ __forceinline__ float sigmoid_f(float x) { return 1.f / (1.f + __expf(-x)); }
__device__ __forceinline__ float gelu_f(float x) {
  float u = 0.7978845608028654f * (x + 0.044715f * x * x * x);
  float e = __expf(2.f * u);
  float th = 1.f - 2.f / (e + 1.f);
  return 0.5f * x * (1.f + th);
}
template <int CTRL, int RMASK>
__device__ __forceinline__ float dpp_mov(float v) {
  return __int_as_float(__builtin_amdgcn_update_dpp(0, __float_as_int(v), CTRL, RMASK, 0xf, false));
}
__device__ __forceinline__ float wave_sum(float v) {
  v += dpp_mov<0xB1, 0xf>(v);
  v += dpp_mov<0x4E, 0xf>(v);
  v += dpp_mov<0x141, 0xf>(v);
  v += dpp_mov<0x140, 0xf>(v);
  v += dpp_mov<0x142, 0xa>(v);
  v += dpp_mov<0x143, 0xc>(v);
  return __int_as_float(__builtin_amdgcn_readlane(__float_as_int(v), 63));
}

__device__ __forceinline__ int tid_opaque() { int t = threadIdx.x; asm volatile("" : "+v"(t)); return t; }
#define GTID (blockIdx.x * blockDim.x + tid_opaque())
#define GSZ (gridDim.x * blockDim.x)

__device__ __forceinline__ void ph_mod(const P& p, float* smem) {
  const int tid = tid_opaque(), cl = tid & 31, ks = tid >> 5;
  for (int it = blockIdx.x; it < 2 * 192; it += gridDim.x) {
    const int nc = it % 192, l = it / 192;
    const int n = nc * 32 + cl;
    const float* w = p.w_mod + (size_t)l * 1024 * 6144 + n;
    float a0 = 0.f, a1 = 0.f;
#pragma unroll 8
    for (int i = 0; i < 128; ++i) {
      int k = i * 8 + ks;
      float wv = w[(size_t)k * 6144];
      a0 += silu_f(p.c[k]) * wv;
      a1 += silu_f(p.c_ctx[k]) * wv;
    }
    __syncthreads();
    smem[tid] = a0; smem[256 + tid] = a1;
    __syncthreads();
    if (tid < 64) {
      const int which = tid >> 5;
      float s = p.b_mod[l * 6144 + n];
#pragma unroll
      for (int q = 0; q < 8; ++q) s += smem[which * 256 + q * 32 + cl];
      p.mod[(l * 2 + which) * 6144 + n] = s;
    }
  }
}

__device__ __forceinline__ void ph_bq(const P& p, float* smem) {
  const int tid = tid_opaque(), cl = tid & 31, ks = tid >> 5;
  for (int it = blockIdx.x; it < 2 * 64; it += gridDim.x) {
    const int nc = it % 64, l = it / 64;
    const int n = nc * 32 + cl;
    const float* w = p.wq + (size_t)l * 1024 * NPQ + n;
    const float* v0 = p.mod + (l * 2 + 0) * 6144 + 3072;
    const float* v1 = p.mod + (l * 2 + 1) * 6144 + 3072;
    float a0 = 0.f, a1 = 0.f;
#pragma unroll 8
    for (int i = 0; i < 128; ++i) {
      int k = i * 8 + ks;
      float wv = w[(size_t)k * NPQ];
      a0 += v0[k] * wv;
      a1 += v1[k] * wv;
    }
    __syncthreads();
    smem[tid] = a0; smem[256 + tid] = a1;
    __syncthreads();
    if (tid < 64) {
      const int which = tid >> 5;
      float s = 0.f;
#pragma unroll
      for (int q = 0; q < 8; ++q) s += smem[which * 256 + q * 32 + cl];
      p.bq[(l * 2 + which) * NPQ + n] = s;
    }
  }
}

__device__ __forceinline__ void ph_shb(const P& p) {
  for (int idx = GTID; idx < 3 * 2 * 1024; idx += GSZ) {
    const int k = idx & 1023, which = (idx >> 10) & 1, m = idx >> 11;
    const int l = (m == 0) ? 0 : 1, off = (m == 2) ? 0 : 3072;
    p.shb[((size_t)m * 128 + which) * 1024 + k] = f2bf(p.mod[(l * 2 + which) * 6144 + off + k]);
  }
}

__device__ __forceinline__ void ph_copy_in(const P& p) {
  const float4* xs = (const float4*)p.x;
  const float4* cs = (const float4*)p.ctx;
  float4* d = (float4*)p.xall;
  for (int i = GTID; i < TT * 256; i += GSZ) d[i] = (i < LC * 256) ? cs[i] : xs[i - LC * 256];
}

__device__ __forceinline__ void ph_copy_out(const P& p) {
  const float4* s = (const float4*)(p.xall + (size_t)LC * 1024);
  float4* d = (float4*)p.out;
  for (int i = GTID; i < SEQ * 256; i += GSZ) d[i] = s[i];
}

__device__ __forceinline__ void ph_norm_mod(const P& p, int l, int which_norm, int t0, float* smem, bool from_input = false) {
  const float* g = (which_norm ? p.norm2_g : p.norm1_g) + l * 1024;
  const int sh_off = which_norm ? 3072 : 0, sc_off = which_norm ? 4096 : 1024;
  const int tid = tid_opaque();
  for (int t = t0 + blockIdx.x; t < TT; t += gridDim.x) {
    const float* mod = p.mod + (l * 2 + (t < LC ? 1 : 0)) * 6144;
    float4 v;
    if (from_input) {
      v = t < LC ? ((const float4*)(p.ctx + (size_t)t * 1024))[tid] : ((const float4*)(p.x + (size_t)(t - LC) * 1024))[tid];
    } else v = ((const float4*)(p.xall + (size_t)t * 1024))[tid];
    float ss = wave_sum(v.x * v.x + v.y * v.y + v.z * v.z + v.w * v.w);
    __syncthreads();
    if ((tid & 63) == 0) smem[tid >> 6] = ss;
    __syncthreads();
    float tot = smem[0] + smem[1] + smem[2] + smem[3];
    float rinv = rsqrtf(tot * (1.f / 1024.f) + EPS);
    float4 gg = ((const float4*)g)[tid];
    float4 sc = ((const float4*)(mod + sc_off))[tid];
    float4 sh = ((const float4*)(mod + sh_off))[tid];
    float4 o;
    o.x = v.x * rinv * gg.x * (1.f + sc.x) + sh.x;
    o.y = v.y * rinv * gg.y * (1.f + sc.y) + sh.y;
    o.z = v.z * rinv * gg.z * (1.f + sc.z) + sh.z;
    o.w = v.w * rinv * gg.w * (1.f + sc.w) + sh.w;
    ((uint2*)(p.hb + (size_t)t * 1024))[tid] = make_uint2(pack2bf(o.x, o.y), pack2bf(o.z, o.w));
  }
}

__device__ __forceinline__ void prep_transpose(const float* W, bf16_t* Wt, int K, int N, int item0, int nitems_total, float* smem) {
  (void)nitems_total;
  float(*ts)[65] = (float(*)[65])smem;
  const int tid = tid_opaque();
  const int tn = N / 64, nt = (K / 64) * tn;
  for (int it = blockIdx.x; it < nt; it += gridDim.x) {
    int k0 = (it / tn) * 64, n0 = (it % tn) * 64;
    __syncthreads();
#pragma unroll
    for (int i = 0; i < 16; ++i) {
      int r = (tid >> 6) + i * 4, c = tid & 63;
      ts[r][c] = W[(size_t)(k0 + r) * N + n0 + c];
    }
    __syncthreads();
#pragma unroll
    for (int i = 0; i < 16; ++i) {
      int r = (tid >> 6) + i * 4, c = tid & 63;
      Wt[(size_t)(n0 + r) * K + k0 + c] = f2bf(ts[c][r]);
    }
  }
  (void)item0;
}

__device__ __forceinline__ void ph_prep(const P& p, float* smem) {
  for (int l = 0; l < 2; ++l) {
    prep_transpose(p.w_in + (size_t)l * 1024 * DIN, p.w_in_t + (size_t)l * 1024 * DIN, 1024, DIN, 0, 0, smem);
    prep_transpose(p.w_out + (size_t)l * 1024 * 1024, p.w_out_t + (size_t)l * 1024 * 1024, 1024, 1024, 0, 0, smem);
    prep_transpose(p.wq + (size_t)l * 1024 * NPQ, p.wq_t + (size_t)l * 1024 * NPQ, 1024, NPQ, 0, 0, smem);
  }
}

struct EpiStoreF32 {
  __device__ __forceinline__ float pre(const P&, int, int) const { return 0.f; }
  float* C; int ldc;
  __device__ __forceinline__ void operator()(const P& p, f32x4 (&acc)[4][4], int m0, int n0, int wm, int wn, int lane, char* smem, float epre) const {
    const int mw0 = m0 + wm * 64, nw0 = n0 + wn * 64;
#pragma unroll
    for (int i = 0; i < 4; ++i)
#pragma unroll
      for (int r = 0; r < 4; ++r) {
        int row = mw0 + 16 * i + (lane >> 4) * 4 + r;
#pragma unroll
        for (int j = 0; j < 4; ++j) C[(size_t)row * ldc + nw0 + 16 * j + (lane & 15)] = acc[i][j][r];
      }
  }
};
struct EpiProjSplit {
  __device__ __forceinline__ float pre(const P&, int, int) const { return 0.f; }
  __device__ __forceinline__ void operator()(const P& p, f32x4 (&acc)[4][4], int m0, int n0, int wm, int wn, int lane, char* smem, float epre) const {
    const int mw0 = m0 + wm * 64, nw0 = n0 + wn * 64;
#pragma unroll
    for (int i = 0; i < 4; ++i)
#pragma unroll
      for (int r = 0; r < 4; ++r) {
        int row = mw0 + 16 * i + (lane >> 4) * 4 + r;
#pragma unroll
        for (int j = 0; j < 4; ++j) {
          int col = nw0 + 16 * j + (lane & 15);
          if (n0 < 512) p.proj[(size_t)row * 512 + col] = acc[i][j][r];
          else p.projb[(size_t)row * DIN + col] = f2bf(acc[i][j][r]);
        }
      }
  }
};
__device__ __forceinline__ void ph_rope_tab(const P& p) {
  for (int idx = GTID; idx < 320 * 16; idx += GSZ) {
    int v = idx >> 4, j = idx & 15;
    float inv = __expf(-(float)j * (1.f / 16.f) * 9.210340371976184f);
    float ang = (float)(v < 256 ? v : v - 256) * inv;
    float k = rintf(ang * 0.15915494309189535f);
    float r = fmaf(-k, 6.2831854820251465f, ang);
    r = fmaf(-k, -1.7484555e-07f, r);
    ((float2*)p.ropetab)[idx] = make_float2(__cosf(r), __sinf(r));
  }
}

template <int CTRL>
__device__ __forceinline__ float dpp_row(float v) {
  return __int_as_float(__builtin_amdgcn_update_dpp(0, __float_as_int(v), CTRL, 0xf, 0xf, false));
}
struct EpiBias {
  __device__ __forceinline__ float pre(const P&, int, int) const { return 0.f; }
  float* dst; int N;
  __device__ __forceinline__ void operator()(const P& p, f32x4 (&acc)[4][4], int m0, int n0, int wm, int wn, int lane, char* smem, float epre) const {
    if (wm == 0 && (lane >> 4) == 0) {
      const int col = n0 + wn * 64 + (lane & 15);
#pragma unroll
      for (int j = 0; j < 4; ++j) { dst[col + 16 * j] = acc[0][j][0]; dst[N + col + 16 * j] = acc[0][j][1]; }
    }
  }
};
struct EpiProj {
  int l;
  __device__ __forceinline__ float pre(const P& p, int m0, int tid) const {
    float s = 0.f;
    if (l == 1 && tid < 128) {
#pragma unroll
      for (int q = 0; q < 8; ++q) s += p.rowss[(size_t)q * TT + m0 + tid];
    }
    return s;
  }
  __device__ __forceinline__ void operator()(const P& p, f32x4 (&acc)[4][4], int m0, int n0, int wm, int wn, int lane, char* smem, float epre) const {
    const int g = lane >> 4, lr = lane & 15;
    const int mw0 = m0 + wm * 64, nw0 = n0 + wn * 64;
    if (l == 1) {
      float* rinvl = (float*)smem;
      const int tid = ((wm * 2 + wn) << 6) | lane;
      if (tid < 128) rinvl[tid] = rsqrtf(epre * (1.f / 1024.f) + EPS);
      __syncthreads();
      const float* bb = p.bin + (m0 < LC ? 1 : 0) * DIN + nw0 + lr;
      float bv[4];
#pragma unroll
      for (int j = 0; j < 4; ++j) bv[j] = bb[16 * j];
#pragma unroll
      for (int i = 0; i < 4; ++i)
#pragma unroll
        for (int r = 0; r < 4; ++r) {
          const float rv = rinvl[wm * 64 + 16 * i + 4 * g + r];
#pragma unroll
          for (int j = 0; j < 4; ++j) acc[i][j][r] = acc[i][j][r] * rv + bv[j];
        }
    }
    if (n0 < 512) {
#pragma unroll
      for (int i = 0; i < 4; ++i)
#pragma unroll
        for (int r = 0; r < 4; ++r) {
          int row = mw0 + 16 * i + 4 * g + r;
#pragma unroll
          for (int j = 0; j < 4; ++j) p.proj[(size_t)row * 512 + nw0 + 16 * j + lr] = acc[i][j][r];
        }
      return;
    }
    const float* gain = nullptr; bool rope = false; float scale = 1.f;
    if (nw0 < 896) { gain = p.win_qn + l * 64; rope = true; scale = QSCALE; }
    else if (nw0 < 1024) { gain = p.win_kn + l * 64; rope = true; }
    else if (nw0 < 1152) { }
    else if (nw0 < 1536) { gain = p.na_qn + l * 64; scale = QSCALE; }
    else if (nw0 < 1920) { gain = p.na_kn + l * 64; }
    rope = rope && (m0 >= LC);
    float gj[4] = {1.f, 1.f, 1.f, 1.f};
    if (gain) {
#pragma unroll
      for (int j = 0; j < 4; ++j) gj[j] = gain[16 * j + lr] * scale;
    }
#pragma unroll
    for (int i = 0; i < 4; ++i)
#pragma unroll
      for (int r = 0; r < 4; ++r) {
        const int row = mw0 + 16 * i + 4 * g + r;
        float y[4] = {acc[i][0][r], acc[i][1][r], acc[i][2][r], acc[i][3][r]};
        if (gain) {
          float ss = y[0] * y[0] + y[1] * y[1] + y[2] * y[2] + y[3] * y[3];
          ss += dpp_row<0xB1>(ss);
          ss += dpp_row<0x4E>(ss);
          ss += dpp_row<0x141>(ss);
          ss += dpp_row<0x140>(ss);
          const float rinv = rsqrtf(ss * (1.f / 64.f) + EPS);
#pragma unroll
          for (int j = 0; j < 4; ++j) y[j] *= rinv * gj[j];
        }
        if (rope) {
          const int pos = row - LC;
          const float2 tr = ((const float2*)p.ropetab)[(pos >> 6) * 16 + lr];
          const float2 tc = ((const float2*)p.ropetab)[(256 + (pos & 63)) * 16 + lr];
          float a0 = y[0] * tr.x - y[1] * tr.y, a1 = y[0] * tr.y + y[1] * tr.x;
          float a2 = y[2] * tc.x - y[3] * tc.y, a3 = y[2] * tc.y + y[3] * tc.x;
          y[0] = a0; y[1] = a1; y[2] = a2; y[3] = a3;
        }
#pragma unroll
        for (int j = 0; j < 4; ++j) p.projb[(size_t)row * DIN + nw0 + 16 * j + lr] = f2bf(y[j]);
      }
  }
};
struct EpiResid {
  __device__ __forceinline__ float pre(const P&, int, int) const { return 0.f; }
  int l;
  __device__ __forceinline__ void operator()(const P& p, f32x4 (&acc)[4][4], int m0, int n0, int wm, int wn, int lane, char* smem, float epre) const {
    float* tile = (float*)smem;
    {
      const int g = lane >> 4, lr = lane & 15;
      float* tw = tile + (wm * 64 + 4 * g) * 132 + wn * 64 + lr;
#pragma unroll
      for (int i = 0; i < 4; ++i)
#pragma unroll
        for (int r = 0; r < 4; ++r)
#pragma unroll
          for (int j = 0; j < 4; ++j) tw[(16 * i + r) * 132 + 16 * j] = acc[i][j][r];
    }
    __syncthreads();
    const int tid = ((wm * 2 + wn) << 6) | lane, c8 = tid & 15, rsub = tid >> 4;
    const float* mod = p.mod + (l * 2 + (m0 < LC ? 1 : 0)) * 6144;
    const int col = n0 + 8 * c8;
    float g1v[8], gs[8];
    {
      const float4 a0 = *(const float4*)(mod + 2048 + col), a1 = *(const float4*)(mod + 2048 + col + 4);
      const float4 s0 = *(const float4*)(mod + 4096 + col), s1 = *(const float4*)(mod + 4096 + col + 4);
      const float4 n0v = *(const float4*)(p.norm2_g + l * 1024 + col), n1v = *(const float4*)(p.norm2_g + l * 1024 + col + 4);
      g1v[0] = a0.x; g1v[1] = a0.y; g1v[2] = a0.z; g1v[3] = a0.w; g1v[4] = a1.x; g1v[5] = a1.y; g1v[6] = a1.z; g1v[7] = a1.w;
      gs[0] = n0v.x * (1.f + s0.x); gs[1] = n0v.y * (1.f + s0.y); gs[2] = n0v.z * (1.f + s0.z); gs[3] = n0v.w * (1.f + s0.w);
      gs[4] = n1v.x * (1.f + s1.x); gs[5] = n1v.y * (1.f + s1.y); gs[6] = n1v.z * (1.f + s1.z); gs[7] = n1v.w * (1.f + s1.w);
    }
#pragma unroll
    for (int it = 0; it < 8; ++it) {
      const int rl = it * 16 + rsub, row = m0 + rl;
      float4* xp = (float4*)(p.xall + (size_t)row * 1024 + col);
      const float4* xi = (l == 0) ? (const float4*)((row < LC ? p.ctx + (size_t)row * 1024 : p.x + (size_t)(row - LC) * 1024) + col) : (const float4*)xp;
      float4 x0 = xi[0], x1 = xi[1];
      const float4 t0 = *(const float4*)(tile + rl * 132 + 8 * c8), t1 = *(const float4*)(tile + rl * 132 + 8 * c8 + 4);
      x0.x += g1v[0] * t0.x; x0.y += g1v[1] * t0.y; x0.z += g1v[2] * t0.z; x0.w += g1v[3] * t0.w;
      x1.x += g1v[4] * t1.x; x1.y += g1v[5] * t1.y; x1.z += g1v[6] * t1.z; x1.w += g1v[7] * t1.w;
      xp[0] = x0; xp[1] = x1;
      float ss = x0.x * x0.x + x0.y * x0.y + x0.z * x0.z + x0.w * x0.w + x1.x * x1.x + x1.y * x1.y + x1.z * x1.z + x1.w * x1.w;
      ss += dpp_row<0xB1>(ss);
      ss += dpp_row<0x4E>(ss);
      ss += dpp_row<0x141>(ss);
      ss += dpp_row<0x140>(ss);
      *(uint4*)(p.hb + (size_t)row * 1024 + col) = make_uint4(pack2bf(x0.x * gs[0], x0.y * gs[1]), pack2bf(x0.z * gs[2], x0.w * gs[3]),
                                                            pack2bf(x1.x * gs[4], x1.y * gs[5]), pack2bf(x1.z * gs[6], x1.w * gs[7]));
      if (c8 == 0) p.rowss[(size_t)(n0 >> 7) * TT + row] = ss;
    }
  }
};

template <int CTRL, int RMASK>
__device__ __forceinline__ float dpp_mov_id(float v) {
  return __int_as_float(__builtin_amdgcn_update_dpp(__float_as_int(v), __float_as_int(v), CTRL, RMASK, 0xf, false));
}
__device__ __forceinline__ float wave_max(float v) {
  v = fmaxf(v, dpp_mov_id<0xB1, 0xf>(v));
  v = fmaxf(v, dpp_mov_id<0x4E, 0xf>(v));
  v = fmaxf(v, dpp_mov_id<0x141, 0xf>(v));
  v = fmaxf(v, dpp_mov_id<0x140, 0xf>(v));
  v = fmaxf(v, dpp_mov_id<0x142, 0xa>(v));
  v = fmaxf(v, dpp_mov_id<0x143, 0xc>(v));
  return __int_as_float(__builtin_amdgcn_readlane(__float_as_int(v), 63));
}

typedef __attribute__((ext_vector_type(2))) float f32x2;
__device__ __forceinline__ void peer_convert_rows(const P& p, int l, int r0, int r1) {
  const int tid = tid_opaque(), lane = tid & 63;
  for (int rb = r0 + (tid >> 6); rb < r1; rb += 16) {
    float4 v[4][4];
#pragma unroll
    for (int u = 0; u < 4; ++u) {
      const int r = min(rb + 4 * u, r1 - 1);
      const int tbl = r >> 14, e = r & 16383;
      const float4* src = (const float4*)((tbl ? p.pv : p.pu) + ((size_t)l * 16384 + e) * 1024) + lane * 4;
#pragma unroll
      for (int i = 0; i < 4; ++i) v[u][i] = src[i];
    }
#pragma unroll
    for (int u = 0; u < 4; ++u) {
      const int r = rb + 4 * u;
      if (r < r1) {
        const int tbl = r >> 14, e = r & 16383;
        float am = 0.f;
#pragma unroll
        for (int i = 0; i < 4; ++i)
          am = fmaxf(am, fmaxf(fmaxf(fabsf(v[u][i].x), fabsf(v[u][i].y)), fmaxf(fabsf(v[u][i].z), fabsf(v[u][i].w))));
        am = wave_max(am);
        const float sc = am > 0.f ? 224.f / am : 1.f;
        unsigned w[4];
#pragma unroll
        for (int i = 0; i < 4; ++i) {
          int t = __builtin_amdgcn_cvt_pk_fp8_f32(v[u][i].x * sc, v[u][i].y * sc, 0, false);
          t = __builtin_amdgcn_cvt_pk_fp8_f32(v[u][i].z * sc, v[u][i].w * sc, t, true);
          w[i] = (unsigned)t;
        }
        unsigned char* dst = (tbl ? p.vb8 : p.ub8) + (((size_t)l * 8 + (lane >> 3)) * 16384 + e) * 128 + (lane & 7) * 16;
        *(uint4*)dst = make_uint4(w[0], w[1], w[2], w[3]);
        if (lane == 0) (tbl ? p.vsc : p.usc)[l * 16384 + e] = am > 0.f ? am / 224.f : 1.f;
      }
    }
  }
}
__device__ __forceinline__ int gemm_swz(int row) { return (0x78 >> (((row >> 2) & 3) * 2)) & 3; }
template <class Epi>
__device__ __forceinline__ void gemm_bf16_128(const P& p, const bf16_t* __restrict__ A, const bf16_t* __restrict__ Bt, int K, int m_begin, int m_end,
                              int N, char* smem, const Epi& epi, int cl = -1, int rpt = 0, int boff = 0) {
  const int tid = tid_opaque(), lane = tid & 63, wv = __builtin_amdgcn_readfirstlane(tid >> 6), wm = wv >> 1, wn = wv & 1;
  const int tiles_n = N / 128, tiles_m = (m_end - m_begin) / 128;
  const int nk = K / 32;
  const int lr = lane & 15, g = lane >> 4;
  const int a_rd = (wm * 64 + lr) * 64 + ((g ^ gemm_swz(lr)) << 4);
  const int b_rd = 8192 + (wn * 64 + lr) * 64 + ((g ^ gemm_swz(lr)) << 4);
  const int ld_row = lane >> 2, ld_c = (lane & 3) ^ gemm_swz(ld_row);
  for (int tile = ((int)blockIdx.x + (int)gridDim.x - boff) % (int)gridDim.x; tile < tiles_m * tiles_n; tile += gridDim.x) {
    const int m0 = m_begin + (tile / tiles_n) * 128, n0 = (tile % tiles_n) * 128;
    f32x4 acc[4][4];
#pragma unroll
    for (int i = 0; i < 4; ++i)
#pragma unroll
      for (int j = 0; j < 4; ++j) acc[i][j] = (f32x4){0.f, 0.f, 0.f, 0.f};
    const bf16_t* Ag = A + (size_t)(m0 + wv * 32 + ld_row) * K + ld_c * 8;
    const bf16_t* Bg = Bt + (size_t)(n0 + wv * 32 + ld_row) * K + ld_c * 8;
    auto issue = [&](int st, int kt) {
      char* base = smem + st * 16384 + wv * 2048;
#pragma unroll
      for (int i = 0; i < 2; ++i) {
        __builtin_amdgcn_global_load_lds((const unsigned*)(Ag + (size_t)i * 16 * K + kt * 32), (__attribute__((address_space(3))) unsigned*)(base + i * 1024), 16, 0, 0);
        __builtin_amdgcn_global_load_lds((const unsigned*)(Bg + (size_t)i * 16 * K + kt * 32), (__attribute__((address_space(3))) unsigned*)(base + 8192 + i * 1024), 16, 0, 0);
      }
    };
    issue(0, 0); issue(1, 1); issue(2, 2);
    const float epre = epi.pre(p, m0, tid);
    for (int kt0 = 0; kt0 < nk; kt0 += 4) {
#pragma unroll
      for (int u = 0; u < 4; ++u) {
        const int kt = kt0 + u, rem = nk - kt;
        if (rem >= 3) asm volatile("s_waitcnt vmcnt(8) lgkmcnt(0)" ::: "memory");
        else if (rem == 2) asm volatile("s_waitcnt vmcnt(4) lgkmcnt(0)" ::: "memory");
        else asm volatile("s_waitcnt vmcnt(0) lgkmcnt(0)" ::: "memory");
        __builtin_amdgcn_s_barrier();
        if (kt + 3 < nk) issue((u + 3) & 3, kt + 3);
        bf16x8 af[4], bfr[4];
#pragma unroll
        for (int i = 0; i < 4; ++i) af[i] = *(const bf16x8*)(smem + u * 16384 + a_rd + i * 1024);
#pragma unroll
        for (int j = 0; j < 4; ++j) bfr[j] = *(const bf16x8*)(smem + u * 16384 + b_rd + j * 1024);
#pragma unroll
        for (int i = 0; i < 4; ++i)
#pragma unroll
          for (int j = 0; j < 4; ++j) acc[i][j] = __builtin_amdgcn_mfma_f32_16x16x32_bf16(af[i], bfr[j], acc[i][j], 0, 0, 0);
      }
    }
    __syncthreads();
    epi(p, acc, m0, n0, wm, wn, lane, smem, epre);
    if (cl >= 0) peer_convert_rows(p, cl, min(tile * rpt, 32768), min((tile + 1) * rpt, 32768));
    __syncthreads();
  }
}

constexpr int NCHUNK = TT / 64;
__device__ __forceinline__ int lru_pos(int dir, int c) { return dir == 0 ? c : (c < 4 ? 3 - c : 4 + (NCHUNK - 1 - c)); }

__device__ __forceinline__ void ph_lru_prepw(const P& p) {
  for (int idx = GTID; idx < 2 * 2 * 4 * 2 * 4096; idx += GSZ) {
    int d = idx & 63, e = (idx >> 6) & 63, mtx = (idx >> 12) & 1, rest = idx >> 13;
    const float* w = (mtx ? p.wx : p.wa) + (size_t)rest * 4096;
    p.lruw_t[idx] = f2bf(w[d * 64 + e]);
  }
}

template <int PASS>
__device__ __forceinline__ void lru_item(const P& p, int l, int cidx, int kb, char* smem) {
  bf16_t* u_img = (bf16_t*)smem;
  const int tid = tid_opaque(), lane = tid & 63, wv = tid >> 6, g = lane >> 4, lr = lane & 15;
  const int t0 = cidx * 64;
  const int lo = t0 < LC ? 0 : LC, hi = t0 < LC ? LC : TT;
  const int chw = 16 * wv + lr, cw = kb * 64 + chw;
  __syncthreads();
  bf16x8 wfa[2][2], wfx[2][2];
  float bav2[2], bxv2[2], lam2[2], cin[2] = {0.f, 0.f};
#pragma unroll
  for (int dir = 0; dir < 2; ++dir) {
    const int pd = l * 2 + dir;
    const bf16_t* wbase = p.lruw_t + (size_t)((pd * 4 + kb) * 2) * 4096 + chw * 64 + 8 * g;
#pragma unroll
    for (int s = 0; s < 2; ++s) { wfa[dir][s] = *(const bf16x8*)(wbase + 32 * s); wfx[dir][s] = *(const bf16x8*)(wbase + 4096 + 32 * s); }
    bav2[dir] = p.ba[pd * 256 + cw]; bxv2[dir] = p.bx[pd * 256 + cw]; lam2[dir] = p.lam[pd * 256 + cw];
    if (PASS == 2) cin[dir] = p.lcarry[((size_t)dir * NCHUNK + lru_pos(dir, cidx)) * 256 + cw];
  }
  float gav[4][4];
  if (PASS == 2) {
#pragma unroll
    for (int i = 0; i < 4; ++i)
#pragma unroll
      for (int r = 0; r < 4; ++r) gav[i][r] = p.proj[(size_t)(t0 + 16 * i + 4 * g + r) * 512 + OFF_GA + cw];
  }
  {
    const int ch = tid & 63, c = kb * 64 + ch, sg = tid >> 6;
    const float cb = p.conv_b[l * 256 + c];
    float cw4[4];
#pragma unroll
    for (int k = 0; k < 4; ++k) cw4[k] = p.conv_w[(l * 4 + k) * 256 + c];
    float xr[19];
#pragma unroll
    for (int i = 0; i < 19; ++i) {
      int tt = t0 + sg * 16 + i - 2;
      int tc = tt < lo ? lo : (tt >= hi ? hi - 1 : tt);
      float v = p.proj[(size_t)tc * 512 + OFF_XA + c];
      xr[i] = (tt >= lo && tt < hi) ? v : 0.f;
    }
#pragma unroll
    for (int i = 0; i < 16; ++i) {
      int row = sg * 16 + i;
      float acc = cb + cw4[0] * xr[i] + cw4[1] * xr[i + 1] + cw4[2] * xr[i + 2] + cw4[3] * xr[i + 3];
      u_img[row * 64 + ((((ch >> 3) ^ (row & 7)) << 3) | (ch & 7))] = f2bf(acc);
    }
  }
  __syncthreads();
  float hs0[4][4];
#pragma unroll
  for (int dir = 0; dir < 2; ++dir) {
    f32x4 ga[4], gx[4];
#pragma unroll
    for (int i = 0; i < 4; ++i) { ga[i] = (f32x4){0.f, 0.f, 0.f, 0.f}; gx[i] = (f32x4){0.f, 0.f, 0.f, 0.f}; }
#pragma unroll
    for (int s = 0; s < 2; ++s) {
      const bf16x8 ba_ = dir == 0 ? wfa[0][s] : wfa[1][s];
      const bf16x8 bx_ = dir == 0 ? wfx[0][s] : wfx[1][s];
#pragma unroll
      for (int i = 0; i < 4; ++i) {
        int row = 16 * i + lr;
        bf16x8 af = *(const bf16x8*)((const char*)u_img + row * 128 + (((4 * s + g) ^ (row & 7)) << 4));
        ga[i] = __builtin_amdgcn_mfma_f32_16x16x32_bf16(af, ba_, ga[i], 0, 0, 0);
        gx[i] = __builtin_amdgcn_mfma_f32_16x16x32_bf16(af, bx_, gx[i], 0, 0, 0);
      }
    }
    const float bav = dir == 0 ? bav2[0] : bav2[1], bxv = dir == 0 ? bxv2[0] : bxv2[1];
    const float sp = log1pf(expf(-(dir == 0 ? lam2[0] : lam2[1])));
    float av[4][4], bv[4][4];
#pragma unroll
    for (int i = 0; i < 4; ++i)
#pragma unroll
      for (int r = 0; r < 4; ++r) {
        const int row = 16 * i + 4 * g + r;
        float rr = sigmoid_f(ga[i][r] + bav), ig = sigmoid_f(gx[i][r] + bxv);
        float log_a = -8.f * rr * sp;
        float a = __expf(log_a);
        float uu = bf2f(u_img[row * 64 + ((((chw >> 3) ^ (row & 7)) << 3) | (chw & 7))]);
        const float x2 = 2.f * log_a;
        const float ser = -x2 * (1.f + x2 * (0.5f + x2 * (0.16666667f + x2 * (0.041666668f + x2 * 0.0083333338f))));
        const float om = x2 > -0.25f ? ser : 1.f - a * a;
        av[i][r] = a;
        bv[i][r] = sqrtf(om) * ig * uu;
      }
    float As[4], Bs[4];
#pragma unroll
    for (int i = 0; i < 4; ++i) {
      float A = 1.f, B = 0.f;
#pragma unroll
      for (int rr = 0; rr < 4; ++rr) { const int r = dir == 0 ? rr : 3 - rr; B = av[i][r] * B + bv[i][r]; A *= av[i][r]; }
      As[i] = A; Bs[i] = B;
    }
    const int lg = dir == 0 ? g : 3 - g;
    const int src1 = dir == 0 ? lane - 16 : lane + 16, src2 = dir == 0 ? lane - 32 : lane + 32;
    float Ai[4], Bi[4];
#pragma unroll
    for (int i = 0; i < 4; ++i) {
      float A = As[i], B = Bs[i];
      { float Ap = __shfl(A, src1 & 63), Bp = __shfl(B, src1 & 63); if (lg >= 1) { B = A * Bp + B; A = Ap * A; } }
      { float Ap = __shfl(A, src2 & 63), Bp = __shfl(B, src2 & 63); if (lg >= 2) { B = A * Bp + B; A = Ap * A; } }
      Ai[i] = A; Bi[i] = B;
    }
    const int lastl = (dir == 0 ? 48 : 0) + lr;
    float Ae[4], Be[4], At[4], Bt[4];
#pragma unroll
    for (int i = 0; i < 4; ++i) {
      float Ap = __shfl(Ai[i], src1 & 63), Bp = __shfl(Bi[i], src1 & 63);
      Ae[i] = lg >= 1 ? Ap : 1.f; Be[i] = lg >= 1 ? Bp : 0.f;
      At[i] = __shfl(Ai[i], lastl); Bt[i] = __shfl(Bi[i], lastl);
    }
    if (PASS == 1) {
      float A = 1.f, B = 0.f;
#pragma unroll
      for (int ii = 0; ii < 4; ++ii) { const int i = dir == 0 ? ii : 3 - ii; B = At[i] * B + Bt[i]; A *= At[i]; }
      if (g == 0) {
        float2* ag = (float2*)p.lagg + ((size_t)dir * NCHUNK + lru_pos(dir, cidx)) * 256 + cw;
        *ag = make_float2(A, B);
      }
    } else {
      float R = dir == 0 ? cin[0] : cin[1];
#pragma unroll
      for (int ii = 0; ii < 4; ++ii) {
        const int i = dir == 0 ? ii : 3 - ii;
        float h = Ae[i] * R + Be[i];
#pragma unroll
        for (int rr = 0; rr < 4; ++rr) {
          const int r = dir == 0 ? rr : 3 - rr;
          h = av[i][r] * h + bv[i][r];
          if (dir == 0) hs0[i][r] = h;
          else p.mixb[(size_t)(t0 + 16 * i + 4 * g + r) * 1024 + cw] = f2bf((hs0[i][r] + h) * gelu_f(gav[i][r]));
        }
        R = At[i] * R + Bt[i];
      }
    }
  }
}

__device__ __forceinline__ void ph_lru_carry(const P& p, float* smem) {
  const int tid = tid_opaque(), seg = tid >> 4, c16 = tid & 15;
  for (int blk = blockIdx.x; blk < 32; blk += gridDim.x) {
    const int dc = blk * 16 + c16, dir = dc >> 8, ch = dc & 255;
    const float2* ag = (const float2*)p.lagg + (size_t)dir * NCHUNK * 256 + ch;
    float2 v[17];
#pragma unroll
    for (int i = 0; i < 17; ++i) {
      int pos = seg * 17 + i;
      v[i] = pos < NCHUNK ? ag[(size_t)pos * 256] : make_float2(1.f, 0.f);
    }
    float A = 1.f, B = 0.f;
#pragma unroll
    for (int i = 0; i < 17; ++i) { B = v[i].x * B + v[i].y; A *= v[i].x; }
    __syncthreads();
    smem[(seg * 16 + c16) * 2] = A; smem[(seg * 16 + c16) * 2 + 1] = B;
    __syncthreads();
    float h = 0.f;
    for (int s2 = 0; s2 < seg; ++s2) h = smem[(s2 * 16 + c16) * 2] * h + smem[(s2 * 16 + c16) * 2 + 1];
    float* cr = p.lcarry + (size_t)dir * NCHUNK * 256 + ch;
#pragma unroll
    for (int i = 0; i < 17; ++i) {
      int pos = seg * 17 + i;
      if (pos < NCHUNK) cr[(size_t)pos * 256] = h;
      h = v[i].x * h + v[i].y;
    }
  }
}

template <int PASS>
__device__ __forceinline__ void ph_lru(const P& p, int l, char* smem) {
  const int c_begin = (PASS == 2 && l == 1) ? 4 : 0;
  const int nitems = (NCHUNK - c_begin) * 4;
  for (int it = blockIdx.x; it < nitems; it += gridDim.x) lru_item<PASS>(p, l, c_begin + (it >> 2), it & 3, smem);
}

typedef __attribute__((ext_vector_type(4))) short s16x4;
typedef __attribute__((ext_vector_type(4))) unsigned u32x4;

__device__ __forceinline__ void ph_qknorm_rope2(const P& p, int l) {
  const int tid_ = tid_opaque();
  const int lane = tid_ & 63;
  const int wpb = blockDim.x >> 6;
  for (int pair = blockIdx.x * wpb + (tid_ >> 6); pair < TT * 28; pair += gridDim.x * wpb) {
    int t = pair / 28, slot = pair % 28;
    const float* g = nullptr; bool rope = false; float scale = 1.f;
    if (slot < 6) { g = p.win_qn + l * 64; rope = true; scale = QSCALE; }
    else if (slot < 8) { g = p.win_kn + l * 64; rope = true; }
    else if (slot < 10) { }
    else if (slot < 16) { g = p.na_qn + l * 64; scale = QSCALE; }
    else if (slot < 22) { g = p.na_kn + l * 64; }
    rope = rope && (t >= LC);
    const size_t idx = (size_t)t * DIN + 512 + slot * 64 + lane;
    float v = bf2f(p.projb[idx]);
    float y = v;
    if (g) {
      float ss = wave_sum(v * v);
      y = v * rsqrtf(ss * (1.f / 64.f) + EPS) * g[lane];
    }
    float partner = __shfl_xor(y, 16);
    if (rope) {
      int pos = t - LC, row = pos >> 6, col = pos & 63;
      int j = lane & 15, axis = lane >> 5;
      float inv = __expf(-(float)j * (1.f / 16.f) * 9.210340371976184f);
      float ang = (float)(axis ? col : row) * inv;
      float k = rintf(ang * 0.15915494309189535f);
      float r = fmaf(-k, 6.2831854820251465f, ang);
      r = fmaf(-k, -1.7484555e-07f, r);
      float cs = __cosf(r), sn = __sinf(r);
      bool first = ((lane >> 4) & 1) == 0;
      y = first ? (y * cs - partner * sn) : (partner * sn + y * cs);
    }
    p.projb[idx] = f2bf(y * scale);
  }
}

template <class TokFn>
__device__ __forceinline__ void kv_issue(const P& p, char* stage, int koff, int voff, TokFn tok, int wv, int lane) {
#pragma unroll
  for (int i = 0; i < 2; ++i) {
    const int row = 16 * wv + 8 * i + (lane >> 3);
    const bf16_t* src = p.projb + (size_t)tok(row) * DIN + (((lane & 7) ^ (row & 7)) << 3);
    char* dst = stage + (2 * wv + i) * 1024;
    __builtin_amdgcn_global_load_lds((const unsigned*)(src + koff), (__attribute__((address_space(3))) unsigned*)dst, 16, 0, 0);
    __builtin_amdgcn_global_load_lds((const unsigned*)(src + voff), (__attribute__((address_space(3))) unsigned*)(dst + 8192), 16, 0, 0);
  }
}
__device__ __forceinline__ void kv_wait(int rem) {
  if (rem >= 3) asm volatile("s_waitcnt vmcnt(8) lgkmcnt(0)" ::: "memory");
  else if (rem == 2) asm volatile("s_waitcnt vmcnt(4) lgkmcnt(0)" ::: "memory");
  else asm volatile("s_waitcnt vmcnt(0) lgkmcnt(0)" ::: "memory");
  __builtin_amdgcn_s_barrier();
}

template <class MaskFn>
__device__ __forceinline__ void attn_step2(const char* stage, int kr0, const bf16x8 (&qf)[2][2], f32x4 (&o)[2][4], float (&lsum)[2], MaskFn mb,
                                           int lane, bool act0, bool act1) {
  const int g = lane >> 4, lr = lane & 15;
  bf16x8 kf[2][2];
#pragma unroll
  for (int t2 = 0; t2 < 2; ++t2) {
    const int row = kr0 + 16 * t2 + lr;
#pragma unroll
    for (int s = 0; s < 2; ++s) kf[t2][s] = *(const bf16x8*)(stage + row * 128 + (((4 * s + g) ^ (row & 7)) << 4));
  }
  bf16x8 pb[2];
#pragma unroll
  for (int qt = 0; qt < 2; ++qt) {
    if (qt == 0 ? act0 : act1) {
      f32x4 st[2];
#pragma unroll
      for (int t2 = 0; t2 < 2; ++t2) {
        st[t2] = (f32x4){0.f, 0.f, 0.f, 0.f};
#pragma unroll
        for (int s = 0; s < 2; ++s) st[t2] = __builtin_amdgcn_mfma_f32_16x16x32_bf16(kf[t2][s], qf[qt][s], st[t2], 0, 0, 0);
      }
#pragma unroll
      for (int t2 = 0; t2 < 2; ++t2) {
        float pv[4];
#pragma unroll
        for (int r = 0; r < 4; ++r) { pv[r] = __builtin_amdgcn_exp2f(mb(qt, t2, r, st[t2][r])); lsum[qt] += pv[r]; }
        const unsigned w0 = pack2bf(pv[0], pv[1]), w1 = pack2bf(pv[2], pv[3]);
        pb[qt][t2 * 4 + 0] = (short)(w0 & 0xffffu); pb[qt][t2 * 4 + 1] = (short)(w0 >> 16);
        pb[qt][t2 * 4 + 2] = (short)(w1 & 0xffffu); pb[qt][t2 * 4 + 3] = (short)(w1 >> 16);
      }
    }
  }
  const int q = lr >> 2, pp = lane & 3;
#pragma unroll
  for (int m = 0; m < 4; ++m) {
    bf16x8 vf;
#pragma unroll
    for (int t = 0; t < 2; ++t) {
      const int row = kr0 + 16 * t + 4 * g + q;
      const char* addr = stage + 8192 + row * 128 + (((2 * m + (pp >> 1)) ^ (row & 7)) << 4) + 8 * (pp & 1);
      s16x4 v4 = __builtin_amdgcn_ds_read_tr16_b64_v4i16((__attribute__((address_space(3))) s16x4*)addr);
      vf[4 * t + 0] = v4[0]; vf[4 * t + 1] = v4[1]; vf[4 * t + 2] = v4[2]; vf[4 * t + 3] = v4[3];
    }
    if (act0) o[0][m] = __builtin_amdgcn_mfma_f32_16x16x32_bf16(vf, pb[0], o[0][m], 0, 0, 0);
    if (act1) o[1][m] = __builtin_amdgcn_mfma_f32_16x16x32_bf16(vf, pb[1], o[1][m], 0, 0, 0);
  }
}

__device__ __forceinline__ void attn_store_out(const P& p, const f32x4 (&o)[4], float lsum, int tok, int col0, int lane) {
  const int g = lane >> 4;
  lsum += __shfl_xor(lsum, 16);
  lsum += __shfl_xor(lsum, 32);
  const float inv = 1.f / lsum;
  bf16_t* op = p.mixb + (size_t)tok * 1024 + col0 + 4 * g;
#pragma unroll
  for (int m = 0; m < 4; ++m)
    *(uint2*)(op + 16 * m) = make_uint2(pack2bf(o[m][0] * inv, o[m][1] * inv), pack2bf(o[m][2] * inv, o[m][3] * inv));
}

__device__ __forceinline__ void attn_win_item(const P& p, int l, int kind, int qb, int hs, char* smem) {
  const int tid = tid_opaque(), lane = tid & 63, wv = __builtin_amdgcn_readfirstlane(tid >> 6), g = lane >> 4, lr = lane & 15;
  int qoff, koff, voff, ooff; const float *gq, *gk; float sink2 = -1e30f; bool has_sink = false;
  if (kind == 0 || hs < 6) {
    const int h = hs, kvh = h / 3;
    qoff = OFF_QW + h * 64; koff = OFF_KW + kvh * 64; voff = OFF_VW + kvh * 64; ooff = 256 + h * 64;
    gq = p.win_qn + l * 64; gk = p.win_kn + l * 64; sink2 = p.win_sink[l * 6 + h] * LOG2E; has_sink = true;
  } else {
    const int h = hs - 6;
    qoff = OFF_QN + h * 64; koff = OFF_KN + h * 64; voff = OFF_VN + h * 64; ooff = 640 + h * 64;
    gq = p.na_qn + l * 64; gk = p.na_kn + l * 64;
  }
  float bound = 8.f * LOG2E * wave_max(fabsf(gq[lane])) * wave_max(fabsf(gk[lane])) * 1.0001f + 1e-3f;
  if (has_sink) bound = fmaxf(bound, sink2);
  const int q0 = qb * 128;
  const int qtok0 = (kind == 0 ? LC : 0) + q0 + 32 * wv;
  bf16x8 qf[2][2];
#pragma unroll
  for (int qt = 0; qt < 2; ++qt)
#pragma unroll
    for (int s = 0; s < 2; ++s) qf[qt][s] = *(const bf16x8*)(p.projb + (size_t)(qtok0 + 16 * qt + lr) * DIN + qoff + 32 * s + 8 * g);
  f32x4 o[2][4];
#pragma unroll
  for (int qt = 0; qt < 2; ++qt)
#pragma unroll
    for (int m = 0; m < 4; ++m) o[qt][m] = (f32x4){0.f, 0.f, 0.f, 0.f};
  float lsum[2] = {0.f, 0.f};
  const int nloc = (kind == 0) ? 6 : 0, nch = nloc + 4;
  auto tokfn = [&](int c) {
    return [=](int row) {
      if (c < nloc) { int pos = q0 - 128 + 64 * c + row; pos = pos < 0 ? 0 : (pos > SEQ - 1 ? SEQ - 1 : pos); return LC + pos; }
      return 64 * (c - nloc) + row;
    };
  };
  __syncthreads();
  kv_issue(p, smem, koff, voff, tokfn(0), wv, lane);
  kv_issue(p, smem + 16384, koff, voff, tokfn(1), wv, lane);
  kv_issue(p, smem + 32768, koff, voff, tokfn(2), wv, lane);
  for (int c = 0; c < nch; ++c) {
    kv_wait(nch - c);
    if (c + 3 < nch) kv_issue(p, smem + ((c + 3) & 3) * 16384, koff, voff, tokfn(c + 3), wv, lane);
    const char* stage = smem + (c & 3) * 16384;
    if (c < nloc) {
      const int qw0 = q0 + 32 * wv;
#pragma unroll
      for (int st = 0; st < 2; ++st) {
        const int kbase = q0 - 128 + 64 * c + 32 * st;
        const bool a0 = !(kbase - (qw0 + 15) > 128 || qw0 - (kbase + 31) > 128) && (kbase + 31 >= 0) && (kbase < SEQ);
        const bool a1 = !(kbase - (qw0 + 31) > 128 || (qw0 + 16) - (kbase + 31) > 128) && (kbase + 31 >= 0) && (kbase < SEQ);
        const bool allv = (kbase >= 0) && (kbase + 31 < SEQ) && (kbase + 31 - qw0 <= 128) && (qw0 + 31 - kbase <= 128);
        if (allv)
          attn_step2(stage, 32 * st, qf, o, lsum, [&](int qt, int t2, int r, float s) { return s - bound; }, lane, true, true);
        else if (a0 || a1)
          attn_step2(stage, 32 * st, qf, o, lsum, [&](int qt, int t2, int r, float s) {
            int kpos = kbase + 16 * t2 + 4 * g + r;
            int dlt = kpos - (qw0 + 16 * qt + lr); dlt = dlt < 0 ? -dlt : dlt;
            bool valid = (kpos >= 0) && (kpos < SEQ) && (dlt <= 128);
            return valid ? s - bound : -1e30f;
          }, lane, a0, a1);
      }
    } else {
#pragma unroll
      for (int st = 0; st < 2; ++st)
        attn_step2(stage, 32 * st, qf, o, lsum, [&](int qt, int t2, int r, float s) { return s - bound; }, lane, true, true);
    }
  }
#pragma unroll
  for (int qt = 0; qt < 2; ++qt) {
    float ls = lsum[qt];
    if (has_sink && g == 0) ls += __builtin_amdgcn_exp2f(sink2 - bound);
    attn_store_out(p, o[qt], ls, qtok0 + 16 * qt + lr, ooff, lane);
  }
}

__device__ __forceinline__ void attn_na_item(const P& p, int l, int rp, int h, char* smem) {
  const int tid = tid_opaque(), lane = tid & 63, wv = __builtin_amdgcn_readfirstlane(tid >> 6), g = lane >> 4, lr = lane & 15;
  const int qoff = OFF_QN + h * 64, koff = OFF_KN + h * 64, voff = OFF_VN + h * 64, ooff = 640 + h * 64;
  float* rpbl = (float*)(smem + 65536);
  const float* rpbg = p.rpb + (size_t)(l * 6 + h) * 465;
  float bmax = 0.f;
  __syncthreads();
  for (int i = tid; i < 465; i += 256) rpbl[i] = rpbg[i] * LOG2E;
  for (int i = lane; i < 465; i += 64) bmax = fmaxf(bmax, fabsf(rpbg[i]) * LOG2E);
  bmax = wave_max(bmax);
  const float bound = 8.f * LOG2E * wave_max(fabsf(p.na_qn[l * 64 + lane])) * wave_max(fabsf(p.na_kn[l * 64 + lane])) * 1.0001f + bmax + 1e-3f;
  const int r0 = 2 * rp;
  const int qcol = 16 * wv + lr;
  const int qtok0 = LC + r0 * 64 + qcol;
  const int kra = min(max(r0 - 4, 0), 248), krb = min(max(r0 + 1 - 4, 0), 248);
  const int nrow = krb + 8 - kra, nch = nrow + 4;
  const int kc0 = min(max(16 * wv - 8, 0), 32);
  const int qs = min(max(qcol - 8, 0), 48);
  bf16x8 qf[2][2];
#pragma unroll
  for (int qt = 0; qt < 2; ++qt)
#pragma unroll
    for (int s = 0; s < 2; ++s) qf[qt][s] = *(const bf16x8*)(p.projb + (size_t)(qtok0 + 64 * qt) * DIN + qoff + 32 * s + 8 * g);
  f32x4 o[2][4];
#pragma unroll
  for (int qt = 0; qt < 2; ++qt)
#pragma unroll
    for (int m = 0; m < 4; ++m) o[qt][m] = (f32x4){0.f, 0.f, 0.f, 0.f};
  float lsum[2] = {0.f, 0.f};
  auto tokfn = [&](int c) {
    return [=](int row) { return c < nrow ? LC + (kra + c) * 64 + row : 64 * (c - nrow) + row; };
  };
  kv_issue(p, smem, koff, voff, tokfn(0), wv, lane);
  kv_issue(p, smem + 16384, koff, voff, tokfn(1), wv, lane);
  kv_issue(p, smem + 32768, koff, voff, tokfn(2), wv, lane);
  for (int c = 0; c < nch; ++c) {
    kv_wait(nch - c);
    if (c + 3 < nch) kv_issue(p, smem + ((c + 3) & 3) * 16384, koff, voff, tokfn(c + 3), wv, lane);
    const char* stage = smem + (c & 3) * 16384;
    if (c < nrow) {
      const int krow = kra + c;
      const bool a0 = krow < kra + 8, a1 = krow >= krb;
      attn_step2(stage, kc0, qf, o, lsum, [&](int qt, int t2, int rr, float s) {
        int kcol = kc0 + 16 * t2 + 4 * g + rr;
        bool valid = (kcol >= qs) && (kcol < qs + 16);
        int dc = kcol - qcol + 15; dc = dc < 0 ? 0 : (dc > 30 ? 30 : dc);
        int dr = krow - (r0 + qt) + 7; dr = dr < 0 ? 0 : (dr > 14 ? 14 : dr);
        return valid ? s + rpbl[dr * 31 + dc] - bound : -1e30f;
      }, lane, a0, a1);
    } else {
#pragma unroll
      for (int st = 0; st < 2; ++st)
        attn_step2(stage, 32 * st, qf, o, lsum, [&](int qt, int t2, int rr, float s) { return s - bound; }, lane, true, true);
    }
  }
#pragma unroll
  for (int qt = 0; qt < 2; ++qt) attn_store_out(p, o[qt], lsum[qt], qtok0 + 64 * qt, ooff, lane);
}

__device__ __forceinline__ void ph_attn(const P& p, int l, char* smem) {
  const int nitems = 1536 + (l == 0 ? 24 : 0);
  for (int it = blockIdx.x; it < nitems; it += gridDim.x) {
    if (it < 768) attn_win_item(p, l, 0, it / 6, it % 6, smem);
    else if (it < 1536) { int j = it - 768; attn_na_item(p, l, j / 6, j % 6, smem); }
    else { int j = it - 1536; attn_win_item(p, l, 1, j / 12, j % 12, smem); }
  }
}

__device__ __forceinline__ unsigned ord_key(float s) {
  unsigned u = __float_as_uint(s);
  return (u & 0x80000000u) ? ~u : (u | 0x80000000u);
}
__device__ __forceinline__ float ord_val(unsigned pk) {
  unsigned u = pk & ~127u;
  unsigned b = (u & 0x80000000u) ? (u & 0x7fffffffu) : ~u;
  return __uint_as_float(b);
}
__device__ __forceinline__ void ce_desc(unsigned& a, unsigned& b) {
  unsigned mx = a > b ? a : b, mn = a > b ? b : a;
  a = mx; b = mn;
}
__device__ __forceinline__ void sort16_desc(unsigned (&v)[16]) {
#pragma unroll
  for (int k = 2; k <= 16; k <<= 1) {
#pragma unroll
    for (int j = k >> 1; j > 0; j >>= 1) {
#pragma unroll
      for (int i = 0; i < 16; ++i) {
        int m = i ^ j;
        if (m > i) {
          if ((i & k) == 0) ce_desc(v[i], v[m]); else ce_desc(v[m], v[i]);
        }
      }
    }
  }
}
__device__ __forceinline__ void merge16_desc(unsigned (&a)[16], const unsigned (&b)[16]) {
#pragma unroll
  for (int i = 0; i < 16; ++i) { unsigned o = b[15 - i]; a[i] = a[i] > o ? a[i] : o; }
#pragma unroll
  for (int j = 8; j > 0; j >>= 1) {
#pragma unroll
    for (int i = 0; i < 16; ++i) {
      int m = i ^ j;
      if (m > i) ce_desc(a[i], a[m]);
    }
  }
}

typedef __attribute__((ext_vector_type(2))) float f32x2;
__device__ __forceinline__ void peer_convert_tail(const P& p, int l, int ntiles) {
  const int G = gridDim.x, extra = ntiles % G;
  const int first = (extra == 0) ? 0 : extra, np = G - first;
  const int idx = (int)blockIdx.x - first;
  if (idx < 0) return;
  const int q = (32768 + np - 1) / np;
  const int r0 = idx * q, r1 = min(r0 + q, 32768);
  peer_convert_rows(p, l, r0, r1);
}
__device__ __forceinline__ void ph_prep_small(const P& p) {
  for (int i = GTID; i < 2 * 128 * 128; i += GSZ) { p.k1b[i] = f2bf(p.k1[i]); p.k2b[i] = f2bf(p.k2[i]); }
}

struct EpiPeerTopk {
  __device__ __forceinline__ float pre(const P&, int, int) const { return 0.f; }
  int l;
  __device__ __forceinline__ void operator()(const P& p, f32x4 (&acc)[4][4], int m0, int n0, int wm, int wn, int lane, char* smem, float epre) const {
    const int tid = ((wm * 2 + wn) << 6) | lane, g = lane >> 4, lr = lane & 15;
    const int nt = n0 >> 7, head = nt >> 1, hf = nt & 1;
    char* qimg = smem;
    char* kimg = smem + 34816;
    float* rinvl = (float*)(smem + 69632);
    if (tid < 128) {
      float s = 0.f;
#pragma unroll
      for (int q = 0; q < 8; ++q) s += p.rowss[(size_t)q * TT + m0 + tid];
      rinvl[tid] = rsqrtf(s * (1.f / 1024.f) + EPS);
    }
    __syncthreads();
    {
      const float* bq = p.bq + (l * 2 + (m0 < LC ? 1 : 0)) * NPQ + n0 + wn * 64 + lr;
      float bqv[4];
#pragma unroll
      for (int j = 0; j < 4; ++j) bqv[j] = bq[16 * j];
      char* qw = qimg + (wm * 64 + 4 * g) * 272 + (wn * 64 + lr) * 2;
#pragma unroll
      for (int i = 0; i < 4; ++i)
#pragma unroll
        for (int r = 0; r < 4; ++r) {
          const float rv = rinvl[wm * 64 + 16 * i + 4 * g + r];
#pragma unroll
          for (int j = 0; j < 4; ++j) *(bf16_t*)(qw + (16 * i + r) * 272 + 32 * j) = f2bf(acc[i][j][r] * rv + bqv[j]);
        }
      const bf16_t* kk = (hf ? p.k2b : p.k1b) + (size_t)l * 16384 + (tid >> 4) * 128 + (tid & 15) * 8;
      char* kw = kimg + (tid >> 4) * 272 + (tid & 15) * 16;
#pragma unroll
      for (int i = 0; i < 8; ++i) *(uint4*)(kw + i * 16 * 272) = *(const uint4*)(kk + i * 16 * 128);
    }
    __syncthreads();
#pragma unroll
    for (int i = 0; i < 4; ++i)
#pragma unroll
      for (int j = 0; j < 4; ++j) acc[i][j] = (f32x4){0.f, 0.f, 0.f, 0.f};
    {
      const char* qa = qimg + (wm * 64 + lr) * 272 + g * 16;
      const char* kb = kimg + (wn * 64 + lr) * 272 + g * 16;
#pragma unroll
      for (int s = 0; s < 4; ++s) {
        bf16x8 af[4], bfr[4];
#pragma unroll
        for (int i = 0; i < 4; ++i) af[i] = *(const bf16x8*)(qa + i * 16 * 272 + s * 64);
#pragma unroll
        for (int j = 0; j < 4; ++j) bfr[j] = *(const bf16x8*)(kb + j * 16 * 272 + s * 64);
#pragma unroll
        for (int i = 0; i < 4; ++i)
#pragma unroll
          for (int j = 0; j < 4; ++j) acc[i][j] = __builtin_amdgcn_mfma_f32_16x16x32_bf16(af[i], bfr[j], acc[i][j], 0, 0, 0);
      }
    }
    __syncthreads();
    unsigned* simg = (unsigned*)smem;
    {
      unsigned* sw = simg + (wm * 64 + 4 * g) * 129 + wn * 64 + lr;
#pragma unroll
      for (int i = 0; i < 4; ++i)
#pragma unroll
        for (int r = 0; r < 4; ++r)
#pragma unroll
          for (int j = 0; j < 4; ++j)
            sw[(16 * i + r) * 129 + 16 * j] = (ord_key(acc[i][j][r]) & ~127u) | (unsigned)(wn * 64 + 16 * j + lr);
    }
    __syncthreads();
    const int row = tid & 127, half = tid >> 7;
    unsigned top[16];
    {
      const unsigned* sr = simg + row * 129 + half * 64;
#pragma unroll
      for (int k = 0; k < 16; ++k) top[k] = sr[k];
      sort16_desc(top);
#pragma unroll 1
      for (int gi = 1; gi < 4; ++gi) {
        unsigned v1[16];
#pragma unroll
        for (int k = 0; k < 16; ++k) v1[k] = sr[gi * 16 + k];
        sort16_desc(v1);
        merge16_desc(top, v1);
      }
    }
    __syncthreads();
    if (half == 1) {
#pragma unroll
      for (int k = 0; k < 16; ++k) simg[k * 128 + row] = top[k];
    }
    __syncthreads();
    if (half == 0) {
      unsigned o[16];
#pragma unroll
      for (int k = 0; k < 16; ++k) o[k] = simg[k * 128 + row];
      merge16_desc(top, o);
      uint4* dst = (uint4*)(p.pk + (((size_t)(m0 + row) * 8 + head) * 2 + hf) * 16);
#pragma unroll
      for (int k = 0; k < 4; ++k) dst[k] = make_uint4(top[4 * k], top[4 * k + 1], top[4 * k + 2], top[4 * k + 3]);
    }
  }
};

__device__ const unsigned char CAND_A[64] = {0,0,0,0,0,0,0,0,0,0,0,0,0,0,0,0, 1,1,1,1,1,1,1,1, 2,2,2,2,2, 3,3,3,3, 4,4,4, 5,5, 6,6, 7,7,
                                             8,9,10,11,12,13,14,15, 0,0,0,0,0,0,0,0,0,0,0,0,0,0};
__device__ const unsigned char CAND_B[64] = {0,1,2,3,4,5,6,7,8,9,10,11,12,13,14,15, 0,1,2,3,4,5,6,7, 0,1,2,3,4, 0,1,2,3, 0,1,2, 0,1, 0,1, 0,1,
                                             0,0,0,0,0,0,0,0, 0,0,0,0,0,0,0,0,0,0,0,0,0,0};

__device__ __forceinline__ void ph_peer_merge(const P& p, int l, int t0, char* smem) {
  const int tid = tid_opaque(), lane = tid & 63, wv = tid >> 6;
  const float* n2g = p.norm2_g + l * 1024;
  const int ca = CAND_A[lane], cb = CAND_B[lane];
  for (int tk = t0 + blockIdx.x * 4 + wv; tk < TT; tk += gridDim.x * 4) {
    const float* mod = p.mod + (l * 2 + (tk < LC ? 1 : 0)) * 6144;
    unsigned p1[8], p2[8];
    {
      const unsigned* pk = p.pk + (size_t)tk * 256;
#pragma unroll
      for (int head = 0; head < 8; ++head) { p1[head] = pk[head * 32 + ca]; p2[head] = pk[head * 32 + 16 + cb]; }
    }
    {
      const float4* xp = (const float4*)(p.xall + (size_t)tk * 1024) + lane * 4;
      float4 v[4];
      float ss = 0.f;
#pragma unroll
      for (int q = 0; q < 4; ++q) { v[q] = xp[q]; ss += v[q].x * v[q].x + v[q].y * v[q].y + v[q].z * v[q].z + v[q].w * v[q].w; }
      ss = wave_sum(ss);
      const float rinv = rsqrtf(ss * (1.f / 1024.f) + EPS);
      uint2* hp = (uint2*)(p.hb + (size_t)tk * 1024) + lane * 4;
#pragma unroll
      for (int q = 0; q < 4; ++q) {
        float4 gg = ((const float4*)n2g)[lane * 4 + q], sc = ((const float4*)(mod + 4096))[lane * 4 + q], sh = ((const float4*)(mod + 3072))[lane * 4 + q];
        float h0 = v[q].x * rinv * gg.x * (1.f + sc.x) + sh.x, h1 = v[q].y * rinv * gg.y * (1.f + sc.y) + sh.y;
        float h2 = v[q].z * rinv * gg.z * (1.f + sc.z) + sh.z, h3 = v[q].w * rinv * gg.w * (1.f + sc.w) + sh.w;
        hp[q] = make_uint2(pack2bf(h0, h1), pack2bf(h2, h3));
      }
    }
    float sums[8];
    unsigned* candk = (unsigned*)smem + wv * 512;
#pragma unroll
    for (int head = 0; head < 8; ++head) {
      sums[head] = lane < 50 ? ord_val(p1[head]) + ord_val(p2[head]) : -3.0e38f;
      candk[head * 64 + lane] = (ord_key(sums[head]) & ~63u) | (unsigned)(63 - lane);
    }
#pragma unroll
    for (int head = 0; head < 8; ++head) {
      const float sum = sums[head];
      const unsigned kme = (ord_key(sum) & ~63u) | (unsigned)(63 - lane);
      int eid = (int)(p1[head] & 127u) * 128 + (int)(p2[head] & 127u);
      int rank = 0;
#pragma unroll
      for (int m4 = 0; m4 < 13; ++m4) {
        const uint4 km = *(const uint4*)(candk + head * 64 + 4 * m4);
        rank += (km.x > kme) ? 1 : 0;
        rank += (km.y > kme) ? 1 : 0;
        rank += (km.z > kme) ? 1 : 0;
        rank += (km.w > kme) ? 1 : 0;
      }
      float mx = wave_max(sum);
      bool sel = (lane < 50) && (rank < 16);
      float e = sel ? __expf(sum - mx) : 0.f;
      float tot = wave_sum(e);
      if (sel) {
        const int n = head * 16 + rank, idx = (n & 7) * 16 + (n >> 3);
        p.el[(size_t)tk * 128 + idx] = eid;
        p.gl[(size_t)tk * 128 + idx] = e / tot;
      }
    }
  }
}

__device__ __forceinline__ uint4 bload(__amdgpu_buffer_rsrc_t rs, int voff) {
  const u32x4 v = __builtin_amdgcn_raw_buffer_load_b128(rs, voff, 0, 0);
  return make_uint4(v.x, v.y, v.z, v.w);
}
struct XcdWork { int li, np, rank, nloc; };

__device__ __forceinline__ XcdWork load_xw(const float* smem) {
  const volatile LAS unsigned* st = (const volatile LAS unsigned*)(smem + 18432);
  XcdWork xw;
  xw.nloc = __builtin_amdgcn_readfirstlane((int)st[0]); xw.np = __builtin_amdgcn_readfirstlane((int)st[1]);
  xw.rank = __builtin_amdgcn_readfirstlane((int)st[2]); xw.li = __builtin_amdgcn_readfirstlane((int)st[3]);
  return xw;
}
__device__ __forceinline__ void ph_peer_s1(const P& p, int l, int t0, const XcdWork& xw) {
  const int tid = tid_opaque(), lane = tid & 63, wv = tid >> 6, j = lane >> 3, k = lane & 7;
  const unsigned char* U = p.ub8 + (size_t)l * 16384 * 1024;
  const int step = xw.nloc * 4;
  for (int s = xw.li; s < 8; s += xw.np) {
    const unsigned roff = 128u * s + 16u * k;
    const __amdgpu_buffer_rsrc_t urs = __builtin_amdgcn_make_buffer_rsrc((void*)(U + (size_t)s * 16384 * 128), (short)0, 16384 * 128, 0x00020000);
    const int tk0 = t0 + xw.rank * 4 + wv;
    if (tk0 >= TT) continue;
    uint4 ur[2][16]; uint4 hh[2][2]; int4 en[4];
#define S1_LOAD_LIST(TK) { const int4* ep = (const int4*)(p.el + (size_t)(TK) * 128 + j * 16); _Pragma("unroll") for (int q = 0; q < 4; ++q) en[q] = ep[q]; }
#define S1_ISSUE(B, TK) {                                                                            \
      _Pragma("unroll") for (int q = 0; q < 4; ++q) {                                                \
        ur[B][4 * q + 0] = bload(urs, en[q].x * 128 + 16 * k);                  \
        ur[B][4 * q + 1] = bload(urs, en[q].y * 128 + 16 * k);                  \
        ur[B][4 * q + 2] = bload(urs, en[q].z * 128 + 16 * k);                  \
        ur[B][4 * q + 3] = bload(urs, en[q].w * 128 + 16 * k);                  \
      }                                                                                              \
      const uint4* hp = (const uint4*)(p.hb + (size_t)(TK) * 1024 + roff);                           \
      hh[B][0] = hp[0]; hh[B][1] = hp[1]; }
#define S1_CONSUME(B, TK) {                                                                          \
      float hv[16];                                                                                  \
      { unsigned w[8] = {hh[B][0].x, hh[B][0].y, hh[B][0].z, hh[B][0].w, hh[B][1].x, hh[B][1].y, hh[B][1].z, hh[B][1].w}; \
        _Pragma("unroll") for (int q = 0; q < 8; ++q) { hv[2 * q] = __uint_as_float(w[q] << 16); hv[2 * q + 1] = __uint_as_float(w[q] & 0xffff0000u); } } \
      float keep0 = 0.f, keep1 = 0.f;                                                                \
      _Pragma("unroll") for (int i = 0; i < 16; ++i) {                                               \
        unsigned w[4] = {ur[B][i].x, ur[B][i].y, ur[B][i].z, ur[B][i].w};                            \
        float dot = 0.f;                                                                             \
        _Pragma("unroll") for (int q = 0; q < 4; ++q) {                                              \
          f32x2 lo = __builtin_amdgcn_cvt_pk_f32_fp8((int)w[q], false), hi = __builtin_amdgcn_cvt_pk_f32_fp8((int)w[q], true); \
          dot += lo[0] * hv[q * 4] + lo[1] * hv[q * 4 + 1] + hi[0] * hv[q * 4 + 2] + hi[1] * hv[q * 4 + 3]; \
        }                                                                                            \
        dot += dpp_row<0xB1>(dot); dot += dpp_row<0x4E>(dot); dot += dpp_row<0x141>(dot);            \
        if (i < 8) keep0 = (k == i) ? dot : keep0; else keep1 = (k == i - 8) ? dot : keep1;          \
      }                                                                                              \
      float* pd = p.pd + ((size_t)s * TT + (TK)) * 128;                                              \
      pd[8 * k + j] = keep0; pd[8 * (k + 8) + j] = keep1; }
    S1_LOAD_LIST(tk0)
    S1_ISSUE(0, tk0)
    if (tk0 + step < TT) S1_LOAD_LIST(tk0 + step)
    for (int tk = tk0; tk < TT; tk += 2 * step) {
      const bool has1 = tk + step < TT, has2 = tk + 2 * step < TT;
      if (has1) { S1_ISSUE(1, tk + step) if (has2) S1_LOAD_LIST(tk + 2 * step) }
      S1_CONSUME(0, tk)
      if (has1) {
        if (has2) { S1_ISSUE(0, tk + 2 * step) if (tk + 3 * step < TT) S1_LOAD_LIST(tk + 3 * step) }
        S1_CONSUME(1, tk + step)
      }
    }
#undef S1_LOAD_LIST
#undef S1_ISSUE
#undef S1_CONSUME
  }
}

__device__ __forceinline__ void ph_peer_r(const P& p, int l, int t0) {
  const float* usc = p.usc + l * 16384;
  const float* vsc = p.vsc + l * 16384;
  for (int idx = GTID; idx < (TT - t0) * 32; idx += GSZ) {
    const int tk = t0 + (idx >> 5), n0 = (idx & 31) * 4;
    float4 d = make_float4(0.f, 0.f, 0.f, 0.f);
#pragma unroll
    for (int s = 0; s < 8; ++s) {
      const float4 v = *(const float4*)(p.pd + ((size_t)s * TT + tk) * 128 + n0);
      d.x += v.x; d.y += v.y; d.z += v.z; d.w += v.w;
    }
    float dv[4] = {d.x, d.y, d.z, d.w};
#pragma unroll
    for (int q = 0; q < 4; ++q) {
      const int n = n0 + q, li = (n & 7) * 16 + (n >> 3);
      const int ex = p.el[(size_t)tk * 128 + li];
      p.av[(size_t)tk * 128 + li] = p.gl[(size_t)tk * 128 + li] * gelu_f(dv[q] * usc[ex]) * vsc[ex];
    }
  }
}

__device__ __forceinline__ void ph_peer_s2(const P& p, int l, int t0, const XcdWork& xw, char* smem) {
  const int tid = tid_opaque(), lane = tid & 63, wv = tid >> 6, j = lane >> 3, k = lane & 7;
  const int ko = lane >> 3, jo = lane & 7;
  float* red = (float*)smem + wv * 1408;
  int* elb = (int*)(red + 1024);
  float* avb = red + 1024 + 256;
  const unsigned char* V = p.vb8 + (size_t)l * 16384 * 1024;
  const int step = xw.nloc * 4;
  for (int s = xw.li; s < 8; s += xw.np) {
    const __amdgpu_buffer_rsrc_t vrs = __builtin_amdgcn_make_buffer_rsrc((void*)(V + (size_t)s * 16384 * 128), (short)0, 16384 * 128, 0x00020000);
    const int dim = 128 * s + 16 * ko + 2 * jo;
    int tk = t0 + xw.rank * 4 + wv;
    if (tk >= TT) continue;
    const float2 g2l = *(const float2*)(p.mod + (l * 2 + 0) * 6144 + 5120 + dim), g2c = *(const float2*)(p.mod + (l * 2 + 1) * 6144 + 5120 + dim);
    float2 gsl = make_float2(0.f, 0.f), gsc = make_float2(0.f, 0.f);
    if (l == 0) {
      const float2 n1 = *(const float2*)(p.norm1_g + 1024 + dim);
      const float2 sl = *(const float2*)(p.mod + 2 * 6144 + 1024 + dim), sc = *(const float2*)(p.mod + 3 * 6144 + 1024 + dim);
      gsl = make_float2(n1.x * (1.f + sl.x), n1.y * (1.f + sl.y)); gsc = make_float2(n1.x * (1.f + sc.x), n1.y * (1.f + sc.y));
    }
    *(int2*)(elb + 2 * lane) = *(const int2*)(p.el + (size_t)tk * 128 + 2 * lane);
    int par = 0;
    for (; tk < TT; tk += step, par ^= 1) {
      uint4 vr[16];
      {
        const int4* eb = (const int4*)(elb + par * 128 + j * 16);
#pragma unroll
        for (int q = 0; q < 4; ++q) {
          const int4 e4 = eb[q];
          vr[4 * q + 0] = bload(vrs, e4.x * 128 + 16 * k);
          vr[4 * q + 1] = bload(vrs, e4.y * 128 + 16 * k);
          vr[4 * q + 2] = bload(vrs, e4.z * 128 + 16 * k);
          vr[4 * q + 3] = bload(vrs, e4.w * 128 + 16 * k);
        }
      }
      const float2 a2 = *(const float2*)(p.av + (size_t)tk * 128 + 2 * lane);
      const float2 g2 = tk < LC ? g2c : g2l;
      const float2 xin = *(const float2*)(p.xall + (size_t)tk * 1024 + dim);
      if (tk + step < TT) {
        const int2 e2 = *(const int2*)(p.el + (size_t)(tk + step) * 128 + 2 * lane);
        *(int2*)(elb + (par ^ 1) * 128 + 2 * lane) = e2;
      }
      *(float2*)(avb + 2 * lane) = a2;
      float acc[16];
#pragma unroll
      for (int d = 0; d < 16; ++d) acc[d] = 0.f;
#pragma unroll
      for (int i4 = 0; i4 < 4; ++i4) {
        const float4 aq = *(const float4*)(avb + j * 16 + 4 * i4);
        const float av4[4] = {aq.x, aq.y, aq.z, aq.w};
#pragma unroll
        for (int ii = 0; ii < 4; ++ii) {
          const int i = 4 * i4 + ii;
          const float a = av4[ii];
          unsigned y[4] = {vr[i].x, vr[i].y, vr[i].z, vr[i].w};
#pragma unroll
          for (int q = 0; q < 4; ++q) {
            f32x2 lo = __builtin_amdgcn_cvt_pk_f32_fp8((int)y[q], false), hi = __builtin_amdgcn_cvt_pk_f32_fp8((int)y[q], true);
            acc[q * 4] += a * lo[0]; acc[q * 4 + 1] += a * lo[1]; acc[q * 4 + 2] += a * hi[0]; acc[q * 4 + 3] += a * hi[1];
          }
          if (i + 1 < 16) asm volatile("" : "+v"(acc[0]), "+v"(vr[i + 1].x), "+v"(vr[i + 1].y), "+v"(vr[i + 1].z), "+v"(vr[i + 1].w));
        }
      }
#pragma unroll
      for (int q = 0; q < 4; ++q) *(float4*)(red + lane * 16 + 4 * q) = make_float4(acc[4 * q], acc[4 * q + 1], acc[4 * q + 2], acc[4 * q + 3]);
      float f0 = 0.f, f1 = 0.f;
#pragma unroll
      for (int jj = 0; jj < 8; ++jj) {
        const float2 t = *(const float2*)(red + (jj * 8 + ko) * 16 + 2 * jo);
        f0 += t.x; f1 += t.y;
      }
      float2 o = make_float2(xin.x + g2.x * f0, xin.y + g2.y * f1);
      if (l == 1) *(float2*)(p.out + (size_t)(tk - LC) * 1024 + dim) = o;
      else {
        *(float2*)(p.xall + (size_t)tk * 1024 + dim) = o;
        const float2 gs = tk < LC ? gsc : gsl;
        *(unsigned*)(p.hb + (size_t)tk * 1024 + dim) = pack2bf(o.x * gs.x, o.y * gs.y);
        const float ssq = wave_sum(o.x * o.x + o.y * o.y);
        if (lane == 0) p.rowss[(size_t)s * TT + tk] = ssq;
      }
    }
  }
}

#define XB_TMO      128
#define XB_XCNT(j)  (256  + 64 * (j))
#define XB_XSUB(j)  (1280 + 64 * (j))
#define XB_XGEN(j)  (2304 + 64 * (j))
#define XB_TOP      3328
#define XB_TOPGEN   3392
#define XB_RANK(j)  (3456 + 64 * (j))
#define XCD_BAR_WORDS 4480
#define XB_SPIN_CAP (1u << 22)
__device__ __forceinline__ unsigned xb_ld(unsigned* q) { return __hip_atomic_load(q, __ATOMIC_RELAXED, __HIP_MEMORY_SCOPE_AGENT); }
__device__ __forceinline__ unsigned xb_add(unsigned* q, unsigned v) { return __hip_atomic_fetch_add(q, v, __ATOMIC_RELAXED, __HIP_MEMORY_SCOPE_AGENT); }
__device__ __forceinline__ unsigned xb_xcc_id() { return (unsigned)__builtin_amdgcn_s_getreg((3 << 11) | 20) & 0xFu; }
#define XB_SPIN(cond, bar) do { unsigned _sp = 0; while (cond) { __builtin_amdgcn_s_sleep(1); \
    if ((++_sp & 255u) == 0u) { if (xb_ld(&(bar)[XB_TMO])) break; if (_sp > XB_SPIN_CAP) { atomicAdd(&(bar)[XB_TMO], 1u); break; } } } } while (0)
struct XcdBarrier { unsigned* bar; unsigned x; volatile LAS unsigned* st; };
__device__ __forceinline__ XcdBarrier xcd_barrier_post(unsigned* bar, volatile LAS unsigned* st) {
  XcdBarrier b; b.bar = bar; b.x = xb_xcc_id(); b.st = st;
  if (threadIdx.x == 0) { (void)xb_add(&bar[XB_XCNT(b.x)], 1u); st[2] = xb_add(&bar[XB_RANK(b.x)], 1u); }
  return b;
}
__device__ __forceinline__ void xcd_barrier_complete(unsigned* bar, unsigned x, unsigned& nloc, unsigned& nx, unsigned& li) {
  const unsigned G = gridDim.x * gridDim.y * gridDim.z;
  unsigned sum, cnt, mine, below, sp = 0u;
  for (;;) {
    sum = 0u; cnt = 0u; mine = 0u; below = 0u;
#pragma unroll
    for (unsigned j = 0; j < 16; ++j) { const unsigned c = xb_ld(&bar[XB_XCNT(j)]); sum += c; cnt += (c > 0u) ? 1u : 0u; mine = (j == x) ? c : mine; below += (j < x && c > 0u) ? 1u : 0u; }
    if (sum == G) break;
    __builtin_amdgcn_s_sleep(1);
    if ((++sp & 255u) == 0u) { if (xb_ld(&bar[XB_TMO])) break; if (sp > XB_SPIN_CAP) { atomicAdd(&bar[XB_TMO], 1u); break; } }
  }
  nloc = mine > 0u ? mine : 1u; nx = cnt > 0u ? cnt : 1u; li = below;
}
__device__ __forceinline__ void xcd_barrier(const XcdBarrier& b) {
  asm volatile("s_waitcnt vmcnt(0)" ::: "memory");
  __syncthreads();
  if (threadIdx.x == 0) {
    unsigned* bar = b.bar;
    __builtin_amdgcn_s_waitcnt(0);
    unsigned nloc = b.st[0], nx = b.st[1];
    if (nloc == 0u) { unsigned li; xcd_barrier_complete(bar, b.x, nloc, nx, li); b.st[0] = nloc; b.st[1] = nx; b.st[3] = li; }
    const unsigned old = xb_add(&bar[XB_XSUB(b.x)], 1u);
    const unsigned gen = old / nloc;
    if (old + 1u == (gen + 1u) * nloc) {
      __builtin_amdgcn_fence(__ATOMIC_RELEASE, "agent");
      asm volatile("s_waitcnt vmcnt(0)" ::: "memory");
      const unsigned og = xb_add(&bar[XB_TOP], 1u);
      const unsigned tg = og / nx;
      if (og + 1u == (tg + 1u) * nx) xb_add(&bar[XB_TOPGEN], 1u);
      else XB_SPIN(xb_ld(&bar[XB_TOPGEN]) == tg, bar);
      __builtin_amdgcn_fence(__ATOMIC_ACQUIRE, "agent");
      xb_add(&bar[XB_XGEN(b.x)], 1u);
      asm volatile("s_waitcnt vmcnt(0)" ::: "memory");
    } else {
      XB_SPIN(xb_ld(&bar[XB_XGEN(b.x)]) == gen, bar);
      __builtin_amdgcn_fence(__ATOMIC_ACQUIRE, "agent");
      asm volatile("s_waitcnt vmcnt(0)" ::: "memory");
    }
  }
  __syncthreads();
}

#ifndef PROBE_IV
#define PROBE_IV -1
#endif
__device__ __forceinline__ void probe_tick(int& cnt, unsigned long long* slots) {
  if (PROBE_IV >= 0) {
    if (threadIdx.x == 0 && (cnt == PROBE_IV || cnt == PROBE_IV + 1)) slots[cnt - PROBE_IV] = __builtin_amdgcn_s_memrealtime();
    cnt = __builtin_amdgcn_readfirstlane(cnt + 1);
  }
}
#define BARRIER() do { XcdBarrier xb_; xb_.bar = PP.bar; xb_.x = xb_xcc_id(); xb_.st = (volatile LAS unsigned*)(smem + 18432); xcd_barrier(xb_); probe_tick(pcnt, probe_t); } while (0)

typedef const __attribute__((address_space(4))) P* KP;
__device__ __forceinline__ P load_params(KP kp) {
#if defined(__HIP_DEVICE_COMPILE__)
  asm volatile("" : "+s"(kp));
  return *kp;
#else
  return P{};
#endif
}
#define PP load_params(kp)
__global__ void __launch_bounds__(256, 2) k_mega(P p_unused) {
  KP kp = (KP)__builtin_amdgcn_kernarg_segment_ptr();
  __shared__ __attribute__((aligned(16))) float smem[18432 + 8];
  uint4& xb_words = *(uint4*)(smem + 18432);
  cg::grid_group grid = cg::this_grid();
  if (threadIdx.x == 0) xb_words = make_uint4(0u, 0u, 0u, 0u);
  __syncthreads();
  unsigned long long* probe_t = (unsigned long long*)(smem + 18436);
  int pcnt = 0;
  asm volatile("" : "+s"(pcnt));
  probe_tick(pcnt, probe_t);
  ph_mod(PP, smem);
  ph_prep(PP, smem);
  ph_lru_prepw(PP);
  ph_rope_tab(PP);
  ph_prep_small(PP);
  grid.sync();
  probe_tick(pcnt, probe_t);
  (void)xcd_barrier_post(PP.bar, (volatile LAS unsigned*)&xb_words);
  ph_norm_mod(PP, 0, 0, 0, smem, true);
  ph_shb(PP);
  BARRIER();
#pragma unroll 1
  for (int l = 0; l < 2; ++l) {
    const int t0 = (l == 0) ? 0 : LC;
    { const P lp = PP; gemm_bf16_128(lp, lp.hb, lp.w_in_t + (size_t)l * 1024 * DIN, 1024, 0, TT, DIN, (char*)smem, EpiProj{l}, l == 0 ? 0 : -1, 15); }
    if (l == 0) {
      const P lp = PP;
      const int b0 = (130 * 18) % (int)gridDim.x;
      gemm_bf16_128(lp, lp.shb, lp.wq_t, 1024, 0, 128, NPQ, (char*)smem, EpiBias{lp.bq, NPQ}, -1, 0, b0);
      gemm_bf16_128(lp, lp.shb + 128 * 1024, lp.wq_t + (size_t)1024 * NPQ, 1024, 0, 128, NPQ, (char*)smem, EpiBias{lp.bq + 2 * NPQ, NPQ}, -1, 0, (b0 + 16) % (int)gridDim.x);
      gemm_bf16_128(lp, lp.shb + 2 * 128 * 1024, lp.w_in_t + (size_t)1024 * DIN, 1024, 0, 128, DIN, (char*)smem, EpiBias{lp.bin, DIN}, -1, 0, (b0 + 32) % (int)gridDim.x);
    }
    BARRIER();
    ph_lru<1>(PP, l, (char*)smem);
    ph_attn(PP, l, (char*)smem);
    BARRIER();
    ph_lru_carry(PP, smem);
    BARRIER();
    ph_lru<2>(PP, l, (char*)smem);
    BARRIER();
    { const P lp = PP; gemm_bf16_128(lp, lp.mixb, lp.w_out_t + (size_t)l * 1024 * 1024, 1024, t0, TT, 1024, (char*)smem, EpiResid{l}, l == 0 ? 1 : -1, 32); }
    BARRIER();
    { const P lp = PP; gemm_bf16_128(lp, lp.hb, lp.wq_t + (size_t)l * 1024 * NPQ, 1024, t0, TT, NPQ, (char*)smem, EpiPeerTopk{l}); }
    BARRIER();
    ph_peer_merge(PP, l, t0, (char*)smem);
    BARRIER();
    ph_peer_s1(PP, l, t0, load_xw(smem));
    BARRIER();
    ph_peer_r(PP, l, t0);
    BARRIER();
    ph_peer_s2(PP, l, t0, load_xw(smem), (char*)smem);
    if (l == 0) BARRIER();
  }
  if (PROBE_IV >= 0) {
    probe_tick(pcnt, probe_t);
    __syncthreads();
    if (blockIdx.x == 0 && threadIdx.x == 0) {
      const unsigned long long dt = (probe_t[1] - probe_t[0]) * 8ull, ts = __builtin_amdgcn_s_memrealtime();
      while (__builtin_amdgcn_s_memrealtime() - ts < dt) __builtin_amdgcn_s_sleep(8);
    }
  }
}

extern "C" void kernel_launch(void* const* d_in, const int* in_sizes, int n_in, void* d_out, int out_size, void* d_ws,
                              size_t ws_size, hipStream_t stream) {
  P p{};
  const float** fp = (const float**)&p;
  for (int i = 0; i < 28; ++i) fp[i] = (const float*)d_in[i];
  p.out = (float*)d_out;
  float* w = (float*)d_ws;
  size_t o = 0;
  auto carve = [&](size_t n) { float* r = w + o; o += (n + 63) & ~(size_t)63; return r; };
  p.bar = (unsigned*)carve(8192);
  p.mod = carve(4 * 6144);
  p.xall = carve((size_t)TT * 1024);
  p.proj = carve((size_t)TT * 512);
  p.projb = (bf16_t*)carve((size_t)TT * DIN / 2);
  p.mixb = (bf16_t*)carve((size_t)TT * 512);
  p.hb = (bf16_t*)carve((size_t)TT * 512);
  p.w_in_t = (bf16_t*)carve((size_t)1024 * DIN);
  p.w_out_t = (bf16_t*)carve((size_t)1024 * 1024);
  p.wq_t = (bf16_t*)carve((size_t)1024 * NPQ);
  p.lruw_t = (bf16_t*)carve((size_t)2 * 2 * 4 * 2 * 4096 / 2);
  p.lagg = carve((size_t)2 * NCHUNK * 256 * 2);
  p.lcarry = carve((size_t)2 * NCHUNK * 256);
  p.ropetab = carve(320 * 16 * 2);
  p.rowss = carve((size_t)8 * TT);
  p.bq = carve(4 * NPQ);
  p.bin = carve(2 * DIN);
  p.shb = (bf16_t*)carve(3 * 128 * 1024 / 2);
  p.el = (int*)carve((size_t)TT * 128);
  p.gl = carve((size_t)TT * 128);
  p.av = carve((size_t)TT * 128);
  p.pd = carve((size_t)8 * TT * 128);
  p.pk = (unsigned*)carve((size_t)TT * 256);
  p.ub8 = (unsigned char*)carve((size_t)2 * 16384 * 1024 / 4);
  p.vb8 = (unsigned char*)carve((size_t)2 * 16384 * 1024 / 4);
  p.usc = carve(2 * 16384);
  p.vsc = carve(2 * 16384);
  p.k1b = (bf16_t*)carve(16384);
  p.k2b = (bf16_t*)carve(16384);
  if (o * 4 > ws_size) { fprintf(stderr, "workspace too small: need %zu have %zu\n", o * 4, ws_size); return; }
  static int grid_blocks = 0;
  if (!grid_blocks) {
    int dev = 0, cus = 0, per_cu = 0;
    (void)hipGetDevice(&dev);
    (void)hipDeviceGetAttribute(&cus, hipDeviceAttributeMultiprocessorCount, dev);
    (void)hipOccupancyMaxActiveBlocksPerMultiprocessor(&per_cu, k_mega, 256, 0);
    if (per_cu > 2) per_cu = 2;
    grid_blocks = cus * per_cu;
  }
  (void)hipMemsetAsync(p.bar, 0, XCD_BAR_WORDS * 4, stream);
  void* args[] = {&p};
  hipError_t e = hipLaunchCooperativeKernel((void*)k_mega, dim3(grid_blocks), dim3(256), args, 0, stream);
  if (e != hipSuccess) fprintf(stderr, "cooperative launch failed: %s (grid %d)\n", hipGetErrorString(e), grid_blocks);
}
```

```cpp
#include <hip/hip_runtime.h>
#include <hip/hip_cooperative_groups.h>
#include <stdint.h>
#include <stdio.h>
namespace cg = cooperative_groups;

#ifndef SINGLE_LAUNCH
#define SINGLE_LAUNCH 1
#endif

constexpr int DM = 1024, SEQ = 16384, LC = 256, TT = SEQ + LC, DIN = 2304, NPQ = 2048;
constexpr int OFF_XA = 0, OFF_GA = 256, OFF_QW = 512, OFF_KW = 896, OFF_VW = 1024, OFF_QN = 1152, OFF_KN = 1536, OFF_VN = 1920;
constexpr float EPS = 1e-6f;
#define LAS __attribute__((address_space(3)))
constexpr float LOG2E = 1.4426950408889634f;
constexpr float QSCALE = 0.125f * LOG2E;

struct P {
  const float *x, *c, *ctx, *c_ctx, *w_mod, *b_mod, *norm1_g, *norm2_g, *w_in, *w_out,
      *conv_w, *conv_b, *wa, *ba, *wx, *bx, *lam, *win_qn, *win_kn, *win_sink, *na_qn, *na_kn, *rpb,
      *wq, *k1, *k2, *pu, *pv;
  float* out;
  float *mod, *xall, *proj;
  unsigned short* projb;
  unsigned* pk;
  unsigned* bar;
  unsigned short *k1b, *k2b;
  unsigned char *ub8, *vb8;
  float *usc, *vsc;
  unsigned short *hb, *mixb, *w_in_t, *w_out_t, *wq_t, *lruw_t;
  float *lagg, *lcarry, *ropetab, *rowss, *bq, *bin, *gl, *av, *pd;
  unsigned short* shb;
  int* el;
};

typedef unsigned short bf16_t;
typedef __attribute__((ext_vector_type(8))) short bf16x8;
typedef __attribute__((ext_vector_type(4))) float f32x4;
__device__ __forceinline__ unsigned pack2bf(float a, float b) {
  unsigned r;
  asm("v_cvt_pk_bf16_f32 %0, %1, %2" : "=v"(r) : "v"(a), "v"(b));
  return r;
}
__device__ __forceinline__ unsigned short f2bf(float f) { return (unsigned short)(pack2bf(f, 0.f) & 0xffffu); }
__device__ __forceinline__ float bf2f(unsigned short h) { return __uint_as_float(((unsigned)h) << 16); }


__device__ __forceinline__ float silu_f(float x) { return x / (1.f + __expf(-x)); }
__device__ __forceinline__ float sigmoid_f(float x) { return 1.f / (1.f + __expf(-x)); }
__device__ __forceinline__ float gelu_f(float x) {
  float u = 0.7978845608028654f * (x + 0.044715f * x * x * x);
  float e = __expf(2.f * u);
  float th = 1.f - 2.f / (e + 1.f);
  return 0.5f * x * (1.f + th);
}
template <int CTRL, int RMASK>
__device__ __forceinline__ float dpp_mov(float v) {
  return __int_as_float(__builtin_amdgcn_update_dpp(0, __float_as_int(v), CTRL, RMASK, 0xf, false));
}
__device__ __forceinline__ float wave_sum(float v) {
  v += dpp_mov<0xB1, 0xf>(v);
  v += dpp_mov<0x4E, 0xf>(v);
  v += dpp_mov<0x141, 0xf>(v);
  v += dpp_mov<0x140, 0xf>(v);
  v += dpp_mov<0x142, 0xa>(v);
  v += dpp_mov<0x143, 0xc>(v);
  return __int_as_float(__builtin_amdgcn_readlane(__float_as_int(v), 63));
}

__device__ __forceinline__ int tid_opaque() { int t = threadIdx.x; asm volatile("" : "+v"(t)); return t; }
#define GTID (blockIdx.x * blockDim.x + tid_opaque())
#define GSZ (gridDim.x * blockDim.x)

__device__ __forceinline__ void ph_mod(const P& p, float* smem) {
  const int tid = tid_opaque(), cl = tid & 31, ks = tid >> 5;
  for (int it = blockIdx.x; it < 2 * 192; it += gridDim.x) {
    const int nc = it % 192, l = it / 192;
    const int n = nc * 32 + cl;
    const float* w = p.w_mod + (size_t)l * 1024 * 6144 + n;
    float a0 = 0.f, a1 = 0.f;
#pragma unroll 8
    for (int i = 0; i < 128; ++i) {
      int k = i * 8 + ks;
      float wv = w[(size_t)k * 6144];
      a0 += silu_f(p.c[k]) * wv;
      a1 += silu_f(p.c_ctx[k]) * wv;
    }
    __syncthreads();
    smem[tid] = a0; smem[256 + tid] = a1;
    __syncthreads();
    if (tid < 64) {
      const int which = tid >> 5;
      float s = p.b_mod[l * 6144 + n];
#pragma unroll
      for (int q = 0; q < 8; ++q) s += smem[which * 256 + q * 32 + cl];
      p.mod[(l * 2 + which) * 6144 + n] = s;
    }
  }
}

__device__ __forceinline__ void ph_bq(const P& p, float* smem) {
  const int tid = tid_opaque(), cl = tid & 31, ks = tid >> 5;
  for (int it = blockIdx.x; it < 2 * 64; it += gridDim.x) {
    const int nc = it % 64, l = it / 64;
    const int n = nc * 32 + cl;
    const float* w = p.wq + (size_t)l * 1024 * NPQ + n;
    const float* v0 = p.mod + (l * 2 + 0) * 6144 + 3072;
    const float* v1 = p.mod + (l * 2 + 1) * 6144 + 3072;
    float a0 = 0.f, a1 = 0.f;
#pragma unroll 8
    for (int i = 0; i < 128; ++i) {
      int k = i * 8 + ks;
      float wv = w[(size_t)k * NPQ];
      a0 += v0[k] * wv;
      a1 += v1[k] * wv;
    }
    __syncthreads();
    smem[tid] = a0; smem[256 + tid] = a1;
    __syncthreads();
    if (tid < 64) {
      const int which = tid >> 5;
      float s = 0.f;
#pragma unroll
      for (int q = 0; q < 8; ++q) s += smem[which * 256 + q * 32 + cl];
      p.bq[(l * 2 + which) * NPQ + n] = s;
    }
  }
}

__device__ __forceinline__ void ph_shb(const P& p) {
  for (int idx = GTID; idx < 3 * 2 * 1024; idx += GSZ) {
    const int k = idx & 1023, which = (idx >> 10) & 1, m = idx >> 11;
    const int l = (m == 0) ? 0 : 1, off = (m == 2) ? 0 : 3072;
    p.shb[((size_t)m * 128 + which) * 1024 + k] = f2bf(p.mod[(l * 2 + which) * 6144 + off + k]);
  }
}

__device__ __forceinline__ void ph_copy_in(const P& p) {
  const float4* xs = (const float4*)p.x;
  const float4* cs = (const float4*)p.ctx;
  float4* d = (float4*)p.xall;
  for (int i = GTID; i < TT * 256; i += GSZ) d[i] = (i < LC * 256) ? cs[i] : xs[i - LC * 256];
}

__device__ __forceinline__ void ph_copy_out(const P& p) {
  const float4* s = (const float4*)(p.xall + (size_t)LC * 1024);
  float4* d = (float4*)p.out;
  for (int i = GTID; i < SEQ * 256; i += GSZ) d[i] = s[i];
}

__device__ __forceinline__ void ph_norm_mod(const P& p, int l, int which_norm, int t0, float* smem, bool from_input = false) {
  const float* g = (which_norm ? p.norm2_g : p.norm1_g) + l * 1024;
  const int sh_off = which_norm ? 3072 : 0, sc_off = which_norm ? 4096 : 1024;
  const int tid = tid_opaque();
  for (int t = t0 + blockIdx.x; t < TT; t += gridDim.x) {
    const float* mod = p.mod + (l * 2 + (t < LC ? 1 : 0)) * 6144;
    float4 v;
    if (from_input) {
      v = t < LC ? ((const float4*)(p.ctx + (size_t)t * 1024))[tid] : ((const float4*)(p.x + (size_t)(t - LC) * 1024))[tid];
    } else v = ((const float4*)(p.xall + (size_t)t * 1024))[tid];
    float ss = wave_sum(v.x * v.x + v.y * v.y + v.z * v.z + v.w * v.w);
    __syncthreads();
    if ((tid & 63) == 0) smem[tid >> 6] = ss;
    __syncthreads();
    float tot = smem[0] + smem[1] + smem[2] + smem[3];
    float rinv = rsqrtf(tot * (1.f / 1024.f) + EPS);
    float4 gg = ((const float4*)g)[tid];
    float4 sc = ((const float4*)(mod + sc_off))[tid];
    float4 sh = ((const float4*)(mod + sh_off))[tid];
    float4 o;
    o.x = v.x * rinv * gg.x * (1.f + sc.x) + sh.x;
    o.y = v.y * rinv * gg.y * (1.f + sc.y) + sh.y;
    o.z = v.z * rinv * gg.z * (1.f + sc.z) + sh.z;
    o.w = v.w * rinv * gg.w * (1.f + sc.w) + sh.w;
    ((uint2*)(p.hb + (size_t)t * 1024))[tid] = make_uint2(pack2bf(o.x, o.y), pack2bf(o.z, o.w));
  }
}

__device__ __forceinline__ void prep_transpose(const float* W, bf16_t* Wt, int K, int N, int item0, int nitems_total, float* smem) {
  (void)nitems_total;
  float(*ts)[65] = (float(*)[65])smem;
  const int tid = tid_opaque();
  const int tn = N / 64, nt = (K / 64) * tn;
  for (int it = blockIdx.x; it < nt; it += gridDim.x) {
    int k0 = (it / tn) * 64, n0 = (it % tn) * 64;
    __syncthreads();
#pragma unroll
    for (int i = 0; i < 16; ++i) {
      int r = (tid >> 6) + i * 4, c = tid & 63;
      ts[r][c] = W[(size_t)(k0 + r) * N + n0 + c];
    }
    __syncthreads();
#pragma unroll
    for (int i = 0; i < 16; ++i) {
      int r = (tid >> 6) + i * 4, c = tid & 63;
      Wt[(size_t)(n0 + r) * K + k0 + c] = f2bf(ts[c][r]);
    }
  }
  (void)item0;
}

__device__ __forceinline__ void ph_prep(const P& p, float* smem) {
  for (int l = 0; l < 2; ++l) {
    prep_transpose(p.w_in + (size_t)l * 1024 * DIN, p.w_in_t + (size_t)l * 1024 * DIN, 1024, DIN, 0, 0, smem);
    prep_transpose(p.w_out + (size_t)l * 1024 * 1024, p.w_out_t + (size_t)l * 1024 * 1024, 1024, 1024, 0, 0, smem);
    prep_transpose(p.wq + (size_t)l * 1024 * NPQ, p.wq_t + (size_t)l * 1024 * NPQ, 1024, NPQ, 0, 0, smem);
  }
}

struct EpiStoreF32 {
  __device__ __forceinline__ float pre(const P&, int, int) const { return 0.f; }
  float* C; int ldc;
  __device__ __forceinline__ void operator()(const P& p, f32x4 (&acc)[4][4], int m0, int n0, int wm, int wn, int lane, char* smem, float epre) const {
    const int mw0 = m0 + wm * 64, nw0 = n0 + wn * 64;
#pragma unroll
    for (int i = 0; i < 4; ++i)
#pragma unroll
      for (int r = 0; r < 4; ++r) {
        int row = mw0 + 16 * i + (lane >> 4) * 4 + r;
#pragma unroll
        for (int j = 0; j < 4; ++j) C[(size_t)row * ldc + nw0 + 16 * j + (lane & 15)] = acc[i][j][r];
      }
  }
};
struct EpiProjSplit {
  __device__ __forceinline__ float pre(const P&, int, int) const { return 0.f; }
  __device__ __forceinline__ void operator()(const P& p, f32x4 (&acc)[4][4], int m0, int n0, int wm, int wn, int lane, char* smem, float epre) const {
    const int mw0 = m0 + wm * 64, nw0 = n0 + wn * 64;
#pragma unroll
    for (int i = 0; i < 4; ++i)
#pragma unroll
      for (int r = 0; r < 4; ++r) {
        int row = mw0 + 16 * i + (lane >> 4) * 4 + r;
#pragma unroll
        for (int j = 0; j < 4; ++j) {
          int col = nw0 + 16 * j + (lane & 15);
          if (n0 < 512) p.proj[(size_t)row * 512 + col] = acc[i][j][r];
          else p.projb[(size_t)row * DIN + col] = f2bf(acc[i][j][r]);
        }
      }
  }
};
__device__ __forceinline__ void ph_rope_tab(const P& p) {
  for (int idx = GTID; idx < 320 * 16; idx += GSZ) {
    int v = idx >> 4, j = idx & 15;
    float inv = __expf(-(float)j * (1.f / 16.f) * 9.210340371976184f);
    float ang = (float)(v < 256 ? v : v - 256) * inv;
    float k = rintf(ang * 0.15915494309189535f);
    float r = fmaf(-k, 6.2831854820251465f, ang);
    r = fmaf(-k, -1.7484555e-07f, r);
    ((float2*)p.ropetab)[idx] = make_float2(__cosf(r), __sinf(r));
  }
}

template <int CTRL>
__device__ __forceinline__ float dpp_row(float v) {
  return __int_as_float(__builtin_amdgcn_update_dpp(0, __float_as_int(v), CTRL, 0xf, 0xf, false));
}
struct EpiBias {
  __device__ __forceinline__ float pre(const P&, int, int) const { return 0.f; }
  float* dst; int N;
  __device__ __forceinline__ void operator()(const P& p, f32x4 (&acc)[4][4], int m0, int n0, int wm, int wn, int lane, char* smem, float epre) const {
    if (wm == 0 && (lane >> 4) == 0) {
      const int col = n0 + wn * 64 + (lane & 15);
#pragma unroll
      for (int j = 0; j < 4; ++j) { dst[col + 16 * j] = acc[0][j][0]; dst[N + col + 16 * j] = acc[0][j][1]; }
    }
  }
};
struct EpiProj {
  int l;
  __device__ __forceinline__ float pre(const P& p, int m0, int tid) const {
    float s = 0.f;
    if (l == 1 && tid < 128) {
#pragma unroll
      for (int q = 0; q < 8; ++q) s += p.rowss[(size_t)q * TT + m0 + tid];
    }
    return s;
  }
  __device__ __forceinline__ void operator()(const P& p, f32x4 (&acc)[4][4], int m0, int n0, int wm, int wn, int lane, char* smem, float epre) const {
    const int g = lane >> 4, lr = lane & 15;
    const int mw0 = m0 + wm * 64, nw0 = n0 + wn * 64;
    if (l == 1) {
      float* rinvl = (float*)smem;
      const int tid = ((wm * 2 + wn) << 6) | lane;
      if (tid < 128) rinvl[tid] = rsqrtf(epre * (1.f / 1024.f) + EPS);
      __syncthreads();
      const float* bb = p.bin + (m0 < LC ? 1 : 0) * DIN + nw0 + lr;
      float bv[4];
#pragma unroll
      for (int j = 0; j < 4; ++j) bv[j] = bb[16 * j];
#pragma unroll
      for (int i = 0; i < 4; ++i)
#pragma unroll
        for (int r = 0; r < 4; ++r) {
          const float rv = rinvl[wm * 64 + 16 * i + 4 * g + r];
#pragma unroll
          for (int j = 0; j < 4; ++j) acc[i][j][r] = acc[i][j][r] * rv + bv[j];
        }
    }
    if (n0 < 512) {
#pragma unroll
      for (int i = 0; i < 4; ++i)
#pragma unroll
        for (int r = 0; r < 4; ++r) {
          int row = mw0 + 16 * i + 4 * g + r;
#pragma unroll
          for (int j = 0; j < 4; ++j) p.proj[(size_t)row * 512 + nw0 + 16 * j + lr] = acc[i][j][r];
        }
      return;
    }
    const float* gain = nullptr; bool rope = false; float scale = 1.f;
    if (nw0 < 896) { gain = p.win_qn + l * 64; rope = true; scale = QSCALE; }
    else if (nw0 < 1024) { gain = p.win_kn + l * 64; rope = true; }
    else if (nw0 < 1152) { }
    else if (nw0 < 1536) { gain = p.na_qn + l * 64; scale = QSCALE; }
    else if (nw0 < 1920) { gain = p.na_kn + l * 64; }
    rope = rope && (m0 >= LC);
    float gj[4] = {1.f, 1.f, 1.f, 1.f};
    if (gain) {
#pragma unroll
      for (int j = 0; j < 4; ++j) gj[j] = gain[16 * j + lr] * scale;
    }
#pragma unroll
    for (int i = 0; i < 4; ++i)
#pragma unroll
      for (int r = 0; r < 4; ++r) {
        const int row = mw0 + 16 * i + 4 * g + r;
        float y[4] = {acc[i][0][r], acc[i][1][r], acc[i][2][r], acc[i][3][r]};
        if (gain) {
          float ss = y[0] * y[0] + y[1] * y[1] + y[2] * y[2] + y[3] * y[3];
          ss += dpp_row<0xB1>(ss);
          ss += dpp_row<0x4E>(ss);
          ss += dpp_row<0x141>(ss);
          ss += dpp_row<0x140>(ss);
          const float rinv = rsqrtf(ss * (1.f / 64.f) + EPS);
#pragma unroll
          for (int j = 0; j < 4; ++j) y[j] *= rinv * gj[j];
        }
        if (rope) {
          const int pos = row - LC;
          const float2 tr = ((const float2*)p.ropetab)[(pos >> 6) * 16 + lr];
          const float2 tc = ((const float2*)p.ropetab)[(256 + (pos & 63)) * 16 + lr];
          float a0 = y[0] * tr.x - y[1] * tr.y, a1 = y[0] * tr.y + y[1] * tr.x;
          float a2 = y[2] * tc.x - y[3] * tc.y, a3 = y[2] * tc.y + y[3] * tc.x;
          y[0] = a0; y[1] = a1; y[2] = a2; y[3] = a3;
        }
#pragma unroll
        for (int j = 0; j < 4; ++j) p.projb[(size_t)row * DIN + nw0 + 16 * j + lr] = f2bf(y[j]);
      }
  }
};
struct EpiResid {
  __device__ __forceinline__ float pre(const P&, int, int) const { return 0.f; }
  int l;
  __device__ __forceinline__ void operator()(const P& p, f32x4 (&acc)[4][4], int m0, int n0, int wm, int wn, int lane, char* smem, float epre) const {
    float* tile = (float*)smem;
    {
      const int g = lane >> 4, lr = lane & 15;
      float* tw = tile + (wm * 64 + 4 * g) * 132 + wn * 64 + lr;
#pragma unroll
      for (int i = 0; i < 4; ++i)
#pragma unroll
        for (int r = 0; r < 4; ++r)
#pragma unroll
          for (int j = 0; j < 4; ++j) tw[(16 * i + r) * 132 + 16 * j] = acc[i][j][r];
    }
    __syncthreads();
    const int tid = ((wm * 2 + wn) << 6) | lane, c8 = tid & 15, rsub = tid >> 4;
    const float* mod = p.mod + (l * 2 + (m0 < LC ? 1 : 0)) * 6144;
    const int col = n0 + 8 * c8;
    float g1v[8], gs[8];
    {
      const float4 a0 = *(const float4*)(mod + 2048 + col), a1 = *(const float4*)(mod + 2048 + col + 4);
      const float4 s0 = *(const float4*)(mod + 4096 + col), s1 = *(const float4*)(mod + 4096 + col + 4);
      const float4 n0v = *(const float4*)(p.norm2_g + l * 1024 + col), n1v = *(const float4*)(p.norm2_g + l * 1024 + col + 4);
      g1v[0] = a0.x; g1v[1] = a0.y; g1v[2] = a0.z; g1v[3] = a0.w; g1v[4] = a1.x; g1v[5] = a1.y; g1v[6] = a1.z; g1v[7] = a1.w;
      gs[0] = n0v.x * (1.f + s0.x); gs[1] = n0v.y * (1.f + s0.y); gs[2] = n0v.z * (1.f + s0.z); gs[3] = n0v.w * (1.f + s0.w);
      gs[4] = n1v.x * (1.f + s1.x); gs[5] = n1v.y * (1.f + s1.y); gs[6] = n1v.z * (1.f + s1.z); gs[7] = n1v.w * (1.f + s1.w);
    }
#pragma unroll
    for (int it = 0; it < 8; ++it) {
      const int rl = it * 16 + rsub, row = m0 + rl;
      float4* xp = (float4*)(p.xall + (size_t)row * 1024 + col);
      const float4* xi = (l == 0) ? (const float4*)((row < LC ? p.ctx + (size_t)row * 1024 : p.x + (size_t)(row - LC) * 1024) + col) : (const float4*)xp;
      float4 x0 = xi[0], x1 = xi[1];
      const float4 t0 = *(const float4*)(tile + rl * 132 + 8 * c8), t1 = *(const float4*)(tile + rl * 132 + 8 * c8 + 4);
      x0.x += g1v[0] * t0.x; x0.y += g1v[1] * t0.y; x0.z += g1v[2] * t0.z; x0.w += g1v[3] * t0.w;
      x1.x += g1v[4] * t1.x; x1.y += g1v[5] * t1.y; x1.z += g1v[6] * t1.z; x1.w += g1v[7] * t1.w;
      xp[0] = x0; xp[1] = x1;
      float ss = x0.x * x0.x + x0.y * x0.y + x0.z * x0.z + x0.w * x0.w + x1.x * x1.x + x1.y * x1.y + x1.z * x1.z + x1.w * x1.w;
      ss += dpp_row<0xB1>(ss);
      ss += dpp_row<0x4E>(ss);
      ss += dpp_row<0x141>(ss);
      ss += dpp_row<0x140>(ss);
      *(uint4*)(p.hb + (size_t)row * 1024 + col) = make_uint4(pack2bf(x0.x * gs[0], x0.y * gs[1]), pack2bf(x0.z * gs[2], x0.w * gs[3]),
                                                            pack2bf(x1.x * gs[4], x1.y * gs[5]), pack2bf(x1.z * gs[6], x1.w * gs[7]));
      if (c8 == 0) p.rowss[(size_t)(n0 >> 7) * TT + row] = ss;
    }
  }
};

template <int CTRL, int RMASK>
__device__ __forceinline__ float dpp_mov_id(float v) {
  return __int_as_float(__builtin_amdgcn_update_dpp(__float_as_int(v), __float_as_int(v), CTRL, RMASK, 0xf, false));
}
__device__ __forceinline__ float wave_max(float v) {
  v = fmaxf(v, dpp_mov_id<0xB1, 0xf>(v));
  v = fmaxf(v, dpp_mov_id<0x4E, 0xf>(v));
  v = fmaxf(v, dpp_mov_id<0x141, 0xf>(v));
  v = fmaxf(v, dpp_mov_id<0x140, 0xf>(v));
  v = fmaxf(v, dpp_mov_id<0x142, 0xa>(v));
  v = fmaxf(v, dpp_mov_id<0x143, 0xc>(v));
  return __int_as_float(__builtin_amdgcn_readlane(__float_as_int(v), 63));
}

typedef __attribute__((ext_vector_type(2))) float f32x2;
__device__ __forceinline__ void peer_convert_rows(const P& p, int l, int r0, int r1) {
  const int tid = tid_opaque(), lane = tid & 63;
  for (int rb = r0 + (tid >> 6); rb < r1; rb += 16) {
    float4 v[4][4];
#pragma unroll
    for (int u = 0; u < 4; ++u) {
      const int r = min(rb + 4 * u, r1 - 1);
      const int tbl = r >> 14, e = r & 16383;
      const float4* src = (const float4*)((tbl ? p.pv : p.pu) + ((size_t)l * 16384 + e) * 1024) + lane * 4;
#pragma unroll
      for (int i = 0; i < 4; ++i) v[u][i] = src[i];
    }
#pragma unroll
    for (int u = 0; u < 4; ++u) {
      const int r = rb + 4 * u;
      if (r < r1) {
        const int tbl = r >> 14, e = r & 16383;
        float am = 0.f;
#pragma unroll
        for (int i = 0; i < 4; ++i)
          am = fmaxf(am, fmaxf(fmaxf(fabsf(v[u][i].x), fabsf(v[u][i].y)), fmaxf(fabsf(v[u][i].z), fabsf(v[u][i].w))));
        am = wave_max(am);
        const float sc = am > 0.f ? 224.f / am : 1.f;
        unsigned w[4];
#pragma unroll
        for (int i = 0; i < 4; ++i) {
          int t = __builtin_amdgcn_cvt_pk_fp8_f32(v[u][i].x * sc, v[u][i].y * sc, 0, false);
          t = __builtin_amdgcn_cvt_pk_fp8_f32(v[u][i].z * sc, v[u][i].w * sc, t, true);
          w[i] = (unsigned)t;
        }
        unsigned char* dst = (tbl ? p.vb8 : p.ub8) + (((size_t)l * 8 + (lane >> 3)) * 16384 + e) * 128 + (lane & 7) * 16;
        *(uint4*)dst = make_uint4(w[0], w[1], w[2], w[3]);
        if (lane == 0) (tbl ? p.vsc : p.usc)[l * 16384 + e] = am > 0.f ? am / 224.f : 1.f;
      }
    }
  }
}
__device__ __forceinline__ int gemm_swz(int row) { return (0x78 >> (((row >> 2) & 3) * 2)) & 3; }
template <class Epi>
__device__ __forceinline__ void gemm_bf16_128(const P& p, const bf16_t* __restrict__ A, const bf16_t* __restrict__ Bt, int K, int m_begin, int m_end,
                              int N, char* smem, const Epi& epi, int cl = -1, int rpt = 0, int boff = 0) {
  const int tid = tid_opaque(), lane = tid & 63, wv = __builtin_amdgcn_readfirstlane(tid >> 6), wm = wv >> 1, wn = wv & 1;
  const int tiles_n = N / 128, tiles_m = (m_end - m_begin) / 128;
  const int nk = K / 32;
  const int lr = lane & 15, g = lane >> 4;
  const int a_rd = (wm * 64 + lr) * 64 + ((g ^ gemm_swz(lr)) << 4);
  const int b_rd = 8192 + (wn * 64 + lr) * 64 + ((g ^ gemm_swz(lr)) << 4);
  const int ld_row = lane >> 2, ld_c = (lane & 3) ^ gemm_swz(ld_row);
  for (int tile = ((int)blockIdx.x + (int)gridDim.x - boff) % (int)gridDim.x; tile < tiles_m * tiles_n; tile += gridDim.x) {
    const int m0 = m_begin + (tile / tiles_n) * 128, n0 = (tile % tiles_n) * 128;
    f32x4 acc[4][4];
#pragma unroll
    for (int i = 0; i < 4; ++i)
#pragma unroll
      for (int j = 0; j < 4; ++j) acc[i][j] = (f32x4){0.f, 0.f, 0.f, 0.f};
    const bf16_t* Ag = A + (size_t)(m0 + wv * 32 + ld_row) * K + ld_c * 8;
    const bf16_t* Bg = Bt + (size_t)(n0 + wv * 32 + ld_row) * K + ld_c * 8;
    auto issue = [&](int st, int kt) {
      char* base = smem + st * 16384 + wv * 2048;
#pragma unroll
      for (int i = 0; i < 2; ++i) {
        __builtin_amdgcn_global_load_lds((const unsigned*)(Ag + (size_t)i * 16 * K + kt * 32), (__attribute__((address_space(3))) unsigned*)(base + i * 1024), 16, 0, 0);
        __builtin_amdgcn_global_load_lds((const unsigned*)(Bg + (size_t)i * 16 * K + kt * 32), (__attribute__((address_space(3))) unsigned*)(base + 8192 + i * 1024), 16, 0, 0);
      }
    };
    issue(0, 0); issue(1, 1); issue(2, 2);
    const float epre = epi.pre(p, m0, tid);
    for (int kt0 = 0; kt0 < nk; kt0 += 4) {
#pragma unroll
      for (int u = 0; u < 4; ++u) {
        const int kt = kt0 + u, rem = nk - kt;
        if (rem >= 3) asm volatile("s_waitcnt vmcnt(8) lgkmcnt(0)" ::: "memory");
        else if (rem == 2) asm volatile("s_waitcnt vmcnt(4) lgkmcnt(0)" ::: "memory");
        else asm volatile("s_waitcnt vmcnt(0) lgkmcnt(0)" ::: "memory");
        __builtin_amdgcn_s_barrier();
        if (kt + 3 < nk) issue((u + 3) & 3, kt + 3);
        bf16x8 af[4], bfr[4];
#pragma unroll
        for (int i = 0; i < 4; ++i) af[i] = *(const bf16x8*)(smem + u * 16384 + a_rd + i * 1024);
#pragma unroll
        for (int j = 0; j < 4; ++j) bfr[j] = *(const bf16x8*)(smem + u * 16384 + b_rd + j * 1024);
#pragma unroll
        for (int i = 0; i < 4; ++i)
#pragma unroll
          for (int j = 0; j < 4; ++j) acc[i][j] = __builtin_amdgcn_mfma_f32_16x16x32_bf16(af[i], bfr[j], acc[i][j], 0, 0, 0);
      }
    }
    __syncthreads();
    epi(p, acc, m0, n0, wm, wn, lane, smem, epre);
    if (cl >= 0) peer_convert_rows(p, cl, min(tile * rpt, 32768), min((tile + 1) * rpt, 32768));
    __syncthreads();
  }
}

constexpr int NCHUNK = TT / 64;
__device__ __forceinline__ int lru_pos(int dir, int c) { return dir == 0 ? c : (c < 4 ? 3 - c : 4 + (NCHUNK - 1 - c)); }

__device__ __forceinline__ void ph_lru_prepw(const P& p) {
  for (int idx = GTID; idx < 2 * 2 * 4 * 2 * 4096; idx += GSZ) {
    int d = idx & 63, e = (idx >> 6) & 63, mtx = (idx >> 12) & 1, rest = idx >> 13;
    const float* w = (mtx ? p.wx : p.wa) + (size_t)rest * 4096;
    p.lruw_t[idx] = f2bf(w[d * 64 + e]);
  }
}

template <int PASS>
__device__ __forceinline__ void lru_item(const P& p, int l, int cidx, int kb, char* smem) {
  bf16_t* u_img = (bf16_t*)smem;
  const int tid = tid_opaque(), lane = tid & 63, wv = tid >> 6, g = lane >> 4, lr = lane & 15;
  const int t0 = cidx * 64;
  const int lo = t0 < LC ? 0 : LC, hi = t0 < LC ? LC : TT;
  const int chw = 16 * wv + lr, cw = kb * 64 + chw;
  __syncthreads();
  bf16x8 wfa[2][2], wfx[2][2];
  float bav2[2], bxv2[2], lam2[2], cin[2] = {0.f, 0.f};
#pragma unroll
  for (int dir = 0; dir < 2; ++dir) {
    const int pd = l * 2 + dir;
    const bf16_t* wbase = p.lruw_t + (size_t)((pd * 4 + kb) * 2) * 4096 + chw * 64 + 8 * g;
#pragma unroll
    for (int s = 0; s < 2; ++s) { wfa[dir][s] = *(const bf16x8*)(wbase + 32 * s); wfx[dir][s] = *(const bf16x8*)(wbase + 4096 + 32 * s); }
    bav2[dir] = p.ba[pd * 256 + cw]; bxv2[dir] = p.bx[pd * 256 + cw]; lam2[dir] = p.lam[pd * 256 + cw];
    if (PASS == 2) cin[dir] = p.lcarry[((size_t)dir * NCHUNK + lru_pos(dir, cidx)) * 256 + cw];
  }
  float gav[4][4];
  if (PASS == 2) {
#pragma unroll
    for (int i = 0; i < 4; ++i)
#pragma unroll
      for (int r = 0; r < 4; ++r) gav[i][r] = p.proj[(size_t)(t0 + 16 * i + 4 * g + r) * 512 + OFF_GA + cw];
  }
  {
    const int ch = tid & 63, c = kb * 64 + ch, sg = tid >> 6;
    const float cb = p.conv_b[l * 256 + c];
    float cw4[4];
#pragma unroll
    for (int k = 0; k < 4; ++k) cw4[k] = p.conv_w[(l * 4 + k) * 256 + c];
    float xr[19];
#pragma unroll
    for (int i = 0; i < 19; ++i) {
      int tt = t0 + sg * 16 + i - 2;
      int tc = tt < lo ? lo : (tt >= hi ? hi - 1 : tt);
      float v = p.proj[(size_t)tc * 512 + OFF_XA + c];
      xr[i] = (tt >= lo && tt < hi) ? v : 0.f;
    }
#pragma unroll
    for (int i = 0; i < 16; ++i) {
      int row = sg * 16 + i;
      float acc = cb + cw4[0] * xr[i] + cw4[1] * xr[i + 1] + cw4[2] * xr[i + 2] + cw4[3] * xr[i + 3];
      u_img[row * 64 + ((((ch >> 3) ^ (row & 7)) << 3) | (ch & 7))] = f2bf(acc);
    }
  }
  __syncthreads();
  float hs0[4][4];
#pragma unroll
  for (int dir = 0; dir < 2; ++dir) {
    f32x4 ga[4], gx[4];
#pragma unroll
    for (int i = 0; i < 4; ++i) { ga[i] = (f32x4){0.f, 0.f, 0.f, 0.f}; gx[i] = (f32x4){0.f, 0.f, 0.f, 0.f}; }
#pragma unroll
    for (int s = 0; s < 2; ++s) {
      const bf16x8 ba_ = dir == 0 ? wfa[0][s] : wfa[1][s];
      const bf16x8 bx_ = dir == 0 ? wfx[0][s] : wfx[1][s];
#pragma unroll
      for (int i = 0; i < 4; ++i) {
        int row = 16 * i + lr;
        bf16x8 af = *(const bf16x8*)((const char*)u_img + row * 128 + (((4 * s + g) ^ (row & 7)) << 4));
        ga[i] = __builtin_amdgcn_mfma_f32_16x16x32_bf16(af, ba_, ga[i], 0, 0, 0);
        gx[i] = __builtin_amdgcn_mfma_f32_16x16x32_bf16(af, bx_, gx[i], 0, 0, 0);
      }
    }
    const float bav = dir == 0 ? bav2[0] : bav2[1], bxv = dir == 0 ? bxv2[0] : bxv2[1];
    const float sp = log1pf(expf(-(dir == 0 ? lam2[0] : lam2[1])));
    float av[4][4], bv[4][4];
#pragma unroll
    for (int i = 0; i < 4; ++i)
#pragma unroll
      for (int r = 0; r < 4; ++r) {
        const int row = 16 * i + 4 * g + r;
        float rr = sigmoid_f(ga[i][r] + bav), ig = sigmoid_f(gx[i][r] + bxv);
        float log_a = -8.f * rr * sp;
        float a = __expf(log_a);
        float uu = bf2f(u_img[row * 64 + ((((chw >> 3) ^ (row & 7)) << 3) | (chw & 7))]);
        const float x2 = 2.f * log_a;
        const float ser = -x2 * (1.f + x2 * (0.5f + x2 * (0.16666667f + x2 * (0.041666668f + x2 * 0.0083333338f))));
        const float om = x2 > -0.25f ? ser : 1.f - a * a;
        av[i][r] = a;
        bv[i][r] = sqrtf(om) * ig * uu;
      }
    float As[4], Bs[4];
#pragma unroll
    for (int i = 0; i < 4; ++i) {
      float A = 1.f, B = 0.f;
#pragma unroll
      for (int rr = 0; rr < 4; ++rr) { const int r = dir == 0 ? rr : 3 - rr; B = av[i][r] * B + bv[i][r]; A *= av[i][r]; }
      As[i] = A; Bs[i] = B;
    }
    const int lg = dir == 0 ? g : 3 - g;
    const int src1 = dir == 0 ? lane - 16 : lane + 16, src2 = dir == 0 ? lane - 32 : lane + 32;
    float Ai[4], Bi[4];
#pragma unroll
    for (int i = 0; i < 4; ++i) {
      float A = As[i], B = Bs[i];
      { float Ap = __shfl(A, src1 & 63), Bp = __shfl(B, src1 & 63); if (lg >= 1) { B = A * Bp + B; A = Ap * A; } }
      { float Ap = __shfl(A, src2 & 63), Bp = __shfl(B, src2 & 63); if (lg >= 2) { B = A * Bp + B; A = Ap * A; } }
      Ai[i] = A; Bi[i] = B;
    }
    const int lastl = (dir == 0 ? 48 : 0) + lr;
    float Ae[4], Be[4], At[4], Bt[4];
#pragma unroll
    for (int i = 0; i < 4; ++i) {
      float Ap = __shfl(Ai[i], src1 & 63), Bp = __shfl(Bi[i], src1 & 63);
      Ae[i] = lg >= 1 ? Ap : 1.f; Be[i] = lg >= 1 ? Bp : 0.f;
      At[i] = __shfl(Ai[i], lastl); Bt[i] = __shfl(Bi[i], lastl);
    }
    if (PASS == 1) {
      float A = 1.f, B = 0.f;
#pragma unroll
      for (int ii = 0; ii < 4; ++ii) { const int i = dir == 0 ? ii : 3 - ii; B = At[i] * B + Bt[i]; A *= At[i]; }
      if (g == 0) {
        float2* ag = (float2*)p.lagg + ((size_t)dir * NCHUNK + lru_pos(dir, cidx)) * 256 + cw;
        *ag = make_float2(A, B);
      }
    } else {
      float R = dir == 0 ? cin[0] : cin[1];
#pragma unroll
      for (int ii = 0; ii < 4; ++ii) {
        const int i = dir == 0 ? ii : 3 - ii;
        float h = Ae[i] * R + Be[i];
#pragma unroll
        for (int rr = 0; rr < 4; ++rr) {
          const int r = dir == 0 ? rr : 3 - rr;
          h = av[i][r] * h + bv[i][r];
          if (dir == 0) hs0[i][r] = h;
          else p.mixb[(size_t)(t0 + 16 * i + 4 * g + r) * 1024 + cw] = f2bf((hs0[i][r] + h) * gelu_f(gav[i][r]));
        }
        R = At[i] * R + Bt[i];
      }
    }
  }
}

__device__ __forceinline__ void ph_lru_carry(const P& p, float* smem) {
  const int tid = tid_opaque(), seg = tid >> 4, c16 = tid & 15;
  for (int blk = blockIdx.x; blk < 32; blk += gridDim.x) {
    const int dc = blk * 16 + c16, dir = dc >> 8, ch = dc & 255;
    const float2* ag = (const float2*)p.lagg + (size_t)dir * NCHUNK * 256 + ch;
    float2 v[17];
#pragma unroll
    for (int i = 0; i < 17; ++i) {
      int pos = seg * 17 + i;
      v[i] = pos < NCHUNK ? ag[(size_t)pos * 256] : make_float2(1.f, 0.f);
    }
    float A = 1.f, B = 0.f;
#pragma unroll
    for (int i = 0; i < 17; ++i) { B = v[i].x * B + v[i].y; A *= v[i].x; }
    __syncthreads();
    smem[(seg * 16 + c16) * 2] = A; smem[(seg * 16 + c16) * 2 + 1] = B;
    __syncthreads();
    float h = 0.f;
    for (int s2 = 0; s2 < seg; ++s2) h = smem[(s2 * 16 + c16) * 2] * h + smem[(s2 * 16 + c16) * 2 + 1];
    float* cr = p.lcarry + (size_t)dir * NCHUNK * 256 + ch;
#pragma unroll
    for (int i = 0; i < 17; ++i) {
      int pos = seg * 17 + i;
      if (pos < NCHUNK) cr[(size_t)pos * 256] = h;
      h = v[i].x * h + v[i].y;
    }
  }
}

template <int PASS>
__device__ __forceinline__ void ph_lru(const P& p, int l, char* smem) {
  const int c_begin = (PASS == 2 && l == 1) ? 4 : 0;
  const int nitems = (NCHUNK - c_begin) * 4;
  for (int it = blockIdx.x; it < nitems; it += gridDim.x) lru_item<PASS>(p, l, c_begin + (it >> 2), it & 3, smem);
}

typedef __attribute__((ext_vector_type(4))) short s16x4;
typedef __attribute__((ext_vector_type(4))) unsigned u32x4;

__device__ __forceinline__ void ph_qknorm_rope2(const P& p, int l) {
  const int tid_ = tid_opaque();
  const int lane = tid_ & 63;
  const int wpb = blockDim.x >> 6;
  for (int pair = blockIdx.x * wpb + (tid_ >> 6); pair < TT * 28; pair += gridDim.x * wpb) {
    int t = pair / 28, slot = pair % 28;
    const float* g = nullptr; bool rope = false; float scale = 1.f;
    if (slot < 6) { g = p.win_qn + l * 64; rope = true; scale = QSCALE; }
    else if (slot < 8) { g = p.win_kn + l * 64; rope = true; }
    else if (slot < 10) { }
    else if (slot < 16) { g = p.na_qn + l * 64; scale = QSCALE; }
    else if (slot < 22) { g = p.na_kn + l * 64; }
    rope = rope && (t >= LC);
    const size_t idx = (size_t)t * DIN + 512 + slot * 64 + lane;
    float v = bf2f(p.projb[idx]);
    float y = v;
    if (g) {
      float ss = wave_sum(v * v);
      y = v * rsqrtf(ss * (1.f / 64.f) + EPS) * g[lane];
    }
    float partner = __shfl_xor(y, 16);
    if (rope) {
      int pos = t - LC, row = pos >> 6, col = pos & 63;
      int j = lane & 15, axis = lane >> 5;
      float inv = __expf(-(float)j * (1.f / 16.f) * 9.210340371976184f);
      float ang = (float)(axis ? col : row) * inv;
      float k = rintf(ang * 0.15915494309189535f);
      float r = fmaf(-k, 6.2831854820251465f, ang);
      r = fmaf(-k, -1.7484555e-07f, r);
      float cs = __cosf(r), sn = __sinf(r);
      bool first = ((lane >> 4) & 1) == 0;
      y = first ? (y * cs - partner * sn) : (partner * sn + y * cs);
    }
    p.projb[idx] = f2bf(y * scale);
  }
}

template <class TokFn>
__device__ __forceinline__ void kv_issue(const P& p, char* stage, int koff, int voff, TokFn tok, int wv, int lane) {
#pragma unroll
  for (int i = 0; i < 2; ++i) {
    const int row = 16 * wv + 8 * i + (lane >> 3);
    const bf16_t* src = p.projb + (size_t)tok(row) * DIN + (((lane & 7) ^ (row & 7)) << 3);
    char* dst = stage + (2 * wv + i) * 1024;
    __builtin_amdgcn_global_load_lds((const unsigned*)(src + koff), (__attribute__((address_space(3))) unsigned*)dst, 16, 0, 0);
    __builtin_amdgcn_global_load_lds((const unsigned*)(src + voff), (__attribute__((address_space(3))) unsigned*)(dst + 8192), 16, 0, 0);
  }
}
__device__ __forceinline__ void kv_wait(int rem) {
  if (rem >= 3) asm volatile("s_waitcnt vmcnt(8) lgkmcnt(0)" ::: "memory");
  else if (rem == 2) asm volatile("s_waitcnt vmcnt(4) lgkmcnt(0)" ::: "memory");
  else asm volatile("s_waitcnt vmcnt(0) lgkmcnt(0)" ::: "memory");
  __builtin_amdgcn_s_barrier();
}

template <class MaskFn>
__device__ __forceinline__ void attn_step2(const char* stage, int kr0, const bf16x8 (&qf)[2][2], f32x4 (&o)[2][4], float (&lsum)[2], MaskFn mb,
                                           int lane, bool act0, bool act1) {
  const int g = lane >> 4, lr = lane & 15;
  bf16x8 kf[2][2];
#pragma unroll
  for (int t2 = 0; t2 < 2; ++t2) {
    const int row = kr0 + 16 * t2 + lr;
#pragma unroll
    for (int s = 0; s < 2; ++s) kf[t2][s] = *(const bf16x8*)(stage + row * 128 + (((4 * s + g) ^ (row & 7)) << 4));
  }
  bf16x8 pb[2];
#pragma unroll
  for (int qt = 0; qt < 2; ++qt) {
    if (qt == 0 ? act0 : act1) {
      f32x4 st[2];
#pragma unroll
      for (int t2 = 0; t2 < 2; ++t2) {
        st[t2] = (f32x4){0.f, 0.f, 0.f, 0.f};
#pragma unroll
        for (int s = 0; s < 2; ++s) st[t2] = __builtin_amdgcn_mfma_f32_16x16x32_bf16(kf[t2][s], qf[qt][s], st[t2], 0, 0, 0);
      }
#pragma unroll
      for (int t2 = 0; t2 < 2; ++t2) {
        float pv[4];
#pragma unroll
        for (int r = 0; r < 4; ++r) { pv[r] = __builtin_amdgcn_exp2f(mb(qt, t2, r, st[t2][r])); lsum[qt] += pv[r]; }
        const unsigned w0 = pack2bf(pv[0], pv[1]), w1 = pack2bf(pv[2], pv[3]);
        pb[qt][t2 * 4 + 0] = (short)(w0 & 0xffffu); pb[qt][t2 * 4 + 1] = (short)(w0 >> 16);
        pb[qt][t2 * 4 + 2] = (short)(w1 & 0xffffu); pb[qt][t2 * 4 + 3] = (short)(w1 >> 16);
      }
    }
  }
  const int q = lr >> 2, pp = lane & 3;
#pragma unroll
  for (int m = 0; m < 4; ++m) {
    bf16x8 vf;
#pragma unroll
    for (int t = 0; t < 2; ++t) {
      const int row = kr0 + 16 * t + 4 * g + q;
      const char* addr = stage + 8192 + row * 128 + (((2 * m + (pp >> 1)) ^ (row & 7)) << 4) + 8 * (pp & 1);
      s16x4 v4 = __builtin_amdgcn_ds_read_tr16_b64_v4i16((__attribute__((address_space(3))) s16x4*)addr);
      vf[4 * t + 0] = v4[0]; vf[4 * t + 1] = v4[1]; vf[4 * t + 2] = v4[2]; vf[4 * t + 3] = v4[3];
    }
    if (act0) o[0][m] = __builtin_amdgcn_mfma_f32_16x16x32_bf16(vf, pb[0], o[0][m], 0, 0, 0);
    if (act1) o[1][m] = __builtin_amdgcn_mfma_f32_16x16x32_bf16(vf, pb[1], o[1][m], 0, 0, 0);
  }
}

__device__ __forceinline__ void attn_store_out(const P& p, const f32x4 (&o)[4], float lsum, int tok, int col0, int lane) {
  const int g = lane >> 4;
  lsum += __shfl_xor(lsum, 16);
  lsum += __shfl_xor(lsum, 32);
  const float inv = 1.f / lsum;
  bf16_t* op = p.mixb + (size_t)tok * 1024 + col0 + 4 * g;
#pragma unroll
  for (int m = 0; m < 4; ++m)
    *(uint2*)(op + 16 * m) = make_uint2(pack2bf(o[m][0] * inv, o[m][1] * inv), pack2bf(o[m][2] * inv, o[m][3] * inv));
}

__device__ __forceinline__ void attn_win_item(const P& p, int l, int kind, int qb, int hs, char* smem) {
  const int tid = tid_opaque(), lane = tid & 63, wv = __builtin_amdgcn_readfirstlane(tid >> 6), g = lane >> 4, lr = lane & 15;
  int qoff, koff, voff, ooff; const float *gq, *gk; float sink2 = -1e30f; bool has_sink = false;
  if (kind == 0 || hs < 6) {
    const int h = hs, kvh = h / 3;
    qoff = OFF_QW + h * 64; koff = OFF_KW + kvh * 64; voff = OFF_VW + kvh * 64; ooff = 256 + h * 64;
    gq = p.win_qn + l * 64; gk = p.win_kn + l * 64; sink2 = p.win_sink[l * 6 + h] * LOG2E; has_sink = true;
  } else {
    const int h = hs - 6;
    qoff = OFF_QN + h * 64; koff = OFF_KN + h * 64; voff = OFF_VN + h * 64; ooff = 640 + h * 64;
    gq = p.na_qn + l * 64; gk = p.na_kn + l * 64;
  }
  float bound = 8.f * LOG2E * wave_max(fabsf(gq[lane])) * wave_max(fabsf(gk[lane])) * 1.0001f + 1e-3f;
  if (has_sink) bound = fmaxf(bound, sink2);
  const int q0 = qb * 128;
  const int qtok0 = (kind == 0 ? LC : 0) + q0 + 32 * wv;
  bf16x8 qf[2][2];
#pragma unroll
  for (int qt = 0; qt < 2; ++qt)
#pragma unroll
    for (int s = 0; s < 2; ++s) qf[qt][s] = *(const bf16x8*)(p.projb + (size_t)(qtok0 + 16 * qt + lr) * DIN + qoff + 32 * s + 8 * g);
  f32x4 o[2][4];
#pragma unroll
  for (int qt = 0; qt < 2; ++qt)
#pragma unroll
    for (int m = 0; m < 4; ++m) o[qt][m] = (f32x4){0.f, 0.f, 0.f, 0.f};
  float lsum[2] = {0.f, 0.f};
  const int nloc = (kind == 0) ? 6 : 0, nch = nloc + 4;
  auto tokfn = [&](int c) {
    return [=](int row) {
      if (c < nloc) { int pos = q0 - 128 + 64 * c + row; pos = pos < 0 ? 0 : (pos > SEQ - 1 ? SEQ - 1 : pos); return LC + pos; }
      return 64 * (c - nloc) + row;
    };
  };
  __syncthreads();
  kv_issue(p, smem, koff, voff, tokfn(0), wv, lane);
  kv_issue(p, smem + 16384, koff, voff, tokfn(1), wv, lane);
  kv_issue(p, smem + 32768, koff, voff, tokfn(2), wv, lane);
  for (int c = 0; c < nch; ++c) {
    kv_wait(nch - c);
    if (c + 3 < nch) kv_issue(p, smem + ((c + 3) & 3) * 16384, koff, voff, tokfn(c + 3), wv, lane);
    const char* stage = smem + (c & 3) * 16384;
    if (c < nloc) {
      const int qw0 = q0 + 32 * wv;
#pragma unroll
      for (int st = 0; st < 2; ++st) {
        const int kbase = q0 - 128 + 64 * c + 32 * st;
        const bool a0 = !(kbase - (qw0 + 15) > 128 || qw0 - (kbase + 31) > 128) && (kbase + 31 >= 0) && (kbase < SEQ);
        const bool a1 = !(kbase - (qw0 + 31) > 128 || (qw0 + 16) - (kbase + 31) > 128) && (kbase + 31 >= 0) && (kbase < SEQ);
        const bool allv = (kbase >= 0) && (kbase + 31 < SEQ) && (kbase + 31 - qw0 <= 128) && (qw0 + 31 - kbase <= 128);
        if (allv)
          attn_step2(stage, 32 * st, qf, o, lsum, [&](int qt, int t2, int r, float s) { return s - bound; }, lane, true, true);
        else if (a0 || a1)
          attn_step2(stage, 32 * st, qf, o, lsum, [&](int qt, int t2, int r, float s) {
            int kpos = kbase + 16 * t2 + 4 * g + r;
            int dlt = kpos - (qw0 + 16 * qt + lr); dlt = dlt < 0 ? -dlt : dlt;
            bool valid = (kpos >= 0) && (kpos < SEQ) && (dlt <= 128);
            return valid ? s - bound : -1e30f;
          }, lane, a0, a1);
      }
    } else {
#pragma unroll
      for (int st = 0; st < 2; ++st)
        attn_step2(stage, 32 * st, qf, o, lsum, [&](int qt, int t2, int r, float s) { return s - bound; }, lane, true, true);
    }
  }
#pragma unroll
  for (int qt = 0; qt < 2; ++qt) {
    float ls = lsum[qt];
    if (has_sink && g == 0) ls += __builtin_amdgcn_exp2f(sink2 - bound);
    attn_store_out(p, o[qt], ls, qtok0 + 16 * qt + lr, ooff, lane);
  }
}

__device__ __forceinline__ void attn_na_item(const P& p, int l, int rp, int h, char* smem) {
  const int tid = tid_opaque(), lane = tid & 63, wv = __builtin_amdgcn_readfirstlane(tid >> 6), g = lane >> 4, lr = lane & 15;
  const int qoff = OFF_QN + h * 64, koff = OFF_KN + h * 64, voff = OFF_VN + h * 64, ooff = 640 + h * 64;
  float* rpbl = (float*)(smem + 65536);
  const float* rpbg = p.rpb + (size_t)(l * 6 + h) * 465;
  float bmax = 0.f;
  __syncthreads();
  for (int i = tid; i < 465; i += 256) rpbl[i] = rpbg[i] * LOG2E;
  for (int i = lane; i < 465; i += 64) bmax = fmaxf(bmax, fabsf(rpbg[i]) * LOG2E);
  bmax = wave_max(bmax);
  const float bound = 8.f * LOG2E * wave_max(fabsf(p.na_qn[l * 64 + lane])) * wave_max(fabsf(p.na_kn[l * 64 + lane])) * 1.0001f + bmax + 1e-3f;
  const int r0 = 2 * rp;
  const int qcol = 16 * wv + lr;
  const int qtok0 = LC + r0 * 64 + qcol;
  const int kra = min(max(r0 - 4, 0), 248), krb = min(max(r0 + 1 - 4, 0), 248);
  const int nrow = krb + 8 - kra, nch = nrow + 4;
  const int kc0 = min(max(16 * wv - 8, 0), 32);
  const int qs = min(max(qcol - 8, 0), 48);
  bf16x8 qf[2][2];
#pragma unroll
  for (int qt = 0; qt < 2; ++qt)
#pragma unroll
    for (int s = 0; s < 2; ++s) qf[qt][s] = *(const bf16x8*)(p.projb + (size_t)(qtok0 + 64 * qt) * DIN + qoff + 32 * s + 8 * g);
  f32x4 o[2][4];
#pragma unroll
  for (int qt = 0; qt < 2; ++qt)
#pragma unroll
    for (int m = 0; m < 4; ++m) o[qt][m] = (f32x4){0.f, 0.f, 0.f, 0.f};
  float lsum[2] = {0.f, 0.f};
  auto tokfn = [&](int c) {
    return [=](int row) { return c < nrow ? LC + (kra + c) * 64 + row : 64 * (c - nrow) + row; };
  };
  kv_issue(p, smem, koff, voff, tokfn(0), wv, lane);
  kv_issue(p, smem + 16384, koff, voff, tokfn(1), wv, lane);
  kv_issue(p, smem + 32768, koff, voff, tokfn(2), wv, lane);
  for (int c = 0; c < nch; ++c) {
    kv_wait(nch - c);
    if (c + 3 < nch) kv_issue(p, smem + ((c + 3) & 3) * 16384, koff, voff, tokfn(c + 3), wv, lane);
    const char* stage = smem + (c & 3) * 16384;
    if (c < nrow) {
      const int krow = kra + c;
      const bool a0 = krow < kra + 8, a1 = krow >= krb;
      attn_step2(stage, kc0, qf, o, lsum, [&](int qt, int t2, int rr, float s) {
        int kcol = kc0 + 16 * t2 + 4 * g + rr;
        bool valid = (kcol >= qs) && (kcol < qs + 16);
        int dc = kcol - qcol + 15; dc = dc < 0 ? 0 : (dc > 30 ? 30 : dc);
        int dr = krow - (r0 + qt) + 7; dr = dr < 0 ? 0 : (dr > 14 ? 14 : dr);
        return valid ? s + rpbl[dr * 31 + dc] - bound : -1e30f;
      }, lane, a0, a1);
    } else {
#pragma unroll
      for (int st = 0; st < 2; ++st)
        attn_step2(stage, 32 * st, qf, o, lsum, [&](int qt, int t2, int rr, float s) { return s - bound; }, lane, true, true);
    }
  }
#pragma unroll
  for (int qt = 0; qt < 2; ++qt) attn_store_out(p, o[qt], lsum[qt], qtok0 + 64 * qt, ooff, lane);
}

__device__ __forceinline__ void ph_attn(const P& p, int l, char* smem) {
  const int nitems = 1536 + (l == 0 ? 24 : 0);
  for (int it = blockIdx.x; it < nitems; it += gridDim.x) {
    if (it < 768) attn_win_item(p, l, 0, it / 6, it % 6, smem);
    else if (it < 1536) { int j = it - 768; attn_na_item(p, l, j / 6, j % 6, smem); }
    else { int j = it - 1536; attn_win_item(p, l, 1, j / 12, j % 12, smem); }
  }
}

__device__ __forceinline__ unsigned ord_key(float s) {
  unsigned u = __float_as_uint(s);
  return (u & 0x80000000u) ? ~u : (u | 0x80000000u);
}
__device__ __forceinline__ float ord_val(unsigned pk) {
  unsigned u = pk & ~127u;
  unsigned b = (u & 0x80000000u) ? (u & 0x7fffffffu) : ~u;
  return __uint_as_float(b);
}
__device__ __forceinline__ void ce_desc(unsigned& a, unsigned& b) {
  unsigned mx = a > b ? a : b, mn = a > b ? b : a;
  a = mx; b = mn;
}
__device__ __forceinline__ void sort16_desc(unsigned (&v)[16]) {
#pragma unroll
  for (int k = 2; k <= 16; k <<= 1) {
#pragma unroll
    for (int j = k >> 1; j > 0; j >>= 1) {
#pragma unroll
      for (int i = 0; i < 16; ++i) {
        int m = i ^ j;
        if (m > i) {
          if ((i & k) == 0) ce_desc(v[i], v[m]); else ce_desc(v[m], v[i]);
        }
      }
    }
  }
}
__device__ __forceinline__ void merge16_desc(unsigned (&a)[16], const unsigned (&b)[16]) {
#pragma unroll
  for (int i = 0; i < 16; ++i) { unsigned o = b[15 - i]; a[i] = a[i] > o ? a[i] : o; }
#pragma unroll
  for (int j = 8; j > 0; j >>= 1) {
#pragma unroll
    for (int i = 0; i < 16; ++i) {
      int m = i ^ j;
      if (m > i) ce_desc(a[i], a[m]);
    }
  }
}

typedef __attribute__((ext_vector_type(2))) float f32x2;
__device__ __forceinline__ void peer_convert_tail(const P& p, int l, int ntiles) {
  const int G = gridDim.x, extra = ntiles % G;
  const int first = (extra == 0) ? 0 : extra, np = G - first;
  const int idx = (int)blockIdx.x - first;
  if (idx < 0) return;
  const int q = (32768 + np - 1) / np;
  const int r0 = idx * q, r1 = min(r0 + q, 32768);
  peer_convert_rows(p, l, r0, r1);
}
__device__ __forceinline__ void ph_prep_small(const P& p) {
  for (int i = GTID; i < 2 * 128 * 128; i += GSZ) { p.k1b[i] = f2bf(p.k1[i]); p.k2b[i] = f2bf(p.k2[i]); }
}

struct EpiPeerTopk {
  int l;
  __device__ __forceinline__ float pre(const P& p, int m0, int tid) const {
    float s = 0.f;
    if (tid < 128) {
#pragma unroll
      for (int q = 0; q < 8; ++q) s += p.rowss[(size_t)q * TT + m0 + tid];
    }
    return s;
  }
  __device__ __forceinline__ void operator()(const P& p, f32x4 (&acc)[4][4], int m0, int n0, int wm, int wn, int lane, char* smem, float epre) const {
    const int tid = ((wm * 2 + wn) << 6) | lane, g = lane >> 4, lr = lane & 15;
    const int nt = n0 >> 7, head = nt >> 1, hf = nt & 1;
    char* qimg = smem;
    char* kimg = smem + 34816;
    float* rinvl = (float*)(smem + 69632);
    if (tid < 128) rinvl[tid] = rsqrtf(epre * (1.f / 1024.f) + EPS);
    __syncthreads();
    {
      const float* bq = p.bq + (l * 2 + (m0 < LC ? 1 : 0)) * NPQ + n0 + wn * 64 + lr;
      float bqv[4];
#pragma unroll
      for (int j = 0; j < 4; ++j) bqv[j] = bq[16 * j];
      char* qw = qimg + (wm * 64 + 4 * g) * 272 + (wn * 64 + lr) * 2;
#pragma unroll
      for (int i = 0; i < 4; ++i)
#pragma unroll
        for (int r = 0; r < 4; ++r) {
          const float rv = rinvl[wm * 64 + 16 * i + 4 * g + r];
#pragma unroll
          for (int j = 0; j < 4; ++j) *(bf16_t*)(qw + (16 * i + r) * 272 + 32 * j) = f2bf(acc[i][j][r] * rv + bqv[j]);
        }
      const bf16_t* kk = (hf ? p.k2b : p.k1b) + (size_t)l * 16384 + (tid >> 4) * 128 + (tid & 15) * 8;
      char* kw = kimg + (tid >> 4) * 272 + (tid & 15) * 16;
#pragma unroll
      for (int i = 0; i < 8; ++i) *(uint4*)(kw + i * 16 * 272) = *(const uint4*)(kk + i * 16 * 128);
    }
    __syncthreads();
#pragma unroll
    for (int i = 0; i < 4; ++i)
#pragma unroll
      for (int j = 0; j < 4; ++j) acc[i][j] = (f32x4){0.f, 0.f, 0.f, 0.f};
    {
      const char* qa = qimg + (wm * 64 + lr) * 272 + g * 16;
      const char* kb = kimg + (wn * 64 + lr) * 272 + g * 16;
#pragma unroll
      for (int s = 0; s < 4; ++s) {
        bf16x8 af[4], bfr[4];
#pragma unroll
        for (int i = 0; i < 4; ++i) af[i] = *(const bf16x8*)(qa + i * 16 * 272 + s * 64);
#pragma unroll
        for (int j = 0; j < 4; ++j) bfr[j] = *(const bf16x8*)(kb + j * 16 * 272 + s * 64);
#pragma unroll
        for (int i = 0; i < 4; ++i)
#pragma unroll
          for (int j = 0; j < 4; ++j) acc[i][j] = __builtin_amdgcn_mfma_f32_16x16x32_bf16(af[i], bfr[j], acc[i][j], 0, 0, 0);
      }
    }
    __syncthreads();
    unsigned* simg = (unsigned*)smem;
    {
      unsigned* sw = simg + (wm * 64 + 4 * g) * 129 + wn * 64 + lr;
#pragma unroll
      for (int i = 0; i < 4; ++i)
#pragma unroll
        for (int r = 0; r < 4; ++r)
#pragma unroll
          for (int j = 0; j < 4; ++j)
            sw[(16 * i + r) * 129 + 16 * j] = (ord_key(acc[i][j][r]) & ~127u) | (unsigned)(wn * 64 + 16 * j + lr);
    }
    __syncthreads();
    const int row = tid & 127, half = tid >> 7;
    unsigned top[16];
    {
      const unsigned* sr = simg + row * 129 + half * 64;
#pragma unroll
      for (int k = 0; k < 16; ++k) top[k] = sr[k];
      sort16_desc(top);
#pragma unroll 1
      for (int gi = 1; gi < 4; ++gi) {
        unsigned v1[16];
#pragma unroll
        for (int k = 0; k < 16; ++k) v1[k] = sr[gi * 16 + k];
        sort16_desc(v1);
        merge16_desc(top, v1);
      }
    }
    __syncthreads();
    if (half == 1) {
#pragma unroll
      for (int k = 0; k < 16; ++k) simg[k * 128 + row] = top[k];
    }
    __syncthreads();
    if (half == 0) {
      unsigned o[16];
#pragma unroll
      for (int k = 0; k < 16; ++k) o[k] = simg[k * 128 + row];
      merge16_desc(top, o);
      uint4* dst = (uint4*)(p.pk + (((size_t)(m0 + row) * 8 + head) * 2 + hf) * 16);
#pragma unroll
      for (int k = 0; k < 4; ++k) dst[k] = make_uint4(top[4 * k], top[4 * k + 1], top[4 * k + 2], top[4 * k + 3]);
    }
  }
};

__device__ const unsigned char CAND_A[64] = {0,0,0,0,0,0,0,0,0,0,0,0,0,0,0,0, 1,1,1,1,1,1,1,1, 2,2,2,2,2, 3,3,3,3, 4,4,4, 5,5, 6,6, 7,7,
                                             8,9,10,11,12,13,14,15, 0,0,0,0,0,0,0,0,0,0,0,0,0,0};
__device__ const unsigned char CAND_B[64] = {0,1,2,3,4,5,6,7,8,9,10,11,12,13,14,15, 0,1,2,3,4,5,6,7, 0,1,2,3,4, 0,1,2,3, 0,1,2, 0,1, 0,1, 0,1,
                                             0,0,0,0,0,0,0,0, 0,0,0,0,0,0,0,0,0,0,0,0,0,0};

__device__ __forceinline__ void ph_peer_merge(const P& p, int l, int t0, char* smem) {
  const int tid = tid_opaque(), lane = tid & 63, wv = tid >> 6;
  const float* n2g = p.norm2_g + l * 1024;
  const int ca = CAND_A[lane], cb = CAND_B[lane];
  for (int tk = t0 + blockIdx.x * 4 + wv; tk < TT; tk += gridDim.x * 4) {
    const float* mod = p.mod + (l * 2 + (tk < LC ? 1 : 0)) * 6144;
    unsigned p1[8], p2[8];
    {
      const unsigned* pk = p.pk + (size_t)tk * 256;
#pragma unroll
      for (int head = 0; head < 8; ++head) { p1[head] = pk[head * 32 + ca]; p2[head] = pk[head * 32 + 16 + cb]; }
    }
    {
      const float4* xp = (const float4*)(p.xall + (size_t)tk * 1024) + lane * 4;
      float4 v[4];
      float ss = 0.f;
#pragma unroll
      for (int q = 0; q < 4; ++q) { v[q] = xp[q]; ss += v[q].x * v[q].x + v[q].y * v[q].y + v[q].z * v[q].z + v[q].w * v[q].w; }
      ss = wave_sum(ss);
      const float rinv = rsqrtf(ss * (1.f / 1024.f) + EPS);
      uint2* hp = (uint2*)(p.hb + (size_t)tk * 1024) + lane * 4;
#pragma unroll
      for (int q = 0; q < 4; ++q) {
        float4 gg = ((const float4*)n2g)[lane * 4 + q], sc = ((const float4*)(mod + 4096))[lane * 4 + q], sh = ((const float4*)(mod + 3072))[lane * 4 + q];
        float h0 = v[q].x * rinv * gg.x * (1.f + sc.x) + sh.x, h1 = v[q].y * rinv * gg.y * (1.f + sc.y) + sh.y;
        float h2 = v[q].z * rinv * gg.z * (1.f + sc.z) + sh.z, h3 = v[q].w * rinv * gg.w * (1.f + sc.w) + sh.w;
        hp[q] = make_uint2(pack2bf(h0, h1), pack2bf(h2, h3));
      }
    }
    float sums[8];
    unsigned* candk = (unsigned*)smem + wv * 512;
#pragma unroll
    for (int head = 0; head < 8; ++head) {
      sums[head] = lane < 50 ? ord_val(p1[head]) + ord_val(p2[head]) : -3.0e38f;
      candk[head * 64 + lane] = (ord_key(sums[head]) & ~63u) | (unsigned)(63 - lane);
    }
#pragma unroll
    for (int head = 0; head < 8; ++head) {
      const float sum = sums[head];
      const unsigned kme = (ord_key(sum) & ~63u) | (unsigned)(63 - lane);
      int eid = (int)(p1[head] & 127u) * 128 + (int)(p2[head] & 127u);
      int rank = 0;
#pragma unroll
      for (int m4 = 0; m4 < 13; ++m4) {
        const uint4 km = *(const uint4*)(candk + head * 64 + 4 * m4);
        rank += (km.x > kme) ? 1 : 0;
        rank += (km.y > kme) ? 1 : 0;
        rank += (km.z > kme) ? 1 : 0;
        rank += (km.w > kme) ? 1 : 0;
      }
      float mx = wave_max(sum);
      bool sel = (lane < 50) && (rank < 16);
      float e = sel ? __expf(sum - mx) : 0.f;
      float tot = wave_sum(e);
      if (sel) {
        const int n = head * 16 + rank, idx = (n & 7) * 16 + (n >> 3);
        p.el[(size_t)tk * 128 + idx] = eid;
        p.gl[(size_t)tk * 128 + idx] = e / tot;
      }
    }
  }
}

__device__ __forceinline__ uint4 bload(__amdgpu_buffer_rsrc_t rs, int voff) {
  const u32x4 v = __builtin_amdgcn_raw_buffer_load_b128(rs, voff, 0, 0);
  return make_uint4(v.x, v.y, v.z, v.w);
}
struct XcdWork { int li, np, rank, nloc; };

__device__ __forceinline__ XcdWork load_xw(const float* smem) {
  const volatile LAS unsigned* st = (const volatile LAS unsigned*)(smem + 18432);
  XcdWork xw;
  xw.nloc = __builtin_amdgcn_readfirstlane((int)st[0]); xw.np = __builtin_amdgcn_readfirstlane((int)st[1]);
  xw.rank = __builtin_amdgcn_readfirstlane((int)st[2]); xw.li = __builtin_amdgcn_readfirstlane((int)st[3]);
  return xw;
}
__device__ __forceinline__ void ph_peer_s1(const P& p, int l, int t0, const XcdWork& xw) {
  const int tid = tid_opaque(), lane = tid & 63, wv = tid >> 6, j = lane >> 3, k = lane & 7;
  const unsigned char* U = p.ub8 + (size_t)l * 16384 * 1024;
  const int step = xw.nloc * 4;
  for (int s = xw.li; s < 8; s += xw.np) {
    const unsigned roff = 128u * s + 16u * k;
    const __amdgpu_buffer_rsrc_t urs = __builtin_amdgcn_make_buffer_rsrc((void*)(U + (size_t)s * 16384 * 128), (short)0, 16384 * 128, 0x00020000);
    const int tk0 = t0 + xw.rank * 4 + wv;
    if (tk0 >= TT) continue;
    uint4 ur[2][16]; uint4 hh[2][2]; int4 en[4];
#define S1_LOAD_LIST(TK) { const int4* ep = (const int4*)(p.el + (size_t)(TK) * 128 + j * 16); _Pragma("unroll") for (int q = 0; q < 4; ++q) en[q] = ep[q]; }
#define S1_ISSUE(B, TK) {                                                                            \
      _Pragma("unroll") for (int q = 0; q < 4; ++q) {                                                \
        ur[B][4 * q + 0] = bload(urs, en[q].x * 128 + 16 * k);                  \
        ur[B][4 * q + 1] = bload(urs, en[q].y * 128 + 16 * k);                  \
        ur[B][4 * q + 2] = bload(urs, en[q].z * 128 + 16 * k);                  \
        ur[B][4 * q + 3] = bload(urs, en[q].w * 128 + 16 * k);                  \
      }                                                                                              \
      const uint4* hp = (const uint4*)(p.hb + (size_t)(TK) * 1024 + roff);                           \
      hh[B][0] = hp[0]; hh[B][1] = hp[1]; }
#define S1_CONSUME(B, TK) {                                                                          \
      float hv[16];                                                                                  \
      { unsigned w[8] = {hh[B][0].x, hh[B][0].y, hh[B][0].z, hh[B][0].w, hh[B][1].x, hh[B][1].y, hh[B][1].z, hh[B][1].w}; \
        _Pragma("unroll") for (int q = 0; q < 8; ++q) { hv[2 * q] = __uint_as_float(w[q] << 16); hv[2 * q + 1] = __uint_as_float(w[q] & 0xffff0000u); } } \
      float keep0 = 0.f, keep1 = 0.f;                                                                \
      _Pragma("unroll") for (int i = 0; i < 16; ++i) {                                               \
        unsigned w[4] = {ur[B][i].x, ur[B][i].y, ur[B][i].z, ur[B][i].w};                            \
        float dot = 0.f;                                                                             \
        _Pragma("unroll") for (int q = 0; q < 4; ++q) {                                              \
          f32x2 lo = __builtin_amdgcn_cvt_pk_f32_fp8((int)w[q], false), hi = __builtin_amdgcn_cvt_pk_f32_fp8((int)w[q], true); \
          dot += lo[0] * hv[q * 4] + lo[1] * hv[q * 4 + 1] + hi[0] * hv[q * 4 + 2] + hi[1] * hv[q * 4 + 3]; \
        }                                                                                            \
        dot += dpp_row<0xB1>(dot); dot += dpp_row<0x4E>(dot); dot += dpp_row<0x141>(dot);            \
        if (i < 8) keep0 = (k == i) ? dot : keep0; else keep1 = (k == i - 8) ? dot : keep1;          \
      }                                                                                              \
      float* pd = p.pd + ((size_t)s * TT + (TK)) * 128;                                              \
      pd[8 * k + j] = keep0; pd[8 * (k + 8) + j] = keep1; }
    S1_LOAD_LIST(tk0)
    S1_ISSUE(0, tk0)
    if (tk0 + step < TT) S1_LOAD_LIST(tk0 + step)
    for (int tk = tk0; tk < TT; tk += 2 * step) {
      const bool has1 = tk + step < TT, has2 = tk + 2 * step < TT;
      if (has1) { S1_ISSUE(1, tk + step) if (has2) S1_LOAD_LIST(tk + 2 * step) }
      S1_CONSUME(0, tk)
      if (has1) {
        if (has2) { S1_ISSUE(0, tk + 2 * step) if (tk + 3 * step < TT) S1_LOAD_LIST(tk + 3 * step) }
        S1_CONSUME(1, tk + step)
      }
    }
#undef S1_LOAD_LIST
#undef S1_ISSUE
#undef S1_CONSUME
  }
}

__device__ __forceinline__ void ph_peer_r(const P& p, int l, int t0) {
  const float* usc = p.usc + l * 16384;
  const float* vsc = p.vsc + l * 16384;
  for (int idx = GTID; idx < (TT - t0) * 32; idx += GSZ) {
    const int tk = t0 + (idx >> 5), n0 = (idx & 31) * 4;
    float4 d = make_float4(0.f, 0.f, 0.f, 0.f);
#pragma unroll
    for (int s = 0; s < 8; ++s) {
      const float4 v = *(const float4*)(p.pd + ((size_t)s * TT + tk) * 128 + n0);
      d.x += v.x; d.y += v.y; d.z += v.z; d.w += v.w;
    }
    float dv[4] = {d.x, d.y, d.z, d.w};
#pragma unroll
    for (int q = 0; q < 4; ++q) {
      const int n = n0 + q, li = (n & 7) * 16 + (n >> 3);
      const int ex = p.el[(size_t)tk * 128 + li];
      p.av[(size_t)tk * 128 + li] = p.gl[(size_t)tk * 128 + li] * gelu_f(dv[q] * usc[ex]) * vsc[ex];
    }
  }
}

__device__ __forceinline__ void ph_peer_s2(const P& p, int l, int t0, const XcdWork& xw, char* smem) {
  const int tid = tid_opaque(), lane = tid & 63, wv = tid >> 6, j = lane >> 3, k = lane & 7;
  const int ko = lane >> 3, jo = lane & 7;
  float* red = (float*)smem + wv * 1408;
  int* elb = (int*)(red + 1024);
  float* avb = red + 1024 + 256;
  const unsigned char* V = p.vb8 + (size_t)l * 16384 * 1024;
  const int step = xw.nloc * 4;
  for (int s = xw.li; s < 8; s += xw.np) {
    const __amdgpu_buffer_rsrc_t vrs = __builtin_amdgcn_make_buffer_rsrc((void*)(V + (size_t)s * 16384 * 128), (short)0, 16384 * 128, 0x00020000);
    const int dim = 128 * s + 16 * ko + 2 * jo;
    int tk = t0 + xw.rank * 4 + wv;
    if (tk >= TT) continue;
    const float2 g2l = *(const float2*)(p.mod + (l * 2 + 0) * 6144 + 5120 + dim), g2c = *(const float2*)(p.mod + (l * 2 + 1) * 6144 + 5120 + dim);
    float2 gsl = make_float2(0.f, 0.f), gsc = make_float2(0.f, 0.f);
    if (l == 0) {
      const float2 n1 = *(const float2*)(p.norm1_g + 1024 + dim);
      const float2 sl = *(const float2*)(p.mod + 2 * 6144 + 1024 + dim), sc = *(const float2*)(p.mod + 3 * 6144 + 1024 + dim);
      gsl = make_float2(n1.x * (1.f + sl.x), n1.y * (1.f + sl.y)); gsc = make_float2(n1.x * (1.f + sc.x), n1.y * (1.f + sc.y));
    }
    *(int2*)(elb + 2 * lane) = *(const int2*)(p.el + (size_t)tk * 128 + 2 * lane);
    int par = 0;
    for (; tk < TT; tk += step, par ^= 1) {
      uint4 vr[16];
      {
        const int4* eb = (const int4*)(elb + par * 128 + j * 16);
#pragma unroll
        for (int q = 0; q < 4; ++q) {
          const int4 e4 = eb[q];
          vr[4 * q + 0] = bload(vrs, e4.x * 128 + 16 * k);
          vr[4 * q + 1] = bload(vrs, e4.y * 128 + 16 * k);
          vr[4 * q + 2] = bload(vrs, e4.z * 128 + 16 * k);
          vr[4 * q + 3] = bload(vrs, e4.w * 128 + 16 * k);
        }
      }
      const float2 a2 = *(const float2*)(p.av + (size_t)tk * 128 + 2 * lane);
      const float2 g2 = tk < LC ? g2c : g2l;
      const float2 xin = *(const float2*)(p.xall + (size_t)tk * 1024 + dim);
      if (tk + step < TT) {
        const int2 e2 = *(const int2*)(p.el + (size_t)(tk + step) * 128 + 2 * lane);
        *(int2*)(elb + (par ^ 1) * 128 + 2 * lane) = e2;
      }
      *(float2*)(avb + 2 * lane) = a2;
      float acc[16];
#pragma unroll
      for (int d = 0; d < 16; ++d) acc[d] = 0.f;
#pragma unroll
      for (int i4 = 0; i4 < 4; ++i4) {
        const float4 aq = *(const float4*)(avb + j * 16 + 4 * i4);
        const float av4[4] = {aq.x, aq.y, aq.z, aq.w};
#pragma unroll
        for (int ii = 0; ii < 4; ++ii) {
          const int i = 4 * i4 + ii;
          const float a = av4[ii];
          unsigned y[4] = {vr[i].x, vr[i].y, vr[i].z, vr[i].w};
#pragma unroll
          for (int q = 0; q < 4; ++q) {
            f32x2 lo = __builtin_amdgcn_cvt_pk_f32_fp8((int)y[q], false), hi = __builtin_amdgcn_cvt_pk_f32_fp8((int)y[q], true);
            acc[q * 4] += a * lo[0]; acc[q * 4 + 1] += a * lo[1]; acc[q * 4 + 2] += a * hi[0]; acc[q * 4 + 3] += a * hi[1];
          }
          if (i + 1 < 16) asm volatile("" : "+v"(acc[0]), "+v"(vr[i + 1].x), "+v"(vr[i + 1].y), "+v"(vr[i + 1].z), "+v"(vr[i + 1].w));
        }
      }
#pragma unroll
      for (int q = 0; q < 4; ++q) *(float4*)(red + lane * 16 + 4 * q) = make_float4(acc[4 * q], acc[4 * q + 1], acc[4 * q + 2], acc[4 * q + 3]);
      float f0 = 0.f, f1 = 0.f;
#pragma unroll
      for (int jj = 0; jj < 8; ++jj) {
        const float2 t = *(const float2*)(red + (jj * 8 + ko) * 16 + 2 * jo);
        f0 += t.x; f1 += t.y;
      }
      float2 o = make_float2(xin.x + g2.x * f0, xin.y + g2.y * f1);
      if (l == 1) *(float2*)(p.out + (size_t)(tk - LC) * 1024 + dim) = o;
      else {
        *(float2*)(p.xall + (size_t)tk * 1024 + dim) = o;
        const float2 gs = tk < LC ? gsc : gsl;
        *(unsigned*)(p.hb + (size_t)tk * 1024 + dim) = pack2bf(o.x * gs.x, o.y * gs.y);
        const float ssq = wave_sum(o.x * o.x + o.y * o.y);
        if (lane == 0) p.rowss[(size_t)s * TT + tk] = ssq;
      }
    }
  }
}

#define XB_TMO      128
#define XB_XCNT(j)  (256  + 64 * (j))
#define XB_XSUB(j)  (1280 + 64 * (j))
#define XB_XGEN(j)  (2304 + 64 * (j))
#define XB_TOP      3328
#define XB_TOPGEN   3392
#define XB_RANK(j)  (3456 + 64 * (j))
#define XCD_BAR_WORDS 4480
#define XB_SPIN_CAP (1u << 22)
__device__ __forceinline__ unsigned xb_ld(unsigned* q) { return __hip_atomic_load(q, __ATOMIC_RELAXED, __HIP_MEMORY_SCOPE_AGENT); }
__device__ __forceinline__ unsigned xb_add(unsigned* q, unsigned v) { return __hip_atomic_fetch_add(q, v, __ATOMIC_RELAXED, __HIP_MEMORY_SCOPE_AGENT); }
__device__ __forceinline__ unsigned xb_xcc_id() { return (unsigned)__builtin_amdgcn_s_getreg((3 << 11) | 20) & 0xFu; }
#define XB_SPIN(cond, bar) do { unsigned _sp = 0; while (cond) { __builtin_amdgcn_s_sleep(1); \
    if ((++_sp & 255u) == 0u) { if (xb_ld(&(bar)[XB_TMO])) break; if (_sp > XB_SPIN_CAP) { atomicAdd(&(bar)[XB_TMO], 1u); break; } } } } while (0)
struct XcdBarrier { unsigned* bar; unsigned x; volatile LAS unsigned* st; };
__device__ __forceinline__ XcdBarrier xcd_barrier_post(unsigned* bar, volatile LAS unsigned* st) {
  XcdBarrier b; b.bar = bar; b.x = xb_xcc_id(); b.st = st;
  if (threadIdx.x == 0) { (void)xb_add(&bar[XB_XCNT(b.x)], 1u); st[2] = xb_add(&bar[XB_RANK(b.x)], 1u); }
  return b;
}
__device__ __forceinline__ void xcd_barrier_complete(unsigned* bar, unsigned x, unsigned& nloc, unsigned& nx, unsigned& li) {
  const unsigned G = gridDim.x * gridDim.y * gridDim.z;
  unsigned sum, cnt, mine, below, sp = 0u;
  for (;;) {
    sum = 0u; cnt = 0u; mine = 0u; below = 0u;
#pragma unroll
    for (unsigned j = 0; j < 16; ++j) { const unsigned c = xb_ld(&bar[XB_XCNT(j)]); sum += c; cnt += (c > 0u) ? 1u : 0u; mine = (j == x) ? c : mine; below += (j < x && c > 0u) ? 1u : 0u; }
    if (sum == G) break;
    __builtin_amdgcn_s_sleep(1);
    if ((++sp & 255u) == 0u) { if (xb_ld(&bar[XB_TMO])) break; if (sp > XB_SPIN_CAP) { atomicAdd(&bar[XB_TMO], 1u); break; } }
  }
  nloc = mine > 0u ? mine : 1u; nx = cnt > 0u ? cnt : 1u; li = below;
}
__device__ __forceinline__ void xcd_barrier(const XcdBarrier& b) {
  asm volatile("s_waitcnt vmcnt(0)" ::: "memory");
  __syncthreads();
  if (threadIdx.x == 0) {
    unsigned* bar = b.bar;
    __builtin_amdgcn_s_waitcnt(0);
    unsigned nloc = b.st[0], nx = b.st[1];
    if (nloc == 0u) { unsigned li; xcd_barrier_complete(bar, b.x, nloc, nx, li); b.st[0] = nloc; b.st[1] = nx; b.st[3] = li; }
    const unsigned old = xb_add(&bar[XB_XSUB(b.x)], 1u);
    const unsigned gen = old / nloc;
    if (old + 1u == (gen + 1u) * nloc) {
      __builtin_amdgcn_fence(__ATOMIC_RELEASE, "agent");
      asm volatile("s_waitcnt vmcnt(0)" ::: "memory");
      const unsigned og = xb_add(&bar[XB_TOP], 1u);
      const unsigned tg = og / nx;
      if (og + 1u == (tg + 1u) * nx) xb_add(&bar[XB_TOPGEN], 1u);
      else XB_SPIN(xb_ld(&bar[XB_TOPGEN]) == tg, bar);
      __builtin_amdgcn_fence(__ATOMIC_ACQUIRE, "agent");
      xb_add(&bar[XB_XGEN(b.x)], 1u);
      asm volatile("s_waitcnt vmcnt(0)" ::: "memory");
    } else {
      XB_SPIN(xb_ld(&bar[XB_XGEN(b.x)]) == gen, bar);
      __builtin_amdgcn_fence(__ATOMIC_ACQUIRE, "agent");
      asm volatile("s_waitcnt vmcnt(0)" ::: "memory");
    }
  }
  __syncthreads();
}

#ifndef PROBE_IV
#define PROBE_IV -1
#endif
__device__ __forceinline__ void probe_tick(int& cnt, unsigned long long* slots) {
  if (PROBE_IV >= 0) {
    if (threadIdx.x == 0 && (cnt == PROBE_IV || cnt == PROBE_IV + 1)) slots[cnt - PROBE_IV] = __builtin_amdgcn_s_memrealtime();
    cnt = __builtin_amdgcn_readfirstlane(cnt + 1);
  }
}
#define BARRIER() do { XcdBarrier xb_; xb_.bar = PP.bar; xb_.x = xb_xcc_id(); xb_.st = (volatile LAS unsigned*)(smem + 18432); xcd_barrier(xb_); probe_tick(pcnt, probe_t); } while (0)

typedef const __attribute__((address_space(4))) P* KP;
__device__ __forceinline__ P load_params(KP kp) {
#if defined(__HIP_DEVICE_COMPILE__)
  asm volatile("" : "+s"(kp));
  return *kp;
#else
  return P{};
#endif
}
#define PP load_params(kp)
__global__ void __launch_bounds__(256, 2) k_mega(P p_unused) {
  KP kp = (KP)__builtin_amdgcn_kernarg_segment_ptr();
  __shared__ __attribute__((aligned(16))) float smem[18432 + 8];
  uint4& xb_words = *(uint4*)(smem + 18432);
  cg::grid_group grid = cg::this_grid();
  if (threadIdx.x == 0) xb_words = make_uint4(0u, 0u, 0u, 0u);
  __syncthreads();
  unsigned long long* probe_t = (unsigned long long*)(smem + 18436);
  int pcnt = 0;
  asm volatile("" : "+s"(pcnt));
  probe_tick(pcnt, probe_t);
  ph_mod(PP, smem);
  ph_prep(PP, smem);
  ph_lru_prepw(PP);
  ph_rope_tab(PP);
  ph_prep_small(PP);
  grid.sync();
  probe_tick(pcnt, probe_t);
  (void)xcd_barrier_post(PP.bar, (volatile LAS unsigned*)&xb_words);
  ph_norm_mod(PP, 0, 0, 0, smem, true);
  ph_shb(PP);
  BARRIER();
#pragma unroll 1
  for (int l = 0; l < 2; ++l) {
    const int t0 = (l == 0) ? 0 : LC;
    { const P lp = PP; gemm_bf16_128(lp, lp.hb, lp.w_in_t + (size_t)l * 1024 * DIN, 1024, 0, TT, DIN, (char*)smem, EpiProj{l}); }
    if (l == 0) {
      const P lp = PP;
      const int b0 = (130 * 18) % (int)gridDim.x;
      gemm_bf16_128(lp, lp.shb, lp.wq_t, 1024, 0, 128, NPQ, (char*)smem, EpiBias{lp.bq, NPQ}, -1, 0, b0);
      gemm_bf16_128(lp, lp.shb + 128 * 1024, lp.wq_t + (size_t)1024 * NPQ, 1024, 0, 128, NPQ, (char*)smem, EpiBias{lp.bq + 2 * NPQ, NPQ}, -1, 0, (b0 + 16) % (int)gridDim.x);
      gemm_bf16_128(lp, lp.shb + 2 * 128 * 1024, lp.w_in_t + (size_t)1024 * DIN, 1024, 0, 128, DIN, (char*)smem, EpiBias{lp.bin, DIN}, -1, 0, (b0 + 32) % (int)gridDim.x);
    }
    BARRIER();
    ph_lru<1>(PP, l, (char*)smem);
    ph_attn(PP, l, (char*)smem);
    BARRIER();
    ph_lru_carry(PP, smem);
    BARRIER();
    ph_lru<2>(PP, l, (char*)smem);
    BARRIER();
    { const P lp = PP; gemm_bf16_128(lp, lp.mixb, lp.w_out_t + (size_t)l * 1024 * 1024, 1024, t0, TT, 1024, (char*)smem, EpiResid{l}); }
    BARRIER();
    { const P lp = PP; gemm_bf16_128(lp, lp.hb, lp.wq_t + (size_t)l * 1024 * NPQ, 1024, t0, TT, NPQ, (char*)smem, EpiPeerTopk{l}); }
    BARRIER();
    { const P lp = PP; const int q = (32768 + (int)gridDim.x - 1) / (int)gridDim.x; peer_convert_rows(lp, l, min((int)blockIdx.x * q, 32768), min(((int)blockIdx.x + 1) * q, 32768)); }
    ph_peer_merge(PP, l, t0, (char*)smem);
    BARRIER();
    ph_peer_s1(PP, l, t0, load_xw(smem));
    BARRIER();
    ph_peer_r(PP, l, t0);
    BARRIER();
    ph_peer_s2(PP, l, t0, load_xw(smem), (char*)smem);
    if (l == 0) BARRIER();
  }
  if (PROBE_IV >= 0) {
    probe_tick(pcnt, probe_t);
    __syncthreads();
    if (blockIdx.x == 0 && threadIdx.x == 0) {
      const unsigned long long dt = (probe_t[1] - probe_t[0]) * 8ull, ts = __builtin_amdgcn_s_memrealtime();
      while (__builtin_amdgcn_s_memrealtime() - ts < dt) __builtin_amdgcn_s_sleep(8);
    }
  }
}

extern "C" void kernel_launch(void* const* d_in, const int* in_sizes, int n_in, void* d_out, int out_size, void* d_ws,
                              size_t ws_size, hipStream_t stream) {
  P p{};
  const float** fp = (const float**)&p;
  for (int i = 0; i < 28; ++i) fp[i] = (const float*)d_in[i];
  p.out = (float*)d_out;
  float* w = (float*)d_ws;
  size_t o = 0;
  auto carve = [&](size_t n) { float* r = w + o; o += (n + 63) & ~(size_t)63; return r; };
  p.bar = (unsigned*)carve(8192);
  p.mod = carve(4 * 6144);
  p.xall = carve((size_t)TT * 1024);
  p.proj = carve((size_t)TT * 512);
  p.projb = (bf16_t*)carve((size_t)TT * DIN / 2);
  p.mixb = (bf16_t*)carve((size_t)TT * 512);
  p.hb = (bf16_t*)carve((size_t)TT * 512);
  p.w_in_t = (bf16_t*)carve((size_t)1024 * DIN);
  p.w_out_t = (bf16_t*)carve((size_t)1024 * 1024);
  p.wq_t = (bf16_t*)carve((size_t)1024 * NPQ);
  p.lruw_t = (bf16_t*)carve((size_t)2 * 2 * 4 * 2 * 4096 / 2);
  p.lagg = carve((size_t)2 * NCHUNK * 256 * 2);
  p.lcarry = carve((size_t)2 * NCHUNK * 256);
  p.ropetab = carve(320 * 16 * 2);
  p.rowss = carve((size_t)8 * TT);
  p.bq = carve(4 * NPQ);
  p.bin = carve(2 * DIN);
  p.shb = (bf16_t*)carve(3 * 128 * 1024 / 2);
  p.el = (int*)carve((size_t)TT * 128);
  p.gl = carve((size_t)TT * 128);
  p.av = carve((size_t)TT * 128);
  p.pd = carve((size_t)8 * TT * 128);
  p.pk = (unsigned*)carve((size_t)TT * 256);
  p.ub8 = (unsigned char*)carve((size_t)2 * 16384 * 1024 / 4);
  p.vb8 = (unsigned char*)carve((size_t)2 * 16384 * 1024 / 4);
  p.usc = carve(2 * 16384);
  p.vsc = carve(2 * 16384);
  p.k1b = (bf16_t*)carve(16384);
  p.k2b = (bf16_t*)carve(16384);
  if (o * 4 > ws_size) { fprintf(stderr, "workspace too small: need %zu have %zu\n", o * 4, ws_size); return; }
  static int grid_blocks = 0;
  if (!grid_blocks) {
    int dev = 0, cus = 0, per_cu = 0;
    (void)hipGetDevice(&dev);
    (void)hipDeviceGetAttribute(&cus, hipDeviceAttributeMultiprocessorCount, dev);
    (void)hipOccupancyMaxActiveBlocksPerMultiprocessor(&per_cu, k_mega, 256, 0);
    if (per_cu > 2) per_cu = 2;
    grid_blocks = cus * per_cu;
  }
  (void)hipMemsetAsync(p.bar, 0, XCD_BAR_WORDS * 4, stream);
  void* args[] = {&p};
  hipError_t e = hipLaunchCooperativeKernel((void*)k_mega, dim3(grid_blocks), dim3(256), args, 0, stream);
  if (e != hipSuccess) fprintf(stderr, "cooperative launch failed: %s (grid %d)\n", hipGetErrorString(e), grid_blocks);
}
```

```cpp
#include <hip/hip_runtime.h>
#include <hip/hip_cooperative_groups.h>
#include <stdint.h>
#include <stdio.h>
namespace cg = cooperative_groups;

#ifndef SINGLE_LAUNCH
#define SINGLE_LAUNCH 1
#endif

constexpr int DM = 1024, SEQ = 16384, LC = 256, TT = SEQ + LC, DIN = 2304, NPQ = 2048;
constexpr int OFF_XA = 0, OFF_GA = 256, OFF_QW = 512, OFF_KW = 896, OFF_VW = 1024, OFF_QN = 1152, OFF_KN = 1536, OFF_VN = 1920;
constexpr float EPS = 1e-6f;
#define LAS __attribute__((address_space(3)))
constexpr float LOG2E = 1.4426950408889634f;
constexpr float QSCALE = 0.125f * LOG2E;

struct P {
  const float *x, *c, *ctx, *c_ctx, *w_mod, *b_mod, *norm1_g, *norm2_g, *w_in, *w_out,
      *conv_w, *conv_b, *wa, *ba, *wx, *bx, *lam, *win_qn, *win_kn, *win_sink, *na_qn, *na_kn, *rpb,
      *wq, *k1, *k2, *pu, *pv;
  float* out;
  float *mod, *xall, *proj;
  unsigned short* projb;
  unsigned* pk;
  unsigned* bar;
  unsigned short *k1b, *k2b;
  unsigned char *ub8, *vb8;
  float *usc, *vsc;
  unsigned short *hb, *mixb, *w_in_t, *w_out_t, *wq_t, *lruw_t;
  float *lagg, *lcarry, *ropetab, *rowss, *bq, *bin, *gl, *av, *pd;
  unsigned short* shb;
  int* el;
};

typedef unsigned short bf16_t;
typedef __attribute__((ext_vector_type(8))) short bf16x8;
typedef __attribute__((ext_vector_type(4))) float f32x4;
__device__ __forceinline__ unsigned pack2bf(float a, float b) {
  unsigned r;
  asm("v_cvt_pk_bf16_f32 %0, %1, %2" : "=v"(r) : "v"(a), "v"(b));
  return r;
}
__device__ __forceinline__ unsigned short f2bf(float f) { return (unsigned short)(pack2bf(f, 0.f) & 0xffffu); }
__device__ __forceinline__ float bf2f(unsigned short h) { return __uint_as_float(((unsigned)h) << 16); }


__device__ __forceinline__ float silu_f(float x) { return x / (1.f + __expf(-x)); }
__device__ __forceinline__ float sigmoid_f(float x) { return 1.f / (1.f + __expf(-x)); }
__device__ __forceinline__ float gelu_f(float x) {
  float u = 0.7978845608028654f * (x + 0.044715f * x * x * x);
  float e = __expf(2.f * u);
  float th = 1.f - 2.f / (e + 1.f);
  return 0.5f * x * (1.f + th);
}
template <int CTRL, int RMASK>
__device__ __forceinline__ float dpp_mov(float v) {
  return __int_as_float(__builtin_amdgcn_update_dpp(0, __float_as_int(v), CTRL, RMASK, 0xf, false));
}
__device__ __forceinline__ float wave_sum(float v) {
  v += dpp_mov<0xB1, 0xf>(v);
  v += dpp_mov<0x4E, 0xf>(v);
  v += dpp_mov<0x141, 0xf>(v);
  v += dpp_mov<0x140, 0xf>(v);
  v += dpp_mov<0x142, 0xa>(v);
  v += dpp_mov<0x143, 0xc>(v);
  return __int_as_float(__builtin_amdgcn_readlane(__float_as_int(v), 63));
}

__device__ __forceinline__ int tid_opaque() { int t = threadIdx.x; asm volatile("" : "+v"(t)); return t; }
#define GTID (blockIdx.x * blockDim.x + tid_opaque())
#define GSZ (gridDim.x * blockDim.x)

__device__ __forceinline__ void ph_mod(const P& p, float* smem) {
  const int tid = tid_opaque(), cl = tid & 31, ks = tid >> 5;
  float* sc0 = smem + 512;
  float* sc1 = smem + 1536;
  if ((int)blockIdx.x < 2 * 192) {
    __syncthreads();
    for (int k = tid; k < 1024; k += 256) { sc0[k] = silu_f(p.c[k]); sc1[k] = silu_f(p.c_ctx[k]); }
    __syncthreads();
  }
  for (int it = blockIdx.x; it < 2 * 192; it += gridDim.x) {
    const int nc = it % 192, l = it / 192;
    const int n = nc * 32 + cl;
    const float* w = p.w_mod + (size_t)l * 1024 * 6144 + n;
    float a0 = 0.f, a1 = 0.f;
#pragma unroll 1
    for (int i0 = 0; i0 < 128; i0 += 32) {
      float wv[32];
#pragma unroll
      for (int i = 0; i < 32; ++i) wv[i] = w[(size_t)((i0 + i) * 8 + ks) * 6144];
#pragma unroll
      for (int i = 0; i < 32; ++i) { const int k = (i0 + i) * 8 + ks; a0 += sc0[k] * wv[i]; a1 += sc1[k] * wv[i]; }
    }
    __syncthreads();
    smem[tid] = a0; smem[256 + tid] = a1;
    __syncthreads();
    if (tid < 64) {
      const int which = tid >> 5;
      float s = p.b_mod[l * 6144 + n];
#pragma unroll
      for (int q = 0; q < 8; ++q) s += smem[which * 256 + q * 32 + cl];
      p.mod[(l * 2 + which) * 6144 + n] = s;
    }
  }
}

__device__ __forceinline__ void ph_bq(const P& p, float* smem) {
  const int tid = tid_opaque(), cl = tid & 31, ks = tid >> 5;
  for (int it = blockIdx.x; it < 2 * 64; it += gridDim.x) {
    const int nc = it % 64, l = it / 64;
    const int n = nc * 32 + cl;
    const float* w = p.wq + (size_t)l * 1024 * NPQ + n;
    const float* v0 = p.mod + (l * 2 + 0) * 6144 + 3072;
    const float* v1 = p.mod + (l * 2 + 1) * 6144 + 3072;
    float a0 = 0.f, a1 = 0.f;
#pragma unroll 8
    for (int i = 0; i < 128; ++i) {
      int k = i * 8 + ks;
      float wv = w[(size_t)k * NPQ];
      a0 += v0[k] * wv;
      a1 += v1[k] * wv;
    }
    __syncthreads();
    smem[tid] = a0; smem[256 + tid] = a1;
    __syncthreads();
    if (tid < 64) {
      const int which = tid >> 5;
      float s = 0.f;
#pragma unroll
      for (int q = 0; q < 8; ++q) s += smem[which * 256 + q * 32 + cl];
      p.bq[(l * 2 + which) * NPQ + n] = s;
    }
  }
}

__device__ __forceinline__ void ph_shb(const P& p) {
  for (int idx = GTID; idx < 3 * 2 * 1024; idx += GSZ) {
    const int k = idx & 1023, which = (idx >> 10) & 1, m = idx >> 11;
    const int l = (m == 0) ? 0 : 1, off = (m == 2) ? 0 : 3072;
    p.shb[((size_t)m * 128 + which) * 1024 + k] = f2bf(p.mod[(l * 2 + which) * 6144 + off + k]);
  }
}

__device__ __forceinline__ void ph_copy_in(const P& p) {
  const float4* xs = (const float4*)p.x;
  const float4* cs = (const float4*)p.ctx;
  float4* d = (float4*)p.xall;
  for (int i = GTID; i < TT * 256; i += GSZ) d[i] = (i < LC * 256) ? cs[i] : xs[i - LC * 256];
}

__device__ __forceinline__ void ph_copy_out(const P& p) {
  const float4* s = (const float4*)(p.xall + (size_t)LC * 1024);
  float4* d = (float4*)p.out;
  for (int i = GTID; i < SEQ * 256; i += GSZ) d[i] = s[i];
}

__device__ __forceinline__ void ph_norm_mod(const P& p, int l, int which_norm, int t0, float* smem, bool from_input = false) {
  const float* g = (which_norm ? p.norm2_g : p.norm1_g) + l * 1024;
  const int sh_off = which_norm ? 3072 : 0, sc_off = which_norm ? 4096 : 1024;
  const int tid = tid_opaque();
  for (int t = t0 + blockIdx.x; t < TT; t += gridDim.x) {
    const float* mod = p.mod + (l * 2 + (t < LC ? 1 : 0)) * 6144;
    float4 v;
    if (from_input) {
      v = t < LC ? ((const float4*)(p.ctx + (size_t)t * 1024))[tid] : ((const float4*)(p.x + (size_t)(t - LC) * 1024))[tid];
    } else v = ((const float4*)(p.xall + (size_t)t * 1024))[tid];
    float ss = wave_sum(v.x * v.x + v.y * v.y + v.z * v.z + v.w * v.w);
    __syncthreads();
    if ((tid & 63) == 0) smem[tid >> 6] = ss;
    __syncthreads();
    float tot = smem[0] + smem[1] + smem[2] + smem[3];
    float rinv = rsqrtf(tot * (1.f / 1024.f) + EPS);
    float4 gg = ((const float4*)g)[tid];
    float4 sc = ((const float4*)(mod + sc_off))[tid];
    float4 sh = ((const float4*)(mod + sh_off))[tid];
    float4 o;
    o.x = v.x * rinv * gg.x * (1.f + sc.x) + sh.x;
    o.y = v.y * rinv * gg.y * (1.f + sc.y) + sh.y;
    o.z = v.z * rinv * gg.z * (1.f + sc.z) + sh.z;
    o.w = v.w * rinv * gg.w * (1.f + sc.w) + sh.w;
    ((uint2*)(p.hb + (size_t)t * 1024))[tid] = make_uint2(pack2bf(o.x, o.y), pack2bf(o.z, o.w));
  }
}

__device__ __forceinline__ void prep_transpose(const float* W, bf16_t* Wt, int K, int N, int item0, int nitems_total, float* smem) {
  (void)nitems_total;
  float(*ts)[65] = (float(*)[65])smem;
  const int tid = tid_opaque();
  const int tn = N / 64, nt = (K / 64) * tn;
  for (int it = blockIdx.x; it < nt; it += gridDim.x) {
    int k0 = (it / tn) * 64, n0 = (it % tn) * 64;
    __syncthreads();
#pragma unroll
    for (int i = 0; i < 16; ++i) {
      int r = (tid >> 6) + i * 4, c = tid & 63;
      ts[r][c] = W[(size_t)(k0 + r) * N + n0 + c];
    }
    __syncthreads();
#pragma unroll
    for (int i = 0; i < 16; ++i) {
      int r = (tid >> 6) + i * 4, c = tid & 63;
      Wt[(size_t)(n0 + r) * K + k0 + c] = f2bf(ts[c][r]);
    }
  }
  (void)item0;
}

__device__ __forceinline__ void ph_prep(const P& p, float* smem) {
  for (int l = 0; l < 2; ++l) {
    prep_transpose(p.w_in + (size_t)l * 1024 * DIN, p.w_in_t + (size_t)l * 1024 * DIN, 1024, DIN, 0, 0, smem);
    prep_transpose(p.w_out + (size_t)l * 1024 * 1024, p.w_out_t + (size_t)l * 1024 * 1024, 1024, 1024, 0, 0, smem);
    prep_transpose(p.wq + (size_t)l * 1024 * NPQ, p.wq_t + (size_t)l * 1024 * NPQ, 1024, NPQ, 0, 0, smem);
  }
}

struct EpiStoreF32 {
  __device__ __forceinline__ float pre(const P&, int, int) const { return 0.f; }
  float* C; int ldc;
  __device__ __forceinline__ void operator()(const P& p, f32x4 (&acc)[4][4], int m0, int n0, int wm, int wn, int lane, char* smem, float epre) const {
    const int mw0 = m0 + wm * 64, nw0 = n0 + wn * 64;
#pragma unroll
    for (int i = 0; i < 4; ++i)
#pragma unroll
      for (int r = 0; r < 4; ++r) {
        int row = mw0 + 16 * i + (lane >> 4) * 4 + r;
#pragma unroll
        for (int j = 0; j < 4; ++j) C[(size_t)row * ldc + nw0 + 16 * j + (lane & 15)] = acc[i][j][r];
      }
  }
};
struct EpiProjSplit {
  __device__ __forceinline__ float pre(const P&, int, int) const { return 0.f; }
  __device__ __forceinline__ void operator()(const P& p, f32x4 (&acc)[4][4], int m0, int n0, int wm, int wn, int lane, char* smem, float epre) const {
    const int mw0 = m0 + wm * 64, nw0 = n0 + wn * 64;
#pragma unroll
    for (int i = 0; i < 4; ++i)
#pragma unroll
      for (int r = 0; r < 4; ++r) {
        int row = mw0 + 16 * i + (lane >> 4) * 4 + r;
#pragma unroll
        for (int j = 0; j < 4; ++j) {
          int col = nw0 + 16 * j + (lane & 15);
          if (n0 < 512) p.proj[(size_t)row * 512 + col] = acc[i][j][r];
          else p.projb[(size_t)row * DIN + col] = f2bf(acc[i][j][r]);
        }
      }
  }
};
__device__ __forceinline__ void ph_rope_tab(const P& p) {
  for (int idx = GTID; idx < 320 * 16; idx += GSZ) {
    int v = idx >> 4, j = idx & 15;
    float inv = __expf(-(float)j * (1.f / 16.f) * 9.210340371976184f);
    float ang = (float)(v < 256 ? v : v - 256) * inv;
    float k = rintf(ang * 0.15915494309189535f);
    float r = fmaf(-k, 6.2831854820251465f, ang);
    r = fmaf(-k, -1.7484555e-07f, r);
    ((float2*)p.ropetab)[idx] = make_float2(__cosf(r), __sinf(r));
  }
}

template <int CTRL>
__device__ __forceinline__ float dpp_row(float v) {
  return __int_as_float(__builtin_amdgcn_update_dpp(0, __float_as_int(v), CTRL, 0xf, 0xf, false));
}
struct EpiBias {
  __device__ __forceinline__ float pre(const P&, int, int) const { return 0.f; }
  float* dst; int N;
  __device__ __forceinline__ void operator()(const P& p, f32x4 (&acc)[4][4], int m0, int n0, int wm, int wn, int lane, char* smem, float epre) const {
    if (wm == 0 && (lane >> 4) == 0) {
      const int col = n0 + wn * 64 + (lane & 15);
#pragma unroll
      for (int j = 0; j < 4; ++j) { dst[col + 16 * j] = acc[0][j][0]; dst[N + col + 16 * j] = acc[0][j][1]; }
    }
  }
};
struct EpiProj {
  int l;
  __device__ __forceinline__ float pre(const P& p, int m0, int tid) const {
    float s = 0.f;
    if (l == 1 && tid < 128) {
#pragma unroll
      for (int q = 0; q < 8; ++q) s += p.rowss[(size_t)q * TT + m0 + tid];
    }
    return s;
  }
  __device__ __forceinline__ void operator()(const P& p, f32x4 (&acc)[4][4], int m0, int n0, int wm, int wn, int lane, char* smem, float epre) const {
    const int g = lane >> 4, lr = lane & 15;
    const int mw0 = m0 + wm * 64, nw0 = n0 + wn * 64;
    if (l == 1) {
      float* rinvl = (float*)smem;
      const int tid = ((wm * 2 + wn) << 6) | lane;
      if (tid < 128) rinvl[tid] = rsqrtf(epre * (1.f / 1024.f) + EPS);
      __syncthreads();
      const float* bb = p.bin + (m0 < LC ? 1 : 0) * DIN + nw0 + lr;
      float bv[4];
#pragma unroll
      for (int j = 0; j < 4; ++j) bv[j] = bb[16 * j];
#pragma unroll
      for (int i = 0; i < 4; ++i)
#pragma unroll
        for (int r = 0; r < 4; ++r) {
          const float rv = rinvl[wm * 64 + 16 * i + 4 * g + r];
#pragma unroll
          for (int j = 0; j < 4; ++j) acc[i][j][r] = acc[i][j][r] * rv + bv[j];
        }
    }
    if (n0 < 512) {
#pragma unroll
      for (int i = 0; i < 4; ++i)
#pragma unroll
        for (int r = 0; r < 4; ++r) {
          int row = mw0 + 16 * i + 4 * g + r;
#pragma unroll
          for (int j = 0; j < 4; ++j) p.proj[(size_t)row * 512 + nw0 + 16 * j + lr] = acc[i][j][r];
        }
      return;
    }
    const float* gain = nullptr; bool rope = false; float scale = 1.f;
    if (nw0 < 896) { gain = p.win_qn + l * 64; rope = true; scale = QSCALE; }
    else if (nw0 < 1024) { gain = p.win_kn + l * 64; rope = true; }
    else if (nw0 < 1152) { }
    else if (nw0 < 1536) { gain = p.na_qn + l * 64; scale = QSCALE; }
    else if (nw0 < 1920) { gain = p.na_kn + l * 64; }
    rope = rope && (m0 >= LC);
    float gj[4] = {1.f, 1.f, 1.f, 1.f};
    if (gain) {
#pragma unroll
      for (int j = 0; j < 4; ++j) gj[j] = gain[16 * j + lr] * scale;
    }
#pragma unroll
    for (int i = 0; i < 4; ++i)
#pragma unroll
      for (int r = 0; r < 4; ++r) {
        const int row = mw0 + 16 * i + 4 * g + r;
        float y[4] = {acc[i][0][r], acc[i][1][r], acc[i][2][r], acc[i][3][r]};
        if (gain) {
          float ss = y[0] * y[0] + y[1] * y[1] + y[2] * y[2] + y[3] * y[3];
          ss += dpp_row<0xB1>(ss);
          ss += dpp_row<0x4E>(ss);
          ss += dpp_row<0x141>(ss);
          ss += dpp_row<0x140>(ss);
          const float rinv = rsqrtf(ss * (1.f / 64.f) + EPS);
#pragma unroll
          for (int j = 0; j < 4; ++j) y[j] *= rinv * gj[j];
        }
        if (rope) {
          const int pos = row - LC;
          const float2 tr = ((const float2*)p.ropetab)[(pos >> 6) * 16 + lr];
          const float2 tc = ((const float2*)p.ropetab)[(256 + (pos & 63)) * 16 + lr];
          float a0 = y[0] * tr.x - y[1] * tr.y, a1 = y[0] * tr.y + y[1] * tr.x;
          float a2 = y[2] * tc.x - y[3] * tc.y, a3 = y[2] * tc.y + y[3] * tc.x;
          y[0] = a0; y[1] = a1; y[2] = a2; y[3] = a3;
        }
#pragma unroll
        for (int j = 0; j < 4; ++j) p.projb[(size_t)row * DIN + nw0 + 16 * j + lr] = f2bf(y[j]);
      }
  }
};
struct EpiResid {
  __device__ __forceinline__ float pre(const P&, int, int) const { return 0.f; }
  int l;
  __device__ __forceinline__ void operator()(const P& p, f32x4 (&acc)[4][4], int m0, int n0, int wm, int wn, int lane, char* smem, float epre) const {
    float* tile = (float*)smem;
    {
      const int g = lane >> 4, lr = lane & 15;
      float* tw = tile + (wm * 64 + 4 * g) * 132 + wn * 64 + lr;
#pragma unroll
      for (int i = 0; i < 4; ++i)
#pragma unroll
        for (int r = 0; r < 4; ++r)
#pragma unroll
          for (int j = 0; j < 4; ++j) tw[(16 * i + r) * 132 + 16 * j] = acc[i][j][r];
    }
    __syncthreads();
    const int tid = ((wm * 2 + wn) << 6) | lane, c8 = tid & 15, rsub = tid >> 4;
    const float* mod = p.mod + (l * 2 + (m0 < LC ? 1 : 0)) * 6144;
    const int col = n0 + 8 * c8;
    float g1v[8], gs[8];
    {
      const float4 a0 = *(const float4*)(mod + 2048 + col), a1 = *(const float4*)(mod + 2048 + col + 4);
      const float4 s0 = *(const float4*)(mod + 4096 + col), s1 = *(const float4*)(mod + 4096 + col + 4);
      const float4 n0v = *(const float4*)(p.norm2_g + l * 1024 + col), n1v = *(const float4*)(p.norm2_g + l * 1024 + col + 4);
      g1v[0] = a0.x; g1v[1] = a0.y; g1v[2] = a0.z; g1v[3] = a0.w; g1v[4] = a1.x; g1v[5] = a1.y; g1v[6] = a1.z; g1v[7] = a1.w;
      gs[0] = n0v.x * (1.f + s0.x); gs[1] = n0v.y * (1.f + s0.y); gs[2] = n0v.z * (1.f + s0.z); gs[3] = n0v.w * (1.f + s0.w);
      gs[4] = n1v.x * (1.f + s1.x); gs[5] = n1v.y * (1.f + s1.y); gs[6] = n1v.z * (1.f + s1.z); gs[7] = n1v.w * (1.f + s1.w);
    }
#pragma unroll
    for (int it = 0; it < 8; ++it) {
      const int rl = it * 16 + rsub, row = m0 + rl;
      float4* xp = (float4*)(p.xall + (size_t)row * 1024 + col);
      const float4* xi = (l == 0) ? (const float4*)((row < LC ? p.ctx + (size_t)row * 1024 : p.x + (size_t)(row - LC) * 1024) + col) : (const float4*)xp;
      float4 x0 = xi[0], x1 = xi[1];
      const float4 t0 = *(const float4*)(tile + rl * 132 + 8 * c8), t1 = *(const float4*)(tile + rl * 132 + 8 * c8 + 4);
      x0.x += g1v[0] * t0.x; x0.y += g1v[1] * t0.y; x0.z += g1v[2] * t0.z; x0.w += g1v[3] * t0.w;
      x1.x += g1v[4] * t1.x; x1.y += g1v[5] * t1.y; x1.z += g1v[6] * t1.z; x1.w += g1v[7] * t1.w;
      xp[0] = x0; xp[1] = x1;
      float ss = x0.x * x0.x + x0.y * x0.y + x0.z * x0.z + x0.w * x0.w + x1.x * x1.x + x1.y * x1.y + x1.z * x1.z + x1.w * x1.w;
      ss += dpp_row<0xB1>(ss);
      ss += dpp_row<0x4E>(ss);
      ss += dpp_row<0x141>(ss);
      ss += dpp_row<0x140>(ss);
      *(uint4*)(p.hb + (size_t)row * 1024 + col) = make_uint4(pack2bf(x0.x * gs[0], x0.y * gs[1]), pack2bf(x0.z * gs[2], x0.w * gs[3]),
                                                            pack2bf(x1.x * gs[4], x1.y * gs[5]), pack2bf(x1.z * gs[6], x1.w * gs[7]));
      if (c8 == 0) p.rowss[(size_t)(n0 >> 7) * TT + row] = ss;
    }
  }
};

template <int CTRL, int RMASK>
__device__ __forceinline__ float dpp_mov_id(float v) {
  return __int_as_float(__builtin_amdgcn_update_dpp(__float_as_int(v), __float_as_int(v), CTRL, RMASK, 0xf, false));
}
__device__ __forceinline__ float wave_max(float v) {
  v = fmaxf(v, dpp_mov_id<0xB1, 0xf>(v));
  v = fmaxf(v, dpp_mov_id<0x4E, 0xf>(v));
  v = fmaxf(v, dpp_mov_id<0x141, 0xf>(v));
  v = fmaxf(v, dpp_mov_id<0x140, 0xf>(v));
  v = fmaxf(v, dpp_mov_id<0x142, 0xa>(v));
  v = fmaxf(v, dpp_mov_id<0x143, 0xc>(v));
  return __int_as_float(__builtin_amdgcn_readlane(__float_as_int(v), 63));
}

typedef __attribute__((ext_vector_type(2))) float f32x2;
__device__ __forceinline__ void peer_convert_rows(const P& p, int l, int r0, int r1) {
  const int tid = tid_opaque(), lane = tid & 63;
  for (int rb = r0 + (tid >> 6); rb < r1; rb += 16) {
    float4 v[4][4];
#pragma unroll
    for (int u = 0; u < 4; ++u) {
      const int r = min(rb + 4 * u, r1 - 1);
      const int tbl = r >> 14, e = r & 16383;
      const float4* src = (const float4*)((tbl ? p.pv : p.pu) + ((size_t)l * 16384 + e) * 1024) + lane * 4;
#pragma unroll
      for (int i = 0; i < 4; ++i) v[u][i] = src[i];
    }
#pragma unroll
    for (int u = 0; u < 4; ++u) {
      const int r = rb + 4 * u;
      if (r < r1) {
        const int tbl = r >> 14, e = r & 16383;
        float am = 0.f;
#pragma unroll
        for (int i = 0; i < 4; ++i)
          am = fmaxf(am, fmaxf(fmaxf(fabsf(v[u][i].x), fabsf(v[u][i].y)), fmaxf(fabsf(v[u][i].z), fabsf(v[u][i].w))));
        am = wave_max(am);
        const float sc = am > 0.f ? 224.f / am : 1.f;
        unsigned w[4];
#pragma unroll
        for (int i = 0; i < 4; ++i) {
          int t = __builtin_amdgcn_cvt_pk_fp8_f32(v[u][i].x * sc, v[u][i].y * sc, 0, false);
          t = __builtin_amdgcn_cvt_pk_fp8_f32(v[u][i].z * sc, v[u][i].w * sc, t, true);
          w[i] = (unsigned)t;
        }
        unsigned char* dst = (tbl ? p.vb8 : p.ub8) + (((size_t)l * 8 + (lane >> 3)) * 16384 + e) * 128 + (lane & 7) * 16;
        *(uint4*)dst = make_uint4(w[0], w[1], w[2], w[3]);
        if (lane == 0) (tbl ? p.vsc : p.usc)[l * 16384 + e] = am > 0.f ? am / 224.f : 1.f;
      }
    }
  }
}
__device__ __forceinline__ int gemm_swz(int row) { return (0x78 >> (((row >> 2) & 3) * 2)) & 3; }
template <class Epi>
__device__ __forceinline__ void gemm_bf16_128(const P& p, const bf16_t* __restrict__ A, const bf16_t* __restrict__ Bt, int K, int m_begin, int m_end,
                              int N, char* smem, const Epi& epi, int cl = -1, int rpt = 0, int boff = 0) {
  const int tid = tid_opaque(), lane = tid & 63, wv = __builtin_amdgcn_readfirstlane(tid >> 6), wm = wv >> 1, wn = wv & 1;
  const int tiles_n = N / 128, tiles_m = (m_end - m_begin) / 128;
  const int nk = K / 32;
  const int lr = lane & 15, g = lane >> 4;
  const int a_rd = (wm * 64 + lr) * 64 + ((g ^ gemm_swz(lr)) << 4);
  const int b_rd = 8192 + (wn * 64 + lr) * 64 + ((g ^ gemm_swz(lr)) << 4);
  const int ld_row = lane >> 2, ld_c = (lane & 3) ^ gemm_swz(ld_row);
  for (int tile = ((int)blockIdx.x + (int)gridDim.x - boff) % (int)gridDim.x; tile < tiles_m * tiles_n; tile += gridDim.x) {
    const int m0 = m_begin + (tile / tiles_n) * 128, n0 = (tile % tiles_n) * 128;
    f32x4 acc[4][4];
#pragma unroll
    for (int i = 0; i < 4; ++i)
#pragma unroll
      for (int j = 0; j < 4; ++j) acc[i][j] = (f32x4){0.f, 0.f, 0.f, 0.f};
    const bf16_t* Ag = A + (size_t)(m0 + wv * 32 + ld_row) * K + ld_c * 8;
    const bf16_t* Bg = Bt + (size_t)(n0 + wv * 32 + ld_row) * K + ld_c * 8;
    auto issue = [&](int st, int kt) {
      char* base = smem + st * 16384 + wv * 2048;
#pragma unroll
      for (int i = 0; i < 2; ++i) {
        __builtin_amdgcn_global_load_lds((const unsigned*)(Ag + (size_t)i * 16 * K + kt * 32), (__attribute__((address_space(3))) unsigned*)(base + i * 1024), 16, 0, 0);
        __builtin_amdgcn_global_load_lds((const unsigned*)(Bg + (size_t)i * 16 * K + kt * 32), (__attribute__((address_space(3))) unsigned*)(base + 8192 + i * 1024), 16, 0, 0);
      }
    };
    auto issue1 = [&](int st, int kt, int piece) {
      char* base = smem + st * 16384 + wv * 2048 + (piece & 1) * 1024 + (piece >> 1) * 8192;
      const bf16_t* src = ((piece >> 1) ? Bg : Ag) + (size_t)(piece & 1) * 16 * K + kt * 32;
      __builtin_amdgcn_global_load_lds((const unsigned*)src, (__attribute__((address_space(3))) unsigned*)base, 16, 0, 0);
    };
    issue(0, 0); issue(1, 1); issue(2, 2);
    const float epre = epi.pre(p, m0, tid);
    for (int kt0 = 0; kt0 < nk; kt0 += 4) {
#pragma unroll
      for (int u = 0; u < 4; ++u) {
        const int kt = kt0 + u, rem = nk - kt;
        if (rem >= 3) asm volatile("s_waitcnt vmcnt(8) lgkmcnt(0)" ::: "memory");
        else if (rem == 2) asm volatile("s_waitcnt vmcnt(4) lgkmcnt(0)" ::: "memory");
        else asm volatile("s_waitcnt vmcnt(0) lgkmcnt(0)" ::: "memory");
        __builtin_amdgcn_s_barrier();
        const bool pf = kt + 3 < nk;
        bf16x8 af[4], bfr[4];
#pragma unroll
        for (int i = 0; i < 4; ++i) af[i] = *(const bf16x8*)(smem + u * 16384 + a_rd + i * 1024);
#pragma unroll
        for (int j = 0; j < 4; ++j) bfr[j] = *(const bf16x8*)(smem + u * 16384 + b_rd + j * 1024);
#pragma unroll
        for (int i = 0; i < 4; ++i) {
#pragma unroll
          for (int j = 0; j < 4; ++j) acc[i][j] = __builtin_amdgcn_mfma_f32_16x16x32_bf16(af[i], bfr[j], acc[i][j], 0, 0, 0);
          if (pf) issue1((u + 3) & 3, kt + 3, i);
        }
      }
    }
    __syncthreads();
    epi(p, acc, m0, n0, wm, wn, lane, smem, epre);
    if (cl >= 0) peer_convert_rows(p, cl, min(tile * rpt, 32768), min((tile + 1) * rpt, 32768));
    __syncthreads();
  }
}

constexpr int NCHUNK = TT / 64;
__device__ __forceinline__ int lru_pos(int dir, int c) { return dir == 0 ? c : (c < 4 ? 3 - c : 4 + (NCHUNK - 1 - c)); }

__device__ __forceinline__ void ph_lru_prepw(const P& p) {
  for (int idx = GTID; idx < 2 * 2 * 4 * 2 * 4096; idx += GSZ) {
    int d = idx & 63, e = (idx >> 6) & 63, mtx = (idx >> 12) & 1, rest = idx >> 13;
    const float* w = (mtx ? p.wx : p.wa) + (size_t)rest * 4096;
    p.lruw_t[idx] = f2bf(w[d * 64 + e]);
  }
}

template <int PASS>
__device__ __forceinline__ void lru_item(const P& p, int l, int cidx, int kb, char* smem) {
  bf16_t* u_img = (bf16_t*)smem;
  const int tid = tid_opaque(), lane = tid & 63, wv = tid >> 6, g = lane >> 4, lr = lane & 15;
  const int t0 = cidx * 64;
  const int lo = t0 < LC ? 0 : LC, hi = t0 < LC ? LC : TT;
  const int chw = 16 * wv + lr, cw = kb * 64 + chw;
  __syncthreads();
  bf16x8 wfa[2][2], wfx[2][2];
  float bav2[2], bxv2[2], lam2[2], cin[2] = {0.f, 0.f};
#pragma unroll
  for (int dir = 0; dir < 2; ++dir) {
    const int pd = l * 2 + dir;
    const bf16_t* wbase = p.lruw_t + (size_t)((pd * 4 + kb) * 2) * 4096 + chw * 64 + 8 * g;
#pragma unroll
    for (int s = 0; s < 2; ++s) { wfa[dir][s] = *(const bf16x8*)(wbase + 32 * s); wfx[dir][s] = *(const bf16x8*)(wbase + 4096 + 32 * s); }
    bav2[dir] = p.ba[pd * 256 + cw]; bxv2[dir] = p.bx[pd * 256 + cw]; lam2[dir] = p.lam[pd * 256 + cw];
    if (PASS == 2) cin[dir] = p.lcarry[((size_t)dir * NCHUNK + lru_pos(dir, cidx)) * 256 + cw];
  }
  float gav[4][4];
  if (PASS == 2) {
#pragma unroll
    for (int i = 0; i < 4; ++i)
#pragma unroll
      for (int r = 0; r < 4; ++r) gav[i][r] = p.proj[(size_t)(t0 + 16 * i + 4 * g + r) * 512 + OFF_GA + cw];
  }
  {
    const int ch = tid & 63, c = kb * 64 + ch, sg = tid >> 6;
    const float cb = p.conv_b[l * 256 + c];
    float cw4[4];
#pragma unroll
    for (int k = 0; k < 4; ++k) cw4[k] = p.conv_w[(l * 4 + k) * 256 + c];
    float xr[19];
#pragma unroll
    for (int i = 0; i < 19; ++i) {
      int tt = t0 + sg * 16 + i - 2;
      int tc = tt < lo ? lo : (tt >= hi ? hi - 1 : tt);
      float v = p.proj[(size_t)tc * 512 + OFF_XA + c];
      xr[i] = (tt >= lo && tt < hi) ? v : 0.f;
    }
#pragma unroll
    for (int i = 0; i < 16; ++i) {
      int row = sg * 16 + i;
      float acc = cb + cw4[0] * xr[i] + cw4[1] * xr[i + 1] + cw4[2] * xr[i + 2] + cw4[3] * xr[i + 3];
      u_img[row * 64 + ((((ch >> 3) ^ (row & 7)) << 3) | (ch & 7))] = f2bf(acc);
    }
  }
  __syncthreads();
  float hs0[4][4];
#pragma unroll
  for (int dir = 0; dir < 2; ++dir) {
    f32x4 ga[4], gx[4];
#pragma unroll
    for (int i = 0; i < 4; ++i) { ga[i] = (f32x4){0.f, 0.f, 0.f, 0.f}; gx[i] = (f32x4){0.f, 0.f, 0.f, 0.f}; }
#pragma unroll
    for (int s = 0; s < 2; ++s) {
      const bf16x8 ba_ = dir == 0 ? wfa[0][s] : wfa[1][s];
      const bf16x8 bx_ = dir == 0 ? wfx[0][s] : wfx[1][s];
#pragma unroll
      for (int i = 0; i < 4; ++i) {
        int row = 16 * i + lr;
        bf16x8 af = *(const bf16x8*)((const char*)u_img + row * 128 + (((4 * s + g) ^ (row & 7)) << 4));
        ga[i] = __builtin_amdgcn_mfma_f32_16x16x32_bf16(af, ba_, ga[i], 0, 0, 0);
        gx[i] = __builtin_amdgcn_mfma_f32_16x16x32_bf16(af, bx_, gx[i], 0, 0, 0);
      }
    }
    const float bav = dir == 0 ? bav2[0] : bav2[1], bxv = dir == 0 ? bxv2[0] : bxv2[1];
    const float sp = log1pf(expf(-(dir == 0 ? lam2[0] : lam2[1])));
    float av[4][4], bv[4][4];
#pragma unroll
    for (int i = 0; i < 4; ++i)
#pragma unroll
      for (int r = 0; r < 4; ++r) {
        const int row = 16 * i + 4 * g + r;
        float rr = sigmoid_f(ga[i][r] + bav), ig = sigmoid_f(gx[i][r] + bxv);
        float log_a = -8.f * rr * sp;
        float a = __expf(log_a);
        float uu = bf2f(u_img[row * 64 + ((((chw >> 3) ^ (row & 7)) << 3) | (chw & 7))]);
        const float x2 = 2.f * log_a;
        const float ser = -x2 * (1.f + x2 * (0.5f + x2 * (0.16666667f + x2 * (0.041666668f + x2 * 0.0083333338f))));
        const float om = x2 > -0.25f ? ser : 1.f - a * a;
        av[i][r] = a;
        bv[i][r] = sqrtf(om) * ig * uu;
      }
    float As[4], Bs[4];
#pragma unroll
    for (int i = 0; i < 4; ++i) {
      float A = 1.f, B = 0.f;
#pragma unroll
      for (int rr = 0; rr < 4; ++rr) { const int r = dir == 0 ? rr : 3 - rr; B = av[i][r] * B + bv[i][r]; A *= av[i][r]; }
      As[i] = A; Bs[i] = B;
    }
    const int lg = dir == 0 ? g : 3 - g;
    const int src1 = dir == 0 ? lane - 16 : lane + 16, src2 = dir == 0 ? lane - 32 : lane + 32;
    float Ai[4], Bi[4];
#pragma unroll
    for (int i = 0; i < 4; ++i) {
      float A = As[i], B = Bs[i];
      { float Ap = __shfl(A, src1 & 63), Bp = __shfl(B, src1 & 63); if (lg >= 1) { B = A * Bp + B; A = Ap * A; } }
      { float Ap = __shfl(A, src2 & 63), Bp = __shfl(B, src2 & 63); if (lg >= 2) { B = A * Bp + B; A = Ap * A; } }
      Ai[i] = A; Bi[i] = B;
    }
    const int lastl = (dir == 0 ? 48 : 0) + lr;
    float Ae[4], Be[4], At[4], Bt[4];
#pragma unroll
    for (int i = 0; i < 4; ++i) {
      float Ap = __shfl(Ai[i], src1 & 63), Bp = __shfl(Bi[i], src1 & 63);
      Ae[i] = lg >= 1 ? Ap : 1.f; Be[i] = lg >= 1 ? Bp : 0.f;
      At[i] = __shfl(Ai[i], lastl); Bt[i] = __shfl(Bi[i], lastl);
    }
    if (PASS == 1) {
      float A = 1.f, B = 0.f;
#pragma unroll
      for (int ii = 0; ii < 4; ++ii) { const int i = dir == 0 ? ii : 3 - ii; B = At[i] * B + Bt[i]; A *= At[i]; }
      if (g == 0) {
        float2* ag = (float2*)p.lagg + ((size_t)dir * NCHUNK + lru_pos(dir, cidx)) * 256 + cw;
        *ag = make_float2(A, B);
      }
    } else {
      float R = dir == 0 ? cin[0] : cin[1];
#pragma unroll
      for (int ii = 0; ii < 4; ++ii) {
        const int i = dir == 0 ? ii : 3 - ii;
        float h = Ae[i] * R + Be[i];
#pragma unroll
        for (int rr = 0; rr < 4; ++rr) {
          const int r = dir == 0 ? rr : 3 - rr;
          h = av[i][r] * h + bv[i][r];
          if (dir == 0) hs0[i][r] = h;
          else p.mixb[(size_t)(t0 + 16 * i + 4 * g + r) * 1024 + cw] = f2bf((hs0[i][r] + h) * gelu_f(gav[i][r]));
        }
        R = At[i] * R + Bt[i];
      }
    }
  }
}

__device__ __forceinline__ void ph_lru_carry(const P& p, float* smem) {
  const int tid = tid_opaque(), seg = tid >> 4, c16 = tid & 15;
  for (int blk = blockIdx.x; blk < 32; blk += gridDim.x) {
    const int dc = blk * 16 + c16, dir = dc >> 8, ch = dc & 255;
    const float2* ag = (const float2*)p.lagg + (size_t)dir * NCHUNK * 256 + ch;
    float2 v[17];
#pragma unroll
    for (int i = 0; i < 17; ++i) {
      int pos = seg * 17 + i;
      v[i] = pos < NCHUNK ? ag[(size_t)pos * 256] : make_float2(1.f, 0.f);
    }
    float A = 1.f, B = 0.f;
#pragma unroll
    for (int i = 0; i < 17; ++i) { B = v[i].x * B + v[i].y; A *= v[i].x; }
    __syncthreads();
    smem[(seg * 16 + c16) * 2] = A; smem[(seg * 16 + c16) * 2 + 1] = B;
    __syncthreads();
    float h = 0.f;
    for (int s2 = 0; s2 < seg; ++s2) h = smem[(s2 * 16 + c16) * 2] * h + smem[(s2 * 16 + c16) * 2 + 1];
    float* cr = p.lcarry + (size_t)dir * NCHUNK * 256 + ch;
#pragma unroll
    for (int i = 0; i < 17; ++i) {
      int pos = seg * 17 + i;
      if (pos < NCHUNK) cr[(size_t)pos * 256] = h;
      h = v[i].x * h + v[i].y;
    }
  }
}

template <int PASS>
__device__ __forceinline__ void ph_lru(const P& p, int l, char* smem) {
  const int c_begin = (PASS == 2 && l == 1) ? 4 : 0;
  const int nitems = (NCHUNK - c_begin) * 4;
  for (int it = blockIdx.x; it < nitems; it += gridDim.x) lru_item<PASS>(p, l, c_begin + (it >> 2), it & 3, smem);
}

typedef __attribute__((ext_vector_type(4))) short s16x4;
typedef __attribute__((ext_vector_type(4))) unsigned u32x4;

__device__ __forceinline__ void ph_qknorm_rope2(const P& p, int l) {
  const int tid_ = tid_opaque();
  const int lane = tid_ & 63;
  const int wpb = blockDim.x >> 6;
  for (int pair = blockIdx.x * wpb + (tid_ >> 6); pair < TT * 28; pair += gridDim.x * wpb) {
    int t = pair / 28, slot = pair % 28;
    const float* g = nullptr; bool rope = false; float scale = 1.f;
    if (slot < 6) { g = p.win_qn + l * 64; rope = true; scale = QSCALE; }
    else if (slot < 8) { g = p.win_kn + l * 64; rope = true; }
    else if (slot < 10) { }
    else if (slot < 16) { g = p.na_qn + l * 64; scale = QSCALE; }
    else if (slot < 22) { g = p.na_kn + l * 64; }
    rope = rope && (t >= LC);
    const size_t idx = (size_t)t * DIN + 512 + slot * 64 + lane;
    float v = bf2f(p.projb[idx]);
    float y = v;
    if (g) {
      float ss = wave_sum(v * v);
      y = v * rsqrtf(ss * (1.f / 64.f) + EPS) * g[lane];
    }
    float partner = __shfl_xor(y, 16);
    if (rope) {
      int pos = t - LC, row = pos >> 6, col = pos & 63;
      int j = lane & 15, axis = lane >> 5;
      float inv = __expf(-(float)j * (1.f / 16.f) * 9.210340371976184f);
      float ang = (float)(axis ? col : row) * inv;
      float k = rintf(ang * 0.15915494309189535f);
      float r = fmaf(-k, 6.2831854820251465f, ang);
      r = fmaf(-k, -1.7484555e-07f, r);
      float cs = __cosf(r), sn = __sinf(r);
      bool first = ((lane >> 4) & 1) == 0;
      y = first ? (y * cs - partner * sn) : (partner * sn + y * cs);
    }
    p.projb[idx] = f2bf(y * scale);
  }
}

template <class TokFn>
__device__ __forceinline__ void kv_issue(const P& p, char* stage, int koff, int voff, TokFn tok, int wv, int lane) {
#pragma unroll
  for (int i = 0; i < 2; ++i) {
    const int row = 16 * wv + 8 * i + (lane >> 3);
    const bf16_t* src = p.projb + (size_t)tok(row) * DIN + (((lane & 7) ^ (row & 7)) << 3);
    char* dst = stage + (2 * wv + i) * 1024;
    __builtin_amdgcn_global_load_lds((const unsigned*)(src + koff), (__attribute__((address_space(3))) unsigned*)dst, 16, 0, 0);
    __builtin_amdgcn_global_load_lds((const unsigned*)(src + voff), (__attribute__((address_space(3))) unsigned*)(dst + 8192), 16, 0, 0);
  }
}
__device__ __forceinline__ void kv_wait(int rem) {
  if (rem >= 3) asm volatile("s_waitcnt vmcnt(8) lgkmcnt(0)" ::: "memory");
  else if (rem == 2) asm volatile("s_waitcnt vmcnt(4) lgkmcnt(0)" ::: "memory");
  else asm volatile("s_waitcnt vmcnt(0) lgkmcnt(0)" ::: "memory");
  __builtin_amdgcn_s_barrier();
}

template <class MaskFn>
__device__ __forceinline__ void attn_step2(const char* stage, int kr0, const bf16x8 (&qf)[2][2], f32x4 (&o)[2][4], float (&lsum)[2], MaskFn mb,
                                           int lane, bool act0, bool act1) {
  const int g = lane >> 4, lr = lane & 15;
  bf16x8 kf[2][2];
#pragma unroll
  for (int t2 = 0; t2 < 2; ++t2) {
    const int row = kr0 + 16 * t2 + lr;
#pragma unroll
    for (int s = 0; s < 2; ++s) kf[t2][s] = *(const bf16x8*)(stage + row * 128 + (((4 * s + g) ^ (row & 7)) << 4));
  }
  bf16x8 pb[2];
#pragma unroll
  for (int qt = 0; qt < 2; ++qt) {
    if (qt == 0 ? act0 : act1) {
      f32x4 st[2];
#pragma unroll
      for (int t2 = 0; t2 < 2; ++t2) {
        st[t2] = (f32x4){0.f, 0.f, 0.f, 0.f};
#pragma unroll
        for (int s = 0; s < 2; ++s) st[t2] = __builtin_amdgcn_mfma_f32_16x16x32_bf16(kf[t2][s], qf[qt][s], st[t2], 0, 0, 0);
      }
#pragma unroll
      for (int t2 = 0; t2 < 2; ++t2) {
        float pv[4];
#pragma unroll
        for (int r = 0; r < 4; ++r) { pv[r] = __builtin_amdgcn_exp2f(mb(qt, t2, r, st[t2][r])); lsum[qt] += pv[r]; }
        const unsigned w0 = pack2bf(pv[0], pv[1]), w1 = pack2bf(pv[2], pv[3]);
        pb[qt][t2 * 4 + 0] = (short)(w0 & 0xffffu); pb[qt][t2 * 4 + 1] = (short)(w0 >> 16);
        pb[qt][t2 * 4 + 2] = (short)(w1 & 0xffffu); pb[qt][t2 * 4 + 3] = (short)(w1 >> 16);
      }
    }
  }
  const int q = lr >> 2, pp = lane & 3;
#pragma unroll
  for (int m = 0; m < 4; ++m) {
    bf16x8 vf;
#pragma unroll
    for (int t = 0; t < 2; ++t) {
      const int row = kr0 + 16 * t + 4 * g + q;
      const char* addr = stage + 8192 + row * 128 + (((2 * m + (pp >> 1)) ^ (row & 7)) << 4) + 8 * (pp & 1);
      s16x4 v4 = __builtin_amdgcn_ds_read_tr16_b64_v4i16((__attribute__((address_space(3))) s16x4*)addr);
      vf[4 * t + 0] = v4[0]; vf[4 * t + 1] = v4[1]; vf[4 * t + 2] = v4[2]; vf[4 * t + 3] = v4[3];
    }
    if (act0) o[0][m] = __builtin_amdgcn_mfma_f32_16x16x32_bf16(vf, pb[0], o[0][m], 0, 0, 0);
    if (act1) o[1][m] = __builtin_amdgcn_mfma_f32_16x16x32_bf16(vf, pb[1], o[1][m], 0, 0, 0);
  }
}

__device__ __forceinline__ void attn_store_out(const P& p, const f32x4 (&o)[4], float lsum, int tok, int col0, int lane) {
  const int g = lane >> 4;
  lsum += __shfl_xor(lsum, 16);
  lsum += __shfl_xor(lsum, 32);
  const float inv = 1.f / lsum;
  bf16_t* op = p.mixb + (size_t)tok * 1024 + col0 + 4 * g;
#pragma unroll
  for (int m = 0; m < 4; ++m)
    *(uint2*)(op + 16 * m) = make_uint2(pack2bf(o[m][0] * inv, o[m][1] * inv), pack2bf(o[m][2] * inv, o[m][3] * inv));
}

__device__ __forceinline__ void attn_win_item(const P& p, int l, int kind, int qb, int hs, char* smem) {
  const int tid = tid_opaque(), lane = tid & 63, wv = __builtin_amdgcn_readfirstlane(tid >> 6), g = lane >> 4, lr = lane & 15;
  int qoff, koff, voff, ooff; const float *gq, *gk; float sink2 = -1e30f; bool has_sink = false;
  if (kind == 0 || hs < 6) {
    const int h = hs, kvh = h / 3;
    qoff = OFF_QW + h * 64; koff = OFF_KW + kvh * 64; voff = OFF_VW + kvh * 64; ooff = 256 + h * 64;
    gq = p.win_qn + l * 64; gk = p.win_kn + l * 64; sink2 = p.win_sink[l * 6 + h] * LOG2E; has_sink = true;
  } else {
    const int h = hs - 6;
    qoff = OFF_QN + h * 64; koff = OFF_KN + h * 64; voff = OFF_VN + h * 64; ooff = 640 + h * 64;
    gq = p.na_qn + l * 64; gk = p.na_kn + l * 64;
  }
  float bound = 8.f * LOG2E * wave_max(fabsf(gq[lane])) * wave_max(fabsf(gk[lane])) * 1.0001f + 1e-3f;
  if (has_sink) bound = fmaxf(bound, sink2);
  const int q0 = qb * 128;
  const int qtok0 = (kind == 0 ? LC : 0) + q0 + 32 * wv;
  bf16x8 qf[2][2];
#pragma unroll
  for (int qt = 0; qt < 2; ++qt)
#pragma unroll
    for (int s = 0; s < 2; ++s) qf[qt][s] = *(const bf16x8*)(p.projb + (size_t)(qtok0 + 16 * qt + lr) * DIN + qoff + 32 * s + 8 * g);
  f32x4 o[2][4];
#pragma unroll
  for (int qt = 0; qt < 2; ++qt)
#pragma unroll
    for (int m = 0; m < 4; ++m) o[qt][m] = (f32x4){0.f, 0.f, 0.f, 0.f};
  float lsum[2] = {0.f, 0.f};
  const int nloc = (kind == 0) ? 6 : 0, nch = nloc + 4;
  auto tokfn = [&](int c) {
    return [=](int row) {
      if (c < nloc) { int pos = q0 - 128 + 64 * c + row; pos = pos < 0 ? 0 : (pos > SEQ - 1 ? SEQ - 1 : pos); return LC + pos; }
      return 64 * (c - nloc) + row;
    };
  };
  __syncthreads();
  kv_issue(p, smem, koff, voff, tokfn(0), wv, lane);
  kv_issue(p, smem + 16384, koff, voff, tokfn(1), wv, lane);
  kv_issue(p, smem + 32768, koff, voff, tokfn(2), wv, lane);
  for (int c = 0; c < nch; ++c) {
    kv_wait(nch - c);
    if (c + 3 < nch) kv_issue(p, smem + ((c + 3) & 3) * 16384, koff, voff, tokfn(c + 3), wv, lane);
    const char* stage = smem + (c & 3) * 16384;
    if (c < nloc) {
      const int qw0 = q0 + 32 * wv;
#pragma unroll
      for (int st = 0; st < 2; ++st) {
        const int kbase = q0 - 128 + 64 * c + 32 * st;
        const bool a0 = !(kbase - (qw0 + 15) > 128 || qw0 - (kbase + 31) > 128) && (kbase + 31 >= 0) && (kbase < SEQ);
        const bool a1 = !(kbase - (qw0 + 31) > 128 || (qw0 + 16) - (kbase + 31) > 128) && (kbase + 31 >= 0) && (kbase < SEQ);
        const bool allv = (kbase >= 0) && (kbase + 31 < SEQ) && (kbase + 31 - qw0 <= 128) && (qw0 + 31 - kbase <= 128);
        if (allv)
          attn_step2(stage, 32 * st, qf, o, lsum, [&](int qt, int t2, int r, float s) { return s - bound; }, lane, true, true);
        else if (a0 || a1)
          attn_step2(stage, 32 * st, qf, o, lsum, [&](int qt, int t2, int r, float s) {
            int kpos = kbase + 16 * t2 + 4 * g + r;
            int dlt = kpos - (qw0 + 16 * qt + lr); dlt = dlt < 0 ? -dlt : dlt;
            bool valid = (kpos >= 0) && (kpos < SEQ) && (dlt <= 128);
            return valid ? s - bound : -1e30f;
          }, lane, a0, a1);
      }
    } else {
#pragma unroll
      for (int st = 0; st < 2; ++st)
        attn_step2(stage, 32 * st, qf, o, lsum, [&](int qt, int t2, int r, float s) { return s - bound; }, lane, true, true);
    }
  }
#pragma unroll
  for (int qt = 0; qt < 2; ++qt) {
    float ls = lsum[qt];
    if (has_sink && g == 0) ls += __builtin_amdgcn_exp2f(sink2 - bound);
    attn_store_out(p, o[qt], ls, qtok0 + 16 * qt + lr, ooff, lane);
  }
}

__device__ __forceinline__ void attn_na_item(const P& p, int l, int rp, int h, char* smem) {
  const int tid = tid_opaque(), lane = tid & 63, wv = __builtin_amdgcn_readfirstlane(tid >> 6), g = lane >> 4, lr = lane & 15;
  const int qoff = OFF_QN + h * 64, koff = OFF_KN + h * 64, voff = OFF_VN + h * 64, ooff = 640 + h * 64;
  float* rpbl = (float*)(smem + 65536);
  const float* rpbg = p.rpb + (size_t)(l * 6 + h) * 465;
  float bmax = 0.f;
  __syncthreads();
  for (int i = tid; i < 465; i += 256) rpbl[i] = rpbg[i] * LOG2E;
  for (int i = lane; i < 465; i += 64) bmax = fmaxf(bmax, fabsf(rpbg[i]) * LOG2E);
  bmax = wave_max(bmax);
  const float bound = 8.f * LOG2E * wave_max(fabsf(p.na_qn[l * 64 + lane])) * wave_max(fabsf(p.na_kn[l * 64 + lane])) * 1.0001f + bmax + 1e-3f;
  const int r0 = 2 * rp;
  const int qcol = 16 * wv + lr;
  const int qtok0 = LC + r0 * 64 + qcol;
  const int kra = min(max(r0 - 4, 0), 248), krb = min(max(r0 + 1 - 4, 0), 248);
  const int nrow = krb + 8 - kra, nch = nrow + 4;
  const int kc0 = min(max(16 * wv - 8, 0), 32);
  const int qs = min(max(qcol - 8, 0), 48);
  bf16x8 qf[2][2];
#pragma unroll
  for (int qt = 0; qt < 2; ++qt)
#pragma unroll
    for (int s = 0; s < 2; ++s) qf[qt][s] = *(const bf16x8*)(p.projb + (size_t)(qtok0 + 64 * qt) * DIN + qoff + 32 * s + 8 * g);
  f32x4 o[2][4];
#pragma unroll
  for (int qt = 0; qt < 2; ++qt)
#pragma unroll
    for (int m = 0; m < 4; ++m) o[qt][m] = (f32x4){0.f, 0.f, 0.f, 0.f};
  float lsum[2] = {0.f, 0.f};
  auto tokfn = [&](int c) {
    return [=](int row) { return c < nrow ? LC + (kra + c) * 64 + row : 64 * (c - nrow) + row; };
  };
  kv_issue(p, smem, koff, voff, tokfn(0), wv, lane);
  kv_issue(p, smem + 16384, koff, voff, tokfn(1), wv, lane);
  kv_issue(p, smem + 32768, koff, voff, tokfn(2), wv, lane);
  for (int c = 0; c < nch; ++c) {
    kv_wait(nch - c);
    if (c + 3 < nch) kv_issue(p, smem + ((c + 3) & 3) * 16384, koff, voff, tokfn(c + 3), wv, lane);
    const char* stage = smem + (c & 3) * 16384;
    if (c < nrow) {
      const int krow = kra + c;
      const bool a0 = krow < kra + 8, a1 = krow >= krb;
      attn_step2(stage, kc0, qf, o, lsum, [&](int qt, int t2, int rr, float s) {
        int kcol = kc0 + 16 * t2 + 4 * g + rr;
        bool valid = (kcol >= qs) && (kcol < qs + 16);
        int dc = kcol - qcol + 15; dc = dc < 0 ? 0 : (dc > 30 ? 30 : dc);
        int dr = krow - (r0 + qt) + 7; dr = dr < 0 ? 0 : (dr > 14 ? 14 : dr);
        return valid ? s + rpbl[dr * 31 + dc] - bound : -1e30f;
      }, lane, a0, a1);
    } else {
#pragma unroll
      for (int st = 0; st < 2; ++st)
        attn_step2(stage, 32 * st, qf, o, lsum, [&](int qt, int t2, int rr, float s) { return s - bound; }, lane, true, true);
    }
  }
#pragma unroll
  for (int qt = 0; qt < 2; ++qt) attn_store_out(p, o[qt], lsum[qt], qtok0 + 64 * qt, ooff, lane);
}

__device__ __forceinline__ void ph_attn(const P& p, int l, char* smem) {
  const int nitems = 1536 + (l == 0 ? 24 : 0);
  for (int it = blockIdx.x; it < nitems; it += gridDim.x) {
    if (it < 768) attn_win_item(p, l, 0, it / 6, it % 6, smem);
    else if (it < 1536) { int j = it - 768; attn_na_item(p, l, j / 6, j % 6, smem); }
    else { int j = it - 1536; attn_win_item(p, l, 1, j / 12, j % 12, smem); }
  }
}

__device__ __forceinline__ unsigned ord_key(float s) {
  unsigned u = __float_as_uint(s);
  return (u & 0x80000000u) ? ~u : (u | 0x80000000u);
}
__device__ __forceinline__ float ord_val(unsigned pk) {
  unsigned u = pk & ~127u;
  unsigned b = (u & 0x80000000u) ? (u & 0x7fffffffu) : ~u;
  return __uint_as_float(b);
}
__device__ __forceinline__ void ce_desc(unsigned& a, unsigned& b) {
  unsigned mx = a > b ? a : b, mn = a > b ? b : a;
  a = mx; b = mn;
}
__device__ __forceinline__ void sort16_desc(unsigned (&v)[16]) {
#pragma unroll
  for (int k = 2; k <= 16; k <<= 1) {
#pragma unroll
    for (int j = k >> 1; j > 0; j >>= 1) {
#pragma unroll
      for (int i = 0; i < 16; ++i) {
        int m = i ^ j;
        if (m > i) {
          if ((i & k) == 0) ce_desc(v[i], v[m]); else ce_desc(v[m], v[i]);
        }
      }
    }
  }
}
__device__ __forceinline__ void merge16_desc(unsigned (&a)[16], const unsigned (&b)[16]) {
#pragma unroll
  for (int i = 0; i < 16; ++i) { unsigned o = b[15 - i]; a[i] = a[i] > o ? a[i] : o; }
#pragma unroll
  for (int j = 8; j > 0; j >>= 1) {
#pragma unroll
    for (int i = 0; i < 16; ++i) {
      int m = i ^ j;
      if (m > i) ce_desc(a[i], a[m]);
    }
  }
}

typedef __attribute__((ext_vector_type(2))) float f32x2;
__device__ __forceinline__ void peer_convert_tail(const P& p, int l, int ntiles) {
  const int G = gridDim.x, extra = ntiles % G;
  const int first = (extra == 0) ? 0 : extra, np = G - first;
  const int idx = (int)blockIdx.x - first;
  if (idx < 0) return;
  const int q = (32768 + np - 1) / np;
  const int r0 = idx * q, r1 = min(r0 + q, 32768);
  peer_convert_rows(p, l, r0, r1);
}
__device__ __forceinline__ void ph_prep_small(const P& p) {
  for (int i = GTID; i < 2 * 128 * 128; i += GSZ) { p.k1b[i] = f2bf(p.k1[i]); p.k2b[i] = f2bf(p.k2[i]); }
}

struct EpiPeerTopk {
  int l;
  __device__ __forceinline__ float pre(const P& p, int m0, int tid) const {
    float s = 0.f;
    if (tid < 128) {
#pragma unroll
      for (int q = 0; q < 8; ++q) s += p.rowss[(size_t)q * TT + m0 + tid];
    }
    return s;
  }
  __device__ __forceinline__ void operator()(const P& p, f32x4 (&acc)[4][4], int m0, int n0, int wm, int wn, int lane, char* smem, float epre) const {
    const int tid = ((wm * 2 + wn) << 6) | lane, g = lane >> 4, lr = lane & 15;
    const int nt = n0 >> 7, head = nt >> 1, hf = nt & 1;
    char* qimg = smem;
    char* kimg = smem + 34816;
    float* rinvl = (float*)(smem + 69632);
    if (tid < 128) rinvl[tid] = rsqrtf(epre * (1.f / 1024.f) + EPS);
    __syncthreads();
    {
      const float* bq = p.bq + (l * 2 + (m0 < LC ? 1 : 0)) * NPQ + n0 + wn * 64 + lr;
      float bqv[4];
#pragma unroll
      for (int j = 0; j < 4; ++j) bqv[j] = bq[16 * j];
      char* qw = qimg + (wm * 64 + 4 * g) * 272 + (wn * 64 + lr) * 2;
#pragma unroll
      for (int i = 0; i < 4; ++i)
#pragma unroll
        for (int r = 0; r < 4; ++r) {
          const float rv = rinvl[wm * 64 + 16 * i + 4 * g + r];
#pragma unroll
          for (int j = 0; j < 4; ++j) *(bf16_t*)(qw + (16 * i + r) * 272 + 32 * j) = f2bf(acc[i][j][r] * rv + bqv[j]);
        }
      const bf16_t* kk = (hf ? p.k2b : p.k1b) + (size_t)l * 16384 + (tid >> 4) * 128 + (tid & 15) * 8;
      char* kw = kimg + (tid >> 4) * 272 + (tid & 15) * 16;
#pragma unroll
      for (int i = 0; i < 8; ++i) *(uint4*)(kw + i * 16 * 272) = *(const uint4*)(kk + i * 16 * 128);
    }
    __syncthreads();
#pragma unroll
    for (int i = 0; i < 4; ++i)
#pragma unroll
      for (int j = 0; j < 4; ++j) acc[i][j] = (f32x4){0.f, 0.f, 0.f, 0.f};
    {
      const char* qa = qimg + (wm * 64 + lr) * 272 + g * 16;
      const char* kb = kimg + (wn * 64 + lr) * 272 + g * 16;
#pragma unroll
      for (int s = 0; s < 4; ++s) {
        bf16x8 af[4], bfr[4];
#pragma unroll
        for (int i = 0; i < 4; ++i) af[i] = *(const bf16x8*)(qa + i * 16 * 272 + s * 64);
#pragma unroll
        for (int j = 0; j < 4; ++j) bfr[j] = *(const bf16x8*)(kb + j * 16 * 272 + s * 64);
#pragma unroll
        for (int i = 0; i < 4; ++i)
#pragma unroll
          for (int j = 0; j < 4; ++j) acc[i][j] = __builtin_amdgcn_mfma_f32_16x16x32_bf16(af[i], bfr[j], acc[i][j], 0, 0, 0);
      }
    }
    __syncthreads();
    unsigned* simg = (unsigned*)smem;
    {
      unsigned* sw = simg + (wm * 64 + 4 * g) * 129 + wn * 64 + lr;
#pragma unroll
      for (int i = 0; i < 4; ++i)
#pragma unroll
        for (int r = 0; r < 4; ++r)
#pragma unroll
          for (int j = 0; j < 4; ++j)
            sw[(16 * i + r) * 129 + 16 * j] = (ord_key(acc[i][j][r]) & ~127u) | (unsigned)(wn * 64 + 16 * j + lr);
    }
    __syncthreads();
    const int row = tid & 127, half = tid >> 7;
    unsigned top[16];
    {
      const unsigned* sr = simg + row * 129 + half * 64;
#pragma unroll
      for (int k = 0; k < 16; ++k) top[k] = sr[k];
      sort16_desc(top);
#pragma unroll 1
      for (int gi = 1; gi < 4; ++gi) {
        unsigned v1[16];
#pragma unroll
        for (int k = 0; k < 16; ++k) v1[k] = sr[gi * 16 + k];
        sort16_desc(v1);
        merge16_desc(top, v1);
      }
    }
    __syncthreads();
    if (half == 1) {
#pragma unroll
      for (int k = 0; k < 16; ++k) simg[k * 128 + row] = top[k];
    }
    __syncthreads();
    if (half == 0) {
      unsigned o[16];
#pragma unroll
      for (int k = 0; k < 16; ++k) o[k] = simg[k * 128 + row];
      merge16_desc(top, o);
      uint4* dst = (uint4*)(p.pk + (((size_t)(m0 + row) * 8 + head) * 2 + hf) * 16);
#pragma unroll
      for (int k = 0; k < 4; ++k) dst[k] = make_uint4(top[4 * k], top[4 * k + 1], top[4 * k + 2], top[4 * k + 3]);
    }
  }
};

__device__ const unsigned char CAND_A[64] = {0,0,0,0,0,0,0,0,0,0,0,0,0,0,0,0, 1,1,1,1,1,1,1,1, 2,2,2,2,2, 3,3,3,3, 4,4,4, 5,5, 6,6, 7,7,
                                             8,9,10,11,12,13,14,15, 0,0,0,0,0,0,0,0,0,0,0,0,0,0};
__device__ const unsigned char CAND_B[64] = {0,1,2,3,4,5,6,7,8,9,10,11,12,13,14,15, 0,1,2,3,4,5,6,7, 0,1,2,3,4, 0,1,2,3, 0,1,2, 0,1, 0,1, 0,1,
                                             0,0,0,0,0,0,0,0, 0,0,0,0,0,0,0,0,0,0,0,0,0,0};

__device__ __forceinline__ void ph_peer_merge(const P& p, int l, int t0, char* smem) {
  const int tid = tid_opaque(), lane = tid & 63, wv = tid >> 6;
  const float* n2g = p.norm2_g + l * 1024;
  const int ca = CAND_A[lane], cb = CAND_B[lane];
  for (int tk = t0 + blockIdx.x * 4 + wv; tk < TT; tk += gridDim.x * 4) {
    const float* mod = p.mod + (l * 2 + (tk < LC ? 1 : 0)) * 6144;
    unsigned p1[8], p2[8];
    {
      const unsigned* pk = p.pk + (size_t)tk * 256;
#pragma unroll
      for (int head = 0; head < 8; ++head) { p1[head] = pk[head * 32 + ca]; p2[head] = pk[head * 32 + 16 + cb]; }
    }
    {
      const float4* xp = (const float4*)(p.xall + (size_t)tk * 1024) + lane * 4;
      float4 v[4];
      float ss = 0.f;
#pragma unroll
      for (int q = 0; q < 4; ++q) { v[q] = xp[q]; ss += v[q].x * v[q].x + v[q].y * v[q].y + v[q].z * v[q].z + v[q].w * v[q].w; }
      ss = wave_sum(ss);
      const float rinv = rsqrtf(ss * (1.f / 1024.f) + EPS);
      uint2* hp = (uint2*)(p.hb + (size_t)tk * 1024) + lane * 4;
#pragma unroll
      for (int q = 0; q < 4; ++q) {
        float4 gg = ((const float4*)n2g)[lane * 4 + q], sc = ((const float4*)(mod + 4096))[lane * 4 + q], sh = ((const float4*)(mod + 3072))[lane * 4 + q];
        float h0 = v[q].x * rinv * gg.x * (1.f + sc.x) + sh.x, h1 = v[q].y * rinv * gg.y * (1.f + sc.y) + sh.y;
        float h2 = v[q].z * rinv * gg.z * (1.f + sc.z) + sh.z, h3 = v[q].w * rinv * gg.w * (1.f + sc.w) + sh.w;
        hp[q] = make_uint2(pack2bf(h0, h1), pack2bf(h2, h3));
      }
    }
    float sums[8];
    unsigned* candk = (unsigned*)smem + wv * 512;
#pragma unroll
    for (int head = 0; head < 8; ++head) {
      sums[head] = lane < 50 ? ord_val(p1[head]) + ord_val(p2[head]) : -3.0e38f;
      candk[head * 64 + lane] = (ord_key(sums[head]) & ~63u) | (unsigned)(63 - lane);
    }
#pragma unroll
    for (int head = 0; head < 8; ++head) {
      const float sum = sums[head];
      const unsigned kme = (ord_key(sum) & ~63u) | (unsigned)(63 - lane);
      int eid = (int)(p1[head] & 127u) * 128 + (int)(p2[head] & 127u);
      int rank = 0;
#pragma unroll
      for (int m4 = 0; m4 < 13; ++m4) {
        const uint4 km = *(const uint4*)(candk + head * 64 + 4 * m4);
        rank += (km.x > kme) ? 1 : 0;
        rank += (km.y > kme) ? 1 : 0;
        rank += (km.z > kme) ? 1 : 0;
        rank += (km.w > kme) ? 1 : 0;
      }
      float mx = wave_max(sum);
      bool sel = (lane < 50) && (rank < 16);
      float e = sel ? __expf(sum - mx) : 0.f;
      float tot = wave_sum(e);
      if (sel) {
        const int n = head * 16 + rank, idx = (n & 7) * 16 + (n >> 3);
        p.el[(size_t)tk * 128 + idx] = eid;
        p.gl[(size_t)tk * 128 + idx] = e / tot;
      }
    }
  }
}

__device__ __forceinline__ uint4 bload(__amdgpu_buffer_rsrc_t rs, int voff) {
  const u32x4 v = __builtin_amdgcn_raw_buffer_load_b128(rs, voff, 0, 0);
  return make_uint4(v.x, v.y, v.z, v.w);
}
struct XcdWork { int li, np, rank, nloc; };

__device__ __forceinline__ XcdWork load_xw(const float* smem) {
  const volatile LAS unsigned* st = (const volatile LAS unsigned*)(smem + 18432);
  XcdWork xw;
  xw.nloc = __builtin_amdgcn_readfirstlane((int)st[0]); xw.np = __builtin_amdgcn_readfirstlane((int)st[1]);
  xw.rank = __builtin_amdgcn_readfirstlane((int)st[2]); xw.li = __builtin_amdgcn_readfirstlane((int)st[3]);
  return xw;
}
__device__ __forceinline__ void ph_peer_s1(const P& p, int l, int t0, const XcdWork& xw) {
  const int tid = tid_opaque(), lane = tid & 63, wv = tid >> 6, j = lane >> 3, k = lane & 7;
  const unsigned char* U = p.ub8 + (size_t)l * 16384 * 1024;
  const int step = xw.nloc * 4;
  for (int s = xw.li; s < 8; s += xw.np) {
    const unsigned roff = 128u * s + 16u * k;
    const __amdgpu_buffer_rsrc_t urs = __builtin_amdgcn_make_buffer_rsrc((void*)(U + (size_t)s * 16384 * 128), (short)0, 16384 * 128, 0x00020000);
    const int tk0 = t0 + xw.rank * 4 + wv;
    if (tk0 >= TT) continue;
    uint4 ur[2][16]; uint4 hh[2][2]; int4 en[4];
#define S1_LOAD_LIST(TK) { const int4* ep = (const int4*)(p.el + (size_t)(TK) * 128 + j * 16); _Pragma("unroll") for (int q = 0; q < 4; ++q) en[q] = ep[q]; }
#define S1_ISSUE(B, TK) {                                                                            \
      _Pragma("unroll") for (int q = 0; q < 4; ++q) {                                                \
        ur[B][4 * q + 0] = bload(urs, en[q].x * 128 + 16 * k);                  \
        ur[B][4 * q + 1] = bload(urs, en[q].y * 128 + 16 * k);                  \
        ur[B][4 * q + 2] = bload(urs, en[q].z * 128 + 16 * k);                  \
        ur[B][4 * q + 3] = bload(urs, en[q].w * 128 + 16 * k);                  \
      }                                                                                              \
      const uint4* hp = (const uint4*)(p.hb + (size_t)(TK) * 1024 + roff);                           \
      hh[B][0] = hp[0]; hh[B][1] = hp[1]; }
#define S1_CONSUME(B, TK) {                                                                          \
      float hv[16];                                                                                  \
      { unsigned w[8] = {hh[B][0].x, hh[B][0].y, hh[B][0].z, hh[B][0].w, hh[B][1].x, hh[B][1].y, hh[B][1].z, hh[B][1].w}; \
        _Pragma("unroll") for (int q = 0; q < 8; ++q) { hv[2 * q] = __uint_as_float(w[q] << 16); hv[2 * q + 1] = __uint_as_float(w[q] & 0xffff0000u); } } \
      float keep0 = 0.f, keep1 = 0.f;                                                                \
      _Pragma("unroll") for (int i = 0; i < 16; ++i) {                                               \
        unsigned w[4] = {ur[B][i].x, ur[B][i].y, ur[B][i].z, ur[B][i].w};                            \
        float dot = 0.f;                                                                             \
        _Pragma("unroll") for (int q = 0; q < 4; ++q) {                                              \
          f32x2 lo = __builtin_amdgcn_cvt_pk_f32_fp8((int)w[q], false), hi = __builtin_amdgcn_cvt_pk_f32_fp8((int)w[q], true); \
          dot += lo[0] * hv[q * 4] + lo[1] * hv[q * 4 + 1] + hi[0] * hv[q * 4 + 2] + hi[1] * hv[q * 4 + 3]; \
        }                                                                                            \
        dot += dpp_row<0xB1>(dot); dot += dpp_row<0x4E>(dot); dot += dpp_row<0x141>(dot);            \
        if (i < 8) keep0 = (k == i) ? dot : keep0; else keep1 = (k == i - 8) ? dot : keep1;          \
      }                                                                                              \
      float* pd = p.pd + ((size_t)s * TT + (TK)) * 128;                                              \
      pd[8 * k + j] = keep0; pd[8 * (k + 8) + j] = keep1; }
    S1_LOAD_LIST(tk0)
    S1_ISSUE(0, tk0)
    if (tk0 + step < TT) S1_LOAD_LIST(tk0 + step)
    for (int tk = tk0; tk < TT; tk += 2 * step) {
      const bool has1 = tk + step < TT, has2 = tk + 2 * step < TT;
      if (has1) { S1_ISSUE(1, tk + step) if (has2) S1_LOAD_LIST(tk + 2 * step) }
      S1_CONSUME(0, tk)
      if (has1) {
        if (has2) { S1_ISSUE(0, tk + 2 * step) if (tk + 3 * step < TT) S1_LOAD_LIST(tk + 3 * step) }
        S1_CONSUME(1, tk + step)
      }
    }
#undef S1_LOAD_LIST
#undef S1_ISSUE
#undef S1_CONSUME
  }
}

__device__ __forceinline__ void ph_peer_r(const P& p, int l, int t0) {
  const float* usc = p.usc + l * 16384;
  const float* vsc = p.vsc + l * 16384;
  for (int idx = GTID; idx < (TT - t0) * 32; idx += GSZ) {
    const int tk = t0 + (idx >> 5), n0 = (idx & 31) * 4;
    float4 d = make_float4(0.f, 0.f, 0.f, 0.f);
#pragma unroll
    for (int s = 0; s < 8; ++s) {
      const float4 v = *(const float4*)(p.pd + ((size_t)s * TT + tk) * 128 + n0);
      d.x += v.x; d.y += v.y; d.z += v.z; d.w += v.w;
    }
    float dv[4] = {d.x, d.y, d.z, d.w};
#pragma unroll
    for (int q = 0; q < 4; ++q) {
      const int n = n0 + q, li = (n & 7) * 16 + (n >> 3);
      const int ex = p.el[(size_t)tk * 128 + li];
      p.av[(size_t)tk * 128 + li] = p.gl[(size_t)tk * 128 + li] * gelu_f(dv[q] * usc[ex]) * vsc[ex];
    }
  }
}

__device__ __forceinline__ void ph_peer_s2(const P& p, int l, int t0, const XcdWork& xw, char* smem) {
  const int tid = tid_opaque(), lane = tid & 63, wv = tid >> 6, j = lane >> 3, k = lane & 7;
  const int ko = lane >> 3, jo = lane & 7;
  float* red = (float*)smem + wv * 1408;
  int* elb = (int*)(red + 1024);
  float* avb = red + 1024 + 256;
  const unsigned char* V = p.vb8 + (size_t)l * 16384 * 1024;
  const int step = xw.nloc * 4;
  for (int s = xw.li; s < 8; s += xw.np) {
    const __amdgpu_buffer_rsrc_t vrs = __builtin_amdgcn_make_buffer_rsrc((void*)(V + (size_t)s * 16384 * 128), (short)0, 16384 * 128, 0x00020000);
    const int dim = 128 * s + 16 * ko + 2 * jo;
    int tk = t0 + xw.rank * 4 + wv;
    if (tk >= TT) continue;
    const float2 g2l = *(const float2*)(p.mod + (l * 2 + 0) * 6144 + 5120 + dim), g2c = *(const float2*)(p.mod + (l * 2 + 1) * 6144 + 5120 + dim);
    float2 gsl = make_float2(0.f, 0.f), gsc = make_float2(0.f, 0.f);
    if (l == 0) {
      const float2 n1 = *(const float2*)(p.norm1_g + 1024 + dim);
      const float2 sl = *(const float2*)(p.mod + 2 * 6144 + 1024 + dim), sc = *(const float2*)(p.mod + 3 * 6144 + 1024 + dim);
      gsl = make_float2(n1.x * (1.f + sl.x), n1.y * (1.f + sl.y)); gsc = make_float2(n1.x * (1.f + sc.x), n1.y * (1.f + sc.y));
    }
    *(int2*)(elb + 2 * lane) = *(const int2*)(p.el + (size_t)tk * 128 + 2 * lane);
    int par = 0;
    for (; tk < TT; tk += step, par ^= 1) {
      uint4 vr[16];
      {
        const int4* eb = (const int4*)(elb + par * 128 + j * 16);
#pragma unroll
        for (int q = 0; q < 4; ++q) {
          const int4 e4 = eb[q];
          vr[4 * q + 0] = bload(vrs, e4.x * 128 + 16 * k);
          vr[4 * q + 1] = bload(vrs, e4.y * 128 + 16 * k);
          vr[4 * q + 2] = bload(vrs, e4.z * 128 + 16 * k);
          vr[4 * q + 3] = bload(vrs, e4.w * 128 + 16 * k);
        }
      }
      const float2 a2 = *(const float2*)(p.av + (size_t)tk * 128 + 2 * lane);
      const float2 g2 = tk < LC ? g2c : g2l;
      const float2 xin = *(const float2*)(p.xall + (size_t)tk * 1024 + dim);
      if (tk + step < TT) {
        const int2 e2 = *(const int2*)(p.el + (size_t)(tk + step) * 128 + 2 * lane);
        *(int2*)(elb + (par ^ 1) * 128 + 2 * lane) = e2;
      }
      *(float2*)(avb + 2 * lane) = a2;
      float acc[16];
#pragma unroll
      for (int d = 0; d < 16; ++d) acc[d] = 0.f;
#pragma unroll
      for (int i4 = 0; i4 < 4; ++i4) {
        const float4 aq = *(const float4*)(avb + j * 16 + 4 * i4);
        const float av4[4] = {aq.x, aq.y, aq.z, aq.w};
#pragma unroll
        for (int ii = 0; ii < 4; ++ii) {
          const int i = 4 * i4 + ii;
          const float a = av4[ii];
          unsigned y[4] = {vr[i].x, vr[i].y, vr[i].z, vr[i].w};
#pragma unroll
          for (int q = 0; q < 4; ++q) {
            f32x2 lo = __builtin_amdgcn_cvt_pk_f32_fp8((int)y[q], false), hi = __builtin_amdgcn_cvt_pk_f32_fp8((int)y[q], true);
            acc[q * 4] += a * lo[0]; acc[q * 4 + 1] += a * lo[1]; acc[q * 4 + 2] += a * hi[0]; acc[q * 4 + 3] += a * hi[1];
          }
          if (i + 1 < 16) asm volatile("" : "+v"(acc[0]), "+v"(vr[i + 1].x), "+v"(vr[i + 1].y), "+v"(vr[i + 1].z), "+v"(vr[i + 1].w));
        }
      }
#pragma unroll
      for (int q = 0; q < 4; ++q) *(float4*)(red + lane * 16 + 4 * q) = make_float4(acc[4 * q], acc[4 * q + 1], acc[4 * q + 2], acc[4 * q + 3]);
      float f0 = 0.f, f1 = 0.f;
#pragma unroll
      for (int jj = 0; jj < 8; ++jj) {
        const float2 t = *(const float2*)(red + (jj * 8 + ko) * 16 + 2 * jo);
        f0 += t.x; f1 += t.y;
      }
      float2 o = make_float2(xin.x + g2.x * f0, xin.y + g2.y * f1);
      if (l == 1) *(float2*)(p.out + (size_t)(tk - LC) * 1024 + dim) = o;
      else {
        *(float2*)(p.xall + (size_t)tk * 1024 + dim) = o;
        const float2 gs = tk < LC ? gsc : gsl;
        *(unsigned*)(p.hb + (size_t)tk * 1024 + dim) = pack2bf(o.x * gs.x, o.y * gs.y);
        const float ssq = wave_sum(o.x * o.x + o.y * o.y);
        if (lane == 0) p.rowss[(size_t)s * TT + tk] = ssq;
      }
    }
  }
}

#define XB_TMO      128
#define XB_XCNT(j)  (256  + 64 * (j))
#define XB_XSUB(j)  (1280 + 64 * (j))
#define XB_XGEN(j)  (2304 + 64 * (j))
#define XB_TOP      3328
#define XB_TOPGEN   3392
#define XB_RANK(j)  (3456 + 64 * (j))
#define XCD_BAR_WORDS 4480
#define XB_SPIN_CAP (1u << 22)
__device__ __forceinline__ unsigned xb_ld(unsigned* q) { return __hip_atomic_load(q, __ATOMIC_RELAXED, __HIP_MEMORY_SCOPE_AGENT); }
__device__ __forceinline__ unsigned xb_add(unsigned* q, unsigned v) { return __hip_atomic_fetch_add(q, v, __ATOMIC_RELAXED, __HIP_MEMORY_SCOPE_AGENT); }
__device__ __forceinline__ unsigned xb_xcc_id() { return (unsigned)__builtin_amdgcn_s_getreg((3 << 11) | 20) & 0xFu; }
#define XB_SPIN(cond, bar) do { unsigned _sp = 0; while (cond) { __builtin_amdgcn_s_sleep(1); \
    if ((++_sp & 255u) == 0u) { if (xb_ld(&(bar)[XB_TMO])) break; if (_sp > XB_SPIN_CAP) { atomicAdd(&(bar)[XB_TMO], 1u); break; } } } } while (0)
struct XcdBarrier { unsigned* bar; unsigned x; volatile LAS unsigned* st; };
__device__ __forceinline__ XcdBarrier xcd_barrier_post(unsigned* bar, volatile LAS unsigned* st) {
  XcdBarrier b; b.bar = bar; b.x = xb_xcc_id(); b.st = st;
  if (threadIdx.x == 0) { (void)xb_add(&bar[XB_XCNT(b.x)], 1u); st[2] = xb_add(&bar[XB_RANK(b.x)], 1u); }
  return b;
}
__device__ __forceinline__ void xcd_barrier_complete(unsigned* bar, unsigned x, unsigned& nloc, unsigned& nx, unsigned& li) {
  const unsigned G = gridDim.x * gridDim.y * gridDim.z;
  unsigned sum, cnt, mine, below, sp = 0u;
  for (;;) {
    sum = 0u; cnt = 0u; mine = 0u; below = 0u;
#pragma unroll
    for (unsigned j = 0; j < 16; ++j) { const unsigned c = xb_ld(&bar[XB_XCNT(j)]); sum += c; cnt += (c > 0u) ? 1u : 0u; mine = (j == x) ? c : mine; below += (j < x && c > 0u) ? 1u : 0u; }
    if (sum == G) break;
    __builtin_amdgcn_s_sleep(1);
    if ((++sp & 255u) == 0u) { if (xb_ld(&bar[XB_TMO])) break; if (sp > XB_SPIN_CAP) { atomicAdd(&bar[XB_TMO], 1u); break; } }
  }
  nloc = mine > 0u ? mine : 1u; nx = cnt > 0u ? cnt : 1u; li = below;
}
__device__ __forceinline__ void xcd_barrier(const XcdBarrier& b) {
  asm volatile("s_waitcnt vmcnt(0)" ::: "memory");
  __syncthreads();
  if (threadIdx.x == 0) {
    unsigned* bar = b.bar;
    __builtin_amdgcn_s_waitcnt(0);
    unsigned nloc = b.st[0], nx = b.st[1];
    if (nloc == 0u) { unsigned li; xcd_barrier_complete(bar, b.x, nloc, nx, li); b.st[0] = nloc; b.st[1] = nx; b.st[3] = li; }
    const unsigned old = xb_add(&bar[XB_XSUB(b.x)], 1u);
    const unsigned gen = old / nloc;
    if (old + 1u == (gen + 1u) * nloc) {
      __builtin_amdgcn_fence(__ATOMIC_RELEASE, "agent");
      asm volatile("s_waitcnt vmcnt(0)" ::: "memory");
      const unsigned og = xb_add(&bar[XB_TOP], 1u);
      const unsigned tg = og / nx;
      if (og + 1u == (tg + 1u) * nx) xb_add(&bar[XB_TOPGEN], 1u);
      else XB_SPIN(xb_ld(&bar[XB_TOPGEN]) == tg, bar);
      __builtin_amdgcn_fence(__ATOMIC_ACQUIRE, "agent");
      xb_add(&bar[XB_XGEN(b.x)], 1u);
      asm volatile("s_waitcnt vmcnt(0)" ::: "memory");
    } else {
      XB_SPIN(xb_ld(&bar[XB_XGEN(b.x)]) == gen, bar);
      __builtin_amdgcn_fence(__ATOMIC_ACQUIRE, "agent");
      asm volatile("s_waitcnt vmcnt(0)" ::: "memory");
    }
  }
  __syncthreads();
}

#ifndef PROBE_IV
#define PROBE_IV -1
#endif
__device__ __forceinline__ void probe_tick(int& cnt, unsigned long long* slots) {
  if (PROBE_IV >= 0) {
    if (threadIdx.x == 0 && (cnt == PROBE_IV || cnt == PROBE_IV + 1)) slots[cnt - PROBE_IV] = __builtin_amdgcn_s_memrealtime();
    cnt = __builtin_amdgcn_readfirstlane(cnt + 1);
  }
}
#define BARRIER() do { XcdBarrier xb_; xb_.bar = PP.bar; xb_.x = xb_xcc_id(); xb_.st = (volatile LAS unsigned*)(smem + 18432); xcd_barrier(xb_); probe_tick(pcnt, probe_t); } while (0)

typedef const __attribute__((address_space(4))) P* KP;
__device__ __forceinline__ P load_params(KP kp) {
#if defined(__HIP_DEVICE_COMPILE__)
  asm volatile("" : "+s"(kp));
  return *kp;
#else
  return P{};
#endif
}
#define PP load_params(kp)
__global__ void __launch_bounds__(256, 2) k_mega(P p_unused) {
  KP kp = (KP)__builtin_amdgcn_kernarg_segment_ptr();
  __shared__ __attribute__((aligned(16))) float smem[18432 + 8];
  uint4& xb_words = *(uint4*)(smem + 18432);
  cg::grid_group grid = cg::this_grid();
  if (threadIdx.x == 0) xb_words = make_uint4(0u, 0u, 0u, 0u);
  __syncthreads();
  unsigned long long* probe_t = (unsigned long long*)(smem + 18436);
  int pcnt = 0;
  asm volatile("" : "+s"(pcnt));
  probe_tick(pcnt, probe_t);
  ph_mod(PP, smem);
  ph_prep(PP, smem);
  ph_lru_prepw(PP);
  ph_rope_tab(PP);
  ph_prep_small(PP);
  grid.sync();
  probe_tick(pcnt, probe_t);
  (void)xcd_barrier_post(PP.bar, (volatile LAS unsigned*)&xb_words);
  ph_norm_mod(PP, 0, 0, 0, smem, true);
  ph_shb(PP);
  BARRIER();
#pragma unroll 1
  for (int l = 0; l < 2; ++l) {
    const int t0 = (l == 0) ? 0 : LC;
    { const P lp = PP; gemm_bf16_128(lp, lp.hb, lp.w_in_t + (size_t)l * 1024 * DIN, 1024, 0, TT, DIN, (char*)smem, EpiProj{l}); }
    if (l == 0) {
      const P lp = PP;
      const int b0 = (130 * 18) % (int)gridDim.x;
      gemm_bf16_128(lp, lp.shb, lp.wq_t, 1024, 0, 128, NPQ, (char*)smem, EpiBias{lp.bq, NPQ}, -1, 0, b0);
      gemm_bf16_128(lp, lp.shb + 128 * 1024, lp.wq_t + (size_t)1024 * NPQ, 1024, 0, 128, NPQ, (char*)smem, EpiBias{lp.bq + 2 * NPQ, NPQ}, -1, 0, (b0 + 16) % (int)gridDim.x);
      gemm_bf16_128(lp, lp.shb + 2 * 128 * 1024, lp.w_in_t + (size_t)1024 * DIN, 1024, 0, 128, DIN, (char*)smem, EpiBias{lp.bin, DIN}, -1, 0, (b0 + 32) % (int)gridDim.x);
    }
    BARRIER();
    ph_lru<1>(PP, l, (char*)smem);
    ph_attn(PP, l, (char*)smem);
    BARRIER();
    ph_lru_carry(PP, smem);
    BARRIER();
    ph_lru<2>(PP, l, (char*)smem);
    BARRIER();
    { const P lp = PP; gemm_bf16_128(lp, lp.mixb, lp.w_out_t + (size_t)l * 1024 * 1024, 1024, t0, TT, 1024, (char*)smem, EpiResid{l}); }
    BARRIER();
    { const P lp = PP; gemm_bf16_128(lp, lp.hb, lp.wq_t + (size_t)l * 1024 * NPQ, 1024, t0, TT, NPQ, (char*)smem, EpiPeerTopk{l}); }
    BARRIER();
    { const P lp = PP; const int q = (32768 + (int)gridDim.x - 1) / (int)gridDim.x; peer_convert_rows(lp, l, min((int)blockIdx.x * q, 32768), min(((int)blockIdx.x + 1) * q, 32768)); }
    ph_peer_merge(PP, l, t0, (char*)smem);
    BARRIER();
    ph_peer_s1(PP, l, t0, load_xw(smem));
    BARRIER();
    ph_peer_r(PP, l, t0);
    BARRIER();
    ph_peer_s2(PP, l, t0, load_xw(smem), (char*)smem);
    if (l == 0) BARRIER();
  }
  if (PROBE_IV >= 0) {
    probe_tick(pcnt, probe_t);
    __syncthreads();
    if (blockIdx.x == 0 && threadIdx.x == 0) {
      const unsigned long long dt = (probe_t[1] - probe_t[0]) * 8ull, ts = __builtin_amdgcn_s_memrealtime();
      while (__builtin_amdgcn_s_memrealtime() - ts < dt) __builtin_amdgcn_s_sleep(8);
    }
  }
}

extern "C" void kernel_launch(void* const* d_in, const int* in_sizes, int n_in, void* d_out, int out_size, void* d_ws,
                              size_t ws_size, hipStream_t stream) {
  P p{};
  const float** fp = (const float**)&p;
  for (int i = 0; i < 28; ++i) fp[i] = (const float*)d_in[i];
  p.out = (float*)d_out;
  float* w = (float*)d_ws;
  size_t o = 0;
  auto carve = [&](size_t n) { float* r = w + o; o += (n + 63) & ~(size_t)63; return r; };
  p.bar = (unsigned*)carve(8192);
  p.mod = carve(4 * 6144);
  p.xall = carve((size_t)TT * 1024);
  p.proj = carve((size_t)TT * 512);
  p.projb = (bf16_t*)carve((size_t)TT * DIN / 2);
  p.mixb = (bf16_t*)carve((size_t)TT * 512);
  p.hb = (bf16_t*)carve((size_t)TT * 512);
  p.w_in_t = (bf16_t*)carve((size_t)1024 * DIN);
  p.w_out_t = (bf16_t*)carve((size_t)1024 * 1024);
  p.wq_t = (bf16_t*)carve((size_t)1024 * NPQ);
  p.lruw_t = (bf16_t*)carve((size_t)2 * 2 * 4 * 2 * 4096 / 2);
  p.lagg = carve((size_t)2 * NCHUNK * 256 * 2);
  p.lcarry = carve((size_t)2 * NCHUNK * 256);
  p.ropetab = carve(320 * 16 * 2);
  p.rowss = carve((size_t)8 * TT);
  p.bq = carve(4 * NPQ);
  p.bin = carve(2 * DIN);
  p.shb = (bf16_t*)carve(3 * 128 * 1024 / 2);
  p.el = (int*)carve((size_t)TT * 128);
  p.gl = carve((size_t)TT * 128);
  p.av = carve((size_t)TT * 128);
  p.pd = carve((size_t)8 * TT * 128);
  p.pk = (unsigned*)carve((size_t)TT * 256);
  p.ub8 = (unsigned char*)carve((size_t)2 * 16384 * 1024 / 4);
  p.vb8 = (unsigned char*)carve((size_t)2 * 16384 * 1024 / 4);
  p.usc = carve(2 * 16384);
  p.vsc = carve(2 * 16384);
  p.k1b = (bf16_t*)carve(16384);
  p.k2b = (bf16_t*)carve(16384);
  if (o * 4 > ws_size) { fprintf(stderr, "workspace too small: need %zu have %zu\n", o * 4, ws_size); return; }
  static int grid_blocks = 0;
  if (!grid_blocks) {
    int dev = 0, cus = 0, per_cu = 0;
    (void)hipGetDevice(&dev);
    (void)hipDeviceGetAttribute(&cus, hipDeviceAttributeMultiprocessorCount, dev);
    (void)hipOccupancyMaxActiveBlocksPerMultiprocessor(&per_cu, k_mega, 256, 0);
    if (per_cu > 2) per_cu = 2;
    grid_blocks = cus * per_cu;
  }
  (void)hipMemsetAsync(p.bar, 0, XCD_BAR_WORDS * 4, stream);
  void* args[] = {&p};
  hipError_t e = hipLaunchCooperativeKernel((void*)k_mega, dim3(grid_blocks), dim3(256), args, 0, stream);
  if (e != hipSuccess) fprintf(stderr, "cooperative launch failed: %s (grid %d)\n", hipGetErrorString(e), grid_blocks);
}
```

```cpp
#include <hip/hip_runtime.h>
#include <hip/hip_cooperative_groups.h>
#include <stdint.h>
#include <stdio.h>
namespace cg = cooperative_groups;

constexpr int DM = 1024, SEQ = 16384, LC = 256, TT = SEQ + LC, DIN = 2304, NPQ = 2048;
constexpr int OFF_XA = 0, OFF_GA = 256, OFF_QW = 512, OFF_KW = 896, OFF_VW = 1024, OFF_QN = 1152, OFF_KN = 1536, OFF_VN = 1920;
constexpr float EPS = 1e-6f;
#define LAS __attribute__((address_space(3)))
constexpr float LOG2E = 1.4426950408889634f;
constexpr float QSCALE = 0.125f * LOG2E;

struct P {
  const float *x, *c, *ctx, *c_ctx, *w_mod, *b_mod, *norm1_g, *norm2_g, *w_in, *w_out,
      *conv_w, *conv_b, *wa, *ba, *wx, *bx, *lam, *win_qn, *win_kn, *win_sink, *na_qn, *na_kn, *rpb,
      *wq, *k1, *k2, *pu, *pv;
  float* out;
  float *mod, *xall, *proj;
  unsigned short* projb;
  unsigned* pk;
  unsigned* bar;
  unsigned short *k1b, *k2b;
  unsigned char *ub8, *vb8;
  float *usc, *vsc;
  unsigned short *hb, *mixb, *w_in_t, *w_out_t, *wq_t, *lruw_t;
  float *lagg, *lcarry, *ropetab, *rowss, *bq, *bin, *gl, *av, *pd;
  unsigned short* shb;
  int* el;
  float2* lab;
};

typedef unsigned short bf16_t;
typedef __attribute__((ext_vector_type(8))) short bf16x8;
typedef __attribute__((ext_vector_type(4))) float f32x4;
typedef __attribute__((ext_vector_type(2))) float f32x2_cv;
typedef __attribute__((ext_vector_type(2))) __bf16 bf16x2_cv;
__device__ __forceinline__ unsigned pack2bf(float a, float b) {
  const f32x2_cv f = {a, b};
  return __builtin_bit_cast(unsigned, __builtin_convertvector(f, bf16x2_cv));
}
__device__ __forceinline__ unsigned short f2bf(float f) { return (unsigned short)(pack2bf(f, 0.f) & 0xffffu); }
__device__ __forceinline__ float bf2f(unsigned short h) { return __uint_as_float(((unsigned)h) << 16); }
#define PROBE_ROT 0
#ifndef F8_IN
#define F8_IN 1
#endif
#ifndef F8_OUT
#define F8_OUT 0
#endif
constexpr float F8_SA_H = 16.f;
constexpr float F8_SA_MIX = 8.f;
constexpr float F8_SB_W = 1024.f;
__device__ __forceinline__ float f8_clamp(float x) { return __builtin_amdgcn_fmed3f(x, -448.f, 448.f); }
__device__ __forceinline__ unsigned f8_pack2(float a, float b) { return (unsigned)__builtin_amdgcn_cvt_pk_fp8_f32(f8_clamp(a), f8_clamp(b), 0, false) & 0xffffu; }
__device__ __forceinline__ unsigned f8_pack4(float a, float b, float c, float d) {
  int t = __builtin_amdgcn_cvt_pk_fp8_f32(f8_clamp(a), f8_clamp(b), 0, false);
  t = __builtin_amdgcn_cvt_pk_fp8_f32(f8_clamp(c), f8_clamp(d), t, true);
  return (unsigned)t;
}


__device__ __forceinline__ float silu_f(float x) { return x / (1.f + __expf(-x)); }
__device__ __forceinline__ float sigmoid_f(float x) { return 1.f / (1.f + __expf(-x)); }
__device__ __forceinline__ float gelu_f(float x) {
  float u = 0.7978845608028654f * (x + 0.044715f * x * x * x);
  float e = __expf(2.f * u);
  float th = 1.f - 2.f / (e + 1.f);
  return 0.5f * x * (1.f + th);
}
template <int CTRL, int RMASK>
__device__ __forceinline__ float dpp_mov(float v) {
  return __int_as_float(__builtin_amdgcn_update_dpp(0, __float_as_int(v), CTRL, RMASK, 0xf, false));
}
__device__ __forceinline__ float wave_sum(float v) {
  v += dpp_mov<0xB1, 0xf>(v);
  v += dpp_mov<0x4E, 0xf>(v);
  v += dpp_mov<0x141, 0xf>(v);
  v += dpp_mov<0x140, 0xf>(v);
  v += dpp_mov<0x142, 0xa>(v);
  v += dpp_mov<0x143, 0xc>(v);
  return __int_as_float(__builtin_amdgcn_readlane(__float_as_int(v), 63));
}

__device__ __forceinline__ int tid_opaque() { int t = threadIdx.x; asm volatile("" : "+v"(t)); return t; }
#define GTID (blockIdx.x * blockDim.x + tid_opaque())
#define GSZ (gridDim.x * blockDim.x)

__device__ __forceinline__ void ph_mod(const P& p, float* smem) {
  const int tid = tid_opaque(), cl = tid & 31, ks = tid >> 5;
  float* sc0 = smem + 512;
  float* sc1 = smem + 1536;
  if ((int)blockIdx.x < 2 * 192) {
    __syncthreads();
    for (int k = tid; k < 1024; k += 256) { sc0[k] = silu_f(p.c[k]); sc1[k] = silu_f(p.c_ctx[k]); }
    __syncthreads();
  }
  for (int it = blockIdx.x; it < 2 * 192; it += gridDim.x) {
    const int nc = it % 192, l = it / 192;
    const int n = nc * 32 + cl;
    const float* w = p.w_mod + (size_t)l * 1024 * 6144 + n;
    float a0 = 0.f, a1 = 0.f;
#pragma unroll 1
    for (int i0 = 0; i0 < 128; i0 += 32) {
      float wv[32];
#pragma unroll
      for (int i = 0; i < 32; ++i) wv[i] = w[(size_t)((i0 + i) * 8 + ks) * 6144];
#pragma unroll
      for (int i = 0; i < 32; ++i) { const int k = (i0 + i) * 8 + ks; a0 += sc0[k] * wv[i]; a1 += sc1[k] * wv[i]; }
    }
    __syncthreads();
    smem[tid] = a0; smem[256 + tid] = a1;
    __syncthreads();
    if (tid < 64) {
      const int which = tid >> 5;
      float s = p.b_mod[l * 6144 + n];
#pragma unroll
      for (int q = 0; q < 8; ++q) s += smem[which * 256 + q * 32 + cl];
      p.mod[(l * 2 + which) * 6144 + n] = s;
    }
  }
}

__device__ __forceinline__ void ph_shb(const P& p) {
  for (int idx = GTID; idx < 3 * 2 * 1024; idx += GSZ) {
    const int k = idx & 1023, which = (idx >> 10) & 1, m = idx >> 11;
    const int l = (m == 0) ? 0 : 1, off = (m == 2) ? 0 : 3072;
    const float sv = p.mod[(l * 2 + which) * 6144 + off + k];
    if (m == 2 && F8_IN) ((unsigned char*)(p.shb + (size_t)2 * 128 * 1024))[which * 1024 + k] = (unsigned char)f8_pack2(sv * F8_SA_H, 0.f);
    else p.shb[((size_t)m * 128 + which) * 1024 + k] = f2bf(sv);
  }
}

__device__ __forceinline__ void ph_norm_mod(const P& p, int l, int which_norm, int t0, float* smem, bool from_input = false) {
  const float* g = (which_norm ? p.norm2_g : p.norm1_g) + l * 1024;
  const int sh_off = which_norm ? 3072 : 0, sc_off = which_norm ? 4096 : 1024;
  const int tid = tid_opaque(), lane = tid & 63, wv = tid >> 6;
  (void)smem;
  const int nw = gridDim.x * 4;
  for (int tb = t0 + blockIdx.x * 4 + wv; tb < TT; tb += 4 * nw) {
    float4 v[4][4];
#pragma unroll
    for (int u = 0; u < 4; ++u) {
      const int t = min(tb + u * nw, TT - 1);
      const float4* xp = (const float4*)(from_input ? (t < LC ? p.ctx + (size_t)t * 1024 : p.x + (size_t)(t - LC) * 1024) : p.xall + (size_t)t * 1024) + lane * 4;
#pragma unroll
      for (int q = 0; q < 4; ++q) v[u][q] = xp[q];
    }
#pragma unroll
    for (int u = 0; u < 4; ++u) {
      const int t = tb + u * nw;
      if (t < TT) {
        const float* mod = p.mod + (l * 2 + (t < LC ? 1 : 0)) * 6144;
        float ss = 0.f;
#pragma unroll
        for (int q = 0; q < 4; ++q) ss += v[u][q].x * v[u][q].x + v[u][q].y * v[u][q].y + v[u][q].z * v[u][q].z + v[u][q].w * v[u][q].w;
        ss = wave_sum(ss);
        const float rinv = rsqrtf(ss * (1.f / 1024.f) + EPS);
        unsigned w8[4], hb2[4][2];
#pragma unroll
        for (int q = 0; q < 4; ++q) {
          float4 gg = ((const float4*)g)[lane * 4 + q], sc = ((const float4*)(mod + sc_off))[lane * 4 + q], sh = ((const float4*)(mod + sh_off))[lane * 4 + q];
          float h0 = v[u][q].x * rinv * gg.x * (1.f + sc.x) + sh.x, h1 = v[u][q].y * rinv * gg.y * (1.f + sc.y) + sh.y;
          float h2 = v[u][q].z * rinv * gg.z * (1.f + sc.z) + sh.z, h3 = v[u][q].w * rinv * gg.w * (1.f + sc.w) + sh.w;
          w8[q] = f8_pack4(h0 * F8_SA_H, h1 * F8_SA_H, h2 * F8_SA_H, h3 * F8_SA_H);
          hb2[q][0] = pack2bf(h0, h1); hb2[q][1] = pack2bf(h2, h3);
        }
        if (F8_IN) *(uint4*)((unsigned char*)p.hb + (size_t)t * 1024 + lane * 16) = make_uint4(w8[0], w8[1], w8[2], w8[3]);
        else { uint2* hp = (uint2*)(p.hb + (size_t)t * 1024) + lane * 4;
#pragma unroll
          for (int q = 0; q < 4; ++q) hp[q] = make_uint2(hb2[q][0], hb2[q][1]); }
      }
    }
  }
}

template <bool F8>
__device__ __forceinline__ void prep_transpose(const float* W, void* Wtv, int K, int N, float* smem, int boff) {
  float(*ts)[65] = (float(*)[65])smem;
  const int tid = tid_opaque();
  const int tn = N / 64, nt = (K / 64) * tn;
  for (int it = ((int)blockIdx.x + (int)gridDim.x - boff) % (int)gridDim.x; it < nt; it += gridDim.x) {
    const int k0 = (it / tn) * 64, n0 = (it % tn) * 64;
    __syncthreads();
#pragma unroll
    for (int i = 0; i < 4; ++i) {
      const int r = (tid >> 4) + i * 16, c4 = (tid & 15) * 4;
      const float4 v = *(const float4*)(W + (size_t)(k0 + r) * N + n0 + c4);
      ts[r][c4] = v.x; ts[r][c4 + 1] = v.y; ts[r][c4 + 2] = v.z; ts[r][c4 + 3] = v.w;
    }
    __syncthreads();
#pragma unroll
    for (int i = 0; i < 2; ++i) {
      const int id = tid + 256 * i, n = id >> 3, kc = (id & 7) * 8;
      float v[8];
#pragma unroll
      for (int q = 0; q < 8; ++q) v[q] = ts[kc + q][n];
      if constexpr (F8)
        *(uint2*)((unsigned char*)Wtv + (size_t)(n0 + n) * K + k0 + kc) = make_uint2(f8_pack4(v[0] * F8_SB_W, v[1] * F8_SB_W, v[2] * F8_SB_W, v[3] * F8_SB_W),
                                                                                     f8_pack4(v[4] * F8_SB_W, v[5] * F8_SB_W, v[6] * F8_SB_W, v[7] * F8_SB_W));
      else
        *(uint4*)((bf16_t*)Wtv + (size_t)(n0 + n) * K + k0 + kc) = make_uint4(pack2bf(v[0], v[1]), pack2bf(v[2], v[3]), pack2bf(v[4], v[5]), pack2bf(v[6], v[7]));
    }
  }
}

__device__ __forceinline__ void ph_prep(const P& p, float* smem) {
  const int G = (int)gridDim.x;
  for (int l = 0; l < 2; ++l) {
    const int o_in = (l * 448) % G, o_out = (192 + l * 448) % G;
    if (F8_IN) prep_transpose<true>(p.w_in + (size_t)l * 1024 * DIN, (unsigned char*)p.w_in_t + (size_t)l * 1024 * DIN, 1024, DIN, smem, o_in);
    else prep_transpose<false>(p.w_in + (size_t)l * 1024 * DIN, p.w_in_t + (size_t)l * 1024 * DIN, 1024, DIN, smem, o_in);
    if (F8_OUT) prep_transpose<true>(p.w_out + (size_t)l * 1024 * 1024, (unsigned char*)p.w_out_t + (size_t)l * 1024 * 1024, 1024, 1024, smem, o_out);
    else prep_transpose<false>(p.w_out + (size_t)l * 1024 * 1024, p.w_out_t + (size_t)l * 1024 * 1024, 1024, 1024, smem, o_out);
    prep_transpose<false>(p.wq + (size_t)l * 1024 * NPQ, p.wq_t + (size_t)l * 1024 * NPQ, 1024, NPQ, smem, 0);
  }
}

__device__ __forceinline__ void ph_rope_tab(const P& p) {
  for (int idx = GTID; idx < 320 * 16; idx += GSZ) {
    int v = idx >> 4, j = idx & 15;
    float inv = __expf(-(float)j * (1.f / 16.f) * 9.210340371976184f);
    float ang = (float)(v < 256 ? v : v - 256) * inv;
    float k = rintf(ang * 0.15915494309189535f);
    float r = fmaf(-k, 6.2831854820251465f, ang);
    r = fmaf(-k, -1.7484555e-07f, r);
    ((float2*)p.ropetab)[idx] = make_float2(__cosf(r), __sinf(r));
  }
}

template <int CTRL>
__device__ __forceinline__ float dpp_row(float v) {
  return __int_as_float(__builtin_amdgcn_update_dpp(0, __float_as_int(v), CTRL, 0xf, 0xf, false));
}
struct EpiBias {
  __device__ __forceinline__ float pre(const P&, int, int) const { return 0.f; }
  float* dst; int N; float scale;
  __device__ __forceinline__ void operator()(const P& p, f32x4 (&acc)[4][4], int m0, int n0, int wm, int wn, int lane, char* smem, float epre) const {
    if (wm == 0 && (lane >> 4) == 0) {
      const int col = n0 + wn * 64 + (lane & 15);
#pragma unroll
      for (int j = 0; j < 4; ++j) { dst[col + 16 * j] = acc[0][j][0] * scale; dst[N + col + 16 * j] = acc[0][j][1] * scale; }
    }
  }
};
struct EpiProj {
  int l;
  __device__ __forceinline__ float pre(const P& p, int m0, int tid) const {
    float s = 0.f;
    if (l == 1 && tid < 128) {
#pragma unroll
      for (int q = 0; q < 8; ++q) s += p.rowss[(size_t)q * TT + m0 + tid];
    }
    return s;
  }
  __device__ __forceinline__ void operator()(const P& p, f32x4 (&acc)[4][4], int m0, int n0, int wm, int wn, int lane, char* smem, float epre) const {
    const int g = lane >> 4, lr = lane & 15;
    const int mw0 = m0 + wm * 64, nw0 = n0 + wn * 64;
    {
      constexpr float inv = F8_IN ? 1.f / (F8_SA_H * F8_SB_W) : 1.f;
#pragma unroll
      for (int i = 0; i < 4; ++i)
#pragma unroll
        for (int j = 0; j < 4; ++j) acc[i][j] *= inv;
    }
    if (l == 1) {
      float* rinvl = (float*)smem;
      const int tid = ((wm * 2 + wn) << 6) | lane;
      if (tid < 128) rinvl[tid] = rsqrtf(epre * (1.f / 1024.f) + EPS);
      __syncthreads();
      const float* bb = p.bin + (m0 < LC ? 1 : 0) * DIN + nw0 + lr;
      float bv[4];
#pragma unroll
      for (int j = 0; j < 4; ++j) bv[j] = bb[16 * j];
#pragma unroll
      for (int i = 0; i < 4; ++i)
#pragma unroll
        for (int r = 0; r < 4; ++r) {
          const float rv = rinvl[wm * 64 + 16 * i + 4 * g + r];
#pragma unroll
          for (int j = 0; j < 4; ++j) acc[i][j][r] = acc[i][j][r] * rv + bv[j];
        }
    }
    if (n0 < 512) {
#pragma unroll
      for (int i = 0; i < 4; ++i)
#pragma unroll
        for (int r = 0; r < 4; ++r) {
          int row = mw0 + 16 * i + 4 * g + r;
#pragma unroll
          for (int j = 0; j < 4; ++j) p.proj[(size_t)row * 512 + nw0 + 16 * j + lr] = acc[i][j][r];
        }
      return;
    }
    const float* gain = nullptr; bool rope = false; float scale = 1.f;
    if (nw0 < 896) { gain = p.win_qn + l * 64; rope = true; scale = QSCALE; }
    else if (nw0 < 1024) { gain = p.win_kn + l * 64; rope = true; }
    else if (nw0 < 1152) { }
    else if (nw0 < 1536) { gain = p.na_qn + l * 64; scale = QSCALE; }
    else if (nw0 < 1920) { gain = p.na_kn + l * 64; }
    rope = rope && (m0 >= LC);
    float gj[4] = {1.f, 1.f, 1.f, 1.f};
    if (gain) {
#pragma unroll
      for (int j = 0; j < 4; ++j) gj[j] = gain[16 * j + lr] * scale;
    }
#pragma unroll
    for (int i = 0; i < 4; ++i)
#pragma unroll
      for (int r = 0; r < 4; ++r) {
        const int row = mw0 + 16 * i + 4 * g + r;
        float y[4] = {acc[i][0][r], acc[i][1][r], acc[i][2][r], acc[i][3][r]};
        if (gain) {
          float ss = y[0] * y[0] + y[1] * y[1] + y[2] * y[2] + y[3] * y[3];
          ss += dpp_row<0xB1>(ss);
          ss += dpp_row<0x4E>(ss);
          ss += dpp_row<0x141>(ss);
          ss += dpp_row<0x140>(ss);
          const float rinv = rsqrtf(ss * (1.f / 64.f) + EPS);
#pragma unroll
          for (int j = 0; j < 4; ++j) y[j] *= rinv * gj[j];
        }
        if (rope) {
          const int pos = row - LC;
          const float2 tr = ((const float2*)p.ropetab)[(pos >> 6) * 16 + lr];
          const float2 tc = ((const float2*)p.ropetab)[(256 + (pos & 63)) * 16 + lr];
          float a0 = y[0] * tr.x - y[1] * tr.y, a1 = y[0] * tr.y + y[1] * tr.x;
          float a2 = y[2] * tc.x - y[3] * tc.y, a3 = y[2] * tc.y + y[3] * tc.x;
          y[0] = a0; y[1] = a1; y[2] = a2; y[3] = a3;
        }
#pragma unroll
        for (int j = 0; j < 4; ++j) p.projb[(size_t)row * DIN + nw0 + 16 * j + lr] = f2bf(y[j]);
      }
  }
};
struct EpiResid {
  __device__ __forceinline__ float pre(const P&, int, int) const { return 0.f; }
  int l;
  __device__ __forceinline__ void operator()(const P& p, f32x4 (&acc)[4][4], int m0, int n0, int wm, int wn, int lane, char* smem, float epre) const {
    float* tile = (float*)smem;
    const int tid = ((wm * 2 + wn) << 6) | lane, c8 = tid & 15, rsub = tid >> 4;
    const int col = n0 + 8 * c8;
    float4 xa[8][2];
#pragma unroll
    for (int it = 0; it < 8; ++it) {
      const int row = m0 + it * 16 + rsub;
      const float4* xi = (l == 0) ? (const float4*)((row < LC ? p.ctx + (size_t)row * 1024 : p.x + (size_t)(row - LC) * 1024) + col)
                                  : (const float4*)(p.xall + (size_t)row * 1024 + col);
      xa[it][0] = xi[0]; xa[it][1] = xi[1];
    }
    {
      const int g = lane >> 4, lr = lane & 15;
      float* tw = tile + (wm * 64 + 4 * g) * 132 + wn * 64 + lr;
#pragma unroll
      for (int i = 0; i < 4; ++i)
#pragma unroll
        for (int r = 0; r < 4; ++r)
#pragma unroll
          for (int j = 0; j < 4; ++j) tw[(16 * i + r) * 132 + 16 * j] = acc[i][j][r] * (F8_OUT ? 1.f / (F8_SA_MIX * F8_SB_W) : 1.f);
    }
    __syncthreads();
    const float* mod = p.mod + (l * 2 + (m0 < LC ? 1 : 0)) * 6144;
    float g1v[8], gs[8];
    {
      const float4 a0 = *(const float4*)(mod + 2048 + col), a1 = *(const float4*)(mod + 2048 + col + 4);
      const float4 s0 = *(const float4*)(mod + 4096 + col), s1 = *(const float4*)(mod + 4096 + col + 4);
      const float4 n0v = *(const float4*)(p.norm2_g + l * 1024 + col), n1v = *(const float4*)(p.norm2_g + l * 1024 + col + 4);
      g1v[0] = a0.x; g1v[1] = a0.y; g1v[2] = a0.z; g1v[3] = a0.w; g1v[4] = a1.x; g1v[5] = a1.y; g1v[6] = a1.z; g1v[7] = a1.w;
      gs[0] = n0v.x * (1.f + s0.x); gs[1] = n0v.y * (1.f + s0.y); gs[2] = n0v.z * (1.f + s0.z); gs[3] = n0v.w * (1.f + s0.w);
      gs[4] = n1v.x * (1.f + s1.x); gs[5] = n1v.y * (1.f + s1.y); gs[6] = n1v.z * (1.f + s1.z); gs[7] = n1v.w * (1.f + s1.w);
    }
#pragma unroll
    for (int it = 0; it < 8; ++it) {
      const int rl = it * 16 + rsub, row = m0 + rl;
      float4* xp = (float4*)(p.xall + (size_t)row * 1024 + col);
      float4 x0 = xa[it][0], x1 = xa[it][1];
      const float4 t0 = *(const float4*)(tile + rl * 132 + 8 * c8), t1 = *(const float4*)(tile + rl * 132 + 8 * c8 + 4);
      x0.x += g1v[0] * t0.x; x0.y += g1v[1] * t0.y; x0.z += g1v[2] * t0.z; x0.w += g1v[3] * t0.w;
      x1.x += g1v[4] * t1.x; x1.y += g1v[5] * t1.y; x1.z += g1v[6] * t1.z; x1.w += g1v[7] * t1.w;
      xp[0] = x0; xp[1] = x1;
      float ss = x0.x * x0.x + x0.y * x0.y + x0.z * x0.z + x0.w * x0.w + x1.x * x1.x + x1.y * x1.y + x1.z * x1.z + x1.w * x1.w;
      ss += dpp_row<0xB1>(ss);
      ss += dpp_row<0x4E>(ss);
      ss += dpp_row<0x141>(ss);
      ss += dpp_row<0x140>(ss);
      *(uint4*)(p.hb + (size_t)row * 1024 + col) = make_uint4(pack2bf(x0.x * gs[0], x0.y * gs[1]), pack2bf(x0.z * gs[2], x0.w * gs[3]),
                                                            pack2bf(x1.x * gs[4], x1.y * gs[5]), pack2bf(x1.z * gs[6], x1.w * gs[7]));
      if (c8 == 0) p.rowss[(size_t)(n0 >> 7) * TT + row] = ss;
    }
  }
};

template <int CTRL, int RMASK>
__device__ __forceinline__ float dpp_mov_id(float v) {
  return __int_as_float(__builtin_amdgcn_update_dpp(__float_as_int(v), __float_as_int(v), CTRL, RMASK, 0xf, false));
}
__device__ __forceinline__ float wave_max(float v) {
  v = fmaxf(v, dpp_mov_id<0xB1, 0xf>(v));
  v = fmaxf(v, dpp_mov_id<0x4E, 0xf>(v));
  v = fmaxf(v, dpp_mov_id<0x141, 0xf>(v));
  v = fmaxf(v, dpp_mov_id<0x140, 0xf>(v));
  v = fmaxf(v, dpp_mov_id<0x142, 0xa>(v));
  v = fmaxf(v, dpp_mov_id<0x143, 0xc>(v));
  return __int_as_float(__builtin_amdgcn_readlane(__float_as_int(v), 63));
}

typedef __attribute__((ext_vector_type(2))) float f32x2;
struct XcdWork { int li, np, rank, nloc; };
#define AGE_WF 3
#define AGE_WS 2
struct AgeSplit { int begin, end, step; };
__device__ __forceinline__ AgeSplit load_age_split(const float* smem, int t0, int wv) {
  const volatile LAS unsigned* st = (const volatile LAS unsigned*)(smem + 18432);
  const int cls = __builtin_amdgcn_readfirstlane((int)st[4]), crank = __builtin_amdgcn_readfirstlane((int)st[5]);
  const int nF = __builtin_amdgcn_readfirstlane((int)st[6]), nS = __builtin_amdgcn_readfirstlane((int)st[7]);
  const int N = TT - t0;
  const int NA = (int)(((long long)N * (nF * AGE_WF)) / (long long)(nF * AGE_WF + nS * AGE_WS)) & ~3;
  AgeSplit a;
  a.begin = (cls == 0 ? t0 : t0 + NA) + crank * 4 + wv;
  a.end = cls == 0 ? t0 + NA : TT;
  a.step = (cls == 0 ? nF : nS) * 4;
  return a;
}

__device__ __forceinline__ XcdWork load_xw(const float* smem) {
  const volatile LAS unsigned* st = (const volatile LAS unsigned*)(smem + 18432);
  XcdWork xw;
  xw.nloc = __builtin_amdgcn_readfirstlane((int)st[0]); xw.np = __builtin_amdgcn_readfirstlane((int)st[1]);
  xw.rank = __builtin_amdgcn_readfirstlane((int)st[2]); xw.li = __builtin_amdgcn_readfirstlane((int)st[3]);
  return xw;
}
__device__ __forceinline__ int gemm_swz(int row) { return (0x78 >> (((row >> 2) & 3) * 2)) & 3; }
template <bool F8, class Epi>
__device__ __forceinline__ void gemm_128(const P& p, const void* __restrict__ Av, const void* __restrict__ Btv, int K, int m_begin, int m_end,
                              int N, char* smem, const Epi& epi, int boff = 0, const XcdWork* xw = nullptr) {
  const unsigned char* A = (const unsigned char*)Av;
  const unsigned char* Bt = (const unsigned char*)Btv;
  constexpr int EB = F8 ? 1 : 2;
  const int tid = tid_opaque(), lane = tid & 63, wv = __builtin_amdgcn_readfirstlane(tid >> 6), wm = wv >> 1, wn = wv & 1;
  const int tiles_n = N / 128, tiles_m = (m_end - m_begin) / 128;
  const int nk = (K * EB) / 64;
  const int lr = lane & 15, g = lane >> 4;
  const int a_rd = (wm * 64 + lr) * 64 + ((g ^ gemm_swz(lr)) << 4);
  const int b_rd = 8192 + (wn * 64 + lr) * 64 + ((g ^ gemm_swz(lr)) << 4);
  const int a8_0 = (wm * 64 + lr) * 64 + ((((g >> 1)) ^ gemm_swz(lr)) << 4) + 8 * (g & 1);
  const int a8_1 = (wm * 64 + lr) * 64 + (((2 + (g >> 1)) ^ gemm_swz(lr)) << 4) + 8 * (g & 1);
  const int b8_0 = 8192 + (wn * 64 + lr) * 64 + ((((g >> 1)) ^ gemm_swz(lr)) << 4) + 8 * (g & 1);
  const int b8_1 = 8192 + (wn * 64 + lr) * 64 + (((2 + (g >> 1)) ^ gemm_swz(lr)) << 4) + 8 * (g & 1);
  const int ld_row = lane >> 2, ld_c = (lane & 3) ^ gemm_swz(ld_row);
  const int t_first = xw ? xw->rank : ((int)blockIdx.x + (int)gridDim.x - boff) % (int)gridDim.x;
  const int t_step = xw ? xw->nloc : (int)gridDim.x;
  for (int tile = t_first;; tile += t_step) {
    int mt, nt;
    if (xw) { mt = xw->li + (tile / tiles_n) * xw->np; nt = tile % tiles_n; if (mt >= tiles_m) break; }
    else { if (tile >= tiles_m * tiles_n) break; mt = tile / tiles_n; nt = tile % tiles_n; }
    const int m0 = m_begin + mt * 128, n0 = nt * 128;
    f32x4 acc[4][4];
#pragma unroll
    for (int i = 0; i < 4; ++i)
#pragma unroll
      for (int j = 0; j < 4; ++j) acc[i][j] = (f32x4){0.f, 0.f, 0.f, 0.f};
    const __amdgpu_buffer_rsrc_t rsA = __builtin_amdgcn_make_buffer_rsrc((void*)(A + (size_t)m0 * K * EB), (short)0, 128 * K * EB, 0x00020000);
    const __amdgpu_buffer_rsrc_t rsB = __builtin_amdgcn_make_buffer_rsrc((void*)(Bt + (size_t)n0 * K * EB), (short)0, 128 * K * EB, 0x00020000);
    const int voff = (wv * 32 + ld_row) * K * EB + ld_c * 16;
    auto issue1 = [&](int st, int kt, int piece) {
      char* base = smem + st * 16384 + wv * 2048 + (piece & 1) * 1024 + (piece >> 1) * 8192;
      __builtin_amdgcn_raw_ptr_buffer_load_lds((piece >> 1) ? rsB : rsA, (__attribute__((address_space(3))) void*)base, 16, voff,
                                               kt * 64 + (piece & 1) * 16 * K * EB, 0, 0);
    };
    auto issue = [&](int st, int kt) { issue1(st, kt, 0); issue1(st, kt, 2); issue1(st, kt, 1); issue1(st, kt, 3); };
    issue(0, 0); issue(1, 1); issue(2, 2);
    const float epre = epi.pre(p, m0, tid);
    for (int kt0 = 0; kt0 < nk; kt0 += 4) {
#pragma unroll
      for (int u = 0; u < 4; ++u) {
        const int kt = kt0 + u, rem = nk - kt;
        if (rem >= 3) asm volatile("s_waitcnt vmcnt(8) lgkmcnt(0)" ::: "memory");
        else if (rem == 2) asm volatile("s_waitcnt vmcnt(4) lgkmcnt(0)" ::: "memory");
        else asm volatile("s_waitcnt vmcnt(0) lgkmcnt(0)" ::: "memory");
        __builtin_amdgcn_s_barrier();
        const bool pf = kt + 3 < nk;
        if constexpr (!F8) {
          bf16x8 af[4], bfr[4];
#pragma unroll
          for (int i = 0; i < 4; ++i) af[i] = *(const bf16x8*)(smem + u * 16384 + a_rd + i * 1024);
#pragma unroll
          for (int j = 0; j < 4; ++j) bfr[j] = *(const bf16x8*)(smem + u * 16384 + b_rd + j * 1024);
#pragma unroll
          for (int i = 0; i < 4; ++i) {
#pragma unroll
            for (int j = 0; j < 4; ++j) acc[i][j] = __builtin_amdgcn_mfma_f32_16x16x32_bf16(af[i], bfr[j], acc[i][j], 0, 0, 0);
            if (pf) issue1((u + 3) & 3, kt + 3, i);
          }
        } else {
          long af[2][4], bfr[2][4];
#pragma unroll
          for (int i = 0; i < 4; ++i) { af[0][i] = *(const long*)(smem + u * 16384 + a8_0 + i * 1024); af[1][i] = *(const long*)(smem + u * 16384 + a8_1 + i * 1024); }
#pragma unroll
          for (int j = 0; j < 4; ++j) { bfr[0][j] = *(const long*)(smem + u * 16384 + b8_0 + j * 1024); bfr[1][j] = *(const long*)(smem + u * 16384 + b8_1 + j * 1024); }
#pragma unroll
          for (int s = 0; s < 2; ++s)
#pragma unroll
            for (int i = 0; i < 4; ++i) {
#pragma unroll
              for (int j = 0; j < 4; ++j) acc[i][j] = __builtin_amdgcn_mfma_f32_16x16x32_fp8_fp8(af[s][i], bfr[s][j], acc[i][j], 0, 0, 0);
              if (pf && s == 0) issue1((u + 3) & 3, kt + 3, i);
            }
        }
      }
    }
    __syncthreads();
    epi(p, acc, m0, n0, wm, wn, lane, smem, epre);
    __syncthreads();
  }
}

constexpr int NCHUNK = TT / 64;
__device__ __forceinline__ int lru_pos(int dir, int c) { return dir == 0 ? c : (c < 4 ? 3 - c : 4 + (NCHUNK - 1 - c)); }

__device__ __forceinline__ void ph_lru_prepw(const P& p) {
  for (int idx = GTID; idx < 2 * 2 * 4 * 2 * 4096; idx += GSZ) {
    int d = idx & 63, e = (idx >> 6) & 63, mtx = (idx >> 12) & 1, rest = idx >> 13;
    const float* w = (mtx ? p.wx : p.wa) + (size_t)rest * 4096;
    p.lruw_t[idx] = f2bf(w[d * 64 + e]);
  }
}

template <int PASS>
__device__ __forceinline__ void lru_item(const P& p, int l, int cidx, int kb, char* smem) {
  bf16_t* u_img = (bf16_t*)smem;
  const int tid = tid_opaque(), lane = tid & 63, wv = tid >> 6, g = lane >> 4, lr = lane & 15;
  const int t0 = cidx * 64;
  const int lo = t0 < LC ? 0 : LC, hi = t0 < LC ? LC : TT;
  const int chw = 16 * wv + lr, cw = kb * 64 + chw;
  __syncthreads();
  bf16x8 wfa[2][2], wfx[2][2];
  float bav2[2], bxv2[2], lam2[2], cin[2] = {0.f, 0.f};
#pragma unroll
  for (int dir = 0; dir < 2; ++dir) {
    const int pd = l * 2 + dir;
    const bf16_t* wbase = p.lruw_t + (size_t)((pd * 4 + kb) * 2) * 4096 + chw * 64 + 8 * g;
    if (PASS == 1) {
#pragma unroll
      for (int s = 0; s < 2; ++s) { wfa[dir][s] = *(const bf16x8*)(wbase + 32 * s); wfx[dir][s] = *(const bf16x8*)(wbase + 4096 + 32 * s); }
      bav2[dir] = p.ba[pd * 256 + cw]; bxv2[dir] = p.bx[pd * 256 + cw]; lam2[dir] = p.lam[pd * 256 + cw];
    }
    if (PASS == 2) cin[dir] = p.lcarry[((size_t)dir * NCHUNK + lru_pos(dir, cidx)) * 256 + cw];
  }
  float gav[4][4];
  if (PASS == 2) {
#pragma unroll
    for (int i = 0; i < 4; ++i)
#pragma unroll
      for (int r = 0; r < 4; ++r) gav[i][r] = p.proj[(size_t)(t0 + 16 * i + 4 * g + r) * 512 + OFF_GA + cw];
  }
  if (PASS == 1) {
    const int ch = tid & 63, c = kb * 64 + ch, sg = tid >> 6;
    const float cb = p.conv_b[l * 256 + c];
    float cw4[4];
#pragma unroll
    for (int k = 0; k < 4; ++k) cw4[k] = p.conv_w[(l * 4 + k) * 256 + c];
    float xr[19];
#pragma unroll
    for (int i = 0; i < 19; ++i) {
      int tt = t0 + sg * 16 + i - 2;
      int tc = tt < lo ? lo : (tt >= hi ? hi - 1 : tt);
      float v = p.proj[(size_t)tc * 512 + OFF_XA + c];
      xr[i] = (tt >= lo && tt < hi) ? v : 0.f;
    }
#pragma unroll
    for (int i = 0; i < 16; ++i) {
      int row = sg * 16 + i;
      float acc = cb + cw4[0] * xr[i] + cw4[1] * xr[i + 1] + cw4[2] * xr[i + 2] + cw4[3] * xr[i + 3];
      u_img[row * 64 + ((((ch >> 3) ^ (row & 7)) << 3) | (ch & 7))] = f2bf(acc);
    }
  }
  __syncthreads();
  float hs0[4][4];
#pragma unroll
  for (int dir = 0; dir < 2; ++dir) {
    float av[4][4], bv[4][4];
    float2* abp = p.lab + ((size_t)((cidx * 4 + kb) * 2 + dir) * 16) * 256 + tid;
    if (PASS == 2) {
#pragma unroll
      for (int i = 0; i < 4; ++i)
#pragma unroll
        for (int r = 0; r < 4; ++r) { const float2 ab = abp[(i * 4 + r) * 256]; av[i][r] = ab.x; bv[i][r] = ab.y; }
    } else {
    f32x4 ga[4], gx[4];
#pragma unroll
    for (int i = 0; i < 4; ++i) { ga[i] = (f32x4){0.f, 0.f, 0.f, 0.f}; gx[i] = (f32x4){0.f, 0.f, 0.f, 0.f}; }
#pragma unroll
    for (int s = 0; s < 2; ++s) {
      const bf16x8 ba_ = dir == 0 ? wfa[0][s] : wfa[1][s];
      const bf16x8 bx_ = dir == 0 ? wfx[0][s] : wfx[1][s];
#pragma unroll
      for (int i = 0; i < 4; ++i) {
        int row = 16 * i + lr;
        bf16x8 af = *(const bf16x8*)((const char*)u_img + row * 128 + (((4 * s + g) ^ (row & 7)) << 4));
        ga[i] = __builtin_amdgcn_mfma_f32_16x16x32_bf16(af, ba_, ga[i], 0, 0, 0);
        gx[i] = __builtin_amdgcn_mfma_f32_16x16x32_bf16(af, bx_, gx[i], 0, 0, 0);
      }
    }
    const float bav = dir == 0 ? bav2[0] : bav2[1], bxv = dir == 0 ? bxv2[0] : bxv2[1];
    const float sp = log1pf(expf(-(dir == 0 ? lam2[0] : lam2[1])));
#pragma unroll
    for (int i = 0; i < 4; ++i)
#pragma unroll
      for (int r = 0; r < 4; ++r) {
        const int row = 16 * i + 4 * g + r;
        float rr = sigmoid_f(ga[i][r] + bav), ig = sigmoid_f(gx[i][r] + bxv);
        float log_a = -8.f * rr * sp;
        float a = __expf(log_a);
        float uu = bf2f(u_img[row * 64 + ((((chw >> 3) ^ (row & 7)) << 3) | (chw & 7))]);
        const float x2 = 2.f * log_a;
        const float ser = -x2 * (1.f + x2 * (0.5f + x2 * (0.16666667f + x2 * (0.041666668f + x2 * 0.0083333338f))));
        const float om = x2 > -0.25f ? ser : 1.f - a * a;
        av[i][r] = a;
        bv[i][r] = sqrtf(om) * ig * uu;
        abp[(i * 4 + r) * 256] = make_float2(av[i][r], bv[i][r]);
      }
    }
    float As[4], Bs[4];
#pragma unroll
    for (int i = 0; i < 4; ++i) {
      float A = 1.f, B = 0.f;
#pragma unroll
      for (int rr = 0; rr < 4; ++rr) { const int r = dir == 0 ? rr : 3 - rr; B = av[i][r] * B + bv[i][r]; A *= av[i][r]; }
      As[i] = A; Bs[i] = B;
    }
    const int lg = dir == 0 ? g : 3 - g;
    const int src1 = dir == 0 ? lane - 16 : lane + 16, src2 = dir == 0 ? lane - 32 : lane + 32;
    float Ai[4], Bi[4];
#pragma unroll
    for (int i = 0; i < 4; ++i) {
      float A = As[i], B = Bs[i];
      { float Ap = __shfl(A, src1 & 63), Bp = __shfl(B, src1 & 63); if (lg >= 1) { B = A * Bp + B; A = Ap * A; } }
      { float Ap = __shfl(A, src2 & 63), Bp = __shfl(B, src2 & 63); if (lg >= 2) { B = A * Bp + B; A = Ap * A; } }
      Ai[i] = A; Bi[i] = B;
    }
    const int lastl = (dir == 0 ? 48 : 0) + lr;
    float Ae[4], Be[4], At[4], Bt[4];
#pragma unroll
    for (int i = 0; i < 4; ++i) {
      float Ap = __shfl(Ai[i], src1 & 63), Bp = __shfl(Bi[i], src1 & 63);
      Ae[i] = lg >= 1 ? Ap : 1.f; Be[i] = lg >= 1 ? Bp : 0.f;
      At[i] = __shfl(Ai[i], lastl); Bt[i] = __shfl(Bi[i], lastl);
    }
    if (PASS == 1) {
      float A = 1.f, B = 0.f;
#pragma unroll
      for (int ii = 0; ii < 4; ++ii) { const int i = dir == 0 ? ii : 3 - ii; B = At[i] * B + Bt[i]; A *= At[i]; }
      if (g == 0) {
        float2* ag = (float2*)p.lagg + ((size_t)dir * NCHUNK + lru_pos(dir, cidx)) * 256 + cw;
        *ag = make_float2(A, B);
      }
    } else {
      float R = dir == 0 ? cin[0] : cin[1];
#pragma unroll
      for (int ii = 0; ii < 4; ++ii) {
        const int i = dir == 0 ? ii : 3 - ii;
        float h = Ae[i] * R + Be[i];
#pragma unroll
        for (int rr = 0; rr < 4; ++rr) {
          const int r = dir == 0 ? rr : 3 - rr;
          h = av[i][r] * h + bv[i][r];
          if (dir == 0) hs0[i][r] = h;
          else if (F8_OUT) ((unsigned char*)p.mixb)[(size_t)(t0 + 16 * i + 4 * g + r) * 1024 + cw] = (unsigned char)f8_pack2((hs0[i][r] + h) * gelu_f(gav[i][r]) * F8_SA_MIX, 0.f);
          else u_img[(16 * i + 4 * g + r) * 64 + chw] = f2bf((hs0[i][r] + h) * gelu_f(gav[i][r]));
        }
        R = At[i] * R + Bt[i];
      }
    }
  }
  if (PASS == 2 && !F8_OUT) {
    __syncthreads();
    const int row = tid >> 2, q4 = tid & 3;
    const uint4* sp = (const uint4*)(u_img + row * 64 + q4 * 16);
    uint4* dp = (uint4*)(p.mixb + (size_t)(t0 + row) * 1024 + kb * 64 + q4 * 16);
    dp[0] = sp[0]; dp[1] = sp[1];
  }
}

__device__ __forceinline__ void ph_lru_carry(const P& p, float* smem) {
  const int tid = tid_opaque(), seg = tid >> 4, c16 = tid & 15;
  for (int blk = blockIdx.x; blk < 32; blk += gridDim.x) {
    const int dc = blk * 16 + c16, dir = dc >> 8, ch = dc & 255;
    const float2* ag = (const float2*)p.lagg + (size_t)dir * NCHUNK * 256 + ch;
    float2 v[17];
#pragma unroll
    for (int i = 0; i < 17; ++i) {
      int pos = seg * 17 + i;
      v[i] = pos < NCHUNK ? ag[(size_t)pos * 256] : make_float2(1.f, 0.f);
    }
    float A = 1.f, B = 0.f;
#pragma unroll
    for (int i = 0; i < 17; ++i) { B = v[i].x * B + v[i].y; A *= v[i].x; }
    __syncthreads();
    smem[(seg * 16 + c16) * 2] = A; smem[(seg * 16 + c16) * 2 + 1] = B;
    __syncthreads();
    float h = 0.f;
    for (int s2 = 0; s2 < seg; ++s2) h = smem[(s2 * 16 + c16) * 2] * h + smem[(s2 * 16 + c16) * 2 + 1];
    float* cr = p.lcarry + (size_t)dir * NCHUNK * 256 + ch;
#pragma unroll
    for (int i = 0; i < 17; ++i) {
      int pos = seg * 17 + i;
      if (pos < NCHUNK) cr[(size_t)pos * 256] = h;
      h = v[i].x * h + v[i].y;
    }
  }
}

template <int PASS>
__device__ __forceinline__ void ph_lru(const P& p, int l, char* smem) {
  const int c_begin = (PASS == 2 && l == 1) ? 4 : 0;
  const int nitems = (NCHUNK - c_begin) * 4;
  for (int it = blockIdx.x; it < nitems; it += gridDim.x) lru_item<PASS>(p, l, c_begin + (it >> 2), it & 3, smem);
}

typedef __attribute__((ext_vector_type(4))) short s16x4;
typedef __attribute__((ext_vector_type(4))) unsigned u32x4;

template <class TokFn>
__device__ __forceinline__ void kv_issue(const P& p, char* stage, int koff, int voff, TokFn tok, int wv, int lane) {
#pragma unroll
  for (int i = 0; i < 2; ++i) {
    const int row = 16 * wv + 8 * i + (lane >> 3);
    const bf16_t* src = p.projb + (size_t)tok(row) * DIN + (((lane & 7) ^ (row & 7)) << 3);
    char* dst = stage + (2 * wv + i) * 1024;
    __builtin_amdgcn_global_load_lds((const unsigned*)(src + koff), (__attribute__((address_space(3))) unsigned*)dst, 16, 0, 0);
    __builtin_amdgcn_global_load_lds((const unsigned*)(src + voff), (__attribute__((address_space(3))) unsigned*)(dst + 8192), 16, 0, 0);
  }
}
__device__ __forceinline__ void kv_wait(int rem) {
  if (rem >= 3) asm volatile("s_waitcnt vmcnt(8) lgkmcnt(0)" ::: "memory");
  else if (rem == 2) asm volatile("s_waitcnt vmcnt(4) lgkmcnt(0)" ::: "memory");
  else asm volatile("s_waitcnt vmcnt(0) lgkmcnt(0)" ::: "memory");
  __builtin_amdgcn_s_barrier();
}

template <class MaskFn>
__device__ __forceinline__ void attn_step2(const char* stage, int kr0, const bf16x8 (&qf)[2][2], f32x4 (&o)[2][4], float (&lsum)[2], MaskFn mb,
                                           int lane, bool act0, bool act1) {
  const int g = lane >> 4, lr = lane & 15;
  bf16x8 kf[2][2];
#pragma unroll
  for (int t2 = 0; t2 < 2; ++t2) {
    const int row = kr0 + 16 * t2 + lr;
#pragma unroll
    for (int s = 0; s < 2; ++s) kf[t2][s] = *(const bf16x8*)(stage + row * 128 + (((4 * s + g) ^ (row & 7)) << 4));
  }
  bf16x8 pb[2];
  u32x4 pw[2];
#pragma unroll
  for (int qt = 0; qt < 2; ++qt) {
    if (qt == 0 ? act0 : act1) {
      f32x4 st[2];
#pragma unroll
      for (int t2 = 0; t2 < 2; ++t2) {
        st[t2] = (f32x4){0.f, 0.f, 0.f, 0.f};
#pragma unroll
        for (int s = 0; s < 2; ++s) st[t2] = __builtin_amdgcn_mfma_f32_16x16x32_bf16(kf[t2][s], qf[qt][s], st[t2], 0, 0, 0);
      }
#pragma unroll
      for (int t2 = 0; t2 < 2; ++t2) {
        float pv[4];
#pragma unroll
        for (int r = 0; r < 4; ++r) { pv[r] = __builtin_amdgcn_exp2f(mb(qt, t2, r, st[t2][r])); lsum[qt] += pv[r]; }
        pw[qt][2 * t2] = pack2bf(pv[0], pv[1]); pw[qt][2 * t2 + 1] = pack2bf(pv[2], pv[3]);
      }
      pb[qt] = __builtin_bit_cast(bf16x8, pw[qt]);
    }
  }
  const int q = lr >> 2, pp = lane & 3;
#pragma unroll
  for (int m = 0; m < 4; ++m) {
    s16x4 vh[2];
#pragma unroll
    for (int t = 0; t < 2; ++t) {
      const int row = kr0 + 16 * t + 4 * g + q;
      const char* addr = stage + 8192 + row * 128 + (((2 * m + (pp >> 1)) ^ (row & 7)) << 4) + 8 * (pp & 1);
      vh[t] = __builtin_amdgcn_ds_read_tr16_b64_v4i16((__attribute__((address_space(3))) s16x4*)addr);
    }
    const bf16x8 vf = __builtin_shufflevector(vh[0], vh[1], 0, 1, 2, 3, 4, 5, 6, 7);
    if (act0) o[0][m] = __builtin_amdgcn_mfma_f32_16x16x32_bf16(vf, pb[0], o[0][m], 0, 0, 0);
    if (act1) o[1][m] = __builtin_amdgcn_mfma_f32_16x16x32_bf16(vf, pb[1], o[1][m], 0, 0, 0);
  }
}

__device__ __forceinline__ void attn_store_out(const P& p, const f32x4 (&o)[4], float lsum, int tok, int col0, int lane) {
  const int g = lane >> 4;
  lsum += __shfl_xor(lsum, 16);
  lsum += __shfl_xor(lsum, 32);
  const float inv = 1.f / lsum;
  if (F8_OUT) {
    unsigned char* op = (unsigned char*)p.mixb + (size_t)tok * 1024 + col0 + 4 * g;
    const float sc = inv * F8_SA_MIX;
#pragma unroll
    for (int m = 0; m < 4; ++m) *(unsigned*)(op + 16 * m) = f8_pack4(o[m][0] * sc, o[m][1] * sc, o[m][2] * sc, o[m][3] * sc);
  } else {
    bf16_t* op = p.mixb + (size_t)tok * 1024 + col0 + 4 * g;
#pragma unroll
    for (int m = 0; m < 4; ++m) *(uint2*)(op + 16 * m) = make_uint2(pack2bf(o[m][0] * inv, o[m][1] * inv), pack2bf(o[m][2] * inv, o[m][3] * inv));
  }
}

__device__ __forceinline__ void attn_win_item(const P& p, int l, int kind, int qb, int hs, char* smem) {
  const int tid = tid_opaque(), lane = tid & 63, wv = __builtin_amdgcn_readfirstlane(tid >> 6), g = lane >> 4, lr = lane & 15;
  int qoff, koff, voff, ooff; const float *gq, *gk; float sink2 = -1e30f; bool has_sink = false;
  if (kind == 0 || hs < 6) {
    const int h = hs, kvh = h / 3;
    qoff = OFF_QW + h * 64; koff = OFF_KW + kvh * 64; voff = OFF_VW + kvh * 64; ooff = 256 + h * 64;
    gq = p.win_qn + l * 64; gk = p.win_kn + l * 64; sink2 = p.win_sink[l * 6 + h] * LOG2E; has_sink = true;
  } else {
    const int h = hs - 6;
    qoff = OFF_QN + h * 64; koff = OFF_KN + h * 64; voff = OFF_VN + h * 64; ooff = 640 + h * 64;
    gq = p.na_qn + l * 64; gk = p.na_kn + l * 64;
  }
  float bound = 8.f * LOG2E * wave_max(fabsf(gq[lane])) * wave_max(fabsf(gk[lane])) * 1.0001f + 1e-3f;
  if (has_sink) bound = fmaxf(bound, sink2);
  const int q0 = qb * 128;
  const int qtok0 = (kind == 0 ? LC : 0) + q0 + 32 * wv;
  bf16x8 qf[2][2];
#pragma unroll
  for (int qt = 0; qt < 2; ++qt)
#pragma unroll
    for (int s = 0; s < 2; ++s) qf[qt][s] = *(const bf16x8*)(p.projb + (size_t)(qtok0 + 16 * qt + lr) * DIN + qoff + 32 * s + 8 * g);
  f32x4 o[2][4];
#pragma unroll
  for (int qt = 0; qt < 2; ++qt)
#pragma unroll
    for (int m = 0; m < 4; ++m) o[qt][m] = (f32x4){0.f, 0.f, 0.f, 0.f};
  float lsum[2] = {0.f, 0.f};
  const int nloc = (kind == 0) ? 6 : 0, nch = nloc + 4;
  auto tokfn = [&](int c) {
    return [=](int row) {
      if (c < nloc) { int pos = q0 - 128 + 64 * c + row; pos = pos < 0 ? 0 : (pos > SEQ - 1 ? SEQ - 1 : pos); return LC + pos; }
      return 64 * (c - nloc) + row;
    };
  };
  __syncthreads();
  kv_issue(p, smem, koff, voff, tokfn(0), wv, lane);
  kv_issue(p, smem + 16384, koff, voff, tokfn(1), wv, lane);
  kv_issue(p, smem + 32768, koff, voff, tokfn(2), wv, lane);
  for (int c = 0; c < nch; ++c) {
    kv_wait(nch - c);
    if (c + 3 < nch) kv_issue(p, smem + ((c + 3) & 3) * 16384, koff, voff, tokfn(c + 3), wv, lane);
    const char* stage = smem + (c & 3) * 16384;
    if (c < nloc) {
      const int qw0 = q0 + 32 * wv;
#pragma unroll
      for (int st = 0; st < 2; ++st) {
        const int kbase = q0 - 128 + 64 * c + 32 * st;
        const bool a0 = !(kbase - (qw0 + 15) > 128 || qw0 - (kbase + 31) > 128) && (kbase + 31 >= 0) && (kbase < SEQ);
        const bool a1 = !(kbase - (qw0 + 31) > 128 || (qw0 + 16) - (kbase + 31) > 128) && (kbase + 31 >= 0) && (kbase < SEQ);
        const bool allv = (kbase >= 0) && (kbase + 31 < SEQ) && (kbase + 31 - qw0 <= 128) && (qw0 + 31 - kbase <= 128);
        if (allv)
          attn_step2(stage, 32 * st, qf, o, lsum, [&](int qt, int t2, int r, float s) { return s - bound; }, lane, true, true);
        else if (a0 || a1)
          attn_step2(stage, 32 * st, qf, o, lsum, [&](int qt, int t2, int r, float s) {
            int kpos = kbase + 16 * t2 + 4 * g + r;
            int dlt = kpos - (qw0 + 16 * qt + lr); dlt = dlt < 0 ? -dlt : dlt;
            bool valid = (kpos >= 0) && (kpos < SEQ) && (dlt <= 128);
            return valid ? s - bound : -1e30f;
          }, lane, a0, a1);
      }
    } else {
#pragma unroll
      for (int st = 0; st < 2; ++st)
        attn_step2(stage, 32 * st, qf, o, lsum, [&](int qt, int t2, int r, float s) { return s - bound; }, lane, true, true);
    }
  }
#pragma unroll
  for (int qt = 0; qt < 2; ++qt) {
    float ls = lsum[qt];
    if (has_sink && g == 0) ls += __builtin_amdgcn_exp2f(sink2 - bound);
    attn_store_out(p, o[qt], ls, qtok0 + 16 * qt + lr, ooff, lane);
  }
}

__device__ __forceinline__ void attn_na_item(const P& p, int l, int rp, int h, char* smem) {
  const int tid = tid_opaque(), lane = tid & 63, wv = __builtin_amdgcn_readfirstlane(tid >> 6), g = lane >> 4, lr = lane & 15;
  const int qoff = OFF_QN + h * 64, koff = OFF_KN + h * 64, voff = OFF_VN + h * 64, ooff = 640 + h * 64;
  float* rpbl = (float*)(smem + 65536);
  const float* rpbg = p.rpb + (size_t)(l * 6 + h) * 465;
  float bmax = 0.f;
  __syncthreads();
  for (int i = tid; i < 465; i += 256) rpbl[i] = rpbg[i] * LOG2E;
  for (int i = lane; i < 465; i += 64) bmax = fmaxf(bmax, fabsf(rpbg[i]) * LOG2E);
  bmax = wave_max(bmax);
  const float bound = 8.f * LOG2E * wave_max(fabsf(p.na_qn[l * 64 + lane])) * wave_max(fabsf(p.na_kn[l * 64 + lane])) * 1.0001f + bmax + 1e-3f;
  const int r0 = 2 * rp;
  const int qcol = 16 * wv + lr;
  const int qtok0 = LC + r0 * 64 + qcol;
  const int kra = min(max(r0 - 4, 0), 248), krb = min(max(r0 + 1 - 4, 0), 248);
  const int nrow = krb + 8 - kra, nch = nrow + 4;
  const int kc0 = min(max(16 * wv - 8, 0), 32);
  const int qs = min(max(qcol - 8, 0), 48);
  bf16x8 qf[2][2];
#pragma unroll
  for (int qt = 0; qt < 2; ++qt)
#pragma unroll
    for (int s = 0; s < 2; ++s) qf[qt][s] = *(const bf16x8*)(p.projb + (size_t)(qtok0 + 64 * qt) * DIN + qoff + 32 * s + 8 * g);
  f32x4 o[2][4];
#pragma unroll
  for (int qt = 0; qt < 2; ++qt)
#pragma unroll
    for (int m = 0; m < 4; ++m) o[qt][m] = (f32x4){0.f, 0.f, 0.f, 0.f};
  float lsum[2] = {0.f, 0.f};
  auto tokfn = [&](int c) {
    return [=](int row) { return c < nrow ? LC + (kra + c) * 64 + row : 64 * (c - nrow) + row; };
  };
  kv_issue(p, smem, koff, voff, tokfn(0), wv, lane);
  kv_issue(p, smem + 16384, koff, voff, tokfn(1), wv, lane);
  kv_issue(p, smem + 32768, koff, voff, tokfn(2), wv, lane);
  for (int c = 0; c < nch; ++c) {
    kv_wait(nch - c);
    if (c + 3 < nch) kv_issue(p, smem + ((c + 3) & 3) * 16384, koff, voff, tokfn(c + 3), wv, lane);
    const char* stage = smem + (c & 3) * 16384;
    if (c < nrow) {
      const int krow = kra + c;
      const bool a0 = krow < kra + 8, a1 = krow >= krb;
      attn_step2(stage, kc0, qf, o, lsum, [&](int qt, int t2, int rr, float s) {
        int kcol = kc0 + 16 * t2 + 4 * g + rr;
        bool valid = (kcol >= qs) && (kcol < qs + 16);
        int dc = kcol - qcol + 15; dc = dc < 0 ? 0 : (dc > 30 ? 30 : dc);
        int dr = krow - (r0 + qt) + 7; dr = dr < 0 ? 0 : (dr > 14 ? 14 : dr);
        return valid ? s + rpbl[dr * 31 + dc] - bound : -1e30f;
      }, lane, a0, a1);
    } else {
#pragma unroll
      for (int st = 0; st < 2; ++st)
        attn_step2(stage, 32 * st, qf, o, lsum, [&](int qt, int t2, int rr, float s) { return s - bound; }, lane, true, true);
    }
  }
#pragma unroll
  for (int qt = 0; qt < 2; ++qt) attn_store_out(p, o[qt], lsum[qt], qtok0 + 64 * qt, ooff, lane);
}

struct ConvRow { float4 v[4]; };
__device__ __forceinline__ void conv_issue(const P& p, int l, int r, int lane, ConvRow& c) {
  const int tbl = r >> 14, e = r & 16383;
  const float4* src = (const float4*)((tbl ? p.pv : p.pu) + ((size_t)l * 16384 + e) * 1024) + lane * 4;
#pragma unroll
  for (int i = 0; i < 4; ++i) c.v[i] = src[i];
}
__device__ __forceinline__ void conv_finish(const P& p, int l, int r, int lane, const ConvRow& c) {
  const int tbl = r >> 14, e = r & 16383;
  float am = 0.f;
#pragma unroll
  for (int i = 0; i < 4; ++i) am = fmaxf(am, fmaxf(fmaxf(fabsf(c.v[i].x), fabsf(c.v[i].y)), fmaxf(fabsf(c.v[i].z), fabsf(c.v[i].w))));
  am = wave_max(am);
  const float sc = am > 0.f ? 224.f / am : 1.f;
  unsigned w[4];
#pragma unroll
  for (int i = 0; i < 4; ++i) {
    int t = __builtin_amdgcn_cvt_pk_fp8_f32(c.v[i].x * sc, c.v[i].y * sc, 0, false);
    t = __builtin_amdgcn_cvt_pk_fp8_f32(c.v[i].z * sc, c.v[i].w * sc, t, true);
    w[i] = (unsigned)t;
  }
  unsigned char* dst = (tbl ? p.vb8 : p.ub8) + (((size_t)l * 8 + (lane >> 3)) * 16384 + e) * 128 + (lane & 7) * 16;
  *(uint4*)dst = make_uint4(w[0], w[1], w[2], w[3]);
  if (lane == 0) (tbl ? p.vsc : p.usc)[l * 16384 + e] = am > 0.f ? am / 224.f : 1.f;
}

__device__ __forceinline__ void ph_attn(const P& p, int l, char* smem) {
  const int nitems = 1536 + (l == 0 ? 24 : 0);
  const int lane_ = tid_opaque() & 63, wv_ = tid_opaque() >> 6;
  const int nwv = gridDim.x * 4, gw = blockIdx.x * 4 + wv_;
  const int crq = (32768 + nwv - 1) / nwv;
  int cr = min(gw * crq, 32768);
  const int cr_end = min(cr + crq, 32768);
  const int per_item = ((crq + 2) / 3 + 3) & ~3;
  for (int it = blockIdx.x; it < nitems; it += gridDim.x) {
    if (it < 768) attn_win_item(p, l, 0, it / 6, it % 6, smem);
    else if (it < 1536) { int j = it - 768; attn_na_item(p, l, j / 6, j % 6, smem); }
    else { int j = it - 1536; attn_win_item(p, l, 1, j / 12, j % 12, smem); }
    for (int done = 0; done < per_item && cr < cr_end; done += 4, cr += 4) {
      ConvRow c0, c1, c2, c3;
      const bool h1 = cr + 1 < cr_end, h2 = cr + 2 < cr_end, h3 = cr + 3 < cr_end;
      conv_issue(p, l, cr, lane_, c0);
      conv_issue(p, l, h1 ? cr + 1 : cr, lane_, c1);
      conv_issue(p, l, h2 ? cr + 2 : cr, lane_, c2);
      conv_issue(p, l, h3 ? cr + 3 : cr, lane_, c3);
      conv_finish(p, l, cr, lane_, c0);
      if (h1) conv_finish(p, l, cr + 1, lane_, c1);
      if (h2) conv_finish(p, l, cr + 2, lane_, c2);
      if (h3) conv_finish(p, l, cr + 3, lane_, c3);
    }
  }
  for (; cr < cr_end; ++cr) { ConvRow c; conv_issue(p, l, cr, lane_, c); conv_finish(p, l, cr, lane_, c); }
}

__device__ __forceinline__ unsigned ord_key(float s) {
  unsigned u = __float_as_uint(s);
  return (u & 0x80000000u) ? ~u : (u | 0x80000000u);
}
__device__ __forceinline__ float ord_val(unsigned pk) {
  unsigned u = pk & ~127u;
  unsigned b = (u & 0x80000000u) ? (u & 0x7fffffffu) : ~u;
  return __uint_as_float(b);
}
__device__ __forceinline__ void ce_desc(unsigned& a, unsigned& b) {
  unsigned mx = a > b ? a : b, mn = a > b ? b : a;
  a = mx; b = mn;
}
__device__ __forceinline__ void sort16_desc(unsigned (&v)[16]) {
#pragma unroll
  for (int k = 2; k <= 16; k <<= 1) {
#pragma unroll
    for (int j = k >> 1; j > 0; j >>= 1) {
#pragma unroll
      for (int i = 0; i < 16; ++i) {
        int m = i ^ j;
        if (m > i) {
          if ((i & k) == 0) ce_desc(v[i], v[m]); else ce_desc(v[m], v[i]);
        }
      }
    }
  }
}
__device__ __forceinline__ void merge16_desc(unsigned (&a)[16], const unsigned (&b)[16]) {
#pragma unroll
  for (int i = 0; i < 16; ++i) { unsigned o = b[15 - i]; a[i] = a[i] > o ? a[i] : o; }
#pragma unroll
  for (int j = 8; j > 0; j >>= 1) {
#pragma unroll
    for (int i = 0; i < 16; ++i) {
      int m = i ^ j;
      if (m > i) ce_desc(a[i], a[m]);
    }
  }
}

typedef __attribute__((ext_vector_type(2))) float f32x2;
__device__ __forceinline__ void ph_prep_small(const P& p) {
  for (int i = GTID; i < 2 * 128 * 128; i += GSZ) { p.k1b[i] = f2bf(p.k1[i]); p.k2b[i] = f2bf(p.k2[i]); }
}

struct EpiPeerTopk {
  int l;
  __device__ __forceinline__ float pre(const P& p, int m0, int tid) const {
    float s = 0.f;
    if (tid < 128) {
#pragma unroll
      for (int q = 0; q < 8; ++q) s += p.rowss[(size_t)q * TT + m0 + tid];
    }
    return s;
  }
  __device__ __forceinline__ void operator()(const P& p, f32x4 (&acc)[4][4], int m0, int n0, int wm, int wn, int lane, char* smem, float epre) const {
    const int tid = ((wm * 2 + wn) << 6) | lane, g = lane >> 4, lr = lane & 15;
    const int nt = n0 >> 7, head = nt >> 1, hf = nt & 1;
    char* qimg = smem;
    char* kimg = smem + 34816;
    float* rinvl = (float*)(smem + 69632);
    if (tid < 128) rinvl[tid] = rsqrtf(epre * (1.f / 1024.f) + EPS);
    __syncthreads();
    {
      const float* bq = p.bq + (l * 2 + (m0 < LC ? 1 : 0)) * NPQ + n0 + wn * 64 + lr;
      float bqv[4];
#pragma unroll
      for (int j = 0; j < 4; ++j) bqv[j] = bq[16 * j];
      char* qw = qimg + (wm * 64 + 4 * g) * 272 + (wn * 64 + lr) * 2;
#pragma unroll
      for (int i = 0; i < 4; ++i)
#pragma unroll
        for (int r = 0; r < 4; ++r) {
          const float rv = rinvl[wm * 64 + 16 * i + 4 * g + r];
#pragma unroll
          for (int j = 0; j < 4; ++j) *(bf16_t*)(qw + (16 * i + r) * 272 + 32 * j) = f2bf(acc[i][j][r] * rv + bqv[j]);
        }
      const bf16_t* kk = (hf ? p.k2b : p.k1b) + (size_t)l * 16384 + (tid >> 4) * 128 + (tid & 15) * 8;
      char* kw = kimg + (tid >> 4) * 272 + (tid & 15) * 16;
#pragma unroll
      for (int i = 0; i < 8; ++i) *(uint4*)(kw + i * 16 * 272) = *(const uint4*)(kk + i * 16 * 128);
    }
    __syncthreads();
#pragma unroll
    for (int i = 0; i < 4; ++i)
#pragma unroll
      for (int j = 0; j < 4; ++j) acc[i][j] = (f32x4){0.f, 0.f, 0.f, 0.f};
    {
      const char* qa = qimg + (wm * 64 + lr) * 272 + g * 16;
      const char* kb = kimg + (wn * 64 + lr) * 272 + g * 16;
#pragma unroll
      for (int s = 0; s < 4; ++s) {
        bf16x8 af[4], bfr[4];
#pragma unroll
        for (int i = 0; i < 4; ++i) af[i] = *(const bf16x8*)(qa + i * 16 * 272 + s * 64);
#pragma unroll
        for (int j = 0; j < 4; ++j) bfr[j] = *(const bf16x8*)(kb + j * 16 * 272 + s * 64);
#pragma unroll
        for (int i = 0; i < 4; ++i)
#pragma unroll
          for (int j = 0; j < 4; ++j) acc[i][j] = __builtin_amdgcn_mfma_f32_16x16x32_bf16(af[i], bfr[j], acc[i][j], 0, 0, 0);
      }
    }
    __syncthreads();
    unsigned* simg = (unsigned*)smem;
    {
      unsigned* sw = simg + (wm * 64 + 4 * g) * 132 + wn * 64 + lr;
#pragma unroll
      for (int i = 0; i < 4; ++i)
#pragma unroll
        for (int r = 0; r < 4; ++r)
#pragma unroll
          for (int j = 0; j < 4; ++j)
            sw[(16 * i + r) * 132 + 16 * j] = (ord_key(acc[i][j][r]) & ~127u) | (unsigned)(wn * 64 + 16 * j + lr);
    }
    __syncthreads();
    const int row = tid & 127, half = tid >> 7;
    unsigned top[16];
    {
      const uint4* sr = (const uint4*)(simg + row * 132 + half * 64);
#pragma unroll
      for (int k = 0; k < 4; ++k) { const uint4 t = sr[k]; top[4 * k] = t.x; top[4 * k + 1] = t.y; top[4 * k + 2] = t.z; top[4 * k + 3] = t.w; }
      sort16_desc(top);
#pragma unroll 1
      for (int gi = 1; gi < 4; ++gi) {
        unsigned v1[16];
#pragma unroll
        for (int k = 0; k < 4; ++k) { const uint4 t = sr[gi * 4 + k]; v1[4 * k] = t.x; v1[4 * k + 1] = t.y; v1[4 * k + 2] = t.z; v1[4 * k + 3] = t.w; }
        sort16_desc(v1);
        merge16_desc(top, v1);
      }
    }
    __syncthreads();
    if (half == 1) {
#pragma unroll
      for (int k = 0; k < 16; ++k) simg[k * 128 + row] = top[k];
    }
    __syncthreads();
    if (half == 0) {
      unsigned o[16];
#pragma unroll
      for (int k = 0; k < 16; ++k) o[k] = simg[k * 128 + row];
      merge16_desc(top, o);
      uint4* dst = (uint4*)(p.pk + (((size_t)(m0 + row) * 8 + head) * 2 + hf) * 16);
#pragma unroll
      for (int k = 0; k < 4; ++k) dst[k] = make_uint4(top[4 * k], top[4 * k + 1], top[4 * k + 2], top[4 * k + 3]);
    }
  }
};

__device__ const unsigned char CAND_A[64] = {0,0,0,0,0,0,0,0,0,0,0,0,0,0,0,0, 1,1,1,1,1,1,1,1, 2,2,2,2,2, 3,3,3,3, 4,4,4, 5,5, 6,6, 7,7,
                                             8,9,10,11,12,13,14,15, 0,0,0,0,0,0,0,0,0,0,0,0,0,0};
__device__ const unsigned char CAND_B[64] = {0,1,2,3,4,5,6,7,8,9,10,11,12,13,14,15, 0,1,2,3,4,5,6,7, 0,1,2,3,4, 0,1,2,3, 0,1,2, 0,1, 0,1, 0,1,
                                             0,0,0,0,0,0,0,0, 0,0,0,0,0,0,0,0,0,0,0,0,0,0};

struct MergeTok { uint4 raw; float4 v[4]; };
__device__ __forceinline__ void merge_load(const P& p, int tk, int lane, int ca, int cb, MergeTok& s) {
  s.raw = *(const uint4*)(p.pk + (size_t)tk * 256 + lane * 4);
  const float4* xp = (const float4*)(p.xall + (size_t)tk * 1024) + lane * 4;
#pragma unroll
  for (int q = 0; q < 4; ++q) s.v[q] = xp[q];
}
__device__ __forceinline__ void merge_compute(const P& p, int l, int tk, int lane, int ca, int cb, const MergeTok& s, unsigned* candk, unsigned* pkl, int* elw, float* glw) {
  const float* n2g = p.norm2_g + l * 1024;
  const float* mod = p.mod + (l * 2 + (tk < LC ? 1 : 0)) * 6144;
  {
    float ss = 0.f;
#pragma unroll
    for (int q = 0; q < 4; ++q) ss += s.v[q].x * s.v[q].x + s.v[q].y * s.v[q].y + s.v[q].z * s.v[q].z + s.v[q].w * s.v[q].w;
    ss = wave_sum(ss);
    const float rinv = rsqrtf(ss * (1.f / 1024.f) + EPS);
    unsigned whi[4], wlo[4];
#pragma unroll
    for (int q = 0; q < 4; ++q) {
      float4 gg = ((const float4*)n2g)[lane * 4 + q], sc = ((const float4*)(mod + 4096))[lane * 4 + q], sh = ((const float4*)(mod + 3072))[lane * 4 + q];
      float h0 = s.v[q].x * rinv * gg.x * (1.f + sc.x) + sh.x, h1 = s.v[q].y * rinv * gg.y * (1.f + sc.y) + sh.y;
      float h2 = s.v[q].z * rinv * gg.z * (1.f + sc.z) + sh.z, h3 = s.v[q].w * rinv * gg.w * (1.f + sc.w) + sh.w;
      h0 *= 16.f; h1 *= 16.f; h2 *= 16.f; h3 *= 16.f;
      whi[q] = f8_pack4(h0, h1, h2, h3);
      const f32x2 d0 = __builtin_amdgcn_cvt_pk_f32_fp8((int)whi[q], false), d1 = __builtin_amdgcn_cvt_pk_f32_fp8((int)whi[q], true);
      wlo[q] = f8_pack4(h0 - d0[0], h1 - d0[1], h2 - d1[0], h3 - d1[1]);
    }
    unsigned char* hp = (unsigned char*)p.hb + (size_t)tk * 2048 + lane * 16;
    *(uint4*)hp = make_uint4(whi[0], whi[1], whi[2], whi[3]);
    *(uint4*)(hp + 1024) = make_uint4(wlo[0], wlo[1], wlo[2], wlo[3]);
  }
  *(uint4*)(pkl + lane * 4) = s.raw;
  unsigned p1[8], p2[8];
#pragma unroll
  for (int head = 0; head < 8; ++head) { p1[head] = pkl[head * 32 + ca]; p2[head] = pkl[head * 32 + 16 + cb]; }
  float sums[8];
#pragma unroll
  for (int head = 0; head < 8; ++head) {
    sums[head] = lane < 50 ? ord_val(p1[head]) + ord_val(p2[head]) : -3.0e38f;
    candk[head * 64 + lane] = (ord_key(sums[head]) & ~63u) | (unsigned)(63 - lane);
  }
#pragma unroll
  for (int head = 0; head < 8; ++head) {
    const float sum = sums[head];
    const unsigned kme = (ord_key(sum) & ~63u) | (unsigned)(63 - lane);
    int eid = (int)(p1[head] & 127u) * 128 + (int)(p2[head] & 127u);
    int rank = 0;
#pragma unroll
    for (int m4 = 0; m4 < 13; ++m4) {
      const uint4 km = *(const uint4*)(candk + head * 64 + 4 * m4);
      rank += (km.x > kme) ? 1 : 0;
      rank += (km.y > kme) ? 1 : 0;
      rank += (km.z > kme) ? 1 : 0;
      rank += (km.w > kme) ? 1 : 0;
    }
    const float mx = __int_as_float(__builtin_amdgcn_readlane(__float_as_int(sum), 0));
    bool sel = (lane < 50) && (rank < 16);
    float e = sel ? __expf(sum - mx) : 0.f;
    float tot = wave_sum(e);
    if (sel) {
      const int n = head * 16 + rank, idx = (n & 7) * 16 + (n >> 3);
      elw[idx] = eid;
      glw[idx] = e / tot;
    }
  }
  *(int2*)(p.el + (size_t)tk * 128 + 2 * lane) = *(const int2*)(elw + 2 * lane);
  *(float2*)(p.gl + (size_t)tk * 128 + 2 * lane) = *(const float2*)(glw + 2 * lane);
}
__device__ __forceinline__ void ph_peer_merge(const P& p, int l, int t0, char* smem) {
  const int tid = tid_opaque(), lane = tid & 63, wv = tid >> 6;
  const int ca = CAND_A[lane], cb = CAND_B[lane];
  unsigned* candA = (unsigned*)smem + wv * 2048;
  unsigned* candB = candA + 512;
  unsigned* pkl = candA + 1024;
  int* elw = (int*)(pkl + 256);
  float* glw = (float*)(elw + 128);
  const int nwv = gridDim.x * 4, gw = blockIdx.x * 4 + wv;
  for (int tk = t0 + gw; tk < TT; tk += 2 * nwv) {
    const int tkB = tk + nwv;
    const bool hasB = tkB < TT;
    MergeTok sA, sB;
    merge_load(p, tk, lane, ca, cb, sA);
    merge_load(p, hasB ? tkB : tk, lane, ca, cb, sB);
    merge_compute(p, l, tk, lane, ca, cb, sA, candA, pkl, elw, glw);
    if (hasB) merge_compute(p, l, tkB, lane, ca, cb, sB, candB, pkl, elw, glw);
  }
}

__device__ __forceinline__ uint4 bload(__amdgpu_buffer_rsrc_t rs, int voff) {
  const u32x4 v = __builtin_amdgcn_raw_buffer_load_b128(rs, voff, 0, 0);
  return make_uint4(v.x, v.y, v.z, v.w);
}
__device__ __forceinline__ void ph_peer_s1(const P& p, int l, int t0, const XcdWork& xw, char* smem) {
  const int tid = tid_opaque(), lane = tid & 63, wv = tid >> 6, m = lane & 15, g = lane >> 4;
  const unsigned char* U = p.ub8 + (size_t)l * 16384 * 1024;
  const AgeSplit ag = load_age_split((const float*)smem, t0, wv);
  const int step = ag.step, tend = ag.end;
  const __amdgpu_buffer_rsrc_t hrs = __builtin_amdgcn_make_buffer_rsrc((void*)p.hb, (short)0, TT * 2048, 0x00020000);
  const unsigned hsel = m < 4 ? (unsigned)((m & 1) * 1024 + (m >> 1) * 64 + 16 * g) : 0x80000000u;
  const int uo = 64 * (m & 1) + 16 * g;
  int* elb = (int*)smem + wv * 384;
  float* pdl = (float*)(elb + 256);
  for (int s = xw.li; s < 8; s += xw.np) {
    const unsigned roff = hsel + 128u * s;
    const __amdgpu_buffer_rsrc_t urs = __builtin_amdgcn_make_buffer_rsrc((void*)(U + (size_t)s * 16384 * 128), (short)0, 16384 * 128, 0x00020000);
    const int tk0 = ag.begin;
    if (tk0 >= tend) continue;
    uint4 ur[2][16]; uint4 hh[2]; int2 e2;
#define S1_LOAD_LIST(B, TK) { e2 = *(const int2*)(p.el + (size_t)(TK) * 128 + 2 * lane); hh[B] = bload(hrs, (int)((unsigned)(TK) * 2048u + roff)); }
#define S1_PUT_LIST(B) { *(int2*)(elb + (B) * 128 + 2 * lane) = e2; }
#define S1_ISSUE(B, TK) {                                                                            \
      int4 en[4];                                                                                    \
      { const int4* ep = (const int4*)(elb + (B) * 128 + (m >> 1) * 16); _Pragma("unroll") for (int q = 0; q < 4; ++q) en[q] = ep[q]; } \
      _Pragma("unroll") for (int q = 0; q < 4; ++q) {                                                \
        ur[B][4 * q + 0] = bload(urs, en[q].x * 128 + uo);                                           \
        ur[B][4 * q + 1] = bload(urs, en[q].y * 128 + uo);                                           \
        ur[B][4 * q + 2] = bload(urs, en[q].z * 128 + uo);                                           \
        ur[B][4 * q + 3] = bload(urs, en[q].w * 128 + uo);                                           \
      } }
#define S1_CONSUME(B, TK) {                                                                          \
      const long bl = (long)(((unsigned long long)hh[B].y << 32) | hh[B].x), bh = (long)(((unsigned long long)hh[B].w << 32) | hh[B].z); \
      float* pd = pdl + 32 * g;                                                                      \
      _Pragma("unroll") for (int half = 0; half < 2; ++half) {                                       \
        f32x4 acc[8];                                                                                \
        _Pragma("unroll") for (int G = 0; G < 8; ++G) {                                              \
          const uint4 u = ur[B][8 * half + G];                                                       \
          acc[G] = __builtin_amdgcn_mfma_f32_16x16x32_fp8_fp8((long)(((unsigned long long)u.y << 32) | u.x), bl, f32x4{0.f, 0.f, 0.f, 0.f}, 0, 0, 0); \
        }                                                                                            \
        _Pragma("unroll") for (int G = 0; G < 8; ++G) {                                              \
          const uint4 u = ur[B][8 * half + G];                                                       \
          acc[G] = __builtin_amdgcn_mfma_f32_16x16x32_fp8_fp8((long)(((unsigned long long)u.w << 32) | u.z), bh, acc[G], 0, 0, 0); \
        }                                                                                            \
        float o0[8], o1[8];                                                                          \
        _Pragma("unroll") for (int G = 0; G < 8; ++G) {                                              \
          float w0 = acc[G][0] + dpp_row<0x4E>(acc[G][1]), w1 = acc[G][2] + dpp_row<0x4E>(acc[G][3]); \
          o0[G] = w0 + dpp_row<0xB1>(w0); o1[G] = w1 + dpp_row<0xB1>(w1);                            \
        }                                                                                            \
        if (m == 0) {                                                                                \
          *(float4*)(pd + 8 * half) = make_float4(o0[0], o0[1], o0[2], o0[3]); *(float4*)(pd + 8 * half + 4) = make_float4(o0[4], o0[5], o0[6], o0[7]); \
          *(float4*)(pd + 16 + 8 * half) = make_float4(o1[0], o1[1], o1[2], o1[3]); *(float4*)(pd + 16 + 8 * half + 4) = make_float4(o1[4], o1[5], o1[6], o1[7]); \
        }                                                                                            \
      }                                                                                              \
      { const float2 pv = *(const float2*)(pdl + 2 * lane);                                           \
        ((unsigned*)p.pd)[((size_t)s * TT + (TK)) * 64 + lane] = pack2bf(pv.x, pv.y); } }
    S1_LOAD_LIST(0, tk0)
    S1_PUT_LIST(0)
    for (int tk = tk0; tk < tend; tk += 2 * step) {
      const bool has1 = tk + step < tend, has2 = tk + 2 * step < tend;
      if (has1) S1_LOAD_LIST(1, tk + step)
      asm volatile("" ::: "memory");
      S1_ISSUE(0, tk)
      S1_CONSUME(0, tk)
      if (has1) {
        S1_PUT_LIST(1)
        if (has2) S1_LOAD_LIST(0, tk + 2 * step)
        asm volatile("" ::: "memory");
        S1_ISSUE(1, tk + step)
        S1_CONSUME(1, tk + step)
        if (has2) S1_PUT_LIST(0)
      }
    }
#undef S1_LOAD_LIST
#undef S1_PUT_LIST
#undef S1_ISSUE
#undef S1_CONSUME
  }
}

__device__ __forceinline__ void ph_peer_r(const P& p, int l, int t0) {
  const float* usc = p.usc + l * 16384;
  const float* vsc = p.vsc + l * 16384;
  const int nidx = (TT - t0) * 32;
  for (int idx0 = GTID; idx0 < nidx; idx0 += 2 * GSZ) {
    float4 d[2]; int4 ex4[2]; float4 g4[2];
#pragma unroll
    for (int u = 0; u < 2; ++u) {
      const int idx = min(idx0 + u * GSZ, nidx - 1);
      const int tk = t0 + (idx >> 5), n0 = (idx & 31) * 4;
      ex4[u] = *(const int4*)(p.el + (size_t)tk * 128 + n0);
      g4[u] = *(const float4*)(p.gl + (size_t)tk * 128 + n0);
      d[u] = make_float4(0.f, 0.f, 0.f, 0.f);
#pragma unroll
      for (int s = 0; s < 8; ++s) {
        const uint2 v = *(const uint2*)((const unsigned*)p.pd + ((size_t)s * TT + tk) * 64 + (n0 >> 1));
        d[u].x += __uint_as_float(v.x << 16); d[u].y += __uint_as_float(v.x & 0xffff0000u); d[u].z += __uint_as_float(v.y << 16); d[u].w += __uint_as_float(v.y & 0xffff0000u);
      }
    }
#pragma unroll
    for (int u = 0; u < 2; ++u) {
      const int idx = idx0 + u * GSZ;
      if (idx < nidx) {
        const int tk = t0 + (idx >> 5), n0 = (idx & 31) * 4;
        const float dv[4] = {d[u].x, d[u].y, d[u].z, d[u].w};
        const int exv[4] = {ex4[u].x, ex4[u].y, ex4[u].z, ex4[u].w};
        const float gv[4] = {g4[u].x, g4[u].y, g4[u].z, g4[u].w};
        float o[4];
#pragma unroll
        for (int q = 0; q < 4; ++q) o[q] = gv[q] * gelu_f(dv[q] * (usc[exv[q]] * 0.0625f)) * vsc[exv[q]];
        *(float4*)(p.av + (size_t)tk * 128 + n0) = make_float4(o[0], o[1], o[2], o[3]);
      }
    }
  }
}

__device__ __forceinline__ void ph_peer_s2(const P& p, int l, int t0, const XcdWork& xw, char* smem) {
  const int tid = tid_opaque(), lane = tid & 63, wv = tid >> 6, j = lane >> 3, k = lane & 7;
  const int ko = lane >> 3, jo = lane & 7;
  float* red = (float*)smem + wv * 1408;
  int* elb = (int*)(red + 1024);
  float* avb = red + 1024 + 256;
  const unsigned char* V = p.vb8 + (size_t)l * 16384 * 1024;
  const AgeSplit ag = load_age_split((const float*)smem, t0, wv);
  const int step = ag.step, tend = ag.end;
  for (int s_ = xw.li; s_ < 8; s_ += xw.np) {
    const int s = (s_ + PROBE_ROT) & 7;
    const __amdgpu_buffer_rsrc_t vrs = __builtin_amdgcn_make_buffer_rsrc((void*)(V + (size_t)s * 16384 * 128), (short)0, 16384 * 128, 0x00020000);
    const int dim = 128 * s + 16 * ko + 2 * jo;
    int tk = ag.begin;
    if (tk >= tend) continue;
    const float2 g2l = *(const float2*)(p.mod + (l * 2 + 0) * 6144 + 5120 + dim), g2c = *(const float2*)(p.mod + (l * 2 + 1) * 6144 + 5120 + dim);
    float2 gsl = make_float2(0.f, 0.f), gsc = make_float2(0.f, 0.f);
    if (l == 0) {
      const float2 n1 = *(const float2*)(p.norm1_g + 1024 + dim);
      const float2 sl = *(const float2*)(p.mod + 2 * 6144 + 1024 + dim), sc = *(const float2*)(p.mod + 3 * 6144 + 1024 + dim);
      gsl = make_float2(n1.x * (1.f + sl.x), n1.y * (1.f + sl.y)); gsc = make_float2(n1.x * (1.f + sc.x), n1.y * (1.f + sc.y));
    }
    *(int2*)(elb + 2 * lane) = *(const int2*)(p.el + (size_t)tk * 128 + 2 * lane);
    float2 a_c = *(const float2*)(p.av + (size_t)tk * 128 + 2 * lane);
    float2 x_c = *(const float2*)(p.xall + (size_t)tk * 1024 + dim);
    int2 e_n = make_int2(0, 0);
    if (tk + step < tend) e_n = *(const int2*)(p.el + (size_t)(tk + step) * 128 + 2 * lane);
    int par = 0;
    for (; tk < tend; tk += step, par ^= 1) {
      uint4 vr[16];
      {
        const int4* eb = (const int4*)(elb + par * 128 + j * 16);
#pragma unroll
        for (int q = 0; q < 4; ++q) {
          const int4 e4 = eb[q];
          vr[4 * q + 0] = bload(vrs, e4.x * 128 + 16 * k);
          vr[4 * q + 1] = bload(vrs, e4.y * 128 + 16 * k);
          vr[4 * q + 2] = bload(vrs, e4.z * 128 + 16 * k);
          vr[4 * q + 3] = bload(vrs, e4.w * 128 + 16 * k);
        }
      }
      asm volatile("" ::: "memory");
      int2 e_f = e_n; float2 a_n = a_c, x_n = x_c;
      if (tk + 2 * step < tend) e_f = *(const int2*)(p.el + (size_t)(tk + 2 * step) * 128 + 2 * lane);
      if (tk + step < tend) {
        a_n = *(const float2*)(p.av + (size_t)(tk + step) * 128 + 2 * lane);
        x_n = *(const float2*)(p.xall + (size_t)(tk + step) * 1024 + dim);
      }
      asm volatile("" ::: "memory");
      const float2 a2 = a_c, xin = x_c;
      const float2 g2 = tk < LC ? g2c : g2l;
      if (tk + step < tend) *(int2*)(elb + (par ^ 1) * 128 + 2 * lane) = e_n;
      *(float2*)(avb + 2 * lane) = a2;
      float acc[16];
#pragma unroll
      for (int d = 0; d < 16; ++d) acc[d] = 0.f;
#pragma unroll
      for (int i4 = 0; i4 < 4; ++i4) {
        const float4 aq = *(const float4*)(avb + j * 16 + 4 * i4);
        const float av4[4] = {aq.x, aq.y, aq.z, aq.w};
#pragma unroll
        for (int ii = 0; ii < 4; ++ii) {
          const int i = 4 * i4 + ii;
          const float a = av4[ii];
          unsigned y[4] = {vr[i].x, vr[i].y, vr[i].z, vr[i].w};
#pragma unroll
          for (int q = 0; q < 4; ++q) {
            f32x2 lo = __builtin_amdgcn_cvt_pk_f32_fp8((int)y[q], false), hi = __builtin_amdgcn_cvt_pk_f32_fp8((int)y[q], true);
            acc[q * 4] += a * lo[0]; acc[q * 4 + 1] += a * lo[1]; acc[q * 4 + 2] += a * hi[0]; acc[q * 4 + 3] += a * hi[1];
          }
          if (i + 1 < 16) asm volatile("" : "+v"(acc[0]), "+v"(vr[i + 1].x), "+v"(vr[i + 1].y), "+v"(vr[i + 1].z), "+v"(vr[i + 1].w));
        }
      }
#pragma unroll
      for (int q = 0; q < 4; ++q) *(float4*)(red + lane * 16 + 4 * q) = make_float4(acc[4 * q], acc[4 * q + 1], acc[4 * q + 2], acc[4 * q + 3]);
      float f0 = 0.f, f1 = 0.f;
#pragma unroll
      for (int jj = 0; jj < 8; ++jj) {
        const float2 t = *(const float2*)(red + (jj * 8 + ko) * 16 + 2 * jo);
        f0 += t.x; f1 += t.y;
      }
      float2 o = make_float2(xin.x + g2.x * f0, xin.y + g2.y * f1);
      if (l == 1) *(float2*)(p.out + (size_t)(tk - LC) * 1024 + dim) = o;
      else {
        *(float2*)(p.xall + (size_t)tk * 1024 + dim) = o;
        const float2 gs = tk < LC ? gsc : gsl;
        if (F8_IN) *(unsigned short*)((unsigned char*)p.hb + (size_t)tk * 1024 + dim) = (unsigned short)f8_pack2(o.x * gs.x * F8_SA_H, o.y * gs.y * F8_SA_H);
        else *(unsigned*)(p.hb + (size_t)tk * 1024 + dim) = pack2bf(o.x * gs.x, o.y * gs.y);
        const float ssq = wave_sum(o.x * o.x + o.y * o.y);
        if (lane == 0) p.rowss[(size_t)s * TT + tk] = ssq;
      }
      a_c = a_n; x_c = x_n; e_n = e_f;
    }
  }
}

#define XB_TMO      128
#define XB_XCNT(j)  (256  + 64 * (j))
#define XB_XSUB(j)  (1280 + 64 * (j))
#define XB_XGEN(j)  (2304 + 64 * (j))
#define XB_TOP      3328
#define XB_TOPGEN   3392
#define XB_RANK(j)  (3456 + 64 * (j))
#define XCD_BAR_WORDS 4480
#define XB_SPIN_CAP (1u << 22)
__device__ __forceinline__ unsigned xb_ld(unsigned* q) { return __hip_atomic_load(q, __ATOMIC_RELAXED, __HIP_MEMORY_SCOPE_AGENT); }
__device__ __forceinline__ unsigned xb_add(unsigned* q, unsigned v) { return __hip_atomic_fetch_add(q, v, __ATOMIC_RELAXED, __HIP_MEMORY_SCOPE_AGENT); }
__device__ __forceinline__ unsigned xb_xcc_id() { return (unsigned)__builtin_amdgcn_s_getreg((3 << 11) | 20) & 0xFu; }
#define XB_SPIN(cond, bar) do { unsigned _sp = 0; while (cond) { __builtin_amdgcn_s_sleep(1); \
    if ((++_sp & 255u) == 0u) { if (xb_ld(&(bar)[XB_TMO])) break; if (_sp > XB_SPIN_CAP) { atomicAdd(&(bar)[XB_TMO], 1u); break; } } } } while (0)
#define XB_CUCTR    4608
#define XB_CLS(x, c) (8704 + 32 * ((x) * 2 + (c)))
#define XB_ALL_WORDS 16384
struct XcdBarrier { unsigned* bar; unsigned x; volatile LAS unsigned* st; };
__device__ __forceinline__ XcdBarrier xcd_barrier_post(unsigned* bar, volatile LAS unsigned* st) {
  XcdBarrier b; b.bar = bar; b.x = xb_xcc_id(); b.st = st;
  if (threadIdx.x == 0) {
    const unsigned key = (unsigned)__builtin_amdgcn_s_getreg((7 << 11) | (8 << 6) | 4) & 0xffu;
    const unsigned slot = xb_add(&bar[XB_CUCTR + b.x * 256u + key], 1u);
    const unsigned cls = slot > 0u ? 1u : 0u;
    st[4] = cls; st[5] = xb_add(&bar[XB_CLS(b.x, cls)], 1u);
    asm volatile("s_waitcnt vmcnt(0)" ::: "memory");
    (void)xb_add(&bar[XB_XCNT(b.x)], 1u); st[2] = xb_add(&bar[XB_RANK(b.x)], 1u);
  }
  return b;
}
__device__ __forceinline__ void xcd_barrier_complete(unsigned* bar, unsigned x, unsigned& nloc, unsigned& nx, unsigned& li) {
  const unsigned G = gridDim.x * gridDim.y * gridDim.z;
  unsigned sum, cnt, mine, below, sp = 0u;
  for (;;) {
    sum = 0u; cnt = 0u; mine = 0u; below = 0u;
#pragma unroll
    for (unsigned j = 0; j < 16; ++j) { const unsigned c = xb_ld(&bar[XB_XCNT(j)]); sum += c; cnt += (c > 0u) ? 1u : 0u; mine = (j == x) ? c : mine; below += (j < x && c > 0u) ? 1u : 0u; }
    if (sum == G) break;
    __builtin_amdgcn_s_sleep(1);
    if ((++sp & 255u) == 0u) { if (xb_ld(&bar[XB_TMO])) break; if (sp > XB_SPIN_CAP) { atomicAdd(&bar[XB_TMO], 1u); break; } }
  }
  nloc = mine > 0u ? mine : 1u; nx = cnt > 0u ? cnt : 1u; li = below;
}
__device__ __forceinline__ void xcd_barrier(const XcdBarrier& b) {
  asm volatile("s_waitcnt vmcnt(0)" ::: "memory");
  __syncthreads();
  if (threadIdx.x == 0) {
    unsigned* bar = b.bar;
    __builtin_amdgcn_s_waitcnt(0);
    unsigned nloc = b.st[0], nx = b.st[1];
    if (nloc == 0u) { unsigned li; xcd_barrier_complete(bar, b.x, nloc, nx, li); b.st[0] = nloc; b.st[1] = nx; b.st[3] = li;
                      b.st[6] = xb_ld(&bar[XB_CLS(b.x, 0)]); b.st[7] = xb_ld(&bar[XB_CLS(b.x, 1)]); }
    const unsigned old = xb_add(&bar[XB_XSUB(b.x)], 1u);
    const unsigned gen = old / nloc;
    if (old + 1u == (gen + 1u) * nloc) {
      __builtin_amdgcn_fence(__ATOMIC_RELEASE, "agent");
      asm volatile("s_waitcnt vmcnt(0)" ::: "memory");
      const unsigned og = xb_add(&bar[XB_TOP], 1u);
      const unsigned tg = og / nx;
      if (og + 1u == (tg + 1u) * nx) xb_add(&bar[XB_TOPGEN], 1u);
      else XB_SPIN(xb_ld(&bar[XB_TOPGEN]) == tg, bar);
      __builtin_amdgcn_fence(__ATOMIC_ACQUIRE, "agent");
      xb_add(&bar[XB_XGEN(b.x)], 1u);
      asm volatile("s_waitcnt vmcnt(0)" ::: "memory");
    } else {
      XB_SPIN(xb_ld(&bar[XB_XGEN(b.x)]) == gen, bar);
      __builtin_amdgcn_fence(__ATOMIC_ACQUIRE, "agent");
      asm volatile("s_waitcnt vmcnt(0)" ::: "memory");
    }
  }
  __syncthreads();
}

#ifndef PROBE_IV
#define PROBE_IV -1
#endif
#define PROBE_BLK 0
#define PROBE_ENDBAR 0
#define PROBE_OWN 0
__device__ __forceinline__ void probe_tick(int& cnt, unsigned long long* slots) {
  if (PROBE_IV >= 0) {
    if (threadIdx.x == 0 && (cnt == PROBE_IV || (cnt == PROBE_IV + 1 && !PROBE_OWN))) slots[cnt - PROBE_IV] = __builtin_amdgcn_s_memrealtime();
    cnt = __builtin_amdgcn_readfirstlane(cnt + 1);
  }
}
#define BARRIER() do { if (PROBE_IV >= 0 && PROBE_OWN && threadIdx.x == 0 && pcnt == PROBE_IV + 1) probe_t[1] = __builtin_amdgcn_s_memrealtime(); XcdBarrier xb_; xb_.bar = PP.bar; xb_.x = xb_xcc_id(); xb_.st = (volatile LAS unsigned*)(smem + 18432); xcd_barrier(xb_); probe_tick(pcnt, probe_t); } while (0)

typedef const __attribute__((address_space(4))) P* KP;
__device__ __forceinline__ P load_params(KP kp) {
#if defined(__HIP_DEVICE_COMPILE__)
  asm volatile("" : "+s"(kp));
  return *kp;
#else
  return P{};
#endif
}
#define PP load_params(kp)
__global__ void __launch_bounds__(256, 2) k_mega(P p_unused) {
  KP kp = (KP)__builtin_amdgcn_kernarg_segment_ptr();
  __shared__ __attribute__((aligned(16))) float smem[18432 + 12];
  uint4& xb_words = *(uint4*)(smem + 18432);
  cg::grid_group grid = cg::this_grid();
  if (threadIdx.x == 0) xb_words = make_uint4(0u, 0u, 0u, 0u);
  __syncthreads();
  unsigned long long* probe_t = (unsigned long long*)(smem + 18440);
  int pcnt = 0;
  asm volatile("" : "+s"(pcnt));
  probe_tick(pcnt, probe_t);
  (void)xcd_barrier_post(PP.bar, (volatile LAS unsigned*)&xb_words);
  ph_mod(PP, smem);
  ph_prep(PP, smem);
  ph_lru_prepw(PP);
  ph_rope_tab(PP);
  ph_prep_small(PP);
  { XcdBarrier xb_; xb_.bar = PP.bar; xb_.x = xb_xcc_id(); xb_.st = (volatile LAS unsigned*)(smem + 18432); xcd_barrier(xb_); }
  if (PP.bar == nullptr) grid.sync();
  probe_tick(pcnt, probe_t);
  ph_norm_mod(PP, 0, 0, 0, smem, true);
  ph_shb(PP);
  BARRIER();
#pragma unroll 1
  for (int l = 0; l < 2; ++l) {
    const int t0 = (l == 0) ? 0 : LC;
    { const P lp = PP; const XcdWork xwg = load_xw(smem); gemm_128<F8_IN != 0>(lp, lp.hb, (const unsigned char*)lp.w_in_t + (size_t)l * 1024 * DIN * (F8_IN ? 1 : 2), 1024, 0, TT, DIN, (char*)smem, EpiProj{l}, 0, &xwg); }
    if (l == 0) {
      const P lp = PP;
      const int b0 = (130 * 18) % (int)gridDim.x;
      gemm_128<false>(lp, lp.shb, lp.wq_t, 1024, 0, 128, NPQ, (char*)smem, EpiBias{lp.bq, NPQ, 1.f}, b0);
      gemm_128<false>(lp, lp.shb + 128 * 1024, lp.wq_t + (size_t)1024 * NPQ, 1024, 0, 128, NPQ, (char*)smem, EpiBias{lp.bq + 2 * NPQ, NPQ, 1.f}, (b0 + 16) % (int)gridDim.x);
      gemm_128<F8_IN != 0>(lp, lp.shb + 2 * 128 * 1024, (const unsigned char*)lp.w_in_t + (size_t)1024 * DIN * (F8_IN ? 1 : 2), 1024, 0, 128, DIN, (char*)smem, EpiBias{lp.bin, DIN, F8_IN ? 1.f / (F8_SA_H * F8_SB_W) : 1.f}, (b0 + 32) % (int)gridDim.x);
    }
    BARRIER();
    ph_lru<1>(PP, l, (char*)smem);
    ph_attn(PP, l, (char*)smem);
    BARRIER();
    ph_lru_carry(PP, smem);
    BARRIER();
    ph_lru<2>(PP, l, (char*)smem);
    BARRIER();
    { const P lp = PP; const XcdWork xwg = load_xw(smem); gemm_128<F8_OUT != 0>(lp, lp.mixb, (const unsigned char*)lp.w_out_t + (size_t)l * 1024 * 1024 * (F8_OUT ? 1 : 2), 1024, t0, TT, 1024, (char*)smem, EpiResid{l}, 0, &xwg); }
    BARRIER();
    { const P lp = PP; const XcdWork xwg = load_xw(smem); gemm_128<false>(lp, lp.hb, lp.wq_t + (size_t)l * 1024 * NPQ, 1024, t0, TT, NPQ, (char*)smem, EpiPeerTopk{l}, 0, &xwg); }
    BARRIER();
    ph_peer_merge(PP, l, t0, (char*)smem);
    BARRIER();
    ph_peer_s1(PP, l, t0, load_xw(smem), (char*)smem);
    BARRIER();
    ph_peer_r(PP, l, t0);
    BARRIER();
    ph_peer_s2(PP, l, t0, load_xw(smem), (char*)smem);
    if (l == 0 || PROBE_ENDBAR) BARRIER();
  }
  if (PROBE_IV >= 0) {
    probe_tick(pcnt, probe_t);
    __syncthreads();
    if (blockIdx.x == PROBE_BLK && threadIdx.x == 0) {
      const unsigned long long dt = (probe_t[1] - probe_t[0]) * 8ull, ts = __builtin_amdgcn_s_memrealtime();
      while (__builtin_amdgcn_s_memrealtime() - ts < dt) __builtin_amdgcn_s_sleep(8);
    }
  }
}

extern "C" void kernel_launch(void* const* d_in, const int* in_sizes, int n_in, void* d_out, int out_size, void* d_ws,
                              size_t ws_size, hipStream_t stream) {
  P p{};
  const float** fp = (const float**)&p;
  for (int i = 0; i < 28; ++i) fp[i] = (const float*)d_in[i];
  p.out = (float*)d_out;
  float* w = (float*)d_ws;
  size_t o = 0;
  auto carve = [&](size_t n) { float* r = w + o; o += (n + 63) & ~(size_t)63; return r; };
  p.bar = (unsigned*)carve(XB_ALL_WORDS);
  p.mod = carve(4 * 6144);
  p.xall = carve((size_t)TT * 1024);
  p.proj = carve((size_t)TT * 512);
  p.projb = (bf16_t*)carve((size_t)TT * DIN / 2);
  p.mixb = (bf16_t*)carve((size_t)TT * 512);
  p.hb = (bf16_t*)carve((size_t)TT * 512);
  p.w_in_t = (bf16_t*)carve((size_t)1024 * DIN);
  p.w_out_t = (bf16_t*)carve((size_t)1024 * 1024);
  p.wq_t = (bf16_t*)carve((size_t)1024 * NPQ);
  p.lruw_t = (bf16_t*)carve((size_t)2 * 2 * 4 * 2 * 4096 / 2);
  p.lagg = carve((size_t)2 * NCHUNK * 256 * 2);
  p.lcarry = carve((size_t)2 * NCHUNK * 256);
  p.ropetab = carve(320 * 16 * 2);
  p.rowss = carve((size_t)8 * TT);
  p.bq = carve(4 * NPQ);
  p.bin = carve(2 * DIN);
  p.shb = (bf16_t*)carve(3 * 128 * 1024 / 2);
  p.el = (int*)carve((size_t)TT * 128);
  p.gl = carve((size_t)TT * 128);
  p.av = carve((size_t)TT * 128);
  p.pd = carve((size_t)8 * TT * 128);
  p.pk = (unsigned*)carve((size_t)TT * 256);
  p.ub8 = (unsigned char*)carve((size_t)2 * 16384 * 1024 / 4);
  p.vb8 = (unsigned char*)carve((size_t)2 * 16384 * 1024 / 4);
  p.usc = carve(2 * 16384);
  p.vsc = carve(2 * 16384);
  p.k1b = (bf16_t*)carve(16384);
  p.k2b = (bf16_t*)carve(16384);
  p.lab = (float2*)carve((size_t)NCHUNK * 4 * 2 * 16 * 256 * 2);
  if (o * 4 > ws_size) { fprintf(stderr, "workspace too small: need %zu have %zu\n", o * 4, ws_size); return; }
  static int grid_blocks = 0;
  if (!grid_blocks) {
    int dev = 0, cus = 0, per_cu = 0;
    (void)hipGetDevice(&dev);
    (void)hipDeviceGetAttribute(&cus, hipDeviceAttributeMultiprocessorCount, dev);
    (void)hipOccupancyMaxActiveBlocksPerMultiprocessor(&per_cu, k_mega, 256, 0);
    if (per_cu > 2) per_cu = 2;
    grid_blocks = cus * per_cu;
  }
  (void)hipMemsetAsync(p.bar, 0, XB_ALL_WORDS * 4, stream);
  void* args[] = {&p};
  hipError_t e = hipLaunchCooperativeKernel((void*)k_mega, dim3(grid_blocks), dim3(256), args, 0, stream);
  if (e != hipSuccess) fprintf(stderr, "cooperative launch failed: %s (grid %d)\n", hipGetErrorString(e), grid_blocks);
}
```
